# Optimizing an MI355X kernel written in HIP

```python
import math
import jax, jax.numpy as jnp
from jax import lax
import numpy as np

D_MODEL = 1024
BATCH = 16
SEQ = 2048
DEPTH = 1

MEM_LEN = 256
HEAD_DIM = 128
ATTN_HEADS = 6
ATTN_KV_HEADS = 2
ATTN_GROUP = ATTN_HEADS // ATTN_KV_HEADS
WINDOW = 128
BLOCK = 128
ROPE_DIM = HEAD_DIM // 4
ROPE_THETA = 500000.0
LRU_WIDTH = 768
LRU_BLOCKS = 6
LRU_BLOCK_W = LRU_WIDTH // LRU_BLOCKS
CONV_WIDTH = 4
CONV_LEFT = CONV_WIDTH // 2
LRU_C = 8.0
MEM_HEADS = 4
N_BRANCH = 3
PEER_HEADS = 8
PEER_KEYS = 128
PEER_EXPERTS = PEER_KEYS * PEER_KEYS
PEER_QDIM = 256
PEER_HALF = PEER_QDIM // 2
PEER_TOPK = 16
PEER_CHUNK = 128
EPS = 1e-6
NEG_INF = -1e30

ATTN_Q_W = ATTN_HEADS * HEAD_DIM
ATTN_KV_W = ATTN_KV_HEADS * HEAD_DIM
MEM_Q_W = MEM_HEADS * HEAD_DIM
GATE_W = N_BRANCH * D_MODEL
IN_W = ATTN_Q_W + 2 * ATTN_KV_W + 2 * LRU_WIDTH + MEM_Q_W + GATE_W

kernel_name = "hybrid_swa_rglru_mem_peer_encoder"


def rmsnorm(x, g):
    xf = x.astype(jnp.float32)
    y = xf * lax.rsqrt(jnp.mean(xf * xf, axis=-1, keepdims=True) + EPS) * g.astype(jnp.float32)
    return y.astype(x.dtype)


def partial_rope(t, positions):
    half = ROPE_DIM // 2
    inv_freq = ROPE_THETA ** (-jnp.arange(0, ROPE_DIM, 2, dtype=jnp.float32) / ROPE_DIM)
    ang = positions.astype(jnp.float32)[..., None] * inv_freq
    cos = jnp.cos(ang)[:, :, None, :]
    sin = jnp.sin(ang)[:, :, None, :]
    tr = t[..., :ROPE_DIM].astype(jnp.float32)
    t1, t2 = tr[..., :half], tr[..., half:]
    rot = jnp.concatenate([t1 * cos - t2 * sin, t2 * cos + t1 * sin], axis=-1)
    return jnp.concatenate([rot.astype(t.dtype), t[..., ROPE_DIM:]], axis=-1)


def band_blocks(t, nb):
    b = t.shape[0]
    tp = jnp.pad(t, ((0, 0), (BLOCK, BLOCK), (0, 0), (0, 0)))
    tp = tp.reshape(b, nb + 2, BLOCK, t.shape[2], t.shape[3])
    return jnp.concatenate([tp[:, :-2], tp[:, 1:-1], tp[:, 2:]], axis=2)


def windowed_gqa(q, k, v, sink):
    b, s = q.shape[0], q.shape[1]
    nb = s // BLOCK
    qb = q.reshape(b, nb, BLOCK, ATTN_KV_HEADS, ATTN_GROUP, HEAD_DIM)
    kb = band_blocks(k, nb)
    vb = band_blocks(v, nb)
    scores = jnp.einsum('bnqkgd,bnskd->bnkgqs', qb, kb).astype(jnp.float32) * (HEAD_DIM ** -0.5)
    blk = jnp.arange(nb, dtype=jnp.int32)[:, None]
    q_pos = blk * BLOCK + jnp.arange(BLOCK, dtype=jnp.int32)[None, :]
    k_pos = blk * BLOCK - BLOCK + jnp.arange(3 * BLOCK, dtype=jnp.int32)[None, :]
    valid = ((k_pos[:, None, :] >= 0) & (k_pos[:, None, :] < s)
             & (jnp.abs(k_pos[:, None, :] - q_pos[:, :, None]) <= WINDOW))
    scores = jnp.where(valid[None, :, None, None], scores, NEG_INF)
    sink_b = jnp.broadcast_to(sink.astype(jnp.float32).reshape(ATTN_KV_HEADS, ATTN_GROUP)[None, None, :, :, None, None],
                              scores.shape[:-1] + (1,))
    p = jax.nn.softmax(jnp.concatenate([scores, sink_b], axis=-1), axis=-1)[..., :-1]
    out = jnp.einsum('bnkgqs,bnskd->bnqkgd', p.astype(v.dtype), vb)
    return out.reshape(b, s, ATTN_Q_W)


def centred_depthwise_conv(t, w, bias):
    s = t.shape[1]
    tp = jnp.pad(t, ((0, 0), (CONV_LEFT, CONV_WIDTH - 1 - CONV_LEFT), (0, 0)))
    y = bias[None, None, :]
    for j in range(CONV_WIDTH):
        y = y + w[j][None, None, :] * tp[:, j:j + s]
    return y


def _lin_comb(c1, c2):
    a1, b1 = c1
    a2, b2 = c2
    return a1 * a2, a2 * b1 + b2


def bidir_rglru(xc, w_r, b_r, w_i, b_i, lam):
    b, s = xc.shape[0], xc.shape[1]
    xf = xc.astype(jnp.float32)
    xblk = xf.reshape(b, s, LRU_BLOCKS, LRU_BLOCK_W)
    r = jax.nn.sigmoid(jnp.einsum('bshc,dhce->dbshe', xblk, w_r.astype(jnp.float32)).reshape(2, b, s, LRU_WIDTH)
                       + b_r.astype(jnp.float32)[:, None, None, :])
    i = jax.nn.sigmoid(jnp.einsum('bshc,dhce->dbshe', xblk, w_i.astype(jnp.float32)).reshape(2, b, s, LRU_WIDTH)
                       + b_i.astype(jnp.float32)[:, None, None, :])
    log_a = -LRU_C * r * jax.nn.softplus(-lam.astype(jnp.float32))[:, None, None, :]
    a = jnp.exp(log_a)
    bx = jnp.sqrt(-jnp.expm1(2.0 * log_a)) * (i * xf[None])
    _, h_fwd = lax.associative_scan(_lin_comb, (a[0], bx[0]), axis=1)
    _, h_bwd = lax.associative_scan(_lin_comb, (a[1], bx[1]), axis=1, reverse=True)
    return (h_fwd + h_bwd).astype(xc.dtype)


def memory_cross_attention(q, k, v):
    scores = jnp.einsum('bshd,bmhd->bhsm', q, k).astype(jnp.float32) * (HEAD_DIM ** -0.5)
    p = jax.nn.softmax(scores, axis=-1)
    out = jnp.einsum('bhsm,bmhd->bshd', p.astype(v.dtype), v)
    return out.reshape(q.shape[0], q.shape[1], MEM_Q_W)


def peer_ffn(h, w_q, sub_keys, u_tab, v_tab):
    b, s, d = h.shape
    q = (h @ w_q).reshape(b, s, PEER_HEADS, 2, PEER_HALF)
    sc = jnp.einsum('bshpc,hpkc->bshpk', q, sub_keys).astype(jnp.float32)
    top_v, top_i = lax.top_k(sc, PEER_TOPK)
    cand_v = (top_v[..., 0, :, None] + top_v[..., 1, None, :]).reshape(b, s, PEER_HEADS, PEER_TOPK * PEER_TOPK)
    cand_i = (top_i[..., 0, :, None] * PEER_KEYS + top_i[..., 1, None, :]).reshape(b, s, PEER_HEADS, PEER_TOPK * PEER_TOPK)
    best_v, best_pos = lax.top_k(cand_v, PEER_TOPK)
    idx = jnp.take_along_axis(cand_i, best_pos, axis=-1)
    gate = jax.nn.softmax(best_v, axis=-1)
    n_tok = b * s
    n_chunk = n_tok // PEER_CHUNK
    hc = h.reshape(n_chunk, PEER_CHUNK, d)
    ic = idx.reshape(n_chunk, PEER_CHUNK, PEER_HEADS, PEER_TOPK)
    gc = gate.reshape(n_chunk, PEER_CHUNK, PEER_HEADS, PEER_TOPK)

    def expert_chunk(args):
        hx, ix, gx = args
        u = u_tab[ix]
        act = jax.nn.gelu(jnp.einsum('chkd,cd->chk', u, hx).astype(jnp.float32))
        vv = v_tab[ix]
        return jnp.einsum('chk,chkd->cd', (gx * act).astype(vv.dtype), vv)

    out = lax.map(expert_chunk, (hc, ic, gc))
    return out.reshape(b, s, d)


def setup_inputs(seed: int = 0) -> dict:
    key = jax.random.key(seed)
    ks = jax.random.split(key, 32)
    f32 = jnp.float32
    nrm = lambda k, shape, scale: jax.random.normal(k, shape, f32) * scale
    u = jax.random.uniform(ks[12], (DEPTH, 2, LRU_WIDTH), f32, 0.9, 0.999)
    a0 = u ** (1.0 / LRU_C)
    lam = jnp.log(a0) - jnp.log1p(-a0)
    return {
        "x": nrm(ks[0], (BATCH, SEQ, D_MODEL), 1.0),
        "mem": nrm(ks[1], (BATCH, MEM_LEN, D_MODEL), 1.0),
        "positions": jnp.broadcast_to(jnp.arange(SEQ, dtype=jnp.int32)[None, :], (BATCH, SEQ)),
        "g_mix": 1.0 + nrm(ks[2], (DEPTH, D_MODEL), 0.02),
        "g_mem": 1.0 + nrm(ks[3], (DEPTH, D_MODEL), 0.02),
        "w_in": nrm(ks[4], (DEPTH, D_MODEL, IN_W), D_MODEL ** -0.5),
        "gate_b": nrm(ks[5], (DEPTH, GATE_W), 0.02),
        "attn_sink": nrm(ks[6], (DEPTH, ATTN_HEADS), 0.5),
        "conv_w": nrm(ks[7], (DEPTH, CONV_WIDTH, LRU_WIDTH), CONV_WIDTH ** -0.5),
        "conv_b": nrm(ks[8], (DEPTH, LRU_WIDTH), 0.02),
        "lru_wr": nrm(ks[9], (DEPTH, 2, LRU_BLOCKS, LRU_BLOCK_W, LRU_BLOCK_W), LRU_BLOCK_W ** -0.5),
        "lru_br": nrm(ks[10], (DEPTH, 2, LRU_WIDTH), 0.02),
        "lru_wi": nrm(ks[11], (DEPTH, 2, LRU_BLOCKS, LRU_BLOCK_W, LRU_BLOCK_W), LRU_BLOCK_W ** -0.5),
        "lru_bi": nrm(ks[13], (DEPTH, 2, LRU_WIDTH), 0.02),
        "lru_lambda": lam,
        "w_mem_kv": nrm(ks[14], (DEPTH, D_MODEL, 2 * MEM_Q_W), D_MODEL ** -0.5),
        "p_attn": nrm(ks[15], (DEPTH, ATTN_Q_W, D_MODEL), ATTN_Q_W ** -0.5),
        "p_lru": nrm(ks[16], (DEPTH, LRU_WIDTH, D_MODEL), LRU_WIDTH ** -0.5),
        "p_mem": nrm(ks[17], (DEPTH, MEM_Q_W, D_MODEL), MEM_Q_W ** -0.5),
        "w_out": nrm(ks[18], (DEPTH, D_MODEL, D_MODEL), D_MODEL ** -0.5),
        "g_ffn": 1.0 + nrm(ks[19], (DEPTH, D_MODEL), 0.02),
        "w_peer_q": nrm(ks[20], (DEPTH, D_MODEL, PEER_HEADS * PEER_QDIM), D_MODEL ** -0.5),
        "peer_sub_keys": nrm(ks[21], (DEPTH, PEER_HEADS, 2, PEER_KEYS, PEER_HALF), PEER_HALF ** -0.5),
        "peer_u": nrm(ks[22], (DEPTH, PEER_EXPERTS, D_MODEL), D_MODEL ** -0.5),
        "peer_v": nrm(ks[23], (DEPTH, PEER_EXPERTS, D_MODEL), 0.25),
        "g_final": 1.0 + nrm(ks[24], (D_MODEL,), 0.02),
    }


def reference(x, mem, positions, g_mix, g_mem, w_in, gate_b, attn_sink, conv_w, conv_b,
              lru_wr, lru_br, lru_wi, lru_bi, lru_lambda, w_mem_kv, p_attn, p_lru, p_mem,
              w_out, g_ffn, w_peer_q, peer_sub_keys, peer_u, peer_v, g_final):
    b, s, d = x.shape
    offs = [int(o) for o in np.cumsum([ATTN_Q_W, ATTN_KV_W, ATTN_KV_W, LRU_WIDTH, LRU_WIDTH, MEM_Q_W])]
    for l in range(DEPTH):
        h = rmsnorm(x, g_mix[l])
        proj = h @ w_in[l]
        q_a, k_a, v_a, x_l, gate_l, q_m, gates = jnp.split(proj, offs, axis=-1)
        q_a = partial_rope(q_a.reshape(b, s, ATTN_HEADS, HEAD_DIM), positions)
        k_a = partial_rope(k_a.reshape(b, s, ATTN_KV_HEADS, HEAD_DIM), positions)
        v_a = v_a.reshape(b, s, ATTN_KV_HEADS, HEAD_DIM)
        attn_out = windowed_gqa(q_a, k_a, v_a, attn_sink[l])
        xc = centred_depthwise_conv(x_l, conv_w[l], conv_b[l])
        lru_out = bidir_rglru(xc, lru_wr[l], lru_br[l], lru_wi[l], lru_bi[l], lru_lambda[l]) * jax.nn.gelu(gate_l)
        kv_m = rmsnorm(mem, g_mem[l]) @ w_mem_kv[l]
        k_m = kv_m[..., :MEM_Q_W].reshape(b, MEM_LEN, MEM_HEADS, HEAD_DIM)
        v_m = kv_m[..., MEM_Q_W:].reshape(b, MEM_LEN, MEM_HEADS, HEAD_DIM)
        mem_out = memory_cross_attention(q_m.reshape(b, s, MEM_HEADS, HEAD_DIM), k_m, v_m)
        g = jax.nn.sigmoid(gates + gate_b[l]).reshape(b, s, N_BRANCH, d)
        merged = (g[:, :, 0] * (attn_out @ p_attn[l])
                  + g[:, :, 1] * (lru_out @ p_lru[l])
                  + g[:, :, 2] * (mem_out @ p_mem[l]))
        x = x + merged @ w_out[l]
        h2 = rmsnorm(x, g_ffn[l])
        x = x + peer_ffn(h2, w_peer_q[l], peer_sub_keys[l], peer_u[l], peer_v[l])
    return rmsnorm(x, g_final)
```

```cpp
#include <hip/hip_runtime.h>
#include <stdint.h>
#include <stdio.h>

typedef unsigned short bf16_t;
typedef short bf16x8 __attribute__((ext_vector_type(8)));
typedef __bf16 bf16x2v __attribute__((ext_vector_type(2)));
typedef float f32x4 __attribute__((ext_vector_type(4)));

constexpr int B_ = 16, S_ = 2048, D_ = 1024, NTOK = B_ * S_;
constexpr int MEML = 256, NMEM = B_ * MEML;
constexpr int INW = 6400;
constexpr int LW = 768;
constexpr int NEXP = 16384;
constexpr float EPS = 1e-6f;
constexpr float QSCALE = 0.08838834764831845f;

constexpr size_t OFF_WINT = 0;
constexpr size_t OFF_WMKVT = OFF_WINT + (size_t)INW * 1024 * 2;
constexpr size_t OFF_PATTNT = OFF_WMKVT + (size_t)1024 * 1024 * 2;
constexpr size_t OFF_PLRUT = OFF_PATTNT + (size_t)1024 * 768 * 2;
constexpr size_t OFF_PMEMT = OFF_PLRUT + (size_t)1024 * 768 * 2;
constexpr size_t OFF_WOUTT = OFF_PMEMT + (size_t)1024 * 512 * 2;
constexpr size_t OFF_WPQT = OFF_WOUTT + (size_t)1024 * 1024 * 2;
constexpr size_t OFF_LRUWT = OFF_WPQT + (size_t)2048 * 1024 * 2;
constexpr size_t OFF_SUBK = OFF_LRUWT + (size_t)6 * 512 * 128 * 2;
constexpr size_t OFF_UB = OFF_SUBK + (size_t)16 * 128 * 128 * 2;
constexpr size_t OFF_VB = OFF_UB + (size_t)NEXP * 1024 * 2;
constexpr size_t OFF_RA = OFF_VB + (size_t)NEXP * 1024 * 2;
constexpr size_t OFF_QA = OFF_RA;
constexpr size_t OFF_KA = OFF_QA + (size_t)NTOK * 768 * 2;
constexpr size_t OFF_VAT = OFF_KA + (size_t)NTOK * 256 * 2;
constexpr size_t OFF_XL = OFF_VAT + (size_t)NTOK * 256 * 2;
constexpr size_t OFF_GL = OFF_XL + (size_t)NTOK * 768 * 2;
constexpr size_t OFF_QM = OFF_GL + (size_t)NTOK * 768 * 2;
constexpr size_t OFF_GATES = OFF_QM + (size_t)NTOK * 512 * 2;
constexpr size_t OFF_END = OFF_GATES + (size_t)NTOK * 3072 * 2;
constexpr size_t OFF_MERGED = OFF_KA;
constexpr size_t OFF_QPEER = OFF_GATES;
constexpr size_t OFF_TOPL = OFF_QPEER + (size_t)NTOK * 2048 * 2;
constexpr size_t OFF_EIDX = OFF_TOPL + (size_t)NTOK * 256 * 4;
constexpr size_t OFF_EGATE = OFF_EIDX + (size_t)NTOK * 128 * 4;
static_assert(OFF_EGATE + (size_t)NTOK * 128 * 4 <= OFF_END, "overlay");
static_assert(OFF_MERGED + (size_t)NTOK * 1024 * 2 <= OFF_GL, "overlay2");
constexpr size_t DO_HBF = 0;
constexpr size_t DO_MEMBF = DO_HBF + (size_t)NTOK * 1024 * 2;
constexpr size_t DO_KM = DO_MEMBF + (size_t)NMEM * 1024 * 2;
constexpr size_t DO_VMT = DO_KM + (size_t)NMEM * 512 * 2;
constexpr size_t DO_ROPE = DO_VMT + (size_t)NMEM * 512 * 2;
static_assert(DO_ROPE + (size_t)NTOK * 32 * 4 <= (size_t)NTOK * 1024 * 4, "d_out scratch");

struct Params {
    const float *x, *mem; const int* positions;
    const float *g_mix, *g_mem, *w_in, *gate_b, *attn_sink, *conv_w, *conv_b, *lru_wr, *lru_br, *lru_wi, *lru_bi, *lru_lambda,
        *w_mem_kv, *p_attn, *p_lru, *p_mem, *w_out, *g_ffn, *w_peer_q, *peer_sub_keys, *peer_u, *peer_v, *g_final;
    float* out; unsigned char* ws;
};

__device__ __forceinline__ float bf2f(bf16_t b) { return __uint_as_float(((unsigned)b) << 16); }
__device__ __forceinline__ float bflo(unsigned u) { return __uint_as_float(u << 16); }
__device__ __forceinline__ float bfhi(unsigned u) { return __uint_as_float(u & 0xffff0000u); }
__device__ __forceinline__ unsigned pack_bf16(float lo, float hi) { unsigned r; asm("v_cvt_pk_bf16_f32 %0, %1, %2" : "=v"(r) : "v"(lo), "v"(hi)); return r; }
__device__ __forceinline__ bf16_t f2bf(float f) { return (bf16_t)(pack_bf16(f, 0.f) & 0xffffu); }
__device__ __forceinline__ f32x4 mfma16(bf16x8 a, bf16x8 b, f32x4 c) { return __builtin_amdgcn_mfma_f32_16x16x32_bf16(a, b, c, 0, 0, 0); }
__device__ __forceinline__ float sigmoidf_(float x) { return 1.0f / (1.0f + __expf(-x)); }
__device__ __forceinline__ float gelu_tanh(float x) { const float u = 1.5957691216057308f * (x + 0.044715f * x * x * x); return x / (1.0f + __expf(-u)); }
__device__ __forceinline__ float wave_sum(float v) {
#pragma unroll
    for (int o = 32; o >= 1; o >>= 1) v += __shfl_xor(v, o);
    return v;
}

__device__ void convT_tile(const float* __restrict__ src, bf16_t* __restrict__ dst, int K, int N, int tile, unsigned char* smem) {
    float* t = (float*)smem;
    const int tn = N / 64, tk = tile / tn, tnn = tile % tn, k0 = tk * 64, n0 = tnn * 64, tid = threadIdx.x;
    const int r = tid >> 4, c4 = (tid & 15) * 4;
#pragma unroll
    for (int i = 0; i < 4; ++i) {
        const int k = r + 16 * i;
        const float4 v = *(const float4*)(src + (size_t)(k0 + k) * N + n0 + c4);
        t[k * 65 + c4 + 0] = v.x; t[k * 65 + c4 + 1] = v.y; t[k * 65 + c4 + 2] = v.z; t[k * 65 + c4 + 3] = v.w;
    }
    __syncthreads();
    const int n = tid >> 2, kq = (tid & 3) * 16;
    unsigned w[8];
#pragma unroll
    for (int i = 0; i < 8; ++i) w[i] = pack_bf16(t[(kq + 2 * i) * 65 + n], t[(kq + 2 * i + 1) * 65 + n]);
    uint4* d = (uint4*)(dst + (size_t)(n0 + n) * K + k0 + kq);
    d[0] = make_uint4(w[0], w[1], w[2], w[3]); d[1] = make_uint4(w[4], w[5], w[6], w[7]);
    __syncthreads();
}

__global__ void __launch_bounds__(256) k_convT(const float* src, bf16_t* dst, int K, int N) {
    __shared__ __attribute__((aligned(16))) unsigned char smem[64 * 65 * 4];
    const int nt = (K / 64) * (N / 64);
    for (int t = blockIdx.x; t < nt; t += gridDim.x) convT_tile(src, dst, K, N, t, smem);
}
__global__ void __launch_bounds__(256) k_convT_lru(const float* wr, const float* wi, bf16_t* dst) {
    __shared__ __attribute__((aligned(16))) unsigned char smem[64 * 65 * 4];
    for (int u = blockIdx.x; u < 24 * 4; u += gridDim.x) {
        const int mat = u >> 2, tile = u & 3, gsel = mat / 6, h = mat % 6, dir = gsel & 1;
        const float* src = (gsel < 2 ? wr : wi) + (size_t)(dir * 6 + h) * 128 * 128;
        convT_tile(src, dst + (size_t)(h * 512 + gsel * 128) * 128, 128, 128, tile, smem);
    }
}
__global__ void __launch_bounds__(256) k_conv(const float* __restrict__ src, bf16_t* __restrict__ dst, size_t n8) {
    for (size_t i = (size_t)blockIdx.x * 256 + threadIdx.x; i < n8; i += (size_t)gridDim.x * 256) {
        const float4 a = ((const float4*)src)[2 * i], b = ((const float4*)src)[2 * i + 1];
        ((uint4*)dst)[i] = make_uint4(pack_bf16(a.x, a.y), pack_bf16(a.z, a.w), pack_bf16(b.x, b.y), pack_bf16(b.z, b.w));
    }
}
__device__ __forceinline__ void rms_row_bf16(const float* __restrict__ xr, const float* __restrict__ g, bf16_t* __restrict__ o, int lane) {
    float4 v[4]; float ss = 0.f;
#pragma unroll
    for (int i = 0; i < 4; ++i) { v[i] = *(const float4*)(xr + i * 256 + lane * 4); ss += v[i].x * v[i].x + v[i].y * v[i].y + v[i].z * v[i].z + v[i].w * v[i].w; }
    ss = wave_sum(ss);
    const float rs = rsqrtf(ss * (1.0f / 1024.0f) + EPS);
#pragma unroll
    for (int i = 0; i < 4; ++i) {
        const float4 gg = *(const float4*)(g + i * 256 + lane * 4);
        *(uint2*)(o + i * 256 + lane * 4) = make_uint2(pack_bf16(v[i].x * rs * gg.x, v[i].y * rs * gg.y), pack_bf16(v[i].z * rs * gg.z, v[i].w * rs * gg.w));
    }
}
__global__ void __launch_bounds__(256) k_rms(const float* __restrict__ x, const float* __restrict__ g, bf16_t* __restrict__ o, int rows) {
    const int lane = threadIdx.x & 63, wid = threadIdx.x >> 6;
    for (int r = blockIdx.x * 4 + wid; r < rows; r += gridDim.x * 4) rms_row_bf16(x + (size_t)r * 1024, g, o + (size_t)r * 1024, lane);
}
__global__ void __launch_bounds__(256) k_rope(const int* __restrict__ pos, float* __restrict__ cs) {
    const int i = blockIdx.x * 256 + threadIdx.x;
    if (i >= NTOK * 16) return;
    const int t = i >> 4, f = i & 15;
    const float inv = powf(500000.0f, -(float)(2 * f) / 32.0f);
    const float ang = (float)pos[t] * inv;
    float s, c; sincosf(ang, &s, &c);
    cs[2 * i] = c; cs[2 * i + 1] = s;
}

__device__ __forceinline__ int swz(int row) { return (row & 3) | (((row >> 3) & 1) << 2); }

__device__ __forceinline__ void gemm_tile(const bf16_t* __restrict__ A, int lda, const bf16_t* __restrict__ Bt, int ldb, int K,
                                          f32x4 (&acc)[4][4], unsigned char* smem) {
    const int tid = threadIdx.x, lane = tid & 63, wid = tid >> 6, wr = wid >> 1, wc = wid & 1, li = lane & 15, g = lane >> 4;
    const int srow = tid >> 3, skc = tid & 7;
    const int soff = srow * 128 + ((skc ^ swz(srow)) << 4);
    const bf16_t* ga = A + (size_t)srow * lda + skc * 8;
    const bf16_t* gb = Bt + (size_t)srow * ldb + skc * 8;
    uint4 ra[4], rb[4];
    int aoff[4], boff[4], asw[4], bsw[4];
#pragma unroll
    for (int m = 0; m < 4; ++m) { const int row = wr * 64 + m * 16 + li; aoff[m] = row * 128; asw[m] = swz(row); }
#pragma unroll
    for (int n = 0; n < 4; ++n) { const int row = wc * 64 + 32 * (n >> 1) + 8 * (li >> 2) + 4 * (n & 1) + (li & 3); boff[n] = 16384 + row * 128; bsw[n] = swz(row); }
    const int nk = K >> 6;
#pragma unroll
    for (int i = 0; i < 4; ++i) { ra[i] = *(const uint4*)(ga + (size_t)(32 * i) * lda); rb[i] = *(const uint4*)(gb + (size_t)(32 * i) * ldb); }
#pragma unroll
    for (int i = 0; i < 4; ++i) { *(uint4*)(smem + soff + i * 4096) = ra[i]; *(uint4*)(smem + 16384 + soff + i * 4096) = rb[i]; }
    __syncthreads();
    for (int kt = 0; kt < nk; ++kt) {
        const unsigned char* sb = smem + (kt & 1) * 32768;
        if (kt + 1 < nk) {
#pragma unroll
            for (int i = 0; i < 4; ++i) { ra[i] = *(const uint4*)(ga + (size_t)(32 * i) * lda + (kt + 1) * 64); rb[i] = *(const uint4*)(gb + (size_t)(32 * i) * ldb + (kt + 1) * 64); }
        }
#pragma unroll
        for (int ks = 0; ks < 2; ++ks) {
            bf16x8 af[4], bfr[4];
#pragma unroll
            for (int m = 0; m < 4; ++m) af[m] = *(const bf16x8*)(sb + aoff[m] + (((ks * 4 + g) ^ asw[m]) << 4));
#pragma unroll
            for (int n = 0; n < 4; ++n) bfr[n] = *(const bf16x8*)(sb + boff[n] + (((ks * 4 + g) ^ bsw[n]) << 4));
#pragma unroll
            for (int m = 0; m < 4; ++m)
#pragma unroll
                for (int n = 0; n < 4; ++n) acc[m][n] = mfma16(bfr[n], af[m], acc[m][n]);
        }
        if (kt + 1 < nk) {
            unsigned char* sw = smem + ((kt + 1) & 1) * 32768;
#pragma unroll
            for (int i = 0; i < 4; ++i) { *(uint4*)(sw + soff + i * 4096) = ra[i]; *(uint4*)(sw + 16384 + soff + i * 4096) = rb[i]; }
        }
        __syncthreads();
    }
}
__device__ __forceinline__ void acc_zero(f32x4 (&acc)[4][4]) {
#pragma unroll
    for (int m = 0; m < 4; ++m)
#pragma unroll
        for (int n = 0; n < 4; ++n) acc[m][n] = (f32x4){0.f, 0.f, 0.f, 0.f};
}
template <class F> __device__ __forceinline__ void epi_foreach(const f32x4 (&acc)[4][4], F&& f) {
    const int lane = threadIdx.x & 63, wid = threadIdx.x >> 6, wr = wid >> 1, wc = wid & 1, li = lane & 15, g = lane >> 4;
#pragma unroll
    for (int m = 0; m < 4; ++m)
#pragma unroll
        for (int pp = 0; pp < 2; ++pp) {
            float v[8];
#pragma unroll
            for (int r = 0; r < 4; ++r) { v[r] = acc[m][2 * pp][r]; v[4 + r] = acc[m][2 * pp + 1][r]; }
            f(wr * 64 + m * 16 + li, wc * 64 + 32 * pp + 8 * g, v, pp);
        }
}
__device__ __forceinline__ void store_bf16x8(bf16_t* p, const float (&v)[8]) {
    *(uint4*)p = make_uint4(pack_bf16(v[0], v[1]), pack_bf16(v[2], v[3]), pack_bf16(v[4], v[5]), pack_bf16(v[6], v[7]));
}
__device__ __forceinline__ void store_tile_T(const f32x4 (&acc)[4][4], bf16_t* __restrict__ dstT, int ldt, unsigned char* smem) {
    bf16_t* t = (bf16_t*)smem;
    epi_foreach(acc, [&](int r, int c, const float (&v)[8], int) {
#pragma unroll
        for (int e = 0; e < 8; ++e) t[(c + e) * 136 + r] = f2bf(v[e]);
    });
    __syncthreads();
#pragma unroll
    for (int i = 0; i < 8; ++i) {
        const int ch = threadIdx.x + 256 * i, d = ch >> 4, tc = ch & 15;
        *(uint4*)(dstT + (size_t)d * ldt + tc * 8) = *(const uint4*)(smem + d * 272 + tc * 16);
    }
    __syncthreads();
}

__device__ void inproj_tile(const Params& p, int rt, int ct, unsigned char* smem) {
    unsigned char* ws = p.ws; unsigned char* dob = (unsigned char*)p.out;
    const bf16_t* hbf = (const bf16_t*)(dob + DO_HBF);
    const bf16_t* WinT = (const bf16_t*)(ws + OFF_WINT);
    f32x4 acc[4][4]; acc_zero(acc);
    gemm_tile(hbf + (size_t)rt * 128 * 1024, 1024, WinT + (size_t)ct * 128 * 1024, 1024, 1024, acc, smem);
    const int row0 = rt * 128;
    if (ct < 8) {
        const float* cs = (const float*)(dob + DO_ROPE);
        const bool isq = ct < 6;
        bf16_t* dst = isq ? (bf16_t*)(ws + OFF_QA) + ct * 128 : (bf16_t*)(ws + OFF_KA) + (ct - 6) * 128;
        const int ld = isq ? 768 : 256;
        const float sc = isq ? QSCALE : 1.0f;
        const int g = (threadIdx.x & 63) >> 4;
        epi_foreach(acc, [&](int r, int c, float (&v)[8], int pp) {
            const int tok = row0 + r;
            if (pp == 0 && c < 32) {
                const float* csr = cs + (size_t)tok * 32 + (g & 1) * 16;
#pragma unroll
                for (int e = 0; e < 8; ++e) {
                    const float o = __shfl_xor(v[e], 32);
                    const float cc = csr[2 * e], ss = csr[2 * e + 1];
                    v[e] = (g < 2) ? (v[e] * cc - o * ss) : (v[e] * cc + o * ss);
                }
            }
#pragma unroll
            for (int e = 0; e < 8; ++e) v[e] *= sc;
            store_bf16x8(dst + (size_t)tok * ld + c, v);
        });
    } else if (ct < 10) {
        const int kvh = ct - 8, b = row0 / S_, s0 = row0 % S_;
        store_tile_T(acc, (bf16_t*)(ws + OFF_VAT) + (size_t)(b * 2 + kvh) * 128 * S_ + s0, S_, smem);
    } else if (ct < 16) {
        bf16_t* dst = (bf16_t*)(ws + OFF_XL) + (ct - 10) * 128;
        epi_foreach(acc, [&](int r, int c, float (&v)[8], int) { store_bf16x8(dst + (size_t)(row0 + r) * 768 + c, v); });
    } else if (ct < 22) {
        bf16_t* dst = (bf16_t*)(ws + OFF_GL) + (ct - 16) * 128;
        epi_foreach(acc, [&](int r, int c, float (&v)[8], int) {
#pragma unroll
            for (int e = 0; e < 8; ++e) v[e] = gelu_tanh(v[e]);
            store_bf16x8(dst + (size_t)(row0 + r) * 768 + c, v); });
    } else if (ct < 26) {
        bf16_t* dst = (bf16_t*)(ws + OFF_QM) + (ct - 22) * 128;
        epi_foreach(acc, [&](int r, int c, float (&v)[8], int) {
#pragma unroll
            for (int e = 0; e < 8; ++e) v[e] *= QSCALE;
            store_bf16x8(dst + (size_t)(row0 + r) * 512 + c, v); });
    } else {
        const int gc0 = (ct - 26) * 128;
        bf16_t* dst = (bf16_t*)(ws + OFF_GATES) + gc0;
        const float* gb = p.gate_b + gc0;
        epi_foreach(acc, [&](int r, int c, float (&v)[8], int) {
            const float4 b0 = *(const float4*)(gb + c), b1 = *(const float4*)(gb + c + 4);
            v[0] = sigmoidf_(v[0] + b0.x); v[1] = sigmoidf_(v[1] + b0.y); v[2] = sigmoidf_(v[2] + b0.z); v[3] = sigmoidf_(v[3] + b0.w);
            v[4] = sigmoidf_(v[4] + b1.x); v[5] = sigmoidf_(v[5] + b1.y); v[6] = sigmoidf_(v[6] + b1.z); v[7] = sigmoidf_(v[7] + b1.w);
            store_bf16x8(dst + (size_t)(row0 + r) * 3072 + c, v); });
    }
}
__global__ void __launch_bounds__(256) k_inproj(Params p) {
    __shared__ __attribute__((aligned(16))) unsigned char smem[65536];
    for (int u = blockIdx.x; u < 256 * 50; u += gridDim.x) inproj_tile(p, u / 50, u % 50, smem);
}
__device__ void memkv_tile(const Params& p, int rt, int ct, unsigned char* smem) {
    unsigned char* dob = (unsigned char*)p.out;
    f32x4 acc[4][4]; acc_zero(acc);
    gemm_tile((const bf16_t*)(dob + DO_MEMBF) + (size_t)rt * 128 * 1024, 1024, (const bf16_t*)(p.ws + OFF_WMKVT) + (size_t)ct * 128 * 1024, 1024, 1024, acc, smem);
    const int row0 = rt * 128;
    if (ct < 4) {
        bf16_t* dst = (bf16_t*)(dob + DO_KM) + ct * 128;
        epi_foreach(acc, [&](int r, int c, float (&v)[8], int) { store_bf16x8(dst + (size_t)(row0 + r) * 512 + c, v); });
    } else {
        const int h = ct - 4, b = row0 / MEML, m0 = row0 % MEML;
        store_tile_T(acc, (bf16_t*)(dob + DO_VMT) + (size_t)(b * 4 + h) * 128 * MEML + m0, MEML, smem);
    }
}
__global__ void __launch_bounds__(256) k_memkv(Params p) {
    __shared__ __attribute__((aligned(16))) unsigned char smem[65536];
    for (int u = blockIdx.x; u < 32 * 8; u += gridDim.x) memkv_tile(p, u / 8, u % 8, smem);
}

template <int NF, bool WIN>
__device__ __forceinline__ void attn_wave(const bf16_t* Q, int ldq, const bf16_t* __restrict__ Kb, int ldk, const bf16_t* __restrict__ Vt, int ldv,
                                          int q0, int kstart, int nkeys, float sink, bf16_t* O, int ldo) {
    const int lane = threadIdx.x & 63, li = lane & 15, g = lane >> 4;
    bf16x8 qf[4];
#pragma unroll
    for (int ks = 0; ks < 4; ++ks) qf[ks] = *(const bf16x8*)(Q + (size_t)li * ldq + ks * 32 + g * 8);
    f32x4 s[NF];
#pragma unroll
    for (int t = 0; t < NF; ++t) {
        int key = kstart + 16 * t + li; key = key < 0 ? 0 : (key > nkeys - 1 ? nkeys - 1 : key);
        const bf16_t* kp = Kb + (size_t)key * ldk + g * 8;
        f32x4 a = {0.f, 0.f, 0.f, 0.f};
#pragma unroll
        for (int ks = 0; ks < 4; ++ks) a = mfma16(*(const bf16x8*)(kp + ks * 32), qf[ks], a);
        s[t] = a;
    }
    float mx = -1e30f;
#pragma unroll
    for (int t = 0; t < NF; ++t)
#pragma unroll
        for (int r = 0; r < 4; ++r) {
            if (WIN) {
                const int kp = kstart + 16 * t + 4 * g + r, d = kp - (q0 + li);
                const bool valid = kp >= 0 && kp < nkeys && d <= 128 && d >= -128;
                s[t][r] = valid ? s[t][r] : -1e30f;
            }
            mx = fmaxf(mx, s[t][r]);
        }
    mx = fmaxf(mx, __shfl_xor(mx, 16)); mx = fmaxf(mx, __shfl_xor(mx, 32));
    if (WIN) mx = fmaxf(mx, sink);
    float sum = 0.f;
#pragma unroll
    for (int t = 0; t < NF; ++t)
#pragma unroll
        for (int r = 0; r < 4; ++r) { const float pv = __expf(s[t][r] - mx); s[t][r] = pv; sum += pv; }
    sum += __shfl_xor(sum, 16); sum += __shfl_xor(sum, 32);
    if (WIN) sum += __expf(sink - mx);
    const float inv = 1.0f / sum;
    f32x4 o[8];
#pragma unroll
    for (int df = 0; df < 8; ++df) o[df] = (f32x4){0.f, 0.f, 0.f, 0.f};
#pragma unroll
    for (int kk = 0; kk < NF / 2; ++kk) {
        union { unsigned u[4]; bf16x8 v; } pb;
        pb.u[0] = pack_bf16(s[2 * kk][0], s[2 * kk][1]); pb.u[1] = pack_bf16(s[2 * kk][2], s[2 * kk][3]);
        pb.u[2] = pack_bf16(s[2 * kk + 1][0], s[2 * kk + 1][1]); pb.u[3] = pack_bf16(s[2 * kk + 1][2], s[2 * kk + 1][3]);
        int ka = kstart + 32 * kk + 4 * g, kb = ka + 16;
        ka = ka < 0 ? 0 : (ka > nkeys - 4 ? nkeys - 4 : ka); kb = kb < 0 ? 0 : (kb > nkeys - 4 ? nkeys - 4 : kb);
#pragma unroll
        for (int df = 0; df < 8; ++df) {
            const bf16_t* vp = Vt + (size_t)(df * 16 + li) * ldv;
            union { uint2 u[2]; bf16x8 v; } va;
            va.u[0] = *(const uint2*)(vp + ka); va.u[1] = *(const uint2*)(vp + kb);
            o[df] = mfma16(va.v, pb.v, o[df]);
        }
    }
#pragma unroll
    for (int df = 0; df < 8; ++df)
        *(uint2*)(O + (size_t)li * ldo + df * 16 + 4 * g) = make_uint2(pack_bf16(o[df][0] * inv, o[df][1] * inv), pack_bf16(o[df][2] * inv, o[df][3] * inv));
}
__device__ void attn_win_unit(const Params& p, int u) {
    const int wid = threadIdx.x >> 6;
    const int qb = u % 32, head = (u / 32) % 6, b = u / 192, kvh = head / 3;
    const int q0 = qb * 64 + wid * 16;
    bf16_t* Q = (bf16_t*)(p.ws + OFF_QA) + (size_t)(b * S_ + q0) * 768 + head * 128;
    const bf16_t* Kb = (const bf16_t*)(p.ws + OFF_KA) + (size_t)(b * S_) * 256 + kvh * 128;
    const bf16_t* Vt = (const bf16_t*)(p.ws + OFF_VAT) + (size_t)(b * 2 + kvh) * 128 * S_;
    attn_wave<18, true>(Q, 768, Kb, 256, Vt, S_, q0, q0 - 128, S_, p.attn_sink[head], Q, 768);
}
__device__ void attn_mem_unit(const Params& p, int u) {
    const int wid = threadIdx.x >> 6;
    const int qb = u % 32, head = (u / 32) % 4, b = u / 128;
    const int q0 = qb * 64 + wid * 16;
    unsigned char* dob = (unsigned char*)p.out;
    bf16_t* Q = (bf16_t*)(p.ws + OFF_QM) + (size_t)(b * S_ + q0) * 512 + head * 128;
    const bf16_t* Kb = (const bf16_t*)(dob + DO_KM) + (size_t)(b * MEML) * 512 + head * 128;
    const bf16_t* Vt = (const bf16_t*)(dob + DO_VMT) + (size_t)(b * 4 + head) * 128 * MEML;
    attn_wave<16, false>(Q, 512, Kb, 512, Vt, MEML, q0, 0, MEML, 0.f, Q, 512);
}
__global__ void __launch_bounds__(256) k_attn_win(Params p) { for (int u = blockIdx.x; u < 3072; u += gridDim.x) attn_win_unit(p, u); }
__global__ void __launch_bounds__(256) k_attn_mem(Params p) { for (int u = blockIdx.x; u < 2048; u += gridDim.x) attn_mem_unit(p, u); }

__device__ void lru_unit(const Params& p, int u, unsigned char* smem) {
    const int tid = threadIdx.x, lane = tid & 63, wid = tid >> 6, li = lane & 15, g = lane >> 4;
    const int qt = u & 3, h = (u >> 2) % 6, b = u / 24;
    const int cbase = h * 128, cq0 = cbase + qt * 32;
    unsigned char* xcs = smem; unsigned char* wl = smem + 16384;
    float* pre = (float*)(smem + 32768); float* xcf = (float*)(smem + 49152);
    float* cA = (float*)(smem + 57344); float* cH = cA + 256; float* h0 = cH + 256;
    const bf16_t* Xl = (const bf16_t*)(p.ws + OFF_XL) + (size_t)(b * S_) * 768;
    bf16_t* Gl = (bf16_t*)(p.ws + OFF_GL) + (size_t)(b * S_) * 768;
    bf16_t* Hf = (bf16_t*)((unsigned char*)p.out + DO_HBF) + (size_t)(b * S_) * 768;
    const bf16_t* LruWt = (const bf16_t*)(p.ws + OFF_LRUWT);
    const int cp = tid & 63, tq = tid >> 6, cch = cbase + 2 * cp;
    float cw[4][2];
#pragma unroll
    for (int j = 0; j < 4; ++j) { cw[j][0] = p.conv_w[j * LW + cch]; cw[j][1] = p.conv_w[j * LW + cch + 1]; }
    const float cb0 = p.conv_b[cch], cb1 = p.conv_b[cch + 1];
    const int sc_c = tid & 31, sub = tid >> 5, sch = cq0 + sc_c;
    for (int dir = 0; dir < 2; ++dir) {
        __syncthreads();
#pragma unroll
        for (int i = 0; i < 4; ++i) {
            const int ch = tid + 256 * i, j = ch >> 4, kc = ch & 15;
            const int srcrow = h * 512 + ((j >> 5) * 2 + dir) * 128 + qt * 32 + (j & 31);
            *(uint4*)(wl + j * 256 + ((kc ^ (j & 15)) << 4)) = *(const uint4*)(LruWt + (size_t)srcrow * 128 + kc * 8);
        }
        const float br = p.lru_br[dir * LW + sch], bi = p.lru_bi[dir * LW + sch];
        const float lam = p.lru_lambda[dir * LW + sch];
        const float sp8 = -8.0f * log1pf(__expf(-lam));
        if (tid < 32) h0[tid] = 0.f;
        for (int ci = 0; ci < 32; ++ci) {
            const int chunk = dir ? 31 - ci : ci, s0 = chunk * 64;
            {
                float xa[19], xb[19];
#pragma unroll
                for (int i = 0; i < 19; ++i) {
                    const int s = s0 + 16 * tq + i - 2;
                    unsigned w = 0;
                    if (s >= 0 && s < S_) w = *(const unsigned*)(Xl + (size_t)s * 768 + cch);
                    xa[i] = bflo(w); xb[i] = bfhi(w);
                }
#pragma unroll
                for (int i = 0; i < 16; ++i) {
                    const int t = 16 * tq + i;
                    const float y0 = cb0 + cw[0][0] * xa[i] + cw[1][0] * xa[i + 1] + cw[2][0] * xa[i + 2] + cw[3][0] * xa[i + 3];
                    const float y1 = cb1 + cw[0][1] * xb[i] + cw[1][1] * xb[i + 1] + cw[2][1] * xb[i + 2] + cw[3][1] * xb[i + 3];
                    *(unsigned*)(xcs + t * 256 + (((cp >> 2) ^ (t & 15)) << 4) + (cp & 3) * 4) = pack_bf16(y0, y1);
                    if ((cp >> 4) == qt) { xcf[t * 32 + 2 * (cp & 15)] = y0; xcf[t * 32 + 2 * (cp & 15) + 1] = y1; }
                }
            }
            __syncthreads();
            {
                f32x4 a[4];
#pragma unroll
                for (int n = 0; n < 4; ++n) a[n] = (f32x4){0.f, 0.f, 0.f, 0.f};
#pragma unroll
                for (int ks = 0; ks < 4; ++ks) {
                    const int row = wid * 16 + li;
                    const bf16x8 xf = *(const bf16x8*)(xcs + row * 256 + (((ks * 4 + g) ^ (row & 15)) << 4));
#pragma unroll
                    for (int n = 0; n < 4; ++n) {
                        const int j = n * 16 + li;
                        const bf16x8 wf = *(const bf16x8*)(wl + j * 256 + (((ks * 4 + g) ^ (j & 15)) << 4));
                        a[n] = mfma16(xf, wf, a[n]);
                    }
                }
#pragma unroll
                for (int n = 0; n < 4; ++n)
#pragma unroll
                    for (int r = 0; r < 4; ++r) pre[(wid * 16 + 4 * g + r) * 64 + n * 16 + li] = a[n][r];
            }
            __syncthreads();
            float hl[8], ap[8];
            {
                float hh = 0.f, aa = 1.f;
#pragma unroll
                for (int k = 0; k < 8; ++k) {
                    const int pp = sub * 8 + k, t = dir ? 63 - pp : pp;
                    const float r = sigmoidf_(pre[t * 64 + sc_c] + br), ig = sigmoidf_(pre[t * 64 + 32 + sc_c] + bi);
                    const float la = sp8 * r;
                    const float a = __expf(la);
                    const float bx = sqrtf(-expm1f(2.0f * la)) * (ig * xcf[t * 32 + sc_c]);
                    hh = a * hh + bx; aa *= a; hl[k] = hh; ap[k] = aa;
                }
                cA[sub * 32 + sc_c] = aa; cH[sub * 32 + sc_c] = hh;
            }
            __syncthreads();
            {
                float hin = h0[(ci & 1) * 32 + sc_c];
                for (int s2 = 0; s2 < sub; ++s2) hin = cA[s2 * 32 + sc_c] * hin + cH[s2 * 32 + sc_c];
#pragma unroll
                for (int k = 0; k < 8; ++k) {
                    const int pp = sub * 8 + k, t = dir ? 63 - pp : pp;
                    const float hv = hl[k] + ap[k] * hin;
                    const size_t gi = (size_t)(s0 + t) * 768 + sch;
                    if (dir == 0) Hf[gi] = f2bf(hv);
                    else Gl[gi] = f2bf((bf2f(Hf[gi]) + hv) * bf2f(Gl[gi]));
                    if (k == 7 && sub == 7) h0[((ci + 1) & 1) * 32 + sc_c] = hv;
                }
            }
        }
    }
    __syncthreads();
}
__global__ void __launch_bounds__(256) k_lru(Params p) {
    __shared__ __attribute__((aligned(16))) unsigned char smem[65536];
    for (int u = blockIdx.x; u < 384; u += gridDim.x) lru_unit(p, u, smem);
}

__device__ void merge_tile(const Params& p, int rt, int ct, unsigned char* smem) {
    unsigned char* ws = p.ws;
    const int row0 = rt * 128, col0 = ct * 128;
    f32x4 tot[4][4]; acc_zero(tot);
    const bf16_t* Ab[3] = {(const bf16_t*)(ws + OFF_QA), (const bf16_t*)(ws + OFF_GL), (const bf16_t*)(ws + OFF_QM)};
    const bf16_t* Bb[3] = {(const bf16_t*)(ws + OFF_PATTNT), (const bf16_t*)(ws + OFF_PLRUT), (const bf16_t*)(ws + OFF_PMEMT)};
    const int Kb[3] = {768, 768, 512};
    const bf16_t* G = (const bf16_t*)(ws + OFF_GATES);
    const int lane = threadIdx.x & 63, wid = threadIdx.x >> 6, wr = wid >> 1, wc = wid & 1, li = lane & 15, g = lane >> 4;
#pragma unroll
    for (int br = 0; br < 3; ++br) {
        f32x4 acc[4][4]; acc_zero(acc);
        gemm_tile(Ab[br] + (size_t)row0 * Kb[br], Kb[br], Bb[br] + (size_t)col0 * Kb[br], Kb[br], Kb[br], acc, smem);
#pragma unroll
        for (int m = 0; m < 4; ++m)
#pragma unroll
            for (int pp = 0; pp < 2; ++pp) {
                const int r = wr * 64 + m * 16 + li, c = wc * 64 + 32 * pp + 8 * g;
                const uint4 gv = *(const uint4*)(G + (size_t)(row0 + r) * 3072 + br * 1024 + col0 + c);
                tot[m][2 * pp][0] += bflo(gv.x) * acc[m][2 * pp][0]; tot[m][2 * pp][1] += bfhi(gv.x) * acc[m][2 * pp][1];
                tot[m][2 * pp][2] += bflo(gv.y) * acc[m][2 * pp][2]; tot[m][2 * pp][3] += bfhi(gv.y) * acc[m][2 * pp][3];
                tot[m][2 * pp + 1][0] += bflo(gv.z) * acc[m][2 * pp + 1][0]; tot[m][2 * pp + 1][1] += bfhi(gv.z) * acc[m][2 * pp + 1][1];
                tot[m][2 * pp + 1][2] += bflo(gv.w) * acc[m][2 * pp + 1][2]; tot[m][2 * pp + 1][3] += bfhi(gv.w) * acc[m][2 * pp + 1][3];
            }
    }
    bf16_t* dst = (bf16_t*)(ws + OFF_MERGED) + col0;
    epi_foreach(tot, [&](int r, int c, float (&v)[8], int) { store_bf16x8(dst + (size_t)(row0 + r) * 1024 + c, v); });
}
__global__ void __launch_bounds__(256) k_merge(Params p) {
    __shared__ __attribute__((aligned(16))) unsigned char smem[65536];
    for (int u = blockIdx.x; u < 256 * 8; u += gridDim.x) merge_tile(p, u / 8, u % 8, smem);
}
__device__ void outproj_tile(const Params& p, int rt, int ct, unsigned char* smem) {
    const int row0 = rt * 128, col0 = ct * 128;
    f32x4 acc[4][4]; acc_zero(acc);
    gemm_tile((const bf16_t*)(p.ws + OFF_MERGED) + (size_t)row0 * 1024, 1024, (const bf16_t*)(p.ws + OFF_WOUTT) + (size_t)col0 * 1024, 1024, 1024, acc, smem);
    epi_foreach(acc, [&](int r, int c, float (&v)[8], int) {
        const size_t o = (size_t)(row0 + r) * 1024 + col0 + c;
        const float4 x0 = *(const float4*)(p.x + o), x1 = *(const float4*)(p.x + o + 4);
        *(float4*)(p.out + o) = make_float4(x0.x + v[0], x0.y + v[1], x0.z + v[2], x0.w + v[3]);
        *(float4*)(p.out + o + 4) = make_float4(x1.x + v[4], x1.y + v[5], x1.z + v[6], x1.w + v[7]);
    });
}
__global__ void __launch_bounds__(256) k_outproj(Params p) {
    __shared__ __attribute__((aligned(16))) unsigned char smem[65536];
    for (int u = blockIdx.x; u < 256 * 8; u += gridDim.x) outproj_tile(p, u / 8, u % 8, smem);
}
__device__ void peerq_tile(const Params& p, int rt, int ct, unsigned char* smem) {
    const int row0 = rt * 128, col0 = ct * 128;
    f32x4 acc[4][4]; acc_zero(acc);
    gemm_tile((const bf16_t*)(p.ws + OFF_MERGED) + (size_t)row0 * 1024, 1024, (const bf16_t*)(p.ws + OFF_WPQT) + (size_t)col0 * 1024, 1024, 1024, acc, smem);
    bf16_t* dst = (bf16_t*)(p.ws + OFF_QPEER) + col0;
    epi_foreach(acc, [&](int r, int c, float (&v)[8], int) { store_bf16x8(dst + (size_t)(row0 + r) * 2048 + c, v); });
}
__global__ void __launch_bounds__(256) k_peerq(Params p) {
    __shared__ __attribute__((aligned(16))) unsigned char smem[65536];
    for (int u = blockIdx.x; u < 256 * 16; u += gridDim.x) peerq_tile(p, u / 16, u % 16, smem);
}
__device__ __forceinline__ int sortable(float v) { int k = __float_as_int(v); return k ^ ((k >> 31) & 0x7fffffff); }
__device__ __forceinline__ float unsortable(int k) { return __int_as_float(k ^ ((k >> 31) & 0x7fffffff)); }
__device__ __forceinline__ void insert16(int (&lst)[16], int x) {
#pragma unroll
    for (int k = 0; k < 16; ++k) { const int hi = max(lst[k], x); x = min(lst[k], x); lst[k] = hi; }
}
__device__ void scores_tile(const Params& p, int rt, int pq, unsigned char* smem) {
    const int row0 = rt * 128;
    f32x4 acc[4][4]; acc_zero(acc);
    gemm_tile((const bf16_t*)(p.ws + OFF_QPEER) + (size_t)row0 * 2048 + pq * 128, 2048, (const bf16_t*)(p.ws + OFF_SUBK) + (size_t)pq * 128 * 128, 128, 128, acc, smem);
    float* sc = (float*)smem;
    epi_foreach(acc, [&](int r, int c, float (&v)[8], int) {
        *(float4*)(sc + r * 132 + c) = make_float4(v[0], v[1], v[2], v[3]);
        *(float4*)(sc + r * 132 + c + 4) = make_float4(v[4], v[5], v[6], v[7]); });
    __syncthreads();
    if (threadIdx.x < 128) {
        const int r = threadIdx.x;
        int lst[16];
#pragma unroll
        for (int k = 0; k < 16; ++k) lst[k] = (int)0x80000000;
#pragma unroll 2
        for (int j4 = 0; j4 < 32; ++j4) {
            const float4 v = *(const float4*)(sc + r * 132 + j4 * 4);
            insert16(lst, (sortable(v.x) & ~127) | (j4 * 4 + 0));
            insert16(lst, (sortable(v.y) & ~127) | (j4 * 4 + 1));
            insert16(lst, (sortable(v.z) & ~127) | (j4 * 4 + 2));
            insert16(lst, (sortable(v.w) & ~127) | (j4 * 4 + 3));
        }
        int4* dst = (int4*)((int*)(p.ws + OFF_TOPL) + ((size_t)(row0 + r) * 16 + pq) * 16);
        dst[0] = make_int4(lst[0], lst[1], lst[2], lst[3]); dst[1] = make_int4(lst[4], lst[5], lst[6], lst[7]);
        dst[2] = make_int4(lst[8], lst[9], lst[10], lst[11]); dst[3] = make_int4(lst[12], lst[13], lst[14], lst[15]);
    }
    __syncthreads();
}
__global__ void __launch_bounds__(256) k_scores(Params p) {
    __shared__ __attribute__((aligned(16))) unsigned char smem[128 * 132 * 4];
    for (int u = blockIdx.x; u < 256 * 16; u += gridDim.x) scores_tile(p, u / 16, u % 16, smem);
}
__device__ void combine_item(const Params& p, int item) {
    const int tok = item >> 3, hd = item & 7;
    const int* l0 = (const int*)(p.ws + OFF_TOPL) + ((size_t)tok * 16 + hd * 2) * 16;
    const int* l1 = l0 + 16;
    int k0[16], k1[16];
#pragma unroll
    for (int i = 0; i < 4; ++i) {
        const int4 a = ((const int4*)l0)[i], b = ((const int4*)l1)[i];
        k0[4 * i] = a.x; k0[4 * i + 1] = a.y; k0[4 * i + 2] = a.z; k0[4 * i + 3] = a.w;
        k1[4 * i] = b.x; k1[4 * i + 1] = b.y; k1[4 * i + 2] = b.z; k1[4 * i + 3] = b.w;
    }
    float v0[16], v1[16];
#pragma unroll
    for (int i = 0; i < 16; ++i) { v0[i] = unsortable(k0[i] & ~127); v1[i] = unsortable(k1[i] & ~127); }
    int lst[16];
#pragma unroll
    for (int k = 0; k < 16; ++k) lst[k] = (int)0x80000000;
#pragma unroll
    for (int a = 0; a < 16; ++a)
#pragma unroll
        for (int b = 0; b < 16; ++b)
            if ((a + 1) * (b + 1) <= 16) insert16(lst, (sortable(v0[a] + v1[b]) & ~255) | (a * 16 + b));
    float val[16], sum = 0.f;
    const float mx = unsortable(lst[0] & ~255);
#pragma unroll
    for (int k = 0; k < 16; ++k) { val[k] = __expf(unsortable(lst[k] & ~255) - mx); sum += val[k]; }
    const float inv = 1.0f / sum;
    int* ei = (int*)(p.ws + OFF_EIDX) + (size_t)tok * 128 + hd * 16;
    float* eg = (float*)(p.ws + OFF_EGATE) + (size_t)tok * 128 + hd * 16;
#pragma unroll
    for (int k = 0; k < 16; ++k) {
        const int code = lst[k] & 255, a = code >> 4, b = code & 15;
        ei[k] = (l0[a] & 127) * 128 + (l1[b] & 127);
        eg[k] = val[k] * inv;
    }
}
__global__ void __launch_bounds__(256) k_combine(Params p) {
    for (int i = blockIdx.x * 256 + threadIdx.x; i < NTOK * 8; i += gridDim.x * 256) combine_item(p, i);
}
__device__ void gather_token(const Params& p, int tok, int lane) {
    const bf16_t* h2 = (const bf16_t*)(p.ws + OFF_MERGED) + (size_t)tok * 1024;
    const bf16_t* Ub = (const bf16_t*)(p.ws + OFF_UB); const bf16_t* Vb = (const bf16_t*)(p.ws + OFF_VB);
    const int* ei = (const int*)(p.ws + OFF_EIDX) + (size_t)tok * 128;
    const float* eg = (const float*)(p.ws + OFF_EGATE) + (size_t)tok * 128;
    const uint4 ha = *(const uint4*)(h2 + lane * 8), hb = *(const uint4*)(h2 + 512 + lane * 8);
    const unsigned hq[8] = {ha.x, ha.y, ha.z, ha.w, hb.x, hb.y, hb.z, hb.w};
    float o[16];
#pragma unroll
    for (int e = 0; e < 16; ++e) o[e] = 0.f;
    for (int grp = 0; grp < 16; ++grp) {
        int id[8]; float gt[8]; uint4 ua[8], ub[8];
#pragma unroll
        for (int j = 0; j < 8; ++j) { id[j] = __builtin_amdgcn_readfirstlane(ei[grp * 8 + j]); gt[j] = eg[grp * 8 + j]; }
#pragma unroll
        for (int j = 0; j < 8; ++j) { const bf16_t* ur = Ub + (size_t)id[j] * 1024 + lane * 8; ua[j] = *(const uint4*)ur; ub[j] = *(const uint4*)(ur + 512); }
        float w[8];
#pragma unroll
        for (int j = 0; j < 8; ++j) {
            const unsigned uu[8] = {ua[j].x, ua[j].y, ua[j].z, ua[j].w, ub[j].x, ub[j].y, ub[j].z, ub[j].w};
            float d = 0.f;
#pragma unroll
            for (int e = 0; e < 8; ++e) d = __builtin_amdgcn_fdot2_f32_bf16(__builtin_bit_cast(bf16x2v, uu[e]), __builtin_bit_cast(bf16x2v, hq[e]), d, false);
            d = wave_sum(d);
            w[j] = gt[j] * gelu_tanh(d);
        }
#pragma unroll
        for (int j = 0; j < 8; ++j) { const bf16_t* vr = Vb + (size_t)id[j] * 1024 + lane * 8; ua[j] = *(const uint4*)vr; ub[j] = *(const uint4*)(vr + 512); }
#pragma unroll
        for (int j = 0; j < 8; ++j) {
            const unsigned vv[8] = {ua[j].x, ua[j].y, ua[j].z, ua[j].w, ub[j].x, ub[j].y, ub[j].z, ub[j].w};
#pragma unroll
            for (int e = 0; e < 8; ++e) { o[2 * e] += w[j] * bflo(vv[e]); o[2 * e + 1] += w[j] * bfhi(vv[e]); }
        }
    }
    float* xr = p.out + (size_t)tok * 1024;
    float4 x[4];
    x[0] = *(const float4*)(xr + lane * 8); x[1] = *(const float4*)(xr + lane * 8 + 4);
    x[2] = *(const float4*)(xr + 512 + lane * 8); x[3] = *(const float4*)(xr + 512 + lane * 8 + 4);
    float ss = 0.f;
#pragma unroll
    for (int i = 0; i < 4; ++i) {
        x[i].x += o[4 * i]; x[i].y += o[4 * i + 1]; x[i].z += o[4 * i + 2]; x[i].w += o[4 * i + 3];
        ss += x[i].x * x[i].x + x[i].y * x[i].y + x[i].z * x[i].z + x[i].w * x[i].w;
    }
    ss = wave_sum(ss);
    const float rs = rsqrtf(ss * (1.0f / 1024.0f) + EPS);
    const float* gf = p.g_final;
#pragma unroll
    for (int i = 0; i < 4; ++i) {
        const int c = (i >> 1) * 512 + lane * 8 + (i & 1) * 4;
        const float4 gg = *(const float4*)(gf + c);
        *(float4*)(xr + c) = make_float4(x[i].x * rs * gg.x, x[i].y * rs * gg.y, x[i].z * rs * gg.z, x[i].w * rs * gg.w);
    }
}
__global__ void __launch_bounds__(256) k_gather(Params p) {
    const int lane = threadIdx.x & 63, wid = threadIdx.x >> 6;
    for (int t = blockIdx.x * 4 + wid; t < NTOK; t += gridDim.x * 4) gather_token(p, t, lane);
}

extern "C" void kernel_launch(void* const* d_in, const int* in_sizes, int n_in, void* d_out, int out_size, void* d_ws, size_t ws_size, hipStream_t stream) {
    if (ws_size < OFF_END) { fprintf(stderr, "workspace too small: %zu < %zu\n", ws_size, (size_t)OFF_END); return; }
    Params p{};
    p.x = (const float*)d_in[0]; p.mem = (const float*)d_in[1]; p.positions = (const int*)d_in[2];
    p.g_mix = (const float*)d_in[3]; p.g_mem = (const float*)d_in[4]; p.w_in = (const float*)d_in[5]; p.gate_b = (const float*)d_in[6];
    p.attn_sink = (const float*)d_in[7]; p.conv_w = (const float*)d_in[8]; p.conv_b = (const float*)d_in[9];
    p.lru_wr = (const float*)d_in[10]; p.lru_br = (const float*)d_in[11]; p.lru_wi = (const float*)d_in[12]; p.lru_bi = (const float*)d_in[13];
    p.lru_lambda = (const float*)d_in[14]; p.w_mem_kv = (const float*)d_in[15]; p.p_attn = (const float*)d_in[16]; p.p_lru = (const float*)d_in[17];
    p.p_mem = (const float*)d_in[18]; p.w_out = (const float*)d_in[19]; p.g_ffn = (const float*)d_in[20]; p.w_peer_q = (const float*)d_in[21];
    p.peer_sub_keys = (const float*)d_in[22]; p.peer_u = (const float*)d_in[23]; p.peer_v = (const float*)d_in[24]; p.g_final = (const float*)d_in[25];
    p.out = (float*)d_out; p.ws = (unsigned char*)d_ws;
    unsigned char* ws = p.ws; unsigned char* dob = (unsigned char*)d_out;
    const int G = 2048;
    k_convT<<<G, 256, 0, stream>>>(p.w_in, (bf16_t*)(ws + OFF_WINT), 1024, INW);
    k_convT<<<256, 256, 0, stream>>>(p.w_mem_kv, (bf16_t*)(ws + OFF_WMKVT), 1024, 1024);
    k_convT<<<192, 256, 0, stream>>>(p.p_attn, (bf16_t*)(ws + OFF_PATTNT), 768, 1024);
    k_convT<<<192, 256, 0, stream>>>(p.p_lru, (bf16_t*)(ws + OFF_PLRUT), 768, 1024);
    k_convT<<<128, 256, 0, stream>>>(p.p_mem, (bf16_t*)(ws + OFF_PMEMT), 512, 1024);
    k_convT<<<256, 256, 0, stream>>>(p.w_out, (bf16_t*)(ws + OFF_WOUTT), 1024, 1024);
    k_convT<<<512, 256, 0, stream>>>(p.w_peer_q, (bf16_t*)(ws + OFF_WPQT), 1024, 2048);
    k_convT_lru<<<96, 256, 0, stream>>>(p.lru_wr, p.lru_wi, (bf16_t*)(ws + OFF_LRUWT));
    k_conv<<<128, 256, 0, stream>>>(p.peer_sub_keys, (bf16_t*)(ws + OFF_SUBK), (size_t)16 * 128 * 128 / 8);
    k_conv<<<G, 256, 0, stream>>>(p.peer_u, (bf16_t*)(ws + OFF_UB), (size_t)NEXP * 1024 / 8);
    k_conv<<<G, 256, 0, stream>>>(p.peer_v, (bf16_t*)(ws + OFF_VB), (size_t)NEXP * 1024 / 8);
    k_rms<<<G, 256, 0, stream>>>(p.x, p.g_mix, (bf16_t*)(dob + DO_HBF), NTOK);
    k_rms<<<1024, 256, 0, stream>>>(p.mem, p.g_mem, (bf16_t*)(dob + DO_MEMBF), NMEM);
    k_rope<<<NTOK * 16 / 256, 256, 0, stream>>>(p.positions, (float*)(dob + DO_ROPE));
    k_inproj<<<G, 256, 0, stream>>>(p);
    k_memkv<<<256, 256, 0, stream>>>(p);
    k_lru<<<384, 256, 0, stream>>>(p);
    k_attn_win<<<G, 256, 0, stream>>>(p);
    k_attn_mem<<<G, 256, 0, stream>>>(p);
    k_merge<<<G, 256, 0, stream>>>(p);
    k_outproj<<<G, 256, 0, stream>>>(p);
    k_rms<<<G, 256, 0, stream>>>(p.out, p.g_ffn, (bf16_t*)(ws + OFF_MERGED), NTOK);
    k_peerq<<<G, 256, 0, stream>>>(p);
    k_scores<<<G, 256, 0, stream>>>(p);
    k_combine<<<1024, 256, 0, stream>>>(p);
    k_gather<<<G, 256, 0, stream>>>(p);
}
```

```cpp
#include <hip/hip_runtime.h>
#include <stdint.h>
#include <stdio.h>

typedef unsigned short bf16_t;
typedef short bf16x8 __attribute__((ext_vector_type(8)));
typedef __bf16 bf16x2v __attribute__((ext_vector_type(2)));
typedef float f32x4 __attribute__((ext_vector_type(4)));

constexpr int B_ = 16, S_ = 2048, D_ = 1024, NTOK = B_ * S_;
constexpr int MEML = 256, NMEM = B_ * MEML;
constexpr int INW = 6400;
constexpr int LW = 768;
constexpr int NEXP = 16384;
constexpr float EPS = 1e-6f;
constexpr float QSCALE = 0.08838834764831845f;

constexpr size_t OFF_WINT = 0;
constexpr size_t OFF_WMKVT = OFF_WINT + (size_t)INW * 1024 * 2;
constexpr size_t OFF_PATTNT = OFF_WMKVT + (size_t)1024 * 1024 * 2;
constexpr size_t OFF_PLRUT = OFF_PATTNT + (size_t)1024 * 768 * 2;
constexpr size_t OFF_PMEMT = OFF_PLRUT + (size_t)1024 * 768 * 2;
constexpr size_t OFF_WOUTT = OFF_PMEMT + (size_t)1024 * 512 * 2;
constexpr size_t OFF_WPQT = OFF_WOUTT + (size_t)1024 * 1024 * 2;
constexpr size_t OFF_LRUWT = OFF_WPQT + (size_t)2048 * 1024 * 2;
constexpr size_t OFF_SUBK = OFF_LRUWT + (size_t)6 * 512 * 128 * 2;
constexpr size_t OFF_UB = OFF_SUBK + (size_t)16 * 128 * 128 * 2;
constexpr size_t OFF_VB = OFF_UB + (size_t)NEXP * 1024 * 2;
constexpr size_t OFF_RA = OFF_VB + (size_t)NEXP * 1024 * 2;
constexpr size_t OFF_QA = OFF_RA;
constexpr size_t OFF_KA = OFF_QA + (size_t)NTOK * 768 * 2;
constexpr size_t OFF_VAT = OFF_KA + (size_t)NTOK * 256 * 2;
constexpr size_t OFF_XL = OFF_VAT + (size_t)NTOK * 256 * 2;
constexpr size_t OFF_GL = OFF_XL + (size_t)NTOK * 768 * 2;
constexpr size_t OFF_QM = OFF_GL + (size_t)NTOK * 768 * 2;
constexpr size_t OFF_GATES = OFF_QM + (size_t)NTOK * 512 * 2;
constexpr size_t OFF_BAR = OFF_GATES + (size_t)NTOK * 3072 * 2;
constexpr size_t OFF_END = OFF_BAR + 16384;
constexpr size_t OFF_MERGED = OFF_KA;
constexpr size_t OFF_QPEER = OFF_GATES;
constexpr size_t OFF_TOPL = OFF_QPEER + (size_t)NTOK * 2048 * 2;
constexpr size_t OFF_EIDX = OFF_TOPL + (size_t)NTOK * 256 * 4;
constexpr size_t OFF_EGATE = OFF_EIDX + (size_t)NTOK * 128 * 4;
static_assert(OFF_EGATE + (size_t)NTOK * 128 * 4 <= OFF_BAR, "overlay");
static_assert(OFF_MERGED + (size_t)NTOK * 1024 * 2 <= OFF_GL, "overlay2");
constexpr size_t DO_HBF = 0;
constexpr size_t DO_MEMBF = DO_HBF + (size_t)NTOK * 1024 * 2;
constexpr size_t DO_KM = DO_MEMBF + (size_t)NMEM * 1024 * 2;
constexpr size_t DO_VMT = DO_KM + (size_t)NMEM * 512 * 2;
constexpr size_t DO_ROPE = DO_VMT + (size_t)NMEM * 512 * 2;
static_assert(DO_ROPE + (size_t)NTOK * 32 * 4 <= (size_t)NTOK * 1024 * 4, "d_out scratch");

struct Params {
    const float *x, *mem; const int* positions;
    const float *g_mix, *g_mem, *w_in, *gate_b, *attn_sink, *conv_w, *conv_b, *lru_wr, *lru_br, *lru_wi, *lru_bi, *lru_lambda,
        *w_mem_kv, *p_attn, *p_lru, *p_mem, *w_out, *g_ffn, *w_peer_q, *peer_sub_keys, *peer_u, *peer_v, *g_final;
    float* out; unsigned char* ws;
};

__device__ __forceinline__ int tidx() { int t = threadIdx.x; asm volatile("" : "+v"(t)); return t; }
__device__ __forceinline__ float bf2f(bf16_t b) { return __uint_as_float(((unsigned)b) << 16); }
__device__ __forceinline__ float bflo(unsigned u) { return __uint_as_float(u << 16); }
__device__ __forceinline__ float bfhi(unsigned u) { return __uint_as_float(u & 0xffff0000u); }
typedef float f32x2v __attribute__((ext_vector_type(2)));
__device__ __forceinline__ unsigned pack_bf16(float lo, float hi) { const f32x2v f = {lo, hi}; return __builtin_bit_cast(unsigned, __builtin_convertvector(f, bf16x2v)); }
__device__ __forceinline__ bf16_t f2bf(float f) { return (bf16_t)(pack_bf16(f, 0.f) & 0xffffu); }
__device__ __forceinline__ f32x4 mfma16(bf16x8 a, bf16x8 b, f32x4 c) { return __builtin_amdgcn_mfma_f32_16x16x32_bf16(a, b, c, 0, 0, 0); }
__device__ __forceinline__ float sigmoidf_(float x) { return 1.0f / (1.0f + __expf(-x)); }
__device__ __forceinline__ float gelu_tanh(float x) { const float u = 1.5957691216057308f * (x + 0.044715f * x * x * x); return x / (1.0f + __expf(-u)); }
__device__ __forceinline__ float wave_sum(float v) {
#pragma unroll
    for (int o = 32; o >= 1; o >>= 1) v += __shfl_xor(v, o);
    return v;
}

__device__ void convT_tile(const float* __restrict__ src, bf16_t* __restrict__ dst, int K, int N, int tile, unsigned char* smem) {
    float* t = (float*)smem;
    const int tn = N / 64, tk = tile / tn, tnn = tile % tn, k0 = tk * 64, n0 = tnn * 64, tid = tidx();
    const int r = tid >> 4, c4 = (tid & 15) * 4;
#pragma unroll
    for (int i = 0; i < 4; ++i) {
        const int k = r + 16 * i;
        const float4 v = *(const float4*)(src + (size_t)(k0 + k) * N + n0 + c4);
        t[k * 65 + c4 + 0] = v.x; t[k * 65 + c4 + 1] = v.y; t[k * 65 + c4 + 2] = v.z; t[k * 65 + c4 + 3] = v.w;
    }
    __syncthreads();
    const int n = tid >> 2, kq = (tid & 3) * 16;
    unsigned w[8];
#pragma unroll
    for (int i = 0; i < 8; ++i) w[i] = pack_bf16(t[(kq + 2 * i) * 65 + n], t[(kq + 2 * i + 1) * 65 + n]);
    uint4* d = (uint4*)(dst + (size_t)(n0 + n) * K + k0 + kq);
    d[0] = make_uint4(w[0], w[1], w[2], w[3]); d[1] = make_uint4(w[4], w[5], w[6], w[7]);
    __syncthreads();
}


__device__ __forceinline__ void rms_row_bf16(const float* __restrict__ xr, const float* __restrict__ g, bf16_t* __restrict__ o, int lane) {
    float4 v[4]; float ss = 0.f;
#pragma unroll
    for (int i = 0; i < 4; ++i) { v[i] = *(const float4*)(xr + i * 256 + lane * 4); ss += v[i].x * v[i].x + v[i].y * v[i].y + v[i].z * v[i].z + v[i].w * v[i].w; }
    ss = wave_sum(ss);
    const float rs = rsqrtf(ss * (1.0f / 1024.0f) + EPS);
#pragma unroll
    for (int i = 0; i < 4; ++i) {
        const float4 gg = *(const float4*)(g + i * 256 + lane * 4);
        *(uint2*)(o + i * 256 + lane * 4) = make_uint2(pack_bf16(v[i].x * rs * gg.x, v[i].y * rs * gg.y), pack_bf16(v[i].z * rs * gg.z, v[i].w * rs * gg.w));
    }
}


__device__ __forceinline__ void conv_plain(const float* __restrict__ src, bf16_t* __restrict__ dst, size_t n8) {
    for (size_t i = (size_t)blockIdx.x * 256 + tidx(); i < n8; i += (size_t)gridDim.x * 256) {
        const float4 a = ((const float4*)src)[2 * i], b = ((const float4*)src)[2 * i + 1];
        ((uint4*)dst)[i] = make_uint4(pack_bf16(a.x, a.y), pack_bf16(a.z, a.w), pack_bf16(b.x, b.y), pack_bf16(b.z, b.w));
    }
}
__device__ __forceinline__ void rope_item(const int* __restrict__ pos, float* __restrict__ cs, int i) {
    const int t = i >> 4, f = i & 15;
    const float inv = powf(500000.0f, -(float)(2 * f) / 32.0f);
    const float ang = (float)pos[t] * inv;
    float s, c; sincosf(ang, &s, &c);
    cs[2 * i] = c; cs[2 * i + 1] = s;
}

__device__ __forceinline__ int swz(int row) { return (row & 3) | (((row >> 3) & 1) << 2); }

__device__ __forceinline__ void gemm_tile(const bf16_t* __restrict__ A, int lda, const bf16_t* __restrict__ Bt, int ldb, int K,
                                          f32x4 (&acc)[4][4], unsigned char* smem) {
    const int tid = tidx(), lane = tid & 63, wid = tid >> 6, wr = wid >> 1, wc = wid & 1, li = lane & 15, g = lane >> 4;
    const int srow = tid >> 3, skc = tid & 7;
    const int soff = srow * 128 + ((skc ^ swz(srow)) << 4);
    const bf16_t* ga = A + (size_t)srow * lda + skc * 8;
    const bf16_t* gb = Bt + (size_t)srow * ldb + skc * 8;
    uint4 ra[4], rb[4];
    int aoff[4], boff[4], asw[4], bsw[4];
#pragma unroll
    for (int m = 0; m < 4; ++m) { const int row = wr * 64 + m * 16 + li; aoff[m] = row * 128; asw[m] = swz(row); }
#pragma unroll
    for (int n = 0; n < 4; ++n) { const int row = wc * 64 + 32 * (n >> 1) + 8 * (li >> 2) + 4 * (n & 1) + (li & 3); boff[n] = 16384 + row * 128; bsw[n] = swz(row); }
    const int nk = K >> 6;
#pragma unroll
    for (int i = 0; i < 4; ++i) { ra[i] = *(const uint4*)(ga + (size_t)(32 * i) * lda); rb[i] = *(const uint4*)(gb + (size_t)(32 * i) * ldb); }
#pragma unroll
    for (int i = 0; i < 4; ++i) { *(uint4*)(smem + soff + i * 4096) = ra[i]; *(uint4*)(smem + 16384 + soff + i * 4096) = rb[i]; }
    __syncthreads();
    for (int kt = 0; kt < nk; ++kt) {
        const unsigned char* sb = smem + (kt & 1) * 32768;
        if (kt + 1 < nk) {
#pragma unroll
            for (int i = 0; i < 4; ++i) { ra[i] = *(const uint4*)(ga + (size_t)(32 * i) * lda + (kt + 1) * 64); rb[i] = *(const uint4*)(gb + (size_t)(32 * i) * ldb + (kt + 1) * 64); }
        }
#pragma unroll
        for (int ks = 0; ks < 2; ++ks) {
            bf16x8 af[4], bfr[4];
#pragma unroll
            for (int m = 0; m < 4; ++m) af[m] = *(const bf16x8*)(sb + aoff[m] + (((ks * 4 + g) ^ asw[m]) << 4));
#pragma unroll
            for (int n = 0; n < 4; ++n) bfr[n] = *(const bf16x8*)(sb + boff[n] + (((ks * 4 + g) ^ bsw[n]) << 4));
#pragma unroll
            for (int m = 0; m < 4; ++m)
#pragma unroll
                for (int n = 0; n < 4; ++n) acc[m][n] = mfma16(bfr[n], af[m], acc[m][n]);
        }
        if (kt + 1 < nk) {
            unsigned char* sw = smem + ((kt + 1) & 1) * 32768;
#pragma unroll
            for (int i = 0; i < 4; ++i) { *(uint4*)(sw + soff + i * 4096) = ra[i]; *(uint4*)(sw + 16384 + soff + i * 4096) = rb[i]; }
        }
        __syncthreads();
    }
}
__device__ __forceinline__ void acc_zero(f32x4 (&acc)[4][4]) {
#pragma unroll
    for (int m = 0; m < 4; ++m)
#pragma unroll
        for (int n = 0; n < 4; ++n) acc[m][n] = (f32x4){0.f, 0.f, 0.f, 0.f};
}
template <class F> __device__ __forceinline__ void epi_foreach(const f32x4 (&acc)[4][4], F&& f) {
    const int lane = tidx() & 63, wid = tidx() >> 6, wr = wid >> 1, wc = wid & 1, li = lane & 15, g = lane >> 4;
#pragma unroll
    for (int m = 0; m < 4; ++m)
#pragma unroll
        for (int pp = 0; pp < 2; ++pp) {
            float v[8];
#pragma unroll
            for (int r = 0; r < 4; ++r) { v[r] = acc[m][2 * pp][r]; v[4 + r] = acc[m][2 * pp + 1][r]; }
            f(wr * 64 + m * 16 + li, wc * 64 + 32 * pp + 8 * g, v, pp);
        }
}
__device__ __forceinline__ void store_bf16x8(bf16_t* p, const float (&v)[8]) {
    *(uint4*)p = make_uint4(pack_bf16(v[0], v[1]), pack_bf16(v[2], v[3]), pack_bf16(v[4], v[5]), pack_bf16(v[6], v[7]));
}
__device__ __forceinline__ void store_tile_T(const f32x4 (&acc)[4][4], bf16_t* __restrict__ dstT, int ldt, unsigned char* smem) {
    bf16_t* t = (bf16_t*)smem;
    epi_foreach(acc, [&](int r, int c, const float (&v)[8], int) {
#pragma unroll
        for (int e = 0; e < 8; ++e) t[(c + e) * 136 + r] = f2bf(v[e]);
    });
    __syncthreads();
#pragma unroll
    for (int i = 0; i < 8; ++i) {
        const int ch = tidx() + 256 * i, d = ch >> 4, tc = ch & 15;
        *(uint4*)(dstT + (size_t)d * ldt + tc * 8) = *(const uint4*)(smem + d * 272 + tc * 16);
    }
    __syncthreads();
}

__device__ void inproj_tile(const Params& p, int rt, int ct, unsigned char* smem) {
    unsigned char* ws = p.ws; unsigned char* dob = (unsigned char*)p.out;
    const bf16_t* hbf = (const bf16_t*)(dob + DO_HBF);
    const bf16_t* WinT = (const bf16_t*)(ws + OFF_WINT);
    f32x4 acc[4][4]; acc_zero(acc);
    gemm_tile(hbf + (size_t)rt * 128 * 1024, 1024, WinT + (size_t)ct * 128 * 1024, 1024, 1024, acc, smem);
    const int row0 = rt * 128;
    if (ct < 8) {
        const float* cs = (const float*)(dob + DO_ROPE);
        const bool isq = ct < 6;
        bf16_t* dst = isq ? (bf16_t*)(ws + OFF_QA) + ct * 128 : (bf16_t*)(ws + OFF_KA) + (ct - 6) * 128;
        const int ld = isq ? 768 : 256;
        const float sc = isq ? QSCALE : 1.0f;
        const int g = (tidx() & 63) >> 4;
        epi_foreach(acc, [&](int r, int c, float (&v)[8], int pp) {
            const int tok = row0 + r;
            if (pp == 0 && c < 32) {
                const float* csr = cs + (size_t)tok * 32 + (g & 1) * 16;
#pragma unroll
                for (int e = 0; e < 8; ++e) {
                    const float o = __shfl_xor(v[e], 32);
                    const float cc = csr[2 * e], ss = csr[2 * e + 1];
                    v[e] = (g < 2) ? (v[e] * cc - o * ss) : (v[e] * cc + o * ss);
                }
            }
#pragma unroll
            for (int e = 0; e < 8; ++e) v[e] *= sc;
            store_bf16x8(dst + (size_t)tok * ld + c, v);
        });
    } else if (ct < 10) {
        const int kvh = ct - 8, b = row0 / S_, s0 = row0 % S_;
        store_tile_T(acc, (bf16_t*)(ws + OFF_VAT) + (size_t)(b * 2 + kvh) * 128 * S_ + s0, S_, smem);
    } else if (ct < 16) {
        bf16_t* dst = (bf16_t*)(ws + OFF_XL) + (ct - 10) * 128;
        epi_foreach(acc, [&](int r, int c, float (&v)[8], int) { store_bf16x8(dst + (size_t)(row0 + r) * 768 + c, v); });
    } else if (ct < 22) {
        bf16_t* dst = (bf16_t*)(ws + OFF_GL) + (ct - 16) * 128;
        epi_foreach(acc, [&](int r, int c, float (&v)[8], int) {
#pragma unroll
            for (int e = 0; e < 8; ++e) v[e] = gelu_tanh(v[e]);
            store_bf16x8(dst + (size_t)(row0 + r) * 768 + c, v); });
    } else if (ct < 26) {
        bf16_t* dst = (bf16_t*)(ws + OFF_QM) + (ct - 22) * 128;
        epi_foreach(acc, [&](int r, int c, float (&v)[8], int) {
#pragma unroll
            for (int e = 0; e < 8; ++e) v[e] *= QSCALE;
            store_bf16x8(dst + (size_t)(row0 + r) * 512 + c, v); });
    } else {
        const int gc0 = (ct - 26) * 128;
        bf16_t* dst = (bf16_t*)(ws + OFF_GATES) + gc0;
        const float* gb = p.gate_b + gc0;
        epi_foreach(acc, [&](int r, int c, float (&v)[8], int) {
            const float4 b0 = *(const float4*)(gb + c), b1 = *(const float4*)(gb + c + 4);
            v[0] = sigmoidf_(v[0] + b0.x); v[1] = sigmoidf_(v[1] + b0.y); v[2] = sigmoidf_(v[2] + b0.z); v[3] = sigmoidf_(v[3] + b0.w);
            v[4] = sigmoidf_(v[4] + b1.x); v[5] = sigmoidf_(v[5] + b1.y); v[6] = sigmoidf_(v[6] + b1.z); v[7] = sigmoidf_(v[7] + b1.w);
            store_bf16x8(dst + (size_t)(row0 + r) * 3072 + c, v); });
    }
}

__device__ void memkv_tile(const Params& p, int rt, int ct, unsigned char* smem) {
    unsigned char* dob = (unsigned char*)p.out;
    f32x4 acc[4][4]; acc_zero(acc);
    gemm_tile((const bf16_t*)(dob + DO_MEMBF) + (size_t)rt * 128 * 1024, 1024, (const bf16_t*)(p.ws + OFF_WMKVT) + (size_t)ct * 128 * 1024, 1024, 1024, acc, smem);
    const int row0 = rt * 128;
    if (ct < 4) {
        bf16_t* dst = (bf16_t*)(dob + DO_KM) + ct * 128;
        epi_foreach(acc, [&](int r, int c, float (&v)[8], int) { store_bf16x8(dst + (size_t)(row0 + r) * 512 + c, v); });
    } else {
        const int h = ct - 4, b = row0 / MEML, m0 = row0 % MEML;
        store_tile_T(acc, (bf16_t*)(dob + DO_VMT) + (size_t)(b * 4 + h) * 128 * MEML + m0, MEML, smem);
    }
}


template <int NF, bool WIN>
__device__ __forceinline__ void attn_wave(const bf16_t* Q, int ldq, const bf16_t* __restrict__ Kb, int ldk, const bf16_t* __restrict__ Vt, int ldv,
                                          int q0, int kstart, int nkeys, float sink, bf16_t* O, int ldo) {
    const int lane = tidx() & 63, li = lane & 15, g = lane >> 4;
    bf16x8 qf[4];
#pragma unroll
    for (int ks = 0; ks < 4; ++ks) qf[ks] = *(const bf16x8*)(Q + (size_t)li * ldq + ks * 32 + g * 8);
    f32x4 s[NF];
#pragma unroll
    for (int t = 0; t < NF; ++t) {
        int key = kstart + 16 * t + li; key = key < 0 ? 0 : (key > nkeys - 1 ? nkeys - 1 : key);
        const bf16_t* kp = Kb + (size_t)key * ldk + g * 8;
        f32x4 a = {0.f, 0.f, 0.f, 0.f};
#pragma unroll
        for (int ks = 0; ks < 4; ++ks) a = mfma16(*(const bf16x8*)(kp + ks * 32), qf[ks], a);
        s[t] = a;
    }
    float mx = -1e30f;
#pragma unroll
    for (int t = 0; t < NF; ++t)
#pragma unroll
        for (int r = 0; r < 4; ++r) {
            if (WIN) {
                const int kp = kstart + 16 * t + 4 * g + r, d = kp - (q0 + li);
                const bool valid = kp >= 0 && kp < nkeys && d <= 128 && d >= -128;
                s[t][r] = valid ? s[t][r] : -1e30f;
            }
            mx = fmaxf(mx, s[t][r]);
        }
    mx = fmaxf(mx, __shfl_xor(mx, 16)); mx = fmaxf(mx, __shfl_xor(mx, 32));
    if (WIN) mx = fmaxf(mx, sink);
    float sum = 0.f;
#pragma unroll
    for (int t = 0; t < NF; ++t)
#pragma unroll
        for (int r = 0; r < 4; ++r) { const float pv = __expf(s[t][r] - mx); s[t][r] = pv; sum += pv; }
    sum += __shfl_xor(sum, 16); sum += __shfl_xor(sum, 32);
    if (WIN) sum += __expf(sink - mx);
    const float inv = 1.0f / sum;
    f32x4 o[8];
#pragma unroll
    for (int df = 0; df < 8; ++df) o[df] = (f32x4){0.f, 0.f, 0.f, 0.f};
#pragma unroll
    for (int kk = 0; kk < NF / 2; ++kk) {
        union { unsigned u[4]; bf16x8 v; } pb;
        pb.u[0] = pack_bf16(s[2 * kk][0], s[2 * kk][1]); pb.u[1] = pack_bf16(s[2 * kk][2], s[2 * kk][3]);
        pb.u[2] = pack_bf16(s[2 * kk + 1][0], s[2 * kk + 1][1]); pb.u[3] = pack_bf16(s[2 * kk + 1][2], s[2 * kk + 1][3]);
        int ka = kstart + 32 * kk + 4 * g, kb = ka + 16;
        ka = ka < 0 ? 0 : (ka > nkeys - 4 ? nkeys - 4 : ka); kb = kb < 0 ? 0 : (kb > nkeys - 4 ? nkeys - 4 : kb);
#pragma unroll
        for (int df = 0; df < 8; ++df) {
            const bf16_t* vp = Vt + (size_t)(df * 16 + li) * ldv;
            union { uint2 u[2]; bf16x8 v; } va;
            va.u[0] = *(const uint2*)(vp + ka); va.u[1] = *(const uint2*)(vp + kb);
            o[df] = mfma16(va.v, pb.v, o[df]);
        }
    }
#pragma unroll
    for (int df = 0; df < 8; ++df)
        *(uint2*)(O + (size_t)li * ldo + df * 16 + 4 * g) = make_uint2(pack_bf16(o[df][0] * inv, o[df][1] * inv), pack_bf16(o[df][2] * inv, o[df][3] * inv));
}
__device__ void attn_win_unit(const Params& p, int u) {
    const int wid = tidx() >> 6;
    const int qb = u % 32, head = (u / 32) % 6, b = u / 192, kvh = head / 3;
    const int q0 = qb * 64 + wid * 16;
    bf16_t* Q = (bf16_t*)(p.ws + OFF_QA) + (size_t)(b * S_ + q0) * 768 + head * 128;
    const bf16_t* Kb = (const bf16_t*)(p.ws + OFF_KA) + (size_t)(b * S_) * 256 + kvh * 128;
    const bf16_t* Vt = (const bf16_t*)(p.ws + OFF_VAT) + (size_t)(b * 2 + kvh) * 128 * S_;
    attn_wave<18, true>(Q, 768, Kb, 256, Vt, S_, q0, q0 - 128, S_, p.attn_sink[head], Q, 768);
}
__device__ void attn_mem_unit(const Params& p, int u) {
    const int wid = tidx() >> 6;
    const int qb = u % 32, head = (u / 32) % 4, b = u / 128;
    const int q0 = qb * 64 + wid * 16;
    unsigned char* dob = (unsigned char*)p.out;
    bf16_t* Q = (bf16_t*)(p.ws + OFF_QM) + (size_t)(b * S_ + q0) * 512 + head * 128;
    const bf16_t* Kb = (const bf16_t*)(dob + DO_KM) + (size_t)(b * MEML) * 512 + head * 128;
    const bf16_t* Vt = (const bf16_t*)(dob + DO_VMT) + (size_t)(b * 4 + head) * 128 * MEML;
    attn_wave<16, false>(Q, 512, Kb, 512, Vt, MEML, q0, 0, MEML, 0.f, Q, 512);
}


__device__ void lru_unit(const Params& p, int u, unsigned char* smem) {
    const int tid = tidx(), lane = tid & 63, wid = tid >> 6, li = lane & 15, g = lane >> 4;
    const int qt = u & 3, h = (u >> 2) % 6, b = u / 24;
    const int cbase = h * 128, cq0 = cbase + qt * 32;
    unsigned char* xcs = smem; unsigned char* wl = smem + 16384;
    float* pre = (float*)(smem + 32768); float* xcf = (float*)(smem + 49152);
    float* cA = (float*)(smem + 57344); float* cH = cA + 256; float* h0 = cH + 256;
    const bf16_t* Xl = (const bf16_t*)(p.ws + OFF_XL) + (size_t)(b * S_) * 768;
    bf16_t* Gl = (bf16_t*)(p.ws + OFF_GL) + (size_t)(b * S_) * 768;
    bf16_t* Hf = (bf16_t*)((unsigned char*)p.out + DO_HBF) + (size_t)(b * S_) * 768;
    const bf16_t* LruWt = (const bf16_t*)(p.ws + OFF_LRUWT);
    const int cp = tid & 63, tq = tid >> 6, cch = cbase + 2 * cp;
    float cw[4][2];
#pragma unroll
    for (int j = 0; j < 4; ++j) { cw[j][0] = p.conv_w[j * LW + cch]; cw[j][1] = p.conv_w[j * LW + cch + 1]; }
    const float cb0 = p.conv_b[cch], cb1 = p.conv_b[cch + 1];
    const int sc_c = tid & 31, sub = tid >> 5, sch = cq0 + sc_c;
    for (int dir = 0; dir < 2; ++dir) {
        __syncthreads();
#pragma unroll
        for (int i = 0; i < 4; ++i) {
            const int ch = tid + 256 * i, j = ch >> 4, kc = ch & 15;
            const int srcrow = h * 512 + ((j >> 5) * 2 + dir) * 128 + qt * 32 + (j & 31);
            *(uint4*)(wl + j * 256 + ((kc ^ (j & 15)) << 4)) = *(const uint4*)(LruWt + (size_t)srcrow * 128 + kc * 8);
        }
        const float br = p.lru_br[dir * LW + sch], bi = p.lru_bi[dir * LW + sch];
        const float lam = p.lru_lambda[dir * LW + sch];
        const float sp8 = -8.0f * log1pf(__expf(-lam));
        if (tid < 32) h0[tid] = 0.f;
        for (int ci = 0; ci < 32; ++ci) {
            const int chunk = dir ? 31 - ci : ci, s0 = chunk * 64;
            {
                float xa[19], xb[19];
#pragma unroll
                for (int i = 0; i < 19; ++i) {
                    const int s = s0 + 16 * tq + i - 2;
                    unsigned w = 0;
                    if (s >= 0 && s < S_) w = *(const unsigned*)(Xl + (size_t)s * 768 + cch);
                    xa[i] = bflo(w); xb[i] = bfhi(w);
                }
#pragma unroll
                for (int i = 0; i < 16; ++i) {
                    const int t = 16 * tq + i;
                    const float y0 = cb0 + cw[0][0] * xa[i] + cw[1][0] * xa[i + 1] + cw[2][0] * xa[i + 2] + cw[3][0] * xa[i + 3];
                    const float y1 = cb1 + cw[0][1] * xb[i] + cw[1][1] * xb[i + 1] + cw[2][1] * xb[i + 2] + cw[3][1] * xb[i + 3];
                    *(unsigned*)(xcs + t * 256 + (((cp >> 2) ^ (t & 15)) << 4) + (cp & 3) * 4) = pack_bf16(y0, y1);
                    if ((cp >> 4) == qt) { xcf[t * 32 + 2 * (cp & 15)] = y0; xcf[t * 32 + 2 * (cp & 15) + 1] = y1; }
                }
            }
            __syncthreads();
            {
                f32x4 a[4];
#pragma unroll
                for (int n = 0; n < 4; ++n) a[n] = (f32x4){0.f, 0.f, 0.f, 0.f};
#pragma unroll
                for (int ks = 0; ks < 4; ++ks) {
                    const int row = wid * 16 + li;
                    const bf16x8 xf = *(const bf16x8*)(xcs + row * 256 + (((ks * 4 + g) ^ (row & 15)) << 4));
#pragma unroll
                    for (int n = 0; n < 4; ++n) {
                        const int j = n * 16 + li;
                        const bf16x8 wf = *(const bf16x8*)(wl + j * 256 + (((ks * 4 + g) ^ (j & 15)) << 4));
                        a[n] = mfma16(xf, wf, a[n]);
                    }
                }
#pragma unroll
                for (int n = 0; n < 4; ++n)
#pragma unroll
                    for (int r = 0; r < 4; ++r) pre[(wid * 16 + 4 * g + r) * 64 + n * 16 + li] = a[n][r];
            }
            __syncthreads();
            float hl[8], ap[8];
            {
                float hh = 0.f, aa = 1.f;
#pragma unroll
                for (int k = 0; k < 8; ++k) {
                    const int pp = sub * 8 + k, t = dir ? 63 - pp : pp;
                    const float r = sigmoidf_(pre[t * 64 + sc_c] + br), ig = sigmoidf_(pre[t * 64 + 32 + sc_c] + bi);
                    const float la = sp8 * r;
                    const float a = __expf(la);
                    const float bx = sqrtf(-expm1f(2.0f * la)) * (ig * xcf[t * 32 + sc_c]);
                    hh = a * hh + bx; aa *= a; hl[k] = hh; ap[k] = aa;
                }
                cA[sub * 32 + sc_c] = aa; cH[sub * 32 + sc_c] = hh;
            }
            __syncthreads();
            {
                float hin = h0[(ci & 1) * 32 + sc_c];
                for (int s2 = 0; s2 < sub; ++s2) hin = cA[s2 * 32 + sc_c] * hin + cH[s2 * 32 + sc_c];
#pragma unroll
                for (int k = 0; k < 8; ++k) {
                    const int pp = sub * 8 + k, t = dir ? 63 - pp : pp;
                    const float hv = hl[k] + ap[k] * hin;
                    const size_t gi = (size_t)(s0 + t) * 768 + sch;
                    if (dir == 0) Hf[gi] = f2bf(hv);
                    else Gl[gi] = f2bf((bf2f(Hf[gi]) + hv) * bf2f(Gl[gi]));
                    if (k == 7 && sub == 7) h0[((ci + 1) & 1) * 32 + sc_c] = hv;
                }
            }
        }
    }
    __syncthreads();
}


__device__ void merge_tile(const Params& p, int rt, int ct, unsigned char* smem) {
    unsigned char* ws = p.ws;
    const int row0 = rt * 128, col0 = ct * 128;
    uint4 tot[4][2];
    const bf16_t* G = (const bf16_t*)(ws + OFF_GATES);
    const int lane = tidx() & 63, wid = tidx() >> 6, wr = wid >> 1, wc = wid & 1, li = lane & 15, g = lane >> 4;
#pragma unroll 1
    for (int br = 0; br < 3; ++br) {
        const bf16_t* Ab = (const bf16_t*)(ws + (br == 0 ? OFF_QA : (br == 1 ? OFF_GL : OFF_QM)));
        const bf16_t* Bb = (const bf16_t*)(ws + (br == 0 ? OFF_PATTNT : (br == 1 ? OFF_PLRUT : OFF_PMEMT)));
        const int Kb = br == 2 ? 512 : 768;
        f32x4 acc[4][4]; acc_zero(acc);
        gemm_tile(Ab + (size_t)row0 * Kb, Kb, Bb + (size_t)col0 * Kb, Kb, Kb, acc, smem);
#pragma unroll
        for (int m = 0; m < 4; ++m)
#pragma unroll
            for (int pp = 0; pp < 2; ++pp) {
                const int r = wr * 64 + m * 16 + li, c = wc * 64 + 32 * pp + 8 * g;
                const uint4 gv = *(const uint4*)(G + (size_t)(row0 + r) * 3072 + br * 1024 + col0 + c);
                float v[8];
                v[0] = bflo(gv.x) * acc[m][2 * pp][0]; v[1] = bfhi(gv.x) * acc[m][2 * pp][1];
                v[2] = bflo(gv.y) * acc[m][2 * pp][2]; v[3] = bfhi(gv.y) * acc[m][2 * pp][3];
                v[4] = bflo(gv.z) * acc[m][2 * pp + 1][0]; v[5] = bfhi(gv.z) * acc[m][2 * pp + 1][1];
                v[6] = bflo(gv.w) * acc[m][2 * pp + 1][2]; v[7] = bfhi(gv.w) * acc[m][2 * pp + 1][3];
                if (br > 0) {
                    const uint4 t = tot[m][pp];
                    v[0] += bflo(t.x); v[1] += bfhi(t.x); v[2] += bflo(t.y); v[3] += bfhi(t.y);
                    v[4] += bflo(t.z); v[5] += bfhi(t.z); v[6] += bflo(t.w); v[7] += bfhi(t.w);
                }
                tot[m][pp] = make_uint4(pack_bf16(v[0], v[1]), pack_bf16(v[2], v[3]), pack_bf16(v[4], v[5]), pack_bf16(v[6], v[7]));
            }
    }
    bf16_t* dst = (bf16_t*)(ws + OFF_MERGED) + col0;
#pragma unroll
    for (int m = 0; m < 4; ++m)
#pragma unroll
        for (int pp = 0; pp < 2; ++pp) {
            const int r = wr * 64 + m * 16 + li, c = wc * 64 + 32 * pp + 8 * g;
            *(uint4*)(dst + (size_t)(row0 + r) * 1024 + c) = tot[m][pp];
        }
}
__device__ void outproj_tile(const Params& p, int rt, int ct, unsigned char* smem) {
    const int row0 = rt * 128, col0 = ct * 128;
    f32x4 acc[4][4]; acc_zero(acc);
    gemm_tile((const bf16_t*)(p.ws + OFF_MERGED) + (size_t)row0 * 1024, 1024, (const bf16_t*)(p.ws + OFF_WOUTT) + (size_t)col0 * 1024, 1024, 1024, acc, smem);
    epi_foreach(acc, [&](int r, int c, float (&v)[8], int) {
        const size_t o = (size_t)(row0 + r) * 1024 + col0 + c;
        const float4 x0 = *(const float4*)(p.x + o), x1 = *(const float4*)(p.x + o + 4);
        *(float4*)(p.out + o) = make_float4(x0.x + v[0], x0.y + v[1], x0.z + v[2], x0.w + v[3]);
        *(float4*)(p.out + o + 4) = make_float4(x1.x + v[4], x1.y + v[5], x1.z + v[6], x1.w + v[7]);
    });
}

__device__ void peerq_tile(const Params& p, int rt, int ct, unsigned char* smem) {
    const int row0 = rt * 128, col0 = ct * 128;
    f32x4 acc[4][4]; acc_zero(acc);
    gemm_tile((const bf16_t*)(p.ws + OFF_MERGED) + (size_t)row0 * 1024, 1024, (const bf16_t*)(p.ws + OFF_WPQT) + (size_t)col0 * 1024, 1024, 1024, acc, smem);
    bf16_t* dst = (bf16_t*)(p.ws + OFF_QPEER) + col0;
    epi_foreach(acc, [&](int r, int c, float (&v)[8], int) { store_bf16x8(dst + (size_t)(row0 + r) * 2048 + c, v); });
}

__device__ __forceinline__ int sortable(float v) { int k = __float_as_int(v); return k ^ ((k >> 31) & 0x7fffffff); }
__device__ __forceinline__ float unsortable(int k) { return __int_as_float(k ^ ((k >> 31) & 0x7fffffff)); }
__device__ __forceinline__ void insert16(int (&lst)[16], int x) {
#pragma unroll
    for (int k = 0; k < 16; ++k) { const int hi = max(lst[k], x); x = min(lst[k], x); lst[k] = hi; }
}
__device__ void scores_tile(const Params& p, int rt, int pq, unsigned char* smem) {
    const int row0 = rt * 128;
    f32x4 acc[4][4]; acc_zero(acc);
    gemm_tile((const bf16_t*)(p.ws + OFF_QPEER) + (size_t)row0 * 2048 + pq * 128, 2048, (const bf16_t*)(p.ws + OFF_SUBK) + (size_t)pq * 128 * 128, 128, 128, acc, smem);
    float* sc = (float*)smem;
    epi_foreach(acc, [&](int r, int c, float (&v)[8], int) {
        *(float4*)(sc + r * 132 + c) = make_float4(v[0], v[1], v[2], v[3]);
        *(float4*)(sc + r * 132 + c + 4) = make_float4(v[4], v[5], v[6], v[7]); });
    __syncthreads();
    if (tidx() < 128) {
        const int r = tidx();
        int lst[16];
#pragma unroll
        for (int k = 0; k < 16; ++k) lst[k] = (int)0x80000000;
#pragma unroll 2
        for (int j4 = 0; j4 < 32; ++j4) {
            const float4 v = *(const float4*)(sc + r * 132 + j4 * 4);
            insert16(lst, (sortable(v.x) & ~127) | (j4 * 4 + 0));
            insert16(lst, (sortable(v.y) & ~127) | (j4 * 4 + 1));
            insert16(lst, (sortable(v.z) & ~127) | (j4 * 4 + 2));
            insert16(lst, (sortable(v.w) & ~127) | (j4 * 4 + 3));
        }
        int4* dst = (int4*)((int*)(p.ws + OFF_TOPL) + ((size_t)(row0 + r) * 16 + pq) * 16);
        dst[0] = make_int4(lst[0], lst[1], lst[2], lst[3]); dst[1] = make_int4(lst[4], lst[5], lst[6], lst[7]);
        dst[2] = make_int4(lst[8], lst[9], lst[10], lst[11]); dst[3] = make_int4(lst[12], lst[13], lst[14], lst[15]);
    }
    __syncthreads();
}

__device__ void combine_item(const Params& p, int item) {
    const int tok = item >> 3, hd = item & 7;
    const int* l0 = (const int*)(p.ws + OFF_TOPL) + ((size_t)tok * 16 + hd * 2) * 16;
    const int* l1 = l0 + 16;
    int k0[16], k1[16];
#pragma unroll
    for (int i = 0; i < 4; ++i) {
        const int4 a = ((const int4*)l0)[i], b = ((const int4*)l1)[i];
        k0[4 * i] = a.x; k0[4 * i + 1] = a.y; k0[4 * i + 2] = a.z; k0[4 * i + 3] = a.w;
        k1[4 * i] = b.x; k1[4 * i + 1] = b.y; k1[4 * i + 2] = b.z; k1[4 * i + 3] = b.w;
    }
    float v0[16], v1[16];
#pragma unroll
    for (int i = 0; i < 16; ++i) { v0[i] = unsortable(k0[i] & ~127); v1[i] = unsortable(k1[i] & ~127); }
    int lst[16];
#pragma unroll
    for (int k = 0; k < 16; ++k) lst[k] = (int)0x80000000;
#pragma unroll
    for (int a = 0; a < 16; ++a)
#pragma unroll
        for (int b = 0; b < 16; ++b)
            if ((a + 1) * (b + 1) <= 16) insert16(lst, (sortable(v0[a] + v1[b]) & ~255) | (a * 16 + b));
    float val[16], sum = 0.f;
    const float mx = unsortable(lst[0] & ~255);
#pragma unroll
    for (int k = 0; k < 16; ++k) { val[k] = __expf(unsortable(lst[k] & ~255) - mx); sum += val[k]; }
    const float inv = 1.0f / sum;
    int* ei = (int*)(p.ws + OFF_EIDX) + (size_t)tok * 128 + hd * 16;
    float* eg = (float*)(p.ws + OFF_EGATE) + (size_t)tok * 128 + hd * 16;
#pragma unroll
    for (int k = 0; k < 16; ++k) {
        const int code = lst[k] & 255, a = code >> 4, b = code & 15;
        ei[k] = (l0[a] & 127) * 128 + (l1[b] & 127);
        eg[k] = val[k] * inv;
    }
}

__device__ __forceinline__ float dot16(const uint4 (&r)[2], const unsigned (&hq)[8]) {
    const unsigned uu[8] = {r[0].x, r[0].y, r[0].z, r[0].w, r[1].x, r[1].y, r[1].z, r[1].w};
    float d = 0.f;
#pragma unroll
    for (int e = 0; e < 8; ++e) d = __builtin_amdgcn_fdot2_f32_bf16(__builtin_bit_cast(bf16x2v, uu[e]), __builtin_bit_cast(bf16x2v, hq[e]), d, false);
    return d;
}
__device__ __forceinline__ void load4rows(uint4 (&R)[4][2], const bf16_t* __restrict__ tab, int es, int l0, int lane) {
#pragma unroll
    for (int j = 0; j < 4; ++j) {
        const int id = __builtin_amdgcn_readlane(es, l0 + j);
        const bf16_t* rp = tab + (size_t)id * 1024 + lane * 8;
        R[j][0] = *(const uint4*)rp; R[j][1] = *(const uint4*)(rp + 512);
    }
}
__device__ __forceinline__ float dots4(const uint4 (&R)[4][2], const unsigned (&hq)[8], int lane) {
    float pd[4];
#pragma unroll
    for (int j = 0; j < 4; ++j) pd[j] = dot16(R[j], hq);
    const bool lo = lane < 32;
    float k0 = lo ? pd[0] : pd[2], k1 = lo ? pd[1] : pd[3];
    const float s0 = lo ? pd[2] : pd[0], s1 = lo ? pd[3] : pd[1];
    k0 += __shfl_xor(s0, 32); k1 += __shfl_xor(s1, 32);
    const bool b4 = (lane & 16) != 0;
    float kk = b4 ? k1 : k0; const float s = b4 ? k0 : k1;
    kk += __shfl_xor(s, 16);
    kk += __shfl_xor(kk, 8); kk += __shfl_xor(kk, 4); kk += __shfl_xor(kk, 2); kk += __shfl_xor(kk, 1);
    return kk;
}
__device__ __forceinline__ void axpy4(float (&o)[16], const uint4 (&R)[4][2], int wsr, int l15i) {
#pragma unroll
    for (int j = 0; j < 4; ++j) {
        const float c = __int_as_float(__builtin_amdgcn_readlane(wsr, 16 * j + l15i));
        const unsigned vv[8] = {R[j][0].x, R[j][0].y, R[j][0].z, R[j][0].w, R[j][1].x, R[j][1].y, R[j][1].z, R[j][1].w};
#pragma unroll
        for (int e = 0; e < 8; ++e) { o[2 * e] += c * bflo(vv[e]); o[2 * e + 1] += c * bfhi(vv[e]); }
    }
}
__device__ void gather_token(const Params& p, int tok, int lane) {
    const bf16_t* h2 = (const bf16_t*)(p.ws + OFF_MERGED) + (size_t)tok * 1024;
    const bf16_t* Ub = (const bf16_t*)(p.ws + OFF_UB); const bf16_t* Vb = (const bf16_t*)(p.ws + OFF_VB);
    const int* ei = (const int*)(p.ws + OFF_EIDX) + (size_t)tok * 128;
    const float* eg = (const float*)(p.ws + OFF_EGATE) + (size_t)tok * 128;
    const uint4 ha = *(const uint4*)(h2 + lane * 8), hb = *(const uint4*)(h2 + 512 + lane * 8);
    const unsigned hq[8] = {ha.x, ha.y, ha.z, ha.w, hb.x, hb.y, hb.z, hb.w};
    const int l15 = lane & 15, gperm = 4 * l15 + (lane >> 4);
    int es[2]; float gs[2]; int wsr[2] = {0, 0};
    es[0] = ei[lane]; es[1] = ei[lane + 64]; gs[0] = eg[gperm]; gs[1] = eg[64 + gperm];
    uint4 R0[4][2], R1[4][2];
#pragma unroll
    for (int k = 0; k < 2; ++k) {
        load4rows(R0, Ub, es[k], 0, lane);
        for (int ii = 0; ii < 16; ii += 2) {
            load4rows(R1, Ub, es[k], 4 * ii + 4, lane);
            { const float w = gelu_tanh(dots4(R0, hq, lane)) * gs[k]; if (l15 == ii) wsr[k] = __float_as_int(w); }
            if (ii + 2 < 16) load4rows(R0, Ub, es[k], 4 * ii + 8, lane);
            { const float w = gelu_tanh(dots4(R1, hq, lane)) * gs[k]; if (l15 == ii + 1) wsr[k] = __float_as_int(w); }
        }
    }
    float o[16];
#pragma unroll
    for (int e = 0; e < 16; ++e) o[e] = 0.f;
#pragma unroll
    for (int k = 0; k < 2; ++k) {
        load4rows(R0, Vb, es[k], 0, lane);
        for (int ii = 0; ii < 16; ii += 2) {
            load4rows(R1, Vb, es[k], 4 * ii + 4, lane);
            axpy4(o, R0, wsr[k], ii);
            if (ii + 2 < 16) load4rows(R0, Vb, es[k], 4 * ii + 8, lane);
            axpy4(o, R1, wsr[k], ii + 1);
        }
    }
    float* xr = p.out + (size_t)tok * 1024;
    float4 x[4];
    x[0] = *(const float4*)(xr + lane * 8); x[1] = *(const float4*)(xr + lane * 8 + 4);
    x[2] = *(const float4*)(xr + 512 + lane * 8); x[3] = *(const float4*)(xr + 512 + lane * 8 + 4);
    float ss = 0.f;
#pragma unroll
    for (int i = 0; i < 4; ++i) {
        x[i].x += o[4 * i]; x[i].y += o[4 * i + 1]; x[i].z += o[4 * i + 2]; x[i].w += o[4 * i + 3];
        ss += x[i].x * x[i].x + x[i].y * x[i].y + x[i].z * x[i].z + x[i].w * x[i].w;
    }
    ss = wave_sum(ss);
    const float rs = rsqrtf(ss * (1.0f / 1024.0f) + EPS);
    const float* gf = p.g_final;
#pragma unroll
    for (int i = 0; i < 4; ++i) {
        const int c = (i >> 1) * 512 + lane * 8 + (i & 1) * 4;
        const float4 gg = *(const float4*)(gf + c);
        *(float4*)(xr + c) = make_float4(x[i].x * rs * gg.x, x[i].y * rs * gg.y, x[i].z * rs * gg.z, x[i].w * rs * gg.w);
    }
}


#define XB_TMO      128
#define XB_XCNT(j)  (256  + 64 * (j))
#define XB_XSUB(j)  (1280 + 64 * (j))
#define XB_XGEN(j)  (2304 + 64 * (j))
#define XB_TOP      3328
#define XB_TOPGEN   3392
#define XCD_BAR_WORDS 3456
#define XB_SPIN_CAP (1u << 22)
#define LAS __attribute__((address_space(3)))
__device__ __forceinline__ unsigned xb_ld(unsigned* p)              { return __hip_atomic_load(p, __ATOMIC_RELAXED, __HIP_MEMORY_SCOPE_AGENT); }
__device__ __forceinline__ unsigned xb_add(unsigned* p, unsigned v) { return __hip_atomic_fetch_add(p, v, __ATOMIC_RELAXED, __HIP_MEMORY_SCOPE_AGENT); }
__device__ __forceinline__ unsigned xb_xcc_id() { return (unsigned)__builtin_amdgcn_s_getreg((3 << 11) | 20) & 0xFu; }
#define XB_SPIN(cond, bar) do { unsigned _sp = 0; while (cond) { __builtin_amdgcn_s_sleep(1); \
    if ((++_sp & 255u) == 0u) { if (xb_ld(&(bar)[XB_TMO])) break; if (_sp > XB_SPIN_CAP) { atomicAdd(&(bar)[XB_TMO], 1u); break; } } } } while (0)
struct XcdBarrier { unsigned* bar; unsigned x; volatile LAS unsigned* st; };
__device__ __forceinline__ XcdBarrier xcd_barrier_post(unsigned* bar, volatile LAS unsigned* st) {
    XcdBarrier b; b.bar = bar; b.x = xb_xcc_id(); b.st = st;
    if (threadIdx.x == 0) (void)xb_add(&bar[XB_XCNT(b.x)], 1u);
    return b;
}
__device__ __forceinline__ void xcd_barrier_complete(unsigned* bar, unsigned x, unsigned& nloc, unsigned& nx) {
    const unsigned G = gridDim.x;
    unsigned sum, cnt, mine, sp = 0u;
    for (;;) {
        sum = 0u; cnt = 0u; mine = 0u;
#pragma unroll
        for (unsigned j = 0; j < 16; ++j) { const unsigned c = xb_ld(&bar[XB_XCNT(j)]); sum += c; cnt += (c > 0u) ? 1u : 0u; mine = (j == x) ? c : mine; }
        if (sum == G) break;
        __builtin_amdgcn_s_sleep(1);
        if ((++sp & 255u) == 0u) { if (xb_ld(&bar[XB_TMO])) break; if (sp > XB_SPIN_CAP) { atomicAdd(&bar[XB_TMO], 1u); break; } }
    }
    nloc = mine > 0u ? mine : 1u; nx = cnt > 0u ? cnt : 1u;
}
__device__ __forceinline__ void xcd_barrier(const XcdBarrier& b) {
    asm volatile("s_waitcnt vmcnt(0)" ::: "memory");
    __syncthreads();
    if (threadIdx.x == 0) {
        unsigned* bar = b.bar;
        __builtin_amdgcn_s_waitcnt(0);
        unsigned nloc = b.st[0], nx = b.st[1];
        if (nloc == 0u) { xcd_barrier_complete(bar, b.x, nloc, nx); b.st[0] = nloc; b.st[1] = nx; }
        const unsigned old = xb_add(&bar[XB_XSUB(b.x)], 1u);
        const unsigned gen = old / nloc;
        if (old + 1u == (gen + 1u) * nloc) {
            __builtin_amdgcn_fence(__ATOMIC_RELEASE, "agent");
            asm volatile("s_waitcnt vmcnt(0)" ::: "memory");
            const unsigned og = xb_add(&bar[XB_TOP], 1u);
            const unsigned tg = og / nx;
            if (og + 1u == (tg + 1u) * nx) xb_add(&bar[XB_TOPGEN], 1u);
            else XB_SPIN(xb_ld(&bar[XB_TOPGEN]) == tg, bar);
            __builtin_amdgcn_fence(__ATOMIC_ACQUIRE, "agent");
            xb_add(&bar[XB_XGEN(b.x)], 1u);
            asm volatile("s_waitcnt vmcnt(0)" ::: "memory");
        } else {
            XB_SPIN(xb_ld(&bar[XB_XGEN(b.x)]) == gen, bar);
            __builtin_amdgcn_fence(__ATOMIC_ACQUIRE, "agent");
            asm volatile("s_waitcnt vmcnt(0)" ::: "memory");
        }
    }
    __syncthreads();
}

constexpr int SMEM_BYTES = 128 * 132 * 4;

__global__ void __launch_bounds__(256, 2) fwd_megakernel(Params p) {
    __shared__ __attribute__((aligned(16))) unsigned char smem[SMEM_BYTES + 16];
    if (threadIdx.x == 0) *(uint4*)(smem + SMEM_BYTES) = make_uint4(0u, 0u, 0u, 0u);
    __syncthreads();
    const XcdBarrier xb = xcd_barrier_post((unsigned*)(p.ws + OFF_BAR), (volatile LAS unsigned*)(smem + SMEM_BYTES));
    const int bid = blockIdx.x, nb = gridDim.x, tid = tidx(), lane = tid & 63, wid = tid >> 6;
    unsigned char* ws = p.ws; unsigned char* dob = (unsigned char*)p.out;
    {
        for (int u = bid; u < 3232; u += nb) {
            if (u < 1600) convT_tile(p.w_in, (bf16_t*)(ws + OFF_WINT), 1024, INW, u, smem);
            else if (u < 1856) convT_tile(p.w_mem_kv, (bf16_t*)(ws + OFF_WMKVT), 1024, 1024, u - 1600, smem);
            else if (u < 2048) convT_tile(p.p_attn, (bf16_t*)(ws + OFF_PATTNT), 768, 1024, u - 1856, smem);
            else if (u < 2240) convT_tile(p.p_lru, (bf16_t*)(ws + OFF_PLRUT), 768, 1024, u - 2048, smem);
            else if (u < 2368) convT_tile(p.p_mem, (bf16_t*)(ws + OFF_PMEMT), 512, 1024, u - 2240, smem);
            else if (u < 2624) convT_tile(p.w_out, (bf16_t*)(ws + OFF_WOUTT), 1024, 1024, u - 2368, smem);
            else if (u < 3136) convT_tile(p.w_peer_q, (bf16_t*)(ws + OFF_WPQT), 1024, 2048, u - 2624, smem);
            else {
                const int v = u - 3136, mat = v >> 2, tile = v & 3, gsel = mat / 6, h = mat % 6, dir = gsel & 1;
                const float* src = (gsel < 2 ? p.lru_wr : p.lru_wi) + (size_t)(dir * 6 + h) * 128 * 128;
                convT_tile(src, (bf16_t*)(ws + OFF_LRUWT) + (size_t)(h * 512 + gsel * 128) * 128, 128, 128, tile, smem);
            }
        }
        conv_plain(p.peer_sub_keys, (bf16_t*)(ws + OFF_SUBK), (size_t)16 * 128 * 128 / 8);
        conv_plain(p.peer_u, (bf16_t*)(ws + OFF_UB), (size_t)NEXP * 1024 / 8);
        conv_plain(p.peer_v, (bf16_t*)(ws + OFF_VB), (size_t)NEXP * 1024 / 8);
        for (int r = bid * 4 + wid; r < NTOK; r += nb * 4) rms_row_bf16(p.x + (size_t)r * 1024, p.g_mix, (bf16_t*)(dob + DO_HBF) + (size_t)r * 1024, lane);
        for (int r = bid * 4 + wid; r < NMEM; r += nb * 4) rms_row_bf16(p.mem + (size_t)r * 1024, p.g_mem, (bf16_t*)(dob + DO_MEMBF) + (size_t)r * 1024, lane);
        for (int i = bid * 256 + tid; i < NTOK * 16; i += nb * 256) rope_item(p.positions, (float*)(dob + DO_ROPE), i);
    }
    xcd_barrier(xb);
    for (int u = bid; u < 256 * 50 + 256; u += nb) {
        if (u < 256 * 50) inproj_tile(p, u / 50, u % 50, smem);
        else memkv_tile(p, (u - 256 * 50) / 8, (u - 256 * 50) % 8, smem);
    }
    xcd_barrier(xb);
    for (int u = bid; u < 384 + 3072 + 2048; u += nb) {
        if (u < 384) lru_unit(p, u, smem);
        else if (u < 384 + 3072) attn_win_unit(p, u - 384);
        else attn_mem_unit(p, u - 384 - 3072);
    }
    xcd_barrier(xb);
    for (int u = bid; u < 256 * 8; u += nb) merge_tile(p, u / 8, u % 8, smem);
    xcd_barrier(xb);
    for (int u = bid; u < 256 * 8; u += nb) outproj_tile(p, u / 8, u % 8, smem);
    xcd_barrier(xb);
    for (int r = bid * 4 + wid; r < NTOK; r += nb * 4) rms_row_bf16(p.out + (size_t)r * 1024, p.g_ffn, (bf16_t*)(ws + OFF_MERGED) + (size_t)r * 1024, lane);
    xcd_barrier(xb);
    for (int u = bid; u < 256 * 16; u += nb) peerq_tile(p, u / 16, u % 16, smem);
    xcd_barrier(xb);
    for (int u = bid; u < 256 * 16; u += nb) scores_tile(p, u / 16, u % 16, smem);
    xcd_barrier(xb);
    for (int i = bid * 256 + tid; i < NTOK * 8; i += nb * 256) combine_item(p, i);
    xcd_barrier(xb);
    for (int t = bid * 4 + wid; t < NTOK; t += nb * 4) gather_token(p, t, lane);
}

extern "C" void kernel_launch(void* const* d_in, const int* in_sizes, int n_in, void* d_out, int out_size, void* d_ws, size_t ws_size, hipStream_t stream) {
    if (ws_size < OFF_END) { fprintf(stderr, "workspace too small: %zu < %zu\n", ws_size, (size_t)OFF_END); return; }
    Params p{};
    p.x = (const float*)d_in[0]; p.mem = (const float*)d_in[1]; p.positions = (const int*)d_in[2];
    p.g_mix = (const float*)d_in[3]; p.g_mem = (const float*)d_in[4]; p.w_in = (const float*)d_in[5]; p.gate_b = (const float*)d_in[6];
    p.attn_sink = (const float*)d_in[7]; p.conv_w = (const float*)d_in[8]; p.conv_b = (const float*)d_in[9];
    p.lru_wr = (const float*)d_in[10]; p.lru_br = (const float*)d_in[11]; p.lru_wi = (const float*)d_in[12]; p.lru_bi = (const float*)d_in[13];
    p.lru_lambda = (const float*)d_in[14]; p.w_mem_kv = (const float*)d_in[15]; p.p_attn = (const float*)d_in[16]; p.p_lru = (const float*)d_in[17];
    p.p_mem = (const float*)d_in[18]; p.w_out = (const float*)d_in[19]; p.g_ffn = (const float*)d_in[20]; p.w_peer_q = (const float*)d_in[21];
    p.peer_sub_keys = (const float*)d_in[22]; p.peer_u = (const float*)d_in[23]; p.peer_v = (const float*)d_in[24]; p.g_final = (const float*)d_in[25];
    p.out = (float*)d_out; p.ws = (unsigned char*)d_ws;
    static int grid_blocks = 0;
    if (!grid_blocks) {
        int dev = 0, cus = 0, per_cu = 0;
        (void)hipGetDevice(&dev);
        (void)hipDeviceGetAttribute(&cus, hipDeviceAttributeMultiprocessorCount, dev);
        (void)hipOccupancyMaxActiveBlocksPerMultiprocessor(&per_cu, fwd_megakernel, 256, 0);
        if (per_cu > 2) per_cu = 2;
        grid_blocks = cus * per_cu;
    }
    (void)hipMemsetAsync((unsigned char*)d_ws + OFF_BAR, 0, XCD_BAR_WORDS * 4, stream);
    void* args[] = {&p};
    hipError_t e = hipLaunchCooperativeKernel((void*)fwd_megakernel, dim3(grid_blocks), dim3(256), args, 0, stream);
    if (e != hipSuccess) fprintf(stderr, "cooperative launch failed: %s (grid %d)\n", hipGetErrorString(e), grid_blocks);
}
```

```cpp
#include <hip/hip_runtime.h>
#include <stdint.h>
#include <stdio.h>

typedef unsigned short bf16_t;
typedef short bf16x8 __attribute__((ext_vector_type(8)));
typedef __bf16 bf16x2v __attribute__((ext_vector_type(2)));
typedef float f32x4 __attribute__((ext_vector_type(4)));

constexpr int B_ = 16, S_ = 2048, D_ = 1024, NTOK = B_ * S_;
constexpr int MEML = 256, NMEM = B_ * MEML;
constexpr int INW = 6400;
constexpr int LW = 768;
constexpr int NEXP = 16384;
constexpr float EPS = 1e-6f;
constexpr float QSCALE = 0.08838834764831845f;

constexpr size_t OFF_WINT = 0;
constexpr size_t OFF_WMKVT = OFF_WINT + (size_t)INW * 1024 * 2;
constexpr size_t OFF_PATTNT = OFF_WMKVT + (size_t)1024 * 1024 * 2;
constexpr size_t OFF_PLRUT = OFF_PATTNT + (size_t)1024 * 768 * 2;
constexpr size_t OFF_PMEMT = OFF_PLRUT + (size_t)1024 * 768 * 2;
constexpr size_t OFF_WOUTT = OFF_PMEMT + (size_t)1024 * 512 * 2;
constexpr size_t OFF_WPQT = OFF_WOUTT + (size_t)1024 * 1024 * 2;
constexpr size_t OFF_LRUWT = OFF_WPQT + (size_t)2048 * 1024 * 2;
constexpr size_t OFF_SUBK = OFF_LRUWT + (size_t)6 * 512 * 128 * 2;
constexpr size_t OFF_UB = OFF_SUBK + (size_t)16 * 128 * 128 * 2;
constexpr size_t OFF_VB = OFF_UB + (size_t)NEXP * 1024;
constexpr size_t OFF_SU = OFF_VB + (size_t)NEXP * 1024;
constexpr size_t OFF_SV = OFF_SU + (size_t)NEXP * 4;
constexpr size_t OFF_RA = OFF_SV + (size_t)NEXP * 4;
constexpr size_t OFF_QA = OFF_RA;
constexpr size_t OFF_KA = OFF_QA + (size_t)NTOK * 768 * 2;
constexpr size_t OFF_VAT = OFF_KA + (size_t)NTOK * 256 * 2;
constexpr size_t OFF_XL = OFF_VAT + (size_t)NTOK * 256 * 2;
constexpr size_t OFF_GL = OFF_XL + (size_t)NTOK * 768 * 2;
constexpr size_t OFF_QM = OFF_GL + (size_t)NTOK * 768 * 2;
constexpr size_t OFF_GATES = OFF_QM + (size_t)NTOK * 512 * 2;
constexpr size_t OFF_BAR = OFF_GATES + (size_t)NTOK * 3072 * 2;
constexpr size_t OFF_END = OFF_BAR + 16384;
constexpr size_t OFF_MERGED = OFF_KA;
constexpr size_t OFF_QPEER = OFF_GATES;
constexpr size_t OFF_TOPL = OFF_QPEER + (size_t)NTOK * 2048 * 2;
constexpr size_t OFF_EIDX = OFF_TOPL + (size_t)NTOK * 256 * 4;
constexpr size_t OFF_EGATE = OFF_EIDX + (size_t)NTOK * 128 * 4;
static_assert(OFF_EGATE + (size_t)NTOK * 128 * 4 <= OFF_BAR, "overlay");
static_assert(OFF_MERGED + (size_t)NTOK * 1024 * 2 <= OFF_GL, "overlay2");
constexpr size_t DO_HBF = 0;
constexpr size_t DO_MEMBF = DO_HBF + (size_t)NTOK * 1024 * 2;
constexpr size_t DO_KM = DO_MEMBF + (size_t)NMEM * 1024 * 2;
constexpr size_t DO_VMT = DO_KM + (size_t)NMEM * 512 * 2;
constexpr size_t DO_ROPE = DO_VMT + (size_t)NMEM * 512 * 2;
static_assert(DO_ROPE + (size_t)NTOK * 32 * 4 <= (size_t)NTOK * 1024 * 4, "d_out scratch");

struct Params {
    const float *x, *mem; const int* positions;
    const float *g_mix, *g_mem, *w_in, *gate_b, *attn_sink, *conv_w, *conv_b, *lru_wr, *lru_br, *lru_wi, *lru_bi, *lru_lambda,
        *w_mem_kv, *p_attn, *p_lru, *p_mem, *w_out, *g_ffn, *w_peer_q, *peer_sub_keys, *peer_u, *peer_v, *g_final;
    float* out; unsigned char* ws;
};

__device__ __forceinline__ int tidx() { int t = threadIdx.x; asm volatile("" : "+v"(t)); return t; }
__device__ __forceinline__ float bf2f(bf16_t b) { return __uint_as_float(((unsigned)b) << 16); }
__device__ __forceinline__ float bflo(unsigned u) { return __uint_as_float(u << 16); }
__device__ __forceinline__ float bfhi(unsigned u) { return __uint_as_float(u & 0xffff0000u); }
typedef float f32x2v __attribute__((ext_vector_type(2)));
__device__ __forceinline__ unsigned pack_bf16(float lo, float hi) { const f32x2v f = {lo, hi}; return __builtin_bit_cast(unsigned, __builtin_convertvector(f, bf16x2v)); }
__device__ __forceinline__ bf16_t f2bf(float f) { return (bf16_t)(pack_bf16(f, 0.f) & 0xffffu); }
__device__ __forceinline__ f32x4 mfma16(bf16x8 a, bf16x8 b, f32x4 c) { return __builtin_amdgcn_mfma_f32_16x16x32_bf16(a, b, c, 0, 0, 0); }
__device__ __forceinline__ float sigmoidf_(float x) { return 1.0f / (1.0f + __expf(-x)); }
__device__ __forceinline__ float gelu_tanh(float x) { const float u = 1.5957691216057308f * (x + 0.044715f * x * x * x); return x / (1.0f + __expf(-u)); }
__device__ __forceinline__ float wave_sum(float v) {
#pragma unroll
    for (int o = 32; o >= 1; o >>= 1) v += __shfl_xor(v, o);
    return v;
}

__device__ void convT_tile(const float* __restrict__ src, bf16_t* __restrict__ dst, int K, int N, int tile, unsigned char* smem) {
    float* t = (float*)smem;
    const int tn = N / 64, tk = tile / tn, tnn = tile % tn, k0 = tk * 64, n0 = tnn * 64, tid = tidx();
    const int r = tid >> 4, c4 = (tid & 15) * 4;
#pragma unroll
    for (int i = 0; i < 4; ++i) {
        const int k = r + 16 * i;
        const float4 v = *(const float4*)(src + (size_t)(k0 + k) * N + n0 + c4);
        t[k * 65 + c4 + 0] = v.x; t[k * 65 + c4 + 1] = v.y; t[k * 65 + c4 + 2] = v.z; t[k * 65 + c4 + 3] = v.w;
    }
    __syncthreads();
    const int n = tid >> 2, kq = (tid & 3) * 16;
    unsigned w[8];
#pragma unroll
    for (int i = 0; i < 8; ++i) w[i] = pack_bf16(t[(kq + 2 * i) * 65 + n], t[(kq + 2 * i + 1) * 65 + n]);
    uint4* d = (uint4*)(dst + (size_t)(n0 + n) * K + k0 + kq);
    d[0] = make_uint4(w[0], w[1], w[2], w[3]); d[1] = make_uint4(w[4], w[5], w[6], w[7]);
    __syncthreads();
}


__device__ __forceinline__ void rms_row_bf16(const float* __restrict__ xr, const float* __restrict__ g, bf16_t* __restrict__ o, int lane) {
    float4 v[4]; float ss = 0.f;
#pragma unroll
    for (int i = 0; i < 4; ++i) { v[i] = *(const float4*)(xr + i * 256 + lane * 4); ss += v[i].x * v[i].x + v[i].y * v[i].y + v[i].z * v[i].z + v[i].w * v[i].w; }
    ss = wave_sum(ss);
    const float rs = rsqrtf(ss * (1.0f / 1024.0f) + EPS);
#pragma unroll
    for (int i = 0; i < 4; ++i) {
        const float4 gg = *(const float4*)(g + i * 256 + lane * 4);
        *(uint2*)(o + i * 256 + lane * 4) = make_uint2(pack_bf16(v[i].x * rs * gg.x, v[i].y * rs * gg.y), pack_bf16(v[i].z * rs * gg.z, v[i].w * rs * gg.w));
    }
}


__device__ __forceinline__ void conv_plain(const float* __restrict__ src, bf16_t* __restrict__ dst, size_t n8) {
    for (size_t i = (size_t)blockIdx.x * 256 + tidx(); i < n8; i += (size_t)gridDim.x * 256) {
        const float4 a = ((const float4*)src)[2 * i], b = ((const float4*)src)[2 * i + 1];
        ((uint4*)dst)[i] = make_uint4(pack_bf16(a.x, a.y), pack_bf16(a.z, a.w), pack_bf16(b.x, b.y), pack_bf16(b.z, b.w));
    }
}
__device__ __forceinline__ void rope_item(const int* __restrict__ pos, float* __restrict__ cs, int i) {
    const int t = i >> 4, f = i & 15;
    const float inv = powf(500000.0f, -(float)(2 * f) / 32.0f);
    const float ang = (float)pos[t] * inv;
    float s, c; sincosf(ang, &s, &c);
    cs[2 * i] = c; cs[2 * i + 1] = s;
}

__device__ __forceinline__ int swz(int row) { return (row & 3) | (((row >> 3) & 1) << 2); }

__device__ __forceinline__ void gemm_tile(const bf16_t* __restrict__ A, int lda, const bf16_t* __restrict__ Bt, int ldb, int K,
                                          f32x4 (&acc)[4][4], unsigned char* smem) {
    const int tid = tidx(), lane = tid & 63, wid = tid >> 6, wr = wid >> 1, wc = wid & 1, li = lane & 15, g = lane >> 4;
    const int srow = tid >> 3, skc = tid & 7;
    const int soff = srow * 128 + ((skc ^ swz(srow)) << 4);
    const bf16_t* ga = A + (size_t)srow * lda + skc * 8;
    const bf16_t* gb = Bt + (size_t)srow * ldb + skc * 8;
    uint4 ra[4], rb[4];
    int aoff[4], boff[4], asw[4], bsw[4];
#pragma unroll
    for (int m = 0; m < 4; ++m) { const int row = wr * 64 + m * 16 + li; aoff[m] = row * 128; asw[m] = swz(row); }
#pragma unroll
    for (int n = 0; n < 4; ++n) { const int row = wc * 64 + 32 * (n >> 1) + 8 * (li >> 2) + 4 * (n & 1) + (li & 3); boff[n] = 16384 + row * 128; bsw[n] = swz(row); }
    const int nk = K >> 6;
#pragma unroll
    for (int i = 0; i < 4; ++i) { ra[i] = *(const uint4*)(ga + (size_t)(32 * i) * lda); rb[i] = *(const uint4*)(gb + (size_t)(32 * i) * ldb); }
#pragma unroll
    for (int i = 0; i < 4; ++i) { *(uint4*)(smem + soff + i * 4096) = ra[i]; *(uint4*)(smem + 16384 + soff + i * 4096) = rb[i]; }
    __syncthreads();
    for (int kt = 0; kt < nk; ++kt) {
        const unsigned char* sb = smem + (kt & 1) * 32768;
        if (kt + 1 < nk) {
#pragma unroll
            for (int i = 0; i < 4; ++i) { ra[i] = *(const uint4*)(ga + (size_t)(32 * i) * lda + (kt + 1) * 64); rb[i] = *(const uint4*)(gb + (size_t)(32 * i) * ldb + (kt + 1) * 64); }
        }
#pragma unroll
        for (int ks = 0; ks < 2; ++ks) {
            bf16x8 af[4], bfr[4];
#pragma unroll
            for (int m = 0; m < 4; ++m) af[m] = *(const bf16x8*)(sb + aoff[m] + (((ks * 4 + g) ^ asw[m]) << 4));
#pragma unroll
            for (int n = 0; n < 4; ++n) bfr[n] = *(const bf16x8*)(sb + boff[n] + (((ks * 4 + g) ^ bsw[n]) << 4));
#pragma unroll
            for (int m = 0; m < 4; ++m)
#pragma unroll
                for (int n = 0; n < 4; ++n) acc[m][n] = mfma16(bfr[n], af[m], acc[m][n]);
        }
        if (kt + 1 < nk) {
            unsigned char* sw = smem + ((kt + 1) & 1) * 32768;
#pragma unroll
            for (int i = 0; i < 4; ++i) { *(uint4*)(sw + soff + i * 4096) = ra[i]; *(uint4*)(sw + 16384 + soff + i * 4096) = rb[i]; }
        }
        __syncthreads();
    }
}
__device__ __forceinline__ void acc_zero(f32x4 (&acc)[4][4]) {
#pragma unroll
    for (int m = 0; m < 4; ++m)
#pragma unroll
        for (int n = 0; n < 4; ++n) acc[m][n] = (f32x4){0.f, 0.f, 0.f, 0.f};
}
template <class F> __device__ __forceinline__ void epi_foreach(const f32x4 (&acc)[4][4], F&& f) {
    const int lane = tidx() & 63, wid = tidx() >> 6, wr = wid >> 1, wc = wid & 1, li = lane & 15, g = lane >> 4;
#pragma unroll
    for (int m = 0; m < 4; ++m)
#pragma unroll
        for (int pp = 0; pp < 2; ++pp) {
            float v[8];
#pragma unroll
            for (int r = 0; r < 4; ++r) { v[r] = acc[m][2 * pp][r]; v[4 + r] = acc[m][2 * pp + 1][r]; }
            f(wr * 64 + m * 16 + li, wc * 64 + 32 * pp + 8 * g, v, pp);
        }
}
__device__ __forceinline__ void store_bf16x8(bf16_t* p, const float (&v)[8]) {
    *(uint4*)p = make_uint4(pack_bf16(v[0], v[1]), pack_bf16(v[2], v[3]), pack_bf16(v[4], v[5]), pack_bf16(v[6], v[7]));
}
__device__ __forceinline__ void store_tile_T(const f32x4 (&acc)[4][4], bf16_t* __restrict__ dstT, int ldt, unsigned char* smem) {
    bf16_t* t = (bf16_t*)smem;
    epi_foreach(acc, [&](int r, int c, const float (&v)[8], int) {
#pragma unroll
        for (int e = 0; e < 8; ++e) t[(c + e) * 136 + r] = f2bf(v[e]);
    });
    __syncthreads();
#pragma unroll
    for (int i = 0; i < 8; ++i) {
        const int ch = tidx() + 256 * i, d = ch >> 4, tc = ch & 15;
        *(uint4*)(dstT + (size_t)d * ldt + tc * 8) = *(const uint4*)(smem + d * 272 + tc * 16);
    }
    __syncthreads();
}

__device__ void inproj_tile(const Params& p, int rt, int ct, unsigned char* smem) {
    unsigned char* ws = p.ws; unsigned char* dob = (unsigned char*)p.out;
    const bf16_t* hbf = (const bf16_t*)(dob + DO_HBF);
    const bf16_t* WinT = (const bf16_t*)(ws + OFF_WINT);
    f32x4 acc[4][4]; acc_zero(acc);
    gemm_tile(hbf + (size_t)rt * 128 * 1024, 1024, WinT + (size_t)ct * 128 * 1024, 1024, 1024, acc, smem);
    const int row0 = rt * 128;
    if (ct < 8) {
        const float* cs = (const float*)(dob + DO_ROPE);
        const bool isq = ct < 6;
        bf16_t* dst = isq ? (bf16_t*)(ws + OFF_QA) + ct * 128 : (bf16_t*)(ws + OFF_KA) + (ct - 6) * 128;
        const int ld = isq ? 768 : 256;
        const float sc = isq ? QSCALE : 1.0f;
        const int g = (tidx() & 63) >> 4;
        epi_foreach(acc, [&](int r, int c, float (&v)[8], int pp) {
            const int tok = row0 + r;
            if (pp == 0 && c < 32) {
                const float* csr = cs + (size_t)tok * 32 + (g & 1) * 16;
#pragma unroll
                for (int e = 0; e < 8; ++e) {
                    const float o = __shfl_xor(v[e], 32);
                    const float cc = csr[2 * e], ss = csr[2 * e + 1];
                    v[e] = (g < 2) ? (v[e] * cc - o * ss) : (v[e] * cc + o * ss);
                }
            }
#pragma unroll
            for (int e = 0; e < 8; ++e) v[e] *= sc;
            store_bf16x8(dst + (size_t)tok * ld + c, v);
        });
    } else if (ct < 10) {
        const int kvh = ct - 8, b = row0 / S_, s0 = row0 % S_;
        store_tile_T(acc, (bf16_t*)(ws + OFF_VAT) + (size_t)(b * 2 + kvh) * 128 * S_ + s0, S_, smem);
    } else if (ct < 16) {
        bf16_t* dst = (bf16_t*)(ws + OFF_XL) + (ct - 10) * 128;
        epi_foreach(acc, [&](int r, int c, float (&v)[8], int) { store_bf16x8(dst + (size_t)(row0 + r) * 768 + c, v); });
    } else if (ct < 22) {
        bf16_t* dst = (bf16_t*)(ws + OFF_GL) + (ct - 16) * 128;
        epi_foreach(acc, [&](int r, int c, float (&v)[8], int) {
#pragma unroll
            for (int e = 0; e < 8; ++e) v[e] = gelu_tanh(v[e]);
            store_bf16x8(dst + (size_t)(row0 + r) * 768 + c, v); });
    } else if (ct < 26) {
        bf16_t* dst = (bf16_t*)(ws + OFF_QM) + (ct - 22) * 128;
        epi_foreach(acc, [&](int r, int c, float (&v)[8], int) {
#pragma unroll
            for (int e = 0; e < 8; ++e) v[e] *= QSCALE;
            store_bf16x8(dst + (size_t)(row0 + r) * 512 + c, v); });
    } else {
        const int gc0 = (ct - 26) * 128;
        bf16_t* dst = (bf16_t*)(ws + OFF_GATES) + gc0;
        const float* gb = p.gate_b + gc0;
        epi_foreach(acc, [&](int r, int c, float (&v)[8], int) {
            const float4 b0 = *(const float4*)(gb + c), b1 = *(const float4*)(gb + c + 4);
            v[0] = sigmoidf_(v[0] + b0.x); v[1] = sigmoidf_(v[1] + b0.y); v[2] = sigmoidf_(v[2] + b0.z); v[3] = sigmoidf_(v[3] + b0.w);
            v[4] = sigmoidf_(v[4] + b1.x); v[5] = sigmoidf_(v[5] + b1.y); v[6] = sigmoidf_(v[6] + b1.z); v[7] = sigmoidf_(v[7] + b1.w);
            store_bf16x8(dst + (size_t)(row0 + r) * 3072 + c, v); });
    }
}

__device__ void memkv_tile(const Params& p, int rt, int ct, unsigned char* smem) {
    unsigned char* dob = (unsigned char*)p.out;
    f32x4 acc[4][4]; acc_zero(acc);
    gemm_tile((const bf16_t*)(dob + DO_MEMBF) + (size_t)rt * 128 * 1024, 1024, (const bf16_t*)(p.ws + OFF_WMKVT) + (size_t)ct * 128 * 1024, 1024, 1024, acc, smem);
    const int row0 = rt * 128;
    if (ct < 4) {
        bf16_t* dst = (bf16_t*)(dob + DO_KM) + ct * 128;
        epi_foreach(acc, [&](int r, int c, float (&v)[8], int) { store_bf16x8(dst + (size_t)(row0 + r) * 512 + c, v); });
    } else {
        const int h = ct - 4, b = row0 / MEML, m0 = row0 % MEML;
        store_tile_T(acc, (bf16_t*)(dob + DO_VMT) + (size_t)(b * 4 + h) * 128 * MEML + m0, MEML, smem);
    }
}


template <int NF, bool WIN>
__device__ __forceinline__ void attn_wave(const bf16_t* Q, int ldq, const bf16_t* __restrict__ Kb, int ldk, const bf16_t* __restrict__ Vt, int ldv,
                                          int q0, int kstart, int nkeys, float sink, bf16_t* O, int ldo) {
    const int lane = tidx() & 63, li = lane & 15, g = lane >> 4;
    bf16x8 qf[4];
#pragma unroll
    for (int ks = 0; ks < 4; ++ks) qf[ks] = *(const bf16x8*)(Q + (size_t)li * ldq + ks * 32 + g * 8);
    f32x4 s[NF];
#pragma unroll
    for (int t = 0; t < NF; ++t) {
        int key = kstart + 16 * t + li; key = key < 0 ? 0 : (key > nkeys - 1 ? nkeys - 1 : key);
        const bf16_t* kp = Kb + (size_t)key * ldk + g * 8;
        f32x4 a = {0.f, 0.f, 0.f, 0.f};
#pragma unroll
        for (int ks = 0; ks < 4; ++ks) a = mfma16(*(const bf16x8*)(kp + ks * 32), qf[ks], a);
        s[t] = a;
    }
    float mx = -1e30f;
#pragma unroll
    for (int t = 0; t < NF; ++t)
#pragma unroll
        for (int r = 0; r < 4; ++r) {
            if (WIN) {
                const int kp = kstart + 16 * t + 4 * g + r, d = kp - (q0 + li);
                const bool valid = kp >= 0 && kp < nkeys && d <= 128 && d >= -128;
                s[t][r] = valid ? s[t][r] : -1e30f;
            }
            mx = fmaxf(mx, s[t][r]);
        }
    mx = fmaxf(mx, __shfl_xor(mx, 16)); mx = fmaxf(mx, __shfl_xor(mx, 32));
    if (WIN) mx = fmaxf(mx, sink);
    float sum = 0.f;
#pragma unroll
    for (int t = 0; t < NF; ++t)
#pragma unroll
        for (int r = 0; r < 4; ++r) { const float pv = __expf(s[t][r] - mx); s[t][r] = pv; sum += pv; }
    sum += __shfl_xor(sum, 16); sum += __shfl_xor(sum, 32);
    if (WIN) sum += __expf(sink - mx);
    const float inv = 1.0f / sum;
    f32x4 o[8];
#pragma unroll
    for (int df = 0; df < 8; ++df) o[df] = (f32x4){0.f, 0.f, 0.f, 0.f};
#pragma unroll
    for (int kk = 0; kk < NF / 2; ++kk) {
        union { unsigned u[4]; bf16x8 v; } pb;
        pb.u[0] = pack_bf16(s[2 * kk][0], s[2 * kk][1]); pb.u[1] = pack_bf16(s[2 * kk][2], s[2 * kk][3]);
        pb.u[2] = pack_bf16(s[2 * kk + 1][0], s[2 * kk + 1][1]); pb.u[3] = pack_bf16(s[2 * kk + 1][2], s[2 * kk + 1][3]);
        int ka = kstart + 32 * kk + 4 * g, kb = ka + 16;
        ka = ka < 0 ? 0 : (ka > nkeys - 4 ? nkeys - 4 : ka); kb = kb < 0 ? 0 : (kb > nkeys - 4 ? nkeys - 4 : kb);
#pragma unroll
        for (int df = 0; df < 8; ++df) {
            const bf16_t* vp = Vt + (size_t)(df * 16 + li) * ldv;
            union { uint2 u[2]; bf16x8 v; } va;
            va.u[0] = *(const uint2*)(vp + ka); va.u[1] = *(const uint2*)(vp + kb);
            o[df] = mfma16(va.v, pb.v, o[df]);
        }
    }
#pragma unroll
    for (int df = 0; df < 8; ++df)
        *(uint2*)(O + (size_t)li * ldo + df * 16 + 4 * g) = make_uint2(pack_bf16(o[df][0] * inv, o[df][1] * inv), pack_bf16(o[df][2] * inv, o[df][3] * inv));
}
__device__ void attn_win_unit(const Params& p, int u) {
    const int wid = tidx() >> 6;
    const int qb = u % 32, head = (u / 32) % 6, b = u / 192, kvh = head / 3;
    const int q0 = qb * 64 + wid * 16;
    bf16_t* Q = (bf16_t*)(p.ws + OFF_QA) + (size_t)(b * S_ + q0) * 768 + head * 128;
    const bf16_t* Kb = (const bf16_t*)(p.ws + OFF_KA) + (size_t)(b * S_) * 256 + kvh * 128;
    const bf16_t* Vt = (const bf16_t*)(p.ws + OFF_VAT) + (size_t)(b * 2 + kvh) * 128 * S_;
    attn_wave<18, true>(Q, 768, Kb, 256, Vt, S_, q0, q0 - 128, S_, p.attn_sink[head], Q, 768);
}
__device__ void attn_mem_unit(const Params& p, int u) {
    const int wid = tidx() >> 6;
    const int qb = u % 32, head = (u / 32) % 4, b = u / 128;
    const int q0 = qb * 64 + wid * 16;
    unsigned char* dob = (unsigned char*)p.out;
    bf16_t* Q = (bf16_t*)(p.ws + OFF_QM) + (size_t)(b * S_ + q0) * 512 + head * 128;
    const bf16_t* Kb = (const bf16_t*)(dob + DO_KM) + (size_t)(b * MEML) * 512 + head * 128;
    const bf16_t* Vt = (const bf16_t*)(dob + DO_VMT) + (size_t)(b * 4 + head) * 128 * MEML;
    attn_wave<16, false>(Q, 512, Kb, 512, Vt, MEML, q0, 0, MEML, 0.f, Q, 512);
}


__device__ void lru_unit(const Params& p, int u, unsigned char* smem) {
    const int tid = tidx(), lane = tid & 63, wid = tid >> 6, li = lane & 15, g = lane >> 4;
    const int qt = u & 3, h = (u >> 2) % 6, b = u / 24;
    const int cbase = h * 128, cq0 = cbase + qt * 32;
    unsigned char* xcs = smem; unsigned char* wl = smem + 16384;
    float* pre = (float*)(smem + 32768); float* xcf = (float*)(smem + 49152);
    float* cA = (float*)(smem + 57344); float* cH = cA + 256; float* h0 = cH + 256;
    const bf16_t* Xl = (const bf16_t*)(p.ws + OFF_XL) + (size_t)(b * S_) * 768;
    bf16_t* Gl = (bf16_t*)(p.ws + OFF_GL) + (size_t)(b * S_) * 768;
    bf16_t* Hf = (bf16_t*)((unsigned char*)p.out + DO_HBF) + (size_t)(b * S_) * 768;
    const bf16_t* LruWt = (const bf16_t*)(p.ws + OFF_LRUWT);
    const int cp = tid & 63, tq = tid >> 6, cch = cbase + 2 * cp;
    float cw[4][2];
#pragma unroll
    for (int j = 0; j < 4; ++j) { cw[j][0] = p.conv_w[j * LW + cch]; cw[j][1] = p.conv_w[j * LW + cch + 1]; }
    const float cb0 = p.conv_b[cch], cb1 = p.conv_b[cch + 1];
    const int sc_c = tid & 31, sub = tid >> 5, sch = cq0 + sc_c;
    for (int dir = 0; dir < 2; ++dir) {
        __syncthreads();
#pragma unroll
        for (int i = 0; i < 4; ++i) {
            const int ch = tid + 256 * i, j = ch >> 4, kc = ch & 15;
            const int srcrow = h * 512 + ((j >> 5) * 2 + dir) * 128 + qt * 32 + (j & 31);
            *(uint4*)(wl + j * 256 + ((kc ^ (j & 15)) << 4)) = *(const uint4*)(LruWt + (size_t)srcrow * 128 + kc * 8);
        }
        const float br = p.lru_br[dir * LW + sch], bi = p.lru_bi[dir * LW + sch];
        const float lam = p.lru_lambda[dir * LW + sch];
        const float sp8 = -8.0f * log1pf(__expf(-lam));
        if (tid < 32) h0[tid] = 0.f;
        for (int ci = 0; ci < 32; ++ci) {
            const int chunk = dir ? 31 - ci : ci, s0 = chunk * 64;
            {
                float xa[19], xb[19];
#pragma unroll
                for (int i = 0; i < 19; ++i) {
                    const int s = s0 + 16 * tq + i - 2;
                    unsigned w = 0;
                    if (s >= 0 && s < S_) w = *(const unsigned*)(Xl + (size_t)s * 768 + cch);
                    xa[i] = bflo(w); xb[i] = bfhi(w);
                }
#pragma unroll
                for (int i = 0; i < 16; ++i) {
                    const int t = 16 * tq + i;
                    const float y0 = cb0 + cw[0][0] * xa[i] + cw[1][0] * xa[i + 1] + cw[2][0] * xa[i + 2] + cw[3][0] * xa[i + 3];
                    const float y1 = cb1 + cw[0][1] * xb[i] + cw[1][1] * xb[i + 1] + cw[2][1] * xb[i + 2] + cw[3][1] * xb[i + 3];
                    *(unsigned*)(xcs + t * 256 + (((cp >> 2) ^ (t & 15)) << 4) + (cp & 3) * 4) = pack_bf16(y0, y1);
                    if ((cp >> 4) == qt) { xcf[t * 32 + 2 * (cp & 15)] = y0; xcf[t * 32 + 2 * (cp & 15) + 1] = y1; }
                }
            }
            __syncthreads();
            {
                f32x4 a[4];
#pragma unroll
                for (int n = 0; n < 4; ++n) a[n] = (f32x4){0.f, 0.f, 0.f, 0.f};
#pragma unroll
                for (int ks = 0; ks < 4; ++ks) {
                    const int row = wid * 16 + li;
                    const bf16x8 xf = *(const bf16x8*)(xcs + row * 256 + (((ks * 4 + g) ^ (row & 15)) << 4));
#pragma unroll
                    for (int n = 0; n < 4; ++n) {
                        const int j = n * 16 + li;
                        const bf16x8 wf = *(const bf16x8*)(wl + j * 256 + (((ks * 4 + g) ^ (j & 15)) << 4));
                        a[n] = mfma16(xf, wf, a[n]);
                    }
                }
#pragma unroll
                for (int n = 0; n < 4; ++n)
#pragma unroll
                    for (int r = 0; r < 4; ++r) pre[(wid * 16 + 4 * g + r) * 64 + n * 16 + li] = a[n][r];
            }
            __syncthreads();
            float hl[8], ap[8];
            {
                float hh = 0.f, aa = 1.f;
#pragma unroll
                for (int k = 0; k < 8; ++k) {
                    const int pp = sub * 8 + k, t = dir ? 63 - pp : pp;
                    const float r = sigmoidf_(pre[t * 64 + sc_c] + br), ig = sigmoidf_(pre[t * 64 + 32 + sc_c] + bi);
                    const float la = sp8 * r;
                    const float a = __expf(la);
                    const float bx = sqrtf(-expm1f(2.0f * la)) * (ig * xcf[t * 32 + sc_c]);
                    hh = a * hh + bx; aa *= a; hl[k] = hh; ap[k] = aa;
                }
                cA[sub * 32 + sc_c] = aa; cH[sub * 32 + sc_c] = hh;
            }
            __syncthreads();
            {
                float hin = h0[(ci & 1) * 32 + sc_c];
                for (int s2 = 0; s2 < sub; ++s2) hin = cA[s2 * 32 + sc_c] * hin + cH[s2 * 32 + sc_c];
#pragma unroll
                for (int k = 0; k < 8; ++k) {
                    const int pp = sub * 8 + k, t = dir ? 63 - pp : pp;
                    const float hv = hl[k] + ap[k] * hin;
                    const size_t gi = (size_t)(s0 + t) * 768 + sch;
                    if (dir == 0) Hf[gi] = f2bf(hv);
                    else Gl[gi] = f2bf((bf2f(Hf[gi]) + hv) * bf2f(Gl[gi]));
                    if (k == 7 && sub == 7) h0[((ci + 1) & 1) * 32 + sc_c] = hv;
                }
            }
        }
    }
    __syncthreads();
}


__device__ void merge_tile(const Params& p, int rt, int ct, unsigned char* smem) {
    unsigned char* ws = p.ws;
    const int row0 = rt * 128, col0 = ct * 128;
    uint4 tot[4][2];
    const bf16_t* G = (const bf16_t*)(ws + OFF_GATES);
    const int lane = tidx() & 63, wid = tidx() >> 6, wr = wid >> 1, wc = wid & 1, li = lane & 15, g = lane >> 4;
#pragma unroll 1
    for (int br = 0; br < 3; ++br) {
        const bf16_t* Ab = (const bf16_t*)(ws + (br == 0 ? OFF_QA : (br == 1 ? OFF_GL : OFF_QM)));
        const bf16_t* Bb = (const bf16_t*)(ws + (br == 0 ? OFF_PATTNT : (br == 1 ? OFF_PLRUT : OFF_PMEMT)));
        const int Kb = br == 2 ? 512 : 768;
        f32x4 acc[4][4]; acc_zero(acc);
        gemm_tile(Ab + (size_t)row0 * Kb, Kb, Bb + (size_t)col0 * Kb, Kb, Kb, acc, smem);
#pragma unroll
        for (int m = 0; m < 4; ++m)
#pragma unroll
            for (int pp = 0; pp < 2; ++pp) {
                const int r = wr * 64 + m * 16 + li, c = wc * 64 + 32 * pp + 8 * g;
                const uint4 gv = *(const uint4*)(G + (size_t)(row0 + r) * 3072 + br * 1024 + col0 + c);
                float v[8];
                v[0] = bflo(gv.x) * acc[m][2 * pp][0]; v[1] = bfhi(gv.x) * acc[m][2 * pp][1];
                v[2] = bflo(gv.y) * acc[m][2 * pp][2]; v[3] = bfhi(gv.y) * acc[m][2 * pp][3];
                v[4] = bflo(gv.z) * acc[m][2 * pp + 1][0]; v[5] = bfhi(gv.z) * acc[m][2 * pp + 1][1];
                v[6] = bflo(gv.w) * acc[m][2 * pp + 1][2]; v[7] = bfhi(gv.w) * acc[m][2 * pp + 1][3];
                if (br > 0) {
                    const uint4 t = tot[m][pp];
                    v[0] += bflo(t.x); v[1] += bfhi(t.x); v[2] += bflo(t.y); v[3] += bfhi(t.y);
                    v[4] += bflo(t.z); v[5] += bfhi(t.z); v[6] += bflo(t.w); v[7] += bfhi(t.w);
                }
                tot[m][pp] = make_uint4(pack_bf16(v[0], v[1]), pack_bf16(v[2], v[3]), pack_bf16(v[4], v[5]), pack_bf16(v[6], v[7]));
            }
    }
    bf16_t* dst = (bf16_t*)(ws + OFF_MERGED) + col0;
#pragma unroll
    for (int m = 0; m < 4; ++m)
#pragma unroll
        for (int pp = 0; pp < 2; ++pp) {
            const int r = wr * 64 + m * 16 + li, c = wc * 64 + 32 * pp + 8 * g;
            *(uint4*)(dst + (size_t)(row0 + r) * 1024 + c) = tot[m][pp];
        }
}
__device__ void outproj_tile(const Params& p, int rt, int ct, unsigned char* smem) {
    const int row0 = rt * 128, col0 = ct * 128;
    f32x4 acc[4][4]; acc_zero(acc);
    gemm_tile((const bf16_t*)(p.ws + OFF_MERGED) + (size_t)row0 * 1024, 1024, (const bf16_t*)(p.ws + OFF_WOUTT) + (size_t)col0 * 1024, 1024, 1024, acc, smem);
    epi_foreach(acc, [&](int r, int c, float (&v)[8], int) {
        const size_t o = (size_t)(row0 + r) * 1024 + col0 + c;
        const float4 x0 = *(const float4*)(p.x + o), x1 = *(const float4*)(p.x + o + 4);
        *(float4*)(p.out + o) = make_float4(x0.x + v[0], x0.y + v[1], x0.z + v[2], x0.w + v[3]);
        *(float4*)(p.out + o + 4) = make_float4(x1.x + v[4], x1.y + v[5], x1.z + v[6], x1.w + v[7]);
    });
}

__device__ void peerq_tile(const Params& p, int rt, int ct, unsigned char* smem) {
    const int row0 = rt * 128, col0 = ct * 128;
    f32x4 acc[4][4]; acc_zero(acc);
    gemm_tile((const bf16_t*)(p.ws + OFF_MERGED) + (size_t)row0 * 1024, 1024, (const bf16_t*)(p.ws + OFF_WPQT) + (size_t)col0 * 1024, 1024, 1024, acc, smem);
    bf16_t* dst = (bf16_t*)(p.ws + OFF_QPEER) + col0;
    epi_foreach(acc, [&](int r, int c, float (&v)[8], int) { store_bf16x8(dst + (size_t)(row0 + r) * 2048 + c, v); });
}

__device__ __forceinline__ int sortable(float v) { int k = __float_as_int(v); return k ^ ((k >> 31) & 0x7fffffff); }
__device__ __forceinline__ float unsortable(int k) { return __int_as_float(k ^ ((k >> 31) & 0x7fffffff)); }
__device__ __forceinline__ void insert16(int (&lst)[16], int x) {
#pragma unroll
    for (int k = 0; k < 16; ++k) { const int hi = max(lst[k], x); x = min(lst[k], x); lst[k] = hi; }
}
__device__ void scores_tile(const Params& p, int rt, int pq, unsigned char* smem) {
    const int row0 = rt * 128;
    f32x4 acc[4][4]; acc_zero(acc);
    gemm_tile((const bf16_t*)(p.ws + OFF_QPEER) + (size_t)row0 * 2048 + pq * 128, 2048, (const bf16_t*)(p.ws + OFF_SUBK) + (size_t)pq * 128 * 128, 128, 128, acc, smem);
    float* sc = (float*)smem;
    epi_foreach(acc, [&](int r, int c, float (&v)[8], int) {
        *(float4*)(sc + r * 132 + c) = make_float4(v[0], v[1], v[2], v[3]);
        *(float4*)(sc + r * 132 + c + 4) = make_float4(v[4], v[5], v[6], v[7]); });
    __syncthreads();
    if (tidx() < 128) {
        const int r = tidx();
        int lst[16];
#pragma unroll
        for (int k = 0; k < 16; ++k) lst[k] = (int)0x80000000;
#pragma unroll 2
        for (int j4 = 0; j4 < 32; ++j4) {
            const float4 v = *(const float4*)(sc + r * 132 + j4 * 4);
            insert16(lst, (sortable(v.x) & ~127) | (j4 * 4 + 0));
            insert16(lst, (sortable(v.y) & ~127) | (j4 * 4 + 1));
            insert16(lst, (sortable(v.z) & ~127) | (j4 * 4 + 2));
            insert16(lst, (sortable(v.w) & ~127) | (j4 * 4 + 3));
        }
        int4* dst = (int4*)((int*)(p.ws + OFF_TOPL) + ((size_t)(row0 + r) * 16 + pq) * 16);
        dst[0] = make_int4(lst[0], lst[1], lst[2], lst[3]); dst[1] = make_int4(lst[4], lst[5], lst[6], lst[7]);
        dst[2] = make_int4(lst[8], lst[9], lst[10], lst[11]); dst[3] = make_int4(lst[12], lst[13], lst[14], lst[15]);
    }
    __syncthreads();
}

__device__ void combine_item(const Params& p, int item) {
    const int tok = item >> 3, hd = item & 7;
    const int* l0 = (const int*)(p.ws + OFF_TOPL) + ((size_t)tok * 16 + hd * 2) * 16;
    const int* l1 = l0 + 16;
    int k0[16], k1[16];
#pragma unroll
    for (int i = 0; i < 4; ++i) {
        const int4 a = ((const int4*)l0)[i], b = ((const int4*)l1)[i];
        k0[4 * i] = a.x; k0[4 * i + 1] = a.y; k0[4 * i + 2] = a.z; k0[4 * i + 3] = a.w;
        k1[4 * i] = b.x; k1[4 * i + 1] = b.y; k1[4 * i + 2] = b.z; k1[4 * i + 3] = b.w;
    }
    float v0[16], v1[16];
#pragma unroll
    for (int i = 0; i < 16; ++i) { v0[i] = unsortable(k0[i] & ~127); v1[i] = unsortable(k1[i] & ~127); }
    int lst[16];
#pragma unroll
    for (int k = 0; k < 16; ++k) lst[k] = (int)0x80000000;
#pragma unroll
    for (int a = 0; a < 16; ++a)
#pragma unroll
        for (int b = 0; b < 16; ++b)
            if ((a + 1) * (b + 1) <= 16) insert16(lst, (sortable(v0[a] + v1[b]) & ~255) | (a * 16 + b));
    float val[16], sum = 0.f;
    const float mx = unsortable(lst[0] & ~255);
#pragma unroll
    for (int k = 0; k < 16; ++k) { val[k] = __expf(unsortable(lst[k] & ~255) - mx); sum += val[k]; }
    const float inv = 1.0f / sum;
    int* ei = (int*)(p.ws + OFF_EIDX) + (size_t)tok * 128 + hd * 16;
    float* eg = (float*)(p.ws + OFF_EGATE) + (size_t)tok * 128 + hd * 16;
#pragma unroll
    for (int k = 0; k < 16; ++k) {
        const int code = lst[k] & 255, a = code >> 4, b = code & 15;
        ei[k] = (l0[a] & 127) * 128 + (l1[b] & 127);
        eg[k] = val[k] * inv;
    }
}

__device__ __forceinline__ void conv_row_fp8(const float* __restrict__ src, unsigned char* __restrict__ dst, float* __restrict__ scale, int row, int lane) {
    const float4* s = (const float4*)(src + (size_t)row * 1024 + lane * 16);
    float4 v[4]; float am = 0.f;
#pragma unroll
    for (int i = 0; i < 4; ++i) { v[i] = s[i]; am = fmaxf(am, fmaxf(fmaxf(fabsf(v[i].x), fabsf(v[i].y)), fmaxf(fabsf(v[i].z), fabsf(v[i].w)))); }
#pragma unroll
    for (int o = 32; o >= 1; o >>= 1) am = fmaxf(am, __shfl_xor(am, o));
    const float sc = am > 0.f ? am * (1.0f / 224.0f) : 1.0f, inv = 1.0f / sc;
    unsigned w[4];
#pragma unroll
    for (int i = 0; i < 4; ++i) {
        int t = __builtin_amdgcn_cvt_pk_fp8_f32(v[i].x * inv, v[i].y * inv, 0, false);
        t = __builtin_amdgcn_cvt_pk_fp8_f32(v[i].z * inv, v[i].w * inv, t, true);
        w[i] = (unsigned)t;
    }
    *(uint4*)(dst + (size_t)row * 1024 + lane * 16) = make_uint4(w[0], w[1], w[2], w[3]);
    if (lane == 0) scale[row] = sc;
}
__device__ __forceinline__ void load8rows(uint4 (&R)[8], const unsigned char* __restrict__ tab, int es, int l0, int lane) {
#pragma unroll
    for (int j = 0; j < 8; ++j) {
        const int id = __builtin_amdgcn_readlane(es, l0 + j);
        R[j] = *(const uint4*)(tab + (size_t)id * 1024 + lane * 16);
    }
}
__device__ __forceinline__ float dot16q(const uint4& r, const float (&h)[16]) {
    const unsigned q[4] = {r.x, r.y, r.z, r.w};
    float d0 = 0.f, d1 = 0.f;
#pragma unroll
    for (int i = 0; i < 4; ++i) {
        const f32x2v a = __builtin_amdgcn_cvt_pk_f32_fp8((int)q[i], false), b = __builtin_amdgcn_cvt_pk_f32_fp8((int)q[i], true);
        d0 += a.x * h[4 * i]; d1 += a.y * h[4 * i + 1]; d0 += b.x * h[4 * i + 2]; d1 += b.y * h[4 * i + 3];
    }
    return d0 + d1;
}
__device__ __forceinline__ float dots8(const uint4 (&R)[8], const float (&h)[16], int lane) {
    float pd[8];
#pragma unroll
    for (int j = 0; j < 8; ++j) pd[j] = dot16q(R[j], h);
    const bool b5 = (lane & 32) != 0, b4 = (lane & 16) != 0, b3 = (lane & 8) != 0;
    float a[4];
#pragma unroll
    for (int j = 0; j < 4; ++j) { const float keep = b5 ? pd[4 + j] : pd[j], send = b5 ? pd[j] : pd[4 + j]; a[j] = keep + __shfl_xor(send, 32); }
    float c[2];
#pragma unroll
    for (int j = 0; j < 2; ++j) { const float keep = b4 ? a[2 + j] : a[j], send = b4 ? a[j] : a[2 + j]; c[j] = keep + __shfl_xor(send, 16); }
    float kk;
    { const float keep = b3 ? c[1] : c[0], send = b3 ? c[0] : c[1]; kk = keep + __shfl_xor(send, 8); }
    kk += __shfl_xor(kk, 4); kk += __shfl_xor(kk, 2); kk += __shfl_xor(kk, 1);
    return kk;
}
__device__ __forceinline__ void axpy8(float (&o)[16], const uint4 (&R)[8], int wsr, int bb) {
#pragma unroll
    for (int j = 0; j < 8; ++j) {
        const float c = __int_as_float(__builtin_amdgcn_readlane(wsr, 8 * j + bb));
        const unsigned q[4] = {R[j].x, R[j].y, R[j].z, R[j].w};
#pragma unroll
        for (int i = 0; i < 4; ++i) {
            const f32x2v a = __builtin_amdgcn_cvt_pk_f32_fp8((int)q[i], false), b = __builtin_amdgcn_cvt_pk_f32_fp8((int)q[i], true);
            o[4 * i] += c * a.x; o[4 * i + 1] += c * a.y; o[4 * i + 2] += c * b.x; o[4 * i + 3] += c * b.y;
        }
    }
}
__device__ void gather_token(const Params& p, int tok, int lane) {
    const bf16_t* h2 = (const bf16_t*)(p.ws + OFF_MERGED) + (size_t)tok * 1024 + lane * 16;
    const unsigned char* Uq = p.ws + OFF_UB; const unsigned char* Vq = p.ws + OFF_VB;
    const float* SU = (const float*)(p.ws + OFF_SU); const float* SV = (const float*)(p.ws + OFF_SV);
    const int* ei = (const int*)(p.ws + OFF_EIDX) + (size_t)tok * 128;
    const float* eg = (const float*)(p.ws + OFF_EGATE) + (size_t)tok * 128;
    float h[16];
    {
        const uint4 ha = *(const uint4*)h2, hb = *(const uint4*)(h2 + 8);
        const unsigned hq[8] = {ha.x, ha.y, ha.z, ha.w, hb.x, hb.y, hb.z, hb.w};
#pragma unroll
        for (int e = 0; e < 8; ++e) { h[2 * e] = bflo(hq[e]); h[2 * e + 1] = bfhi(hq[e]); }
    }
    const int pe = 8 * (lane & 7) + (lane >> 3);
    int es[2], wsr[2] = {0, 0}; float su[2], gv[2];
#pragma unroll
    for (int k = 0; k < 2; ++k) {
        es[k] = ei[64 * k + lane];
        const int e = ei[64 * k + pe];
        su[k] = SU[e]; gv[k] = eg[64 * k + pe] * SV[e];
    }
    uint4 R0[8], R1[8];
#pragma unroll
    for (int k = 0; k < 2; ++k) {
        load8rows(R0, Uq, es[k], 0, lane);
        for (int bb = 0; bb < 8; bb += 2) {
            load8rows(R1, Uq, es[k], 8 * bb + 8, lane);
            { const float w = gelu_tanh(dots8(R0, h, lane) * su[k]) * gv[k]; if ((lane & 7) == bb) wsr[k] = __float_as_int(w); }
            if (bb + 2 < 8) load8rows(R0, Uq, es[k], 8 * bb + 16, lane);
            { const float w = gelu_tanh(dots8(R1, h, lane) * su[k]) * gv[k]; if ((lane & 7) == bb + 1) wsr[k] = __float_as_int(w); }
        }
    }
    float o[16];
#pragma unroll
    for (int e = 0; e < 16; ++e) o[e] = 0.f;
#pragma unroll
    for (int k = 0; k < 2; ++k) {
        load8rows(R0, Vq, es[k], 0, lane);
        for (int bb = 0; bb < 8; bb += 2) {
            load8rows(R1, Vq, es[k], 8 * bb + 8, lane);
            axpy8(o, R0, wsr[k], bb);
            if (bb + 2 < 8) load8rows(R0, Vq, es[k], 8 * bb + 16, lane);
            axpy8(o, R1, wsr[k], bb + 1);
        }
    }
    float* xr = p.out + (size_t)tok * 1024 + lane * 16;
    float4 x[4]; float ss = 0.f;
#pragma unroll
    for (int i = 0; i < 4; ++i) {
        x[i] = *(const float4*)(xr + 4 * i);
        x[i].x += o[4 * i]; x[i].y += o[4 * i + 1]; x[i].z += o[4 * i + 2]; x[i].w += o[4 * i + 3];
        ss += x[i].x * x[i].x + x[i].y * x[i].y + x[i].z * x[i].z + x[i].w * x[i].w;
    }
    ss = wave_sum(ss);
    const float rs = rsqrtf(ss * (1.0f / 1024.0f) + EPS);
    const float* gf = p.g_final + lane * 16;
#pragma unroll
    for (int i = 0; i < 4; ++i) {
        const float4 gg = *(const float4*)(gf + 4 * i);
        *(float4*)(xr + 4 * i) = make_float4(x[i].x * rs * gg.x, x[i].y * rs * gg.y, x[i].z * rs * gg.z, x[i].w * rs * gg.w);
    }
}

#define XB_TMO      128
#define XB_XCNT(j)  (256  + 64 * (j))
#define XB_XSUB(j)  (1280 + 64 * (j))
#define XB_XGEN(j)  (2304 + 64 * (j))
#define XB_TOP      3328
#define XB_TOPGEN   3392
#define XCD_BAR_WORDS 3456
#define XB_SPIN_CAP (1u << 22)
#define LAS __attribute__((address_space(3)))
__device__ __forceinline__ unsigned xb_ld(unsigned* p)              { return __hip_atomic_load(p, __ATOMIC_RELAXED, __HIP_MEMORY_SCOPE_AGENT); }
__device__ __forceinline__ unsigned xb_add(unsigned* p, unsigned v) { return __hip_atomic_fetch_add(p, v, __ATOMIC_RELAXED, __HIP_MEMORY_SCOPE_AGENT); }
__device__ __forceinline__ unsigned xb_xcc_id() { return (unsigned)__builtin_amdgcn_s_getreg((3 << 11) | 20) & 0xFu; }
#define XB_SPIN(cond, bar) do { unsigned _sp = 0; while (cond) { __builtin_amdgcn_s_sleep(1); \
    if ((++_sp & 255u) == 0u) { if (xb_ld(&(bar)[XB_TMO])) break; if (_sp > XB_SPIN_CAP) { atomicAdd(&(bar)[XB_TMO], 1u); break; } } } } while (0)
struct XcdBarrier { unsigned* bar; unsigned x; volatile LAS unsigned* st; };
__device__ __forceinline__ XcdBarrier xcd_barrier_post(unsigned* bar, volatile LAS unsigned* st) {
    XcdBarrier b; b.bar = bar; b.x = xb_xcc_id(); b.st = st;
    if (threadIdx.x == 0) (void)xb_add(&bar[XB_XCNT(b.x)], 1u);
    return b;
}
__device__ __forceinline__ void xcd_barrier_complete(unsigned* bar, unsigned x, unsigned& nloc, unsigned& nx) {
    const unsigned G = gridDim.x;
    unsigned sum, cnt, mine, sp = 0u;
    for (;;) {
        sum = 0u; cnt = 0u; mine = 0u;
#pragma unroll
        for (unsigned j = 0; j < 16; ++j) { const unsigned c = xb_ld(&bar[XB_XCNT(j)]); sum += c; cnt += (c > 0u) ? 1u : 0u; mine = (j == x) ? c : mine; }
        if (sum == G) break;
        __builtin_amdgcn_s_sleep(1);
        if ((++sp & 255u) == 0u) { if (xb_ld(&bar[XB_TMO])) break; if (sp > XB_SPIN_CAP) { atomicAdd(&bar[XB_TMO], 1u); break; } }
    }
    nloc = mine > 0u ? mine : 1u; nx = cnt > 0u ? cnt : 1u;
}
__device__ __forceinline__ void xcd_barrier(const XcdBarrier& b) {
    asm volatile("s_waitcnt vmcnt(0)" ::: "memory");
    __syncthreads();
    if (threadIdx.x == 0) {
        unsigned* bar = b.bar;
        __builtin_amdgcn_s_waitcnt(0);
        unsigned nloc = b.st[0], nx = b.st[1];
        if (nloc == 0u) { xcd_barrier_complete(bar, b.x, nloc, nx); b.st[0] = nloc; b.st[1] = nx; }
        const unsigned old = xb_add(&bar[XB_XSUB(b.x)], 1u);
        const unsigned gen = old / nloc;
        if (old + 1u == (gen + 1u) * nloc) {
            __builtin_amdgcn_fence(__ATOMIC_RELEASE, "agent");
            asm volatile("s_waitcnt vmcnt(0)" ::: "memory");
            const unsigned og = xb_add(&bar[XB_TOP], 1u);
            const unsigned tg = og / nx;
            if (og + 1u == (tg + 1u) * nx) xb_add(&bar[XB_TOPGEN], 1u);
            else XB_SPIN(xb_ld(&bar[XB_TOPGEN]) == tg, bar);
            __builtin_amdgcn_fence(__ATOMIC_ACQUIRE, "agent");
            xb_add(&bar[XB_XGEN(b.x)], 1u);
            asm volatile("s_waitcnt vmcnt(0)" ::: "memory");
        } else {
            XB_SPIN(xb_ld(&bar[XB_XGEN(b.x)]) == gen, bar);
            __builtin_amdgcn_fence(__ATOMIC_ACQUIRE, "agent");
            asm volatile("s_waitcnt vmcnt(0)" ::: "memory");
        }
    }
    __syncthreads();
}

#ifndef PROBE_PHASE
#define PROBE_PHASE -1
#endif
#define PH_BEGIN(k) if (PROBE_PHASE == (k)) probe_t0 = __builtin_amdgcn_s_memrealtime();
#define PH_END(k)   if (PROBE_PHASE == (k)) probe_dt = __builtin_amdgcn_s_memrealtime() - probe_t0;
constexpr int SMEM_BYTES = 128 * 132 * 4;

__global__ void __launch_bounds__(256, 2) fwd_megakernel(Params p) {
    __shared__ __attribute__((aligned(16))) unsigned char smem[SMEM_BYTES + 16];
    if (threadIdx.x == 0) *(uint4*)(smem + SMEM_BYTES) = make_uint4(0u, 0u, 0u, 0u);
    __syncthreads();
    const XcdBarrier xb = xcd_barrier_post((unsigned*)(p.ws + OFF_BAR), (volatile LAS unsigned*)(smem + SMEM_BYTES));
    const int bid = blockIdx.x, nb = gridDim.x, tid = tidx(), lane = tid & 63, wid = tid >> 6;
    unsigned char* ws = p.ws; unsigned char* dob = (unsigned char*)p.out;
    unsigned long long probe_t0 = 0, probe_dt = 0;
    PH_BEGIN(0)
    {
        for (int u = bid; u < 3232; u += nb) {
            if (u < 1600) convT_tile(p.w_in, (bf16_t*)(ws + OFF_WINT), 1024, INW, u, smem);
            else if (u < 1856) convT_tile(p.w_mem_kv, (bf16_t*)(ws + OFF_WMKVT), 1024, 1024, u - 1600, smem);
            else if (u < 2048) convT_tile(p.p_attn, (bf16_t*)(ws + OFF_PATTNT), 768, 1024, u - 1856, smem);
            else if (u < 2240) convT_tile(p.p_lru, (bf16_t*)(ws + OFF_PLRUT), 768, 1024, u - 2048, smem);
            else if (u < 2368) convT_tile(p.p_mem, (bf16_t*)(ws + OFF_PMEMT), 512, 1024, u - 2240, smem);
            else if (u < 2624) convT_tile(p.w_out, (bf16_t*)(ws + OFF_WOUTT), 1024, 1024, u - 2368, smem);
            else if (u < 3136) convT_tile(p.w_peer_q, (bf16_t*)(ws + OFF_WPQT), 1024, 2048, u - 2624, smem);
            else {
                const int v = u - 3136, mat = v >> 2, tile = v & 3, gsel = mat / 6, h = mat % 6, dir = gsel & 1;
                const float* src = (gsel < 2 ? p.lru_wr : p.lru_wi) + (size_t)(dir * 6 + h) * 128 * 128;
                convT_tile(src, (bf16_t*)(ws + OFF_LRUWT) + (size_t)(h * 512 + gsel * 128) * 128, 128, 128, tile, smem);
            }
        }
        conv_plain(p.peer_sub_keys, (bf16_t*)(ws + OFF_SUBK), (size_t)16 * 128 * 128 / 8);
        for (int r = bid * 4 + wid; r < 2 * NEXP; r += nb * 4) {
            if (r < NEXP) conv_row_fp8(p.peer_u, ws + OFF_UB, (float*)(ws + OFF_SU), r, lane);
            else conv_row_fp8(p.peer_v, ws + OFF_VB, (float*)(ws + OFF_SV), r - NEXP, lane);
        }
        for (int r = bid * 4 + wid; r < NTOK; r += nb * 4) rms_row_bf16(p.x + (size_t)r * 1024, p.g_mix, (bf16_t*)(dob + DO_HBF) + (size_t)r * 1024, lane);
        for (int r = bid * 4 + wid; r < NMEM; r += nb * 4) rms_row_bf16(p.mem + (size_t)r * 1024, p.g_mem, (bf16_t*)(dob + DO_MEMBF) + (size_t)r * 1024, lane);
        for (int i = bid * 256 + tid; i < NTOK * 16; i += nb * 256) rope_item(p.positions, (float*)(dob + DO_ROPE), i);
    }
    xcd_barrier(xb);
    PH_END(0) PH_BEGIN(1)
    for (int u = bid; u < 256 * 50 + 256; u += nb) {
        if (u < 256 * 50) inproj_tile(p, u / 50, u % 50, smem);
        else memkv_tile(p, (u - 256 * 50) / 8, (u - 256 * 50) % 8, smem);
    }
    xcd_barrier(xb);
    PH_END(1) PH_BEGIN(2)
    for (int u = bid; u < 384 + 3072 + 2048; u += nb) {
        if (u < 384) lru_unit(p, u, smem);
        else if (u < 384 + 3072) attn_win_unit(p, u - 384);
        else attn_mem_unit(p, u - 384 - 3072);
    }
    xcd_barrier(xb);
    PH_END(2) PH_BEGIN(3)
    for (int u = bid; u < 256 * 8; u += nb) merge_tile(p, u / 8, u % 8, smem);
    xcd_barrier(xb);
    PH_END(3) PH_BEGIN(4)
    for (int u = bid; u < 256 * 8; u += nb) outproj_tile(p, u / 8, u % 8, smem);
    xcd_barrier(xb);
    PH_END(4) PH_BEGIN(5)
    for (int r = bid * 4 + wid; r < NTOK; r += nb * 4) rms_row_bf16(p.out + (size_t)r * 1024, p.g_ffn, (bf16_t*)(ws + OFF_MERGED) + (size_t)r * 1024, lane);
    xcd_barrier(xb);
    PH_END(5) PH_BEGIN(6)
    for (int u = bid; u < 256 * 16; u += nb) peerq_tile(p, u / 16, u % 16, smem);
    xcd_barrier(xb);
    PH_END(6) PH_BEGIN(7)
    for (int u = bid; u < 256 * 16; u += nb) scores_tile(p, u / 16, u % 16, smem);
    xcd_barrier(xb);
    PH_END(7) PH_BEGIN(8)
    for (int i = bid * 256 + tid; i < NTOK * 8; i += nb * 256) combine_item(p, i);
    xcd_barrier(xb);
    PH_END(8) PH_BEGIN(9)
    for (int t = bid * 4 + wid; t < NTOK; t += nb * 4) gather_token(p, t, lane);
    PH_END(9)
    if (PROBE_PHASE >= 0) { __syncthreads(); const unsigned long long t1 = __builtin_amdgcn_s_memrealtime(); while (__builtin_amdgcn_s_memrealtime() - t1 < probe_dt) __builtin_amdgcn_s_sleep(8); }
}

extern "C" void kernel_launch(void* const* d_in, const int* in_sizes, int n_in, void* d_out, int out_size, void* d_ws, size_t ws_size, hipStream_t stream) {
    if (ws_size < OFF_END) { fprintf(stderr, "workspace too small: %zu < %zu\n", ws_size, (size_t)OFF_END); return; }
    Params p{};
    p.x = (const float*)d_in[0]; p.mem = (const float*)d_in[1]; p.positions = (const int*)d_in[2];
    p.g_mix = (const float*)d_in[3]; p.g_mem = (const float*)d_in[4]; p.w_in = (const float*)d_in[5]; p.gate_b = (const float*)d_in[6];
    p.attn_sink = (const float*)d_in[7]; p.conv_w = (const float*)d_in[8]; p.conv_b = (const float*)d_in[9];
    p.lru_wr = (const float*)d_in[10]; p.lru_br = (const float*)d_in[11]; p.lru_wi = (const float*)d_in[12]; p.lru_bi = (const float*)d_in[13];
    p.lru_lambda = (const float*)d_in[14]; p.w_mem_kv = (const float*)d_in[15]; p.p_attn = (const float*)d_in[16]; p.p_lru = (const float*)d_in[17];
    p.p_mem = (const float*)d_in[18]; p.w_out = (const float*)d_in[19]; p.g_ffn = (const float*)d_in[20]; p.w_peer_q = (const float*)d_in[21];
    p.peer_sub_keys = (const float*)d_in[22]; p.peer_u = (const float*)d_in[23]; p.peer_v = (const float*)d_in[24]; p.g_final = (const float*)d_in[25];
    p.out = (float*)d_out; p.ws = (unsigned char*)d_ws;
    static int grid_blocks = 0;
    if (!grid_blocks) {
        int dev = 0, cus = 0, per_cu = 0;
        (void)hipGetDevice(&dev);
        (void)hipDeviceGetAttribute(&cus, hipDeviceAttributeMultiprocessorCount, dev);
        (void)hipOccupancyMaxActiveBlocksPerMultiprocessor(&per_cu, fwd_megakernel, 256, 0);
        if (per_cu > 2) per_cu = 2;
        grid_blocks = cus * per_cu;
    }
    (void)hipMemsetAsync((unsigned char*)d_ws + OFF_BAR, 0, XCD_BAR_WORDS * 4, stream);
    void* args[] = {&p};
    hipError_t e = hipLaunchCooperativeKernel((void*)fwd_megakernel, dim3(grid_blocks), dim3(256), args, 0, stream);
    if (e != hipSuccess) fprintf(stderr, "cooperative launch failed: %s (grid %d)\n", hipGetErrorString(e), grid_blocks);
}
```

```cpp
#include <hip/hip_runtime.h>
#include <stdint.h>
#include <stdio.h>

typedef unsigned short bf16_t;
typedef short bf16x8 __attribute__((ext_vector_type(8)));
typedef __bf16 bf16x2v __attribute__((ext_vector_type(2)));
typedef float f32x4 __attribute__((ext_vector_type(4)));

constexpr int B_ = 16, S_ = 2048, D_ = 1024, NTOK = B_ * S_;
constexpr int MEML = 256, NMEM = B_ * MEML;
constexpr int INW = 6400;
constexpr int LW = 768;
constexpr int NEXP = 16384;
constexpr float EPS = 1e-6f;
constexpr float QSCALE = 0.08838834764831845f;

constexpr size_t OFF_WINT = 0;
constexpr size_t OFF_WMKVT = OFF_WINT + (size_t)INW * 1024 * 2;
constexpr size_t OFF_PATTNT = OFF_WMKVT + (size_t)1024 * 1024 * 2;
constexpr size_t OFF_PLRUT = OFF_PATTNT + (size_t)1024 * 768 * 2;
constexpr size_t OFF_PMEMT = OFF_PLRUT + (size_t)1024 * 768 * 2;
constexpr size_t OFF_WOUTT = OFF_PMEMT + (size_t)1024 * 512 * 2;
constexpr size_t OFF_WPQT = OFF_WOUTT + (size_t)1024 * 1024 * 2;
constexpr size_t OFF_LRUWT = OFF_WPQT + (size_t)2048 * 1024 * 2;
constexpr size_t OFF_SUBK = OFF_LRUWT + (size_t)6 * 512 * 128 * 2;
constexpr size_t OFF_UB = OFF_SUBK + (size_t)16 * 128 * 128 * 2;
constexpr size_t OFF_VB = OFF_UB + (size_t)NEXP * 1024;
constexpr size_t OFF_SU = OFF_VB + (size_t)NEXP * 1024;
constexpr size_t OFF_SV = OFF_SU + (size_t)NEXP * 4;
constexpr size_t OFF_RA = OFF_SV + (size_t)NEXP * 4;
constexpr size_t OFF_QA = OFF_RA;
constexpr size_t OFF_KA = OFF_QA + (size_t)NTOK * 768 * 2;
constexpr size_t OFF_VAT = OFF_KA + (size_t)NTOK * 256 * 2;
constexpr size_t OFF_XL = OFF_VAT + (size_t)NTOK * 256 * 2;
constexpr size_t OFF_GL = OFF_XL + (size_t)NTOK * 768 * 2;
constexpr size_t OFF_QM = OFF_GL + (size_t)NTOK * 768 * 2;
constexpr size_t OFF_GATES = OFF_QM + (size_t)NTOK * 512 * 2;
constexpr size_t OFF_BAR = OFF_GATES + (size_t)NTOK * 3072 * 2;
constexpr size_t OFF_END = OFF_BAR + 16384;
constexpr size_t OFF_MERGED = OFF_KA;
constexpr size_t OFF_QPEER = OFF_GATES;
constexpr size_t OFF_TOPL = OFF_QPEER + (size_t)NTOK * 2048 * 2;
constexpr size_t OFF_EIDX = OFF_TOPL + (size_t)NTOK * 256 * 4;
constexpr size_t OFF_EGATE = OFF_EIDX + (size_t)NTOK * 128 * 4;
static_assert(OFF_EGATE + (size_t)NTOK * 128 * 4 <= OFF_BAR, "overlay");
static_assert(OFF_MERGED + (size_t)NTOK * 1024 * 2 <= OFF_GL, "overlay2");
constexpr size_t DO_HBF = 0;
constexpr size_t DO_MEMBF = DO_HBF + (size_t)NTOK * 1024 * 2;
constexpr size_t DO_KM = DO_MEMBF + (size_t)NMEM * 1024 * 2;
constexpr size_t DO_VMT = DO_KM + (size_t)NMEM * 512 * 2;
constexpr size_t DO_ROPE = DO_VMT + (size_t)NMEM * 512 * 2;
static_assert(DO_ROPE + (size_t)NTOK * 32 * 4 <= (size_t)NTOK * 1024 * 4, "d_out scratch");

struct Params {
    const float *x, *mem; const int* positions;
    const float *g_mix, *g_mem, *w_in, *gate_b, *attn_sink, *conv_w, *conv_b, *lru_wr, *lru_br, *lru_wi, *lru_bi, *lru_lambda,
        *w_mem_kv, *p_attn, *p_lru, *p_mem, *w_out, *g_ffn, *w_peer_q, *peer_sub_keys, *peer_u, *peer_v, *g_final;
    float* out; unsigned char* ws;
};

__device__ __forceinline__ int tidx() { int t = threadIdx.x; asm volatile("" : "+v"(t)); return t; }
__device__ __forceinline__ float bf2f(bf16_t b) { return __uint_as_float(((unsigned)b) << 16); }
__device__ __forceinline__ float bflo(unsigned u) { return __uint_as_float(u << 16); }
__device__ __forceinline__ float bfhi(unsigned u) { return __uint_as_float(u & 0xffff0000u); }
typedef float f32x2v __attribute__((ext_vector_type(2)));
__device__ __forceinline__ unsigned pack_bf16(float lo, float hi) { const f32x2v f = {lo, hi}; return __builtin_bit_cast(unsigned, __builtin_convertvector(f, bf16x2v)); }
__device__ __forceinline__ bf16_t f2bf(float f) { return (bf16_t)(pack_bf16(f, 0.f) & 0xffffu); }
__device__ __forceinline__ f32x4 mfma16(bf16x8 a, bf16x8 b, f32x4 c) { return __builtin_amdgcn_mfma_f32_16x16x32_bf16(a, b, c, 0, 0, 0); }
__device__ __forceinline__ float sigmoidf_(float x) { return __builtin_amdgcn_rcpf(1.0f + __expf(-x)); }
__device__ __forceinline__ float gelu_tanh(float x) { const float u = 1.5957691216057308f * (x + 0.044715f * x * x * x); return x * __builtin_amdgcn_rcpf(1.0f + __expf(-u)); }
__device__ __forceinline__ float wave_sum(float v) {
#pragma unroll
    for (int o = 32; o >= 1; o >>= 1) v += __shfl_xor(v, o);
    return v;
}

__device__ void convT_tile(const float* __restrict__ src, bf16_t* __restrict__ dst, int K, int N, int tile, unsigned char* smem) {
    float* t = (float*)smem;
    const int tn = N / 64, tk = tile / tn, tnn = tile % tn, k0 = tk * 64, n0 = tnn * 64, tid = tidx();
    const int r = tid >> 4, c4 = (tid & 15) * 4;
#pragma unroll
    for (int i = 0; i < 4; ++i) {
        const int k = r + 16 * i;
        const float4 v = *(const float4*)(src + (size_t)(k0 + k) * N + n0 + c4);
        t[k * 65 + c4 + 0] = v.x; t[k * 65 + c4 + 1] = v.y; t[k * 65 + c4 + 2] = v.z; t[k * 65 + c4 + 3] = v.w;
    }
    __syncthreads();
    const int n = tid >> 2, kq = (tid & 3) * 16;
    unsigned w[8];
#pragma unroll
    for (int i = 0; i < 8; ++i) w[i] = pack_bf16(t[(kq + 2 * i) * 65 + n], t[(kq + 2 * i + 1) * 65 + n]);
    uint4* d = (uint4*)(dst + (size_t)(n0 + n) * K + k0 + kq);
    d[0] = make_uint4(w[0], w[1], w[2], w[3]); d[1] = make_uint4(w[4], w[5], w[6], w[7]);
    __syncthreads();
}


__device__ __forceinline__ void rms_row_bf16(const float* __restrict__ xr, const float* __restrict__ g, bf16_t* __restrict__ o, int lane) {
    float4 v[4]; float ss = 0.f;
#pragma unroll
    for (int i = 0; i < 4; ++i) { v[i] = *(const float4*)(xr + i * 256 + lane * 4); ss += v[i].x * v[i].x + v[i].y * v[i].y + v[i].z * v[i].z + v[i].w * v[i].w; }
    ss = wave_sum(ss);
    const float rs = rsqrtf(ss * (1.0f / 1024.0f) + EPS);
#pragma unroll
    for (int i = 0; i < 4; ++i) {
        const float4 gg = *(const float4*)(g + i * 256 + lane * 4);
        *(uint2*)(o + i * 256 + lane * 4) = make_uint2(pack_bf16(v[i].x * rs * gg.x, v[i].y * rs * gg.y), pack_bf16(v[i].z * rs * gg.z, v[i].w * rs * gg.w));
    }
}


__device__ __forceinline__ void conv_plain(const float* __restrict__ src, bf16_t* __restrict__ dst, size_t n8) {
    for (size_t i = (size_t)blockIdx.x * 256 + tidx(); i < n8; i += (size_t)gridDim.x * 256) {
        const float4 a = ((const float4*)src)[2 * i], b = ((const float4*)src)[2 * i + 1];
        ((uint4*)dst)[i] = make_uint4(pack_bf16(a.x, a.y), pack_bf16(a.z, a.w), pack_bf16(b.x, b.y), pack_bf16(b.z, b.w));
    }
}
__device__ __forceinline__ void rope_item(const int* __restrict__ pos, float* __restrict__ cs, int i) {
    const int t = i >> 4, f = i & 15;
    const float inv = powf(500000.0f, -(float)(2 * f) / 32.0f);
    const float ang = (float)pos[t] * inv;
    float s, c; sincosf(ang, &s, &c);
    cs[2 * i] = c; cs[2 * i + 1] = s;
}

__device__ __forceinline__ int swz(int row) { return (row & 3) | (((row >> 3) & 1) << 2); }

__device__ __forceinline__ void gemm_tile(const bf16_t* __restrict__ A, int lda, const bf16_t* __restrict__ Bt, int ldb, int K,
                                          f32x4 (&acc)[4][4], unsigned char* smem) {
    const int tid = tidx(), lane = tid & 63, wid = tid >> 6, wr = wid >> 1, wc = wid & 1, li = lane & 15, g = lane >> 4;
    const int srow = tid >> 3, skc = tid & 7;
    const int soff = srow * 128 + ((skc ^ swz(srow)) << 4);
    const bf16_t* ga = A + (size_t)srow * lda + skc * 8;
    const bf16_t* gb = Bt + (size_t)srow * ldb + skc * 8;
    uint4 ra[4], rb[4];
    int aoff[4], boff[4], asw[4], bsw[4];
#pragma unroll
    for (int m = 0; m < 4; ++m) { const int row = wr * 64 + m * 16 + li; aoff[m] = row * 128; asw[m] = swz(row); }
#pragma unroll
    for (int n = 0; n < 4; ++n) { const int row = wc * 64 + 32 * (n >> 1) + 8 * (li >> 2) + 4 * (n & 1) + (li & 3); boff[n] = 16384 + row * 128; bsw[n] = swz(row); }
    const int nk = K >> 6;
#pragma unroll
    for (int i = 0; i < 4; ++i) { ra[i] = *(const uint4*)(ga + (size_t)(32 * i) * lda); rb[i] = *(const uint4*)(gb + (size_t)(32 * i) * ldb); }
#pragma unroll
    for (int i = 0; i < 4; ++i) { *(uint4*)(smem + soff + i * 4096) = ra[i]; *(uint4*)(smem + 16384 + soff + i * 4096) = rb[i]; }
    __syncthreads();
    for (int kt = 0; kt < nk; ++kt) {
        const unsigned char* sb = smem + (kt & 1) * 32768;
        if (kt + 1 < nk) {
#pragma unroll
            for (int i = 0; i < 4; ++i) { ra[i] = *(const uint4*)(ga + (size_t)(32 * i) * lda + (kt + 1) * 64); rb[i] = *(const uint4*)(gb + (size_t)(32 * i) * ldb + (kt + 1) * 64); }
        }
#pragma unroll
        for (int ks = 0; ks < 2; ++ks) {
            bf16x8 af[4], bfr[4];
#pragma unroll
            for (int m = 0; m < 4; ++m) af[m] = *(const bf16x8*)(sb + aoff[m] + (((ks * 4 + g) ^ asw[m]) << 4));
#pragma unroll
            for (int n = 0; n < 4; ++n) bfr[n] = *(const bf16x8*)(sb + boff[n] + (((ks * 4 + g) ^ bsw[n]) << 4));
#pragma unroll
            for (int m = 0; m < 4; ++m)
#pragma unroll
                for (int n = 0; n < 4; ++n) acc[m][n] = mfma16(bfr[n], af[m], acc[m][n]);
        }
        if (kt + 1 < nk) {
            unsigned char* sw = smem + ((kt + 1) & 1) * 32768;
#pragma unroll
            for (int i = 0; i < 4; ++i) { *(uint4*)(sw + soff + i * 4096) = ra[i]; *(uint4*)(sw + 16384 + soff + i * 4096) = rb[i]; }
        }
        __syncthreads();
    }
}
__device__ __forceinline__ void acc_zero(f32x4 (&acc)[4][4]) {
#pragma unroll
    for (int m = 0; m < 4; ++m)
#pragma unroll
        for (int n = 0; n < 4; ++n) acc[m][n] = (f32x4){0.f, 0.f, 0.f, 0.f};
}
template <class F> __device__ __forceinline__ void epi_foreach(const f32x4 (&acc)[4][4], F&& f) {
    const int lane = tidx() & 63, wid = tidx() >> 6, wr = wid >> 1, wc = wid & 1, li = lane & 15, g = lane >> 4;
#pragma unroll
    for (int m = 0; m < 4; ++m)
#pragma unroll
        for (int pp = 0; pp < 2; ++pp) {
            float v[8];
#pragma unroll
            for (int r = 0; r < 4; ++r) { v[r] = acc[m][2 * pp][r]; v[4 + r] = acc[m][2 * pp + 1][r]; }
            f(wr * 64 + m * 16 + li, wc * 64 + 32 * pp + 8 * g, v, pp);
        }
}
__device__ __forceinline__ void store_bf16x8(bf16_t* p, const float (&v)[8]) {
    *(uint4*)p = make_uint4(pack_bf16(v[0], v[1]), pack_bf16(v[2], v[3]), pack_bf16(v[4], v[5]), pack_bf16(v[6], v[7]));
}
__device__ __forceinline__ void store_tile_T(const f32x4 (&acc)[4][4], bf16_t* __restrict__ dstT, int ldt, unsigned char* smem) {
    bf16_t* t = (bf16_t*)smem;
    epi_foreach(acc, [&](int r, int c, const float (&v)[8], int) {
#pragma unroll
        for (int e = 0; e < 8; ++e) t[(c + e) * 136 + r] = f2bf(v[e]);
    });
    __syncthreads();
#pragma unroll
    for (int i = 0; i < 8; ++i) {
        const int ch = tidx() + 256 * i, d = ch >> 4, tc = ch & 15;
        *(uint4*)(dstT + (size_t)d * ldt + tc * 8) = *(const uint4*)(smem + d * 272 + tc * 16);
    }
    __syncthreads();
}

__device__ void inproj_tile(const Params& p, int rt, int ct, unsigned char* smem) {
    unsigned char* ws = p.ws; unsigned char* dob = (unsigned char*)p.out;
    const bf16_t* hbf = (const bf16_t*)(dob + DO_HBF);
    const bf16_t* WinT = (const bf16_t*)(ws + OFF_WINT);
    f32x4 acc[4][4]; acc_zero(acc);
    gemm_tile(hbf + (size_t)rt * 128 * 1024, 1024, WinT + (size_t)ct * 128 * 1024, 1024, 1024, acc, smem);
    const int row0 = rt * 128;
    if (ct < 8) {
        const float* cs = (const float*)(dob + DO_ROPE);
        const bool isq = ct < 6;
        bf16_t* dst = isq ? (bf16_t*)(ws + OFF_QA) + ct * 128 : (bf16_t*)(ws + OFF_KA) + (ct - 6) * 128;
        const int ld = isq ? 768 : 256;
        const float sc = isq ? QSCALE : 1.0f;
        const int g = (tidx() & 63) >> 4;
        epi_foreach(acc, [&](int r, int c, float (&v)[8], int pp) {
            const int tok = row0 + r;
            if (pp == 0 && c < 32) {
                const float* csr = cs + (size_t)tok * 32 + (g & 1) * 16;
#pragma unroll
                for (int e = 0; e < 8; ++e) {
                    const float o = __shfl_xor(v[e], 32);
                    const float cc = csr[2 * e], ss = csr[2 * e + 1];
                    v[e] = (g < 2) ? (v[e] * cc - o * ss) : (v[e] * cc + o * ss);
                }
            }
#pragma unroll
            for (int e = 0; e < 8; ++e) v[e] *= sc;
            store_bf16x8(dst + (size_t)tok * ld + c, v);
        });
    } else if (ct < 10) {
        const int kvh = ct - 8, b = row0 / S_, s0 = row0 % S_;
        store_tile_T(acc, (bf16_t*)(ws + OFF_VAT) + (size_t)(b * 2 + kvh) * 128 * S_ + s0, S_, smem);
    } else if (ct < 16) {
        bf16_t* dst = (bf16_t*)(ws + OFF_XL) + (ct - 10) * 128;
        epi_foreach(acc, [&](int r, int c, float (&v)[8], int) { store_bf16x8(dst + (size_t)(row0 + r) * 768 + c, v); });
    } else if (ct < 22) {
        bf16_t* dst = (bf16_t*)(ws + OFF_GL) + (ct - 16) * 128;
        epi_foreach(acc, [&](int r, int c, float (&v)[8], int) {
#pragma unroll
            for (int e = 0; e < 8; ++e) v[e] = gelu_tanh(v[e]);
            store_bf16x8(dst + (size_t)(row0 + r) * 768 + c, v); });
    } else if (ct < 26) {
        bf16_t* dst = (bf16_t*)(ws + OFF_QM) + (ct - 22) * 128;
        epi_foreach(acc, [&](int r, int c, float (&v)[8], int) {
#pragma unroll
            for (int e = 0; e < 8; ++e) v[e] *= QSCALE;
            store_bf16x8(dst + (size_t)(row0 + r) * 512 + c, v); });
    } else {
        const int gc0 = (ct - 26) * 128;
        bf16_t* dst = (bf16_t*)(ws + OFF_GATES) + gc0;
        const float* gb = p.gate_b + gc0;
        epi_foreach(acc, [&](int r, int c, float (&v)[8], int) {
            const float4 b0 = *(const float4*)(gb + c), b1 = *(const float4*)(gb + c + 4);
            v[0] = sigmoidf_(v[0] + b0.x); v[1] = sigmoidf_(v[1] + b0.y); v[2] = sigmoidf_(v[2] + b0.z); v[3] = sigmoidf_(v[3] + b0.w);
            v[4] = sigmoidf_(v[4] + b1.x); v[5] = sigmoidf_(v[5] + b1.y); v[6] = sigmoidf_(v[6] + b1.z); v[7] = sigmoidf_(v[7] + b1.w);
            store_bf16x8(dst + (size_t)(row0 + r) * 3072 + c, v); });
    }
}

__device__ void memkv_tile(const Params& p, int rt, int ct, unsigned char* smem) {
    unsigned char* dob = (unsigned char*)p.out;
    f32x4 acc[4][4]; acc_zero(acc);
    gemm_tile((const bf16_t*)(dob + DO_MEMBF) + (size_t)rt * 128 * 1024, 1024, (const bf16_t*)(p.ws + OFF_WMKVT) + (size_t)ct * 128 * 1024, 1024, 1024, acc, smem);
    const int row0 = rt * 128;
    if (ct < 4) {
        bf16_t* dst = (bf16_t*)(dob + DO_KM) + ct * 128;
        epi_foreach(acc, [&](int r, int c, float (&v)[8], int) { store_bf16x8(dst + (size_t)(row0 + r) * 512 + c, v); });
    } else {
        const int h = ct - 4, b = row0 / MEML, m0 = row0 % MEML;
        store_tile_T(acc, (bf16_t*)(dob + DO_VMT) + (size_t)(b * 4 + h) * 128 * MEML + m0, MEML, smem);
    }
}


template <int NF, bool WIN>
__device__ __forceinline__ void attn_wave(const bf16_t* Q, int ldq, const bf16_t* __restrict__ Kb, int ldk, const bf16_t* __restrict__ Vt, int ldv,
                                          int q0, int kstart, int nkeys, float sink, bf16_t* O, int ldo) {
    const int lane = tidx() & 63, li = lane & 15, g = lane >> 4;
    bf16x8 qf[4];
#pragma unroll
    for (int ks = 0; ks < 4; ++ks) qf[ks] = *(const bf16x8*)(Q + (size_t)li * ldq + ks * 32 + g * 8);
    f32x4 s[NF];
#pragma unroll
    for (int t = 0; t < NF; ++t) {
        int key = kstart + 16 * t + li; key = key < 0 ? 0 : (key > nkeys - 1 ? nkeys - 1 : key);
        const bf16_t* kp = Kb + (size_t)key * ldk + g * 8;
        f32x4 a = {0.f, 0.f, 0.f, 0.f};
#pragma unroll
        for (int ks = 0; ks < 4; ++ks) a = mfma16(*(const bf16x8*)(kp + ks * 32), qf[ks], a);
        s[t] = a;
    }
    float mx = -1e30f;
#pragma unroll
    for (int t = 0; t < NF; ++t)
#pragma unroll
        for (int r = 0; r < 4; ++r) {
            if (WIN) {
                const int kp = kstart + 16 * t + 4 * g + r, d = kp - (q0 + li);
                const bool valid = kp >= 0 && kp < nkeys && d <= 128 && d >= -128;
                s[t][r] = valid ? s[t][r] : -1e30f;
            }
            mx = fmaxf(mx, s[t][r]);
        }
    mx = fmaxf(mx, __shfl_xor(mx, 16)); mx = fmaxf(mx, __shfl_xor(mx, 32));
    if (WIN) mx = fmaxf(mx, sink);
    float sum = 0.f;
#pragma unroll
    for (int t = 0; t < NF; ++t)
#pragma unroll
        for (int r = 0; r < 4; ++r) { const float pv = __expf(s[t][r] - mx); s[t][r] = pv; sum += pv; }
    sum += __shfl_xor(sum, 16); sum += __shfl_xor(sum, 32);
    if (WIN) sum += __expf(sink - mx);
    const float inv = 1.0f / sum;
    f32x4 o[8];
#pragma unroll
    for (int df = 0; df < 8; ++df) o[df] = (f32x4){0.f, 0.f, 0.f, 0.f};
#pragma unroll
    for (int kk = 0; kk < NF / 2; ++kk) {
        union { unsigned u[4]; bf16x8 v; } pb;
        pb.u[0] = pack_bf16(s[2 * kk][0], s[2 * kk][1]); pb.u[1] = pack_bf16(s[2 * kk][2], s[2 * kk][3]);
        pb.u[2] = pack_bf16(s[2 * kk + 1][0], s[2 * kk + 1][1]); pb.u[3] = pack_bf16(s[2 * kk + 1][2], s[2 * kk + 1][3]);
        int ka = kstart + 32 * kk + 4 * g, kb = ka + 16;
        ka = ka < 0 ? 0 : (ka > nkeys - 4 ? nkeys - 4 : ka); kb = kb < 0 ? 0 : (kb > nkeys - 4 ? nkeys - 4 : kb);
#pragma unroll
        for (int df = 0; df < 8; ++df) {
            const bf16_t* vp = Vt + (size_t)(df * 16 + li) * ldv;
            union { uint2 u[2]; bf16x8 v; } va;
            va.u[0] = *(const uint2*)(vp + ka); va.u[1] = *(const uint2*)(vp + kb);
            o[df] = mfma16(va.v, pb.v, o[df]);
        }
    }
#pragma unroll
    for (int df = 0; df < 8; ++df)
        *(uint2*)(O + (size_t)li * ldo + df * 16 + 4 * g) = make_uint2(pack_bf16(o[df][0] * inv, o[df][1] * inv), pack_bf16(o[df][2] * inv, o[df][3] * inv));
}
__device__ void attn_win_unit(const Params& p, int u) {
    const int wid = tidx() >> 6;
    const int qb = u % 32, head = (u / 32) % 6, b = u / 192, kvh = head / 3;
    const int q0 = qb * 64 + wid * 16;
    bf16_t* Q = (bf16_t*)(p.ws + OFF_QA) + (size_t)(b * S_ + q0) * 768 + head * 128;
    const bf16_t* Kb = (const bf16_t*)(p.ws + OFF_KA) + (size_t)(b * S_) * 256 + kvh * 128;
    const bf16_t* Vt = (const bf16_t*)(p.ws + OFF_VAT) + (size_t)(b * 2 + kvh) * 128 * S_;
    attn_wave<18, true>(Q, 768, Kb, 256, Vt, S_, q0, q0 - 128, S_, p.attn_sink[head], Q, 768);
}
__device__ void attn_mem_unit(const Params& p, int u) {
    const int wid = tidx() >> 6;
    const int qb = u % 32, head = (u / 32) % 4, b = u / 128;
    const int q0 = qb * 64 + wid * 16;
    unsigned char* dob = (unsigned char*)p.out;
    bf16_t* Q = (bf16_t*)(p.ws + OFF_QM) + (size_t)(b * S_ + q0) * 512 + head * 128;
    const bf16_t* Kb = (const bf16_t*)(dob + DO_KM) + (size_t)(b * MEML) * 512 + head * 128;
    const bf16_t* Vt = (const bf16_t*)(dob + DO_VMT) + (size_t)(b * 4 + head) * 128 * MEML;
    attn_wave<16, false>(Q, 512, Kb, 512, Vt, MEML, q0, 0, MEML, 0.f, Q, 512);
}


__device__ __forceinline__ void lru_load_x(unsigned (&xw)[19], const bf16_t* __restrict__ Xl, int sbase, int cch) {
#pragma unroll
    for (int i = 0; i < 19; ++i) {
        const int s = sbase + i - 2;
        xw[i] = (s >= 0 && s < S_) ? *(const unsigned*)(Xl + (size_t)s * 768 + cch) : 0u;
    }
}
__device__ void lru_unit(const Params& p, int u, unsigned char* smem) {
    const int tid = tidx(), lane = tid & 63, wid = tid >> 6, li = lane & 15, g = lane >> 4;
    const int qt = u & 3, h = (u >> 2) % 6, b = u / 24;
    const int cbase = h * 128, cq0 = cbase + qt * 32;
    unsigned char* xcs = smem; unsigned char* wl = smem + 16384;
    float* pre = (float*)(smem + 32768); float* xcf = (float*)(smem + 49152);
    float* cA = (float*)(smem + 57344); float* cH = cA + 256; float* h0 = cH + 256;
    const bf16_t* Xl = (const bf16_t*)(p.ws + OFF_XL) + (size_t)(b * S_) * 768;
    bf16_t* Gl = (bf16_t*)(p.ws + OFF_GL) + (size_t)(b * S_) * 768;
    bf16_t* Hf = (bf16_t*)((unsigned char*)p.out + DO_HBF) + (size_t)(b * S_) * 768;
    const bf16_t* LruWt = (const bf16_t*)(p.ws + OFF_LRUWT);
    const int cp = tid & 63, tq = tid >> 6, cch = cbase + 2 * cp;
    float cw[4][2];
#pragma unroll
    for (int j = 0; j < 4; ++j) { cw[j][0] = p.conv_w[j * LW + cch]; cw[j][1] = p.conv_w[j * LW + cch + 1]; }
    const float cb0 = p.conv_b[cch], cb1 = p.conv_b[cch + 1];
    const int sc_c = tid & 31, sub = tid >> 5, sch = cq0 + sc_c;
    for (int dir = 0; dir < 2; ++dir) {
        __syncthreads();
#pragma unroll
        for (int i = 0; i < 4; ++i) {
            const int ch = tid + 256 * i, j = ch >> 4, kc = ch & 15;
            const int srcrow = h * 512 + ((j >> 5) * 2 + dir) * 128 + qt * 32 + (j & 31);
            *(uint4*)(wl + j * 256 + ((kc ^ (j & 15)) << 4)) = *(const uint4*)(LruWt + (size_t)srcrow * 128 + kc * 8);
        }
        const float br = p.lru_br[dir * LW + sch], bi = p.lru_bi[dir * LW + sch];
        const float lam = p.lru_lambda[dir * LW + sch];
        const float sp8 = -8.0f * log1pf(__expf(-lam));
        if (tid < 32) h0[tid] = 0.f;
        unsigned xw[19];
        lru_load_x(xw, Xl, (dir ? 31 : 0) * 64 + 16 * tq, cch);
        for (int ci = 0; ci < 32; ++ci) {
            const int chunk = dir ? 31 - ci : ci, s0 = chunk * 64;
#pragma unroll
            for (int i = 0; i < 16; ++i) {
                const int t = 16 * tq + i;
                const float y0 = cb0 + cw[0][0] * bflo(xw[i]) + cw[1][0] * bflo(xw[i + 1]) + cw[2][0] * bflo(xw[i + 2]) + cw[3][0] * bflo(xw[i + 3]);
                const float y1 = cb1 + cw[0][1] * bfhi(xw[i]) + cw[1][1] * bfhi(xw[i + 1]) + cw[2][1] * bfhi(xw[i + 2]) + cw[3][1] * bfhi(xw[i + 3]);
                *(unsigned*)(xcs + t * 256 + (((cp >> 2) ^ (t & 15)) << 4) + (cp & 3) * 4) = pack_bf16(y0, y1);
                if ((cp >> 4) == qt) { xcf[t * 32 + 2 * (cp & 15)] = y0; xcf[t * 32 + 2 * (cp & 15) + 1] = y1; }
            }
            if (ci + 1 < 32) lru_load_x(xw, Xl, (dir ? 30 - ci : ci + 1) * 64 + 16 * tq, cch);
            float hfv[8], glv[8];
            if (dir) {
#pragma unroll
                for (int k = 0; k < 8; ++k) {
                    const size_t gi = (size_t)(s0 + 63 - (sub * 8 + k)) * 768 + sch;
                    hfv[k] = bf2f(Hf[gi]); glv[k] = bf2f(Gl[gi]);
                }
            }
            __syncthreads();
            {
                f32x4 a[4];
#pragma unroll
                for (int n = 0; n < 4; ++n) a[n] = (f32x4){0.f, 0.f, 0.f, 0.f};
#pragma unroll
                for (int ks = 0; ks < 4; ++ks) {
                    const int row = wid * 16 + li;
                    const bf16x8 xf = *(const bf16x8*)(xcs + row * 256 + (((ks * 4 + g) ^ (row & 15)) << 4));
#pragma unroll
                    for (int n = 0; n < 4; ++n) {
                        const int j = n * 16 + li;
                        const bf16x8 wf = *(const bf16x8*)(wl + j * 256 + (((ks * 4 + g) ^ (j & 15)) << 4));
                        a[n] = mfma16(xf, wf, a[n]);
                    }
                }
#pragma unroll
                for (int n = 0; n < 4; ++n)
#pragma unroll
                    for (int r = 0; r < 4; ++r) pre[(wid * 16 + 4 * g + r) * 64 + n * 16 + li] = a[n][r];
            }
            __syncthreads();
            float hl[8], ap[8];
            {
                float hh = 0.f, aa = 1.f;
#pragma unroll
                for (int k = 0; k < 8; ++k) {
                    const int pp = sub * 8 + k, t = dir ? 63 - pp : pp;
                    const float r = sigmoidf_(pre[t * 64 + sc_c] + br), ig = sigmoidf_(pre[t * 64 + 32 + sc_c] + bi);
                    const float a = __expf(sp8 * r);
                    const float bx = sqrtf(fmaxf(1.0f - a * a, 0.f)) * (ig * xcf[t * 32 + sc_c]);
                    hh = a * hh + bx; aa *= a; hl[k] = hh; ap[k] = aa;
                }
                cA[sub * 32 + sc_c] = aa; cH[sub * 32 + sc_c] = hh;
            }
            __syncthreads();
            {
                float hin = h0[(ci & 1) * 32 + sc_c];
                for (int s2 = 0; s2 < sub; ++s2) hin = cA[s2 * 32 + sc_c] * hin + cH[s2 * 32 + sc_c];
#pragma unroll
                for (int k = 0; k < 8; ++k) {
                    const int pp = sub * 8 + k, t = dir ? 63 - pp : pp;
                    const float hv = hl[k] + ap[k] * hin;
                    const size_t gi = (size_t)(s0 + t) * 768 + sch;
                    if (dir == 0) Hf[gi] = f2bf(hv);
                    else Gl[gi] = f2bf((hfv[k] + hv) * glv[k]);
                    if (k == 7 && sub == 7) h0[((ci + 1) & 1) * 32 + sc_c] = hv;
                }
            }
        }
    }
    __syncthreads();
}

__device__ void merge_tile(const Params& p, int rt, int ct, unsigned char* smem) {
    unsigned char* ws = p.ws;
    const int row0 = rt * 128, col0 = ct * 128;
    uint4 tot[4][2];
    const bf16_t* G = (const bf16_t*)(ws + OFF_GATES);
    const int lane = tidx() & 63, wid = tidx() >> 6, wr = wid >> 1, wc = wid & 1, li = lane & 15, g = lane >> 4;
#pragma unroll 1
    for (int br = 0; br < 3; ++br) {
        const bf16_t* Ab = (const bf16_t*)(ws + (br == 0 ? OFF_QA : (br == 1 ? OFF_GL : OFF_QM)));
        const bf16_t* Bb = (const bf16_t*)(ws + (br == 0 ? OFF_PATTNT : (br == 1 ? OFF_PLRUT : OFF_PMEMT)));
        const int Kb = br == 2 ? 512 : 768;
        f32x4 acc[4][4]; acc_zero(acc);
        gemm_tile(Ab + (size_t)row0 * Kb, Kb, Bb + (size_t)col0 * Kb, Kb, Kb, acc, smem);
#pragma unroll
        for (int m = 0; m < 4; ++m)
#pragma unroll
            for (int pp = 0; pp < 2; ++pp) {
                const int r = wr * 64 + m * 16 + li, c = wc * 64 + 32 * pp + 8 * g;
                const uint4 gv = *(const uint4*)(G + (size_t)(row0 + r) * 3072 + br * 1024 + col0 + c);
                float v[8];
                v[0] = bflo(gv.x) * acc[m][2 * pp][0]; v[1] = bfhi(gv.x) * acc[m][2 * pp][1];
                v[2] = bflo(gv.y) * acc[m][2 * pp][2]; v[3] = bfhi(gv.y) * acc[m][2 * pp][3];
                v[4] = bflo(gv.z) * acc[m][2 * pp + 1][0]; v[5] = bfhi(gv.z) * acc[m][2 * pp + 1][1];
                v[6] = bflo(gv.w) * acc[m][2 * pp + 1][2]; v[7] = bfhi(gv.w) * acc[m][2 * pp + 1][3];
                if (br > 0) {
                    const uint4 t = tot[m][pp];
                    v[0] += bflo(t.x); v[1] += bfhi(t.x); v[2] += bflo(t.y); v[3] += bfhi(t.y);
                    v[4] += bflo(t.z); v[5] += bfhi(t.z); v[6] += bflo(t.w); v[7] += bfhi(t.w);
                }
                tot[m][pp] = make_uint4(pack_bf16(v[0], v[1]), pack_bf16(v[2], v[3]), pack_bf16(v[4], v[5]), pack_bf16(v[6], v[7]));
            }
    }
    bf16_t* dst = (bf16_t*)(ws + OFF_MERGED) + col0;
#pragma unroll
    for (int m = 0; m < 4; ++m)
#pragma unroll
        for (int pp = 0; pp < 2; ++pp) {
            const int r = wr * 64 + m * 16 + li, c = wc * 64 + 32 * pp + 8 * g;
            *(uint4*)(dst + (size_t)(row0 + r) * 1024 + c) = tot[m][pp];
        }
}
__device__ void outproj_tile(const Params& p, int rt, int ct, unsigned char* smem) {
    const int row0 = rt * 128, col0 = ct * 128;
    f32x4 acc[4][4]; acc_zero(acc);
    gemm_tile((const bf16_t*)(p.ws + OFF_MERGED) + (size_t)row0 * 1024, 1024, (const bf16_t*)(p.ws + OFF_WOUTT) + (size_t)col0 * 1024, 1024, 1024, acc, smem);
    epi_foreach(acc, [&](int r, int c, float (&v)[8], int) {
        const size_t o = (size_t)(row0 + r) * 1024 + col0 + c;
        const float4 x0 = *(const float4*)(p.x + o), x1 = *(const float4*)(p.x + o + 4);
        *(float4*)(p.out + o) = make_float4(x0.x + v[0], x0.y + v[1], x0.z + v[2], x0.w + v[3]);
        *(float4*)(p.out + o + 4) = make_float4(x1.x + v[4], x1.y + v[5], x1.z + v[6], x1.w + v[7]);
    });
}

__device__ void peerq_tile(const Params& p, int rt, int ct, unsigned char* smem) {
    const int row0 = rt * 128, col0 = ct * 128;
    f32x4 acc[4][4]; acc_zero(acc);
    gemm_tile((const bf16_t*)(p.ws + OFF_MERGED) + (size_t)row0 * 1024, 1024, (const bf16_t*)(p.ws + OFF_WPQT) + (size_t)col0 * 1024, 1024, 1024, acc, smem);
    bf16_t* dst = (bf16_t*)(p.ws + OFF_QPEER) + col0;
    epi_foreach(acc, [&](int r, int c, float (&v)[8], int) { store_bf16x8(dst + (size_t)(row0 + r) * 2048 + c, v); });
}

__device__ __forceinline__ int sortable(float v) { int k = __float_as_int(v); return k ^ ((k >> 31) & 0x7fffffff); }
__device__ __forceinline__ float unsortable(int k) { return __int_as_float(k ^ ((k >> 31) & 0x7fffffff)); }
__device__ __forceinline__ void insert16(int (&lst)[16], int x) {
#pragma unroll
    for (int k = 0; k < 16; ++k) { const int hi = max(lst[k], x); x = min(lst[k], x); lst[k] = hi; }
}
__device__ void scores_tile(const Params& p, int rt, int pq, unsigned char* smem) {
    const int row0 = rt * 128;
    f32x4 acc[4][4]; acc_zero(acc);
    gemm_tile((const bf16_t*)(p.ws + OFF_QPEER) + (size_t)row0 * 2048 + pq * 128, 2048, (const bf16_t*)(p.ws + OFF_SUBK) + (size_t)pq * 128 * 128, 128, 128, acc, smem);
    float* sc = (float*)smem;
    epi_foreach(acc, [&](int r, int c, float (&v)[8], int) {
        *(float4*)(sc + r * 132 + c) = make_float4(v[0], v[1], v[2], v[3]);
        *(float4*)(sc + r * 132 + c + 4) = make_float4(v[4], v[5], v[6], v[7]); });
    __syncthreads();
    if (tidx() < 128) {
        const int r = tidx();
        int lst[16];
#pragma unroll
        for (int k = 0; k < 16; ++k) lst[k] = (int)0x80000000;
#pragma unroll 2
        for (int j4 = 0; j4 < 32; ++j4) {
            const float4 v = *(const float4*)(sc + r * 132 + j4 * 4);
            insert16(lst, (sortable(v.x) & ~127) | (j4 * 4 + 0));
            insert16(lst, (sortable(v.y) & ~127) | (j4 * 4 + 1));
            insert16(lst, (sortable(v.z) & ~127) | (j4 * 4 + 2));
            insert16(lst, (sortable(v.w) & ~127) | (j4 * 4 + 3));
        }
        int4* dst = (int4*)((int*)(p.ws + OFF_TOPL) + ((size_t)(row0 + r) * 16 + pq) * 16);
        dst[0] = make_int4(lst[0], lst[1], lst[2], lst[3]); dst[1] = make_int4(lst[4], lst[5], lst[6], lst[7]);
        dst[2] = make_int4(lst[8], lst[9], lst[10], lst[11]); dst[3] = make_int4(lst[12], lst[13], lst[14], lst[15]);
    }
    __syncthreads();
}

__device__ void combine_item(const Params& p, int item) {
    const int tok = item >> 3, hd = item & 7;
    const int* l0 = (const int*)(p.ws + OFF_TOPL) + ((size_t)tok * 16 + hd * 2) * 16;
    const int* l1 = l0 + 16;
    int k0[16], k1[16];
#pragma unroll
    for (int i = 0; i < 4; ++i) {
        const int4 a = ((const int4*)l0)[i], b = ((const int4*)l1)[i];
        k0[4 * i] = a.x; k0[4 * i + 1] = a.y; k0[4 * i + 2] = a.z; k0[4 * i + 3] = a.w;
        k1[4 * i] = b.x; k1[4 * i + 1] = b.y; k1[4 * i + 2] = b.z; k1[4 * i + 3] = b.w;
    }
    float v0[16], v1[16];
#pragma unroll
    for (int i = 0; i < 16; ++i) { v0[i] = unsortable(k0[i] & ~127); v1[i] = unsortable(k1[i] & ~127); }
    int lst[16];
#pragma unroll
    for (int k = 0; k < 16; ++k) lst[k] = (int)0x80000000;
#pragma unroll
    for (int a = 0; a < 16; ++a)
#pragma unroll
        for (int b = 0; b < 16; ++b)
            if ((a + 1) * (b + 1) <= 16) insert16(lst, (sortable(v0[a] + v1[b]) & ~255) | (a * 16 + b));
    float val[16], sum = 0.f;
    const float mx = unsortable(lst[0] & ~255);
#pragma unroll
    for (int k = 0; k < 16; ++k) { val[k] = __expf(unsortable(lst[k] & ~255) - mx); sum += val[k]; }
    const float inv = 1.0f / sum;
    int* ei = (int*)(p.ws + OFF_EIDX) + (size_t)tok * 128 + hd * 16;
    float* eg = (float*)(p.ws + OFF_EGATE) + (size_t)tok * 128 + hd * 16;
#pragma unroll
    for (int k = 0; k < 16; ++k) {
        const int code = lst[k] & 255, a = code >> 4, b = code & 15;
        ei[k] = (l0[a] & 127) * 128 + (l1[b] & 127);
        eg[k] = val[k] * inv;
    }
}

__device__ __forceinline__ void conv_row_fp8(const float* __restrict__ src, unsigned char* __restrict__ dst, float* __restrict__ scale, int row, int lane) {
    const float4* s = (const float4*)(src + (size_t)row * 1024 + lane * 16);
    float4 v[4]; float am = 0.f;
#pragma unroll
    for (int i = 0; i < 4; ++i) { v[i] = s[i]; am = fmaxf(am, fmaxf(fmaxf(fabsf(v[i].x), fabsf(v[i].y)), fmaxf(fabsf(v[i].z), fabsf(v[i].w)))); }
#pragma unroll
    for (int o = 32; o >= 1; o >>= 1) am = fmaxf(am, __shfl_xor(am, o));
    const float sc = am > 0.f ? am * (1.0f / 224.0f) : 1.0f, inv = 1.0f / sc;
    unsigned w[4];
#pragma unroll
    for (int i = 0; i < 4; ++i) {
        int t = __builtin_amdgcn_cvt_pk_fp8_f32(v[i].x * inv, v[i].y * inv, 0, false);
        t = __builtin_amdgcn_cvt_pk_fp8_f32(v[i].z * inv, v[i].w * inv, t, true);
        w[i] = (unsigned)t;
    }
    *(uint4*)(dst + (size_t)row * 1024 + lane * 16) = make_uint4(w[0], w[1], w[2], w[3]);
    if (lane == 0) scale[row] = sc;
}
__device__ __forceinline__ void load8rows(uint4 (&R)[8], const unsigned char* __restrict__ tab, int es, int l0, int lane) {
#pragma unroll
    for (int j = 0; j < 8; ++j) {
        const int id = __builtin_amdgcn_readlane(es, l0 + j);
        R[j] = *(const uint4*)(tab + (size_t)id * 1024 + lane * 16);
    }
}
__device__ __forceinline__ float dot16q(const uint4& r, const float (&h)[16]) {
    const unsigned q[4] = {r.x, r.y, r.z, r.w};
    float d0 = 0.f, d1 = 0.f;
#pragma unroll
    for (int i = 0; i < 4; ++i) {
        const f32x2v a = __builtin_amdgcn_cvt_pk_f32_fp8((int)q[i], false), b = __builtin_amdgcn_cvt_pk_f32_fp8((int)q[i], true);
        d0 += a.x * h[4 * i]; d1 += a.y * h[4 * i + 1]; d0 += b.x * h[4 * i + 2]; d1 += b.y * h[4 * i + 3];
    }
    return d0 + d1;
}
__device__ __forceinline__ float dots8(const uint4 (&R)[8], const float (&h)[16], int lane) {
    float pd[8];
#pragma unroll
    for (int j = 0; j < 8; ++j) pd[j] = dot16q(R[j], h);
    const bool b5 = (lane & 32) != 0, b4 = (lane & 16) != 0, b3 = (lane & 8) != 0;
    float a[4];
#pragma unroll
    for (int j = 0; j < 4; ++j) { const float keep = b5 ? pd[4 + j] : pd[j], send = b5 ? pd[j] : pd[4 + j]; a[j] = keep + __shfl_xor(send, 32); }
    float c[2];
#pragma unroll
    for (int j = 0; j < 2; ++j) { const float keep = b4 ? a[2 + j] : a[j], send = b4 ? a[j] : a[2 + j]; c[j] = keep + __shfl_xor(send, 16); }
    float kk;
    { const float keep = b3 ? c[1] : c[0], send = b3 ? c[0] : c[1]; kk = keep + __shfl_xor(send, 8); }
    kk += __shfl_xor(kk, 4); kk += __shfl_xor(kk, 2); kk += __shfl_xor(kk, 1);
    return kk;
}
__device__ __forceinline__ void axpy8(float (&o)[16], const uint4 (&R)[8], int wsr, int bb) {
#pragma unroll
    for (int j = 0; j < 8; ++j) {
        const float c = __int_as_float(__builtin_amdgcn_readlane(wsr, 8 * j + bb));
        const unsigned q[4] = {R[j].x, R[j].y, R[j].z, R[j].w};
#pragma unroll
        for (int i = 0; i < 4; ++i) {
            const f32x2v a = __builtin_amdgcn_cvt_pk_f32_fp8((int)q[i], false), b = __builtin_amdgcn_cvt_pk_f32_fp8((int)q[i], true);
            o[4 * i] += c * a.x; o[4 * i + 1] += c * a.y; o[4 * i + 2] += c * b.x; o[4 * i + 3] += c * b.y;
        }
    }
}
__device__ void gather_token(const Params& p, int tok, int lane) {
    const bf16_t* h2 = (const bf16_t*)(p.ws + OFF_MERGED) + (size_t)tok * 1024 + lane * 16;
    const unsigned char* Uq = p.ws + OFF_UB; const unsigned char* Vq = p.ws + OFF_VB;
    const float* SU = (const float*)(p.ws + OFF_SU); const float* SV = (const float*)(p.ws + OFF_SV);
    const int* ei = (const int*)(p.ws + OFF_EIDX) + (size_t)tok * 128;
    const float* eg = (const float*)(p.ws + OFF_EGATE) + (size_t)tok * 128;
    float h[16];
    {
        const uint4 ha = *(const uint4*)h2, hb = *(const uint4*)(h2 + 8);
        const unsigned hq[8] = {ha.x, ha.y, ha.z, ha.w, hb.x, hb.y, hb.z, hb.w};
#pragma unroll
        for (int e = 0; e < 8; ++e) { h[2 * e] = bflo(hq[e]); h[2 * e + 1] = bfhi(hq[e]); }
    }
    const int pe = 8 * (lane & 7) + (lane >> 3);
    int es[2], wsr[2] = {0, 0}; float su[2], gv[2];
#pragma unroll
    for (int k = 0; k < 2; ++k) {
        es[k] = ei[64 * k + lane];
        const int e = ei[64 * k + pe];
        su[k] = SU[e]; gv[k] = eg[64 * k + pe] * SV[e];
    }
    uint4 R0[8], R1[8];
#pragma unroll
    for (int k = 0; k < 2; ++k) {
        load8rows(R0, Uq, es[k], 0, lane);
        for (int bb = 0; bb < 8; bb += 2) {
            load8rows(R1, Uq, es[k], 8 * bb + 8, lane);
            { const float w = gelu_tanh(dots8(R0, h, lane) * su[k]) * gv[k]; if ((lane & 7) == bb) wsr[k] = __float_as_int(w); }
            if (bb + 2 < 8) load8rows(R0, Uq, es[k], 8 * bb + 16, lane);
            { const float w = gelu_tanh(dots8(R1, h, lane) * su[k]) * gv[k]; if ((lane & 7) == bb + 1) wsr[k] = __float_as_int(w); }
        }
    }
    float o[16];
#pragma unroll
    for (int e = 0; e < 16; ++e) o[e] = 0.f;
#pragma unroll
    for (int k = 0; k < 2; ++k) {
        load8rows(R0, Vq, es[k], 0, lane);
        for (int bb = 0; bb < 8; bb += 2) {
            load8rows(R1, Vq, es[k], 8 * bb + 8, lane);
            axpy8(o, R0, wsr[k], bb);
            if (bb + 2 < 8) load8rows(R0, Vq, es[k], 8 * bb + 16, lane);
            axpy8(o, R1, wsr[k], bb + 1);
        }
    }
    float* xr = p.out + (size_t)tok * 1024 + lane * 16;
    float4 x[4]; float ss = 0.f;
#pragma unroll
    for (int i = 0; i < 4; ++i) {
        x[i] = *(const float4*)(xr + 4 * i);
        x[i].x += o[4 * i]; x[i].y += o[4 * i + 1]; x[i].z += o[4 * i + 2]; x[i].w += o[4 * i + 3];
        ss += x[i].x * x[i].x + x[i].y * x[i].y + x[i].z * x[i].z + x[i].w * x[i].w;
    }
    ss = wave_sum(ss);
    const float rs = rsqrtf(ss * (1.0f / 1024.0f) + EPS);
    const float* gf = p.g_final + lane * 16;
#pragma unroll
    for (int i = 0; i < 4; ++i) {
        const float4 gg = *(const float4*)(gf + 4 * i);
        *(float4*)(xr + 4 * i) = make_float4(x[i].x * rs * gg.x, x[i].y * rs * gg.y, x[i].z * rs * gg.z, x[i].w * rs * gg.w);
    }
}

#define XB_TMO      128
#define XB_XCNT(j)  (256  + 64 * (j))
#define XB_XSUB(j)  (1280 + 64 * (j))
#define XB_XGEN(j)  (2304 + 64 * (j))
#define XB_TOP      3328
#define XB_TOPGEN   3392
#define XCD_BAR_WORDS 3456
#define XB_SPIN_CAP (1u << 22)
#define LAS __attribute__((address_space(3)))
__device__ __forceinline__ unsigned xb_ld(unsigned* p)              { return __hip_atomic_load(p, __ATOMIC_RELAXED, __HIP_MEMORY_SCOPE_AGENT); }
__device__ __forceinline__ unsigned xb_add(unsigned* p, unsigned v) { return __hip_atomic_fetch_add(p, v, __ATOMIC_RELAXED, __HIP_MEMORY_SCOPE_AGENT); }
__device__ __forceinline__ unsigned xb_xcc_id() { return (unsigned)__builtin_amdgcn_s_getreg((3 << 11) | 20) & 0xFu; }
#define XB_SPIN(cond, bar) do { unsigned _sp = 0; while (cond) { __builtin_amdgcn_s_sleep(1); \
    if ((++_sp & 255u) == 0u) { if (xb_ld(&(bar)[XB_TMO])) break; if (_sp > XB_SPIN_CAP) { atomicAdd(&(bar)[XB_TMO], 1u); break; } } } } while (0)
struct XcdBarrier { unsigned* bar; unsigned x; volatile LAS unsigned* st; };
__device__ __forceinline__ XcdBarrier xcd_barrier_post(unsigned* bar, volatile LAS unsigned* st) {
    XcdBarrier b; b.bar = bar; b.x = xb_xcc_id(); b.st = st;
    if (threadIdx.x == 0) (void)xb_add(&bar[XB_XCNT(b.x)], 1u);
    return b;
}
__device__ __forceinline__ void xcd_barrier_complete(unsigned* bar, unsigned x, unsigned& nloc, unsigned& nx) {
    const unsigned G = gridDim.x;
    unsigned sum, cnt, mine, sp = 0u;
    for (;;) {
        sum = 0u; cnt = 0u; mine = 0u;
#pragma unroll
        for (unsigned j = 0; j < 16; ++j) { const unsigned c = xb_ld(&bar[XB_XCNT(j)]); sum += c; cnt += (c > 0u) ? 1u : 0u; mine = (j == x) ? c : mine; }
        if (sum == G) break;
        __builtin_amdgcn_s_sleep(1);
        if ((++sp & 255u) == 0u) { if (xb_ld(&bar[XB_TMO])) break; if (sp > XB_SPIN_CAP) { atomicAdd(&bar[XB_TMO], 1u); break; } }
    }
    nloc = mine > 0u ? mine : 1u; nx = cnt > 0u ? cnt : 1u;
}
__device__ __forceinline__ void xcd_barrier(const XcdBarrier& b) {
    asm volatile("s_waitcnt vmcnt(0)" ::: "memory");
    __syncthreads();
    if (threadIdx.x == 0) {
        unsigned* bar = b.bar;
        __builtin_amdgcn_s_waitcnt(0);
        unsigned nloc = b.st[0], nx = b.st[1];
        if (nloc == 0u) { xcd_barrier_complete(bar, b.x, nloc, nx); b.st[0] = nloc; b.st[1] = nx; }
        const unsigned old = xb_add(&bar[XB_XSUB(b.x)], 1u);
        const unsigned gen = old / nloc;
        if (old + 1u == (gen + 1u) * nloc) {
            __builtin_amdgcn_fence(__ATOMIC_RELEASE, "agent");
            asm volatile("s_waitcnt vmcnt(0)" ::: "memory");
            const unsigned og = xb_add(&bar[XB_TOP], 1u);
            const unsigned tg = og / nx;
            if (og + 1u == (tg + 1u) * nx) xb_add(&bar[XB_TOPGEN], 1u);
            else XB_SPIN(xb_ld(&bar[XB_TOPGEN]) == tg, bar);
            __builtin_amdgcn_fence(__ATOMIC_ACQUIRE, "agent");
            xb_add(&bar[XB_XGEN(b.x)], 1u);
            asm volatile("s_waitcnt vmcnt(0)" ::: "memory");
        } else {
            XB_SPIN(xb_ld(&bar[XB_XGEN(b.x)]) == gen, bar);
            __builtin_amdgcn_fence(__ATOMIC_ACQUIRE, "agent");
            asm volatile("s_waitcnt vmcnt(0)" ::: "memory");
        }
    }
    __syncthreads();
}

#ifndef PROBE_PHASE
#define PROBE_PHASE -1
#endif
#define PH_BEGIN(k) if (PROBE_PHASE == (k)) probe_t0 = __builtin_amdgcn_s_memrealtime();
#define PH_END(k)   if (PROBE_PHASE == (k)) probe_dt = __builtin_amdgcn_s_memrealtime() - probe_t0;
constexpr int SMEM_BYTES = 128 * 132 * 4;

__global__ void __launch_bounds__(256, 2) fwd_megakernel(Params p) {
    __shared__ __attribute__((aligned(16))) unsigned char smem[SMEM_BYTES + 16];
    if (threadIdx.x == 0) *(uint4*)(smem + SMEM_BYTES) = make_uint4(0u, 0u, 0u, 0u);
    __syncthreads();
    const XcdBarrier xb = xcd_barrier_post((unsigned*)(p.ws + OFF_BAR), (volatile LAS unsigned*)(smem + SMEM_BYTES));
    const int bid = blockIdx.x, nb = gridDim.x, tid = tidx(), lane = tid & 63, wid = tid >> 6;
    unsigned char* ws = p.ws; unsigned char* dob = (unsigned char*)p.out;
    unsigned long long probe_t0 = 0, probe_dt = 0;
    PH_BEGIN(0)
    {
        for (int u = bid; u < 3232; u += nb) {
            if (u < 1600) convT_tile(p.w_in, (bf16_t*)(ws + OFF_WINT), 1024, INW, u, smem);
            else if (u < 1856) convT_tile(p.w_mem_kv, (bf16_t*)(ws + OFF_WMKVT), 1024, 1024, u - 1600, smem);
            else if (u < 2048) convT_tile(p.p_attn, (bf16_t*)(ws + OFF_PATTNT), 768, 1024, u - 1856, smem);
            else if (u < 2240) convT_tile(p.p_lru, (bf16_t*)(ws + OFF_PLRUT), 768, 1024, u - 2048, smem);
            else if (u < 2368) convT_tile(p.p_mem, (bf16_t*)(ws + OFF_PMEMT), 512, 1024, u - 2240, smem);
            else if (u < 2624) convT_tile(p.w_out, (bf16_t*)(ws + OFF_WOUTT), 1024, 1024, u - 2368, smem);
            else if (u < 3136) convT_tile(p.w_peer_q, (bf16_t*)(ws + OFF_WPQT), 1024, 2048, u - 2624, smem);
            else {
                const int v = u - 3136, mat = v >> 2, tile = v & 3, gsel = mat / 6, h = mat % 6, dir = gsel & 1;
                const float* src = (gsel < 2 ? p.lru_wr : p.lru_wi) + (size_t)(dir * 6 + h) * 128 * 128;
                convT_tile(src, (bf16_t*)(ws + OFF_LRUWT) + (size_t)(h * 512 + gsel * 128) * 128, 128, 128, tile, smem);
            }
        }
        conv_plain(p.peer_sub_keys, (bf16_t*)(ws + OFF_SUBK), (size_t)16 * 128 * 128 / 8);
        for (int r = bid * 4 + wid; r < 2 * NEXP; r += nb * 4) {
            if (r < NEXP) conv_row_fp8(p.peer_u, ws + OFF_UB, (float*)(ws + OFF_SU), r, lane);
            else conv_row_fp8(p.peer_v, ws + OFF_VB, (float*)(ws + OFF_SV), r - NEXP, lane);
        }
        for (int r = bid * 4 + wid; r < NTOK; r += nb * 4) rms_row_bf16(p.x + (size_t)r * 1024, p.g_mix, (bf16_t*)(dob + DO_HBF) + (size_t)r * 1024, lane);
        for (int r = bid * 4 + wid; r < NMEM; r += nb * 4) rms_row_bf16(p.mem + (size_t)r * 1024, p.g_mem, (bf16_t*)(dob + DO_MEMBF) + (size_t)r * 1024, lane);
        for (int i = bid * 256 + tid; i < NTOK * 16; i += nb * 256) rope_item(p.positions, (float*)(dob + DO_ROPE), i);
    }
    xcd_barrier(xb);
    PH_END(0) PH_BEGIN(1)
    for (int u = bid; u < 256 * 50 + 256; u += nb) {
        if (u < 256 * 50) inproj_tile(p, u / 50, u % 50, smem);
        else memkv_tile(p, (u - 256 * 50) / 8, (u - 256 * 50) % 8, smem);
    }
    xcd_barrier(xb);
    PH_END(1) PH_BEGIN(2)
    {
        unsigned* ctr = (unsigned*)(p.ws + OFF_BAR) + 3600;
        volatile LAS unsigned* slot = (volatile LAS unsigned*)(smem + SMEM_BYTES + 8);
        for (;;) {
            if (tid == 0) *slot = xb_add(ctr, 1u);
            __syncthreads();
            const int u = (int)*slot;
            __syncthreads();
            if (u >= 384 + 3072 + 2048) break;
            if (u < 384) lru_unit(p, u, smem);
            else if (u < 384 + 3072) attn_win_unit(p, u - 384);
            else attn_mem_unit(p, u - 384 - 3072);
        }
    }
    xcd_barrier(xb);
    PH_END(2) PH_BEGIN(3)
    for (int u = bid; u < 256 * 8; u += nb) merge_tile(p, u / 8, u % 8, smem);
    xcd_barrier(xb);
    PH_END(3) PH_BEGIN(4)
    for (int u = bid; u < 256 * 8; u += nb) outproj_tile(p, u / 8, u % 8, smem);
    xcd_barrier(xb);
    PH_END(4) PH_BEGIN(5)
    for (int r = bid * 4 + wid; r < NTOK; r += nb * 4) rms_row_bf16(p.out + (size_t)r * 1024, p.g_ffn, (bf16_t*)(ws + OFF_MERGED) + (size_t)r * 1024, lane);
    xcd_barrier(xb);
    PH_END(5) PH_BEGIN(6)
    for (int u = bid; u < 256 * 16; u += nb) peerq_tile(p, u / 16, u % 16, smem);
    xcd_barrier(xb);
    PH_END(6) PH_BEGIN(7)
    for (int u = bid; u < 256 * 16; u += nb) scores_tile(p, u / 16, u % 16, smem);
    xcd_barrier(xb);
    PH_END(7) PH_BEGIN(8)
    for (int i = bid * 256 + tid; i < NTOK * 8; i += nb * 256) combine_item(p, i);
    xcd_barrier(xb);
    PH_END(8) PH_BEGIN(9)
    for (int t = bid * 4 + wid; t < NTOK; t += nb * 4) gather_token(p, t, lane);
    PH_END(9)
    if (PROBE_PHASE >= 0) { __syncthreads(); const unsigned long long t1 = __builtin_amdgcn_s_memrealtime(); while (__builtin_amdgcn_s_memrealtime() - t1 < probe_dt) __builtin_amdgcn_s_sleep(8); }
}

extern "C" void kernel_launch(void* const* d_in, const int* in_sizes, int n_in, void* d_out, int out_size, void* d_ws, size_t ws_size, hipStream_t stream) {
    if (ws_size < OFF_END) { fprintf(stderr, "workspace too small: %zu < %zu\n", ws_size, (size_t)OFF_END); return; }
    Params p{};
    p.x = (const float*)d_in[0]; p.mem = (const float*)d_in[1]; p.positions = (const int*)d_in[2];
    p.g_mix = (const float*)d_in[3]; p.g_mem = (const float*)d_in[4]; p.w_in = (const float*)d_in[5]; p.gate_b = (const float*)d_in[6];
    p.attn_sink = (const float*)d_in[7]; p.conv_w = (const float*)d_in[8]; p.conv_b = (const float*)d_in[9];
    p.lru_wr = (const float*)d_in[10]; p.lru_br = (const float*)d_in[11]; p.lru_wi = (const float*)d_in[12]; p.lru_bi = (const float*)d_in[13];
    p.lru_lambda = (const float*)d_in[14]; p.w_mem_kv = (const float*)d_in[15]; p.p_attn = (const float*)d_in[16]; p.p_lru = (const float*)d_in[17];
    p.p_mem = (const float*)d_in[18]; p.w_out = (const float*)d_in[19]; p.g_ffn = (const float*)d_in[20]; p.w_peer_q = (const float*)d_in[21];
    p.peer_sub_keys = (const float*)d_in[22]; p.peer_u = (const float*)d_in[23]; p.peer_v = (const float*)d_in[24]; p.g_final = (const float*)d_in[25];
    p.out = (float*)d_out; p.ws = (unsigned char*)d_ws;
    static int grid_blocks = 0;
    if (!grid_blocks) {
        int dev = 0, cus = 0, per_cu = 0;
        (void)hipGetDevice(&dev);
        (void)hipDeviceGetAttribute(&cus, hipDeviceAttributeMultiprocessorCount, dev);
        (void)hipOccupancyMaxActiveBlocksPerMultiprocessor(&per_cu, fwd_megakernel, 256, 0);
        if (per_cu > 2) per_cu = 2;
        grid_blocks = cus * per_cu;
    }
    (void)hipMemsetAsync((unsigned char*)d_ws + OFF_BAR, 0, 16384, stream);
    void* args[] = {&p};
    hipError_t e = hipLaunchCooperativeKernel((void*)fwd_megakernel, dim3(grid_blocks), dim3(256), args, 0, stream);
    if (e != hipSuccess) fprintf(stderr, "cooperative launch failed: %s (grid %d)\n", hipGetErrorString(e), grid_blocks);
}
```

```cpp
#include <hip/hip_runtime.h>
#include <stdint.h>
#include <stdio.h>

typedef unsigned short bf16_t;
typedef short bf16x8 __attribute__((ext_vector_type(8)));
typedef __bf16 bf16x2v __attribute__((ext_vector_type(2)));
typedef float f32x4 __attribute__((ext_vector_type(4)));

constexpr int B_ = 16, S_ = 2048, D_ = 1024, NTOK = B_ * S_;
constexpr int MEML = 256, NMEM = B_ * MEML;
constexpr int INW = 6400;
constexpr int LW = 768;
constexpr int NEXP = 16384;
constexpr float EPS = 1e-6f;
constexpr float QSCALE = 0.08838834764831845f * 1.4426950408889634f;

constexpr size_t OFF_WINT = 0;
constexpr size_t OFF_WMKVT = OFF_WINT + (size_t)INW * 1024 * 2;
constexpr size_t OFF_PATTNT = OFF_WMKVT + (size_t)1024 * 1024 * 2;
constexpr size_t OFF_PLRUT = OFF_PATTNT + (size_t)1024 * 768 * 2;
constexpr size_t OFF_PMEMT = OFF_PLRUT + (size_t)1024 * 768 * 2;
constexpr size_t OFF_WOUTT = OFF_PMEMT + (size_t)1024 * 512 * 2;
constexpr size_t OFF_WPQT = OFF_WOUTT + (size_t)1024 * 1024 * 2;
constexpr size_t OFF_LRUWT = OFF_WPQT + (size_t)2048 * 1024 * 2;
constexpr size_t OFF_SUBK = OFF_LRUWT + (size_t)6 * 512 * 128 * 2;
constexpr size_t OFF_UB = OFF_SUBK + (size_t)16 * 128 * 128 * 2;
constexpr size_t OFF_VB = OFF_UB + (size_t)NEXP * 1024;
constexpr size_t OFF_SU = OFF_VB + (size_t)NEXP * 1024;
constexpr size_t OFF_SV = OFF_SU + (size_t)NEXP * 4;
constexpr size_t OFF_RA = OFF_SV + (size_t)NEXP * 4;
constexpr size_t OFF_QA = OFF_RA;
constexpr size_t OFF_KA = OFF_QA + (size_t)NTOK * 768 * 2;
constexpr size_t OFF_VAT = OFF_KA + (size_t)NTOK * 256 * 2;
constexpr size_t OFF_XL = OFF_VAT + (size_t)NTOK * 256 * 2;
constexpr size_t OFF_GL = OFF_XL + (size_t)NTOK * 768 * 2;
constexpr size_t OFF_QM = OFF_GL + (size_t)NTOK * 768 * 2;
constexpr size_t OFF_GATES = OFF_QM + (size_t)NTOK * 512 * 2;
constexpr size_t OFF_BAR = OFF_GATES + (size_t)NTOK * 3072 * 2;
constexpr size_t OFF_END = OFF_BAR + 16384;
constexpr size_t OFF_MERGED = OFF_KA;
constexpr size_t OFF_QPEER = OFF_GATES;
constexpr size_t OFF_TOPL = OFF_QPEER + (size_t)NTOK * 2048 * 2;
constexpr size_t OFF_EIDX = OFF_TOPL + (size_t)NTOK * 256 * 4;
constexpr size_t OFF_EGATE = OFF_EIDX + (size_t)NTOK * 128 * 4;
static_assert(OFF_EGATE + (size_t)NTOK * 128 * 4 <= OFF_BAR, "overlay");
static_assert(OFF_MERGED + (size_t)NTOK * 1024 * 2 <= OFF_GL, "overlay2");
constexpr size_t DO_HBF = 0;
constexpr size_t DO_MEMBF = DO_HBF + (size_t)NTOK * 1024 * 2;
constexpr size_t DO_KM = DO_MEMBF + (size_t)NMEM * 1024 * 2;
constexpr size_t DO_VMT = DO_KM + (size_t)NMEM * 512 * 2;
constexpr size_t DO_ROPE = DO_VMT + (size_t)NMEM * 512 * 2;
static_assert(DO_ROPE + (size_t)NTOK * 32 * 4 <= (size_t)NTOK * 1024 * 4, "d_out scratch");

struct Params {
    const float *x, *mem; const int* positions;
    const float *g_mix, *g_mem, *w_in, *gate_b, *attn_sink, *conv_w, *conv_b, *lru_wr, *lru_br, *lru_wi, *lru_bi, *lru_lambda,
        *w_mem_kv, *p_attn, *p_lru, *p_mem, *w_out, *g_ffn, *w_peer_q, *peer_sub_keys, *peer_u, *peer_v, *g_final;
    float* out; unsigned char* ws;
};

__device__ __forceinline__ int tidx() { int t = threadIdx.x; asm volatile("" : "+v"(t)); return t; }
__device__ __forceinline__ float bf2f(bf16_t b) { return __uint_as_float(((unsigned)b) << 16); }
__device__ __forceinline__ float bflo(unsigned u) { return __uint_as_float(u << 16); }
__device__ __forceinline__ float bfhi(unsigned u) { return __uint_as_float(u & 0xffff0000u); }
typedef float f32x2v __attribute__((ext_vector_type(2)));
__device__ __forceinline__ unsigned pack_bf16(float lo, float hi) { const f32x2v f = {lo, hi}; return __builtin_bit_cast(unsigned, __builtin_convertvector(f, bf16x2v)); }
__device__ __forceinline__ bf16_t f2bf(float f) { return (bf16_t)(pack_bf16(f, 0.f) & 0xffffu); }
__device__ __forceinline__ f32x4 mfma16(bf16x8 a, bf16x8 b, f32x4 c) { return __builtin_amdgcn_mfma_f32_16x16x32_bf16(a, b, c, 0, 0, 0); }
__device__ __forceinline__ float sigmoidf_(float x) { return __builtin_amdgcn_rcpf(1.0f + __expf(-x)); }
__device__ __forceinline__ float gelu_tanh(float x) { const float u = 1.5957691216057308f * (x + 0.044715f * x * x * x); return x * __builtin_amdgcn_rcpf(1.0f + __expf(-u)); }
__device__ __forceinline__ float wave_sum(float v) {
#pragma unroll
    for (int o = 32; o >= 1; o >>= 1) v += __shfl_xor(v, o);
    return v;
}

__device__ void convT_tile(const float* __restrict__ src, bf16_t* __restrict__ dst, int K, int N, int tile, unsigned char* smem) {
    float* t = (float*)smem;
    const int tn = N / 64, tk = tile / tn, tnn = tile % tn, k0 = tk * 64, n0 = tnn * 64, tid = tidx();
    const int r = tid >> 4, c4 = (tid & 15) * 4;
#pragma unroll
    for (int i = 0; i < 4; ++i) {
        const int k = r + 16 * i;
        const float4 v = *(const float4*)(src + (size_t)(k0 + k) * N + n0 + c4);
        t[k * 65 + c4 + 0] = v.x; t[k * 65 + c4 + 1] = v.y; t[k * 65 + c4 + 2] = v.z; t[k * 65 + c4 + 3] = v.w;
    }
    __syncthreads();
    const int n = tid >> 2, kq = (tid & 3) * 16;
    unsigned w[8];
#pragma unroll
    for (int i = 0; i < 8; ++i) w[i] = pack_bf16(t[(kq + 2 * i) * 65 + n], t[(kq + 2 * i + 1) * 65 + n]);
    uint4* d = (uint4*)(dst + (size_t)(n0 + n) * K + k0 + kq);
    d[0] = make_uint4(w[0], w[1], w[2], w[3]); d[1] = make_uint4(w[4], w[5], w[6], w[7]);
    __syncthreads();
}


__device__ __forceinline__ void rms_row_bf16(const float* __restrict__ xr, const float* __restrict__ g, bf16_t* __restrict__ o, int lane) {
    float4 v[4]; float ss = 0.f;
#pragma unroll
    for (int i = 0; i < 4; ++i) { v[i] = *(const float4*)(xr + i * 256 + lane * 4); ss += v[i].x * v[i].x + v[i].y * v[i].y + v[i].z * v[i].z + v[i].w * v[i].w; }
    ss = wave_sum(ss);
    const float rs = rsqrtf(ss * (1.0f / 1024.0f) + EPS);
#pragma unroll
    for (int i = 0; i < 4; ++i) {
        const float4 gg = *(const float4*)(g + i * 256 + lane * 4);
        *(uint2*)(o + i * 256 + lane * 4) = make_uint2(pack_bf16(v[i].x * rs * gg.x, v[i].y * rs * gg.y), pack_bf16(v[i].z * rs * gg.z, v[i].w * rs * gg.w));
    }
}


__device__ __forceinline__ void conv_plain(const float* __restrict__ src, bf16_t* __restrict__ dst, size_t n8) {
    for (size_t i = (size_t)blockIdx.x * 256 + tidx(); i < n8; i += (size_t)gridDim.x * 256) {
        const float4 a = ((const float4*)src)[2 * i], b = ((const float4*)src)[2 * i + 1];
        ((uint4*)dst)[i] = make_uint4(pack_bf16(a.x, a.y), pack_bf16(a.z, a.w), pack_bf16(b.x, b.y), pack_bf16(b.z, b.w));
    }
}
__device__ __forceinline__ void rope_item(const int* __restrict__ pos, float* __restrict__ cs, int i) {
    const int t = i >> 4, f = i & 15;
    const float inv = powf(500000.0f, -(float)(2 * f) / 32.0f);
    const float ang = (float)pos[t] * inv;
    float s, c; sincosf(ang, &s, &c);
    cs[2 * i] = c; cs[2 * i + 1] = s;
}

__device__ __forceinline__ int swz(int row) { return (row & 3) | (((row >> 3) & 1) << 2); }

__device__ __forceinline__ void gemm_tile(const bf16_t* __restrict__ A, int lda, const bf16_t* __restrict__ Bt, int ldb, int K,
                                          f32x4 (&acc)[4][4], unsigned char* smem) {
    const int tid = tidx(), lane = tid & 63, wid = tid >> 6, wr = wid >> 1, wc = wid & 1, li = lane & 15, g = lane >> 4;
    const int srow = tid >> 3, skc = tid & 7;
    const int soff = srow * 128 + ((skc ^ swz(srow)) << 4);
    const bf16_t* ga = A + (size_t)srow * lda + skc * 8;
    const bf16_t* gb = Bt + (size_t)srow * ldb + skc * 8;
    uint4 ra[4], rb[4];
    int aoff[4], boff[4], asw[4], bsw[4];
#pragma unroll
    for (int m = 0; m < 4; ++m) { const int row = wr * 64 + m * 16 + li; aoff[m] = row * 128; asw[m] = swz(row); }
#pragma unroll
    for (int n = 0; n < 4; ++n) { const int row = wc * 64 + 32 * (n >> 1) + 8 * (li >> 2) + 4 * (n & 1) + (li & 3); boff[n] = 16384 + row * 128; bsw[n] = swz(row); }
    const int nk = K >> 6;
#pragma unroll
    for (int i = 0; i < 4; ++i) { ra[i] = *(const uint4*)(ga + (size_t)(32 * i) * lda); rb[i] = *(const uint4*)(gb + (size_t)(32 * i) * ldb); }
#pragma unroll
    for (int i = 0; i < 4; ++i) { *(uint4*)(smem + soff + i * 4096) = ra[i]; *(uint4*)(smem + 16384 + soff + i * 4096) = rb[i]; }
    __syncthreads();
    for (int kt = 0; kt < nk; ++kt) {
        const unsigned char* sb = smem + (kt & 1) * 32768;
        if (kt + 1 < nk) {
#pragma unroll
            for (int i = 0; i < 4; ++i) { ra[i] = *(const uint4*)(ga + (size_t)(32 * i) * lda + (kt + 1) * 64); rb[i] = *(const uint4*)(gb + (size_t)(32 * i) * ldb + (kt + 1) * 64); }
        }
#pragma unroll
        for (int ks = 0; ks < 2; ++ks) {
            bf16x8 af[4], bfr[4];
#pragma unroll
            for (int m = 0; m < 4; ++m) af[m] = *(const bf16x8*)(sb + aoff[m] + (((ks * 4 + g) ^ asw[m]) << 4));
#pragma unroll
            for (int n = 0; n < 4; ++n) bfr[n] = *(const bf16x8*)(sb + boff[n] + (((ks * 4 + g) ^ bsw[n]) << 4));
#pragma unroll
            for (int m = 0; m < 4; ++m)
#pragma unroll
                for (int n = 0; n < 4; ++n) acc[m][n] = mfma16(bfr[n], af[m], acc[m][n]);
        }
        if (kt + 1 < nk) {
            unsigned char* sw = smem + ((kt + 1) & 1) * 32768;
#pragma unroll
            for (int i = 0; i < 4; ++i) { *(uint4*)(sw + soff + i * 4096) = ra[i]; *(uint4*)(sw + 16384 + soff + i * 4096) = rb[i]; }
        }
        __syncthreads();
    }
}
__device__ __forceinline__ void acc_zero(f32x4 (&acc)[4][4]) {
#pragma unroll
    for (int m = 0; m < 4; ++m)
#pragma unroll
        for (int n = 0; n < 4; ++n) acc[m][n] = (f32x4){0.f, 0.f, 0.f, 0.f};
}
template <class F> __device__ __forceinline__ void epi_foreach(const f32x4 (&acc)[4][4], F&& f) {
    const int lane = tidx() & 63, wid = tidx() >> 6, wr = wid >> 1, wc = wid & 1, li = lane & 15, g = lane >> 4;
#pragma unroll
    for (int m = 0; m < 4; ++m)
#pragma unroll
        for (int pp = 0; pp < 2; ++pp) {
            float v[8];
#pragma unroll
            for (int r = 0; r < 4; ++r) { v[r] = acc[m][2 * pp][r]; v[4 + r] = acc[m][2 * pp + 1][r]; }
            f(wr * 64 + m * 16 + li, wc * 64 + 32 * pp + 8 * g, v, pp);
        }
}
__device__ __forceinline__ void store_bf16x8(bf16_t* p, const float (&v)[8]) {
    *(uint4*)p = make_uint4(pack_bf16(v[0], v[1]), pack_bf16(v[2], v[3]), pack_bf16(v[4], v[5]), pack_bf16(v[6], v[7]));
}
__device__ __forceinline__ void store_tile_T(const f32x4 (&acc)[4][4], bf16_t* __restrict__ dstT, int ldt, unsigned char* smem) {
    bf16_t* t = (bf16_t*)smem;
    epi_foreach(acc, [&](int r, int c, const float (&v)[8], int) {
#pragma unroll
        for (int e = 0; e < 8; ++e) t[(c + e) * 136 + r] = f2bf(v[e]);
    });
    __syncthreads();
#pragma unroll
    for (int i = 0; i < 8; ++i) {
        const int ch = tidx() + 256 * i, d = ch >> 4, tc = ch & 15;
        *(uint4*)(dstT + (size_t)d * ldt + tc * 8) = *(const uint4*)(smem + d * 272 + tc * 16);
    }
    __syncthreads();
}

__device__ void inproj_tile(const Params& p, int rt, int ct, unsigned char* smem) {
    unsigned char* ws = p.ws; unsigned char* dob = (unsigned char*)p.out;
    const bf16_t* hbf = (const bf16_t*)(dob + DO_HBF);
    const bf16_t* WinT = (const bf16_t*)(ws + OFF_WINT);
    f32x4 acc[4][4]; acc_zero(acc);
    gemm_tile(hbf + (size_t)rt * 128 * 1024, 1024, WinT + (size_t)ct * 128 * 1024, 1024, 1024, acc, smem);
    const int row0 = rt * 128;
    if (ct < 8) {
        const float* cs = (const float*)(dob + DO_ROPE);
        const bool isq = ct < 6;
        bf16_t* dst = isq ? (bf16_t*)(ws + OFF_QA) + ct * 128 : (bf16_t*)(ws + OFF_KA) + (ct - 6) * 128;
        const int ld = isq ? 768 : 256;
        const float sc = isq ? QSCALE : 1.0f;
        const int g = (tidx() & 63) >> 4;
        epi_foreach(acc, [&](int r, int c, float (&v)[8], int pp) {
            const int tok = row0 + r;
            if (pp == 0 && c < 32) {
                const float* csr = cs + (size_t)tok * 32 + (g & 1) * 16;
#pragma unroll
                for (int e = 0; e < 8; ++e) {
                    const float o = __shfl_xor(v[e], 32);
                    const float cc = csr[2 * e], ss = csr[2 * e + 1];
                    v[e] = (g < 2) ? (v[e] * cc - o * ss) : (v[e] * cc + o * ss);
                }
            }
#pragma unroll
            for (int e = 0; e < 8; ++e) v[e] *= sc;
            store_bf16x8(dst + (size_t)tok * ld + c, v);
        });
    } else if (ct < 10) {
        const int kvh = ct - 8, b = row0 / S_, s0 = row0 % S_;
        store_tile_T(acc, (bf16_t*)(ws + OFF_VAT) + (size_t)(b * 2 + kvh) * 128 * S_ + s0, S_, smem);
    } else if (ct < 16) {
        bf16_t* dst = (bf16_t*)(ws + OFF_XL) + (ct - 10) * 128;
        epi_foreach(acc, [&](int r, int c, float (&v)[8], int) { store_bf16x8(dst + (size_t)(row0 + r) * 768 + c, v); });
    } else if (ct < 22) {
        bf16_t* dst = (bf16_t*)(ws + OFF_GL) + (ct - 16) * 128;
        epi_foreach(acc, [&](int r, int c, float (&v)[8], int) {
#pragma unroll
            for (int e = 0; e < 8; ++e) v[e] = gelu_tanh(v[e]);
            store_bf16x8(dst + (size_t)(row0 + r) * 768 + c, v); });
    } else if (ct < 26) {
        bf16_t* dst = (bf16_t*)(ws + OFF_QM) + (ct - 22) * 128;
        epi_foreach(acc, [&](int r, int c, float (&v)[8], int) {
#pragma unroll
            for (int e = 0; e < 8; ++e) v[e] *= QSCALE;
            store_bf16x8(dst + (size_t)(row0 + r) * 512 + c, v); });
    } else {
        const int gc0 = (ct - 26) * 128;
        bf16_t* dst = (bf16_t*)(ws + OFF_GATES) + gc0;
        const float* gb = p.gate_b + gc0;
        epi_foreach(acc, [&](int r, int c, float (&v)[8], int) {
            const float4 b0 = *(const float4*)(gb + c), b1 = *(const float4*)(gb + c + 4);
            v[0] = sigmoidf_(v[0] + b0.x); v[1] = sigmoidf_(v[1] + b0.y); v[2] = sigmoidf_(v[2] + b0.z); v[3] = sigmoidf_(v[3] + b0.w);
            v[4] = sigmoidf_(v[4] + b1.x); v[5] = sigmoidf_(v[5] + b1.y); v[6] = sigmoidf_(v[6] + b1.z); v[7] = sigmoidf_(v[7] + b1.w);
            store_bf16x8(dst + (size_t)(row0 + r) * 3072 + c, v); });
    }
}

__device__ void memkv_tile(const Params& p, int rt, int ct, unsigned char* smem) {
    unsigned char* dob = (unsigned char*)p.out;
    f32x4 acc[4][4]; acc_zero(acc);
    gemm_tile((const bf16_t*)(dob + DO_MEMBF) + (size_t)rt * 128 * 1024, 1024, (const bf16_t*)(p.ws + OFF_WMKVT) + (size_t)ct * 128 * 1024, 1024, 1024, acc, smem);
    const int row0 = rt * 128;
    if (ct < 4) {
        bf16_t* dst = (bf16_t*)(dob + DO_KM) + ct * 128;
        epi_foreach(acc, [&](int r, int c, float (&v)[8], int) { store_bf16x8(dst + (size_t)(row0 + r) * 512 + c, v); });
    } else {
        const int h = ct - 4, b = row0 / MEML, m0 = row0 % MEML;
        store_tile_T(acc, (bf16_t*)(dob + DO_VMT) + (size_t)(b * 4 + h) * 128 * MEML + m0, MEML, smem);
    }
}


typedef float f32x16 __attribute__((ext_vector_type(16)));
__device__ __forceinline__ f32x16 mfma32(bf16x8 a, bf16x8 b, f32x16 c) { return __builtin_amdgcn_mfma_f32_32x32x16_bf16(a, b, c, 0, 0, 0); }
constexpr int ATT_STAGE = 16384 + 128 * 136;

template <bool WIN>
__device__ void attn_block(const bf16_t* Qg, int ldq, const bf16_t* __restrict__ Kg, int ldk, const bf16_t* __restrict__ Vtg, int ldv,
                           int q0, int kt0, int nt, float sink2, bf16_t* Og, int ldo, unsigned char* smem) {
    const int tid = tidx(), lane = tid & 63, wid = tid >> 6, r = lane & 31, hh = lane >> 5;
    const int qw = q0 + 32 * wid;
    bf16x8 qf[8];
#pragma unroll
    for (int ks = 0; ks < 8; ++ks) qf[ks] = *(const bf16x8*)(Qg + (size_t)(32 * wid + r) * ldq + ks * 16 + hh * 8);
    f32x16 o[4];
#pragma unroll
    for (int db = 0; db < 4; ++db)
#pragma unroll
        for (int e = 0; e < 16; ++e) o[db][e] = 0.f;
    float m = WIN ? sink2 : -1e30f, l = WIN ? 1.0f : 0.0f;
    const int krow = tid >> 4, kch = tid & 15, vrow = tid >> 3, vch = tid & 7;
    const int koff = krow * 256 + ((kch ^ (krow & 15)) << 4);
    const int voff = 16384 + vrow * 136 + vch * 16;
    uint4 rk[4], rv[4];
    const bf16_t* kgp = Kg + (size_t)(kt0 * 64 + krow) * ldk + kch * 8;
    const bf16_t* vgp = Vtg + (size_t)vrow * ldv + kt0 * 64 + vch * 8;
#pragma unroll
    for (int i = 0; i < 4; ++i) { rk[i] = *(const uint4*)(kgp + (size_t)(16 * i) * ldk); rv[i] = *(const uint4*)(vgp + (size_t)(32 * i) * ldv); }
#pragma unroll
    for (int i = 0; i < 4; ++i) {
        *(uint4*)(smem + koff + i * 4096) = rk[i];
        *(uint2*)(smem + voff + i * 4352) = make_uint2(rv[i].x, rv[i].y); *(uint2*)(smem + voff + i * 4352 + 8) = make_uint2(rv[i].z, rv[i].w);
    }
    __syncthreads();
    for (int t = 0; t < nt; ++t) {
        const unsigned char* sb = smem + (t & 1) * ATT_STAGE;
        {
            const int tn = t + 1 < nt ? t + 1 : t;
#pragma unroll
            for (int i = 0; i < 4; ++i) { rk[i] = *(const uint4*)(kgp + (size_t)(tn * 64 + 16 * i) * ldk); rv[i] = *(const uint4*)(vgp + (size_t)(32 * i) * ldv + tn * 64); }
        }
        const int k0 = (kt0 + t) * 64;
        if (!WIN || (k0 + 63 >= qw - 128 && k0 <= qw + 159)) {
#pragma unroll
            for (int kb = 0; kb < 2; ++kb) {
                const int kb0 = k0 + 32 * kb;
                if (WIN && !(kb0 + 31 >= qw - 128 && kb0 <= qw + 159)) continue;
                f32x16 s;
#pragma unroll
                for (int e = 0; e < 16; ++e) s[e] = 0.f;
                const int row = kb * 32 + r;
#pragma unroll
                for (int ks = 0; ks < 8; ++ks) {
                    const bf16x8 a = *(const bf16x8*)(sb + row * 256 + (((2 * ks + hh) ^ (row & 15)) << 4));
                    s = mfma32(a, qf[ks], s);
                }
                if (WIN && !(kb0 >= qw - 97 && kb0 + 31 <= qw + 128)) {
#pragma unroll
                    for (int e = 0; e < 16; ++e) {
                        const int d = kb0 + (e & 3) + 8 * (e >> 2) + 4 * hh - (qw + r);
                        s[e] = (d <= 128 && d >= -128) ? s[e] : -1e30f;
                    }
                }
                float mx = s[0];
#pragma unroll
                for (int e = 1; e < 16; ++e) mx = fmaxf(mx, s[e]);
                mx = fmaxf(mx, __shfl_xor(mx, 32));
                const float mnew = fmaxf(m, mx), alpha = __builtin_amdgcn_exp2f(m - mnew);
                m = mnew;
                float ps = 0.f;
#pragma unroll
                for (int e = 0; e < 16; ++e) { s[e] = __builtin_amdgcn_exp2f(s[e] - mnew); ps += s[e]; }
                ps += __shfl_xor(ps, 32);
                l = l * alpha + ps;
                if (__any(alpha != 1.0f)) {
#pragma unroll
                    for (int db = 0; db < 4; ++db)
#pragma unroll
                        for (int e = 0; e < 16; ++e) o[db][e] *= alpha;
                }
#pragma unroll
                for (int s2 = 0; s2 < 2; ++s2) {
                    union { unsigned u[4]; bf16x8 v; } pb;
#pragma unroll
                    for (int e = 0; e < 4; ++e) pb.u[e] = pack_bf16(s[8 * s2 + 2 * e], s[8 * s2 + 2 * e + 1]);
#pragma unroll
                    for (int db = 0; db < 4; ++db) {
                        const unsigned char* vp = sb + 16384 + (db * 32 + r) * 136 + (kb * 32 + 16 * s2 + 4 * hh) * 2;
                        union { uint2 u[2]; bf16x8 v; } va;
                        va.u[0] = *(const uint2*)vp; va.u[1] = *(const uint2*)(vp + 16);
                        o[db] = mfma32(va.v, pb.v, o[db]);
                    }
                }
            }
        }
        {
            unsigned char* sw = smem + ((t + 1) & 1) * ATT_STAGE;
#pragma unroll
            for (int i = 0; i < 4; ++i) {
                *(uint4*)(sw + koff + i * 4096) = rk[i];
                *(uint2*)(sw + voff + i * 4352) = make_uint2(rv[i].x, rv[i].y); *(uint2*)(sw + voff + i * 4352 + 8) = make_uint2(rv[i].z, rv[i].w);
            }
        }
        __syncthreads();
    }
    const float inv = __builtin_amdgcn_rcpf(l);
    bf16_t* orow = Og + (size_t)(32 * wid + r) * ldo + 4 * hh;
#pragma unroll
    for (int db = 0; db < 4; ++db)
#pragma unroll
        for (int gq = 0; gq < 4; ++gq)
            *(uint2*)(orow + db * 32 + 8 * gq) = make_uint2(pack_bf16(o[db][4 * gq] * inv, o[db][4 * gq + 1] * inv), pack_bf16(o[db][4 * gq + 2] * inv, o[db][4 * gq + 3] * inv));
}
__device__ void attn_win_unit(const Params& p, int u, unsigned char* smem) {
    const int gh = u % 3, qb = (u / 3) % 16, kvh = (u / 48) % 2, b = u / 96, head = kvh * 3 + gh;
    const int q0 = qb * 128;
    const int ks = q0 - 128 < 0 ? 0 : q0 - 128, ke = q0 + 256 > S_ ? S_ : q0 + 256;
    bf16_t* Q = (bf16_t*)(p.ws + OFF_QA) + (size_t)(b * S_ + q0) * 768 + head * 128;
    const bf16_t* Kb = (const bf16_t*)(p.ws + OFF_KA) + (size_t)(b * S_) * 256 + kvh * 128;
    const bf16_t* Vt = (const bf16_t*)(p.ws + OFF_VAT) + (size_t)(b * 2 + kvh) * 128 * S_;
    attn_block<true>(Q, 768, Kb, 256, Vt, S_, q0, ks / 64, (ke - ks) / 64, p.attn_sink[head] * 1.4426950408889634f, Q, 768, smem);
}
__device__ void attn_mem_unit(const Params& p, int u, unsigned char* smem) {
    const int qb = u % 16, head = (u / 16) % 4, b = u / 64;
    const int q0 = qb * 128;
    unsigned char* dob = (unsigned char*)p.out;
    bf16_t* Q = (bf16_t*)(p.ws + OFF_QM) + (size_t)(b * S_ + q0) * 512 + head * 128;
    const bf16_t* Kb = (const bf16_t*)(dob + DO_KM) + (size_t)(b * MEML) * 512 + head * 128;
    const bf16_t* Vt = (const bf16_t*)(dob + DO_VMT) + (size_t)(b * 4 + head) * 128 * MEML;
    attn_block<false>(Q, 512, Kb, 512, Vt, MEML, q0, 0, 4, 0.f, Q, 512, smem);
}

__device__ __forceinline__ void lru_load_x(unsigned (&xw)[19], const bf16_t* __restrict__ Xl, int sbase, int cch) {
#pragma unroll
    for (int i = 0; i < 19; ++i) {
        const int s = sbase + i - 2;
        xw[i] = (s >= 0 && s < S_) ? *(const unsigned*)(Xl + (size_t)s * 768 + cch) : 0u;
    }
}
__device__ void lru_unit(const Params& p, int u, unsigned char* smem) {
    const int tid = tidx(), lane = tid & 63, wid = tid >> 6, li = lane & 15, g = lane >> 4;
    const int qt = u & 3, h = (u >> 2) % 6, b = u / 24;
    const int cbase = h * 128, cq0 = cbase + qt * 32;
    unsigned char* xcs = smem; unsigned char* wl = smem + 16384;
    float* pre = (float*)(smem + 32768); float* xcf = (float*)(smem + 49152);
    float* cA = (float*)(smem + 57344); float* cH = cA + 256; float* h0 = cH + 256;
    const bf16_t* Xl = (const bf16_t*)(p.ws + OFF_XL) + (size_t)(b * S_) * 768;
    bf16_t* Gl = (bf16_t*)(p.ws + OFF_GL) + (size_t)(b * S_) * 768;
    bf16_t* Hf = (bf16_t*)((unsigned char*)p.out + DO_HBF) + (size_t)(b * S_) * 768;
    const bf16_t* LruWt = (const bf16_t*)(p.ws + OFF_LRUWT);
    const int cp = tid & 63, tq = tid >> 6, cch = cbase + 2 * cp;
    float cw[4][2];
#pragma unroll
    for (int j = 0; j < 4; ++j) { cw[j][0] = p.conv_w[j * LW + cch]; cw[j][1] = p.conv_w[j * LW + cch + 1]; }
    const float cb0 = p.conv_b[cch], cb1 = p.conv_b[cch + 1];
    const int sc_c = tid & 31, sub = tid >> 5, sch = cq0 + sc_c;
    for (int dir = 0; dir < 2; ++dir) {
        __syncthreads();
#pragma unroll
        for (int i = 0; i < 4; ++i) {
            const int ch = tid + 256 * i, j = ch >> 4, kc = ch & 15;
            const int srcrow = h * 512 + ((j >> 5) * 2 + dir) * 128 + qt * 32 + (j & 31);
            *(uint4*)(wl + j * 256 + ((kc ^ (j & 15)) << 4)) = *(const uint4*)(LruWt + (size_t)srcrow * 128 + kc * 8);
        }
        const float br = p.lru_br[dir * LW + sch], bi = p.lru_bi[dir * LW + sch];
        const float lam = p.lru_lambda[dir * LW + sch];
        const float sp8 = -8.0f * log1pf(__expf(-lam));
        if (tid < 32) h0[tid] = 0.f;
        unsigned xw[19];
        lru_load_x(xw, Xl, (dir ? 31 : 0) * 64 + 16 * tq, cch);
        for (int ci = 0; ci < 32; ++ci) {
            const int chunk = dir ? 31 - ci : ci, s0 = chunk * 64;
#pragma unroll
            for (int i = 0; i < 16; ++i) {
                const int t = 16 * tq + i;
                const float y0 = cb0 + cw[0][0] * bflo(xw[i]) + cw[1][0] * bflo(xw[i + 1]) + cw[2][0] * bflo(xw[i + 2]) + cw[3][0] * bflo(xw[i + 3]);
                const float y1 = cb1 + cw[0][1] * bfhi(xw[i]) + cw[1][1] * bfhi(xw[i + 1]) + cw[2][1] * bfhi(xw[i + 2]) + cw[3][1] * bfhi(xw[i + 3]);
                *(unsigned*)(xcs + t * 256 + (((cp >> 2) ^ (t & 15)) << 4) + (cp & 3) * 4) = pack_bf16(y0, y1);
                if ((cp >> 4) == qt) { xcf[t * 32 + 2 * (cp & 15)] = y0; xcf[t * 32 + 2 * (cp & 15) + 1] = y1; }
            }
            if (ci + 1 < 32) lru_load_x(xw, Xl, (dir ? 30 - ci : ci + 1) * 64 + 16 * tq, cch);
            float hfv[8], glv[8];
            if (dir) {
#pragma unroll
                for (int k = 0; k < 8; ++k) {
                    const size_t gi = (size_t)(s0 + 63 - (sub * 8 + k)) * 768 + sch;
                    hfv[k] = bf2f(Hf[gi]); glv[k] = bf2f(Gl[gi]);
                }
            }
            __syncthreads();
            {
                f32x4 a[4];
#pragma unroll
                for (int n = 0; n < 4; ++n) a[n] = (f32x4){0.f, 0.f, 0.f, 0.f};
#pragma unroll
                for (int ks = 0; ks < 4; ++ks) {
                    const int row = wid * 16 + li;
                    const bf16x8 xf = *(const bf16x8*)(xcs + row * 256 + (((ks * 4 + g) ^ (row & 15)) << 4));
#pragma unroll
                    for (int n = 0; n < 4; ++n) {
                        const int j = n * 16 + li;
                        const bf16x8 wf = *(const bf16x8*)(wl + j * 256 + (((ks * 4 + g) ^ (j & 15)) << 4));
                        a[n] = mfma16(xf, wf, a[n]);
                    }
                }
#pragma unroll
                for (int n = 0; n < 4; ++n)
#pragma unroll
                    for (int r = 0; r < 4; ++r) pre[(wid * 16 + 4 * g + r) * 64 + n * 16 + li] = a[n][r];
            }
            __syncthreads();
            float hl[8], ap[8];
            {
                float hh = 0.f, aa = 1.f;
#pragma unroll
                for (int k = 0; k < 8; ++k) {
                    const int pp = sub * 8 + k, t = dir ? 63 - pp : pp;
                    const float r = sigmoidf_(pre[t * 64 + sc_c] + br), ig = sigmoidf_(pre[t * 64 + 32 + sc_c] + bi);
                    const float a = __expf(sp8 * r);
                    const float bx = sqrtf(fmaxf(1.0f - a * a, 0.f)) * (ig * xcf[t * 32 + sc_c]);
                    hh = a * hh + bx; aa *= a; hl[k] = hh; ap[k] = aa;
                }
                cA[sub * 32 + sc_c] = aa; cH[sub * 32 + sc_c] = hh;
            }
            __syncthreads();
            {
                float hin = h0[(ci & 1) * 32 + sc_c];
                for (int s2 = 0; s2 < sub; ++s2) hin = cA[s2 * 32 + sc_c] * hin + cH[s2 * 32 + sc_c];
#pragma unroll
                for (int k = 0; k < 8; ++k) {
                    const int pp = sub * 8 + k, t = dir ? 63 - pp : pp;
                    const float hv = hl[k] + ap[k] * hin;
                    const size_t gi = (size_t)(s0 + t) * 768 + sch;
                    if (dir == 0) Hf[gi] = f2bf(hv);
                    else Gl[gi] = f2bf((hfv[k] + hv) * glv[k]);
                    if (k == 7 && sub == 7) h0[((ci + 1) & 1) * 32 + sc_c] = hv;
                }
            }
        }
    }
    __syncthreads();
}

__device__ void merge_tile(const Params& p, int rt, int ct, unsigned char* smem) {
    unsigned char* ws = p.ws;
    const int row0 = rt * 128, col0 = ct * 128;
    uint4 tot[4][2];
    const bf16_t* G = (const bf16_t*)(ws + OFF_GATES);
    const int lane = tidx() & 63, wid = tidx() >> 6, wr = wid >> 1, wc = wid & 1, li = lane & 15, g = lane >> 4;
#pragma unroll 1
    for (int br = 0; br < 3; ++br) {
        const bf16_t* Ab = (const bf16_t*)(ws + (br == 0 ? OFF_QA : (br == 1 ? OFF_GL : OFF_QM)));
        const bf16_t* Bb = (const bf16_t*)(ws + (br == 0 ? OFF_PATTNT : (br == 1 ? OFF_PLRUT : OFF_PMEMT)));
        const int Kb = br == 2 ? 512 : 768;
        f32x4 acc[4][4]; acc_zero(acc);
        gemm_tile(Ab + (size_t)row0 * Kb, Kb, Bb + (size_t)col0 * Kb, Kb, Kb, acc, smem);
#pragma unroll
        for (int m = 0; m < 4; ++m)
#pragma unroll
            for (int pp = 0; pp < 2; ++pp) {
                const int r = wr * 64 + m * 16 + li, c = wc * 64 + 32 * pp + 8 * g;
                const uint4 gv = *(const uint4*)(G + (size_t)(row0 + r) * 3072 + br * 1024 + col0 + c);
                float v[8];
                v[0] = bflo(gv.x) * acc[m][2 * pp][0]; v[1] = bfhi(gv.x) * acc[m][2 * pp][1];
                v[2] = bflo(gv.y) * acc[m][2 * pp][2]; v[3] = bfhi(gv.y) * acc[m][2 * pp][3];
                v[4] = bflo(gv.z) * acc[m][2 * pp + 1][0]; v[5] = bfhi(gv.z) * acc[m][2 * pp + 1][1];
                v[6] = bflo(gv.w) * acc[m][2 * pp + 1][2]; v[7] = bfhi(gv.w) * acc[m][2 * pp + 1][3];
                if (br > 0) {
                    const uint4 t = tot[m][pp];
                    v[0] += bflo(t.x); v[1] += bfhi(t.x); v[2] += bflo(t.y); v[3] += bfhi(t.y);
                    v[4] += bflo(t.z); v[5] += bfhi(t.z); v[6] += bflo(t.w); v[7] += bfhi(t.w);
                }
                tot[m][pp] = make_uint4(pack_bf16(v[0], v[1]), pack_bf16(v[2], v[3]), pack_bf16(v[4], v[5]), pack_bf16(v[6], v[7]));
            }
    }
    bf16_t* dst = (bf16_t*)(ws + OFF_MERGED) + col0;
#pragma unroll
    for (int m = 0; m < 4; ++m)
#pragma unroll
        for (int pp = 0; pp < 2; ++pp) {
            const int r = wr * 64 + m * 16 + li, c = wc * 64 + 32 * pp + 8 * g;
            *(uint4*)(dst + (size_t)(row0 + r) * 1024 + c) = tot[m][pp];
        }
}
__device__ void outproj_tile(const Params& p, int rt, int ct, unsigned char* smem) {
    const int row0 = rt * 128, col0 = ct * 128;
    f32x4 acc[4][4]; acc_zero(acc);
    gemm_tile((const bf16_t*)(p.ws + OFF_MERGED) + (size_t)row0 * 1024, 1024, (const bf16_t*)(p.ws + OFF_WOUTT) + (size_t)col0 * 1024, 1024, 1024, acc, smem);
    epi_foreach(acc, [&](int r, int c, float (&v)[8], int) {
        const size_t o = (size_t)(row0 + r) * 1024 + col0 + c;
        const float4 x0 = *(const float4*)(p.x + o), x1 = *(const float4*)(p.x + o + 4);
        *(float4*)(p.out + o) = make_float4(x0.x + v[0], x0.y + v[1], x0.z + v[2], x0.w + v[3]);
        *(float4*)(p.out + o + 4) = make_float4(x1.x + v[4], x1.y + v[5], x1.z + v[6], x1.w + v[7]);
    });
}

__device__ void peerq_tile(const Params& p, int rt, int ct, unsigned char* smem) {
    const int row0 = rt * 128, col0 = ct * 128;
    f32x4 acc[4][4]; acc_zero(acc);
    gemm_tile((const bf16_t*)(p.ws + OFF_MERGED) + (size_t)row0 * 1024, 1024, (const bf16_t*)(p.ws + OFF_WPQT) + (size_t)col0 * 1024, 1024, 1024, acc, smem);
    bf16_t* dst = (bf16_t*)(p.ws + OFF_QPEER) + col0;
    epi_foreach(acc, [&](int r, int c, float (&v)[8], int) { store_bf16x8(dst + (size_t)(row0 + r) * 2048 + c, v); });
}

__device__ __forceinline__ int sortable(float v) { int k = __float_as_int(v); return k ^ ((k >> 31) & 0x7fffffff); }
__device__ __forceinline__ float unsortable(int k) { return __int_as_float(k ^ ((k >> 31) & 0x7fffffff)); }
__device__ __forceinline__ void insert16(int (&lst)[16], int x) {
#pragma unroll
    for (int k = 0; k < 16; ++k) { const int hi = max(lst[k], x); x = min(lst[k], x); lst[k] = hi; }
}
__device__ void scores_tile(const Params& p, int rt, int pq, unsigned char* smem) {
    const int row0 = rt * 128;
    f32x4 acc[4][4]; acc_zero(acc);
    gemm_tile((const bf16_t*)(p.ws + OFF_QPEER) + (size_t)row0 * 2048 + pq * 128, 2048, (const bf16_t*)(p.ws + OFF_SUBK) + (size_t)pq * 128 * 128, 128, 128, acc, smem);
    float* sc = (float*)smem;
    epi_foreach(acc, [&](int r, int c, float (&v)[8], int) {
        *(float4*)(sc + r * 132 + c) = make_float4(v[0], v[1], v[2], v[3]);
        *(float4*)(sc + r * 132 + c + 4) = make_float4(v[4], v[5], v[6], v[7]); });
    __syncthreads();
    if (tidx() < 128) {
        const int r = tidx();
        int lst[16];
#pragma unroll
        for (int k = 0; k < 16; ++k) lst[k] = (int)0x80000000;
#pragma unroll 2
        for (int j4 = 0; j4 < 32; ++j4) {
            const float4 v = *(const float4*)(sc + r * 132 + j4 * 4);
            insert16(lst, (sortable(v.x) & ~127) | (j4 * 4 + 0));
            insert16(lst, (sortable(v.y) & ~127) | (j4 * 4 + 1));
            insert16(lst, (sortable(v.z) & ~127) | (j4 * 4 + 2));
            insert16(lst, (sortable(v.w) & ~127) | (j4 * 4 + 3));
        }
        int4* dst = (int4*)((int*)(p.ws + OFF_TOPL) + ((size_t)(row0 + r) * 16 + pq) * 16);
        dst[0] = make_int4(lst[0], lst[1], lst[2], lst[3]); dst[1] = make_int4(lst[4], lst[5], lst[6], lst[7]);
        dst[2] = make_int4(lst[8], lst[9], lst[10], lst[11]); dst[3] = make_int4(lst[12], lst[13], lst[14], lst[15]);
    }
    __syncthreads();
}

__device__ void combine_item(const Params& p, int item) {
    const int tok = item >> 3, hd = item & 7;
    const int* l0 = (const int*)(p.ws + OFF_TOPL) + ((size_t)tok * 16 + hd * 2) * 16;
    const int* l1 = l0 + 16;
    int k0[16], k1[16];
#pragma unroll
    for (int i = 0; i < 4; ++i) {
        const int4 a = ((const int4*)l0)[i], b = ((const int4*)l1)[i];
        k0[4 * i] = a.x; k0[4 * i + 1] = a.y; k0[4 * i + 2] = a.z; k0[4 * i + 3] = a.w;
        k1[4 * i] = b.x; k1[4 * i + 1] = b.y; k1[4 * i + 2] = b.z; k1[4 * i + 3] = b.w;
    }
    float v0[16], v1[16];
#pragma unroll
    for (int i = 0; i < 16; ++i) { v0[i] = unsortable(k0[i] & ~127); v1[i] = unsortable(k1[i] & ~127); }
    int lst[16];
#pragma unroll
    for (int k = 0; k < 16; ++k) lst[k] = (int)0x80000000;
#pragma unroll
    for (int a = 0; a < 16; ++a)
#pragma unroll
        for (int b = 0; b < 16; ++b)
            if ((a + 1) * (b + 1) <= 16) insert16(lst, (sortable(v0[a] + v1[b]) & ~255) | (a * 16 + b));
    float val[16], sum = 0.f;
    const float mx = unsortable(lst[0] & ~255);
#pragma unroll
    for (int k = 0; k < 16; ++k) { val[k] = __expf(unsortable(lst[k] & ~255) - mx); sum += val[k]; }
    const float inv = 1.0f / sum;
    int* ei = (int*)(p.ws + OFF_EIDX) + (size_t)tok * 128 + hd * 16;
    float* eg = (float*)(p.ws + OFF_EGATE) + (size_t)tok * 128 + hd * 16;
#pragma unroll
    for (int k = 0; k < 16; ++k) {
        const int code = lst[k] & 255, a = code >> 4, b = code & 15;
        ei[k] = (l0[a] & 127) * 128 + (l1[b] & 127);
        eg[k] = val[k] * inv;
    }
}

__device__ __forceinline__ void conv_row_fp8(const float* __restrict__ src, unsigned char* __restrict__ dst, float* __restrict__ scale, int row, int lane) {
    const float4* s = (const float4*)(src + (size_t)row * 1024 + lane * 16);
    float4 v[4]; float am = 0.f;
#pragma unroll
    for (int i = 0; i < 4; ++i) { v[i] = s[i]; am = fmaxf(am, fmaxf(fmaxf(fabsf(v[i].x), fabsf(v[i].y)), fmaxf(fabsf(v[i].z), fabsf(v[i].w)))); }
#pragma unroll
    for (int o = 32; o >= 1; o >>= 1) am = fmaxf(am, __shfl_xor(am, o));
    const float sc = am > 0.f ? am * (1.0f / 224.0f) : 1.0f, inv = 1.0f / sc;
    unsigned w[4];
#pragma unroll
    for (int i = 0; i < 4; ++i) {
        int t = __builtin_amdgcn_cvt_pk_fp8_f32(v[i].x * inv, v[i].y * inv, 0, false);
        t = __builtin_amdgcn_cvt_pk_fp8_f32(v[i].z * inv, v[i].w * inv, t, true);
        w[i] = (unsigned)t;
    }
    *(uint4*)(dst + (size_t)row * 1024 + lane * 16) = make_uint4(w[0], w[1], w[2], w[3]);
    if (lane == 0) scale[row] = sc;
}
__device__ __forceinline__ void load8rows(uint4 (&R)[8], const unsigned char* __restrict__ tab, int es, int l0, int lane) {
#pragma unroll
    for (int j = 0; j < 8; ++j) {
        const int id = __builtin_amdgcn_readlane(es, l0 + j);
        R[j] = *(const uint4*)(tab + (size_t)id * 1024 + lane * 16);
    }
}
__device__ __forceinline__ float dot16q(const uint4& r, const float (&h)[16]) {
    const unsigned q[4] = {r.x, r.y, r.z, r.w};
    float d0 = 0.f, d1 = 0.f;
#pragma unroll
    for (int i = 0; i < 4; ++i) {
        const f32x2v a = __builtin_amdgcn_cvt_pk_f32_fp8((int)q[i], false), b = __builtin_amdgcn_cvt_pk_f32_fp8((int)q[i], true);
        d0 += a.x * h[4 * i]; d1 += a.y * h[4 * i + 1]; d0 += b.x * h[4 * i + 2]; d1 += b.y * h[4 * i + 3];
    }
    return d0 + d1;
}
__device__ __forceinline__ float dots8(const uint4 (&R)[8], const float (&h)[16], int lane) {
    float pd[8];
#pragma unroll
    for (int j = 0; j < 8; ++j) pd[j] = dot16q(R[j], h);
    const bool b5 = (lane & 32) != 0, b4 = (lane & 16) != 0, b3 = (lane & 8) != 0;
    float a[4];
#pragma unroll
    for (int j = 0; j < 4; ++j) { const float keep = b5 ? pd[4 + j] : pd[j], send = b5 ? pd[j] : pd[4 + j]; a[j] = keep + __shfl_xor(send, 32); }
    float c[2];
#pragma unroll
    for (int j = 0; j < 2; ++j) { const float keep = b4 ? a[2 + j] : a[j], send = b4 ? a[j] : a[2 + j]; c[j] = keep + __shfl_xor(send, 16); }
    float kk;
    { const float keep = b3 ? c[1] : c[0], send = b3 ? c[0] : c[1]; kk = keep + __shfl_xor(send, 8); }
    kk += __shfl_xor(kk, 4); kk += __shfl_xor(kk, 2); kk += __shfl_xor(kk, 1);
    return kk;
}
__device__ __forceinline__ void axpy8(float (&o)[16], const uint4 (&R)[8], int wsr, int bb) {
#pragma unroll
    for (int j = 0; j < 8; ++j) {
        const float c = __int_as_float(__builtin_amdgcn_readlane(wsr, 8 * j + bb));
        const unsigned q[4] = {R[j].x, R[j].y, R[j].z, R[j].w};
#pragma unroll
        for (int i = 0; i < 4; ++i) {
            const f32x2v a = __builtin_amdgcn_cvt_pk_f32_fp8((int)q[i], false), b = __builtin_amdgcn_cvt_pk_f32_fp8((int)q[i], true);
            o[4 * i] += c * a.x; o[4 * i + 1] += c * a.y; o[4 * i + 2] += c * b.x; o[4 * i + 3] += c * b.y;
        }
    }
}
__device__ void gather_token(const Params& p, int tok, int lane) {
    const bf16_t* h2 = (const bf16_t*)(p.ws + OFF_MERGED) + (size_t)tok * 1024 + lane * 16;
    const unsigned char* Uq = p.ws + OFF_UB; const unsigned char* Vq = p.ws + OFF_VB;
    const float* SU = (const float*)(p.ws + OFF_SU); const float* SV = (const float*)(p.ws + OFF_SV);
    const int* ei = (const int*)(p.ws + OFF_EIDX) + (size_t)tok * 128;
    const float* eg = (const float*)(p.ws + OFF_EGATE) + (size_t)tok * 128;
    float h[16];
    {
        const uint4 ha = *(const uint4*)h2, hb = *(const uint4*)(h2 + 8);
        const unsigned hq[8] = {ha.x, ha.y, ha.z, ha.w, hb.x, hb.y, hb.z, hb.w};
#pragma unroll
        for (int e = 0; e < 8; ++e) { h[2 * e] = bflo(hq[e]); h[2 * e + 1] = bfhi(hq[e]); }
    }
    const int pe = 8 * (lane & 7) + (lane >> 3);
    int es[2], wsr[2] = {0, 0}; float su[2], gv[2];
#pragma unroll
    for (int k = 0; k < 2; ++k) {
        es[k] = ei[64 * k + lane];
        const int e = ei[64 * k + pe];
        su[k] = SU[e]; gv[k] = eg[64 * k + pe] * SV[e];
    }
    uint4 R0[8], R1[8];
#pragma unroll
    for (int k = 0; k < 2; ++k) {
        load8rows(R0, Uq, es[k], 0, lane);
        for (int bb = 0; bb < 8; bb += 2) {
            load8rows(R1, Uq, es[k], 8 * bb + 8, lane);
            { const float w = gelu_tanh(dots8(R0, h, lane) * su[k]) * gv[k]; if ((lane & 7) == bb) wsr[k] = __float_as_int(w); }
            if (bb + 2 < 8) load8rows(R0, Uq, es[k], 8 * bb + 16, lane);
            { const float w = gelu_tanh(dots8(R1, h, lane) * su[k]) * gv[k]; if ((lane & 7) == bb + 1) wsr[k] = __float_as_int(w); }
        }
    }
    float o[16];
#pragma unroll
    for (int e = 0; e < 16; ++e) o[e] = 0.f;
#pragma unroll
    for (int k = 0; k < 2; ++k) {
        load8rows(R0, Vq, es[k], 0, lane);
        for (int bb = 0; bb < 8; bb += 2) {
            load8rows(R1, Vq, es[k], 8 * bb + 8, lane);
            axpy8(o, R0, wsr[k], bb);
            if (bb + 2 < 8) load8rows(R0, Vq, es[k], 8 * bb + 16, lane);
            axpy8(o, R1, wsr[k], bb + 1);
        }
    }
    float* xr = p.out + (size_t)tok * 1024 + lane * 16;
    float4 x[4]; float ss = 0.f;
#pragma unroll
    for (int i = 0; i < 4; ++i) {
        x[i] = *(const float4*)(xr + 4 * i);
        x[i].x += o[4 * i]; x[i].y += o[4 * i + 1]; x[i].z += o[4 * i + 2]; x[i].w += o[4 * i + 3];
        ss += x[i].x * x[i].x + x[i].y * x[i].y + x[i].z * x[i].z + x[i].w * x[i].w;
    }
    ss = wave_sum(ss);
    const float rs = rsqrtf(ss * (1.0f / 1024.0f) + EPS);
    const float* gf = p.g_final + lane * 16;
#pragma unroll
    for (int i = 0; i < 4; ++i) {
        const float4 gg = *(const float4*)(gf + 4 * i);
        *(float4*)(xr + 4 * i) = make_float4(x[i].x * rs * gg.x, x[i].y * rs * gg.y, x[i].z * rs * gg.z, x[i].w * rs * gg.w);
    }
}

#define XB_TMO      128
#define XB_XCNT(j)  (256  + 64 * (j))
#define XB_XSUB(j)  (1280 + 64 * (j))
#define XB_XGEN(j)  (2304 + 64 * (j))
#define XB_TOP      3328
#define XB_TOPGEN   3392
#define XCD_BAR_WORDS 3456
#define XB_SPIN_CAP (1u << 22)
#define LAS __attribute__((address_space(3)))
__device__ __forceinline__ unsigned xb_ld(unsigned* p)              { return __hip_atomic_load(p, __ATOMIC_RELAXED, __HIP_MEMORY_SCOPE_AGENT); }
__device__ __forceinline__ unsigned xb_add(unsigned* p, unsigned v) { return __hip_atomic_fetch_add(p, v, __ATOMIC_RELAXED, __HIP_MEMORY_SCOPE_AGENT); }
__device__ __forceinline__ unsigned xb_xcc_id() { return (unsigned)__builtin_amdgcn_s_getreg((3 << 11) | 20) & 0xFu; }
#define XB_SPIN(cond, bar) do { unsigned _sp = 0; while (cond) { __builtin_amdgcn_s_sleep(1); \
    if ((++_sp & 255u) == 0u) { if (xb_ld(&(bar)[XB_TMO])) break; if (_sp > XB_SPIN_CAP) { atomicAdd(&(bar)[XB_TMO], 1u); break; } } } } while (0)
struct XcdBarrier { unsigned* bar; unsigned x; volatile LAS unsigned* st; };
__device__ __forceinline__ XcdBarrier xcd_barrier_post(unsigned* bar, volatile LAS unsigned* st) {
    XcdBarrier b; b.bar = bar; b.x = xb_xcc_id(); b.st = st;
    if (threadIdx.x == 0) (void)xb_add(&bar[XB_XCNT(b.x)], 1u);
    return b;
}
__device__ __forceinline__ void xcd_barrier_complete(unsigned* bar, unsigned x, unsigned& nloc, unsigned& nx) {
    const unsigned G = gridDim.x;
    unsigned sum, cnt, mine, sp = 0u;
    for (;;) {
        sum = 0u; cnt = 0u; mine = 0u;
#pragma unroll
        for (unsigned j = 0; j < 16; ++j) { const unsigned c = xb_ld(&bar[XB_XCNT(j)]); sum += c; cnt += (c > 0u) ? 1u : 0u; mine = (j == x) ? c : mine; }
        if (sum == G) break;
        __builtin_amdgcn_s_sleep(1);
        if ((++sp & 255u) == 0u) { if (xb_ld(&bar[XB_TMO])) break; if (sp > XB_SPIN_CAP) { atomicAdd(&bar[XB_TMO], 1u); break; } }
    }
    nloc = mine > 0u ? mine : 1u; nx = cnt > 0u ? cnt : 1u;
}
__device__ __forceinline__ void xcd_barrier(const XcdBarrier& b) {
    asm volatile("s_waitcnt vmcnt(0)" ::: "memory");
    __syncthreads();
    if (threadIdx.x == 0) {
        unsigned* bar = b.bar;
        __builtin_amdgcn_s_waitcnt(0);
        unsigned nloc = b.st[0], nx = b.st[1];
        if (nloc == 0u) { xcd_barrier_complete(bar, b.x, nloc, nx); b.st[0] = nloc; b.st[1] = nx; }
        const unsigned old = xb_add(&bar[XB_XSUB(b.x)], 1u);
        const unsigned gen = old / nloc;
        if (old + 1u == (gen + 1u) * nloc) {
            __builtin_amdgcn_fence(__ATOMIC_RELEASE, "agent");
            asm volatile("s_waitcnt vmcnt(0)" ::: "memory");
            const unsigned og = xb_add(&bar[XB_TOP], 1u);
            const unsigned tg = og / nx;
            if (og + 1u == (tg + 1u) * nx) xb_add(&bar[XB_TOPGEN], 1u);
            else XB_SPIN(xb_ld(&bar[XB_TOPGEN]) == tg, bar);
            __builtin_amdgcn_fence(__ATOMIC_ACQUIRE, "agent");
            xb_add(&bar[XB_XGEN(b.x)], 1u);
            asm volatile("s_waitcnt vmcnt(0)" ::: "memory");
        } else {
            XB_SPIN(xb_ld(&bar[XB_XGEN(b.x)]) == gen, bar);
            __builtin_amdgcn_fence(__ATOMIC_ACQUIRE, "agent");
            asm volatile("s_waitcnt vmcnt(0)" ::: "memory");
        }
    }
    __syncthreads();
}

#ifndef PROBE_PHASE
#define PROBE_PHASE -1
#endif
#define PH_BEGIN(k) if (PROBE_PHASE == (k)) probe_t0 = __builtin_amdgcn_s_memrealtime();
#define PH_END(k)   if (PROBE_PHASE == (k)) probe_dt = __builtin_amdgcn_s_memrealtime() - probe_t0;
constexpr int SMEM_BYTES = 128 * 132 * 4;

__global__ void __launch_bounds__(256, 2) fwd_megakernel(Params p) {
    __shared__ __attribute__((aligned(16))) unsigned char smem[SMEM_BYTES + 16];
    if (threadIdx.x == 0) *(uint4*)(smem + SMEM_BYTES) = make_uint4(0u, 0u, 0u, 0u);
    __syncthreads();
    const XcdBarrier xb = xcd_barrier_post((unsigned*)(p.ws + OFF_BAR), (volatile LAS unsigned*)(smem + SMEM_BYTES));
    const int bid = blockIdx.x, nb = gridDim.x, tid = tidx(), lane = tid & 63, wid = tid >> 6;
    unsigned char* ws = p.ws; unsigned char* dob = (unsigned char*)p.out;
    unsigned long long probe_t0 = 0, probe_dt = 0;
    PH_BEGIN(0)
    {
        for (int u = bid; u < 3232; u += nb) {
            if (u < 1600) convT_tile(p.w_in, (bf16_t*)(ws + OFF_WINT), 1024, INW, u, smem);
            else if (u < 1856) convT_tile(p.w_mem_kv, (bf16_t*)(ws + OFF_WMKVT), 1024, 1024, u - 1600, smem);
            else if (u < 2048) convT_tile(p.p_attn, (bf16_t*)(ws + OFF_PATTNT), 768, 1024, u - 1856, smem);
            else if (u < 2240) convT_tile(p.p_lru, (bf16_t*)(ws + OFF_PLRUT), 768, 1024, u - 2048, smem);
            else if (u < 2368) convT_tile(p.p_mem, (bf16_t*)(ws + OFF_PMEMT), 512, 1024, u - 2240, smem);
            else if (u < 2624) convT_tile(p.w_out, (bf16_t*)(ws + OFF_WOUTT), 1024, 1024, u - 2368, smem);
            else if (u < 3136) convT_tile(p.w_peer_q, (bf16_t*)(ws + OFF_WPQT), 1024, 2048, u - 2624, smem);
            else {
                const int v = u - 3136, mat = v >> 2, tile = v & 3, gsel = mat / 6, h = mat % 6, dir = gsel & 1;
                const float* src = (gsel < 2 ? p.lru_wr : p.lru_wi) + (size_t)(dir * 6 + h) * 128 * 128;
                convT_tile(src, (bf16_t*)(ws + OFF_LRUWT) + (size_t)(h * 512 + gsel * 128) * 128, 128, 128, tile, smem);
            }
        }
        conv_plain(p.peer_sub_keys, (bf16_t*)(ws + OFF_SUBK), (size_t)16 * 128 * 128 / 8);
        for (int r = bid * 4 + wid; r < 2 * NEXP; r += nb * 4) {
            if (r < NEXP) conv_row_fp8(p.peer_u, ws + OFF_UB, (float*)(ws + OFF_SU), r, lane);
            else conv_row_fp8(p.peer_v, ws + OFF_VB, (float*)(ws + OFF_SV), r - NEXP, lane);
        }
        for (int r = bid * 4 + wid; r < NTOK; r += nb * 4) rms_row_bf16(p.x + (size_t)r * 1024, p.g_mix, (bf16_t*)(dob + DO_HBF) + (size_t)r * 1024, lane);
        for (int r = bid * 4 + wid; r < NMEM; r += nb * 4) rms_row_bf16(p.mem + (size_t)r * 1024, p.g_mem, (bf16_t*)(dob + DO_MEMBF) + (size_t)r * 1024, lane);
        for (int i = bid * 256 + tid; i < NTOK * 16; i += nb * 256) rope_item(p.positions, (float*)(dob + DO_ROPE), i);
    }
    xcd_barrier(xb);
    PH_END(0) PH_BEGIN(1)
    for (int u = bid; u < 256 * 50 + 256; u += nb) {
        if (u < 256 * 50) inproj_tile(p, u / 50, u % 50, smem);
        else memkv_tile(p, (u - 256 * 50) / 8, (u - 256 * 50) % 8, smem);
    }
    xcd_barrier(xb);
    PH_END(1) PH_BEGIN(2)
    {
        unsigned* ctr = (unsigned*)(p.ws + OFF_BAR) + 3600;
        volatile LAS unsigned* slot = (volatile LAS unsigned*)(smem + SMEM_BYTES + 8);
        for (;;) {
            if (tid == 0) *slot = xb_add(ctr, 1u);
            __syncthreads();
            const int u = (int)*slot;
            __syncthreads();
            if (u >= 384 + 1536 + 1024) break;
            if (u < 384) lru_unit(p, u, smem);
            else if (u < 384 + 1536) attn_win_unit(p, u - 384, smem);
            else attn_mem_unit(p, u - 384 - 1536, smem);
        }
    }
    xcd_barrier(xb);
    PH_END(2) PH_BEGIN(3)
    for (int u = bid; u < 256 * 8; u += nb) merge_tile(p, u / 8, u % 8, smem);
    xcd_barrier(xb);
    PH_END(3) PH_BEGIN(4)
    for (int u = bid; u < 256 * 8; u += nb) outproj_tile(p, u / 8, u % 8, smem);
    xcd_barrier(xb);
    PH_END(4) PH_BEGIN(5)
    for (int r = bid * 4 + wid; r < NTOK; r += nb * 4) rms_row_bf16(p.out + (size_t)r * 1024, p.g_ffn, (bf16_t*)(ws + OFF_MERGED) + (size_t)r * 1024, lane);
    xcd_barrier(xb);
    PH_END(5) PH_BEGIN(6)
    for (int u = bid; u < 256 * 16; u += nb) peerq_tile(p, u / 16, u % 16, smem);
    xcd_barrier(xb);
    PH_END(6) PH_BEGIN(7)
    for (int u = bid; u < 256 * 16; u += nb) scores_tile(p, u / 16, u % 16, smem);
    xcd_barrier(xb);
    PH_END(7) PH_BEGIN(8)
    for (int i = bid * 256 + tid; i < NTOK * 8; i += nb * 256) combine_item(p, i);
    xcd_barrier(xb);
    PH_END(8) PH_BEGIN(9)
    for (int t = bid * 4 + wid; t < NTOK; t += nb * 4) gather_token(p, t, lane);
    PH_END(9)
    if (PROBE_PHASE >= 0) { __syncthreads(); const unsigned long long t1 = __builtin_amdgcn_s_memrealtime(); while (__builtin_amdgcn_s_memrealtime() - t1 < probe_dt) __builtin_amdgcn_s_sleep(8); }
}

extern "C" void kernel_launch(void* const* d_in, const int* in_sizes, int n_in, void* d_out, int out_size, void* d_ws, size_t ws_size, hipStream_t stream) {
    if (ws_size < OFF_END) { fprintf(stderr, "workspace too small: %zu < %zu\n", ws_size, (size_t)OFF_END); return; }
    Params p{};
    p.x = (const float*)d_in[0]; p.mem = (const float*)d_in[1]; p.positions = (const int*)d_in[2];
    p.g_mix = (const float*)d_in[3]; p.g_mem = (const float*)d_in[4]; p.w_in = (const float*)d_in[5]; p.gate_b = (const float*)d_in[6];
    p.attn_sink = (const float*)d_in[7]; p.conv_w = (const float*)d_in[8]; p.conv_b = (const float*)d_in[9];
    p.lru_wr = (const float*)d_in[10]; p.lru_br = (const float*)d_in[11]; p.lru_wi = (const float*)d_in[12]; p.lru_bi = (const float*)d_in[13];
    p.lru_lambda = (const float*)d_in[14]; p.w_mem_kv = (const float*)d_in[15]; p.p_attn = (const float*)d_in[16]; p.p_lru = (const float*)d_in[17];
    p.p_mem = (const float*)d_in[18]; p.w_out = (const float*)d_in[19]; p.g_ffn = (const float*)d_in[20]; p.w_peer_q = (const float*)d_in[21];
    p.peer_sub_keys = (const float*)d_in[22]; p.peer_u = (const float*)d_in[23]; p.peer_v = (const float*)d_in[24]; p.g_final = (const float*)d_in[25];
    p.out = (float*)d_out; p.ws = (unsigned char*)d_ws;
    static int grid_blocks = 0;
    if (!grid_blocks) {
        int dev = 0, cus = 0, per_cu = 0;
        (void)hipGetDevice(&dev);
        (void)hipDeviceGetAttribute(&cus, hipDeviceAttributeMultiprocessorCount, dev);
        (void)hipOccupancyMaxActiveBlocksPerMultiprocessor(&per_cu, fwd_megakernel, 256, 0);
        if (per_cu > 2) per_cu = 2;
        grid_blocks = cus * per_cu;
    }
    (void)hipMemsetAsync((unsigned char*)d_ws + OFF_BAR, 0, 16384, stream);
    void* args[] = {&p};
    hipError_t e = hipLaunchCooperativeKernel((void*)fwd_megakernel, dim3(grid_blocks), dim3(256), args, 0, stream);
    if (e != hipSuccess) fprintf(stderr, "cooperative launch failed: %s (grid %d)\n", hipGetErrorString(e), grid_blocks);
}
```

```cpp
#include <hip/hip_runtime.h>
#include <stdint.h>
#include <stdio.h>

typedef unsigned short bf16_t;
typedef short bf16x8 __attribute__((ext_vector_type(8)));
typedef __bf16 bf16x2v __attribute__((ext_vector_type(2)));
typedef float f32x4 __attribute__((ext_vector_type(4)));

constexpr int B_ = 16, S_ = 2048, D_ = 1024, NTOK = B_ * S_;
constexpr int MEML = 256, NMEM = B_ * MEML;
constexpr int INW = 6400;
constexpr int LW = 768;
constexpr int NEXP = 16384;
constexpr float EPS = 1e-6f;
constexpr float QSCALE = 0.08838834764831845f * 1.4426950408889634f;

constexpr size_t OFF_WINT = 0;
constexpr size_t OFF_WMKVT = OFF_WINT + (size_t)INW * 1024 * 2;
constexpr size_t OFF_PATTNT = OFF_WMKVT + (size_t)1024 * 1024 * 2;
constexpr size_t OFF_PLRUT = OFF_PATTNT + (size_t)1024 * 768 * 2;
constexpr size_t OFF_PMEMT = OFF_PLRUT + (size_t)1024 * 768 * 2;
constexpr size_t OFF_WOUTT = OFF_PMEMT + (size_t)1024 * 512 * 2;
constexpr size_t OFF_WPQT = OFF_WOUTT + (size_t)1024 * 1024 * 2;
constexpr size_t OFF_LRUWT = OFF_WPQT + (size_t)2048 * 1024 * 2;
constexpr size_t OFF_SUBK = OFF_LRUWT + (size_t)6 * 512 * 128 * 2;
constexpr size_t OFF_UB = OFF_SUBK + (size_t)16 * 128 * 128 * 2;
constexpr size_t OFF_VB = OFF_UB + (size_t)NEXP * 1024;
constexpr size_t OFF_SU = OFF_VB + (size_t)NEXP * 1024;
constexpr size_t OFF_SV = OFF_SU + (size_t)NEXP * 4;
constexpr size_t OFF_RA = OFF_SV + (size_t)NEXP * 4;
constexpr size_t OFF_QA = OFF_RA;
constexpr size_t OFF_KA = OFF_QA + (size_t)NTOK * 768 * 2;
constexpr size_t OFF_VAT = OFF_KA + (size_t)NTOK * 256 * 2;
constexpr size_t OFF_XL = OFF_VAT + (size_t)NTOK * 256 * 2;
constexpr size_t OFF_GL = OFF_XL + (size_t)NTOK * 768 * 2;
constexpr size_t OFF_QM = OFF_GL + (size_t)NTOK * 768 * 2;
constexpr size_t OFF_GATES = OFF_QM + (size_t)NTOK * 512 * 2;
constexpr size_t OFF_BAR = OFF_GATES + (size_t)NTOK * 3072 * 2;
constexpr size_t OFF_END = OFF_BAR + 16384;
constexpr size_t OFF_MERGED = OFF_KA;
constexpr size_t OFF_QPEER = OFF_GATES;
constexpr size_t OFF_TOPL = OFF_QPEER + (size_t)NTOK * 2048 * 2;
constexpr size_t OFF_EIDX = OFF_TOPL + (size_t)NTOK * 256 * 4;
constexpr size_t OFF_EGATE = OFF_EIDX + (size_t)NTOK * 128 * 4;
static_assert(OFF_EGATE + (size_t)NTOK * 128 * 4 <= OFF_BAR, "overlay");
static_assert(OFF_MERGED + (size_t)NTOK * 1024 * 2 <= OFF_GL, "overlay2");
constexpr size_t DO_HBF = 0;
constexpr size_t DO_MEMBF = DO_HBF + (size_t)NTOK * 1024 * 2;
constexpr size_t DO_KM = DO_MEMBF + (size_t)NMEM * 1024 * 2;
constexpr size_t DO_VMT = DO_KM + (size_t)NMEM * 512 * 2;
constexpr size_t DO_ROPE = DO_VMT + (size_t)NMEM * 512 * 2;
static_assert(DO_ROPE + (size_t)NTOK * 32 * 4 <= (size_t)NTOK * 1024 * 4, "d_out scratch");

struct Params {
    const float *x, *mem; const int* positions;
    const float *g_mix, *g_mem, *w_in, *gate_b, *attn_sink, *conv_w, *conv_b, *lru_wr, *lru_br, *lru_wi, *lru_bi, *lru_lambda,
        *w_mem_kv, *p_attn, *p_lru, *p_mem, *w_out, *g_ffn, *w_peer_q, *peer_sub_keys, *peer_u, *peer_v, *g_final;
    float* out; unsigned char* ws;
};

__device__ __forceinline__ int tidx() { int t = threadIdx.x; asm volatile("" : "+v"(t)); return t; }
__device__ __forceinline__ float bf2f(bf16_t b) { return __uint_as_float(((unsigned)b) << 16); }
__device__ __forceinline__ float bflo(unsigned u) { return __uint_as_float(u << 16); }
__device__ __forceinline__ float bfhi(unsigned u) { return __uint_as_float(u & 0xffff0000u); }
typedef float f32x2v __attribute__((ext_vector_type(2)));
__device__ __forceinline__ unsigned pack_bf16(float lo, float hi) { const f32x2v f = {lo, hi}; return __builtin_bit_cast(unsigned, __builtin_convertvector(f, bf16x2v)); }
__device__ __forceinline__ bf16_t f2bf(float f) { return (bf16_t)(pack_bf16(f, 0.f) & 0xffffu); }
__device__ __forceinline__ f32x4 mfma16(bf16x8 a, bf16x8 b, f32x4 c) { return __builtin_amdgcn_mfma_f32_16x16x32_bf16(a, b, c, 0, 0, 0); }
__device__ __forceinline__ float sigmoidf_(float x) { return __builtin_amdgcn_rcpf(1.0f + __expf(-x)); }
__device__ __forceinline__ float gelu_tanh(float x) { const float u = 1.5957691216057308f * (x + 0.044715f * x * x * x); return x * __builtin_amdgcn_rcpf(1.0f + __expf(-u)); }
__device__ __forceinline__ float wave_sum(float v) {
#pragma unroll
    for (int o = 32; o >= 1; o >>= 1) v += __shfl_xor(v, o);
    return v;
}

__device__ void convT_tile(const float* __restrict__ src, bf16_t* __restrict__ dst, int K, int N, int tile, unsigned char* smem) {
    float* t = (float*)smem;
    const int tn = N / 64, tk = tile / tn, tnn = tile % tn, k0 = tk * 64, n0 = tnn * 64, tid = tidx();
    const int r = tid >> 4, c4 = (tid & 15) * 4;
#pragma unroll
    for (int i = 0; i < 4; ++i) {
        const int k = r + 16 * i;
        const float4 v = *(const float4*)(src + (size_t)(k0 + k) * N + n0 + c4);
        t[k * 65 + c4 + 0] = v.x; t[k * 65 + c4 + 1] = v.y; t[k * 65 + c4 + 2] = v.z; t[k * 65 + c4 + 3] = v.w;
    }
    __syncthreads();
    const int n = tid >> 2, kq = (tid & 3) * 16;
    unsigned w[8];
#pragma unroll
    for (int i = 0; i < 8; ++i) w[i] = pack_bf16(t[(kq + 2 * i) * 65 + n], t[(kq + 2 * i + 1) * 65 + n]);
    uint4* d = (uint4*)(dst + (size_t)(n0 + n) * K + k0 + kq);
    d[0] = make_uint4(w[0], w[1], w[2], w[3]); d[1] = make_uint4(w[4], w[5], w[6], w[7]);
    __syncthreads();
}


__device__ __forceinline__ void rms_row_bf16(const float* __restrict__ xr, const float* __restrict__ g, bf16_t* __restrict__ o, int lane) {
    float4 v[4]; float ss = 0.f;
#pragma unroll
    for (int i = 0; i < 4; ++i) { v[i] = *(const float4*)(xr + i * 256 + lane * 4); ss += v[i].x * v[i].x + v[i].y * v[i].y + v[i].z * v[i].z + v[i].w * v[i].w; }
    ss = wave_sum(ss);
    const float rs = rsqrtf(ss * (1.0f / 1024.0f) + EPS);
#pragma unroll
    for (int i = 0; i < 4; ++i) {
        const float4 gg = *(const float4*)(g + i * 256 + lane * 4);
        *(uint2*)(o + i * 256 + lane * 4) = make_uint2(pack_bf16(v[i].x * rs * gg.x, v[i].y * rs * gg.y), pack_bf16(v[i].z * rs * gg.z, v[i].w * rs * gg.w));
    }
}


__device__ __forceinline__ void conv_plain(const float* __restrict__ src, bf16_t* __restrict__ dst, size_t n8) {
    for (size_t i = (size_t)blockIdx.x * 256 + tidx(); i < n8; i += (size_t)gridDim.x * 256) {
        const float4 a = ((const float4*)src)[2 * i], b = ((const float4*)src)[2 * i + 1];
        ((uint4*)dst)[i] = make_uint4(pack_bf16(a.x, a.y), pack_bf16(a.z, a.w), pack_bf16(b.x, b.y), pack_bf16(b.z, b.w));
    }
}
__device__ __forceinline__ void rope_item(const int* __restrict__ pos, float* __restrict__ cs, int i) {
    const int t = i >> 4, f = i & 15;
    const float inv = powf(500000.0f, -(float)(2 * f) / 32.0f);
    const float ang = (float)pos[t] * inv;
    float s, c; sincosf(ang, &s, &c);
    cs[2 * i] = c; cs[2 * i + 1] = s;
}

__device__ __forceinline__ int swz(int row) { return (row & 3) | (((row >> 3) & 1) << 2); }

__device__ __forceinline__ void gemm_tile(const bf16_t* __restrict__ A, int lda, const bf16_t* __restrict__ Bt, int ldb, int K,
                                          f32x4 (&acc)[4][4], unsigned char* smem) {
    const int tid = tidx(), lane = tid & 63, wid = tid >> 6, wr = wid >> 1, wc = wid & 1, li = lane & 15, g = lane >> 4;
    const int srow = tid >> 3, skc = (tid & 7) ^ swz(tid >> 3);
    const bf16_t* ga = A + (size_t)srow * lda + skc * 8;
    const bf16_t* gb = Bt + (size_t)srow * ldb + skc * 8;
    unsigned char* ldst = smem + tid * 16;
    int aoff[4], boff[4], asw[4], bsw[4];
#pragma unroll
    for (int m = 0; m < 4; ++m) { const int row = wr * 64 + m * 16 + li; aoff[m] = row * 128; asw[m] = swz(row); }
#pragma unroll
    for (int n = 0; n < 4; ++n) { const int row = wc * 64 + 32 * (n >> 1) + 8 * (li >> 2) + 4 * (n & 1) + (li & 3); boff[n] = 16384 + row * 128; bsw[n] = swz(row); }
    const int nk = K >> 6;
#pragma unroll
    for (int i = 0; i < 4; ++i) {
        __builtin_amdgcn_global_load_lds((const unsigned*)(ga + (size_t)(32 * i) * lda), (unsigned*)(ldst + i * 4096), 16, 0, 0);
        __builtin_amdgcn_global_load_lds((const unsigned*)(gb + (size_t)(32 * i) * ldb), (unsigned*)(ldst + 16384 + i * 4096), 16, 0, 0);
    }
    __syncthreads();
    for (int kt = 0; kt < nk; ++kt) {
        const unsigned char* sb = smem + (kt & 1) * 32768;
        if (kt + 1 < nk) {
            unsigned char* sw = ldst + ((kt + 1) & 1) * 32768;
#pragma unroll
            for (int i = 0; i < 4; ++i) {
                __builtin_amdgcn_global_load_lds((const unsigned*)(ga + (size_t)(32 * i) * lda + (kt + 1) * 64), (unsigned*)(sw + i * 4096), 16, 0, 0);
                __builtin_amdgcn_global_load_lds((const unsigned*)(gb + (size_t)(32 * i) * ldb + (kt + 1) * 64), (unsigned*)(sw + 16384 + i * 4096), 16, 0, 0);
            }
        }
#pragma unroll
        for (int ks = 0; ks < 2; ++ks) {
            bf16x8 af[4], bfr[4];
#pragma unroll
            for (int m = 0; m < 4; ++m) af[m] = *(const bf16x8*)(sb + aoff[m] + (((ks * 4 + g) ^ asw[m]) << 4));
#pragma unroll
            for (int n = 0; n < 4; ++n) bfr[n] = *(const bf16x8*)(sb + boff[n] + (((ks * 4 + g) ^ bsw[n]) << 4));
#pragma unroll
            for (int m = 0; m < 4; ++m)
#pragma unroll
                for (int n = 0; n < 4; ++n) acc[m][n] = mfma16(bfr[n], af[m], acc[m][n]);
        }
        __syncthreads();
    }
}
__device__ __forceinline__ void acc_zero(f32x4 (&acc)[4][4]) {
#pragma unroll
    for (int m = 0; m < 4; ++m)
#pragma unroll
        for (int n = 0; n < 4; ++n) acc[m][n] = (f32x4){0.f, 0.f, 0.f, 0.f};
}
template <class F> __device__ __forceinline__ void epi_foreach(const f32x4 (&acc)[4][4], F&& f) {
    const int lane = tidx() & 63, wid = tidx() >> 6, wr = wid >> 1, wc = wid & 1, li = lane & 15, g = lane >> 4;
#pragma unroll
    for (int m = 0; m < 4; ++m)
#pragma unroll
        for (int pp = 0; pp < 2; ++pp) {
            float v[8];
#pragma unroll
            for (int r = 0; r < 4; ++r) { v[r] = acc[m][2 * pp][r]; v[4 + r] = acc[m][2 * pp + 1][r]; }
            f(wr * 64 + m * 16 + li, wc * 64 + 32 * pp + 8 * g, v, pp);
        }
}
__device__ __forceinline__ void store_bf16x8(bf16_t* p, const float (&v)[8]) {
    *(uint4*)p = make_uint4(pack_bf16(v[0], v[1]), pack_bf16(v[2], v[3]), pack_bf16(v[4], v[5]), pack_bf16(v[6], v[7]));
}
__device__ __forceinline__ void store_tile_T(const f32x4 (&acc)[4][4], bf16_t* __restrict__ dstT, int ldt, unsigned char* smem) {
    bf16_t* t = (bf16_t*)smem;
    epi_foreach(acc, [&](int r, int c, const float (&v)[8], int) {
#pragma unroll
        for (int e = 0; e < 8; ++e) t[(c + e) * 136 + r] = f2bf(v[e]);
    });
    __syncthreads();
#pragma unroll
    for (int i = 0; i < 8; ++i) {
        const int ch = tidx() + 256 * i, d = ch >> 4, tc = ch & 15;
        *(uint4*)(dstT + (size_t)d * ldt + tc * 8) = *(const uint4*)(smem + d * 272 + tc * 16);
    }
    __syncthreads();
}

__device__ void inproj_tile(const Params& p, int rt, int ct, unsigned char* smem) {
    unsigned char* ws = p.ws; unsigned char* dob = (unsigned char*)p.out;
    const bf16_t* hbf = (const bf16_t*)(dob + DO_HBF);
    const bf16_t* WinT = (const bf16_t*)(ws + OFF_WINT);
    f32x4 acc[4][4]; acc_zero(acc);
    gemm_tile(hbf + (size_t)rt * 128 * 1024, 1024, WinT + (size_t)ct * 128 * 1024, 1024, 1024, acc, smem);
    const int row0 = rt * 128;
    if (ct < 8) {
        const float* cs = (const float*)(dob + DO_ROPE);
        const bool isq = ct < 6;
        bf16_t* dst = isq ? (bf16_t*)(ws + OFF_QA) + ct * 128 : (bf16_t*)(ws + OFF_KA) + (ct - 6) * 128;
        const int ld = isq ? 768 : 256;
        const float sc = isq ? QSCALE : 1.0f;
        const int g = (tidx() & 63) >> 4;
        epi_foreach(acc, [&](int r, int c, float (&v)[8], int pp) {
            const int tok = row0 + r;
            if (pp == 0 && c < 32) {
                const float* csr = cs + (size_t)tok * 32 + (g & 1) * 16;
#pragma unroll
                for (int e = 0; e < 8; ++e) {
                    const float o = __shfl_xor(v[e], 32);
                    const float cc = csr[2 * e], ss = csr[2 * e + 1];
                    v[e] = (g < 2) ? (v[e] * cc - o * ss) : (v[e] * cc + o * ss);
                }
            }
#pragma unroll
            for (int e = 0; e < 8; ++e) v[e] *= sc;
            store_bf16x8(dst + (size_t)tok * ld + c, v);
        });
    } else if (ct < 10) {
        const int kvh = ct - 8, b = row0 / S_, s0 = row0 % S_;
        store_tile_T(acc, (bf16_t*)(ws + OFF_VAT) + (size_t)(b * 2 + kvh) * 128 * S_ + s0, S_, smem);
    } else if (ct < 16) {
        bf16_t* dst = (bf16_t*)(ws + OFF_XL) + (ct - 10) * 128;
        epi_foreach(acc, [&](int r, int c, float (&v)[8], int) { store_bf16x8(dst + (size_t)(row0 + r) * 768 + c, v); });
    } else if (ct < 22) {
        bf16_t* dst = (bf16_t*)(ws + OFF_GL) + (ct - 16) * 128;
        epi_foreach(acc, [&](int r, int c, float (&v)[8], int) {
#pragma unroll
            for (int e = 0; e < 8; ++e) v[e] = gelu_tanh(v[e]);
            store_bf16x8(dst + (size_t)(row0 + r) * 768 + c, v); });
    } else if (ct < 26) {
        bf16_t* dst = (bf16_t*)(ws + OFF_QM) + (ct - 22) * 128;
        epi_foreach(acc, [&](int r, int c, float (&v)[8], int) {
#pragma unroll
            for (int e = 0; e < 8; ++e) v[e] *= QSCALE;
            store_bf16x8(dst + (size_t)(row0 + r) * 512 + c, v); });
    } else {
        const int gc0 = (ct - 26) * 128;
        bf16_t* dst = (bf16_t*)(ws + OFF_GATES) + gc0;
        const float* gb = p.gate_b + gc0;
        epi_foreach(acc, [&](int r, int c, float (&v)[8], int) {
            const float4 b0 = *(const float4*)(gb + c), b1 = *(const float4*)(gb + c + 4);
            v[0] = sigmoidf_(v[0] + b0.x); v[1] = sigmoidf_(v[1] + b0.y); v[2] = sigmoidf_(v[2] + b0.z); v[3] = sigmoidf_(v[3] + b0.w);
            v[4] = sigmoidf_(v[4] + b1.x); v[5] = sigmoidf_(v[5] + b1.y); v[6] = sigmoidf_(v[6] + b1.z); v[7] = sigmoidf_(v[7] + b1.w);
            store_bf16x8(dst + (size_t)(row0 + r) * 3072 + c, v); });
    }
}

__device__ void memkv_tile(const Params& p, int rt, int ct, unsigned char* smem) {
    unsigned char* dob = (unsigned char*)p.out;
    f32x4 acc[4][4]; acc_zero(acc);
    gemm_tile((const bf16_t*)(dob + DO_MEMBF) + (size_t)rt * 128 * 1024, 1024, (const bf16_t*)(p.ws + OFF_WMKVT) + (size_t)ct * 128 * 1024, 1024, 1024, acc, smem);
    const int row0 = rt * 128;
    if (ct < 4) {
        bf16_t* dst = (bf16_t*)(dob + DO_KM) + ct * 128;
        epi_foreach(acc, [&](int r, int c, float (&v)[8], int) { store_bf16x8(dst + (size_t)(row0 + r) * 512 + c, v); });
    } else {
        const int h = ct - 4, b = row0 / MEML, m0 = row0 % MEML;
        store_tile_T(acc, (bf16_t*)(dob + DO_VMT) + (size_t)(b * 4 + h) * 128 * MEML + m0, MEML, smem);
    }
}


typedef float f32x16 __attribute__((ext_vector_type(16)));
__device__ __forceinline__ f32x16 mfma32(bf16x8 a, bf16x8 b, f32x16 c) { return __builtin_amdgcn_mfma_f32_32x32x16_bf16(a, b, c, 0, 0, 0); }
constexpr int ATT_STAGE = 16384 + 128 * 136;

template <bool WIN>
__device__ void attn_block(const bf16_t* Qg, int ldq, const bf16_t* __restrict__ Kg, int ldk, const bf16_t* __restrict__ Vtg, int ldv,
                           int q0, int kt0, int nt, float sink2, bf16_t* Og, int ldo, unsigned char* smem) {
    const int tid = tidx(), lane = tid & 63, wid = tid >> 6, r = lane & 31, hh = lane >> 5;
    const int qw = q0 + 32 * wid;
    bf16x8 qf[8];
#pragma unroll
    for (int ks = 0; ks < 8; ++ks) qf[ks] = *(const bf16x8*)(Qg + (size_t)(32 * wid + r) * ldq + ks * 16 + hh * 8);
    f32x16 o[4];
#pragma unroll
    for (int db = 0; db < 4; ++db)
#pragma unroll
        for (int e = 0; e < 16; ++e) o[db][e] = 0.f;
    float m = WIN ? sink2 : -1e30f, l = WIN ? 1.0f : 0.0f;
    const int krow = tid >> 4, kch = tid & 15, vrow = tid >> 3, vch = tid & 7;
    const int koff = krow * 256 + ((kch ^ (krow & 15)) << 4);
    const int voff = 16384 + vrow * 136 + vch * 16;
    uint4 rk[4], rv[4];
    const bf16_t* kgp = Kg + (size_t)(kt0 * 64 + krow) * ldk + kch * 8;
    const bf16_t* vgp = Vtg + (size_t)vrow * ldv + kt0 * 64 + vch * 8;
#pragma unroll
    for (int i = 0; i < 4; ++i) { rk[i] = *(const uint4*)(kgp + (size_t)(16 * i) * ldk); rv[i] = *(const uint4*)(vgp + (size_t)(32 * i) * ldv); }
#pragma unroll
    for (int i = 0; i < 4; ++i) {
        *(uint4*)(smem + koff + i * 4096) = rk[i];
        *(uint2*)(smem + voff + i * 4352) = make_uint2(rv[i].x, rv[i].y); *(uint2*)(smem + voff + i * 4352 + 8) = make_uint2(rv[i].z, rv[i].w);
    }
    __syncthreads();
    for (int t = 0; t < nt; ++t) {
        const unsigned char* sb = smem + (t & 1) * ATT_STAGE;
        {
            const int tn = t + 1 < nt ? t + 1 : t;
#pragma unroll
            for (int i = 0; i < 4; ++i) { rk[i] = *(const uint4*)(kgp + (size_t)(tn * 64 + 16 * i) * ldk); rv[i] = *(const uint4*)(vgp + (size_t)(32 * i) * ldv + tn * 64); }
        }
        const int k0 = (kt0 + t) * 64;
        if (!WIN || (k0 + 63 >= qw - 128 && k0 <= qw + 159)) {
#pragma unroll
            for (int kb = 0; kb < 2; ++kb) {
                const int kb0 = k0 + 32 * kb;
                if (WIN && !(kb0 + 31 >= qw - 128 && kb0 <= qw + 159)) continue;
                f32x16 s;
#pragma unroll
                for (int e = 0; e < 16; ++e) s[e] = 0.f;
                const int row = kb * 32 + r;
#pragma unroll
                for (int ks = 0; ks < 8; ++ks) {
                    const bf16x8 a = *(const bf16x8*)(sb + row * 256 + (((2 * ks + hh) ^ (row & 15)) << 4));
                    s = mfma32(a, qf[ks], s);
                }
                if (WIN && !(kb0 >= qw - 97 && kb0 + 31 <= qw + 128)) {
#pragma unroll
                    for (int e = 0; e < 16; ++e) {
                        const int d = kb0 + (e & 3) + 8 * (e >> 2) + 4 * hh - (qw + r);
                        s[e] = (d <= 128 && d >= -128) ? s[e] : -1e30f;
                    }
                }
                float mx = s[0];
#pragma unroll
                for (int e = 1; e < 16; ++e) mx = fmaxf(mx, s[e]);
                mx = fmaxf(mx, __shfl_xor(mx, 32));
                const float mnew = fmaxf(m, mx), alpha = __builtin_amdgcn_exp2f(m - mnew);
                m = mnew;
                float ps = 0.f;
#pragma unroll
                for (int e = 0; e < 16; ++e) { s[e] = __builtin_amdgcn_exp2f(s[e] - mnew); ps += s[e]; }
                ps += __shfl_xor(ps, 32);
                l = l * alpha + ps;
                if (__any(alpha != 1.0f)) {
#pragma unroll
                    for (int db = 0; db < 4; ++db)
#pragma unroll
                        for (int e = 0; e < 16; ++e) o[db][e] *= alpha;
                }
#pragma unroll
                for (int s2 = 0; s2 < 2; ++s2) {
                    union { unsigned u[4]; bf16x8 v; } pb;
#pragma unroll
                    for (int e = 0; e < 4; ++e) pb.u[e] = pack_bf16(s[8 * s2 + 2 * e], s[8 * s2 + 2 * e + 1]);
#pragma unroll
                    for (int db = 0; db < 4; ++db) {
                        const unsigned char* vp = sb + 16384 + (db * 32 + r) * 136 + (kb * 32 + 16 * s2 + 4 * hh) * 2;
                        union { uint2 u[2]; bf16x8 v; } va;
                        va.u[0] = *(const uint2*)vp; va.u[1] = *(const uint2*)(vp + 16);
                        o[db] = mfma32(va.v, pb.v, o[db]);
                    }
                }
            }
        }
        {
            unsigned char* sw = smem + ((t + 1) & 1) * ATT_STAGE;
#pragma unroll
            for (int i = 0; i < 4; ++i) {
                *(uint4*)(sw + koff + i * 4096) = rk[i];
                *(uint2*)(sw + voff + i * 4352) = make_uint2(rv[i].x, rv[i].y); *(uint2*)(sw + voff + i * 4352 + 8) = make_uint2(rv[i].z, rv[i].w);
            }
        }
        __syncthreads();
    }
    const float inv = __builtin_amdgcn_rcpf(l);
    bf16_t* orow = Og + (size_t)(32 * wid + r) * ldo + 4 * hh;
#pragma unroll
    for (int db = 0; db < 4; ++db)
#pragma unroll
        for (int gq = 0; gq < 4; ++gq)
            *(uint2*)(orow + db * 32 + 8 * gq) = make_uint2(pack_bf16(o[db][4 * gq] * inv, o[db][4 * gq + 1] * inv), pack_bf16(o[db][4 * gq + 2] * inv, o[db][4 * gq + 3] * inv));
}
__device__ void attn_win_unit(const Params& p, int u, unsigned char* smem) {
    const int gh = u % 3, qb = (u / 3) % 16, kvh = (u / 48) % 2, b = u / 96, head = kvh * 3 + gh;
    const int q0 = qb * 128;
    const int ks = q0 - 128 < 0 ? 0 : q0 - 128, ke = q0 + 256 > S_ ? S_ : q0 + 256;
    bf16_t* Q = (bf16_t*)(p.ws + OFF_QA) + (size_t)(b * S_ + q0) * 768 + head * 128;
    const bf16_t* Kb = (const bf16_t*)(p.ws + OFF_KA) + (size_t)(b * S_) * 256 + kvh * 128;
    const bf16_t* Vt = (const bf16_t*)(p.ws + OFF_VAT) + (size_t)(b * 2 + kvh) * 128 * S_;
    attn_block<true>(Q, 768, Kb, 256, Vt, S_, q0, ks / 64, (ke - ks) / 64, p.attn_sink[head] * 1.4426950408889634f, Q, 768, smem);
}
__device__ void attn_mem_unit(const Params& p, int u, unsigned char* smem) {
    const int qb = u % 16, head = (u / 16) % 4, b = u / 64;
    const int q0 = qb * 128;
    unsigned char* dob = (unsigned char*)p.out;
    bf16_t* Q = (bf16_t*)(p.ws + OFF_QM) + (size_t)(b * S_ + q0) * 512 + head * 128;
    const bf16_t* Kb = (const bf16_t*)(dob + DO_KM) + (size_t)(b * MEML) * 512 + head * 128;
    const bf16_t* Vt = (const bf16_t*)(dob + DO_VMT) + (size_t)(b * 4 + head) * 128 * MEML;
    attn_block<false>(Q, 512, Kb, 512, Vt, MEML, q0, 0, 4, 0.f, Q, 512, smem);
}

__device__ __forceinline__ void lru_load_x(unsigned (&xw)[19], const bf16_t* __restrict__ Xl, int sbase, int cch) {
#pragma unroll
    for (int i = 0; i < 19; ++i) {
        const int s = sbase + i - 2;
        xw[i] = (s >= 0 && s < S_) ? *(const unsigned*)(Xl + (size_t)s * 768 + cch) : 0u;
    }
}
__device__ void lru_unit(const Params& p, int u, unsigned char* smem) {
    const int tid = tidx(), lane = tid & 63, wid = tid >> 6, li = lane & 15, g = lane >> 4;
    const int qt = u & 3, h = (u >> 2) % 6, b = u / 24;
    const int cbase = h * 128, cq0 = cbase + qt * 32;
    unsigned char* xcs = smem; unsigned char* wl = smem + 16384;
    float* pre = (float*)(smem + 32768); float* xcf = (float*)(smem + 49152);
    float* cA = (float*)(smem + 57344); float* cH = cA + 256; float* h0 = cH + 256;
    const bf16_t* Xl = (const bf16_t*)(p.ws + OFF_XL) + (size_t)(b * S_) * 768;
    bf16_t* Gl = (bf16_t*)(p.ws + OFF_GL) + (size_t)(b * S_) * 768;
    bf16_t* Hf = (bf16_t*)((unsigned char*)p.out + DO_HBF) + (size_t)(b * S_) * 768;
    const bf16_t* LruWt = (const bf16_t*)(p.ws + OFF_LRUWT);
    const int cp = tid & 63, tq = tid >> 6, cch = cbase + 2 * cp;
    float cw[4][2];
#pragma unroll
    for (int j = 0; j < 4; ++j) { cw[j][0] = p.conv_w[j * LW + cch]; cw[j][1] = p.conv_w[j * LW + cch + 1]; }
    const float cb0 = p.conv_b[cch], cb1 = p.conv_b[cch + 1];
    const int sc_c = tid & 31, sub = tid >> 5, sch = cq0 + sc_c;
    for (int dir = 0; dir < 2; ++dir) {
        __syncthreads();
#pragma unroll
        for (int i = 0; i < 4; ++i) {
            const int ch = tid + 256 * i, j = ch >> 4, kc = ch & 15;
            const int srcrow = h * 512 + ((j >> 5) * 2 + dir) * 128 + qt * 32 + (j & 31);
            *(uint4*)(wl + j * 256 + ((kc ^ (j & 15)) << 4)) = *(const uint4*)(LruWt + (size_t)srcrow * 128 + kc * 8);
        }
        const float br = p.lru_br[dir * LW + sch], bi = p.lru_bi[dir * LW + sch];
        const float lam = p.lru_lambda[dir * LW + sch];
        const float sp8 = -8.0f * log1pf(__expf(-lam));
        if (tid < 32) h0[tid] = 0.f;
        unsigned xw[19];
        lru_load_x(xw, Xl, (dir ? 31 : 0) * 64 + 16 * tq, cch);
        for (int ci = 0; ci < 32; ++ci) {
            const int chunk = dir ? 31 - ci : ci, s0 = chunk * 64;
#pragma unroll
            for (int i = 0; i < 16; ++i) {
                const int t = 16 * tq + i;
                const float y0 = cb0 + cw[0][0] * bflo(xw[i]) + cw[1][0] * bflo(xw[i + 1]) + cw[2][0] * bflo(xw[i + 2]) + cw[3][0] * bflo(xw[i + 3]);
                const float y1 = cb1 + cw[0][1] * bfhi(xw[i]) + cw[1][1] * bfhi(xw[i + 1]) + cw[2][1] * bfhi(xw[i + 2]) + cw[3][1] * bfhi(xw[i + 3]);
                *(unsigned*)(xcs + t * 256 + (((cp >> 2) ^ (t & 15)) << 4) + (cp & 3) * 4) = pack_bf16(y0, y1);
                if ((cp >> 4) == qt) { xcf[t * 32 + 2 * (cp & 15)] = y0; xcf[t * 32 + 2 * (cp & 15) + 1] = y1; }
            }
            if (ci + 1 < 32) lru_load_x(xw, Xl, (dir ? 30 - ci : ci + 1) * 64 + 16 * tq, cch);
            float hfv[8], glv[8];
            if (dir) {
#pragma unroll
                for (int k = 0; k < 8; ++k) {
                    const size_t gi = (size_t)(s0 + 63 - (sub * 8 + k)) * 768 + sch;
                    hfv[k] = bf2f(Hf[gi]); glv[k] = bf2f(Gl[gi]);
                }
            }
            __syncthreads();
            {
                f32x4 a[4];
#pragma unroll
                for (int n = 0; n < 4; ++n) a[n] = (f32x4){0.f, 0.f, 0.f, 0.f};
#pragma unroll
                for (int ks = 0; ks < 4; ++ks) {
                    const int row = wid * 16 + li;
                    const bf16x8 xf = *(const bf16x8*)(xcs + row * 256 + (((ks * 4 + g) ^ (row & 15)) << 4));
#pragma unroll
                    for (int n = 0; n < 4; ++n) {
                        const int j = n * 16 + li;
                        const bf16x8 wf = *(const bf16x8*)(wl + j * 256 + (((ks * 4 + g) ^ (j & 15)) << 4));
                        a[n] = mfma16(xf, wf, a[n]);
                    }
                }
#pragma unroll
                for (int n = 0; n < 4; ++n)
#pragma unroll
                    for (int r = 0; r < 4; ++r) pre[(wid * 16 + 4 * g + r) * 64 + n * 16 + li] = a[n][r];
            }
            __syncthreads();
            float hl[8], ap[8];
            {
                float hh = 0.f, aa = 1.f;
#pragma unroll
                for (int k = 0; k < 8; ++k) {
                    const int pp = sub * 8 + k, t = dir ? 63 - pp : pp;
                    const float r = sigmoidf_(pre[t * 64 + sc_c] + br), ig = sigmoidf_(pre[t * 64 + 32 + sc_c] + bi);
                    const float a = __expf(sp8 * r);
                    const float bx = sqrtf(fmaxf(1.0f - a * a, 0.f)) * (ig * xcf[t * 32 + sc_c]);
                    hh = a * hh + bx; aa *= a; hl[k] = hh; ap[k] = aa;
                }
                cA[sub * 32 + sc_c] = aa; cH[sub * 32 + sc_c] = hh;
            }
            __syncthreads();
            {
                float hin = h0[(ci & 1) * 32 + sc_c];
                for (int s2 = 0; s2 < sub; ++s2) hin = cA[s2 * 32 + sc_c] * hin + cH[s2 * 32 + sc_c];
#pragma unroll
                for (int k = 0; k < 8; ++k) {
                    const int pp = sub * 8 + k, t = dir ? 63 - pp : pp;
                    const float hv = hl[k] + ap[k] * hin;
                    const size_t gi = (size_t)(s0 + t) * 768 + sch;
                    if (dir == 0) Hf[gi] = f2bf(hv);
                    else Gl[gi] = f2bf((hfv[k] + hv) * glv[k]);
                    if (k == 7 && sub == 7) h0[((ci + 1) & 1) * 32 + sc_c] = hv;
                }
            }
        }
    }
    __syncthreads();
}

__device__ void merge_tile(const Params& p, int rt, int ct, unsigned char* smem) {
    unsigned char* ws = p.ws;
    const int row0 = rt * 128, col0 = ct * 128;
    uint4 tot[4][2];
    const bf16_t* G = (const bf16_t*)(ws + OFF_GATES);
    const int lane = tidx() & 63, wid = tidx() >> 6, wr = wid >> 1, wc = wid & 1, li = lane & 15, g = lane >> 4;
#pragma unroll 1
    for (int br = 0; br < 3; ++br) {
        const bf16_t* Ab = (const bf16_t*)(ws + (br == 0 ? OFF_QA : (br == 1 ? OFF_GL : OFF_QM)));
        const bf16_t* Bb = (const bf16_t*)(ws + (br == 0 ? OFF_PATTNT : (br == 1 ? OFF_PLRUT : OFF_PMEMT)));
        const int Kb = br == 2 ? 512 : 768;
        f32x4 acc[4][4]; acc_zero(acc);
        gemm_tile(Ab + (size_t)row0 * Kb, Kb, Bb + (size_t)col0 * Kb, Kb, Kb, acc, smem);
#pragma unroll
        for (int m = 0; m < 4; ++m)
#pragma unroll
            for (int pp = 0; pp < 2; ++pp) {
                const int r = wr * 64 + m * 16 + li, c = wc * 64 + 32 * pp + 8 * g;
                const uint4 gv = *(const uint4*)(G + (size_t)(row0 + r) * 3072 + br * 1024 + col0 + c);
                float v[8];
                v[0] = bflo(gv.x) * acc[m][2 * pp][0]; v[1] = bfhi(gv.x) * acc[m][2 * pp][1];
                v[2] = bflo(gv.y) * acc[m][2 * pp][2]; v[3] = bfhi(gv.y) * acc[m][2 * pp][3];
                v[4] = bflo(gv.z) * acc[m][2 * pp + 1][0]; v[5] = bfhi(gv.z) * acc[m][2 * pp + 1][1];
                v[6] = bflo(gv.w) * acc[m][2 * pp + 1][2]; v[7] = bfhi(gv.w) * acc[m][2 * pp + 1][3];
                if (br > 0) {
                    const uint4 t = tot[m][pp];
                    v[0] += bflo(t.x); v[1] += bfhi(t.x); v[2] += bflo(t.y); v[3] += bfhi(t.y);
                    v[4] += bflo(t.z); v[5] += bfhi(t.z); v[6] += bflo(t.w); v[7] += bfhi(t.w);
                }
                tot[m][pp] = make_uint4(pack_bf16(v[0], v[1]), pack_bf16(v[2], v[3]), pack_bf16(v[4], v[5]), pack_bf16(v[6], v[7]));
            }
    }
    bf16_t* dst = (bf16_t*)(ws + OFF_MERGED) + col0;
#pragma unroll
    for (int m = 0; m < 4; ++m)
#pragma unroll
        for (int pp = 0; pp < 2; ++pp) {
            const int r = wr * 64 + m * 16 + li, c = wc * 64 + 32 * pp + 8 * g;
            *(uint4*)(dst + (size_t)(row0 + r) * 1024 + c) = tot[m][pp];
        }
}
__device__ void outproj_tile(const Params& p, int rt, int ct, unsigned char* smem) {
    const int row0 = rt * 128, col0 = ct * 128;
    f32x4 acc[4][4]; acc_zero(acc);
    gemm_tile((const bf16_t*)(p.ws + OFF_MERGED) + (size_t)row0 * 1024, 1024, (const bf16_t*)(p.ws + OFF_WOUTT) + (size_t)col0 * 1024, 1024, 1024, acc, smem);
    epi_foreach(acc, [&](int r, int c, float (&v)[8], int) {
        const size_t o = (size_t)(row0 + r) * 1024 + col0 + c;
        const float4 x0 = *(const float4*)(p.x + o), x1 = *(const float4*)(p.x + o + 4);
        *(float4*)(p.out + o) = make_float4(x0.x + v[0], x0.y + v[1], x0.z + v[2], x0.w + v[3]);
        *(float4*)(p.out + o + 4) = make_float4(x1.x + v[4], x1.y + v[5], x1.z + v[6], x1.w + v[7]);
    });
}

__device__ void peerq_tile(const Params& p, int rt, int ct, unsigned char* smem) {
    const int row0 = rt * 128, col0 = ct * 128;
    f32x4 acc[4][4]; acc_zero(acc);
    gemm_tile((const bf16_t*)(p.ws + OFF_MERGED) + (size_t)row0 * 1024, 1024, (const bf16_t*)(p.ws + OFF_WPQT) + (size_t)col0 * 1024, 1024, 1024, acc, smem);
    bf16_t* dst = (bf16_t*)(p.ws + OFF_QPEER) + col0;
    epi_foreach(acc, [&](int r, int c, float (&v)[8], int) { store_bf16x8(dst + (size_t)(row0 + r) * 2048 + c, v); });
}

__device__ __forceinline__ int sortable(float v) { int k = __float_as_int(v); return k ^ ((k >> 31) & 0x7fffffff); }
__device__ __forceinline__ float unsortable(int k) { return __int_as_float(k ^ ((k >> 31) & 0x7fffffff)); }
__device__ __forceinline__ void insert16(int (&lst)[16], int x) {
#pragma unroll
    for (int k = 0; k < 16; ++k) { const int hi = max(lst[k], x); x = min(lst[k], x); lst[k] = hi; }
}
__device__ void scores_tile(const Params& p, int rt, int pq, unsigned char* smem) {
    const int row0 = rt * 128;
    f32x4 acc[4][4]; acc_zero(acc);
    gemm_tile((const bf16_t*)(p.ws + OFF_QPEER) + (size_t)row0 * 2048 + pq * 128, 2048, (const bf16_t*)(p.ws + OFF_SUBK) + (size_t)pq * 128 * 128, 128, 128, acc, smem);
    float* sc = (float*)smem;
    epi_foreach(acc, [&](int r, int c, float (&v)[8], int) {
        *(float4*)(sc + r * 132 + c) = make_float4(v[0], v[1], v[2], v[3]);
        *(float4*)(sc + r * 132 + c + 4) = make_float4(v[4], v[5], v[6], v[7]); });
    __syncthreads();
    if (tidx() < 128) {
        const int r = tidx();
        int lst[16];
#pragma unroll
        for (int k = 0; k < 16; ++k) lst[k] = (int)0x80000000;
#pragma unroll 2
        for (int j4 = 0; j4 < 32; ++j4) {
            const float4 v = *(const float4*)(sc + r * 132 + j4 * 4);
            insert16(lst, (sortable(v.x) & ~127) | (j4 * 4 + 0));
            insert16(lst, (sortable(v.y) & ~127) | (j4 * 4 + 1));
            insert16(lst, (sortable(v.z) & ~127) | (j4 * 4 + 2));
            insert16(lst, (sortable(v.w) & ~127) | (j4 * 4 + 3));
        }
        int4* dst = (int4*)((int*)(p.ws + OFF_TOPL) + ((size_t)(row0 + r) * 16 + pq) * 16);
        dst[0] = make_int4(lst[0], lst[1], lst[2], lst[3]); dst[1] = make_int4(lst[4], lst[5], lst[6], lst[7]);
        dst[2] = make_int4(lst[8], lst[9], lst[10], lst[11]); dst[3] = make_int4(lst[12], lst[13], lst[14], lst[15]);
    }
    __syncthreads();
}

__device__ void combine_item(const Params& p, int item) {
    const int tok = item >> 3, hd = item & 7;
    const int* l0 = (const int*)(p.ws + OFF_TOPL) + ((size_t)tok * 16 + hd * 2) * 16;
    const int* l1 = l0 + 16;
    int k0[16], k1[16];
#pragma unroll
    for (int i = 0; i < 4; ++i) {
        const int4 a = ((const int4*)l0)[i], b = ((const int4*)l1)[i];
        k0[4 * i] = a.x; k0[4 * i + 1] = a.y; k0[4 * i + 2] = a.z; k0[4 * i + 3] = a.w;
        k1[4 * i] = b.x; k1[4 * i + 1] = b.y; k1[4 * i + 2] = b.z; k1[4 * i + 3] = b.w;
    }
    float v0[16], v1[16];
#pragma unroll
    for (int i = 0; i < 16; ++i) { v0[i] = unsortable(k0[i] & ~127); v1[i] = unsortable(k1[i] & ~127); }
    int lst[16];
#pragma unroll
    for (int k = 0; k < 16; ++k) lst[k] = (int)0x80000000;
#pragma unroll
    for (int a = 0; a < 16; ++a)
#pragma unroll
        for (int b = 0; b < 16; ++b)
            if ((a + 1) * (b + 1) <= 16) insert16(lst, (sortable(v0[a] + v1[b]) & ~255) | (a * 16 + b));
    float val[16], sum = 0.f;
    const float mx = unsortable(lst[0] & ~255);
#pragma unroll
    for (int k = 0; k < 16; ++k) { val[k] = __expf(unsortable(lst[k] & ~255) - mx); sum += val[k]; }
    const float inv = 1.0f / sum;
    int* ei = (int*)(p.ws + OFF_EIDX) + (size_t)tok * 128 + hd * 16;
    float* eg = (float*)(p.ws + OFF_EGATE) + (size_t)tok * 128 + hd * 16;
#pragma unroll
    for (int k = 0; k < 16; ++k) {
        const int code = lst[k] & 255, a = code >> 4, b = code & 15;
        ei[k] = (l0[a] & 127) * 128 + (l1[b] & 127);
        eg[k] = val[k] * inv;
    }
}

__device__ __forceinline__ void conv_row_fp8(const float* __restrict__ src, unsigned char* __restrict__ dst, float* __restrict__ scale, int row, int lane) {
    const float4* s = (const float4*)(src + (size_t)row * 1024 + lane * 16);
    float4 v[4]; float am = 0.f;
#pragma unroll
    for (int i = 0; i < 4; ++i) { v[i] = s[i]; am = fmaxf(am, fmaxf(fmaxf(fabsf(v[i].x), fabsf(v[i].y)), fmaxf(fabsf(v[i].z), fabsf(v[i].w)))); }
#pragma unroll
    for (int o = 32; o >= 1; o >>= 1) am = fmaxf(am, __shfl_xor(am, o));
    const float sc = am > 0.f ? am * (1.0f / 224.0f) : 1.0f, inv = 1.0f / sc;
    unsigned w[4];
#pragma unroll
    for (int i = 0; i < 4; ++i) {
        int t = __builtin_amdgcn_cvt_pk_fp8_f32(v[i].x * inv, v[i].y * inv, 0, false);
        t = __builtin_amdgcn_cvt_pk_fp8_f32(v[i].z * inv, v[i].w * inv, t, true);
        w[i] = (unsigned)t;
    }
    *(uint4*)(dst + (size_t)row * 1024 + lane * 16) = make_uint4(w[0], w[1], w[2], w[3]);
    if (lane == 0) scale[row] = sc;
}
__device__ __forceinline__ void load8rows(uint4 (&R)[8], const unsigned char* __restrict__ tab, int es, int l0, int lane) {
#pragma unroll
    for (int j = 0; j < 8; ++j) {
        const int id = __builtin_amdgcn_readlane(es, l0 + j);
        R[j] = *(const uint4*)(tab + (size_t)id * 1024 + lane * 16);
    }
}
__device__ __forceinline__ float dot16q(const uint4& r, const float (&h)[16]) {
    const unsigned q[4] = {r.x, r.y, r.z, r.w};
    float d0 = 0.f, d1 = 0.f;
#pragma unroll
    for (int i = 0; i < 4; ++i) {
        const f32x2v a = __builtin_amdgcn_cvt_pk_f32_fp8((int)q[i], false), b = __builtin_amdgcn_cvt_pk_f32_fp8((int)q[i], true);
        d0 += a.x * h[4 * i]; d1 += a.y * h[4 * i + 1]; d0 += b.x * h[4 * i + 2]; d1 += b.y * h[4 * i + 3];
    }
    return d0 + d1;
}
__device__ __forceinline__ float dots8(const uint4 (&R)[8], const float (&h)[16], int lane) {
    float pd[8];
#pragma unroll
    for (int j = 0; j < 8; ++j) pd[j] = dot16q(R[j], h);
    const bool b5 = (lane & 32) != 0, b4 = (lane & 16) != 0, b3 = (lane & 8) != 0;
    float a[4];
#pragma unroll
    for (int j = 0; j < 4; ++j) { const float keep = b5 ? pd[4 + j] : pd[j], send = b5 ? pd[j] : pd[4 + j]; a[j] = keep + __shfl_xor(send, 32); }
    float c[2];
#pragma unroll
    for (int j = 0; j < 2; ++j) { const float keep = b4 ? a[2 + j] : a[j], send = b4 ? a[j] : a[2 + j]; c[j] = keep + __shfl_xor(send, 16); }
    float kk;
    { const float keep = b3 ? c[1] : c[0], send = b3 ? c[0] : c[1]; kk = keep + __shfl_xor(send, 8); }
    kk += __shfl_xor(kk, 4); kk += __shfl_xor(kk, 2); kk += __shfl_xor(kk, 1);
    return kk;
}
__device__ __forceinline__ void axpy8(float (&o)[16], const uint4 (&R)[8], int wsr, int bb) {
#pragma unroll
    for (int j = 0; j < 8; ++j) {
        const float c = __int_as_float(__builtin_amdgcn_readlane(wsr, 8 * j + bb));
        const unsigned q[4] = {R[j].x, R[j].y, R[j].z, R[j].w};
#pragma unroll
        for (int i = 0; i < 4; ++i) {
            const f32x2v a = __builtin_amdgcn_cvt_pk_f32_fp8((int)q[i], false), b = __builtin_amdgcn_cvt_pk_f32_fp8((int)q[i], true);
            o[4 * i] += c * a.x; o[4 * i + 1] += c * a.y; o[4 * i + 2] += c * b.x; o[4 * i + 3] += c * b.y;
        }
    }
}
__device__ void gather_token(const Params& p, int tok, int lane) {
    const bf16_t* h2 = (const bf16_t*)(p.ws + OFF_MERGED) + (size_t)tok * 1024 + lane * 16;
    const unsigned char* Uq = p.ws + OFF_UB; const unsigned char* Vq = p.ws + OFF_VB;
    const float* SU = (const float*)(p.ws + OFF_SU); const float* SV = (const float*)(p.ws + OFF_SV);
    const int* ei = (const int*)(p.ws + OFF_EIDX) + (size_t)tok * 128;
    const float* eg = (const float*)(p.ws + OFF_EGATE) + (size_t)tok * 128;
    float h[16];
    {
        const uint4 ha = *(const uint4*)h2, hb = *(const uint4*)(h2 + 8);
        const unsigned hq[8] = {ha.x, ha.y, ha.z, ha.w, hb.x, hb.y, hb.z, hb.w};
#pragma unroll
        for (int e = 0; e < 8; ++e) { h[2 * e] = bflo(hq[e]); h[2 * e + 1] = bfhi(hq[e]); }
    }
    const int pe = 8 * (lane & 7) + (lane >> 3);
    int es[2], wsr[2] = {0, 0}; float su[2], gv[2];
#pragma unroll
    for (int k = 0; k < 2; ++k) {
        es[k] = ei[64 * k + lane];
        const int e = ei[64 * k + pe];
        su[k] = SU[e]; gv[k] = eg[64 * k + pe] * SV[e];
    }
    uint4 R0[8], R1[8];
#pragma unroll
    for (int k = 0; k < 2; ++k) {
        load8rows(R0, Uq, es[k], 0, lane);
        for (int bb = 0; bb < 8; bb += 2) {
            load8rows(R1, Uq, es[k], 8 * bb + 8, lane);
            { const float w = gelu_tanh(dots8(R0, h, lane) * su[k]) * gv[k]; if ((lane & 7) == bb) wsr[k] = __float_as_int(w); }
            if (bb + 2 < 8) load8rows(R0, Uq, es[k], 8 * bb + 16, lane);
            { const float w = gelu_tanh(dots8(R1, h, lane) * su[k]) * gv[k]; if ((lane & 7) == bb + 1) wsr[k] = __float_as_int(w); }
        }
    }
    float o[16];
#pragma unroll
    for (int e = 0; e < 16; ++e) o[e] = 0.f;
#pragma unroll
    for (int k = 0; k < 2; ++k) {
        load8rows(R0, Vq, es[k], 0, lane);
        for (int bb = 0; bb < 8; bb += 2) {
            load8rows(R1, Vq, es[k], 8 * bb + 8, lane);
            axpy8(o, R0, wsr[k], bb);
            if (bb + 2 < 8) load8rows(R0, Vq, es[k], 8 * bb + 16, lane);
            axpy8(o, R1, wsr[k], bb + 1);
        }
    }
    float* xr = p.out + (size_t)tok * 1024 + lane * 16;
    float4 x[4]; float ss = 0.f;
#pragma unroll
    for (int i = 0; i < 4; ++i) {
        x[i] = *(const float4*)(xr + 4 * i);
        x[i].x += o[4 * i]; x[i].y += o[4 * i + 1]; x[i].z += o[4 * i + 2]; x[i].w += o[4 * i + 3];
        ss += x[i].x * x[i].x + x[i].y * x[i].y + x[i].z * x[i].z + x[i].w * x[i].w;
    }
    ss = wave_sum(ss);
    const float rs = rsqrtf(ss * (1.0f / 1024.0f) + EPS);
    const float* gf = p.g_final + lane * 16;
#pragma unroll
    for (int i = 0; i < 4; ++i) {
        const float4 gg = *(const float4*)(gf + 4 * i);
        *(float4*)(xr + 4 * i) = make_float4(x[i].x * rs * gg.x, x[i].y * rs * gg.y, x[i].z * rs * gg.z, x[i].w * rs * gg.w);
    }
}

#define XB_TMO      128
#define XB_XCNT(j)  (256  + 64 * (j))
#define XB_XSUB(j)  (1280 + 64 * (j))
#define XB_XGEN(j)  (2304 + 64 * (j))
#define XB_TOP      3328
#define XB_TOPGEN   3392
#define XCD_BAR_WORDS 3456
#define XB_SPIN_CAP (1u << 22)
#define LAS __attribute__((address_space(3)))
__device__ __forceinline__ unsigned xb_ld(unsigned* p)              { return __hip_atomic_load(p, __ATOMIC_RELAXED, __HIP_MEMORY_SCOPE_AGENT); }
__device__ __forceinline__ unsigned xb_add(unsigned* p, unsigned v) { return __hip_atomic_fetch_add(p, v, __ATOMIC_RELAXED, __HIP_MEMORY_SCOPE_AGENT); }
__device__ __forceinline__ unsigned xb_xcc_id() { return (unsigned)__builtin_amdgcn_s_getreg((3 << 11) | 20) & 0xFu; }
#define XB_SPIN(cond, bar) do { unsigned _sp = 0; while (cond) { __builtin_amdgcn_s_sleep(1); \
    if ((++_sp & 255u) == 0u) { if (xb_ld(&(bar)[XB_TMO])) break; if (_sp > XB_SPIN_CAP) { atomicAdd(&(bar)[XB_TMO], 1u); break; } } } } while (0)
struct XcdBarrier { unsigned* bar; unsigned x; volatile LAS unsigned* st; };
__device__ __forceinline__ XcdBarrier xcd_barrier_post(unsigned* bar, volatile LAS unsigned* st) {
    XcdBarrier b; b.bar = bar; b.x = xb_xcc_id(); b.st = st;
    if (threadIdx.x == 0) (void)xb_add(&bar[XB_XCNT(b.x)], 1u);
    return b;
}
__device__ __forceinline__ void xcd_barrier_complete(unsigned* bar, unsigned x, unsigned& nloc, unsigned& nx) {
    const unsigned G = gridDim.x;
    unsigned sum, cnt, mine, sp = 0u;
    for (;;) {
        sum = 0u; cnt = 0u; mine = 0u;
#pragma unroll
        for (unsigned j = 0; j < 16; ++j) { const unsigned c = xb_ld(&bar[XB_XCNT(j)]); sum += c; cnt += (c > 0u) ? 1u : 0u; mine = (j == x) ? c : mine; }
        if (sum == G) break;
        __builtin_amdgcn_s_sleep(1);
        if ((++sp & 255u) == 0u) { if (xb_ld(&bar[XB_TMO])) break; if (sp > XB_SPIN_CAP) { atomicAdd(&bar[XB_TMO], 1u); break; } }
    }
    nloc = mine > 0u ? mine : 1u; nx = cnt > 0u ? cnt : 1u;
}
__device__ __forceinline__ void xcd_barrier(const XcdBarrier& b) {
    asm volatile("s_waitcnt vmcnt(0)" ::: "memory");
    __syncthreads();
    if (threadIdx.x == 0) {
        unsigned* bar = b.bar;
        __builtin_amdgcn_s_waitcnt(0);
        unsigned nloc = b.st[0], nx = b.st[1];
        if (nloc == 0u) { xcd_barrier_complete(bar, b.x, nloc, nx); b.st[0] = nloc; b.st[1] = nx; }
        const unsigned old = xb_add(&bar[XB_XSUB(b.x)], 1u);
        const unsigned gen = old / nloc;
        if (old + 1u == (gen + 1u) * nloc) {
            __builtin_amdgcn_fence(__ATOMIC_RELEASE, "agent");
            asm volatile("s_waitcnt vmcnt(0)" ::: "memory");
            const unsigned og = xb_add(&bar[XB_TOP], 1u);
            const unsigned tg = og / nx;
            if (og + 1u == (tg + 1u) * nx) xb_add(&bar[XB_TOPGEN], 1u);
            else XB_SPIN(xb_ld(&bar[XB_TOPGEN]) == tg, bar);
            __builtin_amdgcn_fence(__ATOMIC_ACQUIRE, "agent");
            xb_add(&bar[XB_XGEN(b.x)], 1u);
            asm volatile("s_waitcnt vmcnt(0)" ::: "memory");
        } else {
            XB_SPIN(xb_ld(&bar[XB_XGEN(b.x)]) == gen, bar);
            __builtin_amdgcn_fence(__ATOMIC_ACQUIRE, "agent");
            asm volatile("s_waitcnt vmcnt(0)" ::: "memory");
        }
    }
    __syncthreads();
}

#ifndef PROBE_PHASE
#define PROBE_PHASE -1
#endif
#define PH_BEGIN(k) if (PROBE_PHASE == (k)) probe_t0 = __builtin_amdgcn_s_memrealtime();
#define PH_END(k)   if (PROBE_PHASE == (k)) probe_dt = __builtin_amdgcn_s_memrealtime() - probe_t0;
constexpr int SMEM_BYTES = 128 * 132 * 4;

__global__ void __launch_bounds__(256, 2) fwd_megakernel(Params p) {
    __shared__ __attribute__((aligned(16))) unsigned char smem[SMEM_BYTES + 16];
    if (threadIdx.x == 0) *(uint4*)(smem + SMEM_BYTES) = make_uint4(0u, 0u, 0u, 0u);
    __syncthreads();
    const XcdBarrier xb = xcd_barrier_post((unsigned*)(p.ws + OFF_BAR), (volatile LAS unsigned*)(smem + SMEM_BYTES));
    const int bid = blockIdx.x, nb = gridDim.x, tid = tidx(), lane = tid & 63, wid = tid >> 6;
    unsigned char* ws = p.ws; unsigned char* dob = (unsigned char*)p.out;
    unsigned long long probe_t0 = 0, probe_dt = 0;
    PH_BEGIN(0)
    {
        for (int u = bid; u < 3232; u += nb) {
            if (u < 1600) convT_tile(p.w_in, (bf16_t*)(ws + OFF_WINT), 1024, INW, u, smem);
            else if (u < 1856) convT_tile(p.w_mem_kv, (bf16_t*)(ws + OFF_WMKVT), 1024, 1024, u - 1600, smem);
            else if (u < 2048) convT_tile(p.p_attn, (bf16_t*)(ws + OFF_PATTNT), 768, 1024, u - 1856, smem);
            else if (u < 2240) convT_tile(p.p_lru, (bf16_t*)(ws + OFF_PLRUT), 768, 1024, u - 2048, smem);
            else if (u < 2368) convT_tile(p.p_mem, (bf16_t*)(ws + OFF_PMEMT), 512, 1024, u - 2240, smem);
            else if (u < 2624) convT_tile(p.w_out, (bf16_t*)(ws + OFF_WOUTT), 1024, 1024, u - 2368, smem);
            else if (u < 3136) convT_tile(p.w_peer_q, (bf16_t*)(ws + OFF_WPQT), 1024, 2048, u - 2624, smem);
            else {
                const int v = u - 3136, mat = v >> 2, tile = v & 3, gsel = mat / 6, h = mat % 6, dir = gsel & 1;
                const float* src = (gsel < 2 ? p.lru_wr : p.lru_wi) + (size_t)(dir * 6 + h) * 128 * 128;
                convT_tile(src, (bf16_t*)(ws + OFF_LRUWT) + (size_t)(h * 512 + gsel * 128) * 128, 128, 128, tile, smem);
            }
        }
        conv_plain(p.peer_sub_keys, (bf16_t*)(ws + OFF_SUBK), (size_t)16 * 128 * 128 / 8);
        for (int r = bid * 4 + wid; r < 2 * NEXP; r += nb * 4) {
            if (r < NEXP) conv_row_fp8(p.peer_u, ws + OFF_UB, (float*)(ws + OFF_SU), r, lane);
            else conv_row_fp8(p.peer_v, ws + OFF_VB, (float*)(ws + OFF_SV), r - NEXP, lane);
        }
        for (int r = bid * 4 + wid; r < NTOK; r += nb * 4) rms_row_bf16(p.x + (size_t)r * 1024, p.g_mix, (bf16_t*)(dob + DO_HBF) + (size_t)r * 1024, lane);
        for (int r = bid * 4 + wid; r < NMEM; r += nb * 4) rms_row_bf16(p.mem + (size_t)r * 1024, p.g_mem, (bf16_t*)(dob + DO_MEMBF) + (size_t)r * 1024, lane);
        for (int i = bid * 256 + tid; i < NTOK * 16; i += nb * 256) rope_item(p.positions, (float*)(dob + DO_ROPE), i);
    }
    xcd_barrier(xb);
    PH_END(0) PH_BEGIN(1)
    for (int u = bid; u < 256 * 50 + 256; u += nb) {
        if (u < 256 * 50) inproj_tile(p, u / 50, u % 50, smem);
        else memkv_tile(p, (u - 256 * 50) / 8, (u - 256 * 50) % 8, smem);
    }
    xcd_barrier(xb);
    PH_END(1) PH_BEGIN(2)
    {
        unsigned* ctr = (unsigned*)(p.ws + OFF_BAR) + 3600;
        volatile LAS unsigned* slot = (volatile LAS unsigned*)(smem + SMEM_BYTES + 8);
        for (;;) {
            if (tid == 0) *slot = xb_add(ctr, 1u);
            __syncthreads();
            const int u = (int)*slot;
            __syncthreads();
            if (u >= 384 + 1536 + 1024) break;
            if (u < 384) lru_unit(p, u, smem);
            else if (u < 384 + 1536) attn_win_unit(p, u - 384, smem);
            else attn_mem_unit(p, u - 384 - 1536, smem);
        }
    }
    xcd_barrier(xb);
    PH_END(2) PH_BEGIN(3)
    for (int u = bid; u < 256 * 8; u += nb) merge_tile(p, u / 8, u % 8, smem);
    xcd_barrier(xb);
    PH_END(3) PH_BEGIN(4)
    for (int u = bid; u < 256 * 8; u += nb) outproj_tile(p, u / 8, u % 8, smem);
    xcd_barrier(xb);
    PH_END(4) PH_BEGIN(5)
    for (int r = bid * 4 + wid; r < NTOK; r += nb * 4) rms_row_bf16(p.out + (size_t)r * 1024, p.g_ffn, (bf16_t*)(ws + OFF_MERGED) + (size_t)r * 1024, lane);
    xcd_barrier(xb);
    PH_END(5) PH_BEGIN(6)
    for (int u = bid; u < 256 * 16; u += nb) peerq_tile(p, u / 16, u % 16, smem);
    xcd_barrier(xb);
    PH_END(6) PH_BEGIN(7)
    for (int u = bid; u < 256 * 16; u += nb) scores_tile(p, u / 16, u % 16, smem);
    xcd_barrier(xb);
    PH_END(7) PH_BEGIN(8)
    for (int i = bid * 256 + tid; i < NTOK * 8; i += nb * 256) combine_item(p, i);
    xcd_barrier(xb);
    PH_END(8) PH_BEGIN(9)
    for (int t = bid * 4 + wid; t < NTOK; t += nb * 4) gather_token(p, t, lane);
    PH_END(9)
    if (PROBE_PHASE >= 0) { __syncthreads(); const unsigned long long t1 = __builtin_amdgcn_s_memrealtime(); while (__builtin_amdgcn_s_memrealtime() - t1 < probe_dt) __builtin_amdgcn_s_sleep(8); }
}

extern "C" void kernel_launch(void* const* d_in, const int* in_sizes, int n_in, void* d_out, int out_size, void* d_ws, size_t ws_size, hipStream_t stream) {
    if (ws_size < OFF_END) { fprintf(stderr, "workspace too small: %zu < %zu\n", ws_size, (size_t)OFF_END); return; }
    Params p{};
    p.x = (const float*)d_in[0]; p.mem = (const float*)d_in[1]; p.positions = (const int*)d_in[2];
    p.g_mix = (const float*)d_in[3]; p.g_mem = (const float*)d_in[4]; p.w_in = (const float*)d_in[5]; p.gate_b = (const float*)d_in[6];
    p.attn_sink = (const float*)d_in[7]; p.conv_w = (const float*)d_in[8]; p.conv_b = (const float*)d_in[9];
    p.lru_wr = (const float*)d_in[10]; p.lru_br = (const float*)d_in[11]; p.lru_wi = (const float*)d_in[12]; p.lru_bi = (const float*)d_in[13];
    p.lru_lambda = (const float*)d_in[14]; p.w_mem_kv = (const float*)d_in[15]; p.p_attn = (const float*)d_in[16]; p.p_lru = (const float*)d_in[17];
    p.p_mem = (const float*)d_in[18]; p.w_out = (const float*)d_in[19]; p.g_ffn = (const float*)d_in[20]; p.w_peer_q = (const float*)d_in[21];
    p.peer_sub_keys = (const float*)d_in[22]; p.peer_u = (const float*)d_in[23]; p.peer_v = (const float*)d_in[24]; p.g_final = (const float*)d_in[25];
    p.out = (float*)d_out; p.ws = (unsigned char*)d_ws;
    static int grid_blocks = 0;
    if (!grid_blocks) {
        int dev = 0, cus = 0, per_cu = 0;
        (void)hipGetDevice(&dev);
        (void)hipDeviceGetAttribute(&cus, hipDeviceAttributeMultiprocessorCount, dev);
        (void)hipOccupancyMaxActiveBlocksPerMultiprocessor(&per_cu, fwd_megakernel, 256, 0);
        if (per_cu > 2) per_cu = 2;
        grid_blocks = cus * per_cu;
    }
    (void)hipMemsetAsync((unsigned char*)d_ws + OFF_BAR, 0, 16384, stream);
    void* args[] = {&p};
    hipError_t e = hipLaunchCooperativeKernel((void*)fwd_megakernel, dim3(grid_blocks), dim3(256), args, 0, stream);
    if (e != hipSuccess) fprintf(stderr, "cooperative launch failed: %s (grid %d)\n", hipGetErrorString(e), grid_blocks);
}
```

```cpp
#include <hip/hip_runtime.h>
#include <stdint.h>
#include <stdio.h>

typedef unsigned short bf16_t;
typedef short bf16x8 __attribute__((ext_vector_type(8)));
typedef __bf16 bf16x2v __attribute__((ext_vector_type(2)));
typedef float f32x4 __attribute__((ext_vector_type(4)));

constexpr int B_ = 16, S_ = 2048, D_ = 1024, NTOK = B_ * S_;
constexpr int MEML = 256, NMEM = B_ * MEML;
constexpr int INW = 6400;
constexpr int LW = 768;
constexpr int NEXP = 16384;
constexpr float EPS = 1e-6f;
constexpr float QSCALE = 0.08838834764831845f * 1.4426950408889634f;

constexpr size_t OFF_WINT = 0;
constexpr size_t OFF_WMKVT = OFF_WINT + (size_t)INW * 1024 * 2;
constexpr size_t OFF_PATTNT = OFF_WMKVT + (size_t)1024 * 1024 * 2;
constexpr size_t OFF_PLRUT = OFF_PATTNT + (size_t)1024 * 768 * 2;
constexpr size_t OFF_PMEMT = OFF_PLRUT + (size_t)1024 * 768 * 2;
constexpr size_t OFF_WOUTT = OFF_PMEMT + (size_t)1024 * 512 * 2;
constexpr size_t OFF_WPQT = OFF_WOUTT + (size_t)1024 * 1024 * 2;
constexpr size_t OFF_LRUWT = OFF_WPQT + (size_t)2048 * 1024 * 2;
constexpr size_t OFF_SUBK = OFF_LRUWT + (size_t)6 * 512 * 128 * 2;
constexpr size_t OFF_UB = OFF_SUBK + (size_t)16 * 128 * 128 * 2;
constexpr size_t OFF_VB = OFF_UB + (size_t)NEXP * 1024;
constexpr size_t OFF_SU = OFF_VB + (size_t)NEXP * 1024;
constexpr size_t OFF_SV = OFF_SU + (size_t)NEXP * 4;
constexpr size_t OFF_RA = OFF_SV + (size_t)NEXP * 4;
constexpr size_t OFF_QA = OFF_RA;
constexpr size_t OFF_KA = OFF_QA + (size_t)NTOK * 768 * 2;
constexpr size_t OFF_VAT = OFF_KA + (size_t)NTOK * 256 * 2;
constexpr size_t OFF_XL = OFF_VAT + (size_t)NTOK * 256 * 2;
constexpr size_t OFF_GL = OFF_XL + (size_t)NTOK * 768 * 2;
constexpr size_t OFF_QM = OFF_GL + (size_t)NTOK * 768 * 2;
constexpr size_t OFF_GATES = OFF_QM + (size_t)NTOK * 512 * 2;
constexpr size_t OFF_BAR = OFF_GATES + (size_t)NTOK * 3072 * 2;
constexpr size_t OFF_END = OFF_BAR + 16384;
constexpr size_t OFF_MERGED = OFF_KA;
constexpr size_t OFF_QPEER = OFF_GATES;
constexpr size_t OFF_TOPL = OFF_QPEER + (size_t)NTOK * 2048 * 2;
constexpr size_t OFF_EIDX = OFF_TOPL + (size_t)NTOK * 256 * 4;
constexpr size_t OFF_EGATE = OFF_EIDX + (size_t)NTOK * 128 * 4;
static_assert(OFF_EGATE + (size_t)NTOK * 128 * 4 <= OFF_BAR, "overlay");
static_assert(OFF_MERGED + (size_t)NTOK * 1024 * 2 <= OFF_GL, "overlay2");
constexpr size_t DO_HBF = 0;
constexpr size_t DO_MEMBF = DO_HBF + (size_t)NTOK * 1024 * 2;
constexpr size_t DO_KM = DO_MEMBF + (size_t)NMEM * 1024 * 2;
constexpr size_t DO_VMT = DO_KM + (size_t)NMEM * 512 * 2;
constexpr size_t DO_ROPE = DO_VMT + (size_t)NMEM * 512 * 2;
static_assert(DO_ROPE + (size_t)NTOK * 32 * 4 <= (size_t)NTOK * 1024 * 4, "d_out scratch");

struct Params {
    const float *x, *mem; const int* positions;
    const float *g_mix, *g_mem, *w_in, *gate_b, *attn_sink, *conv_w, *conv_b, *lru_wr, *lru_br, *lru_wi, *lru_bi, *lru_lambda,
        *w_mem_kv, *p_attn, *p_lru, *p_mem, *w_out, *g_ffn, *w_peer_q, *peer_sub_keys, *peer_u, *peer_v, *g_final;
    float* out; unsigned char* ws;
};

__device__ __forceinline__ int tidx() { int t = threadIdx.x; asm volatile("" : "+v"(t)); return t; }
__device__ __forceinline__ float bf2f(bf16_t b) { return __uint_as_float(((unsigned)b) << 16); }
__device__ __forceinline__ float bflo(unsigned u) { return __uint_as_float(u << 16); }
__device__ __forceinline__ float bfhi(unsigned u) { return __uint_as_float(u & 0xffff0000u); }
typedef float f32x2v __attribute__((ext_vector_type(2)));
__device__ __forceinline__ unsigned pack_bf16(float lo, float hi) { const f32x2v f = {lo, hi}; return __builtin_bit_cast(unsigned, __builtin_convertvector(f, bf16x2v)); }
__device__ __forceinline__ bf16_t f2bf(float f) { return (bf16_t)(pack_bf16(f, 0.f) & 0xffffu); }
__device__ __forceinline__ f32x4 mfma16(bf16x8 a, bf16x8 b, f32x4 c) { return __builtin_amdgcn_mfma_f32_16x16x32_bf16(a, b, c, 0, 0, 0); }
__device__ __forceinline__ float sigmoidf_(float x) { return __builtin_amdgcn_rcpf(1.0f + __expf(-x)); }
__device__ __forceinline__ float gelu_tanh(float x) { const float u = 1.5957691216057308f * (x + 0.044715f * x * x * x); return x * __builtin_amdgcn_rcpf(1.0f + __expf(-u)); }
__device__ __forceinline__ float wave_sum(float v) {
#pragma unroll
    for (int o = 32; o >= 1; o >>= 1) v += __shfl_xor(v, o);
    return v;
}

__device__ void convT_tile(const float* __restrict__ src, bf16_t* __restrict__ dst, int K, int N, int tile, unsigned char* smem) {
    float* t = (float*)smem;
    const int tn = N / 64, tk = tile / tn, tnn = tile % tn, k0 = tk * 64, n0 = tnn * 64, tid = tidx();
    const int r = tid >> 4, c4 = (tid & 15) * 4;
#pragma unroll
    for (int i = 0; i < 4; ++i) {
        const int k = r + 16 * i;
        const float4 v = *(const float4*)(src + (size_t)(k0 + k) * N + n0 + c4);
        t[k * 65 + c4 + 0] = v.x; t[k * 65 + c4 + 1] = v.y; t[k * 65 + c4 + 2] = v.z; t[k * 65 + c4 + 3] = v.w;
    }
    __syncthreads();
    const int n = tid >> 2, kq = (tid & 3) * 16;
    unsigned w[8];
#pragma unroll
    for (int i = 0; i < 8; ++i) w[i] = pack_bf16(t[(kq + 2 * i) * 65 + n], t[(kq + 2 * i + 1) * 65 + n]);
    uint4* d = (uint4*)(dst + (size_t)(n0 + n) * K + k0 + kq);
    d[0] = make_uint4(w[0], w[1], w[2], w[3]); d[1] = make_uint4(w[4], w[5], w[6], w[7]);
    __syncthreads();
}


__device__ __forceinline__ void rms_row_bf16(const float* __restrict__ xr, const float* __restrict__ g, bf16_t* __restrict__ o, int lane) {
    float4 v[4]; float ss = 0.f;
#pragma unroll
    for (int i = 0; i < 4; ++i) { v[i] = *(const float4*)(xr + i * 256 + lane * 4); ss += v[i].x * v[i].x + v[i].y * v[i].y + v[i].z * v[i].z + v[i].w * v[i].w; }
    ss = wave_sum(ss);
    const float rs = rsqrtf(ss * (1.0f / 1024.0f) + EPS);
#pragma unroll
    for (int i = 0; i < 4; ++i) {
        const float4 gg = *(const float4*)(g + i * 256 + lane * 4);
        *(uint2*)(o + i * 256 + lane * 4) = make_uint2(pack_bf16(v[i].x * rs * gg.x, v[i].y * rs * gg.y), pack_bf16(v[i].z * rs * gg.z, v[i].w * rs * gg.w));
    }
}


__device__ __forceinline__ void conv_plain(const float* __restrict__ src, bf16_t* __restrict__ dst, size_t n8) {
    for (size_t i = (size_t)blockIdx.x * 256 + tidx(); i < n8; i += (size_t)gridDim.x * 256) {
        const float4 a = ((const float4*)src)[2 * i], b = ((const float4*)src)[2 * i + 1];
        ((uint4*)dst)[i] = make_uint4(pack_bf16(a.x, a.y), pack_bf16(a.z, a.w), pack_bf16(b.x, b.y), pack_bf16(b.z, b.w));
    }
}
__device__ __forceinline__ void rope_item(const int* __restrict__ pos, float* __restrict__ cs, int i) {
    const int t = i >> 4, f = i & 15;
    const float inv = powf(500000.0f, -(float)(2 * f) / 32.0f);
    const float ang = (float)pos[t] * inv;
    float s, c; sincosf(ang, &s, &c);
    cs[2 * i] = c; cs[2 * i + 1] = s;
}

__device__ __forceinline__ int swz(int row) { return (row & 3) | (((row >> 3) & 1) << 2); }

__device__ __forceinline__ void gemm_tile(const bf16_t* __restrict__ A, int lda, const bf16_t* __restrict__ Bt, int ldb, int K,
                                          f32x4 (&acc)[4][4], unsigned char* smem) {
    const int tid = tidx(), lane = tid & 63, wid = tid >> 6, wr = wid >> 1, wc = wid & 1, li = lane & 15, g = lane >> 4;
    const int srow = tid >> 3, skc = (tid & 7) ^ swz(tid >> 3);
    const bf16_t* ga = A + (size_t)srow * lda + skc * 8;
    const bf16_t* gb = Bt + (size_t)srow * ldb + skc * 8;
    unsigned char* ldst = smem + tid * 16;
    int aoff[4], boff[4], asw[4], bsw[4];
#pragma unroll
    for (int m = 0; m < 4; ++m) { const int row = wr * 64 + m * 16 + li; aoff[m] = row * 128; asw[m] = swz(row); }
#pragma unroll
    for (int n = 0; n < 4; ++n) { const int row = wc * 64 + 32 * (n >> 1) + 8 * (li >> 2) + 4 * (n & 1) + (li & 3); boff[n] = 16384 + row * 128; bsw[n] = swz(row); }
    const int nk = K >> 6;
#pragma unroll
    for (int i = 0; i < 4; ++i) {
        __builtin_amdgcn_global_load_lds((const unsigned*)(ga + (size_t)(32 * i) * lda), (unsigned*)(ldst + i * 4096), 16, 0, 0);
        __builtin_amdgcn_global_load_lds((const unsigned*)(gb + (size_t)(32 * i) * ldb), (unsigned*)(ldst + 16384 + i * 4096), 16, 0, 0);
    }
    __syncthreads();
    for (int kt = 0; kt < nk; ++kt) {
        const unsigned char* sb = smem + (kt & 1) * 32768;
        if (kt + 1 < nk) {
            unsigned char* sw = ldst + ((kt + 1) & 1) * 32768;
#pragma unroll
            for (int i = 0; i < 4; ++i) {
                __builtin_amdgcn_global_load_lds((const unsigned*)(ga + (size_t)(32 * i) * lda + (kt + 1) * 64), (unsigned*)(sw + i * 4096), 16, 0, 0);
                __builtin_amdgcn_global_load_lds((const unsigned*)(gb + (size_t)(32 * i) * ldb + (kt + 1) * 64), (unsigned*)(sw + 16384 + i * 4096), 16, 0, 0);
            }
        }
#pragma unroll
        for (int ks = 0; ks < 2; ++ks) {
            bf16x8 af[4], bfr[4];
#pragma unroll
            for (int m = 0; m < 4; ++m) af[m] = *(const bf16x8*)(sb + aoff[m] + (((ks * 4 + g) ^ asw[m]) << 4));
#pragma unroll
            for (int n = 0; n < 4; ++n) bfr[n] = *(const bf16x8*)(sb + boff[n] + (((ks * 4 + g) ^ bsw[n]) << 4));
#pragma unroll
            for (int m = 0; m < 4; ++m)
#pragma unroll
                for (int n = 0; n < 4; ++n) acc[m][n] = mfma16(bfr[n], af[m], acc[m][n]);
        }
        __syncthreads();
    }
}
__device__ __forceinline__ void acc_zero(f32x4 (&acc)[4][4]) {
#pragma unroll
    for (int m = 0; m < 4; ++m)
#pragma unroll
        for (int n = 0; n < 4; ++n) acc[m][n] = (f32x4){0.f, 0.f, 0.f, 0.f};
}
template <class F> __device__ __forceinline__ void epi_foreach(const f32x4 (&acc)[4][4], F&& f) {
    const int lane = tidx() & 63, wid = tidx() >> 6, wr = wid >> 1, wc = wid & 1, li = lane & 15, g = lane >> 4;
#pragma unroll
    for (int m = 0; m < 4; ++m)
#pragma unroll
        for (int pp = 0; pp < 2; ++pp) {
            float v[8];
#pragma unroll
            for (int r = 0; r < 4; ++r) { v[r] = acc[m][2 * pp][r]; v[4 + r] = acc[m][2 * pp + 1][r]; }
            f(wr * 64 + m * 16 + li, wc * 64 + 32 * pp + 8 * g, v, pp);
        }
}
__device__ __forceinline__ void store_bf16x8(bf16_t* p, const float (&v)[8]) {
    *(uint4*)p = make_uint4(pack_bf16(v[0], v[1]), pack_bf16(v[2], v[3]), pack_bf16(v[4], v[5]), pack_bf16(v[6], v[7]));
}
__device__ __forceinline__ void store_tile_T(const f32x4 (&acc)[4][4], bf16_t* __restrict__ dstT, int ldt, unsigned char* smem) {
    bf16_t* t = (bf16_t*)smem;
    epi_foreach(acc, [&](int r, int c, const float (&v)[8], int) {
#pragma unroll
        for (int e = 0; e < 8; ++e) t[(c + e) * 136 + r] = f2bf(v[e]);
    });
    __syncthreads();
#pragma unroll
    for (int i = 0; i < 8; ++i) {
        const int ch = tidx() + 256 * i, d = ch >> 4, tc = ch & 15;
        *(uint4*)(dstT + (size_t)d * ldt + tc * 8) = *(const uint4*)(smem + d * 272 + tc * 16);
    }
    __syncthreads();
}

__device__ void inproj_tile(const Params& p, int rt, int ct, unsigned char* smem) {
    unsigned char* ws = p.ws; unsigned char* dob = (unsigned char*)p.out;
    const bf16_t* hbf = (const bf16_t*)(dob + DO_HBF);
    const bf16_t* WinT = (const bf16_t*)(ws + OFF_WINT);
    f32x4 acc[4][4]; acc_zero(acc);
    gemm_tile(hbf + (size_t)rt * 128 * 1024, 1024, WinT + (size_t)ct * 128 * 1024, 1024, 1024, acc, smem);
    const int row0 = rt * 128;
    if (ct < 8) {
        const float* cs = (const float*)(dob + DO_ROPE);
        const bool isq = ct < 6;
        bf16_t* dst = isq ? (bf16_t*)(ws + OFF_QA) + ct * 128 : (bf16_t*)(ws + OFF_KA) + (ct - 6) * 128;
        const int ld = isq ? 768 : 256;
        const float sc = isq ? QSCALE : 1.0f;
        const int g = (tidx() & 63) >> 4;
        epi_foreach(acc, [&](int r, int c, float (&v)[8], int pp) {
            const int tok = row0 + r;
            if (pp == 0 && c < 32) {
                const float* csr = cs + (size_t)tok * 32 + (g & 1) * 16;
#pragma unroll
                for (int e = 0; e < 8; ++e) {
                    const float o = __shfl_xor(v[e], 32);
                    const float cc = csr[2 * e], ss = csr[2 * e + 1];
                    v[e] = (g < 2) ? (v[e] * cc - o * ss) : (v[e] * cc + o * ss);
                }
            }
#pragma unroll
            for (int e = 0; e < 8; ++e) v[e] *= sc;
            store_bf16x8(dst + (size_t)tok * ld + c, v);
        });
    } else if (ct < 10) {
        const int kvh = ct - 8, b = row0 / S_, s0 = row0 % S_;
        store_tile_T(acc, (bf16_t*)(ws + OFF_VAT) + (size_t)(b * 2 + kvh) * 128 * S_ + s0, S_, smem);
    } else if (ct < 16) {
        bf16_t* dst = (bf16_t*)(ws + OFF_XL) + (ct - 10) * 128;
        epi_foreach(acc, [&](int r, int c, float (&v)[8], int) { store_bf16x8(dst + (size_t)(row0 + r) * 768 + c, v); });
    } else if (ct < 22) {
        bf16_t* dst = (bf16_t*)(ws + OFF_GL) + (ct - 16) * 128;
        epi_foreach(acc, [&](int r, int c, float (&v)[8], int) {
#pragma unroll
            for (int e = 0; e < 8; ++e) v[e] = gelu_tanh(v[e]);
            store_bf16x8(dst + (size_t)(row0 + r) * 768 + c, v); });
    } else if (ct < 26) {
        bf16_t* dst = (bf16_t*)(ws + OFF_QM) + (ct - 22) * 128;
        epi_foreach(acc, [&](int r, int c, float (&v)[8], int) {
#pragma unroll
            for (int e = 0; e < 8; ++e) v[e] *= QSCALE;
            store_bf16x8(dst + (size_t)(row0 + r) * 512 + c, v); });
    } else {
        const int gc0 = (ct - 26) * 128;
        bf16_t* dst = (bf16_t*)(ws + OFF_GATES) + gc0;
        const float* gb = p.gate_b + gc0;
        epi_foreach(acc, [&](int r, int c, float (&v)[8], int) {
            const float4 b0 = *(const float4*)(gb + c), b1 = *(const float4*)(gb + c + 4);
            v[0] = sigmoidf_(v[0] + b0.x); v[1] = sigmoidf_(v[1] + b0.y); v[2] = sigmoidf_(v[2] + b0.z); v[3] = sigmoidf_(v[3] + b0.w);
            v[4] = sigmoidf_(v[4] + b1.x); v[5] = sigmoidf_(v[5] + b1.y); v[6] = sigmoidf_(v[6] + b1.z); v[7] = sigmoidf_(v[7] + b1.w);
            store_bf16x8(dst + (size_t)(row0 + r) * 3072 + c, v); });
    }
}

__device__ void memkv_tile(const Params& p, int rt, int ct, unsigned char* smem) {
    unsigned char* dob = (unsigned char*)p.out;
    f32x4 acc[4][4]; acc_zero(acc);
    gemm_tile((const bf16_t*)(dob + DO_MEMBF) + (size_t)rt * 128 * 1024, 1024, (const bf16_t*)(p.ws + OFF_WMKVT) + (size_t)ct * 128 * 1024, 1024, 1024, acc, smem);
    const int row0 = rt * 128;
    if (ct < 4) {
        bf16_t* dst = (bf16_t*)(dob + DO_KM) + ct * 128;
        epi_foreach(acc, [&](int r, int c, float (&v)[8], int) { store_bf16x8(dst + (size_t)(row0 + r) * 512 + c, v); });
    } else {
        const int h = ct - 4, b = row0 / MEML, m0 = row0 % MEML;
        store_tile_T(acc, (bf16_t*)(dob + DO_VMT) + (size_t)(b * 4 + h) * 128 * MEML + m0, MEML, smem);
    }
}


typedef float f32x16 __attribute__((ext_vector_type(16)));
__device__ __forceinline__ f32x16 mfma32(bf16x8 a, bf16x8 b, f32x16 c) { return __builtin_amdgcn_mfma_f32_32x32x16_bf16(a, b, c, 0, 0, 0); }
constexpr int ATT_STAGE = 16384 + 128 * 136;

template <bool WIN>
__device__ void attn_block(const bf16_t* Qg, int ldq, const bf16_t* __restrict__ Kg, int ldk, const bf16_t* __restrict__ Vtg, int ldv,
                           int q0, int kt0, int nt, float sink2, bf16_t* Og, int ldo, unsigned char* smem) {
    const int tid = tidx(), lane = tid & 63, wid = tid >> 6, r = lane & 31, hh = lane >> 5;
    const int qw = q0 + 32 * wid;
    bf16x8 qf[8];
#pragma unroll
    for (int ks = 0; ks < 8; ++ks) qf[ks] = *(const bf16x8*)(Qg + (size_t)(32 * wid + r) * ldq + ks * 16 + hh * 8);
    f32x16 o[4];
#pragma unroll
    for (int db = 0; db < 4; ++db)
#pragma unroll
        for (int e = 0; e < 16; ++e) o[db][e] = 0.f;
    float m = WIN ? sink2 : -1e30f, l = WIN ? 1.0f : 0.0f;
    const int krow = tid >> 4, kch = tid & 15, vrow = tid >> 3, vch = tid & 7;
    const int koff = krow * 256 + ((kch ^ (krow & 15)) << 4);
    const int voff = 16384 + vrow * 136 + vch * 16;
    uint4 rk[4], rv[4];
    const bf16_t* kgp = Kg + (size_t)(kt0 * 64 + krow) * ldk + kch * 8;
    const bf16_t* vgp = Vtg + (size_t)vrow * ldv + kt0 * 64 + vch * 8;
#pragma unroll
    for (int i = 0; i < 4; ++i) { rk[i] = *(const uint4*)(kgp + (size_t)(16 * i) * ldk); rv[i] = *(const uint4*)(vgp + (size_t)(32 * i) * ldv); }
#pragma unroll
    for (int i = 0; i < 4; ++i) {
        *(uint4*)(smem + koff + i * 4096) = rk[i];
        *(uint2*)(smem + voff + i * 4352) = make_uint2(rv[i].x, rv[i].y); *(uint2*)(smem + voff + i * 4352 + 8) = make_uint2(rv[i].z, rv[i].w);
    }
    __syncthreads();
    for (int t = 0; t < nt; ++t) {
        const unsigned char* sb = smem + (t & 1) * ATT_STAGE;
        {
            const int tn = t + 1 < nt ? t + 1 : t;
#pragma unroll
            for (int i = 0; i < 4; ++i) { rk[i] = *(const uint4*)(kgp + (size_t)(tn * 64 + 16 * i) * ldk); rv[i] = *(const uint4*)(vgp + (size_t)(32 * i) * ldv + tn * 64); }
        }
        const int k0 = (kt0 + t) * 64;
        if (!WIN || (k0 + 63 >= qw - 128 && k0 <= qw + 159)) {
#pragma unroll
            for (int kb = 0; kb < 2; ++kb) {
                const int kb0 = k0 + 32 * kb;
                if (WIN && !(kb0 + 31 >= qw - 128 && kb0 <= qw + 159)) continue;
                f32x16 s;
#pragma unroll
                for (int e = 0; e < 16; ++e) s[e] = 0.f;
                const int row = kb * 32 + r;
#pragma unroll
                for (int ks = 0; ks < 8; ++ks) {
                    const bf16x8 a = *(const bf16x8*)(sb + row * 256 + (((2 * ks + hh) ^ (row & 15)) << 4));
                    s = mfma32(a, qf[ks], s);
                }
                if (WIN && !(kb0 >= qw - 97 && kb0 + 31 <= qw + 128)) {
#pragma unroll
                    for (int e = 0; e < 16; ++e) {
                        const int d = kb0 + (e & 3) + 8 * (e >> 2) + 4 * hh - (qw + r);
                        s[e] = (d <= 128 && d >= -128) ? s[e] : -1e30f;
                    }
                }
                float mx = s[0];
#pragma unroll
                for (int e = 1; e < 16; ++e) mx = fmaxf(mx, s[e]);
                mx = fmaxf(mx, __shfl_xor(mx, 32));
                const float mnew = fmaxf(m, mx), alpha = __builtin_amdgcn_exp2f(m - mnew);
                m = mnew;
                float ps = 0.f;
#pragma unroll
                for (int e = 0; e < 16; ++e) { s[e] = __builtin_amdgcn_exp2f(s[e] - mnew); ps += s[e]; }
                ps += __shfl_xor(ps, 32);
                l = l * alpha + ps;
                if (__any(alpha != 1.0f)) {
#pragma unroll
                    for (int db = 0; db < 4; ++db)
#pragma unroll
                        for (int e = 0; e < 16; ++e) o[db][e] *= alpha;
                }
#pragma unroll
                for (int s2 = 0; s2 < 2; ++s2) {
                    union { unsigned u[4]; bf16x8 v; } pb;
#pragma unroll
                    for (int e = 0; e < 4; ++e) pb.u[e] = pack_bf16(s[8 * s2 + 2 * e], s[8 * s2 + 2 * e + 1]);
#pragma unroll
                    for (int db = 0; db < 4; ++db) {
                        const unsigned char* vp = sb + 16384 + (db * 32 + r) * 136 + (kb * 32 + 16 * s2 + 4 * hh) * 2;
                        union { uint2 u[2]; bf16x8 v; } va;
                        va.u[0] = *(const uint2*)vp; va.u[1] = *(const uint2*)(vp + 16);
                        o[db] = mfma32(va.v, pb.v, o[db]);
                    }
                }
            }
        }
        {
            unsigned char* sw = smem + ((t + 1) & 1) * ATT_STAGE;
#pragma unroll
            for (int i = 0; i < 4; ++i) {
                *(uint4*)(sw + koff + i * 4096) = rk[i];
                *(uint2*)(sw + voff + i * 4352) = make_uint2(rv[i].x, rv[i].y); *(uint2*)(sw + voff + i * 4352 + 8) = make_uint2(rv[i].z, rv[i].w);
            }
        }
        __syncthreads();
    }
    const float inv = __builtin_amdgcn_rcpf(l);
    bf16_t* orow = Og + (size_t)(32 * wid + r) * ldo + 4 * hh;
#pragma unroll
    for (int db = 0; db < 4; ++db)
#pragma unroll
        for (int gq = 0; gq < 4; ++gq)
            *(uint2*)(orow + db * 32 + 8 * gq) = make_uint2(pack_bf16(o[db][4 * gq] * inv, o[db][4 * gq + 1] * inv), pack_bf16(o[db][4 * gq + 2] * inv, o[db][4 * gq + 3] * inv));
}
__device__ void attn_win_unit(const Params& p, int u, unsigned char* smem) {
    const int gh = u % 3, qb = (u / 3) % 16, kvh = (u / 48) % 2, b = u / 96, head = kvh * 3 + gh;
    const int q0 = qb * 128;
    const int ks = q0 - 128 < 0 ? 0 : q0 - 128, ke = q0 + 256 > S_ ? S_ : q0 + 256;
    bf16_t* Q = (bf16_t*)(p.ws + OFF_QA) + (size_t)(b * S_ + q0) * 768 + head * 128;
    const bf16_t* Kb = (const bf16_t*)(p.ws + OFF_KA) + (size_t)(b * S_) * 256 + kvh * 128;
    const bf16_t* Vt = (const bf16_t*)(p.ws + OFF_VAT) + (size_t)(b * 2 + kvh) * 128 * S_;
    attn_block<true>(Q, 768, Kb, 256, Vt, S_, q0, ks / 64, (ke - ks) / 64, p.attn_sink[head] * 1.4426950408889634f, Q, 768, smem);
}
__device__ void attn_mem_unit(const Params& p, int u, unsigned char* smem) {
    const int qb = u % 16, head = (u / 16) % 4, b = u / 64;
    const int q0 = qb * 128;
    unsigned char* dob = (unsigned char*)p.out;
    bf16_t* Q = (bf16_t*)(p.ws + OFF_QM) + (size_t)(b * S_ + q0) * 512 + head * 128;
    const bf16_t* Kb = (const bf16_t*)(dob + DO_KM) + (size_t)(b * MEML) * 512 + head * 128;
    const bf16_t* Vt = (const bf16_t*)(dob + DO_VMT) + (size_t)(b * 4 + head) * 128 * MEML;
    attn_block<false>(Q, 512, Kb, 512, Vt, MEML, q0, 0, 4, 0.f, Q, 512, smem);
}

__device__ __forceinline__ void lru_load_x(unsigned (&xw)[19], const bf16_t* __restrict__ Xl, int sbase, int cch) {
#pragma unroll
    for (int i = 0; i < 19; ++i) {
        const int s = sbase + i - 2;
        xw[i] = (s >= 0 && s < S_) ? *(const unsigned*)(Xl + (size_t)s * 768 + cch) : 0u;
    }
}
__device__ void lru_unit(const Params& p, int u, unsigned char* smem) {
    const int tid = tidx(), lane = tid & 63, wid = tid >> 6, li = lane & 15, g = lane >> 4;
    const int qt = u & 3, h = (u >> 2) % 6, b = u / 24;
    const int cbase = h * 128, cq0 = cbase + qt * 32;
    unsigned char* xcs = smem; unsigned char* wl = smem + 16384;
    float* pre = (float*)(smem + 32768); float* xcf = (float*)(smem + 49152);
    float* cA = (float*)(smem + 57344); float* cH = cA + 256; float* h0 = cH + 256;
    const bf16_t* Xl = (const bf16_t*)(p.ws + OFF_XL) + (size_t)(b * S_) * 768;
    bf16_t* Gl = (bf16_t*)(p.ws + OFF_GL) + (size_t)(b * S_) * 768;
    bf16_t* Hf = (bf16_t*)((unsigned char*)p.out + DO_HBF) + (size_t)(b * S_) * 768;
    const bf16_t* LruWt = (const bf16_t*)(p.ws + OFF_LRUWT);
    const int cp = tid & 63, tq = tid >> 6, cch = cbase + 2 * cp;
    float cw[4][2];
#pragma unroll
    for (int j = 0; j < 4; ++j) { cw[j][0] = p.conv_w[j * LW + cch]; cw[j][1] = p.conv_w[j * LW + cch + 1]; }
    const float cb0 = p.conv_b[cch], cb1 = p.conv_b[cch + 1];
    const int sc_c = tid & 31, sub = tid >> 5, sch = cq0 + sc_c;
    for (int dir = 0; dir < 2; ++dir) {
        __syncthreads();
#pragma unroll
        for (int i = 0; i < 4; ++i) {
            const int ch = tid + 256 * i, j = ch >> 4, kc = ch & 15;
            const int srcrow = h * 512 + ((j >> 5) * 2 + dir) * 128 + qt * 32 + (j & 31);
            *(uint4*)(wl + j * 256 + ((kc ^ (j & 15)) << 4)) = *(const uint4*)(LruWt + (size_t)srcrow * 128 + kc * 8);
        }
        const float br = p.lru_br[dir * LW + sch], bi = p.lru_bi[dir * LW + sch];
        const float lam = p.lru_lambda[dir * LW + sch];
        const float sp8 = -8.0f * log1pf(__expf(-lam));
        if (tid < 32) h0[tid] = 0.f;
        unsigned xw[19];
        lru_load_x(xw, Xl, (dir ? 31 : 0) * 64 + 16 * tq, cch);
        for (int ci = 0; ci < 32; ++ci) {
            const int chunk = dir ? 31 - ci : ci, s0 = chunk * 64;
#pragma unroll
            for (int i = 0; i < 16; ++i) {
                const int t = 16 * tq + i;
                const float y0 = cb0 + cw[0][0] * bflo(xw[i]) + cw[1][0] * bflo(xw[i + 1]) + cw[2][0] * bflo(xw[i + 2]) + cw[3][0] * bflo(xw[i + 3]);
                const float y1 = cb1 + cw[0][1] * bfhi(xw[i]) + cw[1][1] * bfhi(xw[i + 1]) + cw[2][1] * bfhi(xw[i + 2]) + cw[3][1] * bfhi(xw[i + 3]);
                *(unsigned*)(xcs + t * 256 + (((cp >> 2) ^ (t & 15)) << 4) + (cp & 3) * 4) = pack_bf16(y0, y1);
                if ((cp >> 4) == qt) { xcf[t * 32 + 2 * (cp & 15)] = y0; xcf[t * 32 + 2 * (cp & 15) + 1] = y1; }
            }
            if (ci + 1 < 32) lru_load_x(xw, Xl, (dir ? 30 - ci : ci + 1) * 64 + 16 * tq, cch);
            float hfv[8], glv[8];
            if (dir) {
#pragma unroll
                for (int k = 0; k < 8; ++k) {
                    const size_t gi = (size_t)(s0 + 63 - (sub * 8 + k)) * 768 + sch;
                    hfv[k] = bf2f(Hf[gi]); glv[k] = bf2f(Gl[gi]);
                }
            }
            __syncthreads();
            {
                f32x4 a[4];
#pragma unroll
                for (int n = 0; n < 4; ++n) a[n] = (f32x4){0.f, 0.f, 0.f, 0.f};
#pragma unroll
                for (int ks = 0; ks < 4; ++ks) {
                    const int row = wid * 16 + li;
                    const bf16x8 xf = *(const bf16x8*)(xcs + row * 256 + (((ks * 4 + g) ^ (row & 15)) << 4));
#pragma unroll
                    for (int n = 0; n < 4; ++n) {
                        const int j = n * 16 + li;
                        const bf16x8 wf = *(const bf16x8*)(wl + j * 256 + (((ks * 4 + g) ^ (j & 15)) << 4));
                        a[n] = mfma16(xf, wf, a[n]);
                    }
                }
#pragma unroll
                for (int n = 0; n < 4; ++n)
#pragma unroll
                    for (int r = 0; r < 4; ++r) pre[(wid * 16 + 4 * g + r) * 64 + n * 16 + li] = a[n][r];
            }
            __syncthreads();
            float hl[8], ap[8];
            {
                float hh = 0.f, aa = 1.f;
#pragma unroll
                for (int k = 0; k < 8; ++k) {
                    const int pp = sub * 8 + k, t = dir ? 63 - pp : pp;
                    const float r = sigmoidf_(pre[t * 64 + sc_c] + br), ig = sigmoidf_(pre[t * 64 + 32 + sc_c] + bi);
                    const float a = __expf(sp8 * r);
                    const float bx = sqrtf(fmaxf(1.0f - a * a, 0.f)) * (ig * xcf[t * 32 + sc_c]);
                    hh = a * hh + bx; aa *= a; hl[k] = hh; ap[k] = aa;
                }
                cA[sub * 32 + sc_c] = aa; cH[sub * 32 + sc_c] = hh;
            }
            __syncthreads();
            {
                float hin = h0[(ci & 1) * 32 + sc_c];
                for (int s2 = 0; s2 < sub; ++s2) hin = cA[s2 * 32 + sc_c] * hin + cH[s2 * 32 + sc_c];
#pragma unroll
                for (int k = 0; k < 8; ++k) {
                    const int pp = sub * 8 + k, t = dir ? 63 - pp : pp;
                    const float hv = hl[k] + ap[k] * hin;
                    const size_t gi = (size_t)(s0 + t) * 768 + sch;
                    if (dir == 0) Hf[gi] = f2bf(hv);
                    else Gl[gi] = f2bf((hfv[k] + hv) * glv[k]);
                    if (k == 7 && sub == 7) h0[((ci + 1) & 1) * 32 + sc_c] = hv;
                }
            }
        }
    }
    __syncthreads();
}

__device__ void merge_tile(const Params& p, int rt, int ct, unsigned char* smem) {
    unsigned char* ws = p.ws;
    const int row0 = rt * 128, col0 = ct * 128;
    uint4 tot[4][2];
    const bf16_t* G = (const bf16_t*)(ws + OFF_GATES);
    const int lane = tidx() & 63, wid = tidx() >> 6, wr = wid >> 1, wc = wid & 1, li = lane & 15, g = lane >> 4;
#pragma unroll 1
    for (int br = 0; br < 3; ++br) {
        const bf16_t* Ab = (const bf16_t*)(ws + (br == 0 ? OFF_QA : (br == 1 ? OFF_GL : OFF_QM)));
        const bf16_t* Bb = (const bf16_t*)(ws + (br == 0 ? OFF_PATTNT : (br == 1 ? OFF_PLRUT : OFF_PMEMT)));
        const int Kb = br == 2 ? 512 : 768;
        f32x4 acc[4][4]; acc_zero(acc);
        gemm_tile(Ab + (size_t)row0 * Kb, Kb, Bb + (size_t)col0 * Kb, Kb, Kb, acc, smem);
#pragma unroll
        for (int m = 0; m < 4; ++m)
#pragma unroll
            for (int pp = 0; pp < 2; ++pp) {
                const int r = wr * 64 + m * 16 + li, c = wc * 64 + 32 * pp + 8 * g;
                const uint4 gv = *(const uint4*)(G + (size_t)(row0 + r) * 3072 + br * 1024 + col0 + c);
                float v[8];
                v[0] = bflo(gv.x) * acc[m][2 * pp][0]; v[1] = bfhi(gv.x) * acc[m][2 * pp][1];
                v[2] = bflo(gv.y) * acc[m][2 * pp][2]; v[3] = bfhi(gv.y) * acc[m][2 * pp][3];
                v[4] = bflo(gv.z) * acc[m][2 * pp + 1][0]; v[5] = bfhi(gv.z) * acc[m][2 * pp + 1][1];
                v[6] = bflo(gv.w) * acc[m][2 * pp + 1][2]; v[7] = bfhi(gv.w) * acc[m][2 * pp + 1][3];
                if (br > 0) {
                    const uint4 t = tot[m][pp];
                    v[0] += bflo(t.x); v[1] += bfhi(t.x); v[2] += bflo(t.y); v[3] += bfhi(t.y);
                    v[4] += bflo(t.z); v[5] += bfhi(t.z); v[6] += bflo(t.w); v[7] += bfhi(t.w);
                }
                tot[m][pp] = make_uint4(pack_bf16(v[0], v[1]), pack_bf16(v[2], v[3]), pack_bf16(v[4], v[5]), pack_bf16(v[6], v[7]));
            }
    }
    bf16_t* dst = (bf16_t*)(ws + OFF_MERGED) + col0;
#pragma unroll
    for (int m = 0; m < 4; ++m)
#pragma unroll
        for (int pp = 0; pp < 2; ++pp) {
            const int r = wr * 64 + m * 16 + li, c = wc * 64 + 32 * pp + 8 * g;
            *(uint4*)(dst + (size_t)(row0 + r) * 1024 + c) = tot[m][pp];
        }
}
__device__ void outproj_tile(const Params& p, int rt, int ct, unsigned char* smem) {
    const int row0 = rt * 128, col0 = ct * 128;
    f32x4 acc[4][4]; acc_zero(acc);
    gemm_tile((const bf16_t*)(p.ws + OFF_MERGED) + (size_t)row0 * 1024, 1024, (const bf16_t*)(p.ws + OFF_WOUTT) + (size_t)col0 * 1024, 1024, 1024, acc, smem);
    epi_foreach(acc, [&](int r, int c, float (&v)[8], int) {
        const size_t o = (size_t)(row0 + r) * 1024 + col0 + c;
        const float4 x0 = *(const float4*)(p.x + o), x1 = *(const float4*)(p.x + o + 4);
        *(float4*)(p.out + o) = make_float4(x0.x + v[0], x0.y + v[1], x0.z + v[2], x0.w + v[3]);
        *(float4*)(p.out + o + 4) = make_float4(x1.x + v[4], x1.y + v[5], x1.z + v[6], x1.w + v[7]);
    });
}

__device__ void peerq_tile(const Params& p, int rt, int ct, unsigned char* smem) {
    const int row0 = rt * 128, col0 = ct * 128;
    f32x4 acc[4][4]; acc_zero(acc);
    gemm_tile((const bf16_t*)(p.ws + OFF_MERGED) + (size_t)row0 * 1024, 1024, (const bf16_t*)(p.ws + OFF_WPQT) + (size_t)col0 * 1024, 1024, 1024, acc, smem);
    bf16_t* dst = (bf16_t*)(p.ws + OFF_QPEER) + col0;
    epi_foreach(acc, [&](int r, int c, float (&v)[8], int) { store_bf16x8(dst + (size_t)(row0 + r) * 2048 + c, v); });
}

__device__ __forceinline__ int sortable(float v) { int k = __float_as_int(v); return k ^ ((k >> 31) & 0x7fffffff); }
__device__ __forceinline__ float unsortable(int k) { return __int_as_float(k ^ ((k >> 31) & 0x7fffffff)); }
__device__ __forceinline__ void insert16(int (&lst)[16], int x) {
#pragma unroll
    for (int k = 0; k < 16; ++k) { const int hi = max(lst[k], x); x = min(lst[k], x); lst[k] = hi; }
}
__device__ void scores_tile(const Params& p, int rt, int pq, unsigned char* smem) {
    const int row0 = rt * 128;
    f32x4 acc[4][4]; acc_zero(acc);
    gemm_tile((const bf16_t*)(p.ws + OFF_QPEER) + (size_t)row0 * 2048 + pq * 128, 2048, (const bf16_t*)(p.ws + OFF_SUBK) + (size_t)pq * 128 * 128, 128, 128, acc, smem);
    float* sc = (float*)smem;
    epi_foreach(acc, [&](int r, int c, float (&v)[8], int) {
        *(float4*)(sc + r * 132 + c) = make_float4(v[0], v[1], v[2], v[3]);
        *(float4*)(sc + r * 132 + c + 4) = make_float4(v[4], v[5], v[6], v[7]); });
    __syncthreads();
    if (tidx() < 128) {
        const int r = tidx();
        int lst[16];
#pragma unroll
        for (int k = 0; k < 16; ++k) lst[k] = (int)0x80000000;
#pragma unroll 2
        for (int j4 = 0; j4 < 32; ++j4) {
            const float4 v = *(const float4*)(sc + r * 132 + j4 * 4);
            insert16(lst, (sortable(v.x) & ~127) | (j4 * 4 + 0));
            insert16(lst, (sortable(v.y) & ~127) | (j4 * 4 + 1));
            insert16(lst, (sortable(v.z) & ~127) | (j4 * 4 + 2));
            insert16(lst, (sortable(v.w) & ~127) | (j4 * 4 + 3));
        }
        int4* dst = (int4*)((int*)(p.ws + OFF_TOPL) + ((size_t)(row0 + r) * 16 + pq) * 16);
        dst[0] = make_int4(lst[0], lst[1], lst[2], lst[3]); dst[1] = make_int4(lst[4], lst[5], lst[6], lst[7]);
        dst[2] = make_int4(lst[8], lst[9], lst[10], lst[11]); dst[3] = make_int4(lst[12], lst[13], lst[14], lst[15]);
    }
    __syncthreads();
}

__device__ void combine_item(const Params& p, int item) {
    const int tok = item >> 3, hd = item & 7;
    const int* l0 = (const int*)(p.ws + OFF_TOPL) + ((size_t)tok * 16 + hd * 2) * 16;
    const int* l1 = l0 + 16;
    int k0[16], k1[16];
#pragma unroll
    for (int i = 0; i < 4; ++i) {
        const int4 a = ((const int4*)l0)[i], b = ((const int4*)l1)[i];
        k0[4 * i] = a.x; k0[4 * i + 1] = a.y; k0[4 * i + 2] = a.z; k0[4 * i + 3] = a.w;
        k1[4 * i] = b.x; k1[4 * i + 1] = b.y; k1[4 * i + 2] = b.z; k1[4 * i + 3] = b.w;
    }
    float v0[16], v1[16];
#pragma unroll
    for (int i = 0; i < 16; ++i) { v0[i] = unsortable(k0[i] & ~127); v1[i] = unsortable(k1[i] & ~127); }
    int lst[16];
#pragma unroll
    for (int k = 0; k < 16; ++k) lst[k] = (int)0x80000000;
#pragma unroll
    for (int a = 0; a < 16; ++a)
#pragma unroll
        for (int b = 0; b < 16; ++b)
            if ((a + 1) * (b + 1) <= 16) insert16(lst, (sortable(v0[a] + v1[b]) & ~255) | (a * 16 + b));
    float val[16], sum = 0.f;
    const float mx = unsortable(lst[0] & ~255);
#pragma unroll
    for (int k = 0; k < 16; ++k) { val[k] = __expf(unsortable(lst[k] & ~255) - mx); sum += val[k]; }
    const float inv = 1.0f / sum;
    int* ei = (int*)(p.ws + OFF_EIDX) + (size_t)tok * 128 + hd * 16;
    float* eg = (float*)(p.ws + OFF_EGATE) + (size_t)tok * 128 + hd * 16;
#pragma unroll
    for (int k = 0; k < 16; ++k) {
        const int code = lst[k] & 255, a = code >> 4, b = code & 15;
        ei[k] = (l0[a] & 127) * 128 + (l1[b] & 127);
        eg[k] = val[k] * inv;
    }
}

__device__ __forceinline__ void conv_row_fp8(const float* __restrict__ src, unsigned char* __restrict__ dst, float* __restrict__ scale, int row, int lane) {
    const float4* s = (const float4*)(src + (size_t)row * 1024 + lane * 16);
    float4 v[4]; float am = 0.f;
#pragma unroll
    for (int i = 0; i < 4; ++i) { v[i] = s[i]; am = fmaxf(am, fmaxf(fmaxf(fabsf(v[i].x), fabsf(v[i].y)), fmaxf(fabsf(v[i].z), fabsf(v[i].w)))); }
#pragma unroll
    for (int o = 32; o >= 1; o >>= 1) am = fmaxf(am, __shfl_xor(am, o));
    const float sc = am > 0.f ? am * (1.0f / 224.0f) : 1.0f, inv = 1.0f / sc;
    unsigned w[4];
#pragma unroll
    for (int i = 0; i < 4; ++i) {
        int t = __builtin_amdgcn_cvt_pk_fp8_f32(v[i].x * inv, v[i].y * inv, 0, false);
        t = __builtin_amdgcn_cvt_pk_fp8_f32(v[i].z * inv, v[i].w * inv, t, true);
        w[i] = (unsigned)t;
    }
    *(uint4*)(dst + (size_t)row * 1024 + lane * 16) = make_uint4(w[0], w[1], w[2], w[3]);
    if (lane == 0) scale[row] = sc;
}
__device__ __forceinline__ void load8rows(uint4 (&R)[8], const unsigned char* __restrict__ tab, int es, int l0, int lane) {
#pragma unroll
    for (int j = 0; j < 8; ++j) {
        const int id = __builtin_amdgcn_readlane(es, l0 + j);
        R[j] = *(const uint4*)(tab + (size_t)id * 1024 + lane * 16);
    }
}
__device__ __forceinline__ float dot16q(const uint4& r, const float (&h)[16]) {
    const unsigned q[4] = {r.x, r.y, r.z, r.w};
    float d0 = 0.f, d1 = 0.f;
#pragma unroll
    for (int i = 0; i < 4; ++i) {
        const f32x2v a = __builtin_amdgcn_cvt_pk_f32_fp8((int)q[i], false), b = __builtin_amdgcn_cvt_pk_f32_fp8((int)q[i], true);
        d0 += a.x * h[4 * i]; d1 += a.y * h[4 * i + 1]; d0 += b.x * h[4 * i + 2]; d1 += b.y * h[4 * i + 3];
    }
    return d0 + d1;
}
__device__ __forceinline__ float dots8(const uint4 (&R)[8], const float (&h)[16], int lane) {
    float pd[8];
#pragma unroll
    for (int j = 0; j < 8; ++j) pd[j] = dot16q(R[j], h);
    const bool b5 = (lane & 32) != 0, b4 = (lane & 16) != 0, b3 = (lane & 8) != 0;
    float a[4];
#pragma unroll
    for (int j = 0; j < 4; ++j) { const float keep = b5 ? pd[4 + j] : pd[j], send = b5 ? pd[j] : pd[4 + j]; a[j] = keep + __shfl_xor(send, 32); }
    float c[2];
#pragma unroll
    for (int j = 0; j < 2; ++j) { const float keep = b4 ? a[2 + j] : a[j], send = b4 ? a[j] : a[2 + j]; c[j] = keep + __shfl_xor(send, 16); }
    float kk;
    { const float keep = b3 ? c[1] : c[0], send = b3 ? c[0] : c[1]; kk = keep + __shfl_xor(send, 8); }
    kk += __shfl_xor(kk, 4); kk += __shfl_xor(kk, 2); kk += __shfl_xor(kk, 1);
    return kk;
}
__device__ __forceinline__ void axpy8(float (&o)[16], const uint4 (&R)[8], int wsr, int bb) {
#pragma unroll
    for (int j = 0; j < 8; ++j) {
        const float c = __int_as_float(__builtin_amdgcn_readlane(wsr, 8 * j + bb));
        const unsigned q[4] = {R[j].x, R[j].y, R[j].z, R[j].w};
#pragma unroll
        for (int i = 0; i < 4; ++i) {
            const f32x2v a = __builtin_amdgcn_cvt_pk_f32_fp8((int)q[i], false), b = __builtin_amdgcn_cvt_pk_f32_fp8((int)q[i], true);
            o[4 * i] += c * a.x; o[4 * i + 1] += c * a.y; o[4 * i + 2] += c * b.x; o[4 * i + 3] += c * b.y;
        }
    }
}
__device__ void gather_token(const Params& p, int tok, int lane) {
    const bf16_t* h2 = (const bf16_t*)(p.ws + OFF_MERGED) + (size_t)tok * 1024 + lane * 16;
    const unsigned char* Uq = p.ws + OFF_UB; const unsigned char* Vq = p.ws + OFF_VB;
    const float* SU = (const float*)(p.ws + OFF_SU); const float* SV = (const float*)(p.ws + OFF_SV);
    const int* ei = (const int*)(p.ws + OFF_EIDX) + (size_t)tok * 128;
    const float* eg = (const float*)(p.ws + OFF_EGATE) + (size_t)tok * 128;
    float h[16];
    {
        const uint4 ha = *(const uint4*)h2, hb = *(const uint4*)(h2 + 8);
        const unsigned hq[8] = {ha.x, ha.y, ha.z, ha.w, hb.x, hb.y, hb.z, hb.w};
#pragma unroll
        for (int e = 0; e < 8; ++e) { h[2 * e] = bflo(hq[e]); h[2 * e + 1] = bfhi(hq[e]); }
    }
    const int pe = 8 * (lane & 7) + (lane >> 3);
    int es[2], wsr[2] = {0, 0}; float su[2], gv[2];
#pragma unroll
    for (int k = 0; k < 2; ++k) {
        es[k] = ei[64 * k + lane];
        const int e = ei[64 * k + pe];
        su[k] = SU[e]; gv[k] = eg[64 * k + pe] * SV[e];
    }
    uint4 R0[8], R1[8];
#pragma unroll
    for (int k = 0; k < 2; ++k) {
        load8rows(R0, Uq, es[k], 0, lane);
        for (int bb = 0; bb < 8; bb += 2) {
            load8rows(R1, Uq, es[k], 8 * bb + 8, lane);
            { const float w = gelu_tanh(dots8(R0, h, lane) * su[k]) * gv[k]; if ((lane & 7) == bb) wsr[k] = __float_as_int(w); }
            if (bb + 2 < 8) load8rows(R0, Uq, es[k], 8 * bb + 16, lane);
            { const float w = gelu_tanh(dots8(R1, h, lane) * su[k]) * gv[k]; if ((lane & 7) == bb + 1) wsr[k] = __float_as_int(w); }
        }
    }
    float o[16];
#pragma unroll
    for (int e = 0; e < 16; ++e) o[e] = 0.f;
#pragma unroll
    for (int k = 0; k < 2; ++k) {
        load8rows(R0, Vq, es[k], 0, lane);
        for (int bb = 0; bb < 8; bb += 2) {
            load8rows(R1, Vq, es[k], 8 * bb + 8, lane);
            axpy8(o, R0, wsr[k], bb);
            if (bb + 2 < 8) load8rows(R0, Vq, es[k], 8 * bb + 16, lane);
            axpy8(o, R1, wsr[k], bb + 1);
        }
    }
    float* xr = p.out + (size_t)tok * 1024 + lane * 16;
    float4 x[4]; float ss = 0.f;
#pragma unroll
    for (int i = 0; i < 4; ++i) {
        x[i] = *(const float4*)(xr + 4 * i);
        x[i].x += o[4 * i]; x[i].y += o[4 * i + 1]; x[i].z += o[4 * i + 2]; x[i].w += o[4 * i + 3];
        ss += x[i].x * x[i].x + x[i].y * x[i].y + x[i].z * x[i].z + x[i].w * x[i].w;
    }
    ss = wave_sum(ss);
    const float rs = rsqrtf(ss * (1.0f / 1024.0f) + EPS);
    const float* gf = p.g_final + lane * 16;
#pragma unroll
    for (int i = 0; i < 4; ++i) {
        const float4 gg = *(const float4*)(gf + 4 * i);
        *(float4*)(xr + 4 * i) = make_float4(x[i].x * rs * gg.x, x[i].y * rs * gg.y, x[i].z * rs * gg.z, x[i].w * rs * gg.w);
    }
}


__device__ __forceinline__ bool gemm_unit(int it, int nct, int& rt, int& ct) {
    const int x = blockIdx.x & 7, j = blockIdx.x >> 3, nbx = gridDim.x >> 3;
    const int v = j + it * nbx, per_rg = 8 * nct;
    if (v >= 32 * nct) return false;
    const int rgi = v / per_rg, w = v - rgi * per_rg, cg = w >> 6, w2 = w & 63;
    const int rtl = w2 & 7, ctl = w2 >> 3;
    rt = (rgi * 8 + rtl) * 8 + x; ct = cg * 8 + ctl;
    return true;
}

#define XB_TMO      128
#define XB_XCNT(j)  (256  + 64 * (j))
#define XB_XSUB(j)  (1280 + 64 * (j))
#define XB_XGEN(j)  (2304 + 64 * (j))
#define XB_TOP      3328
#define XB_TOPGEN   3392
#define XCD_BAR_WORDS 3456
#define XB_SPIN_CAP (1u << 22)
#define LAS __attribute__((address_space(3)))
__device__ __forceinline__ unsigned xb_ld(unsigned* p)              { return __hip_atomic_load(p, __ATOMIC_RELAXED, __HIP_MEMORY_SCOPE_AGENT); }
__device__ __forceinline__ unsigned xb_add(unsigned* p, unsigned v) { return __hip_atomic_fetch_add(p, v, __ATOMIC_RELAXED, __HIP_MEMORY_SCOPE_AGENT); }
__device__ __forceinline__ unsigned xb_xcc_id() { return (unsigned)__builtin_amdgcn_s_getreg((3 << 11) | 20) & 0xFu; }
#define XB_SPIN(cond, bar) do { unsigned _sp = 0; while (cond) { __builtin_amdgcn_s_sleep(1); \
    if ((++_sp & 255u) == 0u) { if (xb_ld(&(bar)[XB_TMO])) break; if (_sp > XB_SPIN_CAP) { atomicAdd(&(bar)[XB_TMO], 1u); break; } } } } while (0)
struct XcdBarrier { unsigned* bar; unsigned x; volatile LAS unsigned* st; };
__device__ __forceinline__ XcdBarrier xcd_barrier_post(unsigned* bar, volatile LAS unsigned* st) {
    XcdBarrier b; b.bar = bar; b.x = xb_xcc_id(); b.st = st;
    if (threadIdx.x == 0) (void)xb_add(&bar[XB_XCNT(b.x)], 1u);
    return b;
}
__device__ __forceinline__ void xcd_barrier_complete(unsigned* bar, unsigned x, unsigned& nloc, unsigned& nx) {
    const unsigned G = gridDim.x;
    unsigned sum, cnt, mine, sp = 0u;
    for (;;) {
        sum = 0u; cnt = 0u; mine = 0u;
#pragma unroll
        for (unsigned j = 0; j < 16; ++j) { const unsigned c = xb_ld(&bar[XB_XCNT(j)]); sum += c; cnt += (c > 0u) ? 1u : 0u; mine = (j == x) ? c : mine; }
        if (sum == G) break;
        __builtin_amdgcn_s_sleep(1);
        if ((++sp & 255u) == 0u) { if (xb_ld(&bar[XB_TMO])) break; if (sp > XB_SPIN_CAP) { atomicAdd(&bar[XB_TMO], 1u); break; } }
    }
    nloc = mine > 0u ? mine : 1u; nx = cnt > 0u ? cnt : 1u;
}
__device__ __forceinline__ void xcd_barrier(const XcdBarrier& b) {
    asm volatile("s_waitcnt vmcnt(0)" ::: "memory");
    __syncthreads();
    if (threadIdx.x == 0) {
        unsigned* bar = b.bar;
        __builtin_amdgcn_s_waitcnt(0);
        unsigned nloc = b.st[0], nx = b.st[1];
        if (nloc == 0u) { xcd_barrier_complete(bar, b.x, nloc, nx); b.st[0] = nloc; b.st[1] = nx; }
        const unsigned old = xb_add(&bar[XB_XSUB(b.x)], 1u);
        const unsigned gen = old / nloc;
        if (old + 1u == (gen + 1u) * nloc) {
            __builtin_amdgcn_fence(__ATOMIC_RELEASE, "agent");
            asm volatile("s_waitcnt vmcnt(0)" ::: "memory");
            const unsigned og = xb_add(&bar[XB_TOP], 1u);
            const unsigned tg = og / nx;
            if (og + 1u == (tg + 1u) * nx) xb_add(&bar[XB_TOPGEN], 1u);
            else XB_SPIN(xb_ld(&bar[XB_TOPGEN]) == tg, bar);
            __builtin_amdgcn_fence(__ATOMIC_ACQUIRE, "agent");
            xb_add(&bar[XB_XGEN(b.x)], 1u);
            asm volatile("s_waitcnt vmcnt(0)" ::: "memory");
        } else {
            XB_SPIN(xb_ld(&bar[XB_XGEN(b.x)]) == gen, bar);
            __builtin_amdgcn_fence(__ATOMIC_ACQUIRE, "agent");
            asm volatile("s_waitcnt vmcnt(0)" ::: "memory");
        }
    }
    __syncthreads();
}

#ifndef PROBE_PHASE
#define PROBE_PHASE -1
#endif
#define PH_BEGIN(k) if (PROBE_PHASE == (k)) probe_t0 = __builtin_amdgcn_s_memrealtime();
#define PH_END(k)   if (PROBE_PHASE == (k)) probe_dt = __builtin_amdgcn_s_memrealtime() - probe_t0;
constexpr int SMEM_BYTES = 128 * 132 * 4;

__global__ void __launch_bounds__(256, 2) fwd_megakernel(Params p) {
    __shared__ __attribute__((aligned(16))) unsigned char smem[SMEM_BYTES + 16];
    if (threadIdx.x == 0) *(uint4*)(smem + SMEM_BYTES) = make_uint4(0u, 0u, 0u, 0u);
    __syncthreads();
    const XcdBarrier xb = xcd_barrier_post((unsigned*)(p.ws + OFF_BAR), (volatile LAS unsigned*)(smem + SMEM_BYTES));
    const int bid = blockIdx.x, nb = gridDim.x, tid = tidx(), lane = tid & 63, wid = tid >> 6;
    unsigned char* ws = p.ws; unsigned char* dob = (unsigned char*)p.out;
    unsigned long long probe_t0 = 0, probe_dt = 0;
    PH_BEGIN(0)
    {
        for (int u = bid; u < 3232; u += nb) {
            if (u < 1600) convT_tile(p.w_in, (bf16_t*)(ws + OFF_WINT), 1024, INW, u, smem);
            else if (u < 1856) convT_tile(p.w_mem_kv, (bf16_t*)(ws + OFF_WMKVT), 1024, 1024, u - 1600, smem);
            else if (u < 2048) convT_tile(p.p_attn, (bf16_t*)(ws + OFF_PATTNT), 768, 1024, u - 1856, smem);
            else if (u < 2240) convT_tile(p.p_lru, (bf16_t*)(ws + OFF_PLRUT), 768, 1024, u - 2048, smem);
            else if (u < 2368) convT_tile(p.p_mem, (bf16_t*)(ws + OFF_PMEMT), 512, 1024, u - 2240, smem);
            else if (u < 2624) convT_tile(p.w_out, (bf16_t*)(ws + OFF_WOUTT), 1024, 1024, u - 2368, smem);
            else if (u < 3136) convT_tile(p.w_peer_q, (bf16_t*)(ws + OFF_WPQT), 1024, 2048, u - 2624, smem);
            else {
                const int v = u - 3136, mat = v >> 2, tile = v & 3, gsel = mat / 6, h = mat % 6, dir = gsel & 1;
                const float* src = (gsel < 2 ? p.lru_wr : p.lru_wi) + (size_t)(dir * 6 + h) * 128 * 128;
                convT_tile(src, (bf16_t*)(ws + OFF_LRUWT) + (size_t)(h * 512 + gsel * 128) * 128, 128, 128, tile, smem);
            }
        }
        conv_plain(p.peer_sub_keys, (bf16_t*)(ws + OFF_SUBK), (size_t)16 * 128 * 128 / 8);
        for (int r = bid * 4 + wid; r < 2 * NEXP; r += nb * 4) {
            if (r < NEXP) conv_row_fp8(p.peer_u, ws + OFF_UB, (float*)(ws + OFF_SU), r, lane);
            else conv_row_fp8(p.peer_v, ws + OFF_VB, (float*)(ws + OFF_SV), r - NEXP, lane);
        }
        for (int r = bid * 4 + wid; r < NTOK; r += nb * 4) rms_row_bf16(p.x + (size_t)r * 1024, p.g_mix, (bf16_t*)(dob + DO_HBF) + (size_t)r * 1024, lane);
        for (int r = bid * 4 + wid; r < NMEM; r += nb * 4) rms_row_bf16(p.mem + (size_t)r * 1024, p.g_mem, (bf16_t*)(dob + DO_MEMBF) + (size_t)r * 1024, lane);
        for (int i = bid * 256 + tid; i < NTOK * 16; i += nb * 256) rope_item(p.positions, (float*)(dob + DO_ROPE), i);
    }
    xcd_barrier(xb);
    PH_END(0) PH_BEGIN(1)
    for (int u = bid; u < 256; u += nb) memkv_tile(p, u / 8, u % 8, smem);
    { int rt, ct; for (int it = 0; gemm_unit(it, 50, rt, ct); ++it) inproj_tile(p, rt, ct, smem); }
    xcd_barrier(xb);
    PH_END(1) PH_BEGIN(2)
    {
        unsigned* ctr = (unsigned*)(p.ws + OFF_BAR) + 3600;
        volatile LAS unsigned* slot = (volatile LAS unsigned*)(smem + SMEM_BYTES + 8);
        for (;;) {
            if (tid == 0) *slot = xb_add(ctr, 1u);
            __syncthreads();
            const int u = (int)*slot;
            __syncthreads();
            if (u >= 384 + 1536 + 1024) break;
            if (u < 384) lru_unit(p, u, smem);
            else if (u < 384 + 1536) attn_win_unit(p, u - 384, smem);
            else attn_mem_unit(p, u - 384 - 1536, smem);
        }
    }
    xcd_barrier(xb);
    PH_END(2) PH_BEGIN(3)
    { int rt, ct; for (int it = 0; gemm_unit(it, 8, rt, ct); ++it) merge_tile(p, rt, ct, smem); }
    xcd_barrier(xb);
    PH_END(3) PH_BEGIN(4)
    { int rt, ct; for (int it = 0; gemm_unit(it, 8, rt, ct); ++it) outproj_tile(p, rt, ct, smem); }
    xcd_barrier(xb);
    PH_END(4) PH_BEGIN(5)
    for (int r = bid * 4 + wid; r < NTOK; r += nb * 4) rms_row_bf16(p.out + (size_t)r * 1024, p.g_ffn, (bf16_t*)(ws + OFF_MERGED) + (size_t)r * 1024, lane);
    xcd_barrier(xb);
    PH_END(5) PH_BEGIN(6)
    { int rt, ct; for (int it = 0; gemm_unit(it, 16, rt, ct); ++it) peerq_tile(p, rt, ct, smem); }
    xcd_barrier(xb);
    PH_END(6) PH_BEGIN(7)
    for (int u = bid; u < 256 * 16; u += nb) scores_tile(p, u / 16, u % 16, smem);
    xcd_barrier(xb);
    PH_END(7) PH_BEGIN(8)
    for (int i = bid * 256 + tid; i < NTOK * 8; i += nb * 256) combine_item(p, i);
    xcd_barrier(xb);
    PH_END(8) PH_BEGIN(9)
    for (int t = bid * 4 + wid; t < NTOK; t += nb * 4) gather_token(p, t, lane);
    PH_END(9)
    if (PROBE_PHASE >= 0) { __syncthreads(); const unsigned long long t1 = __builtin_amdgcn_s_memrealtime(); while (__builtin_amdgcn_s_memrealtime() - t1 < probe_dt) __builtin_amdgcn_s_sleep(8); }
}

extern "C" void kernel_launch(void* const* d_in, const int* in_sizes, int n_in, void* d_out, int out_size, void* d_ws, size_t ws_size, hipStream_t stream) {
    if (ws_size < OFF_END) { fprintf(stderr, "workspace too small: %zu < %zu\n", ws_size, (size_t)OFF_END); return; }
    Params p{};
    p.x = (const float*)d_in[0]; p.mem = (const float*)d_in[1]; p.positions = (const int*)d_in[2];
    p.g_mix = (const float*)d_in[3]; p.g_mem = (const float*)d_in[4]; p.w_in = (const float*)d_in[5]; p.gate_b = (const float*)d_in[6];
    p.attn_sink = (const float*)d_in[7]; p.conv_w = (const float*)d_in[8]; p.conv_b = (const float*)d_in[9];
    p.lru_wr = (const float*)d_in[10]; p.lru_br = (const float*)d_in[11]; p.lru_wi = (const float*)d_in[12]; p.lru_bi = (const float*)d_in[13];
    p.lru_lambda = (const float*)d_in[14]; p.w_mem_kv = (const float*)d_in[15]; p.p_attn = (const float*)d_in[16]; p.p_lru = (const float*)d_in[17];
    p.p_mem = (const float*)d_in[18]; p.w_out = (const float*)d_in[19]; p.g_ffn = (const float*)d_in[20]; p.w_peer_q = (const float*)d_in[21];
    p.peer_sub_keys = (const float*)d_in[22]; p.peer_u = (const float*)d_in[23]; p.peer_v = (const float*)d_in[24]; p.g_final = (const float*)d_in[25];
    p.out = (float*)d_out; p.ws = (unsigned char*)d_ws;
    static int grid_blocks = 0;
    if (!grid_blocks) {
        int dev = 0, cus = 0, per_cu = 0;
        (void)hipGetDevice(&dev);
        (void)hipDeviceGetAttribute(&cus, hipDeviceAttributeMultiprocessorCount, dev);
        (void)hipOccupancyMaxActiveBlocksPerMultiprocessor(&per_cu, fwd_megakernel, 256, 0);
        if (per_cu > 2) per_cu = 2;
        grid_blocks = cus * per_cu;
    }
    (void)hipMemsetAsync((unsigned char*)d_ws + OFF_BAR, 0, 16384, stream);
    void* args[] = {&p};
    hipError_t e = hipLaunchCooperativeKernel((void*)fwd_megakernel, dim3(grid_blocks), dim3(256), args, 0, stream);
    if (e != hipSuccess) fprintf(stderr, "cooperative launch failed: %s (grid %d)\n", hipGetErrorString(e), grid_blocks);
}
```

```cpp
#include <hip/hip_runtime.h>
#include <stdint.h>
#include <stdio.h>

typedef unsigned short bf16_t;
typedef short bf16x8 __attribute__((ext_vector_type(8)));
typedef __bf16 bf16x2v __attribute__((ext_vector_type(2)));
typedef float f32x4 __attribute__((ext_vector_type(4)));

constexpr int B_ = 16, S_ = 2048, D_ = 1024, NTOK = B_ * S_;
constexpr int MEML = 256, NMEM = B_ * MEML;
constexpr int INW = 6400;
constexpr int LW = 768;
constexpr int NEXP = 16384;
constexpr float EPS = 1e-6f;
constexpr float QSCALE = 0.08838834764831845f * 1.4426950408889634f;

constexpr size_t OFF_WINT = 0;
constexpr size_t OFF_WMKVT = OFF_WINT + (size_t)INW * 1024 * 2;
constexpr size_t OFF_PATTNT = OFF_WMKVT + (size_t)1024 * 1024 * 2;
constexpr size_t OFF_PLRUT = OFF_PATTNT + (size_t)1024 * 768 * 2;
constexpr size_t OFF_PMEMT = OFF_PLRUT + (size_t)1024 * 768 * 2;
constexpr size_t OFF_WOUTT = OFF_PMEMT + (size_t)1024 * 512 * 2;
constexpr size_t OFF_WPQT = OFF_WOUTT + (size_t)1024 * 1024 * 2;
constexpr size_t OFF_LRUWT = OFF_WPQT + (size_t)2048 * 1024 * 2;
constexpr size_t OFF_SUBK = OFF_LRUWT + (size_t)6 * 512 * 128 * 2;
constexpr size_t OFF_UB = OFF_SUBK + (size_t)16 * 128 * 128 * 2;
constexpr size_t OFF_VB = OFF_UB + (size_t)NEXP * 1024;
constexpr size_t OFF_SU = OFF_VB + (size_t)NEXP * 1024;
constexpr size_t OFF_SV = OFF_SU + (size_t)NEXP * 4;
constexpr size_t OFF_RA = OFF_SV + (size_t)NEXP * 4;
constexpr size_t OFF_QA = OFF_RA;
constexpr size_t OFF_KA = OFF_QA + (size_t)NTOK * 768 * 2;
constexpr size_t OFF_VAT = OFF_KA + (size_t)NTOK * 256 * 2;
constexpr size_t OFF_XL = OFF_VAT + (size_t)NTOK * 256 * 2;
constexpr size_t OFF_GL = OFF_XL + (size_t)NTOK * 768 * 2;
constexpr size_t OFF_QM = OFF_GL + (size_t)NTOK * 768 * 2;
constexpr size_t OFF_GATES = OFF_QM + (size_t)NTOK * 512 * 2;
constexpr size_t OFF_BAR = OFF_GATES + (size_t)NTOK * 3072 * 2;
constexpr size_t OFF_END = OFF_BAR + 16384;
constexpr size_t OFF_MERGED = OFF_KA;
constexpr size_t OFF_QPEER = OFF_GATES;
constexpr size_t OFF_TOPL = OFF_QPEER + (size_t)NTOK * 2048 * 2;
constexpr size_t OFF_EIDX = OFF_TOPL + (size_t)NTOK * 256 * 4;
constexpr size_t OFF_EGATE = OFF_EIDX + (size_t)NTOK * 128 * 4;
static_assert(OFF_EGATE + (size_t)NTOK * 128 * 4 <= OFF_BAR, "overlay");
static_assert(OFF_MERGED + (size_t)NTOK * 1024 * 2 <= OFF_GL, "overlay2");
constexpr size_t DO_HBF = 0;
constexpr size_t DO_MEMBF = DO_HBF + (size_t)NTOK * 1024 * 2;
constexpr size_t DO_KM = DO_MEMBF + (size_t)NMEM * 1024 * 2;
constexpr size_t DO_VMT = DO_KM + (size_t)NMEM * 512 * 2;
constexpr size_t DO_ROPE = DO_VMT + (size_t)NMEM * 512 * 2;
static_assert(DO_ROPE + (size_t)NTOK * 32 * 4 <= (size_t)NTOK * 1024 * 4, "d_out scratch");

struct Params {
    const float *x, *mem; const int* positions;
    const float *g_mix, *g_mem, *w_in, *gate_b, *attn_sink, *conv_w, *conv_b, *lru_wr, *lru_br, *lru_wi, *lru_bi, *lru_lambda,
        *w_mem_kv, *p_attn, *p_lru, *p_mem, *w_out, *g_ffn, *w_peer_q, *peer_sub_keys, *peer_u, *peer_v, *g_final;
    float* out; unsigned char* ws;
};

__device__ __forceinline__ int tidx() { int t = threadIdx.x; asm volatile("" : "+v"(t)); return t; }
__device__ __forceinline__ float bf2f(bf16_t b) { return __uint_as_float(((unsigned)b) << 16); }
__device__ __forceinline__ float bflo(unsigned u) { return __uint_as_float(u << 16); }
__device__ __forceinline__ float bfhi(unsigned u) { return __uint_as_float(u & 0xffff0000u); }
typedef float f32x2v __attribute__((ext_vector_type(2)));
__device__ __forceinline__ unsigned pack_bf16(float lo, float hi) { const f32x2v f = {lo, hi}; return __builtin_bit_cast(unsigned, __builtin_convertvector(f, bf16x2v)); }
__device__ __forceinline__ bf16_t f2bf(float f) { return (bf16_t)(pack_bf16(f, 0.f) & 0xffffu); }
__device__ __forceinline__ f32x4 mfma16(bf16x8 a, bf16x8 b, f32x4 c) { return __builtin_amdgcn_mfma_f32_16x16x32_bf16(a, b, c, 0, 0, 0); }
__device__ __forceinline__ float sigmoidf_(float x) { return __builtin_amdgcn_rcpf(1.0f + __expf(-x)); }
__device__ __forceinline__ float gelu_tanh(float x) { const float u = 1.5957691216057308f * (x + 0.044715f * x * x * x); return x * __builtin_amdgcn_rcpf(1.0f + __expf(-u)); }
__device__ __forceinline__ float wave_sum(float v) {
#pragma unroll
    for (int o = 32; o >= 1; o >>= 1) v += __shfl_xor(v, o);
    return v;
}

__device__ void convT_tile(const float* __restrict__ src, bf16_t* __restrict__ dst, int K, int N, int tile, unsigned char* smem) {
    float* t = (float*)smem;
    const int tn = N / 64, tk = tile / tn, tnn = tile % tn, k0 = tk * 64, n0 = tnn * 64, tid = tidx();
    const int r = tid >> 4, c4 = (tid & 15) * 4;
#pragma unroll
    for (int i = 0; i < 4; ++i) {
        const int k = r + 16 * i;
        const float4 v = *(const float4*)(src + (size_t)(k0 + k) * N + n0 + c4);
        t[k * 65 + c4 + 0] = v.x; t[k * 65 + c4 + 1] = v.y; t[k * 65 + c4 + 2] = v.z; t[k * 65 + c4 + 3] = v.w;
    }
    __syncthreads();
    const int n = tid >> 2, kq = (tid & 3) * 16;
    unsigned w[8];
#pragma unroll
    for (int i = 0; i < 8; ++i) w[i] = pack_bf16(t[(kq + 2 * i) * 65 + n], t[(kq + 2 * i + 1) * 65 + n]);
    uint4* d = (uint4*)(dst + (size_t)(n0 + n) * K + k0 + kq);
    d[0] = make_uint4(w[0], w[1], w[2], w[3]); d[1] = make_uint4(w[4], w[5], w[6], w[7]);
    __syncthreads();
}


__device__ __forceinline__ void rms_row_bf16(const float* __restrict__ xr, const float* __restrict__ g, bf16_t* __restrict__ o, int lane) {
    float4 v[4]; float ss = 0.f;
#pragma unroll
    for (int i = 0; i < 4; ++i) { v[i] = *(const float4*)(xr + i * 256 + lane * 4); ss += v[i].x * v[i].x + v[i].y * v[i].y + v[i].z * v[i].z + v[i].w * v[i].w; }
    ss = wave_sum(ss);
    const float rs = rsqrtf(ss * (1.0f / 1024.0f) + EPS);
#pragma unroll
    for (int i = 0; i < 4; ++i) {
        const float4 gg = *(const float4*)(g + i * 256 + lane * 4);
        *(uint2*)(o + i * 256 + lane * 4) = make_uint2(pack_bf16(v[i].x * rs * gg.x, v[i].y * rs * gg.y), pack_bf16(v[i].z * rs * gg.z, v[i].w * rs * gg.w));
    }
}


__device__ __forceinline__ void conv_plain(const float* __restrict__ src, bf16_t* __restrict__ dst, size_t n8) {
    for (size_t i = (size_t)blockIdx.x * 256 + tidx(); i < n8; i += (size_t)gridDim.x * 256) {
        const float4 a = ((const float4*)src)[2 * i], b = ((const float4*)src)[2 * i + 1];
        ((uint4*)dst)[i] = make_uint4(pack_bf16(a.x, a.y), pack_bf16(a.z, a.w), pack_bf16(b.x, b.y), pack_bf16(b.z, b.w));
    }
}
__device__ __forceinline__ void rope_item(const int* __restrict__ pos, float* __restrict__ cs, int i) {
    const int t = i >> 4, f = i & 15;
    const float inv = powf(500000.0f, -(float)(2 * f) / 32.0f);
    const float ang = (float)pos[t] * inv;
    float s, c; sincosf(ang, &s, &c);
    cs[2 * i] = c; cs[2 * i + 1] = s;
}

__device__ __forceinline__ int swz(int row) { return (row & 3) | (((row >> 3) & 1) << 2); }

struct GemmOp { const bf16_t* A; const bf16_t* Bt; int lda, ldb; };
struct GemmPipe { int par; bool pre; };

__device__ __forceinline__ void gemm_tile(const GemmOp& op, int K, f32x4 (&acc)[4][4], unsigned char* smem, GemmPipe& pp, const GemmOp& nx, bool has_next) {
    const int tid = tidx(), lane = tid & 63, wid = tid >> 6, wr = wid >> 1, wc = wid & 1, li = lane & 15, g = lane >> 4;
    const int srow = tid >> 3, skc = (tid & 7) ^ swz(tid >> 3);
    const bf16_t* ga = op.A + (size_t)srow * op.lda + skc * 8;
    const bf16_t* gb = op.Bt + (size_t)srow * op.ldb + skc * 8;
    unsigned char* ldst = smem + tid * 16;
    int aoff[4], boff[4], asw[4], bsw[4];
#pragma unroll
    for (int m = 0; m < 4; ++m) { const int row = wr * 64 + m * 16 + li; aoff[m] = row * 128; asw[m] = swz(row); }
#pragma unroll
    for (int n = 0; n < 4; ++n) { const int row = wc * 64 + 32 * (n >> 1) + 8 * (li >> 2) + 4 * (n & 1) + (li & 3); boff[n] = 16384 + row * 128; bsw[n] = swz(row); }
    const int nk = K >> 6;
    if (!pp.pre) {
        unsigned char* sw = ldst + pp.par * 32768;
#pragma unroll
        for (int i = 0; i < 4; ++i) {
            __builtin_amdgcn_global_load_lds((const unsigned*)(ga + (size_t)(32 * i) * op.lda), (unsigned*)(sw + i * 4096), 16, 0, 0);
            __builtin_amdgcn_global_load_lds((const unsigned*)(gb + (size_t)(32 * i) * op.ldb), (unsigned*)(sw + 16384 + i * 4096), 16, 0, 0);
        }
    }
    __syncthreads();
    for (int kt = 0; kt < nk; ++kt) {
        const int cur = (pp.par + kt) & 1;
        const unsigned char* sb = smem + cur * 32768;
        unsigned char* sw = ldst + (cur ^ 1) * 32768;
        if (kt + 1 < nk) {
#pragma unroll
            for (int i = 0; i < 4; ++i) {
                __builtin_amdgcn_global_load_lds((const unsigned*)(ga + (size_t)(32 * i) * op.lda + (kt + 1) * 64), (unsigned*)(sw + i * 4096), 16, 0, 0);
                __builtin_amdgcn_global_load_lds((const unsigned*)(gb + (size_t)(32 * i) * op.ldb + (kt + 1) * 64), (unsigned*)(sw + 16384 + i * 4096), 16, 0, 0);
            }
        } else if (has_next) {
            const bf16_t* na = nx.A + (size_t)srow * nx.lda + skc * 8;
            const bf16_t* nb = nx.Bt + (size_t)srow * nx.ldb + skc * 8;
#pragma unroll
            for (int i = 0; i < 4; ++i) {
                __builtin_amdgcn_global_load_lds((const unsigned*)(na + (size_t)(32 * i) * nx.lda), (unsigned*)(sw + i * 4096), 16, 0, 0);
                __builtin_amdgcn_global_load_lds((const unsigned*)(nb + (size_t)(32 * i) * nx.ldb), (unsigned*)(sw + 16384 + i * 4096), 16, 0, 0);
            }
        }
#pragma unroll
        for (int ks = 0; ks < 2; ++ks) {
            bf16x8 af[4], bfr[4];
#pragma unroll
            for (int m = 0; m < 4; ++m) af[m] = *(const bf16x8*)(sb + aoff[m] + (((ks * 4 + g) ^ asw[m]) << 4));
#pragma unroll
            for (int n = 0; n < 4; ++n) bfr[n] = *(const bf16x8*)(sb + boff[n] + (((ks * 4 + g) ^ bsw[n]) << 4));
#pragma unroll
            for (int m = 0; m < 4; ++m)
#pragma unroll
                for (int n = 0; n < 4; ++n) acc[m][n] = mfma16(bfr[n], af[m], acc[m][n]);
        }
        if (kt + 1 < nk) __syncthreads();
    }
    pp.par = (pp.par + nk) & 1; pp.pre = has_next;
}
__device__ __forceinline__ void acc_zero(f32x4 (&acc)[4][4]) {
#pragma unroll
    for (int m = 0; m < 4; ++m)
#pragma unroll
        for (int n = 0; n < 4; ++n) acc[m][n] = (f32x4){0.f, 0.f, 0.f, 0.f};
}
template <class F> __device__ __forceinline__ void epi_foreach(const f32x4 (&acc)[4][4], F&& f) {
    const int lane = tidx() & 63, wid = tidx() >> 6, wr = wid >> 1, wc = wid & 1, li = lane & 15, g = lane >> 4;
#pragma unroll
    for (int m = 0; m < 4; ++m)
#pragma unroll
        for (int pp = 0; pp < 2; ++pp) {
            float v[8];
#pragma unroll
            for (int r = 0; r < 4; ++r) { v[r] = acc[m][2 * pp][r]; v[4 + r] = acc[m][2 * pp + 1][r]; }
            f(wr * 64 + m * 16 + li, wc * 64 + 32 * pp + 8 * g, v, pp);
        }
}
__device__ __forceinline__ void store_bf16x8(bf16_t* p, const float (&v)[8]) {
    *(uint4*)p = make_uint4(pack_bf16(v[0], v[1]), pack_bf16(v[2], v[3]), pack_bf16(v[4], v[5]), pack_bf16(v[6], v[7]));
}
__device__ __forceinline__ void store_tile_T(const f32x4 (&acc)[4][4], bf16_t* __restrict__ dstT, int ldt, unsigned char* smem) {
    bf16_t* t = (bf16_t*)smem;
    __syncthreads();
    epi_foreach(acc, [&](int r, int c, const float (&v)[8], int) {
#pragma unroll
        for (int e = 0; e < 8; ++e) t[(c + e) * 136 + r] = f2bf(v[e]);
    });
    __syncthreads();
#pragma unroll
    for (int i = 0; i < 8; ++i) {
        const int ch = tidx() + 256 * i, d = ch >> 4, tc = ch & 15;
        *(uint4*)(dstT + (size_t)d * ldt + tc * 8) = *(const uint4*)(smem + d * 272 + tc * 16);
    }
    __syncthreads();
}

__device__ void inproj_tile(const Params& p, int rt, int ct, unsigned char* smem, GemmPipe& pp, bool hn, int nrt, int nct) {
    unsigned char* ws = p.ws; unsigned char* dob = (unsigned char*)p.out;
    const bf16_t* hbf = (const bf16_t*)(dob + DO_HBF);
    const bf16_t* WinT = (const bf16_t*)(ws + OFF_WINT);
    f32x4 acc[4][4]; acc_zero(acc);
    const GemmOp op{hbf + (size_t)rt * 128 * 1024, WinT + (size_t)ct * 128 * 1024, 1024, 1024};
    const GemmOp nx{hbf + (size_t)nrt * 128 * 1024, WinT + (size_t)nct * 128 * 1024, 1024, 1024};
    gemm_tile(op, 1024, acc, smem, pp, nx, hn && !(ct == 8 || ct == 9));
    const int row0 = rt * 128;
    if (ct < 8) {
        const float* cs = (const float*)(dob + DO_ROPE);
        const bool isq = ct < 6;
        bf16_t* dst = isq ? (bf16_t*)(ws + OFF_QA) + ct * 128 : (bf16_t*)(ws + OFF_KA) + (ct - 6) * 128;
        const int ld = isq ? 768 : 256;
        const float sc = isq ? QSCALE : 1.0f;
        const int g = (tidx() & 63) >> 4;
        epi_foreach(acc, [&](int r, int c, float (&v)[8], int pp) {
            const int tok = row0 + r;
            if (pp == 0 && c < 32) {
                const float* csr = cs + (size_t)tok * 32 + (g & 1) * 16;
#pragma unroll
                for (int e = 0; e < 8; ++e) {
                    const float o = __shfl_xor(v[e], 32);
                    const float cc = csr[2 * e], ss = csr[2 * e + 1];
                    v[e] = (g < 2) ? (v[e] * cc - o * ss) : (v[e] * cc + o * ss);
                }
            }
#pragma unroll
            for (int e = 0; e < 8; ++e) v[e] *= sc;
            store_bf16x8(dst + (size_t)tok * ld + c, v);
        });
    } else if (ct < 10) {
        const int kvh = ct - 8, b = row0 / S_, s0 = row0 % S_;
        store_tile_T(acc, (bf16_t*)(ws + OFF_VAT) + (size_t)(b * 2 + kvh) * 128 * S_ + s0, S_, smem);
    } else if (ct < 16) {
        bf16_t* dst = (bf16_t*)(ws + OFF_XL) + (ct - 10) * 128;
        epi_foreach(acc, [&](int r, int c, float (&v)[8], int) { store_bf16x8(dst + (size_t)(row0 + r) * 768 + c, v); });
    } else if (ct < 22) {
        bf16_t* dst = (bf16_t*)(ws + OFF_GL) + (ct - 16) * 128;
        epi_foreach(acc, [&](int r, int c, float (&v)[8], int) {
#pragma unroll
            for (int e = 0; e < 8; ++e) v[e] = gelu_tanh(v[e]);
            store_bf16x8(dst + (size_t)(row0 + r) * 768 + c, v); });
    } else if (ct < 26) {
        bf16_t* dst = (bf16_t*)(ws + OFF_QM) + (ct - 22) * 128;
        epi_foreach(acc, [&](int r, int c, float (&v)[8], int) {
#pragma unroll
            for (int e = 0; e < 8; ++e) v[e] *= QSCALE;
            store_bf16x8(dst + (size_t)(row0 + r) * 512 + c, v); });
    } else {
        const int gc0 = (ct - 26) * 128;
        bf16_t* dst = (bf16_t*)(ws + OFF_GATES) + gc0;
        const float* gb = p.gate_b + gc0;
        epi_foreach(acc, [&](int r, int c, float (&v)[8], int) {
            const float4 b0 = *(const float4*)(gb + c), b1 = *(const float4*)(gb + c + 4);
            v[0] = sigmoidf_(v[0] + b0.x); v[1] = sigmoidf_(v[1] + b0.y); v[2] = sigmoidf_(v[2] + b0.z); v[3] = sigmoidf_(v[3] + b0.w);
            v[4] = sigmoidf_(v[4] + b1.x); v[5] = sigmoidf_(v[5] + b1.y); v[6] = sigmoidf_(v[6] + b1.z); v[7] = sigmoidf_(v[7] + b1.w);
            store_bf16x8(dst + (size_t)(row0 + r) * 3072 + c, v); });
    }
}

__device__ void memkv_tile(const Params& p, int rt, int ct, unsigned char* smem) {
    unsigned char* dob = (unsigned char*)p.out;
    f32x4 acc[4][4]; acc_zero(acc);
    const GemmOp op{(const bf16_t*)(dob + DO_MEMBF) + (size_t)rt * 128 * 1024, (const bf16_t*)(p.ws + OFF_WMKVT) + (size_t)ct * 128 * 1024, 1024, 1024};
    GemmPipe pp{0, false};
    __syncthreads();
    gemm_tile(op, 1024, acc, smem, pp, op, false);
    const int row0 = rt * 128;
    if (ct < 4) {
        bf16_t* dst = (bf16_t*)(dob + DO_KM) + ct * 128;
        epi_foreach(acc, [&](int r, int c, float (&v)[8], int) { store_bf16x8(dst + (size_t)(row0 + r) * 512 + c, v); });
    } else {
        const int h = ct - 4, b = row0 / MEML, m0 = row0 % MEML;
        store_tile_T(acc, (bf16_t*)(dob + DO_VMT) + (size_t)(b * 4 + h) * 128 * MEML + m0, MEML, smem);
    }
}


typedef float f32x16 __attribute__((ext_vector_type(16)));
__device__ __forceinline__ f32x16 mfma32(bf16x8 a, bf16x8 b, f32x16 c) { return __builtin_amdgcn_mfma_f32_32x32x16_bf16(a, b, c, 0, 0, 0); }
constexpr int ATT_STAGE = 16384 + 128 * 136;

template <bool WIN>
__device__ void attn_block(const bf16_t* Qg, int ldq, const bf16_t* __restrict__ Kg, int ldk, const bf16_t* __restrict__ Vtg, int ldv,
                           int q0, int kt0, int nt, float sink2, bf16_t* Og, int ldo, unsigned char* smem) {
    const int tid = tidx(), lane = tid & 63, wid = tid >> 6, r = lane & 31, hh = lane >> 5;
    const int qw = q0 + 32 * wid;
    bf16x8 qf[8];
#pragma unroll
    for (int ks = 0; ks < 8; ++ks) qf[ks] = *(const bf16x8*)(Qg + (size_t)(32 * wid + r) * ldq + ks * 16 + hh * 8);
    f32x16 o[4];
#pragma unroll
    for (int db = 0; db < 4; ++db)
#pragma unroll
        for (int e = 0; e < 16; ++e) o[db][e] = 0.f;
    float m = WIN ? sink2 : -1e30f, l = WIN ? 1.0f : 0.0f;
    const int krow = tid >> 4, kch = tid & 15, vrow = tid >> 3, vch = tid & 7;
    const int koff = krow * 256 + ((kch ^ (krow & 15)) << 4);
    const int voff = 16384 + vrow * 136 + vch * 16;
    uint4 rk[4], rv[4];
    const bf16_t* kgp = Kg + (size_t)(kt0 * 64 + krow) * ldk + kch * 8;
    const bf16_t* vgp = Vtg + (size_t)vrow * ldv + kt0 * 64 + vch * 8;
#pragma unroll
    for (int i = 0; i < 4; ++i) { rk[i] = *(const uint4*)(kgp + (size_t)(16 * i) * ldk); rv[i] = *(const uint4*)(vgp + (size_t)(32 * i) * ldv); }
#pragma unroll
    for (int i = 0; i < 4; ++i) {
        *(uint4*)(smem + koff + i * 4096) = rk[i];
        *(uint2*)(smem + voff + i * 4352) = make_uint2(rv[i].x, rv[i].y); *(uint2*)(smem + voff + i * 4352 + 8) = make_uint2(rv[i].z, rv[i].w);
    }
    __syncthreads();
    for (int t = 0; t < nt; ++t) {
        const unsigned char* sb = smem + (t & 1) * ATT_STAGE;
        {
            const int tn = t + 1 < nt ? t + 1 : t;
#pragma unroll
            for (int i = 0; i < 4; ++i) { rk[i] = *(const uint4*)(kgp + (size_t)(tn * 64 + 16 * i) * ldk); rv[i] = *(const uint4*)(vgp + (size_t)(32 * i) * ldv + tn * 64); }
        }
        const int k0 = (kt0 + t) * 64;
        if (!WIN || (k0 + 63 >= qw - 128 && k0 <= qw + 159)) {
#pragma unroll
            for (int kb = 0; kb < 2; ++kb) {
                const int kb0 = k0 + 32 * kb;
                if (WIN && !(kb0 + 31 >= qw - 128 && kb0 <= qw + 159)) continue;
                f32x16 s;
#pragma unroll
                for (int e = 0; e < 16; ++e) s[e] = 0.f;
                const int row = kb * 32 + r;
#pragma unroll
                for (int ks = 0; ks < 8; ++ks) {
                    const bf16x8 a = *(const bf16x8*)(sb + row * 256 + (((2 * ks + hh) ^ (row & 15)) << 4));
                    s = mfma32(a, qf[ks], s);
                }
                if (WIN && !(kb0 >= qw - 97 && kb0 + 31 <= qw + 128)) {
#pragma unroll
                    for (int e = 0; e < 16; ++e) {
                        const int d = kb0 + (e & 3) + 8 * (e >> 2) + 4 * hh - (qw + r);
                        s[e] = (d <= 128 && d >= -128) ? s[e] : -1e30f;
                    }
                }
                float mx = s[0];
#pragma unroll
                for (int e = 1; e < 16; ++e) mx = fmaxf(mx, s[e]);
                mx = fmaxf(mx, __shfl_xor(mx, 32));
                const float mnew = fmaxf(m, mx), alpha = __builtin_amdgcn_exp2f(m - mnew);
                m = mnew;
                float ps = 0.f;
#pragma unroll
                for (int e = 0; e < 16; ++e) { s[e] = __builtin_amdgcn_exp2f(s[e] - mnew); ps += s[e]; }
                ps += __shfl_xor(ps, 32);
                l = l * alpha + ps;
                if (__any(alpha != 1.0f)) {
#pragma unroll
                    for (int db = 0; db < 4; ++db)
#pragma unroll
                        for (int e = 0; e < 16; ++e) o[db][e] *= alpha;
                }
#pragma unroll
                for (int s2 = 0; s2 < 2; ++s2) {
                    union { unsigned u[4]; bf16x8 v; } pb;
#pragma unroll
                    for (int e = 0; e < 4; ++e) pb.u[e] = pack_bf16(s[8 * s2 + 2 * e], s[8 * s2 + 2 * e + 1]);
#pragma unroll
                    for (int db = 0; db < 4; ++db) {
                        const unsigned char* vp = sb + 16384 + (db * 32 + r) * 136 + (kb * 32 + 16 * s2 + 4 * hh) * 2;
                        union { uint2 u[2]; bf16x8 v; } va;
                        va.u[0] = *(const uint2*)vp; va.u[1] = *(const uint2*)(vp + 16);
                        o[db] = mfma32(va.v, pb.v, o[db]);
                    }
                }
            }
        }
        {
            unsigned char* sw = smem + ((t + 1) & 1) * ATT_STAGE;
#pragma unroll
            for (int i = 0; i < 4; ++i) {
                *(uint4*)(sw + koff + i * 4096) = rk[i];
                *(uint2*)(sw + voff + i * 4352) = make_uint2(rv[i].x, rv[i].y); *(uint2*)(sw + voff + i * 4352 + 8) = make_uint2(rv[i].z, rv[i].w);
            }
        }
        __syncthreads();
    }
    const float inv = __builtin_amdgcn_rcpf(l);
    bf16_t* orow = Og + (size_t)(32 * wid + r) * ldo + 4 * hh;
#pragma unroll
    for (int db = 0; db < 4; ++db)
#pragma unroll
        for (int gq = 0; gq < 4; ++gq)
            *(uint2*)(orow + db * 32 + 8 * gq) = make_uint2(pack_bf16(o[db][4 * gq] * inv, o[db][4 * gq + 1] * inv), pack_bf16(o[db][4 * gq + 2] * inv, o[db][4 * gq + 3] * inv));
}
__device__ void attn_win_unit(const Params& p, int u, unsigned char* smem) {
    const int gh = u % 3, qb = (u / 3) % 16, kvh = (u / 48) % 2, b = u / 96, head = kvh * 3 + gh;
    const int q0 = qb * 128;
    const int ks = q0 - 128 < 0 ? 0 : q0 - 128, ke = q0 + 256 > S_ ? S_ : q0 + 256;
    bf16_t* Q = (bf16_t*)(p.ws + OFF_QA) + (size_t)(b * S_ + q0) * 768 + head * 128;
    const bf16_t* Kb = (const bf16_t*)(p.ws + OFF_KA) + (size_t)(b * S_) * 256 + kvh * 128;
    const bf16_t* Vt = (const bf16_t*)(p.ws + OFF_VAT) + (size_t)(b * 2 + kvh) * 128 * S_;
    attn_block<true>(Q, 768, Kb, 256, Vt, S_, q0, ks / 64, (ke - ks) / 64, p.attn_sink[head] * 1.4426950408889634f, Q, 768, smem);
}
__device__ void attn_mem_unit(const Params& p, int u, unsigned char* smem) {
    const int qb = u % 16, head = (u / 16) % 4, b = u / 64;
    const int q0 = qb * 128;
    unsigned char* dob = (unsigned char*)p.out;
    bf16_t* Q = (bf16_t*)(p.ws + OFF_QM) + (size_t)(b * S_ + q0) * 512 + head * 128;
    const bf16_t* Kb = (const bf16_t*)(dob + DO_KM) + (size_t)(b * MEML) * 512 + head * 128;
    const bf16_t* Vt = (const bf16_t*)(dob + DO_VMT) + (size_t)(b * 4 + head) * 128 * MEML;
    attn_block<false>(Q, 512, Kb, 512, Vt, MEML, q0, 0, 4, 0.f, Q, 512, smem);
}

__device__ __forceinline__ void lru_load_x(unsigned (&xw)[19], const bf16_t* __restrict__ Xl, int sbase, int cch) {
#pragma unroll
    for (int i = 0; i < 19; ++i) {
        const int s = sbase + i - 2;
        xw[i] = (s >= 0 && s < S_) ? *(const unsigned*)(Xl + (size_t)s * 768 + cch) : 0u;
    }
}
__device__ void lru_unit(const Params& p, int u, unsigned char* smem) {
    const int tid = tidx(), lane = tid & 63, wid = tid >> 6, li = lane & 15, g = lane >> 4;
    const int qt = u & 3, h = (u >> 2) % 6, b = u / 24;
    const int cbase = h * 128, cq0 = cbase + qt * 32;
    unsigned char* xcs = smem; unsigned char* wl = smem + 16384;
    float* pre = (float*)(smem + 32768); float* xcf = (float*)(smem + 49152);
    float* cA = (float*)(smem + 57344); float* cH = cA + 256; float* h0 = cH + 256;
    const bf16_t* Xl = (const bf16_t*)(p.ws + OFF_XL) + (size_t)(b * S_) * 768;
    bf16_t* Gl = (bf16_t*)(p.ws + OFF_GL) + (size_t)(b * S_) * 768;
    bf16_t* Hf = (bf16_t*)((unsigned char*)p.out + DO_HBF) + (size_t)(b * S_) * 768;
    const bf16_t* LruWt = (const bf16_t*)(p.ws + OFF_LRUWT);
    const int cp = tid & 63, tq = tid >> 6, cch = cbase + 2 * cp;
    float cw[4][2];
#pragma unroll
    for (int j = 0; j < 4; ++j) { cw[j][0] = p.conv_w[j * LW + cch]; cw[j][1] = p.conv_w[j * LW + cch + 1]; }
    const float cb0 = p.conv_b[cch], cb1 = p.conv_b[cch + 1];
    const int sc_c = tid & 31, sub = tid >> 5, sch = cq0 + sc_c;
    for (int dir = 0; dir < 2; ++dir) {
        __syncthreads();
#pragma unroll
        for (int i = 0; i < 4; ++i) {
            const int ch = tid + 256 * i, j = ch >> 4, kc = ch & 15;
            const int srcrow = h * 512 + ((j >> 5) * 2 + dir) * 128 + qt * 32 + (j & 31);
            *(uint4*)(wl + j * 256 + ((kc ^ (j & 15)) << 4)) = *(const uint4*)(LruWt + (size_t)srcrow * 128 + kc * 8);
        }
        const float br = p.lru_br[dir * LW + sch], bi = p.lru_bi[dir * LW + sch];
        const float lam = p.lru_lambda[dir * LW + sch];
        const float sp8 = -8.0f * log1pf(__expf(-lam));
        if (tid < 32) h0[tid] = 0.f;
        unsigned xw[19];
        lru_load_x(xw, Xl, (dir ? 31 : 0) * 64 + 16 * tq, cch);
        for (int ci = 0; ci < 32; ++ci) {
            const int chunk = dir ? 31 - ci : ci, s0 = chunk * 64;
#pragma unroll
            for (int i = 0; i < 16; ++i) {
                const int t = 16 * tq + i;
                const float y0 = cb0 + cw[0][0] * bflo(xw[i]) + cw[1][0] * bflo(xw[i + 1]) + cw[2][0] * bflo(xw[i + 2]) + cw[3][0] * bflo(xw[i + 3]);
                const float y1 = cb1 + cw[0][1] * bfhi(xw[i]) + cw[1][1] * bfhi(xw[i + 1]) + cw[2][1] * bfhi(xw[i + 2]) + cw[3][1] * bfhi(xw[i + 3]);
                *(unsigned*)(xcs + t * 256 + (((cp >> 2) ^ (t & 15)) << 4) + (cp & 3) * 4) = pack_bf16(y0, y1);
                if ((cp >> 4) == qt) { xcf[t * 32 + 2 * (cp & 15)] = y0; xcf[t * 32 + 2 * (cp & 15) + 1] = y1; }
            }
            if (ci + 1 < 32) lru_load_x(xw, Xl, (dir ? 30 - ci : ci + 1) * 64 + 16 * tq, cch);
            float hfv[8], glv[8];
            if (dir) {
#pragma unroll
                for (int k = 0; k < 8; ++k) {
                    const size_t gi = (size_t)(s0 + 63 - (sub * 8 + k)) * 768 + sch;
                    hfv[k] = bf2f(Hf[gi]); glv[k] = bf2f(Gl[gi]);
                }
            }
            __syncthreads();
            {
                f32x4 a[4];
#pragma unroll
                for (int n = 0; n < 4; ++n) a[n] = (f32x4){0.f, 0.f, 0.f, 0.f};
#pragma unroll
                for (int ks = 0; ks < 4; ++ks) {
                    const int row = wid * 16 + li;
                    const bf16x8 xf = *(const bf16x8*)(xcs + row * 256 + (((ks * 4 + g) ^ (row & 15)) << 4));
#pragma unroll
                    for (int n = 0; n < 4; ++n) {
                        const int j = n * 16 + li;
                        const bf16x8 wf = *(const bf16x8*)(wl + j * 256 + (((ks * 4 + g) ^ (j & 15)) << 4));
                        a[n] = mfma16(xf, wf, a[n]);
                    }
                }
#pragma unroll
                for (int n = 0; n < 4; ++n)
#pragma unroll
                    for (int r = 0; r < 4; ++r) pre[(wid * 16 + 4 * g + r) * 64 + n * 16 + li] = a[n][r];
            }
            __syncthreads();
            float hl[8], ap[8];
            {
                float hh = 0.f, aa = 1.f;
#pragma unroll
                for (int k = 0; k < 8; ++k) {
                    const int pp = sub * 8 + k, t = dir ? 63 - pp : pp;
                    const float r = sigmoidf_(pre[t * 64 + sc_c] + br), ig = sigmoidf_(pre[t * 64 + 32 + sc_c] + bi);
                    const float a = __expf(sp8 * r);
                    const float bx = sqrtf(fmaxf(1.0f - a * a, 0.f)) * (ig * xcf[t * 32 + sc_c]);
                    hh = a * hh + bx; aa *= a; hl[k] = hh; ap[k] = aa;
                }
                cA[sub * 32 + sc_c] = aa; cH[sub * 32 + sc_c] = hh;
            }
            __syncthreads();
            {
                float hin = h0[(ci & 1) * 32 + sc_c];
                for (int s2 = 0; s2 < sub; ++s2) hin = cA[s2 * 32 + sc_c] * hin + cH[s2 * 32 + sc_c];
#pragma unroll
                for (int k = 0; k < 8; ++k) {
                    const int pp = sub * 8 + k, t = dir ? 63 - pp : pp;
                    const float hv = hl[k] + ap[k] * hin;
                    const size_t gi = (size_t)(s0 + t) * 768 + sch;
                    if (dir == 0) Hf[gi] = f2bf(hv);
                    else Gl[gi] = f2bf((hfv[k] + hv) * glv[k]);
                    if (k == 7 && sub == 7) h0[((ci + 1) & 1) * 32 + sc_c] = hv;
                }
            }
        }
    }
    __syncthreads();
}

__device__ void merge_tile(const Params& p, int rt, int ct, unsigned char* smem, GemmPipe& pp, bool hn, int nrt, int nct) {
    unsigned char* ws = p.ws;
    const int row0 = rt * 128, col0 = ct * 128;
    uint4 tot[4][2];
    const bf16_t* G = (const bf16_t*)(ws + OFF_GATES);
    const int lane = tidx() & 63, wid = tidx() >> 6, wr = wid >> 1, wc = wid & 1, li = lane & 15, g = lane >> 4;
#pragma unroll 1
    for (int br = 0; br < 3; ++br) {
        const bf16_t* Ab = (const bf16_t*)(ws + (br == 0 ? OFF_QA : (br == 1 ? OFF_GL : OFF_QM)));
        const bf16_t* Bb = (const bf16_t*)(ws + (br == 0 ? OFF_PATTNT : (br == 1 ? OFF_PLRUT : OFF_PMEMT)));
        const int Kb = br == 2 ? 512 : 768;
        const int nbr = br == 2 ? 0 : br + 1, nr0 = br == 2 ? nrt * 128 : row0, nc0 = br == 2 ? nct * 128 : col0, nKb = nbr == 2 ? 512 : 768;
        const bf16_t* nAb = (const bf16_t*)(ws + (nbr == 0 ? OFF_QA : (nbr == 1 ? OFF_GL : OFF_QM)));
        const bf16_t* nBb = (const bf16_t*)(ws + (nbr == 0 ? OFF_PATTNT : (nbr == 1 ? OFF_PLRUT : OFF_PMEMT)));
        const GemmOp op{Ab + (size_t)row0 * Kb, Bb + (size_t)col0 * Kb, Kb, Kb};
        const GemmOp nx{nAb + (size_t)nr0 * nKb, nBb + (size_t)nc0 * nKb, nKb, nKb};
        f32x4 acc[4][4]; acc_zero(acc);
        gemm_tile(op, Kb, acc, smem, pp, nx, br < 2 || hn);
#pragma unroll
        for (int m = 0; m < 4; ++m)
#pragma unroll
            for (int pp = 0; pp < 2; ++pp) {
                const int r = wr * 64 + m * 16 + li, c = wc * 64 + 32 * pp + 8 * g;
                const uint4 gv = *(const uint4*)(G + (size_t)(row0 + r) * 3072 + br * 1024 + col0 + c);
                float v[8];
                v[0] = bflo(gv.x) * acc[m][2 * pp][0]; v[1] = bfhi(gv.x) * acc[m][2 * pp][1];
                v[2] = bflo(gv.y) * acc[m][2 * pp][2]; v[3] = bfhi(gv.y) * acc[m][2 * pp][3];
                v[4] = bflo(gv.z) * acc[m][2 * pp + 1][0]; v[5] = bfhi(gv.z) * acc[m][2 * pp + 1][1];
                v[6] = bflo(gv.w) * acc[m][2 * pp + 1][2]; v[7] = bfhi(gv.w) * acc[m][2 * pp + 1][3];
                if (br > 0) {
                    const uint4 t = tot[m][pp];
                    v[0] += bflo(t.x); v[1] += bfhi(t.x); v[2] += bflo(t.y); v[3] += bfhi(t.y);
                    v[4] += bflo(t.z); v[5] += bfhi(t.z); v[6] += bflo(t.w); v[7] += bfhi(t.w);
                }
                tot[m][pp] = make_uint4(pack_bf16(v[0], v[1]), pack_bf16(v[2], v[3]), pack_bf16(v[4], v[5]), pack_bf16(v[6], v[7]));
            }
    }
    bf16_t* dst = (bf16_t*)(ws + OFF_MERGED) + col0;
#pragma unroll
    for (int m = 0; m < 4; ++m)
#pragma unroll
        for (int pp = 0; pp < 2; ++pp) {
            const int r = wr * 64 + m * 16 + li, c = wc * 64 + 32 * pp + 8 * g;
            *(uint4*)(dst + (size_t)(row0 + r) * 1024 + c) = tot[m][pp];
        }
}
__device__ void outproj_tile(const Params& p, int rt, int ct, unsigned char* smem, GemmPipe& pp, bool hn, int nrt, int nct) {
    const int row0 = rt * 128, col0 = ct * 128;
    f32x4 acc[4][4]; acc_zero(acc);
    const GemmOp op{(const bf16_t*)(p.ws + OFF_MERGED) + (size_t)row0 * 1024, (const bf16_t*)(p.ws + OFF_WOUTT) + (size_t)col0 * 1024, 1024, 1024};
    const GemmOp nx{(const bf16_t*)(p.ws + OFF_MERGED) + (size_t)nrt * 128 * 1024, (const bf16_t*)(p.ws + OFF_WOUTT) + (size_t)nct * 128 * 1024, 1024, 1024};
    gemm_tile(op, 1024, acc, smem, pp, nx, hn);
    epi_foreach(acc, [&](int r, int c, float (&v)[8], int) {
        const size_t o = (size_t)(row0 + r) * 1024 + col0 + c;
        const float4 x0 = *(const float4*)(p.x + o), x1 = *(const float4*)(p.x + o + 4);
        *(float4*)(p.out + o) = make_float4(x0.x + v[0], x0.y + v[1], x0.z + v[2], x0.w + v[3]);
        *(float4*)(p.out + o + 4) = make_float4(x1.x + v[4], x1.y + v[5], x1.z + v[6], x1.w + v[7]);
    });
}

__device__ void peerq_tile(const Params& p, int rt, int ct, unsigned char* smem, GemmPipe& pp, bool hn, int nrt, int nct) {
    const int row0 = rt * 128, col0 = ct * 128;
    f32x4 acc[4][4]; acc_zero(acc);
    const GemmOp op{(const bf16_t*)(p.ws + OFF_MERGED) + (size_t)row0 * 1024, (const bf16_t*)(p.ws + OFF_WPQT) + (size_t)col0 * 1024, 1024, 1024};
    const GemmOp nx{(const bf16_t*)(p.ws + OFF_MERGED) + (size_t)nrt * 128 * 1024, (const bf16_t*)(p.ws + OFF_WPQT) + (size_t)nct * 128 * 1024, 1024, 1024};
    gemm_tile(op, 1024, acc, smem, pp, nx, hn);
    bf16_t* dst = (bf16_t*)(p.ws + OFF_QPEER) + col0;
    epi_foreach(acc, [&](int r, int c, float (&v)[8], int) { store_bf16x8(dst + (size_t)(row0 + r) * 2048 + c, v); });
}

__device__ __forceinline__ int sortable(float v) { int k = __float_as_int(v); return k ^ ((k >> 31) & 0x7fffffff); }
__device__ __forceinline__ float unsortable(int k) { return __int_as_float(k ^ ((k >> 31) & 0x7fffffff)); }
__device__ __forceinline__ void insert16(int (&lst)[16], int x) {
#pragma unroll
    for (int k = 0; k < 16; ++k) { const int hi = max(lst[k], x); x = min(lst[k], x); lst[k] = hi; }
}
__device__ void scores_tile(const Params& p, int rt, int pq, unsigned char* smem) {
    const int row0 = rt * 128;
    f32x4 acc[4][4]; acc_zero(acc);
    const GemmOp op{(const bf16_t*)(p.ws + OFF_QPEER) + (size_t)row0 * 2048 + pq * 128, (const bf16_t*)(p.ws + OFF_SUBK) + (size_t)pq * 128 * 128, 2048, 128};
    GemmPipe pp{0, false};
    gemm_tile(op, 128, acc, smem, pp, op, false);
    float* sc = (float*)smem;
    __syncthreads();
    epi_foreach(acc, [&](int r, int c, float (&v)[8], int) {
        *(float4*)(sc + r * 132 + c) = make_float4(v[0], v[1], v[2], v[3]);
        *(float4*)(sc + r * 132 + c + 4) = make_float4(v[4], v[5], v[6], v[7]); });
    __syncthreads();
    {
        const int t = tidx(), r = t & 127, hf = t >> 7;
        int lst[16];
#pragma unroll
        for (int k = 0; k < 16; ++k) lst[k] = (int)0x80000000;
#pragma unroll 2
        for (int j4 = 0; j4 < 16; ++j4) {
            const int j = hf * 64 + j4 * 4;
            const float4 v = *(const float4*)(sc + r * 132 + j);
            insert16(lst, (sortable(v.x) & ~127) | (j + 0));
            insert16(lst, (sortable(v.y) & ~127) | (j + 1));
            insert16(lst, (sortable(v.z) & ~127) | (j + 2));
            insert16(lst, (sortable(v.w) & ~127) | (j + 3));
        }
        __syncthreads();
        int* ls = (int*)smem;
        if (hf) {
#pragma unroll
            for (int k = 0; k < 16; ++k) ls[t * 16 + k] = lst[15 - k];
        }
        __syncthreads();
        if (!hf) {
#pragma unroll
            for (int k = 0; k < 16; ++k) lst[k] = max(lst[k], ls[(t + 128) * 16 + k]);
#pragma unroll
            for (int s = 8; s >= 1; s >>= 1)
#pragma unroll
                for (int k = 0; k < 16; ++k)
                    if ((k & s) == 0) { const int hi = max(lst[k], lst[k + s]), lo = min(lst[k], lst[k + s]); lst[k] = hi; lst[k + s] = lo; }
            int4* dst = (int4*)((int*)(p.ws + OFF_TOPL) + ((size_t)(row0 + r) * 16 + pq) * 16);
            dst[0] = make_int4(lst[0], lst[1], lst[2], lst[3]); dst[1] = make_int4(lst[4], lst[5], lst[6], lst[7]);
            dst[2] = make_int4(lst[8], lst[9], lst[10], lst[11]); dst[3] = make_int4(lst[12], lst[13], lst[14], lst[15]);
        }
    }
    __syncthreads();
}

__device__ void combine_item(const Params& p, int item) {
    const int tok = item >> 3, hd = item & 7;
    const int* l0 = (const int*)(p.ws + OFF_TOPL) + ((size_t)tok * 16 + hd * 2) * 16;
    const int* l1 = l0 + 16;
    int k0[16], k1[16];
#pragma unroll
    for (int i = 0; i < 4; ++i) {
        const int4 a = ((const int4*)l0)[i], b = ((const int4*)l1)[i];
        k0[4 * i] = a.x; k0[4 * i + 1] = a.y; k0[4 * i + 2] = a.z; k0[4 * i + 3] = a.w;
        k1[4 * i] = b.x; k1[4 * i + 1] = b.y; k1[4 * i + 2] = b.z; k1[4 * i + 3] = b.w;
    }
    float v0[16], v1[16];
#pragma unroll
    for (int i = 0; i < 16; ++i) { v0[i] = unsortable(k0[i] & ~127); v1[i] = unsortable(k1[i] & ~127); }
    int lst[16];
#pragma unroll
    for (int k = 0; k < 16; ++k) lst[k] = (int)0x80000000;
#pragma unroll
    for (int a = 0; a < 16; ++a)
#pragma unroll
        for (int b = 0; b < 16; ++b)
            if ((a + 1) * (b + 1) <= 16) insert16(lst, (sortable(v0[a] + v1[b]) & ~255) | (a * 16 + b));
    float val[16], sum = 0.f;
    const float mx = unsortable(lst[0] & ~255);
#pragma unroll
    for (int k = 0; k < 16; ++k) { val[k] = __expf(unsortable(lst[k] & ~255) - mx); sum += val[k]; }
    const float inv = 1.0f / sum;
    int* ei = (int*)(p.ws + OFF_EIDX) + (size_t)tok * 128 + hd * 16;
    float* eg = (float*)(p.ws + OFF_EGATE) + (size_t)tok * 128 + hd * 16;
#pragma unroll
    for (int k = 0; k < 16; ++k) {
        const int code = lst[k] & 255, a = code >> 4, b = code & 15;
        ei[k] = (l0[a] & 127) * 128 + (l1[b] & 127);
        eg[k] = val[k] * inv;
    }
}

__device__ __forceinline__ void conv_row_fp8(const float* __restrict__ src, unsigned char* __restrict__ dst, float* __restrict__ scale, int row, int lane) {
    const float4* s = (const float4*)(src + (size_t)row * 1024 + lane * 16);
    float4 v[4]; float am = 0.f;
#pragma unroll
    for (int i = 0; i < 4; ++i) { v[i] = s[i]; am = fmaxf(am, fmaxf(fmaxf(fabsf(v[i].x), fabsf(v[i].y)), fmaxf(fabsf(v[i].z), fabsf(v[i].w)))); }
#pragma unroll
    for (int o = 32; o >= 1; o >>= 1) am = fmaxf(am, __shfl_xor(am, o));
    const float sc = am > 0.f ? am * (1.0f / 224.0f) : 1.0f, inv = 1.0f / sc;
    unsigned w[4];
#pragma unroll
    for (int i = 0; i < 4; ++i) {
        int t = __builtin_amdgcn_cvt_pk_fp8_f32(v[i].x * inv, v[i].y * inv, 0, false);
        t = __builtin_amdgcn_cvt_pk_fp8_f32(v[i].z * inv, v[i].w * inv, t, true);
        w[i] = (unsigned)t;
    }
    *(uint4*)(dst + (size_t)row * 1024 + lane * 16) = make_uint4(w[0], w[1], w[2], w[3]);
    if (lane == 0) scale[row] = sc;
}
__device__ __forceinline__ void load8rows(uint4 (&R)[8], const unsigned char* __restrict__ tab, int es, int l0, int lane) {
#pragma unroll
    for (int j = 0; j < 8; ++j) {
        const int id = __builtin_amdgcn_readlane(es, l0 + j);
        R[j] = *(const uint4*)(tab + (size_t)id * 1024 + lane * 16);
    }
}
__device__ __forceinline__ float dot16q(const uint4& r, const float (&h)[16]) {
    const unsigned q[4] = {r.x, r.y, r.z, r.w};
    float d0 = 0.f, d1 = 0.f;
#pragma unroll
    for (int i = 0; i < 4; ++i) {
        const f32x2v a = __builtin_amdgcn_cvt_pk_f32_fp8((int)q[i], false), b = __builtin_amdgcn_cvt_pk_f32_fp8((int)q[i], true);
        d0 += a.x * h[4 * i]; d1 += a.y * h[4 * i + 1]; d0 += b.x * h[4 * i + 2]; d1 += b.y * h[4 * i + 3];
    }
    return d0 + d1;
}
__device__ __forceinline__ float dots8(const uint4 (&R)[8], const float (&h)[16], int lane) {
    float pd[8];
#pragma unroll
    for (int j = 0; j < 8; ++j) pd[j] = dot16q(R[j], h);
    const bool b5 = (lane & 32) != 0, b4 = (lane & 16) != 0, b3 = (lane & 8) != 0;
    float a[4];
#pragma unroll
    for (int j = 0; j < 4; ++j) { const float keep = b5 ? pd[4 + j] : pd[j], send = b5 ? pd[j] : pd[4 + j]; a[j] = keep + __shfl_xor(send, 32); }
    float c[2];
#pragma unroll
    for (int j = 0; j < 2; ++j) { const float keep = b4 ? a[2 + j] : a[j], send = b4 ? a[j] : a[2 + j]; c[j] = keep + __shfl_xor(send, 16); }
    float kk;
    { const float keep = b3 ? c[1] : c[0], send = b3 ? c[0] : c[1]; kk = keep + __shfl_xor(send, 8); }
    kk += __shfl_xor(kk, 4); kk += __shfl_xor(kk, 2); kk += __shfl_xor(kk, 1);
    return kk;
}
__device__ __forceinline__ void axpy8(float (&o)[16], const uint4 (&R)[8], int wsr, int bb) {
#pragma unroll
    for (int j = 0; j < 8; ++j) {
        const float c = __int_as_float(__builtin_amdgcn_readlane(wsr, 8 * j + bb));
        const unsigned q[4] = {R[j].x, R[j].y, R[j].z, R[j].w};
#pragma unroll
        for (int i = 0; i < 4; ++i) {
            const f32x2v a = __builtin_amdgcn_cvt_pk_f32_fp8((int)q[i], false), b = __builtin_amdgcn_cvt_pk_f32_fp8((int)q[i], true);
            o[4 * i] += c * a.x; o[4 * i + 1] += c * a.y; o[4 * i + 2] += c * b.x; o[4 * i + 3] += c * b.y;
        }
    }
}
__device__ void gather_token(const Params& p, int tok, int lane) {
    const bf16_t* h2 = (const bf16_t*)(p.ws + OFF_MERGED) + (size_t)tok * 1024 + lane * 16;
    const unsigned char* Uq = p.ws + OFF_UB; const unsigned char* Vq = p.ws + OFF_VB;
    const float* SU = (const float*)(p.ws + OFF_SU); const float* SV = (const float*)(p.ws + OFF_SV);
    const int* ei = (const int*)(p.ws + OFF_EIDX) + (size_t)tok * 128;
    const float* eg = (const float*)(p.ws + OFF_EGATE) + (size_t)tok * 128;
    float h[16];
    {
        const uint4 ha = *(const uint4*)h2, hb = *(const uint4*)(h2 + 8);
        const unsigned hq[8] = {ha.x, ha.y, ha.z, ha.w, hb.x, hb.y, hb.z, hb.w};
#pragma unroll
        for (int e = 0; e < 8; ++e) { h[2 * e] = bflo(hq[e]); h[2 * e + 1] = bfhi(hq[e]); }
    }
    const int pe = 8 * (lane & 7) + (lane >> 3);
    int es[2], wsr[2] = {0, 0}; float su[2], gv[2];
#pragma unroll
    for (int k = 0; k < 2; ++k) {
        es[k] = ei[64 * k + lane];
        const int e = ei[64 * k + pe];
        su[k] = SU[e]; gv[k] = eg[64 * k + pe] * SV[e];
    }
    uint4 R0[8], R1[8];
#pragma unroll
    for (int k = 0; k < 2; ++k) {
        load8rows(R0, Uq, es[k], 0, lane);
        for (int bb = 0; bb < 8; bb += 2) {
            load8rows(R1, Uq, es[k], 8 * bb + 8, lane);
            { const float w = gelu_tanh(dots8(R0, h, lane) * su[k]) * gv[k]; if ((lane & 7) == bb) wsr[k] = __float_as_int(w); }
            if (bb + 2 < 8) load8rows(R0, Uq, es[k], 8 * bb + 16, lane);
            { const float w = gelu_tanh(dots8(R1, h, lane) * su[k]) * gv[k]; if ((lane & 7) == bb + 1) wsr[k] = __float_as_int(w); }
        }
    }
    float o[16];
#pragma unroll
    for (int e = 0; e < 16; ++e) o[e] = 0.f;
#pragma unroll
    for (int k = 0; k < 2; ++k) {
        load8rows(R0, Vq, es[k], 0, lane);
        for (int bb = 0; bb < 8; bb += 2) {
            load8rows(R1, Vq, es[k], 8 * bb + 8, lane);
            axpy8(o, R0, wsr[k], bb);
            if (bb + 2 < 8) load8rows(R0, Vq, es[k], 8 * bb + 16, lane);
            axpy8(o, R1, wsr[k], bb + 1);
        }
    }
    float* xr = p.out + (size_t)tok * 1024 + lane * 16;
    float4 x[4]; float ss = 0.f;
#pragma unroll
    for (int i = 0; i < 4; ++i) {
        x[i] = *(const float4*)(xr + 4 * i);
        x[i].x += o[4 * i]; x[i].y += o[4 * i + 1]; x[i].z += o[4 * i + 2]; x[i].w += o[4 * i + 3];
        ss += x[i].x * x[i].x + x[i].y * x[i].y + x[i].z * x[i].z + x[i].w * x[i].w;
    }
    ss = wave_sum(ss);
    const float rs = rsqrtf(ss * (1.0f / 1024.0f) + EPS);
    const float* gf = p.g_final + lane * 16;
#pragma unroll
    for (int i = 0; i < 4; ++i) {
        const float4 gg = *(const float4*)(gf + 4 * i);
        *(float4*)(xr + 4 * i) = make_float4(x[i].x * rs * gg.x, x[i].y * rs * gg.y, x[i].z * rs * gg.z, x[i].w * rs * gg.w);
    }
}


__device__ __forceinline__ bool gemm_unit(int it, int nct, int& rt, int& ct) {
    const int x = blockIdx.x & 7, j = blockIdx.x >> 3, nbx = gridDim.x >> 3;
    const int v = j + it * nbx, per_rg = 8 * nct;
    if (v >= 32 * nct) return false;
    const int rgi = v / per_rg, w = v - rgi * per_rg, cg = w >> 6, w2 = w & 63;
    const int rtl = w2 & 7, ctl = w2 >> 3;
    rt = (rgi * 8 + rtl) * 8 + x; ct = cg * 8 + ctl;
    return true;
}

#define XB_TMO      128
#define XB_XCNT(j)  (256  + 64 * (j))
#define XB_XSUB(j)  (1280 + 64 * (j))
#define XB_XGEN(j)  (2304 + 64 * (j))
#define XB_TOP      3328
#define XB_TOPGEN   3392
#define XCD_BAR_WORDS 3456
#define XB_SPIN_CAP (1u << 22)
#define LAS __attribute__((address_space(3)))
__device__ __forceinline__ unsigned xb_ld(unsigned* p)              { return __hip_atomic_load(p, __ATOMIC_RELAXED, __HIP_MEMORY_SCOPE_AGENT); }
__device__ __forceinline__ unsigned xb_add(unsigned* p, unsigned v) { return __hip_atomic_fetch_add(p, v, __ATOMIC_RELAXED, __HIP_MEMORY_SCOPE_AGENT); }
__device__ __forceinline__ unsigned xb_xcc_id() { return (unsigned)__builtin_amdgcn_s_getreg((3 << 11) | 20) & 0xFu; }
#define XB_SPIN(cond, bar) do { unsigned _sp = 0; while (cond) { __builtin_amdgcn_s_sleep(1); \
    if ((++_sp & 255u) == 0u) { if (xb_ld(&(bar)[XB_TMO])) break; if (_sp > XB_SPIN_CAP) { atomicAdd(&(bar)[XB_TMO], 1u); break; } } } } while (0)
struct XcdBarrier { unsigned* bar; unsigned x; volatile LAS unsigned* st; };
__device__ __forceinline__ XcdBarrier xcd_barrier_post(unsigned* bar, volatile LAS unsigned* st) {
    XcdBarrier b; b.bar = bar; b.x = xb_xcc_id(); b.st = st;
    if (threadIdx.x == 0) (void)xb_add(&bar[XB_XCNT(b.x)], 1u);
    return b;
}
__device__ __forceinline__ void xcd_barrier_complete(unsigned* bar, unsigned x, unsigned& nloc, unsigned& nx) {
    const unsigned G = gridDim.x;
    unsigned sum, cnt, mine, sp = 0u;
    for (;;) {
        sum = 0u; cnt = 0u; mine = 0u;
#pragma unroll
        for (unsigned j = 0; j < 16; ++j) { const unsigned c = xb_ld(&bar[XB_XCNT(j)]); sum += c; cnt += (c > 0u) ? 1u : 0u; mine = (j == x) ? c : mine; }
        if (sum == G) break;
        __builtin_amdgcn_s_sleep(1);
        if ((++sp & 255u) == 0u) { if (xb_ld(&bar[XB_TMO])) break; if (sp > XB_SPIN_CAP) { atomicAdd(&bar[XB_TMO], 1u); break; } }
    }
    nloc = mine > 0u ? mine : 1u; nx = cnt > 0u ? cnt : 1u;
}
__device__ __forceinline__ void xcd_barrier(const XcdBarrier& b) {
    asm volatile("s_waitcnt vmcnt(0)" ::: "memory");
    __syncthreads();
    if (threadIdx.x == 0) {
        unsigned* bar = b.bar;
        __builtin_amdgcn_s_waitcnt(0);
        unsigned nloc = b.st[0], nx = b.st[1];
        if (nloc == 0u) { xcd_barrier_complete(bar, b.x, nloc, nx); b.st[0] = nloc; b.st[1] = nx; }
        const unsigned old = xb_add(&bar[XB_XSUB(b.x)], 1u);
        const unsigned gen = old / nloc;
        if (old + 1u == (gen + 1u) * nloc) {
            __builtin_amdgcn_fence(__ATOMIC_RELEASE, "agent");
            asm volatile("s_waitcnt vmcnt(0)" ::: "memory");
            const unsigned og = xb_add(&bar[XB_TOP], 1u);
            const unsigned tg = og / nx;
            if (og + 1u == (tg + 1u) * nx) xb_add(&bar[XB_TOPGEN], 1u);
            else XB_SPIN(xb_ld(&bar[XB_TOPGEN]) == tg, bar);
            __builtin_amdgcn_fence(__ATOMIC_ACQUIRE, "agent");
            xb_add(&bar[XB_XGEN(b.x)], 1u);
            asm volatile("s_waitcnt vmcnt(0)" ::: "memory");
        } else {
            XB_SPIN(xb_ld(&bar[XB_XGEN(b.x)]) == gen, bar);
            __builtin_amdgcn_fence(__ATOMIC_ACQUIRE, "agent");
            asm volatile("s_waitcnt vmcnt(0)" ::: "memory");
        }
    }
    __syncthreads();
}

#ifndef PROBE_PHASE
#define PROBE_PHASE -1
#endif
#define PH_BEGIN(k) if (PROBE_PHASE == (k)) probe_t0 = __builtin_amdgcn_s_memrealtime();
#define PH_END(k)   if (PROBE_PHASE == (k)) probe_dt = __builtin_amdgcn_s_memrealtime() - probe_t0;
constexpr int SMEM_BYTES = 128 * 132 * 4;

__global__ void __launch_bounds__(256, 2) fwd_megakernel(Params p) {
    __shared__ __attribute__((aligned(16))) unsigned char smem[SMEM_BYTES + 16];
    if (threadIdx.x == 0) *(uint4*)(smem + SMEM_BYTES) = make_uint4(0u, 0u, 0u, 0u);
    __syncthreads();
    const XcdBarrier xb = xcd_barrier_post((unsigned*)(p.ws + OFF_BAR), (volatile LAS unsigned*)(smem + SMEM_BYTES));
    const int bid = blockIdx.x, nb = gridDim.x, tid = tidx(), lane = tid & 63, wid = tid >> 6;
    unsigned char* ws = p.ws; unsigned char* dob = (unsigned char*)p.out;
    unsigned long long probe_t0 = 0, probe_dt = 0;
    PH_BEGIN(0)
    {
        for (int u = bid; u < 3232; u += nb) {
            if (u < 1600) convT_tile(p.w_in, (bf16_t*)(ws + OFF_WINT), 1024, INW, u, smem);
            else if (u < 1856) convT_tile(p.w_mem_kv, (bf16_t*)(ws + OFF_WMKVT), 1024, 1024, u - 1600, smem);
            else if (u < 2048) convT_tile(p.p_attn, (bf16_t*)(ws + OFF_PATTNT), 768, 1024, u - 1856, smem);
            else if (u < 2240) convT_tile(p.p_lru, (bf16_t*)(ws + OFF_PLRUT), 768, 1024, u - 2048, smem);
            else if (u < 2368) convT_tile(p.p_mem, (bf16_t*)(ws + OFF_PMEMT), 512, 1024, u - 2240, smem);
            else if (u < 2624) convT_tile(p.w_out, (bf16_t*)(ws + OFF_WOUTT), 1024, 1024, u - 2368, smem);
            else if (u < 3136) convT_tile(p.w_peer_q, (bf16_t*)(ws + OFF_WPQT), 1024, 2048, u - 2624, smem);
            else {
                const int v = u - 3136, mat = v >> 2, tile = v & 3, gsel = mat / 6, h = mat % 6, dir = gsel & 1;
                const float* src = (gsel < 2 ? p.lru_wr : p.lru_wi) + (size_t)(dir * 6 + h) * 128 * 128;
                convT_tile(src, (bf16_t*)(ws + OFF_LRUWT) + (size_t)(h * 512 + gsel * 128) * 128, 128, 128, tile, smem);
            }
        }
        conv_plain(p.peer_sub_keys, (bf16_t*)(ws + OFF_SUBK), (size_t)16 * 128 * 128 / 8);
        for (int r = bid * 4 + wid; r < 2 * NEXP; r += nb * 4) {
            if (r < NEXP) conv_row_fp8(p.peer_u, ws + OFF_UB, (float*)(ws + OFF_SU), r, lane);
            else conv_row_fp8(p.peer_v, ws + OFF_VB, (float*)(ws + OFF_SV), r - NEXP, lane);
        }
        for (int r = bid * 4 + wid; r < NTOK; r += nb * 4) rms_row_bf16(p.x + (size_t)r * 1024, p.g_mix, (bf16_t*)(dob + DO_HBF) + (size_t)r * 1024, lane);
        for (int r = bid * 4 + wid; r < NMEM; r += nb * 4) rms_row_bf16(p.mem + (size_t)r * 1024, p.g_mem, (bf16_t*)(dob + DO_MEMBF) + (size_t)r * 1024, lane);
        for (int i = bid * 256 + tid; i < NTOK * 16; i += nb * 256) rope_item(p.positions, (float*)(dob + DO_ROPE), i);
    }
    xcd_barrier(xb);
    PH_END(0) PH_BEGIN(1)
    for (int u = bid; u < 256; u += nb) memkv_tile(p, u / 8, u % 8, smem);
    { GemmPipe pp{0, false}; int rt, ct, nrt = 0, nct = 0; bool have = gemm_unit(0, 50, rt, ct); __syncthreads();
      for (int it = 0; have; ++it) { const bool hn = gemm_unit(it + 1, 50, nrt, nct); inproj_tile(p, rt, ct, smem, pp, hn, nrt, nct); rt = nrt; ct = nct; have = hn; } }
    xcd_barrier(xb);
    PH_END(1) PH_BEGIN(2)
    {
        unsigned* ctr = (unsigned*)(p.ws + OFF_BAR) + 3600;
        volatile LAS unsigned* slot = (volatile LAS unsigned*)(smem + SMEM_BYTES + 8);
        for (;;) {
            if (tid == 0) *slot = xb_add(ctr, 1u);
            __syncthreads();
            const int u = (int)*slot;
            __syncthreads();
            if (u >= 384 + 1536 + 1024) break;
            if (u < 384) lru_unit(p, u, smem);
            else if (u < 384 + 1536) attn_win_unit(p, u - 384, smem);
            else attn_mem_unit(p, u - 384 - 1536, smem);
        }
    }
    xcd_barrier(xb);
    PH_END(2) PH_BEGIN(3)
    { GemmPipe pp{0, false}; int rt, ct, nrt = 0, nct = 0; bool have = gemm_unit(0, 8, rt, ct); __syncthreads();
      for (int it = 0; have; ++it) { const bool hn = gemm_unit(it + 1, 8, nrt, nct); merge_tile(p, rt, ct, smem, pp, hn, nrt, nct); rt = nrt; ct = nct; have = hn; } }
    xcd_barrier(xb);
    PH_END(3) PH_BEGIN(4)
    { GemmPipe pp{0, false}; int rt, ct, nrt = 0, nct = 0; bool have = gemm_unit(0, 8, rt, ct); __syncthreads();
      for (int it = 0; have; ++it) { const bool hn = gemm_unit(it + 1, 8, nrt, nct); outproj_tile(p, rt, ct, smem, pp, hn, nrt, nct); rt = nrt; ct = nct; have = hn; } }
    xcd_barrier(xb);
    PH_END(4) PH_BEGIN(5)
    for (int r = bid * 4 + wid; r < NTOK; r += nb * 4) rms_row_bf16(p.out + (size_t)r * 1024, p.g_ffn, (bf16_t*)(ws + OFF_MERGED) + (size_t)r * 1024, lane);
    xcd_barrier(xb);
    PH_END(5) PH_BEGIN(6)
    { GemmPipe pp{0, false}; int rt, ct, nrt = 0, nct = 0; bool have = gemm_unit(0, 16, rt, ct); __syncthreads();
      for (int it = 0; have; ++it) { const bool hn = gemm_unit(it + 1, 16, nrt, nct); peerq_tile(p, rt, ct, smem, pp, hn, nrt, nct); rt = nrt; ct = nct; have = hn; } }
    xcd_barrier(xb);
    PH_END(6) PH_BEGIN(7)
    for (int u = bid; u < 256 * 16; u += nb) scores_tile(p, u / 16, u % 16, smem);
    xcd_barrier(xb);
    PH_END(7) PH_BEGIN(8)
    for (int i = bid * 256 + tid; i < NTOK * 8; i += nb * 256) combine_item(p, i);
    xcd_barrier(xb);
    PH_END(8) PH_BEGIN(9)
    for (int t = bid * 4 + wid; t < NTOK; t += nb * 4) gather_token(p, t, lane);
    PH_END(9)
    if (PROBE_PHASE >= 0) { __syncthreads(); const unsigned long long t1 = __builtin_amdgcn_s_memrealtime(); while (__builtin_amdgcn_s_memrealtime() - t1 < probe_dt) __builtin_amdgcn_s_sleep(8); }
}

extern "C" void kernel_launch(void* const* d_in, const int* in_sizes, int n_in, void* d_out, int out_size, void* d_ws, size_t ws_size, hipStream_t stream) {
    if (ws_size < OFF_END) { fprintf(stderr, "workspace too small: %zu < %zu\n", ws_size, (size_t)OFF_END); return; }
    Params p{};
    p.x = (const float*)d_in[0]; p.mem = (const float*)d_in[1]; p.positions = (const int*)d_in[2];
    p.g_mix = (const float*)d_in[3]; p.g_mem = (const float*)d_in[4]; p.w_in = (const float*)d_in[5]; p.gate_b = (const float*)d_in[6];
    p.attn_sink = (const float*)d_in[7]; p.conv_w = (const float*)d_in[8]; p.conv_b = (const float*)d_in[9];
    p.lru_wr = (const float*)d_in[10]; p.lru_br = (const float*)d_in[11]; p.lru_wi = (const float*)d_in[12]; p.lru_bi = (const float*)d_in[13];
    p.lru_lambda = (const float*)d_in[14]; p.w_mem_kv = (const float*)d_in[15]; p.p_attn = (const float*)d_in[16]; p.p_lru = (const float*)d_in[17];
    p.p_mem = (const float*)d_in[18]; p.w_out = (const float*)d_in[19]; p.g_ffn = (const float*)d_in[20]; p.w_peer_q = (const float*)d_in[21];
    p.peer_sub_keys = (const float*)d_in[22]; p.peer_u = (const float*)d_in[23]; p.peer_v = (const float*)d_in[24]; p.g_final = (const float*)d_in[25];
    p.out = (float*)d_out; p.ws = (unsigned char*)d_ws;
    static int grid_blocks = 0;
    if (!grid_blocks) {
        int dev = 0, cus = 0, per_cu = 0;
        (void)hipGetDevice(&dev);
        (void)hipDeviceGetAttribute(&cus, hipDeviceAttributeMultiprocessorCount, dev);
        (void)hipOccupancyMaxActiveBlocksPerMultiprocessor(&per_cu, fwd_megakernel, 256, 0);
        if (per_cu > 2) per_cu = 2;
        grid_blocks = cus * per_cu;
    }
    (void)hipMemsetAsync((unsigned char*)d_ws + OFF_BAR, 0, 16384, stream);
    void* args[] = {&p};
    hipError_t e = hipLaunchCooperativeKernel((void*)fwd_megakernel, dim3(grid_blocks), dim3(256), args, 0, stream);
    if (e != hipSuccess) fprintf(stderr, "cooperative launch failed: %s (grid %d)\n", hipGetErrorString(e), grid_blocks);
}
```

```cpp
#include <hip/hip_runtime.h>
#include <stdint.h>
#include <stdio.h>

typedef unsigned short bf16_t;
typedef short bf16x8 __attribute__((ext_vector_type(8)));
typedef __bf16 bf16x2v __attribute__((ext_vector_type(2)));
typedef float f32x4 __attribute__((ext_vector_type(4)));

constexpr int B_ = 16, S_ = 2048, D_ = 1024, NTOK = B_ * S_;
constexpr int MEML = 256, NMEM = B_ * MEML;
constexpr int INW = 6400;
constexpr int LW = 768;
constexpr int NEXP = 16384;
constexpr float EPS = 1e-6f;
constexpr float QSCALE = 0.08838834764831845f * 1.4426950408889634f;

constexpr size_t OFF_WINT = 0;
constexpr size_t OFF_WMKVT = OFF_WINT + (size_t)INW * 1024 * 2;
constexpr size_t OFF_PATTNT = OFF_WMKVT + (size_t)1024 * 1024 * 2;
constexpr size_t OFF_PLRUT = OFF_PATTNT + (size_t)1024 * 768 * 2;
constexpr size_t OFF_PMEMT = OFF_PLRUT + (size_t)1024 * 768 * 2;
constexpr size_t OFF_WOUTT = OFF_PMEMT + (size_t)1024 * 512 * 2;
constexpr size_t OFF_WPQT = OFF_WOUTT + (size_t)1024 * 1024 * 2;
constexpr size_t OFF_LRUWT = OFF_WPQT + (size_t)2048 * 1024 * 2;
constexpr size_t OFF_SUBK = OFF_LRUWT + (size_t)6 * 512 * 128 * 2;
constexpr size_t OFF_UB = OFF_SUBK + (size_t)16 * 128 * 128 * 2;
constexpr size_t OFF_VB = OFF_UB + (size_t)NEXP * 1024;
constexpr size_t OFF_SU = OFF_VB + (size_t)NEXP * 1024;
constexpr size_t OFF_SV = OFF_SU + (size_t)NEXP * 4;
constexpr size_t OFF_RA = OFF_SV + (size_t)NEXP * 4;
constexpr size_t OFF_QA = OFF_RA;
constexpr size_t OFF_KA = OFF_QA + (size_t)NTOK * 768 * 2;
constexpr size_t OFF_VAT = OFF_KA + (size_t)NTOK * 256 * 2;
constexpr size_t OFF_XL = OFF_VAT + (size_t)NTOK * 256 * 2;
constexpr size_t OFF_GL = OFF_XL + (size_t)NTOK * 768 * 2;
constexpr size_t OFF_QM = OFF_GL + (size_t)NTOK * 768 * 2;
constexpr size_t OFF_GATES = OFF_QM + (size_t)NTOK * 512 * 2;
constexpr size_t OFF_BAR = OFF_GATES + (size_t)NTOK * 3072 * 2;
constexpr size_t OFF_SP8 = OFF_BAR + 16384;
constexpr size_t OFF_AGG = OFF_SP8 + 2 * 768 * 4;
constexpr size_t OFF_END = OFF_AGG + (size_t)2 * B_ * 16 * 768 * 8;
constexpr size_t OFF_MERGED = OFF_KA;
constexpr size_t OFF_QPEER = OFF_GATES;
constexpr size_t OFF_TOPL = OFF_QPEER + (size_t)NTOK * 2048 * 2;
constexpr size_t OFF_EIDX = OFF_TOPL + (size_t)NTOK * 256 * 4;
constexpr size_t OFF_EGATE = OFF_EIDX + (size_t)NTOK * 128 * 4;
static_assert(OFF_EGATE + (size_t)NTOK * 128 * 4 <= OFF_BAR, "overlay");
static_assert(OFF_MERGED + (size_t)NTOK * 1024 * 2 <= OFF_GL, "overlay2");
constexpr size_t DO_HBF = 0;
constexpr size_t DO_MEMBF = DO_HBF + (size_t)NTOK * 1024 * 2;
constexpr size_t DO_KM = DO_MEMBF + (size_t)NMEM * 1024 * 2;
constexpr size_t DO_VMT = DO_KM + (size_t)NMEM * 512 * 2;
constexpr size_t DO_ROPE = DO_VMT + (size_t)NMEM * 512 * 2;
static_assert(DO_ROPE + (size_t)NTOK * 32 * 4 <= (size_t)NTOK * 1024 * 4, "d_out scratch");

struct Params {
    const float *x, *mem; const int* positions;
    const float *g_mix, *g_mem, *w_in, *gate_b, *attn_sink, *conv_w, *conv_b, *lru_wr, *lru_br, *lru_wi, *lru_bi, *lru_lambda,
        *w_mem_kv, *p_attn, *p_lru, *p_mem, *w_out, *g_ffn, *w_peer_q, *peer_sub_keys, *peer_u, *peer_v, *g_final;
    float* out; unsigned char* ws;
};

__device__ __forceinline__ int tidx() { int t = threadIdx.x; asm volatile("" : "+v"(t)); return t; }
__device__ __forceinline__ float bf2f(bf16_t b) { return __uint_as_float(((unsigned)b) << 16); }
__device__ __forceinline__ float bflo(unsigned u) { return __uint_as_float(u << 16); }
__device__ __forceinline__ float bfhi(unsigned u) { return __uint_as_float(u & 0xffff0000u); }
typedef float f32x2v __attribute__((ext_vector_type(2)));
__device__ __forceinline__ unsigned pack_bf16(float lo, float hi) { const f32x2v f = {lo, hi}; return __builtin_bit_cast(unsigned, __builtin_convertvector(f, bf16x2v)); }
__device__ __forceinline__ bf16_t f2bf(float f) { return (bf16_t)(pack_bf16(f, 0.f) & 0xffffu); }
__device__ __forceinline__ f32x4 mfma16(bf16x8 a, bf16x8 b, f32x4 c) { return __builtin_amdgcn_mfma_f32_16x16x32_bf16(a, b, c, 0, 0, 0); }
__device__ __forceinline__ float sigmoidf_(float x) { return __builtin_amdgcn_rcpf(1.0f + __expf(-x)); }
__device__ __forceinline__ float gelu_tanh(float x) { const float u = 1.5957691216057308f * (x + 0.044715f * x * x * x); return x * __builtin_amdgcn_rcpf(1.0f + __expf(-u)); }
__device__ __forceinline__ float wave_sum(float v) {
#pragma unroll
    for (int o = 32; o >= 1; o >>= 1) v += __shfl_xor(v, o);
    return v;
}

__device__ void convT_tile(const float* __restrict__ src, bf16_t* __restrict__ dst, int K, int N, int tile, unsigned char* smem) {
    float* t = (float*)smem;
    const int tn = N / 64, tk = tile / tn, tnn = tile % tn, k0 = tk * 64, n0 = tnn * 64, tid = tidx();
    const int r = tid >> 4, c4 = (tid & 15) * 4;
#pragma unroll
    for (int i = 0; i < 4; ++i) {
        const int k = r + 16 * i;
        const float4 v = *(const float4*)(src + (size_t)(k0 + k) * N + n0 + c4);
        t[k * 65 + c4 + 0] = v.x; t[k * 65 + c4 + 1] = v.y; t[k * 65 + c4 + 2] = v.z; t[k * 65 + c4 + 3] = v.w;
    }
    __syncthreads();
    const int n = tid >> 2, kq = (tid & 3) * 16;
    unsigned w[8];
#pragma unroll
    for (int i = 0; i < 8; ++i) w[i] = pack_bf16(t[(kq + 2 * i) * 65 + n], t[(kq + 2 * i + 1) * 65 + n]);
    uint4* d = (uint4*)(dst + (size_t)(n0 + n) * K + k0 + kq);
    d[0] = make_uint4(w[0], w[1], w[2], w[3]); d[1] = make_uint4(w[4], w[5], w[6], w[7]);
    __syncthreads();
}


__device__ __forceinline__ void rms_row_bf16(const float* __restrict__ xr, const float* __restrict__ g, bf16_t* __restrict__ o, int lane) {
    float4 v[4]; float ss = 0.f;
#pragma unroll
    for (int i = 0; i < 4; ++i) { v[i] = *(const float4*)(xr + i * 256 + lane * 4); ss += v[i].x * v[i].x + v[i].y * v[i].y + v[i].z * v[i].z + v[i].w * v[i].w; }
    ss = wave_sum(ss);
    const float rs = rsqrtf(ss * (1.0f / 1024.0f) + EPS);
#pragma unroll
    for (int i = 0; i < 4; ++i) {
        const float4 gg = *(const float4*)(g + i * 256 + lane * 4);
        *(uint2*)(o + i * 256 + lane * 4) = make_uint2(pack_bf16(v[i].x * rs * gg.x, v[i].y * rs * gg.y), pack_bf16(v[i].z * rs * gg.z, v[i].w * rs * gg.w));
    }
}


__device__ __forceinline__ void conv_plain(const float* __restrict__ src, bf16_t* __restrict__ dst, size_t n8) {
    for (size_t i = (size_t)blockIdx.x * 256 + tidx(); i < n8; i += (size_t)gridDim.x * 256) {
        const float4 a = ((const float4*)src)[2 * i], b = ((const float4*)src)[2 * i + 1];
        ((uint4*)dst)[i] = make_uint4(pack_bf16(a.x, a.y), pack_bf16(a.z, a.w), pack_bf16(b.x, b.y), pack_bf16(b.z, b.w));
    }
}
__device__ __forceinline__ void rope_item(const int* __restrict__ pos, float* __restrict__ cs, int i) {
    const int t = i >> 4, f = i & 15;
    const float inv = powf(500000.0f, -(float)(2 * f) / 32.0f);
    const float ang = (float)pos[t] * inv;
    float s, c; sincosf(ang, &s, &c);
    cs[2 * i] = c; cs[2 * i + 1] = s;
}

__device__ __forceinline__ int swz(int row) { return (row & 3) | (((row >> 3) & 1) << 2); }

struct GemmOp { const bf16_t* A; const bf16_t* Bt; int lda, ldb; };
struct GemmPipe { int par; bool pre; };

__device__ __forceinline__ void gemm_tile(const GemmOp& op, int K, f32x4 (&acc)[4][4], unsigned char* smem, GemmPipe& pp, const GemmOp& nx, bool has_next) {
    const int tid = tidx(), lane = tid & 63, wid = tid >> 6, wr = wid >> 1, wc = wid & 1, li = lane & 15, g = lane >> 4;
    const int srow = tid >> 3, skc = (tid & 7) ^ swz(tid >> 3);
    const bf16_t* ga = op.A + (size_t)srow * op.lda + skc * 8;
    const bf16_t* gb = op.Bt + (size_t)srow * op.ldb + skc * 8;
    unsigned char* ldst = smem + tid * 16;
    int aoff[4], boff[4], asw[4], bsw[4];
#pragma unroll
    for (int m = 0; m < 4; ++m) { const int row = wr * 64 + m * 16 + li; aoff[m] = row * 128; asw[m] = swz(row); }
#pragma unroll
    for (int n = 0; n < 4; ++n) { const int row = wc * 64 + 32 * (n >> 1) + 8 * (li >> 2) + 4 * (n & 1) + (li & 3); boff[n] = 16384 + row * 128; bsw[n] = swz(row); }
    const int nk = K >> 6;
    if (!pp.pre) {
        unsigned char* sw = ldst + pp.par * 32768;
#pragma unroll
        for (int i = 0; i < 4; ++i) {
            __builtin_amdgcn_global_load_lds((const unsigned*)(ga + (size_t)(32 * i) * op.lda), (unsigned*)(sw + i * 4096), 16, 0, 0);
            __builtin_amdgcn_global_load_lds((const unsigned*)(gb + (size_t)(32 * i) * op.ldb), (unsigned*)(sw + 16384 + i * 4096), 16, 0, 0);
        }
    }
    __syncthreads();
    for (int kt = 0; kt < nk; ++kt) {
        const int cur = (pp.par + kt) & 1;
        const unsigned char* sb = smem + cur * 32768;
        unsigned char* sw = ldst + (cur ^ 1) * 32768;
        if (kt + 1 < nk) {
#pragma unroll
            for (int i = 0; i < 4; ++i) {
                __builtin_amdgcn_global_load_lds((const unsigned*)(ga + (size_t)(32 * i) * op.lda + (kt + 1) * 64), (unsigned*)(sw + i * 4096), 16, 0, 0);
                __builtin_amdgcn_global_load_lds((const unsigned*)(gb + (size_t)(32 * i) * op.ldb + (kt + 1) * 64), (unsigned*)(sw + 16384 + i * 4096), 16, 0, 0);
            }
        } else if (has_next) {
            const bf16_t* na = nx.A + (size_t)srow * nx.lda + skc * 8;
            const bf16_t* nb = nx.Bt + (size_t)srow * nx.ldb + skc * 8;
#pragma unroll
            for (int i = 0; i < 4; ++i) {
                __builtin_amdgcn_global_load_lds((const unsigned*)(na + (size_t)(32 * i) * nx.lda), (unsigned*)(sw + i * 4096), 16, 0, 0);
                __builtin_amdgcn_global_load_lds((const unsigned*)(nb + (size_t)(32 * i) * nx.ldb), (unsigned*)(sw + 16384 + i * 4096), 16, 0, 0);
            }
        }
#pragma unroll
        for (int ks = 0; ks < 2; ++ks) {
            bf16x8 af[4], bfr[4];
#pragma unroll
            for (int m = 0; m < 4; ++m) af[m] = *(const bf16x8*)(sb + aoff[m] + (((ks * 4 + g) ^ asw[m]) << 4));
#pragma unroll
            for (int n = 0; n < 4; ++n) bfr[n] = *(const bf16x8*)(sb + boff[n] + (((ks * 4 + g) ^ bsw[n]) << 4));
#pragma unroll
            for (int m = 0; m < 4; ++m)
#pragma unroll
                for (int n = 0; n < 4; ++n) acc[m][n] = mfma16(bfr[n], af[m], acc[m][n]);
        }
        if (kt + 1 < nk) __syncthreads();
    }
    pp.par = (pp.par + nk) & 1; pp.pre = has_next;
}
__device__ __forceinline__ void acc_zero(f32x4 (&acc)[4][4]) {
#pragma unroll
    for (int m = 0; m < 4; ++m)
#pragma unroll
        for (int n = 0; n < 4; ++n) acc[m][n] = (f32x4){0.f, 0.f, 0.f, 0.f};
}
template <class F> __device__ __forceinline__ void epi_foreach(const f32x4 (&acc)[4][4], F&& f) {
    const int lane = tidx() & 63, wid = tidx() >> 6, wr = wid >> 1, wc = wid & 1, li = lane & 15, g = lane >> 4;
#pragma unroll
    for (int m = 0; m < 4; ++m)
#pragma unroll
        for (int pp = 0; pp < 2; ++pp) {
            float v[8];
#pragma unroll
            for (int r = 0; r < 4; ++r) { v[r] = acc[m][2 * pp][r]; v[4 + r] = acc[m][2 * pp + 1][r]; }
            f(wr * 64 + m * 16 + li, wc * 64 + 32 * pp + 8 * g, v, pp);
        }
}
__device__ __forceinline__ void store_bf16x8(bf16_t* p, const float (&v)[8]) {
    *(uint4*)p = make_uint4(pack_bf16(v[0], v[1]), pack_bf16(v[2], v[3]), pack_bf16(v[4], v[5]), pack_bf16(v[6], v[7]));
}
__device__ __forceinline__ void store_tile_T(const f32x4 (&acc)[4][4], bf16_t* __restrict__ dstT, int ldt, unsigned char* smem) {
    bf16_t* t = (bf16_t*)smem;
    __syncthreads();
    epi_foreach(acc, [&](int r, int c, const float (&v)[8], int) {
#pragma unroll
        for (int e = 0; e < 8; ++e) t[(c + e) * 136 + r] = f2bf(v[e]);
    });
    __syncthreads();
#pragma unroll
    for (int i = 0; i < 8; ++i) {
        const int ch = tidx() + 256 * i, d = ch >> 4, tc = ch & 15;
        *(uint4*)(dstT + (size_t)d * ldt + tc * 8) = *(const uint4*)(smem + d * 272 + tc * 16);
    }
    __syncthreads();
}

__device__ void inproj_tile(const Params& p, int rt, int ct, unsigned char* smem, GemmPipe& pp, bool hn, int nrt, int nct) {
    unsigned char* ws = p.ws; unsigned char* dob = (unsigned char*)p.out;
    const bf16_t* hbf = (const bf16_t*)(dob + DO_HBF);
    const bf16_t* WinT = (const bf16_t*)(ws + OFF_WINT);
    f32x4 acc[4][4]; acc_zero(acc);
    const GemmOp op{hbf + (size_t)rt * 128 * 1024, WinT + (size_t)ct * 128 * 1024, 1024, 1024};
    const GemmOp nx{hbf + (size_t)nrt * 128 * 1024, WinT + (size_t)nct * 128 * 1024, 1024, 1024};
    gemm_tile(op, 1024, acc, smem, pp, nx, hn && !(ct == 8 || ct == 9));
    const int row0 = rt * 128;
    if (ct < 8) {
        const float* cs = (const float*)(dob + DO_ROPE);
        const bool isq = ct < 6;
        bf16_t* dst = isq ? (bf16_t*)(ws + OFF_QA) + ct * 128 : (bf16_t*)(ws + OFF_KA) + (ct - 6) * 128;
        const int ld = isq ? 768 : 256;
        const float sc = isq ? QSCALE : 1.0f;
        const int g = (tidx() & 63) >> 4;
        epi_foreach(acc, [&](int r, int c, float (&v)[8], int pp) {
            const int tok = row0 + r;
            if (pp == 0 && c < 32) {
                const float* csr = cs + (size_t)tok * 32 + (g & 1) * 16;
#pragma unroll
                for (int e = 0; e < 8; ++e) {
                    const float o = __shfl_xor(v[e], 32);
                    const float cc = csr[2 * e], ss = csr[2 * e + 1];
                    v[e] = (g < 2) ? (v[e] * cc - o * ss) : (v[e] * cc + o * ss);
                }
            }
#pragma unroll
            for (int e = 0; e < 8; ++e) v[e] *= sc;
            store_bf16x8(dst + (size_t)tok * ld + c, v);
        });
    } else if (ct < 10) {
        const int kvh = ct - 8, b = row0 / S_, s0 = row0 % S_;
        store_tile_T(acc, (bf16_t*)(ws + OFF_VAT) + (size_t)(b * 2 + kvh) * 128 * S_ + s0, S_, smem);
    } else if (ct < 16) {
        bf16_t* dst = (bf16_t*)(ws + OFF_XL) + (ct - 10) * 128;
        epi_foreach(acc, [&](int r, int c, float (&v)[8], int) { store_bf16x8(dst + (size_t)(row0 + r) * 768 + c, v); });
    } else if (ct < 22) {
        bf16_t* dst = (bf16_t*)(ws + OFF_GL) + (ct - 16) * 128;
        epi_foreach(acc, [&](int r, int c, float (&v)[8], int) {
#pragma unroll
            for (int e = 0; e < 8; ++e) v[e] = gelu_tanh(v[e]);
            store_bf16x8(dst + (size_t)(row0 + r) * 768 + c, v); });
    } else if (ct < 26) {
        bf16_t* dst = (bf16_t*)(ws + OFF_QM) + (ct - 22) * 128;
        epi_foreach(acc, [&](int r, int c, float (&v)[8], int) {
#pragma unroll
            for (int e = 0; e < 8; ++e) v[e] *= QSCALE;
            store_bf16x8(dst + (size_t)(row0 + r) * 512 + c, v); });
    } else {
        const int gc0 = (ct - 26) * 128;
        bf16_t* dst = (bf16_t*)(ws + OFF_GATES) + gc0;
        const float* gb = p.gate_b + gc0;
        epi_foreach(acc, [&](int r, int c, float (&v)[8], int) {
            const float4 b0 = *(const float4*)(gb + c), b1 = *(const float4*)(gb + c + 4);
            v[0] = sigmoidf_(v[0] + b0.x); v[1] = sigmoidf_(v[1] + b0.y); v[2] = sigmoidf_(v[2] + b0.z); v[3] = sigmoidf_(v[3] + b0.w);
            v[4] = sigmoidf_(v[4] + b1.x); v[5] = sigmoidf_(v[5] + b1.y); v[6] = sigmoidf_(v[6] + b1.z); v[7] = sigmoidf_(v[7] + b1.w);
            store_bf16x8(dst + (size_t)(row0 + r) * 3072 + c, v); });
    }
}

__device__ void memkv_tile(const Params& p, int rt, int ct, unsigned char* smem) {
    unsigned char* dob = (unsigned char*)p.out;
    f32x4 acc[4][4]; acc_zero(acc);
    const GemmOp op{(const bf16_t*)(dob + DO_MEMBF) + (size_t)rt * 128 * 1024, (const bf16_t*)(p.ws + OFF_WMKVT) + (size_t)ct * 128 * 1024, 1024, 1024};
    GemmPipe pp{0, false};
    __syncthreads();
    gemm_tile(op, 1024, acc, smem, pp, op, false);
    const int row0 = rt * 128;
    if (ct < 4) {
        bf16_t* dst = (bf16_t*)(dob + DO_KM) + ct * 128;
        epi_foreach(acc, [&](int r, int c, float (&v)[8], int) { store_bf16x8(dst + (size_t)(row0 + r) * 512 + c, v); });
    } else {
        const int h = ct - 4, b = row0 / MEML, m0 = row0 % MEML;
        store_tile_T(acc, (bf16_t*)(dob + DO_VMT) + (size_t)(b * 4 + h) * 128 * MEML + m0, MEML, smem);
    }
}


typedef float f32x16 __attribute__((ext_vector_type(16)));
__device__ __forceinline__ f32x16 mfma32(bf16x8 a, bf16x8 b, f32x16 c) { return __builtin_amdgcn_mfma_f32_32x32x16_bf16(a, b, c, 0, 0, 0); }
constexpr int ATT_STAGE = 16384 + 128 * 136;

template <bool WIN>
__device__ void attn_block(const bf16_t* Qg, int ldq, const bf16_t* __restrict__ Kg, int ldk, const bf16_t* __restrict__ Vtg, int ldv,
                           int q0, int kt0, int nt, float sink2, bf16_t* Og, int ldo, unsigned char* smem) {
    const int tid = tidx(), lane = tid & 63, wid = tid >> 6, r = lane & 31, hh = lane >> 5;
    const int qw = q0 + 32 * wid;
    bf16x8 qf[8];
#pragma unroll
    for (int ks = 0; ks < 8; ++ks) qf[ks] = *(const bf16x8*)(Qg + (size_t)(32 * wid + r) * ldq + ks * 16 + hh * 8);
    f32x16 o[4];
#pragma unroll
    for (int db = 0; db < 4; ++db)
#pragma unroll
        for (int e = 0; e < 16; ++e) o[db][e] = 0.f;
    float m = WIN ? sink2 : -1e30f, l = WIN ? 1.0f : 0.0f;
    const int krow = tid >> 4, kch = tid & 15, vrow = tid >> 3, vch = tid & 7;
    const int koff = krow * 256 + ((kch ^ (krow & 15)) << 4);
    const int voff = 16384 + vrow * 136 + vch * 16;
    uint4 rk[4], rv[4];
    const bf16_t* kgp = Kg + (size_t)(kt0 * 64 + krow) * ldk + kch * 8;
    const bf16_t* vgp = Vtg + (size_t)vrow * ldv + kt0 * 64 + vch * 8;
#pragma unroll
    for (int i = 0; i < 4; ++i) { rk[i] = *(const uint4*)(kgp + (size_t)(16 * i) * ldk); rv[i] = *(const uint4*)(vgp + (size_t)(32 * i) * ldv); }
#pragma unroll
    for (int i = 0; i < 4; ++i) {
        *(uint4*)(smem + koff + i * 4096) = rk[i];
        *(uint2*)(smem + voff + i * 4352) = make_uint2(rv[i].x, rv[i].y); *(uint2*)(smem + voff + i * 4352 + 8) = make_uint2(rv[i].z, rv[i].w);
    }
    __syncthreads();
    for (int t = 0; t < nt; ++t) {
        const unsigned char* sb = smem + (t & 1) * ATT_STAGE;
        {
            const int tn = t + 1 < nt ? t + 1 : t;
#pragma unroll
            for (int i = 0; i < 4; ++i) { rk[i] = *(const uint4*)(kgp + (size_t)(tn * 64 + 16 * i) * ldk); rv[i] = *(const uint4*)(vgp + (size_t)(32 * i) * ldv + tn * 64); }
        }
        const int k0 = (kt0 + t) * 64;
        if (!WIN || (k0 + 63 >= qw - 128 && k0 <= qw + 159)) {
#pragma unroll
            for (int kb = 0; kb < 2; ++kb) {
                const int kb0 = k0 + 32 * kb;
                if (WIN && !(kb0 + 31 >= qw - 128 && kb0 <= qw + 159)) continue;
                f32x16 s;
#pragma unroll
                for (int e = 0; e < 16; ++e) s[e] = 0.f;
                const int row = kb * 32 + r;
#pragma unroll
                for (int ks = 0; ks < 8; ++ks) {
                    const bf16x8 a = *(const bf16x8*)(sb + row * 256 + (((2 * ks + hh) ^ (row & 15)) << 4));
                    s = mfma32(a, qf[ks], s);
                }
                if (WIN && !(kb0 >= qw - 97 && kb0 + 31 <= qw + 128)) {
#pragma unroll
                    for (int e = 0; e < 16; ++e) {
                        const int d = kb0 + (e & 3) + 8 * (e >> 2) + 4 * hh - (qw + r);
                        s[e] = (d <= 128 && d >= -128) ? s[e] : -1e30f;
                    }
                }
                float mx = s[0];
#pragma unroll
                for (int e = 1; e < 16; ++e) mx = fmaxf(mx, s[e]);
                mx = fmaxf(mx, __shfl_xor(mx, 32));
                const float mnew = fmaxf(m, mx), alpha = __builtin_amdgcn_exp2f(m - mnew);
                m = mnew;
                float ps = 0.f;
#pragma unroll
                for (int e = 0; e < 16; ++e) { s[e] = __builtin_amdgcn_exp2f(s[e] - mnew); ps += s[e]; }
                ps += __shfl_xor(ps, 32);
                l = l * alpha + ps;
                if (__any(alpha != 1.0f)) {
#pragma unroll
                    for (int db = 0; db < 4; ++db)
#pragma unroll
                        for (int e = 0; e < 16; ++e) o[db][e] *= alpha;
                }
#pragma unroll
                for (int s2 = 0; s2 < 2; ++s2) {
                    union { unsigned u[4]; bf16x8 v; } pb;
#pragma unroll
                    for (int e = 0; e < 4; ++e) pb.u[e] = pack_bf16(s[8 * s2 + 2 * e], s[8 * s2 + 2 * e + 1]);
#pragma unroll
                    for (int db = 0; db < 4; ++db) {
                        const unsigned char* vp = sb + 16384 + (db * 32 + r) * 136 + (kb * 32 + 16 * s2 + 4 * hh) * 2;
                        union { uint2 u[2]; bf16x8 v; } va;
                        va.u[0] = *(const uint2*)vp; va.u[1] = *(const uint2*)(vp + 16);
                        o[db] = mfma32(va.v, pb.v, o[db]);
                    }
                }
            }
        }
        {
            unsigned char* sw = smem + ((t + 1) & 1) * ATT_STAGE;
#pragma unroll
            for (int i = 0; i < 4; ++i) {
                *(uint4*)(sw + koff + i * 4096) = rk[i];
                *(uint2*)(sw + voff + i * 4352) = make_uint2(rv[i].x, rv[i].y); *(uint2*)(sw + voff + i * 4352 + 8) = make_uint2(rv[i].z, rv[i].w);
            }
        }
        __syncthreads();
    }
    const float inv = __builtin_amdgcn_rcpf(l);
    bf16_t* orow = Og + (size_t)(32 * wid + r) * ldo + 4 * hh;
#pragma unroll
    for (int db = 0; db < 4; ++db)
#pragma unroll
        for (int gq = 0; gq < 4; ++gq)
            *(uint2*)(orow + db * 32 + 8 * gq) = make_uint2(pack_bf16(o[db][4 * gq] * inv, o[db][4 * gq + 1] * inv), pack_bf16(o[db][4 * gq + 2] * inv, o[db][4 * gq + 3] * inv));
}
__device__ void attn_win_unit(const Params& p, int u, unsigned char* smem) {
    const int gh = u % 3, qb = (u / 3) % 16, kvh = (u / 48) % 2, b = u / 96, head = kvh * 3 + gh;
    const int q0 = qb * 128;
    const int ks = q0 - 128 < 0 ? 0 : q0 - 128, ke = q0 + 256 > S_ ? S_ : q0 + 256;
    bf16_t* Q = (bf16_t*)(p.ws + OFF_QA) + (size_t)(b * S_ + q0) * 768 + head * 128;
    const bf16_t* Kb = (const bf16_t*)(p.ws + OFF_KA) + (size_t)(b * S_) * 256 + kvh * 128;
    const bf16_t* Vt = (const bf16_t*)(p.ws + OFF_VAT) + (size_t)(b * 2 + kvh) * 128 * S_;
    attn_block<true>(Q, 768, Kb, 256, Vt, S_, q0, ks / 64, (ke - ks) / 64, p.attn_sink[head] * 1.4426950408889634f, Q, 768, smem);
}
__device__ void attn_mem_unit(const Params& p, int u, unsigned char* smem) {
    const int qb = u % 16, head = (u / 16) % 4, b = u / 64;
    const int q0 = qb * 128;
    unsigned char* dob = (unsigned char*)p.out;
    bf16_t* Q = (bf16_t*)(p.ws + OFF_QM) + (size_t)(b * S_ + q0) * 512 + head * 128;
    const bf16_t* Kb = (const bf16_t*)(dob + DO_KM) + (size_t)(b * MEML) * 512 + head * 128;
    const bf16_t* Vt = (const bf16_t*)(dob + DO_VMT) + (size_t)(b * 4 + head) * 128 * MEML;
    attn_block<false>(Q, 512, Kb, 512, Vt, MEML, q0, 0, 4, 0.f, Q, 512, smem);
}

typedef _Float16 f16x2v __attribute__((ext_vector_type(2)));
__device__ __forceinline__ unsigned pack_f16(float lo, float hi) { const f16x2v h = {(_Float16)lo, (_Float16)hi}; return __builtin_bit_cast(unsigned, h); }
template <bool FINAL>
__device__ void lru_chunk_unit(const Params& p, int u, unsigned char* smem) {
    const int tid = tidx(), lane = tid & 63, wid = tid >> 6, li = lane & 15, g = lane >> 4;
    const int c = u & 15, h = (u >> 4) % 6, b = u / 96;
    const int cbase = h * 128, s0 = c * 128;
    unsigned char* xcs = smem; unsigned char* LB = smem + 32768; float2* SA = (float2*)(smem + 49152); unsigned char* WL = smem + 51200; float* CC = (float*)(smem + 67584);
    const bf16_t* Xl = (const bf16_t*)(p.ws + OFF_XL) + (size_t)(b * S_) * 768;
    bf16_t* Gl = (bf16_t*)(p.ws + OFF_GL) + (size_t)(b * S_ + s0) * 768;
    const bf16_t* LruWt = (const bf16_t*)(p.ws + OFF_LRUWT) + (size_t)h * 512 * 128;
    const float* SP8 = (const float*)(p.ws + OFF_SP8);
    float2* AGG = (float2*)(p.ws + OFF_AGG);
    auto stage_w = [&](int hc_, int d_) {
#pragma unroll
        for (int i = 0; i < 4; ++i) {
            const int rr = (tid >> 4) + 16 * i, n = rr >> 4, wrow = ((n >> 1) * 2 + d_) * 128 + hc_ * 32 + 16 * (n & 1) + (rr & 15);
            __builtin_amdgcn_global_load_lds((const unsigned*)(LruWt + (size_t)wrow * 128 + (((tid & 15) ^ (rr & 15)) << 3)), (unsigned*)(WL + tid * 16 + i * 4096), 16, 0, 0);
        }
    };
    __syncthreads();
    stage_w(0, 0);
    if (FINAL) {
        const int d_ = tid >> 7, ch_ = tid & 127;
        const float2* ag = AGG + ((size_t)(d_ * B_ + b) * 16) * 768 + cbase + ch_;
        float2 av[16];
#pragma unroll
        for (int j = 0; j < 16; ++j) av[j] = ag[(size_t)j * 768];
        float H = 0.f;
#pragma unroll
        for (int jj = 0; jj < 16; ++jj) {
            const int j = d_ ? 15 - jj : jj;
            const bool on = d_ ? (j > c) : (j < c);
            H = __builtin_amdgcn_exp2f(on ? av[j].x : 0.f) * H + (on ? av[j].y : 0.f);
        }
        CC[tid] = H;
    }
    {
        const int cp = tid & 63, tq = tid >> 6, cch = cbase + 2 * cp;
        float cw[4][2];
#pragma unroll
        for (int j = 0; j < 4; ++j) { cw[j][0] = p.conv_w[j * LW + cch]; cw[j][1] = p.conv_w[j * LW + cch + 1]; }
        const float cb0 = p.conv_b[cch], cb1 = p.conv_b[cch + 1];
        {
            const int tb = 32 * tq;
            unsigned xw[35];
#pragma unroll
            for (int i = 0; i < 35; ++i) { const int s = s0 + tb + i - 2; xw[i] = (s >= 0 && s < S_) ? *(const unsigned*)(Xl + (size_t)s * 768 + cch) : 0u; }
#pragma unroll
            for (int i = 0; i < 32; ++i) {
                const int t = tb + i;
                const float y0 = cb0 + cw[0][0] * bflo(xw[i]) + cw[1][0] * bflo(xw[i + 1]) + cw[2][0] * bflo(xw[i + 2]) + cw[3][0] * bflo(xw[i + 3]);
                const float y1 = cb1 + cw[0][1] * bfhi(xw[i]) + cw[1][1] * bfhi(xw[i + 1]) + cw[2][1] * bfhi(xw[i + 2]) + cw[3][1] * bfhi(xw[i + 3]);
                *(unsigned*)(xcs + t * 256 + (((cp >> 2) ^ (t & 15)) << 4) + (cp & 3) * 4) = pack_bf16(y0, y1);
            }
        }
    }
    const int sch = tid & 31, seg = tid >> 5;
    float4 cst[2][3];
    auto load_cst = [&](int hc_, int d_) {
#pragma unroll
        for (int n = 0; n < 2; ++n) {
            const int gch = cbase + hc_ * 32 + 16 * n + 4 * g;
            cst[n][0] = *(const float4*)(p.lru_br + d_ * LW + gch); cst[n][1] = *(const float4*)(p.lru_bi + d_ * LW + gch); cst[n][2] = *(const float4*)(SP8 + d_ * LW + gch);
        }
    };
    load_cst(0, 0);
    __syncthreads();
#pragma unroll 1
    for (int hc = 0; hc < 4; ++hc) {
        float hfv[16];
#pragma unroll
        for (int d = 0; d < 2; ++d) {
            f32x4 acc[2][4];
#pragma unroll
            for (int m = 0; m < 2; ++m)
#pragma unroll
                for (int n = 0; n < 4; ++n) acc[m][n] = (f32x4){0.f, 0.f, 0.f, 0.f};
#pragma unroll
            for (int ks = 0; ks < 4; ++ks) {
                bf16x8 xf[2];
#pragma unroll
                for (int m = 0; m < 2; ++m) { const int row = 32 * wid + 16 * m + li; xf[m] = *(const bf16x8*)(xcs + row * 256 + (((ks * 4 + g) ^ (row & 15)) << 4)); }
#pragma unroll
                for (int n = 0; n < 4; ++n) {
                    const int rr = 16 * n + li;
                    const bf16x8 wf = *(const bf16x8*)(WL + rr * 256 + (((ks * 4 + g) ^ li) << 4));
#pragma unroll
                    for (int m = 0; m < 2; ++m) acc[m][n] = mfma16(wf, xf[m], acc[m][n]);
                }
            }
#pragma unroll
            for (int n = 0; n < 2; ++n) {
                const int ch4 = 16 * n + 4 * g;
                const float4 br4 = cst[n][0], bi4 = cst[n][1], sp4 = cst[n][2];
                const float brv[4] = {br4.x, br4.y, br4.z, br4.w}, biv[4] = {bi4.x, bi4.y, bi4.z, bi4.w}, spv[4] = {sp4.x, sp4.y, sp4.z, sp4.w};
#pragma unroll
                for (int m = 0; m < 2; ++m) {
                    const int tok = 32 * wid + 16 * m + li;
                    const uint2 xq = *(const uint2*)(xcs + tok * 256 + ((((hc * 32 + ch4) >> 3) ^ (tok & 15)) << 4) + (g & 1) * 8);
                    const float xc[4] = {bflo(xq.x), bfhi(xq.x), bflo(xq.y), bfhi(xq.y)};
                    unsigned w[4];
#pragma unroll
                    for (int r = 0; r < 4; ++r) {
                        const float rg = sigmoidf_(acc[m][n][r] + brv[r]), ig = sigmoidf_(acc[m][n + 2][r] + biv[r]);
                        const float la = spv[r] * rg, a = __builtin_amdgcn_exp2f(la);
                        const float bx = sqrtf(fmaxf(1.0f - a * a, 0.f)) * (ig * xc[r]);
                        w[r] = pack_f16(la, bx);
                    }
                    *(uint4*)(LB + tok * 128 + (((ch4 >> 2) ^ (tok & 7)) << 4)) = make_uint4(w[0], w[1], w[2], w[3]);
                }
            }
            __syncthreads();
            if (!(hc == 3 && d == 1)) { stage_w(d ? hc + 1 : hc, d ^ 1); load_cst(d ? hc + 1 : hc, d ^ 1); }
            const int gch = cbase + hc * 32 + sch;
            {
                float L = 0.f, H = 0.f;
#pragma unroll
                for (int k = 0; k < 16; ++k) {
                    const int tok = 16 * seg + (d ? 15 - k : k);
                    const unsigned w = *(const unsigned*)(LB + tok * 128 + (((sch >> 2) ^ (tok & 7)) << 4) + (sch & 3) * 4);
                    const f16x2v hv = __builtin_bit_cast(f16x2v, w);
                    const float la = (float)hv.x, bx = (float)hv.y;
                    H = __builtin_amdgcn_exp2f(la) * H + bx; L += la;
                }
                SA[seg * 32 + sch] = make_float2(L, H);
            }
            __syncthreads();
            if (!FINAL) {
                if (seg == 0) {
                    float L = 0.f, H = 0.f;
#pragma unroll
                    for (int s = 0; s < 8; ++s) { const float2 a = SA[(d ? 7 - s : s) * 32 + sch]; H = __builtin_amdgcn_exp2f(a.x) * H + a.y; L += a.x; }
                    AGG[((size_t)(d * B_ + b) * 16 + c) * 768 + gch] = make_float2(L, H);
                }
            } else {
                float H = CC[d * 128 + hc * 32 + sch];
#pragma unroll
                for (int ss = 0; ss < 8; ++ss) {
                    const int s = d ? 7 - ss : ss;
                    const bool on = d ? (s > seg) : (s < seg);
                    const float2 a = SA[s * 32 + sch];
                    H = __builtin_amdgcn_exp2f(on ? a.x : 0.f) * H + (on ? a.y : 0.f);
                }
#pragma unroll
                for (int k = 0; k < 16; ++k) {
                    const int kk = d ? 15 - k : k, tok = 16 * seg + kk;
                    const unsigned w = *(const unsigned*)(LB + tok * 128 + (((sch >> 2) ^ (tok & 7)) << 4) + (sch & 3) * 4);
                    const f16x2v hv = __builtin_bit_cast(f16x2v, w);
                    H = __builtin_amdgcn_exp2f((float)hv.x) * H + (float)hv.y;
                    if (d == 0) hfv[kk] = H;
                    else { bf16_t* gp = Gl + (size_t)tok * 768 + gch; *gp = f2bf((hfv[kk] + H) * bf2f(*gp)); }
                }
            }
            __syncthreads();
        }
    }
}

__device__ void merge_tile(const Params& p, int rt, int ct, unsigned char* smem, GemmPipe& pp, bool hn, int nrt, int nct) {
    unsigned char* ws = p.ws;
    const int row0 = rt * 128, col0 = ct * 128;
    uint4 tot[4][2];
    const bf16_t* G = (const bf16_t*)(ws + OFF_GATES);
    const int lane = tidx() & 63, wid = tidx() >> 6, wr = wid >> 1, wc = wid & 1, li = lane & 15, g = lane >> 4;
#pragma unroll 1
    for (int br = 0; br < 3; ++br) {
        const bf16_t* Ab = (const bf16_t*)(ws + (br == 0 ? OFF_QA : (br == 1 ? OFF_GL : OFF_QM)));
        const bf16_t* Bb = (const bf16_t*)(ws + (br == 0 ? OFF_PATTNT : (br == 1 ? OFF_PLRUT : OFF_PMEMT)));
        const int Kb = br == 2 ? 512 : 768;
        const int nbr = br == 2 ? 0 : br + 1, nr0 = br == 2 ? nrt * 128 : row0, nc0 = br == 2 ? nct * 128 : col0, nKb = nbr == 2 ? 512 : 768;
        const bf16_t* nAb = (const bf16_t*)(ws + (nbr == 0 ? OFF_QA : (nbr == 1 ? OFF_GL : OFF_QM)));
        const bf16_t* nBb = (const bf16_t*)(ws + (nbr == 0 ? OFF_PATTNT : (nbr == 1 ? OFF_PLRUT : OFF_PMEMT)));
        const GemmOp op{Ab + (size_t)row0 * Kb, Bb + (size_t)col0 * Kb, Kb, Kb};
        const GemmOp nx{nAb + (size_t)nr0 * nKb, nBb + (size_t)nc0 * nKb, nKb, nKb};
        f32x4 acc[4][4]; acc_zero(acc);
        gemm_tile(op, Kb, acc, smem, pp, nx, br < 2 || hn);
#pragma unroll
        for (int m = 0; m < 4; ++m)
#pragma unroll
            for (int pp = 0; pp < 2; ++pp) {
                const int r = wr * 64 + m * 16 + li, c = wc * 64 + 32 * pp + 8 * g;
                const uint4 gv = *(const uint4*)(G + (size_t)(row0 + r) * 3072 + br * 1024 + col0 + c);
                float v[8];
                v[0] = bflo(gv.x) * acc[m][2 * pp][0]; v[1] = bfhi(gv.x) * acc[m][2 * pp][1];
                v[2] = bflo(gv.y) * acc[m][2 * pp][2]; v[3] = bfhi(gv.y) * acc[m][2 * pp][3];
                v[4] = bflo(gv.z) * acc[m][2 * pp + 1][0]; v[5] = bfhi(gv.z) * acc[m][2 * pp + 1][1];
                v[6] = bflo(gv.w) * acc[m][2 * pp + 1][2]; v[7] = bfhi(gv.w) * acc[m][2 * pp + 1][3];
                if (br > 0) {
                    const uint4 t = tot[m][pp];
                    v[0] += bflo(t.x); v[1] += bfhi(t.x); v[2] += bflo(t.y); v[3] += bfhi(t.y);
                    v[4] += bflo(t.z); v[5] += bfhi(t.z); v[6] += bflo(t.w); v[7] += bfhi(t.w);
                }
                tot[m][pp] = make_uint4(pack_bf16(v[0], v[1]), pack_bf16(v[2], v[3]), pack_bf16(v[4], v[5]), pack_bf16(v[6], v[7]));
            }
    }
    bf16_t* dst = (bf16_t*)(ws + OFF_MERGED) + col0;
#pragma unroll
    for (int m = 0; m < 4; ++m)
#pragma unroll
        for (int pp = 0; pp < 2; ++pp) {
            const int r = wr * 64 + m * 16 + li, c = wc * 64 + 32 * pp + 8 * g;
            *(uint4*)(dst + (size_t)(row0 + r) * 1024 + c) = tot[m][pp];
        }
}
__device__ void outproj_tile(const Params& p, int rt, int ct, unsigned char* smem, GemmPipe& pp, bool hn, int nrt, int nct) {
    const int row0 = rt * 128, col0 = ct * 128;
    f32x4 acc[4][4]; acc_zero(acc);
    const GemmOp op{(const bf16_t*)(p.ws + OFF_MERGED) + (size_t)row0 * 1024, (const bf16_t*)(p.ws + OFF_WOUTT) + (size_t)col0 * 1024, 1024, 1024};
    const GemmOp nx{(const bf16_t*)(p.ws + OFF_MERGED) + (size_t)nrt * 128 * 1024, (const bf16_t*)(p.ws + OFF_WOUTT) + (size_t)nct * 128 * 1024, 1024, 1024};
    gemm_tile(op, 1024, acc, smem, pp, nx, hn);
    epi_foreach(acc, [&](int r, int c, float (&v)[8], int) {
        const size_t o = (size_t)(row0 + r) * 1024 + col0 + c;
        const float4 x0 = *(const float4*)(p.x + o), x1 = *(const float4*)(p.x + o + 4);
        *(float4*)(p.out + o) = make_float4(x0.x + v[0], x0.y + v[1], x0.z + v[2], x0.w + v[3]);
        *(float4*)(p.out + o + 4) = make_float4(x1.x + v[4], x1.y + v[5], x1.z + v[6], x1.w + v[7]);
    });
}

__device__ void peerq_tile(const Params& p, int rt, int ct, unsigned char* smem, GemmPipe& pp, bool hn, int nrt, int nct) {
    const int row0 = rt * 128, col0 = ct * 128;
    f32x4 acc[4][4]; acc_zero(acc);
    const GemmOp op{(const bf16_t*)(p.ws + OFF_MERGED) + (size_t)row0 * 1024, (const bf16_t*)(p.ws + OFF_WPQT) + (size_t)col0 * 1024, 1024, 1024};
    const GemmOp nx{(const bf16_t*)(p.ws + OFF_MERGED) + (size_t)nrt * 128 * 1024, (const bf16_t*)(p.ws + OFF_WPQT) + (size_t)nct * 128 * 1024, 1024, 1024};
    gemm_tile(op, 1024, acc, smem, pp, nx, hn);
    bf16_t* dst = (bf16_t*)(p.ws + OFF_QPEER) + col0;
    epi_foreach(acc, [&](int r, int c, float (&v)[8], int) { store_bf16x8(dst + (size_t)(row0 + r) * 2048 + c, v); });
}

__device__ __forceinline__ int sortable(float v) { int k = __float_as_int(v); return k ^ ((k >> 31) & 0x7fffffff); }
__device__ __forceinline__ float unsortable(int k) { return __int_as_float(k ^ ((k >> 31) & 0x7fffffff)); }
__device__ __forceinline__ void insert16(int (&lst)[16], int x) {
#pragma unroll
    for (int k = 0; k < 16; ++k) { const int hi = max(lst[k], x); x = min(lst[k], x); lst[k] = hi; }
}
__device__ void scores_tile(const Params& p, int rt, int pq, unsigned char* smem) {
    const int row0 = rt * 128;
    f32x4 acc[4][4]; acc_zero(acc);
    const GemmOp op{(const bf16_t*)(p.ws + OFF_QPEER) + (size_t)row0 * 2048 + pq * 128, (const bf16_t*)(p.ws + OFF_SUBK) + (size_t)pq * 128 * 128, 2048, 128};
    GemmPipe pp{0, false};
    gemm_tile(op, 128, acc, smem, pp, op, false);
    float* sc = (float*)smem;
    __syncthreads();
    epi_foreach(acc, [&](int r, int c, float (&v)[8], int) {
        *(float4*)(sc + r * 132 + c) = make_float4(v[0], v[1], v[2], v[3]);
        *(float4*)(sc + r * 132 + c + 4) = make_float4(v[4], v[5], v[6], v[7]); });
    __syncthreads();
    {
        const int t = tidx(), r = t & 127, hf = t >> 7;
        int lst[16];
#pragma unroll
        for (int k = 0; k < 16; ++k) lst[k] = (int)0x80000000;
#pragma unroll 2
        for (int j4 = 0; j4 < 16; ++j4) {
            const int j = hf * 64 + j4 * 4;
            const float4 v = *(const float4*)(sc + r * 132 + j);
            insert16(lst, (sortable(v.x) & ~127) | (j + 0));
            insert16(lst, (sortable(v.y) & ~127) | (j + 1));
            insert16(lst, (sortable(v.z) & ~127) | (j + 2));
            insert16(lst, (sortable(v.w) & ~127) | (j + 3));
        }
        __syncthreads();
        int* ls = (int*)smem;
        if (hf) {
#pragma unroll
            for (int k = 0; k < 16; ++k) ls[t * 16 + k] = lst[15 - k];
        }
        __syncthreads();
        if (!hf) {
#pragma unroll
            for (int k = 0; k < 16; ++k) lst[k] = max(lst[k], ls[(t + 128) * 16 + k]);
#pragma unroll
            for (int s = 8; s >= 1; s >>= 1)
#pragma unroll
                for (int k = 0; k < 16; ++k)
                    if ((k & s) == 0) { const int hi = max(lst[k], lst[k + s]), lo = min(lst[k], lst[k + s]); lst[k] = hi; lst[k + s] = lo; }
            int4* dst = (int4*)((int*)(p.ws + OFF_TOPL) + ((size_t)(row0 + r) * 16 + pq) * 16);
            dst[0] = make_int4(lst[0], lst[1], lst[2], lst[3]); dst[1] = make_int4(lst[4], lst[5], lst[6], lst[7]);
            dst[2] = make_int4(lst[8], lst[9], lst[10], lst[11]); dst[3] = make_int4(lst[12], lst[13], lst[14], lst[15]);
        }
    }
    __syncthreads();
}

__device__ void combine_item(const Params& p, int item) {
    const int tok = item >> 3, hd = item & 7;
    const int* l0 = (const int*)(p.ws + OFF_TOPL) + ((size_t)tok * 16 + hd * 2) * 16;
    const int* l1 = l0 + 16;
    int k0[16], k1[16];
#pragma unroll
    for (int i = 0; i < 4; ++i) {
        const int4 a = ((const int4*)l0)[i], b = ((const int4*)l1)[i];
        k0[4 * i] = a.x; k0[4 * i + 1] = a.y; k0[4 * i + 2] = a.z; k0[4 * i + 3] = a.w;
        k1[4 * i] = b.x; k1[4 * i + 1] = b.y; k1[4 * i + 2] = b.z; k1[4 * i + 3] = b.w;
    }
    float v0[16], v1[16];
#pragma unroll
    for (int i = 0; i < 16; ++i) { v0[i] = unsortable(k0[i] & ~127); v1[i] = unsortable(k1[i] & ~127); }
    int lst[16];
#pragma unroll
    for (int k = 0; k < 16; ++k) lst[k] = (int)0x80000000;
#pragma unroll
    for (int a = 0; a < 16; ++a)
#pragma unroll
        for (int b = 0; b < 16; ++b)
            if ((a + 1) * (b + 1) <= 16) insert16(lst, (sortable(v0[a] + v1[b]) & ~255) | (a * 16 + b));
    float val[16], sum = 0.f;
    const float mx = unsortable(lst[0] & ~255);
#pragma unroll
    for (int k = 0; k < 16; ++k) { val[k] = __expf(unsortable(lst[k] & ~255) - mx); sum += val[k]; }
    const float inv = 1.0f / sum;
    int* ei = (int*)(p.ws + OFF_EIDX) + (size_t)tok * 128 + hd * 16;
    float* eg = (float*)(p.ws + OFF_EGATE) + (size_t)tok * 128 + hd * 16;
#pragma unroll
    for (int k = 0; k < 16; ++k) {
        const int code = lst[k] & 255, a = code >> 4, b = code & 15;
        ei[k] = (l0[a] & 127) * 128 + (l1[b] & 127);
        eg[k] = val[k] * inv;
    }
}

__device__ __forceinline__ void conv_row_fp8(const float* __restrict__ src, unsigned char* __restrict__ dst, float* __restrict__ scale, int row, int lane) {
    const float4* s = (const float4*)(src + (size_t)row * 1024 + lane * 16);
    float4 v[4]; float am = 0.f;
#pragma unroll
    for (int i = 0; i < 4; ++i) { v[i] = s[i]; am = fmaxf(am, fmaxf(fmaxf(fabsf(v[i].x), fabsf(v[i].y)), fmaxf(fabsf(v[i].z), fabsf(v[i].w)))); }
#pragma unroll
    for (int o = 32; o >= 1; o >>= 1) am = fmaxf(am, __shfl_xor(am, o));
    const float sc = am > 0.f ? am * (1.0f / 224.0f) : 1.0f, inv = 1.0f / sc;
    unsigned w[4];
#pragma unroll
    for (int i = 0; i < 4; ++i) {
        int t = __builtin_amdgcn_cvt_pk_fp8_f32(v[i].x * inv, v[i].y * inv, 0, false);
        t = __builtin_amdgcn_cvt_pk_fp8_f32(v[i].z * inv, v[i].w * inv, t, true);
        w[i] = (unsigned)t;
    }
    *(uint4*)(dst + (size_t)row * 1024 + lane * 16) = make_uint4(w[0], w[1], w[2], w[3]);
    if (lane == 0) scale[row] = sc;
}
__device__ __forceinline__ void load8rows(uint4 (&R)[8], const unsigned char* __restrict__ tab, int es, int l0, int lane) {
#pragma unroll
    for (int j = 0; j < 8; ++j) {
        const int id = __builtin_amdgcn_readlane(es, l0 + j);
        R[j] = *(const uint4*)(tab + (size_t)id * 1024 + lane * 16);
    }
}
__device__ __forceinline__ float dot16q(const uint4& r, const float (&h)[16]) {
    const unsigned q[4] = {r.x, r.y, r.z, r.w};
    float d0 = 0.f, d1 = 0.f;
#pragma unroll
    for (int i = 0; i < 4; ++i) {
        const f32x2v a = __builtin_amdgcn_cvt_pk_f32_fp8((int)q[i], false), b = __builtin_amdgcn_cvt_pk_f32_fp8((int)q[i], true);
        d0 += a.x * h[4 * i]; d1 += a.y * h[4 * i + 1]; d0 += b.x * h[4 * i + 2]; d1 += b.y * h[4 * i + 3];
    }
    return d0 + d1;
}
__device__ __forceinline__ float dots8(const uint4 (&R)[8], const float (&h)[16], int lane) {
    float pd[8];
#pragma unroll
    for (int j = 0; j < 8; ++j) pd[j] = dot16q(R[j], h);
    const bool b5 = (lane & 32) != 0, b4 = (lane & 16) != 0, b3 = (lane & 8) != 0;
    float a[4];
#pragma unroll
    for (int j = 0; j < 4; ++j) { const float keep = b5 ? pd[4 + j] : pd[j], send = b5 ? pd[j] : pd[4 + j]; a[j] = keep + __shfl_xor(send, 32); }
    float c[2];
#pragma unroll
    for (int j = 0; j < 2; ++j) { const float keep = b4 ? a[2 + j] : a[j], send = b4 ? a[j] : a[2 + j]; c[j] = keep + __shfl_xor(send, 16); }
    float kk;
    { const float keep = b3 ? c[1] : c[0], send = b3 ? c[0] : c[1]; kk = keep + __shfl_xor(send, 8); }
    kk += __shfl_xor(kk, 4); kk += __shfl_xor(kk, 2); kk += __shfl_xor(kk, 1);
    return kk;
}
__device__ __forceinline__ void axpy8(float (&o)[16], const uint4 (&R)[8], int wsr, int bb) {
#pragma unroll
    for (int j = 0; j < 8; ++j) {
        const float c = __int_as_float(__builtin_amdgcn_readlane(wsr, 8 * j + bb));
        const unsigned q[4] = {R[j].x, R[j].y, R[j].z, R[j].w};
#pragma unroll
        for (int i = 0; i < 4; ++i) {
            const f32x2v a = __builtin_amdgcn_cvt_pk_f32_fp8((int)q[i], false), b = __builtin_amdgcn_cvt_pk_f32_fp8((int)q[i], true);
            o[4 * i] += c * a.x; o[4 * i + 1] += c * a.y; o[4 * i + 2] += c * b.x; o[4 * i + 3] += c * b.y;
        }
    }
}
__device__ void gather_token(const Params& p, int tok, int lane) {
    const bf16_t* h2 = (const bf16_t*)(p.ws + OFF_MERGED) + (size_t)tok * 1024 + lane * 16;
    const unsigned char* Uq = p.ws + OFF_UB; const unsigned char* Vq = p.ws + OFF_VB;
    const float* SU = (const float*)(p.ws + OFF_SU); const float* SV = (const float*)(p.ws + OFF_SV);
    const int* ei = (const int*)(p.ws + OFF_EIDX) + (size_t)tok * 128;
    const float* eg = (const float*)(p.ws + OFF_EGATE) + (size_t)tok * 128;
    float h[16];
    {
        const uint4 ha = *(const uint4*)h2, hb = *(const uint4*)(h2 + 8);
        const unsigned hq[8] = {ha.x, ha.y, ha.z, ha.w, hb.x, hb.y, hb.z, hb.w};
#pragma unroll
        for (int e = 0; e < 8; ++e) { h[2 * e] = bflo(hq[e]); h[2 * e + 1] = bfhi(hq[e]); }
    }
    const int pe = 8 * (lane & 7) + (lane >> 3);
    int es[2], wsr[2] = {0, 0}; float su[2], gv[2];
#pragma unroll
    for (int k = 0; k < 2; ++k) {
        es[k] = ei[64 * k + lane];
        const int e = ei[64 * k + pe];
        su[k] = SU[e]; gv[k] = eg[64 * k + pe] * SV[e];
    }
    uint4 R0[8], R1[8];
#pragma unroll
    for (int k = 0; k < 2; ++k) {
        load8rows(R0, Uq, es[k], 0, lane);
        for (int bb = 0; bb < 8; bb += 2) {
            load8rows(R1, Uq, es[k], 8 * bb + 8, lane);
            { const float w = gelu_tanh(dots8(R0, h, lane) * su[k]) * gv[k]; if ((lane & 7) == bb) wsr[k] = __float_as_int(w); }
            if (bb + 2 < 8) load8rows(R0, Uq, es[k], 8 * bb + 16, lane);
            { const float w = gelu_tanh(dots8(R1, h, lane) * su[k]) * gv[k]; if ((lane & 7) == bb + 1) wsr[k] = __float_as_int(w); }
        }
    }
    float o[16];
#pragma unroll
    for (int e = 0; e < 16; ++e) o[e] = 0.f;
#pragma unroll
    for (int k = 0; k < 2; ++k) {
        load8rows(R0, Vq, es[k], 0, lane);
        for (int bb = 0; bb < 8; bb += 2) {
            load8rows(R1, Vq, es[k], 8 * bb + 8, lane);
            axpy8(o, R0, wsr[k], bb);
            if (bb + 2 < 8) load8rows(R0, Vq, es[k], 8 * bb + 16, lane);
            axpy8(o, R1, wsr[k], bb + 1);
        }
    }
    float* xr = p.out + (size_t)tok * 1024 + lane * 16;
    float4 x[4]; float ss = 0.f;
#pragma unroll
    for (int i = 0; i < 4; ++i) {
        x[i] = *(const float4*)(xr + 4 * i);
        x[i].x += o[4 * i]; x[i].y += o[4 * i + 1]; x[i].z += o[4 * i + 2]; x[i].w += o[4 * i + 3];
        ss += x[i].x * x[i].x + x[i].y * x[i].y + x[i].z * x[i].z + x[i].w * x[i].w;
    }
    ss = wave_sum(ss);
    const float rs = rsqrtf(ss * (1.0f / 1024.0f) + EPS);
    const float* gf = p.g_final + lane * 16;
#pragma unroll
    for (int i = 0; i < 4; ++i) {
        const float4 gg = *(const float4*)(gf + 4 * i);
        *(float4*)(xr + 4 * i) = make_float4(x[i].x * rs * gg.x, x[i].y * rs * gg.y, x[i].z * rs * gg.z, x[i].w * rs * gg.w);
    }
}


__device__ __forceinline__ bool gemm_unit(int it, int nct, int& rt, int& ct) {
    const int x = blockIdx.x & 7, j = blockIdx.x >> 3, nbx = gridDim.x >> 3;
    const int v = j + it * nbx, per_rg = 8 * nct;
    if (v >= 32 * nct) return false;
    const int rgi = v / per_rg, w = v - rgi * per_rg, cg = w >> 6, w2 = w & 63;
    const int rtl = w2 & 7, ctl = w2 >> 3;
    rt = (rgi * 8 + rtl) * 8 + x; ct = cg * 8 + ctl;
    return true;
}

#define XB_TMO      128
#define XB_XCNT(j)  (256  + 64 * (j))
#define XB_XSUB(j)  (1280 + 64 * (j))
#define XB_XGEN(j)  (2304 + 64 * (j))
#define XB_TOP      3328
#define XB_TOPGEN   3392
#define XCD_BAR_WORDS 3456
#define XB_SPIN_CAP (1u << 22)
#define LAS __attribute__((address_space(3)))
__device__ __forceinline__ unsigned xb_ld(unsigned* p)              { return __hip_atomic_load(p, __ATOMIC_RELAXED, __HIP_MEMORY_SCOPE_AGENT); }
__device__ __forceinline__ unsigned xb_add(unsigned* p, unsigned v) { return __hip_atomic_fetch_add(p, v, __ATOMIC_RELAXED, __HIP_MEMORY_SCOPE_AGENT); }
__device__ __forceinline__ unsigned xb_xcc_id() { return (unsigned)__builtin_amdgcn_s_getreg((3 << 11) | 20) & 0xFu; }
#define XB_SPIN(cond, bar) do { unsigned _sp = 0; while (cond) { __builtin_amdgcn_s_sleep(1); \
    if ((++_sp & 255u) == 0u) { if (xb_ld(&(bar)[XB_TMO])) break; if (_sp > XB_SPIN_CAP) { atomicAdd(&(bar)[XB_TMO], 1u); break; } } } } while (0)
struct XcdBarrier { unsigned* bar; unsigned x; volatile LAS unsigned* st; };
__device__ __forceinline__ XcdBarrier xcd_barrier_post(unsigned* bar, volatile LAS unsigned* st) {
    XcdBarrier b; b.bar = bar; b.x = xb_xcc_id(); b.st = st;
    if (threadIdx.x == 0) (void)xb_add(&bar[XB_XCNT(b.x)], 1u);
    return b;
}
__device__ __forceinline__ void xcd_barrier_complete(unsigned* bar, unsigned x, unsigned& nloc, unsigned& nx) {
    const unsigned G = gridDim.x;
    unsigned sum, cnt, mine, sp = 0u;
    for (;;) {
        sum = 0u; cnt = 0u; mine = 0u;
#pragma unroll
        for (unsigned j = 0; j < 16; ++j) { const unsigned c = xb_ld(&bar[XB_XCNT(j)]); sum += c; cnt += (c > 0u) ? 1u : 0u; mine = (j == x) ? c : mine; }
        if (sum == G) break;
        __builtin_amdgcn_s_sleep(1);
        if ((++sp & 255u) == 0u) { if (xb_ld(&bar[XB_TMO])) break; if (sp > XB_SPIN_CAP) { atomicAdd(&bar[XB_TMO], 1u); break; } }
    }
    nloc = mine > 0u ? mine : 1u; nx = cnt > 0u ? cnt : 1u;
}
__device__ __forceinline__ void xcd_barrier(const XcdBarrier& b) {
    asm volatile("s_waitcnt vmcnt(0)" ::: "memory");
    __syncthreads();
    if (threadIdx.x == 0) {
        unsigned* bar = b.bar;
        __builtin_amdgcn_s_waitcnt(0);
        unsigned nloc = b.st[0], nx = b.st[1];
        if (nloc == 0u) { xcd_barrier_complete(bar, b.x, nloc, nx); b.st[0] = nloc; b.st[1] = nx; }
        const unsigned old = xb_add(&bar[XB_XSUB(b.x)], 1u);
        const unsigned gen = old / nloc;
        if (old + 1u == (gen + 1u) * nloc) {
            __builtin_amdgcn_fence(__ATOMIC_RELEASE, "agent");
            asm volatile("s_waitcnt vmcnt(0)" ::: "memory");
            const unsigned og = xb_add(&bar[XB_TOP], 1u);
            const unsigned tg = og / nx;
            if (og + 1u == (tg + 1u) * nx) xb_add(&bar[XB_TOPGEN], 1u);
            else XB_SPIN(xb_ld(&bar[XB_TOPGEN]) == tg, bar);
            __builtin_amdgcn_fence(__ATOMIC_ACQUIRE, "agent");
            xb_add(&bar[XB_XGEN(b.x)], 1u);
            asm volatile("s_waitcnt vmcnt(0)" ::: "memory");
        } else {
            XB_SPIN(xb_ld(&bar[XB_XGEN(b.x)]) == gen, bar);
            __builtin_amdgcn_fence(__ATOMIC_ACQUIRE, "agent");
            asm volatile("s_waitcnt vmcnt(0)" ::: "memory");
        }
    }
    __syncthreads();
}

#ifndef PROBE_PHASE
#define PROBE_PHASE -1
#endif
#define PH_BEGIN(k) if (PROBE_PHASE == (k)) probe_t0 = __builtin_amdgcn_s_memrealtime();
#define PH_END(k)   if (PROBE_PHASE == (k)) probe_dt = __builtin_amdgcn_s_memrealtime() - probe_t0;
constexpr int SMEM_BYTES = 128 * 132 * 4 + 1024;

__global__ void __launch_bounds__(256, 2) fwd_megakernel(Params p) {
    __shared__ __attribute__((aligned(16))) unsigned char smem[SMEM_BYTES + 16];
    if (threadIdx.x == 0) *(uint4*)(smem + SMEM_BYTES) = make_uint4(0u, 0u, 0u, 0u);
    __syncthreads();
    const XcdBarrier xb = xcd_barrier_post((unsigned*)(p.ws + OFF_BAR), (volatile LAS unsigned*)(smem + SMEM_BYTES));
    const int bid = blockIdx.x, nb = gridDim.x, tid = tidx(), lane = tid & 63, wid = tid >> 6;
    unsigned char* ws = p.ws; unsigned char* dob = (unsigned char*)p.out;
    unsigned long long probe_t0 = 0, probe_dt = 0;
    PH_BEGIN(0)
    {
        for (int u = bid; u < 3232; u += nb) {
            if (u < 1600) convT_tile(p.w_in, (bf16_t*)(ws + OFF_WINT), 1024, INW, u, smem);
            else if (u < 1856) convT_tile(p.w_mem_kv, (bf16_t*)(ws + OFF_WMKVT), 1024, 1024, u - 1600, smem);
            else if (u < 2048) convT_tile(p.p_attn, (bf16_t*)(ws + OFF_PATTNT), 768, 1024, u - 1856, smem);
            else if (u < 2240) convT_tile(p.p_lru, (bf16_t*)(ws + OFF_PLRUT), 768, 1024, u - 2048, smem);
            else if (u < 2368) convT_tile(p.p_mem, (bf16_t*)(ws + OFF_PMEMT), 512, 1024, u - 2240, smem);
            else if (u < 2624) convT_tile(p.w_out, (bf16_t*)(ws + OFF_WOUTT), 1024, 1024, u - 2368, smem);
            else if (u < 3136) convT_tile(p.w_peer_q, (bf16_t*)(ws + OFF_WPQT), 1024, 2048, u - 2624, smem);
            else {
                const int v = u - 3136, mat = v >> 2, tile = v & 3, gsel = mat / 6, h = mat % 6, dir = gsel & 1;
                const float* src = (gsel < 2 ? p.lru_wr : p.lru_wi) + (size_t)(dir * 6 + h) * 128 * 128;
                convT_tile(src, (bf16_t*)(ws + OFF_LRUWT) + (size_t)(h * 512 + gsel * 128) * 128, 128, 128, tile, smem);
            }
        }
        conv_plain(p.peer_sub_keys, (bf16_t*)(ws + OFF_SUBK), (size_t)16 * 128 * 128 / 8);
        for (int r = bid * 4 + wid; r < 2 * NEXP; r += nb * 4) {
            if (r < NEXP) conv_row_fp8(p.peer_u, ws + OFF_UB, (float*)(ws + OFF_SU), r, lane);
            else conv_row_fp8(p.peer_v, ws + OFF_VB, (float*)(ws + OFF_SV), r - NEXP, lane);
        }
        for (int r = bid * 4 + wid; r < NTOK; r += nb * 4) rms_row_bf16(p.x + (size_t)r * 1024, p.g_mix, (bf16_t*)(dob + DO_HBF) + (size_t)r * 1024, lane);
        for (int r = bid * 4 + wid; r < NMEM; r += nb * 4) rms_row_bf16(p.mem + (size_t)r * 1024, p.g_mem, (bf16_t*)(dob + DO_MEMBF) + (size_t)r * 1024, lane);
        for (int i = bid * 256 + tid; i < NTOK * 16; i += nb * 256) rope_item(p.positions, (float*)(dob + DO_ROPE), i);
        for (int i = bid * 256 + tid; i < 2 * LW; i += nb * 256) ((float*)(ws + OFF_SP8))[i] = -8.0f * 1.4426950408889634f * log1pf(__expf(-p.lru_lambda[i]));
    }
    xcd_barrier(xb);
    PH_END(0) PH_BEGIN(1)
    for (int u = bid; u < 256; u += nb) memkv_tile(p, u / 8, u % 8, smem);
    { GemmPipe pp{0, false}; int rt, ct, nrt = 0, nct = 0; bool have = gemm_unit(0, 50, rt, ct); __syncthreads();
      for (int it = 0; have; ++it) { const bool hn = gemm_unit(it + 1, 50, nrt, nct); inproj_tile(p, rt, ct, smem, pp, hn, nrt, nct); rt = nrt; ct = nct; have = hn; } }
    xcd_barrier(xb);
    PH_END(1) PH_BEGIN(2)
    {
        unsigned* ctr = (unsigned*)(p.ws + OFF_BAR) + 3600;
        volatile LAS unsigned* slot = (volatile LAS unsigned*)(smem + SMEM_BYTES + 8);
        for (;;) {
            if (tid == 0) *slot = xb_add(ctr, 1u);
            __syncthreads();
            const int u = (int)*slot;
            __syncthreads();
            if (u >= 1536 + 1536 + 1024) break;
            if (u < 1536) lru_chunk_unit<false>(p, u, smem);
            else if (u < 1536 + 1536) attn_win_unit(p, u - 1536, smem);
            else attn_mem_unit(p, u - 1536 - 1536, smem);
        }
    }
    xcd_barrier(xb);
    for (int u = bid; u < 1536; u += nb) lru_chunk_unit<true>(p, u, smem);
    xcd_barrier(xb);
    PH_END(2) PH_BEGIN(3)
    { GemmPipe pp{0, false}; int rt, ct, nrt = 0, nct = 0; bool have = gemm_unit(0, 8, rt, ct); __syncthreads();
      for (int it = 0; have; ++it) { const bool hn = gemm_unit(it + 1, 8, nrt, nct); merge_tile(p, rt, ct, smem, pp, hn, nrt, nct); rt = nrt; ct = nct; have = hn; } }
    xcd_barrier(xb);
    PH_END(3) PH_BEGIN(4)
    { GemmPipe pp{0, false}; int rt, ct, nrt = 0, nct = 0; bool have = gemm_unit(0, 8, rt, ct); __syncthreads();
      for (int it = 0; have; ++it) { const bool hn = gemm_unit(it + 1, 8, nrt, nct); outproj_tile(p, rt, ct, smem, pp, hn, nrt, nct); rt = nrt; ct = nct; have = hn; } }
    xcd_barrier(xb);
    PH_END(4) PH_BEGIN(5)
    for (int r = bid * 4 + wid; r < NTOK; r += nb * 4) rms_row_bf16(p.out + (size_t)r * 1024, p.g_ffn, (bf16_t*)(ws + OFF_MERGED) + (size_t)r * 1024, lane);
    xcd_barrier(xb);
    PH_END(5) PH_BEGIN(6)
    { GemmPipe pp{0, false}; int rt, ct, nrt = 0, nct = 0; bool have = gemm_unit(0, 16, rt, ct); __syncthreads();
      for (int it = 0; have; ++it) { const bool hn = gemm_unit(it + 1, 16, nrt, nct); peerq_tile(p, rt, ct, smem, pp, hn, nrt, nct); rt = nrt; ct = nct; have = hn; } }
    xcd_barrier(xb);
    PH_END(6) PH_BEGIN(7)
    for (int u = bid; u < 256 * 16; u += nb) scores_tile(p, u / 16, u % 16, smem);
    xcd_barrier(xb);
    PH_END(7) PH_BEGIN(8)
    for (int i = bid * 256 + tid; i < NTOK * 8; i += nb * 256) combine_item(p, i);
    xcd_barrier(xb);
    PH_END(8) PH_BEGIN(9)
    for (int t = bid * 4 + wid; t < NTOK; t += nb * 4) gather_token(p, t, lane);
    PH_END(9)
    if (PROBE_PHASE >= 0) { __syncthreads(); const unsigned long long t1 = __builtin_amdgcn_s_memrealtime(); while (__builtin_amdgcn_s_memrealtime() - t1 < probe_dt) __builtin_amdgcn_s_sleep(8); }
}

extern "C" void kernel_launch(void* const* d_in, const int* in_sizes, int n_in, void* d_out, int out_size, void* d_ws, size_t ws_size, hipStream_t stream) {
    if (ws_size < OFF_END) { fprintf(stderr, "workspace too small: %zu < %zu\n", ws_size, (size_t)OFF_END); return; }
    Params p{};
    p.x = (const float*)d_in[0]; p.mem = (const float*)d_in[1]; p.positions = (const int*)d_in[2];
    p.g_mix = (const float*)d_in[3]; p.g_mem = (const float*)d_in[4]; p.w_in = (const float*)d_in[5]; p.gate_b = (const float*)d_in[6];
    p.attn_sink = (const float*)d_in[7]; p.conv_w = (const float*)d_in[8]; p.conv_b = (const float*)d_in[9];
    p.lru_wr = (const float*)d_in[10]; p.lru_br = (const float*)d_in[11]; p.lru_wi = (const float*)d_in[12]; p.lru_bi = (const float*)d_in[13];
    p.lru_lambda = (const float*)d_in[14]; p.w_mem_kv = (const float*)d_in[15]; p.p_attn = (const float*)d_in[16]; p.p_lru = (const float*)d_in[17];
    p.p_mem = (const float*)d_in[18]; p.w_out = (const float*)d_in[19]; p.g_ffn = (const float*)d_in[20]; p.w_peer_q = (const float*)d_in[21];
    p.peer_sub_keys = (const float*)d_in[22]; p.peer_u = (const float*)d_in[23]; p.peer_v = (const float*)d_in[24]; p.g_final = (const float*)d_in[25];
    p.out = (float*)d_out; p.ws = (unsigned char*)d_ws;
    static int grid_blocks = 0;
    if (!grid_blocks) {
        int dev = 0, cus = 0, per_cu = 0;
        (void)hipGetDevice(&dev);
        (void)hipDeviceGetAttribute(&cus, hipDeviceAttributeMultiprocessorCount, dev);
        (void)hipOccupancyMaxActiveBlocksPerMultiprocessor(&per_cu, fwd_megakernel, 256, 0);
        if (per_cu > 2) per_cu = 2;
        grid_blocks = cus * per_cu;
    }
    (void)hipMemsetAsync((unsigned char*)d_ws + OFF_BAR, 0, 16384, stream);
    void* args[] = {&p};
    hipError_t e = hipLaunchCooperativeKernel((void*)fwd_megakernel, dim3(grid_blocks), dim3(256), args, 0, stream);
    if (e != hipSuccess) fprintf(stderr, "cooperative launch failed: %s (grid %d)\n", hipGetErrorString(e), grid_blocks);
}
```

```cpp
#include <hip/hip_runtime.h>
#include <stdint.h>
#include <stdio.h>

typedef unsigned short bf16_t;
typedef short bf16x8 __attribute__((ext_vector_type(8)));
typedef __bf16 bf16x2v __attribute__((ext_vector_type(2)));
typedef float f32x4 __attribute__((ext_vector_type(4)));

constexpr int B_ = 16, S_ = 2048, D_ = 1024, NTOK = B_ * S_;
constexpr int MEML = 256, NMEM = B_ * MEML;
constexpr int INW = 6400;
constexpr int LW = 768;
constexpr int NEXP = 16384;
constexpr float EPS = 1e-6f;
constexpr float QSCALE = 0.08838834764831845f * 1.4426950408889634f;

constexpr size_t OFF_WINT = 0;
constexpr size_t OFF_WMKVT = OFF_WINT + (size_t)INW * 1024 * 2;
constexpr size_t OFF_PATTNT = OFF_WMKVT + (size_t)1024 * 1024 * 2;
constexpr size_t OFF_PLRUT = OFF_PATTNT + (size_t)1024 * 768 * 2;
constexpr size_t OFF_PMEMT = OFF_PLRUT + (size_t)1024 * 768 * 2;
constexpr size_t OFF_WOUTT = OFF_PMEMT + (size_t)1024 * 512 * 2;
constexpr size_t OFF_WPQT = OFF_WOUTT + (size_t)1024 * 1024 * 2;
constexpr size_t OFF_LRUWT = OFF_WPQT + (size_t)2048 * 1024 * 2;
constexpr size_t OFF_SUBK = OFF_LRUWT + (size_t)6 * 512 * 128 * 2;
constexpr size_t OFF_UB = OFF_SUBK + (size_t)16 * 128 * 128 * 2;
constexpr size_t OFF_VB = OFF_UB + (size_t)NEXP * 1024;
constexpr size_t OFF_SU = OFF_VB + (size_t)NEXP * 1024;
constexpr size_t OFF_SV = OFF_SU + (size_t)NEXP * 4;
constexpr size_t OFF_RA = OFF_SV + (size_t)NEXP * 4;
constexpr size_t OFF_QA = OFF_RA;
constexpr size_t OFF_KA = OFF_QA + (size_t)NTOK * 768 * 2;
constexpr size_t OFF_VAT = OFF_KA + (size_t)NTOK * 256 * 2;
constexpr size_t OFF_XL = OFF_VAT + (size_t)NTOK * 256 * 2;
constexpr size_t OFF_GL = OFF_XL + (size_t)NTOK * 768 * 2;
constexpr size_t OFF_QM = OFF_GL + (size_t)NTOK * 768 * 2;
constexpr size_t OFF_GATES = OFF_QM + (size_t)NTOK * 512 * 2;
constexpr size_t OFF_BAR = OFF_GATES + (size_t)NTOK * 3072 * 2;
constexpr size_t OFF_SP8 = OFF_BAR + 16384;
constexpr size_t OFF_AGG = OFF_SP8 + 2 * 768 * 4;
constexpr size_t OFF_END = OFF_AGG + (size_t)2 * B_ * 16 * 768 * 8;
constexpr size_t OFF_MERGED = OFF_KA;
constexpr size_t OFF_QPEER = OFF_GATES;
constexpr size_t OFF_TOPL = OFF_QPEER + (size_t)NTOK * 2048 * 2;
constexpr size_t OFF_EIDX = OFF_TOPL + (size_t)NTOK * 256 * 4;
constexpr size_t OFF_EGATE = OFF_EIDX + (size_t)NTOK * 128 * 4;
static_assert(OFF_EGATE + (size_t)NTOK * 128 * 4 <= OFF_BAR, "overlay");
static_assert(OFF_MERGED + (size_t)NTOK * 1024 * 2 <= OFF_GL, "overlay2");
constexpr size_t DO_HBF = 0;
constexpr size_t DO_MEMBF = DO_HBF + (size_t)NTOK * 1024 * 2;
constexpr size_t DO_KM = DO_MEMBF + (size_t)NMEM * 1024 * 2;
constexpr size_t DO_VMT = DO_KM + (size_t)NMEM * 512 * 2;
constexpr size_t DO_ROPE = DO_VMT + (size_t)NMEM * 512 * 2;
static_assert(DO_ROPE + (size_t)NTOK * 32 * 4 <= (size_t)NTOK * 1024 * 4, "d_out scratch");

struct Params {
    const float *x, *mem; const int* positions;
    const float *g_mix, *g_mem, *w_in, *gate_b, *attn_sink, *conv_w, *conv_b, *lru_wr, *lru_br, *lru_wi, *lru_bi, *lru_lambda,
        *w_mem_kv, *p_attn, *p_lru, *p_mem, *w_out, *g_ffn, *w_peer_q, *peer_sub_keys, *peer_u, *peer_v, *g_final;
    float* out; unsigned char* ws;
};

__device__ __forceinline__ int tidx() { int t = threadIdx.x; asm volatile("" : "+v"(t)); return t; }
__device__ __forceinline__ float bf2f(bf16_t b) { return __uint_as_float(((unsigned)b) << 16); }
__device__ __forceinline__ float bflo(unsigned u) { return __uint_as_float(u << 16); }
__device__ __forceinline__ float bfhi(unsigned u) { return __uint_as_float(u & 0xffff0000u); }
typedef float f32x2v __attribute__((ext_vector_type(2)));
__device__ __forceinline__ unsigned pack_bf16(float lo, float hi) { const f32x2v f = {lo, hi}; return __builtin_bit_cast(unsigned, __builtin_convertvector(f, bf16x2v)); }
__device__ __forceinline__ bf16_t f2bf(float f) { return (bf16_t)(pack_bf16(f, 0.f) & 0xffffu); }
__device__ __forceinline__ f32x4 mfma16(bf16x8 a, bf16x8 b, f32x4 c) { return __builtin_amdgcn_mfma_f32_16x16x32_bf16(a, b, c, 0, 0, 0); }
__device__ __forceinline__ float sigmoidf_(float x) { return __builtin_amdgcn_rcpf(1.0f + __expf(-x)); }
__device__ __forceinline__ float gelu_tanh(float x) { const float u = 1.5957691216057308f * (x + 0.044715f * x * x * x); return x * __builtin_amdgcn_rcpf(1.0f + __expf(-u)); }
__device__ __forceinline__ float wave_sum(float v) {
#pragma unroll
    for (int o = 32; o >= 1; o >>= 1) v += __shfl_xor(v, o);
    return v;
}


typedef unsigned u32x4 __attribute__((ext_vector_type(4)));
#define PIN4(a, o) asm volatile("" : "+v"((a)[(o)]), "+v"((a)[(o) + 1]), "+v"((a)[(o) + 2]), "+v"((a)[(o) + 3]))
#define PIN8(a, o) asm volatile("" : "+v"((a)[(o)]), "+v"((a)[(o) + 1]), "+v"((a)[(o) + 2]), "+v"((a)[(o) + 3]), "+v"((a)[(o) + 4]), "+v"((a)[(o) + 5]), "+v"((a)[(o) + 6]), "+v"((a)[(o) + 7]))
#define PIN15(a, o) asm volatile("" : "+v"((a)[(o)]), "+v"((a)[(o) + 1]), "+v"((a)[(o) + 2]), "+v"((a)[(o) + 3]), "+v"((a)[(o) + 4]), "+v"((a)[(o) + 5]), "+v"((a)[(o) + 6]), "+v"((a)[(o) + 7]), \
    "+v"((a)[(o) + 8]), "+v"((a)[(o) + 9]), "+v"((a)[(o) + 10]), "+v"((a)[(o) + 11]), "+v"((a)[(o) + 12]), "+v"((a)[(o) + 13]), "+v"((a)[(o) + 14]))

__device__ void convT_tile(const float* __restrict__ src, bf16_t* __restrict__ dst, int K, int N, int tile, unsigned char* smem) {
    float* t = (float*)smem;
    const int tn = N / 64, tk = tile / tn, tnn = tile % tn, k0 = tk * 64, n0 = tnn * 64, tid = tidx();
    const int r = tid >> 4, c4 = (tid & 15) * 4;
#pragma unroll
    for (int i = 0; i < 4; ++i) {
        const int k = r + 16 * i;
        const float4 v = *(const float4*)(src + (size_t)(k0 + k) * N + n0 + c4);
        t[k * 65 + c4 + 0] = v.x; t[k * 65 + c4 + 1] = v.y; t[k * 65 + c4 + 2] = v.z; t[k * 65 + c4 + 3] = v.w;
    }
    __syncthreads();
    const int n = tid >> 2, kq = (tid & 3) * 16;
    unsigned w[8];
#pragma unroll
    for (int i = 0; i < 8; ++i) w[i] = pack_bf16(t[(kq + 2 * i) * 65 + n], t[(kq + 2 * i + 1) * 65 + n]);
    uint4* d = (uint4*)(dst + (size_t)(n0 + n) * K + k0 + kq);
    d[0] = make_uint4(w[0], w[1], w[2], w[3]); d[1] = make_uint4(w[4], w[5], w[6], w[7]);
    __syncthreads();
}


__device__ __forceinline__ void rms_row_bf16(const float* __restrict__ xr, const float* __restrict__ g, bf16_t* __restrict__ o, int lane) {
    float4 v[4]; float ss = 0.f;
#pragma unroll
    for (int i = 0; i < 4; ++i) { v[i] = *(const float4*)(xr + i * 256 + lane * 4); ss += v[i].x * v[i].x + v[i].y * v[i].y + v[i].z * v[i].z + v[i].w * v[i].w; }
    ss = wave_sum(ss);
    const float rs = rsqrtf(ss * (1.0f / 1024.0f) + EPS);
#pragma unroll
    for (int i = 0; i < 4; ++i) {
        const float4 gg = *(const float4*)(g + i * 256 + lane * 4);
        *(uint2*)(o + i * 256 + lane * 4) = make_uint2(pack_bf16(v[i].x * rs * gg.x, v[i].y * rs * gg.y), pack_bf16(v[i].z * rs * gg.z, v[i].w * rs * gg.w));
    }
}


__device__ __forceinline__ void conv_plain(const float* __restrict__ src, bf16_t* __restrict__ dst, size_t n8) {
    for (size_t i = (size_t)blockIdx.x * 256 + tidx(); i < n8; i += (size_t)gridDim.x * 256) {
        const float4 a = ((const float4*)src)[2 * i], b = ((const float4*)src)[2 * i + 1];
        ((uint4*)dst)[i] = make_uint4(pack_bf16(a.x, a.y), pack_bf16(a.z, a.w), pack_bf16(b.x, b.y), pack_bf16(b.z, b.w));
    }
}
__device__ __forceinline__ void rope_item(const int* __restrict__ pos, float* __restrict__ cs, int i) {
    const int t = i >> 4, f = i & 15;
    const float inv = powf(500000.0f, -(float)(2 * f) / 32.0f);
    const float ang = (float)pos[t] * inv;
    float s, c; sincosf(ang, &s, &c);
    cs[2 * i] = c; cs[2 * i + 1] = s;
}

__device__ __forceinline__ int swz(int row) { return (row & 3) | (((row >> 3) & 1) << 2); }

struct GemmOp { const bf16_t* A; const bf16_t* Bt; int lda, ldb; };
struct GemmPipe { int par; bool pre; };

__device__ __forceinline__ void gemm_issue(const GemmOp& op, int kt, int st, unsigned char* smem) {
    const int tid = tidx();
    const int srow = tid >> 3, skc = (tid & 7) ^ swz(tid >> 3);
    const bf16_t* ga = op.A + (size_t)srow * op.lda + skc * 8 + kt * 64;
    const bf16_t* gb = op.Bt + (size_t)srow * op.ldb + skc * 8 + kt * 64;
    unsigned char* sw = smem + tid * 16 + st * 32768;
#pragma unroll
    for (int i = 0; i < 4; ++i) {
        __builtin_amdgcn_global_load_lds((const unsigned*)(ga + (size_t)(32 * i) * op.lda), (unsigned*)(sw + i * 4096), 16, 0, 0);
        __builtin_amdgcn_global_load_lds((const unsigned*)(gb + (size_t)(32 * i) * op.ldb), (unsigned*)(sw + 16384 + i * 4096), 16, 0, 0);
    }
}
__device__ __forceinline__ void gemm_prefetch(const GemmOp& nx, unsigned char* smem, GemmPipe& pp) { gemm_issue(nx, 0, pp.par, smem); pp.pre = true; }

__device__ __forceinline__ void gemm_tile(const GemmOp& op, int K, f32x4 (&acc)[4][4], unsigned char* smem, GemmPipe& pp) {
    const int tid = tidx(), lane = tid & 63, wid = tid >> 6, wr = wid >> 1, wc = wid & 1, li = lane & 15, g = lane >> 4;
    int aoff[4], boff[4], asw[4], bsw[4];
#pragma unroll
    for (int m = 0; m < 4; ++m) { const int row = wr * 64 + m * 16 + li; aoff[m] = row * 128; asw[m] = swz(row); }
#pragma unroll
    for (int n = 0; n < 4; ++n) { const int row = wc * 64 + 32 * (n >> 1) + 8 * (li >> 2) + 4 * (n & 1) + (li & 3); boff[n] = 16384 + row * 128; bsw[n] = swz(row); }
    const int nk = K >> 6;
    if (!pp.pre) gemm_issue(op, 0, pp.par, smem);
    __syncthreads();
    for (int kt = 0; kt < nk; ++kt) {
        const int cur = (pp.par + kt) & 1;
        const unsigned char* sb = smem + cur * 32768;
        if (kt + 1 < nk) gemm_issue(op, kt + 1, cur ^ 1, smem);
#pragma unroll
        for (int ks = 0; ks < 2; ++ks) {
            bf16x8 af[4], bfr[4];
#pragma unroll
            for (int m = 0; m < 4; ++m) af[m] = *(const bf16x8*)(sb + aoff[m] + (((ks * 4 + g) ^ asw[m]) << 4));
#pragma unroll
            for (int n = 0; n < 4; ++n) bfr[n] = *(const bf16x8*)(sb + boff[n] + (((ks * 4 + g) ^ bsw[n]) << 4));
#pragma unroll
            for (int m = 0; m < 4; ++m)
#pragma unroll
                for (int n = 0; n < 4; ++n) acc[m][n] = mfma16(bfr[n], af[m], acc[m][n]);
        }
        if (kt + 1 < nk) __syncthreads();
    }
    pp.par = (pp.par + nk) & 1; pp.pre = false;
}
__device__ __forceinline__ void acc_zero(f32x4 (&acc)[4][4]) {
#pragma unroll
    for (int m = 0; m < 4; ++m)
#pragma unroll
        for (int n = 0; n < 4; ++n) acc[m][n] = (f32x4){0.f, 0.f, 0.f, 0.f};
}
template <class F> __device__ __forceinline__ void epi_foreach(const f32x4 (&acc)[4][4], F&& f) {
    const int lane = tidx() & 63, wid = tidx() >> 6, wr = wid >> 1, wc = wid & 1, li = lane & 15, g = lane >> 4;
#pragma unroll
    for (int m = 0; m < 4; ++m)
#pragma unroll
        for (int pp = 0; pp < 2; ++pp) {
            float v[8];
#pragma unroll
            for (int r = 0; r < 4; ++r) { v[r] = acc[m][2 * pp][r]; v[4 + r] = acc[m][2 * pp + 1][r]; }
            f(wr * 64 + m * 16 + li, wc * 64 + 32 * pp + 8 * g, v, pp, m);
        }
}
__device__ __forceinline__ void store_bf16x8(bf16_t* p, const float (&v)[8]) {
    *(uint4*)p = make_uint4(pack_bf16(v[0], v[1]), pack_bf16(v[2], v[3]), pack_bf16(v[4], v[5]), pack_bf16(v[6], v[7]));
}
__device__ __forceinline__ void store_tile_T(const f32x4 (&acc)[4][4], bf16_t* __restrict__ dstT, int ldt, unsigned char* smem) {
    bf16_t* t = (bf16_t*)smem;
    __syncthreads();
    epi_foreach(acc, [&](int r, int c, const float (&v)[8], int, int) {
#pragma unroll
        for (int e = 0; e < 8; ++e) t[(c + e) * 136 + r] = f2bf(v[e]);
    });
    __syncthreads();
#pragma unroll
    for (int i = 0; i < 8; ++i) {
        const int ch = tidx() + 256 * i, d = ch >> 4, tc = ch & 15;
        *(uint4*)(dstT + (size_t)d * ldt + tc * 8) = *(const uint4*)(smem + d * 272 + tc * 16);
    }
    __syncthreads();
}

__device__ void inproj_tile(const Params& p, int rt, int ct, unsigned char* smem, GemmPipe& pp, bool hn, int nrt, int nct) {
    unsigned char* ws = p.ws; unsigned char* dob = (unsigned char*)p.out;
    const bf16_t* hbf = (const bf16_t*)(dob + DO_HBF);
    const bf16_t* WinT = (const bf16_t*)(ws + OFF_WINT);
    f32x4 acc[4][4]; acc_zero(acc);
    const GemmOp op{hbf + (size_t)rt * 128 * 1024, WinT + (size_t)ct * 128 * 1024, 1024, 1024};
    const GemmOp nx{hbf + (size_t)nrt * 128 * 1024, WinT + (size_t)nct * 128 * 1024, 1024, 1024};
    gemm_tile(op, 1024, acc, smem, pp);
    const int row0 = rt * 128;
    if (ct < 8) {
        const float* cs = (const float*)(dob + DO_ROPE);
        const bool isq = ct < 6;
        bf16_t* dst = isq ? (bf16_t*)(ws + OFF_QA) + ct * 128 : (bf16_t*)(ws + OFF_KA) + (ct - 6) * 128;
        const int ld = isq ? 768 : 256;
        const float sc = isq ? QSCALE : 1.0f;
        const int lane_ = tidx() & 63, g = lane_ >> 4, wid_ = tidx() >> 6;
        f32x4 csv[16];
        if ((wid_ & 1) == 0) {
#pragma unroll
            for (int m = 0; m < 4; ++m) {
                const f32x4* csr = (const f32x4*)(cs + (size_t)(row0 + (wid_ >> 1) * 64 + m * 16 + (lane_ & 15)) * 32 + (g & 1) * 16);
#pragma unroll
                for (int q = 0; q < 4; ++q) csv[m * 4 + q] = csr[q];
            }
            PIN8(csv, 0); PIN8(csv, 8);
        }
        if (hn) gemm_prefetch(nx, smem, pp);
        epi_foreach(acc, [&](int r, int c, float (&v)[8], int pq, int mq) {
            const int tok = row0 + r;
            if (pq == 0 && c < 32) {
                const f32x4 c0 = csv[mq * 4], c1 = csv[mq * 4 + 1], c2 = csv[mq * 4 + 2], c3 = csv[mq * 4 + 3];
                const float ccv[8] = {c0[0], c0[2], c1[0], c1[2], c2[0], c2[2], c3[0], c3[2]};
                const float ssv[8] = {c0[1], c0[3], c1[1], c1[3], c2[1], c2[3], c3[1], c3[3]};
#pragma unroll
                for (int e = 0; e < 8; ++e) {
                    const float o = __shfl_xor(v[e], 32);
                    v[e] = (g < 2) ? (v[e] * ccv[e] - o * ssv[e]) : (v[e] * ccv[e] + o * ssv[e]);
                }
            }
#pragma unroll
            for (int e = 0; e < 8; ++e) v[e] *= sc;
            store_bf16x8(dst + (size_t)tok * ld + c, v);
        });
    } else if (ct < 10) {
        const int kvh = ct - 8, b = row0 / S_, s0 = row0 % S_;
        store_tile_T(acc, (bf16_t*)(ws + OFF_VAT) + (size_t)(b * 2 + kvh) * 128 * S_ + s0, S_, smem);
    } else if (ct < 16) {
        if (hn) gemm_prefetch(nx, smem, pp);
        bf16_t* dst = (bf16_t*)(ws + OFF_XL) + (ct - 10) * 128;
        epi_foreach(acc, [&](int r, int c, float (&v)[8], int, int) { store_bf16x8(dst + (size_t)(row0 + r) * 768 + c, v); });
    } else if (ct < 22) {
        if (hn) gemm_prefetch(nx, smem, pp);
        bf16_t* dst = (bf16_t*)(ws + OFF_GL) + (ct - 16) * 128;
        epi_foreach(acc, [&](int r, int c, float (&v)[8], int, int) {
#pragma unroll
            for (int e = 0; e < 8; ++e) v[e] = gelu_tanh(v[e]);
            store_bf16x8(dst + (size_t)(row0 + r) * 768 + c, v); });
    } else if (ct < 26) {
        if (hn) gemm_prefetch(nx, smem, pp);
        bf16_t* dst = (bf16_t*)(ws + OFF_QM) + (ct - 22) * 128;
        epi_foreach(acc, [&](int r, int c, float (&v)[8], int, int) {
#pragma unroll
            for (int e = 0; e < 8; ++e) v[e] *= QSCALE;
            store_bf16x8(dst + (size_t)(row0 + r) * 512 + c, v); });
    } else {
        const int gc0 = (ct - 26) * 128;
        bf16_t* dst = (bf16_t*)(ws + OFF_GATES) + gc0;
        const float* gb = p.gate_b + gc0;
        f32x4 gbv[4];
        {
            const int lane_ = tidx() & 63, c0 = ((tidx() >> 6) & 1) * 64 + 8 * (lane_ >> 4);
#pragma unroll
            for (int q = 0; q < 2; ++q) { gbv[2 * q] = *(const f32x4*)(gb + c0 + 32 * q); gbv[2 * q + 1] = *(const f32x4*)(gb + c0 + 32 * q + 4); }
            PIN4(gbv, 0);
        }
        if (hn) gemm_prefetch(nx, smem, pp);
        epi_foreach(acc, [&](int r, int c, float (&v)[8], int pq, int mq) {
            const f32x4 b0 = gbv[2 * pq], b1 = gbv[2 * pq + 1];
            v[0] = sigmoidf_(v[0] + b0[0]); v[1] = sigmoidf_(v[1] + b0[1]); v[2] = sigmoidf_(v[2] + b0[2]); v[3] = sigmoidf_(v[3] + b0[3]);
            v[4] = sigmoidf_(v[4] + b1[0]); v[5] = sigmoidf_(v[5] + b1[1]); v[6] = sigmoidf_(v[6] + b1[2]); v[7] = sigmoidf_(v[7] + b1[3]);
            store_bf16x8(dst + (size_t)(row0 + r) * 3072 + c, v); });
    }
}

__device__ void memkv_tile(const Params& p, int rt, int ct, unsigned char* smem) {
    unsigned char* dob = (unsigned char*)p.out;
    f32x4 acc[4][4]; acc_zero(acc);
    const GemmOp op{(const bf16_t*)(dob + DO_MEMBF) + (size_t)rt * 128 * 1024, (const bf16_t*)(p.ws + OFF_WMKVT) + (size_t)ct * 128 * 1024, 1024, 1024};
    GemmPipe pp{0, false};
    __syncthreads();
    gemm_tile(op, 1024, acc, smem, pp);
    const int row0 = rt * 128;
    if (ct < 4) {
        bf16_t* dst = (bf16_t*)(dob + DO_KM) + ct * 128;
        epi_foreach(acc, [&](int r, int c, float (&v)[8], int, int) { store_bf16x8(dst + (size_t)(row0 + r) * 512 + c, v); });
    } else {
        const int h = ct - 4, b = row0 / MEML, m0 = row0 % MEML;
        store_tile_T(acc, (bf16_t*)(dob + DO_VMT) + (size_t)(b * 4 + h) * 128 * MEML + m0, MEML, smem);
    }
}


typedef float f32x16 __attribute__((ext_vector_type(16)));
__device__ __forceinline__ f32x16 mfma32(bf16x8 a, bf16x8 b, f32x16 c) { return __builtin_amdgcn_mfma_f32_32x32x16_bf16(a, b, c, 0, 0, 0); }
constexpr int ATT_STAGE = 16384 + 128 * 136;

template <bool WIN>
__device__ void attn_block(const bf16_t* Qg, int ldq, const bf16_t* __restrict__ Kg, int ldk, const bf16_t* __restrict__ Vtg, int ldv,
                           int q0, int kt0, int nt, float sink2, bf16_t* Og, int ldo, unsigned char* smem) {
    const int tid = tidx(), lane = tid & 63, wid = tid >> 6, r = lane & 31, hh = lane >> 5;
    const int qw = q0 + 32 * wid;
    bf16x8 qf[8];
#pragma unroll
    for (int ks = 0; ks < 8; ++ks) qf[ks] = *(const bf16x8*)(Qg + (size_t)(32 * wid + r) * ldq + ks * 16 + hh * 8);
    f32x16 o[4];
#pragma unroll
    for (int db = 0; db < 4; ++db)
#pragma unroll
        for (int e = 0; e < 16; ++e) o[db][e] = 0.f;
    float m = WIN ? sink2 : -1e30f, l = WIN ? 1.0f : 0.0f;
    const int krow = tid >> 4, kch = tid & 15, vrow = tid >> 3, vch = tid & 7;
    const int koff = krow * 256 + ((kch ^ (krow & 15)) << 4);
    const int voff = 16384 + vrow * 136 + vch * 16;
    uint4 rk[4], rv[4];
    const bf16_t* kgp = Kg + (size_t)(kt0 * 64 + krow) * ldk + kch * 8;
    const bf16_t* vgp = Vtg + (size_t)vrow * ldv + kt0 * 64 + vch * 8;
#pragma unroll
    for (int i = 0; i < 4; ++i) { rk[i] = *(const uint4*)(kgp + (size_t)(16 * i) * ldk); rv[i] = *(const uint4*)(vgp + (size_t)(32 * i) * ldv); }
#pragma unroll
    for (int i = 0; i < 4; ++i) {
        *(uint4*)(smem + koff + i * 4096) = rk[i];
        *(uint2*)(smem + voff + i * 4352) = make_uint2(rv[i].x, rv[i].y); *(uint2*)(smem + voff + i * 4352 + 8) = make_uint2(rv[i].z, rv[i].w);
    }
    __syncthreads();
    for (int t = 0; t < nt; ++t) {
        const unsigned char* sb = smem + (t & 1) * ATT_STAGE;
        {
            const int tn = t + 1 < nt ? t + 1 : t;
#pragma unroll
            for (int i = 0; i < 4; ++i) { rk[i] = *(const uint4*)(kgp + (size_t)(tn * 64 + 16 * i) * ldk); rv[i] = *(const uint4*)(vgp + (size_t)(32 * i) * ldv + tn * 64); }
        }
        const int k0 = (kt0 + t) * 64;
        if (!WIN || (k0 + 63 >= qw - 128 && k0 <= qw + 159)) {
#pragma unroll
            for (int kb = 0; kb < 2; ++kb) {
                const int kb0 = k0 + 32 * kb;
                if (WIN && !(kb0 + 31 >= qw - 128 && kb0 <= qw + 159)) continue;
                f32x16 s;
#pragma unroll
                for (int e = 0; e < 16; ++e) s[e] = 0.f;
                const int row = kb * 32 + r;
#pragma unroll
                for (int ks = 0; ks < 8; ++ks) {
                    const bf16x8 a = *(const bf16x8*)(sb + row * 256 + (((2 * ks + hh) ^ (row & 15)) << 4));
                    s = mfma32(a, qf[ks], s);
                }
                if (WIN && !(kb0 >= qw - 97 && kb0 + 31 <= qw + 128)) {
#pragma unroll
                    for (int e = 0; e < 16; ++e) {
                        const int d = kb0 + (e & 3) + 8 * (e >> 2) + 4 * hh - (qw + r);
                        s[e] = (d <= 128 && d >= -128) ? s[e] : -1e30f;
                    }
                }
                float mx = s[0];
#pragma unroll
                for (int e = 1; e < 16; ++e) mx = fmaxf(mx, s[e]);
                mx = fmaxf(mx, __shfl_xor(mx, 32));
                const float mnew = fmaxf(m, mx), alpha = __builtin_amdgcn_exp2f(m - mnew);
                m = mnew;
                float ps = 0.f;
#pragma unroll
                for (int e = 0; e < 16; ++e) { s[e] = __builtin_amdgcn_exp2f(s[e] - mnew); ps += s[e]; }
                ps += __shfl_xor(ps, 32);
                l = l * alpha + ps;
                if (__any(alpha != 1.0f)) {
#pragma unroll
                    for (int db = 0; db < 4; ++db)
#pragma unroll
                        for (int e = 0; e < 16; ++e) o[db][e] *= alpha;
                }
#pragma unroll
                for (int s2 = 0; s2 < 2; ++s2) {
                    union { unsigned u[4]; bf16x8 v; } pb;
#pragma unroll
                    for (int e = 0; e < 4; ++e) pb.u[e] = pack_bf16(s[8 * s2 + 2 * e], s[8 * s2 + 2 * e + 1]);
#pragma unroll
                    for (int db = 0; db < 4; ++db) {
                        const unsigned char* vp = sb + 16384 + (db * 32 + r) * 136 + (kb * 32 + 16 * s2 + 4 * hh) * 2;
                        union { uint2 u[2]; bf16x8 v; } va;
                        va.u[0] = *(const uint2*)vp; va.u[1] = *(const uint2*)(vp + 16);
                        o[db] = mfma32(va.v, pb.v, o[db]);
                    }
                }
            }
        }
        {
            unsigned char* sw = smem + ((t + 1) & 1) * ATT_STAGE;
#pragma unroll
            for (int i = 0; i < 4; ++i) {
                *(uint4*)(sw + koff + i * 4096) = rk[i];
                *(uint2*)(sw + voff + i * 4352) = make_uint2(rv[i].x, rv[i].y); *(uint2*)(sw + voff + i * 4352 + 8) = make_uint2(rv[i].z, rv[i].w);
            }
        }
        __syncthreads();
    }
    const float inv = __builtin_amdgcn_rcpf(l);
    bf16_t* orow = Og + (size_t)(32 * wid + r) * ldo + 4 * hh;
#pragma unroll
    for (int db = 0; db < 4; ++db)
#pragma unroll
        for (int gq = 0; gq < 4; ++gq)
            *(uint2*)(orow + db * 32 + 8 * gq) = make_uint2(pack_bf16(o[db][4 * gq] * inv, o[db][4 * gq + 1] * inv), pack_bf16(o[db][4 * gq + 2] * inv, o[db][4 * gq + 3] * inv));
}
__device__ void attn_win_unit(const Params& p, int u, unsigned char* smem) {
    const int gh = u % 3, qb = (u / 3) % 16, kvh = (u / 48) % 2, b = u / 96, head = kvh * 3 + gh;
    const int q0 = qb * 128;
    const int ks = q0 - 128 < 0 ? 0 : q0 - 128, ke = q0 + 256 > S_ ? S_ : q0 + 256;
    bf16_t* Q = (bf16_t*)(p.ws + OFF_QA) + (size_t)(b * S_ + q0) * 768 + head * 128;
    const bf16_t* Kb = (const bf16_t*)(p.ws + OFF_KA) + (size_t)(b * S_) * 256 + kvh * 128;
    const bf16_t* Vt = (const bf16_t*)(p.ws + OFF_VAT) + (size_t)(b * 2 + kvh) * 128 * S_;
    attn_block<true>(Q, 768, Kb, 256, Vt, S_, q0, ks / 64, (ke - ks) / 64, p.attn_sink[head] * 1.4426950408889634f, Q, 768, smem);
}
__device__ void attn_mem_unit(const Params& p, int u, unsigned char* smem) {
    const int qb = u % 16, head = (u / 16) % 4, b = u / 64;
    const int q0 = qb * 128;
    unsigned char* dob = (unsigned char*)p.out;
    bf16_t* Q = (bf16_t*)(p.ws + OFF_QM) + (size_t)(b * S_ + q0) * 512 + head * 128;
    const bf16_t* Kb = (const bf16_t*)(dob + DO_KM) + (size_t)(b * MEML) * 512 + head * 128;
    const bf16_t* Vt = (const bf16_t*)(dob + DO_VMT) + (size_t)(b * 4 + head) * 128 * MEML;
    attn_block<false>(Q, 512, Kb, 512, Vt, MEML, q0, 0, 4, 0.f, Q, 512, smem);
}

typedef _Float16 f16x2v __attribute__((ext_vector_type(2)));
__device__ __forceinline__ unsigned pack_f16(float lo, float hi) { return __builtin_bit_cast(unsigned, __builtin_amdgcn_cvt_pkrtz(lo, hi)); }
template <bool FINAL>
__device__ void lru_chunk_unit(const Params& p, int u, unsigned char* smem) {
    const int tid = tidx(), lane = tid & 63, wid = tid >> 6, li = lane & 15, g = lane >> 4;
    const int c = u & 15, h = (u >> 4) % 6, b = u / 96;
    const int cbase = h * 128, s0 = c * 128;
    unsigned char* xcs = smem; unsigned char* LB = smem + 32768; float2* SA = (float2*)(smem + 49152); unsigned char* WL = smem + 51200; float* CC = (float*)(smem + 67584);
    const bf16_t* Xl = (const bf16_t*)(p.ws + OFF_XL) + (size_t)(b * S_) * 768;
    bf16_t* Gl = (bf16_t*)(p.ws + OFF_GL) + (size_t)(b * S_ + s0) * 768;
    const bf16_t* LruWt = (const bf16_t*)(p.ws + OFF_LRUWT) + (size_t)h * 512 * 128;
    const float* SP8 = (const float*)(p.ws + OFF_SP8);
    float2* AGG = (float2*)(p.ws + OFF_AGG);
    auto stage_w = [&](int hc_, int d_) {
#pragma unroll
        for (int i = 0; i < 4; ++i) {
            const int rr = (tid >> 4) + 16 * i, n = rr >> 4, wrow = ((n >> 1) * 2 + d_) * 128 + hc_ * 32 + 16 * (n & 1) + (rr & 15);
            __builtin_amdgcn_global_load_lds((const unsigned*)(LruWt + (size_t)wrow * 128 + (((tid & 15) ^ (rr & 15)) << 3)), (unsigned*)(WL + tid * 16 + i * 4096), 16, 0, 0);
        }
    };
    __syncthreads();
    if (FINAL) {
        const int d_ = tid >> 7, ch_ = tid & 127;
        const float2* ag = AGG + ((size_t)(d_ * B_ + b) * 16) * 768 + cbase + ch_;
        f32x2v av[16];
#pragma unroll
        for (int j = 0; j < 16; ++j) av[j] = *(const f32x2v*)(ag + (size_t)j * 768);
        PIN8(av, 0); PIN8(av, 8);
        float H = 0.f;
#pragma unroll
        for (int jj = 0; jj < 16; ++jj) {
            const int j = d_ ? 15 - jj : jj;
            const bool on = d_ ? (j > c) : (j < c);
            H = __builtin_amdgcn_exp2f(on ? av[j][0] : 0.f) * H + (on ? av[j][1] : 0.f);
        }
        CC[tid] = H;
    }
    {
        const int cp = tid & 63, tq = tid >> 6, cch = cbase + 2 * cp;
        float cw[4][2];
#pragma unroll
        for (int j = 0; j < 4; ++j) { cw[j][0] = p.conv_w[j * LW + cch]; cw[j][1] = p.conv_w[j * LW + cch + 1]; }
        const float cb0 = p.conv_b[cch], cb1 = p.conv_b[cch + 1];
#pragma unroll
        for (int hf = 0; hf < 2; ++hf) {
            const int tb = 32 * tq + 16 * hf;
            unsigned xw[19];
#pragma unroll
            for (int i = 0; i < 19; ++i) {
                const int s = s0 + tb + i - 2, sc = s < 0 ? 0 : (s > S_ - 1 ? S_ - 1 : s);
                xw[i] = *(const unsigned*)(Xl + (size_t)sc * 768 + cch);
            }
            PIN15(xw, 0); PIN4(xw, 15);
#pragma unroll
            for (int i = 0; i < 19; ++i) { const int s = s0 + tb + i - 2; xw[i] = (s >= 0 && s < S_) ? xw[i] : 0u; }
#pragma unroll
            for (int i = 0; i < 16; ++i) {
                const int t = tb + i;
                const float y0 = cb0 + cw[0][0] * bflo(xw[i]) + cw[1][0] * bflo(xw[i + 1]) + cw[2][0] * bflo(xw[i + 2]) + cw[3][0] * bflo(xw[i + 3]);
                const float y1 = cb1 + cw[0][1] * bfhi(xw[i]) + cw[1][1] * bfhi(xw[i + 1]) + cw[2][1] * bfhi(xw[i + 2]) + cw[3][1] * bfhi(xw[i + 3]);
                *(unsigned*)(xcs + t * 256 + (((cp >> 2) ^ (t & 15)) << 4) + (cp & 3) * 4) = pack_bf16(y0, y1);
            }
        }
    }
    const int sch = tid & 31, seg = tid >> 5;
    float4 cst[2][3];
    auto load_cst = [&](int hc_, int d_) {
#pragma unroll
        for (int n = 0; n < 2; ++n) {
            const int gch = cbase + hc_ * 32 + 16 * n + 4 * g;
            cst[n][0] = *(const float4*)(p.lru_br + d_ * LW + gch); cst[n][1] = *(const float4*)(p.lru_bi + d_ * LW + gch); cst[n][2] = *(const float4*)(SP8 + d_ * LW + gch);
        }
    };
    stage_w(0, 0);
    __syncthreads();
#pragma unroll 1
    for (int hc = 0; hc < 4; ++hc) {
        float hfv[16];
#pragma unroll
        for (int d = 0; d < 2; ++d) {
            load_cst(hc, d);
            f32x4 acc[2][4];
#pragma unroll
            for (int m = 0; m < 2; ++m)
#pragma unroll
                for (int n = 0; n < 4; ++n) acc[m][n] = (f32x4){0.f, 0.f, 0.f, 0.f};
#pragma unroll
            for (int ks = 0; ks < 4; ++ks) {
                bf16x8 xf[2];
#pragma unroll
                for (int m = 0; m < 2; ++m) { const int row = 32 * wid + 16 * m + li; xf[m] = *(const bf16x8*)(xcs + row * 256 + (((ks * 4 + g) ^ (row & 15)) << 4)); }
#pragma unroll
                for (int n = 0; n < 4; ++n) {
                    const int rr = 16 * n + li;
                    const bf16x8 wf = *(const bf16x8*)(WL + rr * 256 + (((ks * 4 + g) ^ li) << 4));
#pragma unroll
                    for (int m = 0; m < 2; ++m) acc[m][n] = mfma16(wf, xf[m], acc[m][n]);
                }
            }
#pragma unroll
            for (int n = 0; n < 2; ++n) {
                const int ch4 = 16 * n + 4 * g;
                const float4 br4 = cst[n][0], bi4 = cst[n][1], sp4 = cst[n][2];
                const float brv[4] = {br4.x, br4.y, br4.z, br4.w}, biv[4] = {bi4.x, bi4.y, bi4.z, bi4.w}, spv[4] = {sp4.x, sp4.y, sp4.z, sp4.w};
#pragma unroll
                for (int m = 0; m < 2; ++m) {
                    const int tok = 32 * wid + 16 * m + li;
                    const uint2 xq = *(const uint2*)(xcs + tok * 256 + ((((hc * 32 + ch4) >> 3) ^ (tok & 15)) << 4) + (g & 1) * 8);
                    const float xc[4] = {bflo(xq.x), bfhi(xq.x), bflo(xq.y), bfhi(xq.y)};
                    unsigned w[4];
#pragma unroll
                    for (int r = 0; r < 4; ++r) {
                        const float rg = sigmoidf_(acc[m][n][r] + brv[r]), ig = sigmoidf_(acc[m][n + 2][r] + biv[r]);
                        const float la = spv[r] * rg, a = __builtin_amdgcn_exp2f(la);
                        const float bx = __builtin_amdgcn_sqrtf(fmaxf(1.0f - a * a, 0.f)) * (ig * xc[r]);
                        w[r] = pack_f16(la, bx);
                    }
                    *(uint4*)(LB + tok * 128 + (((ch4 >> 2) ^ (tok & 7)) << 4)) = make_uint4(w[0], w[1], w[2], w[3]);
                }
            }
            __syncthreads();
            if (!(hc == 3 && d == 1)) stage_w(d ? hc + 1 : hc, d ^ 1);
            const int gch = cbase + hc * 32 + sch;
            {
                float L = 0.f, H = 0.f;
#pragma unroll
                for (int k = 0; k < 16; ++k) {
                    const int tok = 16 * seg + (d ? 15 - k : k);
                    const unsigned w = *(const unsigned*)(LB + tok * 128 + (((sch >> 2) ^ (tok & 7)) << 4) + (sch & 3) * 4);
                    const f16x2v hv = __builtin_bit_cast(f16x2v, w);
                    const float la = (float)hv.x, bx = (float)hv.y;
                    H = __builtin_amdgcn_exp2f(la) * H + bx; L += la;
                }
                SA[seg * 32 + sch] = make_float2(L, H);
            }
            __syncthreads();
            if (!FINAL) {
                if (seg == 0) {
                    float L = 0.f, H = 0.f;
#pragma unroll
                    for (int s = 0; s < 8; ++s) { const float2 a = SA[(d ? 7 - s : s) * 32 + sch]; H = __builtin_amdgcn_exp2f(a.x) * H + a.y; L += a.x; }
                    AGG[((size_t)(d * B_ + b) * 16 + c) * 768 + gch] = make_float2(L, H);
                }
            } else {
                float H = CC[d * 128 + hc * 32 + sch];
#pragma unroll
                for (int ss = 0; ss < 8; ++ss) {
                    const int s = d ? 7 - ss : ss;
                    const bool on = d ? (s > seg) : (s < seg);
                    const float2 a = SA[s * 32 + sch];
                    H = __builtin_amdgcn_exp2f(on ? a.x : 0.f) * H + (on ? a.y : 0.f);
                }
                bf16_t* gp = Gl + (size_t)(16 * seg) * 768 + gch;
                float gv[16];
                if (d) {
                    unsigned gr[16];
#pragma unroll
                    for (int k = 0; k < 16; ++k) gr[k] = gp[(size_t)k * 768];
                    PIN8(gr, 0); PIN8(gr, 8);
#pragma unroll
                    for (int k = 0; k < 16; ++k) gv[k] = __uint_as_float(gr[k] << 16);
                }
#pragma unroll
                for (int k = 0; k < 16; ++k) {
                    const int kk = d ? 15 - k : k, tok = 16 * seg + kk;
                    const unsigned w = *(const unsigned*)(LB + tok * 128 + (((sch >> 2) ^ (tok & 7)) << 4) + (sch & 3) * 4);
                    const f16x2v hv = __builtin_bit_cast(f16x2v, w);
                    H = __builtin_amdgcn_exp2f((float)hv.x) * H + (float)hv.y;
                    if (d == 0) hfv[kk] = H; else hfv[kk] = (hfv[kk] + H) * gv[kk];
                }
                if (d) {
#pragma unroll
                    for (int k = 0; k < 16; ++k) gp[(size_t)k * 768] = f2bf(hfv[k]);
                }
            }
            __syncthreads();
        }
    }
}

__device__ void merge_tile(const Params& p, int rt, int ct, unsigned char* smem, GemmPipe& pp, bool hn, int nrt, int nct) {
    unsigned char* ws = p.ws;
    const int row0 = rt * 128, col0 = ct * 128;
    uint4 tot[4][2];
    const bf16_t* G = (const bf16_t*)(ws + OFF_GATES);
    const int lane = tidx() & 63, wid = tidx() >> 6, wr = wid >> 1, wc = wid & 1, li = lane & 15, g = lane >> 4;
#pragma unroll 1
    for (int br = 0; br < 3; ++br) {
        const bf16_t* Ab = (const bf16_t*)(ws + (br == 0 ? OFF_QA : (br == 1 ? OFF_GL : OFF_QM)));
        const bf16_t* Bb = (const bf16_t*)(ws + (br == 0 ? OFF_PATTNT : (br == 1 ? OFF_PLRUT : OFF_PMEMT)));
        const int Kb = br == 2 ? 512 : 768;
        const int nbr = br == 2 ? 0 : br + 1, nr0 = br == 2 ? nrt * 128 : row0, nc0 = br == 2 ? nct * 128 : col0, nKb = nbr == 2 ? 512 : 768;
        const bf16_t* nAb = (const bf16_t*)(ws + (nbr == 0 ? OFF_QA : (nbr == 1 ? OFF_GL : OFF_QM)));
        const bf16_t* nBb = (const bf16_t*)(ws + (nbr == 0 ? OFF_PATTNT : (nbr == 1 ? OFF_PLRUT : OFF_PMEMT)));
        const GemmOp op{Ab + (size_t)row0 * Kb, Bb + (size_t)col0 * Kb, Kb, Kb};
        const GemmOp nx{nAb + (size_t)nr0 * nKb, nBb + (size_t)nc0 * nKb, nKb, nKb};
        f32x4 acc[4][4]; acc_zero(acc);
        gemm_tile(op, Kb, acc, smem, pp);
        u32x4 gva[8];
#pragma unroll
        for (int m = 0; m < 4; ++m)
#pragma unroll
            for (int pq = 0; pq < 2; ++pq) {
                const int r = wr * 64 + m * 16 + li, c = wc * 64 + 32 * pq + 8 * g;
                gva[m * 2 + pq] = *(const u32x4*)(G + (size_t)(row0 + r) * 3072 + br * 1024 + col0 + c);
            }
        PIN8(gva, 0);
        if (br < 2 || hn) gemm_prefetch(nx, smem, pp);
#pragma unroll
        for (int m = 0; m < 4; ++m)
#pragma unroll
            for (int pp = 0; pp < 2; ++pp) {
                const uint4 gv = make_uint4(gva[m * 2 + pp][0], gva[m * 2 + pp][1], gva[m * 2 + pp][2], gva[m * 2 + pp][3]);
                float v[8];
                v[0] = bflo(gv.x) * acc[m][2 * pp][0]; v[1] = bfhi(gv.x) * acc[m][2 * pp][1];
                v[2] = bflo(gv.y) * acc[m][2 * pp][2]; v[3] = bfhi(gv.y) * acc[m][2 * pp][3];
                v[4] = bflo(gv.z) * acc[m][2 * pp + 1][0]; v[5] = bfhi(gv.z) * acc[m][2 * pp + 1][1];
                v[6] = bflo(gv.w) * acc[m][2 * pp + 1][2]; v[7] = bfhi(gv.w) * acc[m][2 * pp + 1][3];
                if (br > 0) {
                    const uint4 t = tot[m][pp];
                    v[0] += bflo(t.x); v[1] += bfhi(t.x); v[2] += bflo(t.y); v[3] += bfhi(t.y);
                    v[4] += bflo(t.z); v[5] += bfhi(t.z); v[6] += bflo(t.w); v[7] += bfhi(t.w);
                }
                tot[m][pp] = make_uint4(pack_bf16(v[0], v[1]), pack_bf16(v[2], v[3]), pack_bf16(v[4], v[5]), pack_bf16(v[6], v[7]));
            }
    }
    bf16_t* dst = (bf16_t*)(ws + OFF_MERGED) + col0;
#pragma unroll
    for (int m = 0; m < 4; ++m)
#pragma unroll
        for (int pp = 0; pp < 2; ++pp) {
            const int r = wr * 64 + m * 16 + li, c = wc * 64 + 32 * pp + 8 * g;
            *(uint4*)(dst + (size_t)(row0 + r) * 1024 + c) = tot[m][pp];
        }
}
__device__ void outproj_tile(const Params& p, int rt, int ct, unsigned char* smem, GemmPipe& pp, bool hn, int nrt, int nct) {
    const int row0 = rt * 128, col0 = ct * 128;
    f32x4 acc[4][4]; acc_zero(acc);
    const GemmOp op{(const bf16_t*)(p.ws + OFF_MERGED) + (size_t)row0 * 1024, (const bf16_t*)(p.ws + OFF_WOUTT) + (size_t)col0 * 1024, 1024, 1024};
    const GemmOp nx{(const bf16_t*)(p.ws + OFF_MERGED) + (size_t)nrt * 128 * 1024, (const bf16_t*)(p.ws + OFF_WOUTT) + (size_t)nct * 128 * 1024, 1024, 1024};
    gemm_tile(op, 1024, acc, smem, pp);
    f32x4 xv[16];
    {
        const int lane_ = tidx() & 63, wid_ = tidx() >> 6;
#pragma unroll
        for (int m = 0; m < 4; ++m)
#pragma unroll
            for (int pq = 0; pq < 2; ++pq) {
                const size_t o = (size_t)(row0 + (wid_ >> 1) * 64 + m * 16 + (lane_ & 15)) * 1024 + col0 + (wid_ & 1) * 64 + 32 * pq + 8 * (lane_ >> 4);
                xv[(m * 2 + pq) * 2] = *(const f32x4*)(p.x + o); xv[(m * 2 + pq) * 2 + 1] = *(const f32x4*)(p.x + o + 4);
            }
        PIN8(xv, 0); PIN8(xv, 8);
    }
    if (hn) gemm_prefetch(nx, smem, pp);
    epi_foreach(acc, [&](int r, int c, float (&v)[8], int pq, int mq) {
        const size_t o = (size_t)(row0 + r) * 1024 + col0 + c;
        const f32x4 x0 = xv[(mq * 2 + pq) * 2], x1 = xv[(mq * 2 + pq) * 2 + 1];
        *(float4*)(p.out + o) = make_float4(x0[0] + v[0], x0[1] + v[1], x0[2] + v[2], x0[3] + v[3]);
        *(float4*)(p.out + o + 4) = make_float4(x1[0] + v[4], x1[1] + v[5], x1[2] + v[6], x1[3] + v[7]);
    });
}

__device__ void peerq_tile(const Params& p, int rt, int ct, unsigned char* smem, GemmPipe& pp, bool hn, int nrt, int nct) {
    const int row0 = rt * 128, col0 = ct * 128;
    f32x4 acc[4][4]; acc_zero(acc);
    const GemmOp op{(const bf16_t*)(p.ws + OFF_MERGED) + (size_t)row0 * 1024, (const bf16_t*)(p.ws + OFF_WPQT) + (size_t)col0 * 1024, 1024, 1024};
    const GemmOp nx{(const bf16_t*)(p.ws + OFF_MERGED) + (size_t)nrt * 128 * 1024, (const bf16_t*)(p.ws + OFF_WPQT) + (size_t)nct * 128 * 1024, 1024, 1024};
    gemm_tile(op, 1024, acc, smem, pp);
    if (hn) gemm_prefetch(nx, smem, pp);
    bf16_t* dst = (bf16_t*)(p.ws + OFF_QPEER) + col0;
    epi_foreach(acc, [&](int r, int c, float (&v)[8], int, int) { store_bf16x8(dst + (size_t)(row0 + r) * 2048 + c, v); });
}

__device__ __forceinline__ int sortable(float v) { int k = __float_as_int(v); return k ^ ((k >> 31) & 0x7fffffff); }
__device__ __forceinline__ float unsortable(int k) { return __int_as_float(k ^ ((k >> 31) & 0x7fffffff)); }
__device__ __forceinline__ void insert16(int (&lst)[16], int x) {
#pragma unroll
    for (int k = 0; k < 16; ++k) { const int hi = max(lst[k], x); x = min(lst[k], x); lst[k] = hi; }
}
__device__ void scores_tile(const Params& p, int rt, int pq, unsigned char* smem) {
    const int row0 = rt * 128;
    f32x4 acc[4][4]; acc_zero(acc);
    const GemmOp op{(const bf16_t*)(p.ws + OFF_QPEER) + (size_t)row0 * 2048 + pq * 128, (const bf16_t*)(p.ws + OFF_SUBK) + (size_t)pq * 128 * 128, 2048, 128};
    GemmPipe pp{0, false};
    gemm_tile(op, 128, acc, smem, pp);
    float* sc = (float*)smem;
    __syncthreads();
    epi_foreach(acc, [&](int r, int c, float (&v)[8], int, int) {
        *(float4*)(sc + r * 132 + c) = make_float4(v[0], v[1], v[2], v[3]);
        *(float4*)(sc + r * 132 + c + 4) = make_float4(v[4], v[5], v[6], v[7]); });
    __syncthreads();
    {
        const int t = tidx(), r = t & 127, hf = t >> 7;
        int lst[16];
#pragma unroll
        for (int k = 0; k < 16; ++k) lst[k] = (int)0x80000000;
#pragma unroll 2
        for (int j4 = 0; j4 < 16; ++j4) {
            const int j = hf * 64 + j4 * 4;
            const float4 v = *(const float4*)(sc + r * 132 + j);
            insert16(lst, (sortable(v.x) & ~127) | (j + 0));
            insert16(lst, (sortable(v.y) & ~127) | (j + 1));
            insert16(lst, (sortable(v.z) & ~127) | (j + 2));
            insert16(lst, (sortable(v.w) & ~127) | (j + 3));
        }
        __syncthreads();
        int* ls = (int*)smem;
        if (hf) {
#pragma unroll
            for (int k = 0; k < 16; ++k) ls[t * 16 + k] = lst[15 - k];
        }
        __syncthreads();
        if (!hf) {
#pragma unroll
            for (int k = 0; k < 16; ++k) lst[k] = max(lst[k], ls[(t + 128) * 16 + k]);
#pragma unroll
            for (int s = 8; s >= 1; s >>= 1)
#pragma unroll
                for (int k = 0; k < 16; ++k)
                    if ((k & s) == 0) { const int hi = max(lst[k], lst[k + s]), lo = min(lst[k], lst[k + s]); lst[k] = hi; lst[k + s] = lo; }
            int4* dst = (int4*)((int*)(p.ws + OFF_TOPL) + ((size_t)(row0 + r) * 16 + pq) * 16);
            dst[0] = make_int4(lst[0], lst[1], lst[2], lst[3]); dst[1] = make_int4(lst[4], lst[5], lst[6], lst[7]);
            dst[2] = make_int4(lst[8], lst[9], lst[10], lst[11]); dst[3] = make_int4(lst[12], lst[13], lst[14], lst[15]);
        }
    }
    __syncthreads();
}

__device__ void combine_item(const Params& p, int item) {
    const int tok = item >> 3, hd = item & 7;
    const int* l0 = (const int*)(p.ws + OFF_TOPL) + ((size_t)tok * 16 + hd * 2) * 16;
    const int* l1 = l0 + 16;
    int k0[16], k1[16];
#pragma unroll
    for (int i = 0; i < 4; ++i) {
        const int4 a = ((const int4*)l0)[i], b = ((const int4*)l1)[i];
        k0[4 * i] = a.x; k0[4 * i + 1] = a.y; k0[4 * i + 2] = a.z; k0[4 * i + 3] = a.w;
        k1[4 * i] = b.x; k1[4 * i + 1] = b.y; k1[4 * i + 2] = b.z; k1[4 * i + 3] = b.w;
    }
    float v0[16], v1[16];
#pragma unroll
    for (int i = 0; i < 16; ++i) { v0[i] = unsortable(k0[i] & ~127); v1[i] = unsortable(k1[i] & ~127); }
    int lst[16];
#pragma unroll
    for (int k = 0; k < 16; ++k) lst[k] = (int)0x80000000;
#pragma unroll
    for (int a = 0; a < 16; ++a)
#pragma unroll
        for (int b = 0; b < 16; ++b)
            if ((a + 1) * (b + 1) <= 16) insert16(lst, (sortable(v0[a] + v1[b]) & ~255) | (a * 16 + b));
    float val[16], sum = 0.f;
    const float mx = unsortable(lst[0] & ~255);
#pragma unroll
    for (int k = 0; k < 16; ++k) { val[k] = __expf(unsortable(lst[k] & ~255) - mx); sum += val[k]; }
    const float inv = 1.0f / sum;
    int* ei = (int*)(p.ws + OFF_EIDX) + (size_t)tok * 128 + hd * 16;
    float* eg = (float*)(p.ws + OFF_EGATE) + (size_t)tok * 128 + hd * 16;
#pragma unroll
    for (int k = 0; k < 16; ++k) {
        const int code = lst[k] & 255, a = code >> 4, b = code & 15;
        ei[k] = (l0[a] & 127) * 128 + (l1[b] & 127);
        eg[k] = val[k] * inv;
    }
}

__device__ __forceinline__ void conv_row_fp8(const float* __restrict__ src, unsigned char* __restrict__ dst, float* __restrict__ scale, int row, int lane) {
    const float4* s = (const float4*)(src + (size_t)row * 1024 + lane * 16);
    float4 v[4]; float am = 0.f;
#pragma unroll
    for (int i = 0; i < 4; ++i) { v[i] = s[i]; am = fmaxf(am, fmaxf(fmaxf(fabsf(v[i].x), fabsf(v[i].y)), fmaxf(fabsf(v[i].z), fabsf(v[i].w)))); }
#pragma unroll
    for (int o = 32; o >= 1; o >>= 1) am = fmaxf(am, __shfl_xor(am, o));
    const float sc = am > 0.f ? am * (1.0f / 224.0f) : 1.0f, inv = 1.0f / sc;
    unsigned w[4];
#pragma unroll
    for (int i = 0; i < 4; ++i) {
        int t = __builtin_amdgcn_cvt_pk_fp8_f32(v[i].x * inv, v[i].y * inv, 0, false);
        t = __builtin_amdgcn_cvt_pk_fp8_f32(v[i].z * inv, v[i].w * inv, t, true);
        w[i] = (unsigned)t;
    }
    *(uint4*)(dst + (size_t)row * 1024 + lane * 16) = make_uint4(w[0], w[1], w[2], w[3]);
    if (lane == 0) scale[row] = sc;
}
__device__ __forceinline__ void load8rows(uint4 (&R)[8], const unsigned char* __restrict__ tab, int es, int l0, int lane) {
#pragma unroll
    for (int j = 0; j < 8; ++j) {
        const int id = __builtin_amdgcn_readlane(es, l0 + j);
        R[j] = *(const uint4*)(tab + (size_t)id * 1024 + lane * 16);
    }
}
__device__ __forceinline__ float dot16q(const uint4& r, const float (&h)[16]) {
    const unsigned q[4] = {r.x, r.y, r.z, r.w};
    float d0 = 0.f, d1 = 0.f;
#pragma unroll
    for (int i = 0; i < 4; ++i) {
        const f32x2v a = __builtin_amdgcn_cvt_pk_f32_fp8((int)q[i], false), b = __builtin_amdgcn_cvt_pk_f32_fp8((int)q[i], true);
        d0 += a.x * h[4 * i]; d1 += a.y * h[4 * i + 1]; d0 += b.x * h[4 * i + 2]; d1 += b.y * h[4 * i + 3];
    }
    return d0 + d1;
}
__device__ __forceinline__ float dots8(const uint4 (&R)[8], const float (&h)[16], int lane) {
    float pd[8];
#pragma unroll
    for (int j = 0; j < 8; ++j) pd[j] = dot16q(R[j], h);
    const bool b5 = (lane & 32) != 0, b4 = (lane & 16) != 0, b3 = (lane & 8) != 0;
    float a[4];
#pragma unroll
    for (int j = 0; j < 4; ++j) { const float keep = b5 ? pd[4 + j] : pd[j], send = b5 ? pd[j] : pd[4 + j]; a[j] = keep + __shfl_xor(send, 32); }
    float c[2];
#pragma unroll
    for (int j = 0; j < 2; ++j) { const float keep = b4 ? a[2 + j] : a[j], send = b4 ? a[j] : a[2 + j]; c[j] = keep + __shfl_xor(send, 16); }
    float kk;
    { const float keep = b3 ? c[1] : c[0], send = b3 ? c[0] : c[1]; kk = keep + __shfl_xor(send, 8); }
    kk += __shfl_xor(kk, 4); kk += __shfl_xor(kk, 2); kk += __shfl_xor(kk, 1);
    return kk;
}
__device__ __forceinline__ void axpy8(float (&o)[16], const uint4 (&R)[8], int wsr, int bb) {
#pragma unroll
    for (int j = 0; j < 8; ++j) {
        const float c = __int_as_float(__builtin_amdgcn_readlane(wsr, 8 * j + bb));
        const unsigned q[4] = {R[j].x, R[j].y, R[j].z, R[j].w};
#pragma unroll
        for (int i = 0; i < 4; ++i) {
            const f32x2v a = __builtin_amdgcn_cvt_pk_f32_fp8((int)q[i], false), b = __builtin_amdgcn_cvt_pk_f32_fp8((int)q[i], true);
            o[4 * i] += c * a.x; o[4 * i + 1] += c * a.y; o[4 * i + 2] += c * b.x; o[4 * i + 3] += c * b.y;
        }
    }
}
__device__ void gather_token(const Params& p, int tok, int lane) {
    const bf16_t* h2 = (const bf16_t*)(p.ws + OFF_MERGED) + (size_t)tok * 1024 + lane * 16;
    const unsigned char* Uq = p.ws + OFF_UB; const unsigned char* Vq = p.ws + OFF_VB;
    const float* SU = (const float*)(p.ws + OFF_SU); const float* SV = (const float*)(p.ws + OFF_SV);
    const int* ei = (const int*)(p.ws + OFF_EIDX) + (size_t)tok * 128;
    const float* eg = (const float*)(p.ws + OFF_EGATE) + (size_t)tok * 128;
    float h[16];
    {
        const uint4 ha = *(const uint4*)h2, hb = *(const uint4*)(h2 + 8);
        const unsigned hq[8] = {ha.x, ha.y, ha.z, ha.w, hb.x, hb.y, hb.z, hb.w};
#pragma unroll
        for (int e = 0; e < 8; ++e) { h[2 * e] = bflo(hq[e]); h[2 * e + 1] = bfhi(hq[e]); }
    }
    const int pe = 8 * (lane & 7) + (lane >> 3);
    int es[2], wsr[2] = {0, 0}; float su[2], gv[2];
#pragma unroll
    for (int k = 0; k < 2; ++k) {
        es[k] = ei[64 * k + lane];
        const int e = ei[64 * k + pe];
        su[k] = SU[e]; gv[k] = eg[64 * k + pe] * SV[e];
    }
    uint4 R0[8], R1[8];
#pragma unroll
    for (int k = 0; k < 2; ++k) {
        load8rows(R0, Uq, es[k], 0, lane);
        for (int bb = 0; bb < 8; bb += 2) {
            load8rows(R1, Uq, es[k], 8 * bb + 8, lane);
            { const float w = gelu_tanh(dots8(R0, h, lane) * su[k]) * gv[k]; if ((lane & 7) == bb) wsr[k] = __float_as_int(w); }
            if (bb + 2 < 8) load8rows(R0, Uq, es[k], 8 * bb + 16, lane);
            { const float w = gelu_tanh(dots8(R1, h, lane) * su[k]) * gv[k]; if ((lane & 7) == bb + 1) wsr[k] = __float_as_int(w); }
        }
    }
    float o[16];
#pragma unroll
    for (int e = 0; e < 16; ++e) o[e] = 0.f;
#pragma unroll
    for (int k = 0; k < 2; ++k) {
        load8rows(R0, Vq, es[k], 0, lane);
        for (int bb = 0; bb < 8; bb += 2) {
            load8rows(R1, Vq, es[k], 8 * bb + 8, lane);
            axpy8(o, R0, wsr[k], bb);
            if (bb + 2 < 8) load8rows(R0, Vq, es[k], 8 * bb + 16, lane);
            axpy8(o, R1, wsr[k], bb + 1);
        }
    }
    float* xr = p.out + (size_t)tok * 1024 + lane * 16;
    float4 x[4]; float ss = 0.f;
#pragma unroll
    for (int i = 0; i < 4; ++i) {
        x[i] = *(const float4*)(xr + 4 * i);
        x[i].x += o[4 * i]; x[i].y += o[4 * i + 1]; x[i].z += o[4 * i + 2]; x[i].w += o[4 * i + 3];
        ss += x[i].x * x[i].x + x[i].y * x[i].y + x[i].z * x[i].z + x[i].w * x[i].w;
    }
    ss = wave_sum(ss);
    const float rs = rsqrtf(ss * (1.0f / 1024.0f) + EPS);
    const float* gf = p.g_final + lane * 16;
#pragma unroll
    for (int i = 0; i < 4; ++i) {
        const float4 gg = *(const float4*)(gf + 4 * i);
        *(float4*)(xr + 4 * i) = make_float4(x[i].x * rs * gg.x, x[i].y * rs * gg.y, x[i].z * rs * gg.z, x[i].w * rs * gg.w);
    }
}


__device__ __forceinline__ bool gemm_unit(int it, int nct, int& rt, int& ct) {
    const int x = blockIdx.x & 7, j = blockIdx.x >> 3, nbx = gridDim.x >> 3;
    const int v = j + it * nbx, per_rg = 8 * nct;
    if (v >= 32 * nct) return false;
    const int rgi = v / per_rg, w = v - rgi * per_rg, cg = w >> 6, w2 = w & 63;
    const int rtl = w2 & 7, ctl = w2 >> 3;
    rt = (rgi * 8 + rtl) * 8 + x; ct = cg * 8 + ctl;
    return true;
}

#define XB_TMO      128
#define XB_XCNT(j)  (256  + 64 * (j))
#define XB_XSUB(j)  (1280 + 64 * (j))
#define XB_XGEN(j)  (2304 + 64 * (j))
#define XB_TOP      3328
#define XB_TOPGEN   3392
#define XCD_BAR_WORDS 3456
#define XB_SPIN_CAP (1u << 22)
#define LAS __attribute__((address_space(3)))
__device__ __forceinline__ unsigned xb_ld(unsigned* p)              { return __hip_atomic_load(p, __ATOMIC_RELAXED, __HIP_MEMORY_SCOPE_AGENT); }
__device__ __forceinline__ unsigned xb_add(unsigned* p, unsigned v) { return __hip_atomic_fetch_add(p, v, __ATOMIC_RELAXED, __HIP_MEMORY_SCOPE_AGENT); }
__device__ __forceinline__ unsigned xb_xcc_id() { return (unsigned)__builtin_amdgcn_s_getreg((3 << 11) | 20) & 0xFu; }
#define XB_SPIN(cond, bar) do { unsigned _sp = 0; while (cond) { __builtin_amdgcn_s_sleep(1); \
    if ((++_sp & 255u) == 0u) { if (xb_ld(&(bar)[XB_TMO])) break; if (_sp > XB_SPIN_CAP) { atomicAdd(&(bar)[XB_TMO], 1u); break; } } } } while (0)
struct XcdBarrier { unsigned* bar; unsigned x; volatile LAS unsigned* st; };
__device__ __forceinline__ XcdBarrier xcd_barrier_post(unsigned* bar, volatile LAS unsigned* st) {
    XcdBarrier b; b.bar = bar; b.x = xb_xcc_id(); b.st = st;
    if (threadIdx.x == 0) (void)xb_add(&bar[XB_XCNT(b.x)], 1u);
    return b;
}
__device__ __forceinline__ void xcd_barrier_complete(unsigned* bar, unsigned x, unsigned& nloc, unsigned& nx) {
    const unsigned G = gridDim.x;
    unsigned sum, cnt, mine, sp = 0u;
    for (;;) {
        sum = 0u; cnt = 0u; mine = 0u;
#pragma unroll
        for (unsigned j = 0; j < 16; ++j) { const unsigned c = xb_ld(&bar[XB_XCNT(j)]); sum += c; cnt += (c > 0u) ? 1u : 0u; mine = (j == x) ? c : mine; }
        if (sum == G) break;
        __builtin_amdgcn_s_sleep(1);
        if ((++sp & 255u) == 0u) { if (xb_ld(&bar[XB_TMO])) break; if (sp > XB_SPIN_CAP) { atomicAdd(&bar[XB_TMO], 1u); break; } }
    }
    nloc = mine > 0u ? mine : 1u; nx = cnt > 0u ? cnt : 1u;
}
__device__ __forceinline__ void xcd_barrier(const XcdBarrier& b) {
    asm volatile("s_waitcnt vmcnt(0)" ::: "memory");
    __syncthreads();
    if (threadIdx.x == 0) {
        unsigned* bar = b.bar;
        __builtin_amdgcn_s_waitcnt(0);
        unsigned nloc = b.st[0], nx = b.st[1];
        if (nloc == 0u) { xcd_barrier_complete(bar, b.x, nloc, nx); b.st[0] = nloc; b.st[1] = nx; }
        const unsigned old = xb_add(&bar[XB_XSUB(b.x)], 1u);
        const unsigned gen = old / nloc;
        if (old + 1u == (gen + 1u) * nloc) {
            __builtin_amdgcn_fence(__ATOMIC_RELEASE, "agent");
            asm volatile("s_waitcnt vmcnt(0)" ::: "memory");
            const unsigned og = xb_add(&bar[XB_TOP], 1u);
            const unsigned tg = og / nx;
            if (og + 1u == (tg + 1u) * nx) xb_add(&bar[XB_TOPGEN], 1u);
            else XB_SPIN(xb_ld(&bar[XB_TOPGEN]) == tg, bar);
            __builtin_amdgcn_fence(__ATOMIC_ACQUIRE, "agent");
            xb_add(&bar[XB_XGEN(b.x)], 1u);
            asm volatile("s_waitcnt vmcnt(0)" ::: "memory");
        } else {
            XB_SPIN(xb_ld(&bar[XB_XGEN(b.x)]) == gen, bar);
            __builtin_amdgcn_fence(__ATOMIC_ACQUIRE, "agent");
            asm volatile("s_waitcnt vmcnt(0)" ::: "memory");
        }
    }
    __syncthreads();
}

#ifndef PROBE_PHASE
#define PROBE_PHASE -1
#endif
#define PH_BEGIN(k) if (PROBE_PHASE == (k)) probe_t0 = __builtin_amdgcn_s_memrealtime();
#define PH_END(k)   if (PROBE_PHASE == (k)) probe_dt = __builtin_amdgcn_s_memrealtime() - probe_t0;
constexpr int SMEM_BYTES = 128 * 132 * 4 + 1024;

__global__ void __launch_bounds__(256, 2) fwd_megakernel(Params p) {
    __shared__ __attribute__((aligned(16))) unsigned char smem[SMEM_BYTES + 16];
    if (threadIdx.x == 0) *(uint4*)(smem + SMEM_BYTES) = make_uint4(0u, 0u, 0u, 0u);
    __syncthreads();
    const XcdBarrier xb = xcd_barrier_post((unsigned*)(p.ws + OFF_BAR), (volatile LAS unsigned*)(smem + SMEM_BYTES));
    const int bid = blockIdx.x, nb = gridDim.x, tid = tidx(), lane = tid & 63, wid = tid >> 6;
    unsigned char* ws = p.ws; unsigned char* dob = (unsigned char*)p.out;
    unsigned long long probe_t0 = 0, probe_dt = 0;
    PH_BEGIN(0)
    {
        for (int u = bid; u < 3232; u += nb) {
            if (u < 1600) convT_tile(p.w_in, (bf16_t*)(ws + OFF_WINT), 1024, INW, u, smem);
            else if (u < 1856) convT_tile(p.w_mem_kv, (bf16_t*)(ws + OFF_WMKVT), 1024, 1024, u - 1600, smem);
            else if (u < 2048) convT_tile(p.p_attn, (bf16_t*)(ws + OFF_PATTNT), 768, 1024, u - 1856, smem);
            else if (u < 2240) convT_tile(p.p_lru, (bf16_t*)(ws + OFF_PLRUT), 768, 1024, u - 2048, smem);
            else if (u < 2368) convT_tile(p.p_mem, (bf16_t*)(ws + OFF_PMEMT), 512, 1024, u - 2240, smem);
            else if (u < 2624) convT_tile(p.w_out, (bf16_t*)(ws + OFF_WOUTT), 1024, 1024, u - 2368, smem);
            else if (u < 3136) convT_tile(p.w_peer_q, (bf16_t*)(ws + OFF_WPQT), 1024, 2048, u - 2624, smem);
            else {
                const int v = u - 3136, mat = v >> 2, tile = v & 3, gsel = mat / 6, h = mat % 6, dir = gsel & 1;
                const float* src = (gsel < 2 ? p.lru_wr : p.lru_wi) + (size_t)(dir * 6 + h) * 128 * 128;
                convT_tile(src, (bf16_t*)(ws + OFF_LRUWT) + (size_t)(h * 512 + gsel * 128) * 128, 128, 128, tile, smem);
            }
        }
        conv_plain(p.peer_sub_keys, (bf16_t*)(ws + OFF_SUBK), (size_t)16 * 128 * 128 / 8);
        for (int r = bid * 4 + wid; r < 2 * NEXP; r += nb * 4) {
            if (r < NEXP) conv_row_fp8(p.peer_u, ws + OFF_UB, (float*)(ws + OFF_SU), r, lane);
            else conv_row_fp8(p.peer_v, ws + OFF_VB, (float*)(ws + OFF_SV), r - NEXP, lane);
        }
        for (int r = bid * 4 + wid; r < NTOK; r += nb * 4) rms_row_bf16(p.x + (size_t)r * 1024, p.g_mix, (bf16_t*)(dob + DO_HBF) + (size_t)r * 1024, lane);
        for (int r = bid * 4 + wid; r < NMEM; r += nb * 4) rms_row_bf16(p.mem + (size_t)r * 1024, p.g_mem, (bf16_t*)(dob + DO_MEMBF) + (size_t)r * 1024, lane);
        for (int i = bid * 256 + tid; i < NTOK * 16; i += nb * 256) rope_item(p.positions, (float*)(dob + DO_ROPE), i);
        for (int i = bid * 256 + tid; i < 2 * LW; i += nb * 256) ((float*)(ws + OFF_SP8))[i] = -8.0f * 1.4426950408889634f * log1pf(__expf(-p.lru_lambda[i]));
    }
    xcd_barrier(xb);
    PH_END(0) PH_BEGIN(1)
    for (int u = bid; u < 256; u += nb) memkv_tile(p, u / 8, u % 8, smem);
    { GemmPipe pp{0, false}; int rt, ct, nrt = 0, nct = 0; bool have = gemm_unit(0, 50, rt, ct); __syncthreads();
      for (int it = 0; have; ++it) { const bool hn = gemm_unit(it + 1, 50, nrt, nct); inproj_tile(p, rt, ct, smem, pp, hn, nrt, nct); rt = nrt; ct = nct; have = hn; } }
    xcd_barrier(xb);
    PH_END(1) PH_BEGIN(2)
    {
        unsigned* ctr = (unsigned*)(p.ws + OFF_BAR) + 3600;
        volatile LAS unsigned* slot = (volatile LAS unsigned*)(smem + SMEM_BYTES + 8);
        for (;;) {
            if (tid == 0) *slot = xb_add(ctr, 1u);
            __syncthreads();
            const int u = (int)*slot;
            __syncthreads();
            if (u >= 1536 + 1536 + 1024) break;
            if (u < 1536) lru_chunk_unit<false>(p, u, smem);
            else if (u < 1536 + 1536) attn_win_unit(p, u - 1536, smem);
            else attn_mem_unit(p, u - 1536 - 1536, smem);
        }
    }
    xcd_barrier(xb);
    for (int u = bid; u < 1536; u += nb) lru_chunk_unit<true>(p, u, smem);
    xcd_barrier(xb);
    PH_END(2) PH_BEGIN(3)
    { GemmPipe pp{0, false}; int rt, ct, nrt = 0, nct = 0; bool have = gemm_unit(0, 8, rt, ct); __syncthreads();
      for (int it = 0; have; ++it) { const bool hn = gemm_unit(it + 1, 8, nrt, nct); merge_tile(p, rt, ct, smem, pp, hn, nrt, nct); rt = nrt; ct = nct; have = hn; } }
    xcd_barrier(xb);
    PH_END(3) PH_BEGIN(4)
    { GemmPipe pp{0, false}; int rt, ct, nrt = 0, nct = 0; bool have = gemm_unit(0, 8, rt, ct); __syncthreads();
      for (int it = 0; have; ++it) { const bool hn = gemm_unit(it + 1, 8, nrt, nct); outproj_tile(p, rt, ct, smem, pp, hn, nrt, nct); rt = nrt; ct = nct; have = hn; } }
    xcd_barrier(xb);
    PH_END(4) PH_BEGIN(5)
    for (int r = bid * 4 + wid; r < NTOK; r += nb * 4) rms_row_bf16(p.out + (size_t)r * 1024, p.g_ffn, (bf16_t*)(ws + OFF_MERGED) + (size_t)r * 1024, lane);
    xcd_barrier(xb);
    PH_END(5) PH_BEGIN(6)
    { GemmPipe pp{0, false}; int rt, ct, nrt = 0, nct = 0; bool have = gemm_unit(0, 16, rt, ct); __syncthreads();
      for (int it = 0; have; ++it) { const bool hn = gemm_unit(it + 1, 16, nrt, nct); peerq_tile(p, rt, ct, smem, pp, hn, nrt, nct); rt = nrt; ct = nct; have = hn; } }
    xcd_barrier(xb);
    PH_END(6) PH_BEGIN(7)
    for (int u = bid; u < 256 * 16; u += nb) scores_tile(p, u / 16, u % 16, smem);
    xcd_barrier(xb);
    PH_END(7) PH_BEGIN(8)
    for (int i = bid * 256 + tid; i < NTOK * 8; i += nb * 256) combine_item(p, i);
    xcd_barrier(xb);
    PH_END(8) PH_BEGIN(9)
    for (int t = bid * 4 + wid; t < NTOK; t += nb * 4) gather_token(p, t, lane);
    PH_END(9)
    if (PROBE_PHASE >= 0) { __syncthreads(); const unsigned long long t1 = __builtin_amdgcn_s_memrealtime(); while (__builtin_amdgcn_s_memrealtime() - t1 < probe_dt) __builtin_amdgcn_s_sleep(8); }
}

extern "C" void kernel_launch(void* const* d_in, const int* in_sizes, int n_in, void* d_out, int out_size, void* d_ws, size_t ws_size, hipStream_t stream) {
    if (ws_size < OFF_END) { fprintf(stderr, "workspace too small: %zu < %zu\n", ws_size, (size_t)OFF_END); return; }
    Params p{};
    p.x = (const float*)d_in[0]; p.mem = (const float*)d_in[1]; p.positions = (const int*)d_in[2];
    p.g_mix = (const float*)d_in[3]; p.g_mem = (const float*)d_in[4]; p.w_in = (const float*)d_in[5]; p.gate_b = (const float*)d_in[6];
    p.attn_sink = (const float*)d_in[7]; p.conv_w = (const float*)d_in[8]; p.conv_b = (const float*)d_in[9];
    p.lru_wr = (const float*)d_in[10]; p.lru_br = (const float*)d_in[11]; p.lru_wi = (const float*)d_in[12]; p.lru_bi = (const float*)d_in[13];
    p.lru_lambda = (const float*)d_in[14]; p.w_mem_kv = (const float*)d_in[15]; p.p_attn = (const float*)d_in[16]; p.p_lru = (const float*)d_in[17];
    p.p_mem = (const float*)d_in[18]; p.w_out = (const float*)d_in[19]; p.g_ffn = (const float*)d_in[20]; p.w_peer_q = (const float*)d_in[21];
    p.peer_sub_keys = (const float*)d_in[22]; p.peer_u = (const float*)d_in[23]; p.peer_v = (const float*)d_in[24]; p.g_final = (const float*)d_in[25];
    p.out = (float*)d_out; p.ws = (unsigned char*)d_ws;
    static int grid_blocks = 0;
    if (!grid_blocks) {
        int dev = 0, cus = 0, per_cu = 0;
        (void)hipGetDevice(&dev);
        (void)hipDeviceGetAttribute(&cus, hipDeviceAttributeMultiprocessorCount, dev);
        (void)hipOccupancyMaxActiveBlocksPerMultiprocessor(&per_cu, fwd_megakernel, 256, 0);
        if (per_cu > 2) per_cu = 2;
        grid_blocks = cus * per_cu;
    }
    (void)hipMemsetAsync((unsigned char*)d_ws + OFF_BAR, 0, 16384, stream);
    void* args[] = {&p};
    hipError_t e = hipLaunchCooperativeKernel((void*)fwd_megakernel, dim3(grid_blocks), dim3(256), args, 0, stream);
    if (e != hipSuccess) fprintf(stderr, "cooperative launch failed: %s (grid %d)\n", hipGetErrorString(e), grid_blocks);
}
```

```cpp
#include <hip/hip_runtime.h>
#include <stdint.h>
#include <stdio.h>

typedef unsigned short bf16_t;
typedef short bf16x8 __attribute__((ext_vector_type(8)));
typedef __bf16 bf16x2v __attribute__((ext_vector_type(2)));
typedef float f32x4 __attribute__((ext_vector_type(4)));

constexpr int B_ = 16, S_ = 2048, D_ = 1024, NTOK = B_ * S_;
constexpr int MEML = 256, NMEM = B_ * MEML;
constexpr int INW = 6400;
constexpr int LW = 768;
constexpr int NEXP = 16384;
constexpr float EPS = 1e-6f;
constexpr float QSCALE = 0.08838834764831845f * 1.4426950408889634f;

constexpr size_t OFF_WINT = 0;
constexpr size_t OFF_WMKVT = OFF_WINT + (size_t)INW * 1024 * 2;
constexpr size_t OFF_PATTNT = OFF_WMKVT + (size_t)1024 * 1024 * 2;
constexpr size_t OFF_PLRUT = OFF_PATTNT + (size_t)1024 * 768 * 2;
constexpr size_t OFF_PMEMT = OFF_PLRUT + (size_t)1024 * 768 * 2;
constexpr size_t OFF_WOUTT = OFF_PMEMT + (size_t)1024 * 512 * 2;
constexpr size_t OFF_WPQT = OFF_WOUTT + (size_t)1024 * 1024 * 2;
constexpr size_t OFF_LRUWT = OFF_WPQT + (size_t)2048 * 1024 * 2;
constexpr size_t OFF_SUBK = OFF_LRUWT + (size_t)6 * 512 * 128 * 2;
constexpr size_t OFF_UB = OFF_SUBK + (size_t)16 * 128 * 128 * 2;
constexpr size_t OFF_VB = OFF_UB + (size_t)NEXP * 1024;
constexpr size_t OFF_SU = OFF_VB + (size_t)NEXP * 1024;
constexpr size_t OFF_SV = OFF_SU + (size_t)NEXP * 4;
constexpr size_t OFF_RA = OFF_SV + (size_t)NEXP * 4;
constexpr size_t OFF_QA = OFF_RA;
constexpr size_t OFF_KA = OFF_QA + (size_t)NTOK * 768 * 2;
constexpr size_t OFF_VAT = OFF_KA + (size_t)NTOK * 256 * 2;
constexpr size_t OFF_XL = OFF_VAT + (size_t)NTOK * 256 * 2;
constexpr size_t OFF_GL = OFF_XL + (size_t)NTOK * 768 * 2;
constexpr size_t OFF_QM = OFF_GL + (size_t)NTOK * 768 * 2;
constexpr size_t OFF_GATES = OFF_QM + (size_t)NTOK * 512 * 2;
constexpr size_t OFF_BAR = OFF_GATES + (size_t)NTOK * 3072 * 2;
constexpr size_t OFF_SP8 = OFF_BAR + 16384;
constexpr size_t OFF_AGG = OFF_SP8 + 2 * 768 * 4;
constexpr size_t OFF_ROWSS = OFF_AGG + (size_t)2 * B_ * 16 * 768 * 8;
constexpr size_t OFF_END = OFF_ROWSS + (size_t)NTOK * 4;
constexpr size_t OFF_MERGED = OFF_KA;
constexpr size_t OFF_QPEER = OFF_GATES;
constexpr size_t OFF_TOPL = OFF_QPEER + (size_t)NTOK * 2048 * 2;
constexpr size_t OFF_EIDX = OFF_TOPL + (size_t)NTOK * 256 * 4;
constexpr size_t OFF_ZBUF = OFF_QPEER;
constexpr size_t OFF_WBUF = OFF_TOPL;
constexpr size_t OFF_EGATE = OFF_EIDX + (size_t)NTOK * 128 * 4;
static_assert(OFF_EGATE + (size_t)NTOK * 128 * 4 <= OFF_BAR, "overlay");
static_assert(OFF_MERGED + (size_t)NTOK * 1024 * 2 <= OFF_GL, "overlay2");
constexpr size_t DO_HBF = 0;
constexpr size_t DO_MEMBF = DO_HBF + (size_t)NTOK * 1024 * 2;
constexpr size_t DO_KM = DO_MEMBF + (size_t)NMEM * 1024 * 2;
constexpr size_t DO_VMT = DO_KM + (size_t)NMEM * 512 * 2;
constexpr size_t DO_ROPE = DO_VMT + (size_t)NMEM * 512 * 2;
static_assert(DO_ROPE + (size_t)NTOK * 32 * 4 <= (size_t)NTOK * 1024 * 4, "d_out scratch");

struct Params {
    const float *x, *mem; const int* positions;
    const float *g_mix, *g_mem, *w_in, *gate_b, *attn_sink, *conv_w, *conv_b, *lru_wr, *lru_br, *lru_wi, *lru_bi, *lru_lambda,
        *w_mem_kv, *p_attn, *p_lru, *p_mem, *w_out, *g_ffn, *w_peer_q, *peer_sub_keys, *peer_u, *peer_v, *g_final;
    float* out; unsigned char* ws;
};

__device__ __forceinline__ int tidx() { int t = threadIdx.x; asm volatile("" : "+v"(t)); return t; }
__device__ __forceinline__ float bf2f(bf16_t b) { return __uint_as_float(((unsigned)b) << 16); }
__device__ __forceinline__ float bflo(unsigned u) { return __uint_as_float(u << 16); }
__device__ __forceinline__ float bfhi(unsigned u) { return __uint_as_float(u & 0xffff0000u); }
typedef float f32x2v __attribute__((ext_vector_type(2)));
__device__ __forceinline__ unsigned pack_bf16(float lo, float hi) { const f32x2v f = {lo, hi}; return __builtin_bit_cast(unsigned, __builtin_convertvector(f, bf16x2v)); }
__device__ __forceinline__ bf16_t f2bf(float f) { return (bf16_t)(pack_bf16(f, 0.f) & 0xffffu); }
__device__ __forceinline__ f32x4 mfma16(bf16x8 a, bf16x8 b, f32x4 c) { return __builtin_amdgcn_mfma_f32_16x16x32_bf16(a, b, c, 0, 0, 0); }
__device__ __forceinline__ float sigmoidf_(float x) { return __builtin_amdgcn_rcpf(1.0f + __expf(-x)); }
__device__ __forceinline__ float gelu_tanh(float x) { const float u = 1.5957691216057308f * (x + 0.044715f * x * x * x); return x * __builtin_amdgcn_rcpf(1.0f + __expf(-u)); }
__device__ __forceinline__ float wave_sum(float v) {
#pragma unroll
    for (int o = 32; o >= 1; o >>= 1) v += __shfl_xor(v, o);
    return v;
}


typedef unsigned u32x4 __attribute__((ext_vector_type(4)));
#define PIN4(a, o) asm volatile("" : "+v"((a)[(o)]), "+v"((a)[(o) + 1]), "+v"((a)[(o) + 2]), "+v"((a)[(o) + 3]))
#define PIN8(a, o) asm volatile("" : "+v"((a)[(o)]), "+v"((a)[(o) + 1]), "+v"((a)[(o) + 2]), "+v"((a)[(o) + 3]), "+v"((a)[(o) + 4]), "+v"((a)[(o) + 5]), "+v"((a)[(o) + 6]), "+v"((a)[(o) + 7]))
#define PIN15(a, o) asm volatile("" : "+v"((a)[(o)]), "+v"((a)[(o) + 1]), "+v"((a)[(o) + 2]), "+v"((a)[(o) + 3]), "+v"((a)[(o) + 4]), "+v"((a)[(o) + 5]), "+v"((a)[(o) + 6]), "+v"((a)[(o) + 7]), \
    "+v"((a)[(o) + 8]), "+v"((a)[(o) + 9]), "+v"((a)[(o) + 10]), "+v"((a)[(o) + 11]), "+v"((a)[(o) + 12]), "+v"((a)[(o) + 13]), "+v"((a)[(o) + 14]))

__device__ void convT_tile(const float* __restrict__ src, bf16_t* __restrict__ dst, int K, int N, int tile, unsigned char* smem) {
    float* t = (float*)smem;
    const int tn = N / 64, tk = tile / tn, tnn = tile % tn, k0 = tk * 64, n0 = tnn * 64, tid = tidx();
    const int r = tid >> 4, c4 = (tid & 15) * 4;
#pragma unroll
    for (int i = 0; i < 4; ++i) {
        const int k = r + 16 * i;
        const float4 v = *(const float4*)(src + (size_t)(k0 + k) * N + n0 + c4);
        t[k * 65 + c4 + 0] = v.x; t[k * 65 + c4 + 1] = v.y; t[k * 65 + c4 + 2] = v.z; t[k * 65 + c4 + 3] = v.w;
    }
    __syncthreads();
    const int n = tid >> 2, kq = (tid & 3) * 16;
    unsigned w[8];
#pragma unroll
    for (int i = 0; i < 8; ++i) w[i] = pack_bf16(t[(kq + 2 * i) * 65 + n], t[(kq + 2 * i + 1) * 65 + n]);
    uint4* d = (uint4*)(dst + (size_t)(n0 + n) * K + k0 + kq);
    d[0] = make_uint4(w[0], w[1], w[2], w[3]); d[1] = make_uint4(w[4], w[5], w[6], w[7]);
    __syncthreads();
}


__device__ __forceinline__ void rms_row_bf16(const float* __restrict__ xr, const float* __restrict__ g, bf16_t* __restrict__ o, int lane) {
    float4 v[4]; float ss = 0.f;
#pragma unroll
    for (int i = 0; i < 4; ++i) { v[i] = *(const float4*)(xr + i * 256 + lane * 4); ss += v[i].x * v[i].x + v[i].y * v[i].y + v[i].z * v[i].z + v[i].w * v[i].w; }
    ss = wave_sum(ss);
    const float rs = rsqrtf(ss * (1.0f / 1024.0f) + EPS);
#pragma unroll
    for (int i = 0; i < 4; ++i) {
        const float4 gg = *(const float4*)(g + i * 256 + lane * 4);
        *(uint2*)(o + i * 256 + lane * 4) = make_uint2(pack_bf16(v[i].x * rs * gg.x, v[i].y * rs * gg.y), pack_bf16(v[i].z * rs * gg.z, v[i].w * rs * gg.w));
    }
}


__device__ __forceinline__ void conv_plain(const float* __restrict__ src, bf16_t* __restrict__ dst, size_t n8) {
    for (size_t i = (size_t)blockIdx.x * 256 + tidx(); i < n8; i += (size_t)gridDim.x * 256) {
        const float4 a = ((const float4*)src)[2 * i], b = ((const float4*)src)[2 * i + 1];
        ((uint4*)dst)[i] = make_uint4(pack_bf16(a.x, a.y), pack_bf16(a.z, a.w), pack_bf16(b.x, b.y), pack_bf16(b.z, b.w));
    }
}
__device__ __forceinline__ void rope_item(const int* __restrict__ pos, float* __restrict__ cs, int i) {
    const int t = i >> 4, f = i & 15;
    const float inv = powf(500000.0f, -(float)(2 * f) / 32.0f);
    const float ang = (float)pos[t] * inv;
    float s, c; sincosf(ang, &s, &c);
    cs[2 * i] = c; cs[2 * i + 1] = s;
}

__device__ __forceinline__ int swz(int row) { return (row & 3) | (((row >> 3) & 1) << 2); }

struct GemmOp { const bf16_t* A; const bf16_t* Bt; int lda, ldb; };
struct GemmPipe { int par; bool pre; };

__device__ __forceinline__ void gemm_issue(const GemmOp& op, int kt, int st, unsigned char* smem) {
    const int tid = tidx();
    const int srow = tid >> 3, skc = (tid & 7) ^ swz(tid >> 3);
    const bf16_t* ga = op.A + (size_t)srow * op.lda + skc * 8 + kt * 64;
    const bf16_t* gb = op.Bt + (size_t)srow * op.ldb + skc * 8 + kt * 64;
    unsigned char* sw = smem + tid * 16 + st * 32768;
#pragma unroll
    for (int i = 0; i < 4; ++i) {
        __builtin_amdgcn_global_load_lds((const unsigned*)(ga + (size_t)(32 * i) * op.lda), (unsigned*)(sw + i * 4096), 16, 0, 0);
        __builtin_amdgcn_global_load_lds((const unsigned*)(gb + (size_t)(32 * i) * op.ldb), (unsigned*)(sw + 16384 + i * 4096), 16, 0, 0);
    }
}
__device__ __forceinline__ void gemm_prefetch(const GemmOp& nx, unsigned char* smem, GemmPipe& pp) { gemm_issue(nx, 0, pp.par, smem); pp.pre = true; }

__device__ __forceinline__ void gemm_tile(const GemmOp& op, int K, f32x4 (&acc)[4][4], unsigned char* smem, GemmPipe& pp) {
    const int tid = tidx(), lane = tid & 63, wid = tid >> 6, wr = wid >> 1, wc = wid & 1, li = lane & 15, g = lane >> 4;
    int aoff[4], boff[4], asw[4], bsw[4];
#pragma unroll
    for (int m = 0; m < 4; ++m) { const int row = wr * 64 + m * 16 + li; aoff[m] = row * 128; asw[m] = swz(row); }
#pragma unroll
    for (int n = 0; n < 4; ++n) { const int row = wc * 64 + 32 * (n >> 1) + 8 * (li >> 2) + 4 * (n & 1) + (li & 3); boff[n] = 16384 + row * 128; bsw[n] = swz(row); }
    const int nk = K >> 6;
    if (!pp.pre) gemm_issue(op, 0, pp.par, smem);
    __syncthreads();
    for (int kt = 0; kt < nk; ++kt) {
        const int cur = (pp.par + kt) & 1;
        const unsigned char* sb = smem + cur * 32768;
        if (kt + 1 < nk) gemm_issue(op, kt + 1, cur ^ 1, smem);
#pragma unroll
        for (int ks = 0; ks < 2; ++ks) {
            bf16x8 af[4], bfr[4];
#pragma unroll
            for (int m = 0; m < 4; ++m) af[m] = *(const bf16x8*)(sb + aoff[m] + (((ks * 4 + g) ^ asw[m]) << 4));
#pragma unroll
            for (int n = 0; n < 4; ++n) bfr[n] = *(const bf16x8*)(sb + boff[n] + (((ks * 4 + g) ^ bsw[n]) << 4));
#pragma unroll
            for (int m = 0; m < 4; ++m)
#pragma unroll
                for (int n = 0; n < 4; ++n) acc[m][n] = mfma16(bfr[n], af[m], acc[m][n]);
        }
        if (kt + 1 < nk) __syncthreads();
    }
    pp.par = (pp.par + nk) & 1; pp.pre = false;
}
__device__ __forceinline__ void acc_zero(f32x4 (&acc)[4][4]) {
#pragma unroll
    for (int m = 0; m < 4; ++m)
#pragma unroll
        for (int n = 0; n < 4; ++n) acc[m][n] = (f32x4){0.f, 0.f, 0.f, 0.f};
}
template <class F> __device__ __forceinline__ void epi_foreach(const f32x4 (&acc)[4][4], F&& f) {
    const int lane = tidx() & 63, wid = tidx() >> 6, wr = wid >> 1, wc = wid & 1, li = lane & 15, g = lane >> 4;
#pragma unroll
    for (int m = 0; m < 4; ++m)
#pragma unroll
        for (int pp = 0; pp < 2; ++pp) {
            float v[8];
#pragma unroll
            for (int r = 0; r < 4; ++r) { v[r] = acc[m][2 * pp][r]; v[4 + r] = acc[m][2 * pp + 1][r]; }
            f(wr * 64 + m * 16 + li, wc * 64 + 32 * pp + 8 * g, v, pp, m);
        }
}
__device__ __forceinline__ void store_bf16x8(bf16_t* p, const float (&v)[8]) {
    *(uint4*)p = make_uint4(pack_bf16(v[0], v[1]), pack_bf16(v[2], v[3]), pack_bf16(v[4], v[5]), pack_bf16(v[6], v[7]));
}
__device__ __forceinline__ void store_tile_T(const f32x4 (&acc)[4][4], bf16_t* __restrict__ dstT, int ldt, unsigned char* smem) {
    bf16_t* t = (bf16_t*)smem;
    __syncthreads();
    epi_foreach(acc, [&](int r, int c, const float (&v)[8], int, int) {
#pragma unroll
        for (int e = 0; e < 8; ++e) t[(c + e) * 136 + r] = f2bf(v[e]);
    });
    __syncthreads();
#pragma unroll
    for (int i = 0; i < 8; ++i) {
        const int ch = tidx() + 256 * i, d = ch >> 4, tc = ch & 15;
        *(uint4*)(dstT + (size_t)d * ldt + tc * 8) = *(const uint4*)(smem + d * 272 + tc * 16);
    }
    __syncthreads();
}

__device__ void inproj_tile(const Params& p, int rt, int ct, unsigned char* smem, GemmPipe& pp, bool hn, int nrt, int nct) {
    unsigned char* ws = p.ws; unsigned char* dob = (unsigned char*)p.out;
    const bf16_t* hbf = (const bf16_t*)(dob + DO_HBF);
    const bf16_t* WinT = (const bf16_t*)(ws + OFF_WINT);
    f32x4 acc[4][4]; acc_zero(acc);
    const GemmOp op{hbf + (size_t)rt * 128 * 1024, WinT + (size_t)ct * 128 * 1024, 1024, 1024};
    const GemmOp nx{hbf + (size_t)nrt * 128 * 1024, WinT + (size_t)nct * 128 * 1024, 1024, 1024};
    gemm_tile(op, 1024, acc, smem, pp);
    const int row0 = rt * 128;
    if (ct < 8) {
        const float* cs = (const float*)(dob + DO_ROPE);
        const bool isq = ct < 6;
        bf16_t* dst = isq ? (bf16_t*)(ws + OFF_QA) + ct * 128 : (bf16_t*)(ws + OFF_KA) + (ct - 6) * 128;
        const int ld = isq ? 768 : 256;
        const float sc = isq ? QSCALE : 1.0f;
        const int lane_ = tidx() & 63, g = lane_ >> 4, wid_ = tidx() >> 6;
        f32x4 csv[16];
        if ((wid_ & 1) == 0) {
#pragma unroll
            for (int m = 0; m < 4; ++m) {
                const f32x4* csr = (const f32x4*)(cs + (size_t)(row0 + (wid_ >> 1) * 64 + m * 16 + (lane_ & 15)) * 32 + (g & 1) * 16);
#pragma unroll
                for (int q = 0; q < 4; ++q) csv[m * 4 + q] = csr[q];
            }
            PIN8(csv, 0); PIN8(csv, 8);
        }
        if (hn) gemm_prefetch(nx, smem, pp);
        epi_foreach(acc, [&](int r, int c, float (&v)[8], int pq, int mq) {
            const int tok = row0 + r;
            if (pq == 0 && c < 32) {
                const f32x4 c0 = csv[mq * 4], c1 = csv[mq * 4 + 1], c2 = csv[mq * 4 + 2], c3 = csv[mq * 4 + 3];
                const float ccv[8] = {c0[0], c0[2], c1[0], c1[2], c2[0], c2[2], c3[0], c3[2]};
                const float ssv[8] = {c0[1], c0[3], c1[1], c1[3], c2[1], c2[3], c3[1], c3[3]};
#pragma unroll
                for (int e = 0; e < 8; ++e) {
                    const float o = __shfl_xor(v[e], 32);
                    v[e] = (g < 2) ? (v[e] * ccv[e] - o * ssv[e]) : (v[e] * ccv[e] + o * ssv[e]);
                }
            }
#pragma unroll
            for (int e = 0; e < 8; ++e) v[e] *= sc;
            store_bf16x8(dst + (size_t)tok * ld + c, v);
        });
    } else if (ct < 10) {
        const int kvh = ct - 8, b = row0 / S_, s0 = row0 % S_;
        store_tile_T(acc, (bf16_t*)(ws + OFF_VAT) + (size_t)(b * 2 + kvh) * 128 * S_ + s0, S_, smem);
    } else if (ct < 16) {
        if (hn) gemm_prefetch(nx, smem, pp);
        bf16_t* dst = (bf16_t*)(ws + OFF_XL) + (ct - 10) * 128;
        epi_foreach(acc, [&](int r, int c, float (&v)[8], int, int) { store_bf16x8(dst + (size_t)(row0 + r) * 768 + c, v); });
    } else if (ct < 22) {
        if (hn) gemm_prefetch(nx, smem, pp);
        bf16_t* dst = (bf16_t*)(ws + OFF_GL) + (ct - 16) * 128;
        epi_foreach(acc, [&](int r, int c, float (&v)[8], int, int) {
#pragma unroll
            for (int e = 0; e < 8; ++e) v[e] = gelu_tanh(v[e]);
            store_bf16x8(dst + (size_t)(row0 + r) * 768 + c, v); });
    } else if (ct < 26) {
        if (hn) gemm_prefetch(nx, smem, pp);
        bf16_t* dst = (bf16_t*)(ws + OFF_QM) + (ct - 22) * 128;
        epi_foreach(acc, [&](int r, int c, float (&v)[8], int, int) {
#pragma unroll
            for (int e = 0; e < 8; ++e) v[e] *= QSCALE;
            store_bf16x8(dst + (size_t)(row0 + r) * 512 + c, v); });
    } else {
        const int gc0 = (ct - 26) * 128;
        bf16_t* dst = (bf16_t*)(ws + OFF_GATES) + gc0;
        const float* gb = p.gate_b + gc0;
        f32x4 gbv[4];
        {
            const int lane_ = tidx() & 63, c0 = ((tidx() >> 6) & 1) * 64 + 8 * (lane_ >> 4);
#pragma unroll
            for (int q = 0; q < 2; ++q) { gbv[2 * q] = *(const f32x4*)(gb + c0 + 32 * q); gbv[2 * q + 1] = *(const f32x4*)(gb + c0 + 32 * q + 4); }
            PIN4(gbv, 0);
        }
        if (hn) gemm_prefetch(nx, smem, pp);
        epi_foreach(acc, [&](int r, int c, float (&v)[8], int pq, int mq) {
            const f32x4 b0 = gbv[2 * pq], b1 = gbv[2 * pq + 1];
            v[0] = sigmoidf_(v[0] + b0[0]); v[1] = sigmoidf_(v[1] + b0[1]); v[2] = sigmoidf_(v[2] + b0[2]); v[3] = sigmoidf_(v[3] + b0[3]);
            v[4] = sigmoidf_(v[4] + b1[0]); v[5] = sigmoidf_(v[5] + b1[1]); v[6] = sigmoidf_(v[6] + b1[2]); v[7] = sigmoidf_(v[7] + b1[3]);
            store_bf16x8(dst + (size_t)(row0 + r) * 3072 + c, v); });
    }
}

__device__ void memkv_tile(const Params& p, int rt, int ct, unsigned char* smem) {
    unsigned char* dob = (unsigned char*)p.out;
    f32x4 acc[4][4]; acc_zero(acc);
    const GemmOp op{(const bf16_t*)(dob + DO_MEMBF) + (size_t)rt * 128 * 1024, (const bf16_t*)(p.ws + OFF_WMKVT) + (size_t)ct * 128 * 1024, 1024, 1024};
    GemmPipe pp{0, false};
    __syncthreads();
    gemm_tile(op, 1024, acc, smem, pp);
    const int row0 = rt * 128;
    if (ct < 4) {
        bf16_t* dst = (bf16_t*)(dob + DO_KM) + ct * 128;
        epi_foreach(acc, [&](int r, int c, float (&v)[8], int, int) { store_bf16x8(dst + (size_t)(row0 + r) * 512 + c, v); });
    } else {
        const int h = ct - 4, b = row0 / MEML, m0 = row0 % MEML;
        store_tile_T(acc, (bf16_t*)(dob + DO_VMT) + (size_t)(b * 4 + h) * 128 * MEML + m0, MEML, smem);
    }
}


typedef float f32x16 __attribute__((ext_vector_type(16)));
__device__ __forceinline__ f32x16 mfma32(bf16x8 a, bf16x8 b, f32x16 c) { return __builtin_amdgcn_mfma_f32_32x32x16_bf16(a, b, c, 0, 0, 0); }
constexpr int ATT_STAGE = 16384 + 128 * 136;

template <bool WIN>
__device__ void attn_block(const bf16_t* Qg, int ldq, const bf16_t* __restrict__ Kg, int ldk, const bf16_t* __restrict__ Vtg, int ldv,
                           int q0, int kt0, int nt, float sink2, bf16_t* Og, int ldo, unsigned char* smem) {
    const int tid = tidx(), lane = tid & 63, wid = tid >> 6, r = lane & 31, hh = lane >> 5;
    const int qw = q0 + 32 * wid;
    bf16x8 qf[8];
#pragma unroll
    for (int ks = 0; ks < 8; ++ks) qf[ks] = *(const bf16x8*)(Qg + (size_t)(32 * wid + r) * ldq + ks * 16 + hh * 8);
    f32x16 o[4];
#pragma unroll
    for (int db = 0; db < 4; ++db)
#pragma unroll
        for (int e = 0; e < 16; ++e) o[db][e] = 0.f;
    float m = WIN ? sink2 : -1e30f, l = WIN ? 1.0f : 0.0f;
    const int krow = tid >> 4, kch = tid & 15, vrow = tid >> 3, vch = tid & 7;
    const int koff = krow * 256 + ((kch ^ (krow & 15)) << 4);
    const int voff = 16384 + vrow * 136 + vch * 16;
    uint4 rk[4], rv[4];
    const bf16_t* kgp = Kg + (size_t)(kt0 * 64 + krow) * ldk + kch * 8;
    const bf16_t* vgp = Vtg + (size_t)vrow * ldv + kt0 * 64 + vch * 8;
#pragma unroll
    for (int i = 0; i < 4; ++i) { rk[i] = *(const uint4*)(kgp + (size_t)(16 * i) * ldk); rv[i] = *(const uint4*)(vgp + (size_t)(32 * i) * ldv); }
#pragma unroll
    for (int i = 0; i < 4; ++i) {
        *(uint4*)(smem + koff + i * 4096) = rk[i];
        *(uint2*)(smem + voff + i * 4352) = make_uint2(rv[i].x, rv[i].y); *(uint2*)(smem + voff + i * 4352 + 8) = make_uint2(rv[i].z, rv[i].w);
    }
    __syncthreads();
    for (int t = 0; t < nt; ++t) {
        const unsigned char* sb = smem + (t & 1) * ATT_STAGE;
        {
            const int tn = t + 1 < nt ? t + 1 : t;
#pragma unroll
            for (int i = 0; i < 4; ++i) { rk[i] = *(const uint4*)(kgp + (size_t)(tn * 64 + 16 * i) * ldk); rv[i] = *(const uint4*)(vgp + (size_t)(32 * i) * ldv + tn * 64); }
        }
        const int k0 = (kt0 + t) * 64;
        if (!WIN || (k0 + 63 >= qw - 128 && k0 <= qw + 159)) {
#pragma unroll
            for (int kb = 0; kb < 2; ++kb) {
                const int kb0 = k0 + 32 * kb;
                if (WIN && !(kb0 + 31 >= qw - 128 && kb0 <= qw + 159)) continue;
                f32x16 s;
#pragma unroll
                for (int e = 0; e < 16; ++e) s[e] = 0.f;
                const int row = kb * 32 + r;
#pragma unroll
                for (int ks = 0; ks < 8; ++ks) {
                    const bf16x8 a = *(const bf16x8*)(sb + row * 256 + (((2 * ks + hh) ^ (row & 15)) << 4));
                    s = mfma32(a, qf[ks], s);
                }
                if (WIN && !(kb0 >= qw - 97 && kb0 + 31 <= qw + 128)) {
#pragma unroll
                    for (int e = 0; e < 16; ++e) {
                        const int d = kb0 + (e & 3) + 8 * (e >> 2) + 4 * hh - (qw + r);
                        s[e] = (d <= 128 && d >= -128) ? s[e] : -1e30f;
                    }
                }
                float mx = s[0];
#pragma unroll
                for (int e = 1; e < 16; ++e) mx = fmaxf(mx, s[e]);
                mx = fmaxf(mx, __shfl_xor(mx, 32));
                const float mnew = fmaxf(m, mx), alpha = __builtin_amdgcn_exp2f(m - mnew);
                m = mnew;
                float ps = 0.f;
#pragma unroll
                for (int e = 0; e < 16; ++e) { s[e] = __builtin_amdgcn_exp2f(s[e] - mnew); ps += s[e]; }
                ps += __shfl_xor(ps, 32);
                l = l * alpha + ps;
                if (__any(alpha != 1.0f)) {
#pragma unroll
                    for (int db = 0; db < 4; ++db)
#pragma unroll
                        for (int e = 0; e < 16; ++e) o[db][e] *= alpha;
                }
#pragma unroll
                for (int s2 = 0; s2 < 2; ++s2) {
                    union { unsigned u[4]; bf16x8 v; } pb;
#pragma unroll
                    for (int e = 0; e < 4; ++e) pb.u[e] = pack_bf16(s[8 * s2 + 2 * e], s[8 * s2 + 2 * e + 1]);
#pragma unroll
                    for (int db = 0; db < 4; ++db) {
                        const unsigned char* vp = sb + 16384 + (db * 32 + r) * 136 + (kb * 32 + 16 * s2 + 4 * hh) * 2;
                        union { uint2 u[2]; bf16x8 v; } va;
                        va.u[0] = *(const uint2*)vp; va.u[1] = *(const uint2*)(vp + 16);
                        o[db] = mfma32(va.v, pb.v, o[db]);
                    }
                }
            }
        }
        {
            unsigned char* sw = smem + ((t + 1) & 1) * ATT_STAGE;
#pragma unroll
            for (int i = 0; i < 4; ++i) {
                *(uint4*)(sw + koff + i * 4096) = rk[i];
                *(uint2*)(sw + voff + i * 4352) = make_uint2(rv[i].x, rv[i].y); *(uint2*)(sw + voff + i * 4352 + 8) = make_uint2(rv[i].z, rv[i].w);
            }
        }
        __syncthreads();
    }
    const float inv = __builtin_amdgcn_rcpf(l);
    bf16_t* orow = Og + (size_t)(32 * wid + r) * ldo + 4 * hh;
#pragma unroll
    for (int db = 0; db < 4; ++db)
#pragma unroll
        for (int gq = 0; gq < 4; ++gq)
            *(uint2*)(orow + db * 32 + 8 * gq) = make_uint2(pack_bf16(o[db][4 * gq] * inv, o[db][4 * gq + 1] * inv), pack_bf16(o[db][4 * gq + 2] * inv, o[db][4 * gq + 3] * inv));
}
__device__ void attn_win_unit(const Params& p, int u, unsigned char* smem) {
    const int gh = u % 3, qb = (u / 3) % 16, kvh = (u / 48) % 2, b = u / 96, head = kvh * 3 + gh;
    const int q0 = qb * 128;
    const int ks = q0 - 128 < 0 ? 0 : q0 - 128, ke = q0 + 256 > S_ ? S_ : q0 + 256;
    bf16_t* Q = (bf16_t*)(p.ws + OFF_QA) + (size_t)(b * S_ + q0) * 768 + head * 128;
    const bf16_t* Kb = (const bf16_t*)(p.ws + OFF_KA) + (size_t)(b * S_) * 256 + kvh * 128;
    const bf16_t* Vt = (const bf16_t*)(p.ws + OFF_VAT) + (size_t)(b * 2 + kvh) * 128 * S_;
    attn_block<true>(Q, 768, Kb, 256, Vt, S_, q0, ks / 64, (ke - ks) / 64, p.attn_sink[head] * 1.4426950408889634f, Q, 768, smem);
}
__device__ void attn_mem_unit(const Params& p, int u, unsigned char* smem) {
    const int qb = u % 16, head = (u / 16) % 4, b = u / 64;
    const int q0 = qb * 128;
    unsigned char* dob = (unsigned char*)p.out;
    bf16_t* Q = (bf16_t*)(p.ws + OFF_QM) + (size_t)(b * S_ + q0) * 512 + head * 128;
    const bf16_t* Kb = (const bf16_t*)(dob + DO_KM) + (size_t)(b * MEML) * 512 + head * 128;
    const bf16_t* Vt = (const bf16_t*)(dob + DO_VMT) + (size_t)(b * 4 + head) * 128 * MEML;
    attn_block<false>(Q, 512, Kb, 512, Vt, MEML, q0, 0, 4, 0.f, Q, 512, smem);
}

typedef _Float16 f16x2v __attribute__((ext_vector_type(2)));
__device__ __forceinline__ unsigned pack_f16(float lo, float hi) { return __builtin_bit_cast(unsigned, __builtin_amdgcn_cvt_pkrtz(lo, hi)); }
template <bool FINAL>
__device__ void lru_chunk_unit(const Params& p, int u, unsigned char* smem) {
    const int tid = tidx(), lane = tid & 63, wid = tid >> 6, li = lane & 15, g = lane >> 4;
    const int c = u & 15, h = (u >> 4) % 6, b = u / 96;
    const int cbase = h * 128, s0 = c * 128;
    unsigned char* xcs = smem; unsigned char* LB = smem + 32768; float2* SA = (float2*)(smem + 49152); unsigned char* WL = smem + 51200; float* CC = (float*)(smem + 67584);
    const bf16_t* Xl = (const bf16_t*)(p.ws + OFF_XL) + (size_t)(b * S_) * 768;
    bf16_t* Gl = (bf16_t*)(p.ws + OFF_GL) + (size_t)(b * S_ + s0) * 768;
    const bf16_t* LruWt = (const bf16_t*)(p.ws + OFF_LRUWT) + (size_t)h * 512 * 128;
    const float* SP8 = (const float*)(p.ws + OFF_SP8);
    float2* AGG = (float2*)(p.ws + OFF_AGG);
    auto stage_w = [&](int hc_, int d_) {
#pragma unroll
        for (int i = 0; i < 4; ++i) {
            const int rr = (tid >> 4) + 16 * i, n = rr >> 4, wrow = ((n >> 1) * 2 + d_) * 128 + hc_ * 32 + 16 * (n & 1) + (rr & 15);
            __builtin_amdgcn_global_load_lds((const unsigned*)(LruWt + (size_t)wrow * 128 + (((tid & 15) ^ (rr & 15)) << 3)), (unsigned*)(WL + tid * 16 + i * 4096), 16, 0, 0);
        }
    };
    __syncthreads();
    if (FINAL) {
        const int d_ = tid >> 7, ch_ = tid & 127;
        const float2* ag = AGG + ((size_t)(d_ * B_ + b) * 16) * 768 + cbase + ch_;
        f32x2v av[16];
#pragma unroll
        for (int j = 0; j < 16; ++j) av[j] = *(const f32x2v*)(ag + (size_t)j * 768);
        PIN8(av, 0); PIN8(av, 8);
        float H = 0.f;
#pragma unroll
        for (int jj = 0; jj < 16; ++jj) {
            const int j = d_ ? 15 - jj : jj;
            const bool on = d_ ? (j > c) : (j < c);
            H = __builtin_amdgcn_exp2f(on ? av[j][0] : 0.f) * H + (on ? av[j][1] : 0.f);
        }
        CC[tid] = H;
    }
    {
        const int cp = tid & 63, tq = tid >> 6, cch = cbase + 2 * cp;
        float cw[4][2];
#pragma unroll
        for (int j = 0; j < 4; ++j) { cw[j][0] = p.conv_w[j * LW + cch]; cw[j][1] = p.conv_w[j * LW + cch + 1]; }
        const float cb0 = p.conv_b[cch], cb1 = p.conv_b[cch + 1];
#pragma unroll
        for (int hf = 0; hf < 2; ++hf) {
            const int tb = 32 * tq + 16 * hf;
            unsigned xw[19];
#pragma unroll
            for (int i = 0; i < 19; ++i) {
                const int s = s0 + tb + i - 2, sc = s < 0 ? 0 : (s > S_ - 1 ? S_ - 1 : s);
                xw[i] = *(const unsigned*)(Xl + (size_t)sc * 768 + cch);
            }
            PIN15(xw, 0); PIN4(xw, 15);
#pragma unroll
            for (int i = 0; i < 19; ++i) { const int s = s0 + tb + i - 2; xw[i] = (s >= 0 && s < S_) ? xw[i] : 0u; }
#pragma unroll
            for (int i = 0; i < 16; ++i) {
                const int t = tb + i;
                const float y0 = cb0 + cw[0][0] * bflo(xw[i]) + cw[1][0] * bflo(xw[i + 1]) + cw[2][0] * bflo(xw[i + 2]) + cw[3][0] * bflo(xw[i + 3]);
                const float y1 = cb1 + cw[0][1] * bfhi(xw[i]) + cw[1][1] * bfhi(xw[i + 1]) + cw[2][1] * bfhi(xw[i + 2]) + cw[3][1] * bfhi(xw[i + 3]);
                *(unsigned*)(xcs + t * 256 + (((cp >> 2) ^ (t & 15)) << 4) + (cp & 3) * 4) = pack_bf16(y0, y1);
            }
        }
    }
    const int sch = tid & 31, seg = tid >> 5;
    float4 cst[2][3];
    auto load_cst = [&](int hc_, int d_) {
#pragma unroll
        for (int n = 0; n < 2; ++n) {
            const int gch = cbase + hc_ * 32 + 16 * n + 4 * g;
            cst[n][0] = *(const float4*)(p.lru_br + d_ * LW + gch); cst[n][1] = *(const float4*)(p.lru_bi + d_ * LW + gch); cst[n][2] = *(const float4*)(SP8 + d_ * LW + gch);
        }
    };
    stage_w(0, 0);
    __syncthreads();
#pragma unroll 1
    for (int hc = 0; hc < 4; ++hc) {
        float hfv[16];
#pragma unroll
        for (int d = 0; d < 2; ++d) {
            load_cst(hc, d);
            f32x4 acc[2][4];
#pragma unroll
            for (int m = 0; m < 2; ++m)
#pragma unroll
                for (int n = 0; n < 4; ++n) acc[m][n] = (f32x4){0.f, 0.f, 0.f, 0.f};
#pragma unroll
            for (int ks = 0; ks < 4; ++ks) {
                bf16x8 xf[2];
#pragma unroll
                for (int m = 0; m < 2; ++m) { const int row = 32 * wid + 16 * m + li; xf[m] = *(const bf16x8*)(xcs + row * 256 + (((ks * 4 + g) ^ (row & 15)) << 4)); }
#pragma unroll
                for (int n = 0; n < 4; ++n) {
                    const int rr = 16 * n + li;
                    const bf16x8 wf = *(const bf16x8*)(WL + rr * 256 + (((ks * 4 + g) ^ li) << 4));
#pragma unroll
                    for (int m = 0; m < 2; ++m) acc[m][n] = mfma16(wf, xf[m], acc[m][n]);
                }
            }
#pragma unroll
            for (int n = 0; n < 2; ++n) {
                const int ch4 = 16 * n + 4 * g;
                const float4 br4 = cst[n][0], bi4 = cst[n][1], sp4 = cst[n][2];
                const float brv[4] = {br4.x, br4.y, br4.z, br4.w}, biv[4] = {bi4.x, bi4.y, bi4.z, bi4.w}, spv[4] = {sp4.x, sp4.y, sp4.z, sp4.w};
#pragma unroll
                for (int m = 0; m < 2; ++m) {
                    const int tok = 32 * wid + 16 * m + li;
                    const uint2 xq = *(const uint2*)(xcs + tok * 256 + ((((hc * 32 + ch4) >> 3) ^ (tok & 15)) << 4) + (g & 1) * 8);
                    const float xc[4] = {bflo(xq.x), bfhi(xq.x), bflo(xq.y), bfhi(xq.y)};
                    unsigned w[4];
#pragma unroll
                    for (int r = 0; r < 4; ++r) {
                        const float rg = sigmoidf_(acc[m][n][r] + brv[r]), ig = sigmoidf_(acc[m][n + 2][r] + biv[r]);
                        const float la = spv[r] * rg, a = __builtin_amdgcn_exp2f(la);
                        const float bx = __builtin_amdgcn_sqrtf(fmaxf(1.0f - a * a, 0.f)) * (ig * xc[r]);
                        w[r] = pack_f16(la, bx);
                    }
                    *(uint4*)(LB + tok * 128 + (((ch4 >> 2) ^ (tok & 7)) << 4)) = make_uint4(w[0], w[1], w[2], w[3]);
                }
            }
            __syncthreads();
            if (!(hc == 3 && d == 1)) stage_w(d ? hc + 1 : hc, d ^ 1);
            const int gch = cbase + hc * 32 + sch;
            {
                float L = 0.f, H = 0.f;
#pragma unroll
                for (int k = 0; k < 16; ++k) {
                    const int tok = 16 * seg + (d ? 15 - k : k);
                    const unsigned w = *(const unsigned*)(LB + tok * 128 + (((sch >> 2) ^ (tok & 7)) << 4) + (sch & 3) * 4);
                    const f16x2v hv = __builtin_bit_cast(f16x2v, w);
                    const float la = (float)hv.x, bx = (float)hv.y;
                    H = __builtin_amdgcn_exp2f(la) * H + bx; L += la;
                }
                SA[seg * 32 + sch] = make_float2(L, H);
            }
            __syncthreads();
            if (!FINAL) {
                if (seg == 0) {
                    float L = 0.f, H = 0.f;
#pragma unroll
                    for (int s = 0; s < 8; ++s) { const float2 a = SA[(d ? 7 - s : s) * 32 + sch]; H = __builtin_amdgcn_exp2f(a.x) * H + a.y; L += a.x; }
                    AGG[((size_t)(d * B_ + b) * 16 + c) * 768 + gch] = make_float2(L, H);
                }
            } else {
                float H = CC[d * 128 + hc * 32 + sch];
#pragma unroll
                for (int ss = 0; ss < 8; ++ss) {
                    const int s = d ? 7 - ss : ss;
                    const bool on = d ? (s > seg) : (s < seg);
                    const float2 a = SA[s * 32 + sch];
                    H = __builtin_amdgcn_exp2f(on ? a.x : 0.f) * H + (on ? a.y : 0.f);
                }
                bf16_t* gp = Gl + (size_t)(16 * seg) * 768 + gch;
                float gv[16];
                if (d) {
                    unsigned gr[16];
#pragma unroll
                    for (int k = 0; k < 16; ++k) gr[k] = gp[(size_t)k * 768];
                    PIN8(gr, 0); PIN8(gr, 8);
#pragma unroll
                    for (int k = 0; k < 16; ++k) gv[k] = __uint_as_float(gr[k] << 16);
                }
#pragma unroll
                for (int k = 0; k < 16; ++k) {
                    const int kk = d ? 15 - k : k, tok = 16 * seg + kk;
                    const unsigned w = *(const unsigned*)(LB + tok * 128 + (((sch >> 2) ^ (tok & 7)) << 4) + (sch & 3) * 4);
                    const f16x2v hv = __builtin_bit_cast(f16x2v, w);
                    H = __builtin_amdgcn_exp2f((float)hv.x) * H + (float)hv.y;
                    if (d == 0) hfv[kk] = H; else hfv[kk] = (hfv[kk] + H) * gv[kk];
                }
                if (d) {
#pragma unroll
                    for (int k = 0; k < 16; ++k) gp[(size_t)k * 768] = f2bf(hfv[k]);
                }
            }
            __syncthreads();
        }
    }
}

__device__ void merge_tile(const Params& p, int rt, int ct, unsigned char* smem, GemmPipe& pp, bool hn, int nrt, int nct) {
    unsigned char* ws = p.ws;
    const int row0 = rt * 128, col0 = ct * 128;
    uint4 tot[4][2];
    const bf16_t* G = (const bf16_t*)(ws + OFF_GATES);
    const int lane = tidx() & 63, wid = tidx() >> 6, wr = wid >> 1, wc = wid & 1, li = lane & 15, g = lane >> 4;
#pragma unroll 1
    for (int br = 0; br < 3; ++br) {
        const bf16_t* Ab = (const bf16_t*)(ws + (br == 0 ? OFF_QA : (br == 1 ? OFF_GL : OFF_QM)));
        const bf16_t* Bb = (const bf16_t*)(ws + (br == 0 ? OFF_PATTNT : (br == 1 ? OFF_PLRUT : OFF_PMEMT)));
        const int Kb = br == 2 ? 512 : 768;
        const int nbr = br == 2 ? 0 : br + 1, nr0 = br == 2 ? nrt * 128 : row0, nc0 = br == 2 ? nct * 128 : col0, nKb = nbr == 2 ? 512 : 768;
        const bf16_t* nAb = (const bf16_t*)(ws + (nbr == 0 ? OFF_QA : (nbr == 1 ? OFF_GL : OFF_QM)));
        const bf16_t* nBb = (const bf16_t*)(ws + (nbr == 0 ? OFF_PATTNT : (nbr == 1 ? OFF_PLRUT : OFF_PMEMT)));
        const GemmOp op{Ab + (size_t)row0 * Kb, Bb + (size_t)col0 * Kb, Kb, Kb};
        const GemmOp nx{nAb + (size_t)nr0 * nKb, nBb + (size_t)nc0 * nKb, nKb, nKb};
        f32x4 acc[4][4]; acc_zero(acc);
        gemm_tile(op, Kb, acc, smem, pp);
        u32x4 gva[8];
#pragma unroll
        for (int m = 0; m < 4; ++m)
#pragma unroll
            for (int pq = 0; pq < 2; ++pq) {
                const int r = wr * 64 + m * 16 + li, c = wc * 64 + 32 * pq + 8 * g;
                gva[m * 2 + pq] = *(const u32x4*)(G + (size_t)(row0 + r) * 3072 + br * 1024 + col0 + c);
            }
        PIN8(gva, 0);
        if (br < 2 || hn) gemm_prefetch(nx, smem, pp);
#pragma unroll
        for (int m = 0; m < 4; ++m)
#pragma unroll
            for (int pp = 0; pp < 2; ++pp) {
                const uint4 gv = make_uint4(gva[m * 2 + pp][0], gva[m * 2 + pp][1], gva[m * 2 + pp][2], gva[m * 2 + pp][3]);
                float v[8];
                v[0] = bflo(gv.x) * acc[m][2 * pp][0]; v[1] = bfhi(gv.x) * acc[m][2 * pp][1];
                v[2] = bflo(gv.y) * acc[m][2 * pp][2]; v[3] = bfhi(gv.y) * acc[m][2 * pp][3];
                v[4] = bflo(gv.z) * acc[m][2 * pp + 1][0]; v[5] = bfhi(gv.z) * acc[m][2 * pp + 1][1];
                v[6] = bflo(gv.w) * acc[m][2 * pp + 1][2]; v[7] = bfhi(gv.w) * acc[m][2 * pp + 1][3];
                if (br > 0) {
                    const uint4 t = tot[m][pp];
                    v[0] += bflo(t.x); v[1] += bfhi(t.x); v[2] += bflo(t.y); v[3] += bfhi(t.y);
                    v[4] += bflo(t.z); v[5] += bfhi(t.z); v[6] += bflo(t.w); v[7] += bfhi(t.w);
                }
                tot[m][pp] = make_uint4(pack_bf16(v[0], v[1]), pack_bf16(v[2], v[3]), pack_bf16(v[4], v[5]), pack_bf16(v[6], v[7]));
            }
    }
    bf16_t* dst = (bf16_t*)(ws + OFF_MERGED) + col0;
#pragma unroll
    for (int m = 0; m < 4; ++m)
#pragma unroll
        for (int pp = 0; pp < 2; ++pp) {
            const int r = wr * 64 + m * 16 + li, c = wc * 64 + 32 * pp + 8 * g;
            *(uint4*)(dst + (size_t)(row0 + r) * 1024 + c) = tot[m][pp];
        }
}
__device__ void outproj_tile(const Params& p, int rt, int ct, unsigned char* smem, GemmPipe& pp, bool hn, int nrt, int nct) {
    const int row0 = rt * 128, col0 = ct * 128;
    f32x4 acc[4][4]; acc_zero(acc);
    const GemmOp op{(const bf16_t*)(p.ws + OFF_MERGED) + (size_t)row0 * 1024, (const bf16_t*)(p.ws + OFF_WOUTT) + (size_t)col0 * 1024, 1024, 1024};
    const GemmOp nx{(const bf16_t*)(p.ws + OFF_MERGED) + (size_t)nrt * 128 * 1024, (const bf16_t*)(p.ws + OFF_WOUTT) + (size_t)nct * 128 * 1024, 1024, 1024};
    gemm_tile(op, 1024, acc, smem, pp);
    f32x4 xv[16];
    {
        const int lane_ = tidx() & 63, wid_ = tidx() >> 6;
#pragma unroll
        for (int m = 0; m < 4; ++m)
#pragma unroll
            for (int pq = 0; pq < 2; ++pq) {
                const size_t o = (size_t)(row0 + (wid_ >> 1) * 64 + m * 16 + (lane_ & 15)) * 1024 + col0 + (wid_ & 1) * 64 + 32 * pq + 8 * (lane_ >> 4);
                xv[(m * 2 + pq) * 2] = *(const f32x4*)(p.x + o); xv[(m * 2 + pq) * 2 + 1] = *(const f32x4*)(p.x + o + 4);
            }
        PIN8(xv, 0); PIN8(xv, 8);
    }
    if (hn) gemm_prefetch(nx, smem, pp);
    epi_foreach(acc, [&](int r, int c, float (&v)[8], int pq, int mq) {
        const size_t o = (size_t)(row0 + r) * 1024 + col0 + c;
        const f32x4 x0 = xv[(mq * 2 + pq) * 2], x1 = xv[(mq * 2 + pq) * 2 + 1];
        *(float4*)(p.out + o) = make_float4(x0[0] + v[0], x0[1] + v[1], x0[2] + v[2], x0[3] + v[3]);
        *(float4*)(p.out + o + 4) = make_float4(x1[0] + v[4], x1[1] + v[5], x1[2] + v[6], x1[3] + v[7]);
    });
}

__device__ void peerq_tile(const Params& p, int rt, int ct, unsigned char* smem, GemmPipe& pp, bool hn, int nrt, int nct) {
    const int row0 = rt * 128, col0 = ct * 128;
    f32x4 acc[4][4]; acc_zero(acc);
    const GemmOp op{(const bf16_t*)(p.ws + OFF_MERGED) + (size_t)row0 * 1024, (const bf16_t*)(p.ws + OFF_WPQT) + (size_t)col0 * 1024, 1024, 1024};
    const GemmOp nx{(const bf16_t*)(p.ws + OFF_MERGED) + (size_t)nrt * 128 * 1024, (const bf16_t*)(p.ws + OFF_WPQT) + (size_t)nct * 128 * 1024, 1024, 1024};
    gemm_tile(op, 1024, acc, smem, pp);
    if (hn) gemm_prefetch(nx, smem, pp);
    bf16_t* dst = (bf16_t*)(p.ws + OFF_QPEER) + col0;
    epi_foreach(acc, [&](int r, int c, float (&v)[8], int, int) { store_bf16x8(dst + (size_t)(row0 + r) * 2048 + c, v); });
}

__device__ __forceinline__ int sortable(float v) { int k = __float_as_int(v); return k ^ ((k >> 31) & 0x7fffffff); }
__device__ __forceinline__ float unsortable(int k) { return __int_as_float(k ^ ((k >> 31) & 0x7fffffff)); }
__device__ __forceinline__ void insert16(int (&lst)[16], int x) {
#pragma unroll
    for (int k = 0; k < 16; ++k) { const int hi = max(lst[k], x); x = min(lst[k], x); lst[k] = hi; }
}
__device__ void scores_tile(const Params& p, int rt, int pq, unsigned char* smem) {
    const int row0 = rt * 128;
    f32x4 acc[4][4]; acc_zero(acc);
    const GemmOp op{(const bf16_t*)(p.ws + OFF_QPEER) + (size_t)row0 * 2048 + pq * 128, (const bf16_t*)(p.ws + OFF_SUBK) + (size_t)pq * 128 * 128, 2048, 128};
    GemmPipe pp{0, false};
    gemm_tile(op, 128, acc, smem, pp);
    float* sc = (float*)smem;
    __syncthreads();
    epi_foreach(acc, [&](int r, int c, float (&v)[8], int, int) {
        *(float4*)(sc + r * 132 + c) = make_float4(v[0], v[1], v[2], v[3]);
        *(float4*)(sc + r * 132 + c + 4) = make_float4(v[4], v[5], v[6], v[7]); });
    __syncthreads();
    {
        const int t = tidx(), r = t & 127, hf = t >> 7;
        int lst[16];
#pragma unroll
        for (int k = 0; k < 16; ++k) lst[k] = (int)0x80000000;
#pragma unroll 2
        for (int j4 = 0; j4 < 16; ++j4) {
            const int j = hf * 64 + j4 * 4;
            const float4 v = *(const float4*)(sc + r * 132 + j);
            insert16(lst, (sortable(v.x) & ~127) | (j + 0));
            insert16(lst, (sortable(v.y) & ~127) | (j + 1));
            insert16(lst, (sortable(v.z) & ~127) | (j + 2));
            insert16(lst, (sortable(v.w) & ~127) | (j + 3));
        }
        __syncthreads();
        int* ls = (int*)smem;
        if (hf) {
#pragma unroll
            for (int k = 0; k < 16; ++k) ls[t * 16 + k] = lst[15 - k];
        }
        __syncthreads();
        if (!hf) {
#pragma unroll
            for (int k = 0; k < 16; ++k) lst[k] = max(lst[k], ls[(t + 128) * 16 + k]);
#pragma unroll
            for (int s = 8; s >= 1; s >>= 1)
#pragma unroll
                for (int k = 0; k < 16; ++k)
                    if ((k & s) == 0) { const int hi = max(lst[k], lst[k + s]), lo = min(lst[k], lst[k + s]); lst[k] = hi; lst[k + s] = lo; }
            int4* dst = (int4*)((int*)(p.ws + OFF_TOPL) + ((size_t)(row0 + r) * 16 + pq) * 16);
            dst[0] = make_int4(lst[0], lst[1], lst[2], lst[3]); dst[1] = make_int4(lst[4], lst[5], lst[6], lst[7]);
            dst[2] = make_int4(lst[8], lst[9], lst[10], lst[11]); dst[3] = make_int4(lst[12], lst[13], lst[14], lst[15]);
        }
    }
    __syncthreads();
}

__device__ void combine_item(const Params& p, int item) {
    const int tok = item >> 3, hd = item & 7;
    const int* l0 = (const int*)(p.ws + OFF_TOPL) + ((size_t)tok * 16 + hd * 2) * 16;
    const int* l1 = l0 + 16;
    int k0[16], k1[16];
#pragma unroll
    for (int i = 0; i < 4; ++i) {
        const int4 a = ((const int4*)l0)[i], b = ((const int4*)l1)[i];
        k0[4 * i] = a.x; k0[4 * i + 1] = a.y; k0[4 * i + 2] = a.z; k0[4 * i + 3] = a.w;
        k1[4 * i] = b.x; k1[4 * i + 1] = b.y; k1[4 * i + 2] = b.z; k1[4 * i + 3] = b.w;
    }
    float v0[16], v1[16];
#pragma unroll
    for (int i = 0; i < 16; ++i) { v0[i] = unsortable(k0[i] & ~127); v1[i] = unsortable(k1[i] & ~127); }
    int lst[16];
#pragma unroll
    for (int k = 0; k < 16; ++k) lst[k] = (int)0x80000000;
#pragma unroll
    for (int a = 0; a < 16; ++a)
#pragma unroll
        for (int b = 0; b < 16; ++b)
            if ((a + 1) * (b + 1) <= 16) insert16(lst, (sortable(v0[a] + v1[b]) & ~255) | (a * 16 + b));
    float val[16], sum = 0.f;
    const float mx = unsortable(lst[0] & ~255);
#pragma unroll
    for (int k = 0; k < 16; ++k) { val[k] = __expf(unsortable(lst[k] & ~255) - mx); sum += val[k]; }
    const float inv = 1.0f / sum;
    int* ei = (int*)(p.ws + OFF_EIDX) + (size_t)tok * 128 + hd * 16;
    float* eg = (float*)(p.ws + OFF_EGATE) + (size_t)tok * 128 + hd * 16;
#pragma unroll
    for (int k = 0; k < 16; ++k) {
        const int code = lst[k] & 255, a = code >> 4, b = code & 15;
        ei[k] = (l0[a] & 127) * 128 + (l1[b] & 127);
        eg[k] = val[k] * inv;
    }
}

__device__ __forceinline__ void conv_row_fp8(const float* __restrict__ src, unsigned char* __restrict__ dst, float* __restrict__ scale, int row, int lane) {
    const float4* s = (const float4*)(src + (size_t)row * 1024 + lane * 16);
    float4 v[4]; float am = 0.f;
#pragma unroll
    for (int i = 0; i < 4; ++i) { v[i] = s[i]; am = fmaxf(am, fmaxf(fmaxf(fabsf(v[i].x), fabsf(v[i].y)), fmaxf(fabsf(v[i].z), fabsf(v[i].w)))); }
#pragma unroll
    for (int o = 32; o >= 1; o >>= 1) am = fmaxf(am, __shfl_xor(am, o));
    const float sc = am > 0.f ? am * (1.0f / 224.0f) : 1.0f, inv = 1.0f / sc;
    unsigned w[4];
#pragma unroll
    for (int i = 0; i < 4; ++i) {
        int t = __builtin_amdgcn_cvt_pk_fp8_f32(v[i].x * inv, v[i].y * inv, 0, false);
        t = __builtin_amdgcn_cvt_pk_fp8_f32(v[i].z * inv, v[i].w * inv, t, true);
        w[i] = (unsigned)t;
    }
    *(uint4*)(dst + (size_t)row * 1024 + lane * 16) = make_uint4(w[0], w[1], w[2], w[3]);
    if (lane == 0) scale[row] = sc;
}
__device__ __forceinline__ void load8rows(uint4 (&R)[8], const unsigned char* __restrict__ tab, int es, int l0, int lane) {
#pragma unroll
    for (int j = 0; j < 8; ++j) {
        const int id = __builtin_amdgcn_readlane(es, l0 + j);
        R[j] = *(const uint4*)(tab + (size_t)id * 1024 + lane * 16);
    }
}
__device__ __forceinline__ float dot16q(const uint4& r, const float (&h)[16]) {
    const unsigned q[4] = {r.x, r.y, r.z, r.w};
    float d0 = 0.f, d1 = 0.f;
#pragma unroll
    for (int i = 0; i < 4; ++i) {
        const f32x2v a = __builtin_amdgcn_cvt_pk_f32_fp8((int)q[i], false), b = __builtin_amdgcn_cvt_pk_f32_fp8((int)q[i], true);
        d0 += a.x * h[4 * i]; d1 += a.y * h[4 * i + 1]; d0 += b.x * h[4 * i + 2]; d1 += b.y * h[4 * i + 3];
    }
    return d0 + d1;
}
__device__ __forceinline__ float dots8(const uint4 (&R)[8], const float (&h)[16], int lane) {
    float pd[8];
#pragma unroll
    for (int j = 0; j < 8; ++j) pd[j] = dot16q(R[j], h);
    const bool b5 = (lane & 32) != 0, b4 = (lane & 16) != 0, b3 = (lane & 8) != 0;
    float a[4];
#pragma unroll
    for (int j = 0; j < 4; ++j) { const float keep = b5 ? pd[4 + j] : pd[j], send = b5 ? pd[j] : pd[4 + j]; a[j] = keep + __shfl_xor(send, 32); }
    float c[2];
#pragma unroll
    for (int j = 0; j < 2; ++j) { const float keep = b4 ? a[2 + j] : a[j], send = b4 ? a[j] : a[2 + j]; c[j] = keep + __shfl_xor(send, 16); }
    float kk;
    { const float keep = b3 ? c[1] : c[0], send = b3 ? c[0] : c[1]; kk = keep + __shfl_xor(send, 8); }
    kk += __shfl_xor(kk, 4); kk += __shfl_xor(kk, 2); kk += __shfl_xor(kk, 1);
    return kk;
}
__device__ __forceinline__ void axpy8(float (&o)[16], const uint4 (&R)[8], int wsr, int bb) {
#pragma unroll
    for (int j = 0; j < 8; ++j) {
        const float c = __int_as_float(__builtin_amdgcn_readlane(wsr, 8 * j + bb));
        const unsigned q[4] = {R[j].x, R[j].y, R[j].z, R[j].w};
#pragma unroll
        for (int i = 0; i < 4; ++i) {
            const f32x2v a = __builtin_amdgcn_cvt_pk_f32_fp8((int)q[i], false), b = __builtin_amdgcn_cvt_pk_f32_fp8((int)q[i], true);
            o[4 * i] += c * a.x; o[4 * i + 1] += c * a.y; o[4 * i + 2] += c * b.x; o[4 * i + 3] += c * b.y;
        }
    }
}
__device__ void gather_token(const Params& p, int tok, int lane) {
    const bf16_t* h2 = (const bf16_t*)(p.ws + OFF_MERGED) + (size_t)tok * 1024 + lane * 16;
    const unsigned char* Uq = p.ws + OFF_UB; const unsigned char* Vq = p.ws + OFF_VB;
    const float* SU = (const float*)(p.ws + OFF_SU); const float* SV = (const float*)(p.ws + OFF_SV);
    const int* ei = (const int*)(p.ws + OFF_EIDX) + (size_t)tok * 128;
    const float* eg = (const float*)(p.ws + OFF_EGATE) + (size_t)tok * 128;
    float h[16];
    {
        const uint4 ha = *(const uint4*)h2, hb = *(const uint4*)(h2 + 8);
        const unsigned hq[8] = {ha.x, ha.y, ha.z, ha.w, hb.x, hb.y, hb.z, hb.w};
#pragma unroll
        for (int e = 0; e < 8; ++e) { h[2 * e] = bflo(hq[e]); h[2 * e + 1] = bfhi(hq[e]); }
    }
    const int pe = 8 * (lane & 7) + (lane >> 3);
    int es[2], wsr[2] = {0, 0}; float su[2], gv[2];
#pragma unroll
    for (int k = 0; k < 2; ++k) {
        es[k] = ei[64 * k + lane];
        const int e = ei[64 * k + pe];
        su[k] = SU[e]; gv[k] = eg[64 * k + pe] * SV[e];
    }
    uint4 R0[8], R1[8];
#pragma unroll
    for (int k = 0; k < 2; ++k) {
        load8rows(R0, Uq, es[k], 0, lane);
        for (int bb = 0; bb < 8; bb += 2) {
            load8rows(R1, Uq, es[k], 8 * bb + 8, lane);
            { const float w = gelu_tanh(dots8(R0, h, lane) * su[k]) * gv[k]; if ((lane & 7) == bb) wsr[k] = __float_as_int(w); }
            if (bb + 2 < 8) load8rows(R0, Uq, es[k], 8 * bb + 16, lane);
            { const float w = gelu_tanh(dots8(R1, h, lane) * su[k]) * gv[k]; if ((lane & 7) == bb + 1) wsr[k] = __float_as_int(w); }
        }
    }
    float o[16];
#pragma unroll
    for (int e = 0; e < 16; ++e) o[e] = 0.f;
#pragma unroll
    for (int k = 0; k < 2; ++k) {
        load8rows(R0, Vq, es[k], 0, lane);
        for (int bb = 0; bb < 8; bb += 2) {
            load8rows(R1, Vq, es[k], 8 * bb + 8, lane);
            axpy8(o, R0, wsr[k], bb);
            if (bb + 2 < 8) load8rows(R0, Vq, es[k], 8 * bb + 16, lane);
            axpy8(o, R1, wsr[k], bb + 1);
        }
    }
    float* xr = p.out + (size_t)tok * 1024 + lane * 16;
    float4 x[4]; float ss = 0.f;
#pragma unroll
    for (int i = 0; i < 4; ++i) {
        x[i] = *(const float4*)(xr + 4 * i);
        x[i].x += o[4 * i]; x[i].y += o[4 * i + 1]; x[i].z += o[4 * i + 2]; x[i].w += o[4 * i + 3];
        ss += x[i].x * x[i].x + x[i].y * x[i].y + x[i].z * x[i].z + x[i].w * x[i].w;
    }
    ss = wave_sum(ss);
    const float rs = rsqrtf(ss * (1.0f / 1024.0f) + EPS);
    const float* gf = p.g_final + lane * 16;
#pragma unroll
    for (int i = 0; i < 4; ++i) {
        const float4 gg = *(const float4*)(gf + 4 * i);
        *(float4*)(xr + 4 * i) = make_float4(x[i].x * rs * gg.x, x[i].y * rs * gg.y, x[i].z * rs * gg.z, x[i].w * rs * gg.w);
    }
}


__device__ __forceinline__ void fp8x16_to_f32(const uint4& r, float (&f)[16]) {
    const unsigned q[4] = {r.x, r.y, r.z, r.w};
#pragma unroll
    for (int i = 0; i < 4; ++i) {
        const f32x2v a = __builtin_amdgcn_cvt_pk_f32_fp8((int)q[i], false), b = __builtin_amdgcn_cvt_pk_f32_fp8((int)q[i], true);
        f[4 * i] = a.x; f[4 * i + 1] = a.y; f[4 * i + 2] = b.x; f[4 * i + 3] = b.y;
    }
}
__device__ void peer_u_stripe(const Params& p, int tok, int x, int lane) {
    const int gq = lane >> 3, sub = lane & 7;
    const int* ei = (const int*)(p.ws + OFF_EIDX) + (size_t)tok * 128;
    const bf16_t* h2 = (const bf16_t*)(p.ws + OFF_MERGED) + (size_t)tok * 1024 + x * 128 + sub * 16;
    const unsigned char* Uq = p.ws + OFF_UB + x * 128 + sub * 16;
    int es[2]; es[0] = ei[lane]; es[1] = ei[64 + lane];
    float h[16];
    {
        const uint4 ha = *(const uint4*)h2, hb = *(const uint4*)(h2 + 8);
        const unsigned hq[8] = {ha.x, ha.y, ha.z, ha.w, hb.x, hb.y, hb.z, hb.w};
#pragma unroll
        for (int e = 0; e < 8; ++e) { h[2 * e] = bflo(hq[e]); h[2 * e + 1] = bfhi(hq[e]); }
    }
    float zr[2] = {0.f, 0.f};
#pragma unroll
    for (int k = 0; k < 2; ++k) {
        u32x4 seg[8];
#pragma unroll
        for (int bb = 0; bb < 8; ++bb) {
            const int id = __shfl(es[k], 8 * bb + gq);
            seg[bb] = *(const u32x4*)(Uq + (size_t)id * 1024);
        }
        PIN8(seg, 0);
#pragma unroll
        for (int bb = 0; bb < 8; ++bb) {
            float f[16];
            fp8x16_to_f32(make_uint4(seg[bb][0], seg[bb][1], seg[bb][2], seg[bb][3]), f);
            float d0 = 0.f, d1 = 0.f;
#pragma unroll
            for (int i = 0; i < 8; ++i) { d0 += f[2 * i] * h[2 * i]; d1 += f[2 * i + 1] * h[2 * i + 1]; }
            float d = d0 + d1;
            d += __shfl_xor(d, 1); d += __shfl_xor(d, 2); d += __shfl_xor(d, 4);
            if (sub == bb) zr[k] = d;
        }
    }
    float* Z = (float*)(p.ws + OFF_ZBUF) + ((size_t)tok * 8 + x) * 128;
    Z[lane] = zr[0]; Z[64 + lane] = zr[1];
}
__device__ void peer_coef_token(const Params& p, int tok, int lane) {
    const int pe = 8 * (lane & 7) + (lane >> 3);
    const int* ei = (const int*)(p.ws + OFF_EIDX) + (size_t)tok * 128;
    const float* eg = (const float*)(p.ws + OFF_EGATE) + (size_t)tok * 128;
    const float* SU = (const float*)(p.ws + OFF_SU); const float* SV = (const float*)(p.ws + OFF_SV);
    const float* Z = (const float*)(p.ws + OFF_ZBUF) + (size_t)tok * 8 * 128;
    float* W = (float*)(p.ws + OFF_WBUF) + (size_t)tok * 128;
#pragma unroll
    for (int k = 0; k < 2; ++k) {
        float zv[8];
#pragma unroll
        for (int x = 0; x < 8; ++x) zv[x] = Z[x * 128 + k * 64 + lane];
        const int e = ei[64 * k + pe];
        const float g = eg[64 * k + pe], su = SU[e], sv = SV[e];
        PIN8(zv, 0);
        const float z = ((zv[0] + zv[1]) + (zv[2] + zv[3])) + ((zv[4] + zv[5]) + (zv[6] + zv[7]));
        W[k * 64 + lane] = gelu_tanh(z * su) * g * sv;
    }
}
__device__ void peer_v_stripe(const Params& p, int tok, int x, int lane) {
    const int gq = lane >> 3, sub = lane & 7;
    const int* ei = (const int*)(p.ws + OFF_EIDX) + (size_t)tok * 128;
    const float* W = (const float*)(p.ws + OFF_WBUF) + (size_t)tok * 128;
    const unsigned char* Vq = p.ws + OFF_VB + x * 128 + sub * 16;
    int es[2]; es[0] = ei[lane]; es[1] = ei[64 + lane];
    float wk[2]; wk[0] = W[lane]; wk[1] = W[64 + lane];
    float o[16];
#pragma unroll
    for (int i = 0; i < 16; ++i) o[i] = 0.f;
#pragma unroll
    for (int k = 0; k < 2; ++k) {
        u32x4 seg[8];
#pragma unroll
        for (int bb = 0; bb < 8; ++bb) {
            const int id = __shfl(es[k], 8 * bb + gq);
            seg[bb] = *(const u32x4*)(Vq + (size_t)id * 1024);
        }
        PIN8(seg, 0);
#pragma unroll
        for (int bb = 0; bb < 8; ++bb) {
            const float c = __shfl(wk[k], 8 * gq + bb);
            float f[16];
            fp8x16_to_f32(make_uint4(seg[bb][0], seg[bb][1], seg[bb][2], seg[bb][3]), f);
#pragma unroll
            for (int i = 0; i < 16; ++i) o[i] += c * f[i];
        }
    }
    const bool b5 = (lane & 32) != 0, b4 = (lane & 16) != 0, b3 = (lane & 8) != 0;
    float a8[8], a4[4], a2[2];
#pragma unroll
    for (int i = 0; i < 8; ++i) { const float keep = b5 ? o[8 + i] : o[i], send = b5 ? o[i] : o[8 + i]; a8[i] = keep + __shfl_xor(send, 32); }
#pragma unroll
    for (int i = 0; i < 4; ++i) { const float keep = b4 ? a8[4 + i] : a8[i], send = b4 ? a8[i] : a8[4 + i]; a4[i] = keep + __shfl_xor(send, 16); }
#pragma unroll
    for (int i = 0; i < 2; ++i) { const float keep = b3 ? a4[2 + i] : a4[i], send = b3 ? a4[i] : a4[2 + i]; a2[i] = keep + __shfl_xor(send, 8); }
    const int col = x * 128 + 16 * sub + (b5 ? 8 : 0) + (b4 ? 4 : 0) + (b3 ? 2 : 0);
    float* xr = p.out + (size_t)tok * 1024 + col;
    float2 xv = *(const float2*)xr;
    xv.x += a2[0]; xv.y += a2[1];
    *(float2*)xr = xv;
    const float ss = wave_sum(xv.x * xv.x + xv.y * xv.y);
    if (lane == 0) atomicAdd((float*)(p.ws + OFF_ROWSS) + tok, ss);
}
__device__ void final_norm_row(const Params& p, int tok, int lane) {
    float* xr = p.out + (size_t)tok * 1024 + lane * 16;
    const float rs = rsqrtf(((const float*)(p.ws + OFF_ROWSS))[tok] * (1.0f / 1024.0f) + EPS);
    const float* gf = p.g_final + lane * 16;
#pragma unroll
    for (int i = 0; i < 4; ++i) {
        const float4 v = *(const float4*)(xr + 4 * i), gg = *(const float4*)(gf + 4 * i);
        *(float4*)(xr + 4 * i) = make_float4(v.x * rs * gg.x, v.y * rs * gg.y, v.z * rs * gg.z, v.w * rs * gg.w);
    }
}

__device__ __forceinline__ bool gemm_unit(int it, int nct, int& rt, int& ct) {
    const int x = blockIdx.x & 7, j = blockIdx.x >> 3, nbx = gridDim.x >> 3;
    const int v = j + it * nbx, per_rg = 8 * nct;
    if (v >= 32 * nct) return false;
    const int rgi = v / per_rg, w = v - rgi * per_rg, cg = w >> 6, w2 = w & 63;
    const int rtl = w2 & 7, ctl = w2 >> 3;
    rt = (rgi * 8 + rtl) * 8 + x; ct = cg * 8 + ctl;
    return true;
}

#define XB_TMO      128
#define XB_XCNT(j)  (256  + 64 * (j))
#define XB_XSUB(j)  (1280 + 64 * (j))
#define XB_XGEN(j)  (2304 + 64 * (j))
#define XB_TOP      3328
#define XB_TOPGEN   3392
#define XCD_BAR_WORDS 3456
#define XB_SPIN_CAP (1u << 22)
#define LAS __attribute__((address_space(3)))
__device__ __forceinline__ unsigned xb_ld(unsigned* p)              { return __hip_atomic_load(p, __ATOMIC_RELAXED, __HIP_MEMORY_SCOPE_AGENT); }
__device__ __forceinline__ unsigned xb_add(unsigned* p, unsigned v) { return __hip_atomic_fetch_add(p, v, __ATOMIC_RELAXED, __HIP_MEMORY_SCOPE_AGENT); }
__device__ __forceinline__ unsigned xb_xcc_id() { return (unsigned)__builtin_amdgcn_s_getreg((3 << 11) | 20) & 0xFu; }
#define XB_SPIN(cond, bar) do { unsigned _sp = 0; while (cond) { __builtin_amdgcn_s_sleep(1); \
    if ((++_sp & 255u) == 0u) { if (xb_ld(&(bar)[XB_TMO])) break; if (_sp > XB_SPIN_CAP) { atomicAdd(&(bar)[XB_TMO], 1u); break; } } } } while (0)
struct XcdBarrier { unsigned* bar; unsigned x; volatile LAS unsigned* st; };
__device__ __forceinline__ XcdBarrier xcd_barrier_post(unsigned* bar, volatile LAS unsigned* st) {
    XcdBarrier b; b.bar = bar; b.x = xb_xcc_id(); b.st = st;
    if (threadIdx.x == 0) (void)xb_add(&bar[XB_XCNT(b.x)], 1u);
    return b;
}
__device__ __forceinline__ void xcd_barrier_complete(unsigned* bar, unsigned x, unsigned& nloc, unsigned& nx) {
    const unsigned G = gridDim.x;
    unsigned sum, cnt, mine, sp = 0u;
    for (;;) {
        sum = 0u; cnt = 0u; mine = 0u;
#pragma unroll
        for (unsigned j = 0; j < 16; ++j) { const unsigned c = xb_ld(&bar[XB_XCNT(j)]); sum += c; cnt += (c > 0u) ? 1u : 0u; mine = (j == x) ? c : mine; }
        if (sum == G) break;
        __builtin_amdgcn_s_sleep(1);
        if ((++sp & 255u) == 0u) { if (xb_ld(&bar[XB_TMO])) break; if (sp > XB_SPIN_CAP) { atomicAdd(&bar[XB_TMO], 1u); break; } }
    }
    nloc = mine > 0u ? mine : 1u; nx = cnt > 0u ? cnt : 1u;
}
__device__ __forceinline__ void xcd_barrier(const XcdBarrier& b) {
    asm volatile("s_waitcnt vmcnt(0)" ::: "memory");
    __syncthreads();
    if (threadIdx.x == 0) {
        unsigned* bar = b.bar;
        __builtin_amdgcn_s_waitcnt(0);
        unsigned nloc = b.st[0], nx = b.st[1];
        if (nloc == 0u) { xcd_barrier_complete(bar, b.x, nloc, nx); b.st[0] = nloc; b.st[1] = nx; }
        const unsigned old = xb_add(&bar[XB_XSUB(b.x)], 1u);
        const unsigned gen = old / nloc;
        if (old + 1u == (gen + 1u) * nloc) {
            __builtin_amdgcn_fence(__ATOMIC_RELEASE, "agent");
            asm volatile("s_waitcnt vmcnt(0)" ::: "memory");
            const unsigned og = xb_add(&bar[XB_TOP], 1u);
            const unsigned tg = og / nx;
            if (og + 1u == (tg + 1u) * nx) xb_add(&bar[XB_TOPGEN], 1u);
            else XB_SPIN(xb_ld(&bar[XB_TOPGEN]) == tg, bar);
            __builtin_amdgcn_fence(__ATOMIC_ACQUIRE, "agent");
            xb_add(&bar[XB_XGEN(b.x)], 1u);
            asm volatile("s_waitcnt vmcnt(0)" ::: "memory");
        } else {
            XB_SPIN(xb_ld(&bar[XB_XGEN(b.x)]) == gen, bar);
            __builtin_amdgcn_fence(__ATOMIC_ACQUIRE, "agent");
            asm volatile("s_waitcnt vmcnt(0)" ::: "memory");
        }
    }
    __syncthreads();
}

#ifndef PROBE_PHASE
#define PROBE_PHASE -1
#endif
#define PH_BEGIN(k) if (PROBE_PHASE == (k)) probe_t0 = __builtin_amdgcn_s_memrealtime();
#define PH_END(k)   if (PROBE_PHASE == (k)) probe_dt = __builtin_amdgcn_s_memrealtime() - probe_t0;
constexpr int SMEM_BYTES = 128 * 132 * 4 + 1024;

__global__ void __launch_bounds__(256, 2) fwd_megakernel(Params p) {
    __shared__ __attribute__((aligned(16))) unsigned char smem[SMEM_BYTES + 16];
    if (threadIdx.x == 0) *(uint4*)(smem + SMEM_BYTES) = make_uint4(0u, 0u, 0u, 0u);
    __syncthreads();
    const XcdBarrier xb = xcd_barrier_post((unsigned*)(p.ws + OFF_BAR), (volatile LAS unsigned*)(smem + SMEM_BYTES));
    const int bid = blockIdx.x, nb = gridDim.x, tid = tidx(), lane = tid & 63, wid = tid >> 6;
    unsigned char* ws = p.ws; unsigned char* dob = (unsigned char*)p.out;
    unsigned long long probe_t0 = 0, probe_dt = 0;
    PH_BEGIN(0)
    {
        for (int u = bid; u < 3232; u += nb) {
            if (u < 1600) convT_tile(p.w_in, (bf16_t*)(ws + OFF_WINT), 1024, INW, u, smem);
            else if (u < 1856) convT_tile(p.w_mem_kv, (bf16_t*)(ws + OFF_WMKVT), 1024, 1024, u - 1600, smem);
            else if (u < 2048) convT_tile(p.p_attn, (bf16_t*)(ws + OFF_PATTNT), 768, 1024, u - 1856, smem);
            else if (u < 2240) convT_tile(p.p_lru, (bf16_t*)(ws + OFF_PLRUT), 768, 1024, u - 2048, smem);
            else if (u < 2368) convT_tile(p.p_mem, (bf16_t*)(ws + OFF_PMEMT), 512, 1024, u - 2240, smem);
            else if (u < 2624) convT_tile(p.w_out, (bf16_t*)(ws + OFF_WOUTT), 1024, 1024, u - 2368, smem);
            else if (u < 3136) convT_tile(p.w_peer_q, (bf16_t*)(ws + OFF_WPQT), 1024, 2048, u - 2624, smem);
            else {
                const int v = u - 3136, mat = v >> 2, tile = v & 3, gsel = mat / 6, h = mat % 6, dir = gsel & 1;
                const float* src = (gsel < 2 ? p.lru_wr : p.lru_wi) + (size_t)(dir * 6 + h) * 128 * 128;
                convT_tile(src, (bf16_t*)(ws + OFF_LRUWT) + (size_t)(h * 512 + gsel * 128) * 128, 128, 128, tile, smem);
            }
        }
        conv_plain(p.peer_sub_keys, (bf16_t*)(ws + OFF_SUBK), (size_t)16 * 128 * 128 / 8);
        for (int r = bid * 4 + wid; r < 2 * NEXP; r += nb * 4) {
            if (r < NEXP) conv_row_fp8(p.peer_u, ws + OFF_UB, (float*)(ws + OFF_SU), r, lane);
            else conv_row_fp8(p.peer_v, ws + OFF_VB, (float*)(ws + OFF_SV), r - NEXP, lane);
        }
        for (int r = bid * 4 + wid; r < NTOK; r += nb * 4) rms_row_bf16(p.x + (size_t)r * 1024, p.g_mix, (bf16_t*)(dob + DO_HBF) + (size_t)r * 1024, lane);
        for (int r = bid * 4 + wid; r < NMEM; r += nb * 4) rms_row_bf16(p.mem + (size_t)r * 1024, p.g_mem, (bf16_t*)(dob + DO_MEMBF) + (size_t)r * 1024, lane);
        for (int i = bid * 256 + tid; i < NTOK * 16; i += nb * 256) rope_item(p.positions, (float*)(dob + DO_ROPE), i);
        for (int i = bid * 256 + tid; i < NTOK; i += nb * 256) ((float*)(ws + OFF_ROWSS))[i] = 0.f;
        for (int i = bid * 256 + tid; i < 2 * LW; i += nb * 256) ((float*)(ws + OFF_SP8))[i] = -8.0f * 1.4426950408889634f * log1pf(__expf(-p.lru_lambda[i]));
    }
    xcd_barrier(xb);
    PH_END(0) PH_BEGIN(1)
    for (int u = bid; u < 256; u += nb) memkv_tile(p, u / 8, u % 8, smem);
    { GemmPipe pp{0, false}; int rt, ct, nrt = 0, nct = 0; bool have = gemm_unit(0, 50, rt, ct); __syncthreads();
      for (int it = 0; have; ++it) { const bool hn = gemm_unit(it + 1, 50, nrt, nct); inproj_tile(p, rt, ct, smem, pp, hn, nrt, nct); rt = nrt; ct = nct; have = hn; } }
    xcd_barrier(xb);
    PH_END(1) PH_BEGIN(2)
    {
        unsigned* ctr = (unsigned*)(p.ws + OFF_BAR) + 3600;
        volatile LAS unsigned* slot = (volatile LAS unsigned*)(smem + SMEM_BYTES + 8);
        for (;;) {
            if (tid == 0) *slot = xb_add(ctr, 1u);
            __syncthreads();
            const int u = (int)*slot;
            __syncthreads();
            if (u >= 1536 + 1536 + 1024) break;
            if (u < 1536) lru_chunk_unit<false>(p, u, smem);
            else if (u < 1536 + 1536) attn_win_unit(p, u - 1536, smem);
            else attn_mem_unit(p, u - 1536 - 1536, smem);
        }
    }
    xcd_barrier(xb);
    for (int u = bid; u < 1536; u += nb) lru_chunk_unit<true>(p, u, smem);
    xcd_barrier(xb);
    PH_END(2) PH_BEGIN(3)
    { GemmPipe pp{0, false}; int rt, ct, nrt = 0, nct = 0; bool have = gemm_unit(0, 8, rt, ct); __syncthreads();
      for (int it = 0; have; ++it) { const bool hn = gemm_unit(it + 1, 8, nrt, nct); merge_tile(p, rt, ct, smem, pp, hn, nrt, nct); rt = nrt; ct = nct; have = hn; } }
    xcd_barrier(xb);
    PH_END(3) PH_BEGIN(4)
    { GemmPipe pp{0, false}; int rt, ct, nrt = 0, nct = 0; bool have = gemm_unit(0, 8, rt, ct); __syncthreads();
      for (int it = 0; have; ++it) { const bool hn = gemm_unit(it + 1, 8, nrt, nct); outproj_tile(p, rt, ct, smem, pp, hn, nrt, nct); rt = nrt; ct = nct; have = hn; } }
    xcd_barrier(xb);
    PH_END(4) PH_BEGIN(5)
    for (int r = bid * 4 + wid; r < NTOK; r += nb * 4) rms_row_bf16(p.out + (size_t)r * 1024, p.g_ffn, (bf16_t*)(ws + OFF_MERGED) + (size_t)r * 1024, lane);
    xcd_barrier(xb);
    PH_END(5) PH_BEGIN(6)
    { GemmPipe pp{0, false}; int rt, ct, nrt = 0, nct = 0; bool have = gemm_unit(0, 16, rt, ct); __syncthreads();
      for (int it = 0; have; ++it) { const bool hn = gemm_unit(it + 1, 16, nrt, nct); peerq_tile(p, rt, ct, smem, pp, hn, nrt, nct); rt = nrt; ct = nct; have = hn; } }
    xcd_barrier(xb);
    PH_END(6) PH_BEGIN(7)
    for (int u = bid; u < 256 * 16; u += nb) scores_tile(p, u / 16, u % 16, smem);
    xcd_barrier(xb);
    PH_END(7) PH_BEGIN(8)
    for (int i = bid * 256 + tid; i < NTOK * 8; i += nb * 256) combine_item(p, i);
    xcd_barrier(xb);
    PH_END(8) PH_BEGIN(9)
    {
        const int x = bid & 7, tstep = (nb >> 3) * 4;
        for (int t = (bid >> 3) * 4 + wid; t < NTOK; t += tstep) peer_u_stripe(p, t, x, lane);
        xcd_barrier(xb);
        for (int t = bid * 4 + wid; t < NTOK; t += nb * 4) peer_coef_token(p, t, lane);
        xcd_barrier(xb);
        for (int t = (bid >> 3) * 4 + wid; t < NTOK; t += tstep) peer_v_stripe(p, t, x, lane);
        xcd_barrier(xb);
        for (int t = bid * 4 + wid; t < NTOK; t += nb * 4) final_norm_row(p, t, lane);
    }
    PH_END(9)
    if (PROBE_PHASE >= 0) { __syncthreads(); const unsigned long long t1 = __builtin_amdgcn_s_memrealtime(); while (__builtin_amdgcn_s_memrealtime() - t1 < probe_dt) __builtin_amdgcn_s_sleep(8); }
}

extern "C" void kernel_launch(void* const* d_in, const int* in_sizes, int n_in, void* d_out, int out_size, void* d_ws, size_t ws_size, hipStream_t stream) {
    if (ws_size < OFF_END) { fprintf(stderr, "workspace too small: %zu < %zu\n", ws_size, (size_t)OFF_END); return; }
    Params p{};
    p.x = (const float*)d_in[0]; p.mem = (const float*)d_in[1]; p.positions = (const int*)d_in[2];
    p.g_mix = (const float*)d_in[3]; p.g_mem = (const float*)d_in[4]; p.w_in = (const float*)d_in[5]; p.gate_b = (const float*)d_in[6];
    p.attn_sink = (const float*)d_in[7]; p.conv_w = (const float*)d_in[8]; p.conv_b = (const float*)d_in[9];
    p.lru_wr = (const float*)d_in[10]; p.lru_br = (const float*)d_in[11]; p.lru_wi = (const float*)d_in[12]; p.lru_bi = (const float*)d_in[13];
    p.lru_lambda = (const float*)d_in[14]; p.w_mem_kv = (const float*)d_in[15]; p.p_attn = (const float*)d_in[16]; p.p_lru = (const float*)d_in[17];
    p.p_mem = (const float*)d_in[18]; p.w_out = (const float*)d_in[19]; p.g_ffn = (const float*)d_in[20]; p.w_peer_q = (const float*)d_in[21];
    p.peer_sub_keys = (const float*)d_in[22]; p.peer_u = (const float*)d_in[23]; p.peer_v = (const float*)d_in[24]; p.g_final = (const float*)d_in[25];
    p.out = (float*)d_out; p.ws = (unsigned char*)d_ws;
    static int grid_blocks = 0;
    if (!grid_blocks) {
        int dev = 0, cus = 0, per_cu = 0;
        (void)hipGetDevice(&dev);
        (void)hipDeviceGetAttribute(&cus, hipDeviceAttributeMultiprocessorCount, dev);
        (void)hipOccupancyMaxActiveBlocksPerMultiprocessor(&per_cu, fwd_megakernel, 256, 0);
        if (per_cu > 2) per_cu = 2;
        grid_blocks = cus * per_cu;
    }
    (void)hipMemsetAsync((unsigned char*)d_ws + OFF_BAR, 0, 16384, stream);
    void* args[] = {&p};
    hipError_t e = hipLaunchCooperativeKernel((void*)fwd_megakernel, dim3(grid_blocks), dim3(256), args, 0, stream);
    if (e != hipSuccess) fprintf(stderr, "cooperative launch failed: %s (grid %d)\n", hipGetErrorString(e), grid_blocks);
}
```

```cpp
#include <hip/hip_runtime.h>
#include <stdint.h>
#include <stdio.h>

typedef unsigned short bf16_t;
typedef short bf16x8 __attribute__((ext_vector_type(8)));
typedef __bf16 bf16x2v __attribute__((ext_vector_type(2)));
typedef float f32x4 __attribute__((ext_vector_type(4)));

constexpr int B_ = 16, S_ = 2048, D_ = 1024, NTOK = B_ * S_;
constexpr int MEML = 256, NMEM = B_ * MEML;
constexpr int INW = 6400;
constexpr int LW = 768;
constexpr int NEXP = 16384;
constexpr float EPS = 1e-6f;
constexpr float QSCALE = 0.08838834764831845f * 1.4426950408889634f;

constexpr size_t OFF_WINT = 0;
constexpr size_t OFF_WMKVT = OFF_WINT + (size_t)INW * 1024 * 2;
constexpr size_t OFF_PATTNT = OFF_WMKVT + (size_t)1024 * 1024 * 2;
constexpr size_t OFF_PLRUT = OFF_PATTNT + (size_t)1024 * 768 * 2;
constexpr size_t OFF_PMEMT = OFF_PLRUT + (size_t)1024 * 768 * 2;
constexpr size_t OFF_WOUTT = OFF_PMEMT + (size_t)1024 * 512 * 2;
constexpr size_t OFF_WPQT = OFF_WOUTT + (size_t)1024 * 1024 * 2;
constexpr size_t OFF_LRUWT = OFF_WPQT + (size_t)2048 * 1024 * 2;
constexpr size_t OFF_SUBK = OFF_LRUWT + (size_t)6 * 512 * 128 * 2;
constexpr size_t OFF_UB = OFF_SUBK + (size_t)16 * 128 * 128 * 2;
constexpr size_t OFF_VB = OFF_UB + (size_t)NEXP * 1024;
constexpr size_t OFF_SU = OFF_VB + (size_t)NEXP * 1024;
constexpr size_t OFF_SV = OFF_SU + (size_t)NEXP * 4;
constexpr size_t OFF_RA = OFF_SV + (size_t)NEXP * 4;
constexpr size_t OFF_QA = OFF_RA;
constexpr size_t OFF_KA = OFF_QA + (size_t)NTOK * 768 * 2;
constexpr size_t OFF_VAT = OFF_KA + (size_t)NTOK * 256 * 2;
constexpr size_t OFF_XL = OFF_VAT + (size_t)NTOK * 256 * 2;
constexpr size_t OFF_GL = OFF_XL + (size_t)NTOK * 768 * 2;
constexpr size_t OFF_QM = OFF_GL + (size_t)NTOK * 768 * 2;
constexpr size_t OFF_GATES = OFF_QM + (size_t)NTOK * 512 * 2;
constexpr size_t OFF_BAR = OFF_GATES + (size_t)NTOK * 3072 * 2;
constexpr size_t OFF_SP8 = OFF_BAR + 16384;
constexpr size_t OFF_AGG = OFF_SP8 + 2 * 768 * 4;
constexpr size_t OFF_ROWSS = OFF_AGG + (size_t)2 * B_ * 16 * 768 * 8;
constexpr size_t OFF_END = OFF_ROWSS + (size_t)NTOK * 4;
constexpr size_t OFF_MERGED = OFF_KA;
constexpr size_t OFF_QPEER = OFF_GATES;
constexpr size_t OFF_TOPL = OFF_QPEER + (size_t)NTOK * 2048 * 2;
constexpr size_t OFF_EIDX = OFF_TOPL + (size_t)NTOK * 256 * 4;
constexpr size_t OFF_ZBUF = OFF_QPEER;
constexpr size_t OFF_WBUF = OFF_TOPL;
constexpr size_t OFF_EGATE = OFF_EIDX + (size_t)NTOK * 128 * 4;
static_assert(OFF_EGATE + (size_t)NTOK * 128 * 4 <= OFF_BAR, "overlay");
static_assert(OFF_MERGED + (size_t)NTOK * 1024 * 2 <= OFF_GL, "overlay2");
constexpr size_t DO_HBF = 0;
constexpr size_t DO_MEMBF = DO_HBF + (size_t)NTOK * 1024 * 2;
constexpr size_t DO_KM = DO_MEMBF + (size_t)NMEM * 1024 * 2;
constexpr size_t DO_VMT = DO_KM + (size_t)NMEM * 512 * 2;
constexpr size_t DO_ROPE = DO_VMT + (size_t)NMEM * 512 * 2;
static_assert(DO_ROPE + (size_t)NTOK * 32 * 4 <= (size_t)NTOK * 1024 * 4, "d_out scratch");

struct Params {
    const float *x, *mem; const int* positions;
    const float *g_mix, *g_mem, *w_in, *gate_b, *attn_sink, *conv_w, *conv_b, *lru_wr, *lru_br, *lru_wi, *lru_bi, *lru_lambda,
        *w_mem_kv, *p_attn, *p_lru, *p_mem, *w_out, *g_ffn, *w_peer_q, *peer_sub_keys, *peer_u, *peer_v, *g_final;
    float* out; unsigned char* ws;
};

__device__ __forceinline__ int tidx() { int t = threadIdx.x; asm volatile("" : "+v"(t)); return t; }
__device__ __forceinline__ float bf2f(bf16_t b) { return __uint_as_float(((unsigned)b) << 16); }
__device__ __forceinline__ float bflo(unsigned u) { return __uint_as_float(u << 16); }
__device__ __forceinline__ float bfhi(unsigned u) { return __uint_as_float(u & 0xffff0000u); }
typedef float f32x2v __attribute__((ext_vector_type(2)));
__device__ __forceinline__ unsigned pack_bf16(float lo, float hi) { const f32x2v f = {lo, hi}; return __builtin_bit_cast(unsigned, __builtin_convertvector(f, bf16x2v)); }
__device__ __forceinline__ bf16_t f2bf(float f) { return (bf16_t)(pack_bf16(f, 0.f) & 0xffffu); }
__device__ __forceinline__ f32x4 mfma16(bf16x8 a, bf16x8 b, f32x4 c) { return __builtin_amdgcn_mfma_f32_16x16x32_bf16(a, b, c, 0, 0, 0); }
__device__ __forceinline__ float sigmoidf_(float x) { return __builtin_amdgcn_rcpf(1.0f + __expf(-x)); }
__device__ __forceinline__ float gelu_tanh(float x) { const float u = 1.5957691216057308f * (x + 0.044715f * x * x * x); return x * __builtin_amdgcn_rcpf(1.0f + __expf(-u)); }
__device__ __forceinline__ float wave_sum(float v) {
#pragma unroll
    for (int o = 32; o >= 1; o >>= 1) v += __shfl_xor(v, o);
    return v;
}


typedef unsigned u32x4 __attribute__((ext_vector_type(4)));
#define PIN4(a, o) asm volatile("" : "+v"((a)[(o)]), "+v"((a)[(o) + 1]), "+v"((a)[(o) + 2]), "+v"((a)[(o) + 3]))
#define PIN8(a, o) asm volatile("" : "+v"((a)[(o)]), "+v"((a)[(o) + 1]), "+v"((a)[(o) + 2]), "+v"((a)[(o) + 3]), "+v"((a)[(o) + 4]), "+v"((a)[(o) + 5]), "+v"((a)[(o) + 6]), "+v"((a)[(o) + 7]))
#define PIN15(a, o) asm volatile("" : "+v"((a)[(o)]), "+v"((a)[(o) + 1]), "+v"((a)[(o) + 2]), "+v"((a)[(o) + 3]), "+v"((a)[(o) + 4]), "+v"((a)[(o) + 5]), "+v"((a)[(o) + 6]), "+v"((a)[(o) + 7]), \
    "+v"((a)[(o) + 8]), "+v"((a)[(o) + 9]), "+v"((a)[(o) + 10]), "+v"((a)[(o) + 11]), "+v"((a)[(o) + 12]), "+v"((a)[(o) + 13]), "+v"((a)[(o) + 14]))

__device__ void convT_tile(const float* __restrict__ src, bf16_t* __restrict__ dst, int K, int N, int tile, unsigned char* smem) {
    float* t = (float*)smem;
    const int tn = N / 64, tk = tile / tn, tnn = tile % tn, k0 = tk * 64, n0 = tnn * 64, tid = tidx();
    const int r = tid >> 4, c4 = (tid & 15) * 4;
#pragma unroll
    for (int i = 0; i < 4; ++i) {
        const int k = r + 16 * i;
        const float4 v = *(const float4*)(src + (size_t)(k0 + k) * N + n0 + c4);
        t[k * 65 + c4 + 0] = v.x; t[k * 65 + c4 + 1] = v.y; t[k * 65 + c4 + 2] = v.z; t[k * 65 + c4 + 3] = v.w;
    }
    __syncthreads();
    const int n = tid >> 2, kq = (tid & 3) * 16;
    unsigned w[8];
#pragma unroll
    for (int i = 0; i < 8; ++i) w[i] = pack_bf16(t[(kq + 2 * i) * 65 + n], t[(kq + 2 * i + 1) * 65 + n]);
    uint4* d = (uint4*)(dst + (size_t)(n0 + n) * K + k0 + kq);
    d[0] = make_uint4(w[0], w[1], w[2], w[3]); d[1] = make_uint4(w[4], w[5], w[6], w[7]);
    __syncthreads();
}


__device__ __forceinline__ void rms_row_bf16(const float* __restrict__ xr, const float* __restrict__ g, bf16_t* __restrict__ o, int lane) {
    float4 v[4]; float ss = 0.f;
#pragma unroll
    for (int i = 0; i < 4; ++i) { v[i] = *(const float4*)(xr + i * 256 + lane * 4); ss += v[i].x * v[i].x + v[i].y * v[i].y + v[i].z * v[i].z + v[i].w * v[i].w; }
    ss = wave_sum(ss);
    const float rs = rsqrtf(ss * (1.0f / 1024.0f) + EPS);
#pragma unroll
    for (int i = 0; i < 4; ++i) {
        const float4 gg = *(const float4*)(g + i * 256 + lane * 4);
        *(uint2*)(o + i * 256 + lane * 4) = make_uint2(pack_bf16(v[i].x * rs * gg.x, v[i].y * rs * gg.y), pack_bf16(v[i].z * rs * gg.z, v[i].w * rs * gg.w));
    }
}


__device__ __forceinline__ void conv_plain(const float* __restrict__ src, bf16_t* __restrict__ dst, size_t n8) {
    for (size_t i = (size_t)blockIdx.x * 256 + tidx(); i < n8; i += (size_t)gridDim.x * 256) {
        const float4 a = ((const float4*)src)[2 * i], b = ((const float4*)src)[2 * i + 1];
        ((uint4*)dst)[i] = make_uint4(pack_bf16(a.x, a.y), pack_bf16(a.z, a.w), pack_bf16(b.x, b.y), pack_bf16(b.z, b.w));
    }
}
__device__ __forceinline__ void rope_item(const int* __restrict__ pos, float* __restrict__ cs, int i) {
    const int t = i >> 4, f = i & 15;
    const float inv = powf(500000.0f, -(float)(2 * f) / 32.0f);
    const float ang = (float)pos[t] * inv;
    float s, c; sincosf(ang, &s, &c);
    cs[2 * i] = c; cs[2 * i + 1] = s;
}

__device__ __forceinline__ int swz(int row) { return (row & 3) | (((row >> 3) & 1) << 2); }

struct GemmOp { const bf16_t* A; const bf16_t* Bt; int lda, ldb; };
struct GemmPipe { int par; bool pre; };

__device__ __forceinline__ void gemm_issue(const GemmOp& op, int kt, int st, unsigned char* smem) {
    const int tid = tidx();
    const int srow = tid >> 3, skc = (tid & 7) ^ swz(tid >> 3);
    const bf16_t* ga = op.A + (size_t)srow * op.lda + skc * 8 + kt * 64;
    const bf16_t* gb = op.Bt + (size_t)srow * op.ldb + skc * 8 + kt * 64;
    unsigned char* sw = smem + tid * 16 + st * 32768;
#pragma unroll
    for (int i = 0; i < 4; ++i) {
        __builtin_amdgcn_global_load_lds((const unsigned*)(ga + (size_t)(32 * i) * op.lda), (unsigned*)(sw + i * 4096), 16, 0, 0);
        __builtin_amdgcn_global_load_lds((const unsigned*)(gb + (size_t)(32 * i) * op.ldb), (unsigned*)(sw + 16384 + i * 4096), 16, 0, 0);
    }
}
__device__ __forceinline__ void gemm_prefetch(const GemmOp& nx, unsigned char* smem, GemmPipe& pp) { gemm_issue(nx, 0, pp.par, smem); pp.pre = true; }

__device__ __forceinline__ void gemm_tile(const GemmOp& op, int K, f32x4 (&acc)[4][4], unsigned char* smem, GemmPipe& pp) {
    const int tid = tidx(), lane = tid & 63, wid = tid >> 6, wr = wid >> 1, wc = wid & 1, li = lane & 15, g = lane >> 4;
    int aoff[4], boff[4], asw[4], bsw[4];
#pragma unroll
    for (int m = 0; m < 4; ++m) { const int row = wr * 64 + m * 16 + li; aoff[m] = row * 128; asw[m] = swz(row); }
#pragma unroll
    for (int n = 0; n < 4; ++n) { const int row = wc * 64 + 32 * (n >> 1) + 8 * (li >> 2) + 4 * (n & 1) + (li & 3); boff[n] = 16384 + row * 128; bsw[n] = swz(row); }
    const int nk = K >> 6;
    if (!pp.pre) gemm_issue(op, 0, pp.par, smem);
    __syncthreads();
    for (int kt = 0; kt < nk; ++kt) {
        const int cur = (pp.par + kt) & 1;
        const unsigned char* sb = smem + cur * 32768;
        if (kt + 1 < nk) gemm_issue(op, kt + 1, cur ^ 1, smem);
#pragma unroll
        for (int ks = 0; ks < 2; ++ks) {
            bf16x8 af[4], bfr[4];
#pragma unroll
            for (int m = 0; m < 4; ++m) af[m] = *(const bf16x8*)(sb + aoff[m] + (((ks * 4 + g) ^ asw[m]) << 4));
#pragma unroll
            for (int n = 0; n < 4; ++n) bfr[n] = *(const bf16x8*)(sb + boff[n] + (((ks * 4 + g) ^ bsw[n]) << 4));
#pragma unroll
            for (int m = 0; m < 4; ++m)
#pragma unroll
                for (int n = 0; n < 4; ++n) acc[m][n] = mfma16(bfr[n], af[m], acc[m][n]);
        }
        if (kt + 1 < nk) __syncthreads();
    }
    pp.par = (pp.par + nk) & 1; pp.pre = false;
}
__device__ __forceinline__ void acc_zero(f32x4 (&acc)[4][4]) {
#pragma unroll
    for (int m = 0; m < 4; ++m)
#pragma unroll
        for (int n = 0; n < 4; ++n) acc[m][n] = (f32x4){0.f, 0.f, 0.f, 0.f};
}
template <class F> __device__ __forceinline__ void epi_foreach(const f32x4 (&acc)[4][4], F&& f) {
    const int lane = tidx() & 63, wid = tidx() >> 6, wr = wid >> 1, wc = wid & 1, li = lane & 15, g = lane >> 4;
#pragma unroll
    for (int m = 0; m < 4; ++m)
#pragma unroll
        for (int pp = 0; pp < 2; ++pp) {
            float v[8];
#pragma unroll
            for (int r = 0; r < 4; ++r) { v[r] = acc[m][2 * pp][r]; v[4 + r] = acc[m][2 * pp + 1][r]; }
            f(wr * 64 + m * 16 + li, wc * 64 + 32 * pp + 8 * g, v, pp, m);
        }
}
__device__ __forceinline__ void store_bf16x8(bf16_t* p, const float (&v)[8]) {
    *(uint4*)p = make_uint4(pack_bf16(v[0], v[1]), pack_bf16(v[2], v[3]), pack_bf16(v[4], v[5]), pack_bf16(v[6], v[7]));
}
__device__ __forceinline__ void store_tile_T(const f32x4 (&acc)[4][4], bf16_t* __restrict__ dstT, int ldt, unsigned char* smem) {
    bf16_t* t = (bf16_t*)smem;
    __syncthreads();
    epi_foreach(acc, [&](int r, int c, const float (&v)[8], int, int) {
#pragma unroll
        for (int e = 0; e < 8; ++e) t[(c + e) * 136 + r] = f2bf(v[e]);
    });
    __syncthreads();
#pragma unroll
    for (int i = 0; i < 8; ++i) {
        const int ch = tidx() + 256 * i, d = ch >> 4, tc = ch & 15;
        *(uint4*)(dstT + (size_t)d * ldt + tc * 8) = *(const uint4*)(smem + d * 272 + tc * 16);
    }
    __syncthreads();
}

__device__ void inproj_tile(const Params& p, int rt, int ct, unsigned char* smem, GemmPipe& pp, bool hn, int nrt, int nct) {
    unsigned char* ws = p.ws; unsigned char* dob = (unsigned char*)p.out;
    const bf16_t* hbf = (const bf16_t*)(dob + DO_HBF);
    const bf16_t* WinT = (const bf16_t*)(ws + OFF_WINT);
    f32x4 acc[4][4]; acc_zero(acc);
    const GemmOp op{hbf + (size_t)rt * 128 * 1024, WinT + (size_t)ct * 128 * 1024, 1024, 1024};
    const GemmOp nx{hbf + (size_t)nrt * 128 * 1024, WinT + (size_t)nct * 128 * 1024, 1024, 1024};
    gemm_tile(op, 1024, acc, smem, pp);
    const int row0 = rt * 128;
    if (ct < 8) {
        const float* cs = (const float*)(dob + DO_ROPE);
        const bool isq = ct < 6;
        bf16_t* dst = isq ? (bf16_t*)(ws + OFF_QA) + ct * 128 : (bf16_t*)(ws + OFF_KA) + (ct - 6) * 128;
        const int ld = isq ? 768 : 256;
        const float sc = isq ? QSCALE : 1.0f;
        const int lane_ = tidx() & 63, g = lane_ >> 4, wid_ = tidx() >> 6;
        f32x4 csv[16];
        if ((wid_ & 1) == 0) {
#pragma unroll
            for (int m = 0; m < 4; ++m) {
                const f32x4* csr = (const f32x4*)(cs + (size_t)(row0 + (wid_ >> 1) * 64 + m * 16 + (lane_ & 15)) * 32 + (g & 1) * 16);
#pragma unroll
                for (int q = 0; q < 4; ++q) csv[m * 4 + q] = csr[q];
            }
            PIN8(csv, 0); PIN8(csv, 8);
        }
        if (hn) gemm_prefetch(nx, smem, pp);
        epi_foreach(acc, [&](int r, int c, float (&v)[8], int pq, int mq) {
            const int tok = row0 + r;
            if (pq == 0 && c < 32) {
                const f32x4 c0 = csv[mq * 4], c1 = csv[mq * 4 + 1], c2 = csv[mq * 4 + 2], c3 = csv[mq * 4 + 3];
                const float ccv[8] = {c0[0], c0[2], c1[0], c1[2], c2[0], c2[2], c3[0], c3[2]};
                const float ssv[8] = {c0[1], c0[3], c1[1], c1[3], c2[1], c2[3], c3[1], c3[3]};
#pragma unroll
                for (int e = 0; e < 8; ++e) {
                    const float o = __shfl_xor(v[e], 32);
                    v[e] = (g < 2) ? (v[e] * ccv[e] - o * ssv[e]) : (v[e] * ccv[e] + o * ssv[e]);
                }
            }
#pragma unroll
            for (int e = 0; e < 8; ++e) v[e] *= sc;
            store_bf16x8(dst + (size_t)tok * ld + c, v);
        });
    } else if (ct < 10) {
        const int kvh = ct - 8, b = row0 / S_, s0 = row0 % S_;
        store_tile_T(acc, (bf16_t*)(ws + OFF_VAT) + (size_t)(b * 2 + kvh) * 128 * S_ + s0, S_, smem);
    } else if (ct < 16) {
        if (hn) gemm_prefetch(nx, smem, pp);
        bf16_t* dst = (bf16_t*)(ws + OFF_XL) + (ct - 10) * 128;
        epi_foreach(acc, [&](int r, int c, float (&v)[8], int, int) { store_bf16x8(dst + (size_t)(row0 + r) * 768 + c, v); });
    } else if (ct < 22) {
        if (hn) gemm_prefetch(nx, smem, pp);
        bf16_t* dst = (bf16_t*)(ws + OFF_GL) + (ct - 16) * 128;
        epi_foreach(acc, [&](int r, int c, float (&v)[8], int, int) {
#pragma unroll
            for (int e = 0; e < 8; ++e) v[e] = gelu_tanh(v[e]);
            store_bf16x8(dst + (size_t)(row0 + r) * 768 + c, v); });
    } else if (ct < 26) {
        if (hn) gemm_prefetch(nx, smem, pp);
        bf16_t* dst = (bf16_t*)(ws + OFF_QM) + (ct - 22) * 128;
        epi_foreach(acc, [&](int r, int c, float (&v)[8], int, int) {
#pragma unroll
            for (int e = 0; e < 8; ++e) v[e] *= QSCALE;
            store_bf16x8(dst + (size_t)(row0 + r) * 512 + c, v); });
    } else {
        const int gc0 = (ct - 26) * 128;
        bf16_t* dst = (bf16_t*)(ws + OFF_GATES) + gc0;
        const float* gb = p.gate_b + gc0;
        f32x4 gbv[4];
        {
            const int lane_ = tidx() & 63, c0 = ((tidx() >> 6) & 1) * 64 + 8 * (lane_ >> 4);
#pragma unroll
            for (int q = 0; q < 2; ++q) { gbv[2 * q] = *(const f32x4*)(gb + c0 + 32 * q); gbv[2 * q + 1] = *(const f32x4*)(gb + c0 + 32 * q + 4); }
            PIN4(gbv, 0);
        }
        if (hn) gemm_prefetch(nx, smem, pp);
        epi_foreach(acc, [&](int r, int c, float (&v)[8], int pq, int mq) {
            const f32x4 b0 = gbv[2 * pq], b1 = gbv[2 * pq + 1];
            v[0] = sigmoidf_(v[0] + b0[0]); v[1] = sigmoidf_(v[1] + b0[1]); v[2] = sigmoidf_(v[2] + b0[2]); v[3] = sigmoidf_(v[3] + b0[3]);
            v[4] = sigmoidf_(v[4] + b1[0]); v[5] = sigmoidf_(v[5] + b1[1]); v[6] = sigmoidf_(v[6] + b1[2]); v[7] = sigmoidf_(v[7] + b1[3]);
            store_bf16x8(dst + (size_t)(row0 + r) * 3072 + c, v); });
    }
}

__device__ void memkv_tile(const Params& p, int rt, int ct, unsigned char* smem) {
    unsigned char* dob = (unsigned char*)p.out;
    f32x4 acc[4][4]; acc_zero(acc);
    const GemmOp op{(const bf16_t*)(dob + DO_MEMBF) + (size_t)rt * 128 * 1024, (const bf16_t*)(p.ws + OFF_WMKVT) + (size_t)ct * 128 * 1024, 1024, 1024};
    GemmPipe pp{0, false};
    __syncthreads();
    gemm_tile(op, 1024, acc, smem, pp);
    const int row0 = rt * 128;
    if (ct < 4) {
        bf16_t* dst = (bf16_t*)(dob + DO_KM) + ct * 128;
        epi_foreach(acc, [&](int r, int c, float (&v)[8], int, int) { store_bf16x8(dst + (size_t)(row0 + r) * 512 + c, v); });
    } else {
        const int h = ct - 4, b = row0 / MEML, m0 = row0 % MEML;
        store_tile_T(acc, (bf16_t*)(dob + DO_VMT) + (size_t)(b * 4 + h) * 128 * MEML + m0, MEML, smem);
    }
}


typedef float f32x16 __attribute__((ext_vector_type(16)));
__device__ __forceinline__ f32x16 mfma32(bf16x8 a, bf16x8 b, f32x16 c) { return __builtin_amdgcn_mfma_f32_32x32x16_bf16(a, b, c, 0, 0, 0); }
constexpr int ATT_STAGE = 16384 + 128 * 136;

template <bool WIN>
__device__ void attn_block(const bf16_t* Qg, int ldq, const bf16_t* __restrict__ Kg, int ldk, const bf16_t* __restrict__ Vtg, int ldv,
                           int q0, int kt0, int nt, float sink2, bf16_t* Og, int ldo, unsigned char* smem) {
    const int tid = tidx(), lane = tid & 63, wid = tid >> 6, r = lane & 31, hh = lane >> 5;
    const int qw = q0 + 32 * wid;
    bf16x8 qf[8];
#pragma unroll
    for (int ks = 0; ks < 8; ++ks) qf[ks] = *(const bf16x8*)(Qg + (size_t)(32 * wid + r) * ldq + ks * 16 + hh * 8);
    f32x16 o[4];
#pragma unroll
    for (int db = 0; db < 4; ++db)
#pragma unroll
        for (int e = 0; e < 16; ++e) o[db][e] = 0.f;
    float m = WIN ? sink2 : -1e30f, l = WIN ? 1.0f : 0.0f;
    const int krow = tid >> 4, kch = tid & 15, vrow = tid >> 3, vch = tid & 7;
    const int koff = krow * 256 + ((kch ^ (krow & 15)) << 4);
    const int voff = 16384 + vrow * 136 + vch * 16;
    uint4 rk[4], rv[4];
    const bf16_t* kgp = Kg + (size_t)(kt0 * 64 + krow) * ldk + kch * 8;
    const bf16_t* vgp = Vtg + (size_t)vrow * ldv + kt0 * 64 + vch * 8;
#pragma unroll
    for (int i = 0; i < 4; ++i) { rk[i] = *(const uint4*)(kgp + (size_t)(16 * i) * ldk); rv[i] = *(const uint4*)(vgp + (size_t)(32 * i) * ldv); }
#pragma unroll
    for (int i = 0; i < 4; ++i) {
        *(uint4*)(smem + koff + i * 4096) = rk[i];
        *(uint2*)(smem + voff + i * 4352) = make_uint2(rv[i].x, rv[i].y); *(uint2*)(smem + voff + i * 4352 + 8) = make_uint2(rv[i].z, rv[i].w);
    }
    __syncthreads();
    for (int t = 0; t < nt; ++t) {
        const unsigned char* sb = smem + (t & 1) * ATT_STAGE;
        {
            const int tn = t + 1 < nt ? t + 1 : t;
#pragma unroll
            for (int i = 0; i < 4; ++i) { rk[i] = *(const uint4*)(kgp + (size_t)(tn * 64 + 16 * i) * ldk); rv[i] = *(const uint4*)(vgp + (size_t)(32 * i) * ldv + tn * 64); }
        }
        const int k0 = (kt0 + t) * 64;
        if (!WIN || (k0 + 63 >= qw - 128 && k0 <= qw + 159)) {
#pragma unroll
            for (int kb = 0; kb < 2; ++kb) {
                const int kb0 = k0 + 32 * kb;
                if (WIN && !(kb0 + 31 >= qw - 128 && kb0 <= qw + 159)) continue;
                f32x16 s;
#pragma unroll
                for (int e = 0; e < 16; ++e) s[e] = 0.f;
                const int row = kb * 32 + r;
#pragma unroll
                for (int ks = 0; ks < 8; ++ks) {
                    const bf16x8 a = *(const bf16x8*)(sb + row * 256 + (((2 * ks + hh) ^ (row & 15)) << 4));
                    s = mfma32(a, qf[ks], s);
                }
                if (WIN && !(kb0 >= qw - 97 && kb0 + 31 <= qw + 128)) {
#pragma unroll
                    for (int e = 0; e < 16; ++e) {
                        const int d = kb0 + (e & 3) + 8 * (e >> 2) + 4 * hh - (qw + r);
                        s[e] = (d <= 128 && d >= -128) ? s[e] : -1e30f;
                    }
                }
                float mx = s[0];
#pragma unroll
                for (int e = 1; e < 16; ++e) mx = fmaxf(mx, s[e]);
                mx = fmaxf(mx, __shfl_xor(mx, 32));
                const float mnew = fmaxf(m, mx), alpha = __builtin_amdgcn_exp2f(m - mnew);
                m = mnew;
                float ps = 0.f;
#pragma unroll
                for (int e = 0; e < 16; ++e) { s[e] = __builtin_amdgcn_exp2f(s[e] - mnew); ps += s[e]; }
                ps += __shfl_xor(ps, 32);
                l = l * alpha + ps;
                if (__any(alpha != 1.0f)) {
#pragma unroll
                    for (int db = 0; db < 4; ++db)
#pragma unroll
                        for (int e = 0; e < 16; ++e) o[db][e] *= alpha;
                }
#pragma unroll
                for (int s2 = 0; s2 < 2; ++s2) {
                    union { unsigned u[4]; bf16x8 v; } pb;
#pragma unroll
                    for (int e = 0; e < 4; ++e) pb.u[e] = pack_bf16(s[8 * s2 + 2 * e], s[8 * s2 + 2 * e + 1]);
#pragma unroll
                    for (int db = 0; db < 4; ++db) {
                        const unsigned char* vp = sb + 16384 + (db * 32 + r) * 136 + (kb * 32 + 16 * s2 + 4 * hh) * 2;
                        union { uint2 u[2]; bf16x8 v; } va;
                        va.u[0] = *(const uint2*)vp; va.u[1] = *(const uint2*)(vp + 16);
                        o[db] = mfma32(va.v, pb.v, o[db]);
                    }
                }
            }
        }
        {
            unsigned char* sw = smem + ((t + 1) & 1) * ATT_STAGE;
#pragma unroll
            for (int i = 0; i < 4; ++i) {
                *(uint4*)(sw + koff + i * 4096) = rk[i];
                *(uint2*)(sw + voff + i * 4352) = make_uint2(rv[i].x, rv[i].y); *(uint2*)(sw + voff + i * 4352 + 8) = make_uint2(rv[i].z, rv[i].w);
            }
        }
        __syncthreads();
    }
    const float inv = __builtin_amdgcn_rcpf(l);
    bf16_t* orow = Og + (size_t)(32 * wid + r) * ldo + 4 * hh;
#pragma unroll
    for (int db = 0; db < 4; ++db)
#pragma unroll
        for (int gq = 0; gq < 4; ++gq)
            *(uint2*)(orow + db * 32 + 8 * gq) = make_uint2(pack_bf16(o[db][4 * gq] * inv, o[db][4 * gq + 1] * inv), pack_bf16(o[db][4 * gq + 2] * inv, o[db][4 * gq + 3] * inv));
}
__device__ void attn_win_unit(const Params& p, int u, unsigned char* smem) {
    const int gh = u % 3, qb = (u / 3) % 16, kvh = (u / 48) % 2, b = u / 96, head = kvh * 3 + gh;
    const int q0 = qb * 128;
    const int ks = q0 - 128 < 0 ? 0 : q0 - 128, ke = q0 + 256 > S_ ? S_ : q0 + 256;
    bf16_t* Q = (bf16_t*)(p.ws + OFF_QA) + (size_t)(b * S_ + q0) * 768 + head * 128;
    const bf16_t* Kb = (const bf16_t*)(p.ws + OFF_KA) + (size_t)(b * S_) * 256 + kvh * 128;
    const bf16_t* Vt = (const bf16_t*)(p.ws + OFF_VAT) + (size_t)(b * 2 + kvh) * 128 * S_;
    attn_block<true>(Q, 768, Kb, 256, Vt, S_, q0, ks / 64, (ke - ks) / 64, p.attn_sink[head] * 1.4426950408889634f, Q, 768, smem);
}
__device__ void attn_mem_unit(const Params& p, int u, unsigned char* smem) {
    const int qb = u % 16, head = (u / 16) % 4, b = u / 64;
    const int q0 = qb * 128;
    unsigned char* dob = (unsigned char*)p.out;
    bf16_t* Q = (bf16_t*)(p.ws + OFF_QM) + (size_t)(b * S_ + q0) * 512 + head * 128;
    const bf16_t* Kb = (const bf16_t*)(dob + DO_KM) + (size_t)(b * MEML) * 512 + head * 128;
    const bf16_t* Vt = (const bf16_t*)(dob + DO_VMT) + (size_t)(b * 4 + head) * 128 * MEML;
    attn_block<false>(Q, 512, Kb, 512, Vt, MEML, q0, 0, 4, 0.f, Q, 512, smem);
}

typedef _Float16 f16x2v __attribute__((ext_vector_type(2)));
__device__ __forceinline__ unsigned pack_f16(float lo, float hi) { return __builtin_bit_cast(unsigned, __builtin_amdgcn_cvt_pkrtz(lo, hi)); }
template <bool FINAL>
__device__ void lru_chunk_unit(const Params& p, int u, unsigned char* smem) {
    const int tid = tidx(), lane = tid & 63, wid = tid >> 6, li = lane & 15, g = lane >> 4;
    const int c = u & 15, h = (u >> 4) % 6, b = u / 96;
    const int cbase = h * 128, s0 = c * 128;
    unsigned char* xcs = smem; unsigned char* LB = smem + 32768; float2* SA = (float2*)(smem + 49152); unsigned char* WL = smem + 51200; float* CC = (float*)(smem + 67584);
    const bf16_t* Xl = (const bf16_t*)(p.ws + OFF_XL) + (size_t)(b * S_) * 768;
    bf16_t* Gl = (bf16_t*)(p.ws + OFF_GL) + (size_t)(b * S_ + s0) * 768;
    const bf16_t* LruWt = (const bf16_t*)(p.ws + OFF_LRUWT) + (size_t)h * 512 * 128;
    const float* SP8 = (const float*)(p.ws + OFF_SP8);
    float2* AGG = (float2*)(p.ws + OFF_AGG);
    auto stage_w = [&](int hc_, int d_) {
#pragma unroll
        for (int i = 0; i < 4; ++i) {
            const int rr = (tid >> 4) + 16 * i, n = rr >> 4, wrow = ((n >> 1) * 2 + d_) * 128 + hc_ * 32 + 16 * (n & 1) + (rr & 15);
            __builtin_amdgcn_global_load_lds((const unsigned*)(LruWt + (size_t)wrow * 128 + (((tid & 15) ^ (rr & 15)) << 3)), (unsigned*)(WL + tid * 16 + i * 4096), 16, 0, 0);
        }
    };
    __syncthreads();
    if (FINAL) {
        const int d_ = tid >> 7, ch_ = tid & 127;
        const float2* ag = AGG + ((size_t)(d_ * B_ + b) * 16) * 768 + cbase + ch_;
        f32x2v av[16];
#pragma unroll
        for (int j = 0; j < 16; ++j) av[j] = *(const f32x2v*)(ag + (size_t)j * 768);
        PIN8(av, 0); PIN8(av, 8);
        float H = 0.f;
#pragma unroll
        for (int jj = 0; jj < 16; ++jj) {
            const int j = d_ ? 15 - jj : jj;
            const bool on = d_ ? (j > c) : (j < c);
            H = __builtin_amdgcn_exp2f(on ? av[j][0] : 0.f) * H + (on ? av[j][1] : 0.f);
        }
        CC[tid] = H;
    }
    {
        const int cp = tid & 63, tq = tid >> 6, cch = cbase + 2 * cp;
        float cw[4][2];
#pragma unroll
        for (int j = 0; j < 4; ++j) { cw[j][0] = p.conv_w[j * LW + cch]; cw[j][1] = p.conv_w[j * LW + cch + 1]; }
        const float cb0 = p.conv_b[cch], cb1 = p.conv_b[cch + 1];
#pragma unroll
        for (int hf = 0; hf < 2; ++hf) {
            const int tb = 32 * tq + 16 * hf;
            unsigned xw[19];
#pragma unroll
            for (int i = 0; i < 19; ++i) {
                const int s = s0 + tb + i - 2, sc = s < 0 ? 0 : (s > S_ - 1 ? S_ - 1 : s);
                xw[i] = *(const unsigned*)(Xl + (size_t)sc * 768 + cch);
            }
            PIN15(xw, 0); PIN4(xw, 15);
#pragma unroll
            for (int i = 0; i < 19; ++i) { const int s = s0 + tb + i - 2; xw[i] = (s >= 0 && s < S_) ? xw[i] : 0u; }
#pragma unroll
            for (int i = 0; i < 16; ++i) {
                const int t = tb + i;
                const float y0 = cb0 + cw[0][0] * bflo(xw[i]) + cw[1][0] * bflo(xw[i + 1]) + cw[2][0] * bflo(xw[i + 2]) + cw[3][0] * bflo(xw[i + 3]);
                const float y1 = cb1 + cw[0][1] * bfhi(xw[i]) + cw[1][1] * bfhi(xw[i + 1]) + cw[2][1] * bfhi(xw[i + 2]) + cw[3][1] * bfhi(xw[i + 3]);
                *(unsigned*)(xcs + t * 256 + (((cp >> 2) ^ (t & 15)) << 4) + (cp & 3) * 4) = pack_bf16(y0, y1);
            }
        }
    }
    const int sch = tid & 31, seg = tid >> 5;
    float4 cst[2][3];
    auto load_cst = [&](int hc_, int d_) {
#pragma unroll
        for (int n = 0; n < 2; ++n) {
            const int gch = cbase + hc_ * 32 + 16 * n + 4 * g;
            cst[n][0] = *(const float4*)(p.lru_br + d_ * LW + gch); cst[n][1] = *(const float4*)(p.lru_bi + d_ * LW + gch); cst[n][2] = *(const float4*)(SP8 + d_ * LW + gch);
        }
    };
    stage_w(0, 0);
    __syncthreads();
#pragma unroll 1
    for (int hc = 0; hc < 4; ++hc) {
        float hfv[16];
#pragma unroll
        for (int d = 0; d < 2; ++d) {
            load_cst(hc, d);
            f32x4 acc[2][4];
#pragma unroll
            for (int m = 0; m < 2; ++m)
#pragma unroll
                for (int n = 0; n < 4; ++n) acc[m][n] = (f32x4){0.f, 0.f, 0.f, 0.f};
#pragma unroll
            for (int ks = 0; ks < 4; ++ks) {
                bf16x8 xf[2];
#pragma unroll
                for (int m = 0; m < 2; ++m) { const int row = 32 * wid + 16 * m + li; xf[m] = *(const bf16x8*)(xcs + row * 256 + (((ks * 4 + g) ^ (row & 15)) << 4)); }
#pragma unroll
                for (int n = 0; n < 4; ++n) {
                    const int rr = 16 * n + li;
                    const bf16x8 wf = *(const bf16x8*)(WL + rr * 256 + (((ks * 4 + g) ^ li) << 4));
#pragma unroll
                    for (int m = 0; m < 2; ++m) acc[m][n] = mfma16(wf, xf[m], acc[m][n]);
                }
            }
#pragma unroll
            for (int n = 0; n < 2; ++n) {
                const int ch4 = 16 * n + 4 * g;
                const float4 br4 = cst[n][0], bi4 = cst[n][1], sp4 = cst[n][2];
                const float brv[4] = {br4.x, br4.y, br4.z, br4.w}, biv[4] = {bi4.x, bi4.y, bi4.z, bi4.w}, spv[4] = {sp4.x, sp4.y, sp4.z, sp4.w};
#pragma unroll
                for (int m = 0; m < 2; ++m) {
                    const int tok = 32 * wid + 16 * m + li;
                    const uint2 xq = *(const uint2*)(xcs + tok * 256 + ((((hc * 32 + ch4) >> 3) ^ (tok & 15)) << 4) + (g & 1) * 8);
                    const float xc[4] = {bflo(xq.x), bfhi(xq.x), bflo(xq.y), bfhi(xq.y)};
                    unsigned w[4];
#pragma unroll
                    for (int r = 0; r < 4; ++r) {
                        const float rg = sigmoidf_(acc[m][n][r] + brv[r]), ig = sigmoidf_(acc[m][n + 2][r] + biv[r]);
                        const float la = spv[r] * rg, a = __builtin_amdgcn_exp2f(la);
                        const float bx = __builtin_amdgcn_sqrtf(fmaxf(1.0f - a * a, 0.f)) * (ig * xc[r]);
                        w[r] = pack_f16(la, bx);
                    }
                    *(uint4*)(LB + tok * 128 + (((ch4 >> 2) ^ (tok & 7)) << 4)) = make_uint4(w[0], w[1], w[2], w[3]);
                }
            }
            __syncthreads();
            if (!(hc == 3 && d == 1)) stage_w(d ? hc + 1 : hc, d ^ 1);
            const int gch = cbase + hc * 32 + sch;
            {
                float L = 0.f, H = 0.f;
#pragma unroll
                for (int k = 0; k < 16; ++k) {
                    const int tok = 16 * seg + (d ? 15 - k : k);
                    const unsigned w = *(const unsigned*)(LB + tok * 128 + (((sch >> 2) ^ (tok & 7)) << 4) + (sch & 3) * 4);
                    const f16x2v hv = __builtin_bit_cast(f16x2v, w);
                    const float la = (float)hv.x, bx = (float)hv.y;
                    H = __builtin_amdgcn_exp2f(la) * H + bx; L += la;
                }
                SA[seg * 32 + sch] = make_float2(L, H);
            }
            __syncthreads();
            if (!FINAL) {
                if (seg == 0) {
                    float L = 0.f, H = 0.f;
#pragma unroll
                    for (int s = 0; s < 8; ++s) { const float2 a = SA[(d ? 7 - s : s) * 32 + sch]; H = __builtin_amdgcn_exp2f(a.x) * H + a.y; L += a.x; }
                    AGG[((size_t)(d * B_ + b) * 16 + c) * 768 + gch] = make_float2(L, H);
                }
            } else {
                float H = CC[d * 128 + hc * 32 + sch];
#pragma unroll
                for (int ss = 0; ss < 8; ++ss) {
                    const int s = d ? 7 - ss : ss;
                    const bool on = d ? (s > seg) : (s < seg);
                    const float2 a = SA[s * 32 + sch];
                    H = __builtin_amdgcn_exp2f(on ? a.x : 0.f) * H + (on ? a.y : 0.f);
                }
                bf16_t* gp = Gl + (size_t)(16 * seg) * 768 + gch;
                float gv[16];
                if (d) {
                    unsigned gr[16];
#pragma unroll
                    for (int k = 0; k < 16; ++k) gr[k] = gp[(size_t)k * 768];
                    PIN8(gr, 0); PIN8(gr, 8);
#pragma unroll
                    for (int k = 0; k < 16; ++k) gv[k] = __uint_as_float(gr[k] << 16);
                }
#pragma unroll
                for (int k = 0; k < 16; ++k) {
                    const int kk = d ? 15 - k : k, tok = 16 * seg + kk;
                    const unsigned w = *(const unsigned*)(LB + tok * 128 + (((sch >> 2) ^ (tok & 7)) << 4) + (sch & 3) * 4);
                    const f16x2v hv = __builtin_bit_cast(f16x2v, w);
                    H = __builtin_amdgcn_exp2f((float)hv.x) * H + (float)hv.y;
                    if (d == 0) hfv[kk] = H; else hfv[kk] = (hfv[kk] + H) * gv[kk];
                }
                if (d) {
#pragma unroll
                    for (int k = 0; k < 16; ++k) gp[(size_t)k * 768] = f2bf(hfv[k]);
                }
            }
            __syncthreads();
        }
    }
}

__device__ void merge_tile(const Params& p, int rt, int ct, unsigned char* smem, GemmPipe& pp, bool hn, int nrt, int nct) {
    unsigned char* ws = p.ws;
    const int row0 = rt * 128, col0 = ct * 128;
    uint4 tot[4][2];
    const bf16_t* G = (const bf16_t*)(ws + OFF_GATES);
    const int lane = tidx() & 63, wid = tidx() >> 6, wr = wid >> 1, wc = wid & 1, li = lane & 15, g = lane >> 4;
#pragma unroll 1
    for (int br = 0; br < 3; ++br) {
        const bf16_t* Ab = (const bf16_t*)(ws + (br == 0 ? OFF_QA : (br == 1 ? OFF_GL : OFF_QM)));
        const bf16_t* Bb = (const bf16_t*)(ws + (br == 0 ? OFF_PATTNT : (br == 1 ? OFF_PLRUT : OFF_PMEMT)));
        const int Kb = br == 2 ? 512 : 768;
        const int nbr = br == 2 ? 0 : br + 1, nr0 = br == 2 ? nrt * 128 : row0, nc0 = br == 2 ? nct * 128 : col0, nKb = nbr == 2 ? 512 : 768;
        const bf16_t* nAb = (const bf16_t*)(ws + (nbr == 0 ? OFF_QA : (nbr == 1 ? OFF_GL : OFF_QM)));
        const bf16_t* nBb = (const bf16_t*)(ws + (nbr == 0 ? OFF_PATTNT : (nbr == 1 ? OFF_PLRUT : OFF_PMEMT)));
        const GemmOp op{Ab + (size_t)row0 * Kb, Bb + (size_t)col0 * Kb, Kb, Kb};
        const GemmOp nx{nAb + (size_t)nr0 * nKb, nBb + (size_t)nc0 * nKb, nKb, nKb};
        f32x4 acc[4][4]; acc_zero(acc);
        gemm_tile(op, Kb, acc, smem, pp);
        u32x4 gva[8];
#pragma unroll
        for (int m = 0; m < 4; ++m)
#pragma unroll
            for (int pq = 0; pq < 2; ++pq) {
                const int r = wr * 64 + m * 16 + li, c = wc * 64 + 32 * pq + 8 * g;
                gva[m * 2 + pq] = *(const u32x4*)(G + (size_t)(row0 + r) * 3072 + br * 1024 + col0 + c);
            }
        PIN8(gva, 0);
        if (br < 2 || hn) gemm_prefetch(nx, smem, pp);
#pragma unroll
        for (int m = 0; m < 4; ++m)
#pragma unroll
            for (int pp = 0; pp < 2; ++pp) {
                const uint4 gv = make_uint4(gva[m * 2 + pp][0], gva[m * 2 + pp][1], gva[m * 2 + pp][2], gva[m * 2 + pp][3]);
                float v[8];
                v[0] = bflo(gv.x) * acc[m][2 * pp][0]; v[1] = bfhi(gv.x) * acc[m][2 * pp][1];
                v[2] = bflo(gv.y) * acc[m][2 * pp][2]; v[3] = bfhi(gv.y) * acc[m][2 * pp][3];
                v[4] = bflo(gv.z) * acc[m][2 * pp + 1][0]; v[5] = bfhi(gv.z) * acc[m][2 * pp + 1][1];
                v[6] = bflo(gv.w) * acc[m][2 * pp + 1][2]; v[7] = bfhi(gv.w) * acc[m][2 * pp + 1][3];
                if (br > 0) {
                    const uint4 t = tot[m][pp];
                    v[0] += bflo(t.x); v[1] += bfhi(t.x); v[2] += bflo(t.y); v[3] += bfhi(t.y);
                    v[4] += bflo(t.z); v[5] += bfhi(t.z); v[6] += bflo(t.w); v[7] += bfhi(t.w);
                }
                tot[m][pp] = make_uint4(pack_bf16(v[0], v[1]), pack_bf16(v[2], v[3]), pack_bf16(v[4], v[5]), pack_bf16(v[6], v[7]));
            }
    }
    bf16_t* dst = (bf16_t*)(ws + OFF_MERGED) + col0;
#pragma unroll
    for (int m = 0; m < 4; ++m)
#pragma unroll
        for (int pp = 0; pp < 2; ++pp) {
            const int r = wr * 64 + m * 16 + li, c = wc * 64 + 32 * pp + 8 * g;
            *(uint4*)(dst + (size_t)(row0 + r) * 1024 + c) = tot[m][pp];
        }
}
__device__ void outproj_tile(const Params& p, int rt, int ct, unsigned char* smem, GemmPipe& pp, bool hn, int nrt, int nct) {
    const int row0 = rt * 128, col0 = ct * 128;
    f32x4 acc[4][4]; acc_zero(acc);
    const GemmOp op{(const bf16_t*)(p.ws + OFF_MERGED) + (size_t)row0 * 1024, (const bf16_t*)(p.ws + OFF_WOUTT) + (size_t)col0 * 1024, 1024, 1024};
    const GemmOp nx{(const bf16_t*)(p.ws + OFF_MERGED) + (size_t)nrt * 128 * 1024, (const bf16_t*)(p.ws + OFF_WOUTT) + (size_t)nct * 128 * 1024, 1024, 1024};
    gemm_tile(op, 1024, acc, smem, pp);
    f32x4 xv[16];
    {
        const int lane_ = tidx() & 63, wid_ = tidx() >> 6;
#pragma unroll
        for (int m = 0; m < 4; ++m)
#pragma unroll
            for (int pq = 0; pq < 2; ++pq) {
                const size_t o = (size_t)(row0 + (wid_ >> 1) * 64 + m * 16 + (lane_ & 15)) * 1024 + col0 + (wid_ & 1) * 64 + 32 * pq + 8 * (lane_ >> 4);
                xv[(m * 2 + pq) * 2] = *(const f32x4*)(p.x + o); xv[(m * 2 + pq) * 2 + 1] = *(const f32x4*)(p.x + o + 4);
            }
        PIN8(xv, 0); PIN8(xv, 8);
    }
    if (hn) gemm_prefetch(nx, smem, pp);
    epi_foreach(acc, [&](int r, int c, float (&v)[8], int pq, int mq) {
        const size_t o = (size_t)(row0 + r) * 1024 + col0 + c;
        const f32x4 x0 = xv[(mq * 2 + pq) * 2], x1 = xv[(mq * 2 + pq) * 2 + 1];
        *(float4*)(p.out + o) = make_float4(x0[0] + v[0], x0[1] + v[1], x0[2] + v[2], x0[3] + v[3]);
        *(float4*)(p.out + o + 4) = make_float4(x1[0] + v[4], x1[1] + v[5], x1[2] + v[6], x1[3] + v[7]);
    });
}

__device__ void peerq_tile(const Params& p, int rt, int ct, unsigned char* smem, GemmPipe& pp, bool hn, int nrt, int nct) {
    const int row0 = rt * 128, col0 = ct * 128;
    f32x4 acc[4][4]; acc_zero(acc);
    const GemmOp op{(const bf16_t*)(p.ws + OFF_MERGED) + (size_t)row0 * 1024, (const bf16_t*)(p.ws + OFF_WPQT) + (size_t)col0 * 1024, 1024, 1024};
    const GemmOp nx{(const bf16_t*)(p.ws + OFF_MERGED) + (size_t)nrt * 128 * 1024, (const bf16_t*)(p.ws + OFF_WPQT) + (size_t)nct * 128 * 1024, 1024, 1024};
    gemm_tile(op, 1024, acc, smem, pp);
    if (hn) gemm_prefetch(nx, smem, pp);
    bf16_t* dst = (bf16_t*)(p.ws + OFF_QPEER) + col0;
    epi_foreach(acc, [&](int r, int c, float (&v)[8], int, int) { store_bf16x8(dst + (size_t)(row0 + r) * 2048 + c, v); });
}

__device__ __forceinline__ int sortable(float v) { int k = __float_as_int(v); return k ^ ((k >> 31) & 0x7fffffff); }
__device__ __forceinline__ float unsortable(int k) { return __int_as_float(k ^ ((k >> 31) & 0x7fffffff)); }
__device__ __forceinline__ void insert16(int (&lst)[16], int x) {
#pragma unroll
    for (int k = 0; k < 16; ++k) { const int hi = max(lst[k], x); x = min(lst[k], x); lst[k] = hi; }
}
__device__ void scores_tile(const Params& p, int rt, int pq, unsigned char* smem) {
    const int row0 = rt * 128;
    f32x4 acc[4][4]; acc_zero(acc);
    const GemmOp op{(const bf16_t*)(p.ws + OFF_QPEER) + (size_t)row0 * 2048 + pq * 128, (const bf16_t*)(p.ws + OFF_SUBK) + (size_t)pq * 128 * 128, 2048, 128};
    GemmPipe pp{0, false};
    gemm_tile(op, 128, acc, smem, pp);
    float* sc = (float*)smem;
    __syncthreads();
    epi_foreach(acc, [&](int r, int c, float (&v)[8], int, int) {
        *(float4*)(sc + r * 132 + c) = make_float4(v[0], v[1], v[2], v[3]);
        *(float4*)(sc + r * 132 + c + 4) = make_float4(v[4], v[5], v[6], v[7]); });
    __syncthreads();
    {
        const int t = tidx(), r = t & 127, hf = t >> 7;
        int lst[16];
#pragma unroll
        for (int k = 0; k < 16; ++k) lst[k] = (int)0x80000000;
#pragma unroll 2
        for (int j4 = 0; j4 < 16; ++j4) {
            const int j = hf * 64 + j4 * 4;
            const float4 v = *(const float4*)(sc + r * 132 + j);
            insert16(lst, (sortable(v.x) & ~127) | (j + 0));
            insert16(lst, (sortable(v.y) & ~127) | (j + 1));
            insert16(lst, (sortable(v.z) & ~127) | (j + 2));
            insert16(lst, (sortable(v.w) & ~127) | (j + 3));
        }
        __syncthreads();
        int* ls = (int*)smem;
        if (hf) {
#pragma unroll
            for (int k = 0; k < 16; ++k) ls[t * 16 + k] = lst[15 - k];
        }
        __syncthreads();
        if (!hf) {
#pragma unroll
            for (int k = 0; k < 16; ++k) lst[k] = max(lst[k], ls[(t + 128) * 16 + k]);
#pragma unroll
            for (int s = 8; s >= 1; s >>= 1)
#pragma unroll
                for (int k = 0; k < 16; ++k)
                    if ((k & s) == 0) { const int hi = max(lst[k], lst[k + s]), lo = min(lst[k], lst[k + s]); lst[k] = hi; lst[k + s] = lo; }
            int4* dst = (int4*)((int*)(p.ws + OFF_TOPL) + ((size_t)(row0 + r) * 16 + pq) * 16);
            dst[0] = make_int4(lst[0], lst[1], lst[2], lst[3]); dst[1] = make_int4(lst[4], lst[5], lst[6], lst[7]);
            dst[2] = make_int4(lst[8], lst[9], lst[10], lst[11]); dst[3] = make_int4(lst[12], lst[13], lst[14], lst[15]);
        }
    }
    __syncthreads();
}

__device__ void combine_item(const Params& p, int item) {
    const int tok = item >> 3, hd = item & 7;
    const int* l0 = (const int*)(p.ws + OFF_TOPL) + ((size_t)tok * 16 + hd * 2) * 16;
    const int* l1 = l0 + 16;
    int k0[16], k1[16];
#pragma unroll
    for (int i = 0; i < 4; ++i) {
        const int4 a = ((const int4*)l0)[i], b = ((const int4*)l1)[i];
        k0[4 * i] = a.x; k0[4 * i + 1] = a.y; k0[4 * i + 2] = a.z; k0[4 * i + 3] = a.w;
        k1[4 * i] = b.x; k1[4 * i + 1] = b.y; k1[4 * i + 2] = b.z; k1[4 * i + 3] = b.w;
    }
    float v0[16], v1[16];
#pragma unroll
    for (int i = 0; i < 16; ++i) { v0[i] = unsortable(k0[i] & ~127); v1[i] = unsortable(k1[i] & ~127); }
    int lst[16];
#pragma unroll
    for (int k = 0; k < 16; ++k) lst[k] = (int)0x80000000;
#pragma unroll
    for (int a = 0; a < 16; ++a)
#pragma unroll
        for (int b = 0; b < 16; ++b)
            if ((a + 1) * (b + 1) <= 16) insert16(lst, (sortable(v0[a] + v1[b]) & ~255) | (a * 16 + b));
    float val[16], sum = 0.f;
    const float mx = unsortable(lst[0] & ~255);
#pragma unroll
    for (int k = 0; k < 16; ++k) { val[k] = __expf(unsortable(lst[k] & ~255) - mx); sum += val[k]; }
    const float inv = 1.0f / sum;
    int* ei = (int*)(p.ws + OFF_EIDX) + (size_t)tok * 128 + hd * 16;
    float* eg = (float*)(p.ws + OFF_EGATE) + (size_t)tok * 128 + hd * 16;
#pragma unroll
    for (int k = 0; k < 16; ++k) {
        const int code = lst[k] & 255, a = code >> 4, b = code & 15;
        ei[k] = (l0[a] & 127) * 128 + (l1[b] & 127);
        eg[k] = val[k] * inv;
    }
}

__device__ __forceinline__ void conv_row_fp8(const float* __restrict__ src, unsigned char* __restrict__ dst, float* __restrict__ scale, int row, int lane) {
    const float4* s = (const float4*)(src + (size_t)row * 1024 + lane * 16);
    float4 v[4]; float am = 0.f;
#pragma unroll
    for (int i = 0; i < 4; ++i) { v[i] = s[i]; am = fmaxf(am, fmaxf(fmaxf(fabsf(v[i].x), fabsf(v[i].y)), fmaxf(fabsf(v[i].z), fabsf(v[i].w)))); }
#pragma unroll
    for (int o = 32; o >= 1; o >>= 1) am = fmaxf(am, __shfl_xor(am, o));
    const float sc = am > 0.f ? am * (1.0f / 224.0f) : 1.0f, inv = 1.0f / sc;
    unsigned w[4];
#pragma unroll
    for (int i = 0; i < 4; ++i) {
        int t = __builtin_amdgcn_cvt_pk_fp8_f32(v[i].x * inv, v[i].y * inv, 0, false);
        t = __builtin_amdgcn_cvt_pk_fp8_f32(v[i].z * inv, v[i].w * inv, t, true);
        w[i] = (unsigned)t;
    }
    *(uint4*)(dst + (size_t)row * 1024 + lane * 16) = make_uint4(w[0], w[1], w[2], w[3]);
    if (lane == 0) scale[row] = sc;
}
__device__ __forceinline__ void load8rows(uint4 (&R)[8], const unsigned char* __restrict__ tab, int es, int l0, int lane) {
#pragma unroll
    for (int j = 0; j < 8; ++j) {
        const int id = __builtin_amdgcn_readlane(es, l0 + j);
        R[j] = *(const uint4*)(tab + (size_t)id * 1024 + lane * 16);
    }
}
__device__ __forceinline__ float dot16q(const uint4& r, const float (&h)[16]) {
    const unsigned q[4] = {r.x, r.y, r.z, r.w};
    float d0 = 0.f, d1 = 0.f;
#pragma unroll
    for (int i = 0; i < 4; ++i) {
        const f32x2v a = __builtin_amdgcn_cvt_pk_f32_fp8((int)q[i], false), b = __builtin_amdgcn_cvt_pk_f32_fp8((int)q[i], true);
        d0 += a.x * h[4 * i]; d1 += a.y * h[4 * i + 1]; d0 += b.x * h[4 * i + 2]; d1 += b.y * h[4 * i + 3];
    }
    return d0 + d1;
}
__device__ __forceinline__ float dots8(const uint4 (&R)[8], const float (&h)[16], int lane) {
    float pd[8];
#pragma unroll
    for (int j = 0; j < 8; ++j) pd[j] = dot16q(R[j], h);
    const bool b5 = (lane & 32) != 0, b4 = (lane & 16) != 0, b3 = (lane & 8) != 0;
    float a[4];
#pragma unroll
    for (int j = 0; j < 4; ++j) { const float keep = b5 ? pd[4 + j] : pd[j], send = b5 ? pd[j] : pd[4 + j]; a[j] = keep + __shfl_xor(send, 32); }
    float c[2];
#pragma unroll
    for (int j = 0; j < 2; ++j) { const float keep = b4 ? a[2 + j] : a[j], send = b4 ? a[j] : a[2 + j]; c[j] = keep + __shfl_xor(send, 16); }
    float kk;
    { const float keep = b3 ? c[1] : c[0], send = b3 ? c[0] : c[1]; kk = keep + __shfl_xor(send, 8); }
    kk += __shfl_xor(kk, 4); kk += __shfl_xor(kk, 2); kk += __shfl_xor(kk, 1);
    return kk;
}
__device__ __forceinline__ void axpy8(float (&o)[16], const uint4 (&R)[8], int wsr, int bb) {
#pragma unroll
    for (int j = 0; j < 8; ++j) {
        const float c = __int_as_float(__builtin_amdgcn_readlane(wsr, 8 * j + bb));
        const unsigned q[4] = {R[j].x, R[j].y, R[j].z, R[j].w};
#pragma unroll
        for (int i = 0; i < 4; ++i) {
            const f32x2v a = __builtin_amdgcn_cvt_pk_f32_fp8((int)q[i], false), b = __builtin_amdgcn_cvt_pk_f32_fp8((int)q[i], true);
            o[4 * i] += c * a.x; o[4 * i + 1] += c * a.y; o[4 * i + 2] += c * b.x; o[4 * i + 3] += c * b.y;
        }
    }
}
__device__ void gather_token(const Params& p, int tok, int lane) {
    const bf16_t* h2 = (const bf16_t*)(p.ws + OFF_MERGED) + (size_t)tok * 1024 + lane * 16;
    const unsigned char* Uq = p.ws + OFF_UB; const unsigned char* Vq = p.ws + OFF_VB;
    const float* SU = (const float*)(p.ws + OFF_SU); const float* SV = (const float*)(p.ws + OFF_SV);
    const int* ei = (const int*)(p.ws + OFF_EIDX) + (size_t)tok * 128;
    const float* eg = (const float*)(p.ws + OFF_EGATE) + (size_t)tok * 128;
    float h[16];
    {
        const uint4 ha = *(const uint4*)h2, hb = *(const uint4*)(h2 + 8);
        const unsigned hq[8] = {ha.x, ha.y, ha.z, ha.w, hb.x, hb.y, hb.z, hb.w};
#pragma unroll
        for (int e = 0; e < 8; ++e) { h[2 * e] = bflo(hq[e]); h[2 * e + 1] = bfhi(hq[e]); }
    }
    const int pe = 8 * (lane & 7) + (lane >> 3);
    int es[2], wsr[2] = {0, 0}; float su[2], gv[2];
#pragma unroll
    for (int k = 0; k < 2; ++k) {
        es[k] = ei[64 * k + lane];
        const int e = ei[64 * k + pe];
        su[k] = SU[e]; gv[k] = eg[64 * k + pe] * SV[e];
    }
    uint4 R0[8], R1[8];
#pragma unroll
    for (int k = 0; k < 2; ++k) {
        load8rows(R0, Uq, es[k], 0, lane);
        for (int bb = 0; bb < 8; bb += 2) {
            load8rows(R1, Uq, es[k], 8 * bb + 8, lane);
            { const float w = gelu_tanh(dots8(R0, h, lane) * su[k]) * gv[k]; if ((lane & 7) == bb) wsr[k] = __float_as_int(w); }
            if (bb + 2 < 8) load8rows(R0, Uq, es[k], 8 * bb + 16, lane);
            { const float w = gelu_tanh(dots8(R1, h, lane) * su[k]) * gv[k]; if ((lane & 7) == bb + 1) wsr[k] = __float_as_int(w); }
        }
    }
    float o[16];
#pragma unroll
    for (int e = 0; e < 16; ++e) o[e] = 0.f;
#pragma unroll
    for (int k = 0; k < 2; ++k) {
        load8rows(R0, Vq, es[k], 0, lane);
        for (int bb = 0; bb < 8; bb += 2) {
            load8rows(R1, Vq, es[k], 8 * bb + 8, lane);
            axpy8(o, R0, wsr[k], bb);
            if (bb + 2 < 8) load8rows(R0, Vq, es[k], 8 * bb + 16, lane);
            axpy8(o, R1, wsr[k], bb + 1);
        }
    }
    float* xr = p.out + (size_t)tok * 1024 + lane * 16;
    float4 x[4]; float ss = 0.f;
#pragma unroll
    for (int i = 0; i < 4; ++i) {
        x[i] = *(const float4*)(xr + 4 * i);
        x[i].x += o[4 * i]; x[i].y += o[4 * i + 1]; x[i].z += o[4 * i + 2]; x[i].w += o[4 * i + 3];
        ss += x[i].x * x[i].x + x[i].y * x[i].y + x[i].z * x[i].z + x[i].w * x[i].w;
    }
    ss = wave_sum(ss);
    const float rs = rsqrtf(ss * (1.0f / 1024.0f) + EPS);
    const float* gf = p.g_final + lane * 16;
#pragma unroll
    for (int i = 0; i < 4; ++i) {
        const float4 gg = *(const float4*)(gf + 4 * i);
        *(float4*)(xr + 4 * i) = make_float4(x[i].x * rs * gg.x, x[i].y * rs * gg.y, x[i].z * rs * gg.z, x[i].w * rs * gg.w);
    }
}


__device__ __forceinline__ void fp8x16_to_f32(const uint4& r, float (&f)[16]) {
    const unsigned q[4] = {r.x, r.y, r.z, r.w};
#pragma unroll
    for (int i = 0; i < 4; ++i) {
        const f32x2v a = __builtin_amdgcn_cvt_pk_f32_fp8((int)q[i], false), b = __builtin_amdgcn_cvt_pk_f32_fp8((int)q[i], true);
        f[4 * i] = a.x; f[4 * i + 1] = a.y; f[4 * i + 2] = b.x; f[4 * i + 3] = b.y;
    }
}
__device__ __forceinline__ void peer_u_issue(u32x4 (&seg)[8], const unsigned char* Uq, int es, int gq) {
#pragma unroll
    for (int bb = 0; bb < 8; ++bb) { const int id = __shfl(es, 8 * bb + gq); seg[bb] = *(const u32x4*)(Uq + (size_t)id * 1024); }
}
__device__ __forceinline__ float peer_u_half(u32x4 (&seg)[8], const float (&h)[16], int sub) {
    PIN8(seg, 0);
    float z = 0.f;
#pragma unroll
    for (int bb = 0; bb < 8; ++bb) {
        float f[16];
        fp8x16_to_f32(make_uint4(seg[bb][0], seg[bb][1], seg[bb][2], seg[bb][3]), f);
        float d0 = 0.f, d1 = 0.f;
#pragma unroll
        for (int i = 0; i < 8; ++i) { d0 += f[2 * i] * h[2 * i]; d1 += f[2 * i + 1] * h[2 * i + 1]; }
        float d = d0 + d1;
        d += __shfl_xor(d, 1); d += __shfl_xor(d, 2); d += __shfl_xor(d, 4);
        if (sub == bb) z = d;
    }
    return z;
}
__device__ void peer_u_pass(const Params& p, int t0, int tstep, int x, int lane) {
    const int gq = lane >> 3, sub = lane & 7;
    const int* eib = (const int*)(p.ws + OFF_EIDX);
    const bf16_t* h2b = (const bf16_t*)(p.ws + OFF_MERGED) + x * 128 + sub * 16;
    const unsigned char* Uq = p.ws + OFF_UB + x * 128 + sub * 16;
    float* Zb = (float*)(p.ws + OFF_ZBUF) + (size_t)x * 128;
    if (t0 >= NTOK) return;
    int es0 = eib[(size_t)t0 * 128 + lane], es1 = eib[(size_t)t0 * 128 + 64 + lane];
    uint4 ha = *(const uint4*)(h2b + (size_t)t0 * 1024), hb = *(const uint4*)(h2b + (size_t)t0 * 1024 + 8);
    u32x4 SA[8], SB[8];
    peer_u_issue(SA, Uq, es0, gq);
    for (int t = t0; t < NTOK; t += tstep) {
        float h[16];
        {
            const unsigned hq[8] = {ha.x, ha.y, ha.z, ha.w, hb.x, hb.y, hb.z, hb.w};
#pragma unroll
            for (int e = 0; e < 8; ++e) { h[2 * e] = bflo(hq[e]); h[2 * e + 1] = bfhi(hq[e]); }
        }
        peer_u_issue(SB, Uq, es1, gq);
        const int tn = t + tstep < NTOK ? t + tstep : t;
        es0 = eib[(size_t)tn * 128 + lane]; es1 = eib[(size_t)tn * 128 + 64 + lane];
        ha = *(const uint4*)(h2b + (size_t)tn * 1024); hb = *(const uint4*)(h2b + (size_t)tn * 1024 + 8);
        const float z0 = peer_u_half(SA, h, sub);
        peer_u_issue(SA, Uq, es0, gq);
        const float z1 = peer_u_half(SB, h, sub);
        float* Z = Zb + (size_t)t * 8 * 128;
        Z[lane] = z0; Z[64 + lane] = z1;
    }
}
__device__ void peer_coef_token(const Params& p, int tok, int lane) {
    const int pe = 8 * (lane & 7) + (lane >> 3);
    const int* ei = (const int*)(p.ws + OFF_EIDX) + (size_t)tok * 128;
    const float* eg = (const float*)(p.ws + OFF_EGATE) + (size_t)tok * 128;
    const float* SU = (const float*)(p.ws + OFF_SU); const float* SV = (const float*)(p.ws + OFF_SV);
    const float* Z = (const float*)(p.ws + OFF_ZBUF) + (size_t)tok * 8 * 128;
    float* W = (float*)(p.ws + OFF_WBUF) + (size_t)tok * 128;
#pragma unroll
    for (int k = 0; k < 2; ++k) {
        float zv[8];
#pragma unroll
        for (int x = 0; x < 8; ++x) zv[x] = Z[x * 128 + k * 64 + lane];
        const int e = ei[64 * k + pe];
        const float g = eg[64 * k + pe], su = SU[e], sv = SV[e];
        PIN8(zv, 0);
        const float z = ((zv[0] + zv[1]) + (zv[2] + zv[3])) + ((zv[4] + zv[5]) + (zv[6] + zv[7]));
        W[k * 64 + lane] = gelu_tanh(z * su) * g * sv;
    }
}
#define PINQ(a) asm volatile("" : "+v"((a)[0]), "+v"((a)[1]), "+v"((a)[2]), "+v"((a)[3]))
__device__ __forceinline__ void peer_v_issue4(u32x4 (&seg)[4], const unsigned char* Vq, int es, int gq, int bb0) {
#pragma unroll
    for (int j = 0; j < 4; ++j) { const int id = __shfl(es, 8 * (bb0 + j) + gq); seg[j] = *(const u32x4*)(Vq + (size_t)id * 1024); }
}
__device__ __forceinline__ void peer_v_quarter(u32x4 (&seg)[4], float (&o)[16], float wk, int gq, int bb0) {
    PINQ(seg);
#pragma unroll
    for (int j = 0; j < 4; ++j) {
        const float c = __shfl(wk, 8 * gq + bb0 + j);
        float f[16];
        fp8x16_to_f32(make_uint4(seg[j][0], seg[j][1], seg[j][2], seg[j][3]), f);
#pragma unroll
        for (int i = 0; i < 16; ++i) o[i] += c * f[i];
    }
}
__device__ void peer_v_pass(const Params& p, int t0, int tstep, int x, int lane) {
    const int gq = lane >> 3, sub = lane & 7;
    const int* eib = (const int*)(p.ws + OFF_EIDX);
    const float* Wb = (const float*)(p.ws + OFF_WBUF);
    const unsigned char* Vq = p.ws + OFF_VB + x * 128 + sub * 16;
    if (t0 >= NTOK) return;
    const bool b5 = (lane & 32) != 0, b4 = (lane & 16) != 0, b3 = (lane & 8) != 0;
    const int col = x * 128 + 16 * sub + (b5 ? 8 : 0) + (b4 ? 4 : 0) + (b3 ? 2 : 0);
    int es0 = eib[(size_t)t0 * 128 + lane], es1 = eib[(size_t)t0 * 128 + 64 + lane];
    float wk0 = Wb[(size_t)t0 * 128 + lane], wk1 = Wb[(size_t)t0 * 128 + 64 + lane];
    u32x4 SA[4], SB[4];
    peer_v_issue4(SA, Vq, es0, gq, 0);
    for (int t = t0; t < NTOK; t += tstep) {
        float o[16];
#pragma unroll
        for (int i = 0; i < 16; ++i) o[i] = 0.f;
        const int tn = t + tstep < NTOK ? t + tstep : t;
        const int nes0 = eib[(size_t)tn * 128 + lane], nes1 = eib[(size_t)tn * 128 + 64 + lane];
        const float nwk0 = Wb[(size_t)tn * 128 + lane], nwk1 = Wb[(size_t)tn * 128 + 64 + lane];
        int gl = gq; asm volatile("" : "+v"(gl));
        peer_v_issue4(SB, Vq, es0, gl, 4);  peer_v_quarter(SA, o, wk0, gl, 0);
        peer_v_issue4(SA, Vq, es1, gl, 0);  peer_v_quarter(SB, o, wk0, gl, 4);
        peer_v_issue4(SB, Vq, es1, gl, 4);  peer_v_quarter(SA, o, wk1, gl, 0);
        peer_v_issue4(SA, Vq, nes0, gl, 0); peer_v_quarter(SB, o, wk1, gl, 4);
        es0 = nes0; es1 = nes1; wk0 = nwk0; wk1 = nwk1;
        float a8[8], a4[4], a2[2];
#pragma unroll
        for (int i = 0; i < 8; ++i) { const float keep = b5 ? o[8 + i] : o[i], send = b5 ? o[i] : o[8 + i]; a8[i] = keep + __shfl_xor(send, 32); }
#pragma unroll
        for (int i = 0; i < 4; ++i) { const float keep = b4 ? a8[4 + i] : a8[i], send = b4 ? a8[i] : a8[4 + i]; a4[i] = keep + __shfl_xor(send, 16); }
#pragma unroll
        for (int i = 0; i < 2; ++i) { const float keep = b3 ? a4[2 + i] : a4[i], send = b3 ? a4[i] : a4[2 + i]; a2[i] = keep + __shfl_xor(send, 8); }
        float* xr = p.out + (size_t)t * 1024 + col;
        float2 xv = *(const float2*)xr;
        xv.x += a2[0]; xv.y += a2[1];
        *(float2*)xr = xv;
        const float ss = wave_sum(xv.x * xv.x + xv.y * xv.y);
        if (lane == 0) atomicAdd((float*)(p.ws + OFF_ROWSS) + t, ss);
    }
}
__device__ void final_norm_row(const Params& p, int tok, int lane) {
    float* xr = p.out + (size_t)tok * 1024 + lane * 16;
    const float rs = rsqrtf(((const float*)(p.ws + OFF_ROWSS))[tok] * (1.0f / 1024.0f) + EPS);
    const float* gf = p.g_final + lane * 16;
#pragma unroll
    for (int i = 0; i < 4; ++i) {
        const float4 v = *(const float4*)(xr + 4 * i), gg = *(const float4*)(gf + 4 * i);
        *(float4*)(xr + 4 * i) = make_float4(v.x * rs * gg.x, v.y * rs * gg.y, v.z * rs * gg.z, v.w * rs * gg.w);
    }
}

__device__ __forceinline__ bool gemm_unit(int it, int nct, int& rt, int& ct) {
    const int x = blockIdx.x & 7, j = blockIdx.x >> 3, nbx = gridDim.x >> 3;
    const int v = j + it * nbx, per_rg = 8 * nct;
    if (v >= 32 * nct) return false;
    const int rgi = v / per_rg, w = v - rgi * per_rg, cg = w >> 6, w2 = w & 63;
    const int rtl = w2 & 7, ctl = w2 >> 3;
    rt = (rgi * 8 + rtl) * 8 + x; ct = cg * 8 + ctl;
    return true;
}

#define XB_TMO      128
#define XB_XCNT(j)  (256  + 64 * (j))
#define XB_XSUB(j)  (1280 + 64 * (j))
#define XB_XGEN(j)  (2304 + 64 * (j))
#define XB_TOP      3328
#define XB_TOPGEN   3392
#define XCD_BAR_WORDS 3456
#define XB_SPIN_CAP (1u << 22)
#define LAS __attribute__((address_space(3)))
__device__ __forceinline__ unsigned xb_ld(unsigned* p)              { return __hip_atomic_load(p, __ATOMIC_RELAXED, __HIP_MEMORY_SCOPE_AGENT); }
__device__ __forceinline__ unsigned xb_add(unsigned* p, unsigned v) { return __hip_atomic_fetch_add(p, v, __ATOMIC_RELAXED, __HIP_MEMORY_SCOPE_AGENT); }
__device__ __forceinline__ unsigned xb_xcc_id() { return (unsigned)__builtin_amdgcn_s_getreg((3 << 11) | 20) & 0xFu; }
#define XB_SPIN(cond, bar) do { unsigned _sp = 0; while (cond) { __builtin_amdgcn_s_sleep(1); \
    if ((++_sp & 255u) == 0u) { if (xb_ld(&(bar)[XB_TMO])) break; if (_sp > XB_SPIN_CAP) { atomicAdd(&(bar)[XB_TMO], 1u); break; } } } } while (0)
struct XcdBarrier { unsigned* bar; unsigned x; volatile LAS unsigned* st; };
__device__ __forceinline__ XcdBarrier xcd_barrier_post(unsigned* bar, volatile LAS unsigned* st) {
    XcdBarrier b; b.bar = bar; b.x = xb_xcc_id(); b.st = st;
    if (threadIdx.x == 0) (void)xb_add(&bar[XB_XCNT(b.x)], 1u);
    return b;
}
__device__ __forceinline__ void xcd_barrier_complete(unsigned* bar, unsigned x, unsigned& nloc, unsigned& nx) {
    const unsigned G = gridDim.x;
    unsigned sum, cnt, mine, sp = 0u;
    for (;;) {
        sum = 0u; cnt = 0u; mine = 0u;
#pragma unroll
        for (unsigned j = 0; j < 16; ++j) { const unsigned c = xb_ld(&bar[XB_XCNT(j)]); sum += c; cnt += (c > 0u) ? 1u : 0u; mine = (j == x) ? c : mine; }
        if (sum == G) break;
        __builtin_amdgcn_s_sleep(1);
        if ((++sp & 255u) == 0u) { if (xb_ld(&bar[XB_TMO])) break; if (sp > XB_SPIN_CAP) { atomicAdd(&bar[XB_TMO], 1u); break; } }
    }
    nloc = mine > 0u ? mine : 1u; nx = cnt > 0u ? cnt : 1u;
}
__device__ __forceinline__ void xcd_barrier(const XcdBarrier& b) {
    asm volatile("s_waitcnt vmcnt(0)" ::: "memory");
    __syncthreads();
    if (threadIdx.x == 0) {
        unsigned* bar = b.bar;
        __builtin_amdgcn_s_waitcnt(0);
        unsigned nloc = b.st[0], nx = b.st[1];
        if (nloc == 0u) { xcd_barrier_complete(bar, b.x, nloc, nx); b.st[0] = nloc; b.st[1] = nx; }
        const unsigned old = xb_add(&bar[XB_XSUB(b.x)], 1u);
        const unsigned gen = old / nloc;
        if (old + 1u == (gen + 1u) * nloc) {
            __builtin_amdgcn_fence(__ATOMIC_RELEASE, "agent");
            asm volatile("s_waitcnt vmcnt(0)" ::: "memory");
            const unsigned og = xb_add(&bar[XB_TOP], 1u);
            const unsigned tg = og / nx;
            if (og + 1u == (tg + 1u) * nx) xb_add(&bar[XB_TOPGEN], 1u);
            else XB_SPIN(xb_ld(&bar[XB_TOPGEN]) == tg, bar);
            __builtin_amdgcn_fence(__ATOMIC_ACQUIRE, "agent");
            xb_add(&bar[XB_XGEN(b.x)], 1u);
            asm volatile("s_waitcnt vmcnt(0)" ::: "memory");
        } else {
            XB_SPIN(xb_ld(&bar[XB_XGEN(b.x)]) == gen, bar);
            __builtin_amdgcn_fence(__ATOMIC_ACQUIRE, "agent");
            asm volatile("s_waitcnt vmcnt(0)" ::: "memory");
        }
    }
    __syncthreads();
}

#ifndef PROBE_PHASE
#define PROBE_PHASE -1
#endif
#define PH_BEGIN(k) if (PROBE_PHASE == (k)) probe_t0 = __builtin_amdgcn_s_memrealtime();
#define PH_END(k)   if (PROBE_PHASE == (k)) probe_dt = __builtin_amdgcn_s_memrealtime() - probe_t0;
constexpr int SMEM_BYTES = 128 * 132 * 4 + 1024;

__global__ void __launch_bounds__(256, 2) fwd_megakernel(Params p) {
    __shared__ __attribute__((aligned(16))) unsigned char smem[SMEM_BYTES + 16];
    if (threadIdx.x == 0) *(uint4*)(smem + SMEM_BYTES) = make_uint4(0u, 0u, 0u, 0u);
    __syncthreads();
    const XcdBarrier xb = xcd_barrier_post((unsigned*)(p.ws + OFF_BAR), (volatile LAS unsigned*)(smem + SMEM_BYTES));
    const int bid = blockIdx.x, nb = gridDim.x, tid = tidx(), lane = tid & 63, wid = tid >> 6;
    unsigned char* ws = p.ws; unsigned char* dob = (unsigned char*)p.out;
    unsigned long long probe_t0 = 0, probe_dt = 0;
    PH_BEGIN(0)
    {
        for (int u = bid; u < 3232; u += nb) {
            if (u < 1600) convT_tile(p.w_in, (bf16_t*)(ws + OFF_WINT), 1024, INW, u, smem);
            else if (u < 1856) convT_tile(p.w_mem_kv, (bf16_t*)(ws + OFF_WMKVT), 1024, 1024, u - 1600, smem);
            else if (u < 2048) convT_tile(p.p_attn, (bf16_t*)(ws + OFF_PATTNT), 768, 1024, u - 1856, smem);
            else if (u < 2240) convT_tile(p.p_lru, (bf16_t*)(ws + OFF_PLRUT), 768, 1024, u - 2048, smem);
            else if (u < 2368) convT_tile(p.p_mem, (bf16_t*)(ws + OFF_PMEMT), 512, 1024, u - 2240, smem);
            else if (u < 2624) convT_tile(p.w_out, (bf16_t*)(ws + OFF_WOUTT), 1024, 1024, u - 2368, smem);
            else if (u < 3136) convT_tile(p.w_peer_q, (bf16_t*)(ws + OFF_WPQT), 1024, 2048, u - 2624, smem);
            else {
                const int v = u - 3136, mat = v >> 2, tile = v & 3, gsel = mat / 6, h = mat % 6, dir = gsel & 1;
                const float* src = (gsel < 2 ? p.lru_wr : p.lru_wi) + (size_t)(dir * 6 + h) * 128 * 128;
                convT_tile(src, (bf16_t*)(ws + OFF_LRUWT) + (size_t)(h * 512 + gsel * 128) * 128, 128, 128, tile, smem);
            }
        }
        conv_plain(p.peer_sub_keys, (bf16_t*)(ws + OFF_SUBK), (size_t)16 * 128 * 128 / 8);
        for (int r = bid * 4 + wid; r < 2 * NEXP; r += nb * 4) {
            if (r < NEXP) conv_row_fp8(p.peer_u, ws + OFF_UB, (float*)(ws + OFF_SU), r, lane);
            else conv_row_fp8(p.peer_v, ws + OFF_VB, (float*)(ws + OFF_SV), r - NEXP, lane);
        }
        for (int r = bid * 4 + wid; r < NTOK; r += nb * 4) rms_row_bf16(p.x + (size_t)r * 1024, p.g_mix, (bf16_t*)(dob + DO_HBF) + (size_t)r * 1024, lane);
        for (int r = bid * 4 + wid; r < NMEM; r += nb * 4) rms_row_bf16(p.mem + (size_t)r * 1024, p.g_mem, (bf16_t*)(dob + DO_MEMBF) + (size_t)r * 1024, lane);
        for (int i = bid * 256 + tid; i < NTOK * 16; i += nb * 256) rope_item(p.positions, (float*)(dob + DO_ROPE), i);
        for (int i = bid * 256 + tid; i < NTOK; i += nb * 256) ((float*)(ws + OFF_ROWSS))[i] = 0.f;
        for (int i = bid * 256 + tid; i < 2 * LW; i += nb * 256) ((float*)(ws + OFF_SP8))[i] = -8.0f * 1.4426950408889634f * log1pf(__expf(-p.lru_lambda[i]));
    }
    xcd_barrier(xb);
    PH_END(0) PH_BEGIN(1)
    for (int u = bid; u < 256; u += nb) memkv_tile(p, u / 8, u % 8, smem);
    { GemmPipe pp{0, false}; int rt, ct, nrt = 0, nct = 0; bool have = gemm_unit(0, 50, rt, ct); __syncthreads();
      for (int it = 0; have; ++it) { const bool hn = gemm_unit(it + 1, 50, nrt, nct); inproj_tile(p, rt, ct, smem, pp, hn, nrt, nct); rt = nrt; ct = nct; have = hn; } }
    xcd_barrier(xb);
    PH_END(1) PH_BEGIN(2)
    {
        unsigned* ctr = (unsigned*)(p.ws + OFF_BAR) + 3600;
        volatile LAS unsigned* slot = (volatile LAS unsigned*)(smem + SMEM_BYTES + 8);
        for (;;) {
            if (tid == 0) *slot = xb_add(ctr, 1u);
            __syncthreads();
            const int u = (int)*slot;
            __syncthreads();
            if (u >= 1536 + 1536 + 1024) break;
            if (u < 1536) lru_chunk_unit<false>(p, u, smem);
            else if (u < 1536 + 1536) attn_win_unit(p, u - 1536, smem);
            else attn_mem_unit(p, u - 1536 - 1536, smem);
        }
    }
    xcd_barrier(xb);
    for (int u = bid; u < 1536; u += nb) lru_chunk_unit<true>(p, u, smem);
    xcd_barrier(xb);
    PH_END(2) PH_BEGIN(3)
    { GemmPipe pp{0, false}; int rt, ct, nrt = 0, nct = 0; bool have = gemm_unit(0, 8, rt, ct); __syncthreads();
      for (int it = 0; have; ++it) { const bool hn = gemm_unit(it + 1, 8, nrt, nct); merge_tile(p, rt, ct, smem, pp, hn, nrt, nct); rt = nrt; ct = nct; have = hn; } }
    xcd_barrier(xb);
    PH_END(3) PH_BEGIN(4)
    { GemmPipe pp{0, false}; int rt, ct, nrt = 0, nct = 0; bool have = gemm_unit(0, 8, rt, ct); __syncthreads();
      for (int it = 0; have; ++it) { const bool hn = gemm_unit(it + 1, 8, nrt, nct); outproj_tile(p, rt, ct, smem, pp, hn, nrt, nct); rt = nrt; ct = nct; have = hn; } }
    xcd_barrier(xb);
    PH_END(4) PH_BEGIN(5)
    for (int r = bid * 4 + wid; r < NTOK; r += nb * 4) rms_row_bf16(p.out + (size_t)r * 1024, p.g_ffn, (bf16_t*)(ws + OFF_MERGED) + (size_t)r * 1024, lane);
    xcd_barrier(xb);
    PH_END(5) PH_BEGIN(6)
    { GemmPipe pp{0, false}; int rt, ct, nrt = 0, nct = 0; bool have = gemm_unit(0, 16, rt, ct); __syncthreads();
      for (int it = 0; have; ++it) { const bool hn = gemm_unit(it + 1, 16, nrt, nct); peerq_tile(p, rt, ct, smem, pp, hn, nrt, nct); rt = nrt; ct = nct; have = hn; } }
    xcd_barrier(xb);
    PH_END(6) PH_BEGIN(7)
    for (int u = bid; u < 256 * 16; u += nb) scores_tile(p, u / 16, u % 16, smem);
    xcd_barrier(xb);
    PH_END(7) PH_BEGIN(8)
    for (int i = bid * 256 + tid; i < NTOK * 8; i += nb * 256) combine_item(p, i);
    xcd_barrier(xb);
    PH_END(8) PH_BEGIN(9)
    {
        const int x = bid & 7, tstep = (nb >> 3) * 4;
        peer_u_pass(p, (bid >> 3) * 4 + wid, tstep, x, lane);
        xcd_barrier(xb);
        for (int t = bid * 4 + wid; t < NTOK; t += nb * 4) peer_coef_token(p, t, lane);
        xcd_barrier(xb);
        peer_v_pass(p, (bid >> 3) * 4 + wid, tstep, x, lane);
        xcd_barrier(xb);
        for (int t = bid * 4 + wid; t < NTOK; t += nb * 4) final_norm_row(p, t, lane);
    }
    PH_END(9)
    if (PROBE_PHASE >= 0) { __syncthreads(); const unsigned long long t1 = __builtin_amdgcn_s_memrealtime(); while (__builtin_amdgcn_s_memrealtime() - t1 < probe_dt) __builtin_amdgcn_s_sleep(8); }
}

extern "C" void kernel_launch(void* const* d_in, const int* in_sizes, int n_in, void* d_out, int out_size, void* d_ws, size_t ws_size, hipStream_t stream) {
    if (ws_size < OFF_END) { fprintf(stderr, "workspace too small: %zu < %zu\n", ws_size, (size_t)OFF_END); return; }
    Params p{};
    p.x = (const float*)d_in[0]; p.mem = (const float*)d_in[1]; p.positions = (const int*)d_in[2];
    p.g_mix = (const float*)d_in[3]; p.g_mem = (const float*)d_in[4]; p.w_in = (const float*)d_in[5]; p.gate_b = (const float*)d_in[6];
    p.attn_sink = (const float*)d_in[7]; p.conv_w = (const float*)d_in[8]; p.conv_b = (const float*)d_in[9];
    p.lru_wr = (const float*)d_in[10]; p.lru_br = (const float*)d_in[11]; p.lru_wi = (const float*)d_in[12]; p.lru_bi = (const float*)d_in[13];
    p.lru_lambda = (const float*)d_in[14]; p.w_mem_kv = (const float*)d_in[15]; p.p_attn = (const float*)d_in[16]; p.p_lru = (const float*)d_in[17];
    p.p_mem = (const float*)d_in[18]; p.w_out = (const float*)d_in[19]; p.g_ffn = (const float*)d_in[20]; p.w_peer_q = (const float*)d_in[21];
    p.peer_sub_keys = (const float*)d_in[22]; p.peer_u = (const float*)d_in[23]; p.peer_v = (const float*)d_in[24]; p.g_final = (const float*)d_in[25];
    p.out = (float*)d_out; p.ws = (unsigned char*)d_ws;
    static int grid_blocks = 0;
    if (!grid_blocks) {
        int dev = 0, cus = 0, per_cu = 0;
        (void)hipGetDevice(&dev);
        (void)hipDeviceGetAttribute(&cus, hipDeviceAttributeMultiprocessorCount, dev);
        (void)hipOccupancyMaxActiveBlocksPerMultiprocessor(&per_cu, fwd_megakernel, 256, 0);
        if (per_cu > 2) per_cu = 2;
        grid_blocks = cus * per_cu;
    }
    (void)hipMemsetAsync((unsigned char*)d_ws + OFF_BAR, 0, 16384, stream);
    void* args[] = {&p};
    hipError_t e = hipLaunchCooperativeKernel((void*)fwd_megakernel, dim3(grid_blocks), dim3(256), args, 0, stream);
    if (e != hipSuccess) fprintf(stderr, "cooperative launch failed: %s (grid %d)\n", hipGetErrorString(e), grid_blocks);
}
```

```cpp
#include <hip/hip_runtime.h>
#include <stdint.h>
#include <stdio.h>

typedef unsigned short bf16_t;
typedef short bf16x8 __attribute__((ext_vector_type(8)));
typedef __bf16 bf16x2v __attribute__((ext_vector_type(2)));
typedef float f32x4 __attribute__((ext_vector_type(4)));

constexpr int B_ = 16, S_ = 2048, D_ = 1024, NTOK = B_ * S_;
constexpr int MEML = 256, NMEM = B_ * MEML;
constexpr int INW = 6400;
constexpr int LW = 768;
constexpr int NEXP = 16384;
constexpr float EPS = 1e-6f;
constexpr float QSCALE = 0.08838834764831845f * 1.4426950408889634f;

constexpr size_t OFF_WINT = 0;
constexpr size_t OFF_WMKVT = OFF_WINT + (size_t)INW * 1024 * 2;
constexpr size_t OFF_PATTNT = OFF_WMKVT + (size_t)1024 * 1024 * 2;
constexpr size_t OFF_PLRUT = OFF_PATTNT + (size_t)1024 * 768 * 2;
constexpr size_t OFF_PMEMT = OFF_PLRUT + (size_t)1024 * 768 * 2;
constexpr size_t OFF_WOUTT = OFF_PMEMT + (size_t)1024 * 512 * 2;
constexpr size_t OFF_WPQT = OFF_WOUTT + (size_t)1024 * 1024 * 2;
constexpr size_t OFF_LRUWT = OFF_WPQT + (size_t)2048 * 1024 * 2;
constexpr size_t OFF_SUBK = OFF_LRUWT + (size_t)6 * 512 * 128 * 2;
constexpr size_t OFF_UB = OFF_SUBK + (size_t)16 * 128 * 128 * 2;
constexpr size_t OFF_VB = OFF_UB + (size_t)NEXP * 1024;
constexpr size_t OFF_SU = OFF_VB + (size_t)NEXP * 1024;
constexpr size_t OFF_SV = OFF_SU + (size_t)NEXP * 4;
constexpr size_t OFF_RA = OFF_SV + (size_t)NEXP * 4;
constexpr size_t OFF_QA = OFF_RA;
constexpr size_t OFF_KA = OFF_QA + (size_t)NTOK * 768 * 2;
constexpr size_t OFF_VAT = OFF_KA + (size_t)NTOK * 256 * 2;
constexpr size_t OFF_XL = OFF_VAT + (size_t)NTOK * 256 * 2;
constexpr size_t OFF_GL = OFF_XL + (size_t)NTOK * 768 * 2;
constexpr size_t OFF_QM = OFF_GL + (size_t)NTOK * 768 * 2;
constexpr size_t OFF_GATES = OFF_QM + (size_t)NTOK * 512 * 2;
constexpr size_t OFF_BAR = OFF_GATES + (size_t)NTOK * 3072 * 2;
constexpr size_t OFF_SP8 = OFF_BAR + 16384;
constexpr size_t OFF_AGG = OFF_SP8 + 2 * 768 * 4;
constexpr size_t OFF_ROWSS = OFF_AGG + (size_t)2 * B_ * 16 * 768 * 8;
constexpr size_t OFF_END = OFF_ROWSS + (size_t)NTOK * 4;
constexpr size_t OFF_MERGED = OFF_KA;
constexpr size_t OFF_QPEER = OFF_GATES;
constexpr size_t OFF_TOPL = OFF_QPEER + (size_t)NTOK * 2048 * 2;
constexpr size_t OFF_EIDX = OFF_TOPL + (size_t)NTOK * 256 * 4;
constexpr size_t OFF_ZBUF = OFF_QPEER;
constexpr size_t OFF_WBUF = OFF_TOPL;
constexpr size_t OFF_EGATE = OFF_EIDX + (size_t)NTOK * 128 * 4;
static_assert(OFF_EGATE + (size_t)NTOK * 128 * 4 <= OFF_BAR, "overlay");
static_assert(OFF_MERGED + (size_t)NTOK * 1024 * 2 <= OFF_GL, "overlay2");
constexpr size_t DO_HBF = 0;
constexpr size_t DO_MEMBF = DO_HBF + (size_t)NTOK * 1024 * 2;
constexpr size_t DO_KM = DO_MEMBF + (size_t)NMEM * 1024 * 2;
constexpr size_t DO_VMT = DO_KM + (size_t)NMEM * 512 * 2;
constexpr size_t DO_ROPE = DO_VMT + (size_t)NMEM * 512 * 2;
static_assert(DO_ROPE + (size_t)NTOK * 32 * 4 <= (size_t)NTOK * 1024 * 4, "d_out scratch");

struct Params {
    const float *x, *mem; const int* positions;
    const float *g_mix, *g_mem, *w_in, *gate_b, *attn_sink, *conv_w, *conv_b, *lru_wr, *lru_br, *lru_wi, *lru_bi, *lru_lambda,
        *w_mem_kv, *p_attn, *p_lru, *p_mem, *w_out, *g_ffn, *w_peer_q, *peer_sub_keys, *peer_u, *peer_v, *g_final;
    float* out; unsigned char* ws;
};

__device__ __forceinline__ int tidx() { int t = threadIdx.x; asm volatile("" : "+v"(t)); return t; }
__device__ __forceinline__ float bf2f(bf16_t b) { return __uint_as_float(((unsigned)b) << 16); }
__device__ __forceinline__ float bflo(unsigned u) { return __uint_as_float(u << 16); }
__device__ __forceinline__ float bfhi(unsigned u) { return __uint_as_float(u & 0xffff0000u); }
typedef float f32x2v __attribute__((ext_vector_type(2)));
__device__ __forceinline__ unsigned pack_bf16(float lo, float hi) { const f32x2v f = {lo, hi}; return __builtin_bit_cast(unsigned, __builtin_convertvector(f, bf16x2v)); }
__device__ __forceinline__ bf16_t f2bf(float f) { return (bf16_t)(pack_bf16(f, 0.f) & 0xffffu); }
__device__ __forceinline__ f32x4 mfma16(bf16x8 a, bf16x8 b, f32x4 c) { return __builtin_amdgcn_mfma_f32_16x16x32_bf16(a, b, c, 0, 0, 0); }
__device__ __forceinline__ float sigmoidf_(float x) { return __builtin_amdgcn_rcpf(1.0f + __expf(-x)); }
__device__ __forceinline__ float gelu_tanh(float x) { const float u = 1.5957691216057308f * (x + 0.044715f * x * x * x); return x * __builtin_amdgcn_rcpf(1.0f + __expf(-u)); }
__device__ __forceinline__ float wave_sum(float v) {
#pragma unroll
    for (int o = 32; o >= 1; o >>= 1) v += __shfl_xor(v, o);
    return v;
}


typedef unsigned u32x4 __attribute__((ext_vector_type(4)));
#define PIN4(a, o) asm volatile("" : "+v"((a)[(o)]), "+v"((a)[(o) + 1]), "+v"((a)[(o) + 2]), "+v"((a)[(o) + 3]))
#define PIN8(a, o) asm volatile("" : "+v"((a)[(o)]), "+v"((a)[(o) + 1]), "+v"((a)[(o) + 2]), "+v"((a)[(o) + 3]), "+v"((a)[(o) + 4]), "+v"((a)[(o) + 5]), "+v"((a)[(o) + 6]), "+v"((a)[(o) + 7]))
#define PIN15(a, o) asm volatile("" : "+v"((a)[(o)]), "+v"((a)[(o) + 1]), "+v"((a)[(o) + 2]), "+v"((a)[(o) + 3]), "+v"((a)[(o) + 4]), "+v"((a)[(o) + 5]), "+v"((a)[(o) + 6]), "+v"((a)[(o) + 7]), \
    "+v"((a)[(o) + 8]), "+v"((a)[(o) + 9]), "+v"((a)[(o) + 10]), "+v"((a)[(o) + 11]), "+v"((a)[(o) + 12]), "+v"((a)[(o) + 13]), "+v"((a)[(o) + 14]))

__device__ void convT_tile(const float* __restrict__ src, bf16_t* __restrict__ dst, int K, int N, int tile, unsigned char* smem) {
    float* t = (float*)smem;
    const int tn = N / 64, tk = tile / tn, tnn = tile % tn, k0 = tk * 64, n0 = tnn * 64, tid = tidx();
    const int r = tid >> 4, c4 = (tid & 15) * 4;
#pragma unroll
    for (int i = 0; i < 4; ++i) {
        const int k = r + 16 * i;
        const float4 v = *(const float4*)(src + (size_t)(k0 + k) * N + n0 + c4);
        t[k * 65 + c4 + 0] = v.x; t[k * 65 + c4 + 1] = v.y; t[k * 65 + c4 + 2] = v.z; t[k * 65 + c4 + 3] = v.w;
    }
    __syncthreads();
    const int n = tid >> 2, kq = (tid & 3) * 16;
    unsigned w[8];
#pragma unroll
    for (int i = 0; i < 8; ++i) w[i] = pack_bf16(t[(kq + 2 * i) * 65 + n], t[(kq + 2 * i + 1) * 65 + n]);
    uint4* d = (uint4*)(dst + (size_t)(n0 + n) * K + k0 + kq);
    d[0] = make_uint4(w[0], w[1], w[2], w[3]); d[1] = make_uint4(w[4], w[5], w[6], w[7]);
    __syncthreads();
}


__device__ __forceinline__ void rms_row_bf16(const float* __restrict__ xr, const float* __restrict__ g, bf16_t* __restrict__ o, int lane) {
    float4 v[4]; float ss = 0.f;
#pragma unroll
    for (int i = 0; i < 4; ++i) { v[i] = *(const float4*)(xr + i * 256 + lane * 4); ss += v[i].x * v[i].x + v[i].y * v[i].y + v[i].z * v[i].z + v[i].w * v[i].w; }
    ss = wave_sum(ss);
    const float rs = rsqrtf(ss * (1.0f / 1024.0f) + EPS);
#pragma unroll
    for (int i = 0; i < 4; ++i) {
        const float4 gg = *(const float4*)(g + i * 256 + lane * 4);
        *(uint2*)(o + i * 256 + lane * 4) = make_uint2(pack_bf16(v[i].x * rs * gg.x, v[i].y * rs * gg.y), pack_bf16(v[i].z * rs * gg.z, v[i].w * rs * gg.w));
    }
}


__device__ __forceinline__ void conv_plain(const float* __restrict__ src, bf16_t* __restrict__ dst, size_t n8) {
    for (size_t i = (size_t)blockIdx.x * 256 + tidx(); i < n8; i += (size_t)gridDim.x * 256) {
        const float4 a = ((const float4*)src)[2 * i], b = ((const float4*)src)[2 * i + 1];
        ((uint4*)dst)[i] = make_uint4(pack_bf16(a.x, a.y), pack_bf16(a.z, a.w), pack_bf16(b.x, b.y), pack_bf16(b.z, b.w));
    }
}
__device__ __forceinline__ void rope_item(const int* __restrict__ pos, float* __restrict__ cs, int i) {
    const int t = i >> 4, f = i & 15;
    const float inv = powf(500000.0f, -(float)(2 * f) / 32.0f);
    const float ang = (float)pos[t] * inv;
    float s, c; sincosf(ang, &s, &c);
    cs[2 * i] = c; cs[2 * i + 1] = s;
}

__device__ __forceinline__ int swz(int row) { return (row & 3) | (((row >> 3) & 1) << 2); }

struct GemmOp { const bf16_t* A; const bf16_t* Bt; int lda, ldb; };
struct GemmPipe { int par; bool pre; };

__device__ __forceinline__ void gemm_issue(const GemmOp& op, int kt, int st, unsigned char* smem) {
    const int tid = tidx();
    const int srow = tid >> 3, skc = (tid & 7) ^ swz(tid >> 3);
    const bf16_t* ga = op.A + (size_t)srow * op.lda + skc * 8 + kt * 64;
    const bf16_t* gb = op.Bt + (size_t)srow * op.ldb + skc * 8 + kt * 64;
    unsigned char* sw = smem + tid * 16 + st * 32768;
#pragma unroll
    for (int i = 0; i < 4; ++i) {
        __builtin_amdgcn_global_load_lds((const unsigned*)(ga + (size_t)(32 * i) * op.lda), (unsigned*)(sw + i * 4096), 16, 0, 0);
        __builtin_amdgcn_global_load_lds((const unsigned*)(gb + (size_t)(32 * i) * op.ldb), (unsigned*)(sw + 16384 + i * 4096), 16, 0, 0);
    }
}
__device__ __forceinline__ void gemm_prefetch(const GemmOp& nx, unsigned char* smem, GemmPipe& pp) { gemm_issue(nx, 0, pp.par, smem); pp.pre = true; }

__device__ __forceinline__ void gemm_tile(const GemmOp& op, int K, f32x4 (&acc)[4][4], unsigned char* smem, GemmPipe& pp) {
    const int tid = tidx(), lane = tid & 63, wid = tid >> 6, wr = wid >> 1, wc = wid & 1, li = lane & 15, g = lane >> 4;
    int aoff[4], boff[4], asw[4], bsw[4];
#pragma unroll
    for (int m = 0; m < 4; ++m) { const int row = wr * 64 + m * 16 + li; aoff[m] = row * 128; asw[m] = swz(row); }
#pragma unroll
    for (int n = 0; n < 4; ++n) { const int row = wc * 64 + 32 * (n >> 1) + 8 * (li >> 2) + 4 * (n & 1) + (li & 3); boff[n] = 16384 + row * 128; bsw[n] = swz(row); }
    const int nk = K >> 6;
    if (!pp.pre) gemm_issue(op, 0, pp.par, smem);
    __syncthreads();
    for (int kt = 0; kt < nk; ++kt) {
        const int cur = (pp.par + kt) & 1;
        const unsigned char* sb = smem + cur * 32768;
        if (kt + 1 < nk) gemm_issue(op, kt + 1, cur ^ 1, smem);
#pragma unroll
        for (int ks = 0; ks < 2; ++ks) {
            bf16x8 af[4], bfr[4];
#pragma unroll
            for (int m = 0; m < 4; ++m) af[m] = *(const bf16x8*)(sb + aoff[m] + (((ks * 4 + g) ^ asw[m]) << 4));
#pragma unroll
            for (int n = 0; n < 4; ++n) bfr[n] = *(const bf16x8*)(sb + boff[n] + (((ks * 4 + g) ^ bsw[n]) << 4));
#pragma unroll
            for (int m = 0; m < 4; ++m)
#pragma unroll
                for (int n = 0; n < 4; ++n) acc[m][n] = mfma16(bfr[n], af[m], acc[m][n]);
        }
        if (kt + 1 < nk) __syncthreads();
    }
    pp.par = (pp.par + nk) & 1; pp.pre = false;
}
__device__ __forceinline__ void acc_zero(f32x4 (&acc)[4][4]) {
#pragma unroll
    for (int m = 0; m < 4; ++m)
#pragma unroll
        for (int n = 0; n < 4; ++n) acc[m][n] = (f32x4){0.f, 0.f, 0.f, 0.f};
}
template <class F> __device__ __forceinline__ void epi_foreach(const f32x4 (&acc)[4][4], F&& f) {
    const int lane = tidx() & 63, wid = tidx() >> 6, wr = wid >> 1, wc = wid & 1, li = lane & 15, g = lane >> 4;
#pragma unroll
    for (int m = 0; m < 4; ++m)
#pragma unroll
        for (int pp = 0; pp < 2; ++pp) {
            float v[8];
#pragma unroll
            for (int r = 0; r < 4; ++r) { v[r] = acc[m][2 * pp][r]; v[4 + r] = acc[m][2 * pp + 1][r]; }
            f(wr * 64 + m * 16 + li, wc * 64 + 32 * pp + 8 * g, v, pp, m);
        }
}
__device__ __forceinline__ void store_bf16x8(bf16_t* p, const float (&v)[8]) {
    *(uint4*)p = make_uint4(pack_bf16(v[0], v[1]), pack_bf16(v[2], v[3]), pack_bf16(v[4], v[5]), pack_bf16(v[6], v[7]));
}
__device__ __forceinline__ void store_tile_T(const f32x4 (&acc)[4][4], bf16_t* __restrict__ dstT, int ldt, unsigned char* smem) {
    bf16_t* t = (bf16_t*)smem;
    __syncthreads();
    epi_foreach(acc, [&](int r, int c, const float (&v)[8], int, int) {
#pragma unroll
        for (int e = 0; e < 8; ++e) t[(c + e) * 136 + r] = f2bf(v[e]);
    });
    __syncthreads();
#pragma unroll
    for (int i = 0; i < 8; ++i) {
        const int ch = tidx() + 256 * i, d = ch >> 4, tc = ch & 15;
        *(uint4*)(dstT + (size_t)d * ldt + tc * 8) = *(const uint4*)(smem + d * 272 + tc * 16);
    }
    __syncthreads();
}

__device__ void inproj_tile(const Params& p, int rt, int ct, unsigned char* smem, GemmPipe& pp, bool hn, int nrt, int nct) {
    unsigned char* ws = p.ws; unsigned char* dob = (unsigned char*)p.out;
    const bf16_t* hbf = (const bf16_t*)(dob + DO_HBF);
    const bf16_t* WinT = (const bf16_t*)(ws + OFF_WINT);
    f32x4 acc[4][4]; acc_zero(acc);
    const GemmOp op{hbf + (size_t)rt * 128 * 1024, WinT + (size_t)ct * 128 * 1024, 1024, 1024};
    const GemmOp nx{hbf + (size_t)nrt * 128 * 1024, WinT + (size_t)nct * 128 * 1024, 1024, 1024};
    gemm_tile(op, 1024, acc, smem, pp);
    const int row0 = rt * 128;
    if (ct < 8) {
        const float* cs = (const float*)(dob + DO_ROPE);
        const bool isq = ct < 6;
        bf16_t* dst = isq ? (bf16_t*)(ws + OFF_QA) + ct * 128 : (bf16_t*)(ws + OFF_KA) + (ct - 6) * 128;
        const int ld = isq ? 768 : 256;
        const float sc = isq ? QSCALE : 1.0f;
        const int lane_ = tidx() & 63, g = lane_ >> 4, wid_ = tidx() >> 6;
        f32x4 csv[16];
        if ((wid_ & 1) == 0) {
#pragma unroll
            for (int m = 0; m < 4; ++m) {
                const f32x4* csr = (const f32x4*)(cs + (size_t)(row0 + (wid_ >> 1) * 64 + m * 16 + (lane_ & 15)) * 32 + (g & 1) * 16);
#pragma unroll
                for (int q = 0; q < 4; ++q) csv[m * 4 + q] = csr[q];
            }
            PIN8(csv, 0); PIN8(csv, 8);
        }
        if (hn) gemm_prefetch(nx, smem, pp);
        epi_foreach(acc, [&](int r, int c, float (&v)[8], int pq, int mq) {
            const int tok = row0 + r;
            if (pq == 0 && c < 32) {
                const f32x4 c0 = csv[mq * 4], c1 = csv[mq * 4 + 1], c2 = csv[mq * 4 + 2], c3 = csv[mq * 4 + 3];
                const float ccv[8] = {c0[0], c0[2], c1[0], c1[2], c2[0], c2[2], c3[0], c3[2]};
                const float ssv[8] = {c0[1], c0[3], c1[1], c1[3], c2[1], c2[3], c3[1], c3[3]};
#pragma unroll
                for (int e = 0; e < 8; ++e) {
                    const float o = __shfl_xor(v[e], 32);
                    v[e] = (g < 2) ? (v[e] * ccv[e] - o * ssv[e]) : (v[e] * ccv[e] + o * ssv[e]);
                }
            }
#pragma unroll
            for (int e = 0; e < 8; ++e) v[e] *= sc;
            store_bf16x8(dst + (size_t)tok * ld + c, v);
        });
    } else if (ct < 10) {
        const int kvh = ct - 8, b = row0 / S_, s0 = row0 % S_;
        store_tile_T(acc, (bf16_t*)(ws + OFF_VAT) + (size_t)(b * 2 + kvh) * 128 * S_ + s0, S_, smem);
    } else if (ct < 16) {
        if (hn) gemm_prefetch(nx, smem, pp);
        bf16_t* dst = (bf16_t*)(ws + OFF_XL) + (ct - 10) * 128;
        epi_foreach(acc, [&](int r, int c, float (&v)[8], int, int) { store_bf16x8(dst + (size_t)(row0 + r) * 768 + c, v); });
    } else if (ct < 22) {
        if (hn) gemm_prefetch(nx, smem, pp);
        bf16_t* dst = (bf16_t*)(ws + OFF_GL) + (ct - 16) * 128;
        epi_foreach(acc, [&](int r, int c, float (&v)[8], int, int) {
#pragma unroll
            for (int e = 0; e < 8; ++e) v[e] = gelu_tanh(v[e]);
            store_bf16x8(dst + (size_t)(row0 + r) * 768 + c, v); });
    } else if (ct < 26) {
        if (hn) gemm_prefetch(nx, smem, pp);
        bf16_t* dst = (bf16_t*)(ws + OFF_QM) + (ct - 22) * 128;
        epi_foreach(acc, [&](int r, int c, float (&v)[8], int, int) {
#pragma unroll
            for (int e = 0; e < 8; ++e) v[e] *= QSCALE;
            store_bf16x8(dst + (size_t)(row0 + r) * 512 + c, v); });
    } else {
        const int gc0 = (ct - 26) * 128;
        bf16_t* dst = (bf16_t*)(ws + OFF_GATES) + gc0;
        const float* gb = p.gate_b + gc0;
        f32x4 gbv[4];
        {
            const int lane_ = tidx() & 63, c0 = ((tidx() >> 6) & 1) * 64 + 8 * (lane_ >> 4);
#pragma unroll
            for (int q = 0; q < 2; ++q) { gbv[2 * q] = *(const f32x4*)(gb + c0 + 32 * q); gbv[2 * q + 1] = *(const f32x4*)(gb + c0 + 32 * q + 4); }
            PIN4(gbv, 0);
        }
        if (hn) gemm_prefetch(nx, smem, pp);
        epi_foreach(acc, [&](int r, int c, float (&v)[8], int pq, int mq) {
            const f32x4 b0 = gbv[2 * pq], b1 = gbv[2 * pq + 1];
            v[0] = sigmoidf_(v[0] + b0[0]); v[1] = sigmoidf_(v[1] + b0[1]); v[2] = sigmoidf_(v[2] + b0[2]); v[3] = sigmoidf_(v[3] + b0[3]);
            v[4] = sigmoidf_(v[4] + b1[0]); v[5] = sigmoidf_(v[5] + b1[1]); v[6] = sigmoidf_(v[6] + b1[2]); v[7] = sigmoidf_(v[7] + b1[3]);
            store_bf16x8(dst + (size_t)(row0 + r) * 3072 + c, v); });
    }
}

__device__ void memkv_tile(const Params& p, int rt, int ct, unsigned char* smem) {
    unsigned char* dob = (unsigned char*)p.out;
    f32x4 acc[4][4]; acc_zero(acc);
    const GemmOp op{(const bf16_t*)(dob + DO_MEMBF) + (size_t)rt * 128 * 1024, (const bf16_t*)(p.ws + OFF_WMKVT) + (size_t)ct * 128 * 1024, 1024, 1024};
    GemmPipe pp{0, false};
    __syncthreads();
    gemm_tile(op, 1024, acc, smem, pp);
    const int row0 = rt * 128;
    if (ct < 4) {
        bf16_t* dst = (bf16_t*)(dob + DO_KM) + ct * 128;
        epi_foreach(acc, [&](int r, int c, float (&v)[8], int, int) { store_bf16x8(dst + (size_t)(row0 + r) * 512 + c, v); });
    } else {
        const int h = ct - 4, b = row0 / MEML, m0 = row0 % MEML;
        store_tile_T(acc, (bf16_t*)(dob + DO_VMT) + (size_t)(b * 4 + h) * 128 * MEML + m0, MEML, smem);
    }
}


typedef float f32x16 __attribute__((ext_vector_type(16)));
__device__ __forceinline__ f32x16 mfma32(bf16x8 a, bf16x8 b, f32x16 c) { return __builtin_amdgcn_mfma_f32_32x32x16_bf16(a, b, c, 0, 0, 0); }
constexpr int ATT_STAGE = 16384 + 128 * 136;

template <bool WIN>
__device__ void attn_block(const bf16_t* Qg, int ldq, const bf16_t* __restrict__ Kg, int ldk, const bf16_t* __restrict__ Vtg, int ldv,
                           int q0, int kt0, int nt, float sink2, bf16_t* Og, int ldo, unsigned char* smem) {
    const int tid = tidx(), lane = tid & 63, wid = tid >> 6, r = lane & 31, hh = lane >> 5;
    const int qw = q0 + 32 * wid;
    bf16x8 qf[8];
#pragma unroll
    for (int ks = 0; ks < 8; ++ks) qf[ks] = *(const bf16x8*)(Qg + (size_t)(32 * wid + r) * ldq + ks * 16 + hh * 8);
    f32x16 o[4];
#pragma unroll
    for (int db = 0; db < 4; ++db)
#pragma unroll
        for (int e = 0; e < 16; ++e) o[db][e] = 0.f;
    float m = WIN ? sink2 : -1e30f, l = WIN ? 1.0f : 0.0f;
    const int krow = tid >> 4, kch = tid & 15, vrow = tid >> 3, vch = tid & 7;
    const int koff = krow * 256 + ((kch ^ (krow & 15)) << 4);
    const int voff = 16384 + vrow * 136 + vch * 16;
    uint4 rk[4], rv[4];
    const bf16_t* kgp = Kg + (size_t)(kt0 * 64 + krow) * ldk + kch * 8;
    const bf16_t* vgp = Vtg + (size_t)vrow * ldv + kt0 * 64 + vch * 8;
#pragma unroll
    for (int i = 0; i < 4; ++i) { rk[i] = *(const uint4*)(kgp + (size_t)(16 * i) * ldk); rv[i] = *(const uint4*)(vgp + (size_t)(32 * i) * ldv); }
#pragma unroll
    for (int i = 0; i < 4; ++i) {
        *(uint4*)(smem + koff + i * 4096) = rk[i];
        *(uint2*)(smem + voff + i * 4352) = make_uint2(rv[i].x, rv[i].y); *(uint2*)(smem + voff + i * 4352 + 8) = make_uint2(rv[i].z, rv[i].w);
    }
    __syncthreads();
    for (int t = 0; t < nt; ++t) {
        const unsigned char* sb = smem + (t & 1) * ATT_STAGE;
        {
            const int tn = t + 1 < nt ? t + 1 : t;
#pragma unroll
            for (int i = 0; i < 4; ++i) { rk[i] = *(const uint4*)(kgp + (size_t)(tn * 64 + 16 * i) * ldk); rv[i] = *(const uint4*)(vgp + (size_t)(32 * i) * ldv + tn * 64); }
        }
        const int k0 = (kt0 + t) * 64;
        if (!WIN || (k0 + 63 >= qw - 128 && k0 <= qw + 159)) {
#pragma unroll
            for (int kb = 0; kb < 2; ++kb) {
                const int kb0 = k0 + 32 * kb;
                if (WIN && !(kb0 + 31 >= qw - 128 && kb0 <= qw + 159)) continue;
                f32x16 s;
#pragma unroll
                for (int e = 0; e < 16; ++e) s[e] = 0.f;
                const int row = kb * 32 + r;
#pragma unroll
                for (int ks = 0; ks < 8; ++ks) {
                    const bf16x8 a = *(const bf16x8*)(sb + row * 256 + (((2 * ks + hh) ^ (row & 15)) << 4));
                    s = mfma32(a, qf[ks], s);
                }
                if (WIN && !(kb0 >= qw - 97 && kb0 + 31 <= qw + 128)) {
#pragma unroll
                    for (int e = 0; e < 16; ++e) {
                        const int d = kb0 + (e & 3) + 8 * (e >> 2) + 4 * hh - (qw + r);
                        s[e] = (d <= 128 && d >= -128) ? s[e] : -1e30f;
                    }
                }
                float mx = s[0];
#pragma unroll
                for (int e = 1; e < 16; ++e) mx = fmaxf(mx, s[e]);
                mx = fmaxf(mx, __shfl_xor(mx, 32));
                const float mnew = fmaxf(m, mx), alpha = __builtin_amdgcn_exp2f(m - mnew);
                m = mnew;
                float ps = 0.f;
#pragma unroll
                for (int e = 0; e < 16; ++e) { s[e] = __builtin_amdgcn_exp2f(s[e] - mnew); ps += s[e]; }
                ps += __shfl_xor(ps, 32);
                l = l * alpha + ps;
                if (__any(alpha != 1.0f)) {
#pragma unroll
                    for (int db = 0; db < 4; ++db)
#pragma unroll
                        for (int e = 0; e < 16; ++e) o[db][e] *= alpha;
                }
#pragma unroll
                for (int s2 = 0; s2 < 2; ++s2) {
                    union { unsigned u[4]; bf16x8 v; } pb;
#pragma unroll
                    for (int e = 0; e < 4; ++e) pb.u[e] = pack_bf16(s[8 * s2 + 2 * e], s[8 * s2 + 2 * e + 1]);
#pragma unroll
                    for (int db = 0; db < 4; ++db) {
                        const unsigned char* vp = sb + 16384 + (db * 32 + r) * 136 + (kb * 32 + 16 * s2 + 4 * hh) * 2;
                        union { uint2 u[2]; bf16x8 v; } va;
                        va.u[0] = *(const uint2*)vp; va.u[1] = *(const uint2*)(vp + 16);
                        o[db] = mfma32(va.v, pb.v, o[db]);
                    }
                }
            }
        }
        {
            unsigned char* sw = smem + ((t + 1) & 1) * ATT_STAGE;
#pragma unroll
            for (int i = 0; i < 4; ++i) {
                *(uint4*)(sw + koff + i * 4096) = rk[i];
                *(uint2*)(sw + voff + i * 4352) = make_uint2(rv[i].x, rv[i].y); *(uint2*)(sw + voff + i * 4352 + 8) = make_uint2(rv[i].z, rv[i].w);
            }
        }
        __syncthreads();
    }
    const float inv = __builtin_amdgcn_rcpf(l);
    bf16_t* orow = Og + (size_t)(32 * wid + r) * ldo + 4 * hh;
#pragma unroll
    for (int db = 0; db < 4; ++db)
#pragma unroll
        for (int gq = 0; gq < 4; ++gq)
            *(uint2*)(orow + db * 32 + 8 * gq) = make_uint2(pack_bf16(o[db][4 * gq] * inv, o[db][4 * gq + 1] * inv), pack_bf16(o[db][4 * gq + 2] * inv, o[db][4 * gq + 3] * inv));
}
__device__ void attn_win_unit(const Params& p, int u, unsigned char* smem) {
    const int gh = u % 3, qb = (u / 3) % 16, kvh = (u / 48) % 2, b = u / 96, head = kvh * 3 + gh;
    const int q0 = qb * 128;
    const int ks = q0 - 128 < 0 ? 0 : q0 - 128, ke = q0 + 256 > S_ ? S_ : q0 + 256;
    bf16_t* Q = (bf16_t*)(p.ws + OFF_QA) + (size_t)(b * S_ + q0) * 768 + head * 128;
    const bf16_t* Kb = (const bf16_t*)(p.ws + OFF_KA) + (size_t)(b * S_) * 256 + kvh * 128;
    const bf16_t* Vt = (const bf16_t*)(p.ws + OFF_VAT) + (size_t)(b * 2 + kvh) * 128 * S_;
    attn_block<true>(Q, 768, Kb, 256, Vt, S_, q0, ks / 64, (ke - ks) / 64, p.attn_sink[head] * 1.4426950408889634f, Q, 768, smem);
}
__device__ void attn_mem_unit(const Params& p, int u, unsigned char* smem) {
    const int qb = u % 16, head = (u / 16) % 4, b = u / 64;
    const int q0 = qb * 128;
    unsigned char* dob = (unsigned char*)p.out;
    bf16_t* Q = (bf16_t*)(p.ws + OFF_QM) + (size_t)(b * S_ + q0) * 512 + head * 128;
    const bf16_t* Kb = (const bf16_t*)(dob + DO_KM) + (size_t)(b * MEML) * 512 + head * 128;
    const bf16_t* Vt = (const bf16_t*)(dob + DO_VMT) + (size_t)(b * 4 + head) * 128 * MEML;
    attn_block<false>(Q, 512, Kb, 512, Vt, MEML, q0, 0, 4, 0.f, Q, 512, smem);
}

typedef _Float16 f16x2v __attribute__((ext_vector_type(2)));
__device__ __forceinline__ unsigned pack_f16(float lo, float hi) { return __builtin_bit_cast(unsigned, __builtin_amdgcn_cvt_pkrtz(lo, hi)); }
template <bool FINAL>
__device__ void lru_chunk_unit(const Params& p, int u, unsigned char* smem) {
    const int tid = tidx(), lane = tid & 63, wid = tid >> 6, li = lane & 15, g = lane >> 4;
    const int c = u & 15, h = (u >> 4) % 6, b = u / 96;
    const int cbase = h * 128, s0 = c * 128;
    unsigned char* xcs = smem; unsigned char* LB = smem + 32768; float2* SA = (float2*)(smem + 49152); unsigned char* WL = smem + 51200; float* CC = (float*)(smem + 67584);
    const bf16_t* Xl = (const bf16_t*)(p.ws + OFF_XL) + (size_t)(b * S_) * 768;
    bf16_t* Gl = (bf16_t*)(p.ws + OFF_GL) + (size_t)(b * S_ + s0) * 768;
    const bf16_t* LruWt = (const bf16_t*)(p.ws + OFF_LRUWT) + (size_t)h * 512 * 128;
    const float* SP8 = (const float*)(p.ws + OFF_SP8);
    float2* AGG = (float2*)(p.ws + OFF_AGG);
    auto stage_w = [&](int hc_, int d_) {
#pragma unroll
        for (int i = 0; i < 4; ++i) {
            const int rr = (tid >> 4) + 16 * i, n = rr >> 4, wrow = ((n >> 1) * 2 + d_) * 128 + hc_ * 32 + 16 * (n & 1) + (rr & 15);
            __builtin_amdgcn_global_load_lds((const unsigned*)(LruWt + (size_t)wrow * 128 + (((tid & 15) ^ (rr & 15)) << 3)), (unsigned*)(WL + tid * 16 + i * 4096), 16, 0, 0);
        }
    };
    __syncthreads();
    if (FINAL) {
        const int d_ = tid >> 7, ch_ = tid & 127;
        const float2* ag = AGG + ((size_t)(d_ * B_ + b) * 16) * 768 + cbase + ch_;
        f32x2v av[16];
#pragma unroll
        for (int j = 0; j < 16; ++j) av[j] = *(const f32x2v*)(ag + (size_t)j * 768);
        PIN8(av, 0); PIN8(av, 8);
        float H = 0.f;
#pragma unroll
        for (int jj = 0; jj < 16; ++jj) {
            const int j = d_ ? 15 - jj : jj;
            const bool on = d_ ? (j > c) : (j < c);
            H = __builtin_amdgcn_exp2f(on ? av[j][0] : 0.f) * H + (on ? av[j][1] : 0.f);
        }
        CC[tid] = H;
    }
    {
        const int cp = tid & 63, tq = tid >> 6, cch = cbase + 2 * cp;
        float cw[4][2];
#pragma unroll
        for (int j = 0; j < 4; ++j) { cw[j][0] = p.conv_w[j * LW + cch]; cw[j][1] = p.conv_w[j * LW + cch + 1]; }
        const float cb0 = p.conv_b[cch], cb1 = p.conv_b[cch + 1];
#pragma unroll
        for (int hf = 0; hf < 2; ++hf) {
            const int tb = 32 * tq + 16 * hf;
            unsigned xw[19];
#pragma unroll
            for (int i = 0; i < 19; ++i) {
                const int s = s0 + tb + i - 2, sc = s < 0 ? 0 : (s > S_ - 1 ? S_ - 1 : s);
                xw[i] = *(const unsigned*)(Xl + (size_t)sc * 768 + cch);
            }
            PIN15(xw, 0); PIN4(xw, 15);
#pragma unroll
            for (int i = 0; i < 19; ++i) { const int s = s0 + tb + i - 2; xw[i] = (s >= 0 && s < S_) ? xw[i] : 0u; }
#pragma unroll
            for (int i = 0; i < 16; ++i) {
                const int t = tb + i;
                const float y0 = cb0 + cw[0][0] * bflo(xw[i]) + cw[1][0] * bflo(xw[i + 1]) + cw[2][0] * bflo(xw[i + 2]) + cw[3][0] * bflo(xw[i + 3]);
                const float y1 = cb1 + cw[0][1] * bfhi(xw[i]) + cw[1][1] * bfhi(xw[i + 1]) + cw[2][1] * bfhi(xw[i + 2]) + cw[3][1] * bfhi(xw[i + 3]);
                *(unsigned*)(xcs + t * 256 + (((cp >> 2) ^ (t & 15)) << 4) + (cp & 3) * 4) = pack_bf16(y0, y1);
            }
        }
    }
    const int sch = tid & 31, seg = tid >> 5;
    float4 cst[2][3];
    auto load_cst = [&](int hc_, int d_) {
#pragma unroll
        for (int n = 0; n < 2; ++n) {
            const int gch = cbase + hc_ * 32 + 16 * n + 4 * g;
            cst[n][0] = *(const float4*)(p.lru_br + d_ * LW + gch); cst[n][1] = *(const float4*)(p.lru_bi + d_ * LW + gch); cst[n][2] = *(const float4*)(SP8 + d_ * LW + gch);
        }
    };
    stage_w(0, 0);
    __syncthreads();
#pragma unroll 1
    for (int hc = 0; hc < 4; ++hc) {
        float hfv[16];
#pragma unroll
        for (int d = 0; d < 2; ++d) {
            load_cst(hc, d);
            f32x4 acc[2][4];
#pragma unroll
            for (int m = 0; m < 2; ++m)
#pragma unroll
                for (int n = 0; n < 4; ++n) acc[m][n] = (f32x4){0.f, 0.f, 0.f, 0.f};
#pragma unroll
            for (int ks = 0; ks < 4; ++ks) {
                bf16x8 xf[2];
#pragma unroll
                for (int m = 0; m < 2; ++m) { const int row = 32 * wid + 16 * m + li; xf[m] = *(const bf16x8*)(xcs + row * 256 + (((ks * 4 + g) ^ (row & 15)) << 4)); }
#pragma unroll
                for (int n = 0; n < 4; ++n) {
                    const int rr = 16 * n + li;
                    const bf16x8 wf = *(const bf16x8*)(WL + rr * 256 + (((ks * 4 + g) ^ li) << 4));
#pragma unroll
                    for (int m = 0; m < 2; ++m) acc[m][n] = mfma16(wf, xf[m], acc[m][n]);
                }
            }
#pragma unroll
            for (int n = 0; n < 2; ++n) {
                const int ch4 = 16 * n + 4 * g;
                const float4 br4 = cst[n][0], bi4 = cst[n][1], sp4 = cst[n][2];
                const float brv[4] = {br4.x, br4.y, br4.z, br4.w}, biv[4] = {bi4.x, bi4.y, bi4.z, bi4.w}, spv[4] = {sp4.x, sp4.y, sp4.z, sp4.w};
#pragma unroll
                for (int m = 0; m < 2; ++m) {
                    const int tok = 32 * wid + 16 * m + li;
                    const uint2 xq = *(const uint2*)(xcs + tok * 256 + ((((hc * 32 + ch4) >> 3) ^ (tok & 15)) << 4) + (g & 1) * 8);
                    const float xc[4] = {bflo(xq.x), bfhi(xq.x), bflo(xq.y), bfhi(xq.y)};
                    unsigned w[4];
#pragma unroll
                    for (int r = 0; r < 4; ++r) {
                        const float rg = sigmoidf_(acc[m][n][r] + brv[r]), ig = sigmoidf_(acc[m][n + 2][r] + biv[r]);
                        const float la = spv[r] * rg, a = __builtin_amdgcn_exp2f(la);
                        const float bx = __builtin_amdgcn_sqrtf(fmaxf(1.0f - a * a, 0.f)) * (ig * xc[r]);
                        w[r] = pack_f16(la, bx);
                    }
                    *(uint4*)(LB + tok * 128 + (((ch4 >> 2) ^ (tok & 7)) << 4)) = make_uint4(w[0], w[1], w[2], w[3]);
                }
            }
            __syncthreads();
            if (!(hc == 3 && d == 1)) stage_w(d ? hc + 1 : hc, d ^ 1);
            const int gch = cbase + hc * 32 + sch;
            {
                float L = 0.f, H = 0.f;
#pragma unroll
                for (int k = 0; k < 16; ++k) {
                    const int tok = 16 * seg + (d ? 15 - k : k);
                    const unsigned w = *(const unsigned*)(LB + tok * 128 + (((sch >> 2) ^ (tok & 7)) << 4) + (sch & 3) * 4);
                    const f16x2v hv = __builtin_bit_cast(f16x2v, w);
                    const float la = (float)hv.x, bx = (float)hv.y;
                    H = __builtin_amdgcn_exp2f(la) * H + bx; L += la;
                }
                SA[seg * 32 + sch] = make_float2(L, H);
            }
            __syncthreads();
            if (!FINAL) {
                if (seg == 0) {
                    float L = 0.f, H = 0.f;
#pragma unroll
                    for (int s = 0; s < 8; ++s) { const float2 a = SA[(d ? 7 - s : s) * 32 + sch]; H = __builtin_amdgcn_exp2f(a.x) * H + a.y; L += a.x; }
                    AGG[((size_t)(d * B_ + b) * 16 + c) * 768 + gch] = make_float2(L, H);
                }
            } else {
                float H = CC[d * 128 + hc * 32 + sch];
#pragma unroll
                for (int ss = 0; ss < 8; ++ss) {
                    const int s = d ? 7 - ss : ss;
                    const bool on = d ? (s > seg) : (s < seg);
                    const float2 a = SA[s * 32 + sch];
                    H = __builtin_amdgcn_exp2f(on ? a.x : 0.f) * H + (on ? a.y : 0.f);
                }
                bf16_t* gp = Gl + (size_t)(16 * seg) * 768 + gch;
                float gv[16];
                if (d) {
                    unsigned gr[16];
#pragma unroll
                    for (int k = 0; k < 16; ++k) gr[k] = gp[(size_t)k * 768];
                    PIN8(gr, 0); PIN8(gr, 8);
#pragma unroll
                    for (int k = 0; k < 16; ++k) gv[k] = __uint_as_float(gr[k] << 16);
                }
#pragma unroll
                for (int k = 0; k < 16; ++k) {
                    const int kk = d ? 15 - k : k, tok = 16 * seg + kk;
                    const unsigned w = *(const unsigned*)(LB + tok * 128 + (((sch >> 2) ^ (tok & 7)) << 4) + (sch & 3) * 4);
                    const f16x2v hv = __builtin_bit_cast(f16x2v, w);
                    H = __builtin_amdgcn_exp2f((float)hv.x) * H + (float)hv.y;
                    if (d == 0) hfv[kk] = H; else hfv[kk] = (hfv[kk] + H) * gv[kk];
                }
                if (d) {
#pragma unroll
                    for (int k = 0; k < 16; ++k) gp[(size_t)k * 768] = f2bf(hfv[k]);
                }
            }
            __syncthreads();
        }
    }
}

__device__ void merge_tile(const Params& p, int rt, int ct, unsigned char* smem, GemmPipe& pp, bool hn, int nrt, int nct) {
    unsigned char* ws = p.ws;
    const int row0 = rt * 128, col0 = ct * 128;
    uint4 tot[4][2];
    const bf16_t* G = (const bf16_t*)(ws + OFF_GATES);
    const int lane = tidx() & 63, wid = tidx() >> 6, wr = wid >> 1, wc = wid & 1, li = lane & 15, g = lane >> 4;
#pragma unroll 1
    for (int br = 0; br < 3; ++br) {
        const bf16_t* Ab = (const bf16_t*)(ws + (br == 0 ? OFF_QA : (br == 1 ? OFF_GL : OFF_QM)));
        const bf16_t* Bb = (const bf16_t*)(ws + (br == 0 ? OFF_PATTNT : (br == 1 ? OFF_PLRUT : OFF_PMEMT)));
        const int Kb = br == 2 ? 512 : 768;
        const int nbr = br == 2 ? 0 : br + 1, nr0 = br == 2 ? nrt * 128 : row0, nc0 = br == 2 ? nct * 128 : col0, nKb = nbr == 2 ? 512 : 768;
        const bf16_t* nAb = (const bf16_t*)(ws + (nbr == 0 ? OFF_QA : (nbr == 1 ? OFF_GL : OFF_QM)));
        const bf16_t* nBb = (const bf16_t*)(ws + (nbr == 0 ? OFF_PATTNT : (nbr == 1 ? OFF_PLRUT : OFF_PMEMT)));
        const GemmOp op{Ab + (size_t)row0 * Kb, Bb + (size_t)col0 * Kb, Kb, Kb};
        const GemmOp nx{nAb + (size_t)nr0 * nKb, nBb + (size_t)nc0 * nKb, nKb, nKb};
        f32x4 acc[4][4]; acc_zero(acc);
        gemm_tile(op, Kb, acc, smem, pp);
        u32x4 gva[8];
#pragma unroll
        for (int m = 0; m < 4; ++m)
#pragma unroll
            for (int pq = 0; pq < 2; ++pq) {
                const int r = wr * 64 + m * 16 + li, c = wc * 64 + 32 * pq + 8 * g;
                gva[m * 2 + pq] = *(const u32x4*)(G + (size_t)(row0 + r) * 3072 + br * 1024 + col0 + c);
            }
        PIN8(gva, 0);
        if (br < 2 || hn) gemm_prefetch(nx, smem, pp);
#pragma unroll
        for (int m = 0; m < 4; ++m)
#pragma unroll
            for (int pp = 0; pp < 2; ++pp) {
                const uint4 gv = make_uint4(gva[m * 2 + pp][0], gva[m * 2 + pp][1], gva[m * 2 + pp][2], gva[m * 2 + pp][3]);
                float v[8];
                v[0] = bflo(gv.x) * acc[m][2 * pp][0]; v[1] = bfhi(gv.x) * acc[m][2 * pp][1];
                v[2] = bflo(gv.y) * acc[m][2 * pp][2]; v[3] = bfhi(gv.y) * acc[m][2 * pp][3];
                v[4] = bflo(gv.z) * acc[m][2 * pp + 1][0]; v[5] = bfhi(gv.z) * acc[m][2 * pp + 1][1];
                v[6] = bflo(gv.w) * acc[m][2 * pp + 1][2]; v[7] = bfhi(gv.w) * acc[m][2 * pp + 1][3];
                if (br > 0) {
                    const uint4 t = tot[m][pp];
                    v[0] += bflo(t.x); v[1] += bfhi(t.x); v[2] += bflo(t.y); v[3] += bfhi(t.y);
                    v[4] += bflo(t.z); v[5] += bfhi(t.z); v[6] += bflo(t.w); v[7] += bfhi(t.w);
                }
                tot[m][pp] = make_uint4(pack_bf16(v[0], v[1]), pack_bf16(v[2], v[3]), pack_bf16(v[4], v[5]), pack_bf16(v[6], v[7]));
            }
    }
    bf16_t* dst = (bf16_t*)(ws + OFF_MERGED) + col0;
#pragma unroll
    for (int m = 0; m < 4; ++m)
#pragma unroll
        for (int pp = 0; pp < 2; ++pp) {
            const int r = wr * 64 + m * 16 + li, c = wc * 64 + 32 * pp + 8 * g;
            *(uint4*)(dst + (size_t)(row0 + r) * 1024 + c) = tot[m][pp];
        }
}
__device__ void outproj_tile(const Params& p, int rt, int ct, unsigned char* smem, GemmPipe& pp, bool hn, int nrt, int nct) {
    const int row0 = rt * 128, col0 = ct * 128;
    f32x4 acc[4][4]; acc_zero(acc);
    const GemmOp op{(const bf16_t*)(p.ws + OFF_MERGED) + (size_t)row0 * 1024, (const bf16_t*)(p.ws + OFF_WOUTT) + (size_t)col0 * 1024, 1024, 1024};
    const GemmOp nx{(const bf16_t*)(p.ws + OFF_MERGED) + (size_t)nrt * 128 * 1024, (const bf16_t*)(p.ws + OFF_WOUTT) + (size_t)nct * 128 * 1024, 1024, 1024};
    gemm_tile(op, 1024, acc, smem, pp);
    f32x4 xv[16];
    {
        const int lane_ = tidx() & 63, wid_ = tidx() >> 6;
#pragma unroll
        for (int m = 0; m < 4; ++m)
#pragma unroll
            for (int pq = 0; pq < 2; ++pq) {
                const size_t o = (size_t)(row0 + (wid_ >> 1) * 64 + m * 16 + (lane_ & 15)) * 1024 + col0 + (wid_ & 1) * 64 + 32 * pq + 8 * (lane_ >> 4);
                xv[(m * 2 + pq) * 2] = *(const f32x4*)(p.x + o); xv[(m * 2 + pq) * 2 + 1] = *(const f32x4*)(p.x + o + 4);
            }
        PIN8(xv, 0); PIN8(xv, 8);
    }
    if (hn) gemm_prefetch(nx, smem, pp);
    epi_foreach(acc, [&](int r, int c, float (&v)[8], int pq, int mq) {
        const size_t o = (size_t)(row0 + r) * 1024 + col0 + c;
        const f32x4 x0 = xv[(mq * 2 + pq) * 2], x1 = xv[(mq * 2 + pq) * 2 + 1];
        *(float4*)(p.out + o) = make_float4(x0[0] + v[0], x0[1] + v[1], x0[2] + v[2], x0[3] + v[3]);
        *(float4*)(p.out + o + 4) = make_float4(x1[0] + v[4], x1[1] + v[5], x1[2] + v[6], x1[3] + v[7]);
    });
}

__device__ void peerq_tile(const Params& p, int rt, int ct, unsigned char* smem, GemmPipe& pp, bool hn, int nrt, int nct) {
    const int row0 = rt * 128, col0 = ct * 128;
    f32x4 acc[4][4]; acc_zero(acc);
    const GemmOp op{(const bf16_t*)(p.ws + OFF_MERGED) + (size_t)row0 * 1024, (const bf16_t*)(p.ws + OFF_WPQT) + (size_t)col0 * 1024, 1024, 1024};
    const GemmOp nx{(const bf16_t*)(p.ws + OFF_MERGED) + (size_t)nrt * 128 * 1024, (const bf16_t*)(p.ws + OFF_WPQT) + (size_t)nct * 128 * 1024, 1024, 1024};
    gemm_tile(op, 1024, acc, smem, pp);
    if (hn) gemm_prefetch(nx, smem, pp);
    bf16_t* dst = (bf16_t*)(p.ws + OFF_QPEER) + col0;
    epi_foreach(acc, [&](int r, int c, float (&v)[8], int, int) { store_bf16x8(dst + (size_t)(row0 + r) * 2048 + c, v); });
}

__device__ __forceinline__ int sortable(float v) { int k = __float_as_int(v); return k ^ ((k >> 31) & 0x7fffffff); }
__device__ __forceinline__ float unsortable(int k) { return __int_as_float(k ^ ((k >> 31) & 0x7fffffff)); }
__device__ __forceinline__ void insert16(int (&lst)[16], int x) {
#pragma unroll
    for (int k = 0; k < 16; ++k) { const int hi = max(lst[k], x); x = min(lst[k], x); lst[k] = hi; }
}
__device__ void scores_tile(const Params& p, int rt, int pq, unsigned char* smem) {
    const int row0 = rt * 128;
    f32x4 acc[4][4]; acc_zero(acc);
    const GemmOp op{(const bf16_t*)(p.ws + OFF_QPEER) + (size_t)row0 * 2048 + pq * 128, (const bf16_t*)(p.ws + OFF_SUBK) + (size_t)pq * 128 * 128, 2048, 128};
    GemmPipe pp{0, false};
    gemm_tile(op, 128, acc, smem, pp);
    float* sc = (float*)smem;
    __syncthreads();
    epi_foreach(acc, [&](int r, int c, float (&v)[8], int, int) {
        *(float4*)(sc + r * 132 + c) = make_float4(v[0], v[1], v[2], v[3]);
        *(float4*)(sc + r * 132 + c + 4) = make_float4(v[4], v[5], v[6], v[7]); });
    __syncthreads();
    {
        const int t = tidx(), r = t & 127, hf = t >> 7;
        int lst[16];
#pragma unroll
        for (int k = 0; k < 16; ++k) lst[k] = (int)0x80000000;
#pragma unroll 2
        for (int j4 = 0; j4 < 16; ++j4) {
            const int j = hf * 64 + j4 * 4;
            const float4 v = *(const float4*)(sc + r * 132 + j);
            insert16(lst, (sortable(v.x) & ~127) | (j + 0));
            insert16(lst, (sortable(v.y) & ~127) | (j + 1));
            insert16(lst, (sortable(v.z) & ~127) | (j + 2));
            insert16(lst, (sortable(v.w) & ~127) | (j + 3));
        }
        __syncthreads();
        int* ls = (int*)smem;
        if (hf) {
#pragma unroll
            for (int k = 0; k < 16; ++k) ls[t * 16 + k] = lst[15 - k];
        }
        __syncthreads();
        if (!hf) {
#pragma unroll
            for (int k = 0; k < 16; ++k) lst[k] = max(lst[k], ls[(t + 128) * 16 + k]);
#pragma unroll
            for (int s = 8; s >= 1; s >>= 1)
#pragma unroll
                for (int k = 0; k < 16; ++k)
                    if ((k & s) == 0) { const int hi = max(lst[k], lst[k + s]), lo = min(lst[k], lst[k + s]); lst[k] = hi; lst[k + s] = lo; }
            int4* dst = (int4*)((int*)(p.ws + OFF_TOPL) + ((size_t)(row0 + r) * 16 + pq) * 16);
            dst[0] = make_int4(lst[0], lst[1], lst[2], lst[3]); dst[1] = make_int4(lst[4], lst[5], lst[6], lst[7]);
            dst[2] = make_int4(lst[8], lst[9], lst[10], lst[11]); dst[3] = make_int4(lst[12], lst[13], lst[14], lst[15]);
        }
    }
    __syncthreads();
}

__device__ void combine_item(const Params& p, int item) {
    const int tok = item >> 3, hd = item & 7;
    const int* l0 = (const int*)(p.ws + OFF_TOPL) + ((size_t)tok * 16 + hd * 2) * 16;
    const int* l1 = l0 + 16;
    int k0[16], k1[16];
#pragma unroll
    for (int i = 0; i < 4; ++i) {
        const int4 a = ((const int4*)l0)[i], b = ((const int4*)l1)[i];
        k0[4 * i] = a.x; k0[4 * i + 1] = a.y; k0[4 * i + 2] = a.z; k0[4 * i + 3] = a.w;
        k1[4 * i] = b.x; k1[4 * i + 1] = b.y; k1[4 * i + 2] = b.z; k1[4 * i + 3] = b.w;
    }
    float v0[16], v1[16];
#pragma unroll
    for (int i = 0; i < 16; ++i) { v0[i] = unsortable(k0[i] & ~127); v1[i] = unsortable(k1[i] & ~127); }
    int lst[16];
#pragma unroll
    for (int k = 0; k < 16; ++k) lst[k] = (int)0x80000000;
#pragma unroll
    for (int a = 0; a < 16; ++a)
#pragma unroll
        for (int b = 0; b < 16; ++b)
            if ((a + 1) * (b + 1) <= 16) insert16(lst, (sortable(v0[a] + v1[b]) & ~255) | (a * 16 + b));
    float val[16], sum = 0.f;
    const float mx = unsortable(lst[0] & ~255);
#pragma unroll
    for (int k = 0; k < 16; ++k) { val[k] = __expf(unsortable(lst[k] & ~255) - mx); sum += val[k]; }
    const float inv = 1.0f / sum;
    int* ei = (int*)(p.ws + OFF_EIDX) + (size_t)tok * 128 + hd * 16;
    float* eg = (float*)(p.ws + OFF_EGATE) + (size_t)tok * 128 + hd * 16;
#pragma unroll
    for (int k = 0; k < 16; ++k) {
        const int code = lst[k] & 255, a = code >> 4, b = code & 15;
        ei[k] = (l0[a] & 127) * 128 + (l1[b] & 127);
        eg[k] = val[k] * inv;
    }
}

__device__ __forceinline__ void conv_row_fp8(const float* __restrict__ src, unsigned char* __restrict__ dst, float* __restrict__ scale, int row, int lane) {
    const float4* s = (const float4*)(src + (size_t)row * 1024 + lane * 16);
    float4 v[4]; float am = 0.f;
#pragma unroll
    for (int i = 0; i < 4; ++i) { v[i] = s[i]; am = fmaxf(am, fmaxf(fmaxf(fabsf(v[i].x), fabsf(v[i].y)), fmaxf(fabsf(v[i].z), fabsf(v[i].w)))); }
#pragma unroll
    for (int o = 32; o >= 1; o >>= 1) am = fmaxf(am, __shfl_xor(am, o));
    const float sc = am > 0.f ? am * (1.0f / 224.0f) : 1.0f, inv = 1.0f / sc;
    unsigned w[4];
#pragma unroll
    for (int i = 0; i < 4; ++i) {
        int t = __builtin_amdgcn_cvt_pk_fp8_f32(v[i].x * inv, v[i].y * inv, 0, false);
        t = __builtin_amdgcn_cvt_pk_fp8_f32(v[i].z * inv, v[i].w * inv, t, true);
        w[i] = (unsigned)t;
    }
    *(uint4*)(dst + (size_t)row * 1024 + lane * 16) = make_uint4(w[0], w[1], w[2], w[3]);
    if (lane == 0) scale[row] = sc;
}
__device__ __forceinline__ void load8rows(uint4 (&R)[8], const unsigned char* __restrict__ tab, int es, int l0, int lane) {
#pragma unroll
    for (int j = 0; j < 8; ++j) {
        const int id = __builtin_amdgcn_readlane(es, l0 + j);
        R[j] = *(const uint4*)(tab + (size_t)id * 1024 + lane * 16);
    }
}
__device__ __forceinline__ float dot16q(const uint4& r, const float (&h)[16]) {
    const unsigned q[4] = {r.x, r.y, r.z, r.w};
    float d0 = 0.f, d1 = 0.f;
#pragma unroll
    for (int i = 0; i < 4; ++i) {
        const f32x2v a = __builtin_amdgcn_cvt_pk_f32_fp8((int)q[i], false), b = __builtin_amdgcn_cvt_pk_f32_fp8((int)q[i], true);
        d0 += a.x * h[4 * i]; d1 += a.y * h[4 * i + 1]; d0 += b.x * h[4 * i + 2]; d1 += b.y * h[4 * i + 3];
    }
    return d0 + d1;
}
__device__ __forceinline__ float dots8(const uint4 (&R)[8], const float (&h)[16], int lane) {
    float pd[8];
#pragma unroll
    for (int j = 0; j < 8; ++j) pd[j] = dot16q(R[j], h);
    const bool b5 = (lane & 32) != 0, b4 = (lane & 16) != 0, b3 = (lane & 8) != 0;
    float a[4];
#pragma unroll
    for (int j = 0; j < 4; ++j) { const float keep = b5 ? pd[4 + j] : pd[j], send = b5 ? pd[j] : pd[4 + j]; a[j] = keep + __shfl_xor(send, 32); }
    float c[2];
#pragma unroll
    for (int j = 0; j < 2; ++j) { const float keep = b4 ? a[2 + j] : a[j], send = b4 ? a[j] : a[2 + j]; c[j] = keep + __shfl_xor(send, 16); }
    float kk;
    { const float keep = b3 ? c[1] : c[0], send = b3 ? c[0] : c[1]; kk = keep + __shfl_xor(send, 8); }
    kk += __shfl_xor(kk, 4); kk += __shfl_xor(kk, 2); kk += __shfl_xor(kk, 1);
    return kk;
}
__device__ __forceinline__ void axpy8(float (&o)[16], const uint4 (&R)[8], int wsr, int bb) {
#pragma unroll
    for (int j = 0; j < 8; ++j) {
        const float c = __int_as_float(__builtin_amdgcn_readlane(wsr, 8 * j + bb));
        const unsigned q[4] = {R[j].x, R[j].y, R[j].z, R[j].w};
#pragma unroll
        for (int i = 0; i < 4; ++i) {
            const f32x2v a = __builtin_amdgcn_cvt_pk_f32_fp8((int)q[i], false), b = __builtin_amdgcn_cvt_pk_f32_fp8((int)q[i], true);
            o[4 * i] += c * a.x; o[4 * i + 1] += c * a.y; o[4 * i + 2] += c * b.x; o[4 * i + 3] += c * b.y;
        }
    }
}
__device__ void gather_token(const Params& p, int tok, int lane) {
    const bf16_t* h2 = (const bf16_t*)(p.ws + OFF_MERGED) + (size_t)tok * 1024 + lane * 16;
    const unsigned char* Uq = p.ws + OFF_UB; const unsigned char* Vq = p.ws + OFF_VB;
    const float* SU = (const float*)(p.ws + OFF_SU); const float* SV = (const float*)(p.ws + OFF_SV);
    const int* ei = (const int*)(p.ws + OFF_EIDX) + (size_t)tok * 128;
    const float* eg = (const float*)(p.ws + OFF_EGATE) + (size_t)tok * 128;
    float h[16];
    {
        const uint4 ha = *(const uint4*)h2, hb = *(const uint4*)(h2 + 8);
        const unsigned hq[8] = {ha.x, ha.y, ha.z, ha.w, hb.x, hb.y, hb.z, hb.w};
#pragma unroll
        for (int e = 0; e < 8; ++e) { h[2 * e] = bflo(hq[e]); h[2 * e + 1] = bfhi(hq[e]); }
    }
    const int pe = 8 * (lane & 7) + (lane >> 3);
    int es[2], wsr[2] = {0, 0}; float su[2], gv[2];
#pragma unroll
    for (int k = 0; k < 2; ++k) {
        es[k] = ei[64 * k + lane];
        const int e = ei[64 * k + pe];
        su[k] = SU[e]; gv[k] = eg[64 * k + pe] * SV[e];
    }
    uint4 R0[8], R1[8];
#pragma unroll
    for (int k = 0; k < 2; ++k) {
        load8rows(R0, Uq, es[k], 0, lane);
        for (int bb = 0; bb < 8; bb += 2) {
            load8rows(R1, Uq, es[k], 8 * bb + 8, lane);
            { const float w = gelu_tanh(dots8(R0, h, lane) * su[k]) * gv[k]; if ((lane & 7) == bb) wsr[k] = __float_as_int(w); }
            if (bb + 2 < 8) load8rows(R0, Uq, es[k], 8 * bb + 16, lane);
            { const float w = gelu_tanh(dots8(R1, h, lane) * su[k]) * gv[k]; if ((lane & 7) == bb + 1) wsr[k] = __float_as_int(w); }
        }
    }
    float o[16];
#pragma unroll
    for (int e = 0; e < 16; ++e) o[e] = 0.f;
#pragma unroll
    for (int k = 0; k < 2; ++k) {
        load8rows(R0, Vq, es[k], 0, lane);
        for (int bb = 0; bb < 8; bb += 2) {
            load8rows(R1, Vq, es[k], 8 * bb + 8, lane);
            axpy8(o, R0, wsr[k], bb);
            if (bb + 2 < 8) load8rows(R0, Vq, es[k], 8 * bb + 16, lane);
            axpy8(o, R1, wsr[k], bb + 1);
        }
    }
    float* xr = p.out + (size_t)tok * 1024 + lane * 16;
    float4 x[4]; float ss = 0.f;
#pragma unroll
    for (int i = 0; i < 4; ++i) {
        x[i] = *(const float4*)(xr + 4 * i);
        x[i].x += o[4 * i]; x[i].y += o[4 * i + 1]; x[i].z += o[4 * i + 2]; x[i].w += o[4 * i + 3];
        ss += x[i].x * x[i].x + x[i].y * x[i].y + x[i].z * x[i].z + x[i].w * x[i].w;
    }
    ss = wave_sum(ss);
    const float rs = rsqrtf(ss * (1.0f / 1024.0f) + EPS);
    const float* gf = p.g_final + lane * 16;
#pragma unroll
    for (int i = 0; i < 4; ++i) {
        const float4 gg = *(const float4*)(gf + 4 * i);
        *(float4*)(xr + 4 * i) = make_float4(x[i].x * rs * gg.x, x[i].y * rs * gg.y, x[i].z * rs * gg.z, x[i].w * rs * gg.w);
    }
}


__device__ __forceinline__ void fp8x16_to_f32(const uint4& r, float (&f)[16]) {
    const unsigned q[4] = {r.x, r.y, r.z, r.w};
#pragma unroll
    for (int i = 0; i < 4; ++i) {
        const f32x2v a = __builtin_amdgcn_cvt_pk_f32_fp8((int)q[i], false), b = __builtin_amdgcn_cvt_pk_f32_fp8((int)q[i], true);
        f[4 * i] = a.x; f[4 * i + 1] = a.y; f[4 * i + 2] = b.x; f[4 * i + 3] = b.y;
    }
}
__device__ __forceinline__ float sum8_dpp(float v) {
    v += __int_as_float(__builtin_amdgcn_mov_dpp(__float_as_int(v), 0xB1, 0xF, 0xF, true));
    v += __int_as_float(__builtin_amdgcn_mov_dpp(__float_as_int(v), 0x4E, 0xF, 0xF, true));
    v += __int_as_float(__builtin_amdgcn_mov_dpp(__float_as_int(v), 0x141, 0xF, 0xF, true));
    return v;
}
__device__ __forceinline__ void peer_u_issue(u32x4 (&seg)[8], const unsigned char* Uq, int es, int gq) {
#pragma unroll
    for (int bb = 0; bb < 8; ++bb) { const int id = __shfl(es, 8 * bb + gq); seg[bb] = *(const u32x4*)(Uq + (size_t)id * 1024); }
}
__device__ __forceinline__ float peer_u_half(u32x4 (&seg)[8], const float (&h)[16], int sub) {
    PIN8(seg, 0);
    float z = 0.f;
#pragma unroll
    for (int bb = 0; bb < 8; ++bb) {
        float f[16];
        fp8x16_to_f32(make_uint4(seg[bb][0], seg[bb][1], seg[bb][2], seg[bb][3]), f);
        float d0 = 0.f, d1 = 0.f;
#pragma unroll
        for (int i = 0; i < 8; ++i) { d0 += f[2 * i] * h[2 * i]; d1 += f[2 * i + 1] * h[2 * i + 1]; }
        const float d = sum8_dpp(d0 + d1);
        if (sub == bb) z = d;
    }
    return z;
}
__device__ void peer_u_pass(const Params& p, int t0, int tstep, int x, int lane) {
    const int gq = lane >> 3, sub = lane & 7;
    const int* eib = (const int*)(p.ws + OFF_EIDX);
    const bf16_t* h2b = (const bf16_t*)(p.ws + OFF_MERGED) + x * 128 + sub * 16;
    const unsigned char* Uq = p.ws + OFF_UB + x * 128 + sub * 16;
    float* Zb = (float*)(p.ws + OFF_ZBUF) + (size_t)x * 128;
    if (t0 >= NTOK) return;
    int es0 = eib[(size_t)t0 * 128 + lane], es1 = eib[(size_t)t0 * 128 + 64 + lane];
    uint4 ha = *(const uint4*)(h2b + (size_t)t0 * 1024), hb = *(const uint4*)(h2b + (size_t)t0 * 1024 + 8);
    u32x4 SA[8], SB[8];
    peer_u_issue(SA, Uq, es0, gq);
    for (int t = t0; t < NTOK; t += tstep) {
        float h[16];
        {
            const unsigned hq[8] = {ha.x, ha.y, ha.z, ha.w, hb.x, hb.y, hb.z, hb.w};
#pragma unroll
            for (int e = 0; e < 8; ++e) { h[2 * e] = bflo(hq[e]); h[2 * e + 1] = bfhi(hq[e]); }
        }
        peer_u_issue(SB, Uq, es1, gq);
        const int tn = t + tstep < NTOK ? t + tstep : t;
        es0 = eib[(size_t)tn * 128 + lane]; es1 = eib[(size_t)tn * 128 + 64 + lane];
        ha = *(const uint4*)(h2b + (size_t)tn * 1024); hb = *(const uint4*)(h2b + (size_t)tn * 1024 + 8);
        const float z0 = peer_u_half(SA, h, sub);
        peer_u_issue(SA, Uq, es0, gq);
        const float z1 = peer_u_half(SB, h, sub);
        float* Z = Zb + (size_t)t * 8 * 128;
        Z[lane] = z0; Z[64 + lane] = z1;
    }
}
__device__ void peer_coef_token(const Params& p, int tok, int lane) {
    const int pe = 8 * (lane & 7) + (lane >> 3);
    const int* ei = (const int*)(p.ws + OFF_EIDX) + (size_t)tok * 128;
    const float* eg = (const float*)(p.ws + OFF_EGATE) + (size_t)tok * 128;
    const float* SU = (const float*)(p.ws + OFF_SU); const float* SV = (const float*)(p.ws + OFF_SV);
    const float* Z = (const float*)(p.ws + OFF_ZBUF) + (size_t)tok * 8 * 128;
    float* W = (float*)(p.ws + OFF_WBUF) + (size_t)tok * 128;
#pragma unroll
    for (int k = 0; k < 2; ++k) {
        float zv[8];
#pragma unroll
        for (int x = 0; x < 8; ++x) zv[x] = Z[x * 128 + k * 64 + lane];
        const int e = ei[64 * k + pe];
        const float g = eg[64 * k + pe], su = SU[e], sv = SV[e];
        PIN8(zv, 0);
        const float z = ((zv[0] + zv[1]) + (zv[2] + zv[3])) + ((zv[4] + zv[5]) + (zv[6] + zv[7]));
        W[k * 64 + lane] = gelu_tanh(z * su) * g * sv;
    }
}
#define PINQ(a) asm volatile("" : "+v"((a)[0]), "+v"((a)[1]), "+v"((a)[2]), "+v"((a)[3]))
__device__ __forceinline__ void peer_v_issue4(u32x4 (&seg)[4], const unsigned char* Vq, int es, int gq, int bb0) {
#pragma unroll
    for (int j = 0; j < 4; ++j) { const int id = __shfl(es, 8 * (bb0 + j) + gq); seg[j] = *(const u32x4*)(Vq + (size_t)id * 1024); }
}
__device__ __forceinline__ void peer_v_quarter(u32x4 (&seg)[4], float (&o)[16], float wk, int gq, int bb0) {
    PINQ(seg);
#pragma unroll
    for (int j = 0; j < 4; ++j) {
        const float c = __shfl(wk, 8 * gq + bb0 + j);
        float f[16];
        fp8x16_to_f32(make_uint4(seg[j][0], seg[j][1], seg[j][2], seg[j][3]), f);
#pragma unroll
        for (int i = 0; i < 16; ++i) o[i] += c * f[i];
    }
}
__device__ void peer_v_pass(const Params& p, int t0, int tstep, int x, int lane) {
    const int gq = lane >> 3, sub = lane & 7;
    const int* eib = (const int*)(p.ws + OFF_EIDX);
    const float* Wb = (const float*)(p.ws + OFF_WBUF);
    const unsigned char* Vq = p.ws + OFF_VB + x * 128 + sub * 16;
    if (t0 >= NTOK) return;
    const bool b5 = (lane & 32) != 0, b4 = (lane & 16) != 0, b3 = (lane & 8) != 0;
    const int col = x * 128 + 16 * sub + (b5 ? 8 : 0) + (b4 ? 4 : 0) + (b3 ? 2 : 0);
    int es0 = eib[(size_t)t0 * 128 + lane], es1 = eib[(size_t)t0 * 128 + 64 + lane];
    float wk0 = Wb[(size_t)t0 * 128 + lane], wk1 = Wb[(size_t)t0 * 128 + 64 + lane];
    u32x4 SA[4], SB[4];
    peer_v_issue4(SA, Vq, es0, gq, 0);
    for (int t = t0; t < NTOK; t += tstep) {
        float o[16];
#pragma unroll
        for (int i = 0; i < 16; ++i) o[i] = 0.f;
        const int tn = t + tstep < NTOK ? t + tstep : t;
        const int nes0 = eib[(size_t)tn * 128 + lane], nes1 = eib[(size_t)tn * 128 + 64 + lane];
        const float nwk0 = Wb[(size_t)tn * 128 + lane], nwk1 = Wb[(size_t)tn * 128 + 64 + lane];
        int gl = gq; asm volatile("" : "+v"(gl));
        peer_v_issue4(SB, Vq, es0, gl, 4);  peer_v_quarter(SA, o, wk0, gl, 0);
        peer_v_issue4(SA, Vq, es1, gl, 0);  peer_v_quarter(SB, o, wk0, gl, 4);
        peer_v_issue4(SB, Vq, es1, gl, 4);  peer_v_quarter(SA, o, wk1, gl, 0);
        peer_v_issue4(SA, Vq, nes0, gl, 0); peer_v_quarter(SB, o, wk1, gl, 4);
        es0 = nes0; es1 = nes1; wk0 = nwk0; wk1 = nwk1;
        float a8[8], a4[4], a2[2];
#pragma unroll
        for (int i = 0; i < 8; ++i) { const float keep = b5 ? o[8 + i] : o[i], send = b5 ? o[i] : o[8 + i]; a8[i] = keep + __shfl_xor(send, 32); }
#pragma unroll
        for (int i = 0; i < 4; ++i) { const float keep = b4 ? a8[4 + i] : a8[i], send = b4 ? a8[i] : a8[4 + i]; a4[i] = keep + __shfl_xor(send, 16); }
#pragma unroll
        for (int i = 0; i < 2; ++i) { const float keep = b3 ? a4[2 + i] : a4[i], send = b3 ? a4[i] : a4[2 + i]; a2[i] = keep + __shfl_xor(send, 8); }
        float* xr = p.out + (size_t)t * 1024 + col;
        float2 xv = *(const float2*)xr;
        xv.x += a2[0]; xv.y += a2[1];
        *(float2*)xr = xv;
        const float ss = wave_sum(xv.x * xv.x + xv.y * xv.y);
        if (lane == 0) atomicAdd((float*)(p.ws + OFF_ROWSS) + t, ss);
    }
}
__device__ void final_norm_row(const Params& p, int tok, int lane) {
    float* xr = p.out + (size_t)tok * 1024 + lane * 16;
    const float rs = rsqrtf(((const float*)(p.ws + OFF_ROWSS))[tok] * (1.0f / 1024.0f) + EPS);
    const float* gf = p.g_final + lane * 16;
#pragma unroll
    for (int i = 0; i < 4; ++i) {
        const float4 v = *(const float4*)(xr + 4 * i), gg = *(const float4*)(gf + 4 * i);
        *(float4*)(xr + 4 * i) = make_float4(v.x * rs * gg.x, v.y * rs * gg.y, v.z * rs * gg.z, v.w * rs * gg.w);
    }
}

__device__ __forceinline__ bool gemm_unit(int it, int nct, int& rt, int& ct) {
    const int x = blockIdx.x & 7, j = blockIdx.x >> 3, nbx = gridDim.x >> 3;
    const int v = j + it * nbx, per_rg = 8 * nct;
    if (v >= 32 * nct) return false;
    const int rgi = v / per_rg, w = v - rgi * per_rg, cg = w >> 6, w2 = w & 63;
    const int rtl = w2 & 7, ctl = w2 >> 3;
    rt = (rgi * 8 + rtl) * 8 + x; ct = cg * 8 + ctl;
    return true;
}

#define XB_TMO      128
#define XB_XCNT(j)  (256  + 64 * (j))
#define XB_XSUB(j)  (1280 + 64 * (j))
#define XB_XGEN(j)  (2304 + 64 * (j))
#define XB_TOP      3328
#define XB_TOPGEN   3392
#define XCD_BAR_WORDS 3456
#define XB_SPIN_CAP (1u << 22)
#define LAS __attribute__((address_space(3)))
__device__ __forceinline__ unsigned xb_ld(unsigned* p)              { return __hip_atomic_load(p, __ATOMIC_RELAXED, __HIP_MEMORY_SCOPE_AGENT); }
__device__ __forceinline__ unsigned xb_add(unsigned* p, unsigned v) { return __hip_atomic_fetch_add(p, v, __ATOMIC_RELAXED, __HIP_MEMORY_SCOPE_AGENT); }
__device__ __forceinline__ unsigned xb_xcc_id() { return (unsigned)__builtin_amdgcn_s_getreg((3 << 11) | 20) & 0xFu; }
#define XB_SPIN(cond, bar) do { unsigned _sp = 0; while (cond) { __builtin_amdgcn_s_sleep(1); \
    if ((++_sp & 255u) == 0u) { if (xb_ld(&(bar)[XB_TMO])) break; if (_sp > XB_SPIN_CAP) { atomicAdd(&(bar)[XB_TMO], 1u); break; } } } } while (0)
struct XcdBarrier { unsigned* bar; unsigned x; volatile LAS unsigned* st; };
__device__ __forceinline__ XcdBarrier xcd_barrier_post(unsigned* bar, volatile LAS unsigned* st) {
    XcdBarrier b; b.bar = bar; b.x = xb_xcc_id(); b.st = st;
    if (threadIdx.x == 0) (void)xb_add(&bar[XB_XCNT(b.x)], 1u);
    return b;
}
__device__ __forceinline__ void xcd_barrier_complete(unsigned* bar, unsigned x, unsigned& nloc, unsigned& nx) {
    const unsigned G = gridDim.x;
    unsigned sum, cnt, mine, sp = 0u;
    for (;;) {
        sum = 0u; cnt = 0u; mine = 0u;
#pragma unroll
        for (unsigned j = 0; j < 16; ++j) { const unsigned c = xb_ld(&bar[XB_XCNT(j)]); sum += c; cnt += (c > 0u) ? 1u : 0u; mine = (j == x) ? c : mine; }
        if (sum == G) break;
        __builtin_amdgcn_s_sleep(1);
        if ((++sp & 255u) == 0u) { if (xb_ld(&bar[XB_TMO])) break; if (sp > XB_SPIN_CAP) { atomicAdd(&bar[XB_TMO], 1u); break; } }
    }
    nloc = mine > 0u ? mine : 1u; nx = cnt > 0u ? cnt : 1u;
}
__device__ __forceinline__ void xcd_barrier(const XcdBarrier& b) {
    asm volatile("s_waitcnt vmcnt(0)" ::: "memory");
    __syncthreads();
    if (threadIdx.x == 0) {
        unsigned* bar = b.bar;
        __builtin_amdgcn_s_waitcnt(0);
        unsigned nloc = b.st[0], nx = b.st[1];
        if (nloc == 0u) { xcd_barrier_complete(bar, b.x, nloc, nx); b.st[0] = nloc; b.st[1] = nx; }
        const unsigned old = xb_add(&bar[XB_XSUB(b.x)], 1u);
        const unsigned gen = old / nloc;
        if (old + 1u == (gen + 1u) * nloc) {
            __builtin_amdgcn_fence(__ATOMIC_RELEASE, "agent");
            asm volatile("s_waitcnt vmcnt(0)" ::: "memory");
            const unsigned og = xb_add(&bar[XB_TOP], 1u);
            const unsigned tg = og / nx;
            if (og + 1u == (tg + 1u) * nx) xb_add(&bar[XB_TOPGEN], 1u);
            else XB_SPIN(xb_ld(&bar[XB_TOPGEN]) == tg, bar);
            __builtin_amdgcn_fence(__ATOMIC_ACQUIRE, "agent");
            xb_add(&bar[XB_XGEN(b.x)], 1u);
            asm volatile("s_waitcnt vmcnt(0)" ::: "memory");
        } else {
            XB_SPIN(xb_ld(&bar[XB_XGEN(b.x)]) == gen, bar);
            __builtin_amdgcn_fence(__ATOMIC_ACQUIRE, "agent");
            asm volatile("s_waitcnt vmcnt(0)" ::: "memory");
        }
    }
    __syncthreads();
}

#ifndef PROBE_PHASE
#define PROBE_PHASE -1
#endif
#define PH_BEGIN(k) if (PROBE_PHASE == (k)) probe_t0 = __builtin_amdgcn_s_memrealtime();
#define PH_END(k)   if (PROBE_PHASE == (k)) probe_dt = __builtin_amdgcn_s_memrealtime() - probe_t0;
constexpr int SMEM_BYTES = 128 * 132 * 4 + 1024;

__global__ void __launch_bounds__(256, 2) fwd_megakernel(Params p) {
    __shared__ __attribute__((aligned(16))) unsigned char smem[SMEM_BYTES + 16];
    if (threadIdx.x == 0) *(uint4*)(smem + SMEM_BYTES) = make_uint4(0u, 0u, 0u, 0u);
    __syncthreads();
    const XcdBarrier xb = xcd_barrier_post((unsigned*)(p.ws + OFF_BAR), (volatile LAS unsigned*)(smem + SMEM_BYTES));
    const int bid = blockIdx.x, nb = gridDim.x, tid = tidx(), lane = tid & 63, wid = tid >> 6;
    unsigned char* ws = p.ws; unsigned char* dob = (unsigned char*)p.out;
    unsigned long long probe_t0 = 0, probe_dt = 0;
    PH_BEGIN(0)
    {
        for (int u = bid; u < 3232; u += nb) {
            if (u < 1600) convT_tile(p.w_in, (bf16_t*)(ws + OFF_WINT), 1024, INW, u, smem);
            else if (u < 1856) convT_tile(p.w_mem_kv, (bf16_t*)(ws + OFF_WMKVT), 1024, 1024, u - 1600, smem);
            else if (u < 2048) convT_tile(p.p_attn, (bf16_t*)(ws + OFF_PATTNT), 768, 1024, u - 1856, smem);
            else if (u < 2240) convT_tile(p.p_lru, (bf16_t*)(ws + OFF_PLRUT), 768, 1024, u - 2048, smem);
            else if (u < 2368) convT_tile(p.p_mem, (bf16_t*)(ws + OFF_PMEMT), 512, 1024, u - 2240, smem);
            else if (u < 2624) convT_tile(p.w_out, (bf16_t*)(ws + OFF_WOUTT), 1024, 1024, u - 2368, smem);
            else if (u < 3136) convT_tile(p.w_peer_q, (bf16_t*)(ws + OFF_WPQT), 1024, 2048, u - 2624, smem);
            else {
                const int v = u - 3136, mat = v >> 2, tile = v & 3, gsel = mat / 6, h = mat % 6, dir = gsel & 1;
                const float* src = (gsel < 2 ? p.lru_wr : p.lru_wi) + (size_t)(dir * 6 + h) * 128 * 128;
                convT_tile(src, (bf16_t*)(ws + OFF_LRUWT) + (size_t)(h * 512 + gsel * 128) * 128, 128, 128, tile, smem);
            }
        }
        conv_plain(p.peer_sub_keys, (bf16_t*)(ws + OFF_SUBK), (size_t)16 * 128 * 128 / 8);
        for (int r = bid * 4 + wid; r < 2 * NEXP; r += nb * 4) {
            if (r < NEXP) conv_row_fp8(p.peer_u, ws + OFF_UB, (float*)(ws + OFF_SU), r, lane);
            else conv_row_fp8(p.peer_v, ws + OFF_VB, (float*)(ws + OFF_SV), r - NEXP, lane);
        }
        for (int r = bid * 4 + wid; r < NTOK; r += nb * 4) rms_row_bf16(p.x + (size_t)r * 1024, p.g_mix, (bf16_t*)(dob + DO_HBF) + (size_t)r * 1024, lane);
        for (int r = bid * 4 + wid; r < NMEM; r += nb * 4) rms_row_bf16(p.mem + (size_t)r * 1024, p.g_mem, (bf16_t*)(dob + DO_MEMBF) + (size_t)r * 1024, lane);
        for (int i = bid * 256 + tid; i < NTOK * 16; i += nb * 256) rope_item(p.positions, (float*)(dob + DO_ROPE), i);
        for (int i = bid * 256 + tid; i < NTOK; i += nb * 256) ((float*)(ws + OFF_ROWSS))[i] = 0.f;
        for (int i = bid * 256 + tid; i < 2 * LW; i += nb * 256) ((float*)(ws + OFF_SP8))[i] = -8.0f * 1.4426950408889634f * log1pf(__expf(-p.lru_lambda[i]));
    }
    xcd_barrier(xb);
    PH_END(0) PH_BEGIN(1)
    for (int u = bid; u < 256; u += nb) memkv_tile(p, u / 8, u % 8, smem);
    { GemmPipe pp{0, false}; int rt, ct, nrt = 0, nct = 0; bool have = gemm_unit(0, 50, rt, ct); __syncthreads();
      for (int it = 0; have; ++it) { const bool hn = gemm_unit(it + 1, 50, nrt, nct); inproj_tile(p, rt, ct, smem, pp, hn, nrt, nct); rt = nrt; ct = nct; have = hn; } }
    xcd_barrier(xb);
    PH_END(1) PH_BEGIN(2)
    {
        unsigned* ctr = (unsigned*)(p.ws + OFF_BAR) + 3600;
        volatile LAS unsigned* slot = (volatile LAS unsigned*)(smem + SMEM_BYTES + 8);
        for (;;) {
            if (tid == 0) *slot = xb_add(ctr, 1u);
            __syncthreads();
            const int u = (int)*slot;
            __syncthreads();
            if (u >= 1536 + 1536 + 1024) break;
            if (u < 1536) lru_chunk_unit<false>(p, u, smem);
            else if (u < 1536 + 1536) attn_win_unit(p, u - 1536, smem);
            else attn_mem_unit(p, u - 1536 - 1536, smem);
        }
    }
    xcd_barrier(xb);
    for (int u = bid; u < 1536; u += nb) lru_chunk_unit<true>(p, u, smem);
    xcd_barrier(xb);
    PH_END(2) PH_BEGIN(3)
    { GemmPipe pp{0, false}; int rt, ct, nrt = 0, nct = 0; bool have = gemm_unit(0, 8, rt, ct); __syncthreads();
      for (int it = 0; have; ++it) { const bool hn = gemm_unit(it + 1, 8, nrt, nct); merge_tile(p, rt, ct, smem, pp, hn, nrt, nct); rt = nrt; ct = nct; have = hn; } }
    xcd_barrier(xb);
    PH_END(3) PH_BEGIN(4)
    { GemmPipe pp{0, false}; int rt, ct, nrt = 0, nct = 0; bool have = gemm_unit(0, 8, rt, ct); __syncthreads();
      for (int it = 0; have; ++it) { const bool hn = gemm_unit(it + 1, 8, nrt, nct); outproj_tile(p, rt, ct, smem, pp, hn, nrt, nct); rt = nrt; ct = nct; have = hn; } }
    xcd_barrier(xb);
    PH_END(4) PH_BEGIN(5)
    for (int r = bid * 4 + wid; r < NTOK; r += nb * 4) rms_row_bf16(p.out + (size_t)r * 1024, p.g_ffn, (bf16_t*)(ws + OFF_MERGED) + (size_t)r * 1024, lane);
    xcd_barrier(xb);
    PH_END(5) PH_BEGIN(6)
    { GemmPipe pp{0, false}; int rt, ct, nrt = 0, nct = 0; bool have = gemm_unit(0, 16, rt, ct); __syncthreads();
      for (int it = 0; have; ++it) { const bool hn = gemm_unit(it + 1, 16, nrt, nct); peerq_tile(p, rt, ct, smem, pp, hn, nrt, nct); rt = nrt; ct = nct; have = hn; } }
    xcd_barrier(xb);
    PH_END(6) PH_BEGIN(7)
    for (int u = bid; u < 256 * 16; u += nb) scores_tile(p, u / 16, u % 16, smem);
    xcd_barrier(xb);
    PH_END(7) PH_BEGIN(8)
    for (int i = bid * 256 + tid; i < NTOK * 8; i += nb * 256) combine_item(p, i);
    xcd_barrier(xb);
    PH_END(8) PH_BEGIN(9)
    {
        const int x = bid & 7, tstep = (nb >> 3) * 4;
        peer_u_pass(p, (bid >> 3) * 4 + wid, tstep, x, lane);
        xcd_barrier(xb);
        for (int t = bid * 4 + wid; t < NTOK; t += nb * 4) peer_coef_token(p, t, lane);
        xcd_barrier(xb);
        peer_v_pass(p, (bid >> 3) * 4 + wid, tstep, x, lane);
        xcd_barrier(xb);
        for (int t = bid * 4 + wid; t < NTOK; t += nb * 4) final_norm_row(p, t, lane);
    }
    PH_END(9)
    if (PROBE_PHASE >= 0) { __syncthreads(); const unsigned long long t1 = __builtin_amdgcn_s_memrealtime(); while (__builtin_amdgcn_s_memrealtime() - t1 < probe_dt) __builtin_amdgcn_s_sleep(8); }
}

extern "C" void kernel_launch(void* const* d_in, const int* in_sizes, int n_in, void* d_out, int out_size, void* d_ws, size_t ws_size, hipStream_t stream) {
    if (ws_size < OFF_END) { fprintf(stderr, "workspace too small: %zu < %zu\n", ws_size, (size_t)OFF_END); return; }
    Params p{};
    p.x = (const float*)d_in[0]; p.mem = (const float*)d_in[1]; p.positions = (const int*)d_in[2];
    p.g_mix = (const float*)d_in[3]; p.g_mem = (const float*)d_in[4]; p.w_in = (const float*)d_in[5]; p.gate_b = (const float*)d_in[6];
    p.attn_sink = (const float*)d_in[7]; p.conv_w = (const float*)d_in[8]; p.conv_b = (const float*)d_in[9];
    p.lru_wr = (const float*)d_in[10]; p.lru_br = (const float*)d_in[11]; p.lru_wi = (const float*)d_in[12]; p.lru_bi = (const float*)d_in[13];
    p.lru_lambda = (const float*)d_in[14]; p.w_mem_kv = (const float*)d_in[15]; p.p_attn = (const float*)d_in[16]; p.p_lru = (const float*)d_in[17];
    p.p_mem = (const float*)d_in[18]; p.w_out = (const float*)d_in[19]; p.g_ffn = (const float*)d_in[20]; p.w_peer_q = (const float*)d_in[21];
    p.peer_sub_keys = (const float*)d_in[22]; p.peer_u = (const float*)d_in[23]; p.peer_v = (const float*)d_in[24]; p.g_final = (const float*)d_in[25];
    p.out = (float*)d_out; p.ws = (unsigned char*)d_ws;
    static int grid_blocks = 0;
    if (!grid_blocks) {
        int dev = 0, cus = 0, per_cu = 0;
        (void)hipGetDevice(&dev);
        (void)hipDeviceGetAttribute(&cus, hipDeviceAttributeMultiprocessorCount, dev);
        (void)hipOccupancyMaxActiveBlocksPerMultiprocessor(&per_cu, fwd_megakernel, 256, 0);
        if (per_cu > 2) per_cu = 2;
        grid_blocks = cus * per_cu;
    }
    (void)hipMemsetAsync((unsigned char*)d_ws + OFF_BAR, 0, 16384, stream);
    void* args[] = {&p};
    hipError_t e = hipLaunchCooperativeKernel((void*)fwd_megakernel, dim3(grid_blocks), dim3(256), args, 0, stream);
    if (e != hipSuccess) fprintf(stderr, "cooperative launch failed: %s (grid %d)\n", hipGetErrorString(e), grid_blocks);
}
```

```cpp
#include <hip/hip_runtime.h>
#include <stdint.h>
#include <stdio.h>

typedef unsigned short bf16_t;
typedef short bf16x8 __attribute__((ext_vector_type(8)));
typedef __bf16 bf16x2v __attribute__((ext_vector_type(2)));
typedef float f32x4 __attribute__((ext_vector_type(4)));

constexpr int B_ = 16, S_ = 2048, D_ = 1024, NTOK = B_ * S_;
constexpr int MEML = 256, NMEM = B_ * MEML;
constexpr int INW = 6400;
constexpr int LW = 768;
constexpr int NEXP = 16384;
constexpr float EPS = 1e-6f;
constexpr float QSCALE = 0.08838834764831845f * 1.4426950408889634f;

constexpr size_t OFF_WINT = 0;
constexpr size_t OFF_WMKVT = OFF_WINT + (size_t)INW * 1024 * 2;
constexpr size_t OFF_PATTNT = OFF_WMKVT + (size_t)1024 * 1024 * 2;
constexpr size_t OFF_PLRUT = OFF_PATTNT + (size_t)1024 * 768 * 2;
constexpr size_t OFF_PMEMT = OFF_PLRUT + (size_t)1024 * 768 * 2;
constexpr size_t OFF_WOUTT = OFF_PMEMT + (size_t)1024 * 512 * 2;
constexpr size_t OFF_WPQT = OFF_WOUTT + (size_t)1024 * 1024 * 2;
constexpr size_t OFF_LRUWT = OFF_WPQT + (size_t)2048 * 1024 * 2;
constexpr size_t OFF_SUBK = OFF_LRUWT + (size_t)6 * 512 * 128 * 2;
constexpr size_t OFF_UB = OFF_SUBK + (size_t)16 * 128 * 128 * 2;
constexpr size_t OFF_VB = OFF_UB + (size_t)NEXP * 1024;
constexpr size_t OFF_SU = OFF_VB + (size_t)NEXP * 1024;
constexpr size_t OFF_SV = OFF_SU + (size_t)NEXP * 4;
constexpr size_t OFF_RA = OFF_SV + (size_t)NEXP * 4;
constexpr size_t OFF_QA = OFF_RA;
constexpr size_t OFF_KA = OFF_QA + (size_t)NTOK * 768 * 2;
constexpr size_t OFF_VAT = OFF_KA + (size_t)NTOK * 256 * 2;
constexpr size_t OFF_XL = OFF_VAT + (size_t)NTOK * 256 * 2;
constexpr size_t OFF_GL = OFF_XL + (size_t)NTOK * 768 * 2;
constexpr size_t OFF_QM = OFF_GL + (size_t)NTOK * 768 * 2;
constexpr size_t OFF_GATES = OFF_QM + (size_t)NTOK * 512 * 2;
constexpr size_t OFF_BAR = OFF_GATES + (size_t)NTOK * 3072 * 2;
constexpr size_t OFF_SP8 = OFF_BAR + 16384;
constexpr size_t OFF_AGG = OFF_SP8 + 2 * 768 * 4;
constexpr size_t OFF_ROWSS = OFF_AGG + (size_t)2 * B_ * 16 * 768 * 8;
constexpr size_t OFF_END = OFF_ROWSS + (size_t)NTOK * 4;
constexpr size_t OFF_MERGED = OFF_KA;
constexpr size_t OFF_QPEER = OFF_GATES;
constexpr size_t OFF_TOPL = OFF_QPEER + (size_t)NTOK * 2048 * 2;
constexpr size_t OFF_EIDX = OFF_TOPL + (size_t)NTOK * 256 * 4;
constexpr size_t OFF_ZBUF = OFF_QPEER;
constexpr size_t OFF_WBUF = OFF_TOPL;
constexpr size_t OFF_EGATE = OFF_EIDX + (size_t)NTOK * 128 * 4;
static_assert(OFF_EGATE + (size_t)NTOK * 128 * 4 <= OFF_BAR, "overlay");
static_assert(OFF_MERGED + (size_t)NTOK * 1024 * 2 <= OFF_GL, "overlay2");
constexpr size_t DO_HBF = 0;
constexpr size_t DO_MEMBF = DO_HBF + (size_t)NTOK * 1024 * 2;
constexpr size_t DO_KM = DO_MEMBF + (size_t)NMEM * 1024 * 2;
constexpr size_t DO_VMT = DO_KM + (size_t)NMEM * 512 * 2;
constexpr size_t DO_ROPE = DO_VMT + (size_t)NMEM * 512 * 2;
static_assert(DO_ROPE + (size_t)NTOK * 32 * 4 <= (size_t)NTOK * 1024 * 4, "d_out scratch");

struct Params {
    const float *x, *mem; const int* positions;
    const float *g_mix, *g_mem, *w_in, *gate_b, *attn_sink, *conv_w, *conv_b, *lru_wr, *lru_br, *lru_wi, *lru_bi, *lru_lambda,
        *w_mem_kv, *p_attn, *p_lru, *p_mem, *w_out, *g_ffn, *w_peer_q, *peer_sub_keys, *peer_u, *peer_v, *g_final;
    float* out; unsigned char* ws;
};

__device__ __forceinline__ int tidx() { int t = threadIdx.x & 255; asm volatile("" : "+v"(t)); return t; }
__device__ __forceinline__ int vbid() { return (int)(blockIdx.x + (threadIdx.x >> 8) * gridDim.x); }
__device__ __forceinline__ int vnb() { return (int)(2 * gridDim.x); }
__device__ __forceinline__ float bf2f(bf16_t b) { return __uint_as_float(((unsigned)b) << 16); }
__device__ __forceinline__ float bflo(unsigned u) { return __uint_as_float(u << 16); }
__device__ __forceinline__ float bfhi(unsigned u) { return __uint_as_float(u & 0xffff0000u); }
typedef float f32x2v __attribute__((ext_vector_type(2)));
__device__ __forceinline__ unsigned pack_bf16(float lo, float hi) { const f32x2v f = {lo, hi}; return __builtin_bit_cast(unsigned, __builtin_convertvector(f, bf16x2v)); }
__device__ __forceinline__ bf16_t f2bf(float f) { return (bf16_t)(pack_bf16(f, 0.f) & 0xffffu); }
__device__ __forceinline__ f32x4 mfma16(bf16x8 a, bf16x8 b, f32x4 c) { return __builtin_amdgcn_mfma_f32_16x16x32_bf16(a, b, c, 0, 0, 0); }
__device__ __forceinline__ float sigmoidf_(float x) { return __builtin_amdgcn_rcpf(1.0f + __expf(-x)); }
__device__ __forceinline__ float gelu_tanh(float x) { const float u = 1.5957691216057308f * (x + 0.044715f * x * x * x); return x * __builtin_amdgcn_rcpf(1.0f + __expf(-u)); }
__device__ __forceinline__ float wave_sum(float v) {
#pragma unroll
    for (int o = 32; o >= 1; o >>= 1) v += __shfl_xor(v, o);
    return v;
}


typedef unsigned u32x4 __attribute__((ext_vector_type(4)));
#define PIN4(a, o) asm volatile("" : "+v"((a)[(o)]), "+v"((a)[(o) + 1]), "+v"((a)[(o) + 2]), "+v"((a)[(o) + 3]))
#define PIN8(a, o) asm volatile("" : "+v"((a)[(o)]), "+v"((a)[(o) + 1]), "+v"((a)[(o) + 2]), "+v"((a)[(o) + 3]), "+v"((a)[(o) + 4]), "+v"((a)[(o) + 5]), "+v"((a)[(o) + 6]), "+v"((a)[(o) + 7]))
#define PIN15(a, o) asm volatile("" : "+v"((a)[(o)]), "+v"((a)[(o) + 1]), "+v"((a)[(o) + 2]), "+v"((a)[(o) + 3]), "+v"((a)[(o) + 4]), "+v"((a)[(o) + 5]), "+v"((a)[(o) + 6]), "+v"((a)[(o) + 7]), \
    "+v"((a)[(o) + 8]), "+v"((a)[(o) + 9]), "+v"((a)[(o) + 10]), "+v"((a)[(o) + 11]), "+v"((a)[(o) + 12]), "+v"((a)[(o) + 13]), "+v"((a)[(o) + 14]))

__device__ void convT_tile(const float* __restrict__ src, bf16_t* __restrict__ dst, int K, int N, int tile, unsigned char* smem) {
    float* t = (float*)smem;
    const int tn = N / 64, tk = tile / tn, tnn = tile % tn, k0 = tk * 64, n0 = tnn * 64, tid = tidx();
    const int r = tid >> 4, c4 = (tid & 15) * 4;
#pragma unroll
    for (int i = 0; i < 4; ++i) {
        const int k = r + 16 * i;
        const float4 v = *(const float4*)(src + (size_t)(k0 + k) * N + n0 + c4);
        t[k * 65 + c4 + 0] = v.x; t[k * 65 + c4 + 1] = v.y; t[k * 65 + c4 + 2] = v.z; t[k * 65 + c4 + 3] = v.w;
    }
    __syncthreads();
    const int n = tid >> 2, kq = (tid & 3) * 16;
    unsigned w[8];
#pragma unroll
    for (int i = 0; i < 8; ++i) w[i] = pack_bf16(t[(kq + 2 * i) * 65 + n], t[(kq + 2 * i + 1) * 65 + n]);
    uint4* d = (uint4*)(dst + (size_t)(n0 + n) * K + k0 + kq);
    d[0] = make_uint4(w[0], w[1], w[2], w[3]); d[1] = make_uint4(w[4], w[5], w[6], w[7]);
    __syncthreads();
}


__device__ __forceinline__ void rms_row_bf16(const float* __restrict__ xr, const float* __restrict__ g, bf16_t* __restrict__ o, int lane) {
    float4 v[4]; float ss = 0.f;
#pragma unroll
    for (int i = 0; i < 4; ++i) { v[i] = *(const float4*)(xr + i * 256 + lane * 4); ss += v[i].x * v[i].x + v[i].y * v[i].y + v[i].z * v[i].z + v[i].w * v[i].w; }
    ss = wave_sum(ss);
    const float rs = rsqrtf(ss * (1.0f / 1024.0f) + EPS);
#pragma unroll
    for (int i = 0; i < 4; ++i) {
        const float4 gg = *(const float4*)(g + i * 256 + lane * 4);
        *(uint2*)(o + i * 256 + lane * 4) = make_uint2(pack_bf16(v[i].x * rs * gg.x, v[i].y * rs * gg.y), pack_bf16(v[i].z * rs * gg.z, v[i].w * rs * gg.w));
    }
}


__device__ __forceinline__ void conv_plain(const float* __restrict__ src, bf16_t* __restrict__ dst, size_t n8) {
    for (size_t i = (size_t)vbid() * 256 + tidx(); i < n8; i += (size_t)vnb() * 256) {
        const float4 a = ((const float4*)src)[2 * i], b = ((const float4*)src)[2 * i + 1];
        ((uint4*)dst)[i] = make_uint4(pack_bf16(a.x, a.y), pack_bf16(a.z, a.w), pack_bf16(b.x, b.y), pack_bf16(b.z, b.w));
    }
}
__device__ __forceinline__ void rope_item(const int* __restrict__ pos, float* __restrict__ cs, int i) {
    const int t = i >> 4, f = i & 15;
    const float inv = powf(500000.0f, -(float)(2 * f) / 32.0f);
    const float ang = (float)pos[t] * inv;
    float s, c; sincosf(ang, &s, &c);
    cs[2 * i] = c; cs[2 * i + 1] = s;
}

__device__ __forceinline__ int swz(int row) { return (row & 3) | (((row >> 3) & 1) << 2); }

struct GemmOp { const bf16_t* A; const bf16_t* Bt; int lda, ldb; };
struct GemmPipe { int par; bool pre; };

__device__ __forceinline__ void gemm_issue(const GemmOp& op, int kt, int st, unsigned char* smem) {
    const int tid = tidx();
    const int srow = tid >> 3, skc = (tid & 7) ^ swz(tid >> 3);
    const bf16_t* ga = op.A + (size_t)srow * op.lda + skc * 8 + kt * 64;
    const bf16_t* gb = op.Bt + (size_t)srow * op.ldb + skc * 8 + kt * 64;
    unsigned char* sw = smem + tid * 16 + st * 32768;
#pragma unroll
    for (int i = 0; i < 4; ++i) {
        __builtin_amdgcn_global_load_lds((const unsigned*)(ga + (size_t)(32 * i) * op.lda), (unsigned*)(sw + i * 4096), 16, 0, 0);
        __builtin_amdgcn_global_load_lds((const unsigned*)(gb + (size_t)(32 * i) * op.ldb), (unsigned*)(sw + 16384 + i * 4096), 16, 0, 0);
    }
}
__device__ __forceinline__ void gemm_prefetch(const GemmOp& nx, unsigned char* smem, GemmPipe& pp) { gemm_issue(nx, 0, pp.par, smem); pp.pre = true; }

__device__ __forceinline__ void gemm_tile(const GemmOp& op, int K, f32x4 (&acc)[4][4], unsigned char* smem, GemmPipe& pp) {
    const int tid = tidx(), lane = tid & 63, wid = tid >> 6, wr = wid >> 1, wc = wid & 1, li = lane & 15, g = lane >> 4;
    int aoff[4], boff[4], asw[4], bsw[4];
#pragma unroll
    for (int m = 0; m < 4; ++m) { const int row = wr * 64 + m * 16 + li; aoff[m] = row * 128; asw[m] = swz(row); }
#pragma unroll
    for (int n = 0; n < 4; ++n) { const int row = wc * 64 + 32 * (n >> 1) + 8 * (li >> 2) + 4 * (n & 1) + (li & 3); boff[n] = 16384 + row * 128; bsw[n] = swz(row); }
    const int nk = K >> 6;
    if (!pp.pre) gemm_issue(op, 0, pp.par, smem);
    __syncthreads();
    for (int kt = 0; kt < nk; ++kt) {
        const int cur = (pp.par + kt) & 1;
        const unsigned char* sb = smem + cur * 32768;
        if (kt + 1 < nk) gemm_issue(op, kt + 1, cur ^ 1, smem);
#pragma unroll
        for (int ks = 0; ks < 2; ++ks) {
            bf16x8 af[4], bfr[4];
#pragma unroll
            for (int m = 0; m < 4; ++m) af[m] = *(const bf16x8*)(sb + aoff[m] + (((ks * 4 + g) ^ asw[m]) << 4));
#pragma unroll
            for (int n = 0; n < 4; ++n) bfr[n] = *(const bf16x8*)(sb + boff[n] + (((ks * 4 + g) ^ bsw[n]) << 4));
#pragma unroll
            for (int m = 0; m < 4; ++m)
#pragma unroll
                for (int n = 0; n < 4; ++n) acc[m][n] = mfma16(bfr[n], af[m], acc[m][n]);
        }
        if (kt + 1 < nk) __syncthreads();
    }
    pp.par = (pp.par + nk) & 1; pp.pre = false;
}
__device__ __forceinline__ void acc_zero(f32x4 (&acc)[4][4]) {
#pragma unroll
    for (int m = 0; m < 4; ++m)
#pragma unroll
        for (int n = 0; n < 4; ++n) acc[m][n] = (f32x4){0.f, 0.f, 0.f, 0.f};
}
template <class F> __device__ __forceinline__ void epi_foreach(const f32x4 (&acc)[4][4], F&& f) {
    const int lane = tidx() & 63, wid = tidx() >> 6, wr = wid >> 1, wc = wid & 1, li = lane & 15, g = lane >> 4;
#pragma unroll
    for (int m = 0; m < 4; ++m)
#pragma unroll
        for (int pp = 0; pp < 2; ++pp) {
            float v[8];
#pragma unroll
            for (int r = 0; r < 4; ++r) { v[r] = acc[m][2 * pp][r]; v[4 + r] = acc[m][2 * pp + 1][r]; }
            f(wr * 64 + m * 16 + li, wc * 64 + 32 * pp + 8 * g, v, pp, m);
        }
}
__device__ __forceinline__ void store_bf16x8(bf16_t* p, const float (&v)[8]) {
    *(uint4*)p = make_uint4(pack_bf16(v[0], v[1]), pack_bf16(v[2], v[3]), pack_bf16(v[4], v[5]), pack_bf16(v[6], v[7]));
}
__device__ __forceinline__ void store_tile_T(const f32x4 (&acc)[4][4], bf16_t* __restrict__ dstT, int ldt, unsigned char* smem) {
    bf16_t* t = (bf16_t*)smem;
    __syncthreads();
    epi_foreach(acc, [&](int r, int c, const float (&v)[8], int, int) {
#pragma unroll
        for (int e = 0; e < 8; ++e) t[(c + e) * 136 + r] = f2bf(v[e]);
    });
    __syncthreads();
#pragma unroll
    for (int i = 0; i < 8; ++i) {
        const int ch = tidx() + 256 * i, d = ch >> 4, tc = ch & 15;
        *(uint4*)(dstT + (size_t)d * ldt + tc * 8) = *(const uint4*)(smem + d * 272 + tc * 16);
    }
    __syncthreads();
}

__device__ void inproj_tile(const Params& p, int rt, int ct, unsigned char* smem, GemmPipe& pp, bool hn, int nrt, int nct) {
    unsigned char* ws = p.ws; unsigned char* dob = (unsigned char*)p.out;
    const bf16_t* hbf = (const bf16_t*)(dob + DO_HBF);
    const bf16_t* WinT = (const bf16_t*)(ws + OFF_WINT);
    f32x4 acc[4][4]; acc_zero(acc);
    const GemmOp op{hbf + (size_t)rt * 128 * 1024, WinT + (size_t)ct * 128 * 1024, 1024, 1024};
    const GemmOp nx{hbf + (size_t)nrt * 128 * 1024, WinT + (size_t)nct * 128 * 1024, 1024, 1024};
    gemm_tile(op, 1024, acc, smem, pp);
    const int row0 = rt * 128;
    if (ct < 8) {
        const float* cs = (const float*)(dob + DO_ROPE);
        const bool isq = ct < 6;
        bf16_t* dst = isq ? (bf16_t*)(ws + OFF_QA) + ct * 128 : (bf16_t*)(ws + OFF_KA) + (ct - 6) * 128;
        const int ld = isq ? 768 : 256;
        const float sc = isq ? QSCALE : 1.0f;
        const int lane_ = tidx() & 63, g = lane_ >> 4, wid_ = tidx() >> 6;
        f32x4 csv[16];
        if ((wid_ & 1) == 0) {
#pragma unroll
            for (int m = 0; m < 4; ++m) {
                const f32x4* csr = (const f32x4*)(cs + (size_t)(row0 + (wid_ >> 1) * 64 + m * 16 + (lane_ & 15)) * 32 + (g & 1) * 16);
#pragma unroll
                for (int q = 0; q < 4; ++q) csv[m * 4 + q] = csr[q];
            }
            PIN8(csv, 0); PIN8(csv, 8);
        }
        if (hn) gemm_prefetch(nx, smem, pp);
        epi_foreach(acc, [&](int r, int c, float (&v)[8], int pq, int mq) {
            const int tok = row0 + r;
            if (pq == 0 && c < 32) {
                const f32x4 c0 = csv[mq * 4], c1 = csv[mq * 4 + 1], c2 = csv[mq * 4 + 2], c3 = csv[mq * 4 + 3];
                const float ccv[8] = {c0[0], c0[2], c1[0], c1[2], c2[0], c2[2], c3[0], c3[2]};
                const float ssv[8] = {c0[1], c0[3], c1[1], c1[3], c2[1], c2[3], c3[1], c3[3]};
#pragma unroll
                for (int e = 0; e < 8; ++e) {
                    const float o = __shfl_xor(v[e], 32);
                    v[e] = (g < 2) ? (v[e] * ccv[e] - o * ssv[e]) : (v[e] * ccv[e] + o * ssv[e]);
                }
            }
#pragma unroll
            for (int e = 0; e < 8; ++e) v[e] *= sc;
            store_bf16x8(dst + (size_t)tok * ld + c, v);
        });
    }
    if (!(ct == 8 || ct == 9)) { __syncthreads(); __syncthreads(); __syncthreads(); }
    if (ct < 8) { } else if (ct < 10) {
        const int kvh = ct - 8, b = row0 / S_, s0 = row0 % S_;
        store_tile_T(acc, (bf16_t*)(ws + OFF_VAT) + (size_t)(b * 2 + kvh) * 128 * S_ + s0, S_, smem);
    } else if (ct < 16) {
        if (hn) gemm_prefetch(nx, smem, pp);
        bf16_t* dst = (bf16_t*)(ws + OFF_XL) + (ct - 10) * 128;
        epi_foreach(acc, [&](int r, int c, float (&v)[8], int, int) { store_bf16x8(dst + (size_t)(row0 + r) * 768 + c, v); });
    } else if (ct < 22) {
        if (hn) gemm_prefetch(nx, smem, pp);
        bf16_t* dst = (bf16_t*)(ws + OFF_GL) + (ct - 16) * 128;
        epi_foreach(acc, [&](int r, int c, float (&v)[8], int, int) {
#pragma unroll
            for (int e = 0; e < 8; ++e) v[e] = gelu_tanh(v[e]);
            store_bf16x8(dst + (size_t)(row0 + r) * 768 + c, v); });
    } else if (ct < 26) {
        if (hn) gemm_prefetch(nx, smem, pp);
        bf16_t* dst = (bf16_t*)(ws + OFF_QM) + (ct - 22) * 128;
        epi_foreach(acc, [&](int r, int c, float (&v)[8], int, int) {
#pragma unroll
            for (int e = 0; e < 8; ++e) v[e] *= QSCALE;
            store_bf16x8(dst + (size_t)(row0 + r) * 512 + c, v); });
    } else {
        const int gc0 = (ct - 26) * 128;
        bf16_t* dst = (bf16_t*)(ws + OFF_GATES) + gc0;
        const float* gb = p.gate_b + gc0;
        f32x4 gbv[4];
        {
            const int lane_ = tidx() & 63, c0 = ((tidx() >> 6) & 1) * 64 + 8 * (lane_ >> 4);
#pragma unroll
            for (int q = 0; q < 2; ++q) { gbv[2 * q] = *(const f32x4*)(gb + c0 + 32 * q); gbv[2 * q + 1] = *(const f32x4*)(gb + c0 + 32 * q + 4); }
            PIN4(gbv, 0);
        }
        if (hn) gemm_prefetch(nx, smem, pp);
        epi_foreach(acc, [&](int r, int c, float (&v)[8], int pq, int mq) {
            const f32x4 b0 = gbv[2 * pq], b1 = gbv[2 * pq + 1];
            v[0] = sigmoidf_(v[0] + b0[0]); v[1] = sigmoidf_(v[1] + b0[1]); v[2] = sigmoidf_(v[2] + b0[2]); v[3] = sigmoidf_(v[3] + b0[3]);
            v[4] = sigmoidf_(v[4] + b1[0]); v[5] = sigmoidf_(v[5] + b1[1]); v[6] = sigmoidf_(v[6] + b1[2]); v[7] = sigmoidf_(v[7] + b1[3]);
            store_bf16x8(dst + (size_t)(row0 + r) * 3072 + c, v); });
    }
}

__device__ void memkv_tile(const Params& p, int rt, int ct, unsigned char* smem) {
    unsigned char* dob = (unsigned char*)p.out;
    f32x4 acc[4][4]; acc_zero(acc);
    const GemmOp op{(const bf16_t*)(dob + DO_MEMBF) + (size_t)rt * 128 * 1024, (const bf16_t*)(p.ws + OFF_WMKVT) + (size_t)ct * 128 * 1024, 1024, 1024};
    GemmPipe pp{0, false};
    __syncthreads();
    gemm_tile(op, 1024, acc, smem, pp);
    const int row0 = rt * 128;
    if (ct < 4) {
        bf16_t* dst = (bf16_t*)(dob + DO_KM) + ct * 128;
        epi_foreach(acc, [&](int r, int c, float (&v)[8], int, int) { store_bf16x8(dst + (size_t)(row0 + r) * 512 + c, v); });
    } else {
        const int h = ct - 4, b = row0 / MEML, m0 = row0 % MEML;
        store_tile_T(acc, (bf16_t*)(dob + DO_VMT) + (size_t)(b * 4 + h) * 128 * MEML + m0, MEML, smem);
    }
}


typedef float f32x16 __attribute__((ext_vector_type(16)));
__device__ __forceinline__ f32x16 mfma32(bf16x8 a, bf16x8 b, f32x16 c) { return __builtin_amdgcn_mfma_f32_32x32x16_bf16(a, b, c, 0, 0, 0); }
constexpr int ATT_STAGE = 16384 + 128 * 136;

template <bool WIN>
__device__ void attn_block(const bf16_t* Qg, int ldq, const bf16_t* __restrict__ Kg, int ldk, const bf16_t* __restrict__ Vtg, int ldv,
                           int q0, int kt0, int nt, float sink2, bf16_t* Og, int ldo, unsigned char* smem) {
    const int tid = tidx(), lane = tid & 63, wid = tid >> 6, r = lane & 31, hh = lane >> 5;
    const int qw = q0 + 32 * wid;
    bf16x8 qf[8];
#pragma unroll
    for (int ks = 0; ks < 8; ++ks) qf[ks] = *(const bf16x8*)(Qg + (size_t)(32 * wid + r) * ldq + ks * 16 + hh * 8);
    f32x16 o[4];
#pragma unroll
    for (int db = 0; db < 4; ++db)
#pragma unroll
        for (int e = 0; e < 16; ++e) o[db][e] = 0.f;
    float m = WIN ? sink2 : -1e30f, l = WIN ? 1.0f : 0.0f;
    const int krow = tid >> 4, kch = tid & 15, vrow = tid >> 3, vch = tid & 7;
    const int koff = krow * 256 + ((kch ^ (krow & 15)) << 4);
    const int voff = 16384 + vrow * 136 + vch * 16;
    uint4 rk[4], rv[4];
    const bf16_t* kgp = Kg + (size_t)(kt0 * 64 + krow) * ldk + kch * 8;
    const bf16_t* vgp = Vtg + (size_t)vrow * ldv + kt0 * 64 + vch * 8;
#pragma unroll
    for (int i = 0; i < 4; ++i) { rk[i] = *(const uint4*)(kgp + (size_t)(16 * i) * ldk); rv[i] = *(const uint4*)(vgp + (size_t)(32 * i) * ldv); }
#pragma unroll
    for (int i = 0; i < 4; ++i) {
        *(uint4*)(smem + koff + i * 4096) = rk[i];
        *(uint2*)(smem + voff + i * 4352) = make_uint2(rv[i].x, rv[i].y); *(uint2*)(smem + voff + i * 4352 + 8) = make_uint2(rv[i].z, rv[i].w);
    }
    __syncthreads();
    constexpr int NTL = WIN ? 6 : 4;
    for (int t = 0; t < NTL; ++t) {
        const unsigned char* sb = smem + (t & 1) * ATT_STAGE;
        {
            const int tn = t + 1 < nt ? t + 1 : nt - 1;
#pragma unroll
            for (int i = 0; i < 4; ++i) { rk[i] = *(const uint4*)(kgp + (size_t)(tn * 64 + 16 * i) * ldk); rv[i] = *(const uint4*)(vgp + (size_t)(32 * i) * ldv + tn * 64); }
        }
        const int k0 = (kt0 + t) * 64;
        if (t < nt && (!WIN || (k0 + 63 >= qw - 128 && k0 <= qw + 159))) {
#pragma unroll
            for (int kb = 0; kb < 2; ++kb) {
                const int kb0 = k0 + 32 * kb;
                if (WIN && !(kb0 + 31 >= qw - 128 && kb0 <= qw + 159)) continue;
                f32x16 s;
#pragma unroll
                for (int e = 0; e < 16; ++e) s[e] = 0.f;
                const int row = kb * 32 + r;
#pragma unroll
                for (int ks = 0; ks < 8; ++ks) {
                    const bf16x8 a = *(const bf16x8*)(sb + row * 256 + (((2 * ks + hh) ^ (row & 15)) << 4));
                    s = mfma32(a, qf[ks], s);
                }
                if (WIN && !(kb0 >= qw - 97 && kb0 + 31 <= qw + 128)) {
#pragma unroll
                    for (int e = 0; e < 16; ++e) {
                        const int d = kb0 + (e & 3) + 8 * (e >> 2) + 4 * hh - (qw + r);
                        s[e] = (d <= 128 && d >= -128) ? s[e] : -1e30f;
                    }
                }
                float mx = s[0];
#pragma unroll
                for (int e = 1; e < 16; ++e) mx = fmaxf(mx, s[e]);
                mx = fmaxf(mx, __shfl_xor(mx, 32));
                const float mnew = fmaxf(m, mx), alpha = __builtin_amdgcn_exp2f(m - mnew);
                m = mnew;
                float ps = 0.f;
#pragma unroll
                for (int e = 0; e < 16; ++e) { s[e] = __builtin_amdgcn_exp2f(s[e] - mnew); ps += s[e]; }
                ps += __shfl_xor(ps, 32);
                l = l * alpha + ps;
                if (__any(alpha != 1.0f)) {
#pragma unroll
                    for (int db = 0; db < 4; ++db)
#pragma unroll
                        for (int e = 0; e < 16; ++e) o[db][e] *= alpha;
                }
#pragma unroll
                for (int s2 = 0; s2 < 2; ++s2) {
                    union { unsigned u[4]; bf16x8 v; } pb;
#pragma unroll
                    for (int e = 0; e < 4; ++e) pb.u[e] = pack_bf16(s[8 * s2 + 2 * e], s[8 * s2 + 2 * e + 1]);
#pragma unroll
                    for (int db = 0; db < 4; ++db) {
                        const unsigned char* vp = sb + 16384 + (db * 32 + r) * 136 + (kb * 32 + 16 * s2 + 4 * hh) * 2;
                        union { uint2 u[2]; bf16x8 v; } va;
                        va.u[0] = *(const uint2*)vp; va.u[1] = *(const uint2*)(vp + 16);
                        o[db] = mfma32(va.v, pb.v, o[db]);
                    }
                }
            }
        }
        {
            unsigned char* sw = smem + ((t + 1) & 1) * ATT_STAGE;
#pragma unroll
            for (int i = 0; i < 4; ++i) {
                *(uint4*)(sw + koff + i * 4096) = rk[i];
                *(uint2*)(sw + voff + i * 4352) = make_uint2(rv[i].x, rv[i].y); *(uint2*)(sw + voff + i * 4352 + 8) = make_uint2(rv[i].z, rv[i].w);
            }
        }
        __syncthreads();
    }
    const float inv = __builtin_amdgcn_rcpf(l);
    bf16_t* orow = Og + (size_t)(32 * wid + r) * ldo + 4 * hh;
#pragma unroll
    for (int db = 0; db < 4; ++db)
#pragma unroll
        for (int gq = 0; gq < 4; ++gq)
            *(uint2*)(orow + db * 32 + 8 * gq) = make_uint2(pack_bf16(o[db][4 * gq] * inv, o[db][4 * gq + 1] * inv), pack_bf16(o[db][4 * gq + 2] * inv, o[db][4 * gq + 3] * inv));
}
__device__ void attn_win_unit(const Params& p, int u, unsigned char* smem) {
    const int gh = u % 3, qb = (u / 3) % 16, kvh = (u / 48) % 2, b = u / 96, head = kvh * 3 + gh;
    const int q0 = qb * 128;
    const int ks = q0 - 128 < 0 ? 0 : q0 - 128, ke = q0 + 256 > S_ ? S_ : q0 + 256;
    bf16_t* Q = (bf16_t*)(p.ws + OFF_QA) + (size_t)(b * S_ + q0) * 768 + head * 128;
    const bf16_t* Kb = (const bf16_t*)(p.ws + OFF_KA) + (size_t)(b * S_) * 256 + kvh * 128;
    const bf16_t* Vt = (const bf16_t*)(p.ws + OFF_VAT) + (size_t)(b * 2 + kvh) * 128 * S_;
    attn_block<true>(Q, 768, Kb, 256, Vt, S_, q0, ks / 64, (ke - ks) / 64, p.attn_sink[head] * 1.4426950408889634f, Q, 768, smem);
}
__device__ void attn_mem_unit(const Params& p, int u, unsigned char* smem) {
    const int qb = u % 16, head = (u / 16) % 4, b = u / 64;
    const int q0 = qb * 128;
    unsigned char* dob = (unsigned char*)p.out;
    bf16_t* Q = (bf16_t*)(p.ws + OFF_QM) + (size_t)(b * S_ + q0) * 512 + head * 128;
    const bf16_t* Kb = (const bf16_t*)(dob + DO_KM) + (size_t)(b * MEML) * 512 + head * 128;
    const bf16_t* Vt = (const bf16_t*)(dob + DO_VMT) + (size_t)(b * 4 + head) * 128 * MEML;
    attn_block<false>(Q, 512, Kb, 512, Vt, MEML, q0, 0, 4, 0.f, Q, 512, smem);
}

typedef _Float16 f16x2v __attribute__((ext_vector_type(2)));
__device__ __forceinline__ unsigned pack_f16(float lo, float hi) { return __builtin_bit_cast(unsigned, __builtin_amdgcn_cvt_pkrtz(lo, hi)); }
template <bool FINAL>
__device__ void lru_chunk_unit(const Params& p, int u, unsigned char* smem) {
    const int tid = tidx(), lane = tid & 63, wid = tid >> 6, li = lane & 15, g = lane >> 4;
    const int c = u & 15, h = (u >> 4) % 6, b = u / 96;
    const int cbase = h * 128, s0 = c * 128;
    unsigned char* xcs = smem; unsigned char* LB = smem + 32768; float2* SA = (float2*)(smem + 49152); unsigned char* WL = smem + 51200; float* CC = (float*)(smem + 67584);
    const bf16_t* Xl = (const bf16_t*)(p.ws + OFF_XL) + (size_t)(b * S_) * 768;
    bf16_t* Gl = (bf16_t*)(p.ws + OFF_GL) + (size_t)(b * S_ + s0) * 768;
    const bf16_t* LruWt = (const bf16_t*)(p.ws + OFF_LRUWT) + (size_t)h * 512 * 128;
    const float* SP8 = (const float*)(p.ws + OFF_SP8);
    float2* AGG = (float2*)(p.ws + OFF_AGG);
    auto stage_w = [&](int hc_, int d_) {
#pragma unroll
        for (int i = 0; i < 4; ++i) {
            const int rr = (tid >> 4) + 16 * i, n = rr >> 4, wrow = ((n >> 1) * 2 + d_) * 128 + hc_ * 32 + 16 * (n & 1) + (rr & 15);
            __builtin_amdgcn_global_load_lds((const unsigned*)(LruWt + (size_t)wrow * 128 + (((tid & 15) ^ (rr & 15)) << 3)), (unsigned*)(WL + tid * 16 + i * 4096), 16, 0, 0);
        }
    };
    __syncthreads();
    if (FINAL) {
        const int d_ = tid >> 7, ch_ = tid & 127;
        const float2* ag = AGG + ((size_t)(d_ * B_ + b) * 16) * 768 + cbase + ch_;
        f32x2v av[16];
#pragma unroll
        for (int j = 0; j < 16; ++j) av[j] = *(const f32x2v*)(ag + (size_t)j * 768);
        PIN8(av, 0); PIN8(av, 8);
        float H = 0.f;
#pragma unroll
        for (int jj = 0; jj < 16; ++jj) {
            const int j = d_ ? 15 - jj : jj;
            const bool on = d_ ? (j > c) : (j < c);
            H = __builtin_amdgcn_exp2f(on ? av[j][0] : 0.f) * H + (on ? av[j][1] : 0.f);
        }
        CC[tid] = H;
    }
    {
        const int cp = tid & 63, tq = tid >> 6, cch = cbase + 2 * cp;
        float cw[4][2];
#pragma unroll
        for (int j = 0; j < 4; ++j) { cw[j][0] = p.conv_w[j * LW + cch]; cw[j][1] = p.conv_w[j * LW + cch + 1]; }
        const float cb0 = p.conv_b[cch], cb1 = p.conv_b[cch + 1];
#pragma unroll
        for (int hf = 0; hf < 2; ++hf) {
            const int tb = 32 * tq + 16 * hf;
            unsigned xw[19];
#pragma unroll
            for (int i = 0; i < 19; ++i) {
                const int s = s0 + tb + i - 2, sc = s < 0 ? 0 : (s > S_ - 1 ? S_ - 1 : s);
                xw[i] = *(const unsigned*)(Xl + (size_t)sc * 768 + cch);
            }
            PIN15(xw, 0); PIN4(xw, 15);
#pragma unroll
            for (int i = 0; i < 19; ++i) { const int s = s0 + tb + i - 2; xw[i] = (s >= 0 && s < S_) ? xw[i] : 0u; }
#pragma unroll
            for (int i = 0; i < 16; ++i) {
                const int t = tb + i;
                const float y0 = cb0 + cw[0][0] * bflo(xw[i]) + cw[1][0] * bflo(xw[i + 1]) + cw[2][0] * bflo(xw[i + 2]) + cw[3][0] * bflo(xw[i + 3]);
                const float y1 = cb1 + cw[0][1] * bfhi(xw[i]) + cw[1][1] * bfhi(xw[i + 1]) + cw[2][1] * bfhi(xw[i + 2]) + cw[3][1] * bfhi(xw[i + 3]);
                *(unsigned*)(xcs + t * 256 + (((cp >> 2) ^ (t & 15)) << 4) + (cp & 3) * 4) = pack_bf16(y0, y1);
            }
        }
    }
    const int sch = tid & 31, seg = tid >> 5;
    float4 cst[2][3];
    auto load_cst = [&](int hc_, int d_) {
#pragma unroll
        for (int n = 0; n < 2; ++n) {
            const int gch = cbase + hc_ * 32 + 16 * n + 4 * g;
            cst[n][0] = *(const float4*)(p.lru_br + d_ * LW + gch); cst[n][1] = *(const float4*)(p.lru_bi + d_ * LW + gch); cst[n][2] = *(const float4*)(SP8 + d_ * LW + gch);
        }
    };
    stage_w(0, 0);
    __syncthreads();
#pragma unroll 1
    for (int hc = 0; hc < 4; ++hc) {
        float hfv[16];
#pragma unroll
        for (int d = 0; d < 2; ++d) {
            load_cst(hc, d);
            f32x4 acc[2][4];
#pragma unroll
            for (int m = 0; m < 2; ++m)
#pragma unroll
                for (int n = 0; n < 4; ++n) acc[m][n] = (f32x4){0.f, 0.f, 0.f, 0.f};
#pragma unroll
            for (int ks = 0; ks < 4; ++ks) {
                bf16x8 xf[2];
#pragma unroll
                for (int m = 0; m < 2; ++m) { const int row = 32 * wid + 16 * m + li; xf[m] = *(const bf16x8*)(xcs + row * 256 + (((ks * 4 + g) ^ (row & 15)) << 4)); }
#pragma unroll
                for (int n = 0; n < 4; ++n) {
                    const int rr = 16 * n + li;
                    const bf16x8 wf = *(const bf16x8*)(WL + rr * 256 + (((ks * 4 + g) ^ li) << 4));
#pragma unroll
                    for (int m = 0; m < 2; ++m) acc[m][n] = mfma16(wf, xf[m], acc[m][n]);
                }
            }
#pragma unroll
            for (int n = 0; n < 2; ++n) {
                const int ch4 = 16 * n + 4 * g;
                const float4 br4 = cst[n][0], bi4 = cst[n][1], sp4 = cst[n][2];
                const float brv[4] = {br4.x, br4.y, br4.z, br4.w}, biv[4] = {bi4.x, bi4.y, bi4.z, bi4.w}, spv[4] = {sp4.x, sp4.y, sp4.z, sp4.w};
#pragma unroll
                for (int m = 0; m < 2; ++m) {
                    const int tok = 32 * wid + 16 * m + li;
                    const uint2 xq = *(const uint2*)(xcs + tok * 256 + ((((hc * 32 + ch4) >> 3) ^ (tok & 15)) << 4) + (g & 1) * 8);
                    const float xc[4] = {bflo(xq.x), bfhi(xq.x), bflo(xq.y), bfhi(xq.y)};
                    unsigned w[4];
#pragma unroll
                    for (int r = 0; r < 4; ++r) {
                        const float rg = sigmoidf_(acc[m][n][r] + brv[r]), ig = sigmoidf_(acc[m][n + 2][r] + biv[r]);
                        const float la = spv[r] * rg, a = __builtin_amdgcn_exp2f(la);
                        const float bx = __builtin_amdgcn_sqrtf(fmaxf(1.0f - a * a, 0.f)) * (ig * xc[r]);
                        w[r] = pack_f16(la, bx);
                    }
                    *(uint4*)(LB + tok * 128 + (((ch4 >> 2) ^ (tok & 7)) << 4)) = make_uint4(w[0], w[1], w[2], w[3]);
                }
            }
            __syncthreads();
            if (!(hc == 3 && d == 1)) stage_w(d ? hc + 1 : hc, d ^ 1);
            const int gch = cbase + hc * 32 + sch;
            {
                float L = 0.f, H = 0.f;
#pragma unroll
                for (int k = 0; k < 16; ++k) {
                    const int tok = 16 * seg + (d ? 15 - k : k);
                    const unsigned w = *(const unsigned*)(LB + tok * 128 + (((sch >> 2) ^ (tok & 7)) << 4) + (sch & 3) * 4);
                    const f16x2v hv = __builtin_bit_cast(f16x2v, w);
                    const float la = (float)hv.x, bx = (float)hv.y;
                    H = __builtin_amdgcn_exp2f(la) * H + bx; L += la;
                }
                SA[seg * 32 + sch] = make_float2(L, H);
            }
            __syncthreads();
            if (!FINAL) {
                if (seg == 0) {
                    float L = 0.f, H = 0.f;
#pragma unroll
                    for (int s = 0; s < 8; ++s) { const float2 a = SA[(d ? 7 - s : s) * 32 + sch]; H = __builtin_amdgcn_exp2f(a.x) * H + a.y; L += a.x; }
                    AGG[((size_t)(d * B_ + b) * 16 + c) * 768 + gch] = make_float2(L, H);
                }
            } else {
                float H = CC[d * 128 + hc * 32 + sch];
#pragma unroll
                for (int ss = 0; ss < 8; ++ss) {
                    const int s = d ? 7 - ss : ss;
                    const bool on = d ? (s > seg) : (s < seg);
                    const float2 a = SA[s * 32 + sch];
                    H = __builtin_amdgcn_exp2f(on ? a.x : 0.f) * H + (on ? a.y : 0.f);
                }
                bf16_t* gp = Gl + (size_t)(16 * seg) * 768 + gch;
                float gv[16];
                if (d) {
                    unsigned gr[16];
#pragma unroll
                    for (int k = 0; k < 16; ++k) gr[k] = gp[(size_t)k * 768];
                    PIN8(gr, 0); PIN8(gr, 8);
#pragma unroll
                    for (int k = 0; k < 16; ++k) gv[k] = __uint_as_float(gr[k] << 16);
                }
#pragma unroll
                for (int k = 0; k < 16; ++k) {
                    const int kk = d ? 15 - k : k, tok = 16 * seg + kk;
                    const unsigned w = *(const unsigned*)(LB + tok * 128 + (((sch >> 2) ^ (tok & 7)) << 4) + (sch & 3) * 4);
                    const f16x2v hv = __builtin_bit_cast(f16x2v, w);
                    H = __builtin_amdgcn_exp2f((float)hv.x) * H + (float)hv.y;
                    if (d == 0) hfv[kk] = H; else hfv[kk] = (hfv[kk] + H) * gv[kk];
                }
                if (d) {
#pragma unroll
                    for (int k = 0; k < 16; ++k) gp[(size_t)k * 768] = f2bf(hfv[k]);
                }
            }
            __syncthreads();
        }
    }
}

__device__ void merge_tile(const Params& p, int rt, int ct, unsigned char* smem, GemmPipe& pp, bool hn, int nrt, int nct) {
    unsigned char* ws = p.ws;
    const int row0 = rt * 128, col0 = ct * 128;
    uint4 tot[4][2];
    const bf16_t* G = (const bf16_t*)(ws + OFF_GATES);
    const int lane = tidx() & 63, wid = tidx() >> 6, wr = wid >> 1, wc = wid & 1, li = lane & 15, g = lane >> 4;
#pragma unroll 1
    for (int br = 0; br < 3; ++br) {
        const bf16_t* Ab = (const bf16_t*)(ws + (br == 0 ? OFF_QA : (br == 1 ? OFF_GL : OFF_QM)));
        const bf16_t* Bb = (const bf16_t*)(ws + (br == 0 ? OFF_PATTNT : (br == 1 ? OFF_PLRUT : OFF_PMEMT)));
        const int Kb = br == 2 ? 512 : 768;
        const int nbr = br == 2 ? 0 : br + 1, nr0 = br == 2 ? nrt * 128 : row0, nc0 = br == 2 ? nct * 128 : col0, nKb = nbr == 2 ? 512 : 768;
        const bf16_t* nAb = (const bf16_t*)(ws + (nbr == 0 ? OFF_QA : (nbr == 1 ? OFF_GL : OFF_QM)));
        const bf16_t* nBb = (const bf16_t*)(ws + (nbr == 0 ? OFF_PATTNT : (nbr == 1 ? OFF_PLRUT : OFF_PMEMT)));
        const GemmOp op{Ab + (size_t)row0 * Kb, Bb + (size_t)col0 * Kb, Kb, Kb};
        const GemmOp nx{nAb + (size_t)nr0 * nKb, nBb + (size_t)nc0 * nKb, nKb, nKb};
        f32x4 acc[4][4]; acc_zero(acc);
        gemm_tile(op, Kb, acc, smem, pp);
        u32x4 gva[8];
#pragma unroll
        for (int m = 0; m < 4; ++m)
#pragma unroll
            for (int pq = 0; pq < 2; ++pq) {
                const int r = wr * 64 + m * 16 + li, c = wc * 64 + 32 * pq + 8 * g;
                gva[m * 2 + pq] = *(const u32x4*)(G + (size_t)(row0 + r) * 3072 + br * 1024 + col0 + c);
            }
        PIN8(gva, 0);
        if (br < 2 || hn) gemm_prefetch(nx, smem, pp);
#pragma unroll
        for (int m = 0; m < 4; ++m)
#pragma unroll
            for (int pp = 0; pp < 2; ++pp) {
                const uint4 gv = make_uint4(gva[m * 2 + pp][0], gva[m * 2 + pp][1], gva[m * 2 + pp][2], gva[m * 2 + pp][3]);
                float v[8];
                v[0] = bflo(gv.x) * acc[m][2 * pp][0]; v[1] = bfhi(gv.x) * acc[m][2 * pp][1];
                v[2] = bflo(gv.y) * acc[m][2 * pp][2]; v[3] = bfhi(gv.y) * acc[m][2 * pp][3];
                v[4] = bflo(gv.z) * acc[m][2 * pp + 1][0]; v[5] = bfhi(gv.z) * acc[m][2 * pp + 1][1];
                v[6] = bflo(gv.w) * acc[m][2 * pp + 1][2]; v[7] = bfhi(gv.w) * acc[m][2 * pp + 1][3];
                if (br > 0) {
                    const uint4 t = tot[m][pp];
                    v[0] += bflo(t.x); v[1] += bfhi(t.x); v[2] += bflo(t.y); v[3] += bfhi(t.y);
                    v[4] += bflo(t.z); v[5] += bfhi(t.z); v[6] += bflo(t.w); v[7] += bfhi(t.w);
                }
                tot[m][pp] = make_uint4(pack_bf16(v[0], v[1]), pack_bf16(v[2], v[3]), pack_bf16(v[4], v[5]), pack_bf16(v[6], v[7]));
            }
    }
    bf16_t* dst = (bf16_t*)(ws + OFF_MERGED) + col0;
#pragma unroll
    for (int m = 0; m < 4; ++m)
#pragma unroll
        for (int pp = 0; pp < 2; ++pp) {
            const int r = wr * 64 + m * 16 + li, c = wc * 64 + 32 * pp + 8 * g;
            *(uint4*)(dst + (size_t)(row0 + r) * 1024 + c) = tot[m][pp];
        }
}
__device__ void outproj_tile(const Params& p, int rt, int ct, unsigned char* smem, GemmPipe& pp, bool hn, int nrt, int nct) {
    const int row0 = rt * 128, col0 = ct * 128;
    f32x4 acc[4][4]; acc_zero(acc);
    const GemmOp op{(const bf16_t*)(p.ws + OFF_MERGED) + (size_t)row0 * 1024, (const bf16_t*)(p.ws + OFF_WOUTT) + (size_t)col0 * 1024, 1024, 1024};
    const GemmOp nx{(const bf16_t*)(p.ws + OFF_MERGED) + (size_t)nrt * 128 * 1024, (const bf16_t*)(p.ws + OFF_WOUTT) + (size_t)nct * 128 * 1024, 1024, 1024};
    gemm_tile(op, 1024, acc, smem, pp);
    f32x4 xv[16];
    {
        const int lane_ = tidx() & 63, wid_ = tidx() >> 6;
#pragma unroll
        for (int m = 0; m < 4; ++m)
#pragma unroll
            for (int pq = 0; pq < 2; ++pq) {
                const size_t o = (size_t)(row0 + (wid_ >> 1) * 64 + m * 16 + (lane_ & 15)) * 1024 + col0 + (wid_ & 1) * 64 + 32 * pq + 8 * (lane_ >> 4);
                xv[(m * 2 + pq) * 2] = *(const f32x4*)(p.x + o); xv[(m * 2 + pq) * 2 + 1] = *(const f32x4*)(p.x + o + 4);
            }
        PIN8(xv, 0); PIN8(xv, 8);
    }
    if (hn) gemm_prefetch(nx, smem, pp);
    epi_foreach(acc, [&](int r, int c, float (&v)[8], int pq, int mq) {
        const size_t o = (size_t)(row0 + r) * 1024 + col0 + c;
        const f32x4 x0 = xv[(mq * 2 + pq) * 2], x1 = xv[(mq * 2 + pq) * 2 + 1];
        *(float4*)(p.out + o) = make_float4(x0[0] + v[0], x0[1] + v[1], x0[2] + v[2], x0[3] + v[3]);
        *(float4*)(p.out + o + 4) = make_float4(x1[0] + v[4], x1[1] + v[5], x1[2] + v[6], x1[3] + v[7]);
    });
}

__device__ void peerq_tile(const Params& p, int rt, int ct, unsigned char* smem, GemmPipe& pp, bool hn, int nrt, int nct) {
    const int row0 = rt * 128, col0 = ct * 128;
    f32x4 acc[4][4]; acc_zero(acc);
    const GemmOp op{(const bf16_t*)(p.ws + OFF_MERGED) + (size_t)row0 * 1024, (const bf16_t*)(p.ws + OFF_WPQT) + (size_t)col0 * 1024, 1024, 1024};
    const GemmOp nx{(const bf16_t*)(p.ws + OFF_MERGED) + (size_t)nrt * 128 * 1024, (const bf16_t*)(p.ws + OFF_WPQT) + (size_t)nct * 128 * 1024, 1024, 1024};
    gemm_tile(op, 1024, acc, smem, pp);
    if (hn) gemm_prefetch(nx, smem, pp);
    bf16_t* dst = (bf16_t*)(p.ws + OFF_QPEER) + col0;
    epi_foreach(acc, [&](int r, int c, float (&v)[8], int, int) { store_bf16x8(dst + (size_t)(row0 + r) * 2048 + c, v); });
}

__device__ __forceinline__ int sortable(float v) { int k = __float_as_int(v); return k ^ ((k >> 31) & 0x7fffffff); }
__device__ __forceinline__ float unsortable(int k) { return __int_as_float(k ^ ((k >> 31) & 0x7fffffff)); }
__device__ __forceinline__ void insert16(int (&lst)[16], int x) {
#pragma unroll
    for (int k = 0; k < 16; ++k) { const int hi = max(lst[k], x); x = min(lst[k], x); lst[k] = hi; }
}
__device__ void scores_tile(const Params& p, int rt, int pq, unsigned char* smem) {
    const int row0 = rt * 128;
    f32x4 acc[4][4]; acc_zero(acc);
    const GemmOp op{(const bf16_t*)(p.ws + OFF_QPEER) + (size_t)row0 * 2048 + pq * 128, (const bf16_t*)(p.ws + OFF_SUBK) + (size_t)pq * 128 * 128, 2048, 128};
    GemmPipe pp{0, false};
    gemm_tile(op, 128, acc, smem, pp);
    float* sc = (float*)smem;
    __syncthreads();
    epi_foreach(acc, [&](int r, int c, float (&v)[8], int, int) {
        *(float4*)(sc + r * 132 + c) = make_float4(v[0], v[1], v[2], v[3]);
        *(float4*)(sc + r * 132 + c + 4) = make_float4(v[4], v[5], v[6], v[7]); });
    __syncthreads();
    {
        const int t = tidx(), r = t & 127, hf = t >> 7;
        int lst[16];
#pragma unroll
        for (int k = 0; k < 16; ++k) lst[k] = (int)0x80000000;
#pragma unroll 2
        for (int j4 = 0; j4 < 16; ++j4) {
            const int j = hf * 64 + j4 * 4;
            const float4 v = *(const float4*)(sc + r * 132 + j);
            insert16(lst, (sortable(v.x) & ~127) | (j + 0));
            insert16(lst, (sortable(v.y) & ~127) | (j + 1));
            insert16(lst, (sortable(v.z) & ~127) | (j + 2));
            insert16(lst, (sortable(v.w) & ~127) | (j + 3));
        }
        __syncthreads();
        int* ls = (int*)smem;
        if (hf) {
#pragma unroll
            for (int k = 0; k < 16; ++k) ls[t * 16 + k] = lst[15 - k];
        }
        __syncthreads();
        if (!hf) {
#pragma unroll
            for (int k = 0; k < 16; ++k) lst[k] = max(lst[k], ls[(t + 128) * 16 + k]);
#pragma unroll
            for (int s = 8; s >= 1; s >>= 1)
#pragma unroll
                for (int k = 0; k < 16; ++k)
                    if ((k & s) == 0) { const int hi = max(lst[k], lst[k + s]), lo = min(lst[k], lst[k + s]); lst[k] = hi; lst[k + s] = lo; }
            int4* dst = (int4*)((int*)(p.ws + OFF_TOPL) + ((size_t)(row0 + r) * 16 + pq) * 16);
            dst[0] = make_int4(lst[0], lst[1], lst[2], lst[3]); dst[1] = make_int4(lst[4], lst[5], lst[6], lst[7]);
            dst[2] = make_int4(lst[8], lst[9], lst[10], lst[11]); dst[3] = make_int4(lst[12], lst[13], lst[14], lst[15]);
        }
    }
    __syncthreads();
}

__device__ void combine_item(const Params& p, int item) {
    const int tok = item >> 3, hd = item & 7;
    const int* l0 = (const int*)(p.ws + OFF_TOPL) + ((size_t)tok * 16 + hd * 2) * 16;
    const int* l1 = l0 + 16;
    int k0[16], k1[16];
#pragma unroll
    for (int i = 0; i < 4; ++i) {
        const int4 a = ((const int4*)l0)[i], b = ((const int4*)l1)[i];
        k0[4 * i] = a.x; k0[4 * i + 1] = a.y; k0[4 * i + 2] = a.z; k0[4 * i + 3] = a.w;
        k1[4 * i] = b.x; k1[4 * i + 1] = b.y; k1[4 * i + 2] = b.z; k1[4 * i + 3] = b.w;
    }
    float v0[16], v1[16];
#pragma unroll
    for (int i = 0; i < 16; ++i) { v0[i] = unsortable(k0[i] & ~127); v1[i] = unsortable(k1[i] & ~127); }
    int lst[16];
#pragma unroll
    for (int k = 0; k < 16; ++k) lst[k] = (int)0x80000000;
#pragma unroll
    for (int a = 0; a < 16; ++a)
#pragma unroll
        for (int b = 0; b < 16; ++b)
            if ((a + 1) * (b + 1) <= 16) insert16(lst, (sortable(v0[a] + v1[b]) & ~255) | (a * 16 + b));
    float val[16], sum = 0.f;
    const float mx = unsortable(lst[0] & ~255);
#pragma unroll
    for (int k = 0; k < 16; ++k) { val[k] = __expf(unsortable(lst[k] & ~255) - mx); sum += val[k]; }
    const float inv = 1.0f / sum;
    int* ei = (int*)(p.ws + OFF_EIDX) + (size_t)tok * 128 + hd * 16;
    float* eg = (float*)(p.ws + OFF_EGATE) + (size_t)tok * 128 + hd * 16;
#pragma unroll
    for (int k = 0; k < 16; ++k) {
        const int code = lst[k] & 255, a = code >> 4, b = code & 15;
        ei[k] = (l0[a] & 127) * 128 + (l1[b] & 127);
        eg[k] = val[k] * inv;
    }
}

__device__ __forceinline__ void conv_row_fp8(const float* __restrict__ src, unsigned char* __restrict__ dst, float* __restrict__ scale, int row, int lane) {
    const float4* s = (const float4*)(src + (size_t)row * 1024 + lane * 16);
    float4 v[4]; float am = 0.f;
#pragma unroll
    for (int i = 0; i < 4; ++i) { v[i] = s[i]; am = fmaxf(am, fmaxf(fmaxf(fabsf(v[i].x), fabsf(v[i].y)), fmaxf(fabsf(v[i].z), fabsf(v[i].w)))); }
#pragma unroll
    for (int o = 32; o >= 1; o >>= 1) am = fmaxf(am, __shfl_xor(am, o));
    const float sc = am > 0.f ? am * (1.0f / 224.0f) : 1.0f, inv = 1.0f / sc;
    unsigned w[4];
#pragma unroll
    for (int i = 0; i < 4; ++i) {
        int t = __builtin_amdgcn_cvt_pk_fp8_f32(v[i].x * inv, v[i].y * inv, 0, false);
        t = __builtin_amdgcn_cvt_pk_fp8_f32(v[i].z * inv, v[i].w * inv, t, true);
        w[i] = (unsigned)t;
    }
    *(uint4*)(dst + (size_t)row * 1024 + lane * 16) = make_uint4(w[0], w[1], w[2], w[3]);
    if (lane == 0) scale[row] = sc;
}
__device__ __forceinline__ void load8rows(uint4 (&R)[8], const unsigned char* __restrict__ tab, int es, int l0, int lane) {
#pragma unroll
    for (int j = 0; j < 8; ++j) {
        const int id = __builtin_amdgcn_readlane(es, l0 + j);
        R[j] = *(const uint4*)(tab + (size_t)id * 1024 + lane * 16);
    }
}
__device__ __forceinline__ float dot16q(const uint4& r, const float (&h)[16]) {
    const unsigned q[4] = {r.x, r.y, r.z, r.w};
    float d0 = 0.f, d1 = 0.f;
#pragma unroll
    for (int i = 0; i < 4; ++i) {
        const f32x2v a = __builtin_amdgcn_cvt_pk_f32_fp8((int)q[i], false), b = __builtin_amdgcn_cvt_pk_f32_fp8((int)q[i], true);
        d0 += a.x * h[4 * i]; d1 += a.y * h[4 * i + 1]; d0 += b.x * h[4 * i + 2]; d1 += b.y * h[4 * i + 3];
    }
    return d0 + d1;
}
__device__ __forceinline__ float dots8(const uint4 (&R)[8], const float (&h)[16], int lane) {
    float pd[8];
#pragma unroll
    for (int j = 0; j < 8; ++j) pd[j] = dot16q(R[j], h);
    const bool b5 = (lane & 32) != 0, b4 = (lane & 16) != 0, b3 = (lane & 8) != 0;
    float a[4];
#pragma unroll
    for (int j = 0; j < 4; ++j) { const float keep = b5 ? pd[4 + j] : pd[j], send = b5 ? pd[j] : pd[4 + j]; a[j] = keep + __shfl_xor(send, 32); }
    float c[2];
#pragma unroll
    for (int j = 0; j < 2; ++j) { const float keep = b4 ? a[2 + j] : a[j], send = b4 ? a[j] : a[2 + j]; c[j] = keep + __shfl_xor(send, 16); }
    float kk;
    { const float keep = b3 ? c[1] : c[0], send = b3 ? c[0] : c[1]; kk = keep + __shfl_xor(send, 8); }
    kk += __shfl_xor(kk, 4); kk += __shfl_xor(kk, 2); kk += __shfl_xor(kk, 1);
    return kk;
}
__device__ __forceinline__ void axpy8(float (&o)[16], const uint4 (&R)[8], int wsr, int bb) {
#pragma unroll
    for (int j = 0; j < 8; ++j) {
        const float c = __int_as_float(__builtin_amdgcn_readlane(wsr, 8 * j + bb));
        const unsigned q[4] = {R[j].x, R[j].y, R[j].z, R[j].w};
#pragma unroll
        for (int i = 0; i < 4; ++i) {
            const f32x2v a = __builtin_amdgcn_cvt_pk_f32_fp8((int)q[i], false), b = __builtin_amdgcn_cvt_pk_f32_fp8((int)q[i], true);
            o[4 * i] += c * a.x; o[4 * i + 1] += c * a.y; o[4 * i + 2] += c * b.x; o[4 * i + 3] += c * b.y;
        }
    }
}
__device__ void gather_token(const Params& p, int tok, int lane) {
    const bf16_t* h2 = (const bf16_t*)(p.ws + OFF_MERGED) + (size_t)tok * 1024 + lane * 16;
    const unsigned char* Uq = p.ws + OFF_UB; const unsigned char* Vq = p.ws + OFF_VB;
    const float* SU = (const float*)(p.ws + OFF_SU); const float* SV = (const float*)(p.ws + OFF_SV);
    const int* ei = (const int*)(p.ws + OFF_EIDX) + (size_t)tok * 128;
    const float* eg = (const float*)(p.ws + OFF_EGATE) + (size_t)tok * 128;
    float h[16];
    {
        const uint4 ha = *(const uint4*)h2, hb = *(const uint4*)(h2 + 8);
        const unsigned hq[8] = {ha.x, ha.y, ha.z, ha.w, hb.x, hb.y, hb.z, hb.w};
#pragma unroll
        for (int e = 0; e < 8; ++e) { h[2 * e] = bflo(hq[e]); h[2 * e + 1] = bfhi(hq[e]); }
    }
    const int pe = 8 * (lane & 7) + (lane >> 3);
    int es[2], wsr[2] = {0, 0}; float su[2], gv[2];
#pragma unroll
    for (int k = 0; k < 2; ++k) {
        es[k] = ei[64 * k + lane];
        const int e = ei[64 * k + pe];
        su[k] = SU[e]; gv[k] = eg[64 * k + pe] * SV[e];
    }
    uint4 R0[8], R1[8];
#pragma unroll
    for (int k = 0; k < 2; ++k) {
        load8rows(R0, Uq, es[k], 0, lane);
        for (int bb = 0; bb < 8; bb += 2) {
            load8rows(R1, Uq, es[k], 8 * bb + 8, lane);
            { const float w = gelu_tanh(dots8(R0, h, lane) * su[k]) * gv[k]; if ((lane & 7) == bb) wsr[k] = __float_as_int(w); }
            if (bb + 2 < 8) load8rows(R0, Uq, es[k], 8 * bb + 16, lane);
            { const float w = gelu_tanh(dots8(R1, h, lane) * su[k]) * gv[k]; if ((lane & 7) == bb + 1) wsr[k] = __float_as_int(w); }
        }
    }
    float o[16];
#pragma unroll
    for (int e = 0; e < 16; ++e) o[e] = 0.f;
#pragma unroll
    for (int k = 0; k < 2; ++k) {
        load8rows(R0, Vq, es[k], 0, lane);
        for (int bb = 0; bb < 8; bb += 2) {
            load8rows(R1, Vq, es[k], 8 * bb + 8, lane);
            axpy8(o, R0, wsr[k], bb);
            if (bb + 2 < 8) load8rows(R0, Vq, es[k], 8 * bb + 16, lane);
            axpy8(o, R1, wsr[k], bb + 1);
        }
    }
    float* xr = p.out + (size_t)tok * 1024 + lane * 16;
    float4 x[4]; float ss = 0.f;
#pragma unroll
    for (int i = 0; i < 4; ++i) {
        x[i] = *(const float4*)(xr + 4 * i);
        x[i].x += o[4 * i]; x[i].y += o[4 * i + 1]; x[i].z += o[4 * i + 2]; x[i].w += o[4 * i + 3];
        ss += x[i].x * x[i].x + x[i].y * x[i].y + x[i].z * x[i].z + x[i].w * x[i].w;
    }
    ss = wave_sum(ss);
    const float rs = rsqrtf(ss * (1.0f / 1024.0f) + EPS);
    const float* gf = p.g_final + lane * 16;
#pragma unroll
    for (int i = 0; i < 4; ++i) {
        const float4 gg = *(const float4*)(gf + 4 * i);
        *(float4*)(xr + 4 * i) = make_float4(x[i].x * rs * gg.x, x[i].y * rs * gg.y, x[i].z * rs * gg.z, x[i].w * rs * gg.w);
    }
}


__device__ __forceinline__ void fp8x16_to_f32(const uint4& r, float (&f)[16]) {
    const unsigned q[4] = {r.x, r.y, r.z, r.w};
#pragma unroll
    for (int i = 0; i < 4; ++i) {
        const f32x2v a = __builtin_amdgcn_cvt_pk_f32_fp8((int)q[i], false), b = __builtin_amdgcn_cvt_pk_f32_fp8((int)q[i], true);
        f[4 * i] = a.x; f[4 * i + 1] = a.y; f[4 * i + 2] = b.x; f[4 * i + 3] = b.y;
    }
}
__device__ __forceinline__ float sum8_dpp(float v) {
    v += __int_as_float(__builtin_amdgcn_mov_dpp(__float_as_int(v), 0xB1, 0xF, 0xF, true));
    v += __int_as_float(__builtin_amdgcn_mov_dpp(__float_as_int(v), 0x4E, 0xF, 0xF, true));
    v += __int_as_float(__builtin_amdgcn_mov_dpp(__float_as_int(v), 0x141, 0xF, 0xF, true));
    return v;
}
__device__ __forceinline__ void peer_u_issue(u32x4 (&seg)[8], const unsigned char* Uq, int es, int gq) {
#pragma unroll
    for (int bb = 0; bb < 8; ++bb) { const int id = __shfl(es, 8 * bb + gq); seg[bb] = *(const u32x4*)(Uq + (size_t)id * 1024); }
}
__device__ __forceinline__ float peer_u_half(u32x4 (&seg)[8], const float (&h)[16], int sub) {
    PIN8(seg, 0);
    float z = 0.f;
#pragma unroll
    for (int bb = 0; bb < 8; ++bb) {
        float f[16];
        fp8x16_to_f32(make_uint4(seg[bb][0], seg[bb][1], seg[bb][2], seg[bb][3]), f);
        float d0 = 0.f, d1 = 0.f;
#pragma unroll
        for (int i = 0; i < 8; ++i) { d0 += f[2 * i] * h[2 * i]; d1 += f[2 * i + 1] * h[2 * i + 1]; }
        const float d = sum8_dpp(d0 + d1);
        if (sub == bb) z = d;
    }
    return z;
}
__device__ void peer_u_pass(const Params& p, int t0, int tstep, int x, int lane) {
    const int gq = lane >> 3, sub = lane & 7;
    const int* eib = (const int*)(p.ws + OFF_EIDX);
    const bf16_t* h2b = (const bf16_t*)(p.ws + OFF_MERGED) + x * 128 + sub * 16;
    const unsigned char* Uq = p.ws + OFF_UB + x * 128 + sub * 16;
    float* Zb = (float*)(p.ws + OFF_ZBUF) + (size_t)x * 128;
    if (t0 >= NTOK) return;
    int es0 = eib[(size_t)t0 * 128 + lane], es1 = eib[(size_t)t0 * 128 + 64 + lane];
    uint4 ha = *(const uint4*)(h2b + (size_t)t0 * 1024), hb = *(const uint4*)(h2b + (size_t)t0 * 1024 + 8);
    u32x4 SA[8], SB[8];
    peer_u_issue(SA, Uq, es0, gq);
    for (int t = t0; t < NTOK; t += tstep) {
        float h[16];
        {
            const unsigned hq[8] = {ha.x, ha.y, ha.z, ha.w, hb.x, hb.y, hb.z, hb.w};
#pragma unroll
            for (int e = 0; e < 8; ++e) { h[2 * e] = bflo(hq[e]); h[2 * e + 1] = bfhi(hq[e]); }
        }
        peer_u_issue(SB, Uq, es1, gq);
        const int tn = t + tstep < NTOK ? t + tstep : t;
        es0 = eib[(size_t)tn * 128 + lane]; es1 = eib[(size_t)tn * 128 + 64 + lane];
        ha = *(const uint4*)(h2b + (size_t)tn * 1024); hb = *(const uint4*)(h2b + (size_t)tn * 1024 + 8);
        const float z0 = peer_u_half(SA, h, sub);
        peer_u_issue(SA, Uq, es0, gq);
        const float z1 = peer_u_half(SB, h, sub);
        float* Z = Zb + (size_t)t * 8 * 128;
        Z[lane] = z0; Z[64 + lane] = z1;
    }
}
__device__ void peer_coef_token(const Params& p, int tok, int lane) {
    const int pe = 8 * (lane & 7) + (lane >> 3);
    const int* ei = (const int*)(p.ws + OFF_EIDX) + (size_t)tok * 128;
    const float* eg = (const float*)(p.ws + OFF_EGATE) + (size_t)tok * 128;
    const float* SU = (const float*)(p.ws + OFF_SU); const float* SV = (const float*)(p.ws + OFF_SV);
    const float* Z = (const float*)(p.ws + OFF_ZBUF) + (size_t)tok * 8 * 128;
    float* W = (float*)(p.ws + OFF_WBUF) + (size_t)tok * 128;
#pragma unroll
    for (int k = 0; k < 2; ++k) {
        float zv[8];
#pragma unroll
        for (int x = 0; x < 8; ++x) zv[x] = Z[x * 128 + k * 64 + lane];
        const int e = ei[64 * k + pe];
        const float g = eg[64 * k + pe], su = SU[e], sv = SV[e];
        PIN8(zv, 0);
        const float z = ((zv[0] + zv[1]) + (zv[2] + zv[3])) + ((zv[4] + zv[5]) + (zv[6] + zv[7]));
        W[k * 64 + lane] = gelu_tanh(z * su) * g * sv;
    }
}
#define PINQ(a) asm volatile("" : "+v"((a)[0]), "+v"((a)[1]), "+v"((a)[2]), "+v"((a)[3]))
__device__ __forceinline__ void peer_v_issue4(u32x4 (&seg)[4], const unsigned char* Vq, int es, int gq, int bb0) {
#pragma unroll
    for (int j = 0; j < 4; ++j) { const int id = __shfl(es, 8 * (bb0 + j) + gq); seg[j] = *(const u32x4*)(Vq + (size_t)id * 1024); }
}
__device__ __forceinline__ void peer_v_quarter(u32x4 (&seg)[4], float (&o)[16], float wk, int gq, int bb0) {
    PINQ(seg);
#pragma unroll
    for (int j = 0; j < 4; ++j) {
        const float c = __shfl(wk, 8 * gq + bb0 + j);
        float f[16];
        fp8x16_to_f32(make_uint4(seg[j][0], seg[j][1], seg[j][2], seg[j][3]), f);
#pragma unroll
        for (int i = 0; i < 16; ++i) o[i] += c * f[i];
    }
}
__device__ void peer_v_pass(const Params& p, int t0, int tstep, int x, int lane) {
    const int gq = lane >> 3, sub = lane & 7;
    const int* eib = (const int*)(p.ws + OFF_EIDX);
    const float* Wb = (const float*)(p.ws + OFF_WBUF);
    const unsigned char* Vq = p.ws + OFF_VB + x * 128 + sub * 16;
    if (t0 >= NTOK) return;
    const bool b5 = (lane & 32) != 0, b4 = (lane & 16) != 0, b3 = (lane & 8) != 0;
    const int col = x * 128 + 16 * sub + (b5 ? 8 : 0) + (b4 ? 4 : 0) + (b3 ? 2 : 0);
    int es0 = eib[(size_t)t0 * 128 + lane], es1 = eib[(size_t)t0 * 128 + 64 + lane];
    float wk0 = Wb[(size_t)t0 * 128 + lane], wk1 = Wb[(size_t)t0 * 128 + 64 + lane];
    u32x4 SA[4], SB[4];
    peer_v_issue4(SA, Vq, es0, gq, 0);
    for (int t = t0; t < NTOK; t += tstep) {
        float o[16];
#pragma unroll
        for (int i = 0; i < 16; ++i) o[i] = 0.f;
        const int tn = t + tstep < NTOK ? t + tstep : t;
        const int nes0 = eib[(size_t)tn * 128 + lane], nes1 = eib[(size_t)tn * 128 + 64 + lane];
        const float nwk0 = Wb[(size_t)tn * 128 + lane], nwk1 = Wb[(size_t)tn * 128 + 64 + lane];
        int gl = gq; asm volatile("" : "+v"(gl));
        peer_v_issue4(SB, Vq, es0, gl, 4);  peer_v_quarter(SA, o, wk0, gl, 0);
        peer_v_issue4(SA, Vq, es1, gl, 0);  peer_v_quarter(SB, o, wk0, gl, 4);
        peer_v_issue4(SB, Vq, es1, gl, 4);  peer_v_quarter(SA, o, wk1, gl, 0);
        peer_v_issue4(SA, Vq, nes0, gl, 0); peer_v_quarter(SB, o, wk1, gl, 4);
        es0 = nes0; es1 = nes1; wk0 = nwk0; wk1 = nwk1;
        float a8[8], a4[4], a2[2];
#pragma unroll
        for (int i = 0; i < 8; ++i) { const float keep = b5 ? o[8 + i] : o[i], send = b5 ? o[i] : o[8 + i]; a8[i] = keep + __shfl_xor(send, 32); }
#pragma unroll
        for (int i = 0; i < 4; ++i) { const float keep = b4 ? a8[4 + i] : a8[i], send = b4 ? a8[i] : a8[4 + i]; a4[i] = keep + __shfl_xor(send, 16); }
#pragma unroll
        for (int i = 0; i < 2; ++i) { const float keep = b3 ? a4[2 + i] : a4[i], send = b3 ? a4[i] : a4[2 + i]; a2[i] = keep + __shfl_xor(send, 8); }
        float* xr = p.out + (size_t)t * 1024 + col;
        float2 xv = *(const float2*)xr;
        xv.x += a2[0]; xv.y += a2[1];
        *(float2*)xr = xv;
        const float ss = wave_sum(xv.x * xv.x + xv.y * xv.y);
        if (lane == 0) atomicAdd((float*)(p.ws + OFF_ROWSS) + t, ss);
    }
}
__device__ void final_norm_row(const Params& p, int tok, int lane) {
    float* xr = p.out + (size_t)tok * 1024 + lane * 16;
    const float rs = rsqrtf(((const float*)(p.ws + OFF_ROWSS))[tok] * (1.0f / 1024.0f) + EPS);
    const float* gf = p.g_final + lane * 16;
#pragma unroll
    for (int i = 0; i < 4; ++i) {
        const float4 v = *(const float4*)(xr + 4 * i), gg = *(const float4*)(gf + 4 * i);
        *(float4*)(xr + 4 * i) = make_float4(v.x * rs * gg.x, v.y * rs * gg.y, v.z * rs * gg.z, v.w * rs * gg.w);
    }
}

__device__ __forceinline__ bool gemm_unit(int it, int nct, int& rt, int& ct) {
    const int x = vbid() & 7, j = vbid() >> 3, nbx = vnb() >> 3;
    const int v = j + it * nbx, per_rg = 8 * nct;
    if (v >= 32 * nct) return false;
    const int rgi = v / per_rg, w = v - rgi * per_rg, cg = w >> 6, w2 = w & 63;
    const int rtl = w2 & 7, ctl = w2 >> 3;
    rt = (rgi * 8 + rtl) * 8 + x; ct = cg * 8 + ctl;
    return true;
}


namespace pg8 {
#define PG8_LAS __attribute__((address_space(3)))
constexpr int BM = 256, BK = 64, HALF = 128, HTB = HALF * BK * 2  , STAGE_BYTES = 8 * HTB, NXCD = 8, WGM = 8;

__host__ __device__ __forceinline__ int lds_byte(int r, int c) { const int st = (r >> 4) * 2 + (c >> 5), rr = r & 15, cc = c & 31, ob = rr * 64 + cc * 2; return st * 1024 + (ob ^ (((ob >> 9) & 1) << 5)); }
__host__ __device__ __forceinline__ void stage_rc(int b, int& R, int& C) { const int st = b / 1024, sb = b % 1024, swz = sb ^ (((sb >> 9) & 1) << 5); R = (st >> 1) * 16 + swz / 64; C = (st & 1) * 32 + (swz % 64) / 2; }
__host__ __device__ __forceinline__ int perm32(int rho) { const int n = rho >> 4, i = rho & 15; return 8 * (i >> 2) + 4 * n + (i & 3); }

struct Unit { int pm, pn; };
struct Gemm { const bf16_t* A; const bf16_t* Bt; int M, N, K; };

struct StaticOrder {
    int nM, nN, nwg, G, c;
    __host__ __device__ void init(int M, int N, int G_, int c_) { nM = M / BM; nN = N / BM; nwg = nM * nN; G = G_; c = c_; }
    __host__ __device__ bool next(int i, Unit& u) const {
        const long L = (long)i * G + c; if (L >= nwg) return false;
        int wgid = (int)L; { const int q = nwg / NXCD, r = nwg % NXCD, xcd = wgid % NXCD, off = wgid / NXCD; wgid = (xcd < r ? xcd * (q + 1) : r * (q + 1) + (xcd - r) * q) + off; }
        const int nig = WGM * nN, gid = wgid / nig, fm = gid * WGM, gsz = (nM - fm) < WGM ? (nM - fm) : WGM;
        u.pm = fm + ((wgid % nig) % gsz); u.pn = (wgid % nig) / gsz; return true;
    }
    __device__ __forceinline__ void a_ready(const Unit&) const {}
    __device__ __forceinline__ void done(const Unit&) const {}
};


template <class F> struct EpiFn {
    static constexpr bool PERM = true, AFTER_DRAIN = false;
    F f;
    __device__ __forceinline__ void operator()(const f32x4 (&acc)[2][2][4][2], const Unit& u, int wr, int wc, int fr, int fq) const {
#pragma unroll
        for (int ai = 0; ai < 2; ++ai)
#pragma unroll
            for (int m = 0; m < 4; ++m)
#pragma unroll
                for (int bj = 0; bj < 2; ++bj) {
                    float v[8];
#pragma unroll
                    for (int r = 0; r < 4; ++r) { v[r] = acc[ai][bj][m][0][r]; v[4 + r] = acc[ai][bj][m][1][r]; }
                    f(u.pm * BM + ai * HALF + wr * 64 + m * 16 + fr, u.pn * BM + bj * HALF + wc * 32 + 8 * fq, v);
                }
    }
};
template <class Epi, class Sched, bool ALIGN_EPI = false, bool SP2 = false>
__device__ __forceinline__ void gemm_phase(PG8_LAS unsigned char* lds, const Gemm g, const Sched& S, const Epi& E) {
    int tid_ = threadIdx.x; asm volatile("" : "+v"(tid_));
    const int tid = tid_, wid = __builtin_amdgcn_readfirstlane(tid >> 6), lane = tid & 63, wr = wid >> 2, wc = wid & 3, fr = lane & 15, fq = lane >> 4;
    const int K = g.K, nt = K / BK;
    unsigned voffA[2], voffB[2];
#pragma unroll
    for (int i = 0; i < 2; ++i) { int R, C; stage_rc(tid * 16 + i * 8192, R, C); const int Rb = Epi::PERM ? ((R & ~31) + perm32(R & 31)) : R;
        voffA[i] = (unsigned)(R * K + C) * 2u; voffB[i] = (unsigned)(Rb * K + C) * 2u; }
    const size_t kstep = (size_t)(BK * 2);
    const size_t hstep = (size_t)HALF * K * 2;
    const size_t tstep = 2 * hstep;
    const unsigned ldsw = (unsigned)wid * 1024u;
    const int aoff = lds_byte(wr * 64 + fr, fq * 8), boff = lds_byte(wc * 32 + fr, fq * 8);
#define PG8_SA(b, h) (((b) * 2 + (h)) * HTB)
#define PG8_SB(b, h) ((4 + (b) * 2 + (h)) * HTB)
#define PG8_STAGE(bufoff, gbase, voff) do { _Pragma("unroll") for (int _i = 0; _i < 2; ++_i) \
        __builtin_amdgcn_global_load_lds((const unsigned*)((const char*)(gbase) + (voff)[_i]), (PG8_LAS unsigned*)(lds + (bufoff) + ldsw + _i * 8192), 16, 0, 0); } while (0)
#define PG8_LDA(dst, b, h) do { _Pragma("unroll") for (int m = 0; m < 4; ++m) _Pragma("unroll") for (int k = 0; k < 2; ++k) dst[m][k] = *(const PG8_LAS bf16x8*)(lds + PG8_SA(b, h) + aoff + m * 2048 + k * 1024); } while (0)
#define PG8_LDB(dst, b, h) do { _Pragma("unroll") for (int n = 0; n < 2; ++n) _Pragma("unroll") for (int k = 0; k < 2; ++k) dst[n][k] = *(const PG8_LAS bf16x8*)(lds + PG8_SB(b, h) + boff + n * 2048 + k * 1024); } while (0)
#define PG8_MMA(ai, bj, At, Bt) do { __builtin_amdgcn_s_setprio(1); _Pragma("unroll") for (int m = 0; m < 4; ++m) _Pragma("unroll") for (int n = 0; n < 2; ++n) _Pragma("unroll") for (int k = 0; k < 2; ++k) \
        acc[ai][bj][m][n] = __builtin_amdgcn_mfma_f32_16x16x32_bf16(Bt[n][k], At[m][k], acc[ai][bj][m][n], 0, 0, 0); __builtin_amdgcn_s_setprio(0); } while (0)
#define PG8_WAIT_V(n) asm volatile("s_waitcnt vmcnt(" #n ")" ::: "memory")
#define PG8_WAIT_L(n) asm volatile("s_waitcnt lgkmcnt(" #n ")" ::: "memory")
#define PG8_BAR __builtin_amdgcn_s_barrier()
#define PG8_SCHED __builtin_amdgcn_sched_barrier(0)
    Unit cur, nxt; int ui = 0;
    if (!S.next(0, cur)) return;
    f32x4 acc[2][2][4][2];
#pragma unroll
    for (int a = 0; a < 2; ++a)
#pragma unroll
        for (int b = 0; b < 2; ++b)
#pragma unroll
            for (int m = 0; m < 4; ++m)
#pragma unroll
                for (int n = 0; n < 2; ++n) acc[a][b][m][n] = (f32x4){0.f, 0.f, 0.f, 0.f};
    bf16x8 At[4][2], B0[2][2], B1[2][2];
    const char* cA = (const char*)g.A + (size_t)cur.pm * tstep; const char* cB = (const char*)g.Bt + (size_t)cur.pn * tstep;
    S.a_ready(cur);
    if constexpr (SP2) {
        PG8_STAGE(PG8_SB(0, 0), cB, voffB); PG8_STAGE(PG8_SB(0, 1), cB + hstep, voffB); PG8_STAGE(PG8_SA(0, 0), cA, voffA); PG8_STAGE(PG8_SA(0, 1), cA + hstep, voffA);
        if (wr == 1) PG8_BAR;
        PG8_WAIT_V(2); PG8_BAR;
        PG8_STAGE(PG8_SB(1, 0), cB + kstep, voffB); PG8_STAGE(PG8_SA(1, 0), cA + kstep, voffA); PG8_STAGE(PG8_SB(1, 1), cB + hstep + kstep, voffB);
        PG8_WAIT_V(6); PG8_BAR;
    } else {
        PG8_STAGE(PG8_SB(0, 0), cB, voffB); PG8_STAGE(PG8_SA(0, 0), cA, voffA); PG8_STAGE(PG8_SB(0, 1), cB + hstep, voffB); PG8_STAGE(PG8_SA(0, 1), cA + hstep, voffA);
        if (wr == 1) PG8_BAR;
        PG8_WAIT_V(4); PG8_BAR;
        PG8_STAGE(PG8_SB(1, 0), cB + kstep, voffB); PG8_STAGE(PG8_SA(1, 0), cA + kstep, voffA); PG8_STAGE(PG8_SB(1, 1), cB + hstep + kstep, voffB);
        PG8_WAIT_V(6); PG8_BAR;
    }
    for (;;) {
        const bool has_next = S.next(ui + 1, nxt);
        const char* nA = has_next ? (const char*)g.A + (size_t)nxt.pm * tstep : cA; const char* nB = has_next ? (const char*)g.Bt + (size_t)nxt.pn * tstep : cB;
        for (int t = 0; t < nt; t += 2) {
            const bool last = (t == nt - 2);
            const char* a1 = cA + (size_t)(t + 1) * kstep;
            const char* a2 = last ? nA : cA + (size_t)(t + 2) * kstep; const char* b2 = last ? nB : cB + (size_t)(t + 2) * kstep;
            const char* a3 = a2 + kstep; const char* b3 = b2 + kstep;
            if (last && has_next) S.a_ready(nxt);
            if constexpr (SP2) {
            PG8_LDB(B0, 0, 0); PG8_LDB(B1, 0, 1); PG8_SCHED; PG8_LDA(At, 0, 0); PG8_STAGE(PG8_SA(1, 1), a1 + hstep, voffA);
            PG8_WAIT_V(8); PG8_WAIT_L(0); PG8_BAR; PG8_MMA(0, 0, At, B0); PG8_MMA(0, 1, At, B1); PG8_BAR; PG8_SCHED;
            PG8_LDA(At, 0, 1); PG8_STAGE(PG8_SB(0, 0), b2, voffB); PG8_STAGE(PG8_SB(0, 1), b2 + hstep, voffB); PG8_STAGE(PG8_SA(0, 0), a2, voffA);
            PG8_WAIT_V(8); PG8_WAIT_L(0); PG8_BAR; PG8_MMA(1, 0, At, B0); PG8_MMA(1, 1, At, B1); PG8_BAR; PG8_SCHED;
            PG8_LDB(B0, 1, 0); PG8_LDB(B1, 1, 1); PG8_SCHED; PG8_LDA(At, 1, 0); PG8_STAGE(PG8_SA(0, 1), a2 + hstep, voffA);
            PG8_WAIT_V(8); PG8_WAIT_L(0); PG8_BAR; PG8_MMA(0, 0, At, B0); PG8_MMA(0, 1, At, B1); PG8_BAR; PG8_SCHED;
            PG8_LDA(At, 1, 1); PG8_STAGE(PG8_SB(1, 0), b3, voffB); PG8_STAGE(PG8_SB(1, 1), b3 + hstep, voffB); PG8_STAGE(PG8_SA(1, 0), a3, voffA);
            PG8_WAIT_V(8); PG8_WAIT_L(0); PG8_BAR; PG8_MMA(1, 0, At, B0); PG8_MMA(1, 1, At, B1); PG8_BAR; PG8_SCHED;
            } else {
            PG8_LDB(B0, 0, 0); PG8_SCHED; PG8_LDA(At, 0, 0); PG8_STAGE(PG8_SA(1, 1), a1 + hstep, voffA);
            PG8_WAIT_L(8); PG8_BAR; PG8_WAIT_L(0); PG8_MMA(0, 0, At, B0); PG8_BAR; PG8_SCHED;
            PG8_LDB(B1, 0, 1); PG8_STAGE(PG8_SB(0, 0), b2, voffB);
            PG8_BAR; PG8_WAIT_L(0); PG8_MMA(0, 1, At, B1); PG8_BAR;
            PG8_LDA(At, 0, 1); PG8_STAGE(PG8_SA(0, 0), a2, voffA);
            PG8_BAR; PG8_WAIT_L(0); PG8_MMA(1, 0, At, B0); PG8_BAR; PG8_SCHED;
            PG8_STAGE(PG8_SB(0, 1), b2 + hstep, voffB);
            PG8_WAIT_V(6); PG8_BAR; PG8_MMA(1, 1, At, B1); PG8_BAR;
            PG8_LDB(B0, 1, 0); PG8_SCHED; PG8_LDA(At, 1, 0); PG8_STAGE(PG8_SA(0, 1), a2 + hstep, voffA);
            PG8_WAIT_L(8); PG8_BAR; PG8_WAIT_L(0); PG8_MMA(0, 0, At, B0); PG8_BAR; PG8_SCHED;
            PG8_LDB(B1, 1, 1); PG8_STAGE(PG8_SB(1, 0), b3, voffB);
            PG8_BAR; PG8_WAIT_L(0); PG8_MMA(0, 1, At, B1); PG8_BAR;
            PG8_LDA(At, 1, 1); PG8_STAGE(PG8_SA(1, 0), a3, voffA);
            PG8_BAR; PG8_WAIT_L(0); PG8_MMA(1, 0, At, B0); PG8_BAR; PG8_SCHED;
            PG8_STAGE(PG8_SB(1, 1), b3 + hstep, voffB);
            PG8_WAIT_V(6); PG8_BAR; PG8_MMA(1, 1, At, B1); PG8_BAR;
            }
        }
        if constexpr (ALIGN_EPI) { if (wr == 0) PG8_BAR; }
        if constexpr (!Epi::AFTER_DRAIN) { E(acc, cur, wr, wc, fr, fq); S.done(cur); }
        if (!has_next) break;
#pragma unroll
        for (int a = 0; a < 2; ++a)
#pragma unroll
            for (int b = 0; b < 2; ++b)
#pragma unroll
                for (int m = 0; m < 4; ++m)
#pragma unroll
                    for (int n = 0; n < 2; ++n) acc[a][b][m][n] = (f32x4){0.f, 0.f, 0.f, 0.f};
        cur = nxt; cA = nA; cB = nB; ++ui;
        if constexpr (ALIGN_EPI) { if (wr == 1) PG8_BAR; }
    }
    PG8_WAIT_V(0);
    if constexpr (!ALIGN_EPI) { if (wr == 0) PG8_BAR; }
    PG8_BAR;
    if constexpr (Epi::AFTER_DRAIN) { E.fused(acc, cur, wr, wc, fr, fq, lds, wid, lane); S.done(cur); }
#undef PG8_SA
#undef PG8_SB
#undef PG8_STAGE
#undef PG8_LDA
#undef PG8_LDB
#undef PG8_MMA
#undef PG8_WAIT_V
#undef PG8_WAIT_L
#undef PG8_BAR
#undef PG8_SCHED
}

}


namespace pg8 {
__device__ __forceinline__ void item_vals(const f32x4 (&acc)[2][2][4][2], int ai, int bj, int m, float (&v)[8]) {
#pragma unroll
    for (int r = 0; r < 4; ++r) { v[r] = acc[ai][bj][m][0][r]; v[4 + r] = acc[ai][bj][m][1][r]; }
}
struct EpiOutproj {
    static constexpr bool PERM = true, AFTER_DRAIN = false;
    const float* x; float* out;
    __device__ __forceinline__ void operator()(const f32x4 (&acc)[2][2][4][2], const Unit& u, int wr, int wc, int fr, int fq) const {
#pragma unroll
        for (int ai = 0; ai < 2; ++ai)
#pragma unroll
            for (int mh = 0; mh < 2; ++mh) {
                f32x4 xv[8];
#pragma unroll
                for (int mm = 0; mm < 2; ++mm)
#pragma unroll
                    for (int bj = 0; bj < 2; ++bj) {
                        const int m = mh * 2 + mm;
                        const size_t o = (size_t)(u.pm * BM + ai * HALF + wr * 64 + m * 16 + fr) * 1024 + u.pn * BM + bj * HALF + wc * 32 + 8 * fq;
                        xv[(mm * 2 + bj) * 2] = *(const f32x4*)(x + o); xv[(mm * 2 + bj) * 2 + 1] = *(const f32x4*)(x + o + 4);
                    }
                PIN8(xv, 0);
#pragma unroll
                for (int mm = 0; mm < 2; ++mm)
#pragma unroll
                    for (int bj = 0; bj < 2; ++bj) {
                        const int m = mh * 2 + mm;
                        const size_t o = (size_t)(u.pm * BM + ai * HALF + wr * 64 + m * 16 + fr) * 1024 + u.pn * BM + bj * HALF + wc * 32 + 8 * fq;
                        *(f32x4*)(out + o) = xv[(mm * 2 + bj) * 2] + acc[ai][bj][m][0];
                        *(f32x4*)(out + o + 4) = xv[(mm * 2 + bj) * 2 + 1] + acc[ai][bj][m][1];
                    }
            }
    }
};
struct EpiMerge {
    static constexpr bool PERM = true, AFTER_DRAIN = false;
    const bf16_t* G; bf16_t* merged; int br;
    __device__ __forceinline__ void operator()(const f32x4 (&acc)[2][2][4][2], const Unit& u, int wr, int wc, int fr, int fq) const {
#pragma unroll
        for (int ai = 0; ai < 2; ++ai)
#pragma unroll
            for (int mh = 0; mh < 2; ++mh) {
                u32x4 gm[8];
#pragma unroll
                for (int mm = 0; mm < 2; ++mm)
#pragma unroll
                    for (int bj = 0; bj < 2; ++bj) {
                        const int m = mh * 2 + mm;
                        const size_t row = (size_t)(u.pm * BM + ai * HALF + wr * 64 + m * 16 + fr); const int col = u.pn * BM + bj * HALF + wc * 32 + 8 * fq;
                        gm[mm * 2 + bj] = *(const u32x4*)(G + row * 3072 + br * 1024 + col);
                        gm[4 + mm * 2 + bj] = br > 0 ? *(const u32x4*)(merged + row * 1024 + col) : (u32x4){0u, 0u, 0u, 0u};
                    }
                PIN8(gm, 0);
#pragma unroll
                for (int mm = 0; mm < 2; ++mm)
#pragma unroll
                    for (int bj = 0; bj < 2; ++bj) {
                        const int m = mh * 2 + mm;
                        const size_t row = (size_t)(u.pm * BM + ai * HALF + wr * 64 + m * 16 + fr); const int col = u.pn * BM + bj * HALF + wc * 32 + 8 * fq;
                        float v[8]; item_vals(acc, ai, bj, m, v);
                        const u32x4 g4 = gm[mm * 2 + bj], t = gm[4 + mm * 2 + bj];
#pragma unroll
                        for (int e = 0; e < 4; ++e) { v[2 * e] = v[2 * e] * bflo(g4[e]) + bflo(t[e]); v[2 * e + 1] = v[2 * e + 1] * bfhi(g4[e]) + bfhi(t[e]); }
                        store_bf16x8(merged + row * 1024 + col, v);
                    }
            }
    }
};
struct EpiInproj {
    static constexpr bool PERM = true, AFTER_DRAIN = false;
    unsigned char* ws; const float* cs; const float* gate_b;
    __device__ __forceinline__ void operator()(const f32x4 (&acc)[2][2][4][2], const Unit& u, int wr, int wc, int fr, int fq) const {
        const int pn = u.pn;
        if (pn < 4) {
            const bool isq = pn < 3;
            bf16_t* dst = isq ? (bf16_t*)(ws + OFF_QA) + pn * 256 : (bf16_t*)(ws + OFF_KA);
            const int ld = isq ? 768 : 256; const float sc = isq ? QSCALE : 1.0f;
#pragma unroll
            for (int ai = 0; ai < 2; ++ai)
#pragma unroll
                for (int mh = 0; mh < 2; ++mh) {
                    f32x4 csv[8];
                    if (wc == 0) {
#pragma unroll
                        for (int mm = 0; mm < 2; ++mm) {
                            const f32x4* csr = (const f32x4*)(cs + (size_t)(u.pm * BM + ai * HALF + wr * 64 + (mh * 2 + mm) * 16 + fr) * 32 + (fq & 1) * 16);
#pragma unroll
                            for (int q = 0; q < 4; ++q) csv[mm * 4 + q] = csr[q];
                        }
                        PIN8(csv, 0);
                    }
#pragma unroll
                    for (int mm = 0; mm < 2; ++mm)
#pragma unroll
                        for (int bj = 0; bj < 2; ++bj) {
                            const int m = mh * 2 + mm;
                            const size_t row = (size_t)(u.pm * BM + ai * HALF + wr * 64 + m * 16 + fr);
                            float v[8]; item_vals(acc, ai, bj, m, v);
                            if (wc == 0) {
                                const f32x4 c0 = csv[mm * 4], c1 = csv[mm * 4 + 1], c2 = csv[mm * 4 + 2], c3 = csv[mm * 4 + 3];
                                const float ccv[8] = {c0[0], c0[2], c1[0], c1[2], c2[0], c2[2], c3[0], c3[2]};
                                const float ssv[8] = {c0[1], c0[3], c1[1], c1[3], c2[1], c2[3], c3[1], c3[3]};
#pragma unroll
                                for (int e = 0; e < 8; ++e) {
                                    const float o = __shfl_xor(v[e], 32);
                                    v[e] = (fq < 2) ? (v[e] * ccv[e] - o * ssv[e]) : (v[e] * ccv[e] + o * ssv[e]);
                                }
                            }
#pragma unroll
                            for (int e = 0; e < 8; ++e) v[e] *= sc;
                            store_bf16x8(dst + row * ld + bj * HALF + wc * 32 + 8 * fq, v);
                        }
                }
        } else if (pn == 4) {
#pragma unroll
            for (int ai = 0; ai < 2; ++ai)
#pragma unroll
                for (int m = 0; m < 4; ++m)
#pragma unroll
                    for (int bj = 0; bj < 2; ++bj) {
                        const int row = u.pm * BM + ai * HALF + wr * 64 + m * 16 + fr, b = row / S_, s = row % S_;
                        float v[8]; item_vals(acc, ai, bj, m, v);
                        bf16_t* vt = (bf16_t*)(ws + OFF_VAT) + ((size_t)(b * 2 + bj) * 128 + wc * 32 + 8 * fq) * S_ + s;
#pragma unroll
                        for (int e = 0; e < 8; ++e) vt[(size_t)e * S_] = f2bf(v[e]);
                    }
        } else if (pn < 13) {
            const int kind = pn < 8 ? 0 : (pn < 11 ? 1 : 2);
            bf16_t* dst = kind == 0 ? (bf16_t*)(ws + OFF_XL) + (pn - 5) * 256 : (kind == 1 ? (bf16_t*)(ws + OFF_GL) + (pn - 8) * 256 : (bf16_t*)(ws + OFF_QM) + (pn - 11) * 256);
            const int ld = kind == 2 ? 512 : 768;
#pragma unroll
            for (int ai = 0; ai < 2; ++ai)
#pragma unroll
                for (int m = 0; m < 4; ++m)
#pragma unroll
                    for (int bj = 0; bj < 2; ++bj) {
                        const size_t row = (size_t)(u.pm * BM + ai * HALF + wr * 64 + m * 16 + fr);
                        float v[8]; item_vals(acc, ai, bj, m, v);
                        if (kind == 1) {
#pragma unroll
                            for (int e = 0; e < 8; ++e) v[e] = gelu_tanh(v[e]);
                        } else if (kind == 2) {
#pragma unroll
                            for (int e = 0; e < 8; ++e) v[e] *= QSCALE;
                        }
                        store_bf16x8(dst + row * ld + bj * HALF + wc * 32 + 8 * fq, v);
                    }
        } else {
            const int gc0 = (pn - 13) * 256;
            f32x4 gbv[4];
#pragma unroll
            for (int bj = 0; bj < 2; ++bj) { const float* gb = gate_b + gc0 + bj * HALF + wc * 32 + 8 * fq; gbv[2 * bj] = *(const f32x4*)gb; gbv[2 * bj + 1] = *(const f32x4*)(gb + 4); }
            PIN4(gbv, 0);
            bf16_t* dst = (bf16_t*)(ws + OFF_GATES) + gc0;
#pragma unroll
            for (int ai = 0; ai < 2; ++ai)
#pragma unroll
                for (int m = 0; m < 4; ++m)
#pragma unroll
                    for (int bj = 0; bj < 2; ++bj) {
                        const size_t row = (size_t)(u.pm * BM + ai * HALF + wr * 64 + m * 16 + fr);
                        float v[8]; item_vals(acc, ai, bj, m, v);
                        const f32x4 b0 = gbv[2 * bj], b1 = gbv[2 * bj + 1];
#pragma unroll
                        for (int e = 0; e < 4; ++e) { v[e] = sigmoidf_(v[e] + b0[e]); v[4 + e] = sigmoidf_(v[4 + e] + b1[e]); }
                        store_bf16x8(dst + row * 3072 + bj * HALF + wc * 32 + 8 * fq, v);
                    }
        }
    }
};
}

#define XB_TMO      128
#define XB_XCNT(j)  (256  + 64 * (j))
#define XB_XSUB(j)  (1280 + 64 * (j))
#define XB_XGEN(j)  (2304 + 64 * (j))
#define XB_TOP      3328
#define XB_TOPGEN   3392
#define XCD_BAR_WORDS 3456
#define XB_SPIN_CAP (1u << 22)
#define LAS __attribute__((address_space(3)))
__device__ __forceinline__ unsigned xb_ld(unsigned* p)              { return __hip_atomic_load(p, __ATOMIC_RELAXED, __HIP_MEMORY_SCOPE_AGENT); }
__device__ __forceinline__ unsigned xb_add(unsigned* p, unsigned v) { return __hip_atomic_fetch_add(p, v, __ATOMIC_RELAXED, __HIP_MEMORY_SCOPE_AGENT); }
__device__ __forceinline__ unsigned xb_xcc_id() { return (unsigned)__builtin_amdgcn_s_getreg((3 << 11) | 20) & 0xFu; }
#define XB_SPIN(cond, bar) do { unsigned _sp = 0; while (cond) { __builtin_amdgcn_s_sleep(1); \
    if ((++_sp & 255u) == 0u) { if (xb_ld(&(bar)[XB_TMO])) break; if (_sp > XB_SPIN_CAP) { atomicAdd(&(bar)[XB_TMO], 1u); break; } } } } while (0)
struct XcdBarrier { unsigned* bar; unsigned x; volatile LAS unsigned* st; };
__device__ __forceinline__ XcdBarrier xcd_barrier_post(unsigned* bar, volatile LAS unsigned* st) {
    XcdBarrier b; b.bar = bar; b.x = xb_xcc_id(); b.st = st;
    if (threadIdx.x == 0) (void)xb_add(&bar[XB_XCNT(b.x)], 1u);
    return b;
}
__device__ __forceinline__ void xcd_barrier_complete(unsigned* bar, unsigned x, unsigned& nloc, unsigned& nx) {
    const unsigned G = gridDim.x;
    unsigned sum, cnt, mine, sp = 0u;
    for (;;) {
        sum = 0u; cnt = 0u; mine = 0u;
#pragma unroll
        for (unsigned j = 0; j < 16; ++j) { const unsigned c = xb_ld(&bar[XB_XCNT(j)]); sum += c; cnt += (c > 0u) ? 1u : 0u; mine = (j == x) ? c : mine; }
        if (sum == G) break;
        __builtin_amdgcn_s_sleep(1);
        if ((++sp & 255u) == 0u) { if (xb_ld(&bar[XB_TMO])) break; if (sp > XB_SPIN_CAP) { atomicAdd(&bar[XB_TMO], 1u); break; } }
    }
    nloc = mine > 0u ? mine : 1u; nx = cnt > 0u ? cnt : 1u;
}
__device__ __forceinline__ void xcd_barrier(const XcdBarrier& b) {
    asm volatile("s_waitcnt vmcnt(0)" ::: "memory");
    __syncthreads();
    if (threadIdx.x == 0) {
        unsigned* bar = b.bar;
        __builtin_amdgcn_s_waitcnt(0);
        unsigned nloc = b.st[0], nx = b.st[1];
        if (nloc == 0u) { xcd_barrier_complete(bar, b.x, nloc, nx); b.st[0] = nloc; b.st[1] = nx; }
        const unsigned old = xb_add(&bar[XB_XSUB(b.x)], 1u);
        const unsigned gen = old / nloc;
        if (old + 1u == (gen + 1u) * nloc) {
            __builtin_amdgcn_fence(__ATOMIC_RELEASE, "agent");
            asm volatile("s_waitcnt vmcnt(0)" ::: "memory");
            const unsigned og = xb_add(&bar[XB_TOP], 1u);
            const unsigned tg = og / nx;
            if (og + 1u == (tg + 1u) * nx) xb_add(&bar[XB_TOPGEN], 1u);
            else XB_SPIN(xb_ld(&bar[XB_TOPGEN]) == tg, bar);
            __builtin_amdgcn_fence(__ATOMIC_ACQUIRE, "agent");
            xb_add(&bar[XB_XGEN(b.x)], 1u);
            asm volatile("s_waitcnt vmcnt(0)" ::: "memory");
        } else {
            XB_SPIN(xb_ld(&bar[XB_XGEN(b.x)]) == gen, bar);
            __builtin_amdgcn_fence(__ATOMIC_ACQUIRE, "agent");
            asm volatile("s_waitcnt vmcnt(0)" ::: "memory");
        }
    }
    __syncthreads();
}

#ifndef PROBE_PHASE
#define PROBE_PHASE -1
#endif
#define PH_BEGIN(k) if (PROBE_PHASE == (k)) probe_t0 = __builtin_amdgcn_s_memrealtime();
#define PH_END(k)   if (PROBE_PHASE == (k)) probe_dt = __builtin_amdgcn_s_memrealtime() - probe_t0;
constexpr int SMEM_BYTES = 128 * 132 * 4 + 1024;

__global__ void __launch_bounds__(512, 2) fwd_megakernel(Params p) {
    __shared__ __attribute__((aligned(16))) unsigned char smem_all[2 * SMEM_BYTES + 32];
    if (threadIdx.x == 0) { *(uint4*)(smem_all + 2 * SMEM_BYTES) = make_uint4(0u, 0u, 0u, 0u); *(uint4*)(smem_all + 2 * SMEM_BYTES + 16) = make_uint4(0u, 0u, 0u, 0u); }
    __syncthreads();
    const XcdBarrier xb = xcd_barrier_post((unsigned*)(p.ws + OFF_BAR), (volatile LAS unsigned*)(smem_all + 2 * SMEM_BYTES));
    const int nb = vnb();
#define PHASE_IDS int vb_ = threadIdx.x >> 8; asm volatile("" : "+v"(vb_)); const int vb = vb_, bid = (int)blockIdx.x + vb * (int)gridDim.x, tid = tidx(), lane = tid & 63, wid = tid >> 6; unsigned char* smem = smem_all + vb * SMEM_BYTES; (void)bid; (void)tid; (void)lane; (void)wid; (void)smem;
    unsigned char* ws = p.ws; unsigned char* dob = (unsigned char*)p.out;
    unsigned long long probe_t0 = 0, probe_dt = 0;
    PH_BEGIN(0)
    { PHASE_IDS
    {
        for (int u0 = bid; u0 < 3232 + nb - 1 - (3231 % nb); u0 += nb) {
            const int u = u0 < 3232 ? u0 : 3231;
            if (u < 1600) convT_tile(p.w_in, (bf16_t*)(ws + OFF_WINT), 1024, INW, u, smem);
            else if (u < 1856) convT_tile(p.w_mem_kv, (bf16_t*)(ws + OFF_WMKVT), 1024, 1024, u - 1600, smem);
            else if (u < 2048) convT_tile(p.p_attn, (bf16_t*)(ws + OFF_PATTNT), 768, 1024, u - 1856, smem);
            else if (u < 2240) convT_tile(p.p_lru, (bf16_t*)(ws + OFF_PLRUT), 768, 1024, u - 2048, smem);
            else if (u < 2368) convT_tile(p.p_mem, (bf16_t*)(ws + OFF_PMEMT), 512, 1024, u - 2240, smem);
            else if (u < 2624) convT_tile(p.w_out, (bf16_t*)(ws + OFF_WOUTT), 1024, 1024, u - 2368, smem);
            else if (u < 3136) convT_tile(p.w_peer_q, (bf16_t*)(ws + OFF_WPQT), 1024, 2048, u - 2624, smem);
            else {
                const int v = u - 3136, mat = v >> 2, tile = v & 3, gsel = mat / 6, h = mat % 6, dir = gsel & 1;
                const float* src = (gsel < 2 ? p.lru_wr : p.lru_wi) + (size_t)(dir * 6 + h) * 128 * 128;
                convT_tile(src, (bf16_t*)(ws + OFF_LRUWT) + (size_t)(h * 512 + gsel * 128) * 128, 128, 128, tile, smem);
            }
        }
        conv_plain(p.peer_sub_keys, (bf16_t*)(ws + OFF_SUBK), (size_t)16 * 128 * 128 / 8);
        for (int r = bid * 4 + wid; r < 2 * NEXP; r += nb * 4) {
            if (r < NEXP) conv_row_fp8(p.peer_u, ws + OFF_UB, (float*)(ws + OFF_SU), r, lane);
            else conv_row_fp8(p.peer_v, ws + OFF_VB, (float*)(ws + OFF_SV), r - NEXP, lane);
        }
        for (int r = bid * 4 + wid; r < NTOK; r += nb * 4) rms_row_bf16(p.x + (size_t)r * 1024, p.g_mix, (bf16_t*)(dob + DO_HBF) + (size_t)r * 1024, lane);
        for (int r = bid * 4 + wid; r < NMEM; r += nb * 4) rms_row_bf16(p.mem + (size_t)r * 1024, p.g_mem, (bf16_t*)(dob + DO_MEMBF) + (size_t)r * 1024, lane);
        for (int i = bid * 256 + tid; i < NTOK * 16; i += nb * 256) rope_item(p.positions, (float*)(dob + DO_ROPE), i);
        for (int i = bid * 256 + tid; i < NTOK; i += nb * 256) ((float*)(ws + OFF_ROWSS))[i] = 0.f;
        for (int i = bid * 256 + tid; i < 2 * LW; i += nb * 256) ((float*)(ws + OFF_SP8))[i] = -8.0f * 1.4426950408889634f * log1pf(__expf(-p.lru_lambda[i]));
    }
    xcd_barrier(xb);
    PH_END(0) PH_BEGIN(1)
    }
    { PHASE_IDS
    { const int u = bid & 255; memkv_tile(p, u / 8, u % 8, smem); }
    {
        const pg8::Gemm g{(const bf16_t*)(dob + DO_HBF), (const bf16_t*)(ws + OFF_WINT), NTOK, INW, 1024};
        pg8::StaticOrder S; S.init(NTOK, INW, (int)gridDim.x, (int)blockIdx.x);
        __syncthreads();
        pg8::gemm_phase<pg8::EpiInproj, pg8::StaticOrder, true, true>((PG8_LAS unsigned char*)smem_all, g, S, pg8::EpiInproj{ws, (const float*)(dob + DO_ROPE), p.gate_b});
    }
    xcd_barrier(xb);
    PH_END(1) PH_BEGIN(2)
    }
    { PHASE_IDS
    {
        unsigned* ctr = (unsigned*)(p.ws + OFF_BAR) + 3600;
        volatile LAS unsigned* slot = (volatile LAS unsigned*)(smem_all + 2 * SMEM_BYTES + 16);
        for (;;) {
            if (threadIdx.x == 0) *slot = xb_add(ctr, 2u);
            __syncthreads();
            const int u = (int)*slot + vb;
            __syncthreads();
            if (u >= 1536 + 1536 + 1024) break;
            if (u < 1536) lru_chunk_unit<false>(p, u, smem);
            else if (u < 1536 + 1536) attn_win_unit(p, u - 1536, smem);
            else attn_mem_unit(p, u - 1536 - 1536, smem);
        }
    }
    xcd_barrier(xb);
    }
    { PHASE_IDS
    for (int u = bid; u < 1536; u += nb) lru_chunk_unit<true>(p, u, smem);
    xcd_barrier(xb);
    PH_END(2) PH_BEGIN(3)
    }
    { PHASE_IDS
    {
        pg8::StaticOrder S; S.init(NTOK, 1024, (int)gridDim.x, (int)blockIdx.x);
        const bf16_t* G = (const bf16_t*)(ws + OFF_GATES); bf16_t* mg = (bf16_t*)(ws + OFF_MERGED);
        __syncthreads();
        { const pg8::Gemm g{(const bf16_t*)(ws + OFF_QA), (const bf16_t*)(ws + OFF_PATTNT), NTOK, 1024, 768};
          pg8::gemm_phase<pg8::EpiMerge, pg8::StaticOrder, true, true>((PG8_LAS unsigned char*)smem_all, g, S, pg8::EpiMerge{G, mg, 0}); }
        { const pg8::Gemm g{(const bf16_t*)(ws + OFF_GL), (const bf16_t*)(ws + OFF_PLRUT), NTOK, 1024, 768};
          pg8::gemm_phase<pg8::EpiMerge, pg8::StaticOrder, true, true>((PG8_LAS unsigned char*)smem_all, g, S, pg8::EpiMerge{G, mg, 1}); }
        { const pg8::Gemm g{(const bf16_t*)(ws + OFF_QM), (const bf16_t*)(ws + OFF_PMEMT), NTOK, 1024, 512};
          pg8::gemm_phase<pg8::EpiMerge, pg8::StaticOrder, true, true>((PG8_LAS unsigned char*)smem_all, g, S, pg8::EpiMerge{G, mg, 2}); }
    }
    xcd_barrier(xb);
    PH_END(3) PH_BEGIN(4)
    }
    { PHASE_IDS
    {
        const pg8::Gemm g{(const bf16_t*)(ws + OFF_MERGED), (const bf16_t*)(ws + OFF_WOUTT), NTOK, 1024, 1024};
        pg8::StaticOrder S; S.init(NTOK, 1024, (int)gridDim.x, (int)blockIdx.x);
        __syncthreads();
        pg8::gemm_phase<pg8::EpiOutproj, pg8::StaticOrder, true, true>((PG8_LAS unsigned char*)smem_all, g, S, pg8::EpiOutproj{p.x, p.out});
    }
    xcd_barrier(xb);
    PH_END(4) PH_BEGIN(5)
    }
    { PHASE_IDS
    for (int r = bid * 4 + wid; r < NTOK; r += nb * 4) rms_row_bf16(p.out + (size_t)r * 1024, p.g_ffn, (bf16_t*)(ws + OFF_MERGED) + (size_t)r * 1024, lane);
    xcd_barrier(xb);
    PH_END(5) PH_BEGIN(6)
    }
    { PHASE_IDS
    {
        const pg8::Gemm g{(const bf16_t*)(ws + OFF_MERGED), (const bf16_t*)(ws + OFF_WPQT), NTOK, 2048, 1024};
        pg8::StaticOrder S; S.init(NTOK, 2048, (int)gridDim.x, (int)blockIdx.x);
        bf16_t* qp = (bf16_t*)(ws + OFF_QPEER);
        auto f = [=](int row, int col, const float (&v)[8]) { store_bf16x8(qp + (size_t)row * 2048 + col, v); };
        pg8::gemm_phase<pg8::EpiFn<decltype(f)>, pg8::StaticOrder, true, true>((PG8_LAS unsigned char*)smem_all, g, S, pg8::EpiFn<decltype(f)>{f});
    }
    xcd_barrier(xb);
    PH_END(6) PH_BEGIN(7)
    }
    { PHASE_IDS
    for (int u = bid; u < 256 * 16; u += nb) scores_tile(p, u / 16, u % 16, smem);
    xcd_barrier(xb);
    PH_END(7) PH_BEGIN(8)
    }
    { PHASE_IDS
    for (int i = bid * 256 + tid; i < NTOK * 8; i += nb * 256) combine_item(p, i);
    xcd_barrier(xb);
    PH_END(8) PH_BEGIN(9)
    }
    { PHASE_IDS
    {
        const int x = bid & 7, tstep = (nb >> 3) * 4;
        peer_u_pass(p, (bid >> 3) * 4 + wid, tstep, x, lane);
        xcd_barrier(xb);
        for (int t = bid * 4 + wid; t < NTOK; t += nb * 4) peer_coef_token(p, t, lane);
        xcd_barrier(xb);
        peer_v_pass(p, (bid >> 3) * 4 + wid, tstep, x, lane);
        xcd_barrier(xb);
        for (int t = bid * 4 + wid; t < NTOK; t += nb * 4) final_norm_row(p, t, lane);
    }
    }
    PH_END(9)
    if (PROBE_PHASE >= 0) { __syncthreads(); const unsigned long long t1 = __builtin_amdgcn_s_memrealtime(); while (__builtin_amdgcn_s_memrealtime() - t1 < probe_dt) __builtin_amdgcn_s_sleep(8); }
}

extern "C" void kernel_launch(void* const* d_in, const int* in_sizes, int n_in, void* d_out, int out_size, void* d_ws, size_t ws_size, hipStream_t stream) {
    if (ws_size < OFF_END) { fprintf(stderr, "workspace too small: %zu < %zu\n", ws_size, (size_t)OFF_END); return; }
    Params p{};
    p.x = (const float*)d_in[0]; p.mem = (const float*)d_in[1]; p.positions = (const int*)d_in[2];
    p.g_mix = (const float*)d_in[3]; p.g_mem = (const float*)d_in[4]; p.w_in = (const float*)d_in[5]; p.gate_b = (const float*)d_in[6];
    p.attn_sink = (const float*)d_in[7]; p.conv_w = (const float*)d_in[8]; p.conv_b = (const float*)d_in[9];
    p.lru_wr = (const float*)d_in[10]; p.lru_br = (const float*)d_in[11]; p.lru_wi = (const float*)d_in[12]; p.lru_bi = (const float*)d_in[13];
    p.lru_lambda = (const float*)d_in[14]; p.w_mem_kv = (const float*)d_in[15]; p.p_attn = (const float*)d_in[16]; p.p_lru = (const float*)d_in[17];
    p.p_mem = (const float*)d_in[18]; p.w_out = (const float*)d_in[19]; p.g_ffn = (const float*)d_in[20]; p.w_peer_q = (const float*)d_in[21];
    p.peer_sub_keys = (const float*)d_in[22]; p.peer_u = (const float*)d_in[23]; p.peer_v = (const float*)d_in[24]; p.g_final = (const float*)d_in[25];
    p.out = (float*)d_out; p.ws = (unsigned char*)d_ws;
    static int grid_blocks = 0;
    if (!grid_blocks) {
        int dev = 0, cus = 0, per_cu = 0;
        (void)hipGetDevice(&dev);
        (void)hipDeviceGetAttribute(&cus, hipDeviceAttributeMultiprocessorCount, dev);
        (void)hipOccupancyMaxActiveBlocksPerMultiprocessor(&per_cu, fwd_megakernel, 512, 0);
        if (per_cu > 1) per_cu = 1;
        grid_blocks = cus * per_cu;
    }
    (void)hipMemsetAsync((unsigned char*)d_ws + OFF_BAR, 0, 16384, stream);
    void* args[] = {&p};
    hipError_t e = hipLaunchCooperativeKernel((void*)fwd_megakernel, dim3(grid_blocks), dim3(512), args, 0, stream);
    if (e != hipSuccess) fprintf(stderr, "cooperative launch failed: %s (grid %d)\n", hipGetErrorString(e), grid_blocks);
}
```

```cpp
#include <hip/hip_runtime.h>
#include <stdint.h>
#include <stdio.h>

typedef unsigned short bf16_t;
typedef short bf16x8 __attribute__((ext_vector_type(8)));
typedef __bf16 bf16x2v __attribute__((ext_vector_type(2)));
typedef float f32x4 __attribute__((ext_vector_type(4)));

constexpr int B_ = 16, S_ = 2048, D_ = 1024, NTOK = B_ * S_;
constexpr int MEML = 256, NMEM = B_ * MEML;
constexpr int INW = 6400;
constexpr int LW = 768;
constexpr int NEXP = 16384;
constexpr float EPS = 1e-6f;
constexpr float QSCALE = 0.08838834764831845f * 1.4426950408889634f;

constexpr size_t OFF_WINT = 0;
constexpr size_t OFF_WMKVT = OFF_WINT + (size_t)INW * 1024 * 2;
constexpr size_t OFF_PATTNT = OFF_WMKVT + (size_t)1024 * 1024 * 2;
constexpr size_t OFF_PLRUT = OFF_PATTNT + (size_t)1024 * 768 * 2;
constexpr size_t OFF_PMEMT = OFF_PLRUT + (size_t)1024 * 768 * 2;
constexpr size_t OFF_WOUTT = OFF_PMEMT + (size_t)1024 * 512 * 2;
constexpr size_t OFF_WPQT = OFF_WOUTT + (size_t)1024 * 1024 * 2;
constexpr size_t OFF_LRUWT = OFF_WPQT + (size_t)2048 * 1024 * 2;
constexpr size_t OFF_SUBK = OFF_LRUWT + (size_t)6 * 512 * 128 * 2;
constexpr size_t OFF_UB = OFF_SUBK + (size_t)16 * 128 * 128 * 2;
constexpr size_t OFF_VB = OFF_UB + (size_t)NEXP * 1024;
constexpr size_t OFF_SU = OFF_VB + (size_t)NEXP * 1024;
constexpr size_t OFF_SV = OFF_SU + (size_t)NEXP * 4;
constexpr size_t OFF_RA = OFF_SV + (size_t)NEXP * 4;
constexpr size_t OFF_QA = OFF_RA;
constexpr size_t OFF_KA = OFF_QA + (size_t)NTOK * 768 * 2;
constexpr size_t OFF_VAT = OFF_KA + (size_t)NTOK * 256 * 2;
constexpr size_t OFF_XL = OFF_VAT + (size_t)NTOK * 256 * 2;
constexpr size_t OFF_GL = OFF_XL + (size_t)NTOK * 768 * 2;
constexpr size_t OFF_QM = OFF_GL + (size_t)NTOK * 768 * 2;
constexpr size_t OFF_GATES = OFF_QM + (size_t)NTOK * 512 * 2;
constexpr size_t OFF_BAR = OFF_GATES + (size_t)NTOK * 3072 * 2;
constexpr size_t OFF_SP8 = OFF_BAR + 16384;
constexpr size_t OFF_AGG = OFF_SP8 + 2 * 768 * 4;
constexpr size_t OFF_ROWSS = OFF_AGG + (size_t)2 * B_ * 16 * 768 * 8;
constexpr size_t OFF_LCB = OFF_ROWSS + (size_t)NTOK * 4;
constexpr size_t OFF_END = OFF_LCB + (size_t)NTOK * 768 * 2;
constexpr size_t OFF_MERGED = OFF_KA;
constexpr size_t OFF_QPEER = OFF_GATES;
constexpr size_t OFF_TOPL = OFF_QPEER + (size_t)NTOK * 2048 * 2;
constexpr size_t OFF_EIDX = OFF_TOPL + (size_t)NTOK * 256 * 4;
constexpr size_t OFF_ZBUF = OFF_QPEER;
constexpr size_t OFF_WBUF = OFF_TOPL;
constexpr size_t OFF_EGATE = OFF_EIDX + (size_t)NTOK * 128 * 4;
static_assert(OFF_EGATE + (size_t)NTOK * 128 * 4 <= OFF_BAR, "overlay");
static_assert(OFF_MERGED + (size_t)NTOK * 1024 * 2 <= OFF_GL, "overlay2");
constexpr size_t DO_LCF = 0;
constexpr size_t DO_HBF = 0;
constexpr size_t DO_MEMBF = DO_HBF + (size_t)NTOK * 1024 * 2;
constexpr size_t DO_KM = DO_MEMBF + (size_t)NMEM * 1024 * 2;
constexpr size_t DO_VMT = DO_KM + (size_t)NMEM * 512 * 2;
constexpr size_t DO_ROPE = DO_VMT + (size_t)NMEM * 512 * 2;
static_assert(DO_ROPE + (size_t)NTOK * 32 * 4 <= (size_t)NTOK * 1024 * 4, "d_out scratch");

struct Params {
    const float *x, *mem; const int* positions;
    const float *g_mix, *g_mem, *w_in, *gate_b, *attn_sink, *conv_w, *conv_b, *lru_wr, *lru_br, *lru_wi, *lru_bi, *lru_lambda,
        *w_mem_kv, *p_attn, *p_lru, *p_mem, *w_out, *g_ffn, *w_peer_q, *peer_sub_keys, *peer_u, *peer_v, *g_final;
    float* out; unsigned char* ws;
};

__device__ __forceinline__ int tidx() { int t = threadIdx.x & 255; asm volatile("" : "+v"(t)); return t; }
__device__ __forceinline__ int vbid() { return (int)(blockIdx.x + (threadIdx.x >> 8) * gridDim.x); }
__device__ __forceinline__ int vnb() { return (int)(2 * gridDim.x); }
__device__ __forceinline__ float bf2f(bf16_t b) { return __uint_as_float(((unsigned)b) << 16); }
__device__ __forceinline__ float bflo(unsigned u) { return __uint_as_float(u << 16); }
__device__ __forceinline__ float bfhi(unsigned u) { return __uint_as_float(u & 0xffff0000u); }
typedef float f32x2v __attribute__((ext_vector_type(2)));
__device__ __forceinline__ unsigned pack_bf16(float lo, float hi) { const f32x2v f = {lo, hi}; return __builtin_bit_cast(unsigned, __builtin_convertvector(f, bf16x2v)); }
__device__ __forceinline__ bf16_t f2bf(float f) { return (bf16_t)(pack_bf16(f, 0.f) & 0xffffu); }
__device__ __forceinline__ f32x4 mfma16(bf16x8 a, bf16x8 b, f32x4 c) { return __builtin_amdgcn_mfma_f32_16x16x32_bf16(a, b, c, 0, 0, 0); }
__device__ __forceinline__ float sigmoidf_(float x) { return __builtin_amdgcn_rcpf(1.0f + __expf(-x)); }
__device__ __forceinline__ float gelu_tanh(float x) { const float u = 1.5957691216057308f * (x + 0.044715f * x * x * x); return x * __builtin_amdgcn_rcpf(1.0f + __expf(-u)); }
__device__ __forceinline__ float wave_sum(float v) {
#pragma unroll
    for (int o = 32; o >= 1; o >>= 1) v += __shfl_xor(v, o);
    return v;
}


typedef unsigned u32x4 __attribute__((ext_vector_type(4)));
#define PIN4(a, o) asm volatile("" : "+v"((a)[(o)]), "+v"((a)[(o) + 1]), "+v"((a)[(o) + 2]), "+v"((a)[(o) + 3]))
#define PIN8(a, o) asm volatile("" : "+v"((a)[(o)]), "+v"((a)[(o) + 1]), "+v"((a)[(o) + 2]), "+v"((a)[(o) + 3]), "+v"((a)[(o) + 4]), "+v"((a)[(o) + 5]), "+v"((a)[(o) + 6]), "+v"((a)[(o) + 7]))
#define PIN15(a, o) asm volatile("" : "+v"((a)[(o)]), "+v"((a)[(o) + 1]), "+v"((a)[(o) + 2]), "+v"((a)[(o) + 3]), "+v"((a)[(o) + 4]), "+v"((a)[(o) + 5]), "+v"((a)[(o) + 6]), "+v"((a)[(o) + 7]), \
    "+v"((a)[(o) + 8]), "+v"((a)[(o) + 9]), "+v"((a)[(o) + 10]), "+v"((a)[(o) + 11]), "+v"((a)[(o) + 12]), "+v"((a)[(o) + 13]), "+v"((a)[(o) + 14]))

__device__ void convT_tile(const float* __restrict__ src, bf16_t* __restrict__ dst, int K, int N, int tile, unsigned char* smem) {
    float* t = (float*)smem;
    const int tn = N / 64, tk = tile / tn, tnn = tile % tn, k0 = tk * 64, n0 = tnn * 64, tid = tidx();
    const int r = tid >> 4, c4 = (tid & 15) * 4;
#pragma unroll
    for (int i = 0; i < 4; ++i) {
        const int k = r + 16 * i;
        const float4 v = *(const float4*)(src + (size_t)(k0 + k) * N + n0 + c4);
        t[k * 65 + c4 + 0] = v.x; t[k * 65 + c4 + 1] = v.y; t[k * 65 + c4 + 2] = v.z; t[k * 65 + c4 + 3] = v.w;
    }
    __syncthreads();
    const int n = tid >> 2, kq = (tid & 3) * 16;
    unsigned w[8];
#pragma unroll
    for (int i = 0; i < 8; ++i) w[i] = pack_bf16(t[(kq + 2 * i) * 65 + n], t[(kq + 2 * i + 1) * 65 + n]);
    uint4* d = (uint4*)(dst + (size_t)(n0 + n) * K + k0 + kq);
    d[0] = make_uint4(w[0], w[1], w[2], w[3]); d[1] = make_uint4(w[4], w[5], w[6], w[7]);
    __syncthreads();
}


__device__ __forceinline__ void rms_row_bf16(const float* __restrict__ xr, const float* __restrict__ g, bf16_t* __restrict__ o, int lane) {
    float4 v[4]; float ss = 0.f;
#pragma unroll
    for (int i = 0; i < 4; ++i) { v[i] = *(const float4*)(xr + i * 256 + lane * 4); ss += v[i].x * v[i].x + v[i].y * v[i].y + v[i].z * v[i].z + v[i].w * v[i].w; }
    ss = wave_sum(ss);
    const float rs = rsqrtf(ss * (1.0f / 1024.0f) + EPS);
#pragma unroll
    for (int i = 0; i < 4; ++i) {
        const float4 gg = *(const float4*)(g + i * 256 + lane * 4);
        *(uint2*)(o + i * 256 + lane * 4) = make_uint2(pack_bf16(v[i].x * rs * gg.x, v[i].y * rs * gg.y), pack_bf16(v[i].z * rs * gg.z, v[i].w * rs * gg.w));
    }
}


__device__ __forceinline__ void conv_plain(const float* __restrict__ src, bf16_t* __restrict__ dst, size_t n8) {
    for (size_t i = (size_t)vbid() * 256 + tidx(); i < n8; i += (size_t)vnb() * 256) {
        const float4 a = ((const float4*)src)[2 * i], b = ((const float4*)src)[2 * i + 1];
        ((uint4*)dst)[i] = make_uint4(pack_bf16(a.x, a.y), pack_bf16(a.z, a.w), pack_bf16(b.x, b.y), pack_bf16(b.z, b.w));
    }
}
__device__ __forceinline__ void rope_item(const int* __restrict__ pos, float* __restrict__ cs, int i) {
    const int t = i >> 4, f = i & 15;
    const float inv = powf(500000.0f, -(float)(2 * f) / 32.0f);
    const float ang = (float)pos[t] * inv;
    float s, c; sincosf(ang, &s, &c);
    cs[2 * i] = c; cs[2 * i + 1] = s;
}

__device__ __forceinline__ int swz(int row) { return (row & 3) | (((row >> 3) & 1) << 2); }

struct GemmOp { const bf16_t* A; const bf16_t* Bt; int lda, ldb; };
struct GemmPipe { int par; bool pre; };

__device__ __forceinline__ void gemm_issue(const GemmOp& op, int kt, int st, unsigned char* smem) {
    const int tid = tidx();
    const int srow = tid >> 3, skc = (tid & 7) ^ swz(tid >> 3);
    const bf16_t* ga = op.A + (size_t)srow * op.lda + skc * 8 + kt * 64;
    const bf16_t* gb = op.Bt + (size_t)srow * op.ldb + skc * 8 + kt * 64;
    unsigned char* sw = smem + tid * 16 + st * 32768;
#pragma unroll
    for (int i = 0; i < 4; ++i) {
        __builtin_amdgcn_global_load_lds((const unsigned*)(ga + (size_t)(32 * i) * op.lda), (unsigned*)(sw + i * 4096), 16, 0, 0);
        __builtin_amdgcn_global_load_lds((const unsigned*)(gb + (size_t)(32 * i) * op.ldb), (unsigned*)(sw + 16384 + i * 4096), 16, 0, 0);
    }
}
__device__ __forceinline__ void gemm_prefetch(const GemmOp& nx, unsigned char* smem, GemmPipe& pp) { gemm_issue(nx, 0, pp.par, smem); pp.pre = true; }

__device__ __forceinline__ void gemm_tile(const GemmOp& op, int K, f32x4 (&acc)[4][4], unsigned char* smem, GemmPipe& pp) {
    const int tid = tidx(), lane = tid & 63, wid = tid >> 6, wr = wid >> 1, wc = wid & 1, li = lane & 15, g = lane >> 4;
    int aoff[4], boff[4], asw[4], bsw[4];
#pragma unroll
    for (int m = 0; m < 4; ++m) { const int row = wr * 64 + m * 16 + li; aoff[m] = row * 128; asw[m] = swz(row); }
#pragma unroll
    for (int n = 0; n < 4; ++n) { const int row = wc * 64 + 32 * (n >> 1) + 8 * (li >> 2) + 4 * (n & 1) + (li & 3); boff[n] = 16384 + row * 128; bsw[n] = swz(row); }
    const int nk = K >> 6;
    if (!pp.pre) gemm_issue(op, 0, pp.par, smem);
    __syncthreads();
    for (int kt = 0; kt < nk; ++kt) {
        const int cur = (pp.par + kt) & 1;
        const unsigned char* sb = smem + cur * 32768;
        if (kt + 1 < nk) gemm_issue(op, kt + 1, cur ^ 1, smem);
#pragma unroll
        for (int ks = 0; ks < 2; ++ks) {
            bf16x8 af[4], bfr[4];
#pragma unroll
            for (int m = 0; m < 4; ++m) af[m] = *(const bf16x8*)(sb + aoff[m] + (((ks * 4 + g) ^ asw[m]) << 4));
#pragma unroll
            for (int n = 0; n < 4; ++n) bfr[n] = *(const bf16x8*)(sb + boff[n] + (((ks * 4 + g) ^ bsw[n]) << 4));
#pragma unroll
            for (int m = 0; m < 4; ++m)
#pragma unroll
                for (int n = 0; n < 4; ++n) acc[m][n] = mfma16(bfr[n], af[m], acc[m][n]);
        }
        if (kt + 1 < nk) __syncthreads();
    }
    pp.par = (pp.par + nk) & 1; pp.pre = false;
}
__device__ __forceinline__ void acc_zero(f32x4 (&acc)[4][4]) {
#pragma unroll
    for (int m = 0; m < 4; ++m)
#pragma unroll
        for (int n = 0; n < 4; ++n) acc[m][n] = (f32x4){0.f, 0.f, 0.f, 0.f};
}
template <class F> __device__ __forceinline__ void epi_foreach(const f32x4 (&acc)[4][4], F&& f) {
    const int lane = tidx() & 63, wid = tidx() >> 6, wr = wid >> 1, wc = wid & 1, li = lane & 15, g = lane >> 4;
#pragma unroll
    for (int m = 0; m < 4; ++m)
#pragma unroll
        for (int pp = 0; pp < 2; ++pp) {
            float v[8];
#pragma unroll
            for (int r = 0; r < 4; ++r) { v[r] = acc[m][2 * pp][r]; v[4 + r] = acc[m][2 * pp + 1][r]; }
            f(wr * 64 + m * 16 + li, wc * 64 + 32 * pp + 8 * g, v, pp, m);
        }
}
__device__ __forceinline__ void store_bf16x8(bf16_t* p, const float (&v)[8]) {
    *(uint4*)p = make_uint4(pack_bf16(v[0], v[1]), pack_bf16(v[2], v[3]), pack_bf16(v[4], v[5]), pack_bf16(v[6], v[7]));
}
__device__ __forceinline__ void store_tile_T(const f32x4 (&acc)[4][4], bf16_t* __restrict__ dstT, int ldt, unsigned char* smem) {
    bf16_t* t = (bf16_t*)smem;
    __syncthreads();
    epi_foreach(acc, [&](int r, int c, const float (&v)[8], int, int) {
#pragma unroll
        for (int e = 0; e < 8; ++e) t[(c + e) * 136 + r] = f2bf(v[e]);
    });
    __syncthreads();
#pragma unroll
    for (int i = 0; i < 8; ++i) {
        const int ch = tidx() + 256 * i, d = ch >> 4, tc = ch & 15;
        *(uint4*)(dstT + (size_t)d * ldt + tc * 8) = *(const uint4*)(smem + d * 272 + tc * 16);
    }
    __syncthreads();
}

__device__ void inproj_tile(const Params& p, int rt, int ct, unsigned char* smem, GemmPipe& pp, bool hn, int nrt, int nct) {
    unsigned char* ws = p.ws; unsigned char* dob = (unsigned char*)p.out;
    const bf16_t* hbf = (const bf16_t*)(dob + DO_HBF);
    const bf16_t* WinT = (const bf16_t*)(ws + OFF_WINT);
    f32x4 acc[4][4]; acc_zero(acc);
    const GemmOp op{hbf + (size_t)rt * 128 * 1024, WinT + (size_t)ct * 128 * 1024, 1024, 1024};
    const GemmOp nx{hbf + (size_t)nrt * 128 * 1024, WinT + (size_t)nct * 128 * 1024, 1024, 1024};
    gemm_tile(op, 1024, acc, smem, pp);
    const int row0 = rt * 128;
    if (ct < 8) {
        const float* cs = (const float*)(dob + DO_ROPE);
        const bool isq = ct < 6;
        bf16_t* dst = isq ? (bf16_t*)(ws + OFF_QA) + ct * 128 : (bf16_t*)(ws + OFF_KA) + (ct - 6) * 128;
        const int ld = isq ? 768 : 256;
        const float sc = isq ? QSCALE : 1.0f;
        const int lane_ = tidx() & 63, g = lane_ >> 4, wid_ = tidx() >> 6;
        f32x4 csv[16];
        if ((wid_ & 1) == 0) {
#pragma unroll
            for (int m = 0; m < 4; ++m) {
                const f32x4* csr = (const f32x4*)(cs + (size_t)(row0 + (wid_ >> 1) * 64 + m * 16 + (lane_ & 15)) * 32 + (g & 1) * 16);
#pragma unroll
                for (int q = 0; q < 4; ++q) csv[m * 4 + q] = csr[q];
            }
            PIN8(csv, 0); PIN8(csv, 8);
        }
        if (hn) gemm_prefetch(nx, smem, pp);
        epi_foreach(acc, [&](int r, int c, float (&v)[8], int pq, int mq) {
            const int tok = row0 + r;
            if (pq == 0 && c < 32) {
                const f32x4 c0 = csv[mq * 4], c1 = csv[mq * 4 + 1], c2 = csv[mq * 4 + 2], c3 = csv[mq * 4 + 3];
                const float ccv[8] = {c0[0], c0[2], c1[0], c1[2], c2[0], c2[2], c3[0], c3[2]};
                const float ssv[8] = {c0[1], c0[3], c1[1], c1[3], c2[1], c2[3], c3[1], c3[3]};
#pragma unroll
                for (int e = 0; e < 8; ++e) {
                    const float o = __shfl_xor(v[e], 32);
                    v[e] = (g < 2) ? (v[e] * ccv[e] - o * ssv[e]) : (v[e] * ccv[e] + o * ssv[e]);
                }
            }
#pragma unroll
            for (int e = 0; e < 8; ++e) v[e] *= sc;
            store_bf16x8(dst + (size_t)tok * ld + c, v);
        });
    }
    if (!(ct == 8 || ct == 9)) { __syncthreads(); __syncthreads(); __syncthreads(); }
    if (ct < 8) { } else if (ct < 10) {
        const int kvh = ct - 8, b = row0 / S_, s0 = row0 % S_;
        store_tile_T(acc, (bf16_t*)(ws + OFF_VAT) + (size_t)(b * 2 + kvh) * 128 * S_ + s0, S_, smem);
    } else if (ct < 16) {
        if (hn) gemm_prefetch(nx, smem, pp);
        bf16_t* dst = (bf16_t*)(ws + OFF_XL) + (ct - 10) * 128;
        epi_foreach(acc, [&](int r, int c, float (&v)[8], int, int) { store_bf16x8(dst + (size_t)(row0 + r) * 768 + c, v); });
    } else if (ct < 22) {
        if (hn) gemm_prefetch(nx, smem, pp);
        bf16_t* dst = (bf16_t*)(ws + OFF_GL) + (ct - 16) * 128;
        epi_foreach(acc, [&](int r, int c, float (&v)[8], int, int) {
#pragma unroll
            for (int e = 0; e < 8; ++e) v[e] = gelu_tanh(v[e]);
            store_bf16x8(dst + (size_t)(row0 + r) * 768 + c, v); });
    } else if (ct < 26) {
        if (hn) gemm_prefetch(nx, smem, pp);
        bf16_t* dst = (bf16_t*)(ws + OFF_QM) + (ct - 22) * 128;
        epi_foreach(acc, [&](int r, int c, float (&v)[8], int, int) {
#pragma unroll
            for (int e = 0; e < 8; ++e) v[e] *= QSCALE;
            store_bf16x8(dst + (size_t)(row0 + r) * 512 + c, v); });
    } else {
        const int gc0 = (ct - 26) * 128;
        bf16_t* dst = (bf16_t*)(ws + OFF_GATES) + gc0;
        const float* gb = p.gate_b + gc0;
        f32x4 gbv[4];
        {
            const int lane_ = tidx() & 63, c0 = ((tidx() >> 6) & 1) * 64 + 8 * (lane_ >> 4);
#pragma unroll
            for (int q = 0; q < 2; ++q) { gbv[2 * q] = *(const f32x4*)(gb + c0 + 32 * q); gbv[2 * q + 1] = *(const f32x4*)(gb + c0 + 32 * q + 4); }
            PIN4(gbv, 0);
        }
        if (hn) gemm_prefetch(nx, smem, pp);
        epi_foreach(acc, [&](int r, int c, float (&v)[8], int pq, int mq) {
            const f32x4 b0 = gbv[2 * pq], b1 = gbv[2 * pq + 1];
            v[0] = sigmoidf_(v[0] + b0[0]); v[1] = sigmoidf_(v[1] + b0[1]); v[2] = sigmoidf_(v[2] + b0[2]); v[3] = sigmoidf_(v[3] + b0[3]);
            v[4] = sigmoidf_(v[4] + b1[0]); v[5] = sigmoidf_(v[5] + b1[1]); v[6] = sigmoidf_(v[6] + b1[2]); v[7] = sigmoidf_(v[7] + b1[3]);
            store_bf16x8(dst + (size_t)(row0 + r) * 3072 + c, v); });
    }
}

__device__ void memkv_tile(const Params& p, int rt, int ct, unsigned char* smem) {
    unsigned char* dob = (unsigned char*)p.out;
    f32x4 acc[4][4]; acc_zero(acc);
    const GemmOp op{(const bf16_t*)(dob + DO_MEMBF) + (size_t)rt * 128 * 1024, (const bf16_t*)(p.ws + OFF_WMKVT) + (size_t)ct * 128 * 1024, 1024, 1024};
    GemmPipe pp{0, false};
    __syncthreads();
    gemm_tile(op, 1024, acc, smem, pp);
    const int row0 = rt * 128;
    if (ct < 4) {
        bf16_t* dst = (bf16_t*)(dob + DO_KM) + ct * 128;
        epi_foreach(acc, [&](int r, int c, float (&v)[8], int, int) { store_bf16x8(dst + (size_t)(row0 + r) * 512 + c, v); });
    } else {
        const int h = ct - 4, b = row0 / MEML, m0 = row0 % MEML;
        store_tile_T(acc, (bf16_t*)(dob + DO_VMT) + (size_t)(b * 4 + h) * 128 * MEML + m0, MEML, smem);
    }
}


typedef float f32x16 __attribute__((ext_vector_type(16)));
__device__ __forceinline__ f32x16 mfma32(bf16x8 a, bf16x8 b, f32x16 c) { return __builtin_amdgcn_mfma_f32_32x32x16_bf16(a, b, c, 0, 0, 0); }
constexpr int ATT_STAGE = 16384 + 128 * 136;

template <bool WIN>
__device__ void attn_block(const bf16_t* Qg, int ldq, const bf16_t* __restrict__ Kg, int ldk, const bf16_t* __restrict__ Vtg, int ldv,
                           int q0, int kt0, int nt, float sink2, bf16_t* Og, int ldo, unsigned char* smem) {
    const int tid = tidx(), lane = tid & 63, wid = tid >> 6, r = lane & 31, hh = lane >> 5;
    const int qw = q0 + 32 * wid;
    bf16x8 qf[8];
#pragma unroll
    for (int ks = 0; ks < 8; ++ks) qf[ks] = *(const bf16x8*)(Qg + (size_t)(32 * wid + r) * ldq + ks * 16 + hh * 8);
    f32x16 o[4];
#pragma unroll
    for (int db = 0; db < 4; ++db)
#pragma unroll
        for (int e = 0; e < 16; ++e) o[db][e] = 0.f;
    float m = WIN ? sink2 : -1e30f, l = WIN ? 1.0f : 0.0f;
    const int krow = tid >> 4, kch = tid & 15, vrow = tid >> 3, vch = tid & 7;
    const int koff = krow * 256 + ((kch ^ (krow & 15)) << 4);
    const int voff = 16384 + vrow * 136 + vch * 16;
    uint4 rk[4], rv[4];
    const bf16_t* kgp = Kg + (size_t)(kt0 * 64 + krow) * ldk + kch * 8;
    const bf16_t* vgp = Vtg + (size_t)vrow * ldv + kt0 * 64 + vch * 8;
#pragma unroll
    for (int i = 0; i < 4; ++i) { rk[i] = *(const uint4*)(kgp + (size_t)(16 * i) * ldk); rv[i] = *(const uint4*)(vgp + (size_t)(32 * i) * ldv); }
#pragma unroll
    for (int i = 0; i < 4; ++i) {
        *(uint4*)(smem + koff + i * 4096) = rk[i];
        *(uint2*)(smem + voff + i * 4352) = make_uint2(rv[i].x, rv[i].y); *(uint2*)(smem + voff + i * 4352 + 8) = make_uint2(rv[i].z, rv[i].w);
    }
    __syncthreads();
    constexpr int NTL = WIN ? 6 : 4;
    for (int t = 0; t < NTL; ++t) {
        const unsigned char* sb = smem + (t & 1) * ATT_STAGE;
        {
            const int tn = t + 1 < nt ? t + 1 : nt - 1;
#pragma unroll
            for (int i = 0; i < 4; ++i) { rk[i] = *(const uint4*)(kgp + (size_t)(tn * 64 + 16 * i) * ldk); rv[i] = *(const uint4*)(vgp + (size_t)(32 * i) * ldv + tn * 64); }
        }
        const int k0 = (kt0 + t) * 64;
        if (t < nt && (!WIN || (k0 + 63 >= qw - 128 && k0 <= qw + 159))) {
#pragma unroll
            for (int kb = 0; kb < 2; ++kb) {
                const int kb0 = k0 + 32 * kb;
                if (WIN && !(kb0 + 31 >= qw - 128 && kb0 <= qw + 159)) continue;
                f32x16 s;
#pragma unroll
                for (int e = 0; e < 16; ++e) s[e] = 0.f;
                const int row = kb * 32 + r;
#pragma unroll
                for (int ks = 0; ks < 8; ++ks) {
                    const bf16x8 a = *(const bf16x8*)(sb + row * 256 + (((2 * ks + hh) ^ (row & 15)) << 4));
                    s = mfma32(a, qf[ks], s);
                }
                if (WIN && !(kb0 >= qw - 97 && kb0 + 31 <= qw + 128)) {
#pragma unroll
                    for (int e = 0; e < 16; ++e) {
                        const int d = kb0 + (e & 3) + 8 * (e >> 2) + 4 * hh - (qw + r);
                        s[e] = (d <= 128 && d >= -128) ? s[e] : -1e30f;
                    }
                }
                float mx = s[0];
#pragma unroll
                for (int e = 1; e < 16; ++e) mx = fmaxf(mx, s[e]);
                mx = fmaxf(mx, __shfl_xor(mx, 32));
                const float mnew = fmaxf(m, mx), alpha = __builtin_amdgcn_exp2f(m - mnew);
                m = mnew;
                float ps = 0.f;
#pragma unroll
                for (int e = 0; e < 16; ++e) { s[e] = __builtin_amdgcn_exp2f(s[e] - mnew); ps += s[e]; }
                ps += __shfl_xor(ps, 32);
                l = l * alpha + ps;
                if (__any(alpha != 1.0f)) {
#pragma unroll
                    for (int db = 0; db < 4; ++db)
#pragma unroll
                        for (int e = 0; e < 16; ++e) o[db][e] *= alpha;
                }
#pragma unroll
                for (int s2 = 0; s2 < 2; ++s2) {
                    union { unsigned u[4]; bf16x8 v; } pb;
#pragma unroll
                    for (int e = 0; e < 4; ++e) pb.u[e] = pack_bf16(s[8 * s2 + 2 * e], s[8 * s2 + 2 * e + 1]);
#pragma unroll
                    for (int db = 0; db < 4; ++db) {
                        const unsigned char* vp = sb + 16384 + (db * 32 + r) * 136 + (kb * 32 + 16 * s2 + 4 * hh) * 2;
                        union { uint2 u[2]; bf16x8 v; } va;
                        va.u[0] = *(const uint2*)vp; va.u[1] = *(const uint2*)(vp + 16);
                        o[db] = mfma32(va.v, pb.v, o[db]);
                    }
                }
            }
        }
        {
            unsigned char* sw = smem + ((t + 1) & 1) * ATT_STAGE;
#pragma unroll
            for (int i = 0; i < 4; ++i) {
                *(uint4*)(sw + koff + i * 4096) = rk[i];
                *(uint2*)(sw + voff + i * 4352) = make_uint2(rv[i].x, rv[i].y); *(uint2*)(sw + voff + i * 4352 + 8) = make_uint2(rv[i].z, rv[i].w);
            }
        }
        __syncthreads();
    }
    const float inv = __builtin_amdgcn_rcpf(l);
    bf16_t* orow = Og + (size_t)(32 * wid + r) * ldo + 4 * hh;
#pragma unroll
    for (int db = 0; db < 4; ++db)
#pragma unroll
        for (int gq = 0; gq < 4; ++gq)
            *(uint2*)(orow + db * 32 + 8 * gq) = make_uint2(pack_bf16(o[db][4 * gq] * inv, o[db][4 * gq + 1] * inv), pack_bf16(o[db][4 * gq + 2] * inv, o[db][4 * gq + 3] * inv));
}
__device__ void attn_win_unit(const Params& p, int u, unsigned char* smem) {
    const int gh = u % 3, qb = (u / 3) % 16, kvh = (u / 48) % 2, b = u / 96, head = kvh * 3 + gh;
    const int q0 = qb * 128;
    const int ks = q0 - 128 < 0 ? 0 : q0 - 128, ke = q0 + 256 > S_ ? S_ : q0 + 256;
    bf16_t* Q = (bf16_t*)(p.ws + OFF_QA) + (size_t)(b * S_ + q0) * 768 + head * 128;
    const bf16_t* Kb = (const bf16_t*)(p.ws + OFF_KA) + (size_t)(b * S_) * 256 + kvh * 128;
    const bf16_t* Vt = (const bf16_t*)(p.ws + OFF_VAT) + (size_t)(b * 2 + kvh) * 128 * S_;
    attn_block<true>(Q, 768, Kb, 256, Vt, S_, q0, ks / 64, (ke - ks) / 64, p.attn_sink[head] * 1.4426950408889634f, Q, 768, smem);
}
__device__ void attn_mem_unit(const Params& p, int u, unsigned char* smem) {
    const int qb = u % 16, head = (u / 16) % 4, b = u / 64;
    const int q0 = qb * 128;
    unsigned char* dob = (unsigned char*)p.out;
    bf16_t* Q = (bf16_t*)(p.ws + OFF_QM) + (size_t)(b * S_ + q0) * 512 + head * 128;
    const bf16_t* Kb = (const bf16_t*)(dob + DO_KM) + (size_t)(b * MEML) * 512 + head * 128;
    const bf16_t* Vt = (const bf16_t*)(dob + DO_VMT) + (size_t)(b * 4 + head) * 128 * MEML;
    attn_block<false>(Q, 512, Kb, 512, Vt, MEML, q0, 0, 4, 0.f, Q, 512, smem);
}

typedef _Float16 f16x2v __attribute__((ext_vector_type(2)));
__device__ __forceinline__ unsigned pack_f16(float lo, float hi) { return __builtin_bit_cast(unsigned, __builtin_amdgcn_cvt_pkrtz(lo, hi)); }
template <bool FINAL>
__device__ void lru_chunk_unit(const Params& p, int u, unsigned char* smem) {
    const int tid = tidx(), lane = tid & 63, wid = tid >> 6, li = lane & 15, g = lane >> 4;
    const int c = u & 15, h = (u >> 4) % 6, b = u / 96;
    const int cbase = h * 128, s0 = c * 128;
    unsigned char* xcs = smem; unsigned char* LB = smem + 32768; float2* SA = (float2*)(smem + 49152); unsigned char* WL = smem + 51200; float* CC = (float*)(smem + 67584);
    const bf16_t* Xl = (const bf16_t*)(p.ws + OFF_XL) + (size_t)(b * S_) * 768;
    bf16_t* Gl = (bf16_t*)(p.ws + OFF_GL) + (size_t)(b * S_ + s0) * 768;
    const bf16_t* LruWt = (const bf16_t*)(p.ws + OFF_LRUWT) + (size_t)h * 512 * 128;
    const float* SP8 = (const float*)(p.ws + OFF_SP8);
    float2* AGG = (float2*)(p.ws + OFF_AGG);
    bf16_t* LCF = (bf16_t*)((unsigned char*)p.out + DO_LCF) + (size_t)(b * S_ + s0) * 768; bf16_t* LCB = (bf16_t*)(p.ws + OFF_LCB) + (size_t)(b * S_ + s0) * 768;
    auto stage_w = [&](int hc_, int d_) {
#pragma unroll
        for (int i = 0; i < 4; ++i) {
            const int rr = (tid >> 4) + 16 * i, n = rr >> 4, wrow = ((n >> 1) * 2 + d_) * 128 + hc_ * 32 + 16 * (n & 1) + (rr & 15);
            __builtin_amdgcn_global_load_lds((const unsigned*)(LruWt + (size_t)wrow * 128 + (((tid & 15) ^ (rr & 15)) << 3)), (unsigned*)(WL + tid * 16 + i * 4096), 16, 0, 0);
        }
    };
    __syncthreads();
    {
        const int cp = tid & 63, tq = tid >> 6, cch = cbase + 2 * cp;
        float cw[4][2];
#pragma unroll
        for (int j = 0; j < 4; ++j) { cw[j][0] = p.conv_w[j * LW + cch]; cw[j][1] = p.conv_w[j * LW + cch + 1]; }
        const float cb0 = p.conv_b[cch], cb1 = p.conv_b[cch + 1];
#pragma unroll
        for (int hf = 0; hf < 2; ++hf) {
            const int tb = 32 * tq + 16 * hf;
            unsigned xw[19];
#pragma unroll
            for (int i = 0; i < 19; ++i) {
                const int s = s0 + tb + i - 2, sc = s < 0 ? 0 : (s > S_ - 1 ? S_ - 1 : s);
                xw[i] = *(const unsigned*)(Xl + (size_t)sc * 768 + cch);
            }
            PIN15(xw, 0); PIN4(xw, 15);
#pragma unroll
            for (int i = 0; i < 19; ++i) { const int s = s0 + tb + i - 2; xw[i] = (s >= 0 && s < S_) ? xw[i] : 0u; }
#pragma unroll
            for (int i = 0; i < 16; ++i) {
                const int t = tb + i;
                const float y0 = cb0 + cw[0][0] * bflo(xw[i]) + cw[1][0] * bflo(xw[i + 1]) + cw[2][0] * bflo(xw[i + 2]) + cw[3][0] * bflo(xw[i + 3]);
                const float y1 = cb1 + cw[0][1] * bfhi(xw[i]) + cw[1][1] * bfhi(xw[i + 1]) + cw[2][1] * bfhi(xw[i + 2]) + cw[3][1] * bfhi(xw[i + 3]);
                *(unsigned*)(xcs + t * 256 + (((cp >> 2) ^ (t & 15)) << 4) + (cp & 3) * 4) = pack_bf16(y0, y1);
            }
        }
    }
    const int sch = tid & 31, seg = tid >> 5;
    float4 cst[2][3];
    auto load_cst = [&](int hc_, int d_) {
#pragma unroll
        for (int n = 0; n < 2; ++n) {
            const int gch = cbase + hc_ * 32 + 16 * n + 4 * g;
            cst[n][0] = *(const float4*)(p.lru_br + d_ * LW + gch); cst[n][1] = *(const float4*)(p.lru_bi + d_ * LW + gch); cst[n][2] = *(const float4*)(SP8 + d_ * LW + gch);
        }
    };
    stage_w(0, 0);
    __syncthreads();
#pragma unroll 1
    for (int hc = 0; hc < 4; ++hc) {
        float hfv[16], pfv[16];
#pragma unroll
        for (int d = 0; d < 2; ++d) {
            load_cst(hc, d);
            f32x4 acc[2][4];
#pragma unroll
            for (int m = 0; m < 2; ++m)
#pragma unroll
                for (int n = 0; n < 4; ++n) acc[m][n] = (f32x4){0.f, 0.f, 0.f, 0.f};
#pragma unroll
            for (int ks = 0; ks < 4; ++ks) {
                bf16x8 xf[2];
#pragma unroll
                for (int m = 0; m < 2; ++m) { const int row = 32 * wid + 16 * m + li; xf[m] = *(const bf16x8*)(xcs + row * 256 + (((ks * 4 + g) ^ (row & 15)) << 4)); }
#pragma unroll
                for (int n = 0; n < 4; ++n) {
                    const int rr = 16 * n + li;
                    const bf16x8 wf = *(const bf16x8*)(WL + rr * 256 + (((ks * 4 + g) ^ li) << 4));
#pragma unroll
                    for (int m = 0; m < 2; ++m) acc[m][n] = mfma16(wf, xf[m], acc[m][n]);
                }
            }
#pragma unroll
            for (int n = 0; n < 2; ++n) {
                const int ch4 = 16 * n + 4 * g;
                const float4 br4 = cst[n][0], bi4 = cst[n][1], sp4 = cst[n][2];
                const float brv[4] = {br4.x, br4.y, br4.z, br4.w}, biv[4] = {bi4.x, bi4.y, bi4.z, bi4.w}, spv[4] = {sp4.x, sp4.y, sp4.z, sp4.w};
#pragma unroll
                for (int m = 0; m < 2; ++m) {
                    const int tok = 32 * wid + 16 * m + li;
                    const uint2 xq = *(const uint2*)(xcs + tok * 256 + ((((hc * 32 + ch4) >> 3) ^ (tok & 15)) << 4) + (g & 1) * 8);
                    const float xc[4] = {bflo(xq.x), bfhi(xq.x), bflo(xq.y), bfhi(xq.y)};
                    unsigned w[4];
#pragma unroll
                    for (int r = 0; r < 4; ++r) {
                        const float rg = sigmoidf_(acc[m][n][r] + brv[r]), ig = sigmoidf_(acc[m][n + 2][r] + biv[r]);
                        const float la = spv[r] * rg, a = __builtin_amdgcn_exp2f(la);
                        const float bx = __builtin_amdgcn_sqrtf(fmaxf(1.0f - a * a, 0.f)) * (ig * xc[r]);
                        w[r] = pack_f16(la, bx);
                    }
                    *(uint4*)(LB + tok * 128 + (((ch4 >> 2) ^ (tok & 7)) << 4)) = make_uint4(w[0], w[1], w[2], w[3]);
                }
            }
            __syncthreads();
            if (!(hc == 3 && d == 1)) stage_w(d ? hc + 1 : hc, d ^ 1);
            const int gch = cbase + hc * 32 + sch;
            {
                float L = 0.f, H = 0.f;
#pragma unroll
                for (int k = 0; k < 16; ++k) {
                    const int tok = 16 * seg + (d ? 15 - k : k);
                    const unsigned w = *(const unsigned*)(LB + tok * 128 + (((sch >> 2) ^ (tok & 7)) << 4) + (sch & 3) * 4);
                    const f16x2v hv = __builtin_bit_cast(f16x2v, w);
                    const float la = (float)hv.x, bx = (float)hv.y;
                    H = __builtin_amdgcn_exp2f(la) * H + bx; L += la;
                }
                SA[seg * 32 + sch] = make_float2(L, H);
            }
            __syncthreads();
            if (seg == 0) {
                float L = 0.f, H = 0.f;
#pragma unroll
                for (int s = 0; s < 8; ++s) { const float2 a = SA[(d ? 7 - s : s) * 32 + sch]; H = __builtin_amdgcn_exp2f(a.x) * H + a.y; L += a.x; }
                AGG[((size_t)(d * B_ + b) * 16 + c) * 768 + gch] = make_float2(L, H);
            }
            {
                float H = 0.f, Lc = 0.f;
#pragma unroll
                for (int ss = 0; ss < 8; ++ss) {
                    const int s = d ? 7 - ss : ss;
                    const bool on = d ? (s > seg) : (s < seg);
                    const float2 a = SA[s * 32 + sch];
                    H = __builtin_amdgcn_exp2f(on ? a.x : 0.f) * H + (on ? a.y : 0.f); Lc += on ? a.x : 0.f;
                }
                bf16_t* gp = Gl + (size_t)(16 * seg) * 768 + gch;
                float gv[16];
                if (d) {
                    unsigned gr[16];
#pragma unroll
                    for (int k = 0; k < 16; ++k) gr[k] = gp[(size_t)k * 768];
                    PIN8(gr, 0); PIN8(gr, 8);
#pragma unroll
                    for (int k = 0; k < 16; ++k) gv[k] = __uint_as_float(gr[k] << 16);
                }
                bf16_t* cfp = LCF + (size_t)(16 * seg) * 768 + gch; bf16_t* cbp = LCB + (size_t)(16 * seg) * 768 + gch;
#pragma unroll
                for (int k = 0; k < 16; ++k) {
                    const int kk = d ? 15 - k : k, tok = 16 * seg + kk;
                    const unsigned w = *(const unsigned*)(LB + tok * 128 + (((sch >> 2) ^ (tok & 7)) << 4) + (sch & 3) * 4);
                    const f16x2v hv = __builtin_bit_cast(f16x2v, w);
                    const float la = (float)hv.x;
                    H = __builtin_amdgcn_exp2f(la) * H + (float)hv.y; Lc += la;
                    const float P = __builtin_amdgcn_exp2f(Lc);
                    if (d == 0) { hfv[kk] = H; pfv[kk] = P; }
                    else {
                        hfv[kk] = (hfv[kk] + H) * gv[kk];
                        cfp[(size_t)kk * 768] = f2bf(pfv[kk] * gv[kk]);
                        cbp[(size_t)kk * 768] = f2bf(P * gv[kk]);
                    }
                }
                if (d) {
#pragma unroll
                    for (int k = 0; k < 16; ++k) gp[(size_t)k * 768] = f2bf(hfv[k]);
                }
            }
            __syncthreads();
        }
    }
}


__device__ void lru_fixup_unit(const Params& p, int u) {
    const int tid = tidx(), cp = tid & 63, tq = tid >> 6;
    const int c = u & 15, h = (u >> 4) % 6, b = u / 96, cch = h * 128 + 2 * cp, s0 = c * 128;
    const float2* AGG = (const float2*)(p.ws + OFF_AGG);
    float hin[2][2];
#pragma unroll
    for (int d = 0; d < 2; ++d) {
        f32x4 av[16];
#pragma unroll
        for (int j = 0; j < 16; ++j) av[j] = *(const f32x4*)(AGG + ((size_t)(d * B_ + b) * 16 + j) * 768 + cch);
        PIN8(av, 0); PIN8(av, 8);
        float H0 = 0.f, H1 = 0.f;
#pragma unroll
        for (int jj = 0; jj < 16; ++jj) {
            const int j = d ? 15 - jj : jj;
            const bool on = d ? (j > c) : (j < c);
            H0 = __builtin_amdgcn_exp2f(on ? av[j][0] : 0.f) * H0 + (on ? av[j][1] : 0.f);
            H1 = __builtin_amdgcn_exp2f(on ? av[j][2] : 0.f) * H1 + (on ? av[j][3] : 0.f);
        }
        hin[d][0] = H0; hin[d][1] = H1;
    }
    const size_t base = (size_t)(b * S_ + s0 + 32 * tq) * 768 + cch;
    bf16_t* Gl = (bf16_t*)(p.ws + OFF_GL) + base;
    const bf16_t* LCF = (const bf16_t*)((const unsigned char*)p.out + DO_LCF) + base; const bf16_t* LCB = (const bf16_t*)(p.ws + OFF_LCB) + base;
#pragma unroll 1
    for (int g8 = 0; g8 < 4; ++g8) {
        unsigned sv[8], fv[8], bv[8];
#pragma unroll
        for (int i = 0; i < 8; ++i) { const size_t o = (size_t)(g8 * 8 + i) * 768; sv[i] = *(const unsigned*)(Gl + o); fv[i] = *(const unsigned*)(LCF + o); bv[i] = *(const unsigned*)(LCB + o); }
        PIN8(sv, 0); PIN8(fv, 0); PIN8(bv, 0);
#pragma unroll
        for (int i = 0; i < 8; ++i) {
            const float o0 = bflo(sv[i]) + bflo(fv[i]) * hin[0][0] + bflo(bv[i]) * hin[1][0];
            const float o1 = bfhi(sv[i]) + bfhi(fv[i]) * hin[0][1] + bfhi(bv[i]) * hin[1][1];
            *(unsigned*)(Gl + (size_t)(g8 * 8 + i) * 768) = pack_bf16(o0, o1);
        }
    }
}

__device__ void merge_tile(const Params& p, int rt, int ct, unsigned char* smem, GemmPipe& pp, bool hn, int nrt, int nct) {
    unsigned char* ws = p.ws;
    const int row0 = rt * 128, col0 = ct * 128;
    uint4 tot[4][2];
    const bf16_t* G = (const bf16_t*)(ws + OFF_GATES);
    const int lane = tidx() & 63, wid = tidx() >> 6, wr = wid >> 1, wc = wid & 1, li = lane & 15, g = lane >> 4;
#pragma unroll 1
    for (int br = 0; br < 3; ++br) {
        const bf16_t* Ab = (const bf16_t*)(ws + (br == 0 ? OFF_QA : (br == 1 ? OFF_GL : OFF_QM)));
        const bf16_t* Bb = (const bf16_t*)(ws + (br == 0 ? OFF_PATTNT : (br == 1 ? OFF_PLRUT : OFF_PMEMT)));
        const int Kb = br == 2 ? 512 : 768;
        const int nbr = br == 2 ? 0 : br + 1, nr0 = br == 2 ? nrt * 128 : row0, nc0 = br == 2 ? nct * 128 : col0, nKb = nbr == 2 ? 512 : 768;
        const bf16_t* nAb = (const bf16_t*)(ws + (nbr == 0 ? OFF_QA : (nbr == 1 ? OFF_GL : OFF_QM)));
        const bf16_t* nBb = (const bf16_t*)(ws + (nbr == 0 ? OFF_PATTNT : (nbr == 1 ? OFF_PLRUT : OFF_PMEMT)));
        const GemmOp op{Ab + (size_t)row0 * Kb, Bb + (size_t)col0 * Kb, Kb, Kb};
        const GemmOp nx{nAb + (size_t)nr0 * nKb, nBb + (size_t)nc0 * nKb, nKb, nKb};
        f32x4 acc[4][4]; acc_zero(acc);
        gemm_tile(op, Kb, acc, smem, pp);
        u32x4 gva[8];
#pragma unroll
        for (int m = 0; m < 4; ++m)
#pragma unroll
            for (int pq = 0; pq < 2; ++pq) {
                const int r = wr * 64 + m * 16 + li, c = wc * 64 + 32 * pq + 8 * g;
                gva[m * 2 + pq] = *(const u32x4*)(G + (size_t)(row0 + r) * 3072 + br * 1024 + col0 + c);
            }
        PIN8(gva, 0);
        if (br < 2 || hn) gemm_prefetch(nx, smem, pp);
#pragma unroll
        for (int m = 0; m < 4; ++m)
#pragma unroll
            for (int pp = 0; pp < 2; ++pp) {
                const uint4 gv = make_uint4(gva[m * 2 + pp][0], gva[m * 2 + pp][1], gva[m * 2 + pp][2], gva[m * 2 + pp][3]);
                float v[8];
                v[0] = bflo(gv.x) * acc[m][2 * pp][0]; v[1] = bfhi(gv.x) * acc[m][2 * pp][1];
                v[2] = bflo(gv.y) * acc[m][2 * pp][2]; v[3] = bfhi(gv.y) * acc[m][2 * pp][3];
                v[4] = bflo(gv.z) * acc[m][2 * pp + 1][0]; v[5] = bfhi(gv.z) * acc[m][2 * pp + 1][1];
                v[6] = bflo(gv.w) * acc[m][2 * pp + 1][2]; v[7] = bfhi(gv.w) * acc[m][2 * pp + 1][3];
                if (br > 0) {
                    const uint4 t = tot[m][pp];
                    v[0] += bflo(t.x); v[1] += bfhi(t.x); v[2] += bflo(t.y); v[3] += bfhi(t.y);
                    v[4] += bflo(t.z); v[5] += bfhi(t.z); v[6] += bflo(t.w); v[7] += bfhi(t.w);
                }
                tot[m][pp] = make_uint4(pack_bf16(v[0], v[1]), pack_bf16(v[2], v[3]), pack_bf16(v[4], v[5]), pack_bf16(v[6], v[7]));
            }
    }
    bf16_t* dst = (bf16_t*)(ws + OFF_MERGED) + col0;
#pragma unroll
    for (int m = 0; m < 4; ++m)
#pragma unroll
        for (int pp = 0; pp < 2; ++pp) {
            const int r = wr * 64 + m * 16 + li, c = wc * 64 + 32 * pp + 8 * g;
            *(uint4*)(dst + (size_t)(row0 + r) * 1024 + c) = tot[m][pp];
        }
}
__device__ void outproj_tile(const Params& p, int rt, int ct, unsigned char* smem, GemmPipe& pp, bool hn, int nrt, int nct) {
    const int row0 = rt * 128, col0 = ct * 128;
    f32x4 acc[4][4]; acc_zero(acc);
    const GemmOp op{(const bf16_t*)(p.ws + OFF_MERGED) + (size_t)row0 * 1024, (const bf16_t*)(p.ws + OFF_WOUTT) + (size_t)col0 * 1024, 1024, 1024};
    const GemmOp nx{(const bf16_t*)(p.ws + OFF_MERGED) + (size_t)nrt * 128 * 1024, (const bf16_t*)(p.ws + OFF_WOUTT) + (size_t)nct * 128 * 1024, 1024, 1024};
    gemm_tile(op, 1024, acc, smem, pp);
    f32x4 xv[16];
    {
        const int lane_ = tidx() & 63, wid_ = tidx() >> 6;
#pragma unroll
        for (int m = 0; m < 4; ++m)
#pragma unroll
            for (int pq = 0; pq < 2; ++pq) {
                const size_t o = (size_t)(row0 + (wid_ >> 1) * 64 + m * 16 + (lane_ & 15)) * 1024 + col0 + (wid_ & 1) * 64 + 32 * pq + 8 * (lane_ >> 4);
                xv[(m * 2 + pq) * 2] = *(const f32x4*)(p.x + o); xv[(m * 2 + pq) * 2 + 1] = *(const f32x4*)(p.x + o + 4);
            }
        PIN8(xv, 0); PIN8(xv, 8);
    }
    if (hn) gemm_prefetch(nx, smem, pp);
    epi_foreach(acc, [&](int r, int c, float (&v)[8], int pq, int mq) {
        const size_t o = (size_t)(row0 + r) * 1024 + col0 + c;
        const f32x4 x0 = xv[(mq * 2 + pq) * 2], x1 = xv[(mq * 2 + pq) * 2 + 1];
        *(float4*)(p.out + o) = make_float4(x0[0] + v[0], x0[1] + v[1], x0[2] + v[2], x0[3] + v[3]);
        *(float4*)(p.out + o + 4) = make_float4(x1[0] + v[4], x1[1] + v[5], x1[2] + v[6], x1[3] + v[7]);
    });
}

__device__ void peerq_tile(const Params& p, int rt, int ct, unsigned char* smem, GemmPipe& pp, bool hn, int nrt, int nct) {
    const int row0 = rt * 128, col0 = ct * 128;
    f32x4 acc[4][4]; acc_zero(acc);
    const GemmOp op{(const bf16_t*)(p.ws + OFF_MERGED) + (size_t)row0 * 1024, (const bf16_t*)(p.ws + OFF_WPQT) + (size_t)col0 * 1024, 1024, 1024};
    const GemmOp nx{(const bf16_t*)(p.ws + OFF_MERGED) + (size_t)nrt * 128 * 1024, (const bf16_t*)(p.ws + OFF_WPQT) + (size_t)nct * 128 * 1024, 1024, 1024};
    gemm_tile(op, 1024, acc, smem, pp);
    if (hn) gemm_prefetch(nx, smem, pp);
    bf16_t* dst = (bf16_t*)(p.ws + OFF_QPEER) + col0;
    epi_foreach(acc, [&](int r, int c, float (&v)[8], int, int) { store_bf16x8(dst + (size_t)(row0 + r) * 2048 + c, v); });
}

__device__ __forceinline__ int sortable(float v) { int k = __float_as_int(v); return k ^ ((k >> 31) & 0x7fffffff); }
__device__ __forceinline__ float unsortable(int k) { return __int_as_float(k ^ ((k >> 31) & 0x7fffffff)); }
__device__ __forceinline__ void insert16(int (&lst)[16], int x) {
#pragma unroll
    for (int k = 0; k < 16; ++k) { const int hi = max(lst[k], x); x = min(lst[k], x); lst[k] = hi; }
}
__device__ void scores_tile(const Params& p, int rt, int pq, unsigned char* smem) {
    const int row0 = rt * 128;
    f32x4 acc[4][4]; acc_zero(acc);
    const GemmOp op{(const bf16_t*)(p.ws + OFF_QPEER) + (size_t)row0 * 2048 + pq * 128, (const bf16_t*)(p.ws + OFF_SUBK) + (size_t)pq * 128 * 128, 2048, 128};
    GemmPipe pp{0, false};
    gemm_tile(op, 128, acc, smem, pp);
    float* sc = (float*)smem;
    __syncthreads();
    epi_foreach(acc, [&](int r, int c, float (&v)[8], int, int) {
        *(float4*)(sc + r * 132 + c) = make_float4(v[0], v[1], v[2], v[3]);
        *(float4*)(sc + r * 132 + c + 4) = make_float4(v[4], v[5], v[6], v[7]); });
    __syncthreads();
    {
        const int t = tidx(), r = t & 127, hf = t >> 7;
        int lst[16];
#pragma unroll
        for (int k = 0; k < 16; ++k) lst[k] = (int)0x80000000;
#pragma unroll 2
        for (int j4 = 0; j4 < 16; ++j4) {
            const int j = hf * 64 + j4 * 4;
            const float4 v = *(const float4*)(sc + r * 132 + j);
            insert16(lst, (sortable(v.x) & ~127) | (j + 0));
            insert16(lst, (sortable(v.y) & ~127) | (j + 1));
            insert16(lst, (sortable(v.z) & ~127) | (j + 2));
            insert16(lst, (sortable(v.w) & ~127) | (j + 3));
        }
        __syncthreads();
        int* ls = (int*)smem;
        if (hf) {
#pragma unroll
            for (int k = 0; k < 16; ++k) ls[t * 16 + k] = lst[15 - k];
        }
        __syncthreads();
        if (!hf) {
#pragma unroll
            for (int k = 0; k < 16; ++k) lst[k] = max(lst[k], ls[(t + 128) * 16 + k]);
#pragma unroll
            for (int s = 8; s >= 1; s >>= 1)
#pragma unroll
                for (int k = 0; k < 16; ++k)
                    if ((k & s) == 0) { const int hi = max(lst[k], lst[k + s]), lo = min(lst[k], lst[k + s]); lst[k] = hi; lst[k + s] = lo; }
            int4* dst = (int4*)((int*)(p.ws + OFF_TOPL) + ((size_t)(row0 + r) * 16 + pq) * 16);
            dst[0] = make_int4(lst[0], lst[1], lst[2], lst[3]); dst[1] = make_int4(lst[4], lst[5], lst[6], lst[7]);
            dst[2] = make_int4(lst[8], lst[9], lst[10], lst[11]); dst[3] = make_int4(lst[12], lst[13], lst[14], lst[15]);
        }
    }
    __syncthreads();
}

__device__ void combine_item(const Params& p, int item) {
    const int tok = item >> 3, hd = item & 7;
    const int* l0 = (const int*)(p.ws + OFF_TOPL) + ((size_t)tok * 16 + hd * 2) * 16;
    const int* l1 = l0 + 16;
    int k0[16], k1[16];
#pragma unroll
    for (int i = 0; i < 4; ++i) {
        const int4 a = ((const int4*)l0)[i], b = ((const int4*)l1)[i];
        k0[4 * i] = a.x; k0[4 * i + 1] = a.y; k0[4 * i + 2] = a.z; k0[4 * i + 3] = a.w;
        k1[4 * i] = b.x; k1[4 * i + 1] = b.y; k1[4 * i + 2] = b.z; k1[4 * i + 3] = b.w;
    }
    float v0[16], v1[16];
#pragma unroll
    for (int i = 0; i < 16; ++i) { v0[i] = unsortable(k0[i] & ~127); v1[i] = unsortable(k1[i] & ~127); }
    int lst[16];
#pragma unroll
    for (int k = 0; k < 16; ++k) lst[k] = (int)0x80000000;
#pragma unroll
    for (int a = 0; a < 16; ++a)
#pragma unroll
        for (int b = 0; b < 16; ++b)
            if ((a + 1) * (b + 1) <= 16) insert16(lst, (sortable(v0[a] + v1[b]) & ~255) | (a * 16 + b));
    float val[16], sum = 0.f;
    const float mx = unsortable(lst[0] & ~255);
#pragma unroll
    for (int k = 0; k < 16; ++k) { val[k] = __expf(unsortable(lst[k] & ~255) - mx); sum += val[k]; }
    const float inv = 1.0f / sum;
    int* ei = (int*)(p.ws + OFF_EIDX) + (size_t)tok * 128 + hd * 16;
    float* eg = (float*)(p.ws + OFF_EGATE) + (size_t)tok * 128 + hd * 16;
#pragma unroll
    for (int k = 0; k < 16; ++k) {
        const int code = lst[k] & 255, a = code >> 4, b = code & 15;
        ei[k] = (l0[a] & 127) * 128 + (l1[b] & 127);
        eg[k] = val[k] * inv;
    }
}

__device__ __forceinline__ void conv_row_fp8(const float* __restrict__ src, unsigned char* __restrict__ dst, float* __restrict__ scale, int row, int lane) {
    const float4* s = (const float4*)(src + (size_t)row * 1024 + lane * 16);
    float4 v[4]; float am = 0.f;
#pragma unroll
    for (int i = 0; i < 4; ++i) { v[i] = s[i]; am = fmaxf(am, fmaxf(fmaxf(fabsf(v[i].x), fabsf(v[i].y)), fmaxf(fabsf(v[i].z), fabsf(v[i].w)))); }
#pragma unroll
    for (int o = 32; o >= 1; o >>= 1) am = fmaxf(am, __shfl_xor(am, o));
    const float sc = am > 0.f ? am * (1.0f / 224.0f) : 1.0f, inv = 1.0f / sc;
    unsigned w[4];
#pragma unroll
    for (int i = 0; i < 4; ++i) {
        int t = __builtin_amdgcn_cvt_pk_fp8_f32(v[i].x * inv, v[i].y * inv, 0, false);
        t = __builtin_amdgcn_cvt_pk_fp8_f32(v[i].z * inv, v[i].w * inv, t, true);
        w[i] = (unsigned)t;
    }
    *(uint4*)(dst + (size_t)row * 1024 + lane * 16) = make_uint4(w[0], w[1], w[2], w[3]);
    if (lane == 0) scale[row] = sc;
}
__device__ __forceinline__ void load8rows(uint4 (&R)[8], const unsigned char* __restrict__ tab, int es, int l0, int lane) {
#pragma unroll
    for (int j = 0; j < 8; ++j) {
        const int id = __builtin_amdgcn_readlane(es, l0 + j);
        R[j] = *(const uint4*)(tab + (size_t)id * 1024 + lane * 16);
    }
}
__device__ __forceinline__ float dot16q(const uint4& r, const float (&h)[16]) {
    const unsigned q[4] = {r.x, r.y, r.z, r.w};
    float d0 = 0.f, d1 = 0.f;
#pragma unroll
    for (int i = 0; i < 4; ++i) {
        const f32x2v a = __builtin_amdgcn_cvt_pk_f32_fp8((int)q[i], false), b = __builtin_amdgcn_cvt_pk_f32_fp8((int)q[i], true);
        d0 += a.x * h[4 * i]; d1 += a.y * h[4 * i + 1]; d0 += b.x * h[4 * i + 2]; d1 += b.y * h[4 * i + 3];
    }
    return d0 + d1;
}
__device__ __forceinline__ float dots8(const uint4 (&R)[8], const float (&h)[16], int lane) {
    float pd[8];
#pragma unroll
    for (int j = 0; j < 8; ++j) pd[j] = dot16q(R[j], h);
    const bool b5 = (lane & 32) != 0, b4 = (lane & 16) != 0, b3 = (lane & 8) != 0;
    float a[4];
#pragma unroll
    for (int j = 0; j < 4; ++j) { const float keep = b5 ? pd[4 + j] : pd[j], send = b5 ? pd[j] : pd[4 + j]; a[j] = keep + __shfl_xor(send, 32); }
    float c[2];
#pragma unroll
    for (int j = 0; j < 2; ++j) { const float keep = b4 ? a[2 + j] : a[j], send = b4 ? a[j] : a[2 + j]; c[j] = keep + __shfl_xor(send, 16); }
    float kk;
    { const float keep = b3 ? c[1] : c[0], send = b3 ? c[0] : c[1]; kk = keep + __shfl_xor(send, 8); }
    kk += __shfl_xor(kk, 4); kk += __shfl_xor(kk, 2); kk += __shfl_xor(kk, 1);
    return kk;
}
__device__ __forceinline__ void axpy8(float (&o)[16], const uint4 (&R)[8], int wsr, int bb) {
#pragma unroll
    for (int j = 0; j < 8; ++j) {
        const float c = __int_as_float(__builtin_amdgcn_readlane(wsr, 8 * j + bb));
        const unsigned q[4] = {R[j].x, R[j].y, R[j].z, R[j].w};
#pragma unroll
        for (int i = 0; i < 4; ++i) {
            const f32x2v a = __builtin_amdgcn_cvt_pk_f32_fp8((int)q[i], false), b = __builtin_amdgcn_cvt_pk_f32_fp8((int)q[i], true);
            o[4 * i] += c * a.x; o[4 * i + 1] += c * a.y; o[4 * i + 2] += c * b.x; o[4 * i + 3] += c * b.y;
        }
    }
}
__device__ void gather_token(const Params& p, int tok, int lane) {
    const bf16_t* h2 = (const bf16_t*)(p.ws + OFF_MERGED) + (size_t)tok * 1024 + lane * 16;
    const unsigned char* Uq = p.ws + OFF_UB; const unsigned char* Vq = p.ws + OFF_VB;
    const float* SU = (const float*)(p.ws + OFF_SU); const float* SV = (const float*)(p.ws + OFF_SV);
    const int* ei = (const int*)(p.ws + OFF_EIDX) + (size_t)tok * 128;
    const float* eg = (const float*)(p.ws + OFF_EGATE) + (size_t)tok * 128;
    float h[16];
    {
        const uint4 ha = *(const uint4*)h2, hb = *(const uint4*)(h2 + 8);
        const unsigned hq[8] = {ha.x, ha.y, ha.z, ha.w, hb.x, hb.y, hb.z, hb.w};
#pragma unroll
        for (int e = 0; e < 8; ++e) { h[2 * e] = bflo(hq[e]); h[2 * e + 1] = bfhi(hq[e]); }
    }
    const int pe = 8 * (lane & 7) + (lane >> 3);
    int es[2], wsr[2] = {0, 0}; float su[2], gv[2];
#pragma unroll
    for (int k = 0; k < 2; ++k) {
        es[k] = ei[64 * k + lane];
        const int e = ei[64 * k + pe];
        su[k] = SU[e]; gv[k] = eg[64 * k + pe] * SV[e];
    }
    uint4 R0[8], R1[8];
#pragma unroll
    for (int k = 0; k < 2; ++k) {
        load8rows(R0, Uq, es[k], 0, lane);
        for (int bb = 0; bb < 8; bb += 2) {
            load8rows(R1, Uq, es[k], 8 * bb + 8, lane);
            { const float w = gelu_tanh(dots8(R0, h, lane) * su[k]) * gv[k]; if ((lane & 7) == bb) wsr[k] = __float_as_int(w); }
            if (bb + 2 < 8) load8rows(R0, Uq, es[k], 8 * bb + 16, lane);
            { const float w = gelu_tanh(dots8(R1, h, lane) * su[k]) * gv[k]; if ((lane & 7) == bb + 1) wsr[k] = __float_as_int(w); }
        }
    }
    float o[16];
#pragma unroll
    for (int e = 0; e < 16; ++e) o[e] = 0.f;
#pragma unroll
    for (int k = 0; k < 2; ++k) {
        load8rows(R0, Vq, es[k], 0, lane);
        for (int bb = 0; bb < 8; bb += 2) {
            load8rows(R1, Vq, es[k], 8 * bb + 8, lane);
            axpy8(o, R0, wsr[k], bb);
            if (bb + 2 < 8) load8rows(R0, Vq, es[k], 8 * bb + 16, lane);
            axpy8(o, R1, wsr[k], bb + 1);
        }
    }
    float* xr = p.out + (size_t)tok * 1024 + lane * 16;
    float4 x[4]; float ss = 0.f;
#pragma unroll
    for (int i = 0; i < 4; ++i) {
        x[i] = *(const float4*)(xr + 4 * i);
        x[i].x += o[4 * i]; x[i].y += o[4 * i + 1]; x[i].z += o[4 * i + 2]; x[i].w += o[4 * i + 3];
        ss += x[i].x * x[i].x + x[i].y * x[i].y + x[i].z * x[i].z + x[i].w * x[i].w;
    }
    ss = wave_sum(ss);
    const float rs = rsqrtf(ss * (1.0f / 1024.0f) + EPS);
    const float* gf = p.g_final + lane * 16;
#pragma unroll
    for (int i = 0; i < 4; ++i) {
        const float4 gg = *(const float4*)(gf + 4 * i);
        *(float4*)(xr + 4 * i) = make_float4(x[i].x * rs * gg.x, x[i].y * rs * gg.y, x[i].z * rs * gg.z, x[i].w * rs * gg.w);
    }
}


__device__ __forceinline__ void fp8x16_to_f32(const uint4& r, float (&f)[16]) {
    const unsigned q[4] = {r.x, r.y, r.z, r.w};
#pragma unroll
    for (int i = 0; i < 4; ++i) {
        const f32x2v a = __builtin_amdgcn_cvt_pk_f32_fp8((int)q[i], false), b = __builtin_amdgcn_cvt_pk_f32_fp8((int)q[i], true);
        f[4 * i] = a.x; f[4 * i + 1] = a.y; f[4 * i + 2] = b.x; f[4 * i + 3] = b.y;
    }
}
__device__ __forceinline__ float sum8_dpp(float v) {
    v += __int_as_float(__builtin_amdgcn_mov_dpp(__float_as_int(v), 0xB1, 0xF, 0xF, true));
    v += __int_as_float(__builtin_amdgcn_mov_dpp(__float_as_int(v), 0x4E, 0xF, 0xF, true));
    v += __int_as_float(__builtin_amdgcn_mov_dpp(__float_as_int(v), 0x141, 0xF, 0xF, true));
    return v;
}
__device__ __forceinline__ void peer_u_issue(u32x4 (&seg)[8], const unsigned char* Uq, int es, int gq) {
#pragma unroll
    for (int bb = 0; bb < 8; ++bb) { const int id = __shfl(es, 8 * bb + gq); seg[bb] = *(const u32x4*)(Uq + (size_t)id * 1024); }
}
__device__ __forceinline__ float peer_u_half(u32x4 (&seg)[8], const float (&h)[16], int sub) {
    PIN8(seg, 0);
    float z = 0.f;
#pragma unroll
    for (int bb = 0; bb < 8; ++bb) {
        float f[16];
        fp8x16_to_f32(make_uint4(seg[bb][0], seg[bb][1], seg[bb][2], seg[bb][3]), f);
        float d0 = 0.f, d1 = 0.f;
#pragma unroll
        for (int i = 0; i < 8; ++i) { d0 += f[2 * i] * h[2 * i]; d1 += f[2 * i + 1] * h[2 * i + 1]; }
        const float d = sum8_dpp(d0 + d1);
        if (sub == bb) z = d;
    }
    return z;
}
__device__ void peer_u_pass(const Params& p, int t0, int tstep, int x, int lane) {
    const int gq = lane >> 3, sub = lane & 7;
    const int* eib = (const int*)(p.ws + OFF_EIDX);
    const bf16_t* h2b = (const bf16_t*)(p.ws + OFF_MERGED) + x * 128 + sub * 16;
    const unsigned char* Uq = p.ws + OFF_UB + x * 128 + sub * 16;
    float* Zb = (float*)(p.ws + OFF_ZBUF) + (size_t)x * 128;
    if (t0 >= NTOK) return;
    int es0 = eib[(size_t)t0 * 128 + lane], es1 = eib[(size_t)t0 * 128 + 64 + lane];
    uint4 ha = *(const uint4*)(h2b + (size_t)t0 * 1024), hb = *(const uint4*)(h2b + (size_t)t0 * 1024 + 8);
    u32x4 SA[8], SB[8];
    peer_u_issue(SA, Uq, es0, gq);
    for (int t = t0; t < NTOK; t += tstep) {
        float h[16];
        {
            const unsigned hq[8] = {ha.x, ha.y, ha.z, ha.w, hb.x, hb.y, hb.z, hb.w};
#pragma unroll
            for (int e = 0; e < 8; ++e) { h[2 * e] = bflo(hq[e]); h[2 * e + 1] = bfhi(hq[e]); }
        }
        peer_u_issue(SB, Uq, es1, gq);
        const int tn = t + tstep < NTOK ? t + tstep : t;
        es0 = eib[(size_t)tn * 128 + lane]; es1 = eib[(size_t)tn * 128 + 64 + lane];
        ha = *(const uint4*)(h2b + (size_t)tn * 1024); hb = *(const uint4*)(h2b + (size_t)tn * 1024 + 8);
        const float z0 = peer_u_half(SA, h, sub);
        peer_u_issue(SA, Uq, es0, gq);
        const float z1 = peer_u_half(SB, h, sub);
        float* Z = Zb + (size_t)t * 8 * 128;
        Z[lane] = z0; Z[64 + lane] = z1;
    }
}
__device__ void peer_coef_token(const Params& p, int tok, int lane) {
    const int pe = 8 * (lane & 7) + (lane >> 3);
    const int* ei = (const int*)(p.ws + OFF_EIDX) + (size_t)tok * 128;
    const float* eg = (const float*)(p.ws + OFF_EGATE) + (size_t)tok * 128;
    const float* SU = (const float*)(p.ws + OFF_SU); const float* SV = (const float*)(p.ws + OFF_SV);
    const float* Z = (const float*)(p.ws + OFF_ZBUF) + (size_t)tok * 8 * 128;
    float* W = (float*)(p.ws + OFF_WBUF) + (size_t)tok * 128;
#pragma unroll
    for (int k = 0; k < 2; ++k) {
        float zv[8];
#pragma unroll
        for (int x = 0; x < 8; ++x) zv[x] = Z[x * 128 + k * 64 + lane];
        const int e = ei[64 * k + pe];
        const float g = eg[64 * k + pe], su = SU[e], sv = SV[e];
        PIN8(zv, 0);
        const float z = ((zv[0] + zv[1]) + (zv[2] + zv[3])) + ((zv[4] + zv[5]) + (zv[6] + zv[7]));
        W[k * 64 + lane] = gelu_tanh(z * su) * g * sv;
    }
}
#define PINQ(a) asm volatile("" : "+v"((a)[0]), "+v"((a)[1]), "+v"((a)[2]), "+v"((a)[3]))
__device__ __forceinline__ void peer_v_issue4(u32x4 (&seg)[4], const unsigned char* Vq, int es, int gq, int bb0) {
#pragma unroll
    for (int j = 0; j < 4; ++j) { const int id = __shfl(es, 8 * (bb0 + j) + gq); seg[j] = *(const u32x4*)(Vq + (size_t)id * 1024); }
}
__device__ __forceinline__ void peer_v_quarter(u32x4 (&seg)[4], float (&o)[16], float wk, int gq, int bb0) {
    PINQ(seg);
#pragma unroll
    for (int j = 0; j < 4; ++j) {
        const float c = __shfl(wk, 8 * gq + bb0 + j);
        float f[16];
        fp8x16_to_f32(make_uint4(seg[j][0], seg[j][1], seg[j][2], seg[j][3]), f);
#pragma unroll
        for (int i = 0; i < 16; ++i) o[i] += c * f[i];
    }
}
__device__ void peer_v_pass(const Params& p, int t0, int tstep, int x, int lane) {
    const int gq = lane >> 3, sub = lane & 7;
    const int* eib = (const int*)(p.ws + OFF_EIDX);
    const float* Wb = (const float*)(p.ws + OFF_WBUF);
    const unsigned char* Vq = p.ws + OFF_VB + x * 128 + sub * 16;
    if (t0 >= NTOK) return;
    const bool b5 = (lane & 32) != 0, b4 = (lane & 16) != 0, b3 = (lane & 8) != 0;
    const int col = x * 128 + 16 * sub + (b5 ? 8 : 0) + (b4 ? 4 : 0) + (b3 ? 2 : 0);
    int es0 = eib[(size_t)t0 * 128 + lane], es1 = eib[(size_t)t0 * 128 + 64 + lane];
    float wk0 = Wb[(size_t)t0 * 128 + lane], wk1 = Wb[(size_t)t0 * 128 + 64 + lane];
    u32x4 SA[4], SB[4];
    peer_v_issue4(SA, Vq, es0, gq, 0);
    for (int t = t0; t < NTOK; t += tstep) {
        float o[16];
#pragma unroll
        for (int i = 0; i < 16; ++i) o[i] = 0.f;
        const int tn = t + tstep < NTOK ? t + tstep : t;
        const int nes0 = eib[(size_t)tn * 128 + lane], nes1 = eib[(size_t)tn * 128 + 64 + lane];
        const float nwk0 = Wb[(size_t)tn * 128 + lane], nwk1 = Wb[(size_t)tn * 128 + 64 + lane];
        int gl = gq; asm volatile("" : "+v"(gl));
        peer_v_issue4(SB, Vq, es0, gl, 4);  peer_v_quarter(SA, o, wk0, gl, 0);
        peer_v_issue4(SA, Vq, es1, gl, 0);  peer_v_quarter(SB, o, wk0, gl, 4);
        peer_v_issue4(SB, Vq, es1, gl, 4);  peer_v_quarter(SA, o, wk1, gl, 0);
        peer_v_issue4(SA, Vq, nes0, gl, 0); peer_v_quarter(SB, o, wk1, gl, 4);
        es0 = nes0; es1 = nes1; wk0 = nwk0; wk1 = nwk1;
        float a8[8], a4[4], a2[2];
#pragma unroll
        for (int i = 0; i < 8; ++i) { const float keep = b5 ? o[8 + i] : o[i], send = b5 ? o[i] : o[8 + i]; a8[i] = keep + __shfl_xor(send, 32); }
#pragma unroll
        for (int i = 0; i < 4; ++i) { const float keep = b4 ? a8[4 + i] : a8[i], send = b4 ? a8[i] : a8[4 + i]; a4[i] = keep + __shfl_xor(send, 16); }
#pragma unroll
        for (int i = 0; i < 2; ++i) { const float keep = b3 ? a4[2 + i] : a4[i], send = b3 ? a4[i] : a4[2 + i]; a2[i] = keep + __shfl_xor(send, 8); }
        float* xr = p.out + (size_t)t * 1024 + col;
        float2 xv = *(const float2*)xr;
        xv.x += a2[0]; xv.y += a2[1];
        *(float2*)xr = xv;
        const float ss = wave_sum(xv.x * xv.x + xv.y * xv.y);
        if (lane == 0) atomicAdd((float*)(p.ws + OFF_ROWSS) + t, ss);
    }
}
__device__ void final_norm_row(const Params& p, int tok, int lane) {
    float* xr = p.out + (size_t)tok * 1024 + lane * 16;
    const float rs = rsqrtf(((const float*)(p.ws + OFF_ROWSS))[tok] * (1.0f / 1024.0f) + EPS);
    const float* gf = p.g_final + lane * 16;
#pragma unroll
    for (int i = 0; i < 4; ++i) {
        const float4 v = *(const float4*)(xr + 4 * i), gg = *(const float4*)(gf + 4 * i);
        *(float4*)(xr + 4 * i) = make_float4(v.x * rs * gg.x, v.y * rs * gg.y, v.z * rs * gg.z, v.w * rs * gg.w);
    }
}

__device__ __forceinline__ bool gemm_unit(int it, int nct, int& rt, int& ct) {
    const int x = vbid() & 7, j = vbid() >> 3, nbx = vnb() >> 3;
    const int v = j + it * nbx, per_rg = 8 * nct;
    if (v >= 32 * nct) return false;
    const int rgi = v / per_rg, w = v - rgi * per_rg, cg = w >> 6, w2 = w & 63;
    const int rtl = w2 & 7, ctl = w2 >> 3;
    rt = (rgi * 8 + rtl) * 8 + x; ct = cg * 8 + ctl;
    return true;
}


namespace pg8 {
#define PG8_LAS __attribute__((address_space(3)))
constexpr int BM = 256, BK = 64, HALF = 128, HTB = HALF * BK * 2  , STAGE_BYTES = 8 * HTB, NXCD = 8, WGM = 8;

__host__ __device__ __forceinline__ int lds_byte(int r, int c) { const int st = (r >> 4) * 2 + (c >> 5), rr = r & 15, cc = c & 31, ob = rr * 64 + cc * 2; return st * 1024 + (ob ^ (((ob >> 9) & 1) << 5)); }
__host__ __device__ __forceinline__ void stage_rc(int b, int& R, int& C) { const int st = b / 1024, sb = b % 1024, swz = sb ^ (((sb >> 9) & 1) << 5); R = (st >> 1) * 16 + swz / 64; C = (st & 1) * 32 + (swz % 64) / 2; }
__host__ __device__ __forceinline__ int perm32(int rho) { const int n = rho >> 4, i = rho & 15; return 8 * (i >> 2) + 4 * n + (i & 3); }

struct Unit { int pm, pn; };
struct Gemm { const bf16_t* A; const bf16_t* Bt; int M, N, K; };

struct StaticOrder {
    int nM, nN, nwg, G, c;
    __host__ __device__ void init(int M, int N, int G_, int c_) { nM = M / BM; nN = N / BM; nwg = nM * nN; G = G_; c = c_; }
    __host__ __device__ bool next(int i, Unit& u) const {
        const long L = (long)i * G + c; if (L >= nwg) return false;
        int wgid = (int)L; { const int q = nwg / NXCD, r = nwg % NXCD, xcd = wgid % NXCD, off = wgid / NXCD; wgid = (xcd < r ? xcd * (q + 1) : r * (q + 1) + (xcd - r) * q) + off; }
        const int nig = WGM * nN, gid = wgid / nig, fm = gid * WGM, gsz = (nM - fm) < WGM ? (nM - fm) : WGM;
        u.pm = fm + ((wgid % nig) % gsz); u.pn = (wgid % nig) / gsz; return true;
    }
    __device__ __forceinline__ void a_ready(const Unit&) const {}
    __device__ __forceinline__ void done(const Unit&) const {}
};


template <class F> struct EpiFn {
    static constexpr bool PERM = true, AFTER_DRAIN = false;
    F f;
    __device__ __forceinline__ void operator()(const f32x4 (&acc)[2][2][4][2], const Unit& u, int wr, int wc, int fr, int fq) const {
#pragma unroll
        for (int ai = 0; ai < 2; ++ai)
#pragma unroll
            for (int m = 0; m < 4; ++m)
#pragma unroll
                for (int bj = 0; bj < 2; ++bj) {
                    float v[8];
#pragma unroll
                    for (int r = 0; r < 4; ++r) { v[r] = acc[ai][bj][m][0][r]; v[4 + r] = acc[ai][bj][m][1][r]; }
                    f(u.pm * BM + ai * HALF + wr * 64 + m * 16 + fr, u.pn * BM + bj * HALF + wc * 32 + 8 * fq, v);
                }
    }
};
template <class Epi, class Sched, bool ALIGN_EPI = false, bool SP2 = false>
__device__ __forceinline__ void gemm_phase(PG8_LAS unsigned char* lds, const Gemm g, const Sched& S, const Epi& E) {
    int tid_ = threadIdx.x; asm volatile("" : "+v"(tid_));
    const int tid = tid_, wid = __builtin_amdgcn_readfirstlane(tid >> 6), lane = tid & 63, wr = wid >> 2, wc = wid & 3, fr = lane & 15, fq = lane >> 4;
    const int K = g.K, nt = K / BK;
    unsigned voffA[2], voffB[2];
#pragma unroll
    for (int i = 0; i < 2; ++i) { int R, C; stage_rc(tid * 16 + i * 8192, R, C); const int Rb = Epi::PERM ? ((R & ~31) + perm32(R & 31)) : R;
        voffA[i] = (unsigned)(R * K + C) * 2u; voffB[i] = (unsigned)(Rb * K + C) * 2u; }
    const size_t kstep = (size_t)(BK * 2);
    const size_t hstep = (size_t)HALF * K * 2;
    const size_t tstep = 2 * hstep;
    const unsigned ldsw = (unsigned)wid * 1024u;
    const int aoff = lds_byte(wr * 64 + fr, fq * 8), boff = lds_byte(wc * 32 + fr, fq * 8);
#define PG8_SA(b, h) (((b) * 2 + (h)) * HTB)
#define PG8_SB(b, h) ((4 + (b) * 2 + (h)) * HTB)
#define PG8_STAGE(bufoff, gbase, voff) do { _Pragma("unroll") for (int _i = 0; _i < 2; ++_i) \
        __builtin_amdgcn_global_load_lds((const unsigned*)((const char*)(gbase) + (voff)[_i]), (PG8_LAS unsigned*)(lds + (bufoff) + ldsw + _i * 8192), 16, 0, 0); } while (0)
#define PG8_LDA(dst, b, h) do { _Pragma("unroll") for (int m = 0; m < 4; ++m) _Pragma("unroll") for (int k = 0; k < 2; ++k) dst[m][k] = *(const PG8_LAS bf16x8*)(lds + PG8_SA(b, h) + aoff + m * 2048 + k * 1024); } while (0)
#define PG8_LDB(dst, b, h) do { _Pragma("unroll") for (int n = 0; n < 2; ++n) _Pragma("unroll") for (int k = 0; k < 2; ++k) dst[n][k] = *(const PG8_LAS bf16x8*)(lds + PG8_SB(b, h) + boff + n * 2048 + k * 1024); } while (0)
#define PG8_MMA(ai, bj, At, Bt) do { __builtin_amdgcn_s_setprio(1); _Pragma("unroll") for (int m = 0; m < 4; ++m) _Pragma("unroll") for (int n = 0; n < 2; ++n) _Pragma("unroll") for (int k = 0; k < 2; ++k) \
        acc[ai][bj][m][n] = __builtin_amdgcn_mfma_f32_16x16x32_bf16(Bt[n][k], At[m][k], acc[ai][bj][m][n], 0, 0, 0); __builtin_amdgcn_s_setprio(0); } while (0)
#define PG8_WAIT_V(n) asm volatile("s_waitcnt vmcnt(" #n ")" ::: "memory")
#define PG8_WAIT_L(n) asm volatile("s_waitcnt lgkmcnt(" #n ")" ::: "memory")
#define PG8_BAR __builtin_amdgcn_s_barrier()
#define PG8_SCHED __builtin_amdgcn_sched_barrier(0)
    Unit cur, nxt; int ui = 0;
    if (!S.next(0, cur)) return;
    f32x4 acc[2][2][4][2];
#pragma unroll
    for (int a = 0; a < 2; ++a)
#pragma unroll
        for (int b = 0; b < 2; ++b)
#pragma unroll
            for (int m = 0; m < 4; ++m)
#pragma unroll
                for (int n = 0; n < 2; ++n) acc[a][b][m][n] = (f32x4){0.f, 0.f, 0.f, 0.f};
    bf16x8 At[4][2], B0[2][2], B1[2][2];
    const char* cA = (const char*)g.A + (size_t)cur.pm * tstep; const char* cB = (const char*)g.Bt + (size_t)cur.pn * tstep;
    S.a_ready(cur);
    if constexpr (SP2) {
        PG8_STAGE(PG8_SB(0, 0), cB, voffB); PG8_STAGE(PG8_SB(0, 1), cB + hstep, voffB); PG8_STAGE(PG8_SA(0, 0), cA, voffA); PG8_STAGE(PG8_SA(0, 1), cA + hstep, voffA);
        if (wr == 1) PG8_BAR;
        PG8_WAIT_V(2); PG8_BAR;
        PG8_STAGE(PG8_SB(1, 0), cB + kstep, voffB); PG8_STAGE(PG8_SA(1, 0), cA + kstep, voffA); PG8_STAGE(PG8_SB(1, 1), cB + hstep + kstep, voffB);
        PG8_WAIT_V(6); PG8_BAR;
    } else {
        PG8_STAGE(PG8_SB(0, 0), cB, voffB); PG8_STAGE(PG8_SA(0, 0), cA, voffA); PG8_STAGE(PG8_SB(0, 1), cB + hstep, voffB); PG8_STAGE(PG8_SA(0, 1), cA + hstep, voffA);
        if (wr == 1) PG8_BAR;
        PG8_WAIT_V(4); PG8_BAR;
        PG8_STAGE(PG8_SB(1, 0), cB + kstep, voffB); PG8_STAGE(PG8_SA(1, 0), cA + kstep, voffA); PG8_STAGE(PG8_SB(1, 1), cB + hstep + kstep, voffB);
        PG8_WAIT_V(6); PG8_BAR;
    }
    for (;;) {
        const bool has_next = S.next(ui + 1, nxt);
        const char* nA = has_next ? (const char*)g.A + (size_t)nxt.pm * tstep : cA; const char* nB = has_next ? (const char*)g.Bt + (size_t)nxt.pn * tstep : cB;
        for (int t = 0; t < nt; t += 2) {
            const bool last = (t == nt - 2);
            const char* a1 = cA + (size_t)(t + 1) * kstep;
            const char* a2 = last ? nA : cA + (size_t)(t + 2) * kstep; const char* b2 = last ? nB : cB + (size_t)(t + 2) * kstep;
            const char* a3 = a2 + kstep; const char* b3 = b2 + kstep;
            if (last && has_next) S.a_ready(nxt);
            if constexpr (SP2) {
            PG8_LDB(B0, 0, 0); PG8_LDB(B1, 0, 1); PG8_SCHED; PG8_LDA(At, 0, 0); PG8_STAGE(PG8_SA(1, 1), a1 + hstep, voffA);
            PG8_WAIT_V(8); PG8_WAIT_L(0); PG8_BAR; PG8_MMA(0, 0, At, B0); PG8_MMA(0, 1, At, B1); PG8_BAR; PG8_SCHED;
            PG8_LDA(At, 0, 1); PG8_STAGE(PG8_SB(0, 0), b2, voffB); PG8_STAGE(PG8_SB(0, 1), b2 + hstep, voffB); PG8_STAGE(PG8_SA(0, 0), a2, voffA);
            PG8_WAIT_V(8); PG8_WAIT_L(0); PG8_BAR; PG8_MMA(1, 0, At, B0); PG8_MMA(1, 1, At, B1); PG8_BAR; PG8_SCHED;
            PG8_LDB(B0, 1, 0); PG8_LDB(B1, 1, 1); PG8_SCHED; PG8_LDA(At, 1, 0); PG8_STAGE(PG8_SA(0, 1), a2 + hstep, voffA);
            PG8_WAIT_V(8); PG8_WAIT_L(0); PG8_BAR; PG8_MMA(0, 0, At, B0); PG8_MMA(0, 1, At, B1); PG8_BAR; PG8_SCHED;
            PG8_LDA(At, 1, 1); PG8_STAGE(PG8_SB(1, 0), b3, voffB); PG8_STAGE(PG8_SB(1, 1), b3 + hstep, voffB); PG8_STAGE(PG8_SA(1, 0), a3, voffA);
            PG8_WAIT_V(8); PG8_WAIT_L(0); PG8_BAR; PG8_MMA(1, 0, At, B0); PG8_MMA(1, 1, At, B1); PG8_BAR; PG8_SCHED;
            } else {
            PG8_LDB(B0, 0, 0); PG8_SCHED; PG8_LDA(At, 0, 0); PG8_STAGE(PG8_SA(1, 1), a1 + hstep, voffA);
            PG8_WAIT_L(8); PG8_BAR; PG8_WAIT_L(0); PG8_MMA(0, 0, At, B0); PG8_BAR; PG8_SCHED;
            PG8_LDB(B1, 0, 1); PG8_STAGE(PG8_SB(0, 0), b2, voffB);
            PG8_BAR; PG8_WAIT_L(0); PG8_MMA(0, 1, At, B1); PG8_BAR;
            PG8_LDA(At, 0, 1); PG8_STAGE(PG8_SA(0, 0), a2, voffA);
            PG8_BAR; PG8_WAIT_L(0); PG8_MMA(1, 0, At, B0); PG8_BAR; PG8_SCHED;
            PG8_STAGE(PG8_SB(0, 1), b2 + hstep, voffB);
            PG8_WAIT_V(6); PG8_BAR; PG8_MMA(1, 1, At, B1); PG8_BAR;
            PG8_LDB(B0, 1, 0); PG8_SCHED; PG8_LDA(At, 1, 0); PG8_STAGE(PG8_SA(0, 1), a2 + hstep, voffA);
            PG8_WAIT_L(8); PG8_BAR; PG8_WAIT_L(0); PG8_MMA(0, 0, At, B0); PG8_BAR; PG8_SCHED;
            PG8_LDB(B1, 1, 1); PG8_STAGE(PG8_SB(1, 0), b3, voffB);
            PG8_BAR; PG8_WAIT_L(0); PG8_MMA(0, 1, At, B1); PG8_BAR;
            PG8_LDA(At, 1, 1); PG8_STAGE(PG8_SA(1, 0), a3, voffA);
            PG8_BAR; PG8_WAIT_L(0); PG8_MMA(1, 0, At, B0); PG8_BAR; PG8_SCHED;
            PG8_STAGE(PG8_SB(1, 1), b3 + hstep, voffB);
            PG8_WAIT_V(6); PG8_BAR; PG8_MMA(1, 1, At, B1); PG8_BAR;
            }
        }
        if constexpr (ALIGN_EPI) { if (wr == 0) PG8_BAR; }
        if constexpr (!Epi::AFTER_DRAIN) { E(acc, cur, wr, wc, fr, fq); S.done(cur); }
        if (!has_next) break;
#pragma unroll
        for (int a = 0; a < 2; ++a)
#pragma unroll
            for (int b = 0; b < 2; ++b)
#pragma unroll
                for (int m = 0; m < 4; ++m)
#pragma unroll
                    for (int n = 0; n < 2; ++n) acc[a][b][m][n] = (f32x4){0.f, 0.f, 0.f, 0.f};
        cur = nxt; cA = nA; cB = nB; ++ui;
        if constexpr (ALIGN_EPI) { if (wr == 1) PG8_BAR; }
    }
    PG8_WAIT_V(0);
    if constexpr (!ALIGN_EPI) { if (wr == 0) PG8_BAR; }
    PG8_BAR;
    if constexpr (Epi::AFTER_DRAIN) { E.fused(acc, cur, wr, wc, fr, fq, lds, wid, lane); S.done(cur); }
#undef PG8_SA
#undef PG8_SB
#undef PG8_STAGE
#undef PG8_LDA
#undef PG8_LDB
#undef PG8_MMA
#undef PG8_WAIT_V
#undef PG8_WAIT_L
#undef PG8_BAR
#undef PG8_SCHED
}

}


namespace pg8 {
__device__ __forceinline__ void item_vals(const f32x4 (&acc)[2][2][4][2], int ai, int bj, int m, float (&v)[8]) {
#pragma unroll
    for (int r = 0; r < 4; ++r) { v[r] = acc[ai][bj][m][0][r]; v[4 + r] = acc[ai][bj][m][1][r]; }
}
struct EpiOutproj {
    static constexpr bool PERM = true, AFTER_DRAIN = false;
    const float* x; float* out;
    __device__ __forceinline__ void operator()(const f32x4 (&acc)[2][2][4][2], const Unit& u, int wr, int wc, int fr, int fq) const {
#pragma unroll
        for (int ai = 0; ai < 2; ++ai)
#pragma unroll
            for (int mh = 0; mh < 2; ++mh) {
                f32x4 xv[8];
#pragma unroll
                for (int mm = 0; mm < 2; ++mm)
#pragma unroll
                    for (int bj = 0; bj < 2; ++bj) {
                        const int m = mh * 2 + mm;
                        const size_t o = (size_t)(u.pm * BM + ai * HALF + wr * 64 + m * 16 + fr) * 1024 + u.pn * BM + bj * HALF + wc * 32 + 8 * fq;
                        xv[(mm * 2 + bj) * 2] = *(const f32x4*)(x + o); xv[(mm * 2 + bj) * 2 + 1] = *(const f32x4*)(x + o + 4);
                    }
                PIN8(xv, 0);
#pragma unroll
                for (int mm = 0; mm < 2; ++mm)
#pragma unroll
                    for (int bj = 0; bj < 2; ++bj) {
                        const int m = mh * 2 + mm;
                        const size_t o = (size_t)(u.pm * BM + ai * HALF + wr * 64 + m * 16 + fr) * 1024 + u.pn * BM + bj * HALF + wc * 32 + 8 * fq;
                        *(f32x4*)(out + o) = xv[(mm * 2 + bj) * 2] + acc[ai][bj][m][0];
                        *(f32x4*)(out + o + 4) = xv[(mm * 2 + bj) * 2 + 1] + acc[ai][bj][m][1];
                    }
            }
    }
};
struct EpiMerge {
    static constexpr bool PERM = true, AFTER_DRAIN = false;
    const bf16_t* G; bf16_t* merged; int br;
    __device__ __forceinline__ void operator()(const f32x4 (&acc)[2][2][4][2], const Unit& u, int wr, int wc, int fr, int fq) const {
#pragma unroll
        for (int ai = 0; ai < 2; ++ai)
#pragma unroll
            for (int mh = 0; mh < 2; ++mh) {
                u32x4 gm[8];
#pragma unroll
                for (int mm = 0; mm < 2; ++mm)
#pragma unroll
                    for (int bj = 0; bj < 2; ++bj) {
                        const int m = mh * 2 + mm;
                        const size_t row = (size_t)(u.pm * BM + ai * HALF + wr * 64 + m * 16 + fr); const int col = u.pn * BM + bj * HALF + wc * 32 + 8 * fq;
                        gm[mm * 2 + bj] = *(const u32x4*)(G + row * 3072 + br * 1024 + col);
                        gm[4 + mm * 2 + bj] = br > 0 ? *(const u32x4*)(merged + row * 1024 + col) : (u32x4){0u, 0u, 0u, 0u};
                    }
                PIN8(gm, 0);
#pragma unroll
                for (int mm = 0; mm < 2; ++mm)
#pragma unroll
                    for (int bj = 0; bj < 2; ++bj) {
                        const int m = mh * 2 + mm;
                        const size_t row = (size_t)(u.pm * BM + ai * HALF + wr * 64 + m * 16 + fr); const int col = u.pn * BM + bj * HALF + wc * 32 + 8 * fq;
                        float v[8]; item_vals(acc, ai, bj, m, v);
                        const u32x4 g4 = gm[mm * 2 + bj], t = gm[4 + mm * 2 + bj];
#pragma unroll
                        for (int e = 0; e < 4; ++e) { v[2 * e] = v[2 * e] * bflo(g4[e]) + bflo(t[e]); v[2 * e + 1] = v[2 * e + 1] * bfhi(g4[e]) + bfhi(t[e]); }
                        store_bf16x8(merged + row * 1024 + col, v);
                    }
            }
    }
};
struct EpiInproj {
    static constexpr bool PERM = true, AFTER_DRAIN = false;
    unsigned char* ws; const float* cs; const float* gate_b;
    __device__ __forceinline__ void operator()(const f32x4 (&acc)[2][2][4][2], const Unit& u, int wr, int wc, int fr, int fq) const {
        const int pn = u.pn;
        if (pn < 4) {
            const bool isq = pn < 3;
            bf16_t* dst = isq ? (bf16_t*)(ws + OFF_QA) + pn * 256 : (bf16_t*)(ws + OFF_KA);
            const int ld = isq ? 768 : 256; const float sc = isq ? QSCALE : 1.0f;
#pragma unroll
            for (int ai = 0; ai < 2; ++ai)
#pragma unroll
                for (int mh = 0; mh < 2; ++mh) {
                    f32x4 csv[8];
                    if (wc == 0) {
#pragma unroll
                        for (int mm = 0; mm < 2; ++mm) {
                            const f32x4* csr = (const f32x4*)(cs + (size_t)(u.pm * BM + ai * HALF + wr * 64 + (mh * 2 + mm) * 16 + fr) * 32 + (fq & 1) * 16);
#pragma unroll
                            for (int q = 0; q < 4; ++q) csv[mm * 4 + q] = csr[q];
                        }
                        PIN8(csv, 0);
                    }
#pragma unroll
                    for (int mm = 0; mm < 2; ++mm)
#pragma unroll
                        for (int bj = 0; bj < 2; ++bj) {
                            const int m = mh * 2 + mm;
                            const size_t row = (size_t)(u.pm * BM + ai * HALF + wr * 64 + m * 16 + fr);
                            float v[8]; item_vals(acc, ai, bj, m, v);
                            if (wc == 0) {
                                const f32x4 c0 = csv[mm * 4], c1 = csv[mm * 4 + 1], c2 = csv[mm * 4 + 2], c3 = csv[mm * 4 + 3];
                                const float ccv[8] = {c0[0], c0[2], c1[0], c1[2], c2[0], c2[2], c3[0], c3[2]};
                                const float ssv[8] = {c0[1], c0[3], c1[1], c1[3], c2[1], c2[3], c3[1], c3[3]};
#pragma unroll
                                for (int e = 0; e < 8; ++e) {
                                    const float o = __shfl_xor(v[e], 32);
                                    v[e] = (fq < 2) ? (v[e] * ccv[e] - o * ssv[e]) : (v[e] * ccv[e] + o * ssv[e]);
                                }
                            }
#pragma unroll
                            for (int e = 0; e < 8; ++e) v[e] *= sc;
                            store_bf16x8(dst + row * ld + bj * HALF + wc * 32 + 8 * fq, v);
                        }
                }
        } else if (pn == 4) {
#pragma unroll
            for (int ai = 0; ai < 2; ++ai)
#pragma unroll
                for (int m = 0; m < 4; ++m)
#pragma unroll
                    for (int bj = 0; bj < 2; ++bj) {
                        const int row = u.pm * BM + ai * HALF + wr * 64 + m * 16 + fr, b = row / S_, s = row % S_;
                        float v[8]; item_vals(acc, ai, bj, m, v);
                        bf16_t* vt = (bf16_t*)(ws + OFF_VAT) + ((size_t)(b * 2 + bj) * 128 + wc * 32 + 8 * fq) * S_ + s;
#pragma unroll
                        for (int e = 0; e < 8; ++e) vt[(size_t)e * S_] = f2bf(v[e]);
                    }
        } else if (pn < 13) {
            const int kind = pn < 8 ? 0 : (pn < 11 ? 1 : 2);
            bf16_t* dst = kind == 0 ? (bf16_t*)(ws + OFF_XL) + (pn - 5) * 256 : (kind == 1 ? (bf16_t*)(ws + OFF_GL) + (pn - 8) * 256 : (bf16_t*)(ws + OFF_QM) + (pn - 11) * 256);
            const int ld = kind == 2 ? 512 : 768;
#pragma unroll
            for (int ai = 0; ai < 2; ++ai)
#pragma unroll
                for (int m = 0; m < 4; ++m)
#pragma unroll
                    for (int bj = 0; bj < 2; ++bj) {
                        const size_t row = (size_t)(u.pm * BM + ai * HALF + wr * 64 + m * 16 + fr);
                        float v[8]; item_vals(acc, ai, bj, m, v);
                        if (kind == 1) {
#pragma unroll
                            for (int e = 0; e < 8; ++e) v[e] = gelu_tanh(v[e]);
                        } else if (kind == 2) {
#pragma unroll
                            for (int e = 0; e < 8; ++e) v[e] *= QSCALE;
                        }
                        store_bf16x8(dst + row * ld + bj * HALF + wc * 32 + 8 * fq, v);
                    }
        } else {
            const int gc0 = (pn - 13) * 256;
            f32x4 gbv[4];
#pragma unroll
            for (int bj = 0; bj < 2; ++bj) { const float* gb = gate_b + gc0 + bj * HALF + wc * 32 + 8 * fq; gbv[2 * bj] = *(const f32x4*)gb; gbv[2 * bj + 1] = *(const f32x4*)(gb + 4); }
            PIN4(gbv, 0);
            bf16_t* dst = (bf16_t*)(ws + OFF_GATES) + gc0;
#pragma unroll
            for (int ai = 0; ai < 2; ++ai)
#pragma unroll
                for (int m = 0; m < 4; ++m)
#pragma unroll
                    for (int bj = 0; bj < 2; ++bj) {
                        const size_t row = (size_t)(u.pm * BM + ai * HALF + wr * 64 + m * 16 + fr);
                        float v[8]; item_vals(acc, ai, bj, m, v);
                        const f32x4 b0 = gbv[2 * bj], b1 = gbv[2 * bj + 1];
#pragma unroll
                        for (int e = 0; e < 4; ++e) { v[e] = sigmoidf_(v[e] + b0[e]); v[4 + e] = sigmoidf_(v[4 + e] + b1[e]); }
                        store_bf16x8(dst + row * 3072 + bj * HALF + wc * 32 + 8 * fq, v);
                    }
        }
    }
};
}

#define XB_TMO      128
#define XB_XCNT(j)  (256  + 64 * (j))
#define XB_XSUB(j)  (1280 + 64 * (j))
#define XB_XGEN(j)  (2304 + 64 * (j))
#define XB_TOP      3328
#define XB_TOPGEN   3392
#define XCD_BAR_WORDS 3456
#define XB_SPIN_CAP (1u << 22)
#define LAS __attribute__((address_space(3)))
__device__ __forceinline__ unsigned xb_ld(unsigned* p)              { return __hip_atomic_load(p, __ATOMIC_RELAXED, __HIP_MEMORY_SCOPE_AGENT); }
__device__ __forceinline__ unsigned xb_add(unsigned* p, unsigned v) { return __hip_atomic_fetch_add(p, v, __ATOMIC_RELAXED, __HIP_MEMORY_SCOPE_AGENT); }
__device__ __forceinline__ unsigned xb_xcc_id() { return (unsigned)__builtin_amdgcn_s_getreg((3 << 11) | 20) & 0xFu; }
#define XB_SPIN(cond, bar) do { unsigned _sp = 0; while (cond) { __builtin_amdgcn_s_sleep(1); \
    if ((++_sp & 255u) == 0u) { if (xb_ld(&(bar)[XB_TMO])) break; if (_sp > XB_SPIN_CAP) { atomicAdd(&(bar)[XB_TMO], 1u); break; } } } } while (0)
struct XcdBarrier { unsigned* bar; unsigned x; volatile LAS unsigned* st; };
__device__ __forceinline__ XcdBarrier xcd_barrier_post(unsigned* bar, volatile LAS unsigned* st) {
    XcdBarrier b; b.bar = bar; b.x = xb_xcc_id(); b.st = st;
    if (threadIdx.x == 0) (void)xb_add(&bar[XB_XCNT(b.x)], 1u);
    return b;
}
__device__ __forceinline__ void xcd_barrier_complete(unsigned* bar, unsigned x, unsigned& nloc, unsigned& nx) {
    const unsigned G = gridDim.x;
    unsigned sum, cnt, mine, sp = 0u;
    for (;;) {
        sum = 0u; cnt = 0u; mine = 0u;
#pragma unroll
        for (unsigned j = 0; j < 16; ++j) { const unsigned c = xb_ld(&bar[XB_XCNT(j)]); sum += c; cnt += (c > 0u) ? 1u : 0u; mine = (j == x) ? c : mine; }
        if (sum == G) break;
        __builtin_amdgcn_s_sleep(1);
        if ((++sp & 255u) == 0u) { if (xb_ld(&bar[XB_TMO])) break; if (sp > XB_SPIN_CAP) { atomicAdd(&bar[XB_TMO], 1u); break; } }
    }
    nloc = mine > 0u ? mine : 1u; nx = cnt > 0u ? cnt : 1u;
}
__device__ __forceinline__ void xcd_barrier(const XcdBarrier& b) {
    asm volatile("s_waitcnt vmcnt(0)" ::: "memory");
    __syncthreads();
    if (threadIdx.x == 0) {
        unsigned* bar = b.bar;
        __builtin_amdgcn_s_waitcnt(0);
        unsigned nloc = b.st[0], nx = b.st[1];
        if (nloc == 0u) { xcd_barrier_complete(bar, b.x, nloc, nx); b.st[0] = nloc; b.st[1] = nx; }
        const unsigned old = xb_add(&bar[XB_XSUB(b.x)], 1u);
        const unsigned gen = old / nloc;
        if (old + 1u == (gen + 1u) * nloc) {
            __builtin_amdgcn_fence(__ATOMIC_RELEASE, "agent");
            asm volatile("s_waitcnt vmcnt(0)" ::: "memory");
            const unsigned og = xb_add(&bar[XB_TOP], 1u);
            const unsigned tg = og / nx;
            if (og + 1u == (tg + 1u) * nx) xb_add(&bar[XB_TOPGEN], 1u);
            else XB_SPIN(xb_ld(&bar[XB_TOPGEN]) == tg, bar);
            __builtin_amdgcn_fence(__ATOMIC_ACQUIRE, "agent");
            xb_add(&bar[XB_XGEN(b.x)], 1u);
            asm volatile("s_waitcnt vmcnt(0)" ::: "memory");
        } else {
            XB_SPIN(xb_ld(&bar[XB_XGEN(b.x)]) == gen, bar);
            __builtin_amdgcn_fence(__ATOMIC_ACQUIRE, "agent");
            asm volatile("s_waitcnt vmcnt(0)" ::: "memory");
        }
    }
    __syncthreads();
}

#ifndef PROBE_PHASE
#define PROBE_PHASE -1
#endif
#define PH_BEGIN(k) if (PROBE_PHASE == (k)) probe_t0 = __builtin_amdgcn_s_memrealtime();
#define PH_END(k)   if (PROBE_PHASE == (k)) probe_dt = __builtin_amdgcn_s_memrealtime() - probe_t0;
constexpr int SMEM_BYTES = 128 * 132 * 4 + 1024;

__global__ void __launch_bounds__(512, 2) fwd_megakernel(Params p) {
    __shared__ __attribute__((aligned(16))) unsigned char smem_all[2 * SMEM_BYTES + 32];
    if (threadIdx.x == 0) { *(uint4*)(smem_all + 2 * SMEM_BYTES) = make_uint4(0u, 0u, 0u, 0u); *(uint4*)(smem_all + 2 * SMEM_BYTES + 16) = make_uint4(0u, 0u, 0u, 0u); }
    __syncthreads();
    const XcdBarrier xb = xcd_barrier_post((unsigned*)(p.ws + OFF_BAR), (volatile LAS unsigned*)(smem_all + 2 * SMEM_BYTES));
    const int nb = vnb();
#define PHASE_IDS int vb_ = threadIdx.x >> 8; asm volatile("" : "+v"(vb_)); const int vb = vb_, bid = (int)blockIdx.x + vb * (int)gridDim.x, tid = tidx(), lane = tid & 63, wid = tid >> 6; unsigned char* smem = smem_all + vb * SMEM_BYTES; (void)bid; (void)tid; (void)lane; (void)wid; (void)smem;
    unsigned char* ws = p.ws; unsigned char* dob = (unsigned char*)p.out;
    unsigned long long probe_t0 = 0, probe_dt = 0;
    PH_BEGIN(0)
    { PHASE_IDS
    {
        for (int u0 = bid; u0 < 3232 + nb - 1 - (3231 % nb); u0 += nb) {
            const int u = u0 < 3232 ? u0 : 3231;
            if (u < 1600) convT_tile(p.w_in, (bf16_t*)(ws + OFF_WINT), 1024, INW, u, smem);
            else if (u < 1856) convT_tile(p.w_mem_kv, (bf16_t*)(ws + OFF_WMKVT), 1024, 1024, u - 1600, smem);
            else if (u < 2048) convT_tile(p.p_attn, (bf16_t*)(ws + OFF_PATTNT), 768, 1024, u - 1856, smem);
            else if (u < 2240) convT_tile(p.p_lru, (bf16_t*)(ws + OFF_PLRUT), 768, 1024, u - 2048, smem);
            else if (u < 2368) convT_tile(p.p_mem, (bf16_t*)(ws + OFF_PMEMT), 512, 1024, u - 2240, smem);
            else if (u < 2624) convT_tile(p.w_out, (bf16_t*)(ws + OFF_WOUTT), 1024, 1024, u - 2368, smem);
            else if (u < 3136) convT_tile(p.w_peer_q, (bf16_t*)(ws + OFF_WPQT), 1024, 2048, u - 2624, smem);
            else {
                const int v = u - 3136, mat = v >> 2, tile = v & 3, gsel = mat / 6, h = mat % 6, dir = gsel & 1;
                const float* src = (gsel < 2 ? p.lru_wr : p.lru_wi) + (size_t)(dir * 6 + h) * 128 * 128;
                convT_tile(src, (bf16_t*)(ws + OFF_LRUWT) + (size_t)(h * 512 + gsel * 128) * 128, 128, 128, tile, smem);
            }
        }
        conv_plain(p.peer_sub_keys, (bf16_t*)(ws + OFF_SUBK), (size_t)16 * 128 * 128 / 8);
        for (int r = bid * 4 + wid; r < 2 * NEXP; r += nb * 4) {
            if (r < NEXP) conv_row_fp8(p.peer_u, ws + OFF_UB, (float*)(ws + OFF_SU), r, lane);
            else conv_row_fp8(p.peer_v, ws + OFF_VB, (float*)(ws + OFF_SV), r - NEXP, lane);
        }
        for (int r = bid * 4 + wid; r < NTOK; r += nb * 4) rms_row_bf16(p.x + (size_t)r * 1024, p.g_mix, (bf16_t*)(dob + DO_HBF) + (size_t)r * 1024, lane);
        for (int r = bid * 4 + wid; r < NMEM; r += nb * 4) rms_row_bf16(p.mem + (size_t)r * 1024, p.g_mem, (bf16_t*)(dob + DO_MEMBF) + (size_t)r * 1024, lane);
        for (int i = bid * 256 + tid; i < NTOK * 16; i += nb * 256) rope_item(p.positions, (float*)(dob + DO_ROPE), i);
        for (int i = bid * 256 + tid; i < NTOK; i += nb * 256) ((float*)(ws + OFF_ROWSS))[i] = 0.f;
        for (int i = bid * 256 + tid; i < 2 * LW; i += nb * 256) ((float*)(ws + OFF_SP8))[i] = -8.0f * 1.4426950408889634f * log1pf(__expf(-p.lru_lambda[i]));
    }
    xcd_barrier(xb);
    PH_END(0) PH_BEGIN(1)
    }
    { PHASE_IDS
    { const int u = bid & 255; memkv_tile(p, u / 8, u % 8, smem); }
    {
        const pg8::Gemm g{(const bf16_t*)(dob + DO_HBF), (const bf16_t*)(ws + OFF_WINT), NTOK, INW, 1024};
        pg8::StaticOrder S; S.init(NTOK, INW, (int)gridDim.x, (int)blockIdx.x);
        __syncthreads();
        pg8::gemm_phase<pg8::EpiInproj, pg8::StaticOrder, true, true>((PG8_LAS unsigned char*)smem_all, g, S, pg8::EpiInproj{ws, (const float*)(dob + DO_ROPE), p.gate_b});
    }
    xcd_barrier(xb);
    PH_END(1) PH_BEGIN(2)
    }
    { PHASE_IDS
    {
        unsigned* ctr = (unsigned*)(p.ws + OFF_BAR) + 3600;
        volatile LAS unsigned* slot = (volatile LAS unsigned*)(smem_all + 2 * SMEM_BYTES + 16);
        for (;;) {
            if (threadIdx.x == 0) *slot = xb_add(ctr, 2u);
            __syncthreads();
            const int u = (int)*slot + vb;
            __syncthreads();
            if (u >= 1536 + 1536 + 1024) break;
            if (u < 1536) lru_chunk_unit<true>(p, u, smem);
            else if (u < 1536 + 1536) attn_win_unit(p, u - 1536, smem);
            else attn_mem_unit(p, u - 1536 - 1536, smem);
        }
    }
    xcd_barrier(xb);
    }
    { PHASE_IDS
    for (int u = bid; u < 1536; u += nb) lru_fixup_unit(p, u);
    xcd_barrier(xb);
    PH_END(2) PH_BEGIN(3)
    }
    { PHASE_IDS
    {
        pg8::StaticOrder S; S.init(NTOK, 1024, (int)gridDim.x, (int)blockIdx.x);
        const bf16_t* G = (const bf16_t*)(ws + OFF_GATES); bf16_t* mg = (bf16_t*)(ws + OFF_MERGED);
        __syncthreads();
        { const pg8::Gemm g{(const bf16_t*)(ws + OFF_QA), (const bf16_t*)(ws + OFF_PATTNT), NTOK, 1024, 768};
          pg8::gemm_phase<pg8::EpiMerge, pg8::StaticOrder, true, true>((PG8_LAS unsigned char*)smem_all, g, S, pg8::EpiMerge{G, mg, 0}); }
        { const pg8::Gemm g{(const bf16_t*)(ws + OFF_GL), (const bf16_t*)(ws + OFF_PLRUT), NTOK, 1024, 768};
          pg8::gemm_phase<pg8::EpiMerge, pg8::StaticOrder, true, true>((PG8_LAS unsigned char*)smem_all, g, S, pg8::EpiMerge{G, mg, 1}); }
        { const pg8::Gemm g{(const bf16_t*)(ws + OFF_QM), (const bf16_t*)(ws + OFF_PMEMT), NTOK, 1024, 512};
          pg8::gemm_phase<pg8::EpiMerge, pg8::StaticOrder, true, true>((PG8_LAS unsigned char*)smem_all, g, S, pg8::EpiMerge{G, mg, 2}); }
    }
    xcd_barrier(xb);
    PH_END(3) PH_BEGIN(4)
    }
    { PHASE_IDS
    {
        const pg8::Gemm g{(const bf16_t*)(ws + OFF_MERGED), (const bf16_t*)(ws + OFF_WOUTT), NTOK, 1024, 1024};
        pg8::StaticOrder S; S.init(NTOK, 1024, (int)gridDim.x, (int)blockIdx.x);
        __syncthreads();
        pg8::gemm_phase<pg8::EpiOutproj, pg8::StaticOrder, true, true>((PG8_LAS unsigned char*)smem_all, g, S, pg8::EpiOutproj{p.x, p.out});
    }
    xcd_barrier(xb);
    PH_END(4) PH_BEGIN(5)
    }
    { PHASE_IDS
    for (int r = bid * 4 + wid; r < NTOK; r += nb * 4) rms_row_bf16(p.out + (size_t)r * 1024, p.g_ffn, (bf16_t*)(ws + OFF_MERGED) + (size_t)r * 1024, lane);
    xcd_barrier(xb);
    PH_END(5) PH_BEGIN(6)
    }
    { PHASE_IDS
    {
        const pg8::Gemm g{(const bf16_t*)(ws + OFF_MERGED), (const bf16_t*)(ws + OFF_WPQT), NTOK, 2048, 1024};
        pg8::StaticOrder S; S.init(NTOK, 2048, (int)gridDim.x, (int)blockIdx.x);
        bf16_t* qp = (bf16_t*)(ws + OFF_QPEER);
        auto f = [=](int row, int col, const float (&v)[8]) { store_bf16x8(qp + (size_t)row * 2048 + col, v); };
        pg8::gemm_phase<pg8::EpiFn<decltype(f)>, pg8::StaticOrder, true, true>((PG8_LAS unsigned char*)smem_all, g, S, pg8::EpiFn<decltype(f)>{f});
    }
    xcd_barrier(xb);
    PH_END(6) PH_BEGIN(7)
    }
    { PHASE_IDS
    for (int u = bid; u < 256 * 16; u += nb) scores_tile(p, u / 16, u % 16, smem);
    xcd_barrier(xb);
    PH_END(7) PH_BEGIN(8)
    }
    { PHASE_IDS
    for (int i = bid * 256 + tid; i < NTOK * 8; i += nb * 256) combine_item(p, i);
    xcd_barrier(xb);
    PH_END(8) PH_BEGIN(9)
    }
    { PHASE_IDS
    {
        const int x = bid & 7, tstep = (nb >> 3) * 4;
        peer_u_pass(p, (bid >> 3) * 4 + wid, tstep, x, lane);
        xcd_barrier(xb);
        for (int t = bid * 4 + wid; t < NTOK; t += nb * 4) peer_coef_token(p, t, lane);
        xcd_barrier(xb);
        peer_v_pass(p, (bid >> 3) * 4 + wid, tstep, x, lane);
        xcd_barrier(xb);
        for (int t = bid * 4 + wid; t < NTOK; t += nb * 4) final_norm_row(p, t, lane);
    }
    }
    PH_END(9)
    if (PROBE_PHASE >= 0) { __syncthreads(); const unsigned long long t1 = __builtin_amdgcn_s_memrealtime(); while (__builtin_amdgcn_s_memrealtime() - t1 < probe_dt) __builtin_amdgcn_s_sleep(8); }
}

extern "C" void kernel_launch(void* const* d_in, const int* in_sizes, int n_in, void* d_out, int out_size, void* d_ws, size_t ws_size, hipStream_t stream) {
    if (ws_size < OFF_END) { fprintf(stderr, "workspace too small: %zu < %zu\n", ws_size, (size_t)OFF_END); return; }
    Params p{};
    p.x = (const float*)d_in[0]; p.mem = (const float*)d_in[1]; p.positions = (const int*)d_in[2];
    p.g_mix = (const float*)d_in[3]; p.g_mem = (const float*)d_in[4]; p.w_in = (const float*)d_in[5]; p.gate_b = (const float*)d_in[6];
    p.attn_sink = (const float*)d_in[7]; p.conv_w = (const float*)d_in[8]; p.conv_b = (const float*)d_in[9];
    p.lru_wr = (const float*)d_in[10]; p.lru_br = (const float*)d_in[11]; p.lru_wi = (const float*)d_in[12]; p.lru_bi = (const float*)d_in[13];
    p.lru_lambda = (const float*)d_in[14]; p.w_mem_kv = (const float*)d_in[15]; p.p_attn = (const float*)d_in[16]; p.p_lru = (const float*)d_in[17];
    p.p_mem = (const float*)d_in[18]; p.w_out = (const float*)d_in[19]; p.g_ffn = (const float*)d_in[20]; p.w_peer_q = (const float*)d_in[21];
    p.peer_sub_keys = (const float*)d_in[22]; p.peer_u = (const float*)d_in[23]; p.peer_v = (const float*)d_in[24]; p.g_final = (const float*)d_in[25];
    p.out = (float*)d_out; p.ws = (unsigned char*)d_ws;
    static int grid_blocks = 0;
    if (!grid_blocks) {
        int dev = 0, cus = 0, per_cu = 0;
        (void)hipGetDevice(&dev);
        (void)hipDeviceGetAttribute(&cus, hipDeviceAttributeMultiprocessorCount, dev);
        (void)hipOccupancyMaxActiveBlocksPerMultiprocessor(&per_cu, fwd_megakernel, 512, 0);
        if (per_cu > 1) per_cu = 1;
        grid_blocks = cus * per_cu;
    }
    (void)hipMemsetAsync((unsigned char*)d_ws + OFF_BAR, 0, 16384, stream);
    void* args[] = {&p};
    hipError_t e = hipLaunchCooperativeKernel((void*)fwd_megakernel, dim3(grid_blocks), dim3(512), args, 0, stream);
    if (e != hipSuccess) fprintf(stderr, "cooperative launch failed: %s (grid %d)\n", hipGetErrorString(e), grid_blocks);
}
```

```cpp
#include <hip/hip_runtime.h>
#include <stdint.h>
#include <stdio.h>

typedef unsigned short bf16_t;
typedef short bf16x8 __attribute__((ext_vector_type(8)));
typedef __bf16 bf16x2v __attribute__((ext_vector_type(2)));
typedef float f32x4 __attribute__((ext_vector_type(4)));

constexpr int B_ = 16, S_ = 2048, D_ = 1024, NTOK = B_ * S_;
constexpr int MEML = 256, NMEM = B_ * MEML;
constexpr int INW = 6400;
constexpr int LW = 768;
constexpr int NEXP = 16384;
constexpr float EPS = 1e-6f;
constexpr float QSCALE = 0.08838834764831845f * 1.4426950408889634f;

constexpr size_t OFF_WINT = 0;
constexpr size_t OFF_WMKVT = OFF_WINT + (size_t)INW * 1024 * 2;
constexpr size_t OFF_PATTNT = OFF_WMKVT + (size_t)1024 * 1024 * 2;
constexpr size_t OFF_PLRUT = OFF_PATTNT + (size_t)1024 * 768 * 2;
constexpr size_t OFF_PMEMT = OFF_PLRUT + (size_t)1024 * 768 * 2;
constexpr size_t OFF_WOUTT = OFF_PMEMT + (size_t)1024 * 512 * 2;
constexpr size_t OFF_WPQT = OFF_WOUTT + (size_t)1024 * 1024 * 2;
constexpr size_t OFF_LRUWT = OFF_WPQT + (size_t)2048 * 1024 * 2;
constexpr size_t OFF_SUBK = OFF_LRUWT + (size_t)6 * 512 * 128 * 2;
constexpr size_t OFF_UB = OFF_SUBK + (size_t)16 * 128 * 128 * 2;
constexpr size_t OFF_VB = OFF_UB + (size_t)NEXP * 1024;
constexpr size_t OFF_SU = OFF_VB + (size_t)NEXP * 1024;
constexpr size_t OFF_SV = OFF_SU + (size_t)NEXP * 4;
constexpr size_t OFF_RA = OFF_SV + (size_t)NEXP * 4;
constexpr size_t OFF_QA = OFF_RA;
constexpr size_t OFF_KA = OFF_QA + (size_t)NTOK * 768 * 2;
constexpr size_t OFF_VAT = OFF_KA + (size_t)NTOK * 256 * 2;
constexpr size_t OFF_XL = OFF_VAT + (size_t)NTOK * 256 * 2;
constexpr size_t OFF_GL = OFF_XL + (size_t)NTOK * 768 * 2;
constexpr size_t OFF_QM = OFF_GL + (size_t)NTOK * 768 * 2;
constexpr size_t OFF_GATES = OFF_QM + (size_t)NTOK * 512 * 2;
constexpr size_t OFF_BAR = OFF_GATES + (size_t)NTOK * 3072 * 2;
constexpr size_t OFF_SP8 = OFF_BAR + 16384;
constexpr size_t OFF_AGG = OFF_SP8 + 2 * 768 * 4;
constexpr size_t OFF_ROWSS = OFF_AGG + (size_t)2 * B_ * 16 * 768 * 8;
constexpr size_t OFF_LCB = OFF_ROWSS + (size_t)NTOK * 4;
constexpr size_t OFF_END = OFF_LCB + (size_t)NTOK * 768 * 2;
constexpr size_t OFF_MERGED = OFF_KA;
constexpr size_t OFF_QPEER = OFF_GATES;
constexpr size_t OFF_TOPL = OFF_QPEER + (size_t)NTOK * 2048 * 2;
constexpr size_t OFF_EIDX = OFF_TOPL + (size_t)NTOK * 256 * 4;
constexpr size_t OFF_ZBUF = OFF_QPEER;
constexpr size_t OFF_WBUF = OFF_TOPL;
constexpr size_t OFF_EGATE = OFF_EIDX + (size_t)NTOK * 128 * 4;
static_assert(OFF_EGATE + (size_t)NTOK * 128 * 4 <= OFF_BAR, "overlay");
static_assert(OFF_MERGED + (size_t)NTOK * 1024 * 2 <= OFF_GL, "overlay2");
constexpr size_t DO_LCF = 0;
constexpr size_t DO_HBF = 0;
constexpr size_t DO_MEMBF = DO_HBF + (size_t)NTOK * 1024 * 2;
constexpr size_t DO_KM = DO_MEMBF + (size_t)NMEM * 1024 * 2;
constexpr size_t DO_VMT = DO_KM + (size_t)NMEM * 512 * 2;
constexpr size_t DO_ROPE = DO_VMT + (size_t)NMEM * 512 * 2;
static_assert(DO_ROPE + (size_t)NTOK * 32 * 4 <= (size_t)NTOK * 1024 * 4, "d_out scratch");

struct Params {
    const float *x, *mem; const int* positions;
    const float *g_mix, *g_mem, *w_in, *gate_b, *attn_sink, *conv_w, *conv_b, *lru_wr, *lru_br, *lru_wi, *lru_bi, *lru_lambda,
        *w_mem_kv, *p_attn, *p_lru, *p_mem, *w_out, *g_ffn, *w_peer_q, *peer_sub_keys, *peer_u, *peer_v, *g_final;
    float* out; unsigned char* ws;
};

__device__ __forceinline__ int tidx() { int t = threadIdx.x & 255; asm volatile("" : "+v"(t)); return t; }
__device__ __forceinline__ int vbid() { return (int)(blockIdx.x + (threadIdx.x >> 8) * gridDim.x); }
__device__ __forceinline__ int vnb() { return (int)(2 * gridDim.x); }
__device__ __forceinline__ float bf2f(bf16_t b) { return __uint_as_float(((unsigned)b) << 16); }
__device__ __forceinline__ float bflo(unsigned u) { return __uint_as_float(u << 16); }
__device__ __forceinline__ float bfhi(unsigned u) { return __uint_as_float(u & 0xffff0000u); }
typedef float f32x2v __attribute__((ext_vector_type(2)));
__device__ __forceinline__ unsigned pack_bf16(float lo, float hi) { const f32x2v f = {lo, hi}; return __builtin_bit_cast(unsigned, __builtin_convertvector(f, bf16x2v)); }
__device__ __forceinline__ bf16_t f2bf(float f) { return (bf16_t)(pack_bf16(f, 0.f) & 0xffffu); }
__device__ __forceinline__ f32x4 mfma16(bf16x8 a, bf16x8 b, f32x4 c) { return __builtin_amdgcn_mfma_f32_16x16x32_bf16(a, b, c, 0, 0, 0); }
__device__ __forceinline__ float sigmoidf_(float x) { return __builtin_amdgcn_rcpf(1.0f + __expf(-x)); }
__device__ __forceinline__ float gelu_tanh(float x) { const float u = 1.5957691216057308f * (x + 0.044715f * x * x * x); return x * __builtin_amdgcn_rcpf(1.0f + __expf(-u)); }
__device__ __forceinline__ float wave_sum(float v) {
#pragma unroll
    for (int o = 32; o >= 1; o >>= 1) v += __shfl_xor(v, o);
    return v;
}


typedef unsigned u32x4 __attribute__((ext_vector_type(4)));
#define PIN4(a, o) asm volatile("" : "+v"((a)[(o)]), "+v"((a)[(o) + 1]), "+v"((a)[(o) + 2]), "+v"((a)[(o) + 3]))
#define PIN8(a, o) asm volatile("" : "+v"((a)[(o)]), "+v"((a)[(o) + 1]), "+v"((a)[(o) + 2]), "+v"((a)[(o) + 3]), "+v"((a)[(o) + 4]), "+v"((a)[(o) + 5]), "+v"((a)[(o) + 6]), "+v"((a)[(o) + 7]))
#define PIN15(a, o) asm volatile("" : "+v"((a)[(o)]), "+v"((a)[(o) + 1]), "+v"((a)[(o) + 2]), "+v"((a)[(o) + 3]), "+v"((a)[(o) + 4]), "+v"((a)[(o) + 5]), "+v"((a)[(o) + 6]), "+v"((a)[(o) + 7]), \
    "+v"((a)[(o) + 8]), "+v"((a)[(o) + 9]), "+v"((a)[(o) + 10]), "+v"((a)[(o) + 11]), "+v"((a)[(o) + 12]), "+v"((a)[(o) + 13]), "+v"((a)[(o) + 14]))

__device__ void convT_tile(const float* __restrict__ src, bf16_t* __restrict__ dst, int K, int N, int tile, unsigned char* smem) {
    float* t = (float*)smem;
    const int tn = N / 64, tk = tile / tn, tnn = tile % tn, k0 = tk * 64, n0 = tnn * 64, tid = tidx();
    const int r = tid >> 4, c4 = (tid & 15) * 4;
#pragma unroll
    for (int i = 0; i < 4; ++i) {
        const int k = r + 16 * i;
        const float4 v = *(const float4*)(src + (size_t)(k0 + k) * N + n0 + c4);
        t[k * 65 + c4 + 0] = v.x; t[k * 65 + c4 + 1] = v.y; t[k * 65 + c4 + 2] = v.z; t[k * 65 + c4 + 3] = v.w;
    }
    __syncthreads();
    const int n = tid >> 2, kq = (tid & 3) * 16;
    unsigned w[8];
#pragma unroll
    for (int i = 0; i < 8; ++i) w[i] = pack_bf16(t[(kq + 2 * i) * 65 + n], t[(kq + 2 * i + 1) * 65 + n]);
    uint4* d = (uint4*)(dst + (size_t)(n0 + n) * K + k0 + kq);
    d[0] = make_uint4(w[0], w[1], w[2], w[3]); d[1] = make_uint4(w[4], w[5], w[6], w[7]);
    __syncthreads();
}


__device__ __forceinline__ void rms_row_bf16(const float* __restrict__ xr, const float* __restrict__ g, bf16_t* __restrict__ o, int lane) {
    float4 v[4]; float ss = 0.f;
#pragma unroll
    for (int i = 0; i < 4; ++i) { v[i] = *(const float4*)(xr + i * 256 + lane * 4); ss += v[i].x * v[i].x + v[i].y * v[i].y + v[i].z * v[i].z + v[i].w * v[i].w; }
    ss = wave_sum(ss);
    const float rs = rsqrtf(ss * (1.0f / 1024.0f) + EPS);
#pragma unroll
    for (int i = 0; i < 4; ++i) {
        const float4 gg = *(const float4*)(g + i * 256 + lane * 4);
        *(uint2*)(o + i * 256 + lane * 4) = make_uint2(pack_bf16(v[i].x * rs * gg.x, v[i].y * rs * gg.y), pack_bf16(v[i].z * rs * gg.z, v[i].w * rs * gg.w));
    }
}


__device__ __forceinline__ void conv_plain(const float* __restrict__ src, bf16_t* __restrict__ dst, size_t n8) {
    for (size_t i = (size_t)vbid() * 256 + tidx(); i < n8; i += (size_t)vnb() * 256) {
        const float4 a = ((const float4*)src)[2 * i], b = ((const float4*)src)[2 * i + 1];
        ((uint4*)dst)[i] = make_uint4(pack_bf16(a.x, a.y), pack_bf16(a.z, a.w), pack_bf16(b.x, b.y), pack_bf16(b.z, b.w));
    }
}
__device__ __forceinline__ void rope_item(const int* __restrict__ pos, float* __restrict__ cs, int i) {
    const int t = i >> 4, f = i & 15;
    const float inv = powf(500000.0f, -(float)(2 * f) / 32.0f);
    const float ang = (float)pos[t] * inv;
    float s, c; sincosf(ang, &s, &c);
    cs[2 * i] = c; cs[2 * i + 1] = s;
}

__device__ __forceinline__ int swz(int row) { return (row & 3) | (((row >> 3) & 1) << 2); }

struct GemmOp { const bf16_t* A; const bf16_t* Bt; int lda, ldb; };
struct GemmPipe { int par; bool pre; };

__device__ __forceinline__ void gemm_issue(const GemmOp& op, int kt, int st, unsigned char* smem) {
    const int tid = tidx();
    const int srow = tid >> 3, skc = (tid & 7) ^ swz(tid >> 3);
    const bf16_t* ga = op.A + (size_t)srow * op.lda + skc * 8 + kt * 64;
    const bf16_t* gb = op.Bt + (size_t)srow * op.ldb + skc * 8 + kt * 64;
    unsigned char* sw = smem + tid * 16 + st * 32768;
#pragma unroll
    for (int i = 0; i < 4; ++i) {
        __builtin_amdgcn_global_load_lds((const unsigned*)(ga + (size_t)(32 * i) * op.lda), (unsigned*)(sw + i * 4096), 16, 0, 0);
        __builtin_amdgcn_global_load_lds((const unsigned*)(gb + (size_t)(32 * i) * op.ldb), (unsigned*)(sw + 16384 + i * 4096), 16, 0, 0);
    }
}
__device__ __forceinline__ void gemm_prefetch(const GemmOp& nx, unsigned char* smem, GemmPipe& pp) { gemm_issue(nx, 0, pp.par, smem); pp.pre = true; }

__device__ __forceinline__ void gemm_tile(const GemmOp& op, int K, f32x4 (&acc)[4][4], unsigned char* smem, GemmPipe& pp) {
    const int tid = tidx(), lane = tid & 63, wid = tid >> 6, wr = wid >> 1, wc = wid & 1, li = lane & 15, g = lane >> 4;
    int aoff[4], boff[4], asw[4], bsw[4];
#pragma unroll
    for (int m = 0; m < 4; ++m) { const int row = wr * 64 + m * 16 + li; aoff[m] = row * 128; asw[m] = swz(row); }
#pragma unroll
    for (int n = 0; n < 4; ++n) { const int row = wc * 64 + 32 * (n >> 1) + 8 * (li >> 2) + 4 * (n & 1) + (li & 3); boff[n] = 16384 + row * 128; bsw[n] = swz(row); }
    const int nk = K >> 6;
    if (!pp.pre) gemm_issue(op, 0, pp.par, smem);
    __syncthreads();
    for (int kt = 0; kt < nk; ++kt) {
        const int cur = (pp.par + kt) & 1;
        const unsigned char* sb = smem + cur * 32768;
        if (kt + 1 < nk) gemm_issue(op, kt + 1, cur ^ 1, smem);
#pragma unroll
        for (int ks = 0; ks < 2; ++ks) {
            bf16x8 af[4], bfr[4];
#pragma unroll
            for (int m = 0; m < 4; ++m) af[m] = *(const bf16x8*)(sb + aoff[m] + (((ks * 4 + g) ^ asw[m]) << 4));
#pragma unroll
            for (int n = 0; n < 4; ++n) bfr[n] = *(const bf16x8*)(sb + boff[n] + (((ks * 4 + g) ^ bsw[n]) << 4));
#pragma unroll
            for (int m = 0; m < 4; ++m)
#pragma unroll
                for (int n = 0; n < 4; ++n) acc[m][n] = mfma16(bfr[n], af[m], acc[m][n]);
        }
        if (kt + 1 < nk) __syncthreads();
    }
    pp.par = (pp.par + nk) & 1; pp.pre = false;
}
__device__ __forceinline__ void acc_zero(f32x4 (&acc)[4][4]) {
#pragma unroll
    for (int m = 0; m < 4; ++m)
#pragma unroll
        for (int n = 0; n < 4; ++n) acc[m][n] = (f32x4){0.f, 0.f, 0.f, 0.f};
}
template <class F> __device__ __forceinline__ void epi_foreach(const f32x4 (&acc)[4][4], F&& f) {
    const int lane = tidx() & 63, wid = tidx() >> 6, wr = wid >> 1, wc = wid & 1, li = lane & 15, g = lane >> 4;
#pragma unroll
    for (int m = 0; m < 4; ++m)
#pragma unroll
        for (int pp = 0; pp < 2; ++pp) {
            float v[8];
#pragma unroll
            for (int r = 0; r < 4; ++r) { v[r] = acc[m][2 * pp][r]; v[4 + r] = acc[m][2 * pp + 1][r]; }
            f(wr * 64 + m * 16 + li, wc * 64 + 32 * pp + 8 * g, v, pp, m);
        }
}
__device__ __forceinline__ void store_bf16x8(bf16_t* p, const float (&v)[8]) {
    *(uint4*)p = make_uint4(pack_bf16(v[0], v[1]), pack_bf16(v[2], v[3]), pack_bf16(v[4], v[5]), pack_bf16(v[6], v[7]));
}
__device__ __forceinline__ void store_tile_T(const f32x4 (&acc)[4][4], bf16_t* __restrict__ dstT, int ldt, unsigned char* smem) {
    bf16_t* t = (bf16_t*)smem;
    __syncthreads();
    epi_foreach(acc, [&](int r, int c, const float (&v)[8], int, int) {
#pragma unroll
        for (int e = 0; e < 8; ++e) t[(c + e) * 136 + r] = f2bf(v[e]);
    });
    __syncthreads();
#pragma unroll
    for (int i = 0; i < 8; ++i) {
        const int ch = tidx() + 256 * i, d = ch >> 4, tc = ch & 15;
        *(uint4*)(dstT + (size_t)d * ldt + tc * 8) = *(const uint4*)(smem + d * 272 + tc * 16);
    }
    __syncthreads();
}

__device__ void inproj_tile(const Params& p, int rt, int ct, unsigned char* smem, GemmPipe& pp, bool hn, int nrt, int nct) {
    unsigned char* ws = p.ws; unsigned char* dob = (unsigned char*)p.out;
    const bf16_t* hbf = (const bf16_t*)(dob + DO_HBF);
    const bf16_t* WinT = (const bf16_t*)(ws + OFF_WINT);
    f32x4 acc[4][4]; acc_zero(acc);
    const GemmOp op{hbf + (size_t)rt * 128 * 1024, WinT + (size_t)ct * 128 * 1024, 1024, 1024};
    const GemmOp nx{hbf + (size_t)nrt * 128 * 1024, WinT + (size_t)nct * 128 * 1024, 1024, 1024};
    gemm_tile(op, 1024, acc, smem, pp);
    const int row0 = rt * 128;
    if (ct < 8) {
        const float* cs = (const float*)(dob + DO_ROPE);
        const bool isq = ct < 6;
        bf16_t* dst = isq ? (bf16_t*)(ws + OFF_QA) + ct * 128 : (bf16_t*)(ws + OFF_KA) + (ct - 6) * 128;
        const int ld = isq ? 768 : 256;
        const float sc = isq ? QSCALE : 1.0f;
        const int lane_ = tidx() & 63, g = lane_ >> 4, wid_ = tidx() >> 6;
        f32x4 csv[16];
        if ((wid_ & 1) == 0) {
#pragma unroll
            for (int m = 0; m < 4; ++m) {
                const f32x4* csr = (const f32x4*)(cs + (size_t)(row0 + (wid_ >> 1) * 64 + m * 16 + (lane_ & 15)) * 32 + (g & 1) * 16);
#pragma unroll
                for (int q = 0; q < 4; ++q) csv[m * 4 + q] = csr[q];
            }
            PIN8(csv, 0); PIN8(csv, 8);
        }
        if (hn) gemm_prefetch(nx, smem, pp);
        epi_foreach(acc, [&](int r, int c, float (&v)[8], int pq, int mq) {
            const int tok = row0 + r;
            if (pq == 0 && c < 32) {
                const f32x4 c0 = csv[mq * 4], c1 = csv[mq * 4 + 1], c2 = csv[mq * 4 + 2], c3 = csv[mq * 4 + 3];
                const float ccv[8] = {c0[0], c0[2], c1[0], c1[2], c2[0], c2[2], c3[0], c3[2]};
                const float ssv[8] = {c0[1], c0[3], c1[1], c1[3], c2[1], c2[3], c3[1], c3[3]};
#pragma unroll
                for (int e = 0; e < 8; ++e) {
                    const float o = __shfl_xor(v[e], 32);
                    v[e] = (g < 2) ? (v[e] * ccv[e] - o * ssv[e]) : (v[e] * ccv[e] + o * ssv[e]);
                }
            }
#pragma unroll
            for (int e = 0; e < 8; ++e) v[e] *= sc;
            store_bf16x8(dst + (size_t)tok * ld + c, v);
        });
    }
    if (!(ct == 8 || ct == 9)) { __syncthreads(); __syncthreads(); __syncthreads(); }
    if (ct < 8) { } else if (ct < 10) {
        const int kvh = ct - 8, b = row0 / S_, s0 = row0 % S_;
        store_tile_T(acc, (bf16_t*)(ws + OFF_VAT) + (size_t)(b * 2 + kvh) * 128 * S_ + s0, S_, smem);
    } else if (ct < 16) {
        if (hn) gemm_prefetch(nx, smem, pp);
        bf16_t* dst = (bf16_t*)(ws + OFF_XL) + (ct - 10) * 128;
        epi_foreach(acc, [&](int r, int c, float (&v)[8], int, int) { store_bf16x8(dst + (size_t)(row0 + r) * 768 + c, v); });
    } else if (ct < 22) {
        if (hn) gemm_prefetch(nx, smem, pp);
        bf16_t* dst = (bf16_t*)(ws + OFF_GL) + (ct - 16) * 128;
        epi_foreach(acc, [&](int r, int c, float (&v)[8], int, int) {
#pragma unroll
            for (int e = 0; e < 8; ++e) v[e] = gelu_tanh(v[e]);
            store_bf16x8(dst + (size_t)(row0 + r) * 768 + c, v); });
    } else if (ct < 26) {
        if (hn) gemm_prefetch(nx, smem, pp);
        bf16_t* dst = (bf16_t*)(ws + OFF_QM) + (ct - 22) * 128;
        epi_foreach(acc, [&](int r, int c, float (&v)[8], int, int) {
#pragma unroll
            for (int e = 0; e < 8; ++e) v[e] *= QSCALE;
            store_bf16x8(dst + (size_t)(row0 + r) * 512 + c, v); });
    } else {
        const int gc0 = (ct - 26) * 128;
        bf16_t* dst = (bf16_t*)(ws + OFF_GATES) + gc0;
        const float* gb = p.gate_b + gc0;
        f32x4 gbv[4];
        {
            const int lane_ = tidx() & 63, c0 = ((tidx() >> 6) & 1) * 64 + 8 * (lane_ >> 4);
#pragma unroll
            for (int q = 0; q < 2; ++q) { gbv[2 * q] = *(const f32x4*)(gb + c0 + 32 * q); gbv[2 * q + 1] = *(const f32x4*)(gb + c0 + 32 * q + 4); }
            PIN4(gbv, 0);
        }
        if (hn) gemm_prefetch(nx, smem, pp);
        epi_foreach(acc, [&](int r, int c, float (&v)[8], int pq, int mq) {
            const f32x4 b0 = gbv[2 * pq], b1 = gbv[2 * pq + 1];
            v[0] = sigmoidf_(v[0] + b0[0]); v[1] = sigmoidf_(v[1] + b0[1]); v[2] = sigmoidf_(v[2] + b0[2]); v[3] = sigmoidf_(v[3] + b0[3]);
            v[4] = sigmoidf_(v[4] + b1[0]); v[5] = sigmoidf_(v[5] + b1[1]); v[6] = sigmoidf_(v[6] + b1[2]); v[7] = sigmoidf_(v[7] + b1[3]);
            store_bf16x8(dst + (size_t)(row0 + r) * 3072 + c, v); });
    }
}

__device__ void memkv_tile(const Params& p, int rt, int ct, unsigned char* smem) {
    unsigned char* dob = (unsigned char*)p.out;
    f32x4 acc[4][4]; acc_zero(acc);
    const GemmOp op{(const bf16_t*)(dob + DO_MEMBF) + (size_t)rt * 128 * 1024, (const bf16_t*)(p.ws + OFF_WMKVT) + (size_t)ct * 128 * 1024, 1024, 1024};
    GemmPipe pp{0, false};
    __syncthreads();
    gemm_tile(op, 1024, acc, smem, pp);
    const int row0 = rt * 128;
    if (ct < 4) {
        bf16_t* dst = (bf16_t*)(dob + DO_KM) + ct * 128;
        epi_foreach(acc, [&](int r, int c, float (&v)[8], int, int) { store_bf16x8(dst + (size_t)(row0 + r) * 512 + c, v); });
    } else {
        const int h = ct - 4, b = row0 / MEML, m0 = row0 % MEML;
        store_tile_T(acc, (bf16_t*)(dob + DO_VMT) + (size_t)(b * 4 + h) * 128 * MEML + m0, MEML, smem);
    }
}


typedef float f32x16 __attribute__((ext_vector_type(16)));
__device__ __forceinline__ f32x16 mfma32(bf16x8 a, bf16x8 b, f32x16 c) { return __builtin_amdgcn_mfma_f32_32x32x16_bf16(a, b, c, 0, 0, 0); }
constexpr int ATT_STAGE = 16384 + 128 * 136;

template <bool WIN>
__device__ void attn_block(const bf16_t* Qg, int ldq, const bf16_t* __restrict__ Kg, int ldk, const bf16_t* __restrict__ Vtg, int ldv,
                           int q0, int kt0, int nt, float sink2, bf16_t* Og, int ldo, unsigned char* smem) {
    const int tid = tidx(), lane = tid & 63, wid = tid >> 6, r = lane & 31, hh = lane >> 5;
    const int qw = q0 + 32 * wid;
    bf16x8 qf[8];
#pragma unroll
    for (int ks = 0; ks < 8; ++ks) qf[ks] = *(const bf16x8*)(Qg + (size_t)(32 * wid + r) * ldq + ks * 16 + hh * 8);
    f32x16 o[4];
#pragma unroll
    for (int db = 0; db < 4; ++db)
#pragma unroll
        for (int e = 0; e < 16; ++e) o[db][e] = 0.f;
    float m = WIN ? sink2 : -1e30f, l = WIN ? 1.0f : 0.0f;
    const int krow = tid >> 4, kch = tid & 15, vrow = tid >> 3, vch = tid & 7;
    const int koff = krow * 256 + ((kch ^ (krow & 15)) << 4);
    const int voff = 16384 + vrow * 136 + vch * 16;
    uint4 rk[4], rv[4];
    const bf16_t* kgp = Kg + (size_t)(kt0 * 64 + krow) * ldk + kch * 8;
    const bf16_t* vgp = Vtg + (size_t)vrow * ldv + kt0 * 64 + vch * 8;
#pragma unroll
    for (int i = 0; i < 4; ++i) { rk[i] = *(const uint4*)(kgp + (size_t)(16 * i) * ldk); rv[i] = *(const uint4*)(vgp + (size_t)(32 * i) * ldv); }
#pragma unroll
    for (int i = 0; i < 4; ++i) {
        *(uint4*)(smem + koff + i * 4096) = rk[i];
        *(uint2*)(smem + voff + i * 4352) = make_uint2(rv[i].x, rv[i].y); *(uint2*)(smem + voff + i * 4352 + 8) = make_uint2(rv[i].z, rv[i].w);
    }
    __syncthreads();
    constexpr int NTL = WIN ? 6 : 4;
    for (int t = 0; t < NTL; ++t) {
        const unsigned char* sb = smem + (t & 1) * ATT_STAGE;
        {
            const int tn = t + 1 < nt ? t + 1 : nt - 1;
#pragma unroll
            for (int i = 0; i < 4; ++i) { rk[i] = *(const uint4*)(kgp + (size_t)(tn * 64 + 16 * i) * ldk); rv[i] = *(const uint4*)(vgp + (size_t)(32 * i) * ldv + tn * 64); }
        }
        const int k0 = (kt0 + t) * 64;
        if (t < nt && (!WIN || (k0 + 63 >= qw - 128 && k0 <= qw + 159))) {
#pragma unroll
            for (int kb = 0; kb < 2; ++kb) {
                const int kb0 = k0 + 32 * kb;
                if (WIN && !(kb0 + 31 >= qw - 128 && kb0 <= qw + 159)) continue;
                f32x16 s;
#pragma unroll
                for (int e = 0; e < 16; ++e) s[e] = 0.f;
                const int row = kb * 32 + r;
#pragma unroll
                for (int ks = 0; ks < 8; ++ks) {
                    const bf16x8 a = *(const bf16x8*)(sb + row * 256 + (((2 * ks + hh) ^ (row & 15)) << 4));
                    s = mfma32(a, qf[ks], s);
                }
                if (WIN && !(kb0 >= qw - 97 && kb0 + 31 <= qw + 128)) {
#pragma unroll
                    for (int e = 0; e < 16; ++e) {
                        const int d = kb0 + (e & 3) + 8 * (e >> 2) + 4 * hh - (qw + r);
                        s[e] = (d <= 128 && d >= -128) ? s[e] : -1e30f;
                    }
                }
                float mx = s[0];
#pragma unroll
                for (int e = 1; e < 16; ++e) mx = fmaxf(mx, s[e]);
                mx = fmaxf(mx, __shfl_xor(mx, 32));
                const float mnew = fmaxf(m, mx), alpha = __builtin_amdgcn_exp2f(m - mnew);
                m = mnew;
                float ps = 0.f;
#pragma unroll
                for (int e = 0; e < 16; ++e) { s[e] = __builtin_amdgcn_exp2f(s[e] - mnew); ps += s[e]; }
                ps += __shfl_xor(ps, 32);
                l = l * alpha + ps;
                if (__any(alpha != 1.0f)) {
#pragma unroll
                    for (int db = 0; db < 4; ++db)
#pragma unroll
                        for (int e = 0; e < 16; ++e) o[db][e] *= alpha;
                }
#pragma unroll
                for (int s2 = 0; s2 < 2; ++s2) {
                    union { unsigned u[4]; bf16x8 v; } pb;
#pragma unroll
                    for (int e = 0; e < 4; ++e) pb.u[e] = pack_bf16(s[8 * s2 + 2 * e], s[8 * s2 + 2 * e + 1]);
#pragma unroll
                    for (int db = 0; db < 4; ++db) {
                        const unsigned char* vp = sb + 16384 + (db * 32 + r) * 136 + (kb * 32 + 16 * s2 + 4 * hh) * 2;
                        union { uint2 u[2]; bf16x8 v; } va;
                        va.u[0] = *(const uint2*)vp; va.u[1] = *(const uint2*)(vp + 16);
                        o[db] = mfma32(va.v, pb.v, o[db]);
                    }
                }
            }
        }
        {
            unsigned char* sw = smem + ((t + 1) & 1) * ATT_STAGE;
#pragma unroll
            for (int i = 0; i < 4; ++i) {
                *(uint4*)(sw + koff + i * 4096) = rk[i];
                *(uint2*)(sw + voff + i * 4352) = make_uint2(rv[i].x, rv[i].y); *(uint2*)(sw + voff + i * 4352 + 8) = make_uint2(rv[i].z, rv[i].w);
            }
        }
        __syncthreads();
    }
    const float inv = __builtin_amdgcn_rcpf(l);
    bf16_t* orow = Og + (size_t)(32 * wid + r) * ldo + 4 * hh;
#pragma unroll
    for (int db = 0; db < 4; ++db)
#pragma unroll
        for (int gq = 0; gq < 4; ++gq)
            *(uint2*)(orow + db * 32 + 8 * gq) = make_uint2(pack_bf16(o[db][4 * gq] * inv, o[db][4 * gq + 1] * inv), pack_bf16(o[db][4 * gq + 2] * inv, o[db][4 * gq + 3] * inv));
}
__device__ void attn_win_unit(const Params& p, int u, unsigned char* smem) {
    const int gh = u % 3, qb = (u / 3) % 16, kvh = (u / 48) % 2, b = u / 96, head = kvh * 3 + gh;
    const int q0 = qb * 128;
    const int ks = q0 - 128 < 0 ? 0 : q0 - 128, ke = q0 + 256 > S_ ? S_ : q0 + 256;
    bf16_t* Q = (bf16_t*)(p.ws + OFF_QA) + (size_t)(b * S_ + q0) * 768 + head * 128;
    const bf16_t* Kb = (const bf16_t*)(p.ws + OFF_KA) + (size_t)(b * S_) * 256 + kvh * 128;
    const bf16_t* Vt = (const bf16_t*)(p.ws + OFF_VAT) + (size_t)(b * 2 + kvh) * 128 * S_;
    attn_block<true>(Q, 768, Kb, 256, Vt, S_, q0, ks / 64, (ke - ks) / 64, p.attn_sink[head] * 1.4426950408889634f, Q, 768, smem);
}
__device__ void attn_mem_unit(const Params& p, int u, unsigned char* smem) {
    const int qb = u % 16, head = (u / 16) % 4, b = u / 64;
    const int q0 = qb * 128;
    unsigned char* dob = (unsigned char*)p.out;
    bf16_t* Q = (bf16_t*)(p.ws + OFF_QM) + (size_t)(b * S_ + q0) * 512 + head * 128;
    const bf16_t* Kb = (const bf16_t*)(dob + DO_KM) + (size_t)(b * MEML) * 512 + head * 128;
    const bf16_t* Vt = (const bf16_t*)(dob + DO_VMT) + (size_t)(b * 4 + head) * 128 * MEML;
    attn_block<false>(Q, 512, Kb, 512, Vt, MEML, q0, 0, 4, 0.f, Q, 512, smem);
}

typedef _Float16 f16x2v __attribute__((ext_vector_type(2)));
__device__ __forceinline__ unsigned pack_f16(float lo, float hi) { return __builtin_bit_cast(unsigned, __builtin_amdgcn_cvt_pkrtz(lo, hi)); }
template <bool FINAL>
__device__ void lru_chunk_unit(const Params& p, int u, unsigned char* smem) {
    const int tid = tidx(), lane = tid & 63, wid = tid >> 6, li = lane & 15, g = lane >> 4;
    const int c = u & 15, h = (u >> 4) % 6, b = u / 96;
    const int cbase = h * 128, s0 = c * 128;
    unsigned char* xcs = smem; unsigned char* LB = smem + 32768; float2* SA = (float2*)(smem + 49152); unsigned char* WL = smem + 51200; float* CC = (float*)(smem + 67584);
    const bf16_t* Xl = (const bf16_t*)(p.ws + OFF_XL) + (size_t)(b * S_) * 768;
    bf16_t* Gl = (bf16_t*)(p.ws + OFF_GL) + (size_t)(b * S_ + s0) * 768;
    const bf16_t* LruWt = (const bf16_t*)(p.ws + OFF_LRUWT) + (size_t)h * 512 * 128;
    const float* SP8 = (const float*)(p.ws + OFF_SP8);
    float2* AGG = (float2*)(p.ws + OFF_AGG);
    bf16_t* LCF = (bf16_t*)((unsigned char*)p.out + DO_LCF) + (size_t)(b * S_ + s0) * 768; bf16_t* LCB = (bf16_t*)(p.ws + OFF_LCB) + (size_t)(b * S_ + s0) * 768;
    auto stage_w = [&](int hc_, int d_) {
#pragma unroll
        for (int i = 0; i < 4; ++i) {
            const int rr = (tid >> 4) + 16 * i, n = rr >> 4, wrow = ((n >> 1) * 2 + d_) * 128 + hc_ * 32 + 16 * (n & 1) + (rr & 15);
            __builtin_amdgcn_global_load_lds((const unsigned*)(LruWt + (size_t)wrow * 128 + (((tid & 15) ^ (rr & 15)) << 3)), (unsigned*)(WL + tid * 16 + i * 4096), 16, 0, 0);
        }
    };
    __syncthreads();
    {
        const int cp = tid & 63, tq = tid >> 6, cch = cbase + 2 * cp;
        float cw[4][2];
#pragma unroll
        for (int j = 0; j < 4; ++j) { cw[j][0] = p.conv_w[j * LW + cch]; cw[j][1] = p.conv_w[j * LW + cch + 1]; }
        const float cb0 = p.conv_b[cch], cb1 = p.conv_b[cch + 1];
#pragma unroll
        for (int hf = 0; hf < 2; ++hf) {
            const int tb = 32 * tq + 16 * hf;
            unsigned xw[19];
#pragma unroll
            for (int i = 0; i < 19; ++i) {
                const int s = s0 + tb + i - 2, sc = s < 0 ? 0 : (s > S_ - 1 ? S_ - 1 : s);
                xw[i] = *(const unsigned*)(Xl + (size_t)sc * 768 + cch);
            }
            PIN15(xw, 0); PIN4(xw, 15);
#pragma unroll
            for (int i = 0; i < 19; ++i) { const int s = s0 + tb + i - 2; xw[i] = (s >= 0 && s < S_) ? xw[i] : 0u; }
#pragma unroll
            for (int i = 0; i < 16; ++i) {
                const int t = tb + i;
                const float y0 = cb0 + cw[0][0] * bflo(xw[i]) + cw[1][0] * bflo(xw[i + 1]) + cw[2][0] * bflo(xw[i + 2]) + cw[3][0] * bflo(xw[i + 3]);
                const float y1 = cb1 + cw[0][1] * bfhi(xw[i]) + cw[1][1] * bfhi(xw[i + 1]) + cw[2][1] * bfhi(xw[i + 2]) + cw[3][1] * bfhi(xw[i + 3]);
                *(unsigned*)(xcs + t * 256 + (((cp >> 2) ^ (t & 15)) << 4) + (cp & 3) * 4) = pack_bf16(y0, y1);
            }
        }
    }
    const int sch = tid & 31, seg = tid >> 5;
    float4 cst[2][3];
    auto load_cst = [&](int hc_, int d_) {
#pragma unroll
        for (int n = 0; n < 2; ++n) {
            const int gch = cbase + hc_ * 32 + 16 * n + 4 * g;
            cst[n][0] = *(const float4*)(p.lru_br + d_ * LW + gch); cst[n][1] = *(const float4*)(p.lru_bi + d_ * LW + gch); cst[n][2] = *(const float4*)(SP8 + d_ * LW + gch);
        }
    };
    stage_w(0, 0);
    __syncthreads();
#pragma unroll 1
    for (int hc = 0; hc < 4; ++hc) {
        float hfv[16], pfv[16];
#pragma unroll
        for (int d = 0; d < 2; ++d) {
            load_cst(hc, d);
            f32x4 acc[2][4];
#pragma unroll
            for (int m = 0; m < 2; ++m)
#pragma unroll
                for (int n = 0; n < 4; ++n) acc[m][n] = (f32x4){0.f, 0.f, 0.f, 0.f};
#pragma unroll
            for (int ks = 0; ks < 4; ++ks) {
                bf16x8 xf[2];
#pragma unroll
                for (int m = 0; m < 2; ++m) { const int row = 32 * wid + 16 * m + li; xf[m] = *(const bf16x8*)(xcs + row * 256 + (((ks * 4 + g) ^ (row & 15)) << 4)); }
#pragma unroll
                for (int n = 0; n < 4; ++n) {
                    const int rr = 16 * n + li;
                    const bf16x8 wf = *(const bf16x8*)(WL + rr * 256 + (((ks * 4 + g) ^ li) << 4));
#pragma unroll
                    for (int m = 0; m < 2; ++m) acc[m][n] = mfma16(wf, xf[m], acc[m][n]);
                }
            }
#pragma unroll
            for (int n = 0; n < 2; ++n) {
                const int ch4 = 16 * n + 4 * g;
                const float4 br4 = cst[n][0], bi4 = cst[n][1], sp4 = cst[n][2];
                const float brv[4] = {br4.x, br4.y, br4.z, br4.w}, biv[4] = {bi4.x, bi4.y, bi4.z, bi4.w}, spv[4] = {sp4.x, sp4.y, sp4.z, sp4.w};
#pragma unroll
                for (int m = 0; m < 2; ++m) {
                    const int tok = 32 * wid + 16 * m + li;
                    const uint2 xq = *(const uint2*)(xcs + tok * 256 + ((((hc * 32 + ch4) >> 3) ^ (tok & 15)) << 4) + (g & 1) * 8);
                    const float xc[4] = {bflo(xq.x), bfhi(xq.x), bflo(xq.y), bfhi(xq.y)};
                    unsigned w[4];
#pragma unroll
                    for (int r = 0; r < 4; ++r) {
                        const float rg = sigmoidf_(acc[m][n][r] + brv[r]), ig = sigmoidf_(acc[m][n + 2][r] + biv[r]);
                        const float la = spv[r] * rg, a = __builtin_amdgcn_exp2f(la);
                        const float bx = __builtin_amdgcn_sqrtf(fmaxf(1.0f - a * a, 0.f)) * (ig * xc[r]);
                        w[r] = pack_f16(la, bx);
                    }
                    *(uint4*)(LB + tok * 128 + (((ch4 >> 2) ^ (tok & 7)) << 4)) = make_uint4(w[0], w[1], w[2], w[3]);
                }
            }
            __syncthreads();
            if (!(hc == 3 && d == 1)) stage_w(d ? hc + 1 : hc, d ^ 1);
            const int gch = cbase + hc * 32 + sch;
            {
                float L = 0.f, H = 0.f;
#pragma unroll
                for (int k = 0; k < 16; ++k) {
                    const int tok = 16 * seg + (d ? 15 - k : k);
                    const unsigned w = *(const unsigned*)(LB + tok * 128 + (((sch >> 2) ^ (tok & 7)) << 4) + (sch & 3) * 4);
                    const f16x2v hv = __builtin_bit_cast(f16x2v, w);
                    const float la = (float)hv.x, bx = (float)hv.y;
                    H = __builtin_amdgcn_exp2f(la) * H + bx; L += la;
                }
                SA[seg * 32 + sch] = make_float2(L, H);
            }
            __syncthreads();
            if (seg == 0) {
                float L = 0.f, H = 0.f;
#pragma unroll
                for (int s = 0; s < 8; ++s) { const float2 a = SA[(d ? 7 - s : s) * 32 + sch]; H = __builtin_amdgcn_exp2f(a.x) * H + a.y; L += a.x; }
                AGG[((size_t)(d * B_ + b) * 16 + c) * 768 + gch] = make_float2(L, H);
            }
            {
                float H = 0.f, Lc = 0.f;
#pragma unroll
                for (int ss = 0; ss < 8; ++ss) {
                    const int s = d ? 7 - ss : ss;
                    const bool on = d ? (s > seg) : (s < seg);
                    const float2 a = SA[s * 32 + sch];
                    H = __builtin_amdgcn_exp2f(on ? a.x : 0.f) * H + (on ? a.y : 0.f); Lc += on ? a.x : 0.f;
                }
                bf16_t* gp = Gl + (size_t)(16 * seg) * 768 + gch;
                float gv[16];
                if (d) {
                    unsigned gr[16];
#pragma unroll
                    for (int k = 0; k < 16; ++k) gr[k] = gp[(size_t)k * 768];
                    PIN8(gr, 0); PIN8(gr, 8);
#pragma unroll
                    for (int k = 0; k < 16; ++k) gv[k] = __uint_as_float(gr[k] << 16);
                }
                bf16_t* cfp = LCF + (size_t)(16 * seg) * 768 + gch; bf16_t* cbp = LCB + (size_t)(16 * seg) * 768 + gch;
#pragma unroll
                for (int k = 0; k < 16; ++k) {
                    const int kk = d ? 15 - k : k, tok = 16 * seg + kk;
                    const unsigned w = *(const unsigned*)(LB + tok * 128 + (((sch >> 2) ^ (tok & 7)) << 4) + (sch & 3) * 4);
                    const f16x2v hv = __builtin_bit_cast(f16x2v, w);
                    const float la = (float)hv.x;
                    H = __builtin_amdgcn_exp2f(la) * H + (float)hv.y; Lc += la;
                    const float P = __builtin_amdgcn_exp2f(Lc);
                    if (d == 0) { hfv[kk] = H; pfv[kk] = P; }
                    else {
                        hfv[kk] = (hfv[kk] + H) * gv[kk];
                        cfp[(size_t)kk * 768] = f2bf(pfv[kk] * gv[kk]);
                        cbp[(size_t)kk * 768] = f2bf(P * gv[kk]);
                    }
                }
                if (d) {
#pragma unroll
                    for (int k = 0; k < 16; ++k) gp[(size_t)k * 768] = f2bf(hfv[k]);
                }
            }
            __syncthreads();
        }
    }
}


__device__ void lru_fixup_unit(const Params& p, int u) {
    const int tid = tidx(), cp = tid & 63, tq = tid >> 6;
    const int c = u & 15, h = (u >> 4) % 6, b = u / 96, cch = h * 128 + 2 * cp, s0 = c * 128;
    const float2* AGG = (const float2*)(p.ws + OFF_AGG);
    float hin[2][2];
#pragma unroll
    for (int d = 0; d < 2; ++d) {
        f32x4 av[16];
#pragma unroll
        for (int j = 0; j < 16; ++j) av[j] = *(const f32x4*)(AGG + ((size_t)(d * B_ + b) * 16 + j) * 768 + cch);
        PIN8(av, 0); PIN8(av, 8);
        float H0 = 0.f, H1 = 0.f;
#pragma unroll
        for (int jj = 0; jj < 16; ++jj) {
            const int j = d ? 15 - jj : jj;
            const bool on = d ? (j > c) : (j < c);
            H0 = __builtin_amdgcn_exp2f(on ? av[j][0] : 0.f) * H0 + (on ? av[j][1] : 0.f);
            H1 = __builtin_amdgcn_exp2f(on ? av[j][2] : 0.f) * H1 + (on ? av[j][3] : 0.f);
        }
        hin[d][0] = H0; hin[d][1] = H1;
    }
    const size_t base = (size_t)(b * S_ + s0 + 32 * tq) * 768 + cch;
    bf16_t* Gl = (bf16_t*)(p.ws + OFF_GL) + base;
    const bf16_t* LCF = (const bf16_t*)((const unsigned char*)p.out + DO_LCF) + base; const bf16_t* LCB = (const bf16_t*)(p.ws + OFF_LCB) + base;
#pragma unroll 1
    for (int g8 = 0; g8 < 4; ++g8) {
        unsigned sv[8], fv[8], bv[8];
#pragma unroll
        for (int i = 0; i < 8; ++i) { const size_t o = (size_t)(g8 * 8 + i) * 768; sv[i] = *(const unsigned*)(Gl + o); fv[i] = *(const unsigned*)(LCF + o); bv[i] = *(const unsigned*)(LCB + o); }
        PIN8(sv, 0); PIN8(fv, 0); PIN8(bv, 0);
#pragma unroll
        for (int i = 0; i < 8; ++i) {
            const float o0 = bflo(sv[i]) + bflo(fv[i]) * hin[0][0] + bflo(bv[i]) * hin[1][0];
            const float o1 = bfhi(sv[i]) + bfhi(fv[i]) * hin[0][1] + bfhi(bv[i]) * hin[1][1];
            *(unsigned*)(Gl + (size_t)(g8 * 8 + i) * 768) = pack_bf16(o0, o1);
        }
    }
}

__device__ void merge_tile(const Params& p, int rt, int ct, unsigned char* smem, GemmPipe& pp, bool hn, int nrt, int nct) {
    unsigned char* ws = p.ws;
    const int row0 = rt * 128, col0 = ct * 128;
    uint4 tot[4][2];
    const bf16_t* G = (const bf16_t*)(ws + OFF_GATES);
    const int lane = tidx() & 63, wid = tidx() >> 6, wr = wid >> 1, wc = wid & 1, li = lane & 15, g = lane >> 4;
#pragma unroll 1
    for (int br = 0; br < 3; ++br) {
        const bf16_t* Ab = (const bf16_t*)(ws + (br == 0 ? OFF_QA : (br == 1 ? OFF_GL : OFF_QM)));
        const bf16_t* Bb = (const bf16_t*)(ws + (br == 0 ? OFF_PATTNT : (br == 1 ? OFF_PLRUT : OFF_PMEMT)));
        const int Kb = br == 2 ? 512 : 768;
        const int nbr = br == 2 ? 0 : br + 1, nr0 = br == 2 ? nrt * 128 : row0, nc0 = br == 2 ? nct * 128 : col0, nKb = nbr == 2 ? 512 : 768;
        const bf16_t* nAb = (const bf16_t*)(ws + (nbr == 0 ? OFF_QA : (nbr == 1 ? OFF_GL : OFF_QM)));
        const bf16_t* nBb = (const bf16_t*)(ws + (nbr == 0 ? OFF_PATTNT : (nbr == 1 ? OFF_PLRUT : OFF_PMEMT)));
        const GemmOp op{Ab + (size_t)row0 * Kb, Bb + (size_t)col0 * Kb, Kb, Kb};
        const GemmOp nx{nAb + (size_t)nr0 * nKb, nBb + (size_t)nc0 * nKb, nKb, nKb};
        f32x4 acc[4][4]; acc_zero(acc);
        gemm_tile(op, Kb, acc, smem, pp);
        u32x4 gva[8];
#pragma unroll
        for (int m = 0; m < 4; ++m)
#pragma unroll
            for (int pq = 0; pq < 2; ++pq) {
                const int r = wr * 64 + m * 16 + li, c = wc * 64 + 32 * pq + 8 * g;
                gva[m * 2 + pq] = *(const u32x4*)(G + (size_t)(row0 + r) * 3072 + br * 1024 + col0 + c);
            }
        PIN8(gva, 0);
        if (br < 2 || hn) gemm_prefetch(nx, smem, pp);
#pragma unroll
        for (int m = 0; m < 4; ++m)
#pragma unroll
            for (int pp = 0; pp < 2; ++pp) {
                const uint4 gv = make_uint4(gva[m * 2 + pp][0], gva[m * 2 + pp][1], gva[m * 2 + pp][2], gva[m * 2 + pp][3]);
                float v[8];
                v[0] = bflo(gv.x) * acc[m][2 * pp][0]; v[1] = bfhi(gv.x) * acc[m][2 * pp][1];
                v[2] = bflo(gv.y) * acc[m][2 * pp][2]; v[3] = bfhi(gv.y) * acc[m][2 * pp][3];
                v[4] = bflo(gv.z) * acc[m][2 * pp + 1][0]; v[5] = bfhi(gv.z) * acc[m][2 * pp + 1][1];
                v[6] = bflo(gv.w) * acc[m][2 * pp + 1][2]; v[7] = bfhi(gv.w) * acc[m][2 * pp + 1][3];
                if (br > 0) {
                    const uint4 t = tot[m][pp];
                    v[0] += bflo(t.x); v[1] += bfhi(t.x); v[2] += bflo(t.y); v[3] += bfhi(t.y);
                    v[4] += bflo(t.z); v[5] += bfhi(t.z); v[6] += bflo(t.w); v[7] += bfhi(t.w);
                }
                tot[m][pp] = make_uint4(pack_bf16(v[0], v[1]), pack_bf16(v[2], v[3]), pack_bf16(v[4], v[5]), pack_bf16(v[6], v[7]));
            }
    }
    bf16_t* dst = (bf16_t*)(ws + OFF_MERGED) + col0;
#pragma unroll
    for (int m = 0; m < 4; ++m)
#pragma unroll
        for (int pp = 0; pp < 2; ++pp) {
            const int r = wr * 64 + m * 16 + li, c = wc * 64 + 32 * pp + 8 * g;
            *(uint4*)(dst + (size_t)(row0 + r) * 1024 + c) = tot[m][pp];
        }
}
__device__ void outproj_tile(const Params& p, int rt, int ct, unsigned char* smem, GemmPipe& pp, bool hn, int nrt, int nct) {
    const int row0 = rt * 128, col0 = ct * 128;
    f32x4 acc[4][4]; acc_zero(acc);
    const GemmOp op{(const bf16_t*)(p.ws + OFF_MERGED) + (size_t)row0 * 1024, (const bf16_t*)(p.ws + OFF_WOUTT) + (size_t)col0 * 1024, 1024, 1024};
    const GemmOp nx{(const bf16_t*)(p.ws + OFF_MERGED) + (size_t)nrt * 128 * 1024, (const bf16_t*)(p.ws + OFF_WOUTT) + (size_t)nct * 128 * 1024, 1024, 1024};
    gemm_tile(op, 1024, acc, smem, pp);
    f32x4 xv[16];
    {
        const int lane_ = tidx() & 63, wid_ = tidx() >> 6;
#pragma unroll
        for (int m = 0; m < 4; ++m)
#pragma unroll
            for (int pq = 0; pq < 2; ++pq) {
                const size_t o = (size_t)(row0 + (wid_ >> 1) * 64 + m * 16 + (lane_ & 15)) * 1024 + col0 + (wid_ & 1) * 64 + 32 * pq + 8 * (lane_ >> 4);
                xv[(m * 2 + pq) * 2] = *(const f32x4*)(p.x + o); xv[(m * 2 + pq) * 2 + 1] = *(const f32x4*)(p.x + o + 4);
            }
        PIN8(xv, 0); PIN8(xv, 8);
    }
    if (hn) gemm_prefetch(nx, smem, pp);
    epi_foreach(acc, [&](int r, int c, float (&v)[8], int pq, int mq) {
        const size_t o = (size_t)(row0 + r) * 1024 + col0 + c;
        const f32x4 x0 = xv[(mq * 2 + pq) * 2], x1 = xv[(mq * 2 + pq) * 2 + 1];
        *(float4*)(p.out + o) = make_float4(x0[0] + v[0], x0[1] + v[1], x0[2] + v[2], x0[3] + v[3]);
        *(float4*)(p.out + o + 4) = make_float4(x1[0] + v[4], x1[1] + v[5], x1[2] + v[6], x1[3] + v[7]);
    });
}

__device__ void peerq_tile(const Params& p, int rt, int ct, unsigned char* smem, GemmPipe& pp, bool hn, int nrt, int nct) {
    const int row0 = rt * 128, col0 = ct * 128;
    f32x4 acc[4][4]; acc_zero(acc);
    const GemmOp op{(const bf16_t*)(p.ws + OFF_MERGED) + (size_t)row0 * 1024, (const bf16_t*)(p.ws + OFF_WPQT) + (size_t)col0 * 1024, 1024, 1024};
    const GemmOp nx{(const bf16_t*)(p.ws + OFF_MERGED) + (size_t)nrt * 128 * 1024, (const bf16_t*)(p.ws + OFF_WPQT) + (size_t)nct * 128 * 1024, 1024, 1024};
    gemm_tile(op, 1024, acc, smem, pp);
    if (hn) gemm_prefetch(nx, smem, pp);
    bf16_t* dst = (bf16_t*)(p.ws + OFF_QPEER) + col0;
    epi_foreach(acc, [&](int r, int c, float (&v)[8], int, int) { store_bf16x8(dst + (size_t)(row0 + r) * 2048 + c, v); });
}

__device__ __forceinline__ int sortable(float v) { int k = __float_as_int(v); return k ^ ((k >> 31) & 0x7fffffff); }
__device__ __forceinline__ float unsortable(int k) { return __int_as_float(k ^ ((k >> 31) & 0x7fffffff)); }
__device__ __forceinline__ void insert16(int (&lst)[16], int x) {
#pragma unroll
    for (int k = 0; k < 16; ++k) { const int hi = max(lst[k], x); x = min(lst[k], x); lst[k] = hi; }
}
__device__ __forceinline__ void cex_desc(int& a, int& b) { const int hi = max(a, b), lo = min(a, b); a = hi; b = lo; }
__device__ __forceinline__ void sort16_desc(int (&a)[16]) {
#pragma unroll
    for (int k = 2; k <= 16; k <<= 1)
#pragma unroll
        for (int j = k >> 1; j >= 1; j >>= 1)
#pragma unroll
            for (int i = 0; i < 16; ++i) {
                const int l = i ^ j;
                if (l > i) { if ((i & k) == 0) cex_desc(a[i], a[l]); else cex_desc(a[l], a[i]); }
            }
}
__device__ __forceinline__ void merge16_desc(int (&a)[16], const int (&b)[16]) {
#pragma unroll
    for (int k = 0; k < 16; ++k) a[k] = max(a[k], b[15 - k]);
#pragma unroll
    for (int s = 8; s >= 1; s >>= 1)
#pragma unroll
        for (int k = 0; k < 16; ++k)
            if ((k & s) == 0) cex_desc(a[k], a[k + s]);
}
__device__ __forceinline__ void scores_half(const Params& p, int row0, int pq, unsigned char* smem, int (&lst)[16]) {
    f32x4 acc[4][4]; acc_zero(acc);
    const GemmOp op{(const bf16_t*)(p.ws + OFF_QPEER) + (size_t)row0 * 2048 + pq * 128, (const bf16_t*)(p.ws + OFF_SUBK) + (size_t)pq * 128 * 128, 2048, 128};
    GemmPipe pp{0, false};
    gemm_tile(op, 128, acc, smem, pp);
    float* sc = (float*)smem;
    __syncthreads();
    epi_foreach(acc, [&](int r, int c, float (&v)[8], int, int) {
        *(float4*)(sc + r * 132 + c) = make_float4(v[0], v[1], v[2], v[3]);
        *(float4*)(sc + r * 132 + c + 4) = make_float4(v[4], v[5], v[6], v[7]); });
    __syncthreads();
    const int t = tidx(), r = t & 127, hf = t >> 7;
    {
        int g1[16], g2[16], g3[16];
        auto load16 = [&](int (&g)[16], int q) {
#pragma unroll
            for (int j4 = 0; j4 < 4; ++j4) {
                const int j = hf * 64 + q * 16 + j4 * 4;
                const float4 v = *(const float4*)(sc + r * 132 + j);
                g[4 * j4] = (sortable(v.x) & ~127) | j; g[4 * j4 + 1] = (sortable(v.y) & ~127) | (j + 1);
                g[4 * j4 + 2] = (sortable(v.z) & ~127) | (j + 2); g[4 * j4 + 3] = (sortable(v.w) & ~127) | (j + 3);
            }
        };
        load16(lst, 0); sort16_desc(lst); load16(g1, 1); sort16_desc(g1); merge16_desc(lst, g1);
        load16(g2, 2); sort16_desc(g2); load16(g3, 3); sort16_desc(g3); merge16_desc(g2, g3);
        merge16_desc(lst, g2);
    }
    __syncthreads();
    int* ls = (int*)smem;
    if (hf) {
#pragma unroll
        for (int k = 0; k < 16; ++k) ls[t * 16 + k] = lst[15 - k];
    }
    __syncthreads();
    if (!hf) {
        int ob[16];
#pragma unroll
        for (int k = 0; k < 16; ++k) ob[15 - k] = ls[(t + 128) * 16 + k];
        merge16_desc(lst, ob);
    }
    __syncthreads();
}
__device__ void scores_tile(const Params& p, int rt, int hd, unsigned char* smem) {
    const int row0 = rt * 128;
    int k0[16], k1[16];
    scores_half(p, row0, 2 * hd, smem, k0);
    scores_half(p, row0, 2 * hd + 1, smem, k1);
    const int t = tidx();
    int* ls = (int*)smem;
    if (t < 128) {
#pragma unroll
        for (int k = 0; k < 16; ++k) { ls[t * 32 + k] = k0[k]; ls[t * 32 + 16 + k] = k1[k]; }
        float v0[16], v1[16];
#pragma unroll
        for (int i = 0; i < 16; ++i) { v0[i] = unsortable(k0[i] & ~127); v1[i] = unsortable(k1[i] & ~127); }
        int lst[16], g1[16], g2[16], g3[16];
#pragma unroll
        for (int b = 0; b < 16; ++b) lst[b] = (sortable(v0[0] + v1[b]) & ~255) | b;
        {
            int n = 0;
#pragma unroll
            for (int a = 1; a < 16; ++a)
#pragma unroll
                for (int b = 0; b < 16; ++b)
                    if ((a + 1) * (b + 1) <= 16) {
                        const int key = (sortable(v0[a] + v1[b]) & ~255) | (a * 16 + b);
                        if (n < 16) g1[n] = key; else if (n < 32) g2[n - 16] = key; else g3[n - 32] = key;
                        ++n;
                    }
#pragma unroll
            for (int k = 2; k < 16; ++k) g3[k] = (int)0x80000000;
        }
        sort16_desc(lst); sort16_desc(g1); merge16_desc(lst, g1);
        sort16_desc(g2); sort16_desc(g3); merge16_desc(g2, g3);
        merge16_desc(lst, g2);
        float val[16], sum = 0.f;
        const float mx = unsortable(lst[0] & ~255);
#pragma unroll
        for (int k = 0; k < 16; ++k) { val[k] = __expf(unsortable(lst[k] & ~255) - mx); sum += val[k]; }
        const float inv = 1.0f / sum;
        const int tok = row0 + t;
        int* ei = (int*)(p.ws + OFF_EIDX) + (size_t)tok * 128 + hd * 16;
        float* eg = (float*)(p.ws + OFF_EGATE) + (size_t)tok * 128 + hd * 16;
#pragma unroll
        for (int k = 0; k < 16; ++k) {
            const int code = lst[k] & 255, a = code >> 4, b = code & 15;
            ei[k] = (ls[t * 32 + a] & 127) * 128 + (ls[t * 32 + 16 + b] & 127);
            eg[k] = val[k] * inv;
        }
    }
    __syncthreads();
}

__device__ __forceinline__ void conv_row_fp8(const float* __restrict__ src, unsigned char* __restrict__ dst, float* __restrict__ scale, int row, int lane) {
    const float4* s = (const float4*)(src + (size_t)row * 1024 + lane * 16);
    float4 v[4]; float am = 0.f;
#pragma unroll
    for (int i = 0; i < 4; ++i) { v[i] = s[i]; am = fmaxf(am, fmaxf(fmaxf(fabsf(v[i].x), fabsf(v[i].y)), fmaxf(fabsf(v[i].z), fabsf(v[i].w)))); }
#pragma unroll
    for (int o = 32; o >= 1; o >>= 1) am = fmaxf(am, __shfl_xor(am, o));
    const float sc = am > 0.f ? am * (1.0f / 224.0f) : 1.0f, inv = 1.0f / sc;
    unsigned w[4];
#pragma unroll
    for (int i = 0; i < 4; ++i) {
        int t = __builtin_amdgcn_cvt_pk_fp8_f32(v[i].x * inv, v[i].y * inv, 0, false);
        t = __builtin_amdgcn_cvt_pk_fp8_f32(v[i].z * inv, v[i].w * inv, t, true);
        w[i] = (unsigned)t;
    }
    *(uint4*)(dst + (size_t)row * 1024 + lane * 16) = make_uint4(w[0], w[1], w[2], w[3]);
    if (lane == 0) scale[row] = sc;
}
__device__ __forceinline__ void load8rows(uint4 (&R)[8], const unsigned char* __restrict__ tab, int es, int l0, int lane) {
#pragma unroll
    for (int j = 0; j < 8; ++j) {
        const int id = __builtin_amdgcn_readlane(es, l0 + j);
        R[j] = *(const uint4*)(tab + (size_t)id * 1024 + lane * 16);
    }
}
__device__ __forceinline__ float dot16q(const uint4& r, const float (&h)[16]) {
    const unsigned q[4] = {r.x, r.y, r.z, r.w};
    float d0 = 0.f, d1 = 0.f;
#pragma unroll
    for (int i = 0; i < 4; ++i) {
        const f32x2v a = __builtin_amdgcn_cvt_pk_f32_fp8((int)q[i], false), b = __builtin_amdgcn_cvt_pk_f32_fp8((int)q[i], true);
        d0 += a.x * h[4 * i]; d1 += a.y * h[4 * i + 1]; d0 += b.x * h[4 * i + 2]; d1 += b.y * h[4 * i + 3];
    }
    return d0 + d1;
}
__device__ __forceinline__ float dots8(const uint4 (&R)[8], const float (&h)[16], int lane) {
    float pd[8];
#pragma unroll
    for (int j = 0; j < 8; ++j) pd[j] = dot16q(R[j], h);
    const bool b5 = (lane & 32) != 0, b4 = (lane & 16) != 0, b3 = (lane & 8) != 0;
    float a[4];
#pragma unroll
    for (int j = 0; j < 4; ++j) { const float keep = b5 ? pd[4 + j] : pd[j], send = b5 ? pd[j] : pd[4 + j]; a[j] = keep + __shfl_xor(send, 32); }
    float c[2];
#pragma unroll
    for (int j = 0; j < 2; ++j) { const float keep = b4 ? a[2 + j] : a[j], send = b4 ? a[j] : a[2 + j]; c[j] = keep + __shfl_xor(send, 16); }
    float kk;
    { const float keep = b3 ? c[1] : c[0], send = b3 ? c[0] : c[1]; kk = keep + __shfl_xor(send, 8); }
    kk += __shfl_xor(kk, 4); kk += __shfl_xor(kk, 2); kk += __shfl_xor(kk, 1);
    return kk;
}
__device__ __forceinline__ void axpy8(float (&o)[16], const uint4 (&R)[8], int wsr, int bb) {
#pragma unroll
    for (int j = 0; j < 8; ++j) {
        const float c = __int_as_float(__builtin_amdgcn_readlane(wsr, 8 * j + bb));
        const unsigned q[4] = {R[j].x, R[j].y, R[j].z, R[j].w};
#pragma unroll
        for (int i = 0; i < 4; ++i) {
            const f32x2v a = __builtin_amdgcn_cvt_pk_f32_fp8((int)q[i], false), b = __builtin_amdgcn_cvt_pk_f32_fp8((int)q[i], true);
            o[4 * i] += c * a.x; o[4 * i + 1] += c * a.y; o[4 * i + 2] += c * b.x; o[4 * i + 3] += c * b.y;
        }
    }
}
__device__ void gather_token(const Params& p, int tok, int lane) {
    const bf16_t* h2 = (const bf16_t*)(p.ws + OFF_MERGED) + (size_t)tok * 1024 + lane * 16;
    const unsigned char* Uq = p.ws + OFF_UB; const unsigned char* Vq = p.ws + OFF_VB;
    const float* SU = (const float*)(p.ws + OFF_SU); const float* SV = (const float*)(p.ws + OFF_SV);
    const int* ei = (const int*)(p.ws + OFF_EIDX) + (size_t)tok * 128;
    const float* eg = (const float*)(p.ws + OFF_EGATE) + (size_t)tok * 128;
    float h[16];
    {
        const uint4 ha = *(const uint4*)h2, hb = *(const uint4*)(h2 + 8);
        const unsigned hq[8] = {ha.x, ha.y, ha.z, ha.w, hb.x, hb.y, hb.z, hb.w};
#pragma unroll
        for (int e = 0; e < 8; ++e) { h[2 * e] = bflo(hq[e]); h[2 * e + 1] = bfhi(hq[e]); }
    }
    const int pe = 8 * (lane & 7) + (lane >> 3);
    int es[2], wsr[2] = {0, 0}; float su[2], gv[2];
#pragma unroll
    for (int k = 0; k < 2; ++k) {
        es[k] = ei[64 * k + lane];
        const int e = ei[64 * k + pe];
        su[k] = SU[e]; gv[k] = eg[64 * k + pe] * SV[e];
    }
    uint4 R0[8], R1[8];
#pragma unroll
    for (int k = 0; k < 2; ++k) {
        load8rows(R0, Uq, es[k], 0, lane);
        for (int bb = 0; bb < 8; bb += 2) {
            load8rows(R1, Uq, es[k], 8 * bb + 8, lane);
            { const float w = gelu_tanh(dots8(R0, h, lane) * su[k]) * gv[k]; if ((lane & 7) == bb) wsr[k] = __float_as_int(w); }
            if (bb + 2 < 8) load8rows(R0, Uq, es[k], 8 * bb + 16, lane);
            { const float w = gelu_tanh(dots8(R1, h, lane) * su[k]) * gv[k]; if ((lane & 7) == bb + 1) wsr[k] = __float_as_int(w); }
        }
    }
    float o[16];
#pragma unroll
    for (int e = 0; e < 16; ++e) o[e] = 0.f;
#pragma unroll
    for (int k = 0; k < 2; ++k) {
        load8rows(R0, Vq, es[k], 0, lane);
        for (int bb = 0; bb < 8; bb += 2) {
            load8rows(R1, Vq, es[k], 8 * bb + 8, lane);
            axpy8(o, R0, wsr[k], bb);
            if (bb + 2 < 8) load8rows(R0, Vq, es[k], 8 * bb + 16, lane);
            axpy8(o, R1, wsr[k], bb + 1);
        }
    }
    float* xr = p.out + (size_t)tok * 1024 + lane * 16;
    float4 x[4]; float ss = 0.f;
#pragma unroll
    for (int i = 0; i < 4; ++i) {
        x[i] = *(const float4*)(xr + 4 * i);
        x[i].x += o[4 * i]; x[i].y += o[4 * i + 1]; x[i].z += o[4 * i + 2]; x[i].w += o[4 * i + 3];
        ss += x[i].x * x[i].x + x[i].y * x[i].y + x[i].z * x[i].z + x[i].w * x[i].w;
    }
    ss = wave_sum(ss);
    const float rs = rsqrtf(ss * (1.0f / 1024.0f) + EPS);
    const float* gf = p.g_final + lane * 16;
#pragma unroll
    for (int i = 0; i < 4; ++i) {
        const float4 gg = *(const float4*)(gf + 4 * i);
        *(float4*)(xr + 4 * i) = make_float4(x[i].x * rs * gg.x, x[i].y * rs * gg.y, x[i].z * rs * gg.z, x[i].w * rs * gg.w);
    }
}


__device__ __forceinline__ void fp8x16_to_f32(const uint4& r, float (&f)[16]) {
    const unsigned q[4] = {r.x, r.y, r.z, r.w};
#pragma unroll
    for (int i = 0; i < 4; ++i) {
        const f32x2v a = __builtin_amdgcn_cvt_pk_f32_fp8((int)q[i], false), b = __builtin_amdgcn_cvt_pk_f32_fp8((int)q[i], true);
        f[4 * i] = a.x; f[4 * i + 1] = a.y; f[4 * i + 2] = b.x; f[4 * i + 3] = b.y;
    }
}
__device__ __forceinline__ float sum8_dpp(float v) {
    v += __int_as_float(__builtin_amdgcn_mov_dpp(__float_as_int(v), 0xB1, 0xF, 0xF, true));
    v += __int_as_float(__builtin_amdgcn_mov_dpp(__float_as_int(v), 0x4E, 0xF, 0xF, true));
    v += __int_as_float(__builtin_amdgcn_mov_dpp(__float_as_int(v), 0x141, 0xF, 0xF, true));
    return v;
}
__device__ __forceinline__ void peer_u_issue(u32x4 (&seg)[8], const unsigned char* Uq, int es, int gq) {
#pragma unroll
    for (int bb = 0; bb < 8; ++bb) { const int id = __shfl(es, 8 * bb + gq); seg[bb] = *(const u32x4*)(Uq + (size_t)id * 1024); }
}
__device__ __forceinline__ float peer_u_half(u32x4 (&seg)[8], const float (&h)[16], int sub) {
    PIN8(seg, 0);
    float z = 0.f;
#pragma unroll
    for (int bb = 0; bb < 8; ++bb) {
        float f[16];
        fp8x16_to_f32(make_uint4(seg[bb][0], seg[bb][1], seg[bb][2], seg[bb][3]), f);
        float d0 = 0.f, d1 = 0.f;
#pragma unroll
        for (int i = 0; i < 8; ++i) { d0 += f[2 * i] * h[2 * i]; d1 += f[2 * i + 1] * h[2 * i + 1]; }
        const float d = sum8_dpp(d0 + d1);
        if (sub == bb) z = d;
    }
    return z;
}
__device__ void peer_u_pass(const Params& p, int t0, int tstep, int x, int lane) {
    const int gq = lane >> 3, sub = lane & 7;
    const int* eib = (const int*)(p.ws + OFF_EIDX);
    const bf16_t* h2b = (const bf16_t*)(p.ws + OFF_MERGED) + x * 128 + sub * 16;
    const unsigned char* Uq = p.ws + OFF_UB + x * 128 + sub * 16;
    float* Zb = (float*)(p.ws + OFF_ZBUF) + (size_t)x * 128;
    if (t0 >= NTOK) return;
    int es0 = eib[(size_t)t0 * 128 + lane], es1 = eib[(size_t)t0 * 128 + 64 + lane];
    uint4 ha = *(const uint4*)(h2b + (size_t)t0 * 1024), hb = *(const uint4*)(h2b + (size_t)t0 * 1024 + 8);
    u32x4 SA[8], SB[8];
    peer_u_issue(SA, Uq, es0, gq);
    for (int t = t0; t < NTOK; t += tstep) {
        float h[16];
        {
            const unsigned hq[8] = {ha.x, ha.y, ha.z, ha.w, hb.x, hb.y, hb.z, hb.w};
#pragma unroll
            for (int e = 0; e < 8; ++e) { h[2 * e] = bflo(hq[e]); h[2 * e + 1] = bfhi(hq[e]); }
        }
        peer_u_issue(SB, Uq, es1, gq);
        const int tn = t + tstep < NTOK ? t + tstep : t;
        es0 = eib[(size_t)tn * 128 + lane]; es1 = eib[(size_t)tn * 128 + 64 + lane];
        ha = *(const uint4*)(h2b + (size_t)tn * 1024); hb = *(const uint4*)(h2b + (size_t)tn * 1024 + 8);
        const float z0 = peer_u_half(SA, h, sub);
        peer_u_issue(SA, Uq, es0, gq);
        const float z1 = peer_u_half(SB, h, sub);
        float* Z = Zb + (size_t)t * 8 * 128;
        Z[lane] = z0; Z[64 + lane] = z1;
    }
}
__device__ void peer_coef_token(const Params& p, int tok, int lane) {
    const int pe = 8 * (lane & 7) + (lane >> 3);
    const int* ei = (const int*)(p.ws + OFF_EIDX) + (size_t)tok * 128;
    const float* eg = (const float*)(p.ws + OFF_EGATE) + (size_t)tok * 128;
    const float* SU = (const float*)(p.ws + OFF_SU); const float* SV = (const float*)(p.ws + OFF_SV);
    const float* Z = (const float*)(p.ws + OFF_ZBUF) + (size_t)tok * 8 * 128;
    float* W = (float*)(p.ws + OFF_WBUF) + (size_t)tok * 128;
#pragma unroll
    for (int k = 0; k < 2; ++k) {
        float zv[8];
#pragma unroll
        for (int x = 0; x < 8; ++x) zv[x] = Z[x * 128 + k * 64 + lane];
        const int e = ei[64 * k + pe];
        const float g = eg[64 * k + pe], su = SU[e], sv = SV[e];
        PIN8(zv, 0);
        const float z = ((zv[0] + zv[1]) + (zv[2] + zv[3])) + ((zv[4] + zv[5]) + (zv[6] + zv[7]));
        W[k * 64 + lane] = gelu_tanh(z * su) * g * sv;
    }
}
#define PINQ(a) asm volatile("" : "+v"((a)[0]), "+v"((a)[1]), "+v"((a)[2]), "+v"((a)[3]))
__device__ __forceinline__ void peer_v_issue4(u32x4 (&seg)[4], const unsigned char* Vq, int es, int gq, int bb0) {
#pragma unroll
    for (int j = 0; j < 4; ++j) { const int id = __shfl(es, 8 * (bb0 + j) + gq); seg[j] = *(const u32x4*)(Vq + (size_t)id * 1024); }
}
__device__ __forceinline__ void peer_v_quarter(u32x4 (&seg)[4], float (&o)[16], float wk, int gq, int bb0) {
    PINQ(seg);
#pragma unroll
    for (int j = 0; j < 4; ++j) {
        const float c = __shfl(wk, 8 * gq + bb0 + j);
        float f[16];
        fp8x16_to_f32(make_uint4(seg[j][0], seg[j][1], seg[j][2], seg[j][3]), f);
#pragma unroll
        for (int i = 0; i < 16; ++i) o[i] += c * f[i];
    }
}
__device__ void peer_v_pass(const Params& p, int t0, int tstep, int x, int lane) {
    const int gq = lane >> 3, sub = lane & 7;
    const int* eib = (const int*)(p.ws + OFF_EIDX);
    const float* Wb = (const float*)(p.ws + OFF_WBUF);
    const unsigned char* Vq = p.ws + OFF_VB + x * 128 + sub * 16;
    if (t0 >= NTOK) return;
    const bool b5 = (lane & 32) != 0, b4 = (lane & 16) != 0, b3 = (lane & 8) != 0;
    const int col = x * 128 + 16 * sub + (b5 ? 8 : 0) + (b4 ? 4 : 0) + (b3 ? 2 : 0);
    int es0 = eib[(size_t)t0 * 128 + lane], es1 = eib[(size_t)t0 * 128 + 64 + lane];
    float wk0 = Wb[(size_t)t0 * 128 + lane], wk1 = Wb[(size_t)t0 * 128 + 64 + lane];
    u32x4 SA[4], SB[4];
    peer_v_issue4(SA, Vq, es0, gq, 0);
    for (int t = t0; t < NTOK; t += tstep) {
        float o[16];
#pragma unroll
        for (int i = 0; i < 16; ++i) o[i] = 0.f;
        const int tn = t + tstep < NTOK ? t + tstep : t;
        const int nes0 = eib[(size_t)tn * 128 + lane], nes1 = eib[(size_t)tn * 128 + 64 + lane];
        const float nwk0 = Wb[(size_t)tn * 128 + lane], nwk1 = Wb[(size_t)tn * 128 + 64 + lane];
        int gl = gq; asm volatile("" : "+v"(gl));
        peer_v_issue4(SB, Vq, es0, gl, 4);  peer_v_quarter(SA, o, wk0, gl, 0);
        peer_v_issue4(SA, Vq, es1, gl, 0);  peer_v_quarter(SB, o, wk0, gl, 4);
        peer_v_issue4(SB, Vq, es1, gl, 4);  peer_v_quarter(SA, o, wk1, gl, 0);
        peer_v_issue4(SA, Vq, nes0, gl, 0); peer_v_quarter(SB, o, wk1, gl, 4);
        es0 = nes0; es1 = nes1; wk0 = nwk0; wk1 = nwk1;
        float a8[8], a4[4], a2[2];
#pragma unroll
        for (int i = 0; i < 8; ++i) { const float keep = b5 ? o[8 + i] : o[i], send = b5 ? o[i] : o[8 + i]; a8[i] = keep + __shfl_xor(send, 32); }
#pragma unroll
        for (int i = 0; i < 4; ++i) { const float keep = b4 ? a8[4 + i] : a8[i], send = b4 ? a8[i] : a8[4 + i]; a4[i] = keep + __shfl_xor(send, 16); }
#pragma unroll
        for (int i = 0; i < 2; ++i) { const float keep = b3 ? a4[2 + i] : a4[i], send = b3 ? a4[i] : a4[2 + i]; a2[i] = keep + __shfl_xor(send, 8); }
        float* xr = p.out + (size_t)t * 1024 + col;
        float2 xv = *(const float2*)xr;
        xv.x += a2[0]; xv.y += a2[1];
        *(float2*)xr = xv;
        const float ss = wave_sum(xv.x * xv.x + xv.y * xv.y);
        if (lane == 0) atomicAdd((float*)(p.ws + OFF_ROWSS) + t, ss);
    }
}
__device__ void final_norm_row(const Params& p, int tok, int lane) {
    float* xr = p.out + (size_t)tok * 1024 + lane * 16;
    const float rs = rsqrtf(((const float*)(p.ws + OFF_ROWSS))[tok] * (1.0f / 1024.0f) + EPS);
    const float* gf = p.g_final + lane * 16;
#pragma unroll
    for (int i = 0; i < 4; ++i) {
        const float4 v = *(const float4*)(xr + 4 * i), gg = *(const float4*)(gf + 4 * i);
        *(float4*)(xr + 4 * i) = make_float4(v.x * rs * gg.x, v.y * rs * gg.y, v.z * rs * gg.z, v.w * rs * gg.w);
    }
}

__device__ __forceinline__ bool gemm_unit(int it, int nct, int& rt, int& ct) {
    const int x = vbid() & 7, j = vbid() >> 3, nbx = vnb() >> 3;
    const int v = j + it * nbx, per_rg = 8 * nct;
    if (v >= 32 * nct) return false;
    const int rgi = v / per_rg, w = v - rgi * per_rg, cg = w >> 6, w2 = w & 63;
    const int rtl = w2 & 7, ctl = w2 >> 3;
    rt = (rgi * 8 + rtl) * 8 + x; ct = cg * 8 + ctl;
    return true;
}


namespace pg8 {
#define PG8_LAS __attribute__((address_space(3)))
constexpr int BM = 256, BK = 64, HALF = 128, HTB = HALF * BK * 2  , STAGE_BYTES = 8 * HTB, NXCD = 8, WGM = 8;

__host__ __device__ __forceinline__ int lds_byte(int r, int c) { const int st = (r >> 4) * 2 + (c >> 5), rr = r & 15, cc = c & 31, ob = rr * 64 + cc * 2; return st * 1024 + (ob ^ (((ob >> 9) & 1) << 5)); }
__host__ __device__ __forceinline__ void stage_rc(int b, int& R, int& C) { const int st = b / 1024, sb = b % 1024, swz = sb ^ (((sb >> 9) & 1) << 5); R = (st >> 1) * 16 + swz / 64; C = (st & 1) * 32 + (swz % 64) / 2; }
__host__ __device__ __forceinline__ int perm32(int rho) { const int n = rho >> 4, i = rho & 15; return 8 * (i >> 2) + 4 * n + (i & 3); }

struct Unit { int pm, pn; };
struct Gemm { const bf16_t* A; const bf16_t* Bt; int M, N, K; };

struct StaticOrder {
    int nM, nN, nwg, G, c;
    __host__ __device__ void init(int M, int N, int G_, int c_) { nM = M / BM; nN = N / BM; nwg = nM * nN; G = G_; c = c_; }
    __host__ __device__ bool next(int i, Unit& u) const {
        const long L = (long)i * G + c; if (L >= nwg) return false;
        int wgid = (int)L; { const int q = nwg / NXCD, r = nwg % NXCD, xcd = wgid % NXCD, off = wgid / NXCD; wgid = (xcd < r ? xcd * (q + 1) : r * (q + 1) + (xcd - r) * q) + off; }
        const int nig = WGM * nN, gid = wgid / nig, fm = gid * WGM, gsz = (nM - fm) < WGM ? (nM - fm) : WGM;
        u.pm = fm + ((wgid % nig) % gsz); u.pn = (wgid % nig) / gsz; return true;
    }
    __device__ __forceinline__ void a_ready(const Unit&) const {}
    __device__ __forceinline__ void done(const Unit&) const {}
};


template <class F> struct EpiFn {
    static constexpr bool PERM = true, AFTER_DRAIN = false;
    F f;
    __device__ __forceinline__ void operator()(const f32x4 (&acc)[2][2][4][2], const Unit& u, int wr, int wc, int fr, int fq) const {
#pragma unroll
        for (int ai = 0; ai < 2; ++ai)
#pragma unroll
            for (int m = 0; m < 4; ++m)
#pragma unroll
                for (int bj = 0; bj < 2; ++bj) {
                    float v[8];
#pragma unroll
                    for (int r = 0; r < 4; ++r) { v[r] = acc[ai][bj][m][0][r]; v[4 + r] = acc[ai][bj][m][1][r]; }
                    f(u.pm * BM + ai * HALF + wr * 64 + m * 16 + fr, u.pn * BM + bj * HALF + wc * 32 + 8 * fq, v);
                }
    }
};
template <class Epi, class Sched, bool ALIGN_EPI = false, bool SP2 = false>
__device__ __forceinline__ void gemm_phase(PG8_LAS unsigned char* lds, const Gemm g, const Sched& S, const Epi& E) {
    int tid_ = threadIdx.x; asm volatile("" : "+v"(tid_));
    const int tid = tid_, wid = __builtin_amdgcn_readfirstlane(tid >> 6), lane = tid & 63, wr = wid >> 2, wc = wid & 3, fr = lane & 15, fq = lane >> 4;
    const int K = g.K, nt = K / BK;
    unsigned voffA[2], voffB[2];
#pragma unroll
    for (int i = 0; i < 2; ++i) { int R, C; stage_rc(tid * 16 + i * 8192, R, C); const int Rb = Epi::PERM ? ((R & ~31) + perm32(R & 31)) : R;
        voffA[i] = (unsigned)(R * K + C) * 2u; voffB[i] = (unsigned)(Rb * K + C) * 2u; }
    const size_t kstep = (size_t)(BK * 2);
    const size_t hstep = (size_t)HALF * K * 2;
    const size_t tstep = 2 * hstep;
    const unsigned ldsw = (unsigned)wid * 1024u;
    const int aoff = lds_byte(wr * 64 + fr, fq * 8), boff = lds_byte(wc * 32 + fr, fq * 8);
#define PG8_SA(b, h) (((b) * 2 + (h)) * HTB)
#define PG8_SB(b, h) ((4 + (b) * 2 + (h)) * HTB)
#define PG8_STAGE(bufoff, gbase, voff) do { _Pragma("unroll") for (int _i = 0; _i < 2; ++_i) \
        __builtin_amdgcn_global_load_lds((const unsigned*)((const char*)(gbase) + (voff)[_i]), (PG8_LAS unsigned*)(lds + (bufoff) + ldsw + _i * 8192), 16, 0, 0); } while (0)
#define PG8_LDA(dst, b, h) do { _Pragma("unroll") for (int m = 0; m < 4; ++m) _Pragma("unroll") for (int k = 0; k < 2; ++k) dst[m][k] = *(const PG8_LAS bf16x8*)(lds + PG8_SA(b, h) + aoff + m * 2048 + k * 1024); } while (0)
#define PG8_LDB(dst, b, h) do { _Pragma("unroll") for (int n = 0; n < 2; ++n) _Pragma("unroll") for (int k = 0; k < 2; ++k) dst[n][k] = *(const PG8_LAS bf16x8*)(lds + PG8_SB(b, h) + boff + n * 2048 + k * 1024); } while (0)
#define PG8_MMA(ai, bj, At, Bt) do { __builtin_amdgcn_s_setprio(1); _Pragma("unroll") for (int m = 0; m < 4; ++m) _Pragma("unroll") for (int n = 0; n < 2; ++n) _Pragma("unroll") for (int k = 0; k < 2; ++k) \
        acc[ai][bj][m][n] = __builtin_amdgcn_mfma_f32_16x16x32_bf16(Bt[n][k], At[m][k], acc[ai][bj][m][n], 0, 0, 0); __builtin_amdgcn_s_setprio(0); } while (0)
#define PG8_WAIT_V(n) asm volatile("s_waitcnt vmcnt(" #n ")" ::: "memory")
#define PG8_WAIT_L(n) asm volatile("s_waitcnt lgkmcnt(" #n ")" ::: "memory")
#define PG8_BAR __builtin_amdgcn_s_barrier()
#define PG8_SCHED __builtin_amdgcn_sched_barrier(0)
    Unit cur, nxt; int ui = 0;
    if (!S.next(0, cur)) return;
    f32x4 acc[2][2][4][2];
#pragma unroll
    for (int a = 0; a < 2; ++a)
#pragma unroll
        for (int b = 0; b < 2; ++b)
#pragma unroll
            for (int m = 0; m < 4; ++m)
#pragma unroll
                for (int n = 0; n < 2; ++n) acc[a][b][m][n] = (f32x4){0.f, 0.f, 0.f, 0.f};
    bf16x8 At[4][2], B0[2][2], B1[2][2];
    const char* cA = (const char*)g.A + (size_t)cur.pm * tstep; const char* cB = (const char*)g.Bt + (size_t)cur.pn * tstep;
    S.a_ready(cur);
    if constexpr (SP2) {
        PG8_STAGE(PG8_SB(0, 0), cB, voffB); PG8_STAGE(PG8_SB(0, 1), cB + hstep, voffB); PG8_STAGE(PG8_SA(0, 0), cA, voffA); PG8_STAGE(PG8_SA(0, 1), cA + hstep, voffA);
        if (wr == 1) PG8_BAR;
        PG8_WAIT_V(2); PG8_BAR;
        PG8_STAGE(PG8_SB(1, 0), cB + kstep, voffB); PG8_STAGE(PG8_SA(1, 0), cA + kstep, voffA); PG8_STAGE(PG8_SB(1, 1), cB + hstep + kstep, voffB);
        PG8_WAIT_V(6); PG8_BAR;
    } else {
        PG8_STAGE(PG8_SB(0, 0), cB, voffB); PG8_STAGE(PG8_SA(0, 0), cA, voffA); PG8_STAGE(PG8_SB(0, 1), cB + hstep, voffB); PG8_STAGE(PG8_SA(0, 1), cA + hstep, voffA);
        if (wr == 1) PG8_BAR;
        PG8_WAIT_V(4); PG8_BAR;
        PG8_STAGE(PG8_SB(1, 0), cB + kstep, voffB); PG8_STAGE(PG8_SA(1, 0), cA + kstep, voffA); PG8_STAGE(PG8_SB(1, 1), cB + hstep + kstep, voffB);
        PG8_WAIT_V(6); PG8_BAR;
    }
    for (;;) {
        const bool has_next = S.next(ui + 1, nxt);
        const char* nA = has_next ? (const char*)g.A + (size_t)nxt.pm * tstep : cA; const char* nB = has_next ? (const char*)g.Bt + (size_t)nxt.pn * tstep : cB;
        for (int t = 0; t < nt; t += 2) {
            const bool last = (t == nt - 2);
            const char* a1 = cA + (size_t)(t + 1) * kstep;
            const char* a2 = last ? nA : cA + (size_t)(t + 2) * kstep; const char* b2 = last ? nB : cB + (size_t)(t + 2) * kstep;
            const char* a3 = a2 + kstep; const char* b3 = b2 + kstep;
            if (last && has_next) S.a_ready(nxt);
            if constexpr (SP2) {
            PG8_LDB(B0, 0, 0); PG8_LDB(B1, 0, 1); PG8_SCHED; PG8_LDA(At, 0, 0); PG8_STAGE(PG8_SA(1, 1), a1 + hstep, voffA);
            PG8_WAIT_V(8); PG8_WAIT_L(0); PG8_BAR; PG8_MMA(0, 0, At, B0); PG8_MMA(0, 1, At, B1); PG8_BAR; PG8_SCHED;
            PG8_LDA(At, 0, 1); PG8_STAGE(PG8_SB(0, 0), b2, voffB); PG8_STAGE(PG8_SB(0, 1), b2 + hstep, voffB); PG8_STAGE(PG8_SA(0, 0), a2, voffA);
            PG8_WAIT_V(8); PG8_WAIT_L(0); PG8_BAR; PG8_MMA(1, 0, At, B0); PG8_MMA(1, 1, At, B1); PG8_BAR; PG8_SCHED;
            PG8_LDB(B0, 1, 0); PG8_LDB(B1, 1, 1); PG8_SCHED; PG8_LDA(At, 1, 0); PG8_STAGE(PG8_SA(0, 1), a2 + hstep, voffA);
            PG8_WAIT_V(8); PG8_WAIT_L(0); PG8_BAR; PG8_MMA(0, 0, At, B0); PG8_MMA(0, 1, At, B1); PG8_BAR; PG8_SCHED;
            PG8_LDA(At, 1, 1); PG8_STAGE(PG8_SB(1, 0), b3, voffB); PG8_STAGE(PG8_SB(1, 1), b3 + hstep, voffB); PG8_STAGE(PG8_SA(1, 0), a3, voffA);
            PG8_WAIT_V(8); PG8_WAIT_L(0); PG8_BAR; PG8_MMA(1, 0, At, B0); PG8_MMA(1, 1, At, B1); PG8_BAR; PG8_SCHED;
            } else {
            PG8_LDB(B0, 0, 0); PG8_SCHED; PG8_LDA(At, 0, 0); PG8_STAGE(PG8_SA(1, 1), a1 + hstep, voffA);
            PG8_WAIT_L(8); PG8_BAR; PG8_WAIT_L(0); PG8_MMA(0, 0, At, B0); PG8_BAR; PG8_SCHED;
            PG8_LDB(B1, 0, 1); PG8_STAGE(PG8_SB(0, 0), b2, voffB);
            PG8_BAR; PG8_WAIT_L(0); PG8_MMA(0, 1, At, B1); PG8_BAR;
            PG8_LDA(At, 0, 1); PG8_STAGE(PG8_SA(0, 0), a2, voffA);
            PG8_BAR; PG8_WAIT_L(0); PG8_MMA(1, 0, At, B0); PG8_BAR; PG8_SCHED;
            PG8_STAGE(PG8_SB(0, 1), b2 + hstep, voffB);
            PG8_WAIT_V(6); PG8_BAR; PG8_MMA(1, 1, At, B1); PG8_BAR;
            PG8_LDB(B0, 1, 0); PG8_SCHED; PG8_LDA(At, 1, 0); PG8_STAGE(PG8_SA(0, 1), a2 + hstep, voffA);
            PG8_WAIT_L(8); PG8_BAR; PG8_WAIT_L(0); PG8_MMA(0, 0, At, B0); PG8_BAR; PG8_SCHED;
            PG8_LDB(B1, 1, 1); PG8_STAGE(PG8_SB(1, 0), b3, voffB);
            PG8_BAR; PG8_WAIT_L(0); PG8_MMA(0, 1, At, B1); PG8_BAR;
            PG8_LDA(At, 1, 1); PG8_STAGE(PG8_SA(1, 0), a3, voffA);
            PG8_BAR; PG8_WAIT_L(0); PG8_MMA(1, 0, At, B0); PG8_BAR; PG8_SCHED;
            PG8_STAGE(PG8_SB(1, 1), b3 + hstep, voffB);
            PG8_WAIT_V(6); PG8_BAR; PG8_MMA(1, 1, At, B1); PG8_BAR;
            }
        }
        if constexpr (ALIGN_EPI) { if (wr == 0) PG8_BAR; }
        if constexpr (!Epi::AFTER_DRAIN) { E(acc, cur, wr, wc, fr, fq); S.done(cur); }
        if (!has_next) break;
#pragma unroll
        for (int a = 0; a < 2; ++a)
#pragma unroll
            for (int b = 0; b < 2; ++b)
#pragma unroll
                for (int m = 0; m < 4; ++m)
#pragma unroll
                    for (int n = 0; n < 2; ++n) acc[a][b][m][n] = (f32x4){0.f, 0.f, 0.f, 0.f};
        cur = nxt; cA = nA; cB = nB; ++ui;
        if constexpr (ALIGN_EPI) { if (wr == 1) PG8_BAR; }
    }
    PG8_WAIT_V(0);
    if constexpr (!ALIGN_EPI) { if (wr == 0) PG8_BAR; }
    PG8_BAR;
    if constexpr (Epi::AFTER_DRAIN) { E.fused(acc, cur, wr, wc, fr, fq, lds, wid, lane); S.done(cur); }
#undef PG8_SA
#undef PG8_SB
#undef PG8_STAGE
#undef PG8_LDA
#undef PG8_LDB
#undef PG8_MMA
#undef PG8_WAIT_V
#undef PG8_WAIT_L
#undef PG8_BAR
#undef PG8_SCHED
}

}


namespace pg8 {
__device__ __forceinline__ void item_vals(const f32x4 (&acc)[2][2][4][2], int ai, int bj, int m, float (&v)[8]) {
#pragma unroll
    for (int r = 0; r < 4; ++r) { v[r] = acc[ai][bj][m][0][r]; v[4 + r] = acc[ai][bj][m][1][r]; }
}
struct EpiOutproj {
    static constexpr bool PERM = true, AFTER_DRAIN = false;
    const float* x; float* out;
    __device__ __forceinline__ void operator()(const f32x4 (&acc)[2][2][4][2], const Unit& u, int wr, int wc, int fr, int fq) const {
#pragma unroll
        for (int ai = 0; ai < 2; ++ai)
#pragma unroll
            for (int mh = 0; mh < 2; ++mh) {
                f32x4 xv[8];
#pragma unroll
                for (int mm = 0; mm < 2; ++mm)
#pragma unroll
                    for (int bj = 0; bj < 2; ++bj) {
                        const int m = mh * 2 + mm;
                        const size_t o = (size_t)(u.pm * BM + ai * HALF + wr * 64 + m * 16 + fr) * 1024 + u.pn * BM + bj * HALF + wc * 32 + 8 * fq;
                        xv[(mm * 2 + bj) * 2] = *(const f32x4*)(x + o); xv[(mm * 2 + bj) * 2 + 1] = *(const f32x4*)(x + o + 4);
                    }
                PIN8(xv, 0);
#pragma unroll
                for (int mm = 0; mm < 2; ++mm)
#pragma unroll
                    for (int bj = 0; bj < 2; ++bj) {
                        const int m = mh * 2 + mm;
                        const size_t o = (size_t)(u.pm * BM + ai * HALF + wr * 64 + m * 16 + fr) * 1024 + u.pn * BM + bj * HALF + wc * 32 + 8 * fq;
                        *(f32x4*)(out + o) = xv[(mm * 2 + bj) * 2] + acc[ai][bj][m][0];
                        *(f32x4*)(out + o + 4) = xv[(mm * 2 + bj) * 2 + 1] + acc[ai][bj][m][1];
                    }
            }
    }
};
struct EpiMerge {
    static constexpr bool PERM = true, AFTER_DRAIN = false;
    const bf16_t* G; bf16_t* merged; int br;
    __device__ __forceinline__ void operator()(const f32x4 (&acc)[2][2][4][2], const Unit& u, int wr, int wc, int fr, int fq) const {
#pragma unroll
        for (int ai = 0; ai < 2; ++ai)
#pragma unroll
            for (int mh = 0; mh < 2; ++mh) {
                u32x4 gm[8];
#pragma unroll
                for (int mm = 0; mm < 2; ++mm)
#pragma unroll
                    for (int bj = 0; bj < 2; ++bj) {
                        const int m = mh * 2 + mm;
                        const size_t row = (size_t)(u.pm * BM + ai * HALF + wr * 64 + m * 16 + fr); const int col = u.pn * BM + bj * HALF + wc * 32 + 8 * fq;
                        gm[mm * 2 + bj] = *(const u32x4*)(G + row * 3072 + br * 1024 + col);
                        gm[4 + mm * 2 + bj] = br > 0 ? *(const u32x4*)(merged + row * 1024 + col) : (u32x4){0u, 0u, 0u, 0u};
                    }
                PIN8(gm, 0);
#pragma unroll
                for (int mm = 0; mm < 2; ++mm)
#pragma unroll
                    for (int bj = 0; bj < 2; ++bj) {
                        const int m = mh * 2 + mm;
                        const size_t row = (size_t)(u.pm * BM + ai * HALF + wr * 64 + m * 16 + fr); const int col = u.pn * BM + bj * HALF + wc * 32 + 8 * fq;
                        float v[8]; item_vals(acc, ai, bj, m, v);
                        const u32x4 g4 = gm[mm * 2 + bj], t = gm[4 + mm * 2 + bj];
#pragma unroll
                        for (int e = 0; e < 4; ++e) { v[2 * e] = v[2 * e] * bflo(g4[e]) + bflo(t[e]); v[2 * e + 1] = v[2 * e + 1] * bfhi(g4[e]) + bfhi(t[e]); }
                        store_bf16x8(merged + row * 1024 + col, v);
                    }
            }
    }
};
struct EpiInproj {
    static constexpr bool PERM = true, AFTER_DRAIN = false;
    unsigned char* ws; const float* cs; const float* gate_b;
    __device__ __forceinline__ void operator()(const f32x4 (&acc)[2][2][4][2], const Unit& u, int wr, int wc, int fr, int fq) const {
        const int pn = u.pn;
        if (pn < 4) {
            const bool isq = pn < 3;
            bf16_t* dst = isq ? (bf16_t*)(ws + OFF_QA) + pn * 256 : (bf16_t*)(ws + OFF_KA);
            const int ld = isq ? 768 : 256; const float sc = isq ? QSCALE : 1.0f;
#pragma unroll
            for (int ai = 0; ai < 2; ++ai)
#pragma unroll
                for (int mh = 0; mh < 2; ++mh) {
                    f32x4 csv[8];
                    if (wc == 0) {
#pragma unroll
                        for (int mm = 0; mm < 2; ++mm) {
                            const f32x4* csr = (const f32x4*)(cs + (size_t)(u.pm * BM + ai * HALF + wr * 64 + (mh * 2 + mm) * 16 + fr) * 32 + (fq & 1) * 16);
#pragma unroll
                            for (int q = 0; q < 4; ++q) csv[mm * 4 + q] = csr[q];
                        }
                        PIN8(csv, 0);
                    }
#pragma unroll
                    for (int mm = 0; mm < 2; ++mm)
#pragma unroll
                        for (int bj = 0; bj < 2; ++bj) {
                            const int m = mh * 2 + mm;
                            const size_t row = (size_t)(u.pm * BM + ai * HALF + wr * 64 + m * 16 + fr);
                            float v[8]; item_vals(acc, ai, bj, m, v);
                            if (wc == 0) {
                                const f32x4 c0 = csv[mm * 4], c1 = csv[mm * 4 + 1], c2 = csv[mm * 4 + 2], c3 = csv[mm * 4 + 3];
                                const float ccv[8] = {c0[0], c0[2], c1[0], c1[2], c2[0], c2[2], c3[0], c3[2]};
                                const float ssv[8] = {c0[1], c0[3], c1[1], c1[3], c2[1], c2[3], c3[1], c3[3]};
#pragma unroll
                                for (int e = 0; e < 8; ++e) {
                                    const float o = __shfl_xor(v[e], 32);
                                    v[e] = (fq < 2) ? (v[e] * ccv[e] - o * ssv[e]) : (v[e] * ccv[e] + o * ssv[e]);
                                }
                            }
#pragma unroll
                            for (int e = 0; e < 8; ++e) v[e] *= sc;
                            store_bf16x8(dst + row * ld + bj * HALF + wc * 32 + 8 * fq, v);
                        }
                }
        } else if (pn == 4) {
#pragma unroll
            for (int ai = 0; ai < 2; ++ai)
#pragma unroll
                for (int m = 0; m < 4; ++m)
#pragma unroll
                    for (int bj = 0; bj < 2; ++bj) {
                        const int row = u.pm * BM + ai * HALF + wr * 64 + m * 16 + fr, b = row / S_, s = row % S_;
                        float v[8]; item_vals(acc, ai, bj, m, v);
                        bf16_t* vt = (bf16_t*)(ws + OFF_VAT) + ((size_t)(b * 2 + bj) * 128 + wc * 32 + 8 * fq) * S_ + s;
#pragma unroll
                        for (int e = 0; e < 8; ++e) vt[(size_t)e * S_] = f2bf(v[e]);
                    }
        } else if (pn < 13) {
            const int kind = pn < 8 ? 0 : (pn < 11 ? 1 : 2);
            bf16_t* dst = kind == 0 ? (bf16_t*)(ws + OFF_XL) + (pn - 5) * 256 : (kind == 1 ? (bf16_t*)(ws + OFF_GL) + (pn - 8) * 256 : (bf16_t*)(ws + OFF_QM) + (pn - 11) * 256);
            const int ld = kind == 2 ? 512 : 768;
#pragma unroll
            for (int ai = 0; ai < 2; ++ai)
#pragma unroll
                for (int m = 0; m < 4; ++m)
#pragma unroll
                    for (int bj = 0; bj < 2; ++bj) {
                        const size_t row = (size_t)(u.pm * BM + ai * HALF + wr * 64 + m * 16 + fr);
                        float v[8]; item_vals(acc, ai, bj, m, v);
                        if (kind == 1) {
#pragma unroll
                            for (int e = 0; e < 8; ++e) v[e] = gelu_tanh(v[e]);
                        } else if (kind == 2) {
#pragma unroll
                            for (int e = 0; e < 8; ++e) v[e] *= QSCALE;
                        }
                        store_bf16x8(dst + row * ld + bj * HALF + wc * 32 + 8 * fq, v);
                    }
        } else {
            const int gc0 = (pn - 13) * 256;
            f32x4 gbv[4];
#pragma unroll
            for (int bj = 0; bj < 2; ++bj) { const float* gb = gate_b + gc0 + bj * HALF + wc * 32 + 8 * fq; gbv[2 * bj] = *(const f32x4*)gb; gbv[2 * bj + 1] = *(const f32x4*)(gb + 4); }
            PIN4(gbv, 0);
            bf16_t* dst = (bf16_t*)(ws + OFF_GATES) + gc0;
#pragma unroll
            for (int ai = 0; ai < 2; ++ai)
#pragma unroll
                for (int m = 0; m < 4; ++m)
#pragma unroll
                    for (int bj = 0; bj < 2; ++bj) {
                        const size_t row = (size_t)(u.pm * BM + ai * HALF + wr * 64 + m * 16 + fr);
                        float v[8]; item_vals(acc, ai, bj, m, v);
                        const f32x4 b0 = gbv[2 * bj], b1 = gbv[2 * bj + 1];
#pragma unroll
                        for (int e = 0; e < 4; ++e) { v[e] = sigmoidf_(v[e] + b0[e]); v[4 + e] = sigmoidf_(v[4 + e] + b1[e]); }
                        store_bf16x8(dst + row * 3072 + bj * HALF + wc * 32 + 8 * fq, v);
                    }
        }
    }
};
}

#define XB_TMO      128
#define XB_XCNT(j)  (256  + 64 * (j))
#define XB_XSUB(j)  (1280 + 64 * (j))
#define XB_XGEN(j)  (2304 + 64 * (j))
#define XB_TOP      3328
#define XB_TOPGEN   3392
#define XCD_BAR_WORDS 3456
#define XB_SPIN_CAP (1u << 22)
#define LAS __attribute__((address_space(3)))
__device__ __forceinline__ unsigned xb_ld(unsigned* p)              { return __hip_atomic_load(p, __ATOMIC_RELAXED, __HIP_MEMORY_SCOPE_AGENT); }
__device__ __forceinline__ unsigned xb_add(unsigned* p, unsigned v) { return __hip_atomic_fetch_add(p, v, __ATOMIC_RELAXED, __HIP_MEMORY_SCOPE_AGENT); }
__device__ __forceinline__ unsigned xb_xcc_id() { return (unsigned)__builtin_amdgcn_s_getreg((3 << 11) | 20) & 0xFu; }
#define XB_SPIN(cond, bar) do { unsigned _sp = 0; while (cond) { __builtin_amdgcn_s_sleep(1); \
    if ((++_sp & 255u) == 0u) { if (xb_ld(&(bar)[XB_TMO])) break; if (_sp > XB_SPIN_CAP) { atomicAdd(&(bar)[XB_TMO], 1u); break; } } } } while (0)
struct XcdBarrier { unsigned* bar; unsigned x; volatile LAS unsigned* st; };
__device__ __forceinline__ XcdBarrier xcd_barrier_post(unsigned* bar, volatile LAS unsigned* st) {
    XcdBarrier b; b.bar = bar; b.x = xb_xcc_id(); b.st = st;
    if (threadIdx.x == 0) (void)xb_add(&bar[XB_XCNT(b.x)], 1u);
    return b;
}
__device__ __forceinline__ void xcd_barrier_complete(unsigned* bar, unsigned x, unsigned& nloc, unsigned& nx) {
    const unsigned G = gridDim.x;
    unsigned sum, cnt, mine, sp = 0u;
    for (;;) {
        sum = 0u; cnt = 0u; mine = 0u;
#pragma unroll
        for (unsigned j = 0; j < 16; ++j) { const unsigned c = xb_ld(&bar[XB_XCNT(j)]); sum += c; cnt += (c > 0u) ? 1u : 0u; mine = (j == x) ? c : mine; }
        if (sum == G) break;
        __builtin_amdgcn_s_sleep(1);
        if ((++sp & 255u) == 0u) { if (xb_ld(&bar[XB_TMO])) break; if (sp > XB_SPIN_CAP) { atomicAdd(&bar[XB_TMO], 1u); break; } }
    }
    nloc = mine > 0u ? mine : 1u; nx = cnt > 0u ? cnt : 1u;
}
__device__ __forceinline__ void xcd_barrier(const XcdBarrier& b) {
    asm volatile("s_waitcnt vmcnt(0)" ::: "memory");
    __syncthreads();
    if (threadIdx.x == 0) {
        unsigned* bar = b.bar;
        __builtin_amdgcn_s_waitcnt(0);
        unsigned nloc = b.st[0], nx = b.st[1];
        if (nloc == 0u) { xcd_barrier_complete(bar, b.x, nloc, nx); b.st[0] = nloc; b.st[1] = nx; }
        const unsigned old = xb_add(&bar[XB_XSUB(b.x)], 1u);
        const unsigned gen = old / nloc;
        if (old + 1u == (gen + 1u) * nloc) {
            __builtin_amdgcn_fence(__ATOMIC_RELEASE, "agent");
            asm volatile("s_waitcnt vmcnt(0)" ::: "memory");
            const unsigned og = xb_add(&bar[XB_TOP], 1u);
            const unsigned tg = og / nx;
            if (og + 1u == (tg + 1u) * nx) xb_add(&bar[XB_TOPGEN], 1u);
            else XB_SPIN(xb_ld(&bar[XB_TOPGEN]) == tg, bar);
            __builtin_amdgcn_fence(__ATOMIC_ACQUIRE, "agent");
            xb_add(&bar[XB_XGEN(b.x)], 1u);
            asm volatile("s_waitcnt vmcnt(0)" ::: "memory");
        } else {
            XB_SPIN(xb_ld(&bar[XB_XGEN(b.x)]) == gen, bar);
            __builtin_amdgcn_fence(__ATOMIC_ACQUIRE, "agent");
            asm volatile("s_waitcnt vmcnt(0)" ::: "memory");
        }
    }
    __syncthreads();
}

#ifndef PROBE_PHASE
#define PROBE_PHASE -1
#endif
#define PH_BEGIN(k) if (PROBE_PHASE == (k)) probe_t0 = __builtin_amdgcn_s_memrealtime();
#define PH_END(k)   if (PROBE_PHASE == (k)) probe_dt = __builtin_amdgcn_s_memrealtime() - probe_t0;
constexpr int SMEM_BYTES = 128 * 132 * 4 + 1024;

__global__ void __launch_bounds__(512, 2) fwd_megakernel(Params p) {
    __shared__ __attribute__((aligned(16))) unsigned char smem_all[2 * SMEM_BYTES + 32];
    if (threadIdx.x == 0) { *(uint4*)(smem_all + 2 * SMEM_BYTES) = make_uint4(0u, 0u, 0u, 0u); *(uint4*)(smem_all + 2 * SMEM_BYTES + 16) = make_uint4(0u, 0u, 0u, 0u); }
    __syncthreads();
    const XcdBarrier xb = xcd_barrier_post((unsigned*)(p.ws + OFF_BAR), (volatile LAS unsigned*)(smem_all + 2 * SMEM_BYTES));
    const int nb = vnb();
#define PHASE_IDS int vb_ = threadIdx.x >> 8; asm volatile("" : "+v"(vb_)); const int vb = vb_, bid = (int)blockIdx.x + vb * (int)gridDim.x, tid = tidx(), lane = tid & 63, wid = tid >> 6; unsigned char* smem = smem_all + vb * SMEM_BYTES; (void)bid; (void)tid; (void)lane; (void)wid; (void)smem;
    unsigned char* ws = p.ws; unsigned char* dob = (unsigned char*)p.out;
    unsigned long long probe_t0 = 0, probe_dt = 0;
    PH_BEGIN(0)
    { PHASE_IDS
    {
        for (int u0 = bid; u0 < 3232 + nb - 1 - (3231 % nb); u0 += nb) {
            const int u = u0 < 3232 ? u0 : 3231;
            if (u < 1600) convT_tile(p.w_in, (bf16_t*)(ws + OFF_WINT), 1024, INW, u, smem);
            else if (u < 1856) convT_tile(p.w_mem_kv, (bf16_t*)(ws + OFF_WMKVT), 1024, 1024, u - 1600, smem);
            else if (u < 2048) convT_tile(p.p_attn, (bf16_t*)(ws + OFF_PATTNT), 768, 1024, u - 1856, smem);
            else if (u < 2240) convT_tile(p.p_lru, (bf16_t*)(ws + OFF_PLRUT), 768, 1024, u - 2048, smem);
            else if (u < 2368) convT_tile(p.p_mem, (bf16_t*)(ws + OFF_PMEMT), 512, 1024, u - 2240, smem);
            else if (u < 2624) convT_tile(p.w_out, (bf16_t*)(ws + OFF_WOUTT), 1024, 1024, u - 2368, smem);
            else if (u < 3136) convT_tile(p.w_peer_q, (bf16_t*)(ws + OFF_WPQT), 1024, 2048, u - 2624, smem);
            else {
                const int v = u - 3136, mat = v >> 2, tile = v & 3, gsel = mat / 6, h = mat % 6, dir = gsel & 1;
                const float* src = (gsel < 2 ? p.lru_wr : p.lru_wi) + (size_t)(dir * 6 + h) * 128 * 128;
                convT_tile(src, (bf16_t*)(ws + OFF_LRUWT) + (size_t)(h * 512 + gsel * 128) * 128, 128, 128, tile, smem);
            }
        }
        conv_plain(p.peer_sub_keys, (bf16_t*)(ws + OFF_SUBK), (size_t)16 * 128 * 128 / 8);
        for (int r = bid * 4 + wid; r < 2 * NEXP; r += nb * 4) {
            if (r < NEXP) conv_row_fp8(p.peer_u, ws + OFF_UB, (float*)(ws + OFF_SU), r, lane);
            else conv_row_fp8(p.peer_v, ws + OFF_VB, (float*)(ws + OFF_SV), r - NEXP, lane);
        }
        for (int r = bid * 4 + wid; r < NTOK; r += nb * 4) rms_row_bf16(p.x + (size_t)r * 1024, p.g_mix, (bf16_t*)(dob + DO_HBF) + (size_t)r * 1024, lane);
        for (int r = bid * 4 + wid; r < NMEM; r += nb * 4) rms_row_bf16(p.mem + (size_t)r * 1024, p.g_mem, (bf16_t*)(dob + DO_MEMBF) + (size_t)r * 1024, lane);
        for (int i = bid * 256 + tid; i < NTOK * 16; i += nb * 256) rope_item(p.positions, (float*)(dob + DO_ROPE), i);
        for (int i = bid * 256 + tid; i < NTOK; i += nb * 256) ((float*)(ws + OFF_ROWSS))[i] = 0.f;
        for (int i = bid * 256 + tid; i < 2 * LW; i += nb * 256) ((float*)(ws + OFF_SP8))[i] = -8.0f * 1.4426950408889634f * log1pf(__expf(-p.lru_lambda[i]));
    }
    xcd_barrier(xb);
    PH_END(0) PH_BEGIN(1)
    }
    { PHASE_IDS
    { const int u = bid & 255; memkv_tile(p, u / 8, u % 8, smem); }
    {
        const pg8::Gemm g{(const bf16_t*)(dob + DO_HBF), (const bf16_t*)(ws + OFF_WINT), NTOK, INW, 1024};
        pg8::StaticOrder S; S.init(NTOK, INW, (int)gridDim.x, (int)blockIdx.x);
        __syncthreads();
        pg8::gemm_phase<pg8::EpiInproj, pg8::StaticOrder, true, true>((PG8_LAS unsigned char*)smem_all, g, S, pg8::EpiInproj{ws, (const float*)(dob + DO_ROPE), p.gate_b});
    }
    xcd_barrier(xb);
    PH_END(1) PH_BEGIN(2)
    }
    { PHASE_IDS
    {
        unsigned* ctr = (unsigned*)(p.ws + OFF_BAR) + 3600;
        volatile LAS unsigned* slot = (volatile LAS unsigned*)(smem_all + 2 * SMEM_BYTES + 16);
        for (;;) {
            if (threadIdx.x == 0) *slot = xb_add(ctr, 2u);
            __syncthreads();
            const int u = (int)*slot + vb;
            __syncthreads();
            if (u >= 1536 + 1536 + 1024) break;
            if (u < 1536) lru_chunk_unit<true>(p, u, smem);
            else if (u < 1536 + 1536) attn_win_unit(p, u - 1536, smem);
            else attn_mem_unit(p, u - 1536 - 1536, smem);
        }
    }
    xcd_barrier(xb);
    }
    { PHASE_IDS
    for (int u = bid; u < 1536; u += nb) lru_fixup_unit(p, u);
    xcd_barrier(xb);
    PH_END(2) PH_BEGIN(3)
    }
    { PHASE_IDS
    {
        pg8::StaticOrder S; S.init(NTOK, 1024, (int)gridDim.x, (int)blockIdx.x);
        const bf16_t* G = (const bf16_t*)(ws + OFF_GATES); bf16_t* mg = (bf16_t*)(ws + OFF_MERGED);
        __syncthreads();
        { const pg8::Gemm g{(const bf16_t*)(ws + OFF_QA), (const bf16_t*)(ws + OFF_PATTNT), NTOK, 1024, 768};
          pg8::gemm_phase<pg8::EpiMerge, pg8::StaticOrder, true, true>((PG8_LAS unsigned char*)smem_all, g, S, pg8::EpiMerge{G, mg, 0}); }
        { const pg8::Gemm g{(const bf16_t*)(ws + OFF_GL), (const bf16_t*)(ws + OFF_PLRUT), NTOK, 1024, 768};
          pg8::gemm_phase<pg8::EpiMerge, pg8::StaticOrder, true, true>((PG8_LAS unsigned char*)smem_all, g, S, pg8::EpiMerge{G, mg, 1}); }
        { const pg8::Gemm g{(const bf16_t*)(ws + OFF_QM), (const bf16_t*)(ws + OFF_PMEMT), NTOK, 1024, 512};
          pg8::gemm_phase<pg8::EpiMerge, pg8::StaticOrder, true, true>((PG8_LAS unsigned char*)smem_all, g, S, pg8::EpiMerge{G, mg, 2}); }
    }
    xcd_barrier(xb);
    PH_END(3) PH_BEGIN(4)
    }
    { PHASE_IDS
    {
        const pg8::Gemm g{(const bf16_t*)(ws + OFF_MERGED), (const bf16_t*)(ws + OFF_WOUTT), NTOK, 1024, 1024};
        pg8::StaticOrder S; S.init(NTOK, 1024, (int)gridDim.x, (int)blockIdx.x);
        __syncthreads();
        pg8::gemm_phase<pg8::EpiOutproj, pg8::StaticOrder, true, true>((PG8_LAS unsigned char*)smem_all, g, S, pg8::EpiOutproj{p.x, p.out});
    }
    xcd_barrier(xb);
    PH_END(4) PH_BEGIN(5)
    }
    { PHASE_IDS
    for (int r = bid * 4 + wid; r < NTOK; r += nb * 4) rms_row_bf16(p.out + (size_t)r * 1024, p.g_ffn, (bf16_t*)(ws + OFF_MERGED) + (size_t)r * 1024, lane);
    xcd_barrier(xb);
    PH_END(5) PH_BEGIN(6)
    }
    { PHASE_IDS
    {
        const pg8::Gemm g{(const bf16_t*)(ws + OFF_MERGED), (const bf16_t*)(ws + OFF_WPQT), NTOK, 2048, 1024};
        pg8::StaticOrder S; S.init(NTOK, 2048, (int)gridDim.x, (int)blockIdx.x);
        bf16_t* qp = (bf16_t*)(ws + OFF_QPEER);
        auto f = [=](int row, int col, const float (&v)[8]) { store_bf16x8(qp + (size_t)row * 2048 + col, v); };
        pg8::gemm_phase<pg8::EpiFn<decltype(f)>, pg8::StaticOrder, true, true>((PG8_LAS unsigned char*)smem_all, g, S, pg8::EpiFn<decltype(f)>{f});
    }
    xcd_barrier(xb);
    PH_END(6) PH_BEGIN(7)
    }
    { PHASE_IDS
    for (int u = bid; u < 256 * 8; u += nb) scores_tile(p, u / 8, u % 8, smem);
    xcd_barrier(xb);
    PH_END(7) PH_BEGIN(9)
    }
    { PHASE_IDS
    {
        const int x = bid & 7, tstep = (nb >> 3) * 4;
        peer_u_pass(p, (bid >> 3) * 4 + wid, tstep, x, lane);
        xcd_barrier(xb);
        for (int t = bid * 4 + wid; t < NTOK; t += nb * 4) peer_coef_token(p, t, lane);
        xcd_barrier(xb);
        peer_v_pass(p, (bid >> 3) * 4 + wid, tstep, x, lane);
        xcd_barrier(xb);
        for (int t = bid * 4 + wid; t < NTOK; t += nb * 4) final_norm_row(p, t, lane);
    }
    }
    PH_END(9)
    if (PROBE_PHASE >= 0) { __syncthreads(); const unsigned long long t1 = __builtin_amdgcn_s_memrealtime(); while (__builtin_amdgcn_s_memrealtime() - t1 < probe_dt) __builtin_amdgcn_s_sleep(8); }
}

extern "C" void kernel_launch(void* const* d_in, const int* in_sizes, int n_in, void* d_out, int out_size, void* d_ws, size_t ws_size, hipStream_t stream) {
    if (ws_size < OFF_END) { fprintf(stderr, "workspace too small: %zu < %zu\n", ws_size, (size_t)OFF_END); return; }
    Params p{};
    p.x = (const float*)d_in[0]; p.mem = (const float*)d_in[1]; p.positions = (const int*)d_in[2];
    p.g_mix = (const float*)d_in[3]; p.g_mem = (const float*)d_in[4]; p.w_in = (const float*)d_in[5]; p.gate_b = (const float*)d_in[6];
    p.attn_sink = (const float*)d_in[7]; p.conv_w = (const float*)d_in[8]; p.conv_b = (const float*)d_in[9];
    p.lru_wr = (const float*)d_in[10]; p.lru_br = (const float*)d_in[11]; p.lru_wi = (const float*)d_in[12]; p.lru_bi = (const float*)d_in[13];
    p.lru_lambda = (const float*)d_in[14]; p.w_mem_kv = (const float*)d_in[15]; p.p_attn = (const float*)d_in[16]; p.p_lru = (const float*)d_in[17];
    p.p_mem = (const float*)d_in[18]; p.w_out = (const float*)d_in[19]; p.g_ffn = (const float*)d_in[20]; p.w_peer_q = (const float*)d_in[21];
    p.peer_sub_keys = (const float*)d_in[22]; p.peer_u = (const float*)d_in[23]; p.peer_v = (const float*)d_in[24]; p.g_final = (const float*)d_in[25];
    p.out = (float*)d_out; p.ws = (unsigned char*)d_ws;
    static int grid_blocks = 0;
    if (!grid_blocks) {
        int dev = 0, cus = 0, per_cu = 0;
        (void)hipGetDevice(&dev);
        (void)hipDeviceGetAttribute(&cus, hipDeviceAttributeMultiprocessorCount, dev);
        (void)hipOccupancyMaxActiveBlocksPerMultiprocessor(&per_cu, fwd_megakernel, 512, 0);
        if (per_cu > 1) per_cu = 1;
        grid_blocks = cus * per_cu;
    }
    (void)hipMemsetAsync((unsigned char*)d_ws + OFF_BAR, 0, 16384, stream);
    void* args[] = {&p};
    hipError_t e = hipLaunchCooperativeKernel((void*)fwd_megakernel, dim3(grid_blocks), dim3(512), args, 0, stream);
    if (e != hipSuccess) fprintf(stderr, "cooperative launch failed: %s (grid %d)\n", hipGetErrorString(e), grid_blocks);
}
```

```cpp
#include <hip/hip_runtime.h>
#include <stdint.h>
#include <stdio.h>

typedef unsigned short bf16_t;
typedef short bf16x8 __attribute__((ext_vector_type(8)));
typedef __bf16 bf16x2v __attribute__((ext_vector_type(2)));
typedef float f32x4 __attribute__((ext_vector_type(4)));

constexpr int B_ = 16, S_ = 2048, D_ = 1024, NTOK = B_ * S_;
constexpr int MEML = 256, NMEM = B_ * MEML;
constexpr int INW = 6400;
constexpr int LW = 768;
constexpr int NEXP = 16384;
constexpr float EPS = 1e-6f;
constexpr float QSCALE = 0.08838834764831845f * 1.4426950408889634f;

constexpr size_t OFF_WINT = 0;
constexpr size_t OFF_WMKVT = OFF_WINT + (size_t)INW * 1024 * 2;
constexpr size_t OFF_PATTNT = OFF_WMKVT + (size_t)1024 * 1024 * 2;
constexpr size_t OFF_PLRUT = OFF_PATTNT + (size_t)1024 * 768 * 2;
constexpr size_t OFF_PMEMT = OFF_PLRUT + (size_t)1024 * 768 * 2;
constexpr size_t OFF_WOUTT = OFF_PMEMT + (size_t)1024 * 512 * 2;
constexpr size_t OFF_WPQT = OFF_WOUTT + (size_t)1024 * 1024 * 2;
constexpr size_t OFF_LRUWT = OFF_WPQT + (size_t)2048 * 1024 * 2;
constexpr size_t OFF_SUBK = OFF_LRUWT + (size_t)6 * 512 * 128 * 2;
constexpr size_t OFF_UB = OFF_SUBK + (size_t)16 * 128 * 128 * 2;
constexpr size_t OFF_VB = OFF_UB + (size_t)NEXP * 1024;
constexpr size_t OFF_SU = OFF_VB + (size_t)NEXP * 1024;
constexpr size_t OFF_SV = OFF_SU + (size_t)NEXP * 4;
constexpr size_t OFF_RA = OFF_SV + (size_t)NEXP * 4;
constexpr size_t OFF_QA = OFF_RA;
constexpr size_t OFF_KA = OFF_QA + (size_t)NTOK * 768 * 2;
constexpr size_t OFF_VAT = OFF_KA + (size_t)NTOK * 256 * 2;
constexpr size_t OFF_XL = OFF_VAT + (size_t)NTOK * 256 * 2;
constexpr size_t OFF_GL = OFF_XL + (size_t)NTOK * 768 * 2;
constexpr size_t OFF_QM = OFF_GL + (size_t)NTOK * 768 * 2;
constexpr size_t OFF_GATES = OFF_QM + (size_t)NTOK * 512 * 2;
constexpr size_t OFF_BAR = OFF_GATES + (size_t)NTOK * 3072 * 2;
constexpr size_t OFF_SP8 = OFF_BAR + 16384;
constexpr size_t OFF_AGG = OFF_SP8 + 2 * 768 * 4;
constexpr size_t OFF_ROWSS = OFF_AGG + (size_t)2 * B_ * 16 * 768 * 8;
constexpr size_t OFF_ROWSS1 = OFF_ROWSS + (size_t)NTOK * 4;
constexpr size_t OFF_LCB = OFF_ROWSS1 + (size_t)NTOK * 4;
constexpr size_t OFF_END = OFF_LCB + (size_t)NTOK * 768 * 2;
constexpr size_t OFF_XB = OFF_GL;
constexpr size_t OFF_MERGED = OFF_KA;
constexpr size_t OFF_QPEER = OFF_GATES;
constexpr size_t OFF_TOPL = OFF_QPEER + (size_t)NTOK * 2048 * 2;
constexpr size_t OFF_EIDX = OFF_TOPL + (size_t)NTOK * 256 * 4;
constexpr size_t OFF_ZBUF = OFF_QPEER;
constexpr size_t OFF_WBUF = OFF_TOPL;
constexpr size_t OFF_EGATE = OFF_EIDX + (size_t)NTOK * 128 * 4;
static_assert(OFF_EGATE + (size_t)NTOK * 128 * 4 <= OFF_BAR, "overlay");
static_assert(OFF_MERGED + (size_t)NTOK * 1024 * 2 <= OFF_GL, "overlay2");
constexpr size_t DO_LCF = 0;
constexpr size_t DO_HBF = 0;
constexpr size_t DO_MEMBF = DO_HBF + (size_t)NTOK * 1024 * 2;
constexpr size_t DO_KM = DO_MEMBF + (size_t)NMEM * 1024 * 2;
constexpr size_t DO_VMT = DO_KM + (size_t)NMEM * 512 * 2;
constexpr size_t DO_ROPE = DO_VMT + (size_t)NMEM * 512 * 2;
static_assert(DO_ROPE + (size_t)NTOK * 32 * 4 <= (size_t)NTOK * 1024 * 4, "d_out scratch");

struct Params {
    const float *x, *mem; const int* positions;
    const float *g_mix, *g_mem, *w_in, *gate_b, *attn_sink, *conv_w, *conv_b, *lru_wr, *lru_br, *lru_wi, *lru_bi, *lru_lambda,
        *w_mem_kv, *p_attn, *p_lru, *p_mem, *w_out, *g_ffn, *w_peer_q, *peer_sub_keys, *peer_u, *peer_v, *g_final;
    float* out; unsigned char* ws;
};

__device__ __forceinline__ int tidx() { int t = threadIdx.x & 255; asm volatile("" : "+v"(t)); return t; }
__device__ __forceinline__ int vbid() { return (int)(blockIdx.x + (threadIdx.x >> 8) * gridDim.x); }
__device__ __forceinline__ int vnb() { return (int)(2 * gridDim.x); }
__device__ __forceinline__ float bf2f(bf16_t b) { return __uint_as_float(((unsigned)b) << 16); }
__device__ __forceinline__ float bflo(unsigned u) { return __uint_as_float(u << 16); }
__device__ __forceinline__ float bfhi(unsigned u) { return __uint_as_float(u & 0xffff0000u); }
typedef float f32x2v __attribute__((ext_vector_type(2)));
__device__ __forceinline__ unsigned pack_bf16(float lo, float hi) { const f32x2v f = {lo, hi}; return __builtin_bit_cast(unsigned, __builtin_convertvector(f, bf16x2v)); }
__device__ __forceinline__ bf16_t f2bf(float f) { return (bf16_t)(pack_bf16(f, 0.f) & 0xffffu); }
__device__ __forceinline__ f32x4 mfma16(bf16x8 a, bf16x8 b, f32x4 c) { return __builtin_amdgcn_mfma_f32_16x16x32_bf16(a, b, c, 0, 0, 0); }
__device__ __forceinline__ float sigmoidf_(float x) { return __builtin_amdgcn_rcpf(1.0f + __expf(-x)); }
__device__ __forceinline__ float gelu_tanh(float x) { const float u = 1.5957691216057308f * (x + 0.044715f * x * x * x); return x * __builtin_amdgcn_rcpf(1.0f + __expf(-u)); }
__device__ __forceinline__ float wave_sum(float v) {
#pragma unroll
    for (int o = 32; o >= 1; o >>= 1) v += __shfl_xor(v, o);
    return v;
}


typedef unsigned u32x4 __attribute__((ext_vector_type(4)));
#define PIN4(a, o) asm volatile("" : "+v"((a)[(o)]), "+v"((a)[(o) + 1]), "+v"((a)[(o) + 2]), "+v"((a)[(o) + 3]))
#define PIN8(a, o) asm volatile("" : "+v"((a)[(o)]), "+v"((a)[(o) + 1]), "+v"((a)[(o) + 2]), "+v"((a)[(o) + 3]), "+v"((a)[(o) + 4]), "+v"((a)[(o) + 5]), "+v"((a)[(o) + 6]), "+v"((a)[(o) + 7]))
#define PIN15(a, o) asm volatile("" : "+v"((a)[(o)]), "+v"((a)[(o) + 1]), "+v"((a)[(o) + 2]), "+v"((a)[(o) + 3]), "+v"((a)[(o) + 4]), "+v"((a)[(o) + 5]), "+v"((a)[(o) + 6]), "+v"((a)[(o) + 7]), \
    "+v"((a)[(o) + 8]), "+v"((a)[(o) + 9]), "+v"((a)[(o) + 10]), "+v"((a)[(o) + 11]), "+v"((a)[(o) + 12]), "+v"((a)[(o) + 13]), "+v"((a)[(o) + 14]))

__device__ void convT_tile(const float* __restrict__ src, bf16_t* __restrict__ dst, int K, int N, int tile, unsigned char* smem) {
    float* t = (float*)smem;
    const int tn = N / 64, tk = tile / tn, tnn = tile % tn, k0 = tk * 64, n0 = tnn * 64, tid = tidx();
    const int r = tid >> 4, c4 = (tid & 15) * 4;
#pragma unroll
    for (int i = 0; i < 4; ++i) {
        const int k = r + 16 * i;
        const float4 v = *(const float4*)(src + (size_t)(k0 + k) * N + n0 + c4);
        t[k * 65 + c4 + 0] = v.x; t[k * 65 + c4 + 1] = v.y; t[k * 65 + c4 + 2] = v.z; t[k * 65 + c4 + 3] = v.w;
    }
    __syncthreads();
    const int n = tid >> 2, kq = (tid & 3) * 16;
    unsigned w[8];
#pragma unroll
    for (int i = 0; i < 8; ++i) w[i] = pack_bf16(t[(kq + 2 * i) * 65 + n], t[(kq + 2 * i + 1) * 65 + n]);
    uint4* d = (uint4*)(dst + (size_t)(n0 + n) * K + k0 + kq);
    d[0] = make_uint4(w[0], w[1], w[2], w[3]); d[1] = make_uint4(w[4], w[5], w[6], w[7]);
    __syncthreads();
}


__device__ __forceinline__ void rms_row_bf16(const float* __restrict__ xr, const float* __restrict__ g, bf16_t* __restrict__ o, int lane) {
    float4 v[4]; float ss = 0.f;
#pragma unroll
    for (int i = 0; i < 4; ++i) { v[i] = *(const float4*)(xr + i * 256 + lane * 4); ss += v[i].x * v[i].x + v[i].y * v[i].y + v[i].z * v[i].z + v[i].w * v[i].w; }
    ss = wave_sum(ss);
    const float rs = rsqrtf(ss * (1.0f / 1024.0f) + EPS);
#pragma unroll
    for (int i = 0; i < 4; ++i) {
        const float4 gg = *(const float4*)(g + i * 256 + lane * 4);
        *(uint2*)(o + i * 256 + lane * 4) = make_uint2(pack_bf16(v[i].x * rs * gg.x, v[i].y * rs * gg.y), pack_bf16(v[i].z * rs * gg.z, v[i].w * rs * gg.w));
    }
}


__device__ __forceinline__ void conv_plain(const float* __restrict__ src, bf16_t* __restrict__ dst, size_t n8) {
    for (size_t i = (size_t)vbid() * 256 + tidx(); i < n8; i += (size_t)vnb() * 256) {
        const float4 a = ((const float4*)src)[2 * i], b = ((const float4*)src)[2 * i + 1];
        ((uint4*)dst)[i] = make_uint4(pack_bf16(a.x, a.y), pack_bf16(a.z, a.w), pack_bf16(b.x, b.y), pack_bf16(b.z, b.w));
    }
}
__device__ __forceinline__ void rope_item(const int* __restrict__ pos, float* __restrict__ cs, int i) {
    const int t = i >> 4, f = i & 15;
    const float inv = powf(500000.0f, -(float)(2 * f) / 32.0f);
    const float ang = (float)pos[t] * inv;
    float s, c; sincosf(ang, &s, &c);
    cs[2 * i] = c; cs[2 * i + 1] = s;
}

__device__ __forceinline__ int swz(int row) { return (row & 3) | (((row >> 3) & 1) << 2); }

struct GemmOp { const bf16_t* A; const bf16_t* Bt; int lda, ldb; };
struct GemmPipe { int par; bool pre; };

__device__ __forceinline__ void gemm_issue(const GemmOp& op, int kt, int st, unsigned char* smem) {
    const int tid = tidx();
    const int srow = tid >> 3, skc = (tid & 7) ^ swz(tid >> 3);
    const bf16_t* ga = op.A + (size_t)srow * op.lda + skc * 8 + kt * 64;
    const bf16_t* gb = op.Bt + (size_t)srow * op.ldb + skc * 8 + kt * 64;
    unsigned char* sw = smem + tid * 16 + st * 32768;
#pragma unroll
    for (int i = 0; i < 4; ++i) {
        __builtin_amdgcn_global_load_lds((const unsigned*)(ga + (size_t)(32 * i) * op.lda), (unsigned*)(sw + i * 4096), 16, 0, 0);
        __builtin_amdgcn_global_load_lds((const unsigned*)(gb + (size_t)(32 * i) * op.ldb), (unsigned*)(sw + 16384 + i * 4096), 16, 0, 0);
    }
}
__device__ __forceinline__ void gemm_prefetch(const GemmOp& nx, unsigned char* smem, GemmPipe& pp) { gemm_issue(nx, 0, pp.par, smem); pp.pre = true; }

__device__ __forceinline__ void gemm_tile(const GemmOp& op, int K, f32x4 (&acc)[4][4], unsigned char* smem, GemmPipe& pp) {
    const int tid = tidx(), lane = tid & 63, wid = tid >> 6, wr = wid >> 1, wc = wid & 1, li = lane & 15, g = lane >> 4;
    int aoff[4], boff[4], asw[4], bsw[4];
#pragma unroll
    for (int m = 0; m < 4; ++m) { const int row = wr * 64 + m * 16 + li; aoff[m] = row * 128; asw[m] = swz(row); }
#pragma unroll
    for (int n = 0; n < 4; ++n) { const int row = wc * 64 + 32 * (n >> 1) + 8 * (li >> 2) + 4 * (n & 1) + (li & 3); boff[n] = 16384 + row * 128; bsw[n] = swz(row); }
    const int nk = K >> 6;
    if (!pp.pre) gemm_issue(op, 0, pp.par, smem);
    __syncthreads();
    for (int kt = 0; kt < nk; ++kt) {
        const int cur = (pp.par + kt) & 1;
        const unsigned char* sb = smem + cur * 32768;
        if (kt + 1 < nk) gemm_issue(op, kt + 1, cur ^ 1, smem);
#pragma unroll
        for (int ks = 0; ks < 2; ++ks) {
            bf16x8 af[4], bfr[4];
#pragma unroll
            for (int m = 0; m < 4; ++m) af[m] = *(const bf16x8*)(sb + aoff[m] + (((ks * 4 + g) ^ asw[m]) << 4));
#pragma unroll
            for (int n = 0; n < 4; ++n) bfr[n] = *(const bf16x8*)(sb + boff[n] + (((ks * 4 + g) ^ bsw[n]) << 4));
#pragma unroll
            for (int m = 0; m < 4; ++m)
#pragma unroll
                for (int n = 0; n < 4; ++n) acc[m][n] = mfma16(bfr[n], af[m], acc[m][n]);
        }
        if (kt + 1 < nk) __syncthreads();
    }
    pp.par = (pp.par + nk) & 1; pp.pre = false;
}
__device__ __forceinline__ void acc_zero(f32x4 (&acc)[4][4]) {
#pragma unroll
    for (int m = 0; m < 4; ++m)
#pragma unroll
        for (int n = 0; n < 4; ++n) acc[m][n] = (f32x4){0.f, 0.f, 0.f, 0.f};
}
template <class F> __device__ __forceinline__ void epi_foreach(const f32x4 (&acc)[4][4], F&& f) {
    const int lane = tidx() & 63, wid = tidx() >> 6, wr = wid >> 1, wc = wid & 1, li = lane & 15, g = lane >> 4;
#pragma unroll
    for (int m = 0; m < 4; ++m)
#pragma unroll
        for (int pp = 0; pp < 2; ++pp) {
            float v[8];
#pragma unroll
            for (int r = 0; r < 4; ++r) { v[r] = acc[m][2 * pp][r]; v[4 + r] = acc[m][2 * pp + 1][r]; }
            f(wr * 64 + m * 16 + li, wc * 64 + 32 * pp + 8 * g, v, pp, m);
        }
}
__device__ __forceinline__ void store_bf16x8(bf16_t* p, const float (&v)[8]) {
    *(uint4*)p = make_uint4(pack_bf16(v[0], v[1]), pack_bf16(v[2], v[3]), pack_bf16(v[4], v[5]), pack_bf16(v[6], v[7]));
}
__device__ __forceinline__ void store_tile_T(const f32x4 (&acc)[4][4], bf16_t* __restrict__ dstT, int ldt, unsigned char* smem) {
    bf16_t* t = (bf16_t*)smem;
    __syncthreads();
    epi_foreach(acc, [&](int r, int c, const float (&v)[8], int, int) {
#pragma unroll
        for (int e = 0; e < 8; ++e) t[(c + e) * 136 + r] = f2bf(v[e]);
    });
    __syncthreads();
#pragma unroll
    for (int i = 0; i < 8; ++i) {
        const int ch = tidx() + 256 * i, d = ch >> 4, tc = ch & 15;
        *(uint4*)(dstT + (size_t)d * ldt + tc * 8) = *(const uint4*)(smem + d * 272 + tc * 16);
    }
    __syncthreads();
}

__device__ void inproj_tile(const Params& p, int rt, int ct, unsigned char* smem, GemmPipe& pp, bool hn, int nrt, int nct) {
    unsigned char* ws = p.ws; unsigned char* dob = (unsigned char*)p.out;
    const bf16_t* hbf = (const bf16_t*)(dob + DO_HBF);
    const bf16_t* WinT = (const bf16_t*)(ws + OFF_WINT);
    f32x4 acc[4][4]; acc_zero(acc);
    const GemmOp op{hbf + (size_t)rt * 128 * 1024, WinT + (size_t)ct * 128 * 1024, 1024, 1024};
    const GemmOp nx{hbf + (size_t)nrt * 128 * 1024, WinT + (size_t)nct * 128 * 1024, 1024, 1024};
    gemm_tile(op, 1024, acc, smem, pp);
    const int row0 = rt * 128;
    if (ct < 8) {
        const float* cs = (const float*)(dob + DO_ROPE);
        const bool isq = ct < 6;
        bf16_t* dst = isq ? (bf16_t*)(ws + OFF_QA) + ct * 128 : (bf16_t*)(ws + OFF_KA) + (ct - 6) * 128;
        const int ld = isq ? 768 : 256;
        const float sc = isq ? QSCALE : 1.0f;
        const int lane_ = tidx() & 63, g = lane_ >> 4, wid_ = tidx() >> 6;
        f32x4 csv[16];
        if ((wid_ & 1) == 0) {
#pragma unroll
            for (int m = 0; m < 4; ++m) {
                const f32x4* csr = (const f32x4*)(cs + (size_t)(row0 + (wid_ >> 1) * 64 + m * 16 + (lane_ & 15)) * 32 + (g & 1) * 16);
#pragma unroll
                for (int q = 0; q < 4; ++q) csv[m * 4 + q] = csr[q];
            }
            PIN8(csv, 0); PIN8(csv, 8);
        }
        if (hn) gemm_prefetch(nx, smem, pp);
        epi_foreach(acc, [&](int r, int c, float (&v)[8], int pq, int mq) {
            const int tok = row0 + r;
            if (pq == 0 && c < 32) {
                const f32x4 c0 = csv[mq * 4], c1 = csv[mq * 4 + 1], c2 = csv[mq * 4 + 2], c3 = csv[mq * 4 + 3];
                const float ccv[8] = {c0[0], c0[2], c1[0], c1[2], c2[0], c2[2], c3[0], c3[2]};
                const float ssv[8] = {c0[1], c0[3], c1[1], c1[3], c2[1], c2[3], c3[1], c3[3]};
#pragma unroll
                for (int e = 0; e < 8; ++e) {
                    const float o = __shfl_xor(v[e], 32);
                    v[e] = (g < 2) ? (v[e] * ccv[e] - o * ssv[e]) : (v[e] * ccv[e] + o * ssv[e]);
                }
            }
#pragma unroll
            for (int e = 0; e < 8; ++e) v[e] *= sc;
            store_bf16x8(dst + (size_t)tok * ld + c, v);
        });
    }
    if (!(ct == 8 || ct == 9)) { __syncthreads(); __syncthreads(); __syncthreads(); }
    if (ct < 8) { } else if (ct < 10) {
        const int kvh = ct - 8, b = row0 / S_, s0 = row0 % S_;
        store_tile_T(acc, (bf16_t*)(ws + OFF_VAT) + (size_t)(b * 2 + kvh) * 128 * S_ + s0, S_, smem);
    } else if (ct < 16) {
        if (hn) gemm_prefetch(nx, smem, pp);
        bf16_t* dst = (bf16_t*)(ws + OFF_XL) + (ct - 10) * 128;
        epi_foreach(acc, [&](int r, int c, float (&v)[8], int, int) { store_bf16x8(dst + (size_t)(row0 + r) * 768 + c, v); });
    } else if (ct < 22) {
        if (hn) gemm_prefetch(nx, smem, pp);
        bf16_t* dst = (bf16_t*)(ws + OFF_GL) + (ct - 16) * 128;
        epi_foreach(acc, [&](int r, int c, float (&v)[8], int, int) {
#pragma unroll
            for (int e = 0; e < 8; ++e) v[e] = gelu_tanh(v[e]);
            store_bf16x8(dst + (size_t)(row0 + r) * 768 + c, v); });
    } else if (ct < 26) {
        if (hn) gemm_prefetch(nx, smem, pp);
        bf16_t* dst = (bf16_t*)(ws + OFF_QM) + (ct - 22) * 128;
        epi_foreach(acc, [&](int r, int c, float (&v)[8], int, int) {
#pragma unroll
            for (int e = 0; e < 8; ++e) v[e] *= QSCALE;
            store_bf16x8(dst + (size_t)(row0 + r) * 512 + c, v); });
    } else {
        const int gc0 = (ct - 26) * 128;
        bf16_t* dst = (bf16_t*)(ws + OFF_GATES) + gc0;
        const float* gb = p.gate_b + gc0;
        f32x4 gbv[4];
        {
            const int lane_ = tidx() & 63, c0 = ((tidx() >> 6) & 1) * 64 + 8 * (lane_ >> 4);
#pragma unroll
            for (int q = 0; q < 2; ++q) { gbv[2 * q] = *(const f32x4*)(gb + c0 + 32 * q); gbv[2 * q + 1] = *(const f32x4*)(gb + c0 + 32 * q + 4); }
            PIN4(gbv, 0);
        }
        if (hn) gemm_prefetch(nx, smem, pp);
        epi_foreach(acc, [&](int r, int c, float (&v)[8], int pq, int mq) {
            const f32x4 b0 = gbv[2 * pq], b1 = gbv[2 * pq + 1];
            v[0] = sigmoidf_(v[0] + b0[0]); v[1] = sigmoidf_(v[1] + b0[1]); v[2] = sigmoidf_(v[2] + b0[2]); v[3] = sigmoidf_(v[3] + b0[3]);
            v[4] = sigmoidf_(v[4] + b1[0]); v[5] = sigmoidf_(v[5] + b1[1]); v[6] = sigmoidf_(v[6] + b1[2]); v[7] = sigmoidf_(v[7] + b1[3]);
            store_bf16x8(dst + (size_t)(row0 + r) * 3072 + c, v); });
    }
}

__device__ void memkv_tile(const Params& p, int rt, int ct, unsigned char* smem) {
    unsigned char* dob = (unsigned char*)p.out;
    f32x4 acc[4][4]; acc_zero(acc);
    const GemmOp op{(const bf16_t*)(dob + DO_MEMBF) + (size_t)rt * 128 * 1024, (const bf16_t*)(p.ws + OFF_WMKVT) + (size_t)ct * 128 * 1024, 1024, 1024};
    GemmPipe pp{0, false};
    __syncthreads();
    gemm_tile(op, 1024, acc, smem, pp);
    const int row0 = rt * 128;
    if (ct < 4) {
        bf16_t* dst = (bf16_t*)(dob + DO_KM) + ct * 128;
        epi_foreach(acc, [&](int r, int c, float (&v)[8], int, int) { store_bf16x8(dst + (size_t)(row0 + r) * 512 + c, v); });
    } else {
        const int h = ct - 4, b = row0 / MEML, m0 = row0 % MEML;
        store_tile_T(acc, (bf16_t*)(dob + DO_VMT) + (size_t)(b * 4 + h) * 128 * MEML + m0, MEML, smem);
    }
}


typedef float f32x16 __attribute__((ext_vector_type(16)));
__device__ __forceinline__ f32x16 mfma32(bf16x8 a, bf16x8 b, f32x16 c) { return __builtin_amdgcn_mfma_f32_32x32x16_bf16(a, b, c, 0, 0, 0); }
constexpr int ATT_STAGE = 16384 + 128 * 136;

template <bool WIN>
__device__ void attn_block(const bf16_t* Qg, int ldq, const bf16_t* __restrict__ Kg, int ldk, const bf16_t* __restrict__ Vtg, int ldv,
                           int q0, int kt0, int nt, float sink2, bf16_t* Og, int ldo, unsigned char* smem) {
    const int tid = tidx(), lane = tid & 63, wid = tid >> 6, r = lane & 31, hh = lane >> 5;
    const int qw = q0 + 32 * wid;
    bf16x8 qf[8];
#pragma unroll
    for (int ks = 0; ks < 8; ++ks) qf[ks] = *(const bf16x8*)(Qg + (size_t)(32 * wid + r) * ldq + ks * 16 + hh * 8);
    f32x16 o[4];
#pragma unroll
    for (int db = 0; db < 4; ++db)
#pragma unroll
        for (int e = 0; e < 16; ++e) o[db][e] = 0.f;
    float m = WIN ? sink2 : -1e30f, l = WIN ? 1.0f : 0.0f;
    const int krow = tid >> 4, kch = tid & 15, vrow = tid >> 3, vch = tid & 7;
    const int koff = krow * 256 + ((kch ^ (krow & 15)) << 4);
    const int voff = 16384 + vrow * 136 + vch * 16;
    uint4 rk[4], rv[4];
    const bf16_t* kgp = Kg + (size_t)(kt0 * 64 + krow) * ldk + kch * 8;
    const bf16_t* vgp = Vtg + (size_t)vrow * ldv + kt0 * 64 + vch * 8;
#pragma unroll
    for (int i = 0; i < 4; ++i) { rk[i] = *(const uint4*)(kgp + (size_t)(16 * i) * ldk); rv[i] = *(const uint4*)(vgp + (size_t)(32 * i) * ldv); }
#pragma unroll
    for (int i = 0; i < 4; ++i) {
        *(uint4*)(smem + koff + i * 4096) = rk[i];
        *(uint2*)(smem + voff + i * 4352) = make_uint2(rv[i].x, rv[i].y); *(uint2*)(smem + voff + i * 4352 + 8) = make_uint2(rv[i].z, rv[i].w);
    }
    __syncthreads();
    constexpr int NTL = WIN ? 6 : 4;
    for (int t = 0; t < NTL; ++t) {
        const unsigned char* sb = smem + (t & 1) * ATT_STAGE;
        {
            const int tn = t + 1 < nt ? t + 1 : nt - 1;
#pragma unroll
            for (int i = 0; i < 4; ++i) { rk[i] = *(const uint4*)(kgp + (size_t)(tn * 64 + 16 * i) * ldk); rv[i] = *(const uint4*)(vgp + (size_t)(32 * i) * ldv + tn * 64); }
        }
        const int k0 = (kt0 + t) * 64;
        if (t < nt && (!WIN || (k0 + 63 >= qw - 128 && k0 <= qw + 159))) {
#pragma unroll
            for (int kb = 0; kb < 2; ++kb) {
                const int kb0 = k0 + 32 * kb;
                if (WIN && !(kb0 + 31 >= qw - 128 && kb0 <= qw + 159)) continue;
                f32x16 s;
#pragma unroll
                for (int e = 0; e < 16; ++e) s[e] = 0.f;
                const int row = kb * 32 + r;
#pragma unroll
                for (int ks = 0; ks < 8; ++ks) {
                    const bf16x8 a = *(const bf16x8*)(sb + row * 256 + (((2 * ks + hh) ^ (row & 15)) << 4));
                    s = mfma32(a, qf[ks], s);
                }
                if (WIN && !(kb0 >= qw - 97 && kb0 + 31 <= qw + 128)) {
#pragma unroll
                    for (int e = 0; e < 16; ++e) {
                        const int d = kb0 + (e & 3) + 8 * (e >> 2) + 4 * hh - (qw + r);
                        s[e] = (d <= 128 && d >= -128) ? s[e] : -1e30f;
                    }
                }
                float mx = s[0];
#pragma unroll
                for (int e = 1; e < 16; ++e) mx = fmaxf(mx, s[e]);
                mx = fmaxf(mx, __shfl_xor(mx, 32));
                const float mnew = fmaxf(m, mx), alpha = __builtin_amdgcn_exp2f(m - mnew);
                m = mnew;
                float ps = 0.f;
#pragma unroll
                for (int e = 0; e < 16; ++e) { s[e] = __builtin_amdgcn_exp2f(s[e] - mnew); ps += s[e]; }
                ps += __shfl_xor(ps, 32);
                l = l * alpha + ps;
                if (__any(alpha != 1.0f)) {
#pragma unroll
                    for (int db = 0; db < 4; ++db)
#pragma unroll
                        for (int e = 0; e < 16; ++e) o[db][e] *= alpha;
                }
#pragma unroll
                for (int s2 = 0; s2 < 2; ++s2) {
                    union { unsigned u[4]; bf16x8 v; } pb;
#pragma unroll
                    for (int e = 0; e < 4; ++e) pb.u[e] = pack_bf16(s[8 * s2 + 2 * e], s[8 * s2 + 2 * e + 1]);
#pragma unroll
                    for (int db = 0; db < 4; ++db) {
                        const unsigned char* vp = sb + 16384 + (db * 32 + r) * 136 + (kb * 32 + 16 * s2 + 4 * hh) * 2;
                        union { uint2 u[2]; bf16x8 v; } va;
                        va.u[0] = *(const uint2*)vp; va.u[1] = *(const uint2*)(vp + 16);
                        o[db] = mfma32(va.v, pb.v, o[db]);
                    }
                }
            }
        }
        {
            unsigned char* sw = smem + ((t + 1) & 1) * ATT_STAGE;
#pragma unroll
            for (int i = 0; i < 4; ++i) {
                *(uint4*)(sw + koff + i * 4096) = rk[i];
                *(uint2*)(sw + voff + i * 4352) = make_uint2(rv[i].x, rv[i].y); *(uint2*)(sw + voff + i * 4352 + 8) = make_uint2(rv[i].z, rv[i].w);
            }
        }
        __syncthreads();
    }
    const float inv = __builtin_amdgcn_rcpf(l);
    bf16_t* orow = Og + (size_t)(32 * wid + r) * ldo + 4 * hh;
#pragma unroll
    for (int db = 0; db < 4; ++db)
#pragma unroll
        for (int gq = 0; gq < 4; ++gq)
            *(uint2*)(orow + db * 32 + 8 * gq) = make_uint2(pack_bf16(o[db][4 * gq] * inv, o[db][4 * gq + 1] * inv), pack_bf16(o[db][4 * gq + 2] * inv, o[db][4 * gq + 3] * inv));
}
__device__ void attn_win_unit(const Params& p, int u, unsigned char* smem) {
    const int gh = u % 3, qb = (u / 3) % 16, kvh = (u / 48) % 2, b = u / 96, head = kvh * 3 + gh;
    const int q0 = qb * 128;
    const int ks = q0 - 128 < 0 ? 0 : q0 - 128, ke = q0 + 256 > S_ ? S_ : q0 + 256;
    bf16_t* Q = (bf16_t*)(p.ws + OFF_QA) + (size_t)(b * S_ + q0) * 768 + head * 128;
    const bf16_t* Kb = (const bf16_t*)(p.ws + OFF_KA) + (size_t)(b * S_) * 256 + kvh * 128;
    const bf16_t* Vt = (const bf16_t*)(p.ws + OFF_VAT) + (size_t)(b * 2 + kvh) * 128 * S_;
    attn_block<true>(Q, 768, Kb, 256, Vt, S_, q0, ks / 64, (ke - ks) / 64, p.attn_sink[head] * 1.4426950408889634f, Q, 768, smem);
}
__device__ void attn_mem_unit(const Params& p, int u, unsigned char* smem) {
    const int qb = u % 16, head = (u / 16) % 4, b = u / 64;
    const int q0 = qb * 128;
    unsigned char* dob = (unsigned char*)p.out;
    bf16_t* Q = (bf16_t*)(p.ws + OFF_QM) + (size_t)(b * S_ + q0) * 512 + head * 128;
    const bf16_t* Kb = (const bf16_t*)(dob + DO_KM) + (size_t)(b * MEML) * 512 + head * 128;
    const bf16_t* Vt = (const bf16_t*)(dob + DO_VMT) + (size_t)(b * 4 + head) * 128 * MEML;
    attn_block<false>(Q, 512, Kb, 512, Vt, MEML, q0, 0, 4, 0.f, Q, 512, smem);
}

typedef _Float16 f16x2v __attribute__((ext_vector_type(2)));
__device__ __forceinline__ unsigned pack_f16(float lo, float hi) { return __builtin_bit_cast(unsigned, __builtin_amdgcn_cvt_pkrtz(lo, hi)); }
template <bool FINAL>
__device__ void lru_chunk_unit(const Params& p, int u, unsigned char* smem) {
    const int tid = tidx(), lane = tid & 63, wid = tid >> 6, li = lane & 15, g = lane >> 4;
    const int c = u & 15, h = (u >> 4) % 6, b = u / 96;
    const int cbase = h * 128, s0 = c * 128;
    unsigned char* xcs = smem; unsigned char* LB = smem + 32768; float2* SA = (float2*)(smem + 49152); unsigned char* WL = smem + 51200; float* CC = (float*)(smem + 67584);
    const bf16_t* Xl = (const bf16_t*)(p.ws + OFF_XL) + (size_t)(b * S_) * 768;
    bf16_t* Gl = (bf16_t*)(p.ws + OFF_GL) + (size_t)(b * S_ + s0) * 768;
    const bf16_t* LruWt = (const bf16_t*)(p.ws + OFF_LRUWT) + (size_t)h * 512 * 128;
    const float* SP8 = (const float*)(p.ws + OFF_SP8);
    float2* AGG = (float2*)(p.ws + OFF_AGG);
    bf16_t* LCF = (bf16_t*)((unsigned char*)p.out + DO_LCF) + (size_t)(b * S_ + s0) * 768; bf16_t* LCB = (bf16_t*)(p.ws + OFF_LCB) + (size_t)(b * S_ + s0) * 768;
    auto stage_w = [&](int hc_, int d_) {
#pragma unroll
        for (int i = 0; i < 4; ++i) {
            const int rr = (tid >> 4) + 16 * i, n = rr >> 4, wrow = ((n >> 1) * 2 + d_) * 128 + hc_ * 32 + 16 * (n & 1) + (rr & 15);
            __builtin_amdgcn_global_load_lds((const unsigned*)(LruWt + (size_t)wrow * 128 + (((tid & 15) ^ (rr & 15)) << 3)), (unsigned*)(WL + tid * 16 + i * 4096), 16, 0, 0);
        }
    };
    __syncthreads();
    {
        const int cp = tid & 63, tq = tid >> 6, cch = cbase + 2 * cp;
        float cw[4][2];
#pragma unroll
        for (int j = 0; j < 4; ++j) { cw[j][0] = p.conv_w[j * LW + cch]; cw[j][1] = p.conv_w[j * LW + cch + 1]; }
        const float cb0 = p.conv_b[cch], cb1 = p.conv_b[cch + 1];
#pragma unroll
        for (int hf = 0; hf < 2; ++hf) {
            const int tb = 32 * tq + 16 * hf;
            unsigned xw[19];
#pragma unroll
            for (int i = 0; i < 19; ++i) {
                const int s = s0 + tb + i - 2, sc = s < 0 ? 0 : (s > S_ - 1 ? S_ - 1 : s);
                xw[i] = *(const unsigned*)(Xl + (size_t)sc * 768 + cch);
            }
            PIN15(xw, 0); PIN4(xw, 15);
#pragma unroll
            for (int i = 0; i < 19; ++i) { const int s = s0 + tb + i - 2; xw[i] = (s >= 0 && s < S_) ? xw[i] : 0u; }
#pragma unroll
            for (int i = 0; i < 16; ++i) {
                const int t = tb + i;
                const float y0 = cb0 + cw[0][0] * bflo(xw[i]) + cw[1][0] * bflo(xw[i + 1]) + cw[2][0] * bflo(xw[i + 2]) + cw[3][0] * bflo(xw[i + 3]);
                const float y1 = cb1 + cw[0][1] * bfhi(xw[i]) + cw[1][1] * bfhi(xw[i + 1]) + cw[2][1] * bfhi(xw[i + 2]) + cw[3][1] * bfhi(xw[i + 3]);
                *(unsigned*)(xcs + t * 256 + (((cp >> 2) ^ (t & 15)) << 4) + (cp & 3) * 4) = pack_bf16(y0, y1);
            }
        }
    }
    const int sch = tid & 31, seg = tid >> 5;
    float4 cst[2][3];
    auto load_cst = [&](int hc_, int d_) {
#pragma unroll
        for (int n = 0; n < 2; ++n) {
            const int gch = cbase + hc_ * 32 + 16 * n + 4 * g;
            cst[n][0] = *(const float4*)(p.lru_br + d_ * LW + gch); cst[n][1] = *(const float4*)(p.lru_bi + d_ * LW + gch); cst[n][2] = *(const float4*)(SP8 + d_ * LW + gch);
        }
    };
    stage_w(0, 0);
    __syncthreads();
#pragma unroll 1
    for (int hc = 0; hc < 4; ++hc) {
        float hfv[16], pfv[16];
#pragma unroll
        for (int d = 0; d < 2; ++d) {
            load_cst(hc, d);
            f32x4 acc[2][4];
#pragma unroll
            for (int m = 0; m < 2; ++m)
#pragma unroll
                for (int n = 0; n < 4; ++n) acc[m][n] = (f32x4){0.f, 0.f, 0.f, 0.f};
#pragma unroll
            for (int ks = 0; ks < 4; ++ks) {
                bf16x8 xf[2];
#pragma unroll
                for (int m = 0; m < 2; ++m) { const int row = 32 * wid + 16 * m + li; xf[m] = *(const bf16x8*)(xcs + row * 256 + (((ks * 4 + g) ^ (row & 15)) << 4)); }
#pragma unroll
                for (int n = 0; n < 4; ++n) {
                    const int rr = 16 * n + li;
                    const bf16x8 wf = *(const bf16x8*)(WL + rr * 256 + (((ks * 4 + g) ^ li) << 4));
#pragma unroll
                    for (int m = 0; m < 2; ++m) acc[m][n] = mfma16(wf, xf[m], acc[m][n]);
                }
            }
#pragma unroll
            for (int n = 0; n < 2; ++n) {
                const int ch4 = 16 * n + 4 * g;
                const float4 br4 = cst[n][0], bi4 = cst[n][1], sp4 = cst[n][2];
                const float brv[4] = {br4.x, br4.y, br4.z, br4.w}, biv[4] = {bi4.x, bi4.y, bi4.z, bi4.w}, spv[4] = {sp4.x, sp4.y, sp4.z, sp4.w};
#pragma unroll
                for (int m = 0; m < 2; ++m) {
                    const int tok = 32 * wid + 16 * m + li;
                    const uint2 xq = *(const uint2*)(xcs + tok * 256 + ((((hc * 32 + ch4) >> 3) ^ (tok & 15)) << 4) + (g & 1) * 8);
                    const float xc[4] = {bflo(xq.x), bfhi(xq.x), bflo(xq.y), bfhi(xq.y)};
                    unsigned w[4];
#pragma unroll
                    for (int r = 0; r < 4; ++r) {
                        const float rg = sigmoidf_(acc[m][n][r] + brv[r]), ig = sigmoidf_(acc[m][n + 2][r] + biv[r]);
                        const float la = spv[r] * rg, a = __builtin_amdgcn_exp2f(la);
                        const float bx = __builtin_amdgcn_sqrtf(fmaxf(1.0f - a * a, 0.f)) * (ig * xc[r]);
                        w[r] = pack_f16(la, bx);
                    }
                    *(uint4*)(LB + tok * 128 + (((ch4 >> 2) ^ (tok & 7)) << 4)) = make_uint4(w[0], w[1], w[2], w[3]);
                }
            }
            __syncthreads();
            if (!(hc == 3 && d == 1)) stage_w(d ? hc + 1 : hc, d ^ 1);
            const int gch = cbase + hc * 32 + sch;
            {
                float L = 0.f, H = 0.f;
#pragma unroll
                for (int k = 0; k < 16; ++k) {
                    const int tok = 16 * seg + (d ? 15 - k : k);
                    const unsigned w = *(const unsigned*)(LB + tok * 128 + (((sch >> 2) ^ (tok & 7)) << 4) + (sch & 3) * 4);
                    const f16x2v hv = __builtin_bit_cast(f16x2v, w);
                    const float la = (float)hv.x, bx = (float)hv.y;
                    H = __builtin_amdgcn_exp2f(la) * H + bx; L += la;
                }
                SA[seg * 32 + sch] = make_float2(L, H);
            }
            __syncthreads();
            if (seg == 0) {
                float L = 0.f, H = 0.f;
#pragma unroll
                for (int s = 0; s < 8; ++s) { const float2 a = SA[(d ? 7 - s : s) * 32 + sch]; H = __builtin_amdgcn_exp2f(a.x) * H + a.y; L += a.x; }
                AGG[((size_t)(d * B_ + b) * 16 + c) * 768 + gch] = make_float2(L, H);
            }
            {
                float H = 0.f, Lc = 0.f;
#pragma unroll
                for (int ss = 0; ss < 8; ++ss) {
                    const int s = d ? 7 - ss : ss;
                    const bool on = d ? (s > seg) : (s < seg);
                    const float2 a = SA[s * 32 + sch];
                    H = __builtin_amdgcn_exp2f(on ? a.x : 0.f) * H + (on ? a.y : 0.f); Lc += on ? a.x : 0.f;
                }
                bf16_t* gp = Gl + (size_t)(16 * seg) * 768 + gch;
                float gv[16];
                if (d) {
                    unsigned gr[16];
#pragma unroll
                    for (int k = 0; k < 16; ++k) gr[k] = gp[(size_t)k * 768];
                    PIN8(gr, 0); PIN8(gr, 8);
#pragma unroll
                    for (int k = 0; k < 16; ++k) gv[k] = __uint_as_float(gr[k] << 16);
                }
                bf16_t* cfp = LCF + (size_t)(16 * seg) * 768 + gch; bf16_t* cbp = LCB + (size_t)(16 * seg) * 768 + gch;
#pragma unroll
                for (int k = 0; k < 16; ++k) {
                    const int kk = d ? 15 - k : k, tok = 16 * seg + kk;
                    const unsigned w = *(const unsigned*)(LB + tok * 128 + (((sch >> 2) ^ (tok & 7)) << 4) + (sch & 3) * 4);
                    const f16x2v hv = __builtin_bit_cast(f16x2v, w);
                    const float la = (float)hv.x;
                    H = __builtin_amdgcn_exp2f(la) * H + (float)hv.y; Lc += la;
                    const float P = __builtin_amdgcn_exp2f(Lc);
                    if (d == 0) { hfv[kk] = H; pfv[kk] = P; }
                    else {
                        hfv[kk] = (hfv[kk] + H) * gv[kk];
                        cfp[(size_t)kk * 768] = f2bf(pfv[kk] * gv[kk]);
                        cbp[(size_t)kk * 768] = f2bf(P * gv[kk]);
                    }
                }
                if (d) {
#pragma unroll
                    for (int k = 0; k < 16; ++k) gp[(size_t)k * 768] = f2bf(hfv[k]);
                }
            }
            __syncthreads();
        }
    }
}


__device__ void lru_fixup_unit(const Params& p, int u) {
    const int tid = tidx(), cp = tid & 63, tq = tid >> 6;
    const int c = u & 15, h = (u >> 4) % 6, b = u / 96, cch = h * 128 + 2 * cp, s0 = c * 128;
    const float2* AGG = (const float2*)(p.ws + OFF_AGG);
    float hin[2][2];
#pragma unroll
    for (int d = 0; d < 2; ++d) {
        f32x4 av[16];
#pragma unroll
        for (int j = 0; j < 16; ++j) av[j] = *(const f32x4*)(AGG + ((size_t)(d * B_ + b) * 16 + j) * 768 + cch);
        PIN8(av, 0); PIN8(av, 8);
        float H0 = 0.f, H1 = 0.f;
#pragma unroll
        for (int jj = 0; jj < 16; ++jj) {
            const int j = d ? 15 - jj : jj;
            const bool on = d ? (j > c) : (j < c);
            H0 = __builtin_amdgcn_exp2f(on ? av[j][0] : 0.f) * H0 + (on ? av[j][1] : 0.f);
            H1 = __builtin_amdgcn_exp2f(on ? av[j][2] : 0.f) * H1 + (on ? av[j][3] : 0.f);
        }
        hin[d][0] = H0; hin[d][1] = H1;
    }
    const size_t base = (size_t)(b * S_ + s0 + 32 * tq) * 768 + cch;
    bf16_t* Gl = (bf16_t*)(p.ws + OFF_GL) + base;
    const bf16_t* LCF = (const bf16_t*)((const unsigned char*)p.out + DO_LCF) + base; const bf16_t* LCB = (const bf16_t*)(p.ws + OFF_LCB) + base;
#pragma unroll 1
    for (int g8 = 0; g8 < 4; ++g8) {
        unsigned sv[8], fv[8], bv[8];
#pragma unroll
        for (int i = 0; i < 8; ++i) { const size_t o = (size_t)(g8 * 8 + i) * 768; sv[i] = *(const unsigned*)(Gl + o); fv[i] = *(const unsigned*)(LCF + o); bv[i] = *(const unsigned*)(LCB + o); }
        PIN8(sv, 0); PIN8(fv, 0); PIN8(bv, 0);
#pragma unroll
        for (int i = 0; i < 8; ++i) {
            const float o0 = bflo(sv[i]) + bflo(fv[i]) * hin[0][0] + bflo(bv[i]) * hin[1][0];
            const float o1 = bfhi(sv[i]) + bfhi(fv[i]) * hin[0][1] + bfhi(bv[i]) * hin[1][1];
            *(unsigned*)(Gl + (size_t)(g8 * 8 + i) * 768) = pack_bf16(o0, o1);
        }
    }
}

__device__ void merge_tile(const Params& p, int rt, int ct, unsigned char* smem, GemmPipe& pp, bool hn, int nrt, int nct) {
    unsigned char* ws = p.ws;
    const int row0 = rt * 128, col0 = ct * 128;
    uint4 tot[4][2];
    const bf16_t* G = (const bf16_t*)(ws + OFF_GATES);
    const int lane = tidx() & 63, wid = tidx() >> 6, wr = wid >> 1, wc = wid & 1, li = lane & 15, g = lane >> 4;
#pragma unroll 1
    for (int br = 0; br < 3; ++br) {
        const bf16_t* Ab = (const bf16_t*)(ws + (br == 0 ? OFF_QA : (br == 1 ? OFF_GL : OFF_QM)));
        const bf16_t* Bb = (const bf16_t*)(ws + (br == 0 ? OFF_PATTNT : (br == 1 ? OFF_PLRUT : OFF_PMEMT)));
        const int Kb = br == 2 ? 512 : 768;
        const int nbr = br == 2 ? 0 : br + 1, nr0 = br == 2 ? nrt * 128 : row0, nc0 = br == 2 ? nct * 128 : col0, nKb = nbr == 2 ? 512 : 768;
        const bf16_t* nAb = (const bf16_t*)(ws + (nbr == 0 ? OFF_QA : (nbr == 1 ? OFF_GL : OFF_QM)));
        const bf16_t* nBb = (const bf16_t*)(ws + (nbr == 0 ? OFF_PATTNT : (nbr == 1 ? OFF_PLRUT : OFF_PMEMT)));
        const GemmOp op{Ab + (size_t)row0 * Kb, Bb + (size_t)col0 * Kb, Kb, Kb};
        const GemmOp nx{nAb + (size_t)nr0 * nKb, nBb + (size_t)nc0 * nKb, nKb, nKb};
        f32x4 acc[4][4]; acc_zero(acc);
        gemm_tile(op, Kb, acc, smem, pp);
        u32x4 gva[8];
#pragma unroll
        for (int m = 0; m < 4; ++m)
#pragma unroll
            for (int pq = 0; pq < 2; ++pq) {
                const int r = wr * 64 + m * 16 + li, c = wc * 64 + 32 * pq + 8 * g;
                gva[m * 2 + pq] = *(const u32x4*)(G + (size_t)(row0 + r) * 3072 + br * 1024 + col0 + c);
            }
        PIN8(gva, 0);
        if (br < 2 || hn) gemm_prefetch(nx, smem, pp);
#pragma unroll
        for (int m = 0; m < 4; ++m)
#pragma unroll
            for (int pp = 0; pp < 2; ++pp) {
                const uint4 gv = make_uint4(gva[m * 2 + pp][0], gva[m * 2 + pp][1], gva[m * 2 + pp][2], gva[m * 2 + pp][3]);
                float v[8];
                v[0] = bflo(gv.x) * acc[m][2 * pp][0]; v[1] = bfhi(gv.x) * acc[m][2 * pp][1];
                v[2] = bflo(gv.y) * acc[m][2 * pp][2]; v[3] = bfhi(gv.y) * acc[m][2 * pp][3];
                v[4] = bflo(gv.z) * acc[m][2 * pp + 1][0]; v[5] = bfhi(gv.z) * acc[m][2 * pp + 1][1];
                v[6] = bflo(gv.w) * acc[m][2 * pp + 1][2]; v[7] = bfhi(gv.w) * acc[m][2 * pp + 1][3];
                if (br > 0) {
                    const uint4 t = tot[m][pp];
                    v[0] += bflo(t.x); v[1] += bfhi(t.x); v[2] += bflo(t.y); v[3] += bfhi(t.y);
                    v[4] += bflo(t.z); v[5] += bfhi(t.z); v[6] += bflo(t.w); v[7] += bfhi(t.w);
                }
                tot[m][pp] = make_uint4(pack_bf16(v[0], v[1]), pack_bf16(v[2], v[3]), pack_bf16(v[4], v[5]), pack_bf16(v[6], v[7]));
            }
    }
    bf16_t* dst = (bf16_t*)(ws + OFF_MERGED) + col0;
#pragma unroll
    for (int m = 0; m < 4; ++m)
#pragma unroll
        for (int pp = 0; pp < 2; ++pp) {
            const int r = wr * 64 + m * 16 + li, c = wc * 64 + 32 * pp + 8 * g;
            *(uint4*)(dst + (size_t)(row0 + r) * 1024 + c) = tot[m][pp];
        }
}
__device__ void outproj_tile(const Params& p, int rt, int ct, unsigned char* smem, GemmPipe& pp, bool hn, int nrt, int nct) {
    const int row0 = rt * 128, col0 = ct * 128;
    f32x4 acc[4][4]; acc_zero(acc);
    const GemmOp op{(const bf16_t*)(p.ws + OFF_MERGED) + (size_t)row0 * 1024, (const bf16_t*)(p.ws + OFF_WOUTT) + (size_t)col0 * 1024, 1024, 1024};
    const GemmOp nx{(const bf16_t*)(p.ws + OFF_MERGED) + (size_t)nrt * 128 * 1024, (const bf16_t*)(p.ws + OFF_WOUTT) + (size_t)nct * 128 * 1024, 1024, 1024};
    gemm_tile(op, 1024, acc, smem, pp);
    f32x4 xv[16];
    {
        const int lane_ = tidx() & 63, wid_ = tidx() >> 6;
#pragma unroll
        for (int m = 0; m < 4; ++m)
#pragma unroll
            for (int pq = 0; pq < 2; ++pq) {
                const size_t o = (size_t)(row0 + (wid_ >> 1) * 64 + m * 16 + (lane_ & 15)) * 1024 + col0 + (wid_ & 1) * 64 + 32 * pq + 8 * (lane_ >> 4);
                xv[(m * 2 + pq) * 2] = *(const f32x4*)(p.x + o); xv[(m * 2 + pq) * 2 + 1] = *(const f32x4*)(p.x + o + 4);
            }
        PIN8(xv, 0); PIN8(xv, 8);
    }
    if (hn) gemm_prefetch(nx, smem, pp);
    epi_foreach(acc, [&](int r, int c, float (&v)[8], int pq, int mq) {
        const size_t o = (size_t)(row0 + r) * 1024 + col0 + c;
        const f32x4 x0 = xv[(mq * 2 + pq) * 2], x1 = xv[(mq * 2 + pq) * 2 + 1];
        *(float4*)(p.out + o) = make_float4(x0[0] + v[0], x0[1] + v[1], x0[2] + v[2], x0[3] + v[3]);
        *(float4*)(p.out + o + 4) = make_float4(x1[0] + v[4], x1[1] + v[5], x1[2] + v[6], x1[3] + v[7]);
    });
}

__device__ void peerq_tile(const Params& p, int rt, int ct, unsigned char* smem, GemmPipe& pp, bool hn, int nrt, int nct) {
    const int row0 = rt * 128, col0 = ct * 128;
    f32x4 acc[4][4]; acc_zero(acc);
    const GemmOp op{(const bf16_t*)(p.ws + OFF_MERGED) + (size_t)row0 * 1024, (const bf16_t*)(p.ws + OFF_WPQT) + (size_t)col0 * 1024, 1024, 1024};
    const GemmOp nx{(const bf16_t*)(p.ws + OFF_MERGED) + (size_t)nrt * 128 * 1024, (const bf16_t*)(p.ws + OFF_WPQT) + (size_t)nct * 128 * 1024, 1024, 1024};
    gemm_tile(op, 1024, acc, smem, pp);
    if (hn) gemm_prefetch(nx, smem, pp);
    bf16_t* dst = (bf16_t*)(p.ws + OFF_QPEER) + col0;
    epi_foreach(acc, [&](int r, int c, float (&v)[8], int, int) { store_bf16x8(dst + (size_t)(row0 + r) * 2048 + c, v); });
}

__device__ __forceinline__ int sortable(float v) { int k = __float_as_int(v); return k ^ ((k >> 31) & 0x7fffffff); }
__device__ __forceinline__ float unsortable(int k) { return __int_as_float(k ^ ((k >> 31) & 0x7fffffff)); }
__device__ __forceinline__ void insert16(int (&lst)[16], int x) {
#pragma unroll
    for (int k = 0; k < 16; ++k) { const int hi = max(lst[k], x); x = min(lst[k], x); lst[k] = hi; }
}
__device__ __forceinline__ void cex_desc(int& a, int& b) { const int hi = max(a, b), lo = min(a, b); a = hi; b = lo; }
__device__ __forceinline__ void sort16_desc(int (&a)[16]) {
#pragma unroll
    for (int k = 2; k <= 16; k <<= 1)
#pragma unroll
        for (int j = k >> 1; j >= 1; j >>= 1)
#pragma unroll
            for (int i = 0; i < 16; ++i) {
                const int l = i ^ j;
                if (l > i) { if ((i & k) == 0) cex_desc(a[i], a[l]); else cex_desc(a[l], a[i]); }
            }
}
__device__ __forceinline__ void merge16_desc(int (&a)[16], const int (&b)[16]) {
#pragma unroll
    for (int k = 0; k < 16; ++k) a[k] = max(a[k], b[15 - k]);
#pragma unroll
    for (int s = 8; s >= 1; s >>= 1)
#pragma unroll
        for (int k = 0; k < 16; ++k)
            if ((k & s) == 0) cex_desc(a[k], a[k + s]);
}
__device__ __forceinline__ void scores_half(const Params& p, int row0, int pq, unsigned char* smem, int (&lst)[16]) {
    f32x4 acc[4][4]; acc_zero(acc);
    const GemmOp op{(const bf16_t*)(p.ws + OFF_QPEER) + (size_t)row0 * 2048 + pq * 128, (const bf16_t*)(p.ws + OFF_SUBK) + (size_t)pq * 128 * 128, 2048, 128};
    GemmPipe pp{0, false};
    gemm_tile(op, 128, acc, smem, pp);
    float* sc = (float*)smem;
    __syncthreads();
    epi_foreach(acc, [&](int r, int c, float (&v)[8], int, int) {
        *(float4*)(sc + r * 132 + c) = make_float4(v[0], v[1], v[2], v[3]);
        *(float4*)(sc + r * 132 + c + 4) = make_float4(v[4], v[5], v[6], v[7]); });
    __syncthreads();
    const int t = tidx(), r = t & 127, hf = t >> 7;
    {
        int g1[16], g2[16], g3[16];
        auto load16 = [&](int (&g)[16], int q) {
#pragma unroll
            for (int j4 = 0; j4 < 4; ++j4) {
                const int j = hf * 64 + q * 16 + j4 * 4;
                const float4 v = *(const float4*)(sc + r * 132 + j);
                g[4 * j4] = (sortable(v.x) & ~127) | j; g[4 * j4 + 1] = (sortable(v.y) & ~127) | (j + 1);
                g[4 * j4 + 2] = (sortable(v.z) & ~127) | (j + 2); g[4 * j4 + 3] = (sortable(v.w) & ~127) | (j + 3);
            }
        };
        load16(lst, 0); sort16_desc(lst); load16(g1, 1); sort16_desc(g1); merge16_desc(lst, g1);
        load16(g2, 2); sort16_desc(g2); load16(g3, 3); sort16_desc(g3); merge16_desc(g2, g3);
        merge16_desc(lst, g2);
    }
    __syncthreads();
    int* ls = (int*)smem;
    if (hf) {
#pragma unroll
        for (int k = 0; k < 16; ++k) ls[t * 16 + k] = lst[15 - k];
    }
    __syncthreads();
    if (!hf) {
        int ob[16];
#pragma unroll
        for (int k = 0; k < 16; ++k) ob[15 - k] = ls[(t + 128) * 16 + k];
        merge16_desc(lst, ob);
    }
    __syncthreads();
}
__device__ void scores_tile(const Params& p, int rt, int hd, unsigned char* smem) {
    const int row0 = rt * 128;
    int k0[16], k1[16];
    scores_half(p, row0, 2 * hd, smem, k0);
    scores_half(p, row0, 2 * hd + 1, smem, k1);
    const int t = tidx();
    int* ls = (int*)smem;
    if (t < 128) {
#pragma unroll
        for (int k = 0; k < 16; ++k) { ls[t * 32 + k] = k0[k]; ls[t * 32 + 16 + k] = k1[k]; }
        float v0[16], v1[16];
#pragma unroll
        for (int i = 0; i < 16; ++i) { v0[i] = unsortable(k0[i] & ~127); v1[i] = unsortable(k1[i] & ~127); }
        int lst[16], g1[16], g2[16], g3[16];
#pragma unroll
        for (int b = 0; b < 16; ++b) lst[b] = (sortable(v0[0] + v1[b]) & ~255) | b;
        {
            int n = 0;
#pragma unroll
            for (int a = 1; a < 16; ++a)
#pragma unroll
                for (int b = 0; b < 16; ++b)
                    if ((a + 1) * (b + 1) <= 16) {
                        const int key = (sortable(v0[a] + v1[b]) & ~255) | (a * 16 + b);
                        if (n < 16) g1[n] = key; else if (n < 32) g2[n - 16] = key; else g3[n - 32] = key;
                        ++n;
                    }
#pragma unroll
            for (int k = 2; k < 16; ++k) g3[k] = (int)0x80000000;
        }
        sort16_desc(lst); sort16_desc(g1); merge16_desc(lst, g1);
        sort16_desc(g2); sort16_desc(g3); merge16_desc(g2, g3);
        merge16_desc(lst, g2);
        float val[16], sum = 0.f;
        const float mx = unsortable(lst[0] & ~255);
#pragma unroll
        for (int k = 0; k < 16; ++k) { val[k] = __expf(unsortable(lst[k] & ~255) - mx); sum += val[k]; }
        const float inv = 1.0f / sum;
        const int tok = row0 + t;
        int* ei = (int*)(p.ws + OFF_EIDX) + (size_t)tok * 128 + hd * 16;
        float* eg = (float*)(p.ws + OFF_EGATE) + (size_t)tok * 128 + hd * 16;
#pragma unroll
        for (int k = 0; k < 16; ++k) {
            const int code = lst[k] & 255, a = code >> 4, b = code & 15;
            ei[k] = (ls[t * 32 + a] & 127) * 128 + (ls[t * 32 + 16 + b] & 127);
            eg[k] = val[k] * inv;
        }
    }
    __syncthreads();
}

__device__ __forceinline__ void conv_row_fp8(const float* __restrict__ src, unsigned char* __restrict__ dst, float* __restrict__ scale, int row, int lane) {
    const float4* s = (const float4*)(src + (size_t)row * 1024 + lane * 16);
    float4 v[4]; float am = 0.f;
#pragma unroll
    for (int i = 0; i < 4; ++i) { v[i] = s[i]; am = fmaxf(am, fmaxf(fmaxf(fabsf(v[i].x), fabsf(v[i].y)), fmaxf(fabsf(v[i].z), fabsf(v[i].w)))); }
#pragma unroll
    for (int o = 32; o >= 1; o >>= 1) am = fmaxf(am, __shfl_xor(am, o));
    const float sc = am > 0.f ? am * (1.0f / 224.0f) : 1.0f, inv = 1.0f / sc;
    unsigned w[4];
#pragma unroll
    for (int i = 0; i < 4; ++i) {
        int t = __builtin_amdgcn_cvt_pk_fp8_f32(v[i].x * inv, v[i].y * inv, 0, false);
        t = __builtin_amdgcn_cvt_pk_fp8_f32(v[i].z * inv, v[i].w * inv, t, true);
        w[i] = (unsigned)t;
    }
    *(uint4*)(dst + (size_t)row * 1024 + lane * 16) = make_uint4(w[0], w[1], w[2], w[3]);
    if (lane == 0) scale[row] = sc;
}
__device__ __forceinline__ void load8rows(uint4 (&R)[8], const unsigned char* __restrict__ tab, int es, int l0, int lane) {
#pragma unroll
    for (int j = 0; j < 8; ++j) {
        const int id = __builtin_amdgcn_readlane(es, l0 + j);
        R[j] = *(const uint4*)(tab + (size_t)id * 1024 + lane * 16);
    }
}
__device__ __forceinline__ float dot16q(const uint4& r, const float (&h)[16]) {
    const unsigned q[4] = {r.x, r.y, r.z, r.w};
    float d0 = 0.f, d1 = 0.f;
#pragma unroll
    for (int i = 0; i < 4; ++i) {
        const f32x2v a = __builtin_amdgcn_cvt_pk_f32_fp8((int)q[i], false), b = __builtin_amdgcn_cvt_pk_f32_fp8((int)q[i], true);
        d0 += a.x * h[4 * i]; d1 += a.y * h[4 * i + 1]; d0 += b.x * h[4 * i + 2]; d1 += b.y * h[4 * i + 3];
    }
    return d0 + d1;
}
__device__ __forceinline__ float dots8(const uint4 (&R)[8], const float (&h)[16], int lane) {
    float pd[8];
#pragma unroll
    for (int j = 0; j < 8; ++j) pd[j] = dot16q(R[j], h);
    const bool b5 = (lane & 32) != 0, b4 = (lane & 16) != 0, b3 = (lane & 8) != 0;
    float a[4];
#pragma unroll
    for (int j = 0; j < 4; ++j) { const float keep = b5 ? pd[4 + j] : pd[j], send = b5 ? pd[j] : pd[4 + j]; a[j] = keep + __shfl_xor(send, 32); }
    float c[2];
#pragma unroll
    for (int j = 0; j < 2; ++j) { const float keep = b4 ? a[2 + j] : a[j], send = b4 ? a[j] : a[2 + j]; c[j] = keep + __shfl_xor(send, 16); }
    float kk;
    { const float keep = b3 ? c[1] : c[0], send = b3 ? c[0] : c[1]; kk = keep + __shfl_xor(send, 8); }
    kk += __shfl_xor(kk, 4); kk += __shfl_xor(kk, 2); kk += __shfl_xor(kk, 1);
    return kk;
}
__device__ __forceinline__ void axpy8(float (&o)[16], const uint4 (&R)[8], int wsr, int bb) {
#pragma unroll
    for (int j = 0; j < 8; ++j) {
        const float c = __int_as_float(__builtin_amdgcn_readlane(wsr, 8 * j + bb));
        const unsigned q[4] = {R[j].x, R[j].y, R[j].z, R[j].w};
#pragma unroll
        for (int i = 0; i < 4; ++i) {
            const f32x2v a = __builtin_amdgcn_cvt_pk_f32_fp8((int)q[i], false), b = __builtin_amdgcn_cvt_pk_f32_fp8((int)q[i], true);
            o[4 * i] += c * a.x; o[4 * i + 1] += c * a.y; o[4 * i + 2] += c * b.x; o[4 * i + 3] += c * b.y;
        }
    }
}
__device__ void gather_token(const Params& p, int tok, int lane) {
    const bf16_t* h2 = (const bf16_t*)(p.ws + OFF_MERGED) + (size_t)tok * 1024 + lane * 16;
    const unsigned char* Uq = p.ws + OFF_UB; const unsigned char* Vq = p.ws + OFF_VB;
    const float* SU = (const float*)(p.ws + OFF_SU); const float* SV = (const float*)(p.ws + OFF_SV);
    const int* ei = (const int*)(p.ws + OFF_EIDX) + (size_t)tok * 128;
    const float* eg = (const float*)(p.ws + OFF_EGATE) + (size_t)tok * 128;
    float h[16];
    {
        const uint4 ha = *(const uint4*)h2, hb = *(const uint4*)(h2 + 8);
        const unsigned hq[8] = {ha.x, ha.y, ha.z, ha.w, hb.x, hb.y, hb.z, hb.w};
#pragma unroll
        for (int e = 0; e < 8; ++e) { h[2 * e] = bflo(hq[e]); h[2 * e + 1] = bfhi(hq[e]); }
    }
    const int pe = 8 * (lane & 7) + (lane >> 3);
    int es[2], wsr[2] = {0, 0}; float su[2], gv[2];
#pragma unroll
    for (int k = 0; k < 2; ++k) {
        es[k] = ei[64 * k + lane];
        const int e = ei[64 * k + pe];
        su[k] = SU[e]; gv[k] = eg[64 * k + pe] * SV[e];
    }
    uint4 R0[8], R1[8];
#pragma unroll
    for (int k = 0; k < 2; ++k) {
        load8rows(R0, Uq, es[k], 0, lane);
        for (int bb = 0; bb < 8; bb += 2) {
            load8rows(R1, Uq, es[k], 8 * bb + 8, lane);
            { const float w = gelu_tanh(dots8(R0, h, lane) * su[k]) * gv[k]; if ((lane & 7) == bb) wsr[k] = __float_as_int(w); }
            if (bb + 2 < 8) load8rows(R0, Uq, es[k], 8 * bb + 16, lane);
            { const float w = gelu_tanh(dots8(R1, h, lane) * su[k]) * gv[k]; if ((lane & 7) == bb + 1) wsr[k] = __float_as_int(w); }
        }
    }
    float o[16];
#pragma unroll
    for (int e = 0; e < 16; ++e) o[e] = 0.f;
#pragma unroll
    for (int k = 0; k < 2; ++k) {
        load8rows(R0, Vq, es[k], 0, lane);
        for (int bb = 0; bb < 8; bb += 2) {
            load8rows(R1, Vq, es[k], 8 * bb + 8, lane);
            axpy8(o, R0, wsr[k], bb);
            if (bb + 2 < 8) load8rows(R0, Vq, es[k], 8 * bb + 16, lane);
            axpy8(o, R1, wsr[k], bb + 1);
        }
    }
    float* xr = p.out + (size_t)tok * 1024 + lane * 16;
    float4 x[4]; float ss = 0.f;
#pragma unroll
    for (int i = 0; i < 4; ++i) {
        x[i] = *(const float4*)(xr + 4 * i);
        x[i].x += o[4 * i]; x[i].y += o[4 * i + 1]; x[i].z += o[4 * i + 2]; x[i].w += o[4 * i + 3];
        ss += x[i].x * x[i].x + x[i].y * x[i].y + x[i].z * x[i].z + x[i].w * x[i].w;
    }
    ss = wave_sum(ss);
    const float rs = rsqrtf(ss * (1.0f / 1024.0f) + EPS);
    const float* gf = p.g_final + lane * 16;
#pragma unroll
    for (int i = 0; i < 4; ++i) {
        const float4 gg = *(const float4*)(gf + 4 * i);
        *(float4*)(xr + 4 * i) = make_float4(x[i].x * rs * gg.x, x[i].y * rs * gg.y, x[i].z * rs * gg.z, x[i].w * rs * gg.w);
    }
}


__device__ __forceinline__ void fp8x16_to_f32(const uint4& r, float (&f)[16]) {
    const unsigned q[4] = {r.x, r.y, r.z, r.w};
#pragma unroll
    for (int i = 0; i < 4; ++i) {
        const f32x2v a = __builtin_amdgcn_cvt_pk_f32_fp8((int)q[i], false), b = __builtin_amdgcn_cvt_pk_f32_fp8((int)q[i], true);
        f[4 * i] = a.x; f[4 * i + 1] = a.y; f[4 * i + 2] = b.x; f[4 * i + 3] = b.y;
    }
}
__device__ __forceinline__ float sum8_dpp(float v) {
    v += __int_as_float(__builtin_amdgcn_mov_dpp(__float_as_int(v), 0xB1, 0xF, 0xF, true));
    v += __int_as_float(__builtin_amdgcn_mov_dpp(__float_as_int(v), 0x4E, 0xF, 0xF, true));
    v += __int_as_float(__builtin_amdgcn_mov_dpp(__float_as_int(v), 0x141, 0xF, 0xF, true));
    return v;
}
__device__ __forceinline__ void peer_u_issue(u32x4 (&seg)[8], const unsigned char* Uq, int es, int gq) {
#pragma unroll
    for (int bb = 0; bb < 8; ++bb) { const int id = __shfl(es, 8 * bb + gq); seg[bb] = *(const u32x4*)(Uq + (size_t)id * 1024); }
}
__device__ __forceinline__ float peer_u_half(u32x4 (&seg)[8], const float (&h)[16], int sub) {
    PIN8(seg, 0);
    float z = 0.f;
#pragma unroll
    for (int bb = 0; bb < 8; ++bb) {
        float f[16];
        fp8x16_to_f32(make_uint4(seg[bb][0], seg[bb][1], seg[bb][2], seg[bb][3]), f);
        float d0 = 0.f, d1 = 0.f;
#pragma unroll
        for (int i = 0; i < 8; ++i) { d0 += f[2 * i] * h[2 * i]; d1 += f[2 * i + 1] * h[2 * i + 1]; }
        const float d = sum8_dpp(d0 + d1);
        if (sub == bb) z = d;
    }
    return z;
}
__device__ void peer_u_pass(const Params& p, int t0, int tstep, int x, int lane) {
    const int gq = lane >> 3, sub = lane & 7;
    const int* eib = (const int*)(p.ws + OFF_EIDX);
    const bf16_t* h2b = (const bf16_t*)(p.ws + OFF_XB) + x * 128 + sub * 16;
    const unsigned char* Uq = p.ws + OFF_UB + x * 128 + sub * 16;
    float* Zb = (float*)(p.ws + OFF_ZBUF) + (size_t)x * 128;
    if (t0 >= NTOK) return;
    int es0 = eib[(size_t)t0 * 128 + lane], es1 = eib[(size_t)t0 * 128 + 64 + lane];
    uint4 ha = *(const uint4*)(h2b + (size_t)t0 * 1024), hb = *(const uint4*)(h2b + (size_t)t0 * 1024 + 8);
    u32x4 SA[8], SB[8];
    peer_u_issue(SA, Uq, es0, gq);
    for (int t = t0; t < NTOK; t += tstep) {
        float h[16];
        {
            const unsigned hq[8] = {ha.x, ha.y, ha.z, ha.w, hb.x, hb.y, hb.z, hb.w};
#pragma unroll
            for (int e = 0; e < 8; ++e) { h[2 * e] = bflo(hq[e]); h[2 * e + 1] = bfhi(hq[e]); }
        }
        peer_u_issue(SB, Uq, es1, gq);
        const int tn = t + tstep < NTOK ? t + tstep : t;
        es0 = eib[(size_t)tn * 128 + lane]; es1 = eib[(size_t)tn * 128 + 64 + lane];
        ha = *(const uint4*)(h2b + (size_t)tn * 1024); hb = *(const uint4*)(h2b + (size_t)tn * 1024 + 8);
        const float z0 = peer_u_half(SA, h, sub);
        peer_u_issue(SA, Uq, es0, gq);
        const float z1 = peer_u_half(SB, h, sub);
        float* Z = Zb + (size_t)t * 8 * 128;
        Z[lane] = z0; Z[64 + lane] = z1;
    }
}
__device__ void peer_coef_token(const Params& p, int tok, int lane) {
    const int pe = 8 * (lane & 7) + (lane >> 3);
    const int* ei = (const int*)(p.ws + OFF_EIDX) + (size_t)tok * 128;
    const float* eg = (const float*)(p.ws + OFF_EGATE) + (size_t)tok * 128;
    const float* SU = (const float*)(p.ws + OFF_SU); const float* SV = (const float*)(p.ws + OFF_SV);
    const float* Z = (const float*)(p.ws + OFF_ZBUF) + (size_t)tok * 8 * 128;
    float* W = (float*)(p.ws + OFF_WBUF) + (size_t)tok * 128;
    const float rs = rsqrtf(((const float*)(p.ws + OFF_ROWSS1))[tok] * (1.0f / 1024.0f) + EPS);
#pragma unroll
    for (int k = 0; k < 2; ++k) {
        float zv[8];
#pragma unroll
        for (int x = 0; x < 8; ++x) zv[x] = Z[x * 128 + k * 64 + lane];
        const int e = ei[64 * k + pe];
        const float g = eg[64 * k + pe], su = SU[e], sv = SV[e];
        PIN8(zv, 0);
        const float z = ((zv[0] + zv[1]) + (zv[2] + zv[3])) + ((zv[4] + zv[5]) + (zv[6] + zv[7]));
        W[k * 64 + lane] = gelu_tanh(z * su * rs) * g * sv;
    }
}
#define PINQ(a) asm volatile("" : "+v"((a)[0]), "+v"((a)[1]), "+v"((a)[2]), "+v"((a)[3]))
__device__ __forceinline__ void peer_v_issue4(u32x4 (&seg)[4], const unsigned char* Vq, int es, int gq, int bb0) {
#pragma unroll
    for (int j = 0; j < 4; ++j) { const int id = __shfl(es, 8 * (bb0 + j) + gq); seg[j] = *(const u32x4*)(Vq + (size_t)id * 1024); }
}
__device__ __forceinline__ void peer_v_quarter(u32x4 (&seg)[4], float (&o)[16], float wk, int gq, int bb0) {
    PINQ(seg);
#pragma unroll
    for (int j = 0; j < 4; ++j) {
        const float c = __shfl(wk, 8 * gq + bb0 + j);
        float f[16];
        fp8x16_to_f32(make_uint4(seg[j][0], seg[j][1], seg[j][2], seg[j][3]), f);
#pragma unroll
        for (int i = 0; i < 16; ++i) o[i] += c * f[i];
    }
}
__device__ void peer_v_pass(const Params& p, int t0, int tstep, int x, int lane) {
    const int gq = lane >> 3, sub = lane & 7;
    const int* eib = (const int*)(p.ws + OFF_EIDX);
    const float* Wb = (const float*)(p.ws + OFF_WBUF);
    const unsigned char* Vq = p.ws + OFF_VB + x * 128 + sub * 16;
    if (t0 >= NTOK) return;
    const bool b5 = (lane & 32) != 0, b4 = (lane & 16) != 0, b3 = (lane & 8) != 0;
    const int col = x * 128 + 16 * sub + (b5 ? 8 : 0) + (b4 ? 4 : 0) + (b3 ? 2 : 0);
    int es0 = eib[(size_t)t0 * 128 + lane], es1 = eib[(size_t)t0 * 128 + 64 + lane];
    float wk0 = Wb[(size_t)t0 * 128 + lane], wk1 = Wb[(size_t)t0 * 128 + 64 + lane];
    u32x4 SA[4], SB[4];
    peer_v_issue4(SA, Vq, es0, gq, 0);
    for (int t = t0; t < NTOK; t += tstep) {
        float o[16];
#pragma unroll
        for (int i = 0; i < 16; ++i) o[i] = 0.f;
        const int tn = t + tstep < NTOK ? t + tstep : t;
        const int nes0 = eib[(size_t)tn * 128 + lane], nes1 = eib[(size_t)tn * 128 + 64 + lane];
        const float nwk0 = Wb[(size_t)tn * 128 + lane], nwk1 = Wb[(size_t)tn * 128 + 64 + lane];
        int gl = gq; asm volatile("" : "+v"(gl));
        peer_v_issue4(SB, Vq, es0, gl, 4);  peer_v_quarter(SA, o, wk0, gl, 0);
        peer_v_issue4(SA, Vq, es1, gl, 0);  peer_v_quarter(SB, o, wk0, gl, 4);
        peer_v_issue4(SB, Vq, es1, gl, 4);  peer_v_quarter(SA, o, wk1, gl, 0);
        peer_v_issue4(SA, Vq, nes0, gl, 0); peer_v_quarter(SB, o, wk1, gl, 4);
        es0 = nes0; es1 = nes1; wk0 = nwk0; wk1 = nwk1;
        float a8[8], a4[4], a2[2];
#pragma unroll
        for (int i = 0; i < 8; ++i) { const float keep = b5 ? o[8 + i] : o[i], send = b5 ? o[i] : o[8 + i]; a8[i] = keep + __shfl_xor(send, 32); }
#pragma unroll
        for (int i = 0; i < 4; ++i) { const float keep = b4 ? a8[4 + i] : a8[i], send = b4 ? a8[i] : a8[4 + i]; a4[i] = keep + __shfl_xor(send, 16); }
#pragma unroll
        for (int i = 0; i < 2; ++i) { const float keep = b3 ? a4[2 + i] : a4[i], send = b3 ? a4[i] : a4[2 + i]; a2[i] = keep + __shfl_xor(send, 8); }
        float* xr = p.out + (size_t)t * 1024 + col;
        float2 xv = *(const float2*)xr;
        xv.x += a2[0]; xv.y += a2[1];
        *(float2*)xr = xv;
        const float ss = wave_sum(xv.x * xv.x + xv.y * xv.y);
        if (lane == 0) atomicAdd((float*)(p.ws + OFF_ROWSS) + t, ss);
    }
}
__device__ void final_norm_row(const Params& p, int tok, int lane) {
    float* xr = p.out + (size_t)tok * 1024 + lane * 16;
    const float rs = rsqrtf(((const float*)(p.ws + OFF_ROWSS))[tok] * (1.0f / 1024.0f) + EPS);
    const float* gf = p.g_final + lane * 16;
#pragma unroll
    for (int i = 0; i < 4; ++i) {
        const float4 v = *(const float4*)(xr + 4 * i), gg = *(const float4*)(gf + 4 * i);
        *(float4*)(xr + 4 * i) = make_float4(v.x * rs * gg.x, v.y * rs * gg.y, v.z * rs * gg.z, v.w * rs * gg.w);
    }
}

__device__ __forceinline__ bool gemm_unit(int it, int nct, int& rt, int& ct) {
    const int x = vbid() & 7, j = vbid() >> 3, nbx = vnb() >> 3;
    const int v = j + it * nbx, per_rg = 8 * nct;
    if (v >= 32 * nct) return false;
    const int rgi = v / per_rg, w = v - rgi * per_rg, cg = w >> 6, w2 = w & 63;
    const int rtl = w2 & 7, ctl = w2 >> 3;
    rt = (rgi * 8 + rtl) * 8 + x; ct = cg * 8 + ctl;
    return true;
}


namespace pg8 {
#define PG8_LAS __attribute__((address_space(3)))
constexpr int BM = 256, BK = 64, HALF = 128, HTB = HALF * BK * 2  , STAGE_BYTES = 8 * HTB, NXCD = 8, WGM = 8;

__host__ __device__ __forceinline__ int lds_byte(int r, int c) { const int st = (r >> 4) * 2 + (c >> 5), rr = r & 15, cc = c & 31, ob = rr * 64 + cc * 2; return st * 1024 + (ob ^ (((ob >> 9) & 1) << 5)); }
__host__ __device__ __forceinline__ void stage_rc(int b, int& R, int& C) { const int st = b / 1024, sb = b % 1024, swz = sb ^ (((sb >> 9) & 1) << 5); R = (st >> 1) * 16 + swz / 64; C = (st & 1) * 32 + (swz % 64) / 2; }
__host__ __device__ __forceinline__ int perm32(int rho) { const int n = rho >> 4, i = rho & 15; return 8 * (i >> 2) + 4 * n + (i & 3); }

struct Unit { int pm, pn; };
struct Gemm { const bf16_t* A; const bf16_t* Bt; int M, N, K; };

struct StaticOrder {
    int nM, nN, nwg, G, c;
    __host__ __device__ void init(int M, int N, int G_, int c_) { nM = M / BM; nN = N / BM; nwg = nM * nN; G = G_; c = c_; }
    __host__ __device__ bool next(int i, Unit& u) const {
        const long L = (long)i * G + c; if (L >= nwg) return false;
        int wgid = (int)L; { const int q = nwg / NXCD, r = nwg % NXCD, xcd = wgid % NXCD, off = wgid / NXCD; wgid = (xcd < r ? xcd * (q + 1) : r * (q + 1) + (xcd - r) * q) + off; }
        const int nig = WGM * nN, gid = wgid / nig, fm = gid * WGM, gsz = (nM - fm) < WGM ? (nM - fm) : WGM;
        u.pm = fm + ((wgid % nig) % gsz); u.pn = (wgid % nig) / gsz; return true;
    }
    __device__ __forceinline__ void a_ready(const Unit&) const {}
    __device__ __forceinline__ void done(const Unit&) const {}
};


template <class F> struct EpiFn {
    static constexpr bool PERM = true, AFTER_DRAIN = false;
    F f;
    __device__ __forceinline__ void operator()(const f32x4 (&acc)[2][2][4][2], const Unit& u, int wr, int wc, int fr, int fq) const {
#pragma unroll
        for (int ai = 0; ai < 2; ++ai)
#pragma unroll
            for (int m = 0; m < 4; ++m)
#pragma unroll
                for (int bj = 0; bj < 2; ++bj) {
                    float v[8];
#pragma unroll
                    for (int r = 0; r < 4; ++r) { v[r] = acc[ai][bj][m][0][r]; v[4 + r] = acc[ai][bj][m][1][r]; }
                    f(u.pm * BM + ai * HALF + wr * 64 + m * 16 + fr, u.pn * BM + bj * HALF + wc * 32 + 8 * fq, v);
                }
    }
};
template <class Epi, class Sched, bool ALIGN_EPI = false, bool SP2 = false>
__device__ __forceinline__ void gemm_phase(PG8_LAS unsigned char* lds, const Gemm g, const Sched& S, const Epi& E) {
    int tid_ = threadIdx.x; asm volatile("" : "+v"(tid_));
    const int tid = tid_, wid = __builtin_amdgcn_readfirstlane(tid >> 6), lane = tid & 63, wr = wid >> 2, wc = wid & 3, fr = lane & 15, fq = lane >> 4;
    const int K = g.K, nt = K / BK;
    unsigned voffA[2], voffB[2];
#pragma unroll
    for (int i = 0; i < 2; ++i) { int R, C; stage_rc(tid * 16 + i * 8192, R, C); const int Rb = Epi::PERM ? ((R & ~31) + perm32(R & 31)) : R;
        voffA[i] = (unsigned)(R * K + C) * 2u; voffB[i] = (unsigned)(Rb * K + C) * 2u; }
    const size_t kstep = (size_t)(BK * 2);
    const size_t hstep = (size_t)HALF * K * 2;
    const size_t tstep = 2 * hstep;
    const unsigned ldsw = (unsigned)wid * 1024u;
    const int aoff = lds_byte(wr * 64 + fr, fq * 8), boff = lds_byte(wc * 32 + fr, fq * 8);
#define PG8_SA(b, h) (((b) * 2 + (h)) * HTB)
#define PG8_SB(b, h) ((4 + (b) * 2 + (h)) * HTB)
#define PG8_STAGE(bufoff, gbase, voff) do { _Pragma("unroll") for (int _i = 0; _i < 2; ++_i) \
        __builtin_amdgcn_global_load_lds((const unsigned*)((const char*)(gbase) + (voff)[_i]), (PG8_LAS unsigned*)(lds + (bufoff) + ldsw + _i * 8192), 16, 0, 0); } while (0)
#define PG8_LDA(dst, b, h) do { _Pragma("unroll") for (int m = 0; m < 4; ++m) _Pragma("unroll") for (int k = 0; k < 2; ++k) dst[m][k] = *(const PG8_LAS bf16x8*)(lds + PG8_SA(b, h) + aoff + m * 2048 + k * 1024); } while (0)
#define PG8_LDB(dst, b, h) do { _Pragma("unroll") for (int n = 0; n < 2; ++n) _Pragma("unroll") for (int k = 0; k < 2; ++k) dst[n][k] = *(const PG8_LAS bf16x8*)(lds + PG8_SB(b, h) + boff + n * 2048 + k * 1024); } while (0)
#define PG8_MMA(ai, bj, At, Bt) do { __builtin_amdgcn_s_setprio(1); _Pragma("unroll") for (int m = 0; m < 4; ++m) _Pragma("unroll") for (int n = 0; n < 2; ++n) _Pragma("unroll") for (int k = 0; k < 2; ++k) \
        acc[ai][bj][m][n] = __builtin_amdgcn_mfma_f32_16x16x32_bf16(Bt[n][k], At[m][k], acc[ai][bj][m][n], 0, 0, 0); __builtin_amdgcn_s_setprio(0); } while (0)
#define PG8_WAIT_V(n) asm volatile("s_waitcnt vmcnt(" #n ")" ::: "memory")
#define PG8_WAIT_L(n) asm volatile("s_waitcnt lgkmcnt(" #n ")" ::: "memory")
#define PG8_BAR __builtin_amdgcn_s_barrier()
#define PG8_SCHED __builtin_amdgcn_sched_barrier(0)
    Unit cur, nxt; int ui = 0;
    if (!S.next(0, cur)) return;
    f32x4 acc[2][2][4][2];
#pragma unroll
    for (int a = 0; a < 2; ++a)
#pragma unroll
        for (int b = 0; b < 2; ++b)
#pragma unroll
            for (int m = 0; m < 4; ++m)
#pragma unroll
                for (int n = 0; n < 2; ++n) acc[a][b][m][n] = (f32x4){0.f, 0.f, 0.f, 0.f};
    bf16x8 At[4][2], B0[2][2], B1[2][2];
    const char* cA = (const char*)g.A + (size_t)cur.pm * tstep; const char* cB = (const char*)g.Bt + (size_t)cur.pn * tstep;
    S.a_ready(cur);
    if constexpr (SP2) {
        PG8_STAGE(PG8_SB(0, 0), cB, voffB); PG8_STAGE(PG8_SB(0, 1), cB + hstep, voffB); PG8_STAGE(PG8_SA(0, 0), cA, voffA); PG8_STAGE(PG8_SA(0, 1), cA + hstep, voffA);
        if (wr == 1) PG8_BAR;
        PG8_WAIT_V(2); PG8_BAR;
        PG8_STAGE(PG8_SB(1, 0), cB + kstep, voffB); PG8_STAGE(PG8_SA(1, 0), cA + kstep, voffA); PG8_STAGE(PG8_SB(1, 1), cB + hstep + kstep, voffB);
        PG8_WAIT_V(6); PG8_BAR;
    } else {
        PG8_STAGE(PG8_SB(0, 0), cB, voffB); PG8_STAGE(PG8_SA(0, 0), cA, voffA); PG8_STAGE(PG8_SB(0, 1), cB + hstep, voffB); PG8_STAGE(PG8_SA(0, 1), cA + hstep, voffA);
        if (wr == 1) PG8_BAR;
        PG8_WAIT_V(4); PG8_BAR;
        PG8_STAGE(PG8_SB(1, 0), cB + kstep, voffB); PG8_STAGE(PG8_SA(1, 0), cA + kstep, voffA); PG8_STAGE(PG8_SB(1, 1), cB + hstep + kstep, voffB);
        PG8_WAIT_V(6); PG8_BAR;
    }
    for (;;) {
        const bool has_next = S.next(ui + 1, nxt);
        const char* nA = has_next ? (const char*)g.A + (size_t)nxt.pm * tstep : cA; const char* nB = has_next ? (const char*)g.Bt + (size_t)nxt.pn * tstep : cB;
        for (int t = 0; t < nt; t += 2) {
            const bool last = (t == nt - 2);
            const char* a1 = cA + (size_t)(t + 1) * kstep;
            const char* a2 = last ? nA : cA + (size_t)(t + 2) * kstep; const char* b2 = last ? nB : cB + (size_t)(t + 2) * kstep;
            const char* a3 = a2 + kstep; const char* b3 = b2 + kstep;
            if (last && has_next) S.a_ready(nxt);
            if constexpr (SP2) {
            PG8_LDB(B0, 0, 0); PG8_LDB(B1, 0, 1); PG8_SCHED; PG8_LDA(At, 0, 0); PG8_STAGE(PG8_SA(1, 1), a1 + hstep, voffA);
            PG8_WAIT_V(8); PG8_WAIT_L(0); PG8_BAR; PG8_MMA(0, 0, At, B0); PG8_MMA(0, 1, At, B1); PG8_BAR; PG8_SCHED;
            PG8_LDA(At, 0, 1); PG8_STAGE(PG8_SB(0, 0), b2, voffB); PG8_STAGE(PG8_SB(0, 1), b2 + hstep, voffB); PG8_STAGE(PG8_SA(0, 0), a2, voffA);
            PG8_WAIT_V(8); PG8_WAIT_L(0); PG8_BAR; PG8_MMA(1, 0, At, B0); PG8_MMA(1, 1, At, B1); PG8_BAR; PG8_SCHED;
            PG8_LDB(B0, 1, 0); PG8_LDB(B1, 1, 1); PG8_SCHED; PG8_LDA(At, 1, 0); PG8_STAGE(PG8_SA(0, 1), a2 + hstep, voffA);
            PG8_WAIT_V(8); PG8_WAIT_L(0); PG8_BAR; PG8_MMA(0, 0, At, B0); PG8_MMA(0, 1, At, B1); PG8_BAR; PG8_SCHED;
            PG8_LDA(At, 1, 1); PG8_STAGE(PG8_SB(1, 0), b3, voffB); PG8_STAGE(PG8_SB(1, 1), b3 + hstep, voffB); PG8_STAGE(PG8_SA(1, 0), a3, voffA);
            PG8_WAIT_V(8); PG8_WAIT_L(0); PG8_BAR; PG8_MMA(1, 0, At, B0); PG8_MMA(1, 1, At, B1); PG8_BAR; PG8_SCHED;
            } else {
            PG8_LDB(B0, 0, 0); PG8_SCHED; PG8_LDA(At, 0, 0); PG8_STAGE(PG8_SA(1, 1), a1 + hstep, voffA);
            PG8_WAIT_L(8); PG8_BAR; PG8_WAIT_L(0); PG8_MMA(0, 0, At, B0); PG8_BAR; PG8_SCHED;
            PG8_LDB(B1, 0, 1); PG8_STAGE(PG8_SB(0, 0), b2, voffB);
            PG8_BAR; PG8_WAIT_L(0); PG8_MMA(0, 1, At, B1); PG8_BAR;
            PG8_LDA(At, 0, 1); PG8_STAGE(PG8_SA(0, 0), a2, voffA);
            PG8_BAR; PG8_WAIT_L(0); PG8_MMA(1, 0, At, B0); PG8_BAR; PG8_SCHED;
            PG8_STAGE(PG8_SB(0, 1), b2 + hstep, voffB);
            PG8_WAIT_V(6); PG8_BAR; PG8_MMA(1, 1, At, B1); PG8_BAR;
            PG8_LDB(B0, 1, 0); PG8_SCHED; PG8_LDA(At, 1, 0); PG8_STAGE(PG8_SA(0, 1), a2 + hstep, voffA);
            PG8_WAIT_L(8); PG8_BAR; PG8_WAIT_L(0); PG8_MMA(0, 0, At, B0); PG8_BAR; PG8_SCHED;
            PG8_LDB(B1, 1, 1); PG8_STAGE(PG8_SB(1, 0), b3, voffB);
            PG8_BAR; PG8_WAIT_L(0); PG8_MMA(0, 1, At, B1); PG8_BAR;
            PG8_LDA(At, 1, 1); PG8_STAGE(PG8_SA(1, 0), a3, voffA);
            PG8_BAR; PG8_WAIT_L(0); PG8_MMA(1, 0, At, B0); PG8_BAR; PG8_SCHED;
            PG8_STAGE(PG8_SB(1, 1), b3 + hstep, voffB);
            PG8_WAIT_V(6); PG8_BAR; PG8_MMA(1, 1, At, B1); PG8_BAR;
            }
        }
        if constexpr (ALIGN_EPI) { if (wr == 0) PG8_BAR; }
        if constexpr (!Epi::AFTER_DRAIN) { E(acc, cur, wr, wc, fr, fq); S.done(cur); }
        if (!has_next) break;
#pragma unroll
        for (int a = 0; a < 2; ++a)
#pragma unroll
            for (int b = 0; b < 2; ++b)
#pragma unroll
                for (int m = 0; m < 4; ++m)
#pragma unroll
                    for (int n = 0; n < 2; ++n) acc[a][b][m][n] = (f32x4){0.f, 0.f, 0.f, 0.f};
        cur = nxt; cA = nA; cB = nB; ++ui;
        if constexpr (ALIGN_EPI) { if (wr == 1) PG8_BAR; }
    }
    PG8_WAIT_V(0);
    if constexpr (!ALIGN_EPI) { if (wr == 0) PG8_BAR; }
    PG8_BAR;
    if constexpr (Epi::AFTER_DRAIN) { E.fused(acc, cur, wr, wc, fr, fq, lds, wid, lane); S.done(cur); }
#undef PG8_SA
#undef PG8_SB
#undef PG8_STAGE
#undef PG8_LDA
#undef PG8_LDB
#undef PG8_MMA
#undef PG8_WAIT_V
#undef PG8_WAIT_L
#undef PG8_BAR
#undef PG8_SCHED
}

}


namespace pg8 {
__device__ __forceinline__ void item_vals(const f32x4 (&acc)[2][2][4][2], int ai, int bj, int m, float (&v)[8]) {
#pragma unroll
    for (int r = 0; r < 4; ++r) { v[r] = acc[ai][bj][m][0][r]; v[4 + r] = acc[ai][bj][m][1][r]; }
}
struct EpiOutproj {
    static constexpr bool PERM = true, AFTER_DRAIN = false;
    const float* x; float* out; const float* gffn; bf16_t* xb; float* rowss;
    __device__ __forceinline__ void operator()(const f32x4 (&acc)[2][2][4][2], const Unit& u, int wr, int wc, int fr, int fq) const {
        f32x4 gv[4];
#pragma unroll
        for (int bj = 0; bj < 2; ++bj) { const float* gp = gffn + u.pn * BM + bj * HALF + wc * 32 + 8 * fq; gv[2 * bj] = *(const f32x4*)gp; gv[2 * bj + 1] = *(const f32x4*)(gp + 4); }
#pragma unroll
        for (int ai = 0; ai < 2; ++ai)
#pragma unroll
            for (int mh = 0; mh < 2; ++mh) {
                f32x4 xv[8];
#pragma unroll
                for (int mm = 0; mm < 2; ++mm)
#pragma unroll
                    for (int bj = 0; bj < 2; ++bj) {
                        const int m = mh * 2 + mm;
                        const size_t o = (size_t)(u.pm * BM + ai * HALF + wr * 64 + m * 16 + fr) * 1024 + u.pn * BM + bj * HALF + wc * 32 + 8 * fq;
                        xv[(mm * 2 + bj) * 2] = *(const f32x4*)(x + o); xv[(mm * 2 + bj) * 2 + 1] = *(const f32x4*)(x + o + 4);
                    }
                PIN8(xv, 0); if (ai == 0 && mh == 0) PIN4(gv, 0);
#pragma unroll
                for (int mm = 0; mm < 2; ++mm) {
                    const int m = mh * 2 + mm;
                    const size_t row = (size_t)(u.pm * BM + ai * HALF + wr * 64 + m * 16 + fr);
                    float ss = 0.f;
#pragma unroll
                    for (int bj = 0; bj < 2; ++bj) {
                        const size_t o = row * 1024 + u.pn * BM + bj * HALF + wc * 32 + 8 * fq;
                        const f32x4 a = xv[(mm * 2 + bj) * 2] + acc[ai][bj][m][0], b = xv[(mm * 2 + bj) * 2 + 1] + acc[ai][bj][m][1];
                        *(f32x4*)(out + o) = a; *(f32x4*)(out + o + 4) = b;
                        ss += (a[0] * a[0] + a[1] * a[1]) + (a[2] * a[2] + a[3] * a[3]) + (b[0] * b[0] + b[1] * b[1]) + (b[2] * b[2] + b[3] * b[3]);
                        const f32x4 ga = a * gv[2 * bj], gb = b * gv[2 * bj + 1];
                        const float v[8] = {ga[0], ga[1], ga[2], ga[3], gb[0], gb[1], gb[2], gb[3]};
                        store_bf16x8(xb + o, v);
                    }
                    ss += __shfl_xor(ss, 16); ss += __shfl_xor(ss, 32);
                    if (fq == 0) atomicAdd(rowss + row, ss);
                }
            }
    }
};
struct EpiMerge {
    static constexpr bool PERM = true, AFTER_DRAIN = false;
    const bf16_t* G; bf16_t* merged; int br;
    __device__ __forceinline__ void operator()(const f32x4 (&acc)[2][2][4][2], const Unit& u, int wr, int wc, int fr, int fq) const {
#pragma unroll
        for (int ai = 0; ai < 2; ++ai)
#pragma unroll
            for (int mh = 0; mh < 2; ++mh) {
                u32x4 gm[8];
#pragma unroll
                for (int mm = 0; mm < 2; ++mm)
#pragma unroll
                    for (int bj = 0; bj < 2; ++bj) {
                        const int m = mh * 2 + mm;
                        const size_t row = (size_t)(u.pm * BM + ai * HALF + wr * 64 + m * 16 + fr); const int col = u.pn * BM + bj * HALF + wc * 32 + 8 * fq;
                        gm[mm * 2 + bj] = *(const u32x4*)(G + row * 3072 + br * 1024 + col);
                        gm[4 + mm * 2 + bj] = br > 0 ? *(const u32x4*)(merged + row * 1024 + col) : (u32x4){0u, 0u, 0u, 0u};
                    }
                PIN8(gm, 0);
#pragma unroll
                for (int mm = 0; mm < 2; ++mm)
#pragma unroll
                    for (int bj = 0; bj < 2; ++bj) {
                        const int m = mh * 2 + mm;
                        const size_t row = (size_t)(u.pm * BM + ai * HALF + wr * 64 + m * 16 + fr); const int col = u.pn * BM + bj * HALF + wc * 32 + 8 * fq;
                        float v[8]; item_vals(acc, ai, bj, m, v);
                        const u32x4 g4 = gm[mm * 2 + bj], t = gm[4 + mm * 2 + bj];
#pragma unroll
                        for (int e = 0; e < 4; ++e) { v[2 * e] = v[2 * e] * bflo(g4[e]) + bflo(t[e]); v[2 * e + 1] = v[2 * e + 1] * bfhi(g4[e]) + bfhi(t[e]); }
                        store_bf16x8(merged + row * 1024 + col, v);
                    }
            }
    }
};
struct EpiInproj {
    static constexpr bool PERM = true, AFTER_DRAIN = false;
    unsigned char* ws; const float* cs; const float* gate_b;
    __device__ __forceinline__ void operator()(const f32x4 (&acc)[2][2][4][2], const Unit& u, int wr, int wc, int fr, int fq) const {
        const int pn = u.pn;
        if (pn < 4) {
            const bool isq = pn < 3;
            bf16_t* dst = isq ? (bf16_t*)(ws + OFF_QA) + pn * 256 : (bf16_t*)(ws + OFF_KA);
            const int ld = isq ? 768 : 256; const float sc = isq ? QSCALE : 1.0f;
#pragma unroll
            for (int ai = 0; ai < 2; ++ai)
#pragma unroll
                for (int mh = 0; mh < 2; ++mh) {
                    f32x4 csv[8];
                    if (wc == 0) {
#pragma unroll
                        for (int mm = 0; mm < 2; ++mm) {
                            const f32x4* csr = (const f32x4*)(cs + (size_t)(u.pm * BM + ai * HALF + wr * 64 + (mh * 2 + mm) * 16 + fr) * 32 + (fq & 1) * 16);
#pragma unroll
                            for (int q = 0; q < 4; ++q) csv[mm * 4 + q] = csr[q];
                        }
                        PIN8(csv, 0);
                    }
#pragma unroll
                    for (int mm = 0; mm < 2; ++mm)
#pragma unroll
                        for (int bj = 0; bj < 2; ++bj) {
                            const int m = mh * 2 + mm;
                            const size_t row = (size_t)(u.pm * BM + ai * HALF + wr * 64 + m * 16 + fr);
                            float v[8]; item_vals(acc, ai, bj, m, v);
                            if (wc == 0) {
                                const f32x4 c0 = csv[mm * 4], c1 = csv[mm * 4 + 1], c2 = csv[mm * 4 + 2], c3 = csv[mm * 4 + 3];
                                const float ccv[8] = {c0[0], c0[2], c1[0], c1[2], c2[0], c2[2], c3[0], c3[2]};
                                const float ssv[8] = {c0[1], c0[3], c1[1], c1[3], c2[1], c2[3], c3[1], c3[3]};
#pragma unroll
                                for (int e = 0; e < 8; ++e) {
                                    const float o = __shfl_xor(v[e], 32);
                                    v[e] = (fq < 2) ? (v[e] * ccv[e] - o * ssv[e]) : (v[e] * ccv[e] + o * ssv[e]);
                                }
                            }
#pragma unroll
                            for (int e = 0; e < 8; ++e) v[e] *= sc;
                            store_bf16x8(dst + row * ld + bj * HALF + wc * 32 + 8 * fq, v);
                        }
                }
        } else if (pn == 4) {
#pragma unroll
            for (int ai = 0; ai < 2; ++ai)
#pragma unroll
                for (int m = 0; m < 4; ++m)
#pragma unroll
                    for (int bj = 0; bj < 2; ++bj) {
                        const int row = u.pm * BM + ai * HALF + wr * 64 + m * 16 + fr, b = row / S_, s = row % S_;
                        float v[8]; item_vals(acc, ai, bj, m, v);
                        bf16_t* vt = (bf16_t*)(ws + OFF_VAT) + ((size_t)(b * 2 + bj) * 128 + wc * 32 + 8 * fq) * S_ + s;
#pragma unroll
                        for (int e = 0; e < 8; ++e) vt[(size_t)e * S_] = f2bf(v[e]);
                    }
        } else if (pn < 13) {
            const int kind = pn < 8 ? 0 : (pn < 11 ? 1 : 2);
            bf16_t* dst = kind == 0 ? (bf16_t*)(ws + OFF_XL) + (pn - 5) * 256 : (kind == 1 ? (bf16_t*)(ws + OFF_GL) + (pn - 8) * 256 : (bf16_t*)(ws + OFF_QM) + (pn - 11) * 256);
            const int ld = kind == 2 ? 512 : 768;
#pragma unroll
            for (int ai = 0; ai < 2; ++ai)
#pragma unroll
                for (int m = 0; m < 4; ++m)
#pragma unroll
                    for (int bj = 0; bj < 2; ++bj) {
                        const size_t row = (size_t)(u.pm * BM + ai * HALF + wr * 64 + m * 16 + fr);
                        float v[8]; item_vals(acc, ai, bj, m, v);
                        if (kind == 1) {
#pragma unroll
                            for (int e = 0; e < 8; ++e) v[e] = gelu_tanh(v[e]);
                        } else if (kind == 2) {
#pragma unroll
                            for (int e = 0; e < 8; ++e) v[e] *= QSCALE;
                        }
                        store_bf16x8(dst + row * ld + bj * HALF + wc * 32 + 8 * fq, v);
                    }
        } else {
            const int gc0 = (pn - 13) * 256;
            f32x4 gbv[4];
#pragma unroll
            for (int bj = 0; bj < 2; ++bj) { const float* gb = gate_b + gc0 + bj * HALF + wc * 32 + 8 * fq; gbv[2 * bj] = *(const f32x4*)gb; gbv[2 * bj + 1] = *(const f32x4*)(gb + 4); }
            PIN4(gbv, 0);
            bf16_t* dst = (bf16_t*)(ws + OFF_GATES) + gc0;
#pragma unroll
            for (int ai = 0; ai < 2; ++ai)
#pragma unroll
                for (int m = 0; m < 4; ++m)
#pragma unroll
                    for (int bj = 0; bj < 2; ++bj) {
                        const size_t row = (size_t)(u.pm * BM + ai * HALF + wr * 64 + m * 16 + fr);
                        float v[8]; item_vals(acc, ai, bj, m, v);
                        const f32x4 b0 = gbv[2 * bj], b1 = gbv[2 * bj + 1];
#pragma unroll
                        for (int e = 0; e < 4; ++e) { v[e] = sigmoidf_(v[e] + b0[e]); v[4 + e] = sigmoidf_(v[4 + e] + b1[e]); }
                        store_bf16x8(dst + row * 3072 + bj * HALF + wc * 32 + 8 * fq, v);
                    }
        }
    }
};
}

#define XB_TMO      128
#define XB_XCNT(j)  (256  + 64 * (j))
#define XB_XSUB(j)  (1280 + 64 * (j))
#define XB_XGEN(j)  (2304 + 64 * (j))
#define XB_TOP      3328
#define XB_TOPGEN   3392
#define XCD_BAR_WORDS 3456
#define XB_SPIN_CAP (1u << 22)
#define LAS __attribute__((address_space(3)))
__device__ __forceinline__ unsigned xb_ld(unsigned* p)              { return __hip_atomic_load(p, __ATOMIC_RELAXED, __HIP_MEMORY_SCOPE_AGENT); }
__device__ __forceinline__ unsigned xb_add(unsigned* p, unsigned v) { return __hip_atomic_fetch_add(p, v, __ATOMIC_RELAXED, __HIP_MEMORY_SCOPE_AGENT); }
__device__ __forceinline__ unsigned xb_xcc_id() { return (unsigned)__builtin_amdgcn_s_getreg((3 << 11) | 20) & 0xFu; }
#define XB_SPIN(cond, bar) do { unsigned _sp = 0; while (cond) { __builtin_amdgcn_s_sleep(1); \
    if ((++_sp & 255u) == 0u) { if (xb_ld(&(bar)[XB_TMO])) break; if (_sp > XB_SPIN_CAP) { atomicAdd(&(bar)[XB_TMO], 1u); break; } } } } while (0)
struct XcdBarrier { unsigned* bar; unsigned x; volatile LAS unsigned* st; };
__device__ __forceinline__ XcdBarrier xcd_barrier_post(unsigned* bar, volatile LAS unsigned* st) {
    XcdBarrier b; b.bar = bar; b.x = xb_xcc_id(); b.st = st;
    if (threadIdx.x == 0) (void)xb_add(&bar[XB_XCNT(b.x)], 1u);
    return b;
}
__device__ __forceinline__ void xcd_barrier_complete(unsigned* bar, unsigned x, unsigned& nloc, unsigned& nx) {
    const unsigned G = gridDim.x;
    unsigned sum, cnt, mine, sp = 0u;
    for (;;) {
        sum = 0u; cnt = 0u; mine = 0u;
#pragma unroll
        for (unsigned j = 0; j < 16; ++j) { const unsigned c = xb_ld(&bar[XB_XCNT(j)]); sum += c; cnt += (c > 0u) ? 1u : 0u; mine = (j == x) ? c : mine; }
        if (sum == G) break;
        __builtin_amdgcn_s_sleep(1);
        if ((++sp & 255u) == 0u) { if (xb_ld(&bar[XB_TMO])) break; if (sp > XB_SPIN_CAP) { atomicAdd(&bar[XB_TMO], 1u); break; } }
    }
    nloc = mine > 0u ? mine : 1u; nx = cnt > 0u ? cnt : 1u;
}
__device__ __forceinline__ void xcd_barrier(const XcdBarrier& b) {
    asm volatile("s_waitcnt vmcnt(0)" ::: "memory");
    __syncthreads();
    if (threadIdx.x == 0) {
        unsigned* bar = b.bar;
        __builtin_amdgcn_s_waitcnt(0);
        unsigned nloc = b.st[0], nx = b.st[1];
        if (nloc == 0u) { xcd_barrier_complete(bar, b.x, nloc, nx); b.st[0] = nloc; b.st[1] = nx; }
        const unsigned old = xb_add(&bar[XB_XSUB(b.x)], 1u);
        const unsigned gen = old / nloc;
        if (old + 1u == (gen + 1u) * nloc) {
            __builtin_amdgcn_fence(__ATOMIC_RELEASE, "agent");
            asm volatile("s_waitcnt vmcnt(0)" ::: "memory");
            const unsigned og = xb_add(&bar[XB_TOP], 1u);
            const unsigned tg = og / nx;
            if (og + 1u == (tg + 1u) * nx) xb_add(&bar[XB_TOPGEN], 1u);
            else XB_SPIN(xb_ld(&bar[XB_TOPGEN]) == tg, bar);
            __builtin_amdgcn_fence(__ATOMIC_ACQUIRE, "agent");
            xb_add(&bar[XB_XGEN(b.x)], 1u);
            asm volatile("s_waitcnt vmcnt(0)" ::: "memory");
        } else {
            XB_SPIN(xb_ld(&bar[XB_XGEN(b.x)]) == gen, bar);
            __builtin_amdgcn_fence(__ATOMIC_ACQUIRE, "agent");
            asm volatile("s_waitcnt vmcnt(0)" ::: "memory");
        }
    }
    __syncthreads();
}

#ifndef PROBE_PHASE
#define PROBE_PHASE -1
#endif
#define PH_BEGIN(k) if (PROBE_PHASE == (k)) probe_t0 = __builtin_amdgcn_s_memrealtime();
#define PH_END(k)   if (PROBE_PHASE == (k)) probe_dt = __builtin_amdgcn_s_memrealtime() - probe_t0;
constexpr int SMEM_BYTES = 128 * 132 * 4 + 1024;

__global__ void __launch_bounds__(512, 2) fwd_megakernel(Params p) {
    __shared__ __attribute__((aligned(16))) unsigned char smem_all[2 * SMEM_BYTES + 32];
    if (threadIdx.x == 0) { *(uint4*)(smem_all + 2 * SMEM_BYTES) = make_uint4(0u, 0u, 0u, 0u); *(uint4*)(smem_all + 2 * SMEM_BYTES + 16) = make_uint4(0u, 0u, 0u, 0u); }
    __syncthreads();
    const XcdBarrier xb = xcd_barrier_post((unsigned*)(p.ws + OFF_BAR), (volatile LAS unsigned*)(smem_all + 2 * SMEM_BYTES));
    const int nb = vnb();
#define PHASE_IDS int vb_ = threadIdx.x >> 8; asm volatile("" : "+v"(vb_)); const int vb = vb_, bid = (int)blockIdx.x + vb * (int)gridDim.x, tid = tidx(), lane = tid & 63, wid = tid >> 6; unsigned char* smem = smem_all + vb * SMEM_BYTES; (void)bid; (void)tid; (void)lane; (void)wid; (void)smem;
    unsigned char* ws = p.ws; unsigned char* dob = (unsigned char*)p.out;
    unsigned long long probe_t0 = 0, probe_dt = 0;
    PH_BEGIN(0)
    { PHASE_IDS
    {
        for (int u0 = bid; u0 < 3232 + nb - 1 - (3231 % nb); u0 += nb) {
            const int u = u0 < 3232 ? u0 : 3231;
            if (u < 1600) convT_tile(p.w_in, (bf16_t*)(ws + OFF_WINT), 1024, INW, u, smem);
            else if (u < 1856) convT_tile(p.w_mem_kv, (bf16_t*)(ws + OFF_WMKVT), 1024, 1024, u - 1600, smem);
            else if (u < 2048) convT_tile(p.p_attn, (bf16_t*)(ws + OFF_PATTNT), 768, 1024, u - 1856, smem);
            else if (u < 2240) convT_tile(p.p_lru, (bf16_t*)(ws + OFF_PLRUT), 768, 1024, u - 2048, smem);
            else if (u < 2368) convT_tile(p.p_mem, (bf16_t*)(ws + OFF_PMEMT), 512, 1024, u - 2240, smem);
            else if (u < 2624) convT_tile(p.w_out, (bf16_t*)(ws + OFF_WOUTT), 1024, 1024, u - 2368, smem);
            else if (u < 3136) convT_tile(p.w_peer_q, (bf16_t*)(ws + OFF_WPQT), 1024, 2048, u - 2624, smem);
            else {
                const int v = u - 3136, mat = v >> 2, tile = v & 3, gsel = mat / 6, h = mat % 6, dir = gsel & 1;
                const float* src = (gsel < 2 ? p.lru_wr : p.lru_wi) + (size_t)(dir * 6 + h) * 128 * 128;
                convT_tile(src, (bf16_t*)(ws + OFF_LRUWT) + (size_t)(h * 512 + gsel * 128) * 128, 128, 128, tile, smem);
            }
        }
        conv_plain(p.peer_sub_keys, (bf16_t*)(ws + OFF_SUBK), (size_t)16 * 128 * 128 / 8);
        for (int r = bid * 4 + wid; r < 2 * NEXP; r += nb * 4) {
            if (r < NEXP) conv_row_fp8(p.peer_u, ws + OFF_UB, (float*)(ws + OFF_SU), r, lane);
            else conv_row_fp8(p.peer_v, ws + OFF_VB, (float*)(ws + OFF_SV), r - NEXP, lane);
        }
        for (int r = bid * 4 + wid; r < NTOK; r += nb * 4) rms_row_bf16(p.x + (size_t)r * 1024, p.g_mix, (bf16_t*)(dob + DO_HBF) + (size_t)r * 1024, lane);
        for (int r = bid * 4 + wid; r < NMEM; r += nb * 4) rms_row_bf16(p.mem + (size_t)r * 1024, p.g_mem, (bf16_t*)(dob + DO_MEMBF) + (size_t)r * 1024, lane);
        for (int i = bid * 256 + tid; i < NTOK * 16; i += nb * 256) rope_item(p.positions, (float*)(dob + DO_ROPE), i);
        for (int i = bid * 256 + tid; i < NTOK; i += nb * 256) { ((float*)(ws + OFF_ROWSS))[i] = 0.f; ((float*)(ws + OFF_ROWSS1))[i] = 0.f; }
        for (int i = bid * 256 + tid; i < 2 * LW; i += nb * 256) ((float*)(ws + OFF_SP8))[i] = -8.0f * 1.4426950408889634f * log1pf(__expf(-p.lru_lambda[i]));
    }
    xcd_barrier(xb);
    PH_END(0) PH_BEGIN(1)
    }
    { PHASE_IDS
    { const int u = bid & 255; memkv_tile(p, u / 8, u % 8, smem); }
    {
        const pg8::Gemm g{(const bf16_t*)(dob + DO_HBF), (const bf16_t*)(ws + OFF_WINT), NTOK, INW, 1024};
        pg8::StaticOrder S; S.init(NTOK, INW, (int)gridDim.x, (int)blockIdx.x);
        __syncthreads();
        pg8::gemm_phase<pg8::EpiInproj, pg8::StaticOrder, true, true>((PG8_LAS unsigned char*)smem_all, g, S, pg8::EpiInproj{ws, (const float*)(dob + DO_ROPE), p.gate_b});
    }
    xcd_barrier(xb);
    PH_END(1) PH_BEGIN(2)
    }
    { PHASE_IDS
    {
        unsigned* ctr = (unsigned*)(p.ws + OFF_BAR) + 3600;
        volatile LAS unsigned* slot = (volatile LAS unsigned*)(smem_all + 2 * SMEM_BYTES + 16);
        for (;;) {
            if (threadIdx.x == 0) *slot = xb_add(ctr, 2u);
            __syncthreads();
            const int u = (int)*slot + vb;
            __syncthreads();
            if (u >= 1536 + 1536 + 1024) break;
            if (u < 1536) lru_chunk_unit<true>(p, u, smem);
            else if (u < 1536 + 1536) attn_win_unit(p, u - 1536, smem);
            else attn_mem_unit(p, u - 1536 - 1536, smem);
        }
    }
    xcd_barrier(xb);
    }
    { PHASE_IDS
    for (int u = bid; u < 1536; u += nb) lru_fixup_unit(p, u);
    xcd_barrier(xb);
    PH_END(2) PH_BEGIN(3)
    }
    { PHASE_IDS
    {
        pg8::StaticOrder S; S.init(NTOK, 1024, (int)gridDim.x, (int)blockIdx.x);
        const bf16_t* G = (const bf16_t*)(ws + OFF_GATES); bf16_t* mg = (bf16_t*)(ws + OFF_MERGED);
        __syncthreads();
        { const pg8::Gemm g{(const bf16_t*)(ws + OFF_QA), (const bf16_t*)(ws + OFF_PATTNT), NTOK, 1024, 768};
          pg8::gemm_phase<pg8::EpiMerge, pg8::StaticOrder, true, true>((PG8_LAS unsigned char*)smem_all, g, S, pg8::EpiMerge{G, mg, 0}); }
        { const pg8::Gemm g{(const bf16_t*)(ws + OFF_GL), (const bf16_t*)(ws + OFF_PLRUT), NTOK, 1024, 768};
          pg8::gemm_phase<pg8::EpiMerge, pg8::StaticOrder, true, true>((PG8_LAS unsigned char*)smem_all, g, S, pg8::EpiMerge{G, mg, 1}); }
        { const pg8::Gemm g{(const bf16_t*)(ws + OFF_QM), (const bf16_t*)(ws + OFF_PMEMT), NTOK, 1024, 512};
          pg8::gemm_phase<pg8::EpiMerge, pg8::StaticOrder, true, true>((PG8_LAS unsigned char*)smem_all, g, S, pg8::EpiMerge{G, mg, 2}); }
    }
    xcd_barrier(xb);
    PH_END(3) PH_BEGIN(4)
    }
    { PHASE_IDS
    {
        const pg8::Gemm g{(const bf16_t*)(ws + OFF_MERGED), (const bf16_t*)(ws + OFF_WOUTT), NTOK, 1024, 1024};
        pg8::StaticOrder S; S.init(NTOK, 1024, (int)gridDim.x, (int)blockIdx.x);
        __syncthreads();
        pg8::gemm_phase<pg8::EpiOutproj, pg8::StaticOrder, true, true>((PG8_LAS unsigned char*)smem_all, g, S, pg8::EpiOutproj{p.x, p.out, p.g_ffn, (bf16_t*)(ws + OFF_XB), (float*)(ws + OFF_ROWSS1)});
    }
    xcd_barrier(xb);
    PH_END(4) PH_BEGIN(6)
    }
    { PHASE_IDS
    {
        const pg8::Gemm g{(const bf16_t*)(ws + OFF_XB), (const bf16_t*)(ws + OFF_WPQT), NTOK, 2048, 1024};
        pg8::StaticOrder S; S.init(NTOK, 2048, (int)gridDim.x, (int)blockIdx.x);
        bf16_t* qp = (bf16_t*)(ws + OFF_QPEER); const float* rss = (const float*)(ws + OFF_ROWSS1);
        auto f = [=](int row, int col, float (&v)[8]) {
            const float rs = rsqrtf(rss[row] * (1.0f / 1024.0f) + EPS);
#pragma unroll
            for (int e = 0; e < 8; ++e) v[e] *= rs;
            store_bf16x8(qp + (size_t)row * 2048 + col, v); };
        pg8::gemm_phase<pg8::EpiFn<decltype(f)>, pg8::StaticOrder, true, true>((PG8_LAS unsigned char*)smem_all, g, S, pg8::EpiFn<decltype(f)>{f});
    }
    xcd_barrier(xb);
    PH_END(6) PH_BEGIN(7)
    }
    { PHASE_IDS
    for (int u = bid; u < 256 * 8; u += nb) scores_tile(p, u / 8, u % 8, smem);
    xcd_barrier(xb);
    PH_END(7) PH_BEGIN(9)
    }
    { PHASE_IDS
    {
        const int x = bid & 7, tstep = (nb >> 3) * 4;
        peer_u_pass(p, (bid >> 3) * 4 + wid, tstep, x, lane);
        xcd_barrier(xb);
        for (int t = bid * 4 + wid; t < NTOK; t += nb * 4) peer_coef_token(p, t, lane);
        xcd_barrier(xb);
        peer_v_pass(p, (bid >> 3) * 4 + wid, tstep, x, lane);
        xcd_barrier(xb);
        for (int t = bid * 4 + wid; t < NTOK; t += nb * 4) final_norm_row(p, t, lane);
    }
    }
    PH_END(9)
    if (PROBE_PHASE >= 0) { __syncthreads(); const unsigned long long t1 = __builtin_amdgcn_s_memrealtime(); while (__builtin_amdgcn_s_memrealtime() - t1 < probe_dt) __builtin_amdgcn_s_sleep(8); }
}

extern "C" void kernel_launch(void* const* d_in, const int* in_sizes, int n_in, void* d_out, int out_size, void* d_ws, size_t ws_size, hipStream_t stream) {
    if (ws_size < OFF_END) { fprintf(stderr, "workspace too small: %zu < %zu\n", ws_size, (size_t)OFF_END); return; }
    Params p{};
    p.x = (const float*)d_in[0]; p.mem = (const float*)d_in[1]; p.positions = (const int*)d_in[2];
    p.g_mix = (const float*)d_in[3]; p.g_mem = (const float*)d_in[4]; p.w_in = (const float*)d_in[5]; p.gate_b = (const float*)d_in[6];
    p.attn_sink = (const float*)d_in[7]; p.conv_w = (const float*)d_in[8]; p.conv_b = (const float*)d_in[9];
    p.lru_wr = (const float*)d_in[10]; p.lru_br = (const float*)d_in[11]; p.lru_wi = (const float*)d_in[12]; p.lru_bi = (const float*)d_in[13];
    p.lru_lambda = (const float*)d_in[14]; p.w_mem_kv = (const float*)d_in[15]; p.p_attn = (const float*)d_in[16]; p.p_lru = (const float*)d_in[17];
    p.p_mem = (const float*)d_in[18]; p.w_out = (const float*)d_in[19]; p.g_ffn = (const float*)d_in[20]; p.w_peer_q = (const float*)d_in[21];
    p.peer_sub_keys = (const float*)d_in[22]; p.peer_u = (const float*)d_in[23]; p.peer_v = (const float*)d_in[24]; p.g_final = (const float*)d_in[25];
    p.out = (float*)d_out; p.ws = (unsigned char*)d_ws;
    static int grid_blocks = 0;
    if (!grid_blocks) {
        int dev = 0, cus = 0, per_cu = 0;
        (void)hipGetDevice(&dev);
        (void)hipDeviceGetAttribute(&cus, hipDeviceAttributeMultiprocessorCount, dev);
        (void)hipOccupancyMaxActiveBlocksPerMultiprocessor(&per_cu, fwd_megakernel, 512, 0);
        if (per_cu > 1) per_cu = 1;
        grid_blocks = cus * per_cu;
    }
    (void)hipMemsetAsync((unsigned char*)d_ws + OFF_BAR, 0, 16384, stream);
    void* args[] = {&p};
    hipError_t e = hipLaunchCooperativeKernel((void*)fwd_megakernel, dim3(grid_blocks), dim3(512), args, 0, stream);
    if (e != hipSuccess) fprintf(stderr, "cooperative launch failed: %s (grid %d)\n", hipGetErrorString(e), grid_blocks);
}
```

```cpp
#include <hip/hip_runtime.h>
#include <stdint.h>
#include <stdio.h>

typedef unsigned short bf16_t;
typedef short bf16x8 __attribute__((ext_vector_type(8)));
typedef __bf16 bf16x2v __attribute__((ext_vector_type(2)));
typedef float f32x4 __attribute__((ext_vector_type(4)));
typedef int i32x4 __attribute__((ext_vector_type(4)));
typedef int i32x8 __attribute__((ext_vector_type(8)));

constexpr int B_ = 16, S_ = 2048, D_ = 1024, NTOK = B_ * S_;
constexpr int MEML = 256, NMEM = B_ * MEML;
constexpr int INW = 6400;
constexpr int LW = 768;
constexpr int NEXP = 16384;
constexpr float EPS = 1e-6f;
constexpr float QSCALE = 0.08838834764831845f * 1.4426950408889634f;

constexpr size_t OFF_WINT = 0;
constexpr size_t OFF_WMKVT = OFF_WINT + (size_t)INW * 1024 * 2;
constexpr size_t OFF_PATTNT = OFF_WMKVT + (size_t)1024 * 1024 * 2;
constexpr size_t OFF_PLRUT = OFF_PATTNT + (size_t)1024 * 768 * 2;
constexpr size_t OFF_PMEMT = OFF_PLRUT + (size_t)1024 * 768 * 2;
constexpr size_t OFF_WOUTT = OFF_PMEMT + (size_t)1024 * 512 * 2;
constexpr size_t OFF_WPQT = OFF_WOUTT + (size_t)1024 * 1024 * 2;
constexpr size_t OFF_LRUWT = OFF_WPQT + (size_t)2048 * 1024 * 2;
constexpr size_t OFF_SUBK = OFF_LRUWT + (size_t)6 * 512 * 128 * 2;
constexpr size_t OFF_UB = OFF_SUBK + (size_t)16 * 128 * 128 * 2;
constexpr size_t OFF_VB = OFF_UB + (size_t)NEXP * 1024;
constexpr size_t OFF_SU = OFF_VB + (size_t)NEXP * 1024;
constexpr size_t OFF_SV = OFF_SU + (size_t)NEXP * 4;
constexpr size_t OFF_RA = OFF_SV + (size_t)NEXP * 4;
constexpr size_t OFF_QA = OFF_RA;
constexpr size_t OFF_KA = OFF_QA + (size_t)NTOK * 768 * 2;
constexpr size_t OFF_VAT = OFF_KA + (size_t)NTOK * 256 * 2;
constexpr size_t OFF_XL = OFF_VAT + (size_t)NTOK * 256 * 2;
constexpr size_t OFF_GL = OFF_XL + (size_t)NTOK * 768 * 2;
constexpr size_t OFF_QM = OFF_GL + (size_t)NTOK * 768 * 2;
constexpr size_t OFF_GATES = OFF_QM + (size_t)NTOK * 512 * 2;
constexpr size_t OFF_BAR = OFF_GATES + (size_t)NTOK * 3072 * 2;
constexpr size_t OFF_SP8 = OFF_BAR + 16384;
constexpr size_t OFF_AGG = OFF_SP8 + 2 * 768 * 4;
constexpr size_t OFF_ROWSS = OFF_AGG + (size_t)2 * B_ * 16 * 768 * 8;
constexpr size_t OFF_ROWSS1 = OFF_ROWSS + (size_t)NTOK * 4;
constexpr size_t OFF_LCB = OFF_ROWSS1 + (size_t)NTOK * 4;
constexpr size_t OFF_END = OFF_LCB + (size_t)NTOK * 768 * 2;
constexpr size_t OFF_HB8 = OFF_LCB;
constexpr size_t OFF_WG8 = OFF_HB8 + (size_t)NTOK * 1024;
static_assert(OFF_WG8 + (size_t)3072 * 1024 <= OFF_END, "fp8 operands fit in the LCB slot");
constexpr float WG8_SCALE = 64.0f;
constexpr size_t OFF_XB = OFF_GL;
constexpr size_t OFF_MERGED = OFF_KA;
constexpr size_t OFF_QPEER = OFF_GATES;
constexpr size_t OFF_TOPL = OFF_QPEER + (size_t)NTOK * 2048 * 2;
constexpr size_t OFF_EIDX = OFF_TOPL + (size_t)NTOK * 256 * 4;
constexpr size_t OFF_ZBUF = OFF_QPEER;
constexpr size_t OFF_WBUF = OFF_TOPL;
constexpr size_t OFF_EGATE = OFF_EIDX + (size_t)NTOK * 128 * 4;
constexpr size_t X1B_SPLIT = 24576;
constexpr size_t OFF_X1B_HI = OFF_GL + (size_t)NTOK * 1024 * 2 - X1B_SPLIT * 2048;
static_assert(X1B_SPLIT * 2048 == (size_t)NTOK * 768 * 2, "x1b piece 0 fills attn_out exactly");
static_assert(OFF_X1B_HI + (size_t)NTOK * 2048 == OFF_GATES, "x1b piece 1 ends at the gates region");
static_assert(OFF_EGATE + (size_t)NTOK * 128 * 4 <= OFF_BAR, "overlay");
static_assert(OFF_MERGED + (size_t)NTOK * 1024 * 2 <= OFF_GL, "overlay2");
constexpr size_t DO_LCF = 0;
constexpr size_t DO_HBF = 0;
constexpr size_t DO_MEMBF = DO_HBF + (size_t)NTOK * 1024 * 2;
constexpr size_t DO_KM = DO_MEMBF + (size_t)NMEM * 1024 * 2;
constexpr size_t DO_VMT = DO_KM + (size_t)NMEM * 512 * 2;
constexpr size_t DO_ROPE = DO_VMT + (size_t)NMEM * 512 * 2;
static_assert(DO_ROPE + (size_t)NTOK * 32 * 4 <= (size_t)NTOK * 1024 * 4, "d_out scratch");

struct Params {
    const float *x, *mem; const int* positions;
    const float *g_mix, *g_mem, *w_in, *gate_b, *attn_sink, *conv_w, *conv_b, *lru_wr, *lru_br, *lru_wi, *lru_bi, *lru_lambda,
        *w_mem_kv, *p_attn, *p_lru, *p_mem, *w_out, *g_ffn, *w_peer_q, *peer_sub_keys, *peer_u, *peer_v, *g_final;
    float* out; unsigned char* ws;
};

__shared__ int g_wslot[64];
__device__ __forceinline__ int wave_phys() { return (int)(__builtin_amdgcn_s_getreg(0x2804) & 63u); }
__device__ __forceinline__ int TIDX() { return __builtin_amdgcn_readfirstlane(g_wslot[wave_phys()]) * 64 + (int)__lane_id(); }
__device__ __forceinline__ int tidx() { int t = TIDX() & 255; asm volatile("" : "+v"(t)); return t; }
__device__ __forceinline__ int vbid() { return (int)(blockIdx.x + (TIDX() >> 8) * gridDim.x); }
__device__ __forceinline__ int vnb() { return (int)(2 * gridDim.x); }
__device__ __forceinline__ float bf2f(bf16_t b) { return __uint_as_float(((unsigned)b) << 16); }
__device__ __forceinline__ float bflo(unsigned u) { return __uint_as_float(u << 16); }
__device__ __forceinline__ float bfhi(unsigned u) { return __uint_as_float(u & 0xffff0000u); }
typedef float f32x2v __attribute__((ext_vector_type(2)));
__device__ __forceinline__ unsigned pack_bf16(float lo, float hi) { const f32x2v f = {lo, hi}; return __builtin_bit_cast(unsigned, __builtin_convertvector(f, bf16x2v)); }
__device__ __forceinline__ bf16_t* x1b_row(unsigned char* ws, size_t row) { return (bf16_t*)(ws + (row < X1B_SPLIT ? OFF_QA : OFF_X1B_HI)) + row * 1024; }
__device__ __forceinline__ bf16_t f2bf(float f) { return (bf16_t)(pack_bf16(f, 0.f) & 0xffffu); }
__device__ __forceinline__ f32x4 mfma16(bf16x8 a, bf16x8 b, f32x4 c) { return __builtin_amdgcn_mfma_f32_16x16x32_bf16(a, b, c, 0, 0, 0); }
__device__ __forceinline__ float sigmoidf_(float x) { return __builtin_amdgcn_rcpf(1.0f + __expf(-x)); }
__device__ __forceinline__ float gelu_tanh(float x) { const float u = 1.5957691216057308f * (x + 0.044715f * x * x * x); return x * __builtin_amdgcn_rcpf(1.0f + __expf(-u)); }
__device__ __forceinline__ float wave_sum(float v) {
#pragma unroll
    for (int o = 32; o >= 1; o >>= 1) v += __shfl_xor(v, o);
    return v;
}


typedef unsigned u32x4 __attribute__((ext_vector_type(4)));
typedef unsigned u32x2v __attribute__((ext_vector_type(2)));
typedef _Float16 f16x2v __attribute__((ext_vector_type(2)));
#define PIN4(a, o) asm volatile("" : "+v"((a)[(o)]), "+v"((a)[(o) + 1]), "+v"((a)[(o) + 2]), "+v"((a)[(o) + 3]))
#define PIN8(a, o) asm volatile("" : "+v"((a)[(o)]), "+v"((a)[(o) + 1]), "+v"((a)[(o) + 2]), "+v"((a)[(o) + 3]), "+v"((a)[(o) + 4]), "+v"((a)[(o) + 5]), "+v"((a)[(o) + 6]), "+v"((a)[(o) + 7]))
#define PIN15(a, o) asm volatile("" : "+v"((a)[(o)]), "+v"((a)[(o) + 1]), "+v"((a)[(o) + 2]), "+v"((a)[(o) + 3]), "+v"((a)[(o) + 4]), "+v"((a)[(o) + 5]), "+v"((a)[(o) + 6]), "+v"((a)[(o) + 7]), \
    "+v"((a)[(o) + 8]), "+v"((a)[(o) + 9]), "+v"((a)[(o) + 10]), "+v"((a)[(o) + 11]), "+v"((a)[(o) + 12]), "+v"((a)[(o) + 13]), "+v"((a)[(o) + 14]))

struct ConvT { const float* src; bf16_t* dst; int K, N, tile; int n8; };
__device__ __forceinline__ void convT_load(const ConvT& c, float4 (&v)[4]) {
    const int tn = c.N / 64, tk = c.tile / tn, tnn = c.tile % tn, k0 = tk * 64, n0 = tnn * 64, tid = tidx();
    const int r = tid >> 4, c4 = (tid & 15) * 4;
#pragma unroll
    for (int i = 0; i < 4; ++i) v[i] = *(const float4*)(c.src + (size_t)(k0 + r + 16 * i) * c.N + n0 + c4);
}
__device__ __forceinline__ void convT_finish(const ConvT& c, const float4 (&v)[4], unsigned char* smem) {
    float* t = (float*)smem;
    const int tn = c.N / 64, tk = c.tile / tn, tnn = c.tile % tn, k0 = tk * 64, n0 = tnn * 64, tid = tidx();
    const int r = tid >> 4, c4 = (tid & 15) * 4;
#pragma unroll
    for (int i = 0; i < 4; ++i) {
        const int k = r + 16 * i;
        t[k * 65 + c4 + 0] = v[i].x; t[k * 65 + c4 + 1] = v[i].y; t[k * 65 + c4 + 2] = v[i].z; t[k * 65 + c4 + 3] = v[i].w;
    }
    __syncthreads();
    const int n = tid >> 2, kq = (tid & 3) * 16;
    unsigned w[8];
#pragma unroll
    for (int i = 0; i < 8; ++i) w[i] = pack_bf16(t[(kq + 2 * i) * 65 + n], t[(kq + 2 * i + 1) * 65 + n]);
    if (n0 >= c.n8) {
        unsigned q[4];
#pragma unroll
        for (int i = 0; i < 4; ++i) {
            int tt = __builtin_amdgcn_cvt_pk_fp8_f32(t[(kq + 4 * i) * 65 + n] * WG8_SCALE, t[(kq + 4 * i + 1) * 65 + n] * WG8_SCALE, 0, false);
            tt = __builtin_amdgcn_cvt_pk_fp8_f32(t[(kq + 4 * i + 2) * 65 + n] * WG8_SCALE, t[(kq + 4 * i + 3) * 65 + n] * WG8_SCALE, tt, true);
            q[i] = (unsigned)tt;
        }
        *(uint4*)((unsigned char*)c.dst + (size_t)(n0 - c.n8 + n) * c.K + k0 + kq) = make_uint4(q[0], q[1], q[2], q[3]);
    } else {
        uint4* d = (uint4*)(c.dst + (size_t)(n0 + n) * c.K + k0 + kq);
        d[0] = make_uint4(w[0], w[1], w[2], w[3]); d[1] = make_uint4(w[4], w[5], w[6], w[7]);
    }
    __syncthreads();
}


__device__ __forceinline__ void conv_plain(const float* __restrict__ src, bf16_t* __restrict__ dst, size_t n8) {
    for (size_t i = (size_t)vbid() * 256 + tidx(); i < n8; i += (size_t)vnb() * 256) {
        const float4 a = ((const float4*)src)[2 * i], b = ((const float4*)src)[2 * i + 1];
        ((uint4*)dst)[i] = make_uint4(pack_bf16(a.x, a.y), pack_bf16(a.z, a.w), pack_bf16(b.x, b.y), pack_bf16(b.z, b.w));
    }
}
__device__ __forceinline__ void rope_item(const int* __restrict__ pos, float* __restrict__ cs, int i) {
    const int t = i >> 4, f = i & 15;
    const float inv = powf(500000.0f, -(float)(2 * f) / 32.0f);
    const float ang = (float)pos[t] * inv;
    float s, c; sincosf(ang, &s, &c);
    cs[2 * i] = c; cs[2 * i + 1] = s;
}

__device__ __forceinline__ int swz(int row) { return (row & 3) | (((row >> 3) & 1) << 2); }

struct GemmOp { const bf16_t* A; const bf16_t* Bt; int lda, ldb; };
struct GemmPipe { int par; bool pre; };

__device__ __forceinline__ void gemm_issue(const GemmOp& op, int kt, int st, unsigned char* smem) {
    const int tid = tidx();
    const int srow = tid >> 3, skc = (tid & 7) ^ swz(tid >> 3);
    const bf16_t* ga = op.A + (size_t)srow * op.lda + skc * 8 + kt * 64;
    const bf16_t* gb = op.Bt + (size_t)srow * op.ldb + skc * 8 + kt * 64;
    unsigned char* sw = smem + tid * 16 + st * 32768;
#pragma unroll
    for (int i = 0; i < 4; ++i) {
        __builtin_amdgcn_global_load_lds((const unsigned*)(ga + (size_t)(32 * i) * op.lda), (unsigned*)(sw + i * 4096), 16, 0, 0);
        __builtin_amdgcn_global_load_lds((const unsigned*)(gb + (size_t)(32 * i) * op.ldb), (unsigned*)(sw + 16384 + i * 4096), 16, 0, 0);
    }
}

__device__ __forceinline__ void gemm_tile(const GemmOp& op, int K, f32x4 (&acc)[4][4], unsigned char* smem, GemmPipe& pp) {
    const int tid = tidx(), lane = tid & 63, wid = tid >> 6, wr = wid >> 1, wc = wid & 1, li = lane & 15, g = lane >> 4;
    int aoff[4], boff[4], asw[4], bsw[4];
#pragma unroll
    for (int m = 0; m < 4; ++m) { const int row = wr * 64 + m * 16 + li; aoff[m] = row * 128; asw[m] = swz(row); }
#pragma unroll
    for (int n = 0; n < 4; ++n) { const int row = wc * 64 + 32 * (n >> 1) + 8 * (li >> 2) + 4 * (n & 1) + (li & 3); boff[n] = 16384 + row * 128; bsw[n] = swz(row); }
    const int nk = K >> 6;
    if (!pp.pre) gemm_issue(op, 0, pp.par, smem);
    __syncthreads();
    for (int kt = 0; kt < nk; ++kt) {
        const int cur = (pp.par + kt) & 1;
        const unsigned char* sb = smem + cur * 32768;
        if (kt + 1 < nk) gemm_issue(op, kt + 1, cur ^ 1, smem);
#pragma unroll
        for (int ks = 0; ks < 2; ++ks) {
            bf16x8 af[4], bfr[4];
#pragma unroll
            for (int m = 0; m < 4; ++m) af[m] = *(const bf16x8*)(sb + aoff[m] + (((ks * 4 + g) ^ asw[m]) << 4));
#pragma unroll
            for (int n = 0; n < 4; ++n) bfr[n] = *(const bf16x8*)(sb + boff[n] + (((ks * 4 + g) ^ bsw[n]) << 4));
#pragma unroll
            for (int m = 0; m < 4; ++m)
#pragma unroll
                for (int n = 0; n < 4; ++n) acc[m][n] = mfma16(bfr[n], af[m], acc[m][n]);
        }
        if (kt + 1 < nk) __syncthreads();
    }
    pp.par = (pp.par + nk) & 1; pp.pre = false;
}
__device__ __forceinline__ void acc_zero(f32x4 (&acc)[4][4]) {
#pragma unroll
    for (int m = 0; m < 4; ++m)
#pragma unroll
        for (int n = 0; n < 4; ++n) acc[m][n] = (f32x4){0.f, 0.f, 0.f, 0.f};
}
template <class F> __device__ __forceinline__ void epi_foreach(const f32x4 (&acc)[4][4], F&& f) {
    const int lane = tidx() & 63, wid = tidx() >> 6, wr = wid >> 1, wc = wid & 1, li = lane & 15, g = lane >> 4;
#pragma unroll
    for (int m = 0; m < 4; ++m)
#pragma unroll
        for (int pp = 0; pp < 2; ++pp) {
            float v[8];
#pragma unroll
            for (int r = 0; r < 4; ++r) { v[r] = acc[m][2 * pp][r]; v[4 + r] = acc[m][2 * pp + 1][r]; }
            f(wr * 64 + m * 16 + li, wc * 64 + 32 * pp + 8 * g, v, pp, m);
        }
}
__device__ __forceinline__ void store_bf16x8(bf16_t* p, const float (&v)[8]) {
    *(uint4*)p = make_uint4(pack_bf16(v[0], v[1]), pack_bf16(v[2], v[3]), pack_bf16(v[4], v[5]), pack_bf16(v[6], v[7]));
}
__device__ __forceinline__ void store_tile_T(const f32x4 (&acc)[4][4], bf16_t* __restrict__ dstT, int ldt, unsigned char* smem) {
    bf16_t* t = (bf16_t*)smem;
    __syncthreads();
    epi_foreach(acc, [&](int r, int c, const float (&v)[8], int, int) {
#pragma unroll
        for (int e = 0; e < 8; ++e) t[(c + e) * 136 + r] = f2bf(v[e]);
    });
    __syncthreads();
#pragma unroll
    for (int i = 0; i < 8; ++i) {
        const int ch = tidx() + 256 * i, d = ch >> 4, tc = ch & 15;
        *(uint4*)(dstT + (size_t)d * ldt + tc * 8) = *(const uint4*)(smem + d * 272 + tc * 16);
    }
    __syncthreads();
}


__device__ void memkv_tile(const Params& p, int rt, int ct, unsigned char* smem) {
    unsigned char* dob = (unsigned char*)p.out;
    f32x4 acc[4][4]; acc_zero(acc);
    const GemmOp op{(const bf16_t*)(dob + DO_MEMBF) + (size_t)rt * 128 * 1024, (const bf16_t*)(p.ws + OFF_WMKVT) + (size_t)ct * 128 * 1024, 1024, 1024};
    GemmPipe pp{0, false};
    __syncthreads();
    gemm_tile(op, 1024, acc, smem, pp);
    const int row0 = rt * 128;
    if (ct < 4) {
        bf16_t* dst = (bf16_t*)(dob + DO_KM) + ct * 128;
        epi_foreach(acc, [&](int r, int c, float (&v)[8], int, int) { store_bf16x8(dst + (size_t)(row0 + r) * 512 + c, v); });
    } else {
        const int h = ct - 4, b = row0 / MEML, m0 = row0 % MEML;
        store_tile_T(acc, (bf16_t*)(dob + DO_VMT) + (size_t)(b * 4 + h) * 128 * MEML + m0, MEML, smem);
    }
}


typedef float f32x16 __attribute__((ext_vector_type(16)));
__device__ __forceinline__ f32x16 mfma32(bf16x8 a, bf16x8 b, f32x16 c) { return __builtin_amdgcn_mfma_f32_32x32x16_bf16(a, b, c, 0, 0, 0); }
constexpr int ATT_STAGE = 16384 + 128 * 136;

template <bool WIN>
__device__ void attn_block(const bf16_t* Qg, int ldq, const bf16_t* __restrict__ Kg, int ldk, const bf16_t* __restrict__ Vtg, int ldv,
                           int q0, int kt0, int nt, float sink2, bf16_t* Og, int ldo, unsigned char* smem) {
    const int tid = tidx(), lane = tid & 63, wid = tid >> 6, r = lane & 31, hh = lane >> 5;
    const int qw = q0 + 32 * wid;
    bf16x8 qf[8];
#pragma unroll
    for (int ks = 0; ks < 8; ++ks) qf[ks] = *(const bf16x8*)(Qg + (size_t)(32 * wid + r) * ldq + ks * 16 + hh * 8);
    f32x16 o[4];
#pragma unroll
    for (int db = 0; db < 4; ++db)
#pragma unroll
        for (int e = 0; e < 16; ++e) o[db][e] = 0.f;
    float m = WIN ? sink2 : -1e30f, l = WIN ? 1.0f : 0.0f;
    const int krow = tid >> 4, kch = tid & 15, vrow = tid >> 3, vch = tid & 7;
    const int koff = krow * 256 + ((kch ^ (krow & 15)) << 4);
    const int voff = 16384 + vrow * 136 + vch * 16;
    uint4 rk[4], rv[4];
    const bf16_t* kgp = Kg + (size_t)(kt0 * 64 + krow) * ldk + kch * 8;
    const bf16_t* vgp = Vtg + (size_t)vrow * ldv + kt0 * 64 + vch * 8;
#pragma unroll
    for (int i = 0; i < 4; ++i) { rk[i] = *(const uint4*)(kgp + (size_t)(16 * i) * ldk); rv[i] = *(const uint4*)(vgp + (size_t)(32 * i) * ldv); }
#pragma unroll
    for (int i = 0; i < 4; ++i) {
        *(uint4*)(smem + koff + i * 4096) = rk[i];
        *(uint2*)(smem + voff + i * 4352) = make_uint2(rv[i].x, rv[i].y); *(uint2*)(smem + voff + i * 4352 + 8) = make_uint2(rv[i].z, rv[i].w);
    }
    __syncthreads();
    constexpr int NTL = WIN ? 6 : 4;
    for (int t = 0; t < NTL; ++t) {
        const unsigned char* sb = smem + (t & 1) * ATT_STAGE;
        {
            const int tn = t + 1 < nt ? t + 1 : nt - 1;
#pragma unroll
            for (int i = 0; i < 4; ++i) { rk[i] = *(const uint4*)(kgp + (size_t)(tn * 64 + 16 * i) * ldk); rv[i] = *(const uint4*)(vgp + (size_t)(32 * i) * ldv + tn * 64); }
        }
        const int k0 = (kt0 + t) * 64;
        if (t < nt && (!WIN || (k0 + 63 >= qw - 128 && k0 <= qw + 159))) {
            f32x16 s0, s1;
#pragma unroll
            for (int e = 0; e < 16; ++e) { s0[e] = 0.f; s1[e] = 0.f; }
#pragma unroll
            for (int ks = 0; ks < 8; ++ks) {
                const bf16x8 a0 = *(const bf16x8*)(sb + r * 256 + (((2 * ks + hh) ^ (r & 15)) << 4));
                const bf16x8 a1 = *(const bf16x8*)(sb + (32 + r) * 256 + (((2 * ks + hh) ^ (r & 15)) << 4));
                s0 = mfma32(a0, qf[ks], s0); s1 = mfma32(a1, qf[ks], s1);
            }
            if (WIN && !(k0 >= qw - 97 && k0 + 63 <= qw + 128)) {
#pragma unroll
                for (int e = 0; e < 16; ++e) {
                    const int d = k0 + (e & 3) + 8 * (e >> 2) + 4 * hh - (qw + r);
                    s0[e] = (d <= 128 && d >= -128) ? s0[e] : -1e30f;
                    s1[e] = (d + 32 <= 128 && d + 32 >= -128) ? s1[e] : -1e30f;
                }
            }
            float mx = fmaxf(s0[0], s1[0]);
#pragma unroll
            for (int e = 1; e < 16; ++e) mx = fmaxf(mx, fmaxf(s0[e], s1[e]));
            mx = fmaxf(mx, __shfl_xor(mx, 32));
            const float mnew = fmaxf(m, mx), alpha = __builtin_amdgcn_exp2f(m - mnew);
            m = mnew;
            if (__any(alpha != 1.0f)) {
#pragma unroll
                for (int db = 0; db < 4; ++db)
#pragma unroll
                    for (int e = 0; e < 16; ++e) o[db][e] *= alpha;
            }
            float ps = 0.f;
#pragma unroll
            for (int blk = 0; blk < 2; ++blk) {
                f32x16& sv = blk ? s1 : s0;
#pragma unroll
                for (int e = 0; e < 16; ++e) { sv[e] = __builtin_amdgcn_exp2f(sv[e] - mnew); ps += sv[e]; }
#pragma unroll
                for (int s2 = 0; s2 < 2; ++s2) {
                    union { unsigned u[4]; bf16x8 v; } pb;
#pragma unroll
                    for (int e = 0; e < 4; ++e) pb.u[e] = pack_bf16(sv[8 * s2 + 2 * e], sv[8 * s2 + 2 * e + 1]);
#pragma unroll
                    for (int db = 0; db < 4; ++db) {
                        const unsigned char* vp = sb + 16384 + (db * 32 + r) * 136 + (blk * 32 + 16 * s2 + 4 * hh) * 2;
                        union { uint2 u[2]; bf16x8 v; } va;
                        va.u[0] = *(const uint2*)vp; va.u[1] = *(const uint2*)(vp + 16);
                        o[db] = mfma32(va.v, pb.v, o[db]);
                    }
                }
            }
            ps += __shfl_xor(ps, 32);
            l = l * alpha + ps;
        }
        {
            unsigned char* sw = smem + ((t + 1) & 1) * ATT_STAGE;
#pragma unroll
            for (int i = 0; i < 4; ++i) {
                *(uint4*)(sw + koff + i * 4096) = rk[i];
                *(uint2*)(sw + voff + i * 4352) = make_uint2(rv[i].x, rv[i].y); *(uint2*)(sw + voff + i * 4352 + 8) = make_uint2(rv[i].z, rv[i].w);
            }
        }
        __syncthreads();
    }
    const float inv = __builtin_amdgcn_rcpf(l);
    bf16_t* orow = Og + (size_t)(32 * wid + r) * ldo + 4 * hh;
#pragma unroll
    for (int db = 0; db < 4; ++db)
#pragma unroll
        for (int gq = 0; gq < 4; ++gq)
            *(uint2*)(orow + db * 32 + 8 * gq) = make_uint2(pack_bf16(o[db][4 * gq] * inv, o[db][4 * gq + 1] * inv), pack_bf16(o[db][4 * gq + 2] * inv, o[db][4 * gq + 3] * inv));
}
__device__ void attn_win_unit(const Params& p, int u, unsigned char* smem) {
    const int gh = u % 3, qb = (u / 3) % 16, kvh = (u / 48) % 2, b = u / 96, head = kvh * 3 + gh;
    const int q0 = qb * 128;
    const int ks = q0 - 128 < 0 ? 0 : q0 - 128, ke = q0 + 256 > S_ ? S_ : q0 + 256;
    bf16_t* Q = (bf16_t*)(p.ws + OFF_QA) + (size_t)(b * S_ + q0) * 768 + head * 128;
    const bf16_t* Kb = (const bf16_t*)(p.ws + OFF_KA) + (size_t)(b * S_) * 256 + kvh * 128;
    const bf16_t* Vt = (const bf16_t*)(p.ws + OFF_VAT) + (size_t)(b * 2 + kvh) * 128 * S_;
    attn_block<true>(Q, 768, Kb, 256, Vt, S_, q0, ks / 64, (ke - ks) / 64, p.attn_sink[head] * 1.4426950408889634f, Q, 768, smem);
}
__device__ void attn_mem_unit(const Params& p, int u, unsigned char* smem) {
    const int qb = u % 16, head = (u / 16) % 4, b = u / 64;
    const int q0 = qb * 128;
    unsigned char* dob = (unsigned char*)p.out;
    bf16_t* Q = (bf16_t*)(p.ws + OFF_QM) + (size_t)(b * S_ + q0) * 512 + head * 128;
    const bf16_t* Kb = (const bf16_t*)(dob + DO_KM) + (size_t)(b * MEML) * 512 + head * 128;
    const bf16_t* Vt = (const bf16_t*)(dob + DO_VMT) + (size_t)(b * 4 + head) * 128 * MEML;
    attn_block<false>(Q, 512, Kb, 512, Vt, MEML, q0, 0, 4, 0.f, Q, 512, smem);
}

typedef _Float16 f16x2v __attribute__((ext_vector_type(2)));
__device__ __forceinline__ unsigned pack_f16(float lo, float hi) { return __builtin_bit_cast(unsigned, __builtin_amdgcn_cvt_pkrtz(lo, hi)); }
template <bool FINAL>
__device__ void lru_chunk_unit(const Params& p, int u, unsigned char* smem) {
    const int tid = tidx(), lane = tid & 63, wid = tid >> 6, li = lane & 15, g = lane >> 4;
    const int c = u & 15, h = (u >> 4) % 6, b = u / 96;
    const int cbase = h * 128, s0 = c * 128;
    unsigned char* xcs = smem; unsigned char* LB = smem + 32768; float2* SA = (float2*)(smem + 49152); unsigned char* WL = smem + 51200; float* CC = (float*)(smem + 67584);
    const bf16_t* Xl = (const bf16_t*)(p.ws + OFF_XL) + (size_t)(b * S_) * 768;
    bf16_t* Gl = (bf16_t*)(p.ws + OFF_GL) + (size_t)(b * S_ + s0) * 768;
    const bf16_t* LruWt = (const bf16_t*)(p.ws + OFF_LRUWT) + (size_t)h * 512 * 128;
    const float* SP8 = (const float*)(p.ws + OFF_SP8);
    float2* AGG = (float2*)(p.ws + OFF_AGG);
    bf16_t* LCF = (bf16_t*)((unsigned char*)p.out + DO_LCF) + (size_t)(b * S_ + s0) * 768; bf16_t* LCB = (bf16_t*)(p.ws + OFF_LCB) + (size_t)(b * S_ + s0) * 768;
    auto stage_w = [&](int hc_, int d_) {
#pragma unroll
        for (int i = 0; i < 4; ++i) {
            const int rr = (tid >> 4) + 16 * i, n = rr >> 4, wrow = ((n >> 1) * 2 + d_) * 128 + hc_ * 32 + 16 * (n & 1) + (rr & 15);
            __builtin_amdgcn_global_load_lds((const unsigned*)(LruWt + (size_t)wrow * 128 + (((tid & 15) ^ (rr & 15)) << 3)), (unsigned*)(WL + tid * 16 + i * 4096), 16, 0, 0);
        }
    };
    __syncthreads();
    {
        const int cp = tid & 63, tq = tid >> 6, cch = cbase + 2 * cp;
        float cw[4][2];
#pragma unroll
        for (int j = 0; j < 4; ++j) { cw[j][0] = p.conv_w[j * LW + cch]; cw[j][1] = p.conv_w[j * LW + cch + 1]; }
        const float cb0 = p.conv_b[cch], cb1 = p.conv_b[cch + 1];
#pragma unroll
        for (int hf = 0; hf < 2; ++hf) {
            const int tb = 32 * tq + 16 * hf;
            unsigned xw[19];
#pragma unroll
            for (int i = 0; i < 19; ++i) {
                const int s = s0 + tb + i - 2, sc = s < 0 ? 0 : (s > S_ - 1 ? S_ - 1 : s);
                xw[i] = *(const unsigned*)(Xl + (size_t)sc * 768 + cch);
            }
            PIN15(xw, 0); PIN4(xw, 15);
#pragma unroll
            for (int i = 0; i < 19; ++i) { const int s = s0 + tb + i - 2; xw[i] = (s >= 0 && s < S_) ? xw[i] : 0u; }
#pragma unroll
            for (int i = 0; i < 16; ++i) {
                const int t = tb + i;
                const float y0 = cb0 + cw[0][0] * bflo(xw[i]) + cw[1][0] * bflo(xw[i + 1]) + cw[2][0] * bflo(xw[i + 2]) + cw[3][0] * bflo(xw[i + 3]);
                const float y1 = cb1 + cw[0][1] * bfhi(xw[i]) + cw[1][1] * bfhi(xw[i + 1]) + cw[2][1] * bfhi(xw[i + 2]) + cw[3][1] * bfhi(xw[i + 3]);
                *(unsigned*)(xcs + t * 256 + (((cp >> 2) ^ (t & 15)) << 4) + (cp & 3) * 4) = pack_bf16(y0, y1);
            }
        }
    }
    const int sch = tid & 31, seg = tid >> 5;
    float4 cst[2][3];
    auto load_cst = [&](int hc_, int d_) {
#pragma unroll
        for (int n = 0; n < 2; ++n) {
            const int gch = cbase + hc_ * 32 + 16 * n + 4 * g;
            cst[n][0] = *(const float4*)(p.lru_br + d_ * LW + gch); cst[n][1] = *(const float4*)(p.lru_bi + d_ * LW + gch); cst[n][2] = *(const float4*)(SP8 + d_ * LW + gch);
        }
    };
    stage_w(0, 0);
    __syncthreads();
#pragma unroll 1
    for (int hc = 0; hc < 4; ++hc) {
        float hfv[16], pfv[16];
#pragma unroll
        for (int d = 0; d < 2; ++d) {
            load_cst(hc, d);
            f32x4 acc[2][4];
#pragma unroll
            for (int m = 0; m < 2; ++m)
#pragma unroll
                for (int n = 0; n < 4; ++n) acc[m][n] = (f32x4){0.f, 0.f, 0.f, 0.f};
#pragma unroll
            for (int ks = 0; ks < 4; ++ks) {
                bf16x8 xf[2];
#pragma unroll
                for (int m = 0; m < 2; ++m) { const int row = 32 * wid + 16 * m + li; xf[m] = *(const bf16x8*)(xcs + row * 256 + (((ks * 4 + g) ^ (row & 15)) << 4)); }
#pragma unroll
                for (int n = 0; n < 4; ++n) {
                    const int rr = 16 * n + li;
                    const bf16x8 wf = *(const bf16x8*)(WL + rr * 256 + (((ks * 4 + g) ^ li) << 4));
#pragma unroll
                    for (int m = 0; m < 2; ++m) acc[m][n] = mfma16(wf, xf[m], acc[m][n]);
                }
            }
#pragma unroll
            for (int n = 0; n < 2; ++n) {
                const int ch4 = 16 * n + 4 * g;
                const float4 br4 = cst[n][0], bi4 = cst[n][1], sp4 = cst[n][2];
                const float brv[4] = {br4.x, br4.y, br4.z, br4.w}, biv[4] = {bi4.x, bi4.y, bi4.z, bi4.w}, spv[4] = {sp4.x, sp4.y, sp4.z, sp4.w};
#pragma unroll
                for (int m = 0; m < 2; ++m) {
                    const int tok = 32 * wid + 16 * m + li;
                    const uint2 xq = *(const uint2*)(xcs + tok * 256 + ((((hc * 32 + ch4) >> 3) ^ (tok & 15)) << 4) + (g & 1) * 8);
                    const float xc[4] = {bflo(xq.x), bfhi(xq.x), bflo(xq.y), bfhi(xq.y)};
                    unsigned w[4];
#pragma unroll
                    for (int r = 0; r < 4; ++r) {
                        const float rg = sigmoidf_(acc[m][n][r] + brv[r]), ig = sigmoidf_(acc[m][n + 2][r] + biv[r]);
                        const float la = spv[r] * rg, a = __builtin_amdgcn_exp2f(la);
                        const float bx = __builtin_amdgcn_sqrtf(fmaxf(1.0f - a * a, 0.f)) * (ig * xc[r]);
                        w[r] = pack_f16(la, bx);
                    }
                    *(uint4*)(LB + tok * 128 + (((ch4 >> 2) ^ (tok & 7)) << 4)) = make_uint4(w[0], w[1], w[2], w[3]);
                }
            }
            __syncthreads();
            if (!(hc == 3 && d == 1)) stage_w(d ? hc + 1 : hc, d ^ 1);
            const int gch = cbase + hc * 32 + sch;
            float ak[16];
            {
                float L = 0.f, H = 0.f;
#pragma unroll
                for (int k = 0; k < 16; ++k) {
                    const int tok = 16 * seg + (d ? 15 - k : k);
                    const unsigned w = *(const unsigned*)(LB + tok * 128 + (((sch >> 2) ^ (tok & 7)) << 4) + (sch & 3) * 4);
                    const f16x2v hv = __builtin_bit_cast(f16x2v, w);
                    const float la = (float)hv.x, bx = (float)hv.y;
                    ak[k] = __builtin_amdgcn_exp2f(la);
                    H = ak[k] * H + bx; L += la;
                }
                SA[seg * 32 + sch] = make_float2(L, H);
            }
            __syncthreads();
            if (seg == 0) {
                float L = 0.f, H = 0.f;
#pragma unroll
                for (int s = 0; s < 8; ++s) { const float2 a = SA[(d ? 7 - s : s) * 32 + sch]; H = __builtin_amdgcn_exp2f(a.x) * H + a.y; L += a.x; }
                AGG[((size_t)(d * B_ + b) * 16 + c) * 768 + gch] = make_float2(L, H);
            }
            {
                float H = 0.f, Lc = 0.f;
#pragma unroll
                for (int ss = 0; ss < 8; ++ss) {
                    const int s = d ? 7 - ss : ss;
                    const bool on = d ? (s > seg) : (s < seg);
                    const float2 a = SA[s * 32 + sch];
                    H = __builtin_amdgcn_exp2f(on ? a.x : 0.f) * H + (on ? a.y : 0.f); Lc += on ? a.x : 0.f;
                }
                float Pc = __builtin_amdgcn_exp2f(Lc);
                bf16_t* gp = Gl + (size_t)(16 * seg) * 768 + gch;
                float gv[16];
                if (d) {
                    unsigned gr[16];
#pragma unroll
                    for (int k = 0; k < 16; ++k) gr[k] = gp[(size_t)k * 768];
                    PIN8(gr, 0); PIN8(gr, 8);
#pragma unroll
                    for (int k = 0; k < 16; ++k) gv[k] = __uint_as_float(gr[k] << 16);
                }
                bf16_t* cfp = LCF + (size_t)(16 * seg) * 768 + gch; bf16_t* cbp = LCB + (size_t)(16 * seg) * 768 + gch;
#pragma unroll
                for (int k = 0; k < 16; ++k) {
                    const int kk = d ? 15 - k : k, tok = 16 * seg + kk;
                    const unsigned w = *(const unsigned*)(LB + tok * 128 + (((sch >> 2) ^ (tok & 7)) << 4) + (sch & 3) * 4);
                    const f16x2v hv = __builtin_bit_cast(f16x2v, w);
                    H = ak[k] * H + (float)hv.y;
                    Pc *= ak[k];
                    const float P = Pc;
                    if (d == 0) { hfv[kk] = H; pfv[kk] = P; }
                    else {
                        hfv[kk] = (hfv[kk] + H) * gv[kk];
                        cfp[(size_t)kk * 768] = f2bf(pfv[kk] * gv[kk]);
                        cbp[(size_t)kk * 768] = f2bf(P * gv[kk]);
                    }
                }
                if (d) {
#pragma unroll
                    for (int k = 0; k < 16; ++k) gp[(size_t)k * 768] = f2bf(hfv[k]);
                }
            }
            __syncthreads();
        }
    }
}


__device__ void lru_fixup_unit(const Params& p, int u) {
    const int tid = tidx(), cp = tid & 63, tq = tid >> 6;
    const int c = u & 15, h = (u >> 4) % 6, b = u / 96, cch = h * 128 + 2 * cp, s0 = c * 128;
    const float2* AGG = (const float2*)(p.ws + OFF_AGG);
    float hin[2][2];
#pragma unroll
    for (int d = 0; d < 2; ++d) {
        f32x4 av[16];
#pragma unroll
        for (int j = 0; j < 16; ++j) av[j] = *(const f32x4*)(AGG + ((size_t)(d * B_ + b) * 16 + j) * 768 + cch);
        PIN8(av, 0); PIN8(av, 8);
        float H0 = 0.f, H1 = 0.f;
#pragma unroll
        for (int jj = 0; jj < 16; ++jj) {
            const int j = d ? 15 - jj : jj;
            const bool on = d ? (j > c) : (j < c);
            H0 = __builtin_amdgcn_exp2f(on ? av[j][0] : 0.f) * H0 + (on ? av[j][1] : 0.f);
            H1 = __builtin_amdgcn_exp2f(on ? av[j][2] : 0.f) * H1 + (on ? av[j][3] : 0.f);
        }
        hin[d][0] = H0; hin[d][1] = H1;
    }
    const size_t base = (size_t)(b * S_ + s0 + 32 * tq) * 768 + cch;
    bf16_t* Gl = (bf16_t*)(p.ws + OFF_GL) + base;
    const bf16_t* LCF = (const bf16_t*)((const unsigned char*)p.out + DO_LCF) + base; const bf16_t* LCB = (const bf16_t*)(p.ws + OFF_LCB) + base;
#pragma unroll 1
    for (int g8 = 0; g8 < 4; ++g8) {
        unsigned sv[8], fv[8], bv[8];
#pragma unroll
        for (int i = 0; i < 8; ++i) { const size_t o = (size_t)(g8 * 8 + i) * 768; sv[i] = *(const unsigned*)(Gl + o); fv[i] = *(const unsigned*)(LCF + o); bv[i] = *(const unsigned*)(LCB + o); }
        PIN8(sv, 0); PIN8(fv, 0); PIN8(bv, 0);
#pragma unroll
        for (int i = 0; i < 8; ++i) {
            const float o0 = bflo(sv[i]) + bflo(fv[i]) * hin[0][0] + bflo(bv[i]) * hin[1][0];
            const float o1 = bfhi(sv[i]) + bfhi(fv[i]) * hin[0][1] + bfhi(bv[i]) * hin[1][1];
            *(unsigned*)(Gl + (size_t)(g8 * 8 + i) * 768) = pack_bf16(o0, o1);
        }
    }
}


__device__ __forceinline__ int sortable(float v) { int k = __float_as_int(v); return k ^ ((k >> 31) & 0x7fffffff); }
__device__ __forceinline__ float unsortable(int k) { return __int_as_float(k ^ ((k >> 31) & 0x7fffffff)); }
__device__ __forceinline__ void cex_desc(int& a, int& b) { const int hi = max(a, b), lo = min(a, b); a = hi; b = lo; }
__device__ __forceinline__ void sort16_desc(int (&a)[16]) {
#pragma unroll
    for (int k = 2; k <= 16; k <<= 1)
#pragma unroll
        for (int j = k >> 1; j >= 1; j >>= 1)
#pragma unroll
            for (int i = 0; i < 16; ++i) {
                const int l = i ^ j;
                if (l > i) { if ((i & k) == 0) cex_desc(a[i], a[l]); else cex_desc(a[l], a[i]); }
            }
}
__device__ __forceinline__ void merge16_desc(int (&a)[16], const int (&b)[16]) {
#pragma unroll
    for (int k = 0; k < 16; ++k) a[k] = max(a[k], b[15 - k]);
#pragma unroll
    for (int s = 8; s >= 1; s >>= 1)
#pragma unroll
        for (int k = 0; k < 16; ++k)
            if ((k & s) == 0) cex_desc(a[k], a[k + s]);
}
__device__ __forceinline__ void scores_half(const Params& p, int row0, int pq, unsigned char* smem, int (&lst)[16]) {
    f32x4 acc[4][4]; acc_zero(acc);
    const GemmOp op{(const bf16_t*)(p.ws + OFF_QPEER) + (size_t)row0 * 2048 + pq * 128, (const bf16_t*)(p.ws + OFF_SUBK) + (size_t)pq * 128 * 128, 2048, 128};
    GemmPipe pp{0, false};
    gemm_tile(op, 128, acc, smem, pp);
    float* sc = (float*)smem;
    __syncthreads();
    epi_foreach(acc, [&](int r, int c, float (&v)[8], int, int) {
        *(float4*)(sc + r * 132 + c) = make_float4(v[0], v[1], v[2], v[3]);
        *(float4*)(sc + r * 132 + c + 4) = make_float4(v[4], v[5], v[6], v[7]); });
    __syncthreads();
    const int t = tidx(), r = t & 127, hf = t >> 7;
    {
        int g1[16], g2[16], g3[16];
        auto load16 = [&](int (&g)[16], int q) {
#pragma unroll
            for (int j4 = 0; j4 < 4; ++j4) {
                const int j = hf * 64 + q * 16 + j4 * 4;
                const float4 v = *(const float4*)(sc + r * 132 + j);
                g[4 * j4] = (sortable(v.x) & ~127) | j; g[4 * j4 + 1] = (sortable(v.y) & ~127) | (j + 1);
                g[4 * j4 + 2] = (sortable(v.z) & ~127) | (j + 2); g[4 * j4 + 3] = (sortable(v.w) & ~127) | (j + 3);
            }
        };
        load16(lst, 0); sort16_desc(lst); load16(g1, 1); sort16_desc(g1); merge16_desc(lst, g1);
        load16(g2, 2); sort16_desc(g2); load16(g3, 3); sort16_desc(g3); merge16_desc(g2, g3);
        merge16_desc(lst, g2);
    }
    __syncthreads();
    int* ls = (int*)smem;
    if (hf) {
#pragma unroll
        for (int k = 0; k < 16; ++k) ls[t * 16 + k] = lst[15 - k];
    }
    __syncthreads();
    if (!hf) {
        int ob[16];
#pragma unroll
        for (int k = 0; k < 16; ++k) ob[15 - k] = ls[(t + 128) * 16 + k];
        merge16_desc(lst, ob);
    }
    __syncthreads();
}
__device__ void scores_tile(const Params& p, int rt, int hd, unsigned char* smem) {
    const int row0 = rt * 128;
    int k0[16], k1[16];
    scores_half(p, row0, 2 * hd, smem, k0);
    scores_half(p, row0, 2 * hd + 1, smem, k1);
    const int t = tidx();
    int* ls = (int*)smem;
    if (t < 128) {
#pragma unroll
        for (int k = 0; k < 16; ++k) { ls[t * 32 + k] = k0[k]; ls[t * 32 + 16 + k] = k1[k]; }
        float v0[16], v1[16];
#pragma unroll
        for (int i = 0; i < 16; ++i) { v0[i] = unsortable(k0[i] & ~127); v1[i] = unsortable(k1[i] & ~127); }
        int lst[16], g1[16], g2[16], g3[16];
#pragma unroll
        for (int b = 0; b < 16; ++b) lst[b] = (sortable(v0[0] + v1[b]) & ~255) | b;
        {
            int n = 0;
#pragma unroll
            for (int a = 1; a < 16; ++a)
#pragma unroll
                for (int b = 0; b < 16; ++b)
                    if ((a + 1) * (b + 1) <= 16) {
                        const int key = (sortable(v0[a] + v1[b]) & ~255) | (a * 16 + b);
                        if (n < 16) g1[n] = key; else if (n < 32) g2[n - 16] = key; else g3[n - 32] = key;
                        ++n;
                    }
#pragma unroll
            for (int k = 2; k < 16; ++k) g3[k] = (int)0x80000000;
        }
        sort16_desc(lst); sort16_desc(g1); merge16_desc(lst, g1);
        sort16_desc(g2); sort16_desc(g3); merge16_desc(g2, g3);
        merge16_desc(lst, g2);
        float val[16], sum = 0.f;
        const float mx = unsortable(lst[0] & ~255);
#pragma unroll
        for (int k = 0; k < 16; ++k) { val[k] = __expf(unsortable(lst[k] & ~255) - mx); sum += val[k]; }
        const float inv = 1.0f / sum;
        const int tok = row0 + t;
        int* ei = (int*)(p.ws + OFF_EIDX) + (size_t)tok * 128 + hd * 16;
        float* eg = (float*)(p.ws + OFF_EGATE) + (size_t)tok * 128 + hd * 16;
#pragma unroll
        for (int k = 0; k < 16; ++k) {
            const int code = lst[k] & 255, a = code >> 4, b = code & 15;
            ei[k] = (ls[t * 32 + a] & 127) * 128 + (ls[t * 32 + 16 + b] & 127);
            eg[k] = val[k] * inv;
        }
    }
    __syncthreads();
}


__device__ __forceinline__ void peer_offsets(unsigned (&off)[16], int es0, int es1, int gq, unsigned sub16) {
#pragma unroll
    for (int bb = 0; bb < 8; ++bb) { off[bb] = ((unsigned)__shfl(es0, 8 * bb + gq) << 7) | sub16; off[8 + bb] = ((unsigned)__shfl(es1, 8 * bb + gq) << 7) | sub16; }
}
__device__ __forceinline__ void peer_u_issue(u32x4 (&seg)[8], const unsigned char* Ux, const unsigned (&off)[16], int base) {
#pragma unroll
    for (int bb = 0; bb < 8; ++bb) seg[bb] = *(const u32x4*)(Ux + off[base + bb]);
}
__device__ __forceinline__ int sum8_dpp_i(int v) {
    v += __builtin_amdgcn_mov_dpp(v, 0xB1, 0xF, 0xF, true);
    v += __builtin_amdgcn_mov_dpp(v, 0x4E, 0xF, 0xF, true);
    v += __builtin_amdgcn_mov_dpp(v, 0x141, 0xF, 0xF, true);
    return v;
}
__device__ __forceinline__ float max8_dpp(float v) {
    v = fmaxf(v, __int_as_float(__builtin_amdgcn_mov_dpp(__float_as_int(v), 0xB1, 0xF, 0xF, true)));
    v = fmaxf(v, __int_as_float(__builtin_amdgcn_mov_dpp(__float_as_int(v), 0x4E, 0xF, 0xF, true)));
    v = fmaxf(v, __int_as_float(__builtin_amdgcn_mov_dpp(__float_as_int(v), 0x141, 0xF, 0xF, true)));
    return v;
}
#define DPP_ADD_I(v, ctrl) ((v) + __builtin_amdgcn_mov_dpp((v), (ctrl), 0xF, 0xF, true))
__device__ __forceinline__ int peer_u_half(u32x4 (&seg)[8], const int (&ha)[4], const int (&hb)[4], int sub) {
    PIN8(seg, 0);
    int d[8];
#pragma unroll
    for (int bb = 0; bb < 8; ++bb) {
        int za = 0, zb = 0;
#pragma unroll
        for (int i = 0; i < 4; ++i) { za = __builtin_amdgcn_sdot8((int)seg[bb][i], ha[i], za, false); zb = __builtin_amdgcn_sdot8((int)seg[bb][i], hb[i], zb, false); }
        d[bb] = za * 16 + zb;
    }
    const bool b2 = (sub & 4) != 0, b1 = (sub & 2) != 0, b0 = (sub & 1) != 0;
    int a[4], b[2];
#pragma unroll
    for (int i = 0; i < 4; ++i) { const int lo = DPP_ADD_I(d[i], 0x141), hi = DPP_ADD_I(d[4 + i], 0x141); a[i] = b2 ? hi : lo; }
#pragma unroll
    for (int j = 0; j < 2; ++j) { const int ev = DPP_ADD_I(a[2 * j], 0xB1), od = DPP_ADD_I(a[2 * j + 1], 0xB1); b[j] = b0 ? od : ev; }
    const int c0 = DPP_ADD_I(b[0], 0x4E), c1 = DPP_ADD_I(b[1], 0x4E);
    return b1 ? c1 : c0;
}
__device__ __forceinline__ void peer_u_quant(const uint4 (&hv)[4], int (&ha)[4], int (&hb)[4], float& sh) {
    float h[32];
#pragma unroll
    for (int i = 0; i < 4; ++i) { const unsigned hw[4] = {hv[i].x, hv[i].y, hv[i].z, hv[i].w};
#pragma unroll
        for (int e = 0; e < 4; ++e) { h[8 * i + 2 * e] = bflo(hw[e]); h[8 * i + 2 * e + 1] = bfhi(hw[e]); } }
    float am = 0.f;
#pragma unroll
    for (int e = 0; e < 16; ++e) am = fmaxf(am, fmaxf(fabsf(h[2 * e]), fabsf(h[2 * e + 1])));
    am = max8_dpp(am);
    sh = am > 0.f ? am * (1.0f / 119.0f) : 1.0f;
    const float inv = am > 0.f ? 119.0f * __builtin_amdgcn_rcpf(am) : 0.f;
#pragma unroll
    for (int i = 0; i < 4; ++i) {
        unsigned H[2];
#pragma unroll
        for (int d = 0; d < 2; ++d) {
            const float* hp = h + 8 * i + 4 * d;
            const unsigned b0 = __float_as_uint(hp[0] * inv + 12582912.0f), b1 = __float_as_uint(hp[1] * inv + 12582912.0f);
            const unsigned b2 = __float_as_uint(hp[2] * inv + 12582912.0f), b3 = __float_as_uint(hp[3] * inv + 12582912.0f);
            H[d] = (b0 & 255u) | ((b1 & 255u) << 8) | ((b2 & 255u) << 16) | (b3 << 24);
        }
        const unsigned T0 = ((H[0] & 0x7F7F7F7Fu) + 0x08080808u) ^ (H[0] & 0x80808080u), T1 = ((H[1] & 0x7F7F7F7Fu) + 0x08080808u) ^ (H[1] & 0x80808080u);
        ha[i] = (int)(((T0 >> 4) & 0x0F0F0F0Fu) | (T1 & 0xF0F0F0F0u));
        hb[i] = (int)(((T0 & 0x0F0F0F0Fu) | ((T1 & 0x0F0F0F0Fu) << 4)) ^ 0x88888888u);
    }
}
__device__ void peer_u_pass(const Params& p, int t0, int tstep, int x, int lane) {
    const int gq = lane >> 3, sub = lane & 7;
    const int* eib = (const int*)(p.ws + OFF_EIDX);
    const bf16_t* h2b = (const bf16_t*)(p.ws + OFF_XB) + x * 256 + sub * 32;
    const unsigned char* Uq = p.ws + OFF_UB + (size_t)x * NEXP * 128; const unsigned sub16 = (unsigned)sub * 16u;
    unsigned* Zb = (unsigned*)(p.ws + OFF_ZBUF) + (size_t)x * 64;
    if (t0 >= NTOK) return;
    unsigned off[16];
    { const int es0 = eib[(size_t)t0 * 128 + lane], es1 = eib[(size_t)t0 * 128 + 64 + lane]; peer_offsets(off, es0, es1, gq, sub16); }
    uint4 hv[4];
#pragma unroll
    for (int i = 0; i < 4; ++i) hv[i] = *(const uint4*)(h2b + (size_t)t0 * 1024 + 8 * i);
    u32x4 SA[8], SB[8];
    peer_u_issue(SA, Uq, off, 0);
    for (int t = t0; t < NTOK; t += tstep) {
        const int tn = t + tstep < NTOK ? t + tstep : t;
        const int nes0 = eib[(size_t)tn * 128 + lane], nes1 = eib[(size_t)tn * 128 + 64 + lane];
        uint4 nhv[4];
#pragma unroll
        for (int i = 0; i < 4; ++i) nhv[i] = *(const uint4*)(h2b + (size_t)tn * 1024 + 8 * i);
        int ha[4], hb[4]; float sh;
        peer_u_quant(hv, ha, hb, sh);
        peer_u_issue(SB, Uq, off, 8);
        const int z0 = peer_u_half(SA, ha, hb, sub);
        peer_offsets(off, nes0, nes1, gq, sub16);
        peer_u_issue(SA, Uq, off, 0);
        const int z1 = peer_u_half(SB, ha, hb, sub);
        Zb[(size_t)t * 4 * 64 + lane] = pack_f16((float)z0 * sh, (float)z1 * sh);
#pragma unroll
        for (int i = 0; i < 4; ++i) hv[i] = nhv[i];
    }
}
__device__ void peer_coef_tokens(const Params& p, int tokA, int tokB, int lane) {
    const int pe = 8 * (lane & 7) + (lane >> 3);
    const int* eib = (const int*)(p.ws + OFF_EIDX); const float* egb = (const float*)(p.ws + OFF_EGATE);
    const float* SU = (const float*)(p.ws + OFF_SU); const float* SV = (const float*)(p.ws + OFF_SV);
    const unsigned* Zb = (const unsigned*)(p.ws + OFF_ZBUF); float* Wb = (float*)(p.ws + OFF_WBUF);
    const float* rss = (const float*)(p.ws + OFF_ROWSS1);
    const int tok[2] = {tokA, tokB};
    int e[4]; float g[4], rsv[2];
#pragma unroll
    for (int q = 0; q < 4; ++q) { e[q] = eib[(size_t)tok[q >> 1] * 128 + 64 * (q & 1) + pe]; g[q] = egb[(size_t)tok[q >> 1] * 128 + 64 * (q & 1) + pe]; }
    rsv[0] = rss[tokA]; rsv[1] = rss[tokB];
    unsigned zw[8];
#pragma unroll
    for (int tk = 0; tk < 2; ++tk)
#pragma unroll
        for (int x = 0; x < 4; ++x) zw[tk * 4 + x] = Zb[(size_t)tok[tk] * 4 * 64 + x * 64 + lane];
    float su[4], sv[4];
#pragma unroll
    for (int q = 0; q < 4; ++q) { su[q] = SU[e[q]]; sv[q] = SV[e[q]]; }
    PIN8(zw, 0);
#pragma unroll
    for (int q = 0; q < 4; ++q) {
        float zx[4];
#pragma unroll
        for (int x = 0; x < 4; ++x) { const f16x2v hv = __builtin_bit_cast(f16x2v, zw[(q >> 1) * 4 + x]); zx[x] = (q & 1) ? (float)hv.y : (float)hv.x; }
        const float z = (zx[0] + zx[1]) + (zx[2] + zx[3]);
        const float rs = rsqrtf(rsv[q >> 1] * (1.0f / 1024.0f) + EPS);
        Wb[(size_t)tok[q >> 1] * 128 + (q & 1) * 64 + lane] = gelu_tanh(z * su[q] * rs) * g[q] * sv[q];
    }
}
__device__ __forceinline__ void peer_v_issue4(u32x4 (&seg)[4], const unsigned char* Vx, const unsigned (&off)[16], int base) {
#pragma unroll
    for (int j = 0; j < 4; ++j) seg[j] = *(const u32x4*)(Vx + off[base + j]);
}
__device__ __forceinline__ void peer_v_seg(const u32x4& sg, f32x2v (&o)[16], float c) {
    f32x2v c2; c2.x = c;
    f32x2v t0, t1, t2, t3;
    asm volatile(
        "v_cvt_scalef32_pk_f32_fp4 %[t0], %[s0], 1.0 \n\t"
        "v_cvt_scalef32_pk_f32_fp4 %[t1], %[s0], 1.0 op_sel:[1,0,0]\n\t"
        "v_cvt_scalef32_pk_f32_fp4 %[t2], %[s0], 1.0 op_sel:[0,1,0]\n\t"
        "v_cvt_scalef32_pk_f32_fp4 %[t3], %[s0], 1.0 op_sel:[1,1,0]\n\t"
        "v_pk_fma_f32 %[o0], %[t0], %[c], %[o0] op_sel_hi:[1,0,1]\n\t"
        "v_pk_fma_f32 %[o1], %[t1], %[c], %[o1] op_sel_hi:[1,0,1]\n\t"
        "v_pk_fma_f32 %[o2], %[t2], %[c], %[o2] op_sel_hi:[1,0,1]\n\t"
        "v_pk_fma_f32 %[o3], %[t3], %[c], %[o3] op_sel_hi:[1,0,1]\n\t"
        "v_cvt_scalef32_pk_f32_fp4 %[t0], %[s1], 1.0 \n\t"
        "v_cvt_scalef32_pk_f32_fp4 %[t1], %[s1], 1.0 op_sel:[1,0,0]\n\t"
        "v_cvt_scalef32_pk_f32_fp4 %[t2], %[s1], 1.0 op_sel:[0,1,0]\n\t"
        "v_cvt_scalef32_pk_f32_fp4 %[t3], %[s1], 1.0 op_sel:[1,1,0]\n\t"
        "v_pk_fma_f32 %[o4], %[t0], %[c], %[o4] op_sel_hi:[1,0,1]\n\t"
        "v_pk_fma_f32 %[o5], %[t1], %[c], %[o5] op_sel_hi:[1,0,1]\n\t"
        "v_pk_fma_f32 %[o6], %[t2], %[c], %[o6] op_sel_hi:[1,0,1]\n\t"
        "v_pk_fma_f32 %[o7], %[t3], %[c], %[o7] op_sel_hi:[1,0,1]\n\t"
        "v_cvt_scalef32_pk_f32_fp4 %[t0], %[s2], 1.0 \n\t"
        "v_cvt_scalef32_pk_f32_fp4 %[t1], %[s2], 1.0 op_sel:[1,0,0]\n\t"
        "v_cvt_scalef32_pk_f32_fp4 %[t2], %[s2], 1.0 op_sel:[0,1,0]\n\t"
        "v_cvt_scalef32_pk_f32_fp4 %[t3], %[s2], 1.0 op_sel:[1,1,0]\n\t"
        "v_pk_fma_f32 %[o8], %[t0], %[c], %[o8] op_sel_hi:[1,0,1]\n\t"
        "v_pk_fma_f32 %[o9], %[t1], %[c], %[o9] op_sel_hi:[1,0,1]\n\t"
        "v_pk_fma_f32 %[o10], %[t2], %[c], %[o10] op_sel_hi:[1,0,1]\n\t"
        "v_pk_fma_f32 %[o11], %[t3], %[c], %[o11] op_sel_hi:[1,0,1]\n\t"
        "v_cvt_scalef32_pk_f32_fp4 %[t0], %[s3], 1.0 \n\t"
        "v_cvt_scalef32_pk_f32_fp4 %[t1], %[s3], 1.0 op_sel:[1,0,0]\n\t"
        "v_cvt_scalef32_pk_f32_fp4 %[t2], %[s3], 1.0 op_sel:[0,1,0]\n\t"
        "v_cvt_scalef32_pk_f32_fp4 %[t3], %[s3], 1.0 op_sel:[1,1,0]\n\t"
        "v_pk_fma_f32 %[o12], %[t0], %[c], %[o12] op_sel_hi:[1,0,1]\n\t"
        "v_pk_fma_f32 %[o13], %[t1], %[c], %[o13] op_sel_hi:[1,0,1]\n\t"
        "v_pk_fma_f32 %[o14], %[t2], %[c], %[o14] op_sel_hi:[1,0,1]\n\t"
        "v_pk_fma_f32 %[o15], %[t3], %[c], %[o15] op_sel_hi:[1,0,1]"
        : [o0] "+v"(o[0]), [o1] "+v"(o[1]), [o2] "+v"(o[2]), [o3] "+v"(o[3]), [o4] "+v"(o[4]), [o5] "+v"(o[5]), [o6] "+v"(o[6]), [o7] "+v"(o[7]), [o8] "+v"(o[8]), [o9] "+v"(o[9]), [o10] "+v"(o[10]), [o11] "+v"(o[11]), [o12] "+v"(o[12]), [o13] "+v"(o[13]), [o14] "+v"(o[14]), [o15] "+v"(o[15]),
          [t0] "=&v"(t0), [t1] "=&v"(t1), [t2] "=&v"(t2), [t3] "=&v"(t3)
        : [s0] "v"(sg[0]), [s1] "v"(sg[1]), [s2] "v"(sg[2]), [s3] "v"(sg[3]), [c] "v"(c2));
}
__device__ __forceinline__ void peer_v_quarter(u32x4 (&seg)[4], f32x2v (&o)[16], const float (&cc)[16], int base) {
#pragma unroll
    for (int j = 0; j < 4; ++j) peer_v_seg(seg[j], o, cc[base + j]);
}
__device__ __forceinline__ void peer_coefs(float (&cc)[16], float wk0, float wk1, int gq) {
#pragma unroll
    for (int bb = 0; bb < 8; ++bb) { cc[bb] = __shfl(wk0, 8 * gq + bb); cc[8 + bb] = __shfl(wk1, 8 * gq + bb); }
}
__device__ void peer_v_pass(const Params& p, int t0, int tstep, int x, int lane) {
    const int gq = lane >> 3, sub = lane & 7;
    const int* eib = (const int*)(p.ws + OFF_EIDX);
    const float* Wb = (const float*)(p.ws + OFF_WBUF);
    const unsigned char* Vq = p.ws + OFF_VB + (size_t)x * NEXP * 128; const unsigned sub16 = (unsigned)sub * 16u;
    if (t0 >= NTOK) return;
    const bool b5 = (lane & 32) != 0, b4 = (lane & 16) != 0, b3 = (lane & 8) != 0;
    const int col = x * 256 + 32 * sub + (b5 ? 16 : 0) + (b4 ? 8 : 0) + (b3 ? 4 : 0);
    unsigned off[16]; float cc[16];
    { const int es0 = eib[(size_t)t0 * 128 + lane], es1 = eib[(size_t)t0 * 128 + 64 + lane]; peer_offsets(off, es0, es1, gq, sub16);
      const float wk0 = Wb[(size_t)t0 * 128 + lane], wk1 = Wb[(size_t)t0 * 128 + 64 + lane]; peer_coefs(cc, wk0, wk1, gq); }
    u32x4 SA[4], SB[4], SC[4], SD[4];
    peer_v_issue4(SA, Vq, off, 0); peer_v_issue4(SB, Vq, off, 4);
    for (int t = t0; t < NTOK; t += tstep) {
        f32x2v o2[16];
#pragma unroll
        for (int i = 0; i < 16; ++i) o2[i] = (f32x2v){0.f, 0.f};
        const int tn = t + tstep < NTOK ? t + tstep : t;
        const int nes0 = eib[(size_t)tn * 128 + lane], nes1 = eib[(size_t)tn * 128 + 64 + lane];
        const float nwk0 = Wb[(size_t)tn * 128 + lane], nwk1 = Wb[(size_t)tn * 128 + 64 + lane];
        uint2* xr = (uint2*)(x1b_row(p.ws, (size_t)t) + col);
        const uint2 xw = *xr;
        int gl = gq; asm volatile("" : "+v"(gl));
        peer_v_issue4(SC, Vq, off, 8);  peer_v_quarter(SA, o2, cc, 0);
        peer_v_issue4(SD, Vq, off, 12); peer_v_quarter(SB, o2, cc, 4);
        peer_offsets(off, nes0, nes1, gl, sub16);
        peer_v_issue4(SA, Vq, off, 0);  peer_v_quarter(SC, o2, cc, 8);
        peer_v_issue4(SB, Vq, off, 4);  peer_v_quarter(SD, o2, cc, 12);
        peer_coefs(cc, nwk0, nwk1, gl);
        float a16[16], a8[8], a4[4];
#pragma unroll
        for (int i = 0; i < 16; ++i) { const float lo = (i & 1) ? o2[i >> 1].y : o2[i >> 1].x, hi = (i & 1) ? o2[8 + (i >> 1)].y : o2[8 + (i >> 1)].x;
            const u32x2v r = __builtin_amdgcn_permlane32_swap(__float_as_uint(lo), __float_as_uint(hi), false, false);
            a16[i] = __uint_as_float(r.x) + __uint_as_float(r.y); }
#pragma unroll
        for (int i = 0; i < 8; ++i) { const u32x2v r = __builtin_amdgcn_permlane16_swap(__float_as_uint(a16[i]), __float_as_uint(a16[8 + i]), false, false);
            a8[i] = __uint_as_float(r.x) + __uint_as_float(r.y); }
#pragma unroll
        for (int i = 0; i < 4; ++i) {
            const float u0 = a8[i] + __int_as_float(__builtin_amdgcn_mov_dpp(__float_as_int(a8[i]), 0x128, 0xF, 0xF, true));
            const float u1 = a8[4 + i] + __int_as_float(__builtin_amdgcn_mov_dpp(__float_as_int(a8[4 + i]), 0x128, 0xF, 0xF, true));
            a4[i] = b3 ? u1 : u0;
        }
        const float x0 = bflo(xw.x) + a4[0], x1 = bfhi(xw.x) + a4[1], x2 = bflo(xw.y) + a4[2], x3 = bfhi(xw.y) + a4[3];
        *xr = make_uint2(pack_bf16(x0, x1), pack_bf16(x2, x3));
        const float ss = wave_sum((x0 * x0 + x1 * x1) + (x2 * x2 + x3 * x3));
        if (lane == 0) atomicAdd((float*)(p.ws + OFF_ROWSS) + t, ss);
    }
}
__device__ void final_norm_rows(const Params& p, int t0, int step, int lane) {
    if (t0 >= NTOK) return;
    const float* gf = p.g_final + lane * 16;
    float4 gg[4];
#pragma unroll
    for (int i = 0; i < 4; ++i) gg[i] = *(const float4*)(gf + 4 * i);
    const float* rss = (const float*)(p.ws + OFF_ROWSS);
    uint4 xa, xc; float ss;
    { const uint4* xs = (const uint4*)(x1b_row(p.ws, (size_t)t0) + lane * 16); xa = xs[0]; xc = xs[1]; ss = rss[t0]; }
    for (int t = t0; t < NTOK; t += step) {
        const int tn = t + step < NTOK ? t + step : t;
        const uint4* xs = (const uint4*)(x1b_row(p.ws, (size_t)tn) + lane * 16);
        const uint4 nxa = xs[0], nxc = xs[1]; const float nss = rss[tn];
        float* xr = p.out + (size_t)t * 1024 + lane * 16;
        const float rs = rsqrtf(ss * (1.0f / 1024.0f) + EPS);
        const unsigned xw[8] = {xa.x, xa.y, xa.z, xa.w, xc.x, xc.y, xc.z, xc.w};
#pragma unroll
        for (int i = 0; i < 4; ++i)
            *(float4*)(xr + 4 * i) = make_float4(bflo(xw[2 * i]) * rs * gg[i].x, bfhi(xw[2 * i]) * rs * gg[i].y, bflo(xw[2 * i + 1]) * rs * gg[i].z, bfhi(xw[2 * i + 1]) * rs * gg[i].w);
        xa = nxa; xc = nxc; ss = nss;
    }
}


template <bool F8>
__device__ __forceinline__ void rms_row_finish(const f32x4 (&v)[4], const float* __restrict__ g, bf16_t* __restrict__ o, unsigned char* __restrict__ o8, int lane) {
    float ss = 0.f;
#pragma unroll
    for (int i = 0; i < 4; ++i) ss += (v[i][0] * v[i][0] + v[i][1] * v[i][1]) + (v[i][2] * v[i][2] + v[i][3] * v[i][3]);
    ss = wave_sum(ss);
    const float rs = rsqrtf(ss * (1.0f / 1024.0f) + EPS);
#pragma unroll
    for (int i = 0; i < 4; ++i) {
        const float4 gg = *(const float4*)(g + i * 256 + lane * 4);
        const float y0 = v[i][0] * rs * gg.x, y1 = v[i][1] * rs * gg.y, y2 = v[i][2] * rs * gg.z, y3 = v[i][3] * rs * gg.w;
        *(uint2*)(o + i * 256 + lane * 4) = make_uint2(pack_bf16(y0, y1), pack_bf16(y2, y3));
        if constexpr (F8) { int t = __builtin_amdgcn_cvt_pk_fp8_f32(y0, y1, 0, false); t = __builtin_amdgcn_cvt_pk_fp8_f32(y2, y3, t, true); *(int*)(o8 + i * 256 + lane * 4) = t; }
    }
}
template <bool F8>
__device__ __forceinline__ void rms_rows_pipelined(const float* __restrict__ x, const float* __restrict__ g, bf16_t* __restrict__ o, unsigned char* __restrict__ o8, int nrows, int r0, int step, int lane) {
    if (r0 >= nrows) return;
    f32x4 cur[4], n1[4];
    { const int r1 = r0 + step < nrows ? r0 + step : r0;
#pragma unroll
      for (int i = 0; i < 4; ++i) { cur[i] = *(const f32x4*)(x + (size_t)r0 * 1024 + i * 256 + lane * 4); n1[i] = *(const f32x4*)(x + (size_t)r1 * 1024 + i * 256 + lane * 4); } }
    for (int r = r0; r < nrows; r += step) {
        const int rn = r + 2 * step < nrows ? r + 2 * step : r;
        f32x4 n2[4];
#pragma unroll
        for (int i = 0; i < 4; ++i) n2[i] = *(const f32x4*)(x + (size_t)rn * 1024 + i * 256 + lane * 4);
        PIN4(cur, 0);
        rms_row_finish<F8>(cur, g, o + (size_t)r * 1024, o8 + (size_t)r * 1024, lane);
#pragma unroll
        for (int i = 0; i < 4; ++i) { cur[i] = n1[i]; n1[i] = n2[i]; }
    }
}
template <bool INT8>
__device__ __forceinline__ void conv_row_finish(const f32x4 (&v)[4], unsigned char* __restrict__ dst, float* __restrict__ scale, int row, int lane) {
    float am = 0.f;
#pragma unroll
    for (int i = 0; i < 4; ++i) am = fmaxf(am, fmaxf(fmaxf(fabsf(v[i][0]), fabsf(v[i][1])), fmaxf(fabsf(v[i][2]), fabsf(v[i][3]))));
#pragma unroll
    for (int o = 32; o >= 1; o >>= 1) am = fmaxf(am, __shfl_xor(am, o));
    if constexpr (INT8) {
        float ss = 0.f;
#pragma unroll
        for (int i = 0; i < 4; ++i) ss += (v[i][0] * v[i][0] + v[i][1] * v[i][1]) + (v[i][2] * v[i][2] + v[i][3] * v[i][3]);
#pragma unroll
        for (int o = 32; o >= 1; o >>= 1) ss += __shfl_xor(ss, o);
        const float lim = fminf(am, 2.6f * sqrtf(ss * (1.0f / 1024.0f)));
        const float sc = lim > 0.f ? lim * (1.0f / 7.0f) : 1.0f, inv = 1.0f / sc;
        unsigned w[2];
#pragma unroll
        for (int d = 0; d < 2; ++d) {
            unsigned acc = 0;
#pragma unroll
            for (int b = 0; b < 4; ++b) {
                const int lo = __float2int_rn(fminf(fmaxf(v[2 * d][b] * inv, -7.f), 7.f)), hi = __float2int_rn(fminf(fmaxf(v[2 * d + 1][b] * inv, -7.f), 7.f));
                acc |= (unsigned)((lo & 15) | ((hi & 15) << 4)) << (8 * b);
            }
            w[d] = acc;
        }
        *(uint2*)(dst + ((size_t)(lane >> 4) * NEXP + row) * 128 + (lane & 15) * 8) = make_uint2(w[0], w[1]);
        if (lane == 0) scale[row] = sc;
    } else {
        const float sc4 = am > 0.f ? am * (1.0f / 6.0f) : 1.0f, inv4 = 1.0f / sc4;
        unsigned q[2];
#pragma unroll
        for (int d = 0; d < 2; ++d) {
            unsigned acc = 0;
            acc = __builtin_amdgcn_cvt_scalef32_pk_fp4_f32(acc, v[2 * d][0] * inv4, v[2 * d][1] * inv4, 1.0f, 0);
            acc = __builtin_amdgcn_cvt_scalef32_pk_fp4_f32(acc, v[2 * d][2] * inv4, v[2 * d][3] * inv4, 1.0f, 1);
            acc = __builtin_amdgcn_cvt_scalef32_pk_fp4_f32(acc, v[2 * d + 1][0] * inv4, v[2 * d + 1][1] * inv4, 1.0f, 2);
            acc = __builtin_amdgcn_cvt_scalef32_pk_fp4_f32(acc, v[2 * d + 1][2] * inv4, v[2 * d + 1][3] * inv4, 1.0f, 3);
            q[d] = acc;
        }
        *(uint2*)(dst + ((size_t)(lane >> 4) * NEXP + row) * 128 + (lane & 15) * 8) = make_uint2(q[0], q[1]);
        if (lane == 0) scale[row] = sc4;
    }
}
__device__ __forceinline__ void table_rows_pipelined(const Params& p, int r0, int step, int lane) {
    const int N2 = 2 * NEXP;
    if (r0 >= N2) return;
    auto rowp = [&](int r) { return (const f32x4*)((r < NEXP ? p.peer_u + (size_t)r * 1024 : p.peer_v + (size_t)(r - NEXP) * 1024) + lane * 16); };
    f32x4 cur[4], n1[4];
    { const f32x4* s = rowp(r0); const f32x4* s1 = rowp(r0 + step < N2 ? r0 + step : r0);
#pragma unroll
      for (int i = 0; i < 4; ++i) { cur[i] = s[i]; n1[i] = s1[i]; } }
    for (int r = r0; r < N2; r += step) {
        const f32x4* s = rowp(r + 2 * step < N2 ? r + 2 * step : r);
        f32x4 n2[4];
#pragma unroll
        for (int i = 0; i < 4; ++i) n2[i] = s[i];
        PIN4(cur, 0);
        if (r < NEXP) conv_row_finish<true>(cur, p.ws + OFF_UB, (float*)(p.ws + OFF_SU), r, lane);
        else conv_row_finish<false>(cur, p.ws + OFF_VB, (float*)(p.ws + OFF_SV), r - NEXP, lane);
#pragma unroll
        for (int i = 0; i < 4; ++i) { cur[i] = n1[i]; n1[i] = n2[i]; }
    }
}


namespace pg8 {
#define PG8_LAS __attribute__((address_space(3)))
constexpr int BM = 256, BK = 64, HALF = 128, HTB = HALF * BK * 2  , STAGE_BYTES = 8 * HTB, NXCD = 8, WGM = 8;

__host__ __device__ __forceinline__ int lds_byte(int r, int c) { const int st = (r >> 4) * 2 + (c >> 5), rr = r & 15, cc = c & 31, ob = rr * 64 + cc * 2; return st * 1024 + (ob ^ (((ob >> 9) & 1) << 5)); }
__host__ __device__ __forceinline__ void stage_rc(int b, int& R, int& C) { const int st = b / 1024, sb = b % 1024, swz = sb ^ (((sb >> 9) & 1) << 5); R = (st >> 1) * 16 + swz / 64; C = (st & 1) * 32 + (swz % 64) / 2; }
__host__ __device__ __forceinline__ int perm32(int rho) { const int n = rho >> 4, i = rho & 15; return 8 * (i >> 2) + 4 * n + (i & 3); }

struct Unit { int pm, pn; };
struct Gemm { const bf16_t* A; const bf16_t* Bt; int M, N, K; };

struct StaticOrder {
    int nM, nN, nwg, G, c;
    __host__ __device__ void init(int M, int N, int G_, int c_) { nM = M / BM; nN = N / BM; nwg = nM * nN; G = G_; c = c_; }
    __host__ __device__ bool next(int i, Unit& u) const {
        const long L = (long)i * G + c; if (L >= nwg) return false;
        int wgid = (int)L; { const int q = nwg / NXCD, r = nwg % NXCD, xcd = wgid % NXCD, off = wgid / NXCD; wgid = (xcd < r ? xcd * (q + 1) : r * (q + 1) + (xcd - r) * q) + off; }
        const int nig = WGM * nN, gid = wgid / nig, fm = gid * WGM, gsz = (nM - fm) < WGM ? (nM - fm) : WGM;
        u.pm = fm + ((wgid % nig) % gsz); u.pn = (wgid % nig) / gsz; return true;
    }
    __device__ __forceinline__ void a_ready(const Unit&) const {}
    __device__ __forceinline__ void done(const Unit&) const {}
};


template <class F> struct EpiFn {
    static constexpr bool PERM = true, AFTER_DRAIN = false;
    F f;
    __device__ __forceinline__ void operator()(const f32x4 (&acc)[2][2][4][2], const Unit& u, int wr, int wc, int fr, int fq) const {
#pragma unroll
        for (int ai = 0; ai < 2; ++ai)
#pragma unroll
            for (int m = 0; m < 4; ++m)
#pragma unroll
                for (int bj = 0; bj < 2; ++bj) {
                    float v[8];
#pragma unroll
                    for (int r = 0; r < 4; ++r) { v[r] = acc[ai][bj][m][0][r]; v[4 + r] = acc[ai][bj][m][1][r]; }
                    f(u.pm * BM + ai * HALF + wr * 64 + m * 16 + fr, u.pn * BM + bj * HALF + wc * 32 + 8 * fq, v);
                }
    }
};
template <class Epi, class Sched, bool ALIGN_EPI = false, bool SP2 = false, bool FP8 = false>
__device__ __forceinline__ void gemm_phase(PG8_LAS unsigned char* lds, const Gemm g, const Sched& S, const Epi& E) {
    int tid_ = TIDX(); asm volatile("" : "+v"(tid_));
    const int tid = tid_, wid = __builtin_amdgcn_readfirstlane(tid >> 6), lane = tid & 63, wr = wid >> 2, wc = wid & 3, fr = lane & 15, fq = lane >> 4;
    const int K = g.K, nt = K / BK;
    unsigned voffA[2], voffB[2];
#pragma unroll
    for (int i = 0; i < 2; ++i) { int R, C; stage_rc(tid * 16 + i * 8192, R, C); const int Rb = Epi::PERM ? ((R & ~31) + perm32(R & 31)) : R;
        voffA[i] = (unsigned)(R * K + C) * 2u; voffB[i] = (unsigned)(Rb * K + C) * 2u; }
    const size_t kstep = (size_t)(BK * 2);
    const size_t hstep = (size_t)HALF * K * 2;
    const size_t tstep = 2 * hstep;
    const unsigned ldsw = (unsigned)wid * 1024u;
    const int aoff = lds_byte(wr * 64 + fr, fq * 8), boff = lds_byte(wc * 32 + fr, fq * 8);
#define PG8_SA(b, h) (((b) * 2 + (h)) * HTB)
#define PG8_SB(b, h) ((4 + (b) * 2 + (h)) * HTB)
#define PG8_STAGE(bufoff, gbase, voff) do { const unsigned long long gb_ = (unsigned long long)(gbase); \
        const char* sb_ = (const char*)(((unsigned long long)(unsigned)__builtin_amdgcn_readfirstlane((int)(gb_ >> 32)) << 32) | (unsigned)__builtin_amdgcn_readfirstlane((int)gb_)); \
        _Pragma("unroll") for (int _i = 0; _i < 2; ++_i) \
        __builtin_amdgcn_global_load_lds((const unsigned*)(sb_ + (voff)[_i]), (PG8_LAS unsigned*)(lds + (bufoff) + ldsw + _i * 8192), 16, 0, 0); } while (0)
    unsigned bbase_ = (unsigned)boff + 4u * HTB; asm volatile("" : "+v"(bbase_));
    const unsigned abase = (unsigned)aoff & 0xffffu, bbase = bbase_ & 0x3ffffu;
#define PG8_LDAM(dst, b, h, m0, cnt) do { _Pragma("unroll") for (int m = 0; m < (cnt); ++m) { const i32x4 l0_ = *(const PG8_LAS i32x4*)(lds + abase + (PG8_SA(b, h) + ((m0) + m) * 2048)), l1_ = *(const PG8_LAS i32x4*)(lds + abase + (PG8_SA(b, h) + ((m0) + m) * 2048 + 1024)); \
        dst[m] = __builtin_shufflevector(l0_, l1_, 0, 1, 2, 3, 4, 5, 6, 7); } } while (0)
#define PG8_LDA(dst, b, h) do { if constexpr (FP8) PG8_LDAM(dst, b, h, 0, 2); else PG8_LDAM(dst, b, h, 0, 4); } while (0)
#define PG8_LDB(dst, b, h) do { _Pragma("unroll") for (int n = 0; n < 2; ++n) { const i32x4 l0_ = *(const PG8_LAS i32x4*)(lds + bbase + (((b) * 2 + (h)) * HTB + n * 2048)), l1_ = *(const PG8_LAS i32x4*)(lds + bbase + (((b) * 2 + (h)) * HTB + n * 2048 + 1024)); \
        dst[n] = __builtin_shufflevector(l0_, l1_, 0, 1, 2, 3, 4, 5, 6, 7); } } while (0)
#define PG8_HALF(v, k) __builtin_bit_cast(bf16x8, __builtin_shufflevector(v, v, 4 * (k), 4 * (k) + 1, 4 * (k) + 2, 4 * (k) + 3))
#define PG8_MMA(ai, bj, At, Bt) do { __builtin_amdgcn_s_setprio(1); _Pragma("unroll") for (int m = 0; m < 4; ++m) _Pragma("unroll") for (int n = 0; n < 2; ++n) { \
        acc[ai][bj][m][n] = __builtin_amdgcn_mfma_f32_16x16x32_bf16(PG8_HALF(Bt[n], 0), PG8_HALF(At[m], 0), acc[ai][bj][m][n], 0, 0, 0); \
        acc[ai][bj][m][n] = __builtin_amdgcn_mfma_f32_16x16x32_bf16(PG8_HALF(Bt[n], 1), PG8_HALF(At[m], 1), acc[ai][bj][m][n], 0, 0, 0); } \
        __builtin_amdgcn_s_setprio(0); } while (0)
#define PG8_MMA8(ai, bj, Bt, m0) do { _Pragma("unroll") for (int m = 0; m < 2; ++m) _Pragma("unroll") for (int n = 0; n < 2; ++n) \
        acc[ai][bj][(m0) + m][n] = __builtin_amdgcn_mfma_scale_f32_16x16x128_f8f6f4(Bt[n], At[m], acc[ai][bj][(m0) + m][n], 0, 0, 0, 0, 0, 0); } while (0)
#define PG8_MM2(ai, b, h) do { if constexpr (FP8) { __builtin_amdgcn_s_setprio(1); PG8_MMA8(ai, 0, B0, 0); PG8_MMA8(ai, 1, B1, 0); PG8_LDAM(At, b, h, 2, 2); asm volatile("s_waitcnt lgkmcnt(0)" ::: "memory"); \
        PG8_MMA8(ai, 0, B0, 2); PG8_MMA8(ai, 1, B1, 2); __builtin_amdgcn_s_setprio(0); } else { PG8_MMA(ai, 0, At, B0); PG8_MMA(ai, 1, At, B1); } } while (0)
#define PG8_WAIT_V(n) asm volatile("s_waitcnt vmcnt(" #n ")" ::: "memory")
#define PG8_WAIT_L(n) asm volatile("s_waitcnt lgkmcnt(" #n ")" ::: "memory")
#define PG8_BAR __builtin_amdgcn_s_barrier()
#define PG8_SCHED __builtin_amdgcn_sched_barrier(0)
    Unit cur, nxt; int ui = 0;
    if (!S.next(0, cur)) return;
    f32x4 acc[2][2][4][2];
#pragma unroll
    for (int a = 0; a < 2; ++a)
#pragma unroll
        for (int b = 0; b < 2; ++b)
#pragma unroll
            for (int m = 0; m < 4; ++m)
#pragma unroll
                for (int n = 0; n < 2; ++n) acc[a][b][m][n] = (f32x4){0.f, 0.f, 0.f, 0.f};
    i32x8 At[4], B0[2], B1[2];
    const char* cA = (const char*)g.A + (size_t)cur.pm * tstep; const char* cB = (const char*)g.Bt + (size_t)cur.pn * tstep;
    S.a_ready(cur);
    if constexpr (SP2) {
        PG8_STAGE(PG8_SB(0, 0), cB, voffB); PG8_STAGE(PG8_SB(0, 1), cB + hstep, voffB); PG8_STAGE(PG8_SA(0, 0), cA, voffA); PG8_STAGE(PG8_SA(0, 1), cA + hstep, voffA);
        if (wr == 1) PG8_BAR;
        PG8_WAIT_V(2); PG8_BAR;
        PG8_STAGE(PG8_SB(1, 0), cB + kstep, voffB); PG8_STAGE(PG8_SA(1, 0), cA + kstep, voffA); PG8_STAGE(PG8_SB(1, 1), cB + hstep + kstep, voffB);
        PG8_WAIT_V(6); PG8_BAR;
    } else {
        PG8_STAGE(PG8_SB(0, 0), cB, voffB); PG8_STAGE(PG8_SA(0, 0), cA, voffA); PG8_STAGE(PG8_SB(0, 1), cB + hstep, voffB); PG8_STAGE(PG8_SA(0, 1), cA + hstep, voffA);
        if (wr == 1) PG8_BAR;
        PG8_WAIT_V(4); PG8_BAR;
        PG8_STAGE(PG8_SB(1, 0), cB + kstep, voffB); PG8_STAGE(PG8_SA(1, 0), cA + kstep, voffA); PG8_STAGE(PG8_SB(1, 1), cB + hstep + kstep, voffB);
        PG8_WAIT_V(6); PG8_BAR;
    }
    for (;;) {
        const bool has_next = S.next(ui + 1, nxt);
        const char* nA = has_next ? (const char*)g.A + (size_t)nxt.pm * tstep : cA; const char* nB = has_next ? (const char*)g.Bt + (size_t)nxt.pn * tstep : cB;
        for (int t = 0; t < nt; t += 2) {
            const bool last = (t == nt - 2);
            const char* a1 = cA + (size_t)(t + 1) * kstep;
            const char* a2 = last ? nA : cA + (size_t)(t + 2) * kstep; const char* b2 = last ? nB : cB + (size_t)(t + 2) * kstep;
            const char* a3 = a2 + kstep; const char* b3 = b2 + kstep;
            if (last && has_next) S.a_ready(nxt);
            if constexpr (SP2) {
            PG8_LDB(B0, 0, 0); PG8_LDB(B1, 0, 1); PG8_SCHED; PG8_LDA(At, 0, 0); PG8_STAGE(PG8_SA(1, 1), a1 + hstep, voffA);
            PG8_WAIT_V(8); PG8_WAIT_L(0); PG8_BAR; PG8_MM2(0, 0, 0); PG8_BAR; PG8_SCHED;
            PG8_LDA(At, 0, 1); PG8_STAGE(PG8_SB(0, 0), b2, voffB); PG8_STAGE(PG8_SB(0, 1), b2 + hstep, voffB); PG8_STAGE(PG8_SA(0, 0), a2, voffA);
            PG8_WAIT_V(8); PG8_WAIT_L(0); PG8_BAR; PG8_MM2(1, 0, 1); PG8_BAR; PG8_SCHED;
            PG8_LDB(B0, 1, 0); PG8_LDB(B1, 1, 1); PG8_SCHED; PG8_LDA(At, 1, 0); PG8_STAGE(PG8_SA(0, 1), a2 + hstep, voffA);
            PG8_WAIT_V(8); PG8_WAIT_L(0); PG8_BAR; PG8_MM2(0, 1, 0); PG8_BAR; PG8_SCHED;
            PG8_LDA(At, 1, 1); PG8_STAGE(PG8_SB(1, 0), b3, voffB); PG8_STAGE(PG8_SB(1, 1), b3 + hstep, voffB); PG8_STAGE(PG8_SA(1, 0), a3, voffA);
            PG8_WAIT_V(8); PG8_WAIT_L(0); PG8_BAR; PG8_MM2(1, 1, 1); PG8_BAR; PG8_SCHED;
            } else {
            PG8_LDB(B0, 0, 0); PG8_SCHED; PG8_LDA(At, 0, 0); PG8_STAGE(PG8_SA(1, 1), a1 + hstep, voffA);
            PG8_WAIT_L(8); PG8_BAR; PG8_WAIT_L(0); PG8_MMA(0, 0, At, B0); PG8_BAR; PG8_SCHED;
            PG8_LDB(B1, 0, 1); PG8_STAGE(PG8_SB(0, 0), b2, voffB);
            PG8_BAR; PG8_WAIT_L(0); PG8_MMA(0, 1, At, B1); PG8_BAR;
            PG8_LDA(At, 0, 1); PG8_STAGE(PG8_SA(0, 0), a2, voffA);
            PG8_BAR; PG8_WAIT_L(0); PG8_MMA(1, 0, At, B0); PG8_BAR; PG8_SCHED;
            PG8_STAGE(PG8_SB(0, 1), b2 + hstep, voffB);
            PG8_WAIT_V(6); PG8_BAR; PG8_MMA(1, 1, At, B1); PG8_BAR;
            PG8_LDB(B0, 1, 0); PG8_SCHED; PG8_LDA(At, 1, 0); PG8_STAGE(PG8_SA(0, 1), a2 + hstep, voffA);
            PG8_WAIT_L(8); PG8_BAR; PG8_WAIT_L(0); PG8_MMA(0, 0, At, B0); PG8_BAR; PG8_SCHED;
            PG8_LDB(B1, 1, 1); PG8_STAGE(PG8_SB(1, 0), b3, voffB);
            PG8_BAR; PG8_WAIT_L(0); PG8_MMA(0, 1, At, B1); PG8_BAR;
            PG8_LDA(At, 1, 1); PG8_STAGE(PG8_SA(1, 0), a3, voffA);
            PG8_BAR; PG8_WAIT_L(0); PG8_MMA(1, 0, At, B0); PG8_BAR; PG8_SCHED;
            PG8_STAGE(PG8_SB(1, 1), b3 + hstep, voffB);
            PG8_WAIT_V(6); PG8_BAR; PG8_MMA(1, 1, At, B1); PG8_BAR;
            }
        }
        if constexpr (ALIGN_EPI) { if (wr == 0) PG8_BAR; }
        if constexpr (!Epi::AFTER_DRAIN) { int fr_ = fr, fq_ = fq; asm volatile("" : "+v"(fr_), "+v"(fq_));
                                           E(acc, cur, wr, wc, fr_, fq_); S.done(cur); }
        if (!has_next) break;
#pragma unroll
        for (int a = 0; a < 2; ++a)
#pragma unroll
            for (int b = 0; b < 2; ++b)
#pragma unroll
                for (int m = 0; m < 4; ++m)
#pragma unroll
                    for (int n = 0; n < 2; ++n) acc[a][b][m][n] = (f32x4){0.f, 0.f, 0.f, 0.f};
        cur = nxt; cA = nA; cB = nB; ++ui;
        if constexpr (ALIGN_EPI) { if (wr == 1) PG8_BAR; }
    }
    PG8_WAIT_V(0);
    if constexpr (!ALIGN_EPI) { if (wr == 0) PG8_BAR; }
    PG8_BAR;
    if constexpr (Epi::AFTER_DRAIN) { E.fused(acc, cur, wr, wc, fr, fq, lds, wid, lane); S.done(cur); }
#undef PG8_SA
#undef PG8_SB
#undef PG8_STAGE
#undef PG8_LDA
#undef PG8_LDB
#undef PG8_MMA
#undef PG8_MMA8
#undef PG8_MM2
#undef PG8_LDAM
#undef PG8_HALF
#undef PG8_WAIT_V
#undef PG8_WAIT_L
#undef PG8_BAR
#undef PG8_SCHED
}

}


namespace pg8 {
__device__ __forceinline__ void item_vals(const f32x4 (&acc)[2][2][4][2], int ai, int bj, int m, float (&v)[8]) {
#pragma unroll
    for (int r = 0; r < 4; ++r) { v[r] = acc[ai][bj][m][0][r]; v[4 + r] = acc[ai][bj][m][1][r]; }
}
struct EpiOutproj {
    static constexpr bool PERM = true, AFTER_DRAIN = false;
    const float* x; unsigned char* ws; const float* gffn; bf16_t* xb; float* rowss;
    __device__ __forceinline__ void operator()(const f32x4 (&acc)[2][2][4][2], const Unit& u, int wr, int wc, int fr, int fq) const {
        f32x4 gv[4];
#pragma unroll
        for (int bj = 0; bj < 2; ++bj) { const float* gp = gffn + u.pn * BM + bj * HALF + wc * 32 + 8 * fq; gv[2 * bj] = *(const f32x4*)gp; gv[2 * bj + 1] = *(const f32x4*)(gp + 4); }
#pragma unroll
        for (int ai = 0; ai < 2; ++ai)
#pragma unroll
            for (int mh = 0; mh < 2; ++mh) {
                f32x4 xv[8];
#pragma unroll
                for (int mm = 0; mm < 2; ++mm)
#pragma unroll
                    for (int bj = 0; bj < 2; ++bj) {
                        const int m = mh * 2 + mm;
                        const size_t o = (size_t)(u.pm * BM + ai * HALF + wr * 64 + m * 16 + fr) * 1024 + u.pn * BM + bj * HALF + wc * 32 + 8 * fq;
                        xv[(mm * 2 + bj) * 2] = *(const f32x4*)(x + o); xv[(mm * 2 + bj) * 2 + 1] = *(const f32x4*)(x + o + 4);
                    }
                PIN8(xv, 0); if (ai == 0 && mh == 0) PIN4(gv, 0);
#pragma unroll
                for (int mm = 0; mm < 2; ++mm) {
                    const int m = mh * 2 + mm;
                    const size_t row = (size_t)(u.pm * BM + ai * HALF + wr * 64 + m * 16 + fr);
                    float ss = 0.f;
#pragma unroll
                    for (int bj = 0; bj < 2; ++bj) {
                        const size_t o = row * 1024 + u.pn * BM + bj * HALF + wc * 32 + 8 * fq;
                        const f32x4 a = xv[(mm * 2 + bj) * 2] + acc[ai][bj][m][0], b = xv[(mm * 2 + bj) * 2 + 1] + acc[ai][bj][m][1];
                        { const float xv8[8] = {a[0], a[1], a[2], a[3], b[0], b[1], b[2], b[3]};
                          store_bf16x8(x1b_row(ws, row) + u.pn * BM + bj * HALF + wc * 32 + 8 * fq, xv8); }
                        ss += (a[0] * a[0] + a[1] * a[1]) + (a[2] * a[2] + a[3] * a[3]) + (b[0] * b[0] + b[1] * b[1]) + (b[2] * b[2] + b[3] * b[3]);
                        const f32x4 ga = a * gv[2 * bj], gb = b * gv[2 * bj + 1];
                        const float v[8] = {ga[0], ga[1], ga[2], ga[3], gb[0], gb[1], gb[2], gb[3]};
                        store_bf16x8(xb + o, v);
                    }
                    ss += __shfl_xor(ss, 16); ss += __shfl_xor(ss, 32);
                    if (fq == 0) atomicAdd(rowss + row, ss);
                }
            }
    }
};
struct EpiMerge {
    static constexpr bool PERM = true, AFTER_DRAIN = false;
    const bf16_t* G; bf16_t* merged; int br;
    __device__ __forceinline__ void operator()(const f32x4 (&acc)[2][2][4][2], const Unit& u, int wr, int wc, int fr, int fq) const {
#pragma unroll
        for (int ai = 0; ai < 2; ++ai)
#pragma unroll
            for (int mh = 0; mh < 2; ++mh) {
                u32x4 gm[8];
#pragma unroll
                for (int mm = 0; mm < 2; ++mm)
#pragma unroll
                    for (int bj = 0; bj < 2; ++bj) {
                        const int m = mh * 2 + mm;
                        const size_t row = (size_t)(u.pm * BM + ai * HALF + wr * 64 + m * 16 + fr); const int col = u.pn * BM + bj * HALF + wc * 32 + 8 * fq;
                        gm[mm * 2 + bj] = *(const u32x4*)(G + row * 3072 + br * 1024 + col);
                        gm[4 + mm * 2 + bj] = br > 0 ? *(const u32x4*)(merged + row * 1024 + col) : (u32x4){0u, 0u, 0u, 0u};
                    }
                PIN8(gm, 0);
#pragma unroll
                for (int mm = 0; mm < 2; ++mm)
#pragma unroll
                    for (int bj = 0; bj < 2; ++bj) {
                        const int m = mh * 2 + mm;
                        const size_t row = (size_t)(u.pm * BM + ai * HALF + wr * 64 + m * 16 + fr); const int col = u.pn * BM + bj * HALF + wc * 32 + 8 * fq;
                        float v[8]; item_vals(acc, ai, bj, m, v);
                        const u32x4 g4 = gm[mm * 2 + bj], t = gm[4 + mm * 2 + bj];
#pragma unroll
                        for (int e = 0; e < 4; ++e) { v[2 * e] = v[2 * e] * bflo(g4[e]) + bflo(t[e]); v[2 * e + 1] = v[2 * e + 1] * bfhi(g4[e]) + bfhi(t[e]); }
                        store_bf16x8(merged + row * 1024 + col, v);
                    }
            }
    }
};
struct EpiInproj {
    static constexpr bool PERM = true, AFTER_DRAIN = false;
    unsigned char* ws; const float* cs; const float* gate_b; int pn0; float gsc;
    __device__ __forceinline__ void operator()(const f32x4 (&acc)[2][2][4][2], const Unit& u, int wr, int wc, int fr, int fq) const {
        const int pn = u.pn + pn0;
        if (pn < 4) {
            const bool isq = pn < 3;
            bf16_t* dst = isq ? (bf16_t*)(ws + OFF_QA) + pn * 256 : (bf16_t*)(ws + OFF_KA);
            const int ld = isq ? 768 : 256; const float sc = isq ? QSCALE : 1.0f;
#pragma unroll
            for (int ai = 0; ai < 2; ++ai)
#pragma unroll
                for (int mh = 0; mh < 2; ++mh) {
                    f32x4 csv[8];
                    if (wc == 0) {
#pragma unroll
                        for (int mm = 0; mm < 2; ++mm) {
                            const f32x4* csr = (const f32x4*)(cs + (size_t)(u.pm * BM + ai * HALF + wr * 64 + (mh * 2 + mm) * 16 + fr) * 32 + (fq & 1) * 16);
#pragma unroll
                            for (int q = 0; q < 4; ++q) csv[mm * 4 + q] = csr[q];
                        }
                        PIN8(csv, 0);
                    }
#pragma unroll
                    for (int mm = 0; mm < 2; ++mm)
#pragma unroll
                        for (int bj = 0; bj < 2; ++bj) {
                            const int m = mh * 2 + mm;
                            const size_t row = (size_t)(u.pm * BM + ai * HALF + wr * 64 + m * 16 + fr);
                            float v[8]; item_vals(acc, ai, bj, m, v);
                            if (wc == 0) {
                                const f32x4 c0 = csv[mm * 4], c1 = csv[mm * 4 + 1], c2 = csv[mm * 4 + 2], c3 = csv[mm * 4 + 3];
                                const float ccv[8] = {c0[0], c0[2], c1[0], c1[2], c2[0], c2[2], c3[0], c3[2]};
                                const float ssv[8] = {c0[1], c0[3], c1[1], c1[3], c2[1], c2[3], c3[1], c3[3]};
#pragma unroll
                                for (int e = 0; e < 8; ++e) {
                                    const float o = __shfl_xor(v[e], 32);
                                    v[e] = (fq < 2) ? (v[e] * ccv[e] - o * ssv[e]) : (v[e] * ccv[e] + o * ssv[e]);
                                }
                            }
#pragma unroll
                            for (int e = 0; e < 8; ++e) v[e] *= sc;
                            store_bf16x8(dst + row * ld + bj * HALF + wc * 32 + 8 * fq, v);
                        }
                }
        } else if (pn == 4) {
#pragma unroll
            for (int ai = 0; ai < 2; ++ai)
#pragma unroll
                for (int m = 0; m < 4; ++m)
#pragma unroll
                    for (int bj = 0; bj < 2; ++bj) {
                        const int row = u.pm * BM + ai * HALF + wr * 64 + m * 16 + fr, b = row / S_, s = row % S_;
                        float v[8]; item_vals(acc, ai, bj, m, v);
                        bf16_t* vt = (bf16_t*)(ws + OFF_VAT) + ((size_t)(b * 2 + bj) * 128 + wc * 32 + 8 * fq) * S_ + s;
#pragma unroll
                        for (int e = 0; e < 8; ++e) vt[(size_t)e * S_] = f2bf(v[e]);
                    }
        } else if (pn < 13) {
            const int kind = pn < 8 ? 0 : (pn < 11 ? 1 : 2);
            bf16_t* dst = kind == 0 ? (bf16_t*)(ws + OFF_XL) + (pn - 5) * 256 : (kind == 1 ? (bf16_t*)(ws + OFF_GL) + (pn - 8) * 256 : (bf16_t*)(ws + OFF_QM) + (pn - 11) * 256);
            const int ld = kind == 2 ? 512 : 768;
#pragma unroll
            for (int ai = 0; ai < 2; ++ai)
#pragma unroll
                for (int m = 0; m < 4; ++m)
#pragma unroll
                    for (int bj = 0; bj < 2; ++bj) {
                        const size_t row = (size_t)(u.pm * BM + ai * HALF + wr * 64 + m * 16 + fr);
                        float v[8]; item_vals(acc, ai, bj, m, v);
                        if (kind == 1) {
#pragma unroll
                            for (int e = 0; e < 8; ++e) v[e] = gelu_tanh(v[e]);
                        } else if (kind == 2) {
#pragma unroll
                            for (int e = 0; e < 8; ++e) v[e] *= QSCALE;
                        }
                        store_bf16x8(dst + row * ld + bj * HALF + wc * 32 + 8 * fq, v);
                    }
        } else {
            const int gc0 = (pn - 13) * 256;
            f32x4 gbv[4];
#pragma unroll
            for (int bj = 0; bj < 2; ++bj) { const float* gb = gate_b + gc0 + bj * HALF + wc * 32 + 8 * fq; gbv[2 * bj] = *(const f32x4*)gb; gbv[2 * bj + 1] = *(const f32x4*)(gb + 4); }
            PIN4(gbv, 0);
            bf16_t* dst = (bf16_t*)(ws + OFF_GATES) + gc0;
#pragma unroll
            for (int ai = 0; ai < 2; ++ai)
#pragma unroll
                for (int m = 0; m < 4; ++m)
#pragma unroll
                    for (int bj = 0; bj < 2; ++bj) {
                        const size_t row = (size_t)(u.pm * BM + ai * HALF + wr * 64 + m * 16 + fr);
                        float v[8]; item_vals(acc, ai, bj, m, v);
                        const f32x4 b0 = gbv[2 * bj], b1 = gbv[2 * bj + 1];
#pragma unroll
                        for (int e = 0; e < 4; ++e) { v[e] = sigmoidf_(v[e] * gsc + b0[e]); v[4 + e] = sigmoidf_(v[4 + e] * gsc + b1[e]); }
                        store_bf16x8(dst + row * 3072 + bj * HALF + wc * 32 + 8 * fq, v);
                    }
        }
    }
};
}

#define XB_TMO      128
#define XB_XCNT(j)  (256  + 64 * (j))
#define XB_XSUB(j)  (1280 + 64 * (j))
#define XB_XGEN(j)  (2304 + 64 * (j))
#define XB_TOP      3328
#define XB_TOPGEN   3392
#define XCD_BAR_WORDS 3456
#define XB_SPIN_CAP (1u << 22)
#define LAS __attribute__((address_space(3)))
__device__ __forceinline__ unsigned xb_ld(unsigned* p)              { return __hip_atomic_load(p, __ATOMIC_RELAXED, __HIP_MEMORY_SCOPE_AGENT); }
__device__ __forceinline__ unsigned xb_add(unsigned* p, unsigned v) { return __hip_atomic_fetch_add(p, v, __ATOMIC_RELAXED, __HIP_MEMORY_SCOPE_AGENT); }
__device__ __forceinline__ unsigned xb_xcc_id() { return (unsigned)__builtin_amdgcn_s_getreg((3 << 11) | 20) & 0xFu; }
#define XB_SPIN(cond, bar) do { unsigned _sp = 0; while (cond) { __builtin_amdgcn_s_sleep(1); \
    if ((++_sp & 255u) == 0u) { if (xb_ld(&(bar)[XB_TMO])) break; if (_sp > XB_SPIN_CAP) { atomicAdd(&(bar)[XB_TMO], 1u); break; } } } } while (0)
struct XcdBarrier { unsigned* bar; unsigned x; volatile LAS unsigned* st; };
__device__ __forceinline__ XcdBarrier xcd_barrier_post(unsigned* bar, volatile LAS unsigned* st) {
    XcdBarrier b; b.bar = bar; b.x = xb_xcc_id(); b.st = st;
    if (TIDX() == 0) (void)xb_add(&bar[XB_XCNT(b.x)], 1u);
    return b;
}
__device__ __forceinline__ void xcd_barrier_complete(unsigned* bar, unsigned x, unsigned& nloc, unsigned& nx) {
    const unsigned G = gridDim.x;
    unsigned sum, cnt, mine, sp = 0u;
    for (;;) {
        sum = 0u; cnt = 0u; mine = 0u;
#pragma unroll
        for (unsigned j = 0; j < 16; ++j) { const unsigned c = xb_ld(&bar[XB_XCNT(j)]); sum += c; cnt += (c > 0u) ? 1u : 0u; mine = (j == x) ? c : mine; }
        if (sum == G) break;
        __builtin_amdgcn_s_sleep(1);
        if ((++sp & 255u) == 0u) { if (xb_ld(&bar[XB_TMO])) break; if (sp > XB_SPIN_CAP) { atomicAdd(&bar[XB_TMO], 1u); break; } }
    }
    nloc = mine > 0u ? mine : 1u; nx = cnt > 0u ? cnt : 1u;
}
__device__ __forceinline__ void xcd_barrier(const XcdBarrier& b) {
    asm volatile("s_waitcnt vmcnt(0)" ::: "memory");
    __syncthreads();
    if (TIDX() == 0) {
        unsigned* bar = b.bar;
        __builtin_amdgcn_s_waitcnt(0);
        unsigned nloc = b.st[0], nx = b.st[1];
        if (nloc == 0u) { xcd_barrier_complete(bar, b.x, nloc, nx); b.st[0] = nloc; b.st[1] = nx; }
        const unsigned old = xb_add(&bar[XB_XSUB(b.x)], 1u);
        const unsigned gen = old / nloc;
        if (old + 1u == (gen + 1u) * nloc) {
            __builtin_amdgcn_fence(__ATOMIC_RELEASE, "agent");
            asm volatile("s_waitcnt vmcnt(0)" ::: "memory");
            const unsigned og = xb_add(&bar[XB_TOP], 1u);
            const unsigned tg = og / nx;
            if (og + 1u == (tg + 1u) * nx) xb_add(&bar[XB_TOPGEN], 1u);
            else XB_SPIN(xb_ld(&bar[XB_TOPGEN]) == tg, bar);
            __builtin_amdgcn_fence(__ATOMIC_ACQUIRE, "agent");
            xb_add(&bar[XB_XGEN(b.x)], 1u);
            asm volatile("s_waitcnt vmcnt(0)" ::: "memory");
        } else {
            XB_SPIN(xb_ld(&bar[XB_XGEN(b.x)]) == gen, bar);
            __builtin_amdgcn_fence(__ATOMIC_ACQUIRE, "agent");
            asm volatile("s_waitcnt vmcnt(0)" ::: "memory");
        }
    }
    __syncthreads();
}

#ifndef PROBE_PHASE
#define PROBE_PHASE -1
#endif
#define PH_BEGIN(k) if (PROBE_PHASE == (k)) probe_t0 = __builtin_amdgcn_s_memrealtime();
#define PH_END(k)   if (PROBE_PHASE == (k)) probe_dt = __builtin_amdgcn_s_memrealtime() - probe_t0;
constexpr int SMEM_BYTES = 128 * 132 * 4 + 1024;

__global__ void __launch_bounds__(512, 2) fwd_megakernel(Params p) {
    __shared__ __attribute__((aligned(16))) unsigned char smem_all[2 * SMEM_BYTES + 32];
    if ((threadIdx.x & 63) == 0) g_wslot[wave_phys()] = (int)(threadIdx.x >> 6);
    if (threadIdx.x == 0) { *(uint4*)(smem_all + 2 * SMEM_BYTES) = make_uint4(0u, 0u, 0u, 0u); *(uint4*)(smem_all + 2 * SMEM_BYTES + 16) = make_uint4(0u, 0u, 0u, 0u); }
    __syncthreads();
    const XcdBarrier xb = xcd_barrier_post((unsigned*)(p.ws + OFF_BAR), (volatile LAS unsigned*)(smem_all + 2 * SMEM_BYTES));
    const int nb = vnb();
#define PHASE_IDS int vb_ = TIDX() >> 8; asm volatile("" : "+v"(vb_)); const int vb = vb_, bid = (int)blockIdx.x + vb * (int)gridDim.x, tid = tidx(), lane = tid & 63, wid = tid >> 6; unsigned char* smem = smem_all + vb * SMEM_BYTES; (void)bid; (void)tid; (void)lane; (void)wid; (void)smem;
    unsigned char* ws = p.ws; unsigned char* dob = (unsigned char*)p.out;
    unsigned long long probe_t0 = 0, probe_dt = 0;
    PH_BEGIN(0)
    { PHASE_IDS
    {
        auto unit_desc = [&](int u0) {
            const int u = u0 < 3232 ? u0 : 3231;
            ConvT c;
            if (u < 1600) { const bool g8 = (u % 100) * 64 >= 3328; c = ConvT{p.w_in, g8 ? (bf16_t*)(ws + OFF_WG8) : (bf16_t*)(ws + OFF_WINT), 1024, INW, u, 3328}; }
            else if (u < 1856) c = ConvT{p.w_mem_kv, (bf16_t*)(ws + OFF_WMKVT), 1024, 1024, u - 1600, 1 << 30};
            else if (u < 2048) c = ConvT{p.p_attn, (bf16_t*)(ws + OFF_PATTNT), 768, 1024, u - 1856, 1 << 30};
            else if (u < 2240) c = ConvT{p.p_lru, (bf16_t*)(ws + OFF_PLRUT), 768, 1024, u - 2048, 1 << 30};
            else if (u < 2368) c = ConvT{p.p_mem, (bf16_t*)(ws + OFF_PMEMT), 512, 1024, u - 2240, 1 << 30};
            else if (u < 2624) c = ConvT{p.w_out, (bf16_t*)(ws + OFF_WOUTT), 1024, 1024, u - 2368, 1 << 30};
            else if (u < 3136) c = ConvT{p.w_peer_q, (bf16_t*)(ws + OFF_WPQT), 1024, 2048, u - 2624, 1 << 30};
            else {
                const int v = u - 3136, mat = v >> 2, tile = v & 3, gsel = mat / 6, h = mat % 6, dir = gsel & 1;
                c = ConvT{(gsel < 2 ? p.lru_wr : p.lru_wi) + (size_t)(dir * 6 + h) * 128 * 128, (bf16_t*)(ws + OFF_LRUWT) + (size_t)(h * 512 + gsel * 128) * 128, 128, 128, tile, 1 << 30};
            }
            return c;
        };
        {
            const int uend = 3232 + nb - 1 - (3231 % nb);
            ConvT cur = unit_desc(bid);
            float4 v[4];
            convT_load(cur, v);
            for (int u0 = bid; u0 < uend; u0 += nb) {
                const ConvT nxt = unit_desc(u0 + nb);
                float4 nv[4];
                convT_load(nxt, nv);
                convT_finish(cur, v, smem);
                cur = nxt;
#pragma unroll
                for (int i = 0; i < 4; ++i) v[i] = nv[i];
            }
        }
        conv_plain(p.peer_sub_keys, (bf16_t*)(ws + OFF_SUBK), (size_t)16 * 128 * 128 / 8);
        table_rows_pipelined(p, bid * 4 + wid, nb * 4, lane);
        rms_rows_pipelined<true>(p.x, p.g_mix, (bf16_t*)(dob + DO_HBF), ws + OFF_HB8, NTOK, bid * 4 + wid, nb * 4, lane);
        rms_rows_pipelined<false>(p.mem, p.g_mem, (bf16_t*)(dob + DO_MEMBF), ws, NMEM, bid * 4 + wid, nb * 4, lane);
        for (int i = bid * 256 + tid; i < NTOK * 16; i += nb * 256) rope_item(p.positions, (float*)(dob + DO_ROPE), i);
        for (int i = bid * 256 + tid; i < NTOK; i += nb * 256) { ((float*)(ws + OFF_ROWSS))[i] = 0.f; ((float*)(ws + OFF_ROWSS1))[i] = 0.f; }
        for (int i = bid * 256 + tid; i < 2 * LW; i += nb * 256) ((float*)(ws + OFF_SP8))[i] = -8.0f * 1.4426950408889634f * log1pf(__expf(-p.lru_lambda[i]));
    }
    xcd_barrier(xb);
    PH_END(0) PH_BEGIN(1)
    }
    { PHASE_IDS
    {
        const pg8::Gemm g{(const bf16_t*)(dob + DO_HBF), (const bf16_t*)(ws + OFF_WINT), NTOK, 3328, 1024};
        pg8::StaticOrder S; S.init(NTOK, 3328, (int)gridDim.x, (int)blockIdx.x);
        __syncthreads();
        pg8::gemm_phase<pg8::EpiInproj, pg8::StaticOrder, true, true>((PG8_LAS unsigned char*)smem_all, g, S, pg8::EpiInproj{ws, (const float*)(dob + DO_ROPE), p.gate_b, 0, 1.0f});
    }
    }
    { PHASE_IDS
    { const bool tail = gridDim.x == 256; const int u = tail ? ((int)blockIdx.x - 128) + vb * 128 : (bid & 255);
      if (!tail || blockIdx.x >= 128) memkv_tile(p, u / 8, u % 8, smem); }
    }
    { PHASE_IDS
    {
        const pg8::Gemm g{(const bf16_t*)(ws + OFF_HB8), (const bf16_t*)(ws + OFF_WG8), NTOK, 3072, 512};
        pg8::StaticOrder S; S.init(NTOK, 3072, (int)gridDim.x, (int)blockIdx.x);
        __syncthreads();
        pg8::gemm_phase<pg8::EpiInproj, pg8::StaticOrder, true, true, true>((PG8_LAS unsigned char*)smem_all, g, S, pg8::EpiInproj{ws, (const float*)(dob + DO_ROPE), p.gate_b, 13, 1.0f / WG8_SCALE});
    }
    xcd_barrier(xb);
    PH_END(1) PH_BEGIN(2)
    }
    { PHASE_IDS
    {
        unsigned* ctr = (unsigned*)(p.ws + OFF_BAR) + 3600;
        volatile LAS unsigned* slot = (volatile LAS unsigned*)(smem_all + 2 * SMEM_BYTES + 16);
        for (;;) {
            if (TIDX() == 0) *slot = xb_add(ctr, 2u);
            __syncthreads();
            const int u = (int)*slot + vb;
            __syncthreads();
            if (u >= 1536 + 1536 + 1024) break;
            if (u < 1536) lru_chunk_unit<true>(p, u, smem);
            else if (u < 1536 + 1536) attn_win_unit(p, u - 1536, smem);
            else attn_mem_unit(p, u - 1536 - 1536, smem);
        }
    }
    xcd_barrier(xb);
    }
    { PHASE_IDS
    for (int u = bid; u < 1536; u += nb) lru_fixup_unit(p, u);
    xcd_barrier(xb);
    PH_END(2) PH_BEGIN(3)
    }
    { PHASE_IDS
    {
        pg8::StaticOrder S; S.init(NTOK, 1024, (int)gridDim.x, (int)blockIdx.x);
        const bf16_t* G = (const bf16_t*)(ws + OFF_GATES); bf16_t* mg = (bf16_t*)(ws + OFF_MERGED);
        __syncthreads();
        { const pg8::Gemm g{(const bf16_t*)(ws + OFF_QA), (const bf16_t*)(ws + OFF_PATTNT), NTOK, 1024, 768};
          pg8::gemm_phase<pg8::EpiMerge, pg8::StaticOrder, true, true>((PG8_LAS unsigned char*)smem_all, g, S, pg8::EpiMerge{G, mg, 0}); }
        { const pg8::Gemm g{(const bf16_t*)(ws + OFF_GL), (const bf16_t*)(ws + OFF_PLRUT), NTOK, 1024, 768};
          pg8::gemm_phase<pg8::EpiMerge, pg8::StaticOrder, true, true>((PG8_LAS unsigned char*)smem_all, g, S, pg8::EpiMerge{G, mg, 1}); }
        { const pg8::Gemm g{(const bf16_t*)(ws + OFF_QM), (const bf16_t*)(ws + OFF_PMEMT), NTOK, 1024, 512};
          pg8::gemm_phase<pg8::EpiMerge, pg8::StaticOrder, true, true>((PG8_LAS unsigned char*)smem_all, g, S, pg8::EpiMerge{G, mg, 2}); }
    }
    xcd_barrier(xb);
    PH_END(3) PH_BEGIN(4)
    }
    { PHASE_IDS
    {
        const pg8::Gemm g{(const bf16_t*)(ws + OFF_MERGED), (const bf16_t*)(ws + OFF_WOUTT), NTOK, 1024, 1024};
        pg8::StaticOrder S; S.init(NTOK, 1024, (int)gridDim.x, (int)blockIdx.x);
        __syncthreads();
        pg8::gemm_phase<pg8::EpiOutproj, pg8::StaticOrder, true, true>((PG8_LAS unsigned char*)smem_all, g, S, pg8::EpiOutproj{p.x, ws, p.g_ffn, (bf16_t*)(ws + OFF_XB), (float*)(ws + OFF_ROWSS1)});
    }
    xcd_barrier(xb);
    PH_END(4) PH_BEGIN(6)
    }
    { PHASE_IDS
    {
        const pg8::Gemm g{(const bf16_t*)(ws + OFF_XB), (const bf16_t*)(ws + OFF_WPQT), NTOK, 2048, 1024};
        pg8::StaticOrder S; S.init(NTOK, 2048, (int)gridDim.x, (int)blockIdx.x);
        bf16_t* qp = (bf16_t*)(ws + OFF_QPEER); const float* rss = (const float*)(ws + OFF_ROWSS1);
        auto f = [=](int row, int col, float (&v)[8]) {
            const float rs = rsqrtf(rss[row] * (1.0f / 1024.0f) + EPS);
#pragma unroll
            for (int e = 0; e < 8; ++e) v[e] *= rs;
            store_bf16x8(qp + (size_t)row * 2048 + col, v); };
        pg8::gemm_phase<pg8::EpiFn<decltype(f)>, pg8::StaticOrder, true, true>((PG8_LAS unsigned char*)smem_all, g, S, pg8::EpiFn<decltype(f)>{f});
    }
    xcd_barrier(xb);
    PH_END(6) PH_BEGIN(7)
    }
    { PHASE_IDS
    for (int u = bid; u < 256 * 8; u += nb) scores_tile(p, u / 8, u % 8, smem);
    xcd_barrier(xb);
    PH_END(7) PH_BEGIN(9)
    }
    { PHASE_IDS
    {
        const int x = (int)blockIdx.x & 7, tstep = (nb >> 3) * 4;
        peer_u_pass(p, (bid >> 2) * 4 + wid, (nb >> 2) * 4, x & 3, lane);
        xcd_barrier(xb);
        for (int t = bid * 4 + wid; t < NTOK; t += nb * 8) peer_coef_tokens(p, t, t + nb * 4, lane);
        xcd_barrier(xb);
        peer_v_pass(p, (bid >> 2) * 4 + wid, (nb >> 2) * 4, x & 3, lane);
        xcd_barrier(xb);
        final_norm_rows(p, bid * 4 + wid, nb * 4, lane);
    }
    }
    PH_END(9)
    if (PROBE_PHASE >= 0) { __syncthreads(); const unsigned long long t1 = __builtin_amdgcn_s_memrealtime(); while (__builtin_amdgcn_s_memrealtime() - t1 < probe_dt) __builtin_amdgcn_s_sleep(8); }
}

extern "C" void kernel_launch(void* const* d_in, const int* in_sizes, int n_in, void* d_out, int out_size, void* d_ws, size_t ws_size, hipStream_t stream) {
    if (ws_size < OFF_END) { fprintf(stderr, "workspace too small: %zu < %zu\n", ws_size, (size_t)OFF_END); return; }
    Params p{};
    p.x = (const float*)d_in[0]; p.mem = (const float*)d_in[1]; p.positions = (const int*)d_in[2];
    p.g_mix = (const float*)d_in[3]; p.g_mem = (const float*)d_in[4]; p.w_in = (const float*)d_in[5]; p.gate_b = (const float*)d_in[6];
    p.attn_sink = (const float*)d_in[7]; p.conv_w = (const float*)d_in[8]; p.conv_b = (const float*)d_in[9];
    p.lru_wr = (const float*)d_in[10]; p.lru_br = (const float*)d_in[11]; p.lru_wi = (const float*)d_in[12]; p.lru_bi = (const float*)d_in[13];
    p.lru_lambda = (const float*)d_in[14]; p.w_mem_kv = (const float*)d_in[15]; p.p_attn = (const float*)d_in[16]; p.p_lru = (const float*)d_in[17];
    p.p_mem = (const float*)d_in[18]; p.w_out = (const float*)d_in[19]; p.g_ffn = (const float*)d_in[20]; p.w_peer_q = (const float*)d_in[21];
    p.peer_sub_keys = (const float*)d_in[22]; p.peer_u = (const float*)d_in[23]; p.peer_v = (const float*)d_in[24]; p.g_final = (const float*)d_in[25];
    p.out = (float*)d_out; p.ws = (unsigned char*)d_ws;
    static int grid_blocks = 0;
    if (!grid_blocks) {
        int dev = 0, cus = 0, per_cu = 0;
        (void)hipGetDevice(&dev);
        (void)hipDeviceGetAttribute(&cus, hipDeviceAttributeMultiprocessorCount, dev);
        (void)hipOccupancyMaxActiveBlocksPerMultiprocessor(&per_cu, fwd_megakernel, 512, 0);
        if (per_cu > 1) per_cu = 1;
        grid_blocks = cus * per_cu;
    }
    (void)hipMemsetAsync((unsigned char*)d_ws + OFF_BAR, 0, 16384, stream);
    void* args[] = {&p};
    hipError_t e = hipLaunchCooperativeKernel((void*)fwd_megakernel, dim3(grid_blocks), dim3(512), args, 0, stream);
    if (e != hipSuccess) fprintf(stderr, "cooperative launch failed: %s (grid %d)\n", hipGetErrorString(e), grid_blocks);
}
```

```cpp
#include <hip/hip_runtime.h>
#include <stdint.h>
#include <stdio.h>

typedef unsigned short bf16_t;
typedef short bf16x8 __attribute__((ext_vector_type(8)));
typedef __bf16 bf16x2v __attribute__((ext_vector_type(2)));
typedef float f32x4 __attribute__((ext_vector_type(4)));

constexpr int B_ = 16, S_ = 2048, D_ = 1024, NTOK = B_ * S_;
constexpr int MEML = 256, NMEM = B_ * MEML;
constexpr int INW = 6400;
constexpr int LW = 768;
constexpr int NEXP = 16384;
constexpr float EPS = 1e-6f;
constexpr float QSCALE = 0.08838834764831845f * 1.4426950408889634f;

constexpr size_t OFF_WINT = 0;
constexpr size_t OFF_WMKVT = OFF_WINT + (size_t)INW * 1024 * 2;
constexpr size_t OFF_PATTNT = OFF_WMKVT + (size_t)1024 * 1024 * 2;
constexpr size_t OFF_PLRUT = OFF_PATTNT + (size_t)1024 * 768 * 2;
constexpr size_t OFF_PMEMT = OFF_PLRUT + (size_t)1024 * 768 * 2;
constexpr size_t OFF_WOUTT = OFF_PMEMT + (size_t)1024 * 512 * 2;
constexpr size_t OFF_WPQT = OFF_WOUTT + (size_t)1024 * 1024 * 2;
constexpr size_t OFF_LRUWT = OFF_WPQT + (size_t)2048 * 1024 * 2;
constexpr size_t OFF_SUBK = OFF_LRUWT + (size_t)6 * 512 * 128 * 2;
constexpr size_t OFF_UB = OFF_SUBK + (size_t)16 * 128 * 128 * 2;
constexpr size_t OFF_VB = OFF_UB + (size_t)NEXP * 1024;
constexpr size_t OFF_SU = OFF_VB + (size_t)NEXP * 1024;
constexpr size_t OFF_SV = OFF_SU + (size_t)NEXP * 4;
constexpr size_t OFF_RA = OFF_SV + (size_t)NEXP * 4;
constexpr size_t OFF_QA = OFF_RA;
constexpr size_t OFF_KA = OFF_QA + (size_t)NTOK * 768 * 2;
constexpr size_t OFF_VAT = OFF_KA + (size_t)NTOK * 256 * 2;
constexpr size_t OFF_XL = OFF_VAT + (size_t)NTOK * 256 * 2;
constexpr size_t OFF_GL = OFF_XL + (size_t)NTOK * 768 * 2;
constexpr size_t OFF_QM = OFF_GL + (size_t)NTOK * 768 * 2;
constexpr size_t OFF_GATES = OFF_QM + (size_t)NTOK * 512 * 2;
constexpr size_t OFF_BAR = OFF_GATES + (size_t)NTOK * 3072 * 2;
constexpr size_t OFF_SP8 = OFF_BAR + 16384;
constexpr size_t OFF_AGG = OFF_SP8 + 2 * 768 * 4;
constexpr size_t OFF_ROWSS = OFF_AGG + (size_t)2 * B_ * 16 * 768 * 8;
constexpr size_t OFF_ROWSS1 = OFF_ROWSS + (size_t)NTOK * 4;
constexpr size_t OFF_LCB = OFF_ROWSS1 + (size_t)NTOK * 4;
constexpr size_t OFF_END = OFF_LCB + (size_t)NTOK * 768 * 2;
constexpr size_t OFF_XB = OFF_GL;
constexpr size_t OFF_MERGED = OFF_KA;
constexpr size_t OFF_QPEER = OFF_GATES;
constexpr size_t OFF_TOPL = OFF_QPEER + (size_t)NTOK * 2048 * 2;
constexpr size_t OFF_EIDX = OFF_TOPL + (size_t)NTOK * 256 * 4;
constexpr size_t OFF_ZBUF = OFF_QPEER;
constexpr size_t OFF_WBUF = OFF_TOPL;
constexpr size_t OFF_EGATE = OFF_EIDX + (size_t)NTOK * 128 * 4;
static_assert(OFF_EGATE + (size_t)NTOK * 128 * 4 <= OFF_BAR, "overlay");
static_assert(OFF_MERGED + (size_t)NTOK * 1024 * 2 <= OFF_GL, "overlay2");
constexpr size_t DO_LCF = 0;
constexpr size_t DO_HBF = 0;
constexpr size_t DO_MEMBF = DO_HBF + (size_t)NTOK * 1024 * 2;
constexpr size_t DO_KM = DO_MEMBF + (size_t)NMEM * 1024 * 2;
constexpr size_t DO_VMT = DO_KM + (size_t)NMEM * 512 * 2;
constexpr size_t DO_ROPE = DO_VMT + (size_t)NMEM * 512 * 2;
static_assert(DO_ROPE + (size_t)NTOK * 32 * 4 <= (size_t)NTOK * 1024 * 4, "d_out scratch");

struct Params {
    const float *x, *mem; const int* positions;
    const float *g_mix, *g_mem, *w_in, *gate_b, *attn_sink, *conv_w, *conv_b, *lru_wr, *lru_br, *lru_wi, *lru_bi, *lru_lambda,
        *w_mem_kv, *p_attn, *p_lru, *p_mem, *w_out, *g_ffn, *w_peer_q, *peer_sub_keys, *peer_u, *peer_v, *g_final;
    float* out; unsigned char* ws;
};

__device__ __forceinline__ int tidx() { int t = threadIdx.x & 255; asm volatile("" : "+v"(t)); return t; }
__device__ __forceinline__ int vbid() { return (int)(blockIdx.x + (threadIdx.x >> 8) * gridDim.x); }
__device__ __forceinline__ int vnb() { return (int)(2 * gridDim.x); }
__device__ __forceinline__ float bf2f(bf16_t b) { return __uint_as_float(((unsigned)b) << 16); }
__device__ __forceinline__ float bflo(unsigned u) { return __uint_as_float(u << 16); }
__device__ __forceinline__ float bfhi(unsigned u) { return __uint_as_float(u & 0xffff0000u); }
typedef float f32x2v __attribute__((ext_vector_type(2)));
__device__ __forceinline__ unsigned pack_bf16(float lo, float hi) { const f32x2v f = {lo, hi}; return __builtin_bit_cast(unsigned, __builtin_convertvector(f, bf16x2v)); }
__device__ __forceinline__ bf16_t* x1b_row(unsigned char* ws, size_t row) { return (bf16_t*)(ws + OFF_XB) + row * 1024; }
__device__ __forceinline__ bf16_t f2bf(float f) { return (bf16_t)(pack_bf16(f, 0.f) & 0xffffu); }
__device__ __forceinline__ f32x4 mfma16(bf16x8 a, bf16x8 b, f32x4 c) { return __builtin_amdgcn_mfma_f32_16x16x32_bf16(a, b, c, 0, 0, 0); }
__device__ __forceinline__ float sigmoidf_(float x) { return __builtin_amdgcn_rcpf(1.0f + __expf(-x)); }
__device__ __forceinline__ float gelu_tanh(float x) { const float u = 1.5957691216057308f * (x + 0.044715f * x * x * x); return x * __builtin_amdgcn_rcpf(1.0f + __expf(-u)); }
__device__ __forceinline__ float wave_sum(float v) {
#pragma unroll
    for (int o = 32; o >= 1; o >>= 1) v += __shfl_xor(v, o);
    return v;
}


typedef unsigned u32x4 __attribute__((ext_vector_type(4)));
typedef unsigned u32x2v __attribute__((ext_vector_type(2)));
typedef _Float16 f16x2v __attribute__((ext_vector_type(2)));
#define PIN4(a, o) asm volatile("" : "+v"((a)[(o)]), "+v"((a)[(o) + 1]), "+v"((a)[(o) + 2]), "+v"((a)[(o) + 3]))
#define PIN8(a, o) asm volatile("" : "+v"((a)[(o)]), "+v"((a)[(o) + 1]), "+v"((a)[(o) + 2]), "+v"((a)[(o) + 3]), "+v"((a)[(o) + 4]), "+v"((a)[(o) + 5]), "+v"((a)[(o) + 6]), "+v"((a)[(o) + 7]))
#define PIN15(a, o) asm volatile("" : "+v"((a)[(o)]), "+v"((a)[(o) + 1]), "+v"((a)[(o) + 2]), "+v"((a)[(o) + 3]), "+v"((a)[(o) + 4]), "+v"((a)[(o) + 5]), "+v"((a)[(o) + 6]), "+v"((a)[(o) + 7]), \
    "+v"((a)[(o) + 8]), "+v"((a)[(o) + 9]), "+v"((a)[(o) + 10]), "+v"((a)[(o) + 11]), "+v"((a)[(o) + 12]), "+v"((a)[(o) + 13]), "+v"((a)[(o) + 14]))

struct ConvT { const float* src; bf16_t* dst; int K, N, tile; const float* ks; };
__device__ __forceinline__ void convT_load(const ConvT& c, float4 (&v)[4]) {
    const int tn = c.N / 64, tk = c.tile / tn, tnn = c.tile % tn, k0 = tk * 64, n0 = tnn * 64, tid = tidx();
    const int r = tid >> 4, c4 = (tid & 15) * 4;
#pragma unroll
    for (int i = 0; i < 4; ++i) v[i] = *(const float4*)(c.src + (size_t)(k0 + r + 16 * i) * c.N + n0 + c4);
    if (c.ks) {
#pragma unroll
        for (int i = 0; i < 4; ++i) { const float g = c.ks[k0 + r + 16 * i]; v[i].x *= g; v[i].y *= g; v[i].z *= g; v[i].w *= g; }
    }
}
__device__ __forceinline__ void convT_finish(const ConvT& c, const float4 (&v)[4], unsigned char* smem) {
    float* t = (float*)smem;
    const int tn = c.N / 64, tk = c.tile / tn, tnn = c.tile % tn, k0 = tk * 64, n0 = tnn * 64, tid = tidx();
    const int r = tid >> 4, c4 = (tid & 15) * 4;
#pragma unroll
    for (int i = 0; i < 4; ++i) {
        const int k = r + 16 * i;
        t[k * 65 + c4 + 0] = v[i].x; t[k * 65 + c4 + 1] = v[i].y; t[k * 65 + c4 + 2] = v[i].z; t[k * 65 + c4 + 3] = v[i].w;
    }
    __syncthreads();
    const int n = tid >> 2, kq = (tid & 3) * 16;
    unsigned w[8];
#pragma unroll
    for (int i = 0; i < 8; ++i) w[i] = pack_bf16(t[(kq + 2 * i) * 65 + n], t[(kq + 2 * i + 1) * 65 + n]);
    uint4* d = (uint4*)(c.dst + (size_t)(n0 + n) * c.K + k0 + kq);
    d[0] = make_uint4(w[0], w[1], w[2], w[3]); d[1] = make_uint4(w[4], w[5], w[6], w[7]);
    __syncthreads();
}


__device__ __forceinline__ void conv_plain(const float* __restrict__ src, bf16_t* __restrict__ dst, size_t n8) {
    for (size_t i = (size_t)vbid() * 256 + tidx(); i < n8; i += (size_t)vnb() * 256) {
        const float4 a = ((const float4*)src)[2 * i], b = ((const float4*)src)[2 * i + 1];
        ((uint4*)dst)[i] = make_uint4(pack_bf16(a.x, a.y), pack_bf16(a.z, a.w), pack_bf16(b.x, b.y), pack_bf16(b.z, b.w));
    }
}
__device__ __forceinline__ void rope_item(const int* __restrict__ pos, float* __restrict__ cs, int i) {
    const int t = i >> 4, f = i & 15;
    const float inv = powf(500000.0f, -(float)(2 * f) / 32.0f);
    const float ang = (float)pos[t] * inv;
    float s, c; sincosf(ang, &s, &c);
    cs[2 * i] = c; cs[2 * i + 1] = s;
}

__device__ __forceinline__ int swz(int row) { return (row & 3) | (((row >> 3) & 1) << 2); }

struct GemmOp { const bf16_t* A; const bf16_t* Bt; int lda, ldb; };
struct GemmPipe { int par; bool pre; };

__device__ __forceinline__ void gemm_issue(const GemmOp& op, int kt, int st, unsigned char* smem) {
    const int tid = tidx();
    const int srow = tid >> 3, skc = (tid & 7) ^ swz(tid >> 3);
    const bf16_t* ga = op.A + (size_t)srow * op.lda + skc * 8 + kt * 64;
    const bf16_t* gb = op.Bt + (size_t)srow * op.ldb + skc * 8 + kt * 64;
    unsigned char* sw = smem + tid * 16 + st * 32768;
#pragma unroll
    for (int i = 0; i < 4; ++i) {
        __builtin_amdgcn_global_load_lds((const unsigned*)(ga + (size_t)(32 * i) * op.lda), (unsigned*)(sw + i * 4096), 16, 0, 0);
        __builtin_amdgcn_global_load_lds((const unsigned*)(gb + (size_t)(32 * i) * op.ldb), (unsigned*)(sw + 16384 + i * 4096), 16, 0, 0);
    }
}

__device__ __forceinline__ void gemm_tile(const GemmOp& op, int K, f32x4 (&acc)[4][4], unsigned char* smem, GemmPipe& pp) {
    const int tid = tidx(), lane = tid & 63, wid = tid >> 6, wr = wid >> 1, wc = wid & 1, li = lane & 15, g = lane >> 4;
    int aoff[4], boff[4], asw[4], bsw[4];
#pragma unroll
    for (int m = 0; m < 4; ++m) { const int row = wr * 64 + m * 16 + li; aoff[m] = row * 128; asw[m] = swz(row); }
#pragma unroll
    for (int n = 0; n < 4; ++n) { const int row = wc * 64 + 32 * (n >> 1) + 8 * (li >> 2) + 4 * (n & 1) + (li & 3); boff[n] = 16384 + row * 128; bsw[n] = swz(row); }
    const int nk = K >> 6;
    if (!pp.pre) gemm_issue(op, 0, pp.par, smem);
    __syncthreads();
    for (int kt = 0; kt < nk; ++kt) {
        const int cur = (pp.par + kt) & 1;
        const unsigned char* sb = smem + cur * 32768;
        if (kt + 1 < nk) gemm_issue(op, kt + 1, cur ^ 1, smem);
#pragma unroll
        for (int ks = 0; ks < 2; ++ks) {
            bf16x8 af[4], bfr[4];
#pragma unroll
            for (int m = 0; m < 4; ++m) af[m] = *(const bf16x8*)(sb + aoff[m] + (((ks * 4 + g) ^ asw[m]) << 4));
#pragma unroll
            for (int n = 0; n < 4; ++n) bfr[n] = *(const bf16x8*)(sb + boff[n] + (((ks * 4 + g) ^ bsw[n]) << 4));
#pragma unroll
            for (int m = 0; m < 4; ++m)
#pragma unroll
                for (int n = 0; n < 4; ++n) acc[m][n] = mfma16(bfr[n], af[m], acc[m][n]);
        }
        if (kt + 1 < nk) __syncthreads();
    }
    pp.par = (pp.par + nk) & 1; pp.pre = false;
}
__device__ __forceinline__ void acc_zero(f32x4 (&acc)[4][4]) {
#pragma unroll
    for (int m = 0; m < 4; ++m)
#pragma unroll
        for (int n = 0; n < 4; ++n) acc[m][n] = (f32x4){0.f, 0.f, 0.f, 0.f};
}
template <class F> __device__ __forceinline__ void epi_foreach(const f32x4 (&acc)[4][4], F&& f) {
    const int lane = tidx() & 63, wid = tidx() >> 6, wr = wid >> 1, wc = wid & 1, li = lane & 15, g = lane >> 4;
#pragma unroll
    for (int m = 0; m < 4; ++m)
#pragma unroll
        for (int pp = 0; pp < 2; ++pp) {
            float v[8];
#pragma unroll
            for (int r = 0; r < 4; ++r) { v[r] = acc[m][2 * pp][r]; v[4 + r] = acc[m][2 * pp + 1][r]; }
            f(wr * 64 + m * 16 + li, wc * 64 + 32 * pp + 8 * g, v, pp, m);
        }
}
__device__ __forceinline__ void store_bf16x8(bf16_t* p, const float (&v)[8]) {
    *(uint4*)p = make_uint4(pack_bf16(v[0], v[1]), pack_bf16(v[2], v[3]), pack_bf16(v[4], v[5]), pack_bf16(v[6], v[7]));
}
__device__ __forceinline__ void store_tile_T(const f32x4 (&acc)[4][4], bf16_t* __restrict__ dstT, int ldt, unsigned char* smem) {
    bf16_t* t = (bf16_t*)smem;
    __syncthreads();
    epi_foreach(acc, [&](int r, int c, const float (&v)[8], int, int) {
#pragma unroll
        for (int e = 0; e < 8; ++e) t[(c + e) * 136 + r] = f2bf(v[e]);
    });
    __syncthreads();
#pragma unroll
    for (int i = 0; i < 8; ++i) {
        const int ch = tidx() + 256 * i, d = ch >> 4, tc = ch & 15;
        *(uint4*)(dstT + (size_t)d * ldt + tc * 8) = *(const uint4*)(smem + d * 272 + tc * 16);
    }
    __syncthreads();
}


__device__ void memkv_tile(const Params& p, int rt, int ct, unsigned char* smem) {
    unsigned char* dob = (unsigned char*)p.out;
    f32x4 acc[4][4]; acc_zero(acc);
    const GemmOp op{(const bf16_t*)(dob + DO_MEMBF) + (size_t)rt * 128 * 1024, (const bf16_t*)(p.ws + OFF_WMKVT) + (size_t)ct * 128 * 1024, 1024, 1024};
    GemmPipe pp{0, false};
    __syncthreads();
    gemm_tile(op, 1024, acc, smem, pp);
    const int row0 = rt * 128;
    if (ct < 4) {
        bf16_t* dst = (bf16_t*)(dob + DO_KM) + ct * 128;
        epi_foreach(acc, [&](int r, int c, float (&v)[8], int, int) { store_bf16x8(dst + (size_t)(row0 + r) * 512 + c, v); });
    } else {
        const int h = ct - 4, b = row0 / MEML, m0 = row0 % MEML;
        store_tile_T(acc, (bf16_t*)(dob + DO_VMT) + (size_t)(b * 4 + h) * 128 * MEML + m0, MEML, smem);
    }
}


typedef float f32x16 __attribute__((ext_vector_type(16)));
__device__ __forceinline__ f32x16 mfma32(bf16x8 a, bf16x8 b, f32x16 c) { return __builtin_amdgcn_mfma_f32_32x32x16_bf16(a, b, c, 0, 0, 0); }
constexpr int ATT_STAGE = 16384 + 128 * 136;

template <bool WIN>
__device__ void attn_block(const bf16_t* Qg, int ldq, const bf16_t* __restrict__ Kg, int ldk, const bf16_t* __restrict__ Vtg, int ldv,
                           int q0, int kt0, int nt, float sink2, bf16_t* Og, int ldo, unsigned char* smem) {
    const int tid = tidx(), lane = tid & 63, wid = tid >> 6, r = lane & 31, hh = lane >> 5;
    const int qw = q0 + 32 * wid;
    bf16x8 qf[8];
#pragma unroll
    for (int ks = 0; ks < 8; ++ks) qf[ks] = *(const bf16x8*)(Qg + (size_t)(32 * wid + r) * ldq + ks * 16 + hh * 8);
    f32x16 o[4];
#pragma unroll
    for (int db = 0; db < 4; ++db)
#pragma unroll
        for (int e = 0; e < 16; ++e) o[db][e] = 0.f;
    float m = WIN ? sink2 : -1e30f, l = WIN ? 1.0f : 0.0f;
    const int krow = tid >> 4, kch = tid & 15, vrow = tid >> 3, vch = tid & 7;
    const int koff = krow * 256 + ((kch ^ (krow & 15)) << 4);
    const int voff = 16384 + vrow * 136 + vch * 16;
    uint4 rk[4], rv[4];
    const bf16_t* kgp = Kg + (size_t)(kt0 * 64 + krow) * ldk + kch * 8;
    const bf16_t* vgp = Vtg + (size_t)vrow * ldv + kt0 * 64 + vch * 8;
#pragma unroll
    for (int i = 0; i < 4; ++i) { rk[i] = *(const uint4*)(kgp + (size_t)(16 * i) * ldk); rv[i] = *(const uint4*)(vgp + (size_t)(32 * i) * ldv); }
#pragma unroll
    for (int i = 0; i < 4; ++i) {
        *(uint4*)(smem + koff + i * 4096) = rk[i];
        *(uint2*)(smem + voff + i * 4352) = make_uint2(rv[i].x, rv[i].y); *(uint2*)(smem + voff + i * 4352 + 8) = make_uint2(rv[i].z, rv[i].w);
    }
    __syncthreads();
    constexpr int NTL = WIN ? 6 : 4;
    for (int t = 0; t < NTL; ++t) {
        const unsigned char* sb = smem + (t & 1) * ATT_STAGE;
        {
            const int tn = t + 1 < nt ? t + 1 : nt - 1;
#pragma unroll
            for (int i = 0; i < 4; ++i) { rk[i] = *(const uint4*)(kgp + (size_t)(tn * 64 + 16 * i) * ldk); rv[i] = *(const uint4*)(vgp + (size_t)(32 * i) * ldv + tn * 64); }
        }
        const int k0 = (kt0 + t) * 64;
        if (t < nt && (!WIN || (k0 + 63 >= qw - 128 && k0 <= qw + 159))) {
            f32x16 s0, s1;
#pragma unroll
            for (int e = 0; e < 16; ++e) { s0[e] = 0.f; s1[e] = 0.f; }
#pragma unroll
            for (int ks = 0; ks < 8; ++ks) {
                const bf16x8 a0 = *(const bf16x8*)(sb + r * 256 + (((2 * ks + hh) ^ (r & 15)) << 4));
                const bf16x8 a1 = *(const bf16x8*)(sb + (32 + r) * 256 + (((2 * ks + hh) ^ (r & 15)) << 4));
                s0 = mfma32(a0, qf[ks], s0); s1 = mfma32(a1, qf[ks], s1);
            }
            if (WIN && !(k0 >= qw - 97 && k0 + 63 <= qw + 128)) {
#pragma unroll
                for (int e = 0; e < 16; ++e) {
                    const int d = k0 + (e & 3) + 8 * (e >> 2) + 4 * hh - (qw + r);
                    s0[e] = (d <= 128 && d >= -128) ? s0[e] : -1e30f;
                    s1[e] = (d + 32 <= 128 && d + 32 >= -128) ? s1[e] : -1e30f;
                }
            }
            float mx = fmaxf(s0[0], s1[0]);
#pragma unroll
            for (int e = 1; e < 16; ++e) mx = fmaxf(mx, fmaxf(s0[e], s1[e]));
            mx = fmaxf(mx, __shfl_xor(mx, 32));
            const float mnew = fmaxf(m, mx), alpha = __builtin_amdgcn_exp2f(m - mnew);
            m = mnew;
            if (__any(alpha != 1.0f)) {
#pragma unroll
                for (int db = 0; db < 4; ++db)
#pragma unroll
                    for (int e = 0; e < 16; ++e) o[db][e] *= alpha;
            }
            float ps = 0.f;
#pragma unroll
            for (int blk = 0; blk < 2; ++blk) {
                f32x16& sv = blk ? s1 : s0;
#pragma unroll
                for (int e = 0; e < 16; ++e) { sv[e] = __builtin_amdgcn_exp2f(sv[e] - mnew); ps += sv[e]; }
#pragma unroll
                for (int s2 = 0; s2 < 2; ++s2) {
                    union { unsigned u[4]; bf16x8 v; } pb;
#pragma unroll
                    for (int e = 0; e < 4; ++e) pb.u[e] = pack_bf16(sv[8 * s2 + 2 * e], sv[8 * s2 + 2 * e + 1]);
#pragma unroll
                    for (int db = 0; db < 4; ++db) {
                        const unsigned char* vp = sb + 16384 + (db * 32 + r) * 136 + (blk * 32 + 16 * s2 + 4 * hh) * 2;
                        union { uint2 u[2]; bf16x8 v; } va;
                        va.u[0] = *(const uint2*)vp; va.u[1] = *(const uint2*)(vp + 16);
                        o[db] = mfma32(va.v, pb.v, o[db]);
                    }
                }
            }
            ps += __shfl_xor(ps, 32);
            l = l * alpha + ps;
        }
        {
            unsigned char* sw = smem + ((t + 1) & 1) * ATT_STAGE;
#pragma unroll
            for (int i = 0; i < 4; ++i) {
                *(uint4*)(sw + koff + i * 4096) = rk[i];
                *(uint2*)(sw + voff + i * 4352) = make_uint2(rv[i].x, rv[i].y); *(uint2*)(sw + voff + i * 4352 + 8) = make_uint2(rv[i].z, rv[i].w);
            }
        }
        __syncthreads();
    }
    const float inv = __builtin_amdgcn_rcpf(l);
    bf16_t* orow = Og + (size_t)(32 * wid + r) * ldo + 4 * hh;
#pragma unroll
    for (int db = 0; db < 4; ++db)
#pragma unroll
        for (int gq = 0; gq < 4; ++gq)
            *(uint2*)(orow + db * 32 + 8 * gq) = make_uint2(pack_bf16(o[db][4 * gq] * inv, o[db][4 * gq + 1] * inv), pack_bf16(o[db][4 * gq + 2] * inv, o[db][4 * gq + 3] * inv));
}
__device__ void attn_win_unit(const Params& p, int u, unsigned char* smem) {
    const int gh = u % 3, qb = (u / 3) % 16, kvh = (u / 48) % 2, b = u / 96, head = kvh * 3 + gh;
    const int q0 = qb * 128;
    const int ks = q0 - 128 < 0 ? 0 : q0 - 128, ke = q0 + 256 > S_ ? S_ : q0 + 256;
    bf16_t* Q = (bf16_t*)(p.ws + OFF_QA) + (size_t)(b * S_ + q0) * 768 + head * 128;
    const bf16_t* Kb = (const bf16_t*)(p.ws + OFF_KA) + (size_t)(b * S_) * 256 + kvh * 128;
    const bf16_t* Vt = (const bf16_t*)(p.ws + OFF_VAT) + (size_t)(b * 2 + kvh) * 128 * S_;
    attn_block<true>(Q, 768, Kb, 256, Vt, S_, q0, ks / 64, (ke - ks) / 64, p.attn_sink[head] * 1.4426950408889634f, Q, 768, smem);
}
__device__ void attn_mem_unit(const Params& p, int u, unsigned char* smem) {
    const int qb = u % 16, head = (u / 16) % 4, b = u / 64;
    const int q0 = qb * 128;
    unsigned char* dob = (unsigned char*)p.out;
    bf16_t* Q = (bf16_t*)(p.ws + OFF_QM) + (size_t)(b * S_ + q0) * 512 + head * 128;
    const bf16_t* Kb = (const bf16_t*)(dob + DO_KM) + (size_t)(b * MEML) * 512 + head * 128;
    const bf16_t* Vt = (const bf16_t*)(dob + DO_VMT) + (size_t)(b * 4 + head) * 128 * MEML;
    attn_block<false>(Q, 512, Kb, 512, Vt, MEML, q0, 0, 4, 0.f, Q, 512, smem);
}

typedef _Float16 f16x2v __attribute__((ext_vector_type(2)));
__device__ __forceinline__ unsigned pack_f16(float lo, float hi) { return __builtin_bit_cast(unsigned, __builtin_amdgcn_cvt_pkrtz(lo, hi)); }
template <bool FINAL>
__device__ void lru_chunk_unit(const Params& p, int u, unsigned char* smem) {
    const int tid = tidx(), lane = tid & 63, wid = tid >> 6, li = lane & 15, g = lane >> 4;
    const int c = u & 15, h = (u >> 4) % 6, b = u / 96;
    const int cbase = h * 128, s0 = c * 128;
    unsigned char* xcs = smem; unsigned char* LB = smem + 32768; float2* SA = (float2*)(smem + 49152); unsigned char* WL = smem + 51200; float* CC = (float*)(smem + 67584);
    const bf16_t* Xl = (const bf16_t*)(p.ws + OFF_XL) + (size_t)(b * S_) * 768;
    bf16_t* Gl = (bf16_t*)(p.ws + OFF_GL) + (size_t)(b * S_ + s0) * 768;
    const bf16_t* LruWt = (const bf16_t*)(p.ws + OFF_LRUWT) + (size_t)h * 512 * 128;
    const float* SP8 = (const float*)(p.ws + OFF_SP8);
    float2* AGG = (float2*)(p.ws + OFF_AGG);
    bf16_t* LCF = (bf16_t*)((unsigned char*)p.out + DO_LCF) + (size_t)(b * S_ + s0) * 768; bf16_t* LCB = (bf16_t*)(p.ws + OFF_LCB) + (size_t)(b * S_ + s0) * 768;
    auto stage_w = [&](int hc_, int d_) {
#pragma unroll
        for (int i = 0; i < 4; ++i) {
            const int rr = (tid >> 4) + 16 * i, n = rr >> 4, wrow = ((n >> 1) * 2 + d_) * 128 + hc_ * 32 + 16 * (n & 1) + (rr & 15);
            __builtin_amdgcn_global_load_lds((const unsigned*)(LruWt + (size_t)wrow * 128 + (((tid & 15) ^ (rr & 15)) << 3)), (unsigned*)(WL + tid * 16 + i * 4096), 16, 0, 0);
        }
    };
    __syncthreads();
    {
        const int cp = tid & 63, tq = tid >> 6, cch = cbase + 2 * cp;
        float cw[4][2];
#pragma unroll
        for (int j = 0; j < 4; ++j) { cw[j][0] = p.conv_w[j * LW + cch]; cw[j][1] = p.conv_w[j * LW + cch + 1]; }
        const float cb0 = p.conv_b[cch], cb1 = p.conv_b[cch + 1];
#pragma unroll
        for (int hf = 0; hf < 2; ++hf) {
            const int tb = 32 * tq + 16 * hf;
            unsigned xw[19];
#pragma unroll
            for (int i = 0; i < 19; ++i) {
                const int s = s0 + tb + i - 2, sc = s < 0 ? 0 : (s > S_ - 1 ? S_ - 1 : s);
                xw[i] = *(const unsigned*)(Xl + (size_t)sc * 768 + cch);
            }
            PIN15(xw, 0); PIN4(xw, 15);
#pragma unroll
            for (int i = 0; i < 19; ++i) { const int s = s0 + tb + i - 2; xw[i] = (s >= 0 && s < S_) ? xw[i] : 0u; }
#pragma unroll
            for (int i = 0; i < 16; ++i) {
                const int t = tb + i;
                const float y0 = cb0 + cw[0][0] * bflo(xw[i]) + cw[1][0] * bflo(xw[i + 1]) + cw[2][0] * bflo(xw[i + 2]) + cw[3][0] * bflo(xw[i + 3]);
                const float y1 = cb1 + cw[0][1] * bfhi(xw[i]) + cw[1][1] * bfhi(xw[i + 1]) + cw[2][1] * bfhi(xw[i + 2]) + cw[3][1] * bfhi(xw[i + 3]);
                *(unsigned*)(xcs + t * 256 + (((cp >> 2) ^ (t & 15)) << 4) + (cp & 3) * 4) = pack_bf16(y0, y1);
            }
        }
    }
    const int sch = tid & 31, seg = tid >> 5;
    float4 cst[2][3];
    auto load_cst = [&](int hc_, int d_) {
#pragma unroll
        for (int n = 0; n < 2; ++n) {
            const int gch = cbase + hc_ * 32 + 16 * n + 4 * g;
            cst[n][0] = *(const float4*)(p.lru_br + d_ * LW + gch); cst[n][1] = *(const float4*)(p.lru_bi + d_ * LW + gch); cst[n][2] = *(const float4*)(SP8 + d_ * LW + gch);
        }
    };
    stage_w(0, 0);
    __syncthreads();
#pragma unroll 1
    for (int hc = 0; hc < 4; ++hc) {
        float hfv[16], pfv[16];
#pragma unroll
        for (int d = 0; d < 2; ++d) {
            load_cst(hc, d);
            f32x4 acc[2][4];
#pragma unroll
            for (int m = 0; m < 2; ++m)
#pragma unroll
                for (int n = 0; n < 4; ++n) acc[m][n] = (f32x4){0.f, 0.f, 0.f, 0.f};
#pragma unroll
            for (int ks = 0; ks < 4; ++ks) {
                bf16x8 xf[2];
#pragma unroll
                for (int m = 0; m < 2; ++m) { const int row = 32 * wid + 16 * m + li; xf[m] = *(const bf16x8*)(xcs + row * 256 + (((ks * 4 + g) ^ (row & 15)) << 4)); }
#pragma unroll
                for (int n = 0; n < 4; ++n) {
                    const int rr = 16 * n + li;
                    const bf16x8 wf = *(const bf16x8*)(WL + rr * 256 + (((ks * 4 + g) ^ li) << 4));
#pragma unroll
                    for (int m = 0; m < 2; ++m) acc[m][n] = mfma16(wf, xf[m], acc[m][n]);
                }
            }
#pragma unroll
            for (int n = 0; n < 2; ++n) {
                const int ch4 = 16 * n + 4 * g;
                const float4 br4 = cst[n][0], bi4 = cst[n][1], sp4 = cst[n][2];
                const float brv[4] = {br4.x, br4.y, br4.z, br4.w}, biv[4] = {bi4.x, bi4.y, bi4.z, bi4.w}, spv[4] = {sp4.x, sp4.y, sp4.z, sp4.w};
#pragma unroll
                for (int m = 0; m < 2; ++m) {
                    const int tok = 32 * wid + 16 * m + li;
                    const uint2 xq = *(const uint2*)(xcs + tok * 256 + ((((hc * 32 + ch4) >> 3) ^ (tok & 15)) << 4) + (g & 1) * 8);
                    const float xc[4] = {bflo(xq.x), bfhi(xq.x), bflo(xq.y), bfhi(xq.y)};
                    unsigned w[4];
#pragma unroll
                    for (int r = 0; r < 4; ++r) {
                        const float rg = sigmoidf_(acc[m][n][r] + brv[r]), ig = sigmoidf_(acc[m][n + 2][r] + biv[r]);
                        const float la = spv[r] * rg, a = __builtin_amdgcn_exp2f(la);
                        const float bx = __builtin_amdgcn_sqrtf(fmaxf(1.0f - a * a, 0.f)) * (ig * xc[r]);
                        w[r] = pack_f16(la, bx);
                    }
                    *(uint4*)(LB + tok * 128 + (((ch4 >> 2) ^ (tok & 7)) << 4)) = make_uint4(w[0], w[1], w[2], w[3]);
                }
            }
            __syncthreads();
            if (!(hc == 3 && d == 1)) stage_w(d ? hc + 1 : hc, d ^ 1);
            const int gch = cbase + hc * 32 + sch;
            float ak[16];
            {
                float L = 0.f, H = 0.f;
#pragma unroll
                for (int k = 0; k < 16; ++k) {
                    const int tok = 16 * seg + (d ? 15 - k : k);
                    const unsigned w = *(const unsigned*)(LB + tok * 128 + (((sch >> 2) ^ (tok & 7)) << 4) + (sch & 3) * 4);
                    const f16x2v hv = __builtin_bit_cast(f16x2v, w);
                    const float la = (float)hv.x, bx = (float)hv.y;
                    ak[k] = __builtin_amdgcn_exp2f(la);
                    H = ak[k] * H + bx; L += la;
                }
                SA[seg * 32 + sch] = make_float2(L, H);
            }
            __syncthreads();
            if (seg == 0) {
                float L = 0.f, H = 0.f;
#pragma unroll
                for (int s = 0; s < 8; ++s) { const float2 a = SA[(d ? 7 - s : s) * 32 + sch]; H = __builtin_amdgcn_exp2f(a.x) * H + a.y; L += a.x; }
                AGG[((size_t)(d * B_ + b) * 16 + c) * 768 + gch] = make_float2(L, H);
            }
            {
                float H = 0.f, Lc = 0.f;
#pragma unroll
                for (int ss = 0; ss < 8; ++ss) {
                    const int s = d ? 7 - ss : ss;
                    const bool on = d ? (s > seg) : (s < seg);
                    const float2 a = SA[s * 32 + sch];
                    H = __builtin_amdgcn_exp2f(on ? a.x : 0.f) * H + (on ? a.y : 0.f); Lc += on ? a.x : 0.f;
                }
                float Pc = __builtin_amdgcn_exp2f(Lc);
                bf16_t* gp = Gl + (size_t)(16 * seg) * 768 + gch;
                float gv[16];
                if (d) {
                    unsigned gr[16];
#pragma unroll
                    for (int k = 0; k < 16; ++k) gr[k] = gp[(size_t)k * 768];
                    PIN8(gr, 0); PIN8(gr, 8);
#pragma unroll
                    for (int k = 0; k < 16; ++k) gv[k] = __uint_as_float(gr[k] << 16);
                }
                bf16_t* cfp = LCF + (size_t)(16 * seg) * 768 + gch; bf16_t* cbp = LCB + (size_t)(16 * seg) * 768 + gch;
#pragma unroll
                for (int k = 0; k < 16; ++k) {
                    const int kk = d ? 15 - k : k, tok = 16 * seg + kk;
                    const unsigned w = *(const unsigned*)(LB + tok * 128 + (((sch >> 2) ^ (tok & 7)) << 4) + (sch & 3) * 4);
                    const f16x2v hv = __builtin_bit_cast(f16x2v, w);
                    H = ak[k] * H + (float)hv.y;
                    Pc *= ak[k];
                    const float P = Pc;
                    if (d == 0) { hfv[kk] = H; pfv[kk] = P; }
                    else {
                        hfv[kk] = (hfv[kk] + H) * gv[kk];
                        cfp[(size_t)kk * 768] = f2bf(pfv[kk] * gv[kk]);
                        cbp[(size_t)kk * 768] = f2bf(P * gv[kk]);
                    }
                }
                if (d) {
#pragma unroll
                    for (int k = 0; k < 16; ++k) gp[(size_t)k * 768] = f2bf(hfv[k]);
                }
            }
            __syncthreads();
        }
    }
}


__device__ void lru_fixup_unit(const Params& p, int u) {
    const int tid = tidx(), cp = tid & 63, tq = tid >> 6;
    const int c = u & 15, h = (u >> 4) % 6, b = u / 96, cch = h * 128 + 2 * cp, s0 = c * 128;
    const float2* AGG = (const float2*)(p.ws + OFF_AGG);
    float hin[2][2];
#pragma unroll
    for (int d = 0; d < 2; ++d) {
        f32x4 av[16];
#pragma unroll
        for (int j = 0; j < 16; ++j) av[j] = *(const f32x4*)(AGG + ((size_t)(d * B_ + b) * 16 + j) * 768 + cch);
        PIN8(av, 0); PIN8(av, 8);
        float H0 = 0.f, H1 = 0.f;
#pragma unroll
        for (int jj = 0; jj < 16; ++jj) {
            const int j = d ? 15 - jj : jj;
            const bool on = d ? (j > c) : (j < c);
            H0 = __builtin_amdgcn_exp2f(on ? av[j][0] : 0.f) * H0 + (on ? av[j][1] : 0.f);
            H1 = __builtin_amdgcn_exp2f(on ? av[j][2] : 0.f) * H1 + (on ? av[j][3] : 0.f);
        }
        hin[d][0] = H0; hin[d][1] = H1;
    }
    const size_t base = (size_t)(b * S_ + s0 + 32 * tq) * 768 + cch;
    bf16_t* Gl = (bf16_t*)(p.ws + OFF_GL) + base;
    const bf16_t* LCF = (const bf16_t*)((const unsigned char*)p.out + DO_LCF) + base; const bf16_t* LCB = (const bf16_t*)(p.ws + OFF_LCB) + base;
#pragma unroll 1
    for (int g8 = 0; g8 < 4; ++g8) {
        unsigned sv[8], fv[8], bv[8];
#pragma unroll
        for (int i = 0; i < 8; ++i) { const size_t o = (size_t)(g8 * 8 + i) * 768; sv[i] = *(const unsigned*)(Gl + o); fv[i] = *(const unsigned*)(LCF + o); bv[i] = *(const unsigned*)(LCB + o); }
        PIN8(sv, 0); PIN8(fv, 0); PIN8(bv, 0);
#pragma unroll
        for (int i = 0; i < 8; ++i) {
            const float o0 = bflo(sv[i]) + bflo(fv[i]) * hin[0][0] + bflo(bv[i]) * hin[1][0];
            const float o1 = bfhi(sv[i]) + bfhi(fv[i]) * hin[0][1] + bfhi(bv[i]) * hin[1][1];
            *(unsigned*)(Gl + (size_t)(g8 * 8 + i) * 768) = pack_bf16(o0, o1);
        }
    }
}


__device__ __forceinline__ int sortable(float v) { int k = __float_as_int(v); return k ^ ((k >> 31) & 0x7fffffff); }
__device__ __forceinline__ float unsortable(int k) { return __int_as_float(k ^ ((k >> 31) & 0x7fffffff)); }
__device__ __forceinline__ void cex_desc(int& a, int& b) { const int hi = max(a, b), lo = min(a, b); a = hi; b = lo; }
__device__ __forceinline__ void sort16_desc(int (&a)[16]) {
#pragma unroll
    for (int k = 2; k <= 16; k <<= 1)
#pragma unroll
        for (int j = k >> 1; j >= 1; j >>= 1)
#pragma unroll
            for (int i = 0; i < 16; ++i) {
                const int l = i ^ j;
                if (l > i) { if ((i & k) == 0) cex_desc(a[i], a[l]); else cex_desc(a[l], a[i]); }
            }
}
__device__ __forceinline__ void merge16_desc(int (&a)[16], const int (&b)[16]) {
#pragma unroll
    for (int k = 0; k < 16; ++k) a[k] = max(a[k], b[15 - k]);
#pragma unroll
    for (int s = 8; s >= 1; s >>= 1)
#pragma unroll
        for (int k = 0; k < 16; ++k)
            if ((k & s) == 0) cex_desc(a[k], a[k + s]);
}
__device__ __forceinline__ void scores_half(const Params& p, int row0, int pq, unsigned char* smem, int (&lst)[16]) {
    f32x4 acc[4][4]; acc_zero(acc);
    const GemmOp op{(const bf16_t*)(p.ws + OFF_QPEER) + (size_t)row0 * 2048 + pq * 128, (const bf16_t*)(p.ws + OFF_SUBK) + (size_t)pq * 128 * 128, 2048, 128};
    GemmPipe pp{0, false};
    gemm_tile(op, 128, acc, smem, pp);
    float* sc = (float*)smem;
    __syncthreads();
    epi_foreach(acc, [&](int r, int c, float (&v)[8], int, int) {
        *(float4*)(sc + r * 132 + c) = make_float4(v[0], v[1], v[2], v[3]);
        *(float4*)(sc + r * 132 + c + 4) = make_float4(v[4], v[5], v[6], v[7]); });
    __syncthreads();
    const int t = tidx(), r = t & 127, hf = t >> 7;
    {
        int g1[16], g2[16], g3[16];
        auto load16 = [&](int (&g)[16], int q) {
#pragma unroll
            for (int j4 = 0; j4 < 4; ++j4) {
                const int j = hf * 64 + q * 16 + j4 * 4;
                const float4 v = *(const float4*)(sc + r * 132 + j);
                g[4 * j4] = (sortable(v.x) & ~127) | j; g[4 * j4 + 1] = (sortable(v.y) & ~127) | (j + 1);
                g[4 * j4 + 2] = (sortable(v.z) & ~127) | (j + 2); g[4 * j4 + 3] = (sortable(v.w) & ~127) | (j + 3);
            }
        };
        load16(lst, 0); sort16_desc(lst); load16(g1, 1); sort16_desc(g1); merge16_desc(lst, g1);
        load16(g2, 2); sort16_desc(g2); load16(g3, 3); sort16_desc(g3); merge16_desc(g2, g3);
        merge16_desc(lst, g2);
    }
    __syncthreads();
    int* ls = (int*)smem;
    if (hf) {
#pragma unroll
        for (int k = 0; k < 16; ++k) ls[t * 16 + k] = lst[15 - k];
    }
    __syncthreads();
    if (!hf) {
        int ob[16];
#pragma unroll
        for (int k = 0; k < 16; ++k) ob[15 - k] = ls[(t + 128) * 16 + k];
        merge16_desc(lst, ob);
    }
    __syncthreads();
}
__device__ void scores_tile(const Params& p, int rt, int hd, unsigned char* smem) {
    const int row0 = rt * 128;
    int k0[16], k1[16];
    scores_half(p, row0, 2 * hd, smem, k0);
    scores_half(p, row0, 2 * hd + 1, smem, k1);
    const int t = tidx();
    int* ls = (int*)smem;
    if (t < 128) {
#pragma unroll
        for (int k = 0; k < 16; ++k) { ls[t * 32 + k] = k0[k]; ls[t * 32 + 16 + k] = k1[k]; }
        float v0[16], v1[16];
#pragma unroll
        for (int i = 0; i < 16; ++i) { v0[i] = unsortable(k0[i] & ~127); v1[i] = unsortable(k1[i] & ~127); }
        int lst[16], g1[16], g2[16], g3[16];
#pragma unroll
        for (int b = 0; b < 16; ++b) lst[b] = (sortable(v0[0] + v1[b]) & ~255) | b;
        {
            int n = 0;
#pragma unroll
            for (int a = 1; a < 16; ++a)
#pragma unroll
                for (int b = 0; b < 16; ++b)
                    if ((a + 1) * (b + 1) <= 16) {
                        const int key = (sortable(v0[a] + v1[b]) & ~255) | (a * 16 + b);
                        if (n < 16) g1[n] = key; else if (n < 32) g2[n - 16] = key; else g3[n - 32] = key;
                        ++n;
                    }
#pragma unroll
            for (int k = 2; k < 16; ++k) g3[k] = (int)0x80000000;
        }
        sort16_desc(lst); sort16_desc(g1); merge16_desc(lst, g1);
        sort16_desc(g2); sort16_desc(g3); merge16_desc(g2, g3);
        merge16_desc(lst, g2);
        float val[16], sum = 0.f;
        const float mx = unsortable(lst[0] & ~255);
#pragma unroll
        for (int k = 0; k < 16; ++k) { val[k] = __expf(unsortable(lst[k] & ~255) - mx); sum += val[k]; }
        const float inv = 1.0f / sum;
        const int tok = row0 + t;
        int* ei = (int*)(p.ws + OFF_EIDX) + (size_t)tok * 128 + hd * 16;
        float* eg = (float*)(p.ws + OFF_EGATE) + (size_t)tok * 128 + hd * 16;
#pragma unroll
        for (int k = 0; k < 16; ++k) {
            const int code = lst[k] & 255, a = code >> 4, b = code & 15;
            ei[k] = (ls[t * 32 + a] & 127) * 128 + (ls[t * 32 + 16 + b] & 127);
            eg[k] = val[k] * inv;
        }
    }
    __syncthreads();
}


__device__ __forceinline__ void peer_offsets(unsigned (&off)[16], int es0, int es1, int gq, unsigned sub16) {
#pragma unroll
    for (int bb = 0; bb < 8; ++bb) { off[bb] = ((unsigned)__shfl(es0, 8 * bb + gq) << 7) | sub16; off[8 + bb] = ((unsigned)__shfl(es1, 8 * bb + gq) << 7) | sub16; }
}
__device__ __forceinline__ void peer_u_issue(u32x4 (&seg)[8], const unsigned char* Ux, const unsigned (&off)[16], int base) {
#pragma unroll
    for (int bb = 0; bb < 8; ++bb) seg[bb] = *(const u32x4*)(Ux + off[base + bb]);
}
__device__ __forceinline__ int sum8_dpp_i(int v) {
    v += __builtin_amdgcn_mov_dpp(v, 0xB1, 0xF, 0xF, true);
    v += __builtin_amdgcn_mov_dpp(v, 0x4E, 0xF, 0xF, true);
    v += __builtin_amdgcn_mov_dpp(v, 0x141, 0xF, 0xF, true);
    return v;
}
__device__ __forceinline__ float max8_dpp(float v) {
    v = fmaxf(v, __int_as_float(__builtin_amdgcn_mov_dpp(__float_as_int(v), 0xB1, 0xF, 0xF, true)));
    v = fmaxf(v, __int_as_float(__builtin_amdgcn_mov_dpp(__float_as_int(v), 0x4E, 0xF, 0xF, true)));
    v = fmaxf(v, __int_as_float(__builtin_amdgcn_mov_dpp(__float_as_int(v), 0x141, 0xF, 0xF, true)));
    return v;
}
#define DPP_ADD_I(v, ctrl) ((v) + __builtin_amdgcn_mov_dpp((v), (ctrl), 0xF, 0xF, true))
__device__ __forceinline__ int peer_u_half(u32x4 (&seg)[8], const int (&ha)[4], const int (&hb)[4], int sub) {
    PIN8(seg, 0);
    int d[8];
#pragma unroll
    for (int bb = 0; bb < 8; ++bb) {
        int za = 0, zb = 0;
#pragma unroll
        for (int i = 0; i < 4; ++i) { za = __builtin_amdgcn_sdot8((int)seg[bb][i], ha[i], za, false); zb = __builtin_amdgcn_sdot8((int)seg[bb][i], hb[i], zb, false); }
        d[bb] = za * 16 + zb;
    }
    const bool b2 = (sub & 4) != 0, b1 = (sub & 2) != 0, b0 = (sub & 1) != 0;
    int a[4], b[2];
#pragma unroll
    for (int i = 0; i < 4; ++i) { const int lo = DPP_ADD_I(d[i], 0x141), hi = DPP_ADD_I(d[4 + i], 0x141); a[i] = b2 ? hi : lo; }
#pragma unroll
    for (int j = 0; j < 2; ++j) { const int ev = DPP_ADD_I(a[2 * j], 0xB1), od = DPP_ADD_I(a[2 * j + 1], 0xB1); b[j] = b0 ? od : ev; }
    const int c0 = DPP_ADD_I(b[0], 0x4E), c1 = DPP_ADD_I(b[1], 0x4E);
    return b1 ? c1 : c0;
}
__device__ __forceinline__ void peer_u_quant(const uint4 (&hv)[4], int (&ha)[4], int (&hb)[4], float& sh) {
    float h[32];
#pragma unroll
    for (int i = 0; i < 4; ++i) { const unsigned hw[4] = {hv[i].x, hv[i].y, hv[i].z, hv[i].w};
#pragma unroll
        for (int e = 0; e < 4; ++e) { h[8 * i + 2 * e] = bflo(hw[e]); h[8 * i + 2 * e + 1] = bfhi(hw[e]); } }
    float am = 0.f;
#pragma unroll
    for (int e = 0; e < 16; ++e) am = fmaxf(am, fmaxf(fabsf(h[2 * e]), fabsf(h[2 * e + 1])));
    am = max8_dpp(am);
    sh = am > 0.f ? am * (1.0f / 119.0f) : 1.0f;
    const float inv = am > 0.f ? 119.0f * __builtin_amdgcn_rcpf(am) : 0.f;
#pragma unroll
    for (int i = 0; i < 4; ++i) {
        unsigned H[2];
#pragma unroll
        for (int d = 0; d < 2; ++d) {
            const float* hp = h + 8 * i + 4 * d;
            const unsigned b0 = __float_as_uint(hp[0] * inv + 12582912.0f), b1 = __float_as_uint(hp[1] * inv + 12582912.0f);
            const unsigned b2 = __float_as_uint(hp[2] * inv + 12582912.0f), b3 = __float_as_uint(hp[3] * inv + 12582912.0f);
            H[d] = (b0 & 255u) | ((b1 & 255u) << 8) | ((b2 & 255u) << 16) | (b3 << 24);
        }
        const unsigned T0 = ((H[0] & 0x7F7F7F7Fu) + 0x08080808u) ^ (H[0] & 0x80808080u), T1 = ((H[1] & 0x7F7F7F7Fu) + 0x08080808u) ^ (H[1] & 0x80808080u);
        ha[i] = (int)(((T0 >> 4) & 0x0F0F0F0Fu) | (T1 & 0xF0F0F0F0u));
        hb[i] = (int)(((T0 & 0x0F0F0F0Fu) | ((T1 & 0x0F0F0F0Fu) << 4)) ^ 0x88888888u);
    }
}
__device__ void peer_u_pass(const Params& p, int t0, int tstep, int x, int lane) {
    const int gq = lane >> 3, sub = lane & 7;
    const int* eib = (const int*)(p.ws + OFF_EIDX);
    const bf16_t* h2b = (const bf16_t*)(p.ws + OFF_XB) + x * 256 + sub * 32;
    const unsigned char* Uq = p.ws + OFF_UB + (size_t)x * NEXP * 128; const unsigned sub16 = (unsigned)sub * 16u;
    unsigned* Zb = (unsigned*)(p.ws + OFF_ZBUF) + (size_t)x * 64;
    if (t0 >= NTOK) return;
    unsigned off[16];
    { const int es0 = eib[(size_t)t0 * 128 + lane], es1 = eib[(size_t)t0 * 128 + 64 + lane]; peer_offsets(off, es0, es1, gq, sub16); }
    uint4 hv[4];
#pragma unroll
    for (int i = 0; i < 4; ++i) hv[i] = *(const uint4*)(h2b + (size_t)t0 * 1024 + 8 * i);
    u32x4 SA[8], SB[8];
    peer_u_issue(SA, Uq, off, 0);
    for (int t = t0; t < NTOK; t += tstep) {
        const int tn = t + tstep < NTOK ? t + tstep : t;
        const int nes0 = eib[(size_t)tn * 128 + lane], nes1 = eib[(size_t)tn * 128 + 64 + lane];
        uint4 nhv[4];
#pragma unroll
        for (int i = 0; i < 4; ++i) nhv[i] = *(const uint4*)(h2b + (size_t)tn * 1024 + 8 * i);
        int ha[4], hb[4]; float sh;
        peer_u_quant(hv, ha, hb, sh);
        peer_u_issue(SB, Uq, off, 8);
        const int z0 = peer_u_half(SA, ha, hb, sub);
        peer_offsets(off, nes0, nes1, gq, sub16);
        peer_u_issue(SA, Uq, off, 0);
        const int z1 = peer_u_half(SB, ha, hb, sub);
        Zb[(size_t)t * 4 * 64 + lane] = pack_f16((float)z0 * sh, (float)z1 * sh);
#pragma unroll
        for (int i = 0; i < 4; ++i) hv[i] = nhv[i];
    }
}
__device__ void peer_coef_tokens(const Params& p, int tokA, int tokB, int lane) {
    const int pe = 8 * (lane & 7) + (lane >> 3);
    const int* eib = (const int*)(p.ws + OFF_EIDX); const float* egb = (const float*)(p.ws + OFF_EGATE);
    const float* SU = (const float*)(p.ws + OFF_SU); const float* SV = (const float*)(p.ws + OFF_SV);
    const unsigned* Zb = (const unsigned*)(p.ws + OFF_ZBUF); unsigned* Wb = (unsigned*)(p.ws + OFF_WBUF);
    const float* rss = (const float*)(p.ws + OFF_ROWSS1);
    const int tok[2] = {tokA, tokB};
    int e[4]; float g[4], rsv[2];
#pragma unroll
    for (int q = 0; q < 4; ++q) { e[q] = eib[(size_t)tok[q >> 1] * 128 + 64 * (q & 1) + pe]; g[q] = egb[(size_t)tok[q >> 1] * 128 + 64 * (q & 1) + pe]; }
    rsv[0] = rss[tokA]; rsv[1] = rss[tokB];
    unsigned zw[8];
#pragma unroll
    for (int tk = 0; tk < 2; ++tk)
#pragma unroll
        for (int x = 0; x < 4; ++x) zw[tk * 4 + x] = Zb[(size_t)tok[tk] * 4 * 64 + x * 64 + lane];
    float su[4], sv[4];
#pragma unroll
    for (int q = 0; q < 4; ++q) { su[q] = SU[e[q]]; sv[q] = SV[e[q]]; }
    PIN8(zw, 0);
#pragma unroll
    for (int q = 0; q < 4; ++q) {
        float zx[4];
#pragma unroll
        for (int x = 0; x < 4; ++x) { const f16x2v hv = __builtin_bit_cast(f16x2v, zw[(q >> 1) * 4 + x]); zx[x] = (q & 1) ? (float)hv.y : (float)hv.x; }
        const float z = (zx[0] + zx[1]) + (zx[2] + zx[3]);
        const float rs = rsqrtf(rsv[q >> 1] * (1.0f / 1024.0f) + EPS);
        { const float w = gelu_tanh(z * su[q] * rs) * g[q] * sv[q];
          Wb[(size_t)tok[q >> 1] * 128 + (q & 1) * 64 + lane] = ((unsigned)__builtin_bit_cast(unsigned short, (_Float16)w) << 16) | (unsigned)e[q]; }
    }
}
__device__ __forceinline__ void peer_v_issue4(u32x4 (&seg)[4], const unsigned char* Vx, const unsigned (&off)[16], int base) {
#pragma unroll
    for (int j = 0; j < 4; ++j) seg[j] = *(const u32x4*)(Vx + off[base + j]);
}
__device__ __forceinline__ void peer_v_seg(const u32x4& sg, f32x2v (&o)[16], float c) {
    f32x2v c2; c2.x = c;
    f32x2v t0, t1, t2, t3;
    asm volatile(
        "v_cvt_scalef32_pk_f32_fp4 %[t0], %[s0], 1.0 \n\t"
        "v_cvt_scalef32_pk_f32_fp4 %[t1], %[s0], 1.0 op_sel:[1,0,0]\n\t"
        "v_cvt_scalef32_pk_f32_fp4 %[t2], %[s0], 1.0 op_sel:[0,1,0]\n\t"
        "v_cvt_scalef32_pk_f32_fp4 %[t3], %[s0], 1.0 op_sel:[1,1,0]\n\t"
        "v_pk_fma_f32 %[o0], %[t0], %[c], %[o0] op_sel_hi:[1,0,1]\n\t"
        "v_pk_fma_f32 %[o1], %[t1], %[c], %[o1] op_sel_hi:[1,0,1]\n\t"
        "v_pk_fma_f32 %[o2], %[t2], %[c], %[o2] op_sel_hi:[1,0,1]\n\t"
        "v_pk_fma_f32 %[o3], %[t3], %[c], %[o3] op_sel_hi:[1,0,1]\n\t"
        "v_cvt_scalef32_pk_f32_fp4 %[t0], %[s1], 1.0 \n\t"
        "v_cvt_scalef32_pk_f32_fp4 %[t1], %[s1], 1.0 op_sel:[1,0,0]\n\t"
        "v_cvt_scalef32_pk_f32_fp4 %[t2], %[s1], 1.0 op_sel:[0,1,0]\n\t"
        "v_cvt_scalef32_pk_f32_fp4 %[t3], %[s1], 1.0 op_sel:[1,1,0]\n\t"
        "v_pk_fma_f32 %[o4], %[t0], %[c], %[o4] op_sel_hi:[1,0,1]\n\t"
        "v_pk_fma_f32 %[o5], %[t1], %[c], %[o5] op_sel_hi:[1,0,1]\n\t"
        "v_pk_fma_f32 %[o6], %[t2], %[c], %[o6] op_sel_hi:[1,0,1]\n\t"
        "v_pk_fma_f32 %[o7], %[t3], %[c], %[o7] op_sel_hi:[1,0,1]\n\t"
        "v_cvt_scalef32_pk_f32_fp4 %[t0], %[s2], 1.0 \n\t"
        "v_cvt_scalef32_pk_f32_fp4 %[t1], %[s2], 1.0 op_sel:[1,0,0]\n\t"
        "v_cvt_scalef32_pk_f32_fp4 %[t2], %[s2], 1.0 op_sel:[0,1,0]\n\t"
        "v_cvt_scalef32_pk_f32_fp4 %[t3], %[s2], 1.0 op_sel:[1,1,0]\n\t"
        "v_pk_fma_f32 %[o8], %[t0], %[c], %[o8] op_sel_hi:[1,0,1]\n\t"
        "v_pk_fma_f32 %[o9], %[t1], %[c], %[o9] op_sel_hi:[1,0,1]\n\t"
        "v_pk_fma_f32 %[o10], %[t2], %[c], %[o10] op_sel_hi:[1,0,1]\n\t"
        "v_pk_fma_f32 %[o11], %[t3], %[c], %[o11] op_sel_hi:[1,0,1]\n\t"
        "v_cvt_scalef32_pk_f32_fp4 %[t0], %[s3], 1.0 \n\t"
        "v_cvt_scalef32_pk_f32_fp4 %[t1], %[s3], 1.0 op_sel:[1,0,0]\n\t"
        "v_cvt_scalef32_pk_f32_fp4 %[t2], %[s3], 1.0 op_sel:[0,1,0]\n\t"
        "v_cvt_scalef32_pk_f32_fp4 %[t3], %[s3], 1.0 op_sel:[1,1,0]\n\t"
        "v_pk_fma_f32 %[o12], %[t0], %[c], %[o12] op_sel_hi:[1,0,1]\n\t"
        "v_pk_fma_f32 %[o13], %[t1], %[c], %[o13] op_sel_hi:[1,0,1]\n\t"
        "v_pk_fma_f32 %[o14], %[t2], %[c], %[o14] op_sel_hi:[1,0,1]\n\t"
        "v_pk_fma_f32 %[o15], %[t3], %[c], %[o15] op_sel_hi:[1,0,1]"
        : [o0] "+v"(o[0]), [o1] "+v"(o[1]), [o2] "+v"(o[2]), [o3] "+v"(o[3]), [o4] "+v"(o[4]), [o5] "+v"(o[5]), [o6] "+v"(o[6]), [o7] "+v"(o[7]), [o8] "+v"(o[8]), [o9] "+v"(o[9]), [o10] "+v"(o[10]), [o11] "+v"(o[11]), [o12] "+v"(o[12]), [o13] "+v"(o[13]), [o14] "+v"(o[14]), [o15] "+v"(o[15]),
          [t0] "=&v"(t0), [t1] "=&v"(t1), [t2] "=&v"(t2), [t3] "=&v"(t3)
        : [s0] "v"(sg[0]), [s1] "v"(sg[1]), [s2] "v"(sg[2]), [s3] "v"(sg[3]), [c] "v"(c2));
}
__device__ __forceinline__ void peer_v_quarter(u32x4 (&seg)[4], f32x2v (&o)[16], const float (&cc)[16], int base) {
#pragma unroll
    for (int j = 0; j < 4; ++j) peer_v_seg(seg[j], o, cc[base + j]);
}
__device__ __forceinline__ void peer_unpack(float (&cc)[16], unsigned (&off)[16], unsigned pk0, unsigned pk1, int gq, unsigned sub16) {
#pragma unroll
    for (int bb = 0; bb < 8; ++bb) {
        const unsigned w0 = (unsigned)__shfl((int)pk0, 8 * gq + bb), w1 = (unsigned)__shfl((int)pk1, 8 * gq + bb);
        cc[bb] = (float)__builtin_bit_cast(_Float16, (unsigned short)(w0 >> 16)); cc[8 + bb] = (float)__builtin_bit_cast(_Float16, (unsigned short)(w1 >> 16));
        off[bb] = ((w0 & 0xffffu) << 7) | sub16; off[8 + bb] = ((w1 & 0xffffu) << 7) | sub16;
    }
}
__device__ void peer_v_pass(const Params& p, int t0, int tstep, int x, int lane) {
    const int gq = lane >> 3, sub = lane & 7;
    const unsigned* Wb = (const unsigned*)(p.ws + OFF_WBUF);
    const unsigned char* Vq = p.ws + OFF_VB + (size_t)x * NEXP * 128; const unsigned sub16 = (unsigned)sub * 16u;
    if (t0 >= NTOK) return;
    const bool b5 = (lane & 32) != 0, b4 = (lane & 16) != 0, b3 = (lane & 8) != 0;
    const int col = x * 256 + 32 * sub + (b5 ? 16 : 0) + (b4 ? 8 : 0) + (b3 ? 4 : 0);
    unsigned off[16]; float cc[16];
    { const unsigned pk0 = Wb[(size_t)t0 * 128 + lane], pk1 = Wb[(size_t)t0 * 128 + 64 + lane]; peer_unpack(cc, off, pk0, pk1, gq, sub16); }
    u32x4 SA[4], SB[4], SC[4], SD[4];
    peer_v_issue4(SA, Vq, off, 0); peer_v_issue4(SB, Vq, off, 4);
    for (int t = t0; t < NTOK; t += tstep) {
        f32x2v o2[16];
#pragma unroll
        for (int i = 0; i < 16; ++i) o2[i] = (f32x2v){0.f, 0.f};
        const int tn = t + tstep < NTOK ? t + tstep : t;
        const unsigned npk0 = Wb[(size_t)tn * 128 + lane], npk1 = Wb[(size_t)tn * 128 + 64 + lane];
        uint2* xr = (uint2*)(x1b_row(p.ws, (size_t)t) + col);
        const uint2 xw = *xr;
        int gl = gq; asm volatile("" : "+v"(gl));
        peer_v_issue4(SC, Vq, off, 8);  peer_v_quarter(SA, o2, cc, 0);
        peer_v_issue4(SD, Vq, off, 12); peer_v_quarter(SB, o2, cc, 4);
        float ncc[16];
        peer_unpack(ncc, off, npk0, npk1, gl, sub16);
        peer_v_issue4(SA, Vq, off, 0);  peer_v_quarter(SC, o2, cc, 8);
        peer_v_issue4(SB, Vq, off, 4);  peer_v_quarter(SD, o2, cc, 12);
#pragma unroll
        for (int i = 0; i < 16; ++i) cc[i] = ncc[i];
        float a16[16], a8[8], a4[4];
#pragma unroll
        for (int i = 0; i < 16; ++i) { const float lo = (i & 1) ? o2[i >> 1].y : o2[i >> 1].x, hi = (i & 1) ? o2[8 + (i >> 1)].y : o2[8 + (i >> 1)].x;
            const u32x2v r = __builtin_amdgcn_permlane32_swap(__float_as_uint(lo), __float_as_uint(hi), false, false);
            a16[i] = __uint_as_float(r.x) + __uint_as_float(r.y); }
#pragma unroll
        for (int i = 0; i < 8; ++i) { const u32x2v r = __builtin_amdgcn_permlane16_swap(__float_as_uint(a16[i]), __float_as_uint(a16[8 + i]), false, false);
            a8[i] = __uint_as_float(r.x) + __uint_as_float(r.y); }
#pragma unroll
        for (int i = 0; i < 4; ++i) {
            const float u0 = a8[i] + __int_as_float(__builtin_amdgcn_mov_dpp(__float_as_int(a8[i]), 0x128, 0xF, 0xF, true));
            const float u1 = a8[4 + i] + __int_as_float(__builtin_amdgcn_mov_dpp(__float_as_int(a8[4 + i]), 0x128, 0xF, 0xF, true));
            a4[i] = b3 ? u1 : u0;
        }
        const float x0 = bflo(xw.x) + a4[0], x1 = bfhi(xw.x) + a4[1], x2 = bflo(xw.y) + a4[2], x3 = bfhi(xw.y) + a4[3];
        *xr = make_uint2(pack_bf16(x0, x1), pack_bf16(x2, x3));
    }
}
__device__ void final_norm_rows(const Params& p, int t0, int step, int lane) {
    if (t0 >= NTOK) return;
    const float* gf = p.g_final + lane * 16;
    float4 gg[4];
#pragma unroll
    for (int i = 0; i < 4; ++i) gg[i] = *(const float4*)(gf + 4 * i);
    uint4 xa, xc;
    { const uint4* xs = (const uint4*)(x1b_row(p.ws, (size_t)t0) + lane * 16); xa = xs[0]; xc = xs[1]; }
    for (int t = t0; t < NTOK; t += step) {
        const int tn = t + step < NTOK ? t + step : t;
        const uint4* xs = (const uint4*)(x1b_row(p.ws, (size_t)tn) + lane * 16);
        const uint4 nxa = xs[0], nxc = xs[1];
        float* xr = p.out + (size_t)t * 1024 + lane * 16;
        const unsigned xw[8] = {xa.x, xa.y, xa.z, xa.w, xc.x, xc.y, xc.z, xc.w};
        float ss = 0.f;
#pragma unroll
        for (int i = 0; i < 8; ++i) { const float a = bflo(xw[i]), b = bfhi(xw[i]); ss += a * a + b * b; }
        ss = wave_sum(ss);
        const float rs = rsqrtf(ss * (1.0f / 1024.0f) + EPS);
#pragma unroll
        for (int i = 0; i < 4; ++i)
            *(float4*)(xr + 4 * i) = make_float4(bflo(xw[2 * i]) * rs * gg[i].x, bfhi(xw[2 * i]) * rs * gg[i].y, bflo(xw[2 * i + 1]) * rs * gg[i].z, bfhi(xw[2 * i + 1]) * rs * gg[i].w);
        xa = nxa; xc = nxc;
    }
}


__device__ __forceinline__ void rms_row_finish(const f32x4 (&v)[4], const float* __restrict__ g, bf16_t* __restrict__ o, int lane) {
    float ss = 0.f;
#pragma unroll
    for (int i = 0; i < 4; ++i) ss += (v[i][0] * v[i][0] + v[i][1] * v[i][1]) + (v[i][2] * v[i][2] + v[i][3] * v[i][3]);
    ss = wave_sum(ss);
    const float rs = rsqrtf(ss * (1.0f / 1024.0f) + EPS);
#pragma unroll
    for (int i = 0; i < 4; ++i) {
        const float4 gg = *(const float4*)(g + i * 256 + lane * 4);
        *(uint2*)(o + i * 256 + lane * 4) = make_uint2(pack_bf16(v[i][0] * rs * gg.x, v[i][1] * rs * gg.y), pack_bf16(v[i][2] * rs * gg.z, v[i][3] * rs * gg.w));
    }
}
__device__ __forceinline__ void rms_rows_pipelined(const float* __restrict__ x, const float* __restrict__ g, bf16_t* __restrict__ o, int nrows, int r0, int step, int lane) {
    if (r0 >= nrows) return;
    f32x4 cur[4], n1[4];
    { const int r1 = r0 + step < nrows ? r0 + step : r0;
#pragma unroll
      for (int i = 0; i < 4; ++i) { cur[i] = *(const f32x4*)(x + (size_t)r0 * 1024 + i * 256 + lane * 4); n1[i] = *(const f32x4*)(x + (size_t)r1 * 1024 + i * 256 + lane * 4); } }
    for (int r = r0; r < nrows; r += step) {
        const int rn = r + 2 * step < nrows ? r + 2 * step : r;
        f32x4 n2[4];
#pragma unroll
        for (int i = 0; i < 4; ++i) n2[i] = *(const f32x4*)(x + (size_t)rn * 1024 + i * 256 + lane * 4);
        PIN4(cur, 0);
        rms_row_finish(cur, g, o + (size_t)r * 1024, lane);
#pragma unroll
        for (int i = 0; i < 4; ++i) { cur[i] = n1[i]; n1[i] = n2[i]; }
    }
}
template <bool INT8>
__device__ __forceinline__ void conv_row_finish(const f32x4 (&v)[4], unsigned char* __restrict__ dst, float* __restrict__ scale, int row, int lane) {
    float am = 0.f;
#pragma unroll
    for (int i = 0; i < 4; ++i) am = fmaxf(am, fmaxf(fmaxf(fabsf(v[i][0]), fabsf(v[i][1])), fmaxf(fabsf(v[i][2]), fabsf(v[i][3]))));
#pragma unroll
    for (int o = 32; o >= 1; o >>= 1) am = fmaxf(am, __shfl_xor(am, o));
    if constexpr (INT8) {
        float ss = 0.f;
#pragma unroll
        for (int i = 0; i < 4; ++i) ss += (v[i][0] * v[i][0] + v[i][1] * v[i][1]) + (v[i][2] * v[i][2] + v[i][3] * v[i][3]);
#pragma unroll
        for (int o = 32; o >= 1; o >>= 1) ss += __shfl_xor(ss, o);
        const float lim = fminf(am, 2.6f * sqrtf(ss * (1.0f / 1024.0f)));
        const float sc = lim > 0.f ? lim * (1.0f / 7.0f) : 1.0f, inv = 1.0f / sc;
        const int sh4 = (lane & 1) * 4;
#pragma unroll
        for (int i = 0; i < 4; ++i) {
            unsigned mine = 0;
#pragma unroll
            for (int b = 0; b < 4; ++b) mine |= (unsigned)(__float2int_rn(fminf(fmaxf(v[i][b] * inv, -7.f), 7.f)) & 15) << (8 * b + sh4);
            const unsigned both = mine | (unsigned)__builtin_amdgcn_mov_dpp((int)mine, 0xB1, 0xF, 0xF, true);
            if (!(lane & 1)) *(unsigned*)(dst + ((size_t)i * NEXP + row) * 128 + (lane >> 1) * 4) = both;
        }
        if (lane == 0) scale[row] = sc;
    } else {
        const float sc4 = am > 0.f ? am * (1.0f / 6.0f) : 1.0f, inv4 = 1.0f / sc4;
        const int sh16 = (lane & 1) * 16;
#pragma unroll
        for (int i = 0; i < 4; ++i) {
            unsigned h = 0;
            h = __builtin_amdgcn_cvt_scalef32_pk_fp4_f32(h, v[i][0] * inv4, v[i][1] * inv4, 1.0f, 0);
            h = __builtin_amdgcn_cvt_scalef32_pk_fp4_f32(h, v[i][2] * inv4, v[i][3] * inv4, 1.0f, 1);
            const unsigned mine = (h & 0xffffu) << sh16;
            const unsigned both = mine | (unsigned)__builtin_amdgcn_mov_dpp((int)mine, 0xB1, 0xF, 0xF, true);
            if (!(lane & 1)) *(unsigned*)(dst + ((size_t)i * NEXP + row) * 128 + (lane >> 1) * 4) = both;
        }
        if (lane == 0) scale[row] = sc4;
    }
}
__device__ __forceinline__ void table_rows_pipelined(const Params& p, int r0, int step, int lane) {
    const int N2 = 2 * NEXP;
    if (r0 >= N2) return;
    auto rowp = [&](int r) { return (const f32x4*)((r < NEXP ? p.peer_u + (size_t)r * 1024 : p.peer_v + (size_t)(r - NEXP) * 1024) + lane * 4); };
    f32x4 gf4[4];
#pragma unroll
    for (int i = 0; i < 4; ++i) gf4[i] = *(const f32x4*)(p.g_ffn + i * 256 + lane * 4);
    f32x4 cur[4], n1[4];
    { const f32x4* s = rowp(r0); const f32x4* s1 = rowp(r0 + step < N2 ? r0 + step : r0);
#pragma unroll
      for (int i = 0; i < 4; ++i) { cur[i] = s[i * 64]; n1[i] = s1[i * 64]; } }
    for (int r = r0; r < N2; r += step) {
        const f32x4* s = rowp(r + 2 * step < N2 ? r + 2 * step : r);
        f32x4 n2[4];
#pragma unroll
        for (int i = 0; i < 4; ++i) n2[i] = s[i * 64];
        PIN4(cur, 0);
        if (r < NEXP) {
#pragma unroll
            for (int i = 0; i < 4; ++i) cur[i] *= gf4[i];
        }
        if (r < NEXP) conv_row_finish<true>(cur, p.ws + OFF_UB, (float*)(p.ws + OFF_SU), r, lane);
        else conv_row_finish<false>(cur, p.ws + OFF_VB, (float*)(p.ws + OFF_SV), r - NEXP, lane);
#pragma unroll
        for (int i = 0; i < 4; ++i) { cur[i] = n1[i]; n1[i] = n2[i]; }
    }
}


namespace pg8 {
#define PG8_LAS __attribute__((address_space(3)))
constexpr int BM = 256, BK = 64, HALF = 128, HTB = HALF * BK * 2  , STAGE_BYTES = 8 * HTB, NXCD = 8, WGM = 8;

__host__ __device__ __forceinline__ int lds_byte(int r, int c) { const int st = (r >> 4) * 2 + (c >> 5), rr = r & 15, cc = c & 31, ob = rr * 64 + cc * 2; return st * 1024 + (ob ^ (((ob >> 9) & 1) << 5)); }
__host__ __device__ __forceinline__ void stage_rc(int b, int& R, int& C) { const int st = b / 1024, sb = b % 1024, swz = sb ^ (((sb >> 9) & 1) << 5); R = (st >> 1) * 16 + swz / 64; C = (st & 1) * 32 + (swz % 64) / 2; }
__host__ __device__ __forceinline__ int perm32(int rho) { const int n = rho >> 4, i = rho & 15; return 8 * (i >> 2) + 4 * n + (i & 3); }

struct Unit { int pm, pn; };
struct Gemm { const bf16_t* A; const bf16_t* Bt; int M, N, K; };

struct StaticOrder {
    int nM, nN, nwg, G, c;
    __host__ __device__ void init(int M, int N, int G_, int c_) { nM = M / BM; nN = N / BM; nwg = nM * nN; G = G_; c = c_; }
    __host__ __device__ bool next(int i, Unit& u) const {
        const long L = (long)i * G + c; if (L >= nwg) return false;
        int wgid = (int)L; { const int q = nwg / NXCD, r = nwg % NXCD, xcd = wgid % NXCD, off = wgid / NXCD; wgid = (xcd < r ? xcd * (q + 1) : r * (q + 1) + (xcd - r) * q) + off; }
        const int nig = WGM * nN, gid = wgid / nig, fm = gid * WGM, gsz = (nM - fm) < WGM ? (nM - fm) : WGM;
        u.pm = fm + ((wgid % nig) % gsz); u.pn = (wgid % nig) / gsz; return true;
    }
    __device__ __forceinline__ void a_ready(const Unit&) const {}
    __device__ __forceinline__ void done(const Unit&) const {}
};


template <class F> struct EpiFn {
    static constexpr bool PERM = true, AFTER_DRAIN = false;
    F f;
    __device__ __forceinline__ void operator()(const f32x4 (&acc)[2][2][4][2], const Unit& u, int wr, int wc, int fr, int fq) const {
#pragma unroll
        for (int ai = 0; ai < 2; ++ai)
#pragma unroll
            for (int m = 0; m < 4; ++m)
#pragma unroll
                for (int bj = 0; bj < 2; ++bj) {
                    float v[8];
#pragma unroll
                    for (int r = 0; r < 4; ++r) { v[r] = acc[ai][bj][m][0][r]; v[4 + r] = acc[ai][bj][m][1][r]; }
                    f(u.pm * BM + ai * HALF + wr * 64 + m * 16 + fr, u.pn * BM + bj * HALF + wc * 32 + 8 * fq, v);
                }
    }
};
template <class Epi, class Sched, bool ALIGN_EPI = false, bool SP2 = false>
__device__ __forceinline__ void gemm_phase(PG8_LAS unsigned char* lds, const Gemm g, const Sched& S, const Epi& E) {
    int tid_ = threadIdx.x; asm volatile("" : "+v"(tid_));
    const int tid = tid_, wid = __builtin_amdgcn_readfirstlane(tid >> 6), lane = tid & 63, wr = wid >> 2, wc = wid & 3, fr = lane & 15, fq = lane >> 4;
    const int K = g.K, nt = K / BK;
    unsigned voffA[2], voffB[2];
#pragma unroll
    for (int i = 0; i < 2; ++i) { int R, C; stage_rc(tid * 16 + i * 8192, R, C); const int Rb = Epi::PERM ? ((R & ~31) + perm32(R & 31)) : R;
        voffA[i] = (unsigned)(R * K + C) * 2u; voffB[i] = (unsigned)(Rb * K + C) * 2u; }
    const size_t kstep = (size_t)(BK * 2);
    const size_t hstep = (size_t)HALF * K * 2;
    const size_t tstep = 2 * hstep;
    const unsigned ldsw = (unsigned)wid * 1024u;
    const int aoff = lds_byte(wr * 64 + fr, fq * 8), boff = lds_byte(wc * 32 + fr, fq * 8);
#define PG8_SA(b, h) (((b) * 2 + (h)) * HTB)
#define PG8_SB(b, h) ((4 + (b) * 2 + (h)) * HTB)
#define PG8_STAGE(bufoff, gbase, voff) do { _Pragma("unroll") for (int _i = 0; _i < 2; ++_i) \
        __builtin_amdgcn_global_load_lds((const unsigned*)((const char*)(gbase) + (voff)[_i]), (PG8_LAS unsigned*)(lds + (bufoff) + ldsw + _i * 8192), 16, 0, 0); } while (0)
#define PG8_LDA(dst, b, h) do { _Pragma("unroll") for (int m = 0; m < 4; ++m) _Pragma("unroll") for (int k = 0; k < 2; ++k) dst[m][k] = *(const PG8_LAS bf16x8*)(lds + PG8_SA(b, h) + aoff + m * 2048 + k * 1024); } while (0)
#define PG8_LDB(dst, b, h) do { _Pragma("unroll") for (int n = 0; n < 2; ++n) _Pragma("unroll") for (int k = 0; k < 2; ++k) dst[n][k] = *(const PG8_LAS bf16x8*)(lds + PG8_SB(b, h) + boff + n * 2048 + k * 1024); } while (0)
#define PG8_MMA(ai, bj, At, Bt) do { __builtin_amdgcn_s_setprio(1); _Pragma("unroll") for (int m = 0; m < 4; ++m) _Pragma("unroll") for (int n = 0; n < 2; ++n) _Pragma("unroll") for (int k = 0; k < 2; ++k) \
        acc[ai][bj][m][n] = __builtin_amdgcn_mfma_f32_16x16x32_bf16(Bt[n][k], At[m][k], acc[ai][bj][m][n], 0, 0, 0); __builtin_amdgcn_s_setprio(0); } while (0)
#define PG8_WAIT_V(n) asm volatile("s_waitcnt vmcnt(" #n ")" ::: "memory")
#define PG8_WAIT_L(n) asm volatile("s_waitcnt lgkmcnt(" #n ")" ::: "memory")
#define PG8_BAR __builtin_amdgcn_s_barrier()
#define PG8_SCHED __builtin_amdgcn_sched_barrier(0)
    Unit cur, nxt; int ui = 0;
    if (!S.next(0, cur)) return;
    f32x4 acc[2][2][4][2];
#pragma unroll
    for (int a = 0; a < 2; ++a)
#pragma unroll
        for (int b = 0; b < 2; ++b)
#pragma unroll
            for (int m = 0; m < 4; ++m)
#pragma unroll
                for (int n = 0; n < 2; ++n) acc[a][b][m][n] = (f32x4){0.f, 0.f, 0.f, 0.f};
    bf16x8 At[4][2], B0[2][2], B1[2][2];
    const char* cA = (const char*)g.A + (size_t)cur.pm * tstep; const char* cB = (const char*)g.Bt + (size_t)cur.pn * tstep;
    S.a_ready(cur);
    if constexpr (SP2) {
        PG8_STAGE(PG8_SB(0, 0), cB, voffB); PG8_STAGE(PG8_SB(0, 1), cB + hstep, voffB); PG8_STAGE(PG8_SA(0, 0), cA, voffA); PG8_STAGE(PG8_SA(0, 1), cA + hstep, voffA);
        if (wr == 1) PG8_BAR;
        PG8_WAIT_V(2); PG8_BAR;
        PG8_STAGE(PG8_SB(1, 0), cB + kstep, voffB); PG8_STAGE(PG8_SA(1, 0), cA + kstep, voffA); PG8_STAGE(PG8_SB(1, 1), cB + hstep + kstep, voffB);
        PG8_WAIT_V(6); PG8_BAR;
    } else {
        PG8_STAGE(PG8_SB(0, 0), cB, voffB); PG8_STAGE(PG8_SA(0, 0), cA, voffA); PG8_STAGE(PG8_SB(0, 1), cB + hstep, voffB); PG8_STAGE(PG8_SA(0, 1), cA + hstep, voffA);
        if (wr == 1) PG8_BAR;
        PG8_WAIT_V(4); PG8_BAR;
        PG8_STAGE(PG8_SB(1, 0), cB + kstep, voffB); PG8_STAGE(PG8_SA(1, 0), cA + kstep, voffA); PG8_STAGE(PG8_SB(1, 1), cB + hstep + kstep, voffB);
        PG8_WAIT_V(6); PG8_BAR;
    }
    for (;;) {
        const bool has_next = S.next(ui + 1, nxt);
        const char* nA = has_next ? (const char*)g.A + (size_t)nxt.pm * tstep : cA; const char* nB = has_next ? (const char*)g.Bt + (size_t)nxt.pn * tstep : cB;
        for (int t = 0; t < nt; t += 2) {
            const bool last = (t == nt - 2);
            const char* a1 = cA + (size_t)(t + 1) * kstep;
            const char* a2 = last ? nA : cA + (size_t)(t + 2) * kstep; const char* b2 = last ? nB : cB + (size_t)(t + 2) * kstep;
            const char* a3 = a2 + kstep; const char* b3 = b2 + kstep;
            if (last && has_next) S.a_ready(nxt);
            if constexpr (SP2) {
            PG8_LDB(B0, 0, 0); PG8_LDB(B1, 0, 1); PG8_SCHED; PG8_LDA(At, 0, 0); PG8_STAGE(PG8_SA(1, 1), a1 + hstep, voffA);
            PG8_WAIT_V(8); PG8_WAIT_L(0); PG8_BAR; PG8_MMA(0, 0, At, B0); PG8_MMA(0, 1, At, B1); PG8_BAR; PG8_SCHED;
            PG8_LDA(At, 0, 1); PG8_STAGE(PG8_SB(0, 0), b2, voffB); PG8_STAGE(PG8_SB(0, 1), b2 + hstep, voffB); PG8_STAGE(PG8_SA(0, 0), a2, voffA);
            PG8_WAIT_V(8); PG8_WAIT_L(0); PG8_BAR; PG8_MMA(1, 0, At, B0); PG8_MMA(1, 1, At, B1); PG8_BAR; PG8_SCHED;
            PG8_LDB(B0, 1, 0); PG8_LDB(B1, 1, 1); PG8_SCHED; PG8_LDA(At, 1, 0); PG8_STAGE(PG8_SA(0, 1), a2 + hstep, voffA);
            PG8_WAIT_V(8); PG8_WAIT_L(0); PG8_BAR; PG8_MMA(0, 0, At, B0); PG8_MMA(0, 1, At, B1); PG8_BAR; PG8_SCHED;
            PG8_LDA(At, 1, 1); PG8_STAGE(PG8_SB(1, 0), b3, voffB); PG8_STAGE(PG8_SB(1, 1), b3 + hstep, voffB); PG8_STAGE(PG8_SA(1, 0), a3, voffA);
            PG8_WAIT_V(8); PG8_WAIT_L(0); PG8_BAR; PG8_MMA(1, 0, At, B0); PG8_MMA(1, 1, At, B1); PG8_BAR; PG8_SCHED;
            } else {
            PG8_LDB(B0, 0, 0); PG8_SCHED; PG8_LDA(At, 0, 0); PG8_STAGE(PG8_SA(1, 1), a1 + hstep, voffA);
            PG8_WAIT_L(8); PG8_BAR; PG8_WAIT_L(0); PG8_MMA(0, 0, At, B0); PG8_BAR; PG8_SCHED;
            PG8_LDB(B1, 0, 1); PG8_STAGE(PG8_SB(0, 0), b2, voffB);
            PG8_BAR; PG8_WAIT_L(0); PG8_MMA(0, 1, At, B1); PG8_BAR;
            PG8_LDA(At, 0, 1); PG8_STAGE(PG8_SA(0, 0), a2, voffA);
            PG8_BAR; PG8_WAIT_L(0); PG8_MMA(1, 0, At, B0); PG8_BAR; PG8_SCHED;
            PG8_STAGE(PG8_SB(0, 1), b2 + hstep, voffB);
            PG8_WAIT_V(6); PG8_BAR; PG8_MMA(1, 1, At, B1); PG8_BAR;
            PG8_LDB(B0, 1, 0); PG8_SCHED; PG8_LDA(At, 1, 0); PG8_STAGE(PG8_SA(0, 1), a2 + hstep, voffA);
            PG8_WAIT_L(8); PG8_BAR; PG8_WAIT_L(0); PG8_MMA(0, 0, At, B0); PG8_BAR; PG8_SCHED;
            PG8_LDB(B1, 1, 1); PG8_STAGE(PG8_SB(1, 0), b3, voffB);
            PG8_BAR; PG8_WAIT_L(0); PG8_MMA(0, 1, At, B1); PG8_BAR;
            PG8_LDA(At, 1, 1); PG8_STAGE(PG8_SA(1, 0), a3, voffA);
            PG8_BAR; PG8_WAIT_L(0); PG8_MMA(1, 0, At, B0); PG8_BAR; PG8_SCHED;
            PG8_STAGE(PG8_SB(1, 1), b3 + hstep, voffB);
            PG8_WAIT_V(6); PG8_BAR; PG8_MMA(1, 1, At, B1); PG8_BAR;
            }
        }
        if constexpr (ALIGN_EPI) { if (wr == 0) PG8_BAR; }
        if constexpr (!Epi::AFTER_DRAIN) { E(acc, cur, wr, wc, fr, fq); S.done(cur); }
        if (!has_next) break;
#pragma unroll
        for (int a = 0; a < 2; ++a)
#pragma unroll
            for (int b = 0; b < 2; ++b)
#pragma unroll
                for (int m = 0; m < 4; ++m)
#pragma unroll
                    for (int n = 0; n < 2; ++n) acc[a][b][m][n] = (f32x4){0.f, 0.f, 0.f, 0.f};
        cur = nxt; cA = nA; cB = nB; ++ui;
        if constexpr (ALIGN_EPI) { if (wr == 1) PG8_BAR; }
    }
    PG8_WAIT_V(0);
    if constexpr (!ALIGN_EPI) { if (wr == 0) PG8_BAR; }
    PG8_BAR;
    if constexpr (Epi::AFTER_DRAIN) { E.fused(acc, cur, wr, wc, fr, fq, lds, wid, lane); S.done(cur); }
#undef PG8_SA
#undef PG8_SB
#undef PG8_STAGE
#undef PG8_LDA
#undef PG8_LDB
#undef PG8_MMA
#undef PG8_WAIT_V
#undef PG8_WAIT_L
#undef PG8_BAR
#undef PG8_SCHED
}

}


namespace pg8 {
__device__ __forceinline__ void item_vals(const f32x4 (&acc)[2][2][4][2], int ai, int bj, int m, float (&v)[8]) {
#pragma unroll
    for (int r = 0; r < 4; ++r) { v[r] = acc[ai][bj][m][0][r]; v[4 + r] = acc[ai][bj][m][1][r]; }
}
struct EpiOutproj {
    static constexpr bool PERM = true, AFTER_DRAIN = false;
    const float* x; unsigned char* ws; float* rowss;
    __device__ __forceinline__ void operator()(const f32x4 (&acc)[2][2][4][2], const Unit& u, int wr, int wc, int fr, int fq) const {
#pragma unroll
        for (int ai = 0; ai < 2; ++ai)
#pragma unroll
            for (int mh = 0; mh < 2; ++mh) {
                f32x4 xv[8];
#pragma unroll
                for (int mm = 0; mm < 2; ++mm)
#pragma unroll
                    for (int bj = 0; bj < 2; ++bj) {
                        const int m = mh * 2 + mm;
                        const size_t o = (size_t)(u.pm * BM + ai * HALF + wr * 64 + m * 16 + fr) * 1024 + u.pn * BM + bj * HALF + wc * 32 + 8 * fq;
                        xv[(mm * 2 + bj) * 2] = *(const f32x4*)(x + o); xv[(mm * 2 + bj) * 2 + 1] = *(const f32x4*)(x + o + 4);
                    }
                PIN8(xv, 0);
#pragma unroll
                for (int mm = 0; mm < 2; ++mm) {
                    const int m = mh * 2 + mm;
                    const size_t row = (size_t)(u.pm * BM + ai * HALF + wr * 64 + m * 16 + fr);
                    float ss = 0.f;
#pragma unroll
                    for (int bj = 0; bj < 2; ++bj) {
                        const size_t o = row * 1024 + u.pn * BM + bj * HALF + wc * 32 + 8 * fq;
                        const f32x4 a = xv[(mm * 2 + bj) * 2] + acc[ai][bj][m][0], b = xv[(mm * 2 + bj) * 2 + 1] + acc[ai][bj][m][1];
                        { const float xv8[8] = {a[0], a[1], a[2], a[3], b[0], b[1], b[2], b[3]};
                          store_bf16x8(x1b_row(ws, row) + u.pn * BM + bj * HALF + wc * 32 + 8 * fq, xv8); }
                        ss += (a[0] * a[0] + a[1] * a[1]) + (a[2] * a[2] + a[3] * a[3]) + (b[0] * b[0] + b[1] * b[1]) + (b[2] * b[2] + b[3] * b[3]);
                    }
                    ss += __shfl_xor(ss, 16); ss += __shfl_xor(ss, 32);
                    if (fq == 0) atomicAdd(rowss + row, ss);
                }
            }
    }
};
struct EpiMerge {
    static constexpr bool PERM = true, AFTER_DRAIN = false;
    const bf16_t* G; bf16_t* merged; int br;
    __device__ __forceinline__ void operator()(const f32x4 (&acc)[2][2][4][2], const Unit& u, int wr, int wc, int fr, int fq) const {
#pragma unroll
        for (int ai = 0; ai < 2; ++ai)
#pragma unroll
            for (int mh = 0; mh < 2; ++mh) {
                u32x4 gm[8];
#pragma unroll
                for (int mm = 0; mm < 2; ++mm)
#pragma unroll
                    for (int bj = 0; bj < 2; ++bj) {
                        const int m = mh * 2 + mm;
                        const size_t row = (size_t)(u.pm * BM + ai * HALF + wr * 64 + m * 16 + fr); const int col = u.pn * BM + bj * HALF + wc * 32 + 8 * fq;
                        gm[mm * 2 + bj] = *(const u32x4*)(G + row * 3072 + br * 1024 + col);
                        gm[4 + mm * 2 + bj] = br > 0 ? *(const u32x4*)(merged + row * 1024 + col) : (u32x4){0u, 0u, 0u, 0u};
                    }
                PIN8(gm, 0);
#pragma unroll
                for (int mm = 0; mm < 2; ++mm)
#pragma unroll
                    for (int bj = 0; bj < 2; ++bj) {
                        const int m = mh * 2 + mm;
                        const size_t row = (size_t)(u.pm * BM + ai * HALF + wr * 64 + m * 16 + fr); const int col = u.pn * BM + bj * HALF + wc * 32 + 8 * fq;
                        float v[8]; item_vals(acc, ai, bj, m, v);
                        const u32x4 g4 = gm[mm * 2 + bj], t = gm[4 + mm * 2 + bj];
#pragma unroll
                        for (int e = 0; e < 4; ++e) { v[2 * e] = v[2 * e] * bflo(g4[e]) + bflo(t[e]); v[2 * e + 1] = v[2 * e + 1] * bfhi(g4[e]) + bfhi(t[e]); }
                        store_bf16x8(merged + row * 1024 + col, v);
                    }
            }
    }
};
struct EpiInproj {
    static constexpr bool PERM = true, AFTER_DRAIN = false;
    unsigned char* ws; const float* cs; const float* gate_b;
    __device__ __forceinline__ void operator()(const f32x4 (&acc)[2][2][4][2], const Unit& u, int wr, int wc, int fr, int fq) const {
        const int pn = u.pn;
        if (pn < 4) {
            const bool isq = pn < 3;
            bf16_t* dst = isq ? (bf16_t*)(ws + OFF_QA) + pn * 256 : (bf16_t*)(ws + OFF_KA);
            const int ld = isq ? 768 : 256; const float sc = isq ? QSCALE : 1.0f;
#pragma unroll
            for (int ai = 0; ai < 2; ++ai)
#pragma unroll
                for (int mh = 0; mh < 2; ++mh) {
                    f32x4 csv[8];
                    if (wc == 0) {
#pragma unroll
                        for (int mm = 0; mm < 2; ++mm) {
                            const f32x4* csr = (const f32x4*)(cs + (size_t)(u.pm * BM + ai * HALF + wr * 64 + (mh * 2 + mm) * 16 + fr) * 32 + (fq & 1) * 16);
#pragma unroll
                            for (int q = 0; q < 4; ++q) csv[mm * 4 + q] = csr[q];
                        }
                        PIN8(csv, 0);
                    }
#pragma unroll
                    for (int mm = 0; mm < 2; ++mm)
#pragma unroll
                        for (int bj = 0; bj < 2; ++bj) {
                            const int m = mh * 2 + mm;
                            const size_t row = (size_t)(u.pm * BM + ai * HALF + wr * 64 + m * 16 + fr);
                            float v[8]; item_vals(acc, ai, bj, m, v);
                            if (wc == 0) {
                                const f32x4 c0 = csv[mm * 4], c1 = csv[mm * 4 + 1], c2 = csv[mm * 4 + 2], c3 = csv[mm * 4 + 3];
                                const float ccv[8] = {c0[0], c0[2], c1[0], c1[2], c2[0], c2[2], c3[0], c3[2]};
                                const float ssv[8] = {c0[1], c0[3], c1[1], c1[3], c2[1], c2[3], c3[1], c3[3]};
#pragma unroll
                                for (int e = 0; e < 8; ++e) {
                                    const float o = __shfl_xor(v[e], 32);
                                    v[e] = (fq < 2) ? (v[e] * ccv[e] - o * ssv[e]) : (v[e] * ccv[e] + o * ssv[e]);
                                }
                            }
#pragma unroll
                            for (int e = 0; e < 8; ++e) v[e] *= sc;
                            store_bf16x8(dst + row * ld + bj * HALF + wc * 32 + 8 * fq, v);
                        }
                }
        } else if (pn == 4) {
#pragma unroll
            for (int ai = 0; ai < 2; ++ai)
#pragma unroll
                for (int m = 0; m < 4; ++m)
#pragma unroll
                    for (int bj = 0; bj < 2; ++bj) {
                        const int row = u.pm * BM + ai * HALF + wr * 64 + m * 16 + fr, b = row / S_, s = row % S_;
                        float v[8]; item_vals(acc, ai, bj, m, v);
                        bf16_t* vt = (bf16_t*)(ws + OFF_VAT) + ((size_t)(b * 2 + bj) * 128 + wc * 32 + 8 * fq) * S_ + s;
#pragma unroll
                        for (int e = 0; e < 8; ++e) vt[(size_t)e * S_] = f2bf(v[e]);
                    }
        } else if (pn < 13) {
            const int kind = pn < 8 ? 0 : (pn < 11 ? 1 : 2);
            bf16_t* dst = kind == 0 ? (bf16_t*)(ws + OFF_XL) + (pn - 5) * 256 : (kind == 1 ? (bf16_t*)(ws + OFF_GL) + (pn - 8) * 256 : (bf16_t*)(ws + OFF_QM) + (pn - 11) * 256);
            const int ld = kind == 2 ? 512 : 768;
#pragma unroll
            for (int ai = 0; ai < 2; ++ai)
#pragma unroll
                for (int m = 0; m < 4; ++m)
#pragma unroll
                    for (int bj = 0; bj < 2; ++bj) {
                        const size_t row = (size_t)(u.pm * BM + ai * HALF + wr * 64 + m * 16 + fr);
                        float v[8]; item_vals(acc, ai, bj, m, v);
                        if (kind == 1) {
#pragma unroll
                            for (int e = 0; e < 8; ++e) v[e] = gelu_tanh(v[e]);
                        } else if (kind == 2) {
#pragma unroll
                            for (int e = 0; e < 8; ++e) v[e] *= QSCALE;
                        }
                        store_bf16x8(dst + row * ld + bj * HALF + wc * 32 + 8 * fq, v);
                    }
        } else {
            const int gc0 = (pn - 13) * 256;
            f32x4 gbv[4];
#pragma unroll
            for (int bj = 0; bj < 2; ++bj) { const float* gb = gate_b + gc0 + bj * HALF + wc * 32 + 8 * fq; gbv[2 * bj] = *(const f32x4*)gb; gbv[2 * bj + 1] = *(const f32x4*)(gb + 4); }
            PIN4(gbv, 0);
            bf16_t* dst = (bf16_t*)(ws + OFF_GATES) + gc0;
#pragma unroll
            for (int ai = 0; ai < 2; ++ai)
#pragma unroll
                for (int m = 0; m < 4; ++m)
#pragma unroll
                    for (int bj = 0; bj < 2; ++bj) {
                        const size_t row = (size_t)(u.pm * BM + ai * HALF + wr * 64 + m * 16 + fr);
                        float v[8]; item_vals(acc, ai, bj, m, v);
                        const f32x4 b0 = gbv[2 * bj], b1 = gbv[2 * bj + 1];
#pragma unroll
                        for (int e = 0; e < 4; ++e) { v[e] = sigmoidf_(v[e] + b0[e]); v[4 + e] = sigmoidf_(v[4 + e] + b1[e]); }
                        store_bf16x8(dst + row * 3072 + bj * HALF + wc * 32 + 8 * fq, v);
                    }
        }
    }
};
}

#define XB_TMO      128
#define XB_XCNT(j)  (256  + 64 * (j))
#define XB_XSUB(j)  (1280 + 64 * (j))
#define XB_XGEN(j)  (2304 + 64 * (j))
#define XB_TOP      3328
#define XB_TOPGEN   3392
#define XCD_BAR_WORDS 3456
#define XB_SPIN_CAP (1u << 22)
#define LAS __attribute__((address_space(3)))
__device__ __forceinline__ unsigned xb_ld(unsigned* p)              { return __hip_atomic_load(p, __ATOMIC_RELAXED, __HIP_MEMORY_SCOPE_AGENT); }
__device__ __forceinline__ unsigned xb_add(unsigned* p, unsigned v) { return __hip_atomic_fetch_add(p, v, __ATOMIC_RELAXED, __HIP_MEMORY_SCOPE_AGENT); }
__device__ __forceinline__ unsigned xb_xcc_id() { return (unsigned)__builtin_amdgcn_s_getreg((3 << 11) | 20) & 0xFu; }
#define XB_SPIN(cond, bar) do { unsigned _sp = 0; while (cond) { __builtin_amdgcn_s_sleep(1); \
    if ((++_sp & 255u) == 0u) { if (xb_ld(&(bar)[XB_TMO])) break; if (_sp > XB_SPIN_CAP) { atomicAdd(&(bar)[XB_TMO], 1u); break; } } } } while (0)
struct XcdBarrier { unsigned* bar; unsigned x; volatile LAS unsigned* st; };
__device__ __forceinline__ XcdBarrier xcd_barrier_post(unsigned* bar, volatile LAS unsigned* st) {
    XcdBarrier b; b.bar = bar; b.x = xb_xcc_id(); b.st = st;
    if (threadIdx.x == 0) (void)xb_add(&bar[XB_XCNT(b.x)], 1u);
    return b;
}
__device__ __forceinline__ void xcd_barrier_complete(unsigned* bar, unsigned x, unsigned& nloc, unsigned& nx) {
    const unsigned G = gridDim.x;
    unsigned sum, cnt, mine, sp = 0u;
    for (;;) {
        sum = 0u; cnt = 0u; mine = 0u;
#pragma unroll
        for (unsigned j = 0; j < 16; ++j) { const unsigned c = xb_ld(&bar[XB_XCNT(j)]); sum += c; cnt += (c > 0u) ? 1u : 0u; mine = (j == x) ? c : mine; }
        if (sum == G) break;
        __builtin_amdgcn_s_sleep(1);
        if ((++sp & 255u) == 0u) { if (xb_ld(&bar[XB_TMO])) break; if (sp > XB_SPIN_CAP) { atomicAdd(&bar[XB_TMO], 1u); break; } }
    }
    nloc = mine > 0u ? mine : 1u; nx = cnt > 0u ? cnt : 1u;
}
__device__ __forceinline__ void xcd_barrier(const XcdBarrier& b) {
    asm volatile("s_waitcnt vmcnt(0)" ::: "memory");
    __syncthreads();
    if (threadIdx.x == 0) {
        unsigned* bar = b.bar;
        __builtin_amdgcn_s_waitcnt(0);
        unsigned nloc = b.st[0], nx = b.st[1];
        if (nloc == 0u) { xcd_barrier_complete(bar, b.x, nloc, nx); b.st[0] = nloc; b.st[1] = nx; }
        const unsigned old = xb_add(&bar[XB_XSUB(b.x)], 1u);
        const unsigned gen = old / nloc;
        if (old + 1u == (gen + 1u) * nloc) {
            __builtin_amdgcn_fence(__ATOMIC_RELEASE, "agent");
            asm volatile("s_waitcnt vmcnt(0)" ::: "memory");
            const unsigned og = xb_add(&bar[XB_TOP], 1u);
            const unsigned tg = og / nx;
            if (og + 1u == (tg + 1u) * nx) xb_add(&bar[XB_TOPGEN], 1u);
            else XB_SPIN(xb_ld(&bar[XB_TOPGEN]) == tg, bar);
            __builtin_amdgcn_fence(__ATOMIC_ACQUIRE, "agent");
            asm volatile("s_waitcnt vmcnt(0)" ::: "memory");
        } else {
            XB_SPIN(xb_ld(&bar[XB_TOPGEN]) == gen, bar);
            __builtin_amdgcn_fence(__ATOMIC_ACQUIRE, "agent");
            asm volatile("s_waitcnt vmcnt(0)" ::: "memory");
        }
    }
    __syncthreads();
}

#ifndef PROBE_PHASE
#define PROBE_PHASE -1
#endif
#define PH_BEGIN(k) if (PROBE_PHASE == (k)) probe_t0 = __builtin_amdgcn_s_memrealtime();
#define PH_END(k)   if (PROBE_PHASE == (k)) probe_dt = __builtin_amdgcn_s_memrealtime() - probe_t0;
constexpr int SMEM_BYTES = 128 * 132 * 4 + 1024;

__global__ void __launch_bounds__(512, 2) fwd_megakernel(Params p) {
    __shared__ __attribute__((aligned(16))) unsigned char smem_all[2 * SMEM_BYTES + 32];
    if (threadIdx.x == 0) { *(uint4*)(smem_all + 2 * SMEM_BYTES) = make_uint4(0u, 0u, 0u, 0u); *(uint4*)(smem_all + 2 * SMEM_BYTES + 16) = make_uint4(0u, 0u, 0u, 0u); }
    __syncthreads();
    const XcdBarrier xb = xcd_barrier_post((unsigned*)(p.ws + OFF_BAR), (volatile LAS unsigned*)(smem_all + 2 * SMEM_BYTES));
    const int nb = vnb();
#define PHASE_IDS int vb_ = threadIdx.x >> 8; asm volatile("" : "+v"(vb_)); const int vb = vb_, bid = (int)blockIdx.x + vb * (int)gridDim.x, tid = tidx(), lane = tid & 63, wid = tid >> 6; unsigned char* smem = smem_all + vb * SMEM_BYTES; (void)bid; (void)tid; (void)lane; (void)wid; (void)smem;
    unsigned char* ws = p.ws; unsigned char* dob = (unsigned char*)p.out;
    unsigned long long probe_t0 = 0, probe_dt = 0;
    PH_BEGIN(0)
    { PHASE_IDS
    {
        auto unit_desc = [&](int u0) {
            const int u = u0 < 3232 ? u0 : 3231;
            ConvT c;
            if (u < 1600) c = ConvT{p.w_in, (bf16_t*)(ws + OFF_WINT), 1024, INW, u, nullptr};
            else if (u < 1856) c = ConvT{p.w_mem_kv, (bf16_t*)(ws + OFF_WMKVT), 1024, 1024, u - 1600, nullptr};
            else if (u < 2048) c = ConvT{p.p_attn, (bf16_t*)(ws + OFF_PATTNT), 768, 1024, u - 1856, nullptr};
            else if (u < 2240) c = ConvT{p.p_lru, (bf16_t*)(ws + OFF_PLRUT), 768, 1024, u - 2048, nullptr};
            else if (u < 2368) c = ConvT{p.p_mem, (bf16_t*)(ws + OFF_PMEMT), 512, 1024, u - 2240, nullptr};
            else if (u < 2624) c = ConvT{p.w_out, (bf16_t*)(ws + OFF_WOUTT), 1024, 1024, u - 2368, nullptr};
            else if (u < 3136) c = ConvT{p.w_peer_q, (bf16_t*)(ws + OFF_WPQT), 1024, 2048, u - 2624, p.g_ffn};
            else {
                const int v = u - 3136, mat = v >> 2, tile = v & 3, gsel = mat / 6, h = mat % 6, dir = gsel & 1;
                c = ConvT{(gsel < 2 ? p.lru_wr : p.lru_wi) + (size_t)(dir * 6 + h) * 128 * 128, (bf16_t*)(ws + OFF_LRUWT) + (size_t)(h * 512 + gsel * 128) * 128, 128, 128, tile, nullptr};
            }
            return c;
        };
        {
            const int uend = 3232 + nb - 1 - (3231 % nb);
            ConvT cur = unit_desc(bid);
            float4 v[4];
            convT_load(cur, v);
            for (int u0 = bid; u0 < uend; u0 += nb) {
                const ConvT nxt = unit_desc(u0 + nb);
                float4 nv[4];
                convT_load(nxt, nv);
                convT_finish(cur, v, smem);
                cur = nxt;
#pragma unroll
                for (int i = 0; i < 4; ++i) v[i] = nv[i];
            }
        }
        conv_plain(p.peer_sub_keys, (bf16_t*)(ws + OFF_SUBK), (size_t)16 * 128 * 128 / 8);
        table_rows_pipelined(p, bid * 4 + wid, nb * 4, lane);
        rms_rows_pipelined(p.x, p.g_mix, (bf16_t*)(dob + DO_HBF), NTOK, bid * 4 + wid, nb * 4, lane);
        rms_rows_pipelined(p.mem, p.g_mem, (bf16_t*)(dob + DO_MEMBF), NMEM, bid * 4 + wid, nb * 4, lane);
        for (int i = bid * 256 + tid; i < NTOK * 16; i += nb * 256) rope_item(p.positions, (float*)(dob + DO_ROPE), i);
        for (int i = bid * 256 + tid; i < NTOK; i += nb * 256) { ((float*)(ws + OFF_ROWSS))[i] = 0.f; ((float*)(ws + OFF_ROWSS1))[i] = 0.f; }
        for (int i = bid * 256 + tid; i < 2 * LW; i += nb * 256) ((float*)(ws + OFF_SP8))[i] = -8.0f * 1.4426950408889634f * log1pf(__expf(-p.lru_lambda[i]));
    }
    xcd_barrier(xb);
    PH_END(0) PH_BEGIN(1)
    }
    { PHASE_IDS
    {
        const pg8::Gemm g{(const bf16_t*)(dob + DO_HBF), (const bf16_t*)(ws + OFF_WINT), NTOK, INW, 1024};
        pg8::StaticOrder S; S.init(NTOK, INW, (int)gridDim.x, (int)blockIdx.x);
        __syncthreads();
        pg8::gemm_phase<pg8::EpiInproj, pg8::StaticOrder, true, true>((PG8_LAS unsigned char*)smem_all, g, S, pg8::EpiInproj{ws, (const float*)(dob + DO_ROPE), p.gate_b});
    }
    }
    { PHASE_IDS
    { const bool tail = gridDim.x == 256; const int u = tail ? ((int)blockIdx.x - 128) + vb * 128 : (bid & 255);
      if (!tail || blockIdx.x >= 128) memkv_tile(p, u / 8, u % 8, smem); }
    xcd_barrier(xb);
    PH_END(1) PH_BEGIN(2)
    }
    { PHASE_IDS
    {
        unsigned* ctr = (unsigned*)(p.ws + OFF_BAR) + 3600;
        volatile LAS unsigned* slot = (volatile LAS unsigned*)(smem_all + 2 * SMEM_BYTES + 16);
        for (;;) {
            if (threadIdx.x == 0) *slot = xb_add(ctr, 2u);
            __syncthreads();
            const int u = (int)*slot + vb;
            __syncthreads();
            if (u >= 1536 + 1536 + 1024) break;
            if (u < 1536) lru_chunk_unit<true>(p, u, smem);
            else if (u < 1536 + 1536) attn_win_unit(p, u - 1536, smem);
            else attn_mem_unit(p, u - 1536 - 1536, smem);
        }
    }
    xcd_barrier(xb);
    }
    { PHASE_IDS
    for (int u = bid; u < 1536; u += nb) lru_fixup_unit(p, u);
    xcd_barrier(xb);
    PH_END(2) PH_BEGIN(3)
    }
    { PHASE_IDS
    {
        pg8::StaticOrder S; S.init(NTOK, 1024, (int)gridDim.x, (int)blockIdx.x);
        const bf16_t* G = (const bf16_t*)(ws + OFF_GATES); bf16_t* mg = (bf16_t*)(ws + OFF_MERGED);
        __syncthreads();
        { const pg8::Gemm g{(const bf16_t*)(ws + OFF_QA), (const bf16_t*)(ws + OFF_PATTNT), NTOK, 1024, 768};
          pg8::gemm_phase<pg8::EpiMerge, pg8::StaticOrder, true, true>((PG8_LAS unsigned char*)smem_all, g, S, pg8::EpiMerge{G, mg, 0}); }
        { const pg8::Gemm g{(const bf16_t*)(ws + OFF_GL), (const bf16_t*)(ws + OFF_PLRUT), NTOK, 1024, 768};
          pg8::gemm_phase<pg8::EpiMerge, pg8::StaticOrder, true, true>((PG8_LAS unsigned char*)smem_all, g, S, pg8::EpiMerge{G, mg, 1}); }
        { const pg8::Gemm g{(const bf16_t*)(ws + OFF_QM), (const bf16_t*)(ws + OFF_PMEMT), NTOK, 1024, 512};
          pg8::gemm_phase<pg8::EpiMerge, pg8::StaticOrder, true, true>((PG8_LAS unsigned char*)smem_all, g, S, pg8::EpiMerge{G, mg, 2}); }
    }
    xcd_barrier(xb);
    PH_END(3) PH_BEGIN(4)
    }
    { PHASE_IDS
    {
        const pg8::Gemm g{(const bf16_t*)(ws + OFF_MERGED), (const bf16_t*)(ws + OFF_WOUTT), NTOK, 1024, 1024};
        pg8::StaticOrder S; S.init(NTOK, 1024, (int)gridDim.x, (int)blockIdx.x);
        __syncthreads();
        pg8::gemm_phase<pg8::EpiOutproj, pg8::StaticOrder, true, true>((PG8_LAS unsigned char*)smem_all, g, S, pg8::EpiOutproj{p.x, ws, (float*)(ws + OFF_ROWSS1)});
    }
    xcd_barrier(xb);
    PH_END(4) PH_BEGIN(6)
    }
    { PHASE_IDS
    {
        const pg8::Gemm g{(const bf16_t*)(ws + OFF_XB), (const bf16_t*)(ws + OFF_WPQT), NTOK, 2048, 1024};
        pg8::StaticOrder S; S.init(NTOK, 2048, (int)gridDim.x, (int)blockIdx.x);
        bf16_t* qp = (bf16_t*)(ws + OFF_QPEER); const float* rss = (const float*)(ws + OFF_ROWSS1);
        auto f = [=](int row, int col, float (&v)[8]) {
            const float rs = rsqrtf(rss[row] * (1.0f / 1024.0f) + EPS);
#pragma unroll
            for (int e = 0; e < 8; ++e) v[e] *= rs;
            store_bf16x8(qp + (size_t)row * 2048 + col, v); };
        pg8::gemm_phase<pg8::EpiFn<decltype(f)>, pg8::StaticOrder, true, true>((PG8_LAS unsigned char*)smem_all, g, S, pg8::EpiFn<decltype(f)>{f});
    }
    asm volatile("s_waitcnt vmcnt(0)" ::: "memory");
    __syncthreads();
    PH_END(6) PH_BEGIN(7)
    }
    { PHASE_IDS
    { pg8::StaticOrder S; S.init(NTOK, 2048, (int)gridDim.x, (int)blockIdx.x); pg8::Unit u;
      for (int i = 0; S.next(i, u); ++i) scores_tile(p, 2 * u.pm + vb, u.pn, smem); }
    xcd_barrier(xb);
    PH_END(7) PH_BEGIN(9)
    }
    { PHASE_IDS
    {
        const int x = (int)blockIdx.x & 7, tstep = (nb >> 3) * 4;
        peer_u_pass(p, (bid >> 2) * 4 + wid, (nb >> 2) * 4, x & 3, lane);
        xcd_barrier(xb);
        for (int t = bid * 4 + wid; t < NTOK; t += nb * 8) peer_coef_tokens(p, t, t + nb * 4, lane);
        xcd_barrier(xb);
        peer_v_pass(p, (bid >> 2) * 4 + wid, (nb >> 2) * 4, x & 3, lane);
        xcd_barrier(xb);
        final_norm_rows(p, bid * 4 + wid, nb * 4, lane);
    }
    }
    PH_END(9)
    if (PROBE_PHASE >= 0) { __syncthreads(); const unsigned long long t1 = __builtin_amdgcn_s_memrealtime(); while (__builtin_amdgcn_s_memrealtime() - t1 < probe_dt) __builtin_amdgcn_s_sleep(8); }
}

extern "C" void kernel_launch(void* const* d_in, const int* in_sizes, int n_in, void* d_out, int out_size, void* d_ws, size_t ws_size, hipStream_t stream) {
    if (ws_size < OFF_END) { fprintf(stderr, "workspace too small: %zu < %zu\n", ws_size, (size_t)OFF_END); return; }
    Params p{};
    p.x = (const float*)d_in[0]; p.mem = (const float*)d_in[1]; p.positions = (const int*)d_in[2];
    p.g_mix = (const float*)d_in[3]; p.g_mem = (const float*)d_in[4]; p.w_in = (const float*)d_in[5]; p.gate_b = (const float*)d_in[6];
    p.attn_sink = (const float*)d_in[7]; p.conv_w = (const float*)d_in[8]; p.conv_b = (const float*)d_in[9];
    p.lru_wr = (const float*)d_in[10]; p.lru_br = (const float*)d_in[11]; p.lru_wi = (const float*)d_in[12]; p.lru_bi = (const float*)d_in[13];
    p.lru_lambda = (const float*)d_in[14]; p.w_mem_kv = (const float*)d_in[15]; p.p_attn = (const float*)d_in[16]; p.p_lru = (const float*)d_in[17];
    p.p_mem = (const float*)d_in[18]; p.w_out = (const float*)d_in[19]; p.g_ffn = (const float*)d_in[20]; p.w_peer_q = (const float*)d_in[21];
    p.peer_sub_keys = (const float*)d_in[22]; p.peer_u = (const float*)d_in[23]; p.peer_v = (const float*)d_in[24]; p.g_final = (const float*)d_in[25];
    p.out = (float*)d_out; p.ws = (unsigned char*)d_ws;
    static int grid_blocks = 0;
    if (!grid_blocks) {
        int dev = 0, cus = 0, per_cu = 0;
        (void)hipGetDevice(&dev);
        (void)hipDeviceGetAttribute(&cus, hipDeviceAttributeMultiprocessorCount, dev);
        (void)hipOccupancyMaxActiveBlocksPerMultiprocessor(&per_cu, fwd_megakernel, 512, 0);
        if (per_cu > 1) per_cu = 1;
        grid_blocks = cus * per_cu;
    }
    (void)hipMemsetAsync((unsigned char*)d_ws + OFF_BAR, 0, 16384, stream);
    void* args[] = {&p};
    hipError_t e = hipLaunchCooperativeKernel((void*)fwd_megakernel, dim3(grid_blocks), dim3(512), args, 0, stream);
    if (e != hipSuccess) fprintf(stderr, "cooperative launch failed: %s (grid %d)\n", hipGetErrorString(e), grid_blocks);
}
```
